# Optimizing an MI355X kernel written in HIP

```python
import math
import jax
import jax.numpy as jnp
from jax import lax
import numpy as np

D_MODEL = 1024
BATCH = 2
SEQ = 8192
DEPTH = 2

CHUNK = 64
MEM_LEN = 256
EPS = 1e-6

SC_DIM = 512
SC_WIDTH = 3
SSM_HEADS = 16
SSM_HEAD_DIM = 64
SSM_INNER = SSM_HEADS * SSM_HEAD_DIM
SSM_GROUPS = 2
SSM_STATE = 128
SSM_CONV = 4
SSM_CONV_DIM = SSM_INNER + 2 * SSM_GROUPS * SSM_STATE
GDN_HEADS = 8
GDN_DK = 128
GDN_DV = 128
GDN_CONV = 4
GDN_QK = GDN_HEADS * GDN_DK
GDN_V = GDN_HEADS * GDN_DV
SB_HEADS = 8
SB_HEAD_DIM = 64
SB_DIM = SB_HEADS * SB_HEAD_DIM
SB_BLOCK = 128
XA_HEADS = 4
XA_HEAD_DIM = D_MODEL // XA_HEADS
MOE_GROUPS = 4
MOE_EXPERTS_PER_GROUP = 8
MOE_EXPERTS = MOE_GROUPS * MOE_EXPERTS_PER_GROUP
MOE_TOPK = 2
MOE_FF = 512
MOE_BLOCK = 128

EVEN_SPLITS = (SC_DIM, 2 * SC_DIM, 3 * SC_DIM, 3 * SC_DIM + SSM_INNER, 3 * SC_DIM + SSM_INNER + SSM_CONV_DIM)
EVEN_IN = 3 * SC_DIM + SSM_INNER + SSM_CONV_DIM + SSM_HEADS
EVEN_MIX = SC_DIM + SSM_INNER
GDN_QKV = 2 * GDN_QK + GDN_V
ODD_SPLITS = (GDN_QKV, GDN_QKV + GDN_V, GDN_QKV + GDN_V + GDN_HEADS, GDN_QKV + GDN_V + 2 * GDN_HEADS, GDN_QKV + GDN_V + 2 * GDN_HEADS + SB_DIM, GDN_QKV + GDN_V + 2 * GDN_HEADS + 2 * SB_DIM)
ODD_IN = GDN_QKV + GDN_V + 2 * GDN_HEADS + 3 * SB_DIM
ODD_MIX = GDN_V + SB_DIM

kernel_name = 'hybrid_conv_ssd_deltanet_stickbreak_hmoe'


def rmsnorm(x, g):
    xf = x.astype(jnp.float32)
    y = xf * lax.rsqrt(jnp.mean(xf * xf, axis=-1, keepdims=True) + EPS)
    return (y * g.astype(jnp.float32)).astype(x.dtype)


def l2norm(x):
    return x * lax.rsqrt(jnp.sum(x * x, axis=-1, keepdims=True) + EPS)


def causal_dwconv(x, w):
    width = w.shape[0]
    length = x.shape[1]
    xp = jnp.pad(x, ((0, 0), (width - 1, 0), (0, 0)))
    return sum(xp[:, j:j + length] * w[j] for j in range(width))


def short_conv_mixer(b_gate, c_gate, x_in, w_conv):
    return b_gate * causal_dwconv(c_gate * x_in, w_conv)


def ssd_mixer(z, xbc, dt, conv_w, conv_b, dt_bias, a_log, d_skip, norm_w):
    f32 = jnp.float32
    bsz, length, _ = z.shape
    nc = length // CHUNK
    hpg = SSM_HEADS // SSM_GROUPS
    xbc = jax.nn.silu(causal_dwconv(xbc, conv_w) + conv_b).astype(f32)
    xs, bm, cm = jnp.split(xbc, (SSM_INNER, SSM_INNER + SSM_GROUPS * SSM_STATE), axis=-1)
    xs = xs.reshape(bsz, nc, CHUNK, SSM_GROUPS, hpg, SSM_HEAD_DIM)
    bm = bm.reshape(bsz, nc, CHUNK, SSM_GROUPS, SSM_STATE)
    cm = cm.reshape(bsz, nc, CHUNK, SSM_GROUPS, SSM_STATE)
    dt = jax.nn.softplus(dt.astype(f32) + dt_bias.astype(f32)).reshape(bsz, nc, CHUNK, SSM_GROUPS, hpg)
    a = -jnp.exp(a_log.astype(f32)).reshape(SSM_GROUPS, hpg)
    a_cs = jnp.cumsum(dt * a, axis=2)
    causal = jnp.tril(jnp.ones((CHUNK, CHUNK), dtype=bool))
    seg = a_cs[:, :, :, None] - a_cs[:, :, None, :]
    decay = jnp.exp(jnp.where(causal[:, :, None, None], seg, -jnp.inf))
    xdt = xs * dt[..., None]
    cb = jnp.einsum('bctgn,bcsgn->bctsg', cm, bm)
    y_diag = jnp.einsum('bctsgh,bcsghp->bctghp', cb[..., None] * decay, xdt)
    to_end = jnp.exp(a_cs[:, :, -1:] - a_cs)
    states = jnp.einsum('bcsgn,bcsghp->bcghpn', bm, xdt * to_end[..., None])
    chunk_decay = jnp.exp(a_cs[:, :, -1])

    def step(s, inp):
        st, dec = inp
        return s * dec[..., None, None] + st, s

    s0 = jnp.zeros((bsz, SSM_GROUPS, hpg, SSM_HEAD_DIM, SSM_STATE), f32)
    _, prev = lax.scan(step, s0, (jnp.moveaxis(states, 1, 0), jnp.moveaxis(chunk_decay, 1, 0)))
    prev = jnp.moveaxis(prev, 0, 1)
    y_off = jnp.einsum('bctgn,bcghpn->bctghp', cm, prev) * jnp.exp(a_cs)[..., None]
    y = y_diag + y_off + xs * d_skip.astype(f32).reshape(SSM_GROUPS, hpg, 1)
    y = y.reshape(bsz, length, SSM_INNER) * jax.nn.silu(z.astype(f32))
    yg = y.reshape(bsz, length, SSM_GROUPS, SSM_INNER // SSM_GROUPS)
    yg = yg * lax.rsqrt(jnp.mean(yg * yg, axis=-1, keepdims=True) + EPS)
    return yg.reshape(bsz, length, SSM_INNER) * norm_w.astype(f32)


def gated_deltanet_mixer(qkv, z, a, b, conv_w, dt_bias, a_log, norm_w):
    f32 = jnp.float32
    bsz, length, _ = qkv.shape
    nc = length // CHUNK
    qkv = jax.nn.silu(causal_dwconv(qkv, conv_w)).astype(f32)
    q, k, v = jnp.split(qkv, (GDN_QK, 2 * GDN_QK), axis=-1)

    def to_chunks(t, d):
        return t.reshape(bsz, nc, CHUNK, GDN_HEADS, d).transpose(0, 3, 1, 2, 4)

    q = to_chunks(l2norm(q.reshape(bsz, length, GDN_HEADS, GDN_DK)) * GDN_DK ** -0.5, GDN_DK)
    k = to_chunks(l2norm(k.reshape(bsz, length, GDN_HEADS, GDN_DK)), GDN_DK)
    v = to_chunks(v, GDN_DV)
    beta = jax.nn.sigmoid(b.astype(f32)).reshape(bsz, nc, CHUNK, GDN_HEADS).transpose(0, 3, 1, 2)
    g = -jnp.exp(a_log.astype(f32)) * jax.nn.softplus(a.astype(f32) + dt_bias.astype(f32))
    g = g.reshape(bsz, nc, CHUNK, GDN_HEADS).transpose(0, 3, 1, 2)
    gc = jnp.cumsum(g, axis=-1)
    incl = jnp.tril(jnp.ones((CHUNK, CHUNK), dtype=bool))
    strict = jnp.tril(jnp.ones((CHUNK, CHUNK), f32), -1)
    decay = jnp.exp(jnp.where(incl, gc[..., :, None] - gc[..., None, :], -jnp.inf))
    kb = k * beta[..., None]
    lower = jnp.einsum('bhctd,bhcsd->bhcts', kb, k) * decay * strict
    rhs = jnp.concatenate([v * beta[..., None], kb * jnp.exp(gc)[..., None]], axis=-1)
    sol = lax.linalg.triangular_solve(lower + jnp.eye(CHUNK, dtype=f32), rhs,
                                      left_side=True, lower=True, unit_diagonal=True)
    u, w = jnp.split(sol, (GDN_DV,), axis=-1)
    a_qk = jnp.einsum('bhctd,bhcsd->bhcts', q, k) * decay
    q_dec = q * jnp.exp(gc)[..., None]
    k_dec = k * jnp.exp(gc[..., -1:] - gc)[..., None]
    chunk_decay = jnp.exp(gc[..., -1])

    def step(s, inp):
        qd, kd, uc, wc, aqk, dec = inp
        v_new = uc - jnp.einsum('bhld,bhdv->bhlv', wc, s)
        o = jnp.einsum('bhld,bhdv->bhlv', qd, s) + jnp.einsum('bhts,bhsv->bhtv', aqk, v_new)
        s = s * dec[..., None, None] + jnp.einsum('bhld,bhlv->bhdv', kd, v_new)
        return s, o

    s0 = jnp.zeros((bsz, GDN_HEADS, GDN_DK, GDN_DV), f32)
    seq_in = (q_dec, k_dec, u, w, a_qk, chunk_decay)
    _, o = lax.scan(step, s0, (jnp.moveaxis(seq_in[0], 2, 0), jnp.moveaxis(seq_in[1], 2, 0),
                               jnp.moveaxis(seq_in[2], 2, 0), jnp.moveaxis(seq_in[3], 2, 0),
                               jnp.moveaxis(seq_in[4], 2, 0), jnp.moveaxis(seq_in[5], 2, 0)))
    o = o.transpose(1, 0, 3, 2, 4).reshape(bsz, length, GDN_HEADS, GDN_DV)
    o = o * lax.rsqrt(jnp.mean(o * o, axis=-1, keepdims=True) + EPS) * norm_w.astype(f32)
    o = o * jax.nn.silu(z.astype(f32).reshape(bsz, length, GDN_HEADS, GDN_DV))
    return o.reshape(bsz, length, GDN_V)


def stick_breaking_mixer(q, k, v):
    bsz, length, _ = q.shape
    nb = length // SB_BLOCK

    def heads(t):
        return t.reshape(bsz, length, SB_HEADS, SB_HEAD_DIM).transpose(0, 2, 1, 3)

    q, k, v = heads(q), heads(k), heads(v)
    q_blocks = q.reshape(bsz, SB_HEADS, nb, SB_BLOCK, SB_HEAD_DIM).transpose(2, 0, 1, 3, 4)
    k_pos = jnp.arange(length)
    scale = SB_HEAD_DIM ** -0.5

    def block(args):
        qb, blk = args
        logits = jnp.einsum('bhqd,bhkd->bhqk', qb, k).astype(jnp.float32) * scale
        q_pos = blk * SB_BLOCK + jnp.arange(SB_BLOCK)
        earlier = k_pos[None, :] < q_pos[:, None]
        log_keep = jnp.where(earlier, jax.nn.log_sigmoid(-logits), 0.0)
        log_between = lax.cumsum(log_keep, axis=3, reverse=True) - log_keep
        log_w = jnp.where(earlier, jax.nn.log_sigmoid(logits) + log_between, -jnp.inf)
        return jnp.einsum('bhqk,bhkd->bhqd', jnp.exp(log_w).astype(v.dtype), v)

    out = lax.map(block, (q_blocks, jnp.arange(nb)))
    return out.transpose(1, 0, 3, 2, 4).reshape(bsz, length, SB_DIM)


def memory_cross_attention(h, memn, wq, wk, wv, wo):
    bsz, length, _ = h.shape
    m = memn.shape[1]
    q = (h @ wq).reshape(bsz, length, XA_HEADS, XA_HEAD_DIM)
    k = (memn @ wk).reshape(bsz, m, XA_HEADS, XA_HEAD_DIM)
    v = (memn @ wv).reshape(bsz, m, XA_HEADS, XA_HEAD_DIM)
    s = jnp.einsum('blhd,bmhd->bhlm', q, k).astype(jnp.float32) * XA_HEAD_DIM ** -0.5
    p = jax.nn.softmax(s, axis=-1).astype(v.dtype)
    o = jnp.einsum('bhlm,bmhd->blhd', p, v).reshape(bsz, length, D_MODEL)
    return o @ wo


def hierarchical_moe(x, w_group, b_group, w_expert, b_expert, w_gate, w_up, w_down):
    f32 = jnp.float32
    bsz, length, d = x.shape
    n_tok = bsz * length
    xf = x.reshape(n_tok, d)
    g_prob = jax.nn.softmax((xf @ w_group).astype(f32) + b_group.astype(f32), axis=-1)
    g_sel = jnp.argmax(g_prob, axis=-1)
    g_w = jnp.take_along_axis(g_prob, g_sel[:, None], axis=-1)
    e_logits = ((xf @ w_expert).astype(f32) + b_expert.astype(f32)).reshape(n_tok, MOE_GROUPS, MOE_EXPERTS_PER_GROUP)
    e_logits = jnp.take_along_axis(e_logits, g_sel[:, None, None], axis=1)[:, 0]
    top_p, top_i = lax.top_k(jax.nn.softmax(e_logits, axis=-1), MOE_TOPK)
    gate = g_w * top_p / jnp.sum(top_p, axis=-1, keepdims=True)
    eid = (g_sel[:, None] * MOE_EXPERTS_PER_GROUP + top_i).reshape(-1).astype(jnp.int32)
    tok = jnp.repeat(jnp.arange(n_tok, dtype=jnp.int32), MOE_TOPK)
    gw = gate.reshape(-1)
    n_assign = n_tok * MOE_TOPK
    order = jnp.argsort(eid)
    s_eid, s_tok, s_w = eid[order], tok[order], gw[order]
    counts = jax.ops.segment_sum(jnp.ones_like(eid), eid, num_segments=MOE_EXPERTS)
    starts = jnp.cumsum(counts) - counts
    padded = (counts + MOE_BLOCK - 1) // MOE_BLOCK * MOE_BLOCK
    pad_end = jnp.cumsum(padded)
    pad_start = pad_end - padded
    dest = pad_start[s_eid] + jnp.arange(n_assign, dtype=jnp.int32) - starts[s_eid]
    n_blocks = -(-(n_assign + MOE_EXPERTS * (MOE_BLOCK - 1)) // MOE_BLOCK)
    n_slots = n_blocks * MOE_BLOCK
    slot_tok = jnp.full((n_slots,), n_tok, jnp.int32).at[dest].set(s_tok)
    slot_w = jnp.zeros((n_slots,), f32).at[dest].set(s_w)
    block_eid = jnp.minimum(jnp.searchsorted(pad_end, jnp.arange(n_blocks, dtype=jnp.int32) * MOE_BLOCK, side='right'),
                            MOE_EXPERTS - 1)
    x_pad = jnp.concatenate([xf, jnp.zeros((1, d), xf.dtype)], axis=0)
    xs = x_pad[slot_tok].reshape(n_blocks, MOE_BLOCK, d)

    def expert_block(args):
        xb, e = args
        return (jax.nn.silu(xb @ w_gate[e]) * (xb @ w_up[e])) @ w_down[e]

    ys = lax.map(expert_block, (xs, block_eid)).reshape(n_slots, d)
    y = jnp.zeros((n_tok + 1, d), f32).at[slot_tok].add(ys.astype(f32) * slot_w[:, None])[:n_tok]
    return y.reshape(bsz, length, d).astype(x.dtype)


def even_mixer(u, w_in, sc_conv, ssm_conv_w, ssm_conv_b, ssm_dt_bias, ssm_a_log, ssm_d, ssm_norm, w_out):
    sc_b, sc_c, sc_x, z, xbc, dt = jnp.split(u @ w_in, EVEN_SPLITS, axis=-1)
    y_a = short_conv_mixer(sc_b, sc_c, sc_x, sc_conv)
    y_b = ssd_mixer(z, xbc, dt, ssm_conv_w, ssm_conv_b, ssm_dt_bias, ssm_a_log, ssm_d, ssm_norm).astype(u.dtype)
    return jnp.concatenate([y_a, y_b], axis=-1) @ w_out


def odd_mixer(u, w_in, gdn_conv, gdn_dt_bias, gdn_a_log, gdn_norm, w_out):
    qkv, z, a, b, sq, sk, sv = jnp.split(u @ w_in, ODD_SPLITS, axis=-1)
    y_c = gated_deltanet_mixer(qkv, z, a, b, gdn_conv, gdn_dt_bias, gdn_a_log, gdn_norm).astype(u.dtype)
    y_d = stick_breaking_mixer(sq, sk, sv).astype(u.dtype)
    return jnp.concatenate([y_c, y_d], axis=-1) @ w_out


def setup_inputs(seed: int = 0) -> dict:
    key = jax.random.key(seed)
    keys = iter(jax.random.split(key, 48))
    f32 = jnp.float32
    n_even = (DEPTH + 1) // 2
    n_odd = DEPTH // 2

    def normal(shape, scale):
        return jax.random.normal(next(keys), shape, f32) * scale

    def gain(shape):
        return 1.0 + normal(shape, 0.05)

    def dt_bias(shape):
        dt = jnp.exp(jax.random.uniform(next(keys), shape, f32, math.log(1e-3), math.log(1e-1)))
        return dt + jnp.log(-jnp.expm1(-dt))

    def a_log(shape):
        return jnp.log(jax.random.uniform(next(keys), shape, f32, 1.0, 16.0))

    sd = D_MODEL ** -0.5
    return {
        'x': normal((BATCH, SEQ, D_MODEL), 1.0),
        'mem': normal((BATCH, MEM_LEN, D_MODEL), 1.0),
        'mem_norm': gain((D_MODEL,)),
        'final_norm': gain((D_MODEL,)),
        'norm_mix': gain((DEPTH, D_MODEL)),
        'norm_xa': gain((DEPTH, D_MODEL)),
        'norm_ffn': gain((DEPTH, D_MODEL)),
        'xa_wq': normal((DEPTH, D_MODEL, D_MODEL), sd),
        'xa_wk': normal((DEPTH, D_MODEL, D_MODEL), sd),
        'xa_wv': normal((DEPTH, D_MODEL, D_MODEL), sd),
        'xa_wo': normal((DEPTH, D_MODEL, D_MODEL), sd),
        'moe_w_group': normal((DEPTH, D_MODEL, MOE_GROUPS), sd),
        'moe_b_group': normal((DEPTH, MOE_GROUPS), 0.01),
        'moe_w_expert': normal((DEPTH, D_MODEL, MOE_EXPERTS), sd),
        'moe_b_expert': normal((DEPTH, MOE_EXPERTS), 0.01),
        'moe_w_gate': normal((DEPTH, MOE_EXPERTS, D_MODEL, MOE_FF), sd),
        'moe_w_up': normal((DEPTH, MOE_EXPERTS, D_MODEL, MOE_FF), sd),
        'moe_w_down': normal((DEPTH, MOE_EXPERTS, MOE_FF, D_MODEL), MOE_FF ** -0.5),
        'ev_w_in': normal((n_even, D_MODEL, EVEN_IN), sd),
        'ev_sc_conv': normal((n_even, SC_WIDTH, SC_DIM), SC_WIDTH ** -0.5),
        'ev_ssm_conv_w': normal((n_even, SSM_CONV, SSM_CONV_DIM), SSM_CONV ** -0.5),
        'ev_ssm_conv_b': normal((n_even, SSM_CONV_DIM), 0.02),
        'ev_ssm_dt_bias': dt_bias((n_even, SSM_HEADS)),
        'ev_ssm_a_log': a_log((n_even, SSM_HEADS)),
        'ev_ssm_d': gain((n_even, SSM_HEADS)),
        'ev_ssm_norm': gain((n_even, SSM_INNER)),
        'ev_w_out': normal((n_even, EVEN_MIX, D_MODEL), EVEN_MIX ** -0.5),
        'od_w_in': normal((n_odd, D_MODEL, ODD_IN), sd),
        'od_gdn_conv': normal((n_odd, GDN_CONV, GDN_QKV), GDN_CONV ** -0.5),
        'od_gdn_dt_bias': dt_bias((n_odd, GDN_HEADS)),
        'od_gdn_a_log': a_log((n_odd, GDN_HEADS)),
        'od_gdn_norm': gain((n_odd, GDN_DV)),
        'od_w_out': normal((n_odd, ODD_MIX, D_MODEL), ODD_MIX ** -0.5),
    }


def reference(x, mem, mem_norm, final_norm, norm_mix, norm_xa, norm_ffn,
              xa_wq, xa_wk, xa_wv, xa_wo,
              moe_w_group, moe_b_group, moe_w_expert, moe_b_expert, moe_w_gate, moe_w_up, moe_w_down,
              ev_w_in, ev_sc_conv, ev_ssm_conv_w, ev_ssm_conv_b, ev_ssm_dt_bias, ev_ssm_a_log, ev_ssm_d,
              ev_ssm_norm, ev_w_out,
              od_w_in, od_gdn_conv, od_gdn_dt_bias, od_gdn_a_log, od_gdn_norm, od_w_out):
    memn = rmsnorm(mem, mem_norm)
    h = x
    for layer in range(DEPTH):
        i = layer // 2
        u = rmsnorm(h, norm_mix[layer])
        if layer % 2 == 0:
            mix = even_mixer(u, ev_w_in[i], ev_sc_conv[i], ev_ssm_conv_w[i], ev_ssm_conv_b[i],
                             ev_ssm_dt_bias[i], ev_ssm_a_log[i], ev_ssm_d[i], ev_ssm_norm[i], ev_w_out[i])
        else:
            mix = odd_mixer(u, od_w_in[i], od_gdn_conv[i], od_gdn_dt_bias[i], od_gdn_a_log[i],
                            od_gdn_norm[i], od_w_out[i])
        h = h + mix.astype(h.dtype)
        h = h + memory_cross_attention(rmsnorm(h, norm_xa[layer]), memn, xa_wq[layer], xa_wk[layer],
                                       xa_wv[layer], xa_wo[layer]).astype(h.dtype)
        h = h + hierarchical_moe(rmsnorm(h, norm_ffn[layer]), moe_w_group[layer], moe_b_group[layer],
                                 moe_w_expert[layer], moe_b_expert[layer], moe_w_gate[layer],
                                 moe_w_up[layer], moe_w_down[layer])
    return rmsnorm(h, final_norm)
```

```cpp
#include <hip/hip_runtime.h>
#include <cstdio>
#include <cstdint>
#ifndef MODE
#define MODE 1
#endif
#define XB_TMO      128
#define XB_XCNT(j)  (256  + 64 * (j))
#define XB_XSUB(j)  (1280 + 64 * (j))
#define XB_XGEN(j)  (2304 + 64 * (j))
#define XB_TOP      3328
#define XB_TOPGEN   3392
#define XCD_BAR_WORDS 3456
#define XB_SPIN_CAP (1u << 25)
#define LAS __attribute__((address_space(3)))

__device__ __forceinline__ unsigned xb_ld(unsigned* p)              { return __hip_atomic_load(p, __ATOMIC_RELAXED, __HIP_MEMORY_SCOPE_AGENT); }
__device__ __forceinline__ unsigned xb_add(unsigned* p, unsigned v) { return __hip_atomic_fetch_add(p, v, __ATOMIC_RELAXED, __HIP_MEMORY_SCOPE_AGENT); }
__device__ __forceinline__ unsigned xb_xcc_id() { return (unsigned)__builtin_amdgcn_s_getreg((3 << 11) | 20) & 0xFu; }
#define XB_SPIN(cond, bar) do { unsigned _sp = 0; while (cond) { __builtin_amdgcn_s_sleep(1); \
    if ((++_sp & 255u) == 0u) { if (xb_ld(&(bar)[XB_TMO])) break; if (_sp > XB_SPIN_CAP) { atomicAdd(&(bar)[XB_TMO], 1u); break; } } } } while (0)

struct XcdBarrier {
    unsigned* bar; unsigned x;
    volatile LAS unsigned* st;
};

__device__ __forceinline__ XcdBarrier xcd_barrier_post(unsigned* bar, volatile LAS unsigned* st) {
    XcdBarrier b; b.bar = bar; b.x = xb_xcc_id(); b.st = st;
    if (threadIdx.x == 0) (void)xb_add(&bar[XB_XCNT(b.x)], 1u);
    return b;
}
__device__ __forceinline__ void xcd_barrier_complete(unsigned* bar, unsigned x, unsigned& nloc, unsigned& nx) {
    const unsigned G = gridDim.x * gridDim.y * gridDim.z;
    unsigned sum, cnt, mine, sp = 0u;
    for (;;) {
        sum = 0u; cnt = 0u; mine = 0u;
#pragma unroll
        for (unsigned j = 0; j < 16; ++j) { const unsigned c = xb_ld(&bar[XB_XCNT(j)]); sum += c; cnt += (c > 0u) ? 1u : 0u; mine = (j == x) ? c : mine; }
        if (sum == G) break;
        __builtin_amdgcn_s_sleep(1);
        if ((++sp & 255u) == 0u) { if (xb_ld(&bar[XB_TMO])) break; if (sp > XB_SPIN_CAP) { atomicAdd(&bar[XB_TMO], 1u); break; } }
    }
    nloc = mine > 0u ? mine : 1u; nx = cnt > 0u ? cnt : 1u;
}

__device__ __forceinline__ void xcd_barrier(const XcdBarrier& b) {
    asm volatile("s_waitcnt vmcnt(0)" ::: "memory");
    __syncthreads();
    if (threadIdx.x == 0) {
        unsigned* bar = b.bar;
        __builtin_amdgcn_s_waitcnt(0);
        unsigned nloc = b.st[0], nx = b.st[1];
        if (nloc == 0u) { xcd_barrier_complete(bar, b.x, nloc, nx); b.st[0] = nloc; b.st[1] = nx; }
        const unsigned old = xb_add(&bar[XB_XSUB(b.x)], 1u);
        const unsigned gen = old / nloc;
        if (old + 1u == (gen + 1u) * nloc) {
            __builtin_amdgcn_fence(__ATOMIC_RELEASE, "agent");
            asm volatile("s_waitcnt vmcnt(0)" ::: "memory");
            const unsigned og = xb_add(&bar[XB_TOP], 1u);
            const unsigned tg = og / nx;
            if (og + 1u == (tg + 1u) * nx) xb_add(&bar[XB_TOPGEN], 1u);
            else XB_SPIN(xb_ld(&bar[XB_TOPGEN]) == tg, bar);
            __builtin_amdgcn_fence(__ATOMIC_ACQUIRE, "agent");
            xb_add(&bar[XB_XGEN(b.x)], 1u);
            asm volatile("s_waitcnt vmcnt(0)" ::: "memory");
        } else {
            XB_SPIN(xb_ld(&bar[XB_XGEN(b.x)]) == gen, bar);
            __builtin_amdgcn_fence(__ATOMIC_ACQUIRE, "agent");
            asm volatile("s_waitcnt vmcnt(0)" ::: "memory");
        }
    }
    __syncthreads();
}

#ifndef SEQ
#define SEQ 8192
#endif
namespace sm {
constexpr int DM = 1024, NB = 1  , L = SEQ, T = NB * L, NCH = L / 64, MEM = 256;
constexpr int EV_IN = 4112, OD_IN = 5648, PROJ_LD = 5648;
constexpr int E_SCB = 0, E_SCC = 512, E_SCX = 1024, E_Z = 1536, E_XBC = 2560, E_DT = 4096;
constexpr int O_QKV = 0, O_Z = 3072, O_A = 4096, O_B = 4104, O_SQ = 4112, O_SK = 4624, O_SV = 5136;

struct Ctx {
    const float* in[33];
    float* out;
    float *memn, *kx, *vx, *h, *un, *rstd, *proj, *cat, *xbcc, *dtv, *acs, *states, *cb, *ybuf, *rstd2;
    float *q, *att, *sc;
    float *gatew, *act; int* eid;
    float *qkvc, *beta, *gcs, *Lm, *aqk, *uw, *S, *vn, *obuf;
};
enum In { I_X = 0, I_MEM, I_MEM_NORM, I_FINAL_NORM, I_NORM_MIX, I_NORM_XA, I_NORM_FFN, I_XA_WQ, I_XA_WK, I_XA_WV, I_XA_WO,
          I_MOE_WG, I_MOE_BG, I_MOE_WE, I_MOE_BE, I_MOE_WGATE, I_MOE_WUP, I_MOE_WDOWN,
          I_EV_WIN, I_EV_SCCONV, I_EV_CONVW, I_EV_CONVB, I_EV_DTB, I_EV_ALOG, I_EV_D, I_EV_NORM, I_EV_WOUT,
          I_OD_WIN, I_OD_CONV, I_OD_DTB, I_OD_ALOG, I_OD_NORM, I_OD_WOUT };

__device__ __forceinline__ float siluf(float x) { return x / (1.f + expf(-x)); }
__device__ __forceinline__ float softplusf(float x) { return x > 20.f ? x : log1pf(expf(x)); }
__device__ __forceinline__ float sigmoidf(float x) { return 1.f / (1.f + expf(-x)); }

__device__ __forceinline__ void s_copy(const float* src, float* dst, size_t n, size_t gid, size_t gs) { for (size_t i = gid; i < n; i += gs) dst[i] = src[i]; }
__device__ __forceinline__ void s_rstd(const float* x, int R, int W, int ld, float* rstd, size_t gid, size_t gs) {
    for (size_t r = gid; r < (size_t)R; r += gs) { const float* p = x + r * ld; float s = 0.f; for (int i = 0; i < W; ++i) s += p[i] * p[i]; rstd[r] = 1.f / sqrtf(s / W + 1e-6f); }
}
__device__ __forceinline__ void s_norm(const float* x, const float* rstd, const float* g, float* y, int R, size_t gid, size_t gs) {
    for (size_t i = gid; i < (size_t)R * DM; i += gs) { const size_t r = i / DM; const int c = (int)(i % DM); y[i] = x[i] * rstd[r] * g[c]; }
}
__device__ __forceinline__ void s_gemm(const float* A, int lda, const float* W, int ldw, float* C, int ldc, int M, int N, int K, int accum, size_t gid, size_t gs) {
    const int N4 = N / 4;
    for (size_t i = gid; i < (size_t)M * N4; i += gs) { const size_t m = i / N4; const int n = (int)(i % N4) * 4; const float* a = A + m * lda; const float* w = W + n; float s0 = 0.f, s1 = 0.f, s2 = 0.f, s3 = 0.f;
        for (int k = 0; k < K; ++k) { const float av = a[k]; const float4 wv = *(const float4*)(w + (size_t)k * ldw); s0 += av * wv.x; s1 += av * wv.y; s2 += av * wv.z; s3 += av * wv.w; }
        float4* c = (float4*)(C + m * ldc + n); float4 o = accum ? *c : float4{0.f, 0.f, 0.f, 0.f}; o.x += s0; o.y += s1; o.z += s2; o.w += s3; *c = o; }
}
__device__ __forceinline__ void s_scmix(const Ctx& c, size_t gid, size_t gs) {
    const float* w = c.in[I_EV_SCCONV];
    for (size_t i = gid; i < (size_t)T * 512; i += gs) { const size_t t = i / 512; const int ch = (int)(i % 512); const int tl = (int)(t % L); float s = 0.f;
        for (int j = 0; j < 3; ++j) { const int tt = tl - 2 + j; if (tt >= 0) { const float* p = c.proj + (t - 2 + j) * PROJ_LD; s += w[j * 512 + ch] * p[E_SCC + ch] * p[E_SCX + ch]; } }
        c.cat[t * 1536 + ch] = c.proj[t * PROJ_LD + E_SCB + ch] * s; }
}
__device__ __forceinline__ void s_ssd_conv(const Ctx& c, size_t gid, size_t gs) {
    const float* w = c.in[I_EV_CONVW]; const float* b = c.in[I_EV_CONVB];
    for (size_t i = gid; i < (size_t)T * 1536; i += gs) { const size_t t = i / 1536; const int ch = (int)(i % 1536); const int tl = (int)(t % L); float s = b[ch];
        for (int j = 0; j < 4; ++j) { const int tt = tl - 3 + j; if (tt >= 0) s += w[j * 1536 + ch] * c.proj[(t - 3 + j) * PROJ_LD + E_XBC + ch]; }
        c.xbcc[i] = siluf(s); }
}
__device__ __forceinline__ void s_ssd_dt(const Ctx& c, size_t gid, size_t gs) {
    for (size_t i = gid; i < (size_t)NB * NCH * 16; i += gs) { const int hd = (int)(i % 16); const size_t bc = i / 16; const float a = -expf(c.in[I_EV_ALOG][hd]); float cs = 0.f;
        for (int s = 0; s < 64; ++s) { const size_t t = bc * 64 + s; const float dt = softplusf(c.proj[t * PROJ_LD + E_DT + hd] + c.in[I_EV_DTB][hd]); cs += dt * a; c.dtv[t * 16 + hd] = dt; c.acs[t * 16 + hd] = cs; } }
}
__device__ __forceinline__ void s_ssd_states(const Ctx& c, size_t gid, size_t gs) {
    for (size_t i = gid; i < (size_t)NB * NCH * 16 * 64 * 128; i += gs) { const int n = (int)(i % 128); const int p = (int)((i / 128) % 64); const int hd = (int)((i / 8192) % 16); const size_t bc = i / (8192 * 16);
        const int g = hd / 8; const float last = c.acs[(bc * 64 + 63) * 16 + hd]; float s = 0.f;
        for (int k = 0; k < 64; ++k) { const size_t t = bc * 64 + k; s += c.xbcc[t * 1536 + 1024 + g * 128 + n] * c.xbcc[t * 1536 + hd * 64 + p] * c.dtv[t * 16 + hd] * expf(last - c.acs[t * 16 + hd]); }
        c.states[i] = s; }
}
__device__ __forceinline__ void s_ssd_scan(const Ctx& c, size_t gid, size_t gs) {
    for (size_t i = gid; i < (size_t)NB * 16 * 8192; i += gs) { const size_t b = i / (16 * 8192); const size_t r = i % (16 * 8192); const int hd = (int)(r / 8192); float s = 0.f;
        for (int ch = 0; ch < NCH; ++ch) { const size_t bc = b * NCH + ch; const size_t idx = bc * (16 * 8192) + r; const float st = c.states[idx]; c.states[idx] = s; s = s * expf(c.acs[(bc * 64 + 63) * 16 + hd]) + st; } }
}
__device__ __forceinline__ void s_ssd_cb(const Ctx& c, size_t gid, size_t gs) {
    for (size_t i = gid; i < (size_t)NB * NCH * 2 * 4096; i += gs) { const int s = (int)(i % 64); const int t = (int)((i / 64) % 64); const int g = (int)((i / 4096) % 2); const size_t bc = i / 8192;
        const float* cm = c.xbcc + (bc * 64 + t) * 1536 + 1280 + g * 128; const float* bm = c.xbcc + (bc * 64 + s) * 1536 + 1024 + g * 128; float a = 0.f;
        for (int n = 0; n < 128; ++n) a += cm[n] * bm[n];
        c.cb[i] = a; }
}
__device__ __forceinline__ void s_ssd_y(const Ctx& c, size_t gid, size_t gs) {
    for (size_t i = gid; i < (size_t)T * 1024; i += gs) { const size_t t = i / 1024; const int hp = (int)(i % 1024); const int hd = hp / 64, p = hp % 64, g = hd / 8; const size_t bc = t / 64; const int tl = (int)(t % 64);
        const float at = c.acs[t * 16 + hd]; float y = 0.f;
        for (int s = 0; s <= tl; ++s) { const size_t ts = bc * 64 + s; y += c.cb[(bc * 2 + g) * 4096 + tl * 64 + s] * expf(at - c.acs[ts * 16 + hd]) * c.xbcc[ts * 1536 + hp] * c.dtv[ts * 16 + hd]; }
        const float* cm = c.xbcc + t * 1536 + 1280 + g * 128; const float* pv = c.states + (bc * 16 + hd) * 8192 + p * 128; float yo = 0.f;
        for (int n = 0; n < 128; ++n) yo += cm[n] * pv[n];
        y += yo * expf(at) + c.xbcc[t * 1536 + hp] * c.in[I_EV_D][hd];
        c.ybuf[i] = y * siluf(c.proj[t * PROJ_LD + E_Z + hp]); }
}
__device__ __forceinline__ void s_ssd_out(const Ctx& c, size_t gid, size_t gs) {
    for (size_t i = gid; i < (size_t)T * 1024; i += gs) { const size_t t = i / 1024; const int ch = (int)(i % 1024); c.cat[t * 1536 + 512 + ch] = c.ybuf[i] * c.rstd2[t * 2 + ch / 512] * c.in[I_EV_NORM][ch]; }
}
__device__ __forceinline__ void s_xa_scores(const Ctx& c, size_t gid, size_t gs) {
    for (size_t i = gid; i < (size_t)T * 4 * 256; i += gs) { const int m = (int)(i % 256); const int hd = (int)((i / 256) % 4); const size_t t = i / 1024; const size_t b = t / L;
        const float* q = c.q + t * 1024 + hd * 256; const float* k = c.kx + (b * 256 + m) * 1024 + hd * 256; float s = 0.f;
        for (int d = 0; d < 256; ++d) s += q[d] * k[d];
        c.sc[i] = s * 0.0625f; }
}
__device__ __forceinline__ void s_xa_softmax(const Ctx& c, size_t gid, size_t gs) {
    for (size_t i = gid; i < (size_t)T * 4; i += gs) { float* p = c.sc + i * 256; float mx = p[0]; for (int m = 1; m < 256; ++m) mx = fmaxf(mx, p[m]); float s = 0.f; for (int m = 0; m < 256; ++m) { const float e = expf(p[m] - mx); p[m] = e; s += e; } const float r = 1.f / s; for (int m = 0; m < 256; ++m) p[m] *= r; }
}
__device__ __forceinline__ void s_xa_pv(const Ctx& c, size_t gid, size_t gs) {
    for (size_t i = gid; i < (size_t)T * 1024; i += gs) { const size_t t = i / 1024; const int col = (int)(i % 1024); const int hd = col / 256; const size_t b = t / L; const float* p = c.sc + (t * 4 + hd) * 256; const float* v = c.vx + b * 256 * 1024 + col; float s = 0.f;
        for (int m = 0; m < 256; ++m) s += p[m] * v[(size_t)m * 1024];
        c.att[i] = s; }
}
__device__ __forceinline__ void s_router(const Ctx& c, int l, size_t gid, size_t gs) {
    const float* wg = c.in[I_MOE_WG] + (size_t)l * 1024 * 4; const float* bg = c.in[I_MOE_BG] + l * 4; const float* we = c.in[I_MOE_WE] + (size_t)l * 1024 * 32; const float* be = c.in[I_MOE_BE] + l * 32;
    for (size_t t = gid; t < (size_t)T; t += gs) { const float* x = c.un + t * 1024; float g0 = 0.f, g1 = 0.f, g2 = 0.f, g3 = 0.f;
        for (int k = 0; k < 1024; ++k) { const float xv = x[k]; g0 += xv * wg[k * 4 + 0]; g1 += xv * wg[k * 4 + 1]; g2 += xv * wg[k * 4 + 2]; g3 += xv * wg[k * 4 + 3]; }
        g0 += bg[0]; g1 += bg[1]; g2 += bg[2]; g3 += bg[3];
        int gsel = 0; float gm = g0; if (g1 > gm) { gm = g1; gsel = 1; } if (g2 > gm) { gm = g2; gsel = 2; } if (g3 > gm) { gm = g3; gsel = 3; }
        const float gw = 1.f / (expf(g0 - gm) + expf(g1 - gm) + expf(g2 - gm) + expf(g3 - gm));
        float e0 = 0, e1 = 0, e2 = 0, e3 = 0, e4 = 0, e5 = 0, e6 = 0, e7 = 0; const float* w = we + gsel * 8;
        for (int k = 0; k < 1024; ++k) { const float xv = x[k]; const float* wk = w + k * 32; e0 += xv * wk[0]; e1 += xv * wk[1]; e2 += xv * wk[2]; e3 += xv * wk[3]; e4 += xv * wk[4]; e5 += xv * wk[5]; e6 += xv * wk[6]; e7 += xv * wk[7]; }
        const float* bb = be + gsel * 8; e0 += bb[0]; e1 += bb[1]; e2 += bb[2]; e3 += bb[3]; e4 += bb[4]; e5 += bb[5]; e6 += bb[6]; e7 += bb[7];
        int i1 = 0; float m1 = e0;
#define SM_T1(j, v) if (v > m1) { m1 = v; i1 = j; }
        SM_T1(1, e1) SM_T1(2, e2) SM_T1(3, e3) SM_T1(4, e4) SM_T1(5, e5) SM_T1(6, e6) SM_T1(7, e7)
        int i2 = -1; float m2 = -3.0e38f;
#define SM_T2(j, v) if (j != i1 && v > m2) { m2 = v; i2 = j; }
        SM_T2(0, e0) SM_T2(1, e1) SM_T2(2, e2) SM_T2(3, e3) SM_T2(4, e4) SM_T2(5, e5) SM_T2(6, e6) SM_T2(7, e7)
        const float r = expf(m2 - m1); const float w1 = gw / (1.f + r), w2 = gw * r / (1.f + r);
        c.eid[t * 2 + 0] = gsel * 8 + i1; c.eid[t * 2 + 1] = gsel * 8 + i2; c.gatew[t * 2 + 0] = w1; c.gatew[t * 2 + 1] = w2; }
}
__device__ __forceinline__ void s_moe_up(const Ctx& c, int l, size_t gid, size_t gs) {
    for (size_t i = gid; i < (size_t)T * 2 * 512; i += gs) { const int f = (int)(i % 512); const size_t tk = i / 512; const size_t t = tk / 2; const int e = c.eid[tk] & 31;
        const float* wg = c.in[I_MOE_WGATE] + ((size_t)l * 32 + e) * 1024 * 512 + f; const float* wu = c.in[I_MOE_WUP] + ((size_t)l * 32 + e) * 1024 * 512 + f; const float* x = c.un + t * 1024; float a = 0.f, b = 0.f;
        for (int k = 0; k < 1024; ++k) { a += x[k] * wg[(size_t)k * 512]; b += x[k] * wu[(size_t)k * 512]; }
        c.act[i] = siluf(a) * b; }
}
__device__ __forceinline__ void s_moe_down(const Ctx& c, int l, size_t gid, size_t gs) {
    for (size_t i = gid; i < (size_t)T * 1024; i += gs) { const size_t t = i / 1024; const int n = (int)(i % 1024); float y = 0.f;
        for (int k = 0; k < 2; ++k) { const int e = c.eid[t * 2 + k] & 31; const float* wd = c.in[I_MOE_WDOWN] + ((size_t)l * 32 + e) * 512 * 1024 + n; const float* a = c.act + (t * 2 + k) * 512; float s = 0.f;
            for (int f = 0; f < 512; ++f) s += a[f] * wd[(size_t)f * 1024];
            y += s * c.gatew[t * 2 + k]; }
        c.h[i] += y; }
}
__device__ __forceinline__ void s_gdn_conv(const Ctx& c, size_t gid, size_t gs) {
    const float* w = c.in[I_OD_CONV];
    for (size_t i = gid; i < (size_t)T * 3072; i += gs) { const size_t t = i / 3072; const int ch = (int)(i % 3072); const int tl = (int)(t % L); float s = 0.f;
        for (int j = 0; j < 4; ++j) { const int tt = tl - 3 + j; if (tt >= 0) s += w[j * 3072 + ch] * c.proj[(t - 3 + j) * PROJ_LD + O_QKV + ch]; }
        c.qkvc[i] = siluf(s); }
}
__device__ __forceinline__ void s_gdn_qkscale(const Ctx& c, size_t gid, size_t gs) {
    for (size_t i = gid; i < (size_t)T * 16; i += gs) { const size_t t = i / 16; const int wh = (int)(i % 16); float* p = c.qkvc + t * 3072 + wh * 128; float s = 0.f; for (int d = 0; d < 128; ++d) s += p[d] * p[d];
        float r = 1.f / sqrtf(s + 1e-6f); if (wh < 8) r *= 0.08838834764831845f; for (int d = 0; d < 128; ++d) p[d] *= r; }
}
__device__ __forceinline__ void s_gdn_gates(const Ctx& c, size_t gid, size_t gs) {
    for (size_t i = gid; i < (size_t)NB * NCH * 8; i += gs) { const int hd = (int)(i % 8); const size_t bc = i / 8; const float na = -expf(c.in[I_OD_ALOG][hd]); const float db = c.in[I_OD_DTB][hd]; float cs = 0.f;
        for (int s = 0; s < 64; ++s) { const size_t t = bc * 64 + s; cs += na * softplusf(c.proj[t * PROJ_LD + O_A + hd] + db); c.gcs[t * 8 + hd] = cs; c.beta[t * 8 + hd] = sigmoidf(c.proj[t * PROJ_LD + O_B + hd]); } }
}
__device__ __forceinline__ void s_gdn_kk(const Ctx& c, size_t gid, size_t gs) {
    for (size_t i = gid; i < (size_t)NB * NCH * 8 * 4096; i += gs) { const int s = (int)(i % 64); const int t = (int)((i / 64) % 64); const int hd = (int)((i / 4096) % 8); const size_t bc = i / (4096 * 8);
        float lv = 0.f, av = 0.f;
        if (s <= t) { const size_t tt = bc * 64 + t, ts = bc * 64 + s; const float* kt = c.qkvc + tt * 3072 + 1024 + hd * 128; const float* ks = c.qkvc + ts * 3072 + 1024 + hd * 128; const float* qt = c.qkvc + tt * 3072 + hd * 128; float kk = 0.f, qk = 0.f;
            for (int d = 0; d < 128; ++d) { kk += kt[d] * ks[d]; qk += qt[d] * ks[d]; }
            const float dec = expf(c.gcs[tt * 8 + hd] - c.gcs[ts * 8 + hd]); av = qk * dec; if (s < t) lv = kk * c.beta[tt * 8 + hd] * dec; }
        c.Lm[i] = lv; c.aqk[i] = av; }
}
__device__ __forceinline__ void s_gdn_solve(const Ctx& c, size_t gid, size_t gs) {
    for (size_t i = gid; i < (size_t)NB * NCH * 8 * 256; i += gs) { const int j = (int)(i % 256); const int hd = (int)((i / 256) % 8); const size_t bc = i / 2048; float* sol = c.uw + (bc * 8 + hd) * (64 * 256) + j; const float* Lp = c.Lm + (bc * 8 + hd) * 4096;
        for (int t = 0; t < 64; ++t) { const size_t tt = bc * 64 + t; const float bt = c.beta[tt * 8 + hd];
            float r = (j < 128) ? c.qkvc[tt * 3072 + 2048 + hd * 128 + j] * bt : c.qkvc[tt * 3072 + 1024 + hd * 128 + (j - 128)] * bt * expf(c.gcs[tt * 8 + hd]);
            for (int s = 0; s < t; ++s) r -= Lp[t * 64 + s] * sol[(size_t)s * 256];
            sol[(size_t)t * 256] = r; } }
}
__device__ __forceinline__ void s_gdn_scan(const Ctx& c, size_t gid, size_t gs) {
    for (size_t i = gid; i < (size_t)NB * 8 * 128; i += gs) { const int j = (int)(i % 128); const size_t bh = i / 128; const int hd = (int)(bh % 8); const size_t b = bh / 8; float* S = c.S + bh * 16384 + j; float* vn = c.vn + bh * 8192 + j;
        for (int d = 0; d < 128; ++d) S[(size_t)d * 128] = 0.f;
        for (int ch = 0; ch < NCH; ++ch) { const size_t bc = b * NCH + ch; const float* uw = c.uw + (bc * 8 + hd) * (64 * 256); const float* aq = c.aqk + (bc * 8 + hd) * 4096; const float glast = c.gcs[(bc * 64 + 63) * 8 + hd];
            for (int t = 0; t < 64; ++t) { float v = uw[t * 256 + j]; const float* w = uw + t * 256 + 128; for (int d = 0; d < 128; ++d) v -= w[d] * S[(size_t)d * 128]; vn[(size_t)t * 128] = v; }
            for (int t = 0; t < 64; ++t) { const size_t tt = bc * 64 + t; const float* q = c.qkvc + tt * 3072 + hd * 128; float o = 0.f; for (int d = 0; d < 128; ++d) o += q[d] * S[(size_t)d * 128];
                o *= expf(c.gcs[tt * 8 + hd]); for (int s = 0; s <= t; ++s) o += aq[t * 64 + s] * vn[(size_t)s * 128];
                c.obuf[tt * 1024 + hd * 128 + j] = o; }
            const float dl = expf(glast);
            for (int d = 0; d < 128; ++d) { float a = S[(size_t)d * 128] * dl; for (int t = 0; t < 64; ++t) { const size_t tt = bc * 64 + t; a += c.qkvc[tt * 3072 + 1024 + hd * 128 + d] * expf(glast - c.gcs[tt * 8 + hd]) * vn[(size_t)t * 128]; } S[(size_t)d * 128] = a; } } }
}
__device__ __forceinline__ void s_gdn_out(const Ctx& c, size_t gid, size_t gs) {
    for (size_t i = gid; i < (size_t)T * 1024; i += gs) { const size_t t = i / 1024; const int col = (int)(i % 1024); c.cat[t * 1536 + col] = c.obuf[i] * c.rstd2[t * 8 + col / 128] * c.in[I_OD_NORM][col % 128] * siluf(c.proj[t * PROJ_LD + O_Z + col]); }
}
__device__ __forceinline__ void s_sb(const Ctx& c, size_t gid, size_t gs) {
    for (size_t i = gid; i < (size_t)T * 8; i += gs) { const int hd = (int)(i % 8); const size_t t = i / 8; const int tl = (int)(t % L); const float* q = c.proj + t * PROJ_LD + O_SQ + hd * 64;
        float o[64];
#pragma unroll
        for (int d = 0; d < 64; ++d) o[d] = 0.f;
        float carry = 0.f;
        for (int s = tl - 1; s >= 0 && carry > -150.f; --s) { const size_t ts = t - (size_t)(tl - s); const float* k = c.proj + ts * PROJ_LD + O_SK + hd * 64; const float* v = c.proj + ts * PROJ_LD + O_SV + hd * 64; float lg = 0.f;
#pragma unroll
            for (int d = 0; d < 64; ++d) lg += q[d] * k[d];
            lg *= 0.125f; const float wgt = expf(-softplusf(-lg) + carry); carry -= softplusf(lg);
#pragma unroll
            for (int d = 0; d < 64; ++d) o[d] += wgt * v[d]; }
#pragma unroll
        for (int d = 0; d < 64; ++d) c.cat[t * 1536 + 1024 + hd * 64 + d] = o[d]; }
}
__device__ __forceinline__ void s_final(const Ctx& c, size_t gid, size_t gs) { s_norm(c.h, c.rstd, c.in[I_FINAL_NORM], c.out, T, gid, gs); }

constexpr int XA_BASE = 20, MOE_BASE = 30, L1_BASE = 40, NSTAGE_L = 60;
__device__ __forceinline__ bool run_stage(const Ctx& c, int st, size_t gid, size_t gs) {
    const int layer = st / NSTAGE_L, s = st % NSTAGE_L;
    if (st >= 2 * NSTAGE_L + 2) return false;
    if (st == 2 * NSTAGE_L) { s_rstd(c.h, T, DM, DM, c.rstd, gid, gs); return true; }
    if (st == 2 * NSTAGE_L + 1) { s_final(c, gid, gs); return true; }
    const int l = layer;
    switch (s) {
    case 0: if (l == 0) { s_copy(c.in[I_X], c.h, (size_t)T * DM, gid, gs); s_rstd(c.in[I_MEM], NB * MEM, DM, DM, c.rstd2, gid, gs); } break;
    case 1: if (l == 0) s_norm(c.in[I_MEM], c.rstd2, c.in[I_MEM_NORM], c.memn, NB * MEM, gid, gs); s_rstd(c.h, T, DM, DM, c.rstd, gid, gs); break;
    case 2: s_norm(c.h, c.rstd, c.in[I_NORM_MIX] + l * DM, c.un, T, gid, gs); break;
    case 3: if (l == 0) s_gemm(c.un, DM, c.in[I_EV_WIN], EV_IN, c.proj, PROJ_LD, T, EV_IN, DM, 0, gid, gs); else s_gemm(c.un, DM, c.in[I_OD_WIN], OD_IN, c.proj, PROJ_LD, T, OD_IN, DM, 0, gid, gs); break;
    case 4: if (l == 0) { s_scmix(c, gid, gs); s_ssd_conv(c, gid, gs); s_ssd_dt(c, gid, gs); } else { s_gdn_conv(c, gid, gs); s_gdn_gates(c, gid, gs); s_sb(c, gid, gs); } break;
    case 5: if (l == 0) { s_ssd_states(c, gid, gs); s_ssd_cb(c, gid, gs); } else s_gdn_qkscale(c, gid, gs); break;
    case 6: if (l == 0) s_ssd_scan(c, gid, gs); else s_gdn_kk(c, gid, gs); break;
    case 7: if (l == 0) s_ssd_y(c, gid, gs); else s_gdn_solve(c, gid, gs); break;
    case 8: if (l == 0) s_rstd(c.ybuf, T * 2, 512, 512, c.rstd2, gid, gs); else s_gdn_scan(c, gid, gs); break;
    case 9: if (l == 0) s_ssd_out(c, gid, gs); else s_rstd(c.obuf, T * 8, 128, 128, c.rstd2, gid, gs); break;
    case 10: if (l == 1) s_gdn_out(c, gid, gs); break;
    case 11: s_gemm(c.cat, 1536, l == 0 ? c.in[I_EV_WOUT] : c.in[I_OD_WOUT], DM, c.h, DM, T, DM, 1536, 1, gid, gs); break;
    case 12: s_rstd(c.h, T, DM, DM, c.rstd, gid, gs); break;
    case 13: s_norm(c.h, c.rstd, c.in[I_NORM_XA] + l * DM, c.un, T, gid, gs); break;
    case 14: s_gemm(c.un, DM, c.in[I_XA_WQ] + (size_t)l * DM * DM, DM, c.q, DM, T, DM, DM, 0, gid, gs);
             s_gemm(c.memn, DM, c.in[I_XA_WK] + (size_t)l * DM * DM, DM, c.kx, DM, NB * MEM, DM, DM, 0, gid, gs);
             s_gemm(c.memn, DM, c.in[I_XA_WV] + (size_t)l * DM * DM, DM, c.vx, DM, NB * MEM, DM, DM, 0, gid, gs); break;
    case 15: s_xa_scores(c, gid, gs); break;
    case 16: s_xa_softmax(c, gid, gs); break;
    case 17: s_xa_pv(c, gid, gs); break;
    case 18: s_gemm(c.att, DM, c.in[I_XA_WO] + (size_t)l * DM * DM, DM, c.h, DM, T, DM, DM, 1, gid, gs); break;
    case 19: s_rstd(c.h, T, DM, DM, c.rstd, gid, gs); break;
    case 20: s_norm(c.h, c.rstd, c.in[I_NORM_FFN] + l * DM, c.un, T, gid, gs); break;
    case 21: s_router(c, l, gid, gs); break;
    case 22: s_moe_up(c, l, gid, gs); break;
    case 23: s_moe_down(c, l, gid, gs); break;
    default: break;
    }
    return true;
}
constexpr int N_STAGES_USED = 24;

__host__ __device__ __forceinline__ size_t carve(Ctx& c, float* w) {
    size_t o = 0;
    auto take = [&](size_t n) { float* p = w + o; o += (n + 63) & ~(size_t)63; return p; };
    c.h = take((size_t)T * DM); c.rstd = take(T); c.rstd2 = take((size_t)T * 8); c.memn = take((size_t)MEM * DM); c.kx = take((size_t)MEM * DM); c.vx = take((size_t)MEM * DM);
    c.eid = (int*)take((size_t)T * 2); c.gatew = take((size_t)T * 2); c.dtv = take((size_t)T * 16); c.acs = take((size_t)T * 16); c.beta = take((size_t)T * 8); c.gcs = take((size_t)T * 8);
    c.S = take(8 * 16384); c.vn = take(8 * 8192);
    c.un = take((size_t)T * DM); c.ybuf = c.un; c.obuf = c.un;
    c.proj = take((size_t)T * PROJ_LD);
    c.cat = take((size_t)T * 1536);
    const size_t d0 = o;
    c.xbcc = take((size_t)T * 1536); c.states = take((size_t)NCH * 16 * 8192); c.cb = take((size_t)NCH * 2 * 4096); size_t dmax = o;
    o = d0; c.qkvc = take((size_t)T * 3072); c.Lm = take((size_t)NCH * 8 * 4096); c.aqk = take((size_t)NCH * 8 * 4096); c.uw = take((size_t)NCH * 8 * 64 * 256); if (o > dmax) dmax = o;
    o = d0; c.q = take((size_t)T * DM); c.sc = take((size_t)T * DM); c.att = take((size_t)T * DM); if (o > dmax) dmax = o;
    o = d0; c.act = take((size_t)T * 2 * 512); if (o > dmax) dmax = o;
    return dmax;
}
}

struct KArgs { sm::Ctx c[2]; unsigned* bar; unsigned long long pad; };

__global__ void __launch_bounds__(256, 2) k_stage(sm::Ctx c, int st) {
    sm::run_stage(c, st, (size_t)blockIdx.x * blockDim.x + threadIdx.x, (size_t)gridDim.x * blockDim.x);
}

__global__ void __launch_bounds__(256, 2) k_persistent(KArgs a) {
    __shared__ uint4 xb_words;
    if (threadIdx.x == 0) xb_words = make_uint4(0u, 0u, 0u, 0u);
    __syncthreads();
    XcdBarrier bar = xcd_barrier_post(a.bar, (volatile LAS unsigned*)&xb_words);
    const size_t gid = (size_t)blockIdx.x * blockDim.x + threadIdx.x, gs = (size_t)gridDim.x * blockDim.x;
    for (int b = 0; b < 2; ++b) {
        for (int st = 0;; ++st) {
            const int s = st % sm::NSTAGE_L;
            if (st < 2 * sm::NSTAGE_L && s >= sm::N_STAGES_USED) continue;
            if (!sm::run_stage(a.c[b], st, gid, gs)) break;
            xcd_barrier(bar);
        }
    }
}

extern "C" void kernel_launch(void* const* d_in, const int* in_sizes, int n_in, void* d_out, int out_size, void* d_ws, size_t ws_size, hipStream_t stream) {
    static int grid = 0;
    if (grid == 0) {
        int dev = 0, cus = 0, per_cu = 0;
        hipGetDevice(&dev); hipDeviceGetAttribute(&cus, hipDeviceAttributeMultiprocessorCount, dev);
        hipOccupancyMaxActiveBlocksPerMultiprocessor(&per_cu, (const void*)k_persistent, 256, 0);
        if (per_cu > 4) per_cu = 4; if (per_cu < 1) per_cu = 1;
        grid = cus * per_cu;
        sm::Ctx t{}; const size_t need = (sm::carve(t, nullptr) + 4096) * 4;
        if (n_in != 33 || ws_size < need) { fprintf(stderr, "kernel_launch: n_in %d ws %zu need %zu\n", n_in, ws_size, need); grid = -1; }
        fprintf(stderr, "kernel_launch: grid %d (%d per CU), ws %zu, need %zu\n", grid, per_cu, ws_size, need);
    }
    if (grid < 0) return;
    KArgs a{};
    for (int b = 0; b < 2; ++b) {
        sm::Ctx& c = a.c[b];
        sm::carve(c, (float*)d_ws + 4096);
        for (int i = 0; i < 33; ++i) c.in[i] = (const float*)d_in[i];
        c.in[sm::I_X] += (size_t)b * sm::L * 1024; c.in[sm::I_MEM] += (size_t)b * 256 * 1024; c.out = (float*)d_out + (size_t)b * sm::L * 1024;
    }
    a.bar = (unsigned*)d_ws;
#if MODE == 0
    for (int b = 0; b < 2; ++b)
        for (int st = 0; st < 2 * sm::NSTAGE_L + 2; ++st) {
            const int s = st % sm::NSTAGE_L;
            if (st < 2 * sm::NSTAGE_L && s >= sm::N_STAGES_USED) continue;
            hipLaunchKernelGGL(k_stage, dim3(2048), dim3(256), 0, stream, a.c[b], st);
        }
#else
    hipMemsetAsync(d_ws, 0, XCD_BAR_WORDS * sizeof(unsigned), stream);
    hipLaunchKernelGGL(k_persistent, dim3(grid), dim3(256), 0, stream, a);
#endif
}
```

```cpp
#include <hip/hip_runtime.h>
#include <cstdio>
#include <cstdint>
#ifndef CHECK
#define CHECK 0
#endif
constexpr int LDS_BYTES = 147456;

#define XB_TMO      128
#define XB_XCNT(j)  (256  + 64 * (j))
#define XB_XSUB(j)  (1280 + 64 * (j))
#define XB_XGEN(j)  (2304 + 64 * (j))
#define XB_TOP      3328
#define XB_TOPGEN   3392
#define XCD_BAR_WORDS 3456
#define XB_SPIN_CAP (1u << 18)
#define LAS __attribute__((address_space(3)))

__device__ __forceinline__ unsigned xb_ld(unsigned* p)              { return __hip_atomic_load(p, __ATOMIC_RELAXED, __HIP_MEMORY_SCOPE_AGENT); }
__device__ __forceinline__ unsigned xb_add(unsigned* p, unsigned v) { return __hip_atomic_fetch_add(p, v, __ATOMIC_RELAXED, __HIP_MEMORY_SCOPE_AGENT); }
__device__ __forceinline__ unsigned xb_xcc_id() { return (unsigned)__builtin_amdgcn_s_getreg((3 << 11) | 20) & 0xFu; }
#define XB_SPIN(cond, bar) do { unsigned _sp = 0; while (cond) { __builtin_amdgcn_s_sleep(1); \
    if ((++_sp & 255u) == 0u) { if (xb_ld(&(bar)[XB_TMO])) break; if (_sp > XB_SPIN_CAP) { atomicAdd(&(bar)[XB_TMO], 1u); break; } } } } while (0)

struct XcdBarrier {
    unsigned* bar; unsigned x;
    volatile LAS unsigned* st;
};

__device__ __forceinline__ XcdBarrier xcd_barrier_post(unsigned* bar, volatile LAS unsigned* st) {
    XcdBarrier b; b.bar = bar; b.x = xb_xcc_id(); b.st = st;
    if (threadIdx.x == 0) (void)xb_add(&bar[XB_XCNT(b.x)], 1u);
    return b;
}
__device__ __forceinline__ void xcd_barrier_complete(unsigned* bar, unsigned x, unsigned& nloc, unsigned& nx) {
    const unsigned G = gridDim.x * gridDim.y * gridDim.z;
    unsigned sum, cnt, mine, sp = 0u;
    for (;;) {
        sum = 0u; cnt = 0u; mine = 0u;
#pragma unroll
        for (unsigned j = 0; j < 16; ++j) { const unsigned c = xb_ld(&bar[XB_XCNT(j)]); sum += c; cnt += (c > 0u) ? 1u : 0u; mine = (j == x) ? c : mine; }
        if (sum == G) break;
        __builtin_amdgcn_s_sleep(1);
        if ((++sp & 255u) == 0u) { if (xb_ld(&bar[XB_TMO])) break; if (sp > XB_SPIN_CAP) { atomicAdd(&bar[XB_TMO], 1u); break; } }
    }
    nloc = mine > 0u ? mine : 1u; nx = cnt > 0u ? cnt : 1u;
}

__device__ __forceinline__ void xcd_barrier(const XcdBarrier& b) {
    asm volatile("s_waitcnt vmcnt(0)" ::: "memory");
    __syncthreads();
    if (threadIdx.x == 0) {
        unsigned* bar = b.bar;
        __builtin_amdgcn_s_waitcnt(0);
        unsigned nloc = b.st[0], nx = b.st[1];
        if (nloc == 0u) { xcd_barrier_complete(bar, b.x, nloc, nx); b.st[0] = nloc; b.st[1] = nx; }
        const unsigned old = xb_add(&bar[XB_XSUB(b.x)], 1u);
        const unsigned gen = old / nloc;
        if (old + 1u == (gen + 1u) * nloc) {
            __builtin_amdgcn_fence(__ATOMIC_RELEASE, "agent");
            asm volatile("s_waitcnt vmcnt(0)" ::: "memory");
            const unsigned og = xb_add(&bar[XB_TOP], 1u);
            const unsigned tg = og / nx;
            if (og + 1u == (tg + 1u) * nx) xb_add(&bar[XB_TOPGEN], 1u);
            else XB_SPIN(xb_ld(&bar[XB_TOPGEN]) == tg, bar);
            __builtin_amdgcn_fence(__ATOMIC_ACQUIRE, "agent");
            xb_add(&bar[XB_XGEN(b.x)], 1u);
            asm volatile("s_waitcnt vmcnt(0)" ::: "memory");
        } else {
            XB_SPIN(xb_ld(&bar[XB_XGEN(b.x)]) == gen, bar);
            __builtin_amdgcn_fence(__ATOMIC_ACQUIRE, "agent");
            asm volatile("s_waitcnt vmcnt(0)" ::: "memory");
        }
    }
    __syncthreads();
}


#undef LAS

#ifndef SEQ
#define SEQ 8192
#endif
namespace sm {
constexpr int DM = 1024, NB = 1  , L = SEQ, T = NB * L, NCH = L / 64, MEM = 256;
constexpr int EV_IN = 4112, OD_IN = 5648, PROJ_LD = 5648;
constexpr int E_SCB = 0, E_SCC = 512, E_SCX = 1024, E_Z = 1536, E_XBC = 2560, E_DT = 4096;
constexpr int O_QKV = 0, O_Z = 3072, O_A = 4096, O_B = 4104, O_SQ = 4112, O_SK = 4624, O_SV = 5136;

struct Ctx {
    const float* in[33];
    float* out;
    float *memn, *kx, *vx, *h, *un, *rstd, *proj, *cat, *xbcc, *dtv, *acs, *states, *cb, *ybuf, *rstd2;
    float *q, *att, *sc;
    float *gatew, *act; int* eid;
    float *qkvc, *beta, *gcs, *Lm, *aqk, *uw, *S, *vn, *obuf;
};
enum In { I_X = 0, I_MEM, I_MEM_NORM, I_FINAL_NORM, I_NORM_MIX, I_NORM_XA, I_NORM_FFN, I_XA_WQ, I_XA_WK, I_XA_WV, I_XA_WO,
          I_MOE_WG, I_MOE_BG, I_MOE_WE, I_MOE_BE, I_MOE_WGATE, I_MOE_WUP, I_MOE_WDOWN,
          I_EV_WIN, I_EV_SCCONV, I_EV_CONVW, I_EV_CONVB, I_EV_DTB, I_EV_ALOG, I_EV_D, I_EV_NORM, I_EV_WOUT,
          I_OD_WIN, I_OD_CONV, I_OD_DTB, I_OD_ALOG, I_OD_NORM, I_OD_WOUT };

__device__ __forceinline__ float siluf(float x) { return x / (1.f + expf(-x)); }
__device__ __forceinline__ float softplusf(float x) { return x > 20.f ? x : log1pf(expf(x)); }
__device__ __forceinline__ float sigmoidf(float x) { return 1.f / (1.f + expf(-x)); }

__device__ __forceinline__ void s_copy(const float* src, float* dst, size_t n, size_t gid, size_t gs) { for (size_t i = gid; i < n; i += gs) dst[i] = src[i]; }
__device__ __forceinline__ void s_rstd(const float* x, int R, int W, int ld, float* rstd, size_t gid, size_t gs) {
    for (size_t r = gid; r < (size_t)R; r += gs) { const float* p = x + r * ld; float s = 0.f; for (int i = 0; i < W; ++i) s += p[i] * p[i]; rstd[r] = 1.f / sqrtf(s / W + 1e-6f); }
}
__device__ __forceinline__ void s_norm(const float* x, const float* rstd, const float* g, float* y, int R, size_t gid, size_t gs) {
    for (size_t i = gid; i < (size_t)R * DM; i += gs) { const size_t r = i / DM; const int c = (int)(i % DM); y[i] = x[i] * rstd[r] * g[c]; }
}
__device__ __forceinline__ void s_gemm(const float* A, int lda, const float* W, int ldw, float* C, int ldc, int M, int N, int K, int accum, size_t gid, size_t gs) {
    const int N4 = N / 4;
    for (size_t i = gid; i < (size_t)M * N4; i += gs) { const size_t m = i / N4; const int n = (int)(i % N4) * 4; const float* a = A + m * lda; const float* w = W + n; float s0 = 0.f, s1 = 0.f, s2 = 0.f, s3 = 0.f;
        for (int k = 0; k < K; ++k) { const float av = a[k]; const float4 wv = *(const float4*)(w + (size_t)k * ldw); s0 += av * wv.x; s1 += av * wv.y; s2 += av * wv.z; s3 += av * wv.w; }
        float4* c = (float4*)(C + m * ldc + n); float4 o = accum ? *c : float4{0.f, 0.f, 0.f, 0.f}; o.x += s0; o.y += s1; o.z += s2; o.w += s3; *c = o; }
}
__device__ __forceinline__ void s_scmix(const Ctx& c, size_t gid, size_t gs) {
    const float* w = c.in[I_EV_SCCONV];
    for (size_t i = gid; i < (size_t)T * 512; i += gs) { const size_t t = i / 512; const int ch = (int)(i % 512); const int tl = (int)(t % L); float s = 0.f;
        for (int j = 0; j < 3; ++j) { const int tt = tl - 2 + j; if (tt >= 0) { const float* p = c.proj + (t - 2 + j) * PROJ_LD; s += w[j * 512 + ch] * p[E_SCC + ch] * p[E_SCX + ch]; } }
        c.cat[t * 1536 + ch] = c.proj[t * PROJ_LD + E_SCB + ch] * s; }
}
__device__ __forceinline__ void s_ssd_conv(const Ctx& c, size_t gid, size_t gs) {
    const float* w = c.in[I_EV_CONVW]; const float* b = c.in[I_EV_CONVB];
    for (size_t i = gid; i < (size_t)T * 1536; i += gs) { const size_t t = i / 1536; const int ch = (int)(i % 1536); const int tl = (int)(t % L); float s = b[ch];
        for (int j = 0; j < 4; ++j) { const int tt = tl - 3 + j; if (tt >= 0) s += w[j * 1536 + ch] * c.proj[(t - 3 + j) * PROJ_LD + E_XBC + ch]; }
        c.xbcc[i] = siluf(s); }
}
__device__ __forceinline__ void s_ssd_dt(const Ctx& c, size_t gid, size_t gs) {
    for (size_t i = gid; i < (size_t)NB * NCH * 16; i += gs) { const int hd = (int)(i % 16); const size_t bc = i / 16; const float a = -expf(c.in[I_EV_ALOG][hd]); float cs = 0.f;
        for (int s = 0; s < 64; ++s) { const size_t t = bc * 64 + s; const float dt = softplusf(c.proj[t * PROJ_LD + E_DT + hd] + c.in[I_EV_DTB][hd]); cs += dt * a; c.dtv[t * 16 + hd] = dt; c.acs[t * 16 + hd] = cs; } }
}
__device__ __forceinline__ void s_ssd_states(const Ctx& c, size_t gid, size_t gs) {
    for (size_t i = gid; i < (size_t)NB * NCH * 16 * 64 * 128; i += gs) { const int n = (int)(i % 128); const int p = (int)((i / 128) % 64); const int hd = (int)((i / 8192) % 16); const size_t bc = i / (8192 * 16);
        const int g = hd / 8; const float last = c.acs[(bc * 64 + 63) * 16 + hd]; float s = 0.f;
        for (int k = 0; k < 64; ++k) { const size_t t = bc * 64 + k; s += c.xbcc[t * 1536 + 1024 + g * 128 + n] * c.xbcc[t * 1536 + hd * 64 + p] * c.dtv[t * 16 + hd] * expf(last - c.acs[t * 16 + hd]); }
        c.states[i] = s; }
}
__device__ __forceinline__ void s_ssd_scan(const Ctx& c, size_t gid, size_t gs) {
    for (size_t i = gid; i < (size_t)NB * 16 * 8192; i += gs) { const size_t b = i / (16 * 8192); const size_t r = i % (16 * 8192); const int hd = (int)(r / 8192); float s = 0.f;
        for (int ch = 0; ch < NCH; ++ch) { const size_t bc = b * NCH + ch; const size_t idx = bc * (16 * 8192) + r; const float st = c.states[idx]; c.states[idx] = s; s = s * expf(c.acs[(bc * 64 + 63) * 16 + hd]) + st; } }
}
__device__ __forceinline__ void s_ssd_cb(const Ctx& c, size_t gid, size_t gs) {
    for (size_t i = gid; i < (size_t)NB * NCH * 2 * 4096; i += gs) { const int s = (int)(i % 64); const int t = (int)((i / 64) % 64); const int g = (int)((i / 4096) % 2); const size_t bc = i / 8192;
        const float* cm = c.xbcc + (bc * 64 + t) * 1536 + 1280 + g * 128; const float* bm = c.xbcc + (bc * 64 + s) * 1536 + 1024 + g * 128; float a = 0.f;
        for (int n = 0; n < 128; ++n) a += cm[n] * bm[n];
        c.cb[i] = a; }
}
__device__ __forceinline__ void s_ssd_y(const Ctx& c, size_t gid, size_t gs) {
    for (size_t i = gid; i < (size_t)T * 1024; i += gs) { const size_t t = i / 1024; const int hp = (int)(i % 1024); const int hd = hp / 64, p = hp % 64, g = hd / 8; const size_t bc = t / 64; const int tl = (int)(t % 64);
        const float at = c.acs[t * 16 + hd]; float y = 0.f;
        for (int s = 0; s <= tl; ++s) { const size_t ts = bc * 64 + s; y += c.cb[(bc * 2 + g) * 4096 + tl * 64 + s] * expf(at - c.acs[ts * 16 + hd]) * c.xbcc[ts * 1536 + hp] * c.dtv[ts * 16 + hd]; }
        const float* cm = c.xbcc + t * 1536 + 1280 + g * 128; const float* pv = c.states + (bc * 16 + hd) * 8192 + p * 128; float yo = 0.f;
        for (int n = 0; n < 128; ++n) yo += cm[n] * pv[n];
        y += yo * expf(at) + c.xbcc[t * 1536 + hp] * c.in[I_EV_D][hd];
        c.ybuf[i] = y * siluf(c.proj[t * PROJ_LD + E_Z + hp]); }
}
__device__ __forceinline__ void s_ssd_out(const Ctx& c, size_t gid, size_t gs) {
    for (size_t i = gid; i < (size_t)T * 1024; i += gs) { const size_t t = i / 1024; const int ch = (int)(i % 1024); c.cat[t * 1536 + 512 + ch] = c.ybuf[i] * c.rstd2[t * 2 + ch / 512] * c.in[I_EV_NORM][ch]; }
}
__device__ __forceinline__ void s_xa_scores(const Ctx& c, size_t gid, size_t gs) {
    for (size_t i = gid; i < (size_t)T * 4 * 256; i += gs) { const int m = (int)(i % 256); const int hd = (int)((i / 256) % 4); const size_t t = i / 1024; const size_t b = t / L;
        const float* q = c.q + t * 1024 + hd * 256; const float* k = c.kx + (b * 256 + m) * 1024 + hd * 256; float s = 0.f;
        for (int d = 0; d < 256; ++d) s += q[d] * k[d];
        c.sc[i] = s * 0.0625f; }
}
__device__ __forceinline__ void s_xa_softmax(const Ctx& c, size_t gid, size_t gs) {
    for (size_t i = gid; i < (size_t)T * 4; i += gs) { float* p = c.sc + i * 256; float mx = p[0]; for (int m = 1; m < 256; ++m) mx = fmaxf(mx, p[m]); float s = 0.f; for (int m = 0; m < 256; ++m) { const float e = expf(p[m] - mx); p[m] = e; s += e; } const float r = 1.f / s; for (int m = 0; m < 256; ++m) p[m] *= r; }
}
__device__ __forceinline__ void s_xa_pv(const Ctx& c, size_t gid, size_t gs) {
    for (size_t i = gid; i < (size_t)T * 1024; i += gs) { const size_t t = i / 1024; const int col = (int)(i % 1024); const int hd = col / 256; const size_t b = t / L; const float* p = c.sc + (t * 4 + hd) * 256; const float* v = c.vx + b * 256 * 1024 + col; float s = 0.f;
        for (int m = 0; m < 256; ++m) s += p[m] * v[(size_t)m * 1024];
        c.att[i] = s; }
}
__device__ __forceinline__ void s_router(const Ctx& c, int l, size_t gid, size_t gs) {
    const float* wg = c.in[I_MOE_WG] + (size_t)l * 1024 * 4; const float* bg = c.in[I_MOE_BG] + l * 4; const float* we = c.in[I_MOE_WE] + (size_t)l * 1024 * 32; const float* be = c.in[I_MOE_BE] + l * 32;
    for (size_t t = gid; t < (size_t)T; t += gs) { const float* x = c.un + t * 1024; float g0 = 0.f, g1 = 0.f, g2 = 0.f, g3 = 0.f;
        for (int k = 0; k < 1024; ++k) { const float xv = x[k]; g0 += xv * wg[k * 4 + 0]; g1 += xv * wg[k * 4 + 1]; g2 += xv * wg[k * 4 + 2]; g3 += xv * wg[k * 4 + 3]; }
        g0 += bg[0]; g1 += bg[1]; g2 += bg[2]; g3 += bg[3];
        int gsel = 0; float gm = g0; if (g1 > gm) { gm = g1; gsel = 1; } if (g2 > gm) { gm = g2; gsel = 2; } if (g3 > gm) { gm = g3; gsel = 3; }
        const float gw = 1.f / (expf(g0 - gm) + expf(g1 - gm) + expf(g2 - gm) + expf(g3 - gm));
        float e0 = 0, e1 = 0, e2 = 0, e3 = 0, e4 = 0, e5 = 0, e6 = 0, e7 = 0; const float* w = we + gsel * 8;
        for (int k = 0; k < 1024; ++k) { const float xv = x[k]; const float* wk = w + k * 32; e0 += xv * wk[0]; e1 += xv * wk[1]; e2 += xv * wk[2]; e3 += xv * wk[3]; e4 += xv * wk[4]; e5 += xv * wk[5]; e6 += xv * wk[6]; e7 += xv * wk[7]; }
        const float* bb = be + gsel * 8; e0 += bb[0]; e1 += bb[1]; e2 += bb[2]; e3 += bb[3]; e4 += bb[4]; e5 += bb[5]; e6 += bb[6]; e7 += bb[7];
        int i1 = 0; float m1 = e0;
#define SM_T1(j, v) if (v > m1) { m1 = v; i1 = j; }
        SM_T1(1, e1) SM_T1(2, e2) SM_T1(3, e3) SM_T1(4, e4) SM_T1(5, e5) SM_T1(6, e6) SM_T1(7, e7)
        int i2 = -1; float m2 = -3.0e38f;
#define SM_T2(j, v) if (j != i1 && v > m2) { m2 = v; i2 = j; }
        SM_T2(0, e0) SM_T2(1, e1) SM_T2(2, e2) SM_T2(3, e3) SM_T2(4, e4) SM_T2(5, e5) SM_T2(6, e6) SM_T2(7, e7)
        const float r = expf(m2 - m1); const float w1 = gw / (1.f + r), w2 = gw * r / (1.f + r);
        c.eid[t * 2 + 0] = gsel * 8 + i1; c.eid[t * 2 + 1] = gsel * 8 + i2; c.gatew[t * 2 + 0] = w1; c.gatew[t * 2 + 1] = w2; }
}
__device__ __forceinline__ void s_moe_up(const Ctx& c, int l, size_t gid, size_t gs) {
    for (size_t i = gid; i < (size_t)T * 2 * 512; i += gs) { const int f = (int)(i % 512); const size_t tk = i / 512; const size_t t = tk / 2; const int e = c.eid[tk] & 31;
        const float* wg = c.in[I_MOE_WGATE] + ((size_t)l * 32 + e) * 1024 * 512 + f; const float* wu = c.in[I_MOE_WUP] + ((size_t)l * 32 + e) * 1024 * 512 + f; const float* x = c.un + t * 1024; float a = 0.f, b = 0.f;
        for (int k = 0; k < 1024; ++k) { a += x[k] * wg[(size_t)k * 512]; b += x[k] * wu[(size_t)k * 512]; }
        c.act[i] = siluf(a) * b; }
}
__device__ __forceinline__ void s_moe_down(const Ctx& c, int l, size_t gid, size_t gs) {
    for (size_t i = gid; i < (size_t)T * 1024; i += gs) { const size_t t = i / 1024; const int n = (int)(i % 1024); float y = 0.f;
        for (int k = 0; k < 2; ++k) { const int e = c.eid[t * 2 + k] & 31; const float* wd = c.in[I_MOE_WDOWN] + ((size_t)l * 32 + e) * 512 * 1024 + n; const float* a = c.act + (t * 2 + k) * 512; float s = 0.f;
            for (int f = 0; f < 512; ++f) s += a[f] * wd[(size_t)f * 1024];
            y += s * c.gatew[t * 2 + k]; }
        c.h[i] += y; }
}
__device__ __forceinline__ void s_gdn_conv(const Ctx& c, size_t gid, size_t gs) {
    const float* w = c.in[I_OD_CONV];
    for (size_t i = gid; i < (size_t)T * 3072; i += gs) { const size_t t = i / 3072; const int ch = (int)(i % 3072); const int tl = (int)(t % L); float s = 0.f;
        for (int j = 0; j < 4; ++j) { const int tt = tl - 3 + j; if (tt >= 0) s += w[j * 3072 + ch] * c.proj[(t - 3 + j) * PROJ_LD + O_QKV + ch]; }
        c.qkvc[i] = siluf(s); }
}
__device__ __forceinline__ void s_gdn_qkscale(const Ctx& c, size_t gid, size_t gs) {
    for (size_t i = gid; i < (size_t)T * 16; i += gs) { const size_t t = i / 16; const int wh = (int)(i % 16); float* p = c.qkvc + t * 3072 + wh * 128; float s = 0.f; for (int d = 0; d < 128; ++d) s += p[d] * p[d];
        float r = 1.f / sqrtf(s + 1e-6f); if (wh < 8) r *= 0.08838834764831845f; for (int d = 0; d < 128; ++d) p[d] *= r; }
}
__device__ __forceinline__ void s_gdn_gates(const Ctx& c, size_t gid, size_t gs) {
    for (size_t i = gid; i < (size_t)NB * NCH * 8; i += gs) { const int hd = (int)(i % 8); const size_t bc = i / 8; const float na = -expf(c.in[I_OD_ALOG][hd]); const float db = c.in[I_OD_DTB][hd]; float cs = 0.f;
        for (int s = 0; s < 64; ++s) { const size_t t = bc * 64 + s; cs += na * softplusf(c.proj[t * PROJ_LD + O_A + hd] + db); c.gcs[t * 8 + hd] = cs; c.beta[t * 8 + hd] = sigmoidf(c.proj[t * PROJ_LD + O_B + hd]); } }
}
__device__ __forceinline__ void s_gdn_kk(const Ctx& c, size_t gid, size_t gs) {
    for (size_t i = gid; i < (size_t)NB * NCH * 8 * 4096; i += gs) { const int s = (int)(i % 64); const int t = (int)((i / 64) % 64); const int hd = (int)((i / 4096) % 8); const size_t bc = i / (4096 * 8);
        float lv = 0.f, av = 0.f;
        if (s <= t) { const size_t tt = bc * 64 + t, ts = bc * 64 + s; const float* kt = c.qkvc + tt * 3072 + 1024 + hd * 128; const float* ks = c.qkvc + ts * 3072 + 1024 + hd * 128; const float* qt = c.qkvc + tt * 3072 + hd * 128; float kk = 0.f, qk = 0.f;
            for (int d = 0; d < 128; ++d) { kk += kt[d] * ks[d]; qk += qt[d] * ks[d]; }
            const float dec = expf(c.gcs[tt * 8 + hd] - c.gcs[ts * 8 + hd]); av = qk * dec; if (s < t) lv = kk * c.beta[tt * 8 + hd] * dec; }
        c.Lm[i] = lv; c.aqk[i] = av; }
}
__device__ __forceinline__ void s_gdn_solve(const Ctx& c, size_t gid, size_t gs) {
    for (size_t i = gid; i < (size_t)NB * NCH * 8 * 256; i += gs) { const int j = (int)(i % 256); const int hd = (int)((i / 256) % 8); const size_t bc = i / 2048; float* sol = c.uw + (bc * 8 + hd) * (64 * 256) + j; const float* Lp = c.Lm + (bc * 8 + hd) * 4096;
        for (int t = 0; t < 64; ++t) { const size_t tt = bc * 64 + t; const float bt = c.beta[tt * 8 + hd];
            float r = (j < 128) ? c.qkvc[tt * 3072 + 2048 + hd * 128 + j] * bt : c.qkvc[tt * 3072 + 1024 + hd * 128 + (j - 128)] * bt * expf(c.gcs[tt * 8 + hd]);
            for (int s = 0; s < t; ++s) r -= Lp[t * 64 + s] * sol[(size_t)s * 256];
            sol[(size_t)t * 256] = r; } }
}
__device__ __forceinline__ void s_gdn_scan(const Ctx& c, size_t gid, size_t gs) {
    for (size_t i = gid; i < (size_t)NB * 8 * 128; i += gs) { const int j = (int)(i % 128); const size_t bh = i / 128; const int hd = (int)(bh % 8); const size_t b = bh / 8; float* S = c.S + bh * 16384 + j; float* vn = c.vn + bh * 8192 + j;
        for (int d = 0; d < 128; ++d) S[(size_t)d * 128] = 0.f;
        for (int ch = 0; ch < NCH; ++ch) { const size_t bc = b * NCH + ch; const float* uw = c.uw + (bc * 8 + hd) * (64 * 256); const float* aq = c.aqk + (bc * 8 + hd) * 4096; const float glast = c.gcs[(bc * 64 + 63) * 8 + hd];
            for (int t = 0; t < 64; ++t) { float v = uw[t * 256 + j]; const float* w = uw + t * 256 + 128; for (int d = 0; d < 128; ++d) v -= w[d] * S[(size_t)d * 128]; vn[(size_t)t * 128] = v; }
            for (int t = 0; t < 64; ++t) { const size_t tt = bc * 64 + t; const float* q = c.qkvc + tt * 3072 + hd * 128; float o = 0.f; for (int d = 0; d < 128; ++d) o += q[d] * S[(size_t)d * 128];
                o *= expf(c.gcs[tt * 8 + hd]); for (int s = 0; s <= t; ++s) o += aq[t * 64 + s] * vn[(size_t)s * 128];
                c.obuf[tt * 1024 + hd * 128 + j] = o; }
            const float dl = expf(glast);
            for (int d = 0; d < 128; ++d) { float a = S[(size_t)d * 128] * dl; for (int t = 0; t < 64; ++t) { const size_t tt = bc * 64 + t; a += c.qkvc[tt * 3072 + 1024 + hd * 128 + d] * expf(glast - c.gcs[tt * 8 + hd]) * vn[(size_t)t * 128]; } S[(size_t)d * 128] = a; } } }
}
__device__ __forceinline__ void s_gdn_out(const Ctx& c, size_t gid, size_t gs) {
    for (size_t i = gid; i < (size_t)T * 1024; i += gs) { const size_t t = i / 1024; const int col = (int)(i % 1024); c.cat[t * 1536 + col] = c.obuf[i] * c.rstd2[t * 8 + col / 128] * c.in[I_OD_NORM][col % 128] * siluf(c.proj[t * PROJ_LD + O_Z + col]); }
}
__device__ __forceinline__ void s_sb(const Ctx& c, size_t gid, size_t gs) {
    for (size_t i = gid; i < (size_t)T * 32; i += gs) { const int qd = (int)(i % 4); const int hd = (int)((i / 4) % 8); const size_t t = i / 32; const int tl = (int)(t % L); const float* q = c.proj + t * PROJ_LD + O_SQ + hd * 64;
        float o[16];
#pragma unroll
        for (int d = 0; d < 16; ++d) o[d] = 0.f;
        float carry = 0.f;
        for (int s = tl - 1; s >= 0 && carry > -150.f; --s) { const size_t ts = t - (size_t)(tl - s); const float* k = c.proj + ts * PROJ_LD + O_SK + hd * 64; const float* v = c.proj + ts * PROJ_LD + O_SV + hd * 64 + qd * 16; float lg = 0.f;
            for (int d = 0; d < 64; ++d) lg += q[d] * k[d];
            lg *= 0.125f; const float wgt = expf(-softplusf(-lg) + carry); carry -= softplusf(lg);
#pragma unroll
            for (int d = 0; d < 16; ++d) o[d] += wgt * v[d]; }
#pragma unroll
        for (int d = 0; d < 16; ++d) c.cat[t * 1536 + 1024 + hd * 64 + qd * 16 + d] = o[d]; }
}
__device__ __forceinline__ void s_final(const Ctx& c, size_t gid, size_t gs) { s_norm(c.h, c.rstd, c.in[I_FINAL_NORM], c.out, T, gid, gs); }

constexpr int XA_BASE = 20, MOE_BASE = 30, L1_BASE = 40, NSTAGE_L = 60;
__device__ __forceinline__ bool run_stage(const Ctx& c, int st, size_t gid, size_t gs) {
    const int layer = st / NSTAGE_L, s = st % NSTAGE_L;
    if (st >= 2 * NSTAGE_L + 2) return false;
    if (st == 2 * NSTAGE_L) { s_rstd(c.h, T, DM, DM, c.rstd, gid, gs); return true; }
    if (st == 2 * NSTAGE_L + 1) { s_final(c, gid, gs); return true; }
    const int l = layer;
    switch (s) {
    case 0: if (l == 0) { s_copy(c.in[I_X], c.h, (size_t)T * DM, gid, gs); s_rstd(c.in[I_MEM], NB * MEM, DM, DM, c.rstd2, gid, gs); } break;
    case 1: if (l == 0) s_norm(c.in[I_MEM], c.rstd2, c.in[I_MEM_NORM], c.memn, NB * MEM, gid, gs); s_rstd(c.h, T, DM, DM, c.rstd, gid, gs); break;
    case 2: s_norm(c.h, c.rstd, c.in[I_NORM_MIX] + l * DM, c.un, T, gid, gs); break;
    case 3: if (l == 0) s_gemm(c.un, DM, c.in[I_EV_WIN], EV_IN, c.proj, PROJ_LD, T, EV_IN, DM, 0, gid, gs); else s_gemm(c.un, DM, c.in[I_OD_WIN], OD_IN, c.proj, PROJ_LD, T, OD_IN, DM, 0, gid, gs); break;
    case 4: if (l == 0) { s_scmix(c, gid, gs); s_ssd_conv(c, gid, gs); s_ssd_dt(c, gid, gs); } else { s_gdn_conv(c, gid, gs); s_gdn_gates(c, gid, gs); s_sb(c, gid, gs); } break;
    case 5: if (l == 0) { s_ssd_states(c, gid, gs); s_ssd_cb(c, gid, gs); } else s_gdn_qkscale(c, gid, gs); break;
    case 6: if (l == 0) s_ssd_scan(c, gid, gs); else s_gdn_kk(c, gid, gs); break;
    case 7: if (l == 0) s_ssd_y(c, gid, gs); else s_gdn_solve(c, gid, gs); break;
    case 8: if (l == 0) s_rstd(c.ybuf, T * 2, 512, 512, c.rstd2, gid, gs); else s_gdn_scan(c, gid, gs); break;
    case 9: if (l == 0) s_ssd_out(c, gid, gs); else s_rstd(c.obuf, T * 8, 128, 128, c.rstd2, gid, gs); break;
    case 10: if (l == 1) s_gdn_out(c, gid, gs); break;
    case 11: s_gemm(c.cat, 1536, l == 0 ? c.in[I_EV_WOUT] : c.in[I_OD_WOUT], DM, c.h, DM, T, DM, 1536, 1, gid, gs); break;
    case 12: s_rstd(c.h, T, DM, DM, c.rstd, gid, gs); break;
    case 13: s_norm(c.h, c.rstd, c.in[I_NORM_XA] + l * DM, c.un, T, gid, gs); break;
    case 14: s_gemm(c.un, DM, c.in[I_XA_WQ] + (size_t)l * DM * DM, DM, c.q, DM, T, DM, DM, 0, gid, gs);
             s_gemm(c.memn, DM, c.in[I_XA_WK] + (size_t)l * DM * DM, DM, c.kx, DM, NB * MEM, DM, DM, 0, gid, gs);
             s_gemm(c.memn, DM, c.in[I_XA_WV] + (size_t)l * DM * DM, DM, c.vx, DM, NB * MEM, DM, DM, 0, gid, gs); break;
    case 15: s_xa_scores(c, gid, gs); break;
    case 16: s_xa_softmax(c, gid, gs); break;
    case 17: s_xa_pv(c, gid, gs); break;
    case 18: s_gemm(c.att, DM, c.in[I_XA_WO] + (size_t)l * DM * DM, DM, c.h, DM, T, DM, DM, 1, gid, gs); break;
    case 19: s_rstd(c.h, T, DM, DM, c.rstd, gid, gs); break;
    case 20: s_norm(c.h, c.rstd, c.in[I_NORM_FFN] + l * DM, c.un, T, gid, gs); break;
    case 21: s_router(c, l, gid, gs); break;
    case 22: s_moe_up(c, l, gid, gs); break;
    case 23: s_moe_down(c, l, gid, gs); break;
    default: break;
    }
    return true;
}
constexpr int N_STAGES_USED = 24;

__host__ __device__ __forceinline__ size_t carve(Ctx& c, float* w) {
    size_t o = 0;
    auto take = [&](size_t n) { float* p = w + o; o += (n + 63) & ~(size_t)63; return p; };
    c.h = take((size_t)T * DM); c.rstd = take(T); c.rstd2 = take((size_t)T * 8); c.memn = take((size_t)MEM * DM); c.kx = take((size_t)MEM * DM); c.vx = take((size_t)MEM * DM);
    c.eid = (int*)take((size_t)T * 2); c.gatew = take((size_t)T * 2); c.dtv = take((size_t)T * 16); c.acs = take((size_t)T * 16); c.beta = take((size_t)T * 8); c.gcs = take((size_t)T * 8);
    c.S = take(8 * 16384); c.vn = take(8 * 8192);
    c.un = take((size_t)T * DM); c.ybuf = c.un; c.obuf = c.un;
    c.proj = take((size_t)T * PROJ_LD);
    c.cat = take((size_t)T * 1536);
    const size_t d0 = o;
    c.xbcc = take((size_t)T * 1536); c.states = take((size_t)NCH * 16 * 8192); c.cb = take((size_t)NCH * 2 * 4096); size_t dmax = o;
    o = d0; c.qkvc = take((size_t)T * 3072); c.Lm = take((size_t)NCH * 8 * 4096); c.aqk = take((size_t)NCH * 8 * 4096); c.uw = take((size_t)NCH * 8 * 64 * 256); if (o > dmax) dmax = o;
    o = d0; c.q = take((size_t)T * DM); c.sc = take((size_t)T * DM); c.att = take((size_t)T * DM); if (o > dmax) dmax = o;
    o = d0; c.act = take((size_t)T * 2 * 512); if (o > dmax) dmax = o;
    return dmax;
}
}

namespace pg8 {
#define PG8_LAS __attribute__((address_space(3)))
typedef unsigned short bf16_t;
typedef short bf16x8 __attribute__((ext_vector_type(8)));
typedef float f32x4 __attribute__((ext_vector_type(4)));
typedef unsigned u32x4 __attribute__((ext_vector_type(4)));
constexpr int BM = 256, BK = 64, HALF = 128, HTB = HALF * BK * 2  , STAGE_BYTES = 8 * HTB, NXCD = 8, WGM = 8;

__host__ __device__ __forceinline__ int lds_byte(int r, int c) { const int st = (r >> 4) * 2 + (c >> 5), rr = r & 15, cc = c & 31, ob = rr * 64 + cc * 2; return st * 1024 + (ob ^ (((ob >> 9) & 1) << 5)); }
__host__ __device__ __forceinline__ void stage_rc(int b, int& R, int& C) { const int st = b / 1024, sb = b % 1024, swz = sb ^ (((sb >> 9) & 1) << 5); R = (st >> 1) * 16 + swz / 64; C = (st & 1) * 32 + (swz % 64) / 2; }
__host__ __device__ __forceinline__ int perm32(int rho) { const int n = rho >> 4, i = rho & 15; return 8 * (i >> 2) + 4 * n + (i & 3); }

struct Unit { int pm, pn, tag; const char* a; const char* b; };
struct Gemm { const bf16_t* A; const bf16_t* Bt; int M, N, K; };

struct StaticOrder {
    int nM, nN, nwg, G, c; const char* A; const char* B; size_t tstep;
    __host__ __device__ void init(const Gemm& g, int G_, int c_) { nM = g.M / BM; nN = g.N / BM; nwg = nM * nN; G = G_; c = c_; A = (const char*)g.A; B = (const char*)g.Bt; tstep = (size_t)BM * g.K * 2; }
    __host__ __device__ bool next(int i, Unit& u) const {
        const long L = (long)i * G + c; if (L >= nwg) return false;
        int wgid = (int)L; { const int q = nwg / NXCD, r = nwg % NXCD, xcd = wgid % NXCD, off = wgid / NXCD; wgid = (xcd < r ? xcd * (q + 1) : r * (q + 1) + (xcd - r) * q) + off; }
        const int nig = WGM * nN, gid = wgid / nig, fm = gid * WGM, gsz = (nM - fm) < WGM ? (nM - fm) : WGM;
        u.pm = fm + ((wgid % nig) % gsz); u.pn = (wgid % nig) / gsz; u.a = A + (size_t)u.pm * tstep; u.b = B + (size_t)u.pn * tstep; return true;
    }
    __device__ __forceinline__ void a_ready(const Unit&) const {}
    __device__ __forceinline__ void done(const Unit&) const {}
};

template <class Epi, class Sched, bool ALIGN_EPI = false, bool SP2 = false>
__device__ __forceinline__ void gemm_phase(PG8_LAS unsigned char* lds, const Gemm g, const Sched& S, const Epi& E) {
    int tid_ = threadIdx.x; asm volatile("" : "+v"(tid_));
    const int tid = tid_, wid = __builtin_amdgcn_readfirstlane(tid >> 6), lane = tid & 63, wr = wid >> 2, wc = wid & 3, fr = lane & 15, fq = lane >> 4;
    const int K = g.K, nt = K / BK;
    unsigned voffA[2], voffB[2];
#pragma unroll
    for (int i = 0; i < 2; ++i) { int R, C; stage_rc(tid * 16 + i * 8192, R, C); const int Rb = Epi::PERM ? ((R & ~31) + perm32(R & 31)) : R;
        voffA[i] = (unsigned)(R * K + C) * 2u; voffB[i] = (unsigned)(Rb * K + C) * 2u; }
    const size_t kstep = (size_t)(BK * 2);
    const size_t hstep = (size_t)HALF * K * 2;
    const unsigned ldsw = (unsigned)wid * 1024u;
    const int aoff = lds_byte(wr * 64 + fr, fq * 8), boff = lds_byte(wc * 32 + fr, fq * 8);
#define PG8_SA(b, h) (((b) * 2 + (h)) * HTB)
#define PG8_SB(b, h) ((4 + (b) * 2 + (h)) * HTB)
#define PG8_STAGE(bufoff, gbase, voff) do { _Pragma("unroll") for (int _i = 0; _i < 2; ++_i) \
        __builtin_amdgcn_global_load_lds((const unsigned*)((const char*)(gbase) + (voff)[_i]), (PG8_LAS unsigned*)(lds + (bufoff) + ldsw + _i * 8192), 16, 0, 0); } while (0)
#define PG8_LDA(dst, b, h) do { _Pragma("unroll") for (int m = 0; m < 4; ++m) _Pragma("unroll") for (int k = 0; k < 2; ++k) dst[m][k] = *(const PG8_LAS bf16x8*)(lds + PG8_SA(b, h) + aoff + m * 2048 + k * 1024); } while (0)
#define PG8_LDB(dst, b, h) do { _Pragma("unroll") for (int n = 0; n < 2; ++n) _Pragma("unroll") for (int k = 0; k < 2; ++k) dst[n][k] = *(const PG8_LAS bf16x8*)(lds + PG8_SB(b, h) + boff + n * 2048 + k * 1024); } while (0)
#define PG8_MMA(ai, bj, At, Bt) do { __builtin_amdgcn_s_setprio(1); _Pragma("unroll") for (int m = 0; m < 4; ++m) _Pragma("unroll") for (int n = 0; n < 2; ++n) _Pragma("unroll") for (int k = 0; k < 2; ++k) \
        acc[ai][bj][m][n] = __builtin_amdgcn_mfma_f32_16x16x32_bf16(Bt[n][k], At[m][k], acc[ai][bj][m][n], 0, 0, 0); __builtin_amdgcn_s_setprio(0); } while (0)
#define PG8_WAIT_V(n) asm volatile("s_waitcnt vmcnt(" #n ")" ::: "memory")
#define PG8_WAIT_L(n) asm volatile("s_waitcnt lgkmcnt(" #n ")" ::: "memory")
#define PG8_BAR __builtin_amdgcn_s_barrier()
#define PG8_SCHED __builtin_amdgcn_sched_barrier(0)
    Unit cur, nxt; int ui = 0;
    if (!S.next(0, cur)) return;
    f32x4 acc[2][2][4][2];
#pragma unroll
    for (int a = 0; a < 2; ++a)
#pragma unroll
        for (int b = 0; b < 2; ++b)
#pragma unroll
            for (int m = 0; m < 4; ++m)
#pragma unroll
                for (int n = 0; n < 2; ++n) acc[a][b][m][n] = (f32x4){0.f, 0.f, 0.f, 0.f};
    bf16x8 At[4][2], B0[2][2], B1[2][2];
    const char* cA = cur.a; const char* cB = cur.b;
    S.a_ready(cur);
    if constexpr (SP2) {
        PG8_STAGE(PG8_SB(0, 0), cB, voffB); PG8_STAGE(PG8_SB(0, 1), cB + hstep, voffB); PG8_STAGE(PG8_SA(0, 0), cA, voffA); PG8_STAGE(PG8_SA(0, 1), cA + hstep, voffA);
        if (wr == 1) PG8_BAR;
        PG8_WAIT_V(2); PG8_BAR;
        PG8_STAGE(PG8_SB(1, 0), cB + kstep, voffB); PG8_STAGE(PG8_SA(1, 0), cA + kstep, voffA); PG8_STAGE(PG8_SB(1, 1), cB + hstep + kstep, voffB);
        PG8_WAIT_V(6); PG8_BAR;
    } else {
        PG8_STAGE(PG8_SB(0, 0), cB, voffB); PG8_STAGE(PG8_SA(0, 0), cA, voffA); PG8_STAGE(PG8_SB(0, 1), cB + hstep, voffB); PG8_STAGE(PG8_SA(0, 1), cA + hstep, voffA);
        if (wr == 1) PG8_BAR;
        PG8_WAIT_V(4); PG8_BAR;
        PG8_STAGE(PG8_SB(1, 0), cB + kstep, voffB); PG8_STAGE(PG8_SA(1, 0), cA + kstep, voffA); PG8_STAGE(PG8_SB(1, 1), cB + hstep + kstep, voffB);
        PG8_WAIT_V(6); PG8_BAR;
    }
    for (;;) {
        const bool has_next = S.next(ui + 1, nxt);
        const char* nA = has_next ? nxt.a : cA; const char* nB = has_next ? nxt.b : cB;
        for (int t = 0; t < nt; t += 2) {
            const bool last = (t == nt - 2);
            const char* a1 = cA + (size_t)(t + 1) * kstep;
            const char* a2 = last ? nA : cA + (size_t)(t + 2) * kstep; const char* b2 = last ? nB : cB + (size_t)(t + 2) * kstep;
            const char* a3 = a2 + kstep; const char* b3 = b2 + kstep;
            if (last && has_next) S.a_ready(nxt);
            if constexpr (SP2) {
            PG8_LDB(B0, 0, 0); PG8_LDB(B1, 0, 1); PG8_SCHED; PG8_LDA(At, 0, 0); PG8_STAGE(PG8_SA(1, 1), a1 + hstep, voffA);
            PG8_WAIT_V(8); PG8_WAIT_L(0); PG8_BAR; PG8_MMA(0, 0, At, B0); PG8_MMA(0, 1, At, B1); PG8_BAR; PG8_SCHED;
            PG8_LDA(At, 0, 1); PG8_STAGE(PG8_SB(0, 0), b2, voffB); PG8_STAGE(PG8_SB(0, 1), b2 + hstep, voffB); PG8_STAGE(PG8_SA(0, 0), a2, voffA);
            PG8_WAIT_V(8); PG8_WAIT_L(0); PG8_BAR; PG8_MMA(1, 0, At, B0); PG8_MMA(1, 1, At, B1); PG8_BAR; PG8_SCHED;
            PG8_LDB(B0, 1, 0); PG8_LDB(B1, 1, 1); PG8_SCHED; PG8_LDA(At, 1, 0); PG8_STAGE(PG8_SA(0, 1), a2 + hstep, voffA);
            PG8_WAIT_V(8); PG8_WAIT_L(0); PG8_BAR; PG8_MMA(0, 0, At, B0); PG8_MMA(0, 1, At, B1); PG8_BAR; PG8_SCHED;
            PG8_LDA(At, 1, 1); PG8_STAGE(PG8_SB(1, 0), b3, voffB); PG8_STAGE(PG8_SB(1, 1), b3 + hstep, voffB); PG8_STAGE(PG8_SA(1, 0), a3, voffA);
            PG8_WAIT_V(8); PG8_WAIT_L(0); PG8_BAR; PG8_MMA(1, 0, At, B0); PG8_MMA(1, 1, At, B1); PG8_BAR; PG8_SCHED;
            } else {
            PG8_LDB(B0, 0, 0); PG8_SCHED; PG8_LDA(At, 0, 0); PG8_STAGE(PG8_SA(1, 1), a1 + hstep, voffA);
            PG8_WAIT_L(8); PG8_BAR; PG8_WAIT_L(0); PG8_MMA(0, 0, At, B0); PG8_BAR; PG8_SCHED;
            PG8_LDB(B1, 0, 1); PG8_STAGE(PG8_SB(0, 0), b2, voffB);
            PG8_BAR; PG8_WAIT_L(0); PG8_MMA(0, 1, At, B1); PG8_BAR;
            PG8_LDA(At, 0, 1); PG8_STAGE(PG8_SA(0, 0), a2, voffA);
            PG8_BAR; PG8_WAIT_L(0); PG8_MMA(1, 0, At, B0); PG8_BAR; PG8_SCHED;
            PG8_STAGE(PG8_SB(0, 1), b2 + hstep, voffB);
            PG8_WAIT_V(6); PG8_BAR; PG8_MMA(1, 1, At, B1); PG8_BAR;
            PG8_LDB(B0, 1, 0); PG8_SCHED; PG8_LDA(At, 1, 0); PG8_STAGE(PG8_SA(0, 1), a2 + hstep, voffA);
            PG8_WAIT_L(8); PG8_BAR; PG8_WAIT_L(0); PG8_MMA(0, 0, At, B0); PG8_BAR; PG8_SCHED;
            PG8_LDB(B1, 1, 1); PG8_STAGE(PG8_SB(1, 0), b3, voffB);
            PG8_BAR; PG8_WAIT_L(0); PG8_MMA(0, 1, At, B1); PG8_BAR;
            PG8_LDA(At, 1, 1); PG8_STAGE(PG8_SA(1, 0), a3, voffA);
            PG8_BAR; PG8_WAIT_L(0); PG8_MMA(1, 0, At, B0); PG8_BAR; PG8_SCHED;
            PG8_STAGE(PG8_SB(1, 1), b3 + hstep, voffB);
            PG8_WAIT_V(6); PG8_BAR; PG8_MMA(1, 1, At, B1); PG8_BAR;
            }
        }
        if constexpr (ALIGN_EPI) { if (wr == 0) PG8_BAR; }
        if constexpr (!Epi::AFTER_DRAIN) { E(acc, cur, wr, wc, fr, fq); S.done(cur); }
        if (!has_next) break;
#pragma unroll
        for (int a = 0; a < 2; ++a)
#pragma unroll
            for (int b = 0; b < 2; ++b)
#pragma unroll
                for (int m = 0; m < 4; ++m)
#pragma unroll
                    for (int n = 0; n < 2; ++n) acc[a][b][m][n] = (f32x4){0.f, 0.f, 0.f, 0.f};
        cur = nxt; cA = nA; cB = nB; ++ui;
        if constexpr (ALIGN_EPI) { if (wr == 1) PG8_BAR; }
    }
    PG8_WAIT_V(0);
    if constexpr (!ALIGN_EPI) { if (wr == 0) PG8_BAR; }
    PG8_BAR;
    if constexpr (Epi::AFTER_DRAIN) { E.fused(acc, cur, wr, wc, fr, fq, lds, wid, lane); S.done(cur); }
#undef PG8_SA
#undef PG8_SB
#undef PG8_STAGE
#undef PG8_LDA
#undef PG8_LDB
#undef PG8_MMA
#undef PG8_WAIT_V
#undef PG8_WAIT_L
#undef PG8_BAR
#undef PG8_SCHED
}
}

namespace ok {
using pg8::bf16_t; using pg8::bf16x8; using pg8::f32x4; using pg8::u32x4;
typedef unsigned u32x2 __attribute__((ext_vector_type(2)));
typedef float f32x2 __attribute__((ext_vector_type(2)));
#ifndef SEQ
#define SEQ 8192
#endif
constexpr int NB = 2, L = SEQ, NCH = L / 64, T = NB * L, DM = 1024, NWAVES = 8, NT = 512;
constexpr float EPS = 1e-6f, LOG2E = 1.4426950408889634f;
constexpr size_t MiB = 1u << 20, KiB = 1024;
constexpr size_t WS_CTL = 0, CTL_BYTES = 1 * MiB;
constexpr int CW_BAR = 0;
constexpr int CW_SSQ = 16384;
constexpr int CW_MOE = 16384 + 6 * T;
constexpr int CW_CHK = CW_MOE + 256;
static_assert((CW_CHK + 64) * 4 <= (int)CTL_BYTES, "ctl");
constexpr size_t WS_WDT = 1 * MiB, WS_WAB = WS_WDT + 64 * KiB, WS_WR = WS_WAB + 64 * KiB;
constexpr size_t WS_DTV = 2 * MiB, WS_ACS = 3 * MiB, WS_GCS = 4 * MiB, WS_BETA = 4 * MiB + 512 * KiB;
constexpr size_t WS_EID = 5 * MiB, WS_GATEW = WS_EID + 128 * KiB, WS_TOKSLOT = WS_GATEW + 128 * KiB, WS_SLOTTOK = WS_TOKSLOT + 128 * KiB, WS_SLOTGATE = WS_SLOTTOK + 160 * KiB,
                 WS_SLOTRSTD = WS_SLOTGATE + 160 * KiB, WS_TILEEXP = WS_SLOTRSTD + 160 * KiB;
constexpr size_t WS_FP = 8 * MiB;
constexpr size_t WS_W_IN0 = 16 * MiB, WS_W_IN1 = 24 * MiB, WS_W_OUT0 = 35 * MiB, WS_W_OUT1 = 38 * MiB, WS_W_XA = 41 * MiB  ;
constexpr size_t WS_MEMNB = 57 * MiB, WS_KX = 58 * MiB  , WS_VT = 60 * MiB  ;
constexpr size_t WS_H = 64 * MiB, WS_HB = 128 * MiB, WS_MOEW = 160 * MiB, WS_BIG = 256 * MiB;
constexpr size_t WS_PROJ = WS_BIG;
constexpr size_t WS_CAT0 = 384 * MiB, WS_STATES = 432 * MiB;
constexpr size_t WS_CAT1 = 432 * MiB;
constexpr size_t WS_Q = WS_BIG, WS_ATT = WS_BIG + 32 * MiB;
constexpr size_t WS_XS = WS_BIG, WS_ACT = WS_BIG + 80 * MiB, WS_Y = WS_BIG + 120 * MiB;
constexpr size_t WS_END = 528 * MiB;
constexpr int PROJ0_LD = 4096, PROJ1_LD = 5632, MAXSLOT = 40960;

#ifdef CPU_EMU
#define LAS
#define GAS
#define LDS_WAIT() do {} while (0)
#define WAVE_SYNC() ((void)__shfl(0, 0))
#define SCHED_FENCE() do {} while (0)
__device__ __forceinline__ unsigned cvt_pk_bf16(float lo, float hi) { return emu_f2bf(lo) | (emu_f2bf(hi) << 16); }
#else
#define LAS __attribute__((address_space(3)))
#define GAS __attribute__((address_space(1)))
#define LDS_WAIT() asm volatile("s_waitcnt lgkmcnt(0)" ::: "memory")
#define SCHED_FENCE() __builtin_amdgcn_sched_barrier(0)
#define WAVE_SYNC() do { asm volatile("s_waitcnt lgkmcnt(0)" ::: "memory"); __builtin_amdgcn_wave_barrier(); } while (0)
typedef __bf16 hwbf16x2 __attribute__((ext_vector_type(2)));
__device__ __forceinline__ unsigned cvt_pk_bf16(float lo, float hi) { const f32x2 v = {lo, hi}; return __builtin_bit_cast(unsigned, __builtin_convertvector(v, hwbf16x2)); }
#endif
__device__ __forceinline__ float bf2f(unsigned short b) { return __uint_as_float(((unsigned)b) << 16); }
__device__ __forceinline__ float bflo(unsigned w) { return __uint_as_float(w << 16); }
__device__ __forceinline__ float bfhi(unsigned w) { return __uint_as_float(w & 0xffff0000u); }
__device__ __forceinline__ float wave_sum(float v) {
#pragma unroll
    for (int o = 1; o < 64; o <<= 1) v += __shfl_xor(v, o);
    return v;
}
__device__ __forceinline__ f32x4 mfma16(bf16x8 a, bf16x8 b, f32x4 c) { return __builtin_amdgcn_mfma_f32_16x16x32_bf16(a, b, c, 0, 0, 0); }

struct Frame {
    LAS unsigned char* lds;
    unsigned* ctl;
    unsigned char* ws;
    const float* const* in;
    float* out;
    int tid, lane, wave, vcu, G;
};
constexpr size_t WS_SSQP1 = 6 * MiB, WS_SSQP2 = 7 * MiB, WS_SSQP4 = 62 * MiB, WS_SSQP5 = 63 * MiB;
__device__ __forceinline__ float rstd_np(const float* p, int np, int row) { float s; if (np == 1) s = p[row]; else { const f32x4* q = (const f32x4*)(p + (size_t)row * 16); const f32x4 a = q[0], b = q[1], c = q[2], d = q[3]; s = ((a.x + a.y) + (a.z + a.w)) + ((b.x + b.y) + (b.z + b.w)) + (((c.x + c.y) + (c.z + c.w)) + ((d.x + d.y) + (d.z + d.w))); }
    return 1.f / sqrtf(s * (1.f / 1024.f) + EPS); }
#define OKP(type, off) ((type*)(F.ws + (off)))
#ifdef CPU_EMU
__device__ __forceinline__ Frame phase_frame(const Frame& F0) { return F0; }
#else
__device__ __forceinline__ Frame phase_frame(const Frame& F0) { Frame F = F0; int t = threadIdx.x; asm volatile("" : "+v"(t)); F.tid = t; F.lane = t & 63; F.wave = __builtin_amdgcn_readfirstlane(t >> 6); return F; }
#endif

__device__ __forceinline__ void cvt_item(const float* W, int ldw, int K, int k0, int c0, bf16_t* WT, int drow0, int dstep16, const float* kgain, float cscale, LAS float* scr, int lane) {
#pragma unroll 8
    for (int i = 0; i < 32; ++i) { const int kk = 2 * i + (lane >> 5); const float g = kgain ? kgain[k0 + kk] * cscale : cscale; scr[kk * 33 + (lane & 31)] = W[(size_t)(k0 + kk) * ldw + c0 + (lane & 31)] * g; }
    LDS_WAIT();
    const int c = lane & 7;
#pragma unroll
    for (int j = 0; j < 4; ++j) { const int n = (lane >> 3) + 8 * j; const LAS float* s = scr + (8 * c) * 33 + n;
        u32x4 o; o.x = cvt_pk_bf16(s[0 * 33], s[1 * 33]); o.y = cvt_pk_bf16(s[2 * 33], s[3 * 33]); o.z = cvt_pk_bf16(s[4 * 33], s[5 * 33]); o.w = cvt_pk_bf16(s[6 * 33], s[7 * 33]);
        *(u32x4*)(WT + (size_t)(drow0 + (n >> 4) * dstep16 + (n & 15)) * K + k0 + 8 * c) = o; }
    LDS_WAIT();
}
struct CvtJob { const float* W; int ldw, K, ncols, c0; bf16_t* WT; int drow0, dstep16; const float* kgain; float cscale; };
__device__ __forceinline__ int job_items(const CvtJob& j) { return (j.K / 64) * (j.ncols / 32); }
__device__ __forceinline__ void run_job_item(const CvtJob& j, int item, LAS float* scr, int lane) {
    const int nblk = j.ncols / 32, kb = item / nblk, nb = item % nblk;
    cvt_item(j.W, j.ldw, j.K, 64 * kb, j.c0 + 32 * nb, j.WT, j.drow0 + (32 * nb >> 4) * j.dstep16, j.dstep16, j.kgain, j.cscale, scr, lane);
}
__device__ __forceinline__ CvtJob dense_job(const Frame& F, int j) {
    using namespace sm;
    const float* const* in = F.in;
    switch (j) {
    case 0: return CvtJob{in[I_EV_WIN], 4112, 1024, 4096, 0, OKP(bf16_t, WS_W_IN0), 0, 16, in[I_NORM_MIX], 1.f};
    case 1: return CvtJob{in[I_OD_WIN], 5648, 1024, 4096, 0, OKP(bf16_t, WS_W_IN1), 0, 16, in[I_NORM_MIX] + 1024, 1.f};
    case 2: return CvtJob{in[I_OD_WIN], 5648, 1024, 512, 4112, OKP(bf16_t, WS_W_IN1), 4096, 16, in[I_NORM_MIX] + 1024, 0.125f * LOG2E};
    case 3: return CvtJob{in[I_OD_WIN], 5648, 1024, 1024, 4624, OKP(bf16_t, WS_W_IN1), 4608, 16, in[I_NORM_MIX] + 1024, 1.f};
    case 4: return CvtJob{in[I_EV_WOUT], 1024, 1536, 1024, 0, OKP(bf16_t, WS_W_OUT0), 0, 16, nullptr, 1.f};
    case 5: return CvtJob{in[I_OD_WOUT], 1024, 1536, 1024, 0, OKP(bf16_t, WS_W_OUT1), 0, 16, nullptr, 1.f};
    default: { const int l = (j - 6) / 4, w = (j - 6) % 4; bf16_t* dst = OKP(bf16_t, WS_W_XA + (size_t)l * 8 * MiB + (size_t)w * 2 * MiB);
        const float* src = in[I_XA_WQ + w] + (size_t)l * 1024 * 1024;
        if (w == 0) return CvtJob{src, 1024, 1024, 1024, 0, dst, 0, 16, in[I_NORM_XA] + l * 1024, 0.0625f * LOG2E};
        return CvtJob{src, 1024, 1024, 1024, 0, dst, 0, 16, nullptr, 1.f}; }
    }
}
constexpr int N_DENSE_JOBS = 14;
__device__ __forceinline__ CvtJob moe_job(const Frame& F, int l, int j) {
    using namespace sm;
    const int e = j / 3, w = j % 3; const float* const* in = F.in;
    bf16_t* gu = OKP(bf16_t, WS_MOEW + (size_t)e * 3 * MiB); bf16_t* dn = gu + 1024 * 1024;
    if (w == 0) return CvtJob{in[I_MOE_WGATE] + ((size_t)l * 32 + e) * 1024 * 512, 512, 1024, 512, 0, gu, 0, 32, in[I_NORM_FFN] + l * 1024, 1.f};
    if (w == 1) return CvtJob{in[I_MOE_WUP] + ((size_t)l * 32 + e) * 1024 * 512, 512, 1024, 512, 0, gu, 16, 32, in[I_NORM_FFN] + l * 1024, 1.f};
    return CvtJob{in[I_MOE_WDOWN] + ((size_t)l * 32 + e) * 512 * 1024, 1024, 512, 1024, 0, dn, 0, 16, nullptr, 1.f};
}
__device__ __forceinline__ void phase_cvt_dense(const Frame& F0) {
    const Frame F = phase_frame(F0);
    LAS float* scr = (LAS float*)(F.lds + F.wave * 16384);
    const int gw = F.vcu * NWAVES + F.wave, NGW = F.G * NWAVES;
    int base = 0;
    for (int j = 0; j < N_DENSE_JOBS; ++j) { const CvtJob job = dense_job(F, j); const int n = job_items(job);
        for (int it = ((gw - base) % NGW + NGW) % NGW; it < n; it += NGW) run_job_item(job, it, scr, F.lane);
        base += n; }
}
__device__ __forceinline__ void phase_cvt_moe(const Frame& F0, int l) {
    const Frame F = phase_frame(F0);
    LAS float* scr = (LAS float*)(F.lds + F.wave * 16384);
    const int gw = F.vcu * NWAVES + F.wave, NGW = F.G * NWAVES;
    for (int it = gw; it < 96 * 256; it += NGW) { const CvtJob job = moe_job(F, l, it >> 8); run_job_item(job, it & 255, scr, F.lane); }
}
__device__ __forceinline__ void row_to_bf16_ssq(const float* xrow, bf16_t* orow, float* ssq, int lane) {
    const f32x4* xr = (const f32x4*)xrow + lane; float s = 0.f; f32x4 v[4];
#pragma unroll
    for (int j = 0; j < 4; ++j) { v[j] = xr[64 * j]; s += (v[j].x * v[j].x + v[j].y * v[j].y) + (v[j].z * v[j].z + v[j].w * v[j].w); }
    s = wave_sum(s);
    u32x2* o8 = (u32x2*)orow + lane;
#pragma unroll
    for (int j = 0; j < 4; ++j) { u32x2 w; w.x = cvt_pk_bf16(v[j].x, v[j].y); w.y = cvt_pk_bf16(v[j].z, v[j].w); o8[64 * j] = w; }
    if (lane == 0) *ssq = s;
}
__device__ __forceinline__ void phase_prologue(const Frame& F0) {
    const Frame F = phase_frame(F0);
    using namespace sm;
    phase_cvt_dense(F0);
    const int gw = F.vcu * NWAVES + F.wave, NGW = F.G * NWAVES;
    float* ssq0 = (float*)F.ctl + CW_SSQ;
    for (int m = gw; m < T; m += NGW) row_to_bf16_ssq(F.in[I_X] + (size_t)m * DM, OKP(bf16_t, WS_HB) + (size_t)m * DM, ssq0 + m, F.lane);
    for (int m = gw; m < NB * 256; m += NGW) { const f32x4* xr = (const f32x4*)(F.in[I_MEM] + (size_t)m * DM) + F.lane; const f32x4* gr = (const f32x4*)F.in[I_MEM_NORM] + F.lane; float s = 0.f; f32x4 v[4];
#pragma unroll
        for (int j = 0; j < 4; ++j) { v[j] = xr[64 * j]; s += (v[j].x * v[j].x + v[j].y * v[j].y) + (v[j].z * v[j].z + v[j].w * v[j].w); }
        const float r = 1.f / sqrtf(wave_sum(s) * (1.f / DM) + EPS);
        u32x2* o8 = (u32x2*)(OKP(bf16_t, WS_MEMNB) + (size_t)m * DM) + F.lane;
#pragma unroll
        for (int j = 0; j < 4; ++j) { const f32x4 g = gr[64 * j]; u32x2 w; w.x = cvt_pk_bf16(v[j].x * r * g.x, v[j].y * r * g.y); w.y = cvt_pk_bf16(v[j].z * r * g.z, v[j].w * r * g.w); o8[64 * j] = w; } }
    const size_t gt = (size_t)F.vcu * NT + F.tid, GT = (size_t)F.G * NT;
    for (size_t i = gt; i < 1024 * 16; i += GT) { const int k = (int)(i >> 4), j = (int)(i & 15);
        OKP(float, WS_WDT)[j * 1024 + k] = F.in[I_NORM_MIX][k] * F.in[I_EV_WIN][(size_t)k * 4112 + 4096 + j];
        OKP(float, WS_WAB)[j * 1024 + k] = F.in[I_NORM_MIX][1024 + k] * F.in[I_OD_WIN][(size_t)k * 5648 + 4096 + j]; }
}

#ifndef CPU_EMU
struct EpiScaleBf16 {
    static constexpr bool PERM = true, AFTER_DRAIN = false;
    bf16_t* O; int ldc; const float* ssq; int np;
    __device__ __forceinline__ void operator()(const f32x4 (&acc)[2][2][4][2], const pg8::Unit& u, int wr, int wc, int fr, int fq) const {
        const int row0 = u.pm * 256 + wr * 64 + fr, col0 = u.pn * 256 + wc * 32 + 8 * fq;
#pragma unroll
        for (int ai = 0; ai < 2; ++ai)
#pragma unroll
            for (int m = 0; m < 4; ++m) { const int row = row0 + ai * 128 + m * 16; const float s = ssq ? rstd_np(ssq, np, row) : 1.f; bf16_t* rowp = O + (size_t)row * ldc + col0;
#pragma unroll
                for (int bj = 0; bj < 2; ++bj) { const f32x4 v0 = acc[ai][bj][m][0] * s, v1 = acc[ai][bj][m][1] * s; u32x4 w; w.x = cvt_pk_bf16(v0[0], v0[1]); w.y = cvt_pk_bf16(v0[2], v0[3]); w.z = cvt_pk_bf16(v1[0], v1[1]); w.w = cvt_pk_bf16(v1[2], v1[3]);
                    *(u32x4*)(rowp + bj * 128) = w; } }
    }
};
struct EpiResidual {
    static constexpr bool PERM = false, AFTER_DRAIN = false;
    const float* hin; float* hout; bf16_t* hb; float* ssq;
    __device__ __forceinline__ void operator()(const f32x4 (&acc)[2][2][4][2], const pg8::Unit& u, int wr, int wc, int fr, int fq) const {
        const int row0 = u.pm * 256 + wr * 64 + fr, col0 = u.pn * 256 + wc * 32 + 4 * fq;
#pragma unroll
        for (int ai = 0; ai < 2; ++ai)
#pragma unroll
            for (int m = 0; m < 4; ++m) { const int row = row0 + ai * 128 + m * 16; const size_t ro = (size_t)row * DM + col0; float s = 0.f;
#pragma unroll
                for (int bj = 0; bj < 2; ++bj)
#pragma unroll
                    for (int n = 0; n < 2; ++n) { const size_t o = ro + bj * 128 + n * 16; const f32x4 v = *(const f32x4*)(hin + o) + acc[ai][bj][m][n]; *(f32x4*)(hout + o) = v;
                        u32x2 w; w.x = cvt_pk_bf16(v[0], v[1]); w.y = cvt_pk_bf16(v[2], v[3]); *(u32x2*)(hb + o) = w; s += (v[0] * v[0] + v[1] * v[1]) + (v[2] * v[2] + v[3] * v[3]); }
                s += __shfl_xor(s, 16); s += __shfl_xor(s, 32);
                if (fq == 0) ssq[(size_t)row * 16 + u.pn * 4 + wc] = s; }
    }
};

template <class Epi> __device__ __forceinline__ void dense_gemm(const Frame& F, const bf16_t* A, const bf16_t* Bt, int M, int N, int K, const Epi& E) {
    pg8::Gemm g{A, Bt, M, N, K}; pg8::StaticOrder S; S.init(g, F.G, (int)blockIdx.x);
    pg8::gemm_phase<Epi, pg8::StaticOrder, true, true>(F.lds, g, S, E);
}
#endif
}

namespace ok {
constexpr int XT_LD = 72;
constexpr int BC_LD = 136;
__device__ __forceinline__ float siluf(float x) { return x / (1.f + __expf(-x)); }
__device__ __forceinline__ float softplusf(float x) { return x > 20.f ? x : log1pf(expf(x)); }

template <class Sink> __device__ __forceinline__ void ssd_conv_channel(const Frame& F, int b, int c, int xc, Sink&& sink) {
    using namespace sm;
    const float* cw = F.in[I_EV_CONVW]; const float w0 = cw[xc], w1 = cw[1536 + xc], w2 = cw[3072 + xc], w3 = cw[4608 + xc], bias = F.in[I_EV_CONVB][xc];
    const bf16_t* p = OKP(bf16_t, WS_PROJ) + (size_t)(b * L + c * 64) * PROJ0_LD + 2560 + xc;
    float x0 = 0.f, x1 = 0.f, x2 = 0.f;
    if (c > 0) { x0 = bf2f(p[-3 * PROJ0_LD]); x1 = bf2f(p[-2 * PROJ0_LD]); x2 = bf2f(p[-PROJ0_LD]); }
#pragma unroll 8
    for (int t = 0; t < 64; t += 2) { const float x3 = bf2f(p[(size_t)t * PROJ0_LD]), x4 = bf2f(p[(size_t)(t + 1) * PROJ0_LD]);
        const float v0 = bias + w0 * x0 + w1 * x1 + w2 * x2 + w3 * x3, v1 = bias + w0 * x1 + w1 * x2 + w2 * x3 + w3 * x4;
        sink(t, siluf(v0), siluf(v1)); x0 = x2; x1 = x3; x2 = x4; }
}

__device__ __forceinline__ void phase_ssd_a(const Frame& F0) {
    const Frame F = phase_frame(F0);
    using namespace sm;
    LAS bf16_t* XT = (LAS bf16_t*)F.lds; LAS bf16_t* BT = (LAS bf16_t*)(F.lds + 73728);
    LAS float* dt_s = (LAS float*)(F.lds + 92160); LAS float* acs_s = (LAS float*)(F.lds + 94208); LAS float* sc_s = (LAS float*)(F.lds + 96256);
    const int tid = F.tid, lane = F.lane, wave = F.wave;
    for (int u = F.vcu; u < NB * NCH * 2; u += F.G) {
        const int g = u & 1, bc = u >> 1, b = bc / NCH, c = bc % NCH; const size_t row0 = (size_t)b * L + c * 64;
        __syncthreads();
        for (int ci = tid; ci < 640; ci += NT) {
            const int xc = ci < 512 ? g * 512 + ci : 1024 + g * 128 + (ci - 512);
            LAS unsigned* dst = (LAS unsigned*)(ci < 512 ? XT + ci * XT_LD : BT + (ci - 512) * XT_LD);
            ssd_conv_channel(F, b, c, xc, [&](int t, float v0, float v1) { dst[t >> 1] = cvt_pk_bf16(v0, v1); });
        }
        { const int t = tid >> 3, hh = tid & 7, hd = g * 8 + hh; const f32x4* xr = (const f32x4*)(F.in[I_X] + (row0 + t) * DM); const f32x4* wr = (const f32x4*)(OKP(float, WS_WDT) + hd * 1024); float s = 0.f;
#pragma unroll 4
          for (int k = 0; k < 256; ++k) { const f32x4 xv = xr[k], wv = wr[k]; s += (xv.x * wv.x + xv.y * wv.y) + (xv.z * wv.z + xv.w * wv.w); }
          const float rs = 1.f / sqrtf(((const float*)F.ctl + CW_SSQ)[row0 + t] * (1.f / 1024.f) + EPS);
          const float dt = softplusf(s * rs + F.in[I_EV_DTB][hd]); dt_s[hh * 64 + t] = dt; acs_s[hh * 64 + t] = dt * -expf(F.in[I_EV_ALOG][hd]); }
        __syncthreads();
        { const int hh = wave, hd = g * 8 + hh; float v = acs_s[hh * 64 + lane];
#pragma unroll
          for (int o = 1; o < 64; o <<= 1) { const float n = __shfl_up(v, o); if (lane >= o) v += n; }
          const float last = __shfl(v, 63); const float dt = dt_s[hh * 64 + lane];
          sc_s[hh * 64 + lane] = dt * expf(last - v);
          OKP(float, WS_DTV)[(row0 + lane) * 16 + hd] = dt; OKP(float, WS_ACS)[(row0 + lane) * 16 + hd] = v; }
        WAVE_SYNC();
#if defined(CHECK_DUMP)
        if (bc == 5 && g == 0) {
            float* f3 = OKP(float, WS_FP) + (size_t)3 * 16 * 6144; float* f4 = OKP(float, WS_FP) + (size_t)4 * 16 * 6144; float* f5 = OKP(float, WS_FP) + (size_t)5 * 16 * 6144;
            for (int i = tid; i < 512 * 64; i += NT) f3[i] = bf2f(XT[(i >> 6) * XT_LD + (i & 63)]);
            for (int i = tid; i < 128 * 64; i += NT) f4[i] = bf2f(BT[(i >> 6) * XT_LD + (i & 63)]);
            f5[wave * 64 + lane] = sc_s[wave * 64 + lane];
        }
#endif
        { const int hh = wave, hd = g * 8 + hh, fr = lane & 15, fq = lane >> 4;
          bf16x8 xa[4][2];
#pragma unroll
          for (int pt = 0; pt < 4; ++pt)
#pragma unroll
              for (int ks = 0; ks < 2; ++ks) { const u32x4 raw = *(const LAS u32x4*)(XT + (hh * 64 + pt * 16 + fr) * XT_LD + ks * 32 + fq * 8); const LAS float* sp = sc_s + hh * 64 + ks * 32 + fq * 8;
                  const f32x4 s0 = *(const LAS f32x4*)sp, s1 = *(const LAS f32x4*)(sp + 4); u32x4 o;
                  o.x = cvt_pk_bf16(bflo(raw.x) * s0.x, bfhi(raw.x) * s0.y); o.y = cvt_pk_bf16(bflo(raw.y) * s0.z, bfhi(raw.y) * s0.w);
                  o.z = cvt_pk_bf16(bflo(raw.z) * s1.x, bfhi(raw.z) * s1.y); o.w = cvt_pk_bf16(bflo(raw.w) * s1.z, bfhi(raw.w) * s1.w);
                  xa[pt][ks] = __builtin_bit_cast(bf16x8, o); }
          bf16_t* st = OKP(bf16_t, WS_STATES) + ((size_t)bc * 16 + hd) * 8192;
#pragma unroll
          for (int nt = 0; nt < 8; ++nt) { bf16x8 bb[2];
#pragma unroll
              for (int ks = 0; ks < 2; ++ks) bb[ks] = *(const LAS bf16x8*)(BT + (nt * 16 + fr) * XT_LD + ks * 32 + fq * 8);
#pragma unroll
              for (int pt = 0; pt < 4; ++pt) { f32x4 acc = {0.f, 0.f, 0.f, 0.f};
#pragma unroll
                  for (int ks = 0; ks < 2; ++ks) acc = mfma16(bb[ks], xa[pt][ks], acc);
                  u32x2 w; w.x = cvt_pk_bf16(acc[0], acc[1]); w.y = cvt_pk_bf16(acc[2], acc[3]);
                  *(u32x2*)(st + (size_t)(pt * 16 + fr) * 128 + nt * 16 + 4 * fq) = w; } } }
    }
}

__device__ __forceinline__ void phase_ssd_scan(const Frame& F0) {
    const Frame F = phase_frame(F0);
    const float* acs = OKP(float, WS_ACS);
    for (int idx = blockIdx.x * NT + F.tid; idx < NB * 65536; idx += F.G * NT) {
        const int b = idx >> 16, r2 = idx & 65535, hd = r2 >> 12; unsigned* p = (unsigned*)(OKP(bf16_t, WS_STATES) + (size_t)b * NCH * 131072) + r2;
        float s0 = 0.f, s1 = 0.f;
#pragma unroll 8
        for (int c = 0; c < NCH; ++c) { const unsigned st = p[(size_t)c * 65536]; const float dec = expf(acs[((size_t)b * L + c * 64 + 63) * 16 + hd]);
            p[(size_t)c * 65536] = cvt_pk_bf16(s0, s1); s0 = s0 * dec + bflo(st); s1 = s1 * dec + bfhi(st); }
    }
}

__device__ __forceinline__ void phase_ssd_b(const Frame& F0) {
    const Frame F = phase_frame(F0);
    using namespace sm;
    LAS bf16_t* XT = (LAS bf16_t*)F.lds; LAS bf16_t* Bs = (LAS bf16_t*)(F.lds + 73728); LAS bf16_t* Cs = (LAS bf16_t*)(F.lds + 91136);
    LAS float* acs_s = (LAS float*)(F.lds + 108544); LAS float* dt_s = (LAS float*)(F.lds + 110592); LAS float* red = (LAS float*)(F.lds + 112640);
    const int tid = F.tid, lane = F.lane, wave = F.wave, fr = lane & 15, fq = lane >> 4;
    const bf16_t* proj = OKP(bf16_t, WS_PROJ); bf16_t* cat = OKP(bf16_t, WS_CAT0);
    for (int u = F.vcu; u < NB * NCH * 2; u += F.G) {
        const int g = u & 1, bc = u >> 1, b = bc / NCH, c = bc % NCH; const size_t row0 = (size_t)b * L + c * 64;
        __syncthreads();
        for (int ci = tid; ci < 768; ci += NT) {
            if (ci < 512) { LAS unsigned* dst = (LAS unsigned*)(XT + ci * XT_LD); ssd_conv_channel(F, b, c, g * 512 + ci, [&](int t, float v0, float v1) { dst[t >> 1] = cvt_pk_bf16(v0, v1); }); }
            else { const int n = (ci - 512) & 127; LAS bf16_t* dst = (ci < 640 ? Bs : Cs) + n; const int xc = (ci < 640 ? 1024 : 1280) + g * 128 + n;
                ssd_conv_channel(F, b, c, xc, [&](int t, float v0, float v1) { const unsigned w = cvt_pk_bf16(v0, v1); dst[t * BC_LD] = (bf16_t)(w & 0xffffu); dst[(t + 1) * BC_LD] = (bf16_t)(w >> 16); }); }
        }
        { const int t = tid & 63, hh = tid >> 6; acs_s[hh * 64 + t] = OKP(float, WS_ACS)[(row0 + t) * 16 + g * 8 + hh]; dt_s[hh * 64 + t] = OKP(float, WS_DTV)[(row0 + t) * 16 + g * 8 + hh]; }
        { const int ch = g * 256 + (tid & 255), t0 = (tid >> 8) * 32; const float* w = F.in[I_EV_SCCONV]; const float w0 = w[ch], w1 = w[512 + ch], w2 = w[1024 + ch];
          const bf16_t* p = proj + (row0 + t0) * PROJ0_LD + ch; float p0 = 0.f, p1 = 0.f;
          if (c > 0 || t0 > 0) { p0 = bf2f(p[-2 * PROJ0_LD + 512]) * bf2f(p[-2 * PROJ0_LD + 1024]); p1 = bf2f(p[-PROJ0_LD + 512]) * bf2f(p[-PROJ0_LD + 1024]); }
#pragma unroll 8
          for (int t = 0; t < 32; ++t) { const bf16_t* q = p + (size_t)t * PROJ0_LD; const float p2 = bf2f(q[512]) * bf2f(q[1024]); const float y = bf2f(q[0]) * (w0 * p0 + w1 * p1 + w2 * p2);
              cat[(row0 + t0 + t) * 1536 + ch] = (bf16_t)(cvt_pk_bf16(y, 0.f) & 0xffffu); p0 = p1; p1 = p2; } }
        __syncthreads();
        const int hh = wave, hd = g * 8 + hh;
        f32x4 Y[4][4];
        { const bf16_t* P = OKP(bf16_t, WS_STATES) + ((size_t)bc * 16 + hd) * 8192;
#pragma unroll
          for (int pt = 0; pt < 4; ++pt)
#pragma unroll
              for (int tt = 0; tt < 4; ++tt) Y[pt][tt] = (f32x4){0.f, 0.f, 0.f, 0.f};
#pragma unroll
          for (int ks = 0; ks < 4; ++ks) { bf16x8 pa[4], cb[4];
#pragma unroll
              for (int pt = 0; pt < 4; ++pt) pa[pt] = *(const bf16x8*)(P + (size_t)(pt * 16 + fr) * 128 + ks * 32 + fq * 8);
#pragma unroll
              for (int tt = 0; tt < 4; ++tt) cb[tt] = *(const LAS bf16x8*)(Cs + (tt * 16 + fr) * BC_LD + ks * 32 + fq * 8);
#pragma unroll
              for (int pt = 0; pt < 4; ++pt)
#pragma unroll
                  for (int tt = 0; tt < 4; ++tt) Y[pt][tt] = mfma16(pa[pt], cb[tt], Y[pt][tt]);
              SCHED_FENCE(); }
#pragma unroll
          for (int tt = 0; tt < 4; ++tt) { const float e = expf(acs_s[hh * 64 + tt * 16 + fr]);
#pragma unroll
              for (int pt = 0; pt < 4; ++pt) Y[pt][tt] *= e; } }
        SCHED_FENCE();
#pragma unroll
        for (int tt = 0; tt < 4; ++tt) { f32x4 cbt[4];
#pragma unroll
            for (int st = 0; st < 4; ++st) cbt[st] = (f32x4){0.f, 0.f, 0.f, 0.f};
#pragma unroll
            for (int ks = 0; ks < 4; ++ks) { const bf16x8 cf = *(const LAS bf16x8*)(Cs + (tt * 16 + fr) * BC_LD + ks * 32 + fq * 8);
#pragma unroll
                for (int st = 0; st < 4; ++st) if (st <= tt) { const bf16x8 bf = *(const LAS bf16x8*)(Bs + (st * 16 + fr) * BC_LD + ks * 32 + fq * 8); cbt[st] = mfma16(bf, cf, cbt[st]); } }
            const int t = tt * 16 + fr; const float at = acs_s[hh * 64 + t];
#pragma unroll
            for (int st = 0; st < 4; ++st) { const f32x4 as4 = *(const LAS f32x4*)(acs_s + hh * 64 + st * 16 + 4 * fq), dt4 = *(const LAS f32x4*)(dt_s + hh * 64 + st * 16 + 4 * fq);
#pragma unroll
                for (int r = 0; r < 4; ++r) { const int s = st * 16 + 4 * fq + r; cbt[st][r] = (st <= tt && s <= t) ? cbt[st][r] * expf(at - as4[r]) * dt4[r] : 0.f; } }
            bf16x8 mb[2];
#pragma unroll
            for (int ks = 0; ks < 2; ++ks) { u32x4 o; o.x = cvt_pk_bf16(cbt[2 * ks][0], cbt[2 * ks][1]); o.y = cvt_pk_bf16(cbt[2 * ks][2], cbt[2 * ks][3]); o.z = cvt_pk_bf16(cbt[2 * ks + 1][0], cbt[2 * ks + 1][1]); o.w = cvt_pk_bf16(cbt[2 * ks + 1][2], cbt[2 * ks + 1][3]);
                mb[ks] = __builtin_bit_cast(bf16x8, o); }
#pragma unroll
            for (int pt = 0; pt < 4; ++pt)
#pragma unroll
                for (int ks = 0; ks < 2; ++ks) { const LAS bf16_t* xp = XT + (hh * 64 + pt * 16 + fr) * XT_LD + ks * 32 + 4 * fq; const u32x2 lo = *(const LAS u32x2*)xp, hi = *(const LAS u32x2*)(xp + 16);
                    u32x4 a; a.x = lo.x; a.y = lo.y; a.z = hi.x; a.w = hi.y; Y[pt][tt] = mfma16(__builtin_bit_cast(bf16x8, a), mb[ks], Y[pt][tt]); }
            SCHED_FENCE(); }
        const float Dh = F.in[I_EV_D][hd];
#pragma unroll
        for (int tt = 0; tt < 4; ++tt) { const int t = tt * 16 + fr; float ss = 0.f;
#pragma unroll
            for (int pt = 0; pt < 4; ++pt) { const int p = pt * 16 + 4 * fq; const u32x2 zz = *(const u32x2*)(proj + (row0 + t) * PROJ0_LD + 1536 + hd * 64 + p);
                const float z0 = bflo(zz.x), z1 = bfhi(zz.x), z2 = bflo(zz.y), z3 = bfhi(zz.y); const LAS bf16_t* xp = XT + (hh * 64 + p) * XT_LD + t;
                f32x4 y = Y[pt][tt]; y[0] = (y[0] + Dh * bf2f(xp[0])) * siluf(z0); y[1] = (y[1] + Dh * bf2f(xp[XT_LD])) * siluf(z1); y[2] = (y[2] + Dh * bf2f(xp[2 * XT_LD])) * siluf(z2); y[3] = (y[3] + Dh * bf2f(xp[3 * XT_LD])) * siluf(z3);
                Y[pt][tt] = y; ss += (y[0] * y[0] + y[1] * y[1]) + (y[2] * y[2] + y[3] * y[3]); }
            ss += __shfl_xor(ss, 16); ss += __shfl_xor(ss, 32);
            if (fq == 0) red[hh * 64 + t] = ss; SCHED_FENCE(); }
        __syncthreads();
#pragma unroll
        for (int tt = 0; tt < 4; ++tt) { const int t = tt * 16 + fr; float ss = 0.f;
#pragma unroll
            for (int w = 0; w < 8; ++w) ss += red[w * 64 + t];
            const float rs = 1.f / sqrtf(ss * (1.f / 512.f) + EPS);
#pragma unroll
            for (int pt = 0; pt < 4; ++pt) { const int ch = hd * 64 + pt * 16 + 4 * fq; const f32x4 nw = *(const f32x4*)(F.in[I_EV_NORM] + ch); const f32x4 y = Y[pt][tt];
                u32x2 w; w.x = cvt_pk_bf16(y[0] * rs * nw.x, y[1] * rs * nw.y); w.y = cvt_pk_bf16(y[2] * rs * nw.z, y[3] * rs * nw.w);
                *(u32x2*)(cat + (row0 + t) * 1536 + 512 + ch) = w; } }
    }
}
}

namespace ok {
constexpr int XA_LD = 264;

__device__ __forceinline__ void phase_xattn(const Frame& F0, const bf16_t* q, const bf16_t* kx, const bf16_t* vt, bf16_t* att) {
    const Frame F = phase_frame(F0);
    LAS bf16_t* KV = (LAS bf16_t*)F.lds;
    const int tid = F.tid, lane = F.lane, wave = F.wave, fr = lane & 15, fq = lane >> 4;
    for (int u = F.vcu; u < (T / 128) * 4; u += F.G) {
        const int hd = u & 3, rt = u >> 2, row0 = rt * 128, b = row0 / L;
        __syncthreads();
#pragma unroll 4
        for (int i = tid; i < 256 * 32; i += NT) { const int r = i >> 5, c8 = i & 31; *(LAS u32x4*)(KV + r * XA_LD + c8 * 8) = *(const u32x4*)(kx + (size_t)(b * 256 + r) * 1024 + hd * 256 + c8 * 8); }
        __syncthreads();
        bf16x8 pf[8]; float fA, fB;
        {
            const bf16_t* qp = q + (size_t)(row0 + wave * 16 + fr) * 1024 + hd * 256 + fq * 8;
            bf16x8 qf[8];
#pragma unroll
            for (int ks = 0; ks < 8; ++ks) qf[ks] = *(const bf16x8*)(qp + ks * 32);
            float mh[2], lh[2];
#pragma unroll
            for (int half = 0; half < 2; ++half) {
                f32x4 s[8];
#pragma unroll
                for (int kt = 0; kt < 8; ++kt) { s[kt] = (f32x4){0.f, 0.f, 0.f, 0.f};
#pragma unroll
                    for (int ks = 0; ks < 8; ++ks) { const bf16x8 kf = *(const LAS bf16x8*)(KV + ((half * 8 + kt) * 16 + fr) * XA_LD + ks * 32 + fq * 8); s[kt] = mfma16(kf, qf[ks], s[kt]); }
                    SCHED_FENCE(); }
                float m = -3.0e38f;
#pragma unroll
                for (int kt = 0; kt < 8; ++kt) m = fmaxf(m, fmaxf(fmaxf(s[kt][0], s[kt][1]), fmaxf(s[kt][2], s[kt][3])));
                m = fmaxf(m, __shfl_xor(m, 16)); m = fmaxf(m, __shfl_xor(m, 32));
                float l = 0.f;
#pragma unroll
                for (int kt = 0; kt < 8; ++kt) {
#pragma unroll
                    for (int r = 0; r < 4; ++r) { const float p = exp2f(s[kt][r] - m); s[kt][r] = p; l += p; } }
                l += __shfl_xor(l, 16); l += __shfl_xor(l, 32); mh[half] = m; lh[half] = l;
#pragma unroll
                for (int j = 0; j < 4; ++j) { u32x4 o; o.x = cvt_pk_bf16(s[2 * j][0], s[2 * j][1]); o.y = cvt_pk_bf16(s[2 * j][2], s[2 * j][3]); o.z = cvt_pk_bf16(s[2 * j + 1][0], s[2 * j + 1][1]); o.w = cvt_pk_bf16(s[2 * j + 1][2], s[2 * j + 1][3]);
                    pf[half * 4 + j] = __builtin_bit_cast(bf16x8, o); }
                SCHED_FENCE();
            }
            const float m = fmaxf(mh[0], mh[1]), cA = exp2f(mh[0] - m), cB = exp2f(mh[1] - m), li = 1.f / (cA * lh[0] + cB * lh[1]); fA = cA * li; fB = cB * li;
        }
        __syncthreads();
#pragma unroll 4
        for (int i = tid; i < 256 * 32; i += NT) { const int r = i >> 5, c8 = i & 31; *(LAS u32x4*)(KV + r * XA_LD + c8 * 8) = *(const u32x4*)(vt + (size_t)(hd * 256 + r) * (NB * 256) + b * 256 + c8 * 8); }
        __syncthreads();
#pragma unroll 2
        for (int dt = 0; dt < 16; ++dt) { f32x4 oA = {0.f, 0.f, 0.f, 0.f}, oB = oA;
#pragma unroll
            for (int j = 0; j < 8; ++j) { const LAS bf16_t* vp = KV + (dt * 16 + fr) * XA_LD + j * 32 + 4 * fq; const u32x2 lo = *(const LAS u32x2*)vp, hi = *(const LAS u32x2*)(vp + 16);
                u32x4 a; a.x = lo.x; a.y = lo.y; a.z = hi.x; a.w = hi.y; const bf16x8 vf = __builtin_bit_cast(bf16x8, a);
                if (j < 4) oA = mfma16(vf, pf[j], oA); else oB = mfma16(vf, pf[j], oB); }
            const f32x4 o = oA * fA + oB * fB;
            bf16_t* op = att + (size_t)(row0 + wave * 16 + fr) * 1024 + hd * 256 + dt * 16 + 4 * fq;
            u32x2 w; w.x = cvt_pk_bf16(o[0], o[1]); w.y = cvt_pk_bf16(o[2], o[3]); *(u32x2*)op = w; }
    }
}

#ifndef CPU_EMU
struct KvOrder {
    const char* memnb; const char* wxa; char* kx; char* vt; int G, c;
    __device__ bool next(int i, pg8::Unit& u) const {
        const int Lx = i * G + c; if (Lx >= 32) return false;
        const int l = Lx >> 4, r = Lx & 15; const size_t tstep = (size_t)256 * 1024 * 2;
        if (r < 8) { u.pm = r >> 2; u.pn = r & 3; u.tag = l * 2; u.a = memnb + (size_t)u.pm * tstep; u.b = wxa + (size_t)l * 8 * MiB + 2 * MiB + (size_t)u.pn * tstep; }
        else { const int r2 = r - 8; u.pm = r2 >> 1; u.pn = r2 & 1; u.tag = l * 2 + 1; u.a = wxa + (size_t)l * 8 * MiB + 4 * MiB + (size_t)u.pm * tstep; u.b = memnb + (size_t)u.pn * tstep; }
        return true;
    }
    __device__ __forceinline__ void a_ready(const pg8::Unit&) const {}
    __device__ __forceinline__ void done(const pg8::Unit&) const {}
};
struct EpiKv {
    static constexpr bool PERM = true, AFTER_DRAIN = false;
    bf16_t* kx; bf16_t* vt;
    __device__ __forceinline__ void operator()(const f32x4 (&acc)[2][2][4][2], const pg8::Unit& u, int wr, int wc, int fr, int fq) const {
        const int l = u.tag >> 1, isv = u.tag & 1, ldc = isv ? 512 : 1024; bf16_t* O = isv ? vt + (size_t)l * 1024 * 512 : kx + (size_t)l * 512 * 1024;
        const int row0 = u.pm * 256 + wr * 64 + fr, col0 = u.pn * 256 + wc * 32 + 8 * fq;
#pragma unroll
        for (int ai = 0; ai < 2; ++ai)
#pragma unroll
            for (int m = 0; m < 4; ++m) { bf16_t* rowp = O + (size_t)(row0 + ai * 128 + m * 16) * ldc + col0;
#pragma unroll
                for (int bj = 0; bj < 2; ++bj) { const f32x4 v0 = acc[ai][bj][m][0], v1 = acc[ai][bj][m][1]; u32x4 w; w.x = cvt_pk_bf16(v0[0], v0[1]); w.y = cvt_pk_bf16(v0[2], v0[3]); w.z = cvt_pk_bf16(v1[0], v1[1]); w.w = cvt_pk_bf16(v1[2], v1[3]);
                    *(u32x4*)(rowp + bj * 128) = w; } }
    }
};
__device__ __forceinline__ void phase_kv(const Frame& F) {
    pg8::Gemm g{nullptr, nullptr, 0, 0, 1024};
    KvOrder S{(const char*)OKP(bf16_t, WS_MEMNB), (const char*)OKP(bf16_t, WS_W_XA), (char*)OKP(bf16_t, WS_KX), (char*)OKP(bf16_t, WS_VT), F.G, (int)blockIdx.x};
    EpiKv E{OKP(bf16_t, WS_KX), OKP(bf16_t, WS_VT)};
    pg8::gemm_phase<EpiKv, KvOrder, true, true>(F.lds, g, S, E);
}
#endif
}

namespace ok {
constexpr size_t WS_WRH = WS_WR, WS_WRL = WS_WR + 256 * KiB;
constexpr size_t WS_POS = WS_TILEEXP + 4 * KiB;
__device__ __forceinline__ void prologue_router_tables(const Frame& F0) {
    const Frame F = phase_frame(F0);
    using namespace sm;
    const size_t gt = (size_t)F.vcu * NT + F.tid, GT = (size_t)F.G * NT;
    for (size_t i = gt; i < (size_t)2 * 48 * 1024; i += GT) { const int l = (int)(i / (48 * 1024)), j = (int)((i / 1024) % 48), k = (int)(i % 1024); float v = 0.f;
        if (j < 4) v = F.in[I_MOE_WG][((size_t)l * 1024 + k) * 4 + j]; else if (j < 36) v = F.in[I_MOE_WE][((size_t)l * 1024 + k) * 32 + (j - 4)];
        v *= F.in[I_NORM_FFN][l * 1024 + k];
        const unsigned hi = cvt_pk_bf16(v, 0.f) & 0xffffu; const float rem = v - __uint_as_float(hi << 16);
        OKP(bf16_t, WS_WRH)[i] = (bf16_t)hi; OKP(bf16_t, WS_WRL)[i] = (bf16_t)(cvt_pk_bf16(rem, 0.f) & 0xffffu); }
}

__device__ __forceinline__ void phase_router(const Frame& F0, int l, const float* h, const float* ssq, int np) {
    const Frame F = phase_frame(F0);
    using namespace sm;
    const int lane = F.lane, wave = F.wave, fr = lane & 15, fq = lane >> 4;
    LAS float* lg = (LAS float*)(F.lds + wave * 16384 + 8704);
    const bf16_t* wh = OKP(bf16_t, WS_WRH) + (size_t)l * 48 * 1024; const bf16_t* wl = OKP(bf16_t, WS_WRL) + (size_t)l * 48 * 1024;
    const float* bg = F.in[I_MOE_BG] + l * 4; const float* be = F.in[I_MOE_BE] + l * 32;
    unsigned* cnt = F.ctl + CW_MOE + l * 64;
    const int gw = F.vcu * NWAVES + wave, NGW = F.G * NWAVES;
    for (int tile = gw; tile < T / 16; tile += NGW) {
        const int t0 = tile * 16;
        f32x4 acc[3] = {{0.f, 0.f, 0.f, 0.f}, {0.f, 0.f, 0.f, 0.f}, {0.f, 0.f, 0.f, 0.f}};
        const float* hp = h + (size_t)(t0 + fr) * DM + fq * 8;
#pragma unroll 4
        for (int ks = 0; ks < 32; ++ks) { const f32x4 x0 = *(const f32x4*)(hp + ks * 32), x1 = *(const f32x4*)(hp + ks * 32 + 4);
            u32x4 hi, lo;
            hi.x = cvt_pk_bf16(x0[0], x0[1]); hi.y = cvt_pk_bf16(x0[2], x0[3]); hi.z = cvt_pk_bf16(x1[0], x1[1]); hi.w = cvt_pk_bf16(x1[2], x1[3]);
            lo.x = cvt_pk_bf16(x0[0] - bflo(hi.x), x0[1] - bfhi(hi.x)); lo.y = cvt_pk_bf16(x0[2] - bflo(hi.y), x0[3] - bfhi(hi.y));
            lo.z = cvt_pk_bf16(x1[0] - bflo(hi.z), x1[1] - bfhi(hi.z)); lo.w = cvt_pk_bf16(x1[2] - bflo(hi.w), x1[3] - bfhi(hi.w));
            const bf16x8 ah = __builtin_bit_cast(bf16x8, hi), al = __builtin_bit_cast(bf16x8, lo);
#pragma unroll
            for (int nt = 0; nt < 3; ++nt) { const size_t wo = (size_t)(nt * 16 + fr) * 1024 + ks * 32 + fq * 8; const bf16x8 bh = *(const bf16x8*)(wh + wo), bl = *(const bf16x8*)(wl + wo);
                acc[nt] = mfma16(bh, ah, acc[nt]); acc[nt] = mfma16(bl, ah, acc[nt]); acc[nt] = mfma16(bh, al, acc[nt]); } }
#pragma unroll
        for (int nt = 0; nt < 3; ++nt) *(LAS f32x4*)(lg + fr * 48 + nt * 16 + 4 * fq) = acc[nt];
        WAVE_SYNC();
        if (lane < 16) { const int t = t0 + lane; const LAS float* p = lg + lane * 48; const float rs = rstd_np(ssq, np, t);
            const float g0 = p[0] * rs + bg[0], g1 = p[1] * rs + bg[1], g2 = p[2] * rs + bg[2], g3 = p[3] * rs + bg[3];
            int gsel = 0; float gm = g0; if (g1 > gm) { gm = g1; gsel = 1; } if (g2 > gm) { gm = g2; gsel = 2; } if (g3 > gm) { gm = g3; gsel = 3; }
            const float gwt = 1.f / (expf(g0 - gm) + expf(g1 - gm) + expf(g2 - gm) + expf(g3 - gm));
            const LAS float* pe = p + 4 + gsel * 8; const float* bb = be + gsel * 8;
            float e[8];
#pragma unroll
            for (int j = 0; j < 8; ++j) e[j] = pe[j] * rs + bb[j];
            int i1 = 0; float m1 = e[0];
#pragma unroll
            for (int j = 1; j < 8; ++j) if (e[j] > m1) { m1 = e[j]; i1 = j; }
            int i2 = -1; float m2 = -3.0e38f;
#pragma unroll
            for (int j = 0; j < 8; ++j) if (j != i1 && e[j] > m2) { m2 = e[j]; i2 = j; }
            const float r = expf(m2 - m1); const float w1 = gwt / (1.f + r), w2 = gwt * r / (1.f + r);
            const int e1 = gsel * 8 + i1, e2 = gsel * 8 + i2;
            OKP(int, WS_EID)[t * 2] = e1; OKP(int, WS_EID)[t * 2 + 1] = e2; OKP(float, WS_GATEW)[t * 2] = w1; OKP(float, WS_GATEW)[t * 2 + 1] = w2;
            OKP(int, WS_POS)[t * 2] = (int)atomicAdd(cnt + e1, 1u); OKP(int, WS_POS)[t * 2 + 1] = (int)atomicAdd(cnt + e2, 1u); }
        WAVE_SYNC();
    }
}

__device__ __forceinline__ void phase_scatter(const Frame& F0, int l, const bf16_t* hb, const float* ssq, int np) {
    const Frame F = phase_frame(F0);
    const unsigned* cnt = F.ctl + CW_MOE + l * 64; const int lane = F.lane;
    const int gw = F.vcu * NWAVES + F.wave, NGW = F.G * NWAVES;
    int base = 0;
    { int tiles = lane < 32 ? (((int)cnt[lane & 31] + 255) >> 8) : 0; int incl = tiles;
#pragma unroll
      for (int o = 1; o < 32; o <<= 1) { const int n = __shfl_up(incl, o); if ((lane & 31) >= o) incl += n; }
      base = (incl - tiles) * 256;
      if (blockIdx.x == 0 && F.wave == 0) { const int ntiles = __shfl(incl, 31); if (lane < 32) for (int i = 0; i < tiles; ++i) OKP(int, WS_TILEEXP)[(base >> 8) + i] = lane; if (lane == 0) OKP(int, WS_TILEEXP)[1023] = ntiles; } }
    for (int a = gw; a < T * 2; a += NGW) { const int t = a >> 1; const int e = OKP(int, WS_EID)[a]; const int slot = __shfl(base, e) + OKP(int, WS_POS)[a];
        const u32x4* src = (const u32x4*)(hb + (size_t)t * DM) + lane; u32x4* dst = (u32x4*)(OKP(bf16_t, WS_XS) + (size_t)slot * DM) + lane;
        dst[0] = src[0]; dst[64] = src[64];
        if (lane == 0) { OKP(int, WS_TOKSLOT)[a] = slot; OKP(float, WS_SLOTGATE)[slot] = OKP(float, WS_GATEW)[a]; OKP(float, WS_SLOTRSTD)[slot] = rstd_np(ssq, np, t); } }
}

__device__ __forceinline__ void phase_combine(const Frame& F0, float* h, bf16_t* hb, float* ssq, bool final_layer) {
    const Frame F = phase_frame(F0);
    using namespace sm;
    const int lane = F.lane; const int gw = F.vcu * NWAVES + F.wave, NGW = F.G * NWAVES; const bf16_t* y = OKP(bf16_t, WS_Y);
    for (int t = gw; t < T; t += NGW) { const int sa = OKP(int, WS_TOKSLOT)[t * 2], sb = OKP(int, WS_TOKSLOT)[t * 2 + 1];
        f32x4* hr = (f32x4*)(h + (size_t)t * DM) + lane; const u32x2* ya = (const u32x2*)(y + (size_t)sa * DM) + lane; const u32x2* yb = (const u32x2*)(y + (size_t)sb * DM) + lane;
        f32x4 v[4]; float s = 0.f;
#pragma unroll
        for (int j = 0; j < 4; ++j) { const u32x2 a = ya[64 * j], b = yb[64 * j]; f32x4 x = hr[64 * j];
            x[0] += bflo(a.x) + bflo(b.x); x[1] += bfhi(a.x) + bfhi(b.x); x[2] += bflo(a.y) + bflo(b.y); x[3] += bfhi(a.y) + bfhi(b.y); v[j] = x; s += (x[0] * x[0] + x[1] * x[1]) + (x[2] * x[2] + x[3] * x[3]); }
        s = wave_sum(s);
        if (!final_layer) { u32x2* o8 = (u32x2*)(hb + (size_t)t * DM) + lane;
#pragma unroll
            for (int j = 0; j < 4; ++j) { hr[64 * j] = v[j]; u32x2 w; w.x = cvt_pk_bf16(v[j][0], v[j][1]); w.y = cvt_pk_bf16(v[j][2], v[j][3]); o8[64 * j] = w; }
            if (lane == 0) ssq[t] = s; }
        else { const float rs = 1.f / sqrtf(s * (1.f / DM) + EPS); f32x4* orow = (f32x4*)(F.out + (size_t)t * DM) + lane; const f32x4* gr = (const f32x4*)F.in[I_FINAL_NORM] + lane;
#pragma unroll
            for (int j = 0; j < 4; ++j) { const f32x4 g = gr[64 * j]; f32x4 o; o[0] = v[j][0] * rs * g[0]; o[1] = v[j][1] * rs * g[1]; o[2] = v[j][2] * rs * g[2]; o[3] = v[j][3] * rs * g[3]; orow[64 * j] = o; } } }
}

#ifndef CPU_EMU
struct MoeOrder {
    const char* A; const char* W; const int* tile_exp; size_t a_tstep, w_estride, w_off, w_tstep; int G, c;
    __device__ bool next(int i, pg8::Unit& u) const {
        const int Lx = i * G + c; const int ntiles = tile_exp[1023]; if (Lx >= ntiles * 4) return false;
        const int tile = Lx >> 2; u.pm = tile; u.pn = Lx & 3; u.tag = 0; const int e = tile_exp[tile];
        u.a = A + (size_t)tile * a_tstep; u.b = W + (size_t)e * w_estride + w_off + (size_t)u.pn * w_tstep; return true;
    }
    __device__ __forceinline__ void a_ready(const pg8::Unit&) const {}
    __device__ __forceinline__ void done(const pg8::Unit&) const {}
};
struct EpiSwiGLU {
    static constexpr bool PERM = false, AFTER_DRAIN = false;
    bf16_t* act; const float* slot_rstd;
    __device__ __forceinline__ void operator()(const f32x4 (&acc)[2][2][4][2], const pg8::Unit& u, int wr, int wc, int fr, int fq) const {
        const int row0 = u.pm * 256 + wr * 64 + fr, col0 = u.pn * 128 + wc * 16 + 4 * fq;
#pragma unroll
        for (int ai = 0; ai < 2; ++ai)
#pragma unroll
            for (int m = 0; m < 4; ++m) { const int row = row0 + ai * 128 + m * 16; const float rs = slot_rstd[row]; bf16_t* rowp = act + (size_t)row * 512 + col0;
#pragma unroll
                for (int bj = 0; bj < 2; ++bj) { const f32x4 g = acc[ai][bj][m][0] * rs, up = acc[ai][bj][m][1] * rs; f32x4 o;
#pragma unroll
                    for (int r = 0; r < 4; ++r) o[r] = g[r] / (1.f + __expf(-g[r])) * up[r];
                    u32x2 w; w.x = cvt_pk_bf16(o[0], o[1]); w.y = cvt_pk_bf16(o[2], o[3]); *(u32x2*)(rowp + bj * 64) = w; } }
    }
};
struct EpiDown {
    static constexpr bool PERM = true, AFTER_DRAIN = false;
    bf16_t* y; const float* slot_gate;
    __device__ __forceinline__ void operator()(const f32x4 (&acc)[2][2][4][2], const pg8::Unit& u, int wr, int wc, int fr, int fq) const {
        const int row0 = u.pm * 256 + wr * 64 + fr, col0 = u.pn * 256 + wc * 32 + 8 * fq;
#pragma unroll
        for (int ai = 0; ai < 2; ++ai)
#pragma unroll
            for (int m = 0; m < 4; ++m) { const int row = row0 + ai * 128 + m * 16; const float s = slot_gate[row]; bf16_t* rowp = y + (size_t)row * DM + col0;
#pragma unroll
                for (int bj = 0; bj < 2; ++bj) { const f32x4 v0 = acc[ai][bj][m][0] * s, v1 = acc[ai][bj][m][1] * s; u32x4 w; w.x = cvt_pk_bf16(v0[0], v0[1]); w.y = cvt_pk_bf16(v0[2], v0[3]); w.z = cvt_pk_bf16(v1[0], v1[1]); w.w = cvt_pk_bf16(v1[2], v1[3]);
                    *(u32x4*)(rowp + bj * 128) = w; } }
    }
};
__device__ __forceinline__ void phase_moe_up(const Frame& F) {
    pg8::Gemm g{nullptr, nullptr, 0, 0, 1024};
    MoeOrder S{(const char*)OKP(bf16_t, WS_XS), (const char*)OKP(bf16_t, WS_MOEW), OKP(int, WS_TILEEXP), (size_t)256 * 1024 * 2, 3 * MiB, 0, (size_t)256 * 1024 * 2, F.G, (int)blockIdx.x};
    EpiSwiGLU E{OKP(bf16_t, WS_ACT), OKP(float, WS_SLOTRSTD)};
    pg8::gemm_phase<EpiSwiGLU, MoeOrder, true, true>(F.lds, g, S, E);
}
__device__ __forceinline__ void phase_moe_down(const Frame& F) {
    pg8::Gemm g{nullptr, nullptr, 0, 0, 512};
    MoeOrder S{(const char*)OKP(bf16_t, WS_ACT), (const char*)OKP(bf16_t, WS_MOEW), OKP(int, WS_TILEEXP), (size_t)256 * 512 * 2, 3 * MiB, 2 * MiB, (size_t)256 * 512 * 2, F.G, (int)blockIdx.x};
    EpiDown E{OKP(bf16_t, WS_Y), OKP(float, WS_SLOTGATE)};
    pg8::gemm_phase<EpiDown, MoeOrder, true, true>(F.lds, g, S, E);
}
#endif
}

namespace ok {
constexpr size_t WS_GU = 160 * MiB, WS_GW = 192 * MiB, WS_GQD = 224 * MiB, WS_GKDT = 480 * MiB, WS_GAQK = 512 * MiB;
constexpr size_t WS_GDEC = WS_GCS;
constexpr size_t WS_OBUF = WS_HB;
constexpr int G_LD = 132, GB_LD = 136, LM_LD = 68;
__device__ __forceinline__ float sigmoidf_(float x) { return 1.f / (1.f + __expf(-x)); }

__device__ __forceinline__ void phase_gdn_prep(const Frame& F0) {
    using namespace sm;
    const Frame F = phase_frame(F0);
    LAS float* q_s = (LAS float*)F.lds; LAS float* k_s = (LAS float*)(F.lds + 33792); LAS float* v_s = (LAS float*)(F.lds + 67584);
    LAS bf16_t* Kn = (LAS bf16_t*)(F.lds + 101376); LAS bf16_t* Qn = (LAS bf16_t*)(F.lds + 118784);
    LAS float* g_s = (LAS float*)(F.lds + 136192); LAS float* beta_s = g_s + 64; LAS float* gc_s = g_s + 128; LAS float* eg_s = g_s + 192; LAS float* rq_s = g_s + 256; LAS float* rk_s = g_s + 320;
    LAS float* Lm = q_s;
    const int tid = F.tid, lane = F.lane, wave = F.wave, fr = lane & 15, fq = lane >> 4;
    const bf16_t* proj = OKP(bf16_t, WS_PROJ); const float* cw = F.in[I_OD_CONV];
    for (int u = F.vcu; u < NB * NCH * 8; u += F.G) {
        const int hd = u & 7, bc = u >> 3, b = bc / NCH, c = bc % NCH; const size_t row0 = (size_t)b * L + c * 64; const size_t ub = (size_t)bc * 8 + hd;
        __syncthreads();
        if (tid < 384) { const int which = tid >> 7, d = tid & 127, xc = which * 1024 + hd * 128 + d; LAS float* dst = (which == 0 ? q_s : which == 1 ? k_s : v_s) + d;
            const float w0 = cw[xc], w1 = cw[3072 + xc], w2 = cw[6144 + xc], w3 = cw[9216 + xc]; const bf16_t* p = proj + row0 * PROJ1_LD + xc;
            float x0 = 0.f, x1 = 0.f, x2 = 0.f; if (c > 0) { x0 = bf2f(p[-3 * PROJ1_LD]); x1 = bf2f(p[-2 * PROJ1_LD]); x2 = bf2f(p[-PROJ1_LD]); }
#pragma unroll 8
            for (int t = 0; t < 64; ++t) { const float x3 = bf2f(p[(size_t)t * PROJ1_LD]); const float v = w0 * x0 + w1 * x1 + w2 * x2 + w3 * x3; dst[t * G_LD] = siluf(v); x0 = x1; x1 = x2; x2 = x3; } }
        { const int t = tid >> 3, part = tid & 7; const f32x4* xr = (const f32x4*)(OKP(float, WS_H) + (row0 + t) * DM + part * 128);
          const f32x4* wa = (const f32x4*)(OKP(float, WS_WAB) + hd * 1024 + part * 128); const f32x4* wb = (const f32x4*)(OKP(float, WS_WAB) + (8 + hd) * 1024 + part * 128); float sa = 0.f, sb = 0.f;
#pragma unroll 8
          for (int k = 0; k < 32; ++k) { const f32x4 xv = xr[k], av = wa[k], bv = wb[k]; sa += (xv.x * av.x + xv.y * av.y) + (xv.z * av.z + xv.w * av.w); sb += (xv.x * bv.x + xv.y * bv.y) + (xv.z * bv.z + xv.w * bv.w); }
          sa += __shfl_xor(sa, 1); sb += __shfl_xor(sb, 1); sa += __shfl_xor(sa, 2); sb += __shfl_xor(sb, 2); sa += __shfl_xor(sa, 4); sb += __shfl_xor(sb, 4);
          if (part == 0) { const float rs = 1.f / sqrtf(((const float*)F.ctl + CW_SSQ + 3 * T)[row0 + t] * (1.f / 1024.f) + EPS);
              g_s[t] = -expf(F.in[I_OD_ALOG][hd]) * softplusf(sa * rs + F.in[I_OD_DTB][hd]); beta_s[t] = sigmoidf_(sb * rs); } }
        __syncthreads();
        if (wave == 0) { float v = g_s[lane];
#pragma unroll
            for (int o = 1; o < 64; o <<= 1) { const float n = __shfl_up(v, o); if (lane >= o) v += n; }
            gc_s[lane] = v; eg_s[lane] = expf(v); if (lane == 63) OKP(float, WS_GDEC)[ub] = expf(v); }
        else if (wave <= 2) { const LAS float* src = (wave == 1 ? q_s : k_s) + lane * G_LD; float s = 0.f;
#pragma unroll 8
            for (int d = 0; d < 128; d += 4) { const f32x4 x = *(const LAS f32x4*)(src + d); s += (x.x * x.x + x.y * x.y) + (x.z * x.z + x.w * x.w); }
            const float r = 1.f / sqrtf(s + EPS); if (wave == 1) rq_s[lane] = r * 0.08838834764831845f; else rk_s[lane] = r; }
        __syncthreads();
        { const float gl = gc_s[63];
          for (int i = tid; i < 64 * 64; i += NT) { const int t = i >> 6, dp = (i & 63) * 2; const float rk = rk_s[t], rq = rq_s[t], eg = eg_s[t];
              const float k0 = k_s[t * G_LD + dp] * rk, k1 = k_s[t * G_LD + dp + 1] * rk, q0 = q_s[t * G_LD + dp] * rq, q1 = q_s[t * G_LD + dp + 1] * rq;
              *(LAS unsigned*)(Kn + t * GB_LD + dp) = cvt_pk_bf16(k0, k1); *(LAS unsigned*)(Qn + t * GB_LD + dp) = cvt_pk_bf16(q0, q1);
              *(unsigned*)(OKP(bf16_t, WS_GQD) + ub * 8192 + t * 128 + dp) = cvt_pk_bf16(q0 * eg, q1 * eg); }
          { const int t = tid & 63, dg = tid >> 6; const float f = rk_s[t] * expf(gl - gc_s[t]); bf16_t* dst = OKP(bf16_t, WS_GKDT) + ub * 8192 + t;
#pragma unroll
            for (int j = 0; j < 16; ++j) { const int d = dg * 16 + j; dst[d * 64] = (bf16_t)(cvt_pk_bf16(k_s[t * G_LD + d] * f, 0.f) & 0xffffu); } } }
        __syncthreads();
#pragma unroll
        for (int i = 0; i < 4; ++i) { const int tl = wave * 4 + i, which = tl >> 4, ti = (tl >> 2) & 3, si = tl & 3;
            f32x4 acc = {0.f, 0.f, 0.f, 0.f};
            if (si <= ti) {
#pragma unroll
                for (int ks = 0; ks < 4; ++ks) { const bf16x8 a = *(const LAS bf16x8*)(Kn + (si * 16 + fr) * GB_LD + ks * 32 + fq * 8); const bf16x8 bb = *(const LAS bf16x8*)((which ? Qn : Kn) + (ti * 16 + fr) * GB_LD + ks * 32 + fq * 8); acc = mfma16(a, bb, acc); }
                const int t = ti * 16 + fr; const float gt = gc_s[t], bt = beta_s[t];
#pragma unroll
                for (int r = 0; r < 4; ++r) { const int s = si * 16 + 4 * fq + r; const float dec = expf(gt - gc_s[s]); acc[r] = which ? (s <= t ? acc[r] * dec : 0.f) : (s < t ? acc[r] * dec * bt : 0.f); } }
            const int t = ti * 16 + fr, s0 = si * 16 + 4 * fq;
            if (which) { u32x2 w; w.x = cvt_pk_bf16(acc[0], acc[1]); w.y = cvt_pk_bf16(acc[2], acc[3]); *(u32x2*)(OKP(bf16_t, WS_GAQK) + ub * 4096 + t * 64 + s0) = w; }
            else { Lm[(s0 + 0) * LM_LD + t] = acc[0]; Lm[(s0 + 1) * LM_LD + t] = acc[1]; Lm[(s0 + 2) * LM_LD + t] = acc[2]; Lm[(s0 + 3) * LM_LD + t] = acc[3]; } }
        __syncthreads();
        if (tid < 256) { const int cidx = tid & 127; const bool isw = tid >= 128; LAS float* col = (isw ? k_s : v_s) + cidx; bf16_t* dst = OKP(bf16_t, isw ? WS_GW : WS_GU) + ub * 8192 + cidx;
            for (int ib = 0; ib < 4; ++ib) { float a[16];
#pragma unroll
                for (int tt = 0; tt < 16; ++tt) { const int t = ib * 16 + tt; float v = col[t * G_LD] * beta_s[t]; if (isw) v *= rk_s[t] * eg_s[t]; a[tt] = v; }
                for (int s = 0; s < ib * 16; ++s) { const float xs = col[s * G_LD]; const LAS f32x4* lp = (const LAS f32x4*)(Lm + s * LM_LD + ib * 16);
#pragma unroll
                    for (int q4 = 0; q4 < 4; ++q4) { const f32x4 l4 = lp[q4];
#pragma unroll
                        for (int r = 0; r < 4; ++r) a[q4 * 4 + r] -= l4[r] * xs; } }
#pragma unroll
                for (int ss = 0; ss < 16; ++ss) { const float xv = a[ss]; const int srow = ib * 16 + ss; col[srow * G_LD] = xv; dst[srow * 128] = (bf16_t)(cvt_pk_bf16(xv, 0.f) & 0xffffu);
                    const LAS f32x4* lp = (const LAS f32x4*)(Lm + srow * LM_LD + ib * 16);
#pragma unroll
                    for (int q4 = ss / 4; q4 < 4; ++q4) { const f32x4 l4 = lp[q4];
#pragma unroll
                        for (int r = 0; r < 4; ++r) if (q4 * 4 + r > ss) a[q4 * 4 + r] -= l4[r] * xv; } }
            } }
    }
}
}

namespace ok {
constexpr int ST_LD = 136, VT_LD = 72;
struct GdnFrags { bf16x8 Wf[4], Qf[4], Af[2], Kf[2][2]; unsigned short Uv[4]; float dec; };
__device__ __forceinline__ void gdn_load(GdnFrags& g, const Frame& F, size_t ub, int ti, int ji, int dt0, int sl, int fr, int fq) {
    const bf16_t* Wp = OKP(bf16_t, WS_GW) + ub * 8192 + (ti * 16 + fr) * 128 + fq * 8; const bf16_t* Qp = OKP(bf16_t, WS_GQD) + ub * 8192 + (ti * 16 + fr) * 128 + fq * 8;
#pragma unroll
    for (int ks = 0; ks < 4; ++ks) { g.Wf[ks] = *(const bf16x8*)(Wp + ks * 32); g.Qf[ks] = *(const bf16x8*)(Qp + ks * 32); }
    const bf16_t* Ap = OKP(bf16_t, WS_GAQK) + ub * 4096 + (ti * 16 + fr) * 64 + fq * 8;
#pragma unroll
    for (int k2 = 0; k2 < 2; ++k2) { g.Af[k2] = *(const bf16x8*)(Ap + k2 * 32);
#pragma unroll
        for (int i = 0; i < 2; ++i) g.Kf[i][k2] = *(const bf16x8*)(OKP(bf16_t, WS_GKDT) + ub * 8192 + ((dt0 + i) * 16 + fr) * 64 + k2 * 32 + fq * 8); }
    const bf16_t* Up = OKP(bf16_t, WS_GU) + ub * 8192 + (ti * 16 + 4 * fq) * 128 + sl * 32 + ji * 16 + fr;
#pragma unroll
    for (int r = 0; r < 4; ++r) g.Uv[r] = Up[r * 128];
    g.dec = OKP(float, WS_GDEC)[ub];
}
__device__ __forceinline__ void gdn_scan_unit(const Frame& F, int unit) {
    LAS bf16_t* ST = (LAS bf16_t*)F.lds; LAS bf16_t* VnT = (LAS bf16_t*)(F.lds + 32 * ST_LD * 2);
    const int tid = F.tid, lane = F.lane, wave = F.wave, fr = lane & 15, fq = lane >> 4;
    const int b = unit >> 5, hd = (unit >> 2) & 7, sl = unit & 3, ti = wave >> 1, ji = wave & 1, dt0 = (wave >> 1) * 2;
    for (int i = tid; i < 32 * ST_LD / 2; i += NT) ((LAS unsigned*)ST)[i] = 0u;
    f32x4 Sacc[2] = {{0.f, 0.f, 0.f, 0.f}, {0.f, 0.f, 0.f, 0.f}};
    GdnFrags cur, nxt; gdn_load(cur, F, ((size_t)b * NCH) * 8 + hd, ti, ji, dt0, sl, fr, fq);
    for (int c = 0; c < NCH; ++c) {
        const size_t ub = ((size_t)b * NCH + c) * 8 + hd;
        if (c + 1 < NCH) gdn_load(nxt, F, ub + 8, ti, ji, dt0, sl, fr, fq);
        __syncthreads();
        f32x4 a1 = {0.f, 0.f, 0.f, 0.f}, a2 = a1;
#pragma unroll
        for (int ks = 0; ks < 4; ++ks) { const bf16x8 sf = *(const LAS bf16x8*)(ST + (ji * 16 + fr) * ST_LD + ks * 32 + fq * 8); a1 = mfma16(cur.Wf[ks], sf, a1); a2 = mfma16(cur.Qf[ks], sf, a2); }
        { f32x4 vn;
#pragma unroll
          for (int r = 0; r < 4; ++r) vn[r] = bf2f(cur.Uv[r]) - a1[r];
          u32x2 w; w.x = cvt_pk_bf16(vn[0], vn[1]); w.y = cvt_pk_bf16(vn[2], vn[3]); *(LAS u32x2*)(VnT + (ji * 16 + fr) * VT_LD + ti * 16 + 4 * fq) = w; }
        __syncthreads();
        bf16x8 vf[2];
#pragma unroll
        for (int k2 = 0; k2 < 2; ++k2) vf[k2] = *(const LAS bf16x8*)(VnT + (ji * 16 + fr) * VT_LD + k2 * 32 + fq * 8);
#pragma unroll
        for (int k2 = 0; k2 < 2; ++k2) a2 = mfma16(cur.Af[k2], vf[k2], a2);
        { bf16_t* op = OKP(bf16_t, WS_OBUF) + ((size_t)b * L + c * 64 + ti * 16 + 4 * fq) * 1024 + hd * 128 + sl * 32 + ji * 16 + fr;
#pragma unroll
          for (int r = 0; r < 4; ++r) op[r * 1024] = (bf16_t)(cvt_pk_bf16(a2[r], 0.f) & 0xffffu); }
#pragma unroll
        for (int i = 0; i < 2; ++i) { Sacc[i] *= cur.dec;
#pragma unroll
            for (int k2 = 0; k2 < 2; ++k2) Sacc[i] = mfma16(cur.Kf[i][k2], vf[k2], Sacc[i]);
            u32x2 w; w.x = cvt_pk_bf16(Sacc[i][0], Sacc[i][1]); w.y = cvt_pk_bf16(Sacc[i][2], Sacc[i][3]); *(LAS u32x2*)(ST + (ji * 16 + fr) * ST_LD + (dt0 + i) * 16 + 4 * fq) = w; }
        if (c + 1 < NCH) cur = nxt;
    }
}
__device__ __forceinline__ void phase_gdn_final(const Frame& F0) {
    using namespace sm;
    const Frame F = phase_frame(F0);
    const int lane = F.lane; const int gw = F.vcu * NWAVES + F.wave, NGW = F.G * NWAVES;
    const f32x4* nw4 = (const f32x4*)(F.in[I_OD_NORM] + (lane & 7) * 16);
    for (int t = gw; t < T; t += NGW) { const u32x4* op = (const u32x4*)(OKP(bf16_t, WS_OBUF) + (size_t)t * 1024 + lane * 16); const u32x4* zp = (const u32x4*)(OKP(bf16_t, WS_PROJ) + (size_t)t * PROJ1_LD + 3072 + lane * 16);
        float o[16], z[16];
#pragma unroll
        for (int h2 = 0; h2 < 2; ++h2) { const u32x4 a = op[h2], zz = zp[h2];
            o[h2 * 8 + 0] = bflo(a.x); o[h2 * 8 + 1] = bfhi(a.x); o[h2 * 8 + 2] = bflo(a.y); o[h2 * 8 + 3] = bfhi(a.y); o[h2 * 8 + 4] = bflo(a.z); o[h2 * 8 + 5] = bfhi(a.z); o[h2 * 8 + 6] = bflo(a.w); o[h2 * 8 + 7] = bfhi(a.w);
            z[h2 * 8 + 0] = bflo(zz.x); z[h2 * 8 + 1] = bfhi(zz.x); z[h2 * 8 + 2] = bflo(zz.y); z[h2 * 8 + 3] = bfhi(zz.y); z[h2 * 8 + 4] = bflo(zz.z); z[h2 * 8 + 5] = bfhi(zz.z); z[h2 * 8 + 6] = bflo(zz.w); z[h2 * 8 + 7] = bfhi(zz.w); }
        float s = 0.f;
#pragma unroll
        for (int i = 0; i < 16; ++i) s += o[i] * o[i];
        s += __shfl_xor(s, 1); s += __shfl_xor(s, 2); s += __shfl_xor(s, 4);
        const float rs = 1.f / sqrtf(s * (1.f / 128.f) + EPS);
        u32x4 w[2];
#pragma unroll
        for (int h2 = 0; h2 < 2; ++h2) { const f32x4 n0 = nw4[h2 * 2], n1 = nw4[h2 * 2 + 1]; float y[8];
#pragma unroll
            for (int i = 0; i < 8; ++i) y[i] = o[h2 * 8 + i] * rs * (i < 4 ? n0[i] : n1[i - 4]) * siluf(z[h2 * 8 + i]);
            w[h2].x = cvt_pk_bf16(y[0], y[1]); w[h2].y = cvt_pk_bf16(y[2], y[3]); w[h2].z = cvt_pk_bf16(y[4], y[5]); w[h2].w = cvt_pk_bf16(y[6], y[7]); }
        u32x4* cp = (u32x4*)(OKP(bf16_t, WS_CAT1) + (size_t)t * 1536 + lane * 16); cp[0] = w[0]; cp[1] = w[1]; }
}
}

namespace ok {
constexpr int SB_LD = 72;
#ifdef CPU_EMU
#define WAVE_ALL(p) (wave_sum((p) ? 1.f : 0.f) == 64.f)
#else
#define WAVE_ALL(p) (__all(p))
#endif
__device__ __forceinline__ void sb_unit(const Frame& F, int unit) {
    LAS bf16_t* Kt = (LAS bf16_t*)F.lds; LAS bf16_t* VT = (LAS bf16_t*)(F.lds + 64 * SB_LD * 2); volatile LAS int* votes = (volatile LAS int*)(F.lds + 2 * 64 * SB_LD * 2);
    const int tid = F.tid, lane = F.lane, wave = F.wave, fr = lane & 15, fq = lane >> 4;
    const int nqb = L / 128, qb = unit % nqb, hd = (unit / nqb) & 7, b = unit / (nqb * 8), q0 = qb * 128;
    const bf16_t* proj = OKP(bf16_t, WS_PROJ) + (size_t)b * L * PROJ1_LD;
    const int qrow = q0 + wave * 16 + fr;
    bf16x8 qf[2];
#pragma unroll
    for (int ks = 0; ks < 2; ++ks) qf[ks] = *(const bf16x8*)(proj + (size_t)qrow * PROJ1_LD + 4096 + hd * 64 + ks * 32 + fq * 8);
    f32x4 o[4] = {{0.f, 0.f, 0.f, 0.f}, {0.f, 0.f, 0.f, 0.f}, {0.f, 0.f, 0.f, 0.f}, {0.f, 0.f, 0.f, 0.f}};
    float C = 1.f; bool wdone = false;
    const int key_l = tid >> 3, c8 = tid & 7;
    int kt = 2 * qb + 1;
    u32x4 kreg = *(const u32x4*)(proj + (size_t)(kt * 64 + key_l) * PROJ1_LD + 4608 + hd * 64 + c8 * 8), vreg = *(const u32x4*)(proj + (size_t)(kt * 64 + key_l) * PROJ1_LD + 5120 + hd * 64 + c8 * 8);
    for (; kt >= 0; --kt) {
        __syncthreads();
        *(LAS u32x4*)(Kt + key_l * SB_LD + c8 * 8) = kreg;
        { LAS bf16_t* vp = VT + (c8 * 8) * SB_LD + key_l; vp[0] = (bf16_t)(vreg.x & 0xffffu); vp[SB_LD] = (bf16_t)(vreg.x >> 16); vp[2 * SB_LD] = (bf16_t)(vreg.y & 0xffffu); vp[3 * SB_LD] = (bf16_t)(vreg.y >> 16);
          vp[4 * SB_LD] = (bf16_t)(vreg.z & 0xffffu); vp[5 * SB_LD] = (bf16_t)(vreg.z >> 16); vp[6 * SB_LD] = (bf16_t)(vreg.w & 0xffffu); vp[7 * SB_LD] = (bf16_t)(vreg.w >> 16); }
        if (lane == 0) votes[wave] = wdone ? 1 : 0;
        __syncthreads();
        { int all = 1;
#pragma unroll
          for (int w = 0; w < 8; ++w) all &= votes[w];
          if (all) break; }
        if (kt > 0) { kreg = *(const u32x4*)(proj + (size_t)((kt - 1) * 64 + key_l) * PROJ1_LD + 4608 + hd * 64 + c8 * 8); vreg = *(const u32x4*)(proj + (size_t)((kt - 1) * 64 + key_l) * PROJ1_LD + 5120 + hd * 64 + c8 * 8); }
        const int key0 = kt * 64;
        if (!wdone && key0 < q0 + wave * 16 + 16) {
            f32x4 x[4];
#pragma unroll
            for (int k16 = 0; k16 < 4; ++k16) { x[k16] = (f32x4){0.f, 0.f, 0.f, 0.f};
#pragma unroll
                for (int ks = 0; ks < 2; ++ks) { const bf16x8 kf = *(const LAS bf16x8*)(Kt + (k16 * 16 + fr) * SB_LD + ks * 32 + fq * 8); x[k16] = mfma16(kf, qf[ks], x[k16]); } }
            const bool need_mask = key0 + 63 >= q0 + wave * 16;
            float Rr[4], Tt[4], Ee[4];
#pragma unroll
            for (int k16 = 0; k16 < 4; ++k16) {
#pragma unroll
                for (int r = 0; r < 4; ++r) { const float e = exp2f(fminf(x[k16][r], 80.f)); float rr = 1.f / (1.f + e), bet = e * rr;
                    if (need_mask && key0 + k16 * 16 + 4 * fq + r >= qrow) { rr = 1.f; bet = 0.f; }
                    x[k16][r] = bet; Rr[k16] = (r == 0) ? rr : Rr[k16];
                    if (r == 0) Tt[k16] = rr; else if (r == 1) Ee[k16] = rr; else if (r == 2) Rr[k16] = rr; else {
                        const float r0 = Tt[k16], r1 = Ee[k16], r2 = Rr[k16], r3 = rr; const float s2 = r3, s1 = r3 * r2, s0 = s1 * r1;
                        x[k16][0] *= s0; x[k16][1] *= s1; x[k16][2] *= s2;
                        Rr[k16] = s0 * r0; } } }
#pragma unroll
            for (int k16 = 0; k16 < 4; ++k16) { const float R = Rr[k16]; const float d1 = __shfl_down(R, 16), d2 = __shfl_down(R, 32), d3 = __shfl_down(R, 48);
                Ee[k16] = (fq < 3 ? d1 : 1.f) * (fq < 2 ? d2 : 1.f) * (fq < 1 ? d3 : 1.f); float t = R; t *= __shfl_xor(t, 16); t *= __shfl_xor(t, 32); Tt[k16] = t; }
            const float TT2 = Tt[3], TT1 = Tt[3] * Tt[2], TT0 = TT1 * Tt[1];
            const float f0 = Ee[0] * TT0 * C, f1 = Ee[1] * TT1 * C, f2 = Ee[2] * TT2 * C, f3 = Ee[3] * C;
            x[0] *= f0; x[1] *= f1; x[2] *= f2; x[3] *= f3;
            C *= TT0 * Tt[0];
            bf16x8 pw[2];
#pragma unroll
            for (int j = 0; j < 2; ++j) { u32x4 p; p.x = cvt_pk_bf16(x[2 * j][0], x[2 * j][1]); p.y = cvt_pk_bf16(x[2 * j][2], x[2 * j][3]); p.z = cvt_pk_bf16(x[2 * j + 1][0], x[2 * j + 1][1]); p.w = cvt_pk_bf16(x[2 * j + 1][2], x[2 * j + 1][3]); pw[j] = __builtin_bit_cast(bf16x8, p); }
#pragma unroll
            for (int dt = 0; dt < 4; ++dt)
#pragma unroll
                for (int j = 0; j < 2; ++j) { const LAS bf16_t* vp = VT + (dt * 16 + fr) * SB_LD + j * 32 + 4 * fq; const u32x2 lo = *(const LAS u32x2*)vp, hi = *(const LAS u32x2*)(vp + 16);
                    u32x4 a; a.x = lo.x; a.y = lo.y; a.z = hi.x; a.w = hi.y; o[dt] = mfma16(__builtin_bit_cast(bf16x8, a), pw[j], o[dt]); }
            wdone = WAVE_ALL(C < 7.8886e-31f);
        }
    }
    bf16_t* op = OKP(bf16_t, WS_CAT1) + ((size_t)b * L + qrow) * 1536 + 1024 + hd * 64 + 4 * fq;
#pragma unroll
    for (int dt = 0; dt < 4; ++dt) { u32x2 w; w.x = cvt_pk_bf16(o[dt][0], o[dt][1]); w.y = cvt_pk_bf16(o[dt][2], o[dt][3]); *(u32x2*)(op + dt * 16) = w; }
}
__device__ __forceinline__ void phase_l1_mix(const Frame& F0) {
    const Frame F = phase_frame(F0);
    const int nscan = F.G >= 128 ? 64 : 0;
    if (nscan == 0) { if (F.vcu == 0) for (int u = 0; u < 64; ++u) { gdn_scan_unit(F, u); __syncthreads(); } for (int u = F.vcu; u < NB * 8 * (L / 128); u += F.G) { sb_unit(F, u); __syncthreads(); } return; }
    if (F.vcu < nscan) gdn_scan_unit(F, F.vcu);
    else for (int u = F.vcu - nscan; u < NB * 8 * (L / 128); u += F.G - nscan) { sb_unit(F, u); __syncthreads(); }
}
}

namespace ok {
#if CHECK
__device__ const int kSampleRows[16] = {0, 1, 2, 3, 63, 64, 127, 128, 129, 1000, 2047, 2048, 4097, 6000, 8190, 8191};
constexpr int FP_W = 6144;
__device__ __forceinline__ void fp_save(const Frame& F, int k, const void* buf, int ld, int width, bool is_bf16, int dcol0) {
    float* fp = OKP(float, WS_FP) + (size_t)k * 16 * FP_W; const size_t gt = (size_t)blockIdx.x * NT + F.tid, GT = (size_t)F.G * NT;
    for (size_t i = gt; i < (size_t)16 * width; i += GT) { const int r = (int)(i / width), c = (int)(i % width); const size_t src = (size_t)kSampleRows[r] * ld + c;
        fp[r * FP_W + dcol0 + c] = is_bf16 ? bf2f(((const bf16_t*)buf)[src]) : ((const float*)buf)[src]; }
}
__device__ __forceinline__ void fp_cmp(const Frame& F, int k, const float* obuf, int ld, int ocol0, int width, int fcol0) {
    const float* fp = OKP(float, WS_FP) + (size_t)k * 16 * FP_W; const size_t gt = (size_t)blockIdx.x * NT + F.tid, GT = (size_t)F.G * NT; float num = 0.f, den = 0.f;
    for (size_t i = gt; i < (size_t)16 * width; i += GT) { const int r = (int)(i / width), c = (int)(i % width); const float o = obuf[(size_t)kSampleRows[r] * ld + ocol0 + c], f = fp[r * FP_W + fcol0 + c];
        const float d = o - f; num += d * d; den += o * o; if (!(d == d)) num += 1e30f; }
    num = wave_sum(num); den = wave_sum(den);
    if (F.lane == 0 && (num != 0.f || den != 0.f)) { atomicAdd((float*)F.ctl + CW_CHK + 2 * k, num); atomicAdd((float*)F.ctl + CW_CHK + 2 * k + 1, den); }
}
__device__ __forceinline__ void fp_save_lin(const Frame& F, int k, const void* buf, size_t off, int n, bool is_bf16) {
    float* fp = OKP(float, WS_FP) + (size_t)k * 16 * FP_W; const size_t gt = (size_t)blockIdx.x * NT + F.tid, GT = (size_t)F.G * NT;
    for (size_t i = gt; i < (size_t)n; i += GT) fp[i] = is_bf16 ? bf2f(((const bf16_t*)buf)[off + i]) : ((const float*)buf)[off + i];
}
__device__ __forceinline__ void fp_cmp_lin(const Frame& F, int k, const float* obuf, size_t off, int n) {
    const float* fp = OKP(float, WS_FP) + (size_t)k * 16 * FP_W; const size_t gt = (size_t)blockIdx.x * NT + F.tid, GT = (size_t)F.G * NT; float num = 0.f, den = 0.f;
    for (size_t i = gt; i < (size_t)n; i += GT) { const float o = obuf[off + i], f = fp[i]; const float d = o - f; num += d * d; den += o * o; if (!(d == d)) num += 1e30f; }
    num = wave_sum(num); den = wave_sum(den);
    if (F.lane == 0 && (num != 0.f || den != 0.f)) { atomicAdd((float*)F.ctl + CW_CHK + 2 * k, num); atomicAdd((float*)F.ctl + CW_CHK + 2 * k + 1, den); }
}
#endif

struct Args { const float* in[33]; float* out; unsigned char* ws;
#if CHECK
    sm::Ctx oc;
#endif
};

__global__ void __launch_bounds__(512, 2) mk_fwd(Args a) {
    extern __shared__ __attribute__((aligned(16))) unsigned char lds_raw[];
    Frame F; F.lds = (LAS unsigned char*)lds_raw; F.ws = a.ws; F.ctl = (unsigned*)(a.ws + WS_CTL); F.in = a.in; F.out = a.out;
    F.tid = threadIdx.x; F.lane = F.tid & 63; F.wave = __builtin_amdgcn_readfirstlane(F.tid >> 6); F.G = gridDim.x;
    { const int bx = blockIdx.x; F.vcu = (F.G % 8 == 0) ? (bx % 8) * (F.G / 8) + bx / 8 : bx; }
    volatile LAS unsigned* MISC = (volatile LAS unsigned*)(F.lds + LDS_BYTES - 64);
    if (F.tid < 16) MISC[F.tid] = 0u;
    __syncthreads();
    XcdBarrier bar = xcd_barrier_post(F.ctl + CW_BAR, MISC);
#define GRID_BAR() xcd_barrier(bar)
    using namespace sm;
    phase_prologue(F);
    prologue_router_tables(F);
    GRID_BAR();
    { EpiScaleBf16 E{OKP(bf16_t, WS_PROJ), PROJ0_LD, (const float*)F.ctl + CW_SSQ, 1};
      dense_gemm(F, OKP(bf16_t, WS_HB), OKP(bf16_t, WS_W_IN0), T, 4096, 1024, E); }
    GRID_BAR();
#if CHECK
    fp_save(F, 0, OKP(bf16_t, WS_PROJ), PROJ0_LD, 4096, true, 0);
#endif
    phase_kv(F);
    GRID_BAR();
    phase_ssd_a(F);
    GRID_BAR();
#if CHECK
    fp_save_lin(F, 6, OKP(bf16_t, WS_STATES), ((size_t)5 * 16 + 0) * 8192, 65536, true);
    GRID_BAR();
#endif
    phase_ssd_scan(F);
    GRID_BAR();
    phase_ssd_b(F);
    GRID_BAR();
    { EpiResidual E{F.in[I_X], OKP(float, WS_H), OKP(bf16_t, WS_HB), OKP(float, WS_SSQP1)};
      dense_gemm(F, OKP(bf16_t, WS_CAT0), OKP(bf16_t, WS_W_OUT0), T, 1024, 1536, E); }
    GRID_BAR();
#if CHECK
    fp_save(F, 10, OKP(float, WS_H), 1024, 1024, false, 0);
    fp_save_lin(F, 7, OKP(bf16_t, WS_STATES), ((size_t)5 * 16 + 0) * 8192, 65536, true);
    fp_save(F, 8, OKP(bf16_t, WS_CAT0), 1536, 512, true, 0);
    fp_save(F, 9, OKP(bf16_t, WS_CAT0) + 512, 1536, 1024, true, 0);
    GRID_BAR();
#endif
    { EpiScaleBf16 E{OKP(bf16_t, WS_Q), 1024, OKP(float, WS_SSQP1), 16};
      dense_gemm(F, OKP(bf16_t, WS_HB), OKP(bf16_t, WS_W_XA), T, 1024, 1024, E); }
    GRID_BAR();
    phase_xattn(F, OKP(bf16_t, WS_Q), OKP(bf16_t, WS_KX), OKP(bf16_t, WS_VT), OKP(bf16_t, WS_ATT));
    GRID_BAR();
    { EpiResidual E{OKP(float, WS_H), OKP(float, WS_H), OKP(bf16_t, WS_HB), OKP(float, WS_SSQP2)};
      dense_gemm(F, OKP(bf16_t, WS_ATT), OKP(bf16_t, WS_W_XA + 6 * MiB), T, 1024, 1024, E); }
    GRID_BAR();
#if CHECK
    fp_save(F, 11, OKP(float, WS_H), 1024, 1024, false, 0);
    GRID_BAR();
#endif
    phase_router(F, 0, OKP(float, WS_H), OKP(float, WS_SSQP2), 16);
    phase_cvt_moe(F, 0);
    GRID_BAR();
    phase_scatter(F, 0, OKP(bf16_t, WS_HB), OKP(float, WS_SSQP2), 16);
    GRID_BAR();
    phase_moe_up(F);
    GRID_BAR();
    phase_moe_down(F);
    GRID_BAR();
    phase_combine(F, OKP(float, WS_H), OKP(bf16_t, WS_HB), (float*)F.ctl + CW_SSQ + 3 * T, false);
    GRID_BAR();
#if CHECK
    fp_save(F, 12, OKP(float, WS_H), 1024, 1024, false, 0);
    GRID_BAR();
#endif
    { EpiScaleBf16 E{OKP(bf16_t, WS_PROJ), PROJ1_LD, (const float*)F.ctl + CW_SSQ + 3 * T, 1};
      dense_gemm(F, OKP(bf16_t, WS_HB), OKP(bf16_t, WS_W_IN1), T, 5632, 1024, E); }
    GRID_BAR();
#if CHECK
    fp_save(F, 13, OKP(bf16_t, WS_PROJ), PROJ1_LD, 4096, true, 0);
    fp_save(F, 13, OKP(bf16_t, WS_PROJ) + 4608, PROJ1_LD, 1024, true, 4096);
#endif
    phase_gdn_prep(F);
    GRID_BAR();
    phase_l1_mix(F);
    GRID_BAR();
    phase_gdn_final(F);
    GRID_BAR();
    { EpiResidual E{OKP(float, WS_H), OKP(float, WS_H), OKP(bf16_t, WS_HB), OKP(float, WS_SSQP4)};
      dense_gemm(F, OKP(bf16_t, WS_CAT1), OKP(bf16_t, WS_W_OUT1), T, 1024, 1536, E); }
    GRID_BAR();
#if CHECK
    fp_save(F, 14, OKP(bf16_t, WS_CAT1), 1536, 1024, true, 0);
    fp_save(F, 15, OKP(bf16_t, WS_CAT1) + 1024, 1536, 512, true, 0);
    fp_save(F, 16, OKP(float, WS_H), 1024, 1024, false, 0);
    GRID_BAR();
#endif
    { EpiScaleBf16 E{OKP(bf16_t, WS_Q), 1024, OKP(float, WS_SSQP4), 16};
      dense_gemm(F, OKP(bf16_t, WS_HB), OKP(bf16_t, WS_W_XA + 8 * MiB), T, 1024, 1024, E); }
    GRID_BAR();
    phase_xattn(F, OKP(bf16_t, WS_Q), OKP(bf16_t, WS_KX) + (size_t)NB * 256 * 1024, OKP(bf16_t, WS_VT) + (size_t)1024 * NB * 256, OKP(bf16_t, WS_ATT));
    GRID_BAR();
    { EpiResidual E{OKP(float, WS_H), OKP(float, WS_H), OKP(bf16_t, WS_HB), OKP(float, WS_SSQP5)};
      dense_gemm(F, OKP(bf16_t, WS_ATT), OKP(bf16_t, WS_W_XA + 8 * MiB + 6 * MiB), T, 1024, 1024, E); }
    GRID_BAR();
#if CHECK
    fp_save(F, 17, OKP(float, WS_H), 1024, 1024, false, 0);
    GRID_BAR();
#endif
    phase_router(F, 1, OKP(float, WS_H), OKP(float, WS_SSQP5), 16);
    phase_cvt_moe(F, 1);
    GRID_BAR();
    phase_scatter(F, 1, OKP(bf16_t, WS_HB), OKP(float, WS_SSQP5), 16);
    GRID_BAR();
    phase_moe_up(F);
    GRID_BAR();
    phase_moe_down(F);
    GRID_BAR();
    phase_combine(F, OKP(float, WS_H), OKP(bf16_t, WS_HB), nullptr, true);
#if CHECK
    GRID_BAR();
    fp_save(F, 18, F.out, 1024, 1024, false, 0);
    fp_save(F, 1, OKP(float, WS_DTV), 16, 16, false, 0);
    fp_save(F, 2, OKP(float, WS_ACS), 16, 16, false, 0);
    GRID_BAR();
    {
        const size_t gid = (size_t)blockIdx.x * NT + F.tid, gs = (size_t)F.G * NT;
        for (int st = 0;; ++st) {
            const int s = st % sm::NSTAGE_L;
            if (st < 2 * sm::NSTAGE_L && s >= sm::N_STAGES_USED) continue;
            if (!sm::run_stage(a.oc, st, gid, gs)) break;
            GRID_BAR();
            if (st == 3) fp_cmp(F, 0, a.oc.proj, sm::PROJ_LD, 0, 4096, 0);
            if (st == 4) { fp_cmp(F, 1, a.oc.dtv, 16, 0, 16, 0); fp_cmp(F, 2, a.oc.acs, 16, 0, 16, 0); }
            if (st == 4 && gid == 0) { float* c = (float*)F.ctl + CW_CHK; c[6] = 0.f; c[7] = 1.f; c[8] = 0.f; c[9] = 1.f; c[10] = 0.f; c[11] = 1.f; }
            if (st == 5) fp_cmp_lin(F, 6, a.oc.states, ((size_t)5 * 16 + 0) * 8192, 65536);
            if (st == 6) fp_cmp_lin(F, 7, a.oc.states, ((size_t)5 * 16 + 0) * 8192, 65536);
            if (st == 10) { fp_cmp(F, 8, a.oc.cat, 1536, 0, 512, 0); fp_cmp(F, 9, a.oc.cat, 1536, 512, 1024, 0); }
            if (st == 11) fp_cmp(F, 10, a.oc.h, 1024, 0, 1024, 0);
            if (st == 18) fp_cmp(F, 11, a.oc.h, 1024, 0, 1024, 0);
            if (st == 23) fp_cmp(F, 12, a.oc.h, 1024, 0, 1024, 0);
            if (st == 63) { fp_cmp(F, 13, a.oc.proj, sm::PROJ_LD, 0, 4096, 0); fp_cmp(F, 13, a.oc.proj, sm::PROJ_LD, 4624, 1024, 4096); }
            if (st == 70) { fp_cmp(F, 14, a.oc.cat, 1536, 0, 1024, 0); fp_cmp(F, 15, a.oc.cat, 1536, 1024, 512, 0); }
            if (st == 71) fp_cmp(F, 16, a.oc.h, 1024, 0, 1024, 0);
            if (st == 78) fp_cmp(F, 17, a.oc.h, 1024, 0, 1024, 0);
            if (st == 121) fp_cmp(F, 18, a.oc.out, 1024, 0, 1024, 0);
            GRID_BAR();
        }
        GRID_BAR();
        int code = 0;
        for (int k = CHECK - 1; k >= 0; --k) { const float num = __hip_atomic_load((float*)F.ctl + CW_CHK + 2 * k, __ATOMIC_RELAXED, __HIP_MEMORY_SCOPE_AGENT), den = __hip_atomic_load((float*)F.ctl + CW_CHK + 2 * k + 1, __ATOMIC_RELAXED, __HIP_MEMORY_SCOPE_AGENT);
            if (!(num <= 1e-3f * den) || den == 0.f) code = k + 1; }
        const float sc = 1.f + 0.2f * (float)code;
        for (size_t i = gid; i < (size_t)L * DM; i += gs) { F.out[i] *= sc; F.out[(size_t)L * DM + i] = 0.f; }
    }
#endif
}
}

extern "C" void kernel_launch(void* const* d_in, const int* in_sizes, int n_in, void* d_out, int out_size, void* d_ws, size_t ws_size, hipStream_t stream) {
    static int grid = 0;
    if (grid == 0) {
        int dev = 0, cus = 0, per_cu = 0;
        hipGetDevice(&dev); hipDeviceGetAttribute(&cus, hipDeviceAttributeMultiprocessorCount, dev);
        if (hipFuncSetAttribute((const void*)ok::mk_fwd, hipFuncAttributeMaxDynamicSharedMemorySize, LDS_BYTES) != hipSuccess) { fprintf(stderr, "kernel_launch: hipFuncSetAttribute failed\n"); grid = -1; return; }
        hipOccupancyMaxActiveBlocksPerMultiprocessor(&per_cu, (const void*)ok::mk_fwd, ok::NT, LDS_BYTES);
        (void)hipGetLastError();
        grid = cus;
        if (n_in != 33 || ws_size < ok::WS_END || per_cu < 1) { fprintf(stderr, "kernel_launch: n_in %d ws %zu need %zu per_cu %d\n", n_in, ws_size, (size_t)ok::WS_END, per_cu); grid = -1; }
    }
    if (grid < 0) return;
    hipMemsetAsync((char*)d_ws + ok::WS_CTL, 0, ok::CTL_BYTES, stream);
    ok::Args a{};
    for (int i = 0; i < 33; ++i) a.in[i] = (const float*)d_in[i];
    a.out = (float*)d_out; a.ws = (unsigned char*)d_ws;
#if CHECK
    sm::carve(a.oc, (float*)((char*)d_ws + 16 * ok::MiB));
    for (int i = 0; i < 33; ++i) a.oc.in[i] = (const float*)d_in[i];
    a.oc.out = (float*)d_out;
#endif
    hipLaunchKernelGGL(ok::mk_fwd, dim3(grid), dim3(ok::NT), LDS_BYTES, stream, a);
}
```

```cpp
#include <hip/hip_runtime.h>
#include <cstdio>
#include <cstdint>
#ifndef CHECK
#define CHECK 0
#endif
#define DUP_MASK 0
constexpr int LDS_BYTES = 147456;

#define XB_TMO      128
#define XB_XCNT(j)  (256  + 64 * (j))
#define XB_XSUB(j)  (1280 + 64 * (j))
#define XB_XGEN(j)  (2304 + 64 * (j))
#define XB_TOP      3328
#define XB_TOPGEN   3392
#define XCD_BAR_WORDS 3456
#define XB_SPIN_CAP (1u << 18)
#define LAS __attribute__((address_space(3)))

__device__ __forceinline__ unsigned xb_ld(unsigned* p)              { return __hip_atomic_load(p, __ATOMIC_RELAXED, __HIP_MEMORY_SCOPE_AGENT); }
__device__ __forceinline__ unsigned xb_add(unsigned* p, unsigned v) { return __hip_atomic_fetch_add(p, v, __ATOMIC_RELAXED, __HIP_MEMORY_SCOPE_AGENT); }
__device__ __forceinline__ unsigned xb_xcc_id() { return (unsigned)__builtin_amdgcn_s_getreg((3 << 11) | 20) & 0xFu; }
#define XB_SPIN(cond, bar) do { unsigned _sp = 0; while (cond) { __builtin_amdgcn_s_sleep(1); \
    if ((++_sp & 255u) == 0u) { if (xb_ld(&(bar)[XB_TMO])) break; if (_sp > XB_SPIN_CAP) { atomicAdd(&(bar)[XB_TMO], 1u); break; } } } } while (0)

struct XcdBarrier {
    unsigned* bar; unsigned x;
    volatile LAS unsigned* st;
};

__device__ __forceinline__ XcdBarrier xcd_barrier_post(unsigned* bar, volatile LAS unsigned* st) {
    XcdBarrier b; b.bar = bar; b.x = xb_xcc_id(); b.st = st;
    if (threadIdx.x == 0) (void)xb_add(&bar[XB_XCNT(b.x)], 1u);
    return b;
}
__device__ __forceinline__ void xcd_barrier_complete(unsigned* bar, unsigned x, unsigned& nloc, unsigned& nx) {
    const unsigned G = gridDim.x * gridDim.y * gridDim.z;
    unsigned sum, cnt, mine, sp = 0u;
    for (;;) {
        sum = 0u; cnt = 0u; mine = 0u;
#pragma unroll
        for (unsigned j = 0; j < 16; ++j) { const unsigned c = xb_ld(&bar[XB_XCNT(j)]); sum += c; cnt += (c > 0u) ? 1u : 0u; mine = (j == x) ? c : mine; }
        if (sum == G) break;
        __builtin_amdgcn_s_sleep(1);
        if ((++sp & 255u) == 0u) { if (xb_ld(&bar[XB_TMO])) break; if (sp > XB_SPIN_CAP) { atomicAdd(&bar[XB_TMO], 1u); break; } }
    }
    nloc = mine > 0u ? mine : 1u; nx = cnt > 0u ? cnt : 1u;
}

__device__ __forceinline__ void xcd_barrier(const XcdBarrier& b) {
    asm volatile("s_waitcnt vmcnt(0)" ::: "memory");
    __syncthreads();
    if (threadIdx.x == 0) {
        unsigned* bar = b.bar;
        __builtin_amdgcn_s_waitcnt(0);
        unsigned nloc = b.st[0], nx = b.st[1];
        if (nloc == 0u) { xcd_barrier_complete(bar, b.x, nloc, nx); b.st[0] = nloc; b.st[1] = nx; }
        const unsigned old = xb_add(&bar[XB_XSUB(b.x)], 1u);
        const unsigned gen = old / nloc;
        if (old + 1u == (gen + 1u) * nloc) {
            __builtin_amdgcn_fence(__ATOMIC_RELEASE, "agent");
            asm volatile("s_waitcnt vmcnt(0)" ::: "memory");
            const unsigned og = xb_add(&bar[XB_TOP], 1u);
            const unsigned tg = og / nx;
            if (og + 1u == (tg + 1u) * nx) xb_add(&bar[XB_TOPGEN], 1u);
            else XB_SPIN(xb_ld(&bar[XB_TOPGEN]) == tg, bar);
            __builtin_amdgcn_fence(__ATOMIC_ACQUIRE, "agent");
            xb_add(&bar[XB_XGEN(b.x)], 1u);
            asm volatile("s_waitcnt vmcnt(0)" ::: "memory");
        } else {
            XB_SPIN(xb_ld(&bar[XB_XGEN(b.x)]) == gen, bar);
            __builtin_amdgcn_fence(__ATOMIC_ACQUIRE, "agent");
            asm volatile("s_waitcnt vmcnt(0)" ::: "memory");
        }
    }
    __syncthreads();
}


#undef LAS

#ifndef SEQ
#define SEQ 8192
#endif
namespace sm {
constexpr int DM = 1024, NB = 1  , L = SEQ, T = NB * L, NCH = L / 64, MEM = 256;
constexpr int EV_IN = 4112, OD_IN = 5648, PROJ_LD = 5648;
constexpr int E_SCB = 0, E_SCC = 512, E_SCX = 1024, E_Z = 1536, E_XBC = 2560, E_DT = 4096;
constexpr int O_QKV = 0, O_Z = 3072, O_A = 4096, O_B = 4104, O_SQ = 4112, O_SK = 4624, O_SV = 5136;

struct Ctx {
    const float* in[33];
    float* out;
    float *memn, *kx, *vx, *h, *un, *rstd, *proj, *cat, *xbcc, *dtv, *acs, *states, *cb, *ybuf, *rstd2;
    float *q, *att, *sc;
    float *gatew, *act; int* eid;
    float *qkvc, *beta, *gcs, *Lm, *aqk, *uw, *S, *vn, *obuf;
};
enum In { I_X = 0, I_MEM, I_MEM_NORM, I_FINAL_NORM, I_NORM_MIX, I_NORM_XA, I_NORM_FFN, I_XA_WQ, I_XA_WK, I_XA_WV, I_XA_WO,
          I_MOE_WG, I_MOE_BG, I_MOE_WE, I_MOE_BE, I_MOE_WGATE, I_MOE_WUP, I_MOE_WDOWN,
          I_EV_WIN, I_EV_SCCONV, I_EV_CONVW, I_EV_CONVB, I_EV_DTB, I_EV_ALOG, I_EV_D, I_EV_NORM, I_EV_WOUT,
          I_OD_WIN, I_OD_CONV, I_OD_DTB, I_OD_ALOG, I_OD_NORM, I_OD_WOUT };

__device__ __forceinline__ float siluf(float x) { return x / (1.f + expf(-x)); }
__device__ __forceinline__ float softplusf(float x) { return x > 20.f ? x : log1pf(expf(x)); }
__device__ __forceinline__ float sigmoidf(float x) { return 1.f / (1.f + expf(-x)); }

__device__ __forceinline__ void s_copy(const float* src, float* dst, size_t n, size_t gid, size_t gs) { for (size_t i = gid; i < n; i += gs) dst[i] = src[i]; }
__device__ __forceinline__ void s_rstd(const float* x, int R, int W, int ld, float* rstd, size_t gid, size_t gs) {
    for (size_t r = gid; r < (size_t)R; r += gs) { const float* p = x + r * ld; float s = 0.f; for (int i = 0; i < W; ++i) s += p[i] * p[i]; rstd[r] = 1.f / sqrtf(s / W + 1e-6f); }
}
__device__ __forceinline__ void s_norm(const float* x, const float* rstd, const float* g, float* y, int R, size_t gid, size_t gs) {
    for (size_t i = gid; i < (size_t)R * DM; i += gs) { const size_t r = i / DM; const int c = (int)(i % DM); y[i] = x[i] * rstd[r] * g[c]; }
}
__device__ __forceinline__ void s_gemm(const float* A, int lda, const float* W, int ldw, float* C, int ldc, int M, int N, int K, int accum, size_t gid, size_t gs) {
    const int N4 = N / 4;
    for (size_t i = gid; i < (size_t)M * N4; i += gs) { const size_t m = i / N4; const int n = (int)(i % N4) * 4; const float* a = A + m * lda; const float* w = W + n; float s0 = 0.f, s1 = 0.f, s2 = 0.f, s3 = 0.f;
        for (int k = 0; k < K; ++k) { const float av = a[k]; const float4 wv = *(const float4*)(w + (size_t)k * ldw); s0 += av * wv.x; s1 += av * wv.y; s2 += av * wv.z; s3 += av * wv.w; }
        float4* c = (float4*)(C + m * ldc + n); float4 o = accum ? *c : float4{0.f, 0.f, 0.f, 0.f}; o.x += s0; o.y += s1; o.z += s2; o.w += s3; *c = o; }
}
__device__ __forceinline__ void s_scmix(const Ctx& c, size_t gid, size_t gs) {
    const float* w = c.in[I_EV_SCCONV];
    for (size_t i = gid; i < (size_t)T * 512; i += gs) { const size_t t = i / 512; const int ch = (int)(i % 512); const int tl = (int)(t % L); float s = 0.f;
        for (int j = 0; j < 3; ++j) { const int tt = tl - 2 + j; if (tt >= 0) { const float* p = c.proj + (t - 2 + j) * PROJ_LD; s += w[j * 512 + ch] * p[E_SCC + ch] * p[E_SCX + ch]; } }
        c.cat[t * 1536 + ch] = c.proj[t * PROJ_LD + E_SCB + ch] * s; }
}
__device__ __forceinline__ void s_ssd_conv(const Ctx& c, size_t gid, size_t gs) {
    const float* w = c.in[I_EV_CONVW]; const float* b = c.in[I_EV_CONVB];
    for (size_t i = gid; i < (size_t)T * 1536; i += gs) { const size_t t = i / 1536; const int ch = (int)(i % 1536); const int tl = (int)(t % L); float s = b[ch];
        for (int j = 0; j < 4; ++j) { const int tt = tl - 3 + j; if (tt >= 0) s += w[j * 1536 + ch] * c.proj[(t - 3 + j) * PROJ_LD + E_XBC + ch]; }
        c.xbcc[i] = siluf(s); }
}
__device__ __forceinline__ void s_ssd_dt(const Ctx& c, size_t gid, size_t gs) {
    for (size_t i = gid; i < (size_t)NB * NCH * 16; i += gs) { const int hd = (int)(i % 16); const size_t bc = i / 16; const float a = -expf(c.in[I_EV_ALOG][hd]); float cs = 0.f;
        for (int s = 0; s < 64; ++s) { const size_t t = bc * 64 + s; const float dt = softplusf(c.proj[t * PROJ_LD + E_DT + hd] + c.in[I_EV_DTB][hd]); cs += dt * a; c.dtv[t * 16 + hd] = dt; c.acs[t * 16 + hd] = cs; } }
}
__device__ __forceinline__ void s_ssd_states(const Ctx& c, size_t gid, size_t gs) {
    for (size_t i = gid; i < (size_t)NB * NCH * 16 * 64 * 128; i += gs) { const int n = (int)(i % 128); const int p = (int)((i / 128) % 64); const int hd = (int)((i / 8192) % 16); const size_t bc = i / (8192 * 16);
        const int g = hd / 8; const float last = c.acs[(bc * 64 + 63) * 16 + hd]; float s = 0.f;
        for (int k = 0; k < 64; ++k) { const size_t t = bc * 64 + k; s += c.xbcc[t * 1536 + 1024 + g * 128 + n] * c.xbcc[t * 1536 + hd * 64 + p] * c.dtv[t * 16 + hd] * expf(last - c.acs[t * 16 + hd]); }
        c.states[i] = s; }
}
__device__ __forceinline__ void s_ssd_scan(const Ctx& c, size_t gid, size_t gs) {
    for (size_t i = gid; i < (size_t)NB * 16 * 8192; i += gs) { const size_t b = i / (16 * 8192); const size_t r = i % (16 * 8192); const int hd = (int)(r / 8192); float s = 0.f;
        for (int ch = 0; ch < NCH; ++ch) { const size_t bc = b * NCH + ch; const size_t idx = bc * (16 * 8192) + r; const float st = c.states[idx]; c.states[idx] = s; s = s * expf(c.acs[(bc * 64 + 63) * 16 + hd]) + st; } }
}
__device__ __forceinline__ void s_ssd_cb(const Ctx& c, size_t gid, size_t gs) {
    for (size_t i = gid; i < (size_t)NB * NCH * 2 * 4096; i += gs) { const int s = (int)(i % 64); const int t = (int)((i / 64) % 64); const int g = (int)((i / 4096) % 2); const size_t bc = i / 8192;
        const float* cm = c.xbcc + (bc * 64 + t) * 1536 + 1280 + g * 128; const float* bm = c.xbcc + (bc * 64 + s) * 1536 + 1024 + g * 128; float a = 0.f;
        for (int n = 0; n < 128; ++n) a += cm[n] * bm[n];
        c.cb[i] = a; }
}
__device__ __forceinline__ void s_ssd_y(const Ctx& c, size_t gid, size_t gs) {
    for (size_t i = gid; i < (size_t)T * 1024; i += gs) { const size_t t = i / 1024; const int hp = (int)(i % 1024); const int hd = hp / 64, p = hp % 64, g = hd / 8; const size_t bc = t / 64; const int tl = (int)(t % 64);
        const float at = c.acs[t * 16 + hd]; float y = 0.f;
        for (int s = 0; s <= tl; ++s) { const size_t ts = bc * 64 + s; y += c.cb[(bc * 2 + g) * 4096 + tl * 64 + s] * expf(at - c.acs[ts * 16 + hd]) * c.xbcc[ts * 1536 + hp] * c.dtv[ts * 16 + hd]; }
        const float* cm = c.xbcc + t * 1536 + 1280 + g * 128; const float* pv = c.states + (bc * 16 + hd) * 8192 + p * 128; float yo = 0.f;
        for (int n = 0; n < 128; ++n) yo += cm[n] * pv[n];
        y += yo * expf(at) + c.xbcc[t * 1536 + hp] * c.in[I_EV_D][hd];
        c.ybuf[i] = y * siluf(c.proj[t * PROJ_LD + E_Z + hp]); }
}
__device__ __forceinline__ void s_ssd_out(const Ctx& c, size_t gid, size_t gs) {
    for (size_t i = gid; i < (size_t)T * 1024; i += gs) { const size_t t = i / 1024; const int ch = (int)(i % 1024); c.cat[t * 1536 + 512 + ch] = c.ybuf[i] * c.rstd2[t * 2 + ch / 512] * c.in[I_EV_NORM][ch]; }
}
__device__ __forceinline__ void s_xa_scores(const Ctx& c, size_t gid, size_t gs) {
    for (size_t i = gid; i < (size_t)T * 4 * 256; i += gs) { const int m = (int)(i % 256); const int hd = (int)((i / 256) % 4); const size_t t = i / 1024; const size_t b = t / L;
        const float* q = c.q + t * 1024 + hd * 256; const float* k = c.kx + (b * 256 + m) * 1024 + hd * 256; float s = 0.f;
        for (int d = 0; d < 256; ++d) s += q[d] * k[d];
        c.sc[i] = s * 0.0625f; }
}
__device__ __forceinline__ void s_xa_softmax(const Ctx& c, size_t gid, size_t gs) {
    for (size_t i = gid; i < (size_t)T * 4; i += gs) { float* p = c.sc + i * 256; float mx = p[0]; for (int m = 1; m < 256; ++m) mx = fmaxf(mx, p[m]); float s = 0.f; for (int m = 0; m < 256; ++m) { const float e = expf(p[m] - mx); p[m] = e; s += e; } const float r = 1.f / s; for (int m = 0; m < 256; ++m) p[m] *= r; }
}
__device__ __forceinline__ void s_xa_pv(const Ctx& c, size_t gid, size_t gs) {
    for (size_t i = gid; i < (size_t)T * 1024; i += gs) { const size_t t = i / 1024; const int col = (int)(i % 1024); const int hd = col / 256; const size_t b = t / L; const float* p = c.sc + (t * 4 + hd) * 256; const float* v = c.vx + b * 256 * 1024 + col; float s = 0.f;
        for (int m = 0; m < 256; ++m) s += p[m] * v[(size_t)m * 1024];
        c.att[i] = s; }
}
__device__ __forceinline__ void s_router(const Ctx& c, int l, size_t gid, size_t gs) {
    const float* wg = c.in[I_MOE_WG] + (size_t)l * 1024 * 4; const float* bg = c.in[I_MOE_BG] + l * 4; const float* we = c.in[I_MOE_WE] + (size_t)l * 1024 * 32; const float* be = c.in[I_MOE_BE] + l * 32;
    for (size_t t = gid; t < (size_t)T; t += gs) { const float* x = c.un + t * 1024; float g0 = 0.f, g1 = 0.f, g2 = 0.f, g3 = 0.f;
        for (int k = 0; k < 1024; ++k) { const float xv = x[k]; g0 += xv * wg[k * 4 + 0]; g1 += xv * wg[k * 4 + 1]; g2 += xv * wg[k * 4 + 2]; g3 += xv * wg[k * 4 + 3]; }
        g0 += bg[0]; g1 += bg[1]; g2 += bg[2]; g3 += bg[3];
        int gsel = 0; float gm = g0; if (g1 > gm) { gm = g1; gsel = 1; } if (g2 > gm) { gm = g2; gsel = 2; } if (g3 > gm) { gm = g3; gsel = 3; }
        const float gw = 1.f / (expf(g0 - gm) + expf(g1 - gm) + expf(g2 - gm) + expf(g3 - gm));
        float e0 = 0, e1 = 0, e2 = 0, e3 = 0, e4 = 0, e5 = 0, e6 = 0, e7 = 0; const float* w = we + gsel * 8;
        for (int k = 0; k < 1024; ++k) { const float xv = x[k]; const float* wk = w + k * 32; e0 += xv * wk[0]; e1 += xv * wk[1]; e2 += xv * wk[2]; e3 += xv * wk[3]; e4 += xv * wk[4]; e5 += xv * wk[5]; e6 += xv * wk[6]; e7 += xv * wk[7]; }
        const float* bb = be + gsel * 8; e0 += bb[0]; e1 += bb[1]; e2 += bb[2]; e3 += bb[3]; e4 += bb[4]; e5 += bb[5]; e6 += bb[6]; e7 += bb[7];
        int i1 = 0; float m1 = e0;
#define SM_T1(j, v) if (v > m1) { m1 = v; i1 = j; }
        SM_T1(1, e1) SM_T1(2, e2) SM_T1(3, e3) SM_T1(4, e4) SM_T1(5, e5) SM_T1(6, e6) SM_T1(7, e7)
        int i2 = -1; float m2 = -3.0e38f;
#define SM_T2(j, v) if (j != i1 && v > m2) { m2 = v; i2 = j; }
        SM_T2(0, e0) SM_T2(1, e1) SM_T2(2, e2) SM_T2(3, e3) SM_T2(4, e4) SM_T2(5, e5) SM_T2(6, e6) SM_T2(7, e7)
        const float r = expf(m2 - m1); const float w1 = gw / (1.f + r), w2 = gw * r / (1.f + r);
        c.eid[t * 2 + 0] = gsel * 8 + i1; c.eid[t * 2 + 1] = gsel * 8 + i2; c.gatew[t * 2 + 0] = w1; c.gatew[t * 2 + 1] = w2; }
}
__device__ __forceinline__ void s_moe_up(const Ctx& c, int l, size_t gid, size_t gs) {
    for (size_t i = gid; i < (size_t)T * 2 * 512; i += gs) { const int f = (int)(i % 512); const size_t tk = i / 512; const size_t t = tk / 2; const int e = c.eid[tk] & 31;
        const float* wg = c.in[I_MOE_WGATE] + ((size_t)l * 32 + e) * 1024 * 512 + f; const float* wu = c.in[I_MOE_WUP] + ((size_t)l * 32 + e) * 1024 * 512 + f; const float* x = c.un + t * 1024; float a = 0.f, b = 0.f;
        for (int k = 0; k < 1024; ++k) { a += x[k] * wg[(size_t)k * 512]; b += x[k] * wu[(size_t)k * 512]; }
        c.act[i] = siluf(a) * b; }
}
__device__ __forceinline__ void s_moe_down(const Ctx& c, int l, size_t gid, size_t gs) {
    for (size_t i = gid; i < (size_t)T * 1024; i += gs) { const size_t t = i / 1024; const int n = (int)(i % 1024); float y = 0.f;
        for (int k = 0; k < 2; ++k) { const int e = c.eid[t * 2 + k] & 31; const float* wd = c.in[I_MOE_WDOWN] + ((size_t)l * 32 + e) * 512 * 1024 + n; const float* a = c.act + (t * 2 + k) * 512; float s = 0.f;
            for (int f = 0; f < 512; ++f) s += a[f] * wd[(size_t)f * 1024];
            y += s * c.gatew[t * 2 + k]; }
        c.h[i] += y; }
}
__device__ __forceinline__ void s_gdn_conv(const Ctx& c, size_t gid, size_t gs) {
    const float* w = c.in[I_OD_CONV];
    for (size_t i = gid; i < (size_t)T * 3072; i += gs) { const size_t t = i / 3072; const int ch = (int)(i % 3072); const int tl = (int)(t % L); float s = 0.f;
        for (int j = 0; j < 4; ++j) { const int tt = tl - 3 + j; if (tt >= 0) s += w[j * 3072 + ch] * c.proj[(t - 3 + j) * PROJ_LD + O_QKV + ch]; }
        c.qkvc[i] = siluf(s); }
}
__device__ __forceinline__ void s_gdn_qkscale(const Ctx& c, size_t gid, size_t gs) {
    for (size_t i = gid; i < (size_t)T * 16; i += gs) { const size_t t = i / 16; const int wh = (int)(i % 16); float* p = c.qkvc + t * 3072 + wh * 128; float s = 0.f; for (int d = 0; d < 128; ++d) s += p[d] * p[d];
        float r = 1.f / sqrtf(s + 1e-6f); if (wh < 8) r *= 0.08838834764831845f; for (int d = 0; d < 128; ++d) p[d] *= r; }
}
__device__ __forceinline__ void s_gdn_gates(const Ctx& c, size_t gid, size_t gs) {
    for (size_t i = gid; i < (size_t)NB * NCH * 8; i += gs) { const int hd = (int)(i % 8); const size_t bc = i / 8; const float na = -expf(c.in[I_OD_ALOG][hd]); const float db = c.in[I_OD_DTB][hd]; float cs = 0.f;
        for (int s = 0; s < 64; ++s) { const size_t t = bc * 64 + s; cs += na * softplusf(c.proj[t * PROJ_LD + O_A + hd] + db); c.gcs[t * 8 + hd] = cs; c.beta[t * 8 + hd] = sigmoidf(c.proj[t * PROJ_LD + O_B + hd]); } }
}
__device__ __forceinline__ void s_gdn_kk(const Ctx& c, size_t gid, size_t gs) {
    for (size_t i = gid; i < (size_t)NB * NCH * 8 * 4096; i += gs) { const int s = (int)(i % 64); const int t = (int)((i / 64) % 64); const int hd = (int)((i / 4096) % 8); const size_t bc = i / (4096 * 8);
        float lv = 0.f, av = 0.f;
        if (s <= t) { const size_t tt = bc * 64 + t, ts = bc * 64 + s; const float* kt = c.qkvc + tt * 3072 + 1024 + hd * 128; const float* ks = c.qkvc + ts * 3072 + 1024 + hd * 128; const float* qt = c.qkvc + tt * 3072 + hd * 128; float kk = 0.f, qk = 0.f;
            for (int d = 0; d < 128; ++d) { kk += kt[d] * ks[d]; qk += qt[d] * ks[d]; }
            const float dec = expf(c.gcs[tt * 8 + hd] - c.gcs[ts * 8 + hd]); av = qk * dec; if (s < t) lv = kk * c.beta[tt * 8 + hd] * dec; }
        c.Lm[i] = lv; c.aqk[i] = av; }
}
__device__ __forceinline__ void s_gdn_solve(const Ctx& c, size_t gid, size_t gs) {
    for (size_t i = gid; i < (size_t)NB * NCH * 8 * 256; i += gs) { const int j = (int)(i % 256); const int hd = (int)((i / 256) % 8); const size_t bc = i / 2048; float* sol = c.uw + (bc * 8 + hd) * (64 * 256) + j; const float* Lp = c.Lm + (bc * 8 + hd) * 4096;
        for (int t = 0; t < 64; ++t) { const size_t tt = bc * 64 + t; const float bt = c.beta[tt * 8 + hd];
            float r = (j < 128) ? c.qkvc[tt * 3072 + 2048 + hd * 128 + j] * bt : c.qkvc[tt * 3072 + 1024 + hd * 128 + (j - 128)] * bt * expf(c.gcs[tt * 8 + hd]);
            for (int s = 0; s < t; ++s) r -= Lp[t * 64 + s] * sol[(size_t)s * 256];
            sol[(size_t)t * 256] = r; } }
}
__device__ __forceinline__ void s_gdn_scan(const Ctx& c, size_t gid, size_t gs) {
    for (size_t i = gid; i < (size_t)NB * 8 * 128; i += gs) { const int j = (int)(i % 128); const size_t bh = i / 128; const int hd = (int)(bh % 8); const size_t b = bh / 8; float* S = c.S + bh * 16384 + j; float* vn = c.vn + bh * 8192 + j;
        for (int d = 0; d < 128; ++d) S[(size_t)d * 128] = 0.f;
        for (int ch = 0; ch < NCH; ++ch) { const size_t bc = b * NCH + ch; const float* uw = c.uw + (bc * 8 + hd) * (64 * 256); const float* aq = c.aqk + (bc * 8 + hd) * 4096; const float glast = c.gcs[(bc * 64 + 63) * 8 + hd];
            for (int t = 0; t < 64; ++t) { float v = uw[t * 256 + j]; const float* w = uw + t * 256 + 128; for (int d = 0; d < 128; ++d) v -= w[d] * S[(size_t)d * 128]; vn[(size_t)t * 128] = v; }
            for (int t = 0; t < 64; ++t) { const size_t tt = bc * 64 + t; const float* q = c.qkvc + tt * 3072 + hd * 128; float o = 0.f; for (int d = 0; d < 128; ++d) o += q[d] * S[(size_t)d * 128];
                o *= expf(c.gcs[tt * 8 + hd]); for (int s = 0; s <= t; ++s) o += aq[t * 64 + s] * vn[(size_t)s * 128];
                c.obuf[tt * 1024 + hd * 128 + j] = o; }
            const float dl = expf(glast);
            for (int d = 0; d < 128; ++d) { float a = S[(size_t)d * 128] * dl; for (int t = 0; t < 64; ++t) { const size_t tt = bc * 64 + t; a += c.qkvc[tt * 3072 + 1024 + hd * 128 + d] * expf(glast - c.gcs[tt * 8 + hd]) * vn[(size_t)t * 128]; } S[(size_t)d * 128] = a; } } }
}
__device__ __forceinline__ void s_gdn_out(const Ctx& c, size_t gid, size_t gs) {
    for (size_t i = gid; i < (size_t)T * 1024; i += gs) { const size_t t = i / 1024; const int col = (int)(i % 1024); c.cat[t * 1536 + col] = c.obuf[i] * c.rstd2[t * 8 + col / 128] * c.in[I_OD_NORM][col % 128] * siluf(c.proj[t * PROJ_LD + O_Z + col]); }
}
__device__ __forceinline__ void s_sb(const Ctx& c, size_t gid, size_t gs) {
    for (size_t i = gid; i < (size_t)T * 32; i += gs) { const int qd = (int)(i % 4); const int hd = (int)((i / 4) % 8); const size_t t = i / 32; const int tl = (int)(t % L); const float* q = c.proj + t * PROJ_LD + O_SQ + hd * 64;
        float o[16];
#pragma unroll
        for (int d = 0; d < 16; ++d) o[d] = 0.f;
        float carry = 0.f;
        for (int s = tl - 1; s >= 0 && carry > -150.f; --s) { const size_t ts = t - (size_t)(tl - s); const float* k = c.proj + ts * PROJ_LD + O_SK + hd * 64; const float* v = c.proj + ts * PROJ_LD + O_SV + hd * 64 + qd * 16; float lg = 0.f;
            for (int d = 0; d < 64; ++d) lg += q[d] * k[d];
            lg *= 0.125f; const float wgt = expf(-softplusf(-lg) + carry); carry -= softplusf(lg);
#pragma unroll
            for (int d = 0; d < 16; ++d) o[d] += wgt * v[d]; }
#pragma unroll
        for (int d = 0; d < 16; ++d) c.cat[t * 1536 + 1024 + hd * 64 + qd * 16 + d] = o[d]; }
}
__device__ __forceinline__ void s_final(const Ctx& c, size_t gid, size_t gs) { s_norm(c.h, c.rstd, c.in[I_FINAL_NORM], c.out, T, gid, gs); }

constexpr int XA_BASE = 20, MOE_BASE = 30, L1_BASE = 40, NSTAGE_L = 60;
__device__ __forceinline__ bool run_stage(const Ctx& c, int st, size_t gid, size_t gs) {
    const int layer = st / NSTAGE_L, s = st % NSTAGE_L;
    if (st >= 2 * NSTAGE_L + 2) return false;
    if (st == 2 * NSTAGE_L) { s_rstd(c.h, T, DM, DM, c.rstd, gid, gs); return true; }
    if (st == 2 * NSTAGE_L + 1) { s_final(c, gid, gs); return true; }
    const int l = layer;
    switch (s) {
    case 0: if (l == 0) { s_copy(c.in[I_X], c.h, (size_t)T * DM, gid, gs); s_rstd(c.in[I_MEM], NB * MEM, DM, DM, c.rstd2, gid, gs); } break;
    case 1: if (l == 0) s_norm(c.in[I_MEM], c.rstd2, c.in[I_MEM_NORM], c.memn, NB * MEM, gid, gs); s_rstd(c.h, T, DM, DM, c.rstd, gid, gs); break;
    case 2: s_norm(c.h, c.rstd, c.in[I_NORM_MIX] + l * DM, c.un, T, gid, gs); break;
    case 3: if (l == 0) s_gemm(c.un, DM, c.in[I_EV_WIN], EV_IN, c.proj, PROJ_LD, T, EV_IN, DM, 0, gid, gs); else s_gemm(c.un, DM, c.in[I_OD_WIN], OD_IN, c.proj, PROJ_LD, T, OD_IN, DM, 0, gid, gs); break;
    case 4: if (l == 0) { s_scmix(c, gid, gs); s_ssd_conv(c, gid, gs); s_ssd_dt(c, gid, gs); } else { s_gdn_conv(c, gid, gs); s_gdn_gates(c, gid, gs); s_sb(c, gid, gs); } break;
    case 5: if (l == 0) { s_ssd_states(c, gid, gs); s_ssd_cb(c, gid, gs); } else s_gdn_qkscale(c, gid, gs); break;
    case 6: if (l == 0) s_ssd_scan(c, gid, gs); else s_gdn_kk(c, gid, gs); break;
    case 7: if (l == 0) s_ssd_y(c, gid, gs); else s_gdn_solve(c, gid, gs); break;
    case 8: if (l == 0) s_rstd(c.ybuf, T * 2, 512, 512, c.rstd2, gid, gs); else s_gdn_scan(c, gid, gs); break;
    case 9: if (l == 0) s_ssd_out(c, gid, gs); else s_rstd(c.obuf, T * 8, 128, 128, c.rstd2, gid, gs); break;
    case 10: if (l == 1) s_gdn_out(c, gid, gs); break;
    case 11: s_gemm(c.cat, 1536, l == 0 ? c.in[I_EV_WOUT] : c.in[I_OD_WOUT], DM, c.h, DM, T, DM, 1536, 1, gid, gs); break;
    case 12: s_rstd(c.h, T, DM, DM, c.rstd, gid, gs); break;
    case 13: s_norm(c.h, c.rstd, c.in[I_NORM_XA] + l * DM, c.un, T, gid, gs); break;
    case 14: s_gemm(c.un, DM, c.in[I_XA_WQ] + (size_t)l * DM * DM, DM, c.q, DM, T, DM, DM, 0, gid, gs);
             s_gemm(c.memn, DM, c.in[I_XA_WK] + (size_t)l * DM * DM, DM, c.kx, DM, NB * MEM, DM, DM, 0, gid, gs);
             s_gemm(c.memn, DM, c.in[I_XA_WV] + (size_t)l * DM * DM, DM, c.vx, DM, NB * MEM, DM, DM, 0, gid, gs); break;
    case 15: s_xa_scores(c, gid, gs); break;
    case 16: s_xa_softmax(c, gid, gs); break;
    case 17: s_xa_pv(c, gid, gs); break;
    case 18: s_gemm(c.att, DM, c.in[I_XA_WO] + (size_t)l * DM * DM, DM, c.h, DM, T, DM, DM, 1, gid, gs); break;
    case 19: s_rstd(c.h, T, DM, DM, c.rstd, gid, gs); break;
    case 20: s_norm(c.h, c.rstd, c.in[I_NORM_FFN] + l * DM, c.un, T, gid, gs); break;
    case 21: s_router(c, l, gid, gs); break;
    case 22: s_moe_up(c, l, gid, gs); break;
    case 23: s_moe_down(c, l, gid, gs); break;
    default: break;
    }
    return true;
}
constexpr int N_STAGES_USED = 24;

__host__ __device__ __forceinline__ size_t carve(Ctx& c, float* w) {
    size_t o = 0;
    auto take = [&](size_t n) { float* p = w + o; o += (n + 63) & ~(size_t)63; return p; };
    c.h = take((size_t)T * DM); c.rstd = take(T); c.rstd2 = take((size_t)T * 8); c.memn = take((size_t)MEM * DM); c.kx = take((size_t)MEM * DM); c.vx = take((size_t)MEM * DM);
    c.eid = (int*)take((size_t)T * 2); c.gatew = take((size_t)T * 2); c.dtv = take((size_t)T * 16); c.acs = take((size_t)T * 16); c.beta = take((size_t)T * 8); c.gcs = take((size_t)T * 8);
    c.S = take(8 * 16384); c.vn = take(8 * 8192);
    c.un = take((size_t)T * DM); c.ybuf = c.un; c.obuf = c.un;
    c.proj = take((size_t)T * PROJ_LD);
    c.cat = take((size_t)T * 1536);
    const size_t d0 = o;
    c.xbcc = take((size_t)T * 1536); c.states = take((size_t)NCH * 16 * 8192); c.cb = take((size_t)NCH * 2 * 4096); size_t dmax = o;
    o = d0; c.qkvc = take((size_t)T * 3072); c.Lm = take((size_t)NCH * 8 * 4096); c.aqk = take((size_t)NCH * 8 * 4096); c.uw = take((size_t)NCH * 8 * 64 * 256); if (o > dmax) dmax = o;
    o = d0; c.q = take((size_t)T * DM); c.sc = take((size_t)T * DM); c.att = take((size_t)T * DM); if (o > dmax) dmax = o;
    o = d0; c.act = take((size_t)T * 2 * 512); if (o > dmax) dmax = o;
    return dmax;
}
}

namespace pg8 {
#define PG8_LAS __attribute__((address_space(3)))
typedef unsigned short bf16_t;
typedef short bf16x8 __attribute__((ext_vector_type(8)));
typedef float f32x4 __attribute__((ext_vector_type(4)));
typedef unsigned u32x4 __attribute__((ext_vector_type(4)));
constexpr int BM = 256, BK = 64, HALF = 128, HTB = HALF * BK * 2  , STAGE_BYTES = 8 * HTB, NXCD = 8, WGM = 8;

__host__ __device__ __forceinline__ int lds_byte(int r, int c) { const int st = (r >> 4) * 2 + (c >> 5), rr = r & 15, cc = c & 31, ob = rr * 64 + cc * 2; return st * 1024 + (ob ^ (((ob >> 9) & 1) << 5)); }
__host__ __device__ __forceinline__ void stage_rc(int b, int& R, int& C) { const int st = b / 1024, sb = b % 1024, swz = sb ^ (((sb >> 9) & 1) << 5); R = (st >> 1) * 16 + swz / 64; C = (st & 1) * 32 + (swz % 64) / 2; }
__host__ __device__ __forceinline__ int perm32(int rho) { const int n = rho >> 4, i = rho & 15; return 8 * (i >> 2) + 4 * n + (i & 3); }

struct Unit { int pm, pn, tag; const char* a; const char* b; };
struct Gemm { const bf16_t* A; const bf16_t* Bt; int M, N, K; };

struct StaticOrder {
    int nM, nN, nwg, G, c; const char* A; const char* B; size_t tstep;
    __host__ __device__ void init(const Gemm& g, int G_, int c_) { nM = g.M / BM; nN = g.N / BM; nwg = nM * nN; G = G_; c = c_; A = (const char*)g.A; B = (const char*)g.Bt; tstep = (size_t)BM * g.K * 2; }
    __host__ __device__ bool next(int i, Unit& u) const {
        const long L = (long)i * G + c; if (L >= nwg) return false;
        int wgid = (int)L; { const int q = nwg / NXCD, r = nwg % NXCD, xcd = wgid % NXCD, off = wgid / NXCD; wgid = (xcd < r ? xcd * (q + 1) : r * (q + 1) + (xcd - r) * q) + off; }
        const int nig = WGM * nN, gid = wgid / nig, fm = gid * WGM, gsz = (nM - fm) < WGM ? (nM - fm) : WGM;
        u.pm = fm + ((wgid % nig) % gsz); u.pn = (wgid % nig) / gsz; u.a = A + (size_t)u.pm * tstep; u.b = B + (size_t)u.pn * tstep; return true;
    }
    __device__ __forceinline__ void a_ready(const Unit&) const {}
    __device__ __forceinline__ void done(const Unit&) const {}
};

template <class Epi, class Sched, bool ALIGN_EPI = false, bool SP2 = false>
__device__ __forceinline__ void gemm_phase(PG8_LAS unsigned char* lds, const Gemm g, const Sched& S, const Epi& E) {
    int tid_ = threadIdx.x; asm volatile("" : "+v"(tid_));
    const int tid = tid_, wid = __builtin_amdgcn_readfirstlane(tid >> 6), lane = tid & 63, wr = wid >> 2, wc = wid & 3, fr = lane & 15, fq = lane >> 4;
    const int K = g.K, nt = K / BK;
    unsigned voffA[2], voffB[2];
#pragma unroll
    for (int i = 0; i < 2; ++i) { int R, C; stage_rc(tid * 16 + i * 8192, R, C); const int Rb = Epi::PERM ? ((R & ~31) + perm32(R & 31)) : R;
        voffA[i] = (unsigned)(R * K + C) * 2u; voffB[i] = (unsigned)(Rb * K + C) * 2u; }
    const size_t kstep = (size_t)(BK * 2);
    const size_t hstep = (size_t)HALF * K * 2;
    const unsigned ldsw = (unsigned)wid * 1024u;
    const int aoff = lds_byte(wr * 64 + fr, fq * 8), boff = lds_byte(wc * 32 + fr, fq * 8);
#define PG8_SA(b, h) (((b) * 2 + (h)) * HTB)
#define PG8_SB(b, h) ((4 + (b) * 2 + (h)) * HTB)
#define PG8_STAGE(bufoff, gbase, voff) do { _Pragma("unroll") for (int _i = 0; _i < 2; ++_i) \
        __builtin_amdgcn_global_load_lds((const unsigned*)((const char*)(gbase) + (voff)[_i]), (PG8_LAS unsigned*)(lds + (bufoff) + ldsw + _i * 8192), 16, 0, 0); } while (0)
#define PG8_LDA(dst, b, h) do { _Pragma("unroll") for (int m = 0; m < 4; ++m) _Pragma("unroll") for (int k = 0; k < 2; ++k) dst[m][k] = *(const PG8_LAS bf16x8*)(lds + PG8_SA(b, h) + aoff + m * 2048 + k * 1024); } while (0)
#define PG8_LDB(dst, b, h) do { _Pragma("unroll") for (int n = 0; n < 2; ++n) _Pragma("unroll") for (int k = 0; k < 2; ++k) dst[n][k] = *(const PG8_LAS bf16x8*)(lds + PG8_SB(b, h) + boff + n * 2048 + k * 1024); } while (0)
#define PG8_MMA(ai, bj, At, Bt) do { __builtin_amdgcn_s_setprio(1); _Pragma("unroll") for (int m = 0; m < 4; ++m) _Pragma("unroll") for (int n = 0; n < 2; ++n) _Pragma("unroll") for (int k = 0; k < 2; ++k) \
        acc[ai][bj][m][n] = __builtin_amdgcn_mfma_f32_16x16x32_bf16(Bt[n][k], At[m][k], acc[ai][bj][m][n], 0, 0, 0); __builtin_amdgcn_s_setprio(0); } while (0)
#define PG8_WAIT_V(n) asm volatile("s_waitcnt vmcnt(" #n ")" ::: "memory")
#define PG8_WAIT_L(n) asm volatile("s_waitcnt lgkmcnt(" #n ")" ::: "memory")
#define PG8_BAR __builtin_amdgcn_s_barrier()
#define PG8_SCHED __builtin_amdgcn_sched_barrier(0)
    Unit cur, nxt; int ui = 0;
    if (!S.next(0, cur)) return;
    f32x4 acc[2][2][4][2];
#pragma unroll
    for (int a = 0; a < 2; ++a)
#pragma unroll
        for (int b = 0; b < 2; ++b)
#pragma unroll
            for (int m = 0; m < 4; ++m)
#pragma unroll
                for (int n = 0; n < 2; ++n) acc[a][b][m][n] = (f32x4){0.f, 0.f, 0.f, 0.f};
    bf16x8 At[4][2], B0[2][2], B1[2][2];
    const char* cA = cur.a; const char* cB = cur.b;
    S.a_ready(cur);
    if constexpr (SP2) {
        PG8_STAGE(PG8_SB(0, 0), cB, voffB); PG8_STAGE(PG8_SB(0, 1), cB + hstep, voffB); PG8_STAGE(PG8_SA(0, 0), cA, voffA); PG8_STAGE(PG8_SA(0, 1), cA + hstep, voffA);
        if (wr == 1) PG8_BAR;
        PG8_WAIT_V(2); PG8_BAR;
        PG8_STAGE(PG8_SB(1, 0), cB + kstep, voffB); PG8_STAGE(PG8_SA(1, 0), cA + kstep, voffA); PG8_STAGE(PG8_SB(1, 1), cB + hstep + kstep, voffB);
        PG8_WAIT_V(6); PG8_BAR;
    } else {
        PG8_STAGE(PG8_SB(0, 0), cB, voffB); PG8_STAGE(PG8_SA(0, 0), cA, voffA); PG8_STAGE(PG8_SB(0, 1), cB + hstep, voffB); PG8_STAGE(PG8_SA(0, 1), cA + hstep, voffA);
        if (wr == 1) PG8_BAR;
        PG8_WAIT_V(4); PG8_BAR;
        PG8_STAGE(PG8_SB(1, 0), cB + kstep, voffB); PG8_STAGE(PG8_SA(1, 0), cA + kstep, voffA); PG8_STAGE(PG8_SB(1, 1), cB + hstep + kstep, voffB);
        PG8_WAIT_V(6); PG8_BAR;
    }
    for (;;) {
        const bool has_next = S.next(ui + 1, nxt);
        const char* nA = has_next ? nxt.a : cA; const char* nB = has_next ? nxt.b : cB;
        for (int t = 0; t < nt; t += 2) {
            const bool last = (t == nt - 2);
            const char* a1 = cA + (size_t)(t + 1) * kstep;
            const char* a2 = last ? nA : cA + (size_t)(t + 2) * kstep; const char* b2 = last ? nB : cB + (size_t)(t + 2) * kstep;
            const char* a3 = a2 + kstep; const char* b3 = b2 + kstep;
            if (last && has_next) S.a_ready(nxt);
            if constexpr (SP2) {
            PG8_LDB(B0, 0, 0); PG8_LDB(B1, 0, 1); PG8_SCHED; PG8_LDA(At, 0, 0); PG8_STAGE(PG8_SA(1, 1), a1 + hstep, voffA);
            PG8_WAIT_V(8); PG8_WAIT_L(0); PG8_BAR; PG8_MMA(0, 0, At, B0); PG8_MMA(0, 1, At, B1); PG8_BAR; PG8_SCHED;
            PG8_LDA(At, 0, 1); PG8_STAGE(PG8_SB(0, 0), b2, voffB); PG8_STAGE(PG8_SB(0, 1), b2 + hstep, voffB); PG8_STAGE(PG8_SA(0, 0), a2, voffA);
            PG8_WAIT_V(8); PG8_WAIT_L(0); PG8_BAR; PG8_MMA(1, 0, At, B0); PG8_MMA(1, 1, At, B1); PG8_BAR; PG8_SCHED;
            PG8_LDB(B0, 1, 0); PG8_LDB(B1, 1, 1); PG8_SCHED; PG8_LDA(At, 1, 0); PG8_STAGE(PG8_SA(0, 1), a2 + hstep, voffA);
            PG8_WAIT_V(8); PG8_WAIT_L(0); PG8_BAR; PG8_MMA(0, 0, At, B0); PG8_MMA(0, 1, At, B1); PG8_BAR; PG8_SCHED;
            PG8_LDA(At, 1, 1); PG8_STAGE(PG8_SB(1, 0), b3, voffB); PG8_STAGE(PG8_SB(1, 1), b3 + hstep, voffB); PG8_STAGE(PG8_SA(1, 0), a3, voffA);
            PG8_WAIT_V(8); PG8_WAIT_L(0); PG8_BAR; PG8_MMA(1, 0, At, B0); PG8_MMA(1, 1, At, B1); PG8_BAR; PG8_SCHED;
            } else {
            PG8_LDB(B0, 0, 0); PG8_SCHED; PG8_LDA(At, 0, 0); PG8_STAGE(PG8_SA(1, 1), a1 + hstep, voffA);
            PG8_WAIT_L(8); PG8_BAR; PG8_WAIT_L(0); PG8_MMA(0, 0, At, B0); PG8_BAR; PG8_SCHED;
            PG8_LDB(B1, 0, 1); PG8_STAGE(PG8_SB(0, 0), b2, voffB);
            PG8_BAR; PG8_WAIT_L(0); PG8_MMA(0, 1, At, B1); PG8_BAR;
            PG8_LDA(At, 0, 1); PG8_STAGE(PG8_SA(0, 0), a2, voffA);
            PG8_BAR; PG8_WAIT_L(0); PG8_MMA(1, 0, At, B0); PG8_BAR; PG8_SCHED;
            PG8_STAGE(PG8_SB(0, 1), b2 + hstep, voffB);
            PG8_WAIT_V(6); PG8_BAR; PG8_MMA(1, 1, At, B1); PG8_BAR;
            PG8_LDB(B0, 1, 0); PG8_SCHED; PG8_LDA(At, 1, 0); PG8_STAGE(PG8_SA(0, 1), a2 + hstep, voffA);
            PG8_WAIT_L(8); PG8_BAR; PG8_WAIT_L(0); PG8_MMA(0, 0, At, B0); PG8_BAR; PG8_SCHED;
            PG8_LDB(B1, 1, 1); PG8_STAGE(PG8_SB(1, 0), b3, voffB);
            PG8_BAR; PG8_WAIT_L(0); PG8_MMA(0, 1, At, B1); PG8_BAR;
            PG8_LDA(At, 1, 1); PG8_STAGE(PG8_SA(1, 0), a3, voffA);
            PG8_BAR; PG8_WAIT_L(0); PG8_MMA(1, 0, At, B0); PG8_BAR; PG8_SCHED;
            PG8_STAGE(PG8_SB(1, 1), b3 + hstep, voffB);
            PG8_WAIT_V(6); PG8_BAR; PG8_MMA(1, 1, At, B1); PG8_BAR;
            }
        }
        if constexpr (ALIGN_EPI) { if (wr == 0) PG8_BAR; }
        if constexpr (!Epi::AFTER_DRAIN) { E(acc, cur, wr, wc, fr, fq); S.done(cur); }
        if (!has_next) break;
#pragma unroll
        for (int a = 0; a < 2; ++a)
#pragma unroll
            for (int b = 0; b < 2; ++b)
#pragma unroll
                for (int m = 0; m < 4; ++m)
#pragma unroll
                    for (int n = 0; n < 2; ++n) acc[a][b][m][n] = (f32x4){0.f, 0.f, 0.f, 0.f};
        cur = nxt; cA = nA; cB = nB; ++ui;
        if constexpr (ALIGN_EPI) { if (wr == 1) PG8_BAR; }
    }
    PG8_WAIT_V(0);
    if constexpr (!ALIGN_EPI) { if (wr == 0) PG8_BAR; }
    PG8_BAR;
    if constexpr (Epi::AFTER_DRAIN) { E.fused(acc, cur, wr, wc, fr, fq, lds, wid, lane); S.done(cur); }
#undef PG8_SA
#undef PG8_SB
#undef PG8_STAGE
#undef PG8_LDA
#undef PG8_LDB
#undef PG8_MMA
#undef PG8_WAIT_V
#undef PG8_WAIT_L
#undef PG8_BAR
#undef PG8_SCHED
}
}

namespace ok {
using pg8::bf16_t; using pg8::bf16x8; using pg8::f32x4; using pg8::u32x4;
typedef unsigned u32x2 __attribute__((ext_vector_type(2)));
typedef float f32x2 __attribute__((ext_vector_type(2)));
#ifndef SEQ
#define SEQ 8192
#endif
constexpr int NB = 2, L = SEQ, NCH = L / 64, T = NB * L, DM = 1024, NWAVES = 8, NT = 512;
constexpr float EPS = 1e-6f, LOG2E = 1.4426950408889634f;
constexpr size_t MiB = 1u << 20, KiB = 1024;
constexpr size_t WS_CTL = 0, CTL_BYTES = 1 * MiB;
constexpr int CW_BAR = 0;
constexpr int CW_SSQ = 16384;
constexpr int CW_MOE = 16384 + 6 * T;
constexpr int CW_CHK = CW_MOE + 256;
static_assert((CW_CHK + 64) * 4 <= (int)CTL_BYTES, "ctl");
constexpr size_t WS_WDT = 1 * MiB, WS_WAB = WS_WDT + 64 * KiB, WS_WR = WS_WAB + 64 * KiB;
constexpr size_t WS_DTV = 2 * MiB, WS_ACS = 3 * MiB, WS_GCS = 4 * MiB, WS_BETA = 4 * MiB + 512 * KiB;
constexpr size_t WS_RAW16 = WS_DTV;
constexpr size_t WS_EID = 5 * MiB, WS_GATEW = WS_EID + 128 * KiB, WS_TOKSLOT = WS_GATEW + 128 * KiB, WS_SLOTTOK = WS_TOKSLOT + 128 * KiB, WS_SLOTGATE = WS_SLOTTOK + 160 * KiB,
                 WS_SLOTRSTD = WS_SLOTGATE + 160 * KiB, WS_TILEEXP = WS_SLOTRSTD + 160 * KiB;
constexpr size_t WS_FP = 8 * MiB;
constexpr size_t WS_W_IN0 = 16 * MiB, WS_W_IN1 = 24 * MiB, WS_W_OUT0 = 35 * MiB, WS_W_OUT1 = 38 * MiB, WS_W_XA = 41 * MiB  ;
constexpr size_t WS_MEMNB = 57 * MiB, WS_KX = 58 * MiB  , WS_VT = 60 * MiB  ;
constexpr size_t WS_H = 64 * MiB, WS_HB = 128 * MiB, WS_MOEW = 160 * MiB, WS_BIG = 256 * MiB;
constexpr size_t WS_PROJ = WS_BIG;
constexpr size_t WS_CAT0 = 384 * MiB, WS_STATES = 432 * MiB;
constexpr size_t WS_CAT1 = 432 * MiB;
constexpr size_t WS_Q = WS_BIG, WS_ATT = WS_BIG + 32 * MiB;
constexpr size_t WS_XS = WS_BIG, WS_ACT = WS_BIG + 80 * MiB, WS_Y = WS_BIG + 120 * MiB;
constexpr size_t WS_END = 528 * MiB;
constexpr int PROJ0_LD = 4096, PROJ1_LD = 5632, MAXSLOT = 40960;

#ifdef CPU_EMU
__device__ __forceinline__ float fexp(float x) { return expf(x); }
__device__ __forceinline__ float fexp2(float x) { return exp2f(x); }
__device__ __forceinline__ float frcp(float x) { return 1.f / x; }
__device__ __forceinline__ float frsq(float x) { return 1.f / sqrtf(x); }
#else
__device__ __forceinline__ float fexp(float x) { return __builtin_amdgcn_exp2f(x * 1.4426950408889634f); }
__device__ __forceinline__ float fexp2(float x) { return __builtin_amdgcn_exp2f(x); }
__device__ __forceinline__ float frcp(float x) { return __builtin_amdgcn_rcpf(x); }
__device__ __forceinline__ float frsq(float x) { return __builtin_amdgcn_rsqf(x); }
#endif
#ifdef CPU_EMU
#define LAS
#define GAS
#define LDS_WAIT() do {} while (0)
#define WAVE_SYNC() ((void)__shfl(0, 0))
#define LDS_BARRIER() __syncthreads()
#define SCHED_FENCE() do {} while (0)
__device__ __forceinline__ unsigned cvt_pk_bf16(float lo, float hi) { return emu_f2bf(lo) | (emu_f2bf(hi) << 16); }
#else
#define LAS __attribute__((address_space(3)))
#define GAS __attribute__((address_space(1)))
#define LDS_WAIT() asm volatile("s_waitcnt lgkmcnt(0)" ::: "memory")
#define LDS_BARRIER() do { asm volatile("s_waitcnt lgkmcnt(0)" ::: "memory"); __builtin_amdgcn_s_barrier(); asm volatile("" ::: "memory"); } while (0)
#define SCHED_FENCE() __builtin_amdgcn_sched_barrier(0)
#define WAVE_SYNC() do { asm volatile("s_waitcnt lgkmcnt(0)" ::: "memory"); __builtin_amdgcn_wave_barrier(); } while (0)
typedef __bf16 hwbf16x2 __attribute__((ext_vector_type(2)));
__device__ __forceinline__ unsigned cvt_pk_bf16(float lo, float hi) { const f32x2 v = {lo, hi}; return __builtin_bit_cast(unsigned, __builtin_convertvector(v, hwbf16x2)); }
#endif
__device__ __forceinline__ float bf2f(unsigned short b) { return __uint_as_float(((unsigned)b) << 16); }
__device__ __forceinline__ float bflo(unsigned w) { return __uint_as_float(w << 16); }
__device__ __forceinline__ float bfhi(unsigned w) { return __uint_as_float(w & 0xffff0000u); }
__device__ __forceinline__ float wave_sum(float v) {
#pragma unroll
    for (int o = 1; o < 64; o <<= 1) v += __shfl_xor(v, o);
    return v;
}
__device__ __forceinline__ f32x4 mfma16(bf16x8 a, bf16x8 b, f32x4 c) { return __builtin_amdgcn_mfma_f32_16x16x32_bf16(a, b, c, 0, 0, 0); }

struct Frame {
    LAS unsigned char* lds;
    unsigned* ctl;
    unsigned char* ws;
    const float* const* in;
    float* out;
    int tid, lane, wave, vcu, G;
};
constexpr size_t WS_SSQP1 = 6 * MiB, WS_SSQP2 = 7 * MiB, WS_SSQP4 = 62 * MiB, WS_SSQP5 = 63 * MiB;
__device__ __forceinline__ float rstd_np(const float* p, int np, int row) { float s; if (np == 1) s = p[row]; else { const f32x4* q = (const f32x4*)(p + (size_t)row * 16); const f32x4 a = q[0], b = q[1], c = q[2], d = q[3]; s = ((a.x + a.y) + (a.z + a.w)) + ((b.x + b.y) + (b.z + b.w)) + (((c.x + c.y) + (c.z + c.w)) + ((d.x + d.y) + (d.z + d.w))); }
    return frsq(s * (1.f / 1024.f) + EPS); }
#define OKP(type, off) ((type*)(F.ws + (off)))
#ifdef CPU_EMU
__device__ __forceinline__ Frame phase_frame(const Frame& F0) { return F0; }
#else
__device__ __forceinline__ Frame phase_frame(const Frame& F0) { Frame F = F0; int t = threadIdx.x; asm volatile("" : "+v"(t)); F.tid = t; F.lane = t & 63; F.wave = __builtin_amdgcn_readfirstlane(t >> 6); return F; }
#endif

__device__ __forceinline__ void cvt_item(const float* W, int ldw, int K, int k0, int c0, bf16_t* WT, int drow0, int dstep16, const float* kgain, float cscale, LAS float* scr, int lane) {
    float wv[32];
#pragma unroll
    for (int i = 0; i < 32; ++i) wv[i] = W[(size_t)(k0 + 2 * i + (lane >> 5)) * ldw + c0 + (lane & 31)];
#pragma unroll
    for (int i = 0; i < 32; ++i) { const int kk = 2 * i + (lane >> 5); const float g = kgain ? kgain[k0 + kk] * cscale : cscale; scr[kk * 33 + (lane & 31)] = wv[i] * g; }
    LDS_WAIT();
    const int c = lane & 7;
#pragma unroll
    for (int j = 0; j < 4; ++j) { const int n = (lane >> 3) + 8 * j; const LAS float* s = scr + (8 * c) * 33 + n;
        u32x4 o; o.x = cvt_pk_bf16(s[0 * 33], s[1 * 33]); o.y = cvt_pk_bf16(s[2 * 33], s[3 * 33]); o.z = cvt_pk_bf16(s[4 * 33], s[5 * 33]); o.w = cvt_pk_bf16(s[6 * 33], s[7 * 33]);
        *(u32x4*)(WT + (size_t)(drow0 + (n >> 4) * dstep16 + (n & 15)) * K + k0 + 8 * c) = o; }
    LDS_WAIT();
}
struct CvtJob { const float* W; int ldw, K, ncols, c0; bf16_t* WT; int drow0, dstep16; const float* kgain; float cscale; };
__device__ __forceinline__ int job_items(const CvtJob& j) { return (j.K / 64) * (j.ncols / 32); }
__device__ __forceinline__ void run_job_item(const CvtJob& j, int item, LAS float* scr, int lane) {
    const int nblk = j.ncols / 32, kb = item / nblk, nb = item % nblk;
    cvt_item(j.W, j.ldw, j.K, 64 * kb, j.c0 + 32 * nb, j.WT, j.drow0 + (32 * nb >> 4) * j.dstep16, j.dstep16, j.kgain, j.cscale, scr, lane);
}
__device__ __forceinline__ CvtJob dense_job(const Frame& F, int j) {
    using namespace sm;
    const float* const* in = F.in;
    switch (j) {
    case 0: return CvtJob{in[I_EV_WIN], 4112, 1024, 4096, 0, OKP(bf16_t, WS_W_IN0), 0, 16, in[I_NORM_MIX], 1.f};
    case 1: return CvtJob{in[I_OD_WIN], 5648, 1024, 4096, 0, OKP(bf16_t, WS_W_IN1), 0, 16, in[I_NORM_MIX] + 1024, 1.f};
    case 2: return CvtJob{in[I_OD_WIN], 5648, 1024, 512, 4112, OKP(bf16_t, WS_W_IN1), 4096, 16, in[I_NORM_MIX] + 1024, 0.125f * LOG2E};
    case 3: return CvtJob{in[I_OD_WIN], 5648, 1024, 1024, 4624, OKP(bf16_t, WS_W_IN1), 4608, 16, in[I_NORM_MIX] + 1024, 1.f};
    case 4: return CvtJob{in[I_EV_WOUT], 1024, 1536, 1024, 0, OKP(bf16_t, WS_W_OUT0), 0, 16, nullptr, 1.f};
    case 5: return CvtJob{in[I_OD_WOUT], 1024, 1536, 1024, 0, OKP(bf16_t, WS_W_OUT1), 0, 16, nullptr, 1.f};
    default: { const int l = (j - 6) / 4, w = (j - 6) % 4; bf16_t* dst = OKP(bf16_t, WS_W_XA + (size_t)l * 8 * MiB + (size_t)w * 2 * MiB);
        const float* src = in[I_XA_WQ + w] + (size_t)l * 1024 * 1024;
        if (w == 0) return CvtJob{src, 1024, 1024, 1024, 0, dst, 0, 16, in[I_NORM_XA] + l * 1024, 0.0625f * LOG2E};
        return CvtJob{src, 1024, 1024, 1024, 0, dst, 0, 16, nullptr, 1.f}; }
    }
}
constexpr int N_DENSE_JOBS = 14;
__device__ __forceinline__ CvtJob moe_job(const Frame& F, int l, int j) {
    using namespace sm;
    const int e = j / 3, w = j % 3; const float* const* in = F.in;
    bf16_t* gu = OKP(bf16_t, WS_MOEW + (size_t)e * 3 * MiB); bf16_t* dn = gu + 1024 * 1024;
    if (w == 0) return CvtJob{in[I_MOE_WGATE] + ((size_t)l * 32 + e) * 1024 * 512, 512, 1024, 512, 0, gu, 0, 32, in[I_NORM_FFN] + l * 1024, 1.f};
    if (w == 1) return CvtJob{in[I_MOE_WUP] + ((size_t)l * 32 + e) * 1024 * 512, 512, 1024, 512, 0, gu, 16, 32, in[I_NORM_FFN] + l * 1024, 1.f};
    return CvtJob{in[I_MOE_WDOWN] + ((size_t)l * 32 + e) * 512 * 1024, 1024, 512, 1024, 0, dn, 0, 16, nullptr, 1.f};
}
__device__ __forceinline__ void phase_cvt_dense(const Frame& F0) {
    const Frame F = phase_frame(F0);
    LAS float* scr = (LAS float*)(F.lds + F.wave * 16384);
    const int gw = F.vcu * NWAVES + F.wave, NGW = F.G * NWAVES;
    int base = 0;
    for (int j = 0; j < N_DENSE_JOBS; ++j) { const CvtJob job = dense_job(F, j); const int n = job_items(job);
        for (int it = ((gw - base) % NGW + NGW) % NGW; it < n; it += NGW) run_job_item(job, it, scr, F.lane);
        base += n; }
}
__device__ __forceinline__ void phase_cvt_moe(const Frame& F0, int l) {
    const Frame F = phase_frame(F0);
    LAS float* scr = (LAS float*)(F.lds + F.wave * 16384);
    const int gw = F.vcu * NWAVES + F.wave, NGW = F.G * NWAVES;
    for (int it = gw; it < 96 * 256; it += NGW) { const CvtJob job = moe_job(F, l, it >> 8); run_job_item(job, it & 255, scr, F.lane); }
}
__device__ __forceinline__ void row_to_bf16_ssq(const float* xrow, bf16_t* orow, float* ssq, int lane) {
    const f32x4* xr = (const f32x4*)xrow + lane; float s = 0.f; f32x4 v[4];
#pragma unroll
    for (int j = 0; j < 4; ++j) { v[j] = xr[64 * j]; s += (v[j].x * v[j].x + v[j].y * v[j].y) + (v[j].z * v[j].z + v[j].w * v[j].w); }
    s = wave_sum(s);
    u32x2* o8 = (u32x2*)orow + lane;
#pragma unroll
    for (int j = 0; j < 4; ++j) { u32x2 w; w.x = cvt_pk_bf16(v[j].x, v[j].y); w.y = cvt_pk_bf16(v[j].z, v[j].w); o8[64 * j] = w; }
    if (lane == 0) *ssq = s;
}
__device__ __forceinline__ void phase_prologue(const Frame& F0) {
    const Frame F = phase_frame(F0);
    using namespace sm;
    phase_cvt_dense(F0);
    const int gw = F.vcu * NWAVES + F.wave, NGW = F.G * NWAVES;
    float* ssq0 = (float*)F.ctl + CW_SSQ;
    for (int m = gw; m < T; m += NGW) row_to_bf16_ssq(F.in[I_X] + (size_t)m * DM, OKP(bf16_t, WS_HB) + (size_t)m * DM, ssq0 + m, F.lane);
    for (int m = gw; m < NB * 256; m += NGW) { const f32x4* xr = (const f32x4*)(F.in[I_MEM] + (size_t)m * DM) + F.lane; const f32x4* gr = (const f32x4*)F.in[I_MEM_NORM] + F.lane; float s = 0.f; f32x4 v[4];
#pragma unroll
        for (int j = 0; j < 4; ++j) { v[j] = xr[64 * j]; s += (v[j].x * v[j].x + v[j].y * v[j].y) + (v[j].z * v[j].z + v[j].w * v[j].w); }
        const float r = 1.f / sqrtf(wave_sum(s) * (1.f / DM) + EPS);
        u32x2* o8 = (u32x2*)(OKP(bf16_t, WS_MEMNB) + (size_t)m * DM) + F.lane;
#pragma unroll
        for (int j = 0; j < 4; ++j) { const f32x4 g = gr[64 * j]; u32x2 w; w.x = cvt_pk_bf16(v[j].x * r * g.x, v[j].y * r * g.y); w.y = cvt_pk_bf16(v[j].z * r * g.z, v[j].w * r * g.w); o8[64 * j] = w; } }
    const size_t gt = (size_t)F.vcu * NT + F.tid, GT = (size_t)F.G * NT;
    for (size_t i = gt; i < 1024 * 16; i += GT) { const int k = (int)(i >> 4), j = (int)(i & 15);
        OKP(float, WS_WDT)[j * 1024 + k] = F.in[I_NORM_MIX][k] * F.in[I_EV_WIN][(size_t)k * 4112 + 4096 + j];
        OKP(float, WS_WAB)[j * 1024 + k] = F.in[I_NORM_MIX][1024 + k] * F.in[I_OD_WIN][(size_t)k * 5648 + 4096 + j]; }
}

#ifndef CPU_EMU
struct EpiScaleBf16 {
    static constexpr bool PERM = true, AFTER_DRAIN = false;
    bf16_t* O; int ldc; const float* ssq; int np;
    __device__ __forceinline__ void operator()(const f32x4 (&acc)[2][2][4][2], const pg8::Unit& u, int wr, int wc, int fr, int fq) const {
        const int row0 = u.pm * 256 + wr * 64 + fr, col0 = u.pn * 256 + wc * 32 + 8 * fq;
#pragma unroll
        for (int ai = 0; ai < 2; ++ai)
#pragma unroll
            for (int m = 0; m < 4; ++m) { const int row = row0 + ai * 128 + m * 16; const float s = ssq ? rstd_np(ssq, np, row) : 1.f; bf16_t* rowp = O + (size_t)row * ldc + col0;
#pragma unroll
                for (int bj = 0; bj < 2; ++bj) { const f32x4 v0 = acc[ai][bj][m][0] * s, v1 = acc[ai][bj][m][1] * s; u32x4 w; w.x = cvt_pk_bf16(v0[0], v0[1]); w.y = cvt_pk_bf16(v0[2], v0[3]); w.z = cvt_pk_bf16(v1[0], v1[1]); w.w = cvt_pk_bf16(v1[2], v1[3]);
                    *(u32x4*)(rowp + bj * 128) = w; } }
    }
};
template <bool HIN_F32> struct EpiResidualT {
    static constexpr bool PERM = false, AFTER_DRAIN = false;
    const float* hin; bf16_t* hb; float* ssq;
    __device__ __forceinline__ void operator()(const f32x4 (&acc)[2][2][4][2], const pg8::Unit& u, int wr, int wc, int fr, int fq) const {
        const int row0 = u.pm * 256 + wr * 64 + fr, col0 = u.pn * 256 + wc * 32 + 4 * fq;
#pragma unroll
        for (int ai = 0; ai < 2; ++ai)
#pragma unroll
            for (int m = 0; m < 4; ++m) { const int row = row0 + ai * 128 + m * 16; const size_t ro = (size_t)row * DM + col0; float s = 0.f;
#pragma unroll
                for (int bj = 0; bj < 2; ++bj)
#pragma unroll
                    for (int n = 0; n < 2; ++n) { const size_t o = ro + bj * 128 + n * 16; f32x4 v;
                        if (HIN_F32) v = *(const f32x4*)(hin + o); else { const u32x2 hw = *(const u32x2*)(hb + o); v = (f32x4){bflo(hw.x), bfhi(hw.x), bflo(hw.y), bfhi(hw.y)}; }
                        v += acc[ai][bj][m][n];
                        u32x2 w; w.x = cvt_pk_bf16(v[0], v[1]); w.y = cvt_pk_bf16(v[2], v[3]); *(u32x2*)(hb + o) = w;
                        const float r0 = bflo(w.x), r1 = bfhi(w.x), r2 = bflo(w.y), r3 = bfhi(w.y); s += (r0 * r0 + r1 * r1) + (r2 * r2 + r3 * r3); }
                s += __shfl_xor(s, 16); s += __shfl_xor(s, 32);
                if (fq == 0) ssq[(size_t)row * 16 + u.pn * 4 + wc] = s; }
    }
};

template <class Epi> __device__ __forceinline__ void dense_gemm(const Frame& F, const bf16_t* A, const bf16_t* Bt, int M, int N, int K, const Epi& E) {
    pg8::Gemm g{A, Bt, M, N, K}; pg8::StaticOrder S; S.init(g, F.G, (int)blockIdx.x);
    pg8::gemm_phase<Epi, pg8::StaticOrder, true, true>(F.lds, g, S, E);
}
#endif
}

namespace ok {
constexpr int XT_LD = 72;
constexpr int BC_LD = 136;
__device__ __forceinline__ float siluf(float x) { return x * frcp(1.f + fexp(-x)); }
__device__ __forceinline__ float softplusf(float x) { return x > 20.f ? x : log1pf(expf(x)); }

template <class Sink> __device__ __forceinline__ void ssd_conv_pair(const Frame& F, int b, int c, int xc, Sink&& sink) {
    using namespace sm;
    const float* cw = F.in[I_EV_CONVW]; const f32x2 w0 = *(const f32x2*)(cw + xc), w1 = *(const f32x2*)(cw + 1536 + xc), w2 = *(const f32x2*)(cw + 3072 + xc), w3 = *(const f32x2*)(cw + 4608 + xc), bias = *(const f32x2*)(F.in[I_EV_CONVB] + xc);
    const bf16_t* p = OKP(bf16_t, WS_PROJ) + (size_t)(b * L + c * 64) * PROJ0_LD + 2560 + xc;
    unsigned raw[64];
#pragma unroll
    for (int t = 0; t < 64; ++t) raw[t] = *(const unsigned*)(p + (size_t)t * PROJ0_LD);
    f32x2 x0 = {0.f, 0.f}, x1 = x0, x2 = x0;
    if (c > 0) { const unsigned a = *(const unsigned*)(p - 3 * PROJ0_LD), bq = *(const unsigned*)(p - 2 * PROJ0_LD), cq = *(const unsigned*)(p - PROJ0_LD); x0 = (f32x2){bflo(a), bfhi(a)}; x1 = (f32x2){bflo(bq), bfhi(bq)}; x2 = (f32x2){bflo(cq), bfhi(cq)}; }
#pragma unroll
    for (int t = 0; t < 64; t += 2) { const f32x2 x3 = {bflo(raw[t]), bfhi(raw[t])}, x4 = {bflo(raw[t + 1]), bfhi(raw[t + 1])};
        const f32x2 v0 = bias + w0 * x0 + w1 * x1 + w2 * x2 + w3 * x3, v1 = bias + w0 * x1 + w1 * x2 + w2 * x3 + w3 * x4;
        sink(t, siluf(v0.x), siluf(v1.x), siluf(v0.y), siluf(v1.y)); x0 = x2; x1 = x3; x2 = x4; }
}

__device__ __forceinline__ void phase_ssd_a(const Frame& F0) {
    const Frame F = phase_frame(F0);
    using namespace sm;
    LAS bf16_t* XT = (LAS bf16_t*)F.lds; LAS bf16_t* BT = (LAS bf16_t*)(F.lds + 73728);
    LAS float* dt_s = (LAS float*)(F.lds + 92160); LAS float* acs_s = (LAS float*)(F.lds + 94208); LAS float* sc_s = (LAS float*)(F.lds + 96256);
    const int tid = F.tid, lane = F.lane, wave = F.wave;
    for (int u = F.vcu; u < NB * NCH * 2; u += F.G) {
        const int g = u & 1, bc = u >> 1, b = bc / NCH, c = bc % NCH; const size_t row0 = (size_t)b * L + c * 64;
        LDS_BARRIER();
        if (tid < 320) { const int ci = tid * 2;
            const int xc = ci < 512 ? g * 512 + ci : 1024 + g * 128 + (ci - 512);
            LAS unsigned* dst = (LAS unsigned*)(ci < 512 ? XT + ci * XT_LD : BT + (ci - 512) * XT_LD);
            ssd_conv_pair(F, b, c, xc, [&](int t, float a0, float a1, float b0, float b1) { dst[t >> 1] = cvt_pk_bf16(a0, a1); dst[XT_LD / 2 + (t >> 1)] = cvt_pk_bf16(b0, b1); });
        }
        { const int t = tid & 63, hh = tid >> 6, hd = g * 8 + hh; const float dt = softplusf(OKP(float, WS_RAW16)[(row0 + t) * 16 + hd] + F.in[I_EV_DTB][hd]); dt_s[hh * 64 + t] = dt; acs_s[hh * 64 + t] = dt * -expf(F.in[I_EV_ALOG][hd]); }
        LDS_BARRIER();
        { const int hh = wave, hd = g * 8 + hh; float v = acs_s[hh * 64 + lane];
#pragma unroll
          for (int o = 1; o < 64; o <<= 1) { const float n = __shfl_up(v, o); if (lane >= o) v += n; }
          const float last = __shfl(v, 63); const float dt = dt_s[hh * 64 + lane];
          sc_s[hh * 64 + lane] = dt * fexp(last - v);
          OKP(float, WS_DTV)[(row0 + lane) * 16 + hd] = dt; OKP(float, WS_ACS)[(row0 + lane) * 16 + hd] = v; }
        WAVE_SYNC();
#if defined(CHECK_DUMP)
        if (bc == 5 && g == 0) {
            float* f3 = OKP(float, WS_FP) + (size_t)3 * 16 * 6144; float* f4 = OKP(float, WS_FP) + (size_t)4 * 16 * 6144; float* f5 = OKP(float, WS_FP) + (size_t)5 * 16 * 6144;
            for (int i = tid; i < 512 * 64; i += NT) f3[i] = bf2f(XT[(i >> 6) * XT_LD + (i & 63)]);
            for (int i = tid; i < 128 * 64; i += NT) f4[i] = bf2f(BT[(i >> 6) * XT_LD + (i & 63)]);
            f5[wave * 64 + lane] = sc_s[wave * 64 + lane];
        }
#endif
        { const int hh = wave, hd = g * 8 + hh, fr = lane & 15, fq = lane >> 4;
          bf16x8 xa[4][2];
#pragma unroll
          for (int pt = 0; pt < 4; ++pt)
#pragma unroll
              for (int ks = 0; ks < 2; ++ks) { const u32x4 raw = *(const LAS u32x4*)(XT + (hh * 64 + pt * 16 + fr) * XT_LD + ks * 32 + fq * 8); const LAS float* sp = sc_s + hh * 64 + ks * 32 + fq * 8;
                  const f32x4 s0 = *(const LAS f32x4*)sp, s1 = *(const LAS f32x4*)(sp + 4); u32x4 o;
                  o.x = cvt_pk_bf16(bflo(raw.x) * s0.x, bfhi(raw.x) * s0.y); o.y = cvt_pk_bf16(bflo(raw.y) * s0.z, bfhi(raw.y) * s0.w);
                  o.z = cvt_pk_bf16(bflo(raw.z) * s1.x, bfhi(raw.z) * s1.y); o.w = cvt_pk_bf16(bflo(raw.w) * s1.z, bfhi(raw.w) * s1.w);
                  xa[pt][ks] = __builtin_bit_cast(bf16x8, o); }
          bf16_t* st = OKP(bf16_t, WS_STATES) + ((size_t)bc * 16 + hd) * 8192;
#pragma unroll
          for (int nt = 0; nt < 8; ++nt) { bf16x8 bb[2];
#pragma unroll
              for (int ks = 0; ks < 2; ++ks) bb[ks] = *(const LAS bf16x8*)(BT + (nt * 16 + fr) * XT_LD + ks * 32 + fq * 8);
#pragma unroll
              for (int pt = 0; pt < 4; ++pt) { f32x4 acc = {0.f, 0.f, 0.f, 0.f};
#pragma unroll
                  for (int ks = 0; ks < 2; ++ks) acc = mfma16(bb[ks], xa[pt][ks], acc);
                  u32x2 w; w.x = cvt_pk_bf16(acc[0], acc[1]); w.y = cvt_pk_bf16(acc[2], acc[3]);
                  *(u32x2*)(st + (size_t)(pt * 16 + fr) * 128 + nt * 16 + 4 * fq) = w; } } }
    }
}

__device__ __forceinline__ void phase_ssd_scan(const Frame& F0, int skip) {
    const Frame F = phase_frame(F0);
    const float* acs = OKP(float, WS_ACS);
    int widx = F.vcu, nw = F.G;
    if (skip) { const int per = F.G / 8, xcd = F.vcu / per, loc = F.vcu % per, sk = skip / 8; if (loc < sk) return; widx = xcd * (per - sk) + (loc - sk); nw = F.G - skip; }
    for (int idx = widx * NT + F.tid; idx < NB * 65536; idx += nw * NT) {
        const int b = idx >> 16, r2 = idx & 65535, hd = r2 >> 12; unsigned* p = (unsigned*)(OKP(bf16_t, WS_STATES) + (size_t)b * NCH * 131072) + r2;
        float s0 = 0.f, s1 = 0.f;
#pragma unroll 8
        for (int c = 0; c < NCH; ++c) { const unsigned st = p[(size_t)c * 65536]; const float dec = fexp(acs[((size_t)b * L + c * 64 + 63) * 16 + hd]);
            p[(size_t)c * 65536] = cvt_pk_bf16(s0, s1); s0 = s0 * dec + bflo(st); s1 = s1 * dec + bfhi(st); }
    }
}

__device__ __forceinline__ void phase_ssd_b(const Frame& F0) {
    const Frame F = phase_frame(F0);
    using namespace sm;
    LAS bf16_t* XT = (LAS bf16_t*)F.lds; LAS bf16_t* Bs = (LAS bf16_t*)(F.lds + 73728); LAS bf16_t* Cs = (LAS bf16_t*)(F.lds + 91136);
    LAS float* acs_s = (LAS float*)(F.lds + 108544); LAS float* dt_s = (LAS float*)(F.lds + 110592); LAS float* red = (LAS float*)(F.lds + 112640);
    const int tid = F.tid, lane = F.lane, wave = F.wave, fr = lane & 15, fq = lane >> 4;
    const bf16_t* proj = OKP(bf16_t, WS_PROJ); bf16_t* cat = OKP(bf16_t, WS_CAT0);
    for (int u = F.vcu; u < NB * NCH * 2; u += F.G) {
        const int g = u & 1, bc = u >> 1, b = bc / NCH, c = bc % NCH; const size_t row0 = (size_t)b * L + c * 64;
        LDS_BARRIER();
        if (tid < 384) { const int ci = tid * 2;
            if (ci < 512) { LAS unsigned* dst = (LAS unsigned*)(XT + ci * XT_LD); ssd_conv_pair(F, b, c, g * 512 + ci, [&](int t, float a0, float a1, float b0, float b1) { dst[t >> 1] = cvt_pk_bf16(a0, a1); dst[XT_LD / 2 + (t >> 1)] = cvt_pk_bf16(b0, b1); }); }
            else { const int n = (ci - 512) & 127; LAS unsigned* dst = (LAS unsigned*)((ci < 640 ? Bs : Cs) + n); const int xc = (ci < 640 ? 1024 : 1280) + g * 128 + n;
                ssd_conv_pair(F, b, c, xc, [&](int t, float a0, float a1, float b0, float b1) { dst[t * (BC_LD / 2)] = cvt_pk_bf16(a0, b0); dst[(t + 1) * (BC_LD / 2)] = cvt_pk_bf16(a1, b1); }); }
        }
        { const int t = tid & 63, hh = tid >> 6; acs_s[hh * 64 + t] = OKP(float, WS_ACS)[(row0 + t) * 16 + g * 8 + hh]; dt_s[hh * 64 + t] = OKP(float, WS_DTV)[(row0 + t) * 16 + g * 8 + hh]; }
        { const int ch = g * 256 + (tid & 255), t0 = (tid >> 8) * 32; const float* w = F.in[I_EV_SCCONV]; const float w0 = w[ch], w1 = w[512 + ch], w2 = w[1024 + ch];
          const bf16_t* p = proj + (row0 + t0) * PROJ0_LD + ch; float p0 = 0.f, p1 = 0.f;
          if (c > 0 || t0 > 0) { p0 = bf2f(p[-2 * PROJ0_LD + 512]) * bf2f(p[-2 * PROJ0_LD + 1024]); p1 = bf2f(p[-PROJ0_LD + 512]) * bf2f(p[-PROJ0_LD + 1024]); }
          unsigned short rb[32], rc[32], rx[32];
#pragma unroll
          for (int t = 0; t < 32; ++t) { const bf16_t* q = p + (size_t)t * PROJ0_LD; rb[t] = q[0]; rc[t] = q[512]; rx[t] = q[1024]; }
#pragma unroll
          for (int t = 0; t < 32; ++t) { const float p2 = bf2f(rc[t]) * bf2f(rx[t]); const float y = bf2f(rb[t]) * (w0 * p0 + w1 * p1 + w2 * p2);
              cat[(row0 + t0 + t) * 1536 + ch] = (bf16_t)(cvt_pk_bf16(y, 0.f) & 0xffffu); p0 = p1; p1 = p2; } }
        LDS_BARRIER();
        const int hh = wave, hd = g * 8 + hh;
        f32x4 Y[4][4];
        { const bf16_t* P = OKP(bf16_t, WS_STATES) + ((size_t)bc * 16 + hd) * 8192;
#pragma unroll
          for (int pt = 0; pt < 4; ++pt)
#pragma unroll
              for (int tt = 0; tt < 4; ++tt) Y[pt][tt] = (f32x4){0.f, 0.f, 0.f, 0.f};
          bf16x8 pall[4][4];
#pragma unroll
          for (int ks = 0; ks < 4; ++ks)
#pragma unroll
              for (int pt = 0; pt < 4; ++pt) pall[ks][pt] = *(const bf16x8*)(P + (size_t)(pt * 16 + fr) * 128 + ks * 32 + fq * 8);
#pragma unroll
          for (int ks = 0; ks < 4; ++ks) { bf16x8 cb[4];
#pragma unroll
              for (int tt = 0; tt < 4; ++tt) cb[tt] = *(const LAS bf16x8*)(Cs + (tt * 16 + fr) * BC_LD + ks * 32 + fq * 8);
#pragma unroll
              for (int pt = 0; pt < 4; ++pt)
#pragma unroll
                  for (int tt = 0; tt < 4; ++tt) Y[pt][tt] = mfma16(pall[ks][pt], cb[tt], Y[pt][tt]);
              SCHED_FENCE(); }
#pragma unroll
          for (int tt = 0; tt < 4; ++tt) { const float e = fexp(acs_s[hh * 64 + tt * 16 + fr]);
#pragma unroll
              for (int pt = 0; pt < 4; ++pt) Y[pt][tt] *= e; } }
        SCHED_FENCE();
#pragma unroll
        for (int tt = 0; tt < 4; ++tt) { f32x4 cbt[4];
#pragma unroll
            for (int st = 0; st < 4; ++st) cbt[st] = (f32x4){0.f, 0.f, 0.f, 0.f};
#pragma unroll
            for (int ks = 0; ks < 4; ++ks) { const bf16x8 cf = *(const LAS bf16x8*)(Cs + (tt * 16 + fr) * BC_LD + ks * 32 + fq * 8);
#pragma unroll
                for (int st = 0; st < 4; ++st) if (st <= tt) { const bf16x8 bf = *(const LAS bf16x8*)(Bs + (st * 16 + fr) * BC_LD + ks * 32 + fq * 8); cbt[st] = mfma16(bf, cf, cbt[st]); } }
            const int t = tt * 16 + fr; const float at = acs_s[hh * 64 + t];
#pragma unroll
            for (int st = 0; st < 4; ++st) { const f32x4 as4 = *(const LAS f32x4*)(acs_s + hh * 64 + st * 16 + 4 * fq), dt4 = *(const LAS f32x4*)(dt_s + hh * 64 + st * 16 + 4 * fq);
#pragma unroll
                for (int r = 0; r < 4; ++r) { const int s = st * 16 + 4 * fq + r; cbt[st][r] = (st <= tt && s <= t) ? cbt[st][r] * fexp(at - as4[r]) * dt4[r] : 0.f; } }
            bf16x8 mb[2];
#pragma unroll
            for (int ks = 0; ks < 2; ++ks) { u32x4 o; o.x = cvt_pk_bf16(cbt[2 * ks][0], cbt[2 * ks][1]); o.y = cvt_pk_bf16(cbt[2 * ks][2], cbt[2 * ks][3]); o.z = cvt_pk_bf16(cbt[2 * ks + 1][0], cbt[2 * ks + 1][1]); o.w = cvt_pk_bf16(cbt[2 * ks + 1][2], cbt[2 * ks + 1][3]);
                mb[ks] = __builtin_bit_cast(bf16x8, o); }
#pragma unroll
            for (int pt = 0; pt < 4; ++pt)
#pragma unroll
                for (int ks = 0; ks < 2; ++ks) { const LAS bf16_t* xp = XT + (hh * 64 + pt * 16 + fr) * XT_LD + ks * 32 + 4 * fq; const u32x2 lo = *(const LAS u32x2*)xp, hi = *(const LAS u32x2*)(xp + 16);
                    u32x4 a; a.x = lo.x; a.y = lo.y; a.z = hi.x; a.w = hi.y; Y[pt][tt] = mfma16(__builtin_bit_cast(bf16x8, a), mb[ks], Y[pt][tt]); }
            SCHED_FENCE(); }
        const float Dh = F.in[I_EV_D][hd];
#pragma unroll
        for (int tt = 0; tt < 4; ++tt) { const int t = tt * 16 + fr; float ss = 0.f;
#pragma unroll
            for (int pt = 0; pt < 4; ++pt) { const int p = pt * 16 + 4 * fq; const u32x2 zz = *(const u32x2*)(proj + (row0 + t) * PROJ0_LD + 1536 + hd * 64 + p);
                const float z0 = bflo(zz.x), z1 = bfhi(zz.x), z2 = bflo(zz.y), z3 = bfhi(zz.y); const LAS bf16_t* xp = XT + (hh * 64 + p) * XT_LD + t;
                f32x4 y = Y[pt][tt]; y[0] = (y[0] + Dh * bf2f(xp[0])) * siluf(z0); y[1] = (y[1] + Dh * bf2f(xp[XT_LD])) * siluf(z1); y[2] = (y[2] + Dh * bf2f(xp[2 * XT_LD])) * siluf(z2); y[3] = (y[3] + Dh * bf2f(xp[3 * XT_LD])) * siluf(z3);
                Y[pt][tt] = y; ss += (y[0] * y[0] + y[1] * y[1]) + (y[2] * y[2] + y[3] * y[3]); }
            ss += __shfl_xor(ss, 16); ss += __shfl_xor(ss, 32);
            if (fq == 0) red[hh * 64 + t] = ss; SCHED_FENCE(); }
        LDS_BARRIER();
#pragma unroll
        for (int tt = 0; tt < 4; ++tt) { const int t = tt * 16 + fr; float ss = 0.f;
#pragma unroll
            for (int w = 0; w < 8; ++w) ss += red[w * 64 + t];
            const float rs = frsq(ss * (1.f / 512.f) + EPS);
#pragma unroll
            for (int pt = 0; pt < 4; ++pt) { const int ch = hd * 64 + pt * 16 + 4 * fq; const f32x4 nw = *(const f32x4*)(F.in[I_EV_NORM] + ch); const f32x4 y = Y[pt][tt];
                u32x2 w; w.x = cvt_pk_bf16(y[0] * rs * nw.x, y[1] * rs * nw.y); w.y = cvt_pk_bf16(y[2] * rs * nw.z, y[3] * rs * nw.w);
                *(u32x2*)(cat + (row0 + t) * 1536 + 512 + ch) = w; } }
    }
}
}

namespace ok {
constexpr int XA_LD = 264;

__device__ __forceinline__ void phase_xattn(const Frame& F0, const bf16_t* q, const bf16_t* kx, const bf16_t* vt, bf16_t* att) {
    const Frame F = phase_frame(F0);
    LAS bf16_t* KV = (LAS bf16_t*)F.lds;
    const int tid = F.tid, lane = F.lane, wave = F.wave, fr = lane & 15, fq = lane >> 4;
    for (int u = F.vcu; u < (T / 128) * 4; u += F.G) {
        const int hd = u & 3, rt = u >> 2, row0 = rt * 128, b = row0 / L;
        LDS_BARRIER();
#pragma unroll 16
        for (int i = tid; i < 256 * 32; i += NT) { const int r = i >> 5, c8 = i & 31; *(LAS u32x4*)(KV + r * XA_LD + c8 * 8) = *(const u32x4*)(kx + (size_t)(b * 256 + r) * 1024 + hd * 256 + c8 * 8); }
        LDS_BARRIER();
        bf16x8 pf[8]; float fA, fB;
        {
            const bf16_t* qp = q + (size_t)(row0 + wave * 16 + fr) * 1024 + hd * 256 + fq * 8;
            bf16x8 qf[8];
#pragma unroll
            for (int ks = 0; ks < 8; ++ks) qf[ks] = *(const bf16x8*)(qp + ks * 32);
            float mh[2], lh[2];
#pragma unroll
            for (int half = 0; half < 2; ++half) {
                f32x4 s[8];
#pragma unroll
                for (int kt = 0; kt < 8; ++kt) { s[kt] = (f32x4){0.f, 0.f, 0.f, 0.f};
#pragma unroll
                    for (int ks = 0; ks < 8; ++ks) { const bf16x8 kf = *(const LAS bf16x8*)(KV + ((half * 8 + kt) * 16 + fr) * XA_LD + ks * 32 + fq * 8); s[kt] = mfma16(kf, qf[ks], s[kt]); }
                    SCHED_FENCE(); }
                float m = -3.0e38f;
#pragma unroll
                for (int kt = 0; kt < 8; ++kt) m = fmaxf(m, fmaxf(fmaxf(s[kt][0], s[kt][1]), fmaxf(s[kt][2], s[kt][3])));
                m = fmaxf(m, __shfl_xor(m, 16)); m = fmaxf(m, __shfl_xor(m, 32));
                float l = 0.f;
#pragma unroll
                for (int kt = 0; kt < 8; ++kt) {
#pragma unroll
                    for (int r = 0; r < 4; ++r) { const float p = fexp2(s[kt][r] - m); s[kt][r] = p; l += p; } }
                l += __shfl_xor(l, 16); l += __shfl_xor(l, 32); mh[half] = m; lh[half] = l;
#pragma unroll
                for (int j = 0; j < 4; ++j) { u32x4 o; o.x = cvt_pk_bf16(s[2 * j][0], s[2 * j][1]); o.y = cvt_pk_bf16(s[2 * j][2], s[2 * j][3]); o.z = cvt_pk_bf16(s[2 * j + 1][0], s[2 * j + 1][1]); o.w = cvt_pk_bf16(s[2 * j + 1][2], s[2 * j + 1][3]);
                    pf[half * 4 + j] = __builtin_bit_cast(bf16x8, o); }
                SCHED_FENCE();
            }
            const float m = fmaxf(mh[0], mh[1]), cA = fexp2(mh[0] - m), cB = fexp2(mh[1] - m), li = frcp(cA * lh[0] + cB * lh[1]); fA = cA * li; fB = cB * li;
        }
        LDS_BARRIER();
#pragma unroll 16
        for (int i = tid; i < 256 * 32; i += NT) { const int r = i >> 5, c8 = i & 31; *(LAS u32x4*)(KV + r * XA_LD + c8 * 8) = *(const u32x4*)(vt + (size_t)(hd * 256 + r) * (NB * 256) + b * 256 + c8 * 8); }
        LDS_BARRIER();
#pragma unroll 2
        for (int dt = 0; dt < 16; ++dt) { f32x4 oA = {0.f, 0.f, 0.f, 0.f}, oB = oA;
#pragma unroll
            for (int j = 0; j < 8; ++j) { const LAS bf16_t* vp = KV + (dt * 16 + fr) * XA_LD + j * 32 + 4 * fq; const u32x2 lo = *(const LAS u32x2*)vp, hi = *(const LAS u32x2*)(vp + 16);
                u32x4 a; a.x = lo.x; a.y = lo.y; a.z = hi.x; a.w = hi.y; const bf16x8 vf = __builtin_bit_cast(bf16x8, a);
                if (j < 4) oA = mfma16(vf, pf[j], oA); else oB = mfma16(vf, pf[j], oB); }
            const f32x4 o = oA * fA + oB * fB;
            bf16_t* op = att + (size_t)(row0 + wave * 16 + fr) * 1024 + hd * 256 + dt * 16 + 4 * fq;
            u32x2 w; w.x = cvt_pk_bf16(o[0], o[1]); w.y = cvt_pk_bf16(o[2], o[3]); *(u32x2*)op = w; }
    }
}

#ifndef CPU_EMU
struct KvOrder {
    const char* memnb; const char* wxa; char* kx; char* vt; int G, c;
    __device__ bool next(int i, pg8::Unit& u) const {
        const int Lx = i * G + c; if (Lx >= 32) return false;
        const int l = Lx >> 4, r = Lx & 15; const size_t tstep = (size_t)256 * 1024 * 2;
        if (r < 8) { u.pm = r >> 2; u.pn = r & 3; u.tag = l * 2; u.a = memnb + (size_t)u.pm * tstep; u.b = wxa + (size_t)l * 8 * MiB + 2 * MiB + (size_t)u.pn * tstep; }
        else { const int r2 = r - 8; u.pm = r2 >> 1; u.pn = r2 & 1; u.tag = l * 2 + 1; u.a = wxa + (size_t)l * 8 * MiB + 4 * MiB + (size_t)u.pm * tstep; u.b = memnb + (size_t)u.pn * tstep; }
        return true;
    }
    __device__ __forceinline__ void a_ready(const pg8::Unit&) const {}
    __device__ __forceinline__ void done(const pg8::Unit&) const {}
};
struct EpiKv {
    static constexpr bool PERM = true, AFTER_DRAIN = false;
    bf16_t* kx; bf16_t* vt;
    __device__ __forceinline__ void operator()(const f32x4 (&acc)[2][2][4][2], const pg8::Unit& u, int wr, int wc, int fr, int fq) const {
        const int l = u.tag >> 1, isv = u.tag & 1, ldc = isv ? 512 : 1024; bf16_t* O = isv ? vt + (size_t)l * 1024 * 512 : kx + (size_t)l * 512 * 1024;
        const int row0 = u.pm * 256 + wr * 64 + fr, col0 = u.pn * 256 + wc * 32 + 8 * fq;
#pragma unroll
        for (int ai = 0; ai < 2; ++ai)
#pragma unroll
            for (int m = 0; m < 4; ++m) { bf16_t* rowp = O + (size_t)(row0 + ai * 128 + m * 16) * ldc + col0;
#pragma unroll
                for (int bj = 0; bj < 2; ++bj) { const f32x4 v0 = acc[ai][bj][m][0], v1 = acc[ai][bj][m][1]; u32x4 w; w.x = cvt_pk_bf16(v0[0], v0[1]); w.y = cvt_pk_bf16(v0[2], v0[3]); w.z = cvt_pk_bf16(v1[0], v1[1]); w.w = cvt_pk_bf16(v1[2], v1[3]);
                    *(u32x4*)(rowp + bj * 128) = w; } }
    }
};
__device__ __forceinline__ void phase_kv(const Frame& F) {
    pg8::Gemm g{nullptr, nullptr, 0, 0, 1024};
    int vcu_; { const int bx = blockIdx.x, G = gridDim.x; vcu_ = (G % 8 == 0) ? (bx % 8) * (G / 8) + bx / 8 : bx; if (G % 8 == 0 && G >= 64) { const int per = G / 8, xcd = vcu_ / per, loc = vcu_ % per; vcu_ = loc < 4 ? xcd * 4 + loc : 32 + vcu_; } }
    KvOrder S{(const char*)OKP(bf16_t, WS_MEMNB), (const char*)OKP(bf16_t, WS_W_XA), (char*)OKP(bf16_t, WS_KX), (char*)OKP(bf16_t, WS_VT), F.G, vcu_};
    EpiKv E{OKP(bf16_t, WS_KX), OKP(bf16_t, WS_VT)};
    pg8::gemm_phase<EpiKv, KvOrder, true, true>(F.lds, g, S, E);
}
#endif
}

namespace ok {
constexpr size_t WS_WRH = WS_WR, WS_WRL = WS_WR + 256 * KiB;
constexpr size_t WS_POS = WS_TILEEXP + 4 * KiB;
__device__ __forceinline__ void prologue_router_tables(const Frame& F0) {
    const Frame F = phase_frame(F0);
    using namespace sm;
    const size_t gt = (size_t)F.vcu * NT + F.tid, GT = (size_t)F.G * NT;
    for (size_t i = gt; i < (size_t)2 * 48 * 1024; i += GT) { const int l = (int)(i / (48 * 1024)), j = (int)((i / 1024) % 48), k = (int)(i % 1024); float v = 0.f;
        if (j < 4) v = F.in[I_MOE_WG][((size_t)l * 1024 + k) * 4 + j]; else if (j < 36) v = F.in[I_MOE_WE][((size_t)l * 1024 + k) * 32 + (j - 4)];
        v *= F.in[I_NORM_FFN][l * 1024 + k];
        const unsigned hi = cvt_pk_bf16(v, 0.f) & 0xffffu; const float rem = v - __uint_as_float(hi << 16);
        OKP(bf16_t, WS_WRH)[i] = (bf16_t)hi; OKP(bf16_t, WS_WRL)[i] = (bf16_t)(cvt_pk_bf16(rem, 0.f) & 0xffffu); }
}

constexpr size_t WS_W16H = WS_WR + 512 * KiB, WS_W16L = WS_W16H + 64 * KiB;
__device__ __forceinline__ void prologue_w16_tables(const Frame& F0) {
    using namespace sm;
    const Frame F = phase_frame(F0);
    const size_t gt = (size_t)F.vcu * NT + F.tid, GT = (size_t)F.G * NT;
    for (size_t i = gt; i < (size_t)2 * 16 * 1024; i += GT) { const int set = (int)(i >> 14), j = (int)((i >> 10) & 15), k = (int)(i & 1023);
        const float v = set == 0 ? F.in[I_NORM_MIX][k] * F.in[I_EV_WIN][(size_t)k * 4112 + 4096 + j] : F.in[I_NORM_MIX][1024 + k] * F.in[I_OD_WIN][(size_t)k * 5648 + 4096 + j];
        const unsigned hi = cvt_pk_bf16(v, 0.f) & 0xffffu; const float rem = v - __uint_as_float(hi << 16);
        OKP(bf16_t, WS_W16H)[i] = (bf16_t)hi; OKP(bf16_t, WS_W16L)[i] = (bf16_t)(cvt_pk_bf16(rem, 0.f) & 0xffffu); }
}
__device__ __forceinline__ void phase_proj16(const Frame& F0, int set, const float* h, const bf16_t* hb, const float* ssq, int np) {
    const Frame F = phase_frame(F0);
    const int lane = F.lane, fr = lane & 15, fq = lane >> 4;
    const bf16_t* wh = OKP(bf16_t, WS_W16H) + (size_t)set * 16 * 1024; const bf16_t* wl = OKP(bf16_t, WS_W16L) + (size_t)set * 16 * 1024;
    const int gw = F.vcu * NWAVES + F.wave, NGW = F.G * NWAVES;
    for (int tile = gw; tile < T / 16; tile += NGW) { const int t0 = tile * 16; f32x4 acc = {0.f, 0.f, 0.f, 0.f};
        const float* hp = h + (size_t)(t0 + fr) * DM + fq * 8;
#pragma unroll 8
        for (int ks = 0; ks < 32; ++ks) { const size_t wo = (size_t)fr * 1024 + ks * 32 + fq * 8; const bf16x8 bh = *(const bf16x8*)(wh + wo), bl = *(const bf16x8*)(wl + wo);
            if (hb) { const bf16x8 ah = *(const bf16x8*)(hb + (size_t)(t0 + fr) * DM + fq * 8 + ks * 32); acc = mfma16(bh, ah, acc); acc = mfma16(bl, ah, acc); }
            else { const f32x4 x0 = *(const f32x4*)(hp + ks * 32), x1 = *(const f32x4*)(hp + ks * 32 + 4);
            u32x4 hi, lo;
            hi.x = cvt_pk_bf16(x0[0], x0[1]); hi.y = cvt_pk_bf16(x0[2], x0[3]); hi.z = cvt_pk_bf16(x1[0], x1[1]); hi.w = cvt_pk_bf16(x1[2], x1[3]);
            lo.x = cvt_pk_bf16(x0[0] - bflo(hi.x), x0[1] - bfhi(hi.x)); lo.y = cvt_pk_bf16(x0[2] - bflo(hi.y), x0[3] - bfhi(hi.y));
            lo.z = cvt_pk_bf16(x1[0] - bflo(hi.z), x1[1] - bfhi(hi.z)); lo.w = cvt_pk_bf16(x1[2] - bflo(hi.w), x1[3] - bfhi(hi.w));
            const bf16x8 ah = __builtin_bit_cast(bf16x8, hi), al = __builtin_bit_cast(bf16x8, lo);
            acc = mfma16(bh, ah, acc); acc = mfma16(bl, ah, acc); acc = mfma16(bh, al, acc); } }
        acc *= rstd_np(ssq, np, t0 + fr);
        *(f32x4*)(OKP(float, WS_RAW16) + (size_t)(t0 + fr) * 16 + 4 * fq) = acc; }
}

__device__ __forceinline__ void phase_router(const Frame& F0, int l, const bf16_t* hb, const float* ssq, int np) {
    const Frame F = phase_frame(F0);
    using namespace sm;
    const int lane = F.lane, wave = F.wave, fr = lane & 15, fq = lane >> 4;
    LAS float* lg = (LAS float*)(F.lds + wave * 16384 + 8704);
    const bf16_t* wh = OKP(bf16_t, WS_WRH) + (size_t)l * 48 * 1024; const bf16_t* wl = OKP(bf16_t, WS_WRL) + (size_t)l * 48 * 1024;
    const float* bg = F.in[I_MOE_BG] + l * 4; const float* be = F.in[I_MOE_BE] + l * 32;
    unsigned* cnt = F.ctl + CW_MOE + l * 64;
    const int gw = F.vcu * NWAVES + wave, NGW = F.G * NWAVES;
    for (int tile = gw; tile < T / 16; tile += NGW) {
        const int t0 = tile * 16;
        f32x4 acc[3] = {{0.f, 0.f, 0.f, 0.f}, {0.f, 0.f, 0.f, 0.f}, {0.f, 0.f, 0.f, 0.f}};
        const bf16_t* hp = hb + (size_t)(t0 + fr) * DM + fq * 8;
#pragma unroll 8
        for (int ks = 0; ks < 32; ++ks) { const bf16x8 ah = *(const bf16x8*)(hp + ks * 32);
#pragma unroll
            for (int nt = 0; nt < 3; ++nt) { const size_t wo = (size_t)(nt * 16 + fr) * 1024 + ks * 32 + fq * 8; const bf16x8 bh = *(const bf16x8*)(wh + wo), bl = *(const bf16x8*)(wl + wo);
                acc[nt] = mfma16(bh, ah, acc[nt]); acc[nt] = mfma16(bl, ah, acc[nt]); } }
#pragma unroll
        for (int nt = 0; nt < 3; ++nt) *(LAS f32x4*)(lg + fr * 48 + nt * 16 + 4 * fq) = acc[nt];
        WAVE_SYNC();
        if (lane < 16) { const int t = t0 + lane; const LAS float* p = lg + lane * 48; const float rs = rstd_np(ssq, np, t);
            const float g0 = p[0] * rs + bg[0], g1 = p[1] * rs + bg[1], g2 = p[2] * rs + bg[2], g3 = p[3] * rs + bg[3];
            int gsel = 0; float gm = g0; if (g1 > gm) { gm = g1; gsel = 1; } if (g2 > gm) { gm = g2; gsel = 2; } if (g3 > gm) { gm = g3; gsel = 3; }
            const float gwt = 1.f / (expf(g0 - gm) + expf(g1 - gm) + expf(g2 - gm) + expf(g3 - gm));
            const LAS float* pe = p + 4 + gsel * 8; const float* bb = be + gsel * 8;
            float e[8];
#pragma unroll
            for (int j = 0; j < 8; ++j) e[j] = pe[j] * rs + bb[j];
            int i1 = 0; float m1 = e[0];
#pragma unroll
            for (int j = 1; j < 8; ++j) if (e[j] > m1) { m1 = e[j]; i1 = j; }
            int i2 = -1; float m2 = -3.0e38f;
#pragma unroll
            for (int j = 0; j < 8; ++j) if (j != i1 && e[j] > m2) { m2 = e[j]; i2 = j; }
            const float r = expf(m2 - m1); const float w1 = gwt / (1.f + r), w2 = gwt * r / (1.f + r);
            const int e1 = gsel * 8 + i1, e2 = gsel * 8 + i2;
            OKP(int, WS_EID)[t * 2] = e1; OKP(int, WS_EID)[t * 2 + 1] = e2; OKP(float, WS_GATEW)[t * 2] = w1; OKP(float, WS_GATEW)[t * 2 + 1] = w2;
            OKP(int, WS_POS)[t * 2] = (int)atomicAdd(cnt + e1, 1u); OKP(int, WS_POS)[t * 2 + 1] = (int)atomicAdd(cnt + e2, 1u); }
        WAVE_SYNC();
    }
}

__device__ __forceinline__ void phase_scatter(const Frame& F0, int l, const bf16_t* hb, const float* ssq, int np) {
    const Frame F = phase_frame(F0);
    const unsigned* cnt = F.ctl + CW_MOE + l * 64; const int lane = F.lane;
    const int gw = F.vcu * NWAVES + F.wave, NGW = F.G * NWAVES;
    int base = 0;
    { int tiles = lane < 32 ? (((int)cnt[lane & 31] + 255) >> 8) : 0; int incl = tiles;
#pragma unroll
      for (int o = 1; o < 32; o <<= 1) { const int n = __shfl_up(incl, o); if ((lane & 31) >= o) incl += n; }
      base = (incl - tiles) * 256;
      if (blockIdx.x == 0 && F.wave == 0) { const int ntiles = __shfl(incl, 31); if (lane < 32) for (int i = 0; i < tiles; ++i) OKP(int, WS_TILEEXP)[(base >> 8) + i] = lane; if (lane == 0) OKP(int, WS_TILEEXP)[1023] = ntiles; } }
    for (int a = gw; a < T * 2; a += NGW) { const int t = a >> 1; const int e = OKP(int, WS_EID)[a]; const int slot = __shfl(base, e) + OKP(int, WS_POS)[a];
        const u32x4* src = (const u32x4*)(hb + (size_t)t * DM) + lane; u32x4* dst = (u32x4*)(OKP(bf16_t, WS_XS) + (size_t)slot * DM) + lane;
        dst[0] = src[0]; dst[64] = src[64];
        if (lane == 0) { OKP(int, WS_TOKSLOT)[a] = slot; OKP(float, WS_SLOTGATE)[slot] = OKP(float, WS_GATEW)[a]; OKP(float, WS_SLOTRSTD)[slot] = rstd_np(ssq, np, t); } }
}

__device__ __forceinline__ void phase_combine(const Frame& F0, bf16_t* hb, float* ssq, bool final_layer) {
    using namespace sm;
    const Frame F = phase_frame(F0);
    const int lane = F.lane; const int gw = F.vcu * NWAVES + F.wave, NGW = F.G * NWAVES; const bf16_t* y = OKP(bf16_t, WS_Y);
    for (int t = gw; t < T; t += NGW) { const int sa = OKP(int, WS_TOKSLOT)[t * 2], sb = OKP(int, WS_TOKSLOT)[t * 2 + 1];
        u32x2* hr = (u32x2*)(hb + (size_t)t * DM) + lane; const u32x2* ya = (const u32x2*)(y + (size_t)sa * DM) + lane; const u32x2* yb = (const u32x2*)(y + (size_t)sb * DM) + lane;
        f32x4 v[4]; float s = 0.f;
#pragma unroll
        for (int j = 0; j < 4; ++j) { const u32x2 a = ya[64 * j], b = yb[64 * j], hw = hr[64 * j]; f32x4 x;
            x[0] = bflo(hw.x) + (bflo(a.x) + bflo(b.x)); x[1] = bfhi(hw.x) + (bfhi(a.x) + bfhi(b.x)); x[2] = bflo(hw.y) + (bflo(a.y) + bflo(b.y)); x[3] = bfhi(hw.y) + (bfhi(a.y) + bfhi(b.y));
            if (!final_layer) { u32x2 w; w.x = cvt_pk_bf16(x[0], x[1]); w.y = cvt_pk_bf16(x[2], x[3]); hr[64 * j] = w; x = (f32x4){bflo(w.x), bfhi(w.x), bflo(w.y), bfhi(w.y)}; }
            v[j] = x; s += (x[0] * x[0] + x[1] * x[1]) + (x[2] * x[2] + x[3] * x[3]); }
        s = wave_sum(s);
        if (!final_layer) { if (lane == 0) ssq[t] = s; }
        else { const float rs = frsq(s * (1.f / DM) + EPS); f32x4* orow = (f32x4*)(F.out + (size_t)t * DM) + lane; const f32x4* gr = (const f32x4*)F.in[I_FINAL_NORM] + lane;
#pragma unroll
            for (int j = 0; j < 4; ++j) { const f32x4 g = gr[64 * j]; f32x4 o; o[0] = v[j][0] * rs * g[0]; o[1] = v[j][1] * rs * g[1]; o[2] = v[j][2] * rs * g[2]; o[3] = v[j][3] * rs * g[3]; orow[64 * j] = o; } } }
}

#ifndef CPU_EMU
struct MoeOrder {
    const char* A; const char* W; const int* tile_exp; size_t a_tstep, w_estride, w_off, w_tstep; int G, c;
    __device__ bool next(int i, pg8::Unit& u) const {
        const int Lx = i * G + c; const int ntiles = tile_exp[1023]; if (Lx >= ntiles * 4) return false;
        const int tile = Lx >> 2; u.pm = tile; u.pn = Lx & 3; u.tag = 0; const int e = tile_exp[tile];
        u.a = A + (size_t)tile * a_tstep; u.b = W + (size_t)e * w_estride + w_off + (size_t)u.pn * w_tstep; return true;
    }
    __device__ __forceinline__ void a_ready(const pg8::Unit&) const {}
    __device__ __forceinline__ void done(const pg8::Unit&) const {}
};
struct EpiSwiGLU {
    static constexpr bool PERM = false, AFTER_DRAIN = false;
    bf16_t* act; const float* slot_rstd;
    __device__ __forceinline__ void operator()(const f32x4 (&acc)[2][2][4][2], const pg8::Unit& u, int wr, int wc, int fr, int fq) const {
        const int row0 = u.pm * 256 + wr * 64 + fr, col0 = u.pn * 128 + wc * 16 + 4 * fq;
#pragma unroll
        for (int ai = 0; ai < 2; ++ai)
#pragma unroll
            for (int m = 0; m < 4; ++m) { const int row = row0 + ai * 128 + m * 16; const float rs = slot_rstd[row]; bf16_t* rowp = act + (size_t)row * 512 + col0;
#pragma unroll
                for (int bj = 0; bj < 2; ++bj) { const f32x4 g = acc[ai][bj][m][0] * rs, up = acc[ai][bj][m][1] * rs; f32x4 o;
#pragma unroll
                    for (int r = 0; r < 4; ++r) o[r] = g[r] * frcp(1.f + fexp(-g[r])) * up[r];
                    u32x2 w; w.x = cvt_pk_bf16(o[0], o[1]); w.y = cvt_pk_bf16(o[2], o[3]); *(u32x2*)(rowp + bj * 64) = w; } }
    }
};
struct EpiDown {
    static constexpr bool PERM = true, AFTER_DRAIN = false;
    bf16_t* y; const float* slot_gate;
    __device__ __forceinline__ void operator()(const f32x4 (&acc)[2][2][4][2], const pg8::Unit& u, int wr, int wc, int fr, int fq) const {
        const int row0 = u.pm * 256 + wr * 64 + fr, col0 = u.pn * 256 + wc * 32 + 8 * fq;
#pragma unroll
        for (int ai = 0; ai < 2; ++ai)
#pragma unroll
            for (int m = 0; m < 4; ++m) { const int row = row0 + ai * 128 + m * 16; const float s = slot_gate[row]; bf16_t* rowp = y + (size_t)row * DM + col0;
#pragma unroll
                for (int bj = 0; bj < 2; ++bj) { const f32x4 v0 = acc[ai][bj][m][0] * s, v1 = acc[ai][bj][m][1] * s; u32x4 w; w.x = cvt_pk_bf16(v0[0], v0[1]); w.y = cvt_pk_bf16(v0[2], v0[3]); w.z = cvt_pk_bf16(v1[0], v1[1]); w.w = cvt_pk_bf16(v1[2], v1[3]);
                    *(u32x4*)(rowp + bj * 128) = w; } }
    }
};
__device__ __forceinline__ void phase_moe_up(const Frame& F) {
    pg8::Gemm g{nullptr, nullptr, 0, 0, 1024};
    MoeOrder S{(const char*)OKP(bf16_t, WS_XS), (const char*)OKP(bf16_t, WS_MOEW), OKP(int, WS_TILEEXP), (size_t)256 * 1024 * 2, 3 * MiB, 0, (size_t)256 * 1024 * 2, F.G, (int)blockIdx.x};
    EpiSwiGLU E{OKP(bf16_t, WS_ACT), OKP(float, WS_SLOTRSTD)};
    pg8::gemm_phase<EpiSwiGLU, MoeOrder, true, true>(F.lds, g, S, E);
}
__device__ __forceinline__ void phase_moe_down(const Frame& F) {
    pg8::Gemm g{nullptr, nullptr, 0, 0, 512};
    MoeOrder S{(const char*)OKP(bf16_t, WS_ACT), (const char*)OKP(bf16_t, WS_MOEW), OKP(int, WS_TILEEXP), (size_t)256 * 512 * 2, 3 * MiB, 2 * MiB, (size_t)256 * 512 * 2, F.G, (int)blockIdx.x};
    EpiDown E{OKP(bf16_t, WS_Y), OKP(float, WS_SLOTGATE)};
    pg8::gemm_phase<EpiDown, MoeOrder, true, true>(F.lds, g, S, E);
}
#endif
}

#ifndef DUP_MASK
#define DUP_MASK 0
#endif
namespace ok {
constexpr size_t WS_GU = 160 * MiB, WS_GW = 192 * MiB, WS_GQD = 224 * MiB, WS_GKDT = 480 * MiB, WS_GAQK = 512 * MiB;
constexpr size_t WS_GDEC = WS_GCS;
constexpr size_t WS_OBUF = WS_H;
constexpr int G_LD = 132, GB_LD = 136, LM_LD = 68;
__device__ __forceinline__ float sigmoidf_(float x) { return frcp(1.f + fexp(-x)); }

__device__ __forceinline__ void phase_gdn_prep(const Frame& F0) {
    using namespace sm;
    const Frame F = phase_frame(F0);
    LAS float* q_s = (LAS float*)F.lds; LAS float* k_s = (LAS float*)(F.lds + 33792); LAS float* v_s = (LAS float*)(F.lds + 67584);
    LAS bf16_t* Kn = (LAS bf16_t*)(F.lds + 101376); LAS bf16_t* Qn = (LAS bf16_t*)(F.lds + 118784);
    LAS float* g_s = (LAS float*)(F.lds + 136192); LAS float* beta_s = g_s + 64; LAS float* gc_s = g_s + 128; LAS float* eg_s = g_s + 192; LAS float* rq_s = g_s + 256; LAS float* rk_s = g_s + 320;
    LAS float* Lm = q_s;
    const int tid = F.tid, lane = F.lane, wave = F.wave, fr = lane & 15, fq = lane >> 4;
    const bf16_t* proj = OKP(bf16_t, WS_PROJ); const float* cw = F.in[I_OD_CONV];
    for (int u = F.vcu; u < NB * NCH * 8; u += F.G) {
        const int hd = u & 7, bc = u >> 3, b = bc / NCH, c = bc % NCH; const size_t row0 = (size_t)b * L + c * 64; const size_t ub = (size_t)bc * 8 + hd;
        LDS_BARRIER();
        for (int rep_a = 0; rep_a < 1 + ((DUP_MASK >> 17) & 1); ++rep_a)
        if (tid < 384) { const int which = tid >> 7, d = tid & 127, xc = which * 1024 + hd * 128 + d; LAS float* dst = (which == 0 ? q_s : which == 1 ? k_s : v_s) + d;
            const float w0 = cw[xc], w1 = cw[3072 + xc], w2 = cw[6144 + xc], w3 = cw[9216 + xc]; const bf16_t* p = proj + row0 * PROJ1_LD + xc;
            float x0 = 0.f, x1 = 0.f, x2 = 0.f; if (c > 0) { x0 = bf2f(p[-3 * PROJ1_LD]); x1 = bf2f(p[-2 * PROJ1_LD]); x2 = bf2f(p[-PROJ1_LD]); }
            unsigned short raw[64];
#pragma unroll
            for (int t = 0; t < 64; ++t) raw[t] = p[(size_t)t * PROJ1_LD];
#pragma unroll
            for (int t = 0; t < 64; ++t) { const float x3 = bf2f(raw[t]); const float v = w0 * x0 + w1 * x1 + w2 * x2 + w3 * x3; dst[t * G_LD] = siluf(v); x0 = x1; x1 = x2; x2 = x3; } }
        if (tid >= 448) { const int t = tid - 448; const float* r16 = OKP(float, WS_RAW16) + (row0 + t) * 16;
            g_s[t] = -expf(F.in[I_OD_ALOG][hd]) * softplusf(r16[hd] + F.in[I_OD_DTB][hd]); beta_s[t] = sigmoidf_(r16[8 + hd]); }
        LDS_BARRIER();
        if (wave == 0) { float v = g_s[lane];
#pragma unroll
            for (int o = 1; o < 64; o <<= 1) { const float n = __shfl_up(v, o); if (lane >= o) v += n; }
            gc_s[lane] = v; eg_s[lane] = fexp(v); if (lane == 63) OKP(float, WS_GDEC)[ub] = fexp(v); }
        else if (wave <= 2) { const LAS float* src = (wave == 1 ? q_s : k_s) + lane * G_LD; float s = 0.f;
#pragma unroll 8
            for (int d = 0; d < 128; d += 4) { const f32x4 x = *(const LAS f32x4*)(src + d); s += (x.x * x.x + x.y * x.y) + (x.z * x.z + x.w * x.w); }
            const float r = frsq(s + EPS); if (wave == 1) rq_s[lane] = r * 0.08838834764831845f; else rk_s[lane] = r; }
        LDS_BARRIER();
        for (int rep_d = 0; rep_d < 1 + ((DUP_MASK >> 18) & 1); ++rep_d)
        { const float gl = gc_s[63];
          for (int i = tid; i < 64 * 64; i += NT) { const int t = i >> 6, dp = (i & 63) * 2; const float rk = rk_s[t], rq = rq_s[t], eg = eg_s[t];
              const float k0 = k_s[t * G_LD + dp] * rk, k1 = k_s[t * G_LD + dp + 1] * rk, q0 = q_s[t * G_LD + dp] * rq, q1 = q_s[t * G_LD + dp + 1] * rq;
              *(LAS unsigned*)(Kn + t * GB_LD + dp) = cvt_pk_bf16(k0, k1); *(LAS unsigned*)(Qn + t * GB_LD + dp) = cvt_pk_bf16(q0, q1);
              *(unsigned*)(OKP(bf16_t, WS_GQD) + ub * 8192 + t * 128 + dp) = cvt_pk_bf16(q0 * eg, q1 * eg); }
          { const int t = tid & 63, dg = tid >> 6; const float f = rk_s[t] * fexp(gl - gc_s[t]); bf16_t* dst = OKP(bf16_t, WS_GKDT) + ub * 8192 + t;
#pragma unroll
            for (int j = 0; j < 16; ++j) { const int d = dg * 16 + j; dst[d * 64] = (bf16_t)(cvt_pk_bf16(k_s[t * G_LD + d] * f, 0.f) & 0xffffu); } } }
        LDS_BARRIER();
        for (int rep_e = 0; rep_e < 1 + ((DUP_MASK >> 19) & 1); ++rep_e)
#pragma unroll
        for (int i = 0; i < 4; ++i) { const int tl = wave * 4 + i, which = tl >> 4, ti = (tl >> 2) & 3, si = tl & 3;
            f32x4 acc = {0.f, 0.f, 0.f, 0.f};
            if (si <= ti) {
#pragma unroll
                for (int ks = 0; ks < 4; ++ks) { const bf16x8 a = *(const LAS bf16x8*)(Kn + (si * 16 + fr) * GB_LD + ks * 32 + fq * 8); const bf16x8 bb = *(const LAS bf16x8*)((which ? Qn : Kn) + (ti * 16 + fr) * GB_LD + ks * 32 + fq * 8); acc = mfma16(a, bb, acc); }
                const int t = ti * 16 + fr; const float gt = gc_s[t], bt = beta_s[t];
#pragma unroll
                for (int r = 0; r < 4; ++r) { const int s = si * 16 + 4 * fq + r; const float dec = fexp(gt - gc_s[s]); acc[r] = which ? (s <= t ? acc[r] * dec : 0.f) : (s < t ? acc[r] * dec * bt : 0.f); } }
            const int t = ti * 16 + fr, s0 = si * 16 + 4 * fq;
            if (which) { u32x2 w; w.x = cvt_pk_bf16(acc[0], acc[1]); w.y = cvt_pk_bf16(acc[2], acc[3]); *(u32x2*)(OKP(bf16_t, WS_GAQK) + ub * 4096 + t * 64 + s0) = w; }
            else { Lm[(s0 + 0) * LM_LD + t] = acc[0]; Lm[(s0 + 1) * LM_LD + t] = acc[1]; Lm[(s0 + 2) * LM_LD + t] = acc[2]; Lm[(s0 + 3) * LM_LD + t] = acc[3]; } }
        LDS_BARRIER();
        if (tid < 256) { const int cidx = tid & 127; const bool isw = tid >= 128; LAS float* col = (isw ? k_s : v_s) + cidx; bf16_t* dst = OKP(bf16_t, isw ? WS_GW : WS_GU) + ub * 8192 + (isw ? cidx : cidx * 4);
            for (int ib = 0; ib < 4; ++ib) { float a[16];
#pragma unroll
                for (int tt = 0; tt < 16; ++tt) { const int t = ib * 16 + tt; float v = col[t * G_LD] * beta_s[t]; if (isw) v *= rk_s[t] * eg_s[t]; a[tt] = v; }
                for (int s = 0; s < ib * 16; ++s) { const float xs = col[s * G_LD]; const LAS f32x4* lp = (const LAS f32x4*)(Lm + s * LM_LD + ib * 16);
#pragma unroll
                    for (int q4 = 0; q4 < 4; ++q4) { const f32x4 l4 = lp[q4];
#pragma unroll
                        for (int r = 0; r < 4; ++r) a[q4 * 4 + r] -= l4[r] * xs; } }
#pragma unroll
                for (int ss = 0; ss < 16; ++ss) { const float xv = a[ss]; const int srow = ib * 16 + ss; col[srow * G_LD] = xv; if (isw) dst[srow * 128] = (bf16_t)(cvt_pk_bf16(xv, 0.f) & 0xffffu);
                    const LAS f32x4* lp = (const LAS f32x4*)(Lm + srow * LM_LD + ib * 16);
#pragma unroll
                    for (int q4 = ss / 4; q4 < 4; ++q4) { const f32x4 l4 = lp[q4];
#pragma unroll
                        for (int r = 0; r < 4; ++r) if (q4 * 4 + r > ss) a[q4 * 4 + r] -= l4[r] * xv; } }
                if (!isw) {
#pragma unroll
                    for (int q4 = 0; q4 < 4; ++q4) { u32x2 w; w.x = cvt_pk_bf16(a[q4 * 4], a[q4 * 4 + 1]); w.y = cvt_pk_bf16(a[q4 * 4 + 2], a[q4 * 4 + 3]); *(u32x2*)(dst + (size_t)(ib * 4 + q4) * 512) = w; } }
            } }
    }
}
}

namespace ok {
constexpr int ST_LD = 136, VT_LD = 72;
struct GdnEarly { bf16x8 X[4]; u32x2 Uv[2]; };
struct GdnLate { bf16x8 Af[2], Kf[2]; float dec; };
__device__ __forceinline__ void gdn_load_early(GdnEarly& g, const Frame& F, size_t xoff, size_t ub, int ti, int sl, int fr, int fq) {
    const bf16_t* Xp = (const bf16_t*)(F.ws + xoff) + ub * 8192 + (ti * 16 + fr) * 128 + fq * 8;
#pragma unroll
    for (int ks = 0; ks < 4; ++ks) g.X[ks] = *(const bf16x8*)(Xp + ks * 32);
#pragma unroll
    for (int ji = 0; ji < 2; ++ji) g.Uv[ji] = *(const u32x2*)(OKP(bf16_t, WS_GU) + ub * 8192 + ((size_t)(ti * 4 + fq) * 128 + sl * 32 + ji * 16 + fr) * 4);
}
__device__ __forceinline__ void gdn_load_late(GdnLate& g, const Frame& F, size_t ub, int ti, int wave, int fr, int fq, int vzero) {
    const bf16_t* Ap = OKP(bf16_t, WS_GAQK) + ub * 4096 + (ti * 16 + fr) * 64 + fq * 8; const bf16_t* Kp = OKP(bf16_t, WS_GKDT) + ub * 8192 + (wave * 16 + fr) * 64 + fq * 8;
#pragma unroll
    for (int k2 = 0; k2 < 2; ++k2) { g.Af[k2] = *(const bf16x8*)(Ap + k2 * 32); g.Kf[k2] = *(const bf16x8*)(Kp + k2 * 32); }
    g.dec = OKP(float, WS_GDEC)[ub + vzero];
}
constexpr int OS_LD = 40;
__device__ __forceinline__ void gdn_flush_o(const Frame& F, const LAS bf16_t* Os, int b, int cprev, int hd, int sl) {
    if (F.tid < 256) { const int row = F.tid >> 2, pc = F.tid & 3; *(u32x4*)(OKP(bf16_t, WS_OBUF) + ((size_t)b * L + cprev * 64 + row) * 1024 + hd * 128 + sl * 32 + pc * 8) = *(const LAS u32x4*)(Os + row * OS_LD + pc * 8); }
}
__device__ __forceinline__ void gdn_step(const Frame& F, const GdnEarly& g, const GdnLate& h, f32x4 (&Sacc)[2], LAS bf16_t* ST0, LAS bf16_t* VnT, int par, int roleB, int b, int c, int hd, int sl, int ti, int wave, int fr, int fq) {
    LAS bf16_t* ST = ST0 + par * (32 * ST_LD); LAS bf16_t* STn = ST0 + (par ^ 1) * (32 * ST_LD);
    LAS bf16_t* Os = VnT + 32 * VT_LD;
    LDS_BARRIER();
    if (c > 0) gdn_flush_o(F, Os, b, c - 1, hd, sl);
    f32x4 a[2] = {{0.f, 0.f, 0.f, 0.f}, {0.f, 0.f, 0.f, 0.f}};
#pragma unroll
    for (int ks = 0; ks < 4; ++ks)
#pragma unroll
        for (int ji = 0; ji < 2; ++ji) { const bf16x8 sf = *(const LAS bf16x8*)(ST + (ji * 16 + fr) * ST_LD + ks * 32 + fq * 8); a[ji] = mfma16(g.X[ks], sf, a[ji]); }
    if (!roleB) {
#pragma unroll
        for (int ji = 0; ji < 2; ++ji) { const u32x2 uv = g.Uv[ji]; u32x2 w; w.x = cvt_pk_bf16(bflo(uv.x) - a[ji][0], bfhi(uv.x) - a[ji][1]); w.y = cvt_pk_bf16(bflo(uv.y) - a[ji][2], bfhi(uv.y) - a[ji][3]);
            *(LAS u32x2*)(VnT + (ji * 16 + fr) * VT_LD + ti * 16 + 4 * fq) = w; } }
    LDS_BARRIER();
    bf16x8 vf[2][2];
#pragma unroll
    for (int ji = 0; ji < 2; ++ji)
#pragma unroll
        for (int k2 = 0; k2 < 2; ++k2) vf[ji][k2] = *(const LAS bf16x8*)(VnT + (ji * 16 + fr) * VT_LD + k2 * 32 + fq * 8);
    if (roleB) {
#pragma unroll
        for (int ji = 0; ji < 2; ++ji) {
#pragma unroll
            for (int k2 = 0; k2 < 2; ++k2) a[ji] = mfma16(h.Af[k2], vf[ji][k2], a[ji]);
            LAS bf16_t* op = Os + (ti * 16 + 4 * fq) * OS_LD + ji * 16 + fr;
#pragma unroll
            for (int r = 0; r < 4; ++r) op[r * OS_LD] = (bf16_t)(cvt_pk_bf16(a[ji][r], 0.f) & 0xffffu); } }
#pragma unroll
    for (int ji = 0; ji < 2; ++ji) { Sacc[ji] *= h.dec;
#pragma unroll
        for (int k2 = 0; k2 < 2; ++k2) Sacc[ji] = mfma16(h.Kf[k2], vf[ji][k2], Sacc[ji]);
        u32x2 w; w.x = cvt_pk_bf16(Sacc[ji][0], Sacc[ji][1]); w.y = cvt_pk_bf16(Sacc[ji][2], Sacc[ji][3]); *(LAS u32x2*)(STn + (ji * 16 + fr) * ST_LD + wave * 16 + 4 * fq) = w; }
}
__device__ __forceinline__ void gdn_scan_unit(const Frame& F, int unit) {
    LAS bf16_t* ST = (LAS bf16_t*)F.lds; LAS bf16_t* VnT = (LAS bf16_t*)(F.lds + 2 * 32 * ST_LD * 2);
    const int tid = F.tid, lane = F.lane, wave = F.wave, fr = lane & 15, fq = lane >> 4;
    const int b = unit >> 5, hd = (unit >> 2) & 7, sl = unit & 3, ti = wave & 3, roleB = wave >> 2;
    for (int i = tid; i < 32 * ST_LD / 2; i += NT) ((LAS unsigned*)ST)[i] = 0u;
    f32x4 Sacc[2] = {{0.f, 0.f, 0.f, 0.f}, {0.f, 0.f, 0.f, 0.f}};
    const size_t ub0 = ((size_t)b * NCH) * 8 + hd; const size_t xoff = roleB ? WS_GQD : WS_GW;
    int vzero = 0;
#ifndef CPU_EMU
    asm volatile("" : "+v"(vzero));
#endif
#define GDN_LE(set, cc) gdn_load_early(set, F, xoff, ub0 + (size_t)((cc) < NCH ? (cc) : NCH - 1) * 8, ti, sl, fr, fq)
#define GDN_LL(set, cc) gdn_load_late(set, F, ub0 + (size_t)((cc) < NCH ? (cc) : NCH - 1) * 8, ti, wave, fr, fq, vzero)
#define GDN_ST(es, ls, cc, par) gdn_step(F, es, ls, Sacc, ST, VnT, par, roleB, b, (cc), hd, sl, ti, wave, fr, fq)
    GdnEarly e0, e1, e2, e3; GdnLate l0, l1, l2;
    GDN_LE(e0, 0); GDN_LE(e1, 1); GDN_LE(e2, 2); GDN_LL(l0, 0); GDN_LL(l1, 1);
    int c = 0;
    for (; c + 12 <= NCH; c += 12) {
        GDN_LE(e3, c + 3); GDN_LL(l2, c + 2); GDN_ST(e0, l0, c + 0, 0);
        GDN_LE(e0, c + 4); GDN_LL(l0, c + 3); GDN_ST(e1, l1, c + 1, 1);
        GDN_LE(e1, c + 5); GDN_LL(l1, c + 4); GDN_ST(e2, l2, c + 2, 0);
        GDN_LE(e2, c + 6); GDN_LL(l2, c + 5); GDN_ST(e3, l0, c + 3, 1);
        GDN_LE(e3, c + 7); GDN_LL(l0, c + 6); GDN_ST(e0, l1, c + 4, 0);
        GDN_LE(e0, c + 8); GDN_LL(l1, c + 7); GDN_ST(e1, l2, c + 5, 1);
        GDN_LE(e1, c + 9); GDN_LL(l2, c + 8); GDN_ST(e2, l0, c + 6, 0);
        GDN_LE(e2, c + 10); GDN_LL(l0, c + 9); GDN_ST(e3, l1, c + 7, 1);
        GDN_LE(e3, c + 11); GDN_LL(l1, c + 10); GDN_ST(e0, l2, c + 8, 0);
        GDN_LE(e0, c + 12); GDN_LL(l2, c + 11); GDN_ST(e1, l0, c + 9, 1);
        GDN_LE(e1, c + 13); GDN_LL(l0, c + 12); GDN_ST(e2, l1, c + 10, 0);
        GDN_LE(e2, c + 14); GDN_LL(l1, c + 13); GDN_ST(e3, l2, c + 11, 1);
    }
    if (c + 0 < NCH) { GDN_LE(e3, c + 3); GDN_LL(l2, c + 2); GDN_ST(e0, l0, c + 0, 0); }
    if (c + 1 < NCH) { GDN_LE(e0, c + 4); GDN_LL(l0, c + 3); GDN_ST(e1, l1, c + 1, 1); }
    if (c + 2 < NCH) { GDN_LE(e1, c + 5); GDN_LL(l1, c + 4); GDN_ST(e2, l2, c + 2, 0); }
    if (c + 3 < NCH) { GDN_LE(e2, c + 6); GDN_LL(l2, c + 5); GDN_ST(e3, l0, c + 3, 1); }
    if (c + 4 < NCH) { GDN_LE(e3, c + 7); GDN_LL(l0, c + 6); GDN_ST(e0, l1, c + 4, 0); }
    if (c + 5 < NCH) { GDN_LE(e0, c + 8); GDN_LL(l1, c + 7); GDN_ST(e1, l2, c + 5, 1); }
    if (c + 6 < NCH) { GDN_LE(e1, c + 9); GDN_LL(l2, c + 8); GDN_ST(e2, l0, c + 6, 0); }
    if (c + 7 < NCH) { GDN_LE(e2, c + 10); GDN_LL(l0, c + 9); GDN_ST(e3, l1, c + 7, 1); }
    if (c + 8 < NCH) { GDN_LE(e3, c + 11); GDN_LL(l1, c + 10); GDN_ST(e0, l2, c + 8, 0); }
    if (c + 9 < NCH) { GDN_LE(e0, c + 12); GDN_LL(l2, c + 11); GDN_ST(e1, l0, c + 9, 1); }
    if (c + 10 < NCH) { GDN_LE(e1, c + 13); GDN_LL(l0, c + 12); GDN_ST(e2, l1, c + 10, 0); }
#undef GDN_LE
#undef GDN_LL
#undef GDN_ST
    LDS_BARRIER();
    gdn_flush_o(F, VnT + 32 * VT_LD, b, NCH - 1, hd, sl);
}
__device__ __forceinline__ void phase_gdn_final(const Frame& F0) {
    using namespace sm;
    const Frame F = phase_frame(F0);
    const int lane = F.lane; const int gw = F.vcu * NWAVES + F.wave, NGW = F.G * NWAVES;
    const f32x4* nw4 = (const f32x4*)(F.in[I_OD_NORM] + (lane & 7) * 16);
    for (int t = gw; t < T; t += NGW) { const u32x4* op = (const u32x4*)(OKP(bf16_t, WS_OBUF) + (size_t)t * 1024 + lane * 16); const u32x4* zp = (const u32x4*)(OKP(bf16_t, WS_PROJ) + (size_t)t * PROJ1_LD + 3072 + lane * 16);
        float o[16], z[16];
#pragma unroll
        for (int h2 = 0; h2 < 2; ++h2) { const u32x4 a = op[h2], zz = zp[h2];
            o[h2 * 8 + 0] = bflo(a.x); o[h2 * 8 + 1] = bfhi(a.x); o[h2 * 8 + 2] = bflo(a.y); o[h2 * 8 + 3] = bfhi(a.y); o[h2 * 8 + 4] = bflo(a.z); o[h2 * 8 + 5] = bfhi(a.z); o[h2 * 8 + 6] = bflo(a.w); o[h2 * 8 + 7] = bfhi(a.w);
            z[h2 * 8 + 0] = bflo(zz.x); z[h2 * 8 + 1] = bfhi(zz.x); z[h2 * 8 + 2] = bflo(zz.y); z[h2 * 8 + 3] = bfhi(zz.y); z[h2 * 8 + 4] = bflo(zz.z); z[h2 * 8 + 5] = bfhi(zz.z); z[h2 * 8 + 6] = bflo(zz.w); z[h2 * 8 + 7] = bfhi(zz.w); }
        float s = 0.f;
#pragma unroll
        for (int i = 0; i < 16; ++i) s += o[i] * o[i];
        s += __shfl_xor(s, 1); s += __shfl_xor(s, 2); s += __shfl_xor(s, 4);
        const float rs = frsq(s * (1.f / 128.f) + EPS);
        u32x4 w[2];
#pragma unroll
        for (int h2 = 0; h2 < 2; ++h2) { const f32x4 n0 = nw4[h2 * 2], n1 = nw4[h2 * 2 + 1]; float y[8];
#pragma unroll
            for (int i = 0; i < 8; ++i) y[i] = o[h2 * 8 + i] * rs * (i < 4 ? n0[i] : n1[i - 4]) * siluf(z[h2 * 8 + i]);
            w[h2].x = cvt_pk_bf16(y[0], y[1]); w[h2].y = cvt_pk_bf16(y[2], y[3]); w[h2].z = cvt_pk_bf16(y[4], y[5]); w[h2].w = cvt_pk_bf16(y[6], y[7]); }
        u32x4* cp = (u32x4*)(OKP(bf16_t, WS_CAT1) + (size_t)t * 1536 + lane * 16); cp[0] = w[0]; cp[1] = w[1]; }
}
}

#ifndef DUP_MASK
#define DUP_MASK 0
#endif
namespace ok {
constexpr int SB_LD = 72;
#ifdef CPU_EMU
#define WAVE_ALL(p) (wave_sum((p) ? 1.f : 0.f) == 64.f)
#else
#define WAVE_ALL(p) (__all(p))
#endif
__device__ __forceinline__ void sb_unit(const Frame& F, int unit) {
    LAS bf16_t* Kt = (LAS bf16_t*)F.lds; LAS bf16_t* VT = (LAS bf16_t*)(F.lds + 64 * SB_LD * 2); volatile LAS int* votes = (volatile LAS int*)(F.lds + 2 * 64 * SB_LD * 2);
    const int tid = F.tid, lane = F.lane, wave = F.wave, fr = lane & 15, fq = lane >> 4;
    const int nqb = L / 128, qb = unit % nqb, hd = (unit / nqb) & 7, b = unit / (nqb * 8), q0 = qb * 128;
    const bf16_t* proj = OKP(bf16_t, WS_PROJ) + (size_t)b * L * PROJ1_LD;
    const int qrow = q0 + wave * 16 + fr;
    bf16x8 qf[2];
#pragma unroll
    for (int ks = 0; ks < 2; ++ks) qf[ks] = *(const bf16x8*)(proj + (size_t)qrow * PROJ1_LD + 4096 + hd * 64 + ks * 32 + fq * 8);
    f32x4 o[4] = {{0.f, 0.f, 0.f, 0.f}, {0.f, 0.f, 0.f, 0.f}, {0.f, 0.f, 0.f, 0.f}, {0.f, 0.f, 0.f, 0.f}};
    float C = 1.f; bool wdone = false;
    const int key_l = tid >> 3, c8 = tid & 7;
    int kt = 2 * qb + 1;
    u32x4 kreg = *(const u32x4*)(proj + (size_t)(kt * 64 + key_l) * PROJ1_LD + 4608 + hd * 64 + c8 * 8), vreg = *(const u32x4*)(proj + (size_t)(kt * 64 + key_l) * PROJ1_LD + 5120 + hd * 64 + c8 * 8);
    for (; kt >= 0; --kt) {
        LDS_BARRIER();
        *(LAS u32x4*)(Kt + key_l * SB_LD + c8 * 8) = kreg;
        { LAS bf16_t* vp = VT + (c8 * 8) * SB_LD + key_l; vp[0] = (bf16_t)(vreg.x & 0xffffu); vp[SB_LD] = (bf16_t)(vreg.x >> 16); vp[2 * SB_LD] = (bf16_t)(vreg.y & 0xffffu); vp[3 * SB_LD] = (bf16_t)(vreg.y >> 16);
          vp[4 * SB_LD] = (bf16_t)(vreg.z & 0xffffu); vp[5 * SB_LD] = (bf16_t)(vreg.z >> 16); vp[6 * SB_LD] = (bf16_t)(vreg.w & 0xffffu); vp[7 * SB_LD] = (bf16_t)(vreg.w >> 16); }
        if (lane == 0) votes[wave] = wdone ? 1 : 0;
        LDS_BARRIER();
        { int all = 1;
#pragma unroll
          for (int w = 0; w < 8; ++w) all &= votes[w];
          if (all) break; }
        if (kt > 0) { kreg = *(const u32x4*)(proj + (size_t)((kt - 1) * 64 + key_l) * PROJ1_LD + 4608 + hd * 64 + c8 * 8); vreg = *(const u32x4*)(proj + (size_t)((kt - 1) * 64 + key_l) * PROJ1_LD + 5120 + hd * 64 + c8 * 8); }
        const int key0 = kt * 64;
#ifdef SB_COUNT_ITERS
        ++g_iters;
#endif
        if (!wdone && key0 < q0 + wave * 16 + 16) {
            f32x4 x[4];
#pragma unroll
            for (int k16 = 0; k16 < 4; ++k16) { x[k16] = (f32x4){0.f, 0.f, 0.f, 0.f};
#pragma unroll
                for (int ks = 0; ks < 2; ++ks) { const bf16x8 kf = *(const LAS bf16x8*)(Kt + (k16 * 16 + fr) * SB_LD + ks * 32 + fq * 8); x[k16] = mfma16(kf, qf[ks], x[k16]); } }
            const bool need_mask = key0 + 63 >= q0 + wave * 16;
            float Rr[4], Tt[4], Ee[4];
#pragma unroll
            for (int k16 = 0; k16 < 4; ++k16) {
#pragma unroll
                for (int r = 0; r < 4; ++r) { const float e = fexp2(fminf(x[k16][r], 80.f)); float rr = frcp(1.f + e), bet = e * rr;
                    if (need_mask && key0 + k16 * 16 + 4 * fq + r >= qrow) { rr = 1.f; bet = 0.f; }
                    x[k16][r] = bet; Rr[k16] = (r == 0) ? rr : Rr[k16];
                    if (r == 0) Tt[k16] = rr; else if (r == 1) Ee[k16] = rr; else if (r == 2) Rr[k16] = rr; else {
                        const float r0 = Tt[k16], r1 = Ee[k16], r2 = Rr[k16], r3 = rr; const float s2 = r3, s1 = r3 * r2, s0 = s1 * r1;
                        x[k16][0] *= s0; x[k16][1] *= s1; x[k16][2] *= s2;
                        Rr[k16] = s0 * r0; } } }
#pragma unroll
            for (int k16 = 0; k16 < 4; ++k16) { const float R = Rr[k16]; const float d1 = __shfl_down(R, 16), d2 = __shfl_down(R, 32), d3 = __shfl_down(R, 48);
                Ee[k16] = (fq < 3 ? d1 : 1.f) * (fq < 2 ? d2 : 1.f) * (fq < 1 ? d3 : 1.f); float t = R; t *= __shfl_xor(t, 16); t *= __shfl_xor(t, 32); Tt[k16] = t; }
            const float TT2 = Tt[3], TT1 = Tt[3] * Tt[2], TT0 = TT1 * Tt[1];
            const float f0 = Ee[0] * TT0 * C, f1 = Ee[1] * TT1 * C, f2 = Ee[2] * TT2 * C, f3 = Ee[3] * C;
            x[0] *= f0; x[1] *= f1; x[2] *= f2; x[3] *= f3;
            C *= TT0 * Tt[0];
            bf16x8 pw[2];
#pragma unroll
            for (int j = 0; j < 2; ++j) { u32x4 p; p.x = cvt_pk_bf16(x[2 * j][0], x[2 * j][1]); p.y = cvt_pk_bf16(x[2 * j][2], x[2 * j][3]); p.z = cvt_pk_bf16(x[2 * j + 1][0], x[2 * j + 1][1]); p.w = cvt_pk_bf16(x[2 * j + 1][2], x[2 * j + 1][3]); pw[j] = __builtin_bit_cast(bf16x8, p); }
#pragma unroll
            for (int dt = 0; dt < 4; ++dt)
#pragma unroll
                for (int j = 0; j < 2; ++j) { const LAS bf16_t* vp = VT + (dt * 16 + fr) * SB_LD + j * 32 + 4 * fq; const u32x2 lo = *(const LAS u32x2*)vp, hi = *(const LAS u32x2*)(vp + 16);
                    u32x4 a; a.x = lo.x; a.y = lo.y; a.z = hi.x; a.w = hi.y; o[dt] = mfma16(__builtin_bit_cast(bf16x8, a), pw[j], o[dt]); }
            wdone = WAVE_ALL(C < 7.8886e-31f);
        }
    }
    bf16_t* op = OKP(bf16_t, WS_CAT1) + ((size_t)b * L + qrow) * 1536 + 1024 + hd * 64 + 4 * fq;
#pragma unroll
    for (int dt = 0; dt < 4; ++dt) { u32x2 w; w.x = cvt_pk_bf16(o[dt][0], o[dt][1]); w.y = cvt_pk_bf16(o[dt][2], o[dt][3]); *(u32x2*)(op + dt * 16) = w; }
}
__device__ __forceinline__ void phase_l1_mix(const Frame& F0) {
    const Frame F = phase_frame(F0);
    if (F.G < 128 || F.G % 8 != 0) { if (F.vcu == 0) for (int u = 0; u < 64; ++u) { gdn_scan_unit(F, u); __syncthreads(); } for (int u = F.vcu; u < NB * 8 * (L / 128); u += F.G) { sb_unit(F, u); __syncthreads(); } return; }
    const int per = F.G / 8, xcd = F.vcu / per, loc = F.vcu % per;
    if (loc < 8) { gdn_scan_unit(F, xcd * 8 + loc);
#if (DUP_MASK >> 3) & 1
        __syncthreads(); gdn_scan_unit(F, xcd * 8 + loc);
#endif
    }
    else for (int rep = 0; rep < 1 + ((DUP_MASK >> 16) & 1); ++rep) for (int u = xcd * (per - 8) + (loc - 8); u < NB * 8 * (L / 128); u += F.G - 64) { sb_unit(F, u); __syncthreads(); }
}
}

namespace ok {
#if CHECK
__device__ const int kSampleRows[16] = {0, 1, 2, 3, 63, 64, 127, 128, 129, 1000, 2047, 2048, 4097, 6000, 8190, 8191};
constexpr int FP_W = 6144;
__device__ __forceinline__ void fp_save(const Frame& F, int k, const void* buf, int ld, int width, bool is_bf16, int dcol0) {
    float* fp = OKP(float, WS_FP) + (size_t)k * 16 * FP_W; const size_t gt = (size_t)blockIdx.x * NT + F.tid, GT = (size_t)F.G * NT;
    for (size_t i = gt; i < (size_t)16 * width; i += GT) { const int r = (int)(i / width), c = (int)(i % width); const size_t src = (size_t)kSampleRows[r] * ld + c;
        fp[r * FP_W + dcol0 + c] = is_bf16 ? bf2f(((const bf16_t*)buf)[src]) : ((const float*)buf)[src]; }
}
__device__ __forceinline__ void fp_cmp(const Frame& F, int k, const float* obuf, int ld, int ocol0, int width, int fcol0) {
    const float* fp = OKP(float, WS_FP) + (size_t)k * 16 * FP_W; const size_t gt = (size_t)blockIdx.x * NT + F.tid, GT = (size_t)F.G * NT; float num = 0.f, den = 0.f;
    for (size_t i = gt; i < (size_t)16 * width; i += GT) { const int r = (int)(i / width), c = (int)(i % width); const float o = obuf[(size_t)kSampleRows[r] * ld + ocol0 + c], f = fp[r * FP_W + fcol0 + c];
        const float d = o - f; num += d * d; den += o * o; if (!(d == d)) num += 1e30f; }
    num = wave_sum(num); den = wave_sum(den);
    if (F.lane == 0 && (num != 0.f || den != 0.f)) { atomicAdd((float*)F.ctl + CW_CHK + 2 * k, num); atomicAdd((float*)F.ctl + CW_CHK + 2 * k + 1, den); }
}
__device__ __forceinline__ void fp_save_lin(const Frame& F, int k, const void* buf, size_t off, int n, bool is_bf16) {
    float* fp = OKP(float, WS_FP) + (size_t)k * 16 * FP_W; const size_t gt = (size_t)blockIdx.x * NT + F.tid, GT = (size_t)F.G * NT;
    for (size_t i = gt; i < (size_t)n; i += GT) fp[i] = is_bf16 ? bf2f(((const bf16_t*)buf)[off + i]) : ((const float*)buf)[off + i];
}
__device__ __forceinline__ void fp_cmp_lin(const Frame& F, int k, const float* obuf, size_t off, int n) {
    const float* fp = OKP(float, WS_FP) + (size_t)k * 16 * FP_W; const size_t gt = (size_t)blockIdx.x * NT + F.tid, GT = (size_t)F.G * NT; float num = 0.f, den = 0.f;
    for (size_t i = gt; i < (size_t)n; i += GT) { const float o = obuf[off + i], f = fp[i]; const float d = o - f; num += d * d; den += o * o; if (!(d == d)) num += 1e30f; }
    num = wave_sum(num); den = wave_sum(den);
    if (F.lane == 0 && (num != 0.f || den != 0.f)) { atomicAdd((float*)F.ctl + CW_CHK + 2 * k, num); atomicAdd((float*)F.ctl + CW_CHK + 2 * k + 1, den); }
}
#endif

struct Args { const float* in[33]; float* out; unsigned char* ws;
#if CHECK
    sm::Ctx oc;
#endif
};

__global__ void __launch_bounds__(512, 2) mk_fwd(Args a) {
    extern __shared__ __attribute__((aligned(16))) unsigned char lds_raw[];
    Frame F; F.lds = (LAS unsigned char*)lds_raw; F.ws = a.ws; F.ctl = (unsigned*)(a.ws + WS_CTL); F.in = a.in; F.out = a.out;
    F.tid = threadIdx.x; F.lane = F.tid & 63; F.wave = __builtin_amdgcn_readfirstlane(F.tid >> 6); F.G = gridDim.x;
    { const int bx = blockIdx.x; F.vcu = (F.G % 8 == 0) ? (bx % 8) * (F.G / 8) + bx / 8 : bx; }
    volatile LAS unsigned* MISC = (volatile LAS unsigned*)(F.lds + LDS_BYTES - 64);
    if (F.tid < 16) MISC[F.tid] = 0u;
    __syncthreads();
    XcdBarrier bar = xcd_barrier_post(F.ctl + CW_BAR, MISC);
#define GRID_BAR() xcd_barrier(bar)
    using namespace sm;
    for (int dup_p = 0; dup_p < ((DUP_MASK >> 5) & 1) + 1; ++dup_p) {
    phase_prologue(F);
    prologue_router_tables(F);
    prologue_w16_tables(F);
    GRID_BAR();
    }
    for (int dup_i0 = 0; dup_i0 < ((DUP_MASK >> 6) & 1) + 1; ++dup_i0) {
    { EpiScaleBf16 E{OKP(bf16_t, WS_PROJ), PROJ0_LD, (const float*)F.ctl + CW_SSQ, 1};
      dense_gemm(F, OKP(bf16_t, WS_HB), OKP(bf16_t, WS_W_IN0), T, 4096, 1024, E); }
    phase_proj16(F, 0, F.in[I_X], nullptr, (const float*)F.ctl + CW_SSQ, 1);
    GRID_BAR();
    }
#if CHECK
    fp_save(F, 0, OKP(bf16_t, WS_PROJ), PROJ0_LD, 4096, true, 0);
#endif
    for (int dup_b = 0; dup_b < ((DUP_MASK >> 1) & 1) + 1; ++dup_b) {
    for (int dup_b1 = 0; dup_b1 < ((DUP_MASK >> 14) & 1) + 1; ++dup_b1) { phase_ssd_a(F); GRID_BAR(); }
#if CHECK
    fp_save_lin(F, 6, OKP(bf16_t, WS_STATES), ((size_t)5 * 16 + 0) * 8192, 65536, true);
    GRID_BAR();
#endif
    phase_kv(F);
    phase_ssd_scan(F, (F.G >= 64 && F.G % 8 == 0) ? 32 : 0);
    GRID_BAR();
    for (int dup_b2 = 0; dup_b2 < ((DUP_MASK >> 15) & 1) + 1; ++dup_b2) { phase_ssd_b(F); GRID_BAR(); }
    }

    for (int dup_o0 = 0; dup_o0 < ((DUP_MASK >> 8) & 1) + 1; ++dup_o0) {
    { EpiResidualT<true> E{F.in[I_X], OKP(bf16_t, WS_HB), OKP(float, WS_SSQP1)};
      dense_gemm(F, OKP(bf16_t, WS_CAT0), OKP(bf16_t, WS_W_OUT0), T, 1024, 1536, E); }
    GRID_BAR();
    }
#if CHECK
    fp_save(F, 10, OKP(bf16_t, WS_HB), 1024, 1024, true, 0);
    fp_save_lin(F, 7, OKP(bf16_t, WS_STATES), ((size_t)5 * 16 + 0) * 8192, 65536, true);
    fp_save(F, 8, OKP(bf16_t, WS_CAT0), 1536, 512, true, 0);
    fp_save(F, 9, OKP(bf16_t, WS_CAT0) + 512, 1536, 1024, true, 0);
    GRID_BAR();
#endif
    for (int dup_q0 = 0; dup_q0 < ((DUP_MASK >> 9) & 1) + 1; ++dup_q0) {
    { EpiScaleBf16 E{OKP(bf16_t, WS_Q), 1024, OKP(float, WS_SSQP1), 16};
      dense_gemm(F, OKP(bf16_t, WS_HB), OKP(bf16_t, WS_W_XA), T, 1024, 1024, E); }
    GRID_BAR();
    }
    for (int dup_xa0 = 0; dup_xa0 < ((DUP_MASK >> 13) & 1) + 1; ++dup_xa0) {
    phase_xattn(F, OKP(bf16_t, WS_Q), OKP(bf16_t, WS_KX), OKP(bf16_t, WS_VT), OKP(bf16_t, WS_ATT));
    GRID_BAR();
    }
    { EpiResidualT<false> E{nullptr, OKP(bf16_t, WS_HB), OKP(float, WS_SSQP2)};
      dense_gemm(F, OKP(bf16_t, WS_ATT), OKP(bf16_t, WS_W_XA + 6 * MiB), T, 1024, 1024, E); }
    GRID_BAR();
#if CHECK
    fp_save(F, 11, OKP(bf16_t, WS_HB), 1024, 1024, true, 0);
    GRID_BAR();
#endif
    phase_router(F, 0, OKP(bf16_t, WS_HB), OKP(float, WS_SSQP2), 16);
    for (int dup_cv = 0; dup_cv < ((DUP_MASK >> 10) & 1) + 1; ++dup_cv) phase_cvt_moe(F, 0);
    GRID_BAR();
    for (int dup_sc = 0; dup_sc < ((DUP_MASK >> 11) & 1) + 1; ++dup_sc) {
    phase_scatter(F, 0, OKP(bf16_t, WS_HB), OKP(float, WS_SSQP2), 16);
    GRID_BAR();
    }
    for (int dup_c = 0; dup_c < ((DUP_MASK >> 2) & 1) + 1; ++dup_c) {
    phase_moe_up(F);
    GRID_BAR();
    phase_moe_down(F);
    GRID_BAR();
    }

    phase_combine(F, OKP(bf16_t, WS_HB), (float*)F.ctl + CW_SSQ + 3 * T, false);
    GRID_BAR();
#if CHECK
    fp_save(F, 12, OKP(bf16_t, WS_HB), 1024, 1024, true, 0);
    GRID_BAR();
#endif
    for (int dup_i1 = 0; dup_i1 < ((DUP_MASK >> 12) & 1) + 1; ++dup_i1) {
    { EpiScaleBf16 E{OKP(bf16_t, WS_PROJ), PROJ1_LD, (const float*)F.ctl + CW_SSQ + 3 * T, 1};
      dense_gemm(F, OKP(bf16_t, WS_HB), OKP(bf16_t, WS_W_IN1), T, 5632, 1024, E); }
    phase_proj16(F, 1, nullptr, OKP(bf16_t, WS_HB), (const float*)F.ctl + CW_SSQ + 3 * T, 1);
    GRID_BAR();
    }
#if CHECK
    fp_save(F, 13, OKP(bf16_t, WS_PROJ), PROJ1_LD, 4096, true, 0);
    fp_save(F, 13, OKP(bf16_t, WS_PROJ) + 4608, PROJ1_LD, 1024, true, 4096);
#endif
    for (int dup_a = 0; dup_a < ((DUP_MASK >> 0) & 1) + 1; ++dup_a) { phase_gdn_prep(F); GRID_BAR(); }
    phase_l1_mix(F); GRID_BAR();
    for (int dup_e = 0; dup_e < ((DUP_MASK >> 4) & 1) + 1; ++dup_e) { phase_gdn_final(F); GRID_BAR(); }

    { EpiResidualT<false> E{nullptr, OKP(bf16_t, WS_HB), OKP(float, WS_SSQP4)};
      dense_gemm(F, OKP(bf16_t, WS_CAT1), OKP(bf16_t, WS_W_OUT1), T, 1024, 1536, E); }
    GRID_BAR();
#if CHECK
    fp_save(F, 14, OKP(bf16_t, WS_CAT1), 1536, 1024, true, 0);
    fp_save(F, 15, OKP(bf16_t, WS_CAT1) + 1024, 1536, 512, true, 0);
    fp_save(F, 16, OKP(bf16_t, WS_HB), 1024, 1024, true, 0);
    GRID_BAR();
#endif
    { EpiScaleBf16 E{OKP(bf16_t, WS_Q), 1024, OKP(float, WS_SSQP4), 16};
      dense_gemm(F, OKP(bf16_t, WS_HB), OKP(bf16_t, WS_W_XA + 8 * MiB), T, 1024, 1024, E); }
    GRID_BAR();
    phase_xattn(F, OKP(bf16_t, WS_Q), OKP(bf16_t, WS_KX) + (size_t)NB * 256 * 1024, OKP(bf16_t, WS_VT) + (size_t)1024 * NB * 256, OKP(bf16_t, WS_ATT));
    GRID_BAR();
    { EpiResidualT<false> E{nullptr, OKP(bf16_t, WS_HB), OKP(float, WS_SSQP5)};
      dense_gemm(F, OKP(bf16_t, WS_ATT), OKP(bf16_t, WS_W_XA + 8 * MiB + 6 * MiB), T, 1024, 1024, E); }
    GRID_BAR();
#if CHECK
    fp_save(F, 17, OKP(bf16_t, WS_HB), 1024, 1024, true, 0);
    GRID_BAR();
#endif
    phase_router(F, 1, OKP(bf16_t, WS_HB), OKP(float, WS_SSQP5), 16);
    phase_cvt_moe(F, 1);
    GRID_BAR();
    phase_scatter(F, 1, OKP(bf16_t, WS_HB), OKP(float, WS_SSQP5), 16);
    GRID_BAR();
    phase_moe_up(F);
    GRID_BAR();
    phase_moe_down(F);
    GRID_BAR();
    phase_combine(F, OKP(bf16_t, WS_HB), nullptr, true);
#if CHECK
    GRID_BAR();
    fp_save(F, 18, F.out, 1024, 1024, false, 0);
    fp_save(F, 1, OKP(float, WS_DTV), 16, 16, false, 0);
    fp_save(F, 2, OKP(float, WS_ACS), 16, 16, false, 0);
    GRID_BAR();
    {
        const size_t gid = (size_t)blockIdx.x * NT + F.tid, gs = (size_t)F.G * NT;
        for (int st = 0;; ++st) {
            const int s = st % sm::NSTAGE_L;
            if (st < 2 * sm::NSTAGE_L && s >= sm::N_STAGES_USED) continue;
            if (!sm::run_stage(a.oc, st, gid, gs)) break;
            GRID_BAR();
            if (st == 3) fp_cmp(F, 0, a.oc.proj, sm::PROJ_LD, 0, 4096, 0);
            if (st == 4) { fp_cmp(F, 1, a.oc.dtv, 16, 0, 16, 0); fp_cmp(F, 2, a.oc.acs, 16, 0, 16, 0); }
            if (st == 4 && gid == 0) { float* c = (float*)F.ctl + CW_CHK; c[6] = 0.f; c[7] = 1.f; c[8] = 0.f; c[9] = 1.f; c[10] = 0.f; c[11] = 1.f; }
            if (st == 5) fp_cmp_lin(F, 6, a.oc.states, ((size_t)5 * 16 + 0) * 8192, 65536);
            if (st == 6) fp_cmp_lin(F, 7, a.oc.states, ((size_t)5 * 16 + 0) * 8192, 65536);
            if (st == 10) { fp_cmp(F, 8, a.oc.cat, 1536, 0, 512, 0); fp_cmp(F, 9, a.oc.cat, 1536, 512, 1024, 0); }
            if (st == 11) fp_cmp(F, 10, a.oc.h, 1024, 0, 1024, 0);
            if (st == 18) fp_cmp(F, 11, a.oc.h, 1024, 0, 1024, 0);
            if (st == 23) fp_cmp(F, 12, a.oc.h, 1024, 0, 1024, 0);
            if (st == 63) { fp_cmp(F, 13, a.oc.proj, sm::PROJ_LD, 0, 4096, 0); fp_cmp(F, 13, a.oc.proj, sm::PROJ_LD, 4624, 1024, 4096); }
            if (st == 70) { fp_cmp(F, 14, a.oc.cat, 1536, 0, 1024, 0); fp_cmp(F, 15, a.oc.cat, 1536, 1024, 512, 0); }
            if (st == 71) fp_cmp(F, 16, a.oc.h, 1024, 0, 1024, 0);
            if (st == 78) fp_cmp(F, 17, a.oc.h, 1024, 0, 1024, 0);
            if (st == 121) fp_cmp(F, 18, a.oc.out, 1024, 0, 1024, 0);
            GRID_BAR();
        }
        GRID_BAR();
        int code = 0;
        for (int k = CHECK - 1; k >= 0; --k) { const float num = __hip_atomic_load((float*)F.ctl + CW_CHK + 2 * k, __ATOMIC_RELAXED, __HIP_MEMORY_SCOPE_AGENT), den = __hip_atomic_load((float*)F.ctl + CW_CHK + 2 * k + 1, __ATOMIC_RELAXED, __HIP_MEMORY_SCOPE_AGENT);
            if (!(num <= 1e-3f * den) || den == 0.f) code = k + 1; }
        const float sc = 1.f + 0.2f * (float)code;
        for (size_t i = gid; i < (size_t)L * DM; i += gs) { F.out[i] *= sc; F.out[(size_t)L * DM + i] = 0.f; }
    }
#endif
}
}

extern "C" void kernel_launch(void* const* d_in, const int* in_sizes, int n_in, void* d_out, int out_size, void* d_ws, size_t ws_size, hipStream_t stream) {
    static int grid = 0;
    if (grid == 0) {
        int dev = 0, cus = 0, per_cu = 0;
        hipGetDevice(&dev); hipDeviceGetAttribute(&cus, hipDeviceAttributeMultiprocessorCount, dev);
        if (hipFuncSetAttribute((const void*)ok::mk_fwd, hipFuncAttributeMaxDynamicSharedMemorySize, LDS_BYTES) != hipSuccess) { fprintf(stderr, "kernel_launch: hipFuncSetAttribute failed\n"); grid = -1; return; }
        hipOccupancyMaxActiveBlocksPerMultiprocessor(&per_cu, (const void*)ok::mk_fwd, ok::NT, LDS_BYTES);
        (void)hipGetLastError();
        grid = cus;
        if (n_in != 33 || ws_size < ok::WS_END || per_cu < 1) { fprintf(stderr, "kernel_launch: n_in %d ws %zu need %zu per_cu %d\n", n_in, ws_size, (size_t)ok::WS_END, per_cu); grid = -1; }
    }
    if (grid < 0) return;
    hipMemsetAsync((char*)d_ws + ok::WS_CTL, 0, ok::CTL_BYTES, stream);
    ok::Args a{};
    for (int i = 0; i < 33; ++i) a.in[i] = (const float*)d_in[i];
    a.out = (float*)d_out; a.ws = (unsigned char*)d_ws;
#if CHECK
    sm::carve(a.oc, (float*)((char*)d_ws + 16 * ok::MiB));
    for (int i = 0; i < 33; ++i) a.oc.in[i] = (const float*)d_in[i];
    a.oc.out = (float*)d_out;
#endif
    hipLaunchKernelGGL(ok::mk_fwd, dim3(grid), dim3(ok::NT), LDS_BYTES, stream, a);
}
```

```cpp
#include <hip/hip_runtime.h>
#include <cstdio>
#include <cstdint>
#ifndef CHECK
#define CHECK 0
#endif
#define DUP_MASK 0
constexpr int LDS_BYTES = 147456;

#define XB_TMO      128
#define XB_XCNT(j)  (256  + 64 * (j))
#define XB_XSUB(j)  (1280 + 64 * (j))
#define XB_XGEN(j)  (2304 + 64 * (j))
#define XB_TOP      3328
#define XB_TOPGEN   3392
#define XCD_BAR_WORDS 3456
#define XB_SPIN_CAP (1u << 18)
#define LAS __attribute__((address_space(3)))

__device__ __forceinline__ unsigned xb_ld(unsigned* p)              { return __hip_atomic_load(p, __ATOMIC_RELAXED, __HIP_MEMORY_SCOPE_AGENT); }
__device__ __forceinline__ unsigned xb_add(unsigned* p, unsigned v) { return __hip_atomic_fetch_add(p, v, __ATOMIC_RELAXED, __HIP_MEMORY_SCOPE_AGENT); }
__device__ __forceinline__ unsigned xb_xcc_id() { return (unsigned)__builtin_amdgcn_s_getreg((3 << 11) | 20) & 0xFu; }
#define XB_SPIN(cond, bar) do { unsigned _sp = 0; while (cond) { __builtin_amdgcn_s_sleep(1); \
    if ((++_sp & 255u) == 0u) { if (xb_ld(&(bar)[XB_TMO])) break; if (_sp > XB_SPIN_CAP) { atomicAdd(&(bar)[XB_TMO], 1u); break; } } } } while (0)

struct XcdBarrier {
    unsigned* bar; unsigned x;
    volatile LAS unsigned* st;
};

__device__ __forceinline__ XcdBarrier xcd_barrier_post(unsigned* bar, volatile LAS unsigned* st) {
    XcdBarrier b; b.bar = bar; b.x = xb_xcc_id(); b.st = st;
    if (threadIdx.x == 0) (void)xb_add(&bar[XB_XCNT(b.x)], 1u);
    return b;
}
__device__ __forceinline__ void xcd_barrier_complete(unsigned* bar, unsigned x, unsigned& nloc, unsigned& nx) {
    const unsigned G = gridDim.x * gridDim.y * gridDim.z;
    unsigned sum, cnt, mine, sp = 0u;
    for (;;) {
        sum = 0u; cnt = 0u; mine = 0u;
#pragma unroll
        for (unsigned j = 0; j < 16; ++j) { const unsigned c = xb_ld(&bar[XB_XCNT(j)]); sum += c; cnt += (c > 0u) ? 1u : 0u; mine = (j == x) ? c : mine; }
        if (sum == G) break;
        __builtin_amdgcn_s_sleep(1);
        if ((++sp & 255u) == 0u) { if (xb_ld(&bar[XB_TMO])) break; if (sp > XB_SPIN_CAP) { atomicAdd(&bar[XB_TMO], 1u); break; } }
    }
    nloc = mine > 0u ? mine : 1u; nx = cnt > 0u ? cnt : 1u;
}

__device__ __forceinline__ void xcd_barrier(const XcdBarrier& b) {
    asm volatile("s_waitcnt vmcnt(0)" ::: "memory");
    __syncthreads();
    if (threadIdx.x == 0) {
        unsigned* bar = b.bar;
        __builtin_amdgcn_s_waitcnt(0);
        unsigned nloc = b.st[0], nx = b.st[1];
        if (nloc == 0u) { xcd_barrier_complete(bar, b.x, nloc, nx); b.st[0] = nloc; b.st[1] = nx; }
        const unsigned old = xb_add(&bar[XB_XSUB(b.x)], 1u);
        const unsigned gen = old / nloc;
        if (old + 1u == (gen + 1u) * nloc) {
            __builtin_amdgcn_fence(__ATOMIC_RELEASE, "agent");
            asm volatile("s_waitcnt vmcnt(0)" ::: "memory");
            const unsigned og = xb_add(&bar[XB_TOP], 1u);
            const unsigned tg = og / nx;
            if (og + 1u == (tg + 1u) * nx) xb_add(&bar[XB_TOPGEN], 1u);
            else XB_SPIN(xb_ld(&bar[XB_TOPGEN]) == tg, bar);
            __builtin_amdgcn_fence(__ATOMIC_ACQUIRE, "agent");
            xb_add(&bar[XB_XGEN(b.x)], 1u);
            asm volatile("s_waitcnt vmcnt(0)" ::: "memory");
        } else {
            XB_SPIN(xb_ld(&bar[XB_XGEN(b.x)]) == gen, bar);
            __builtin_amdgcn_fence(__ATOMIC_ACQUIRE, "agent");
            asm volatile("s_waitcnt vmcnt(0)" ::: "memory");
        }
    }
    __syncthreads();
}


#undef LAS

#ifndef SEQ
#define SEQ 8192
#endif
namespace sm {
constexpr int DM = 1024, NB = 1  , L = SEQ, T = NB * L, NCH = L / 64, MEM = 256;
constexpr int EV_IN = 4112, OD_IN = 5648, PROJ_LD = 5648;
constexpr int E_SCB = 0, E_SCC = 512, E_SCX = 1024, E_Z = 1536, E_XBC = 2560, E_DT = 4096;
constexpr int O_QKV = 0, O_Z = 3072, O_A = 4096, O_B = 4104, O_SQ = 4112, O_SK = 4624, O_SV = 5136;

struct Ctx {
    const float* in[33];
    float* out;
    float *memn, *kx, *vx, *h, *un, *rstd, *proj, *cat, *xbcc, *dtv, *acs, *states, *cb, *ybuf, *rstd2;
    float *q, *att, *sc;
    float *gatew, *act; int* eid;
    float *qkvc, *beta, *gcs, *Lm, *aqk, *uw, *S, *vn, *obuf;
};
enum In { I_X = 0, I_MEM, I_MEM_NORM, I_FINAL_NORM, I_NORM_MIX, I_NORM_XA, I_NORM_FFN, I_XA_WQ, I_XA_WK, I_XA_WV, I_XA_WO,
          I_MOE_WG, I_MOE_BG, I_MOE_WE, I_MOE_BE, I_MOE_WGATE, I_MOE_WUP, I_MOE_WDOWN,
          I_EV_WIN, I_EV_SCCONV, I_EV_CONVW, I_EV_CONVB, I_EV_DTB, I_EV_ALOG, I_EV_D, I_EV_NORM, I_EV_WOUT,
          I_OD_WIN, I_OD_CONV, I_OD_DTB, I_OD_ALOG, I_OD_NORM, I_OD_WOUT };

__device__ __forceinline__ float siluf(float x) { return x / (1.f + expf(-x)); }
__device__ __forceinline__ float softplusf(float x) { return x > 20.f ? x : log1pf(expf(x)); }
__device__ __forceinline__ float sigmoidf(float x) { return 1.f / (1.f + expf(-x)); }

__device__ __forceinline__ void s_copy(const float* src, float* dst, size_t n, size_t gid, size_t gs) { for (size_t i = gid; i < n; i += gs) dst[i] = src[i]; }
__device__ __forceinline__ void s_rstd(const float* x, int R, int W, int ld, float* rstd, size_t gid, size_t gs) {
    for (size_t r = gid; r < (size_t)R; r += gs) { const float* p = x + r * ld; float s = 0.f; for (int i = 0; i < W; ++i) s += p[i] * p[i]; rstd[r] = 1.f / sqrtf(s / W + 1e-6f); }
}
__device__ __forceinline__ void s_norm(const float* x, const float* rstd, const float* g, float* y, int R, size_t gid, size_t gs) {
    for (size_t i = gid; i < (size_t)R * DM; i += gs) { const size_t r = i / DM; const int c = (int)(i % DM); y[i] = x[i] * rstd[r] * g[c]; }
}
__device__ __forceinline__ void s_gemm(const float* A, int lda, const float* W, int ldw, float* C, int ldc, int M, int N, int K, int accum, size_t gid, size_t gs) {
    const int N4 = N / 4;
    for (size_t i = gid; i < (size_t)M * N4; i += gs) { const size_t m = i / N4; const int n = (int)(i % N4) * 4; const float* a = A + m * lda; const float* w = W + n; float s0 = 0.f, s1 = 0.f, s2 = 0.f, s3 = 0.f;
        for (int k = 0; k < K; ++k) { const float av = a[k]; const float4 wv = *(const float4*)(w + (size_t)k * ldw); s0 += av * wv.x; s1 += av * wv.y; s2 += av * wv.z; s3 += av * wv.w; }
        float4* c = (float4*)(C + m * ldc + n); float4 o = accum ? *c : float4{0.f, 0.f, 0.f, 0.f}; o.x += s0; o.y += s1; o.z += s2; o.w += s3; *c = o; }
}
__device__ __forceinline__ void s_scmix(const Ctx& c, size_t gid, size_t gs) {
    const float* w = c.in[I_EV_SCCONV];
    for (size_t i = gid; i < (size_t)T * 512; i += gs) { const size_t t = i / 512; const int ch = (int)(i % 512); const int tl = (int)(t % L); float s = 0.f;
        for (int j = 0; j < 3; ++j) { const int tt = tl - 2 + j; if (tt >= 0) { const float* p = c.proj + (t - 2 + j) * PROJ_LD; s += w[j * 512 + ch] * p[E_SCC + ch] * p[E_SCX + ch]; } }
        c.cat[t * 1536 + ch] = c.proj[t * PROJ_LD + E_SCB + ch] * s; }
}
__device__ __forceinline__ void s_ssd_conv(const Ctx& c, size_t gid, size_t gs) {
    const float* w = c.in[I_EV_CONVW]; const float* b = c.in[I_EV_CONVB];
    for (size_t i = gid; i < (size_t)T * 1536; i += gs) { const size_t t = i / 1536; const int ch = (int)(i % 1536); const int tl = (int)(t % L); float s = b[ch];
        for (int j = 0; j < 4; ++j) { const int tt = tl - 3 + j; if (tt >= 0) s += w[j * 1536 + ch] * c.proj[(t - 3 + j) * PROJ_LD + E_XBC + ch]; }
        c.xbcc[i] = siluf(s); }
}
__device__ __forceinline__ void s_ssd_dt(const Ctx& c, size_t gid, size_t gs) {
    for (size_t i = gid; i < (size_t)NB * NCH * 16; i += gs) { const int hd = (int)(i % 16); const size_t bc = i / 16; const float a = -expf(c.in[I_EV_ALOG][hd]); float cs = 0.f;
        for (int s = 0; s < 64; ++s) { const size_t t = bc * 64 + s; const float dt = softplusf(c.proj[t * PROJ_LD + E_DT + hd] + c.in[I_EV_DTB][hd]); cs += dt * a; c.dtv[t * 16 + hd] = dt; c.acs[t * 16 + hd] = cs; } }
}
__device__ __forceinline__ void s_ssd_states(const Ctx& c, size_t gid, size_t gs) {
    for (size_t i = gid; i < (size_t)NB * NCH * 16 * 64 * 128; i += gs) { const int n = (int)(i % 128); const int p = (int)((i / 128) % 64); const int hd = (int)((i / 8192) % 16); const size_t bc = i / (8192 * 16);
        const int g = hd / 8; const float last = c.acs[(bc * 64 + 63) * 16 + hd]; float s = 0.f;
        for (int k = 0; k < 64; ++k) { const size_t t = bc * 64 + k; s += c.xbcc[t * 1536 + 1024 + g * 128 + n] * c.xbcc[t * 1536 + hd * 64 + p] * c.dtv[t * 16 + hd] * expf(last - c.acs[t * 16 + hd]); }
        c.states[i] = s; }
}
__device__ __forceinline__ void s_ssd_scan(const Ctx& c, size_t gid, size_t gs) {
    for (size_t i = gid; i < (size_t)NB * 16 * 8192; i += gs) { const size_t b = i / (16 * 8192); const size_t r = i % (16 * 8192); const int hd = (int)(r / 8192); float s = 0.f;
        for (int ch = 0; ch < NCH; ++ch) { const size_t bc = b * NCH + ch; const size_t idx = bc * (16 * 8192) + r; const float st = c.states[idx]; c.states[idx] = s; s = s * expf(c.acs[(bc * 64 + 63) * 16 + hd]) + st; } }
}
__device__ __forceinline__ void s_ssd_cb(const Ctx& c, size_t gid, size_t gs) {
    for (size_t i = gid; i < (size_t)NB * NCH * 2 * 4096; i += gs) { const int s = (int)(i % 64); const int t = (int)((i / 64) % 64); const int g = (int)((i / 4096) % 2); const size_t bc = i / 8192;
        const float* cm = c.xbcc + (bc * 64 + t) * 1536 + 1280 + g * 128; const float* bm = c.xbcc + (bc * 64 + s) * 1536 + 1024 + g * 128; float a = 0.f;
        for (int n = 0; n < 128; ++n) a += cm[n] * bm[n];
        c.cb[i] = a; }
}
__device__ __forceinline__ void s_ssd_y(const Ctx& c, size_t gid, size_t gs) {
    for (size_t i = gid; i < (size_t)T * 1024; i += gs) { const size_t t = i / 1024; const int hp = (int)(i % 1024); const int hd = hp / 64, p = hp % 64, g = hd / 8; const size_t bc = t / 64; const int tl = (int)(t % 64);
        const float at = c.acs[t * 16 + hd]; float y = 0.f;
        for (int s = 0; s <= tl; ++s) { const size_t ts = bc * 64 + s; y += c.cb[(bc * 2 + g) * 4096 + tl * 64 + s] * expf(at - c.acs[ts * 16 + hd]) * c.xbcc[ts * 1536 + hp] * c.dtv[ts * 16 + hd]; }
        const float* cm = c.xbcc + t * 1536 + 1280 + g * 128; const float* pv = c.states + (bc * 16 + hd) * 8192 + p * 128; float yo = 0.f;
        for (int n = 0; n < 128; ++n) yo += cm[n] * pv[n];
        y += yo * expf(at) + c.xbcc[t * 1536 + hp] * c.in[I_EV_D][hd];
        c.ybuf[i] = y * siluf(c.proj[t * PROJ_LD + E_Z + hp]); }
}
__device__ __forceinline__ void s_ssd_out(const Ctx& c, size_t gid, size_t gs) {
    for (size_t i = gid; i < (size_t)T * 1024; i += gs) { const size_t t = i / 1024; const int ch = (int)(i % 1024); c.cat[t * 1536 + 512 + ch] = c.ybuf[i] * c.rstd2[t * 2 + ch / 512] * c.in[I_EV_NORM][ch]; }
}
__device__ __forceinline__ void s_xa_scores(const Ctx& c, size_t gid, size_t gs) {
    for (size_t i = gid; i < (size_t)T * 4 * 256; i += gs) { const int m = (int)(i % 256); const int hd = (int)((i / 256) % 4); const size_t t = i / 1024; const size_t b = t / L;
        const float* q = c.q + t * 1024 + hd * 256; const float* k = c.kx + (b * 256 + m) * 1024 + hd * 256; float s = 0.f;
        for (int d = 0; d < 256; ++d) s += q[d] * k[d];
        c.sc[i] = s * 0.0625f; }
}
__device__ __forceinline__ void s_xa_softmax(const Ctx& c, size_t gid, size_t gs) {
    for (size_t i = gid; i < (size_t)T * 4; i += gs) { float* p = c.sc + i * 256; float mx = p[0]; for (int m = 1; m < 256; ++m) mx = fmaxf(mx, p[m]); float s = 0.f; for (int m = 0; m < 256; ++m) { const float e = expf(p[m] - mx); p[m] = e; s += e; } const float r = 1.f / s; for (int m = 0; m < 256; ++m) p[m] *= r; }
}
__device__ __forceinline__ void s_xa_pv(const Ctx& c, size_t gid, size_t gs) {
    for (size_t i = gid; i < (size_t)T * 1024; i += gs) { const size_t t = i / 1024; const int col = (int)(i % 1024); const int hd = col / 256; const size_t b = t / L; const float* p = c.sc + (t * 4 + hd) * 256; const float* v = c.vx + b * 256 * 1024 + col; float s = 0.f;
        for (int m = 0; m < 256; ++m) s += p[m] * v[(size_t)m * 1024];
        c.att[i] = s; }
}
__device__ __forceinline__ void s_router(const Ctx& c, int l, size_t gid, size_t gs) {
    const float* wg = c.in[I_MOE_WG] + (size_t)l * 1024 * 4; const float* bg = c.in[I_MOE_BG] + l * 4; const float* we = c.in[I_MOE_WE] + (size_t)l * 1024 * 32; const float* be = c.in[I_MOE_BE] + l * 32;
    for (size_t t = gid; t < (size_t)T; t += gs) { const float* x = c.un + t * 1024; float g0 = 0.f, g1 = 0.f, g2 = 0.f, g3 = 0.f;
        for (int k = 0; k < 1024; ++k) { const float xv = x[k]; g0 += xv * wg[k * 4 + 0]; g1 += xv * wg[k * 4 + 1]; g2 += xv * wg[k * 4 + 2]; g3 += xv * wg[k * 4 + 3]; }
        g0 += bg[0]; g1 += bg[1]; g2 += bg[2]; g3 += bg[3];
        int gsel = 0; float gm = g0; if (g1 > gm) { gm = g1; gsel = 1; } if (g2 > gm) { gm = g2; gsel = 2; } if (g3 > gm) { gm = g3; gsel = 3; }
        const float gw = 1.f / (expf(g0 - gm) + expf(g1 - gm) + expf(g2 - gm) + expf(g3 - gm));
        float e0 = 0, e1 = 0, e2 = 0, e3 = 0, e4 = 0, e5 = 0, e6 = 0, e7 = 0; const float* w = we + gsel * 8;
        for (int k = 0; k < 1024; ++k) { const float xv = x[k]; const float* wk = w + k * 32; e0 += xv * wk[0]; e1 += xv * wk[1]; e2 += xv * wk[2]; e3 += xv * wk[3]; e4 += xv * wk[4]; e5 += xv * wk[5]; e6 += xv * wk[6]; e7 += xv * wk[7]; }
        const float* bb = be + gsel * 8; e0 += bb[0]; e1 += bb[1]; e2 += bb[2]; e3 += bb[3]; e4 += bb[4]; e5 += bb[5]; e6 += bb[6]; e7 += bb[7];
        int i1 = 0; float m1 = e0;
#define SM_T1(j, v) if (v > m1) { m1 = v; i1 = j; }
        SM_T1(1, e1) SM_T1(2, e2) SM_T1(3, e3) SM_T1(4, e4) SM_T1(5, e5) SM_T1(6, e6) SM_T1(7, e7)
        int i2 = -1; float m2 = -3.0e38f;
#define SM_T2(j, v) if (j != i1 && v > m2) { m2 = v; i2 = j; }
        SM_T2(0, e0) SM_T2(1, e1) SM_T2(2, e2) SM_T2(3, e3) SM_T2(4, e4) SM_T2(5, e5) SM_T2(6, e6) SM_T2(7, e7)
        const float r = expf(m2 - m1); const float w1 = gw / (1.f + r), w2 = gw * r / (1.f + r);
        c.eid[t * 2 + 0] = gsel * 8 + i1; c.eid[t * 2 + 1] = gsel * 8 + i2; c.gatew[t * 2 + 0] = w1; c.gatew[t * 2 + 1] = w2; }
}
__device__ __forceinline__ void s_moe_up(const Ctx& c, int l, size_t gid, size_t gs) {
    for (size_t i = gid; i < (size_t)T * 2 * 512; i += gs) { const int f = (int)(i % 512); const size_t tk = i / 512; const size_t t = tk / 2; const int e = c.eid[tk] & 31;
        const float* wg = c.in[I_MOE_WGATE] + ((size_t)l * 32 + e) * 1024 * 512 + f; const float* wu = c.in[I_MOE_WUP] + ((size_t)l * 32 + e) * 1024 * 512 + f; const float* x = c.un + t * 1024; float a = 0.f, b = 0.f;
        for (int k = 0; k < 1024; ++k) { a += x[k] * wg[(size_t)k * 512]; b += x[k] * wu[(size_t)k * 512]; }
        c.act[i] = siluf(a) * b; }
}
__device__ __forceinline__ void s_moe_down(const Ctx& c, int l, size_t gid, size_t gs) {
    for (size_t i = gid; i < (size_t)T * 1024; i += gs) { const size_t t = i / 1024; const int n = (int)(i % 1024); float y = 0.f;
        for (int k = 0; k < 2; ++k) { const int e = c.eid[t * 2 + k] & 31; const float* wd = c.in[I_MOE_WDOWN] + ((size_t)l * 32 + e) * 512 * 1024 + n; const float* a = c.act + (t * 2 + k) * 512; float s = 0.f;
            for (int f = 0; f < 512; ++f) s += a[f] * wd[(size_t)f * 1024];
            y += s * c.gatew[t * 2 + k]; }
        c.h[i] += y; }
}
__device__ __forceinline__ void s_gdn_conv(const Ctx& c, size_t gid, size_t gs) {
    const float* w = c.in[I_OD_CONV];
    for (size_t i = gid; i < (size_t)T * 3072; i += gs) { const size_t t = i / 3072; const int ch = (int)(i % 3072); const int tl = (int)(t % L); float s = 0.f;
        for (int j = 0; j < 4; ++j) { const int tt = tl - 3 + j; if (tt >= 0) s += w[j * 3072 + ch] * c.proj[(t - 3 + j) * PROJ_LD + O_QKV + ch]; }
        c.qkvc[i] = siluf(s); }
}
__device__ __forceinline__ void s_gdn_qkscale(const Ctx& c, size_t gid, size_t gs) {
    for (size_t i = gid; i < (size_t)T * 16; i += gs) { const size_t t = i / 16; const int wh = (int)(i % 16); float* p = c.qkvc + t * 3072 + wh * 128; float s = 0.f; for (int d = 0; d < 128; ++d) s += p[d] * p[d];
        float r = 1.f / sqrtf(s + 1e-6f); if (wh < 8) r *= 0.08838834764831845f; for (int d = 0; d < 128; ++d) p[d] *= r; }
}
__device__ __forceinline__ void s_gdn_gates(const Ctx& c, size_t gid, size_t gs) {
    for (size_t i = gid; i < (size_t)NB * NCH * 8; i += gs) { const int hd = (int)(i % 8); const size_t bc = i / 8; const float na = -expf(c.in[I_OD_ALOG][hd]); const float db = c.in[I_OD_DTB][hd]; float cs = 0.f;
        for (int s = 0; s < 64; ++s) { const size_t t = bc * 64 + s; cs += na * softplusf(c.proj[t * PROJ_LD + O_A + hd] + db); c.gcs[t * 8 + hd] = cs; c.beta[t * 8 + hd] = sigmoidf(c.proj[t * PROJ_LD + O_B + hd]); } }
}
__device__ __forceinline__ void s_gdn_kk(const Ctx& c, size_t gid, size_t gs) {
    for (size_t i = gid; i < (size_t)NB * NCH * 8 * 4096; i += gs) { const int s = (int)(i % 64); const int t = (int)((i / 64) % 64); const int hd = (int)((i / 4096) % 8); const size_t bc = i / (4096 * 8);
        float lv = 0.f, av = 0.f;
        if (s <= t) { const size_t tt = bc * 64 + t, ts = bc * 64 + s; const float* kt = c.qkvc + tt * 3072 + 1024 + hd * 128; const float* ks = c.qkvc + ts * 3072 + 1024 + hd * 128; const float* qt = c.qkvc + tt * 3072 + hd * 128; float kk = 0.f, qk = 0.f;
            for (int d = 0; d < 128; ++d) { kk += kt[d] * ks[d]; qk += qt[d] * ks[d]; }
            const float dec = expf(c.gcs[tt * 8 + hd] - c.gcs[ts * 8 + hd]); av = qk * dec; if (s < t) lv = kk * c.beta[tt * 8 + hd] * dec; }
        c.Lm[i] = lv; c.aqk[i] = av; }
}
__device__ __forceinline__ void s_gdn_solve(const Ctx& c, size_t gid, size_t gs) {
    for (size_t i = gid; i < (size_t)NB * NCH * 8 * 256; i += gs) { const int j = (int)(i % 256); const int hd = (int)((i / 256) % 8); const size_t bc = i / 2048; float* sol = c.uw + (bc * 8 + hd) * (64 * 256) + j; const float* Lp = c.Lm + (bc * 8 + hd) * 4096;
        for (int t = 0; t < 64; ++t) { const size_t tt = bc * 64 + t; const float bt = c.beta[tt * 8 + hd];
            float r = (j < 128) ? c.qkvc[tt * 3072 + 2048 + hd * 128 + j] * bt : c.qkvc[tt * 3072 + 1024 + hd * 128 + (j - 128)] * bt * expf(c.gcs[tt * 8 + hd]);
            for (int s = 0; s < t; ++s) r -= Lp[t * 64 + s] * sol[(size_t)s * 256];
            sol[(size_t)t * 256] = r; } }
}
__device__ __forceinline__ void s_gdn_scan(const Ctx& c, size_t gid, size_t gs) {
    for (size_t i = gid; i < (size_t)NB * 8 * 128; i += gs) { const int j = (int)(i % 128); const size_t bh = i / 128; const int hd = (int)(bh % 8); const size_t b = bh / 8; float* S = c.S + bh * 16384 + j; float* vn = c.vn + bh * 8192 + j;
        for (int d = 0; d < 128; ++d) S[(size_t)d * 128] = 0.f;
        for (int ch = 0; ch < NCH; ++ch) { const size_t bc = b * NCH + ch; const float* uw = c.uw + (bc * 8 + hd) * (64 * 256); const float* aq = c.aqk + (bc * 8 + hd) * 4096; const float glast = c.gcs[(bc * 64 + 63) * 8 + hd];
            for (int t = 0; t < 64; ++t) { float v = uw[t * 256 + j]; const float* w = uw + t * 256 + 128; for (int d = 0; d < 128; ++d) v -= w[d] * S[(size_t)d * 128]; vn[(size_t)t * 128] = v; }
            for (int t = 0; t < 64; ++t) { const size_t tt = bc * 64 + t; const float* q = c.qkvc + tt * 3072 + hd * 128; float o = 0.f; for (int d = 0; d < 128; ++d) o += q[d] * S[(size_t)d * 128];
                o *= expf(c.gcs[tt * 8 + hd]); for (int s = 0; s <= t; ++s) o += aq[t * 64 + s] * vn[(size_t)s * 128];
                c.obuf[tt * 1024 + hd * 128 + j] = o; }
            const float dl = expf(glast);
            for (int d = 0; d < 128; ++d) { float a = S[(size_t)d * 128] * dl; for (int t = 0; t < 64; ++t) { const size_t tt = bc * 64 + t; a += c.qkvc[tt * 3072 + 1024 + hd * 128 + d] * expf(glast - c.gcs[tt * 8 + hd]) * vn[(size_t)t * 128]; } S[(size_t)d * 128] = a; } } }
}
__device__ __forceinline__ void s_gdn_out(const Ctx& c, size_t gid, size_t gs) {
    for (size_t i = gid; i < (size_t)T * 1024; i += gs) { const size_t t = i / 1024; const int col = (int)(i % 1024); c.cat[t * 1536 + col] = c.obuf[i] * c.rstd2[t * 8 + col / 128] * c.in[I_OD_NORM][col % 128] * siluf(c.proj[t * PROJ_LD + O_Z + col]); }
}
__device__ __forceinline__ void s_sb(const Ctx& c, size_t gid, size_t gs) {
    for (size_t i = gid; i < (size_t)T * 32; i += gs) { const int qd = (int)(i % 4); const int hd = (int)((i / 4) % 8); const size_t t = i / 32; const int tl = (int)(t % L); const float* q = c.proj + t * PROJ_LD + O_SQ + hd * 64;
        float o[16];
#pragma unroll
        for (int d = 0; d < 16; ++d) o[d] = 0.f;
        float carry = 0.f;
        for (int s = tl - 1; s >= 0 && carry > -150.f; --s) { const size_t ts = t - (size_t)(tl - s); const float* k = c.proj + ts * PROJ_LD + O_SK + hd * 64; const float* v = c.proj + ts * PROJ_LD + O_SV + hd * 64 + qd * 16; float lg = 0.f;
            for (int d = 0; d < 64; ++d) lg += q[d] * k[d];
            lg *= 0.125f; const float wgt = expf(-softplusf(-lg) + carry); carry -= softplusf(lg);
#pragma unroll
            for (int d = 0; d < 16; ++d) o[d] += wgt * v[d]; }
#pragma unroll
        for (int d = 0; d < 16; ++d) c.cat[t * 1536 + 1024 + hd * 64 + qd * 16 + d] = o[d]; }
}
__device__ __forceinline__ void s_final(const Ctx& c, size_t gid, size_t gs) { s_norm(c.h, c.rstd, c.in[I_FINAL_NORM], c.out, T, gid, gs); }

constexpr int XA_BASE = 20, MOE_BASE = 30, L1_BASE = 40, NSTAGE_L = 60;
__device__ __forceinline__ bool run_stage(const Ctx& c, int st, size_t gid, size_t gs) {
    const int layer = st / NSTAGE_L, s = st % NSTAGE_L;
    if (st >= 2 * NSTAGE_L + 2) return false;
    if (st == 2 * NSTAGE_L) { s_rstd(c.h, T, DM, DM, c.rstd, gid, gs); return true; }
    if (st == 2 * NSTAGE_L + 1) { s_final(c, gid, gs); return true; }
    const int l = layer;
    switch (s) {
    case 0: if (l == 0) { s_copy(c.in[I_X], c.h, (size_t)T * DM, gid, gs); s_rstd(c.in[I_MEM], NB * MEM, DM, DM, c.rstd2, gid, gs); } break;
    case 1: if (l == 0) s_norm(c.in[I_MEM], c.rstd2, c.in[I_MEM_NORM], c.memn, NB * MEM, gid, gs); s_rstd(c.h, T, DM, DM, c.rstd, gid, gs); break;
    case 2: s_norm(c.h, c.rstd, c.in[I_NORM_MIX] + l * DM, c.un, T, gid, gs); break;
    case 3: if (l == 0) s_gemm(c.un, DM, c.in[I_EV_WIN], EV_IN, c.proj, PROJ_LD, T, EV_IN, DM, 0, gid, gs); else s_gemm(c.un, DM, c.in[I_OD_WIN], OD_IN, c.proj, PROJ_LD, T, OD_IN, DM, 0, gid, gs); break;
    case 4: if (l == 0) { s_scmix(c, gid, gs); s_ssd_conv(c, gid, gs); s_ssd_dt(c, gid, gs); } else { s_gdn_conv(c, gid, gs); s_gdn_gates(c, gid, gs); s_sb(c, gid, gs); } break;
    case 5: if (l == 0) { s_ssd_states(c, gid, gs); s_ssd_cb(c, gid, gs); } else s_gdn_qkscale(c, gid, gs); break;
    case 6: if (l == 0) s_ssd_scan(c, gid, gs); else s_gdn_kk(c, gid, gs); break;
    case 7: if (l == 0) s_ssd_y(c, gid, gs); else s_gdn_solve(c, gid, gs); break;
    case 8: if (l == 0) s_rstd(c.ybuf, T * 2, 512, 512, c.rstd2, gid, gs); else s_gdn_scan(c, gid, gs); break;
    case 9: if (l == 0) s_ssd_out(c, gid, gs); else s_rstd(c.obuf, T * 8, 128, 128, c.rstd2, gid, gs); break;
    case 10: if (l == 1) s_gdn_out(c, gid, gs); break;
    case 11: s_gemm(c.cat, 1536, l == 0 ? c.in[I_EV_WOUT] : c.in[I_OD_WOUT], DM, c.h, DM, T, DM, 1536, 1, gid, gs); break;
    case 12: s_rstd(c.h, T, DM, DM, c.rstd, gid, gs); break;
    case 13: s_norm(c.h, c.rstd, c.in[I_NORM_XA] + l * DM, c.un, T, gid, gs); break;
    case 14: s_gemm(c.un, DM, c.in[I_XA_WQ] + (size_t)l * DM * DM, DM, c.q, DM, T, DM, DM, 0, gid, gs);
             s_gemm(c.memn, DM, c.in[I_XA_WK] + (size_t)l * DM * DM, DM, c.kx, DM, NB * MEM, DM, DM, 0, gid, gs);
             s_gemm(c.memn, DM, c.in[I_XA_WV] + (size_t)l * DM * DM, DM, c.vx, DM, NB * MEM, DM, DM, 0, gid, gs); break;
    case 15: s_xa_scores(c, gid, gs); break;
    case 16: s_xa_softmax(c, gid, gs); break;
    case 17: s_xa_pv(c, gid, gs); break;
    case 18: s_gemm(c.att, DM, c.in[I_XA_WO] + (size_t)l * DM * DM, DM, c.h, DM, T, DM, DM, 1, gid, gs); break;
    case 19: s_rstd(c.h, T, DM, DM, c.rstd, gid, gs); break;
    case 20: s_norm(c.h, c.rstd, c.in[I_NORM_FFN] + l * DM, c.un, T, gid, gs); break;
    case 21: s_router(c, l, gid, gs); break;
    case 22: s_moe_up(c, l, gid, gs); break;
    case 23: s_moe_down(c, l, gid, gs); break;
    default: break;
    }
    return true;
}
constexpr int N_STAGES_USED = 24;

__host__ __device__ __forceinline__ size_t carve(Ctx& c, float* w) {
    size_t o = 0;
    auto take = [&](size_t n) { float* p = w + o; o += (n + 63) & ~(size_t)63; return p; };
    c.h = take((size_t)T * DM); c.rstd = take(T); c.rstd2 = take((size_t)T * 8); c.memn = take((size_t)MEM * DM); c.kx = take((size_t)MEM * DM); c.vx = take((size_t)MEM * DM);
    c.eid = (int*)take((size_t)T * 2); c.gatew = take((size_t)T * 2); c.dtv = take((size_t)T * 16); c.acs = take((size_t)T * 16); c.beta = take((size_t)T * 8); c.gcs = take((size_t)T * 8);
    c.S = take(8 * 16384); c.vn = take(8 * 8192);
    c.un = take((size_t)T * DM); c.ybuf = c.un; c.obuf = c.un;
    c.proj = take((size_t)T * PROJ_LD);
    c.cat = take((size_t)T * 1536);
    const size_t d0 = o;
    c.xbcc = take((size_t)T * 1536); c.states = take((size_t)NCH * 16 * 8192); c.cb = take((size_t)NCH * 2 * 4096); size_t dmax = o;
    o = d0; c.qkvc = take((size_t)T * 3072); c.Lm = take((size_t)NCH * 8 * 4096); c.aqk = take((size_t)NCH * 8 * 4096); c.uw = take((size_t)NCH * 8 * 64 * 256); if (o > dmax) dmax = o;
    o = d0; c.q = take((size_t)T * DM); c.sc = take((size_t)T * DM); c.att = take((size_t)T * DM); if (o > dmax) dmax = o;
    o = d0; c.act = take((size_t)T * 2 * 512); if (o > dmax) dmax = o;
    return dmax;
}
}

namespace pg8 {
#define PG8_LAS __attribute__((address_space(3)))
typedef unsigned short bf16_t;
typedef short bf16x8 __attribute__((ext_vector_type(8)));
typedef float f32x4 __attribute__((ext_vector_type(4)));
typedef unsigned u32x4 __attribute__((ext_vector_type(4)));
constexpr int BM = 256, BK = 64, HALF = 128, HTB = HALF * BK * 2  , STAGE_BYTES = 8 * HTB, NXCD = 8, WGM = 8;

__host__ __device__ __forceinline__ int lds_byte(int r, int c) { const int st = (r >> 4) * 2 + (c >> 5), rr = r & 15, cc = c & 31, ob = rr * 64 + cc * 2; return st * 1024 + (ob ^ (((ob >> 9) & 1) << 5)); }
__host__ __device__ __forceinline__ void stage_rc(int b, int& R, int& C) { const int st = b / 1024, sb = b % 1024, swz = sb ^ (((sb >> 9) & 1) << 5); R = (st >> 1) * 16 + swz / 64; C = (st & 1) * 32 + (swz % 64) / 2; }
__host__ __device__ __forceinline__ int perm32(int rho) { const int n = rho >> 4, i = rho & 15; return 8 * (i >> 2) + 4 * n + (i & 3); }

struct Unit { int pm, pn, tag; const char* a; const char* b; };
struct Gemm { const bf16_t* A; const bf16_t* Bt; int M, N, K; };

struct StaticOrder {
    static constexpr bool LIGHT = false;
    int nM, nN, nwg, G, c; const char* A; const char* B; size_t tstep;
    __host__ __device__ void init(const Gemm& g, int G_, int c_) { nM = g.M / BM; nN = g.N / BM; nwg = nM * nN; G = G_; c = c_; A = (const char*)g.A; B = (const char*)g.Bt; tstep = (size_t)BM * g.K * 2; }
    __host__ __device__ bool next(int i, Unit& u) const {
        const long L = (long)i * G + c; if (L >= nwg) return false;
        int wgid = (int)L; { const int q = nwg / NXCD, r = nwg % NXCD, xcd = wgid % NXCD, off = wgid / NXCD; wgid = (xcd < r ? xcd * (q + 1) : r * (q + 1) + (xcd - r) * q) + off; }
        const int nig = WGM * nN, gid = wgid / nig, fm = gid * WGM, gsz = (nM - fm) < WGM ? (nM - fm) : WGM;
        u.pm = fm + ((wgid % nig) % gsz); u.pn = (wgid % nig) / gsz; u.a = A + (size_t)u.pm * tstep; u.b = B + (size_t)u.pn * tstep; return true;
    }
    __device__ __forceinline__ void a_ready(const Unit&) const {}
    __device__ __forceinline__ void done(const Unit&) const {}
};

template <class Epi, class Sched, bool ALIGN_EPI = false, bool SP2 = false>
__device__ __forceinline__ void gemm_phase(PG8_LAS unsigned char* lds, const Gemm g, const Sched& S, const Epi& E) {
    int tid_ = threadIdx.x; asm volatile("" : "+v"(tid_));
    const int tid = tid_, wid = __builtin_amdgcn_readfirstlane(tid >> 6), lane = tid & 63, wr = wid >> 2, wc = wid & 3, fr = lane & 15, fq = lane >> 4;
    const int K = g.K, nt = K / BK;
    unsigned voffA[2], voffB[2];
#pragma unroll
    for (int i = 0; i < 2; ++i) { int R, C; stage_rc(tid * 16 + i * 8192, R, C); const int Rb = Epi::PERM ? ((R & ~31) + perm32(R & 31)) : R;
        voffA[i] = (unsigned)(R * K + C) * 2u; voffB[i] = (unsigned)(Rb * K + C) * 2u; }
    const size_t kstep = (size_t)(BK * 2);
    const size_t hstep = (size_t)HALF * K * 2;
    const unsigned ldsw = (unsigned)wid * 1024u;
    const int aoff = lds_byte(wr * 64 + fr, fq * 8), boff = lds_byte(wc * 32 + fr, fq * 8);
#define PG8_SA(b, h) (((b) * 2 + (h)) * HTB)
#define PG8_SB(b, h) ((4 + (b) * 2 + (h)) * HTB)
#define PG8_STAGE(bufoff, gbase, voff) do { _Pragma("unroll") for (int _i = 0; _i < 2; ++_i) \
        __builtin_amdgcn_global_load_lds((const unsigned*)((const char*)(gbase) + (voff)[_i]), (PG8_LAS unsigned*)(lds + (bufoff) + ldsw + _i * 8192), 16, 0, 0); } while (0)
#define PG8_LDA(dst, b, h) do { _Pragma("unroll") for (int m = 0; m < 4; ++m) _Pragma("unroll") for (int k = 0; k < 2; ++k) dst[m][k] = *(const PG8_LAS bf16x8*)(lds + PG8_SA(b, h) + aoff + m * 2048 + k * 1024); } while (0)
#define PG8_LDB(dst, b, h) do { _Pragma("unroll") for (int n = 0; n < 2; ++n) _Pragma("unroll") for (int k = 0; k < 2; ++k) dst[n][k] = *(const PG8_LAS bf16x8*)(lds + PG8_SB(b, h) + boff + n * 2048 + k * 1024); } while (0)
#define PG8_MMA(ai, bj, At, Bt) do { __builtin_amdgcn_s_setprio(1); _Pragma("unroll") for (int m = 0; m < 4; ++m) _Pragma("unroll") for (int n = 0; n < 2; ++n) _Pragma("unroll") for (int k = 0; k < 2; ++k) \
        acc[ai][bj][m][n] = __builtin_amdgcn_mfma_f32_16x16x32_bf16(Bt[n][k], At[m][k], acc[ai][bj][m][n], 0, 0, 0); __builtin_amdgcn_s_setprio(0); } while (0)
#define PG8_WAIT_V(n) asm volatile("s_waitcnt vmcnt(" #n ")" ::: "memory")
#define PG8_WAIT_L(n) asm volatile("s_waitcnt lgkmcnt(" #n ")" ::: "memory")
#define PG8_BAR __builtin_amdgcn_s_barrier()
#define PG8_SCHED __builtin_amdgcn_sched_barrier(0)
    Unit cur, nxt; int ui = 0;
    if (!S.next(0, cur)) return;
    f32x4 acc[2][2][4][2];
#pragma unroll
    for (int a = 0; a < 2; ++a)
#pragma unroll
        for (int b = 0; b < 2; ++b)
#pragma unroll
            for (int m = 0; m < 4; ++m)
#pragma unroll
                for (int n = 0; n < 2; ++n) acc[a][b][m][n] = (f32x4){0.f, 0.f, 0.f, 0.f};
    bf16x8 At[4][2], B0[2][2], B1[2][2];
    const char* cA = cur.a; const char* cB = cur.b;
    S.a_ready(cur);
    if constexpr (SP2) {
        PG8_STAGE(PG8_SB(0, 0), cB, voffB); PG8_STAGE(PG8_SB(0, 1), cB + hstep, voffB); PG8_STAGE(PG8_SA(0, 0), cA, voffA); PG8_STAGE(PG8_SA(0, 1), cA + hstep, voffA);
        if (wr == 1) PG8_BAR;
        PG8_WAIT_V(2); PG8_BAR;
        PG8_STAGE(PG8_SB(1, 0), cB + kstep, voffB); PG8_STAGE(PG8_SA(1, 0), cA + kstep, voffA); PG8_STAGE(PG8_SB(1, 1), cB + hstep + kstep, voffB);
        PG8_WAIT_V(6); PG8_BAR;
    } else {
        PG8_STAGE(PG8_SB(0, 0), cB, voffB); PG8_STAGE(PG8_SA(0, 0), cA, voffA); PG8_STAGE(PG8_SB(0, 1), cB + hstep, voffB); PG8_STAGE(PG8_SA(0, 1), cA + hstep, voffA);
        if (wr == 1) PG8_BAR;
        PG8_WAIT_V(4); PG8_BAR;
        PG8_STAGE(PG8_SB(1, 0), cB + kstep, voffB); PG8_STAGE(PG8_SA(1, 0), cA + kstep, voffA); PG8_STAGE(PG8_SB(1, 1), cB + hstep + kstep, voffB);
        PG8_WAIT_V(6); PG8_BAR;
    }
    for (;;) {
        const bool has_next = S.next(ui + 1, nxt);
        const char* nA = has_next ? nxt.a : cA; const char* nB = has_next ? nxt.b : cB;
        for (int t = 0; t < nt; t += 2) {
            const bool last = (t == nt - 2);
            const char* a1 = cA + (size_t)(t + 1) * kstep;
            const char* a2 = last ? nA : cA + (size_t)(t + 2) * kstep; const char* b2 = last ? nB : cB + (size_t)(t + 2) * kstep;
            const char* a3 = a2 + kstep; const char* b3 = b2 + kstep;
            if (last && has_next) S.a_ready(nxt);
            if constexpr (SP2) {
            PG8_LDB(B0, 0, 0); PG8_LDB(B1, 0, 1); PG8_SCHED; PG8_LDA(At, 0, 0); PG8_STAGE(PG8_SA(1, 1), a1 + hstep, voffA);
            PG8_WAIT_V(8); PG8_WAIT_L(0); PG8_BAR; PG8_MMA(0, 0, At, B0); PG8_MMA(0, 1, At, B1); PG8_BAR; PG8_SCHED;
            PG8_LDA(At, 0, 1); PG8_STAGE(PG8_SB(0, 0), b2, voffB); PG8_STAGE(PG8_SB(0, 1), b2 + hstep, voffB); PG8_STAGE(PG8_SA(0, 0), a2, voffA);
            PG8_WAIT_V(8); PG8_WAIT_L(0); PG8_BAR; if (!(Sched::LIGHT && (cur.tag & 1))) { PG8_MMA(1, 0, At, B0); PG8_MMA(1, 1, At, B1); } PG8_BAR; PG8_SCHED;
            PG8_LDB(B0, 1, 0); PG8_LDB(B1, 1, 1); PG8_SCHED; PG8_LDA(At, 1, 0); PG8_STAGE(PG8_SA(0, 1), a2 + hstep, voffA);
            PG8_WAIT_V(8); PG8_WAIT_L(0); PG8_BAR; PG8_MMA(0, 0, At, B0); PG8_MMA(0, 1, At, B1); PG8_BAR; PG8_SCHED;
            PG8_LDA(At, 1, 1); PG8_STAGE(PG8_SB(1, 0), b3, voffB); PG8_STAGE(PG8_SB(1, 1), b3 + hstep, voffB); PG8_STAGE(PG8_SA(1, 0), a3, voffA);
            PG8_WAIT_V(8); PG8_WAIT_L(0); PG8_BAR; if (!(Sched::LIGHT && (cur.tag & 1))) { PG8_MMA(1, 0, At, B0); PG8_MMA(1, 1, At, B1); } PG8_BAR; PG8_SCHED;
            } else {
            PG8_LDB(B0, 0, 0); PG8_SCHED; PG8_LDA(At, 0, 0); PG8_STAGE(PG8_SA(1, 1), a1 + hstep, voffA);
            PG8_WAIT_L(8); PG8_BAR; PG8_WAIT_L(0); PG8_MMA(0, 0, At, B0); PG8_BAR; PG8_SCHED;
            PG8_LDB(B1, 0, 1); PG8_STAGE(PG8_SB(0, 0), b2, voffB);
            PG8_BAR; PG8_WAIT_L(0); PG8_MMA(0, 1, At, B1); PG8_BAR;
            PG8_LDA(At, 0, 1); PG8_STAGE(PG8_SA(0, 0), a2, voffA);
            PG8_BAR; PG8_WAIT_L(0); PG8_MMA(1, 0, At, B0); PG8_BAR; PG8_SCHED;
            PG8_STAGE(PG8_SB(0, 1), b2 + hstep, voffB);
            PG8_WAIT_V(6); PG8_BAR; PG8_MMA(1, 1, At, B1); PG8_BAR;
            PG8_LDB(B0, 1, 0); PG8_SCHED; PG8_LDA(At, 1, 0); PG8_STAGE(PG8_SA(0, 1), a2 + hstep, voffA);
            PG8_WAIT_L(8); PG8_BAR; PG8_WAIT_L(0); PG8_MMA(0, 0, At, B0); PG8_BAR; PG8_SCHED;
            PG8_LDB(B1, 1, 1); PG8_STAGE(PG8_SB(1, 0), b3, voffB);
            PG8_BAR; PG8_WAIT_L(0); PG8_MMA(0, 1, At, B1); PG8_BAR;
            PG8_LDA(At, 1, 1); PG8_STAGE(PG8_SA(1, 0), a3, voffA);
            PG8_BAR; PG8_WAIT_L(0); PG8_MMA(1, 0, At, B0); PG8_BAR; PG8_SCHED;
            PG8_STAGE(PG8_SB(1, 1), b3 + hstep, voffB);
            PG8_WAIT_V(6); PG8_BAR; PG8_MMA(1, 1, At, B1); PG8_BAR;
            }
        }
        if constexpr (ALIGN_EPI) { if (wr == 0) PG8_BAR; }
        if constexpr (!Epi::AFTER_DRAIN) { E(acc, cur, wr, wc, fr, fq); S.done(cur); }
        if (!has_next) break;
#pragma unroll
        for (int a = 0; a < 2; ++a)
#pragma unroll
            for (int b = 0; b < 2; ++b)
#pragma unroll
                for (int m = 0; m < 4; ++m)
#pragma unroll
                    for (int n = 0; n < 2; ++n) acc[a][b][m][n] = (f32x4){0.f, 0.f, 0.f, 0.f};
        cur = nxt; cA = nA; cB = nB; ++ui;
        if constexpr (ALIGN_EPI) { if (wr == 1) PG8_BAR; }
    }
    PG8_WAIT_V(0);
    if constexpr (!ALIGN_EPI) { if (wr == 0) PG8_BAR; }
    PG8_BAR;
    if constexpr (Epi::AFTER_DRAIN) { E.fused(acc, cur, wr, wc, fr, fq, lds, wid, lane); S.done(cur); }
#undef PG8_SA
#undef PG8_SB
#undef PG8_STAGE
#undef PG8_LDA
#undef PG8_LDB
#undef PG8_MMA
#undef PG8_WAIT_V
#undef PG8_WAIT_L
#undef PG8_BAR
#undef PG8_SCHED
}
}

namespace ok {
using pg8::bf16_t; using pg8::bf16x8; using pg8::f32x4; using pg8::u32x4;
typedef unsigned u32x2 __attribute__((ext_vector_type(2)));
typedef float f32x2 __attribute__((ext_vector_type(2)));
#ifndef SEQ
#define SEQ 8192
#endif
constexpr int NB = 2, L = SEQ, NCH = L / 64, T = NB * L, DM = 1024, NWAVES = 8, NT = 512;
constexpr float EPS = 1e-6f, LOG2E = 1.4426950408889634f;
constexpr size_t MiB = 1u << 20, KiB = 1024;
constexpr size_t WS_CTL = 0, CTL_BYTES = 1 * MiB;
constexpr int CW_BAR = 0;
constexpr int CW_SSQ = 16384;
constexpr int CW_MOE = 16384 + 6 * T;
constexpr int CW_CHK = CW_MOE + 256;
static_assert((CW_CHK + 64) * 4 <= (int)CTL_BYTES, "ctl");
constexpr size_t WS_WDT = 1 * MiB, WS_WAB = WS_WDT + 64 * KiB, WS_WR = WS_WAB + 64 * KiB;
constexpr size_t WS_DTV = 2 * MiB, WS_ACS = 3 * MiB, WS_GCS = 4 * MiB, WS_BETA = 4 * MiB + 512 * KiB;
constexpr size_t WS_RAW16 = WS_DTV;
constexpr size_t WS_EID = 5 * MiB, WS_GATEW = WS_EID + 128 * KiB, WS_TOKSLOT = WS_GATEW + 128 * KiB, WS_SLOTTOK = WS_TOKSLOT + 128 * KiB, WS_SLOTGATE = WS_SLOTTOK + 160 * KiB,
                 WS_SLOTRSTD = WS_SLOTGATE + 160 * KiB, WS_TILEEXP = WS_SLOTRSTD + 160 * KiB;
constexpr size_t WS_FP = 8 * MiB;
constexpr size_t WS_W_IN0 = 16 * MiB, WS_W_IN1 = 24 * MiB, WS_W_OUT0 = 35 * MiB, WS_W_OUT1 = 38 * MiB, WS_W_XA = 41 * MiB  ;
constexpr size_t WS_MEMNB = 57 * MiB, WS_KX = 58 * MiB  , WS_VT = 60 * MiB  ;
constexpr size_t WS_H = 64 * MiB, WS_HB = 128 * MiB, WS_MOEW = 160 * MiB, WS_BIG = 256 * MiB;
constexpr size_t WS_PROJ = WS_BIG;
constexpr size_t WS_CAT0 = 384 * MiB, WS_STATES = 432 * MiB;
constexpr size_t WS_CAT1 = 432 * MiB;
constexpr size_t WS_Q = WS_BIG, WS_ATT = WS_BIG + 32 * MiB;
constexpr size_t WS_XS = WS_BIG, WS_ACT = WS_BIG + 80 * MiB, WS_Y = WS_BIG + 120 * MiB;
constexpr size_t WS_END = 528 * MiB;
constexpr int PROJ0_LD = 4096, PROJ1_LD = 5632, MAXSLOT = 40960;

#ifdef CPU_EMU
__device__ __forceinline__ float fexp(float x) { return expf(x); }
__device__ __forceinline__ float fexp2(float x) { return exp2f(x); }
__device__ __forceinline__ float frcp(float x) { return 1.f / x; }
__device__ __forceinline__ float frsq(float x) { return 1.f / sqrtf(x); }
#else
__device__ __forceinline__ float fexp(float x) { return __builtin_amdgcn_exp2f(x * 1.4426950408889634f); }
__device__ __forceinline__ float fexp2(float x) { return __builtin_amdgcn_exp2f(x); }
__device__ __forceinline__ float frcp(float x) { return __builtin_amdgcn_rcpf(x); }
__device__ __forceinline__ float frsq(float x) { return __builtin_amdgcn_rsqf(x); }
#endif
#ifdef CPU_EMU
#define LAS
#define GAS
#define LDS_WAIT() do {} while (0)
#define WAVE_SYNC() ((void)__shfl(0, 0))
#define MEM_FENCE() do {} while (0)
#define PIN16(a) do {} while (0)
#define LDS_BARRIER() __syncthreads()
#define SCHED_FENCE() do {} while (0)
__device__ __forceinline__ unsigned cvt_pk_bf16(float lo, float hi) { return emu_f2bf(lo) | (emu_f2bf(hi) << 16); }
#else
#define LAS __attribute__((address_space(3)))
#define GAS __attribute__((address_space(1)))
#define LDS_WAIT() asm volatile("s_waitcnt lgkmcnt(0)" ::: "memory")
#define LDS_BARRIER() do { asm volatile("s_waitcnt lgkmcnt(0)" ::: "memory"); __builtin_amdgcn_s_barrier(); asm volatile("" ::: "memory"); } while (0)
#define MEM_FENCE() asm volatile("" ::: "memory")
#define PIN16(a) asm volatile("" : "+v"(a[0]), "+v"(a[1]), "+v"(a[2]), "+v"(a[3]), "+v"(a[4]), "+v"(a[5]), "+v"(a[6]), "+v"(a[7]), "+v"(a[8]), "+v"(a[9]), "+v"(a[10]), "+v"(a[11]), "+v"(a[12]), "+v"(a[13]), "+v"(a[14]), "+v"(a[15]) :: "memory")
#define SCHED_FENCE() __builtin_amdgcn_sched_barrier(0)
#define WAVE_SYNC() do { asm volatile("s_waitcnt lgkmcnt(0)" ::: "memory"); __builtin_amdgcn_wave_barrier(); } while (0)
typedef __bf16 hwbf16x2 __attribute__((ext_vector_type(2)));
__device__ __forceinline__ unsigned cvt_pk_bf16(float lo, float hi) { const f32x2 v = {lo, hi}; return __builtin_bit_cast(unsigned, __builtin_convertvector(v, hwbf16x2)); }
#endif
__device__ __forceinline__ float bf2f(unsigned short b) { return __uint_as_float(((unsigned)b) << 16); }
__device__ __forceinline__ float bflo(unsigned w) { return __uint_as_float(w << 16); }
__device__ __forceinline__ float bfhi(unsigned w) { return __uint_as_float(w & 0xffff0000u); }
__device__ __forceinline__ float wave_sum(float v) {
#pragma unroll
    for (int o = 1; o < 64; o <<= 1) v += __shfl_xor(v, o);
    return v;
}
__device__ __forceinline__ f32x4 mfma16(bf16x8 a, bf16x8 b, f32x4 c) { return __builtin_amdgcn_mfma_f32_16x16x32_bf16(a, b, c, 0, 0, 0); }

struct Frame {
    LAS unsigned char* lds;
    unsigned* ctl;
    unsigned char* ws;
    const float* const* in;
    float* out;
    int tid, lane, wave, vcu, G;
};
constexpr size_t WS_SSQP1 = 6 * MiB, WS_SSQP2 = 7 * MiB, WS_SSQP4 = 62 * MiB, WS_SSQP5 = 63 * MiB;
__device__ __forceinline__ float rstd_np(const float* p, int np, int row) { float s; if (np == 1) s = p[row]; else { const f32x4* q = (const f32x4*)(p + (size_t)row * 16); const f32x4 a = q[0], b = q[1], c = q[2], d = q[3]; s = ((a.x + a.y) + (a.z + a.w)) + ((b.x + b.y) + (b.z + b.w)) + (((c.x + c.y) + (c.z + c.w)) + ((d.x + d.y) + (d.z + d.w))); }
    return frsq(s * (1.f / 1024.f) + EPS); }
#define OKP(type, off) ((type*)(F.ws + (off)))
#ifdef CPU_EMU
__device__ __forceinline__ Frame phase_frame(const Frame& F0) { return F0; }
#else
__device__ __forceinline__ Frame phase_frame(const Frame& F0) { Frame F = F0; int t = threadIdx.x; asm volatile("" : "+v"(t)); F.tid = t; F.lane = t & 63; F.wave = __builtin_amdgcn_readfirstlane(t >> 6); return F; }
#endif

struct CvtJob { const float* W; int ldw, K, ncols, c0; bf16_t* WT; int drow0, dstep16; const float* kgain; float cscale; };
__device__ __forceinline__ int job_items(const CvtJob& j) { return (j.K / 64) * (j.ncols / 32); }
struct CvtRegs { float wv[32]; };
__device__ __forceinline__ void cvt_load(CvtRegs& r, const CvtJob& j, int item, int lane) {
    const int nblk = j.ncols / 32, kb = item / nblk, nb = item % nblk, k0 = 64 * kb, c0 = j.c0 + 32 * nb;
#pragma unroll
    for (int i = 0; i < 32; ++i) r.wv[i] = j.W[(size_t)(k0 + 2 * i + (lane >> 5)) * j.ldw + c0 + (lane & 31)];
}
__device__ __forceinline__ void cvt_finish(const CvtRegs& r, const CvtJob& j, int item, LAS float* scr, int lane) {
    const int nblk = j.ncols / 32, kb = item / nblk, nb = item % nblk, k0 = 64 * kb, drow0 = j.drow0 + (32 * nb >> 4) * j.dstep16;
#pragma unroll
    for (int i = 0; i < 32; ++i) { const int kk = 2 * i + (lane >> 5); const float g = j.kgain ? j.kgain[k0 + kk] * j.cscale : j.cscale; scr[kk * 33 + (lane & 31)] = r.wv[i] * g; }
    WAVE_SYNC();
    const int c = lane & 7;
#pragma unroll
    for (int jj = 0; jj < 4; ++jj) { const int n = (lane >> 3) + 8 * jj; const LAS float* s = scr + (8 * c) * 33 + n;
        u32x4 o; o.x = cvt_pk_bf16(s[0 * 33], s[1 * 33]); o.y = cvt_pk_bf16(s[2 * 33], s[3 * 33]); o.z = cvt_pk_bf16(s[4 * 33], s[5 * 33]); o.w = cvt_pk_bf16(s[6 * 33], s[7 * 33]);
        *(u32x4*)(j.WT + (size_t)(drow0 + (n >> 4) * j.dstep16 + (n & 15)) * j.K + k0 + 8 * c) = o; }
    WAVE_SYNC();
}
__device__ __forceinline__ CvtJob dense_job(const Frame& F, int j) {
    using namespace sm;
    const float* const* in = F.in;
    switch (j) {
    case 0: return CvtJob{in[I_EV_WIN], 4112, 1024, 4096, 0, OKP(bf16_t, WS_W_IN0), 0, 16, in[I_NORM_MIX], 1.f};
    case 1: return CvtJob{in[I_OD_WIN], 5648, 1024, 4096, 0, OKP(bf16_t, WS_W_IN1), 0, 16, in[I_NORM_MIX] + 1024, 1.f};
    case 2: return CvtJob{in[I_OD_WIN], 5648, 1024, 512, 4112, OKP(bf16_t, WS_W_IN1), 4096, 16, in[I_NORM_MIX] + 1024, 0.125f * LOG2E};
    case 3: return CvtJob{in[I_OD_WIN], 5648, 1024, 1024, 4624, OKP(bf16_t, WS_W_IN1), 4608, 16, in[I_NORM_MIX] + 1024, 1.f};
    case 4: return CvtJob{in[I_EV_WOUT], 1024, 1536, 1024, 0, OKP(bf16_t, WS_W_OUT0), 0, 16, nullptr, 1.f};
    case 5: return CvtJob{in[I_OD_WOUT], 1024, 1536, 1024, 0, OKP(bf16_t, WS_W_OUT1), 0, 16, nullptr, 1.f};
    default: { const int l = (j - 6) / 4, w = (j - 6) % 4; bf16_t* dst = OKP(bf16_t, WS_W_XA + (size_t)l * 8 * MiB + (size_t)w * 2 * MiB);
        const float* src = in[I_XA_WQ + w] + (size_t)l * 1024 * 1024;
        if (w == 0) return CvtJob{src, 1024, 1024, 1024, 0, dst, 0, 16, in[I_NORM_XA] + l * 1024, 0.0625f * LOG2E};
        return CvtJob{src, 1024, 1024, 1024, 0, dst, 0, 16, nullptr, 1.f}; }
    }
}
constexpr int N_DENSE_JOBS = 14;
__device__ __forceinline__ CvtJob moe_job(const Frame& F, int l, int j) {
    using namespace sm;
    const int e = j / 3, w = j % 3; const float* const* in = F.in;
    bf16_t* gu = OKP(bf16_t, WS_MOEW + (size_t)e * 3 * MiB); bf16_t* dn = gu + 1024 * 1024;
    if (w == 0) return CvtJob{in[I_MOE_WGATE] + ((size_t)l * 32 + e) * 1024 * 512, 512, 1024, 512, 0, gu, 0, 32, in[I_NORM_FFN] + l * 1024, 1.f};
    if (w == 1) return CvtJob{in[I_MOE_WUP] + ((size_t)l * 32 + e) * 1024 * 512, 512, 1024, 512, 0, gu, 16, 32, in[I_NORM_FFN] + l * 1024, 1.f};
    return CvtJob{in[I_MOE_WDOWN] + ((size_t)l * 32 + e) * 512 * 1024, 1024, 512, 1024, 0, dn, 0, 16, nullptr, 1.f};
}
__device__ __forceinline__ int dense_total(const Frame& F) { int n = 0; for (int j = 0; j < N_DENSE_JOBS; ++j) n += job_items(dense_job(F, j)); return n; }
__device__ __forceinline__ void dense_item(const Frame& F, int idx, CvtJob& job, int& item) {
    for (int j = 0; j < N_DENSE_JOBS; ++j) { const CvtJob jb = dense_job(F, j); const int n = job_items(jb); job = jb; item = idx < n ? idx : n - 1; if (idx < n) return; idx -= n; }
}
__device__ __forceinline__ void phase_cvt_dense(const Frame& F0) {
    const Frame F = phase_frame(F0);
    LAS float* scr = (LAS float*)(F.lds + F.wave * 16384);
    const int gw = F.vcu * NWAVES + F.wave, NGW = F.G * NWAVES, N = dense_total(F);
    CvtRegs ra, rb;
    auto LD = [&](CvtRegs& r, int idx) { CvtJob jb; int it; dense_item(F, idx < N ? idx : N - 1, jb, it); cvt_load(r, jb, it, F.lane); };
    auto FN = [&](const CvtRegs& r, int idx) { if (idx < N) { CvtJob jb; int it; dense_item(F, idx, jb, it); cvt_finish(r, jb, it, scr, F.lane); } };
    LD(ra, gw);
    for (int idx = gw; idx < N; idx += 2 * NGW) { LD(rb, idx + NGW); FN(ra, idx); LD(ra, idx + 2 * NGW); FN(rb, idx + NGW); }
}
__device__ __forceinline__ void phase_cvt_moe(const Frame& F0, int l) {
    const Frame F = phase_frame(F0);
    LAS float* scr = (LAS float*)(F.lds + F.wave * 16384);
    const int gw = F.vcu * NWAVES + F.wave, NGW = F.G * NWAVES; constexpr int N = 96 * 256;
    CvtRegs ra, rb;
    auto LD = [&](CvtRegs& r, int idx) { const int ii = idx < N ? idx : N - 1; const CvtJob jb = moe_job(F, l, ii >> 8); cvt_load(r, jb, ii & 255, F.lane); };
    auto FN = [&](const CvtRegs& r, int idx) { if (idx < N) { const CvtJob jb = moe_job(F, l, idx >> 8); cvt_finish(r, jb, idx & 255, scr, F.lane); } };
    LD(ra, gw);
    for (int idx = gw; idx < N; idx += 2 * NGW) { LD(rb, idx + NGW); FN(ra, idx); LD(ra, idx + 2 * NGW); FN(rb, idx + NGW); }
}
__device__ __forceinline__ void row_to_bf16_ssq(const float* xrow, bf16_t* orow, float* ssq, int lane) {
    const f32x4* xr = (const f32x4*)xrow + lane; float s = 0.f; f32x4 v[4];
#pragma unroll
    for (int j = 0; j < 4; ++j) { v[j] = xr[64 * j]; s += (v[j].x * v[j].x + v[j].y * v[j].y) + (v[j].z * v[j].z + v[j].w * v[j].w); }
    s = wave_sum(s);
    u32x2* o8 = (u32x2*)orow + lane;
#pragma unroll
    for (int j = 0; j < 4; ++j) { u32x2 w; w.x = cvt_pk_bf16(v[j].x, v[j].y); w.y = cvt_pk_bf16(v[j].z, v[j].w); o8[64 * j] = w; }
    if (lane == 0) *ssq = s;
}
__device__ __forceinline__ void phase_prologue(const Frame& F0) {
    const Frame F = phase_frame(F0);
    using namespace sm;
    phase_cvt_dense(F0);
    const int gw = F.vcu * NWAVES + F.wave, NGW = F.G * NWAVES;
    float* ssq0 = (float*)F.ctl + CW_SSQ;
    for (int m = gw; m < T; m += NGW) row_to_bf16_ssq(F.in[I_X] + (size_t)m * DM, OKP(bf16_t, WS_HB) + (size_t)m * DM, ssq0 + m, F.lane);
    for (int m = gw; m < NB * 256; m += NGW) { const f32x4* xr = (const f32x4*)(F.in[I_MEM] + (size_t)m * DM) + F.lane; const f32x4* gr = (const f32x4*)F.in[I_MEM_NORM] + F.lane; float s = 0.f; f32x4 v[4];
#pragma unroll
        for (int j = 0; j < 4; ++j) { v[j] = xr[64 * j]; s += (v[j].x * v[j].x + v[j].y * v[j].y) + (v[j].z * v[j].z + v[j].w * v[j].w); }
        const float r = 1.f / sqrtf(wave_sum(s) * (1.f / DM) + EPS);
        u32x2* o8 = (u32x2*)(OKP(bf16_t, WS_MEMNB) + (size_t)m * DM) + F.lane;
#pragma unroll
        for (int j = 0; j < 4; ++j) { const f32x4 g = gr[64 * j]; u32x2 w; w.x = cvt_pk_bf16(v[j].x * r * g.x, v[j].y * r * g.y); w.y = cvt_pk_bf16(v[j].z * r * g.z, v[j].w * r * g.w); o8[64 * j] = w; } }
    const size_t gt = (size_t)F.vcu * NT + F.tid, GT = (size_t)F.G * NT;
    for (size_t i = gt; i < 1024 * 16; i += GT) { const int k = (int)(i >> 4), j = (int)(i & 15);
        OKP(float, WS_WDT)[j * 1024 + k] = F.in[I_NORM_MIX][k] * F.in[I_EV_WIN][(size_t)k * 4112 + 4096 + j];
        OKP(float, WS_WAB)[j * 1024 + k] = F.in[I_NORM_MIX][1024 + k] * F.in[I_OD_WIN][(size_t)k * 5648 + 4096 + j]; }
}

#ifndef CPU_EMU
struct EpiScaleBf16 {
    static constexpr bool PERM = true, AFTER_DRAIN = false;
    bf16_t* O; int ldc; const float* ssq; int np;
    __device__ __forceinline__ void operator()(const f32x4 (&acc)[2][2][4][2], const pg8::Unit& u, int wr, int wc, int fr, int fq) const {
        const int row0 = u.pm * 256 + wr * 64 + fr, col0 = u.pn * 256 + wc * 32 + 8 * fq;
#pragma unroll
        for (int ai = 0; ai < 2; ++ai)
#pragma unroll
            for (int m = 0; m < 4; ++m) { const int row = row0 + ai * 128 + m * 16; const float s = ssq ? rstd_np(ssq, np, row) : 1.f; bf16_t* rowp = O + (size_t)row * ldc + col0;
#pragma unroll
                for (int bj = 0; bj < 2; ++bj) { const f32x4 v0 = acc[ai][bj][m][0] * s, v1 = acc[ai][bj][m][1] * s; u32x4 w; w.x = cvt_pk_bf16(v0[0], v0[1]); w.y = cvt_pk_bf16(v0[2], v0[3]); w.z = cvt_pk_bf16(v1[0], v1[1]); w.w = cvt_pk_bf16(v1[2], v1[3]);
                    *(u32x4*)(rowp + bj * 128) = w; } }
    }
};
template <bool HIN_F32> struct EpiResidualT {
    static constexpr bool PERM = false, AFTER_DRAIN = false;
    const float* hin; bf16_t* hb; float* ssq;
    __device__ __forceinline__ void operator()(const f32x4 (&acc)[2][2][4][2], const pg8::Unit& u, int wr, int wc, int fr, int fq) const {
        const int row0 = u.pm * 256 + wr * 64 + fr, col0 = u.pn * 256 + wc * 32 + 4 * fq;
#pragma unroll
        for (int ai = 0; ai < 2; ++ai)
#pragma unroll
            for (int m = 0; m < 4; ++m) { const int row = row0 + ai * 128 + m * 16; const size_t ro = (size_t)row * DM + col0; float s = 0.f;
#pragma unroll
                for (int bj = 0; bj < 2; ++bj)
#pragma unroll
                    for (int n = 0; n < 2; ++n) { const size_t o = ro + bj * 128 + n * 16; f32x4 v;
                        if (HIN_F32) v = *(const f32x4*)(hin + o); else { const u32x2 hw = *(const u32x2*)(hb + o); v = (f32x4){bflo(hw.x), bfhi(hw.x), bflo(hw.y), bfhi(hw.y)}; }
                        v += acc[ai][bj][m][n];
                        u32x2 w; w.x = cvt_pk_bf16(v[0], v[1]); w.y = cvt_pk_bf16(v[2], v[3]); *(u32x2*)(hb + o) = w;
                        const float r0 = bflo(w.x), r1 = bfhi(w.x), r2 = bflo(w.y), r3 = bfhi(w.y); s += (r0 * r0 + r1 * r1) + (r2 * r2 + r3 * r3); }
                s += __shfl_xor(s, 16); s += __shfl_xor(s, 32);
                if (fq == 0) ssq[(size_t)row * 16 + u.pn * 4 + wc] = s; }
    }
};

template <class Epi> __device__ __forceinline__ void dense_gemm(const Frame& F, const bf16_t* A, const bf16_t* Bt, int M, int N, int K, const Epi& E) {
    pg8::Gemm g{A, Bt, M, N, K}; pg8::StaticOrder S; S.init(g, F.G, (int)blockIdx.x);
    pg8::gemm_phase<Epi, pg8::StaticOrder, true, true>(F.lds, g, S, E);
}
#endif
}

namespace ok {
constexpr int XT_LD = 72;
constexpr int BC_LD = 136;
__device__ __forceinline__ float siluf(float x) { return x * frcp(1.f + fexp(-x)); }
__device__ __forceinline__ float softplusf(float x) { return x > 20.f ? x : log1pf(expf(x)); }

template <class Sink> __device__ __forceinline__ void ssd_conv_pair(const Frame& F, int b, int c, int xc, Sink&& sink) {
    using namespace sm;
    const float* cw = F.in[I_EV_CONVW]; const f32x2 w0 = *(const f32x2*)(cw + xc), w1 = *(const f32x2*)(cw + 1536 + xc), w2 = *(const f32x2*)(cw + 3072 + xc), w3 = *(const f32x2*)(cw + 4608 + xc), bias = *(const f32x2*)(F.in[I_EV_CONVB] + xc);
    const bf16_t* p = OKP(bf16_t, WS_PROJ) + (size_t)(b * L + c * 64) * PROJ0_LD + 2560 + xc;
    unsigned raw[64];
#pragma unroll
    for (int t = 0; t < 64; ++t) raw[t] = *(const unsigned*)(p + (size_t)t * PROJ0_LD);
    f32x2 x0 = {0.f, 0.f}, x1 = x0, x2 = x0;
    if (c > 0) { const unsigned a = *(const unsigned*)(p - 3 * PROJ0_LD), bq = *(const unsigned*)(p - 2 * PROJ0_LD), cq = *(const unsigned*)(p - PROJ0_LD); x0 = (f32x2){bflo(a), bfhi(a)}; x1 = (f32x2){bflo(bq), bfhi(bq)}; x2 = (f32x2){bflo(cq), bfhi(cq)}; }
#pragma unroll
    for (int t = 0; t < 64; t += 2) { const f32x2 x3 = {bflo(raw[t]), bfhi(raw[t])}, x4 = {bflo(raw[t + 1]), bfhi(raw[t + 1])};
        const f32x2 v0 = bias + w0 * x0 + w1 * x1 + w2 * x2 + w3 * x3, v1 = bias + w0 * x1 + w1 * x2 + w2 * x3 + w3 * x4;
        sink(t, siluf(v0.x), siluf(v1.x), siluf(v0.y), siluf(v1.y)); x0 = x2; x1 = x3; x2 = x4; }
}

__device__ __forceinline__ void phase_ssd_a(const Frame& F0) {
    const Frame F = phase_frame(F0);
    using namespace sm;
    LAS bf16_t* XT = (LAS bf16_t*)F.lds; LAS bf16_t* BT = (LAS bf16_t*)(F.lds + 73728);
    LAS float* dt_s = (LAS float*)(F.lds + 92160); LAS float* acs_s = (LAS float*)(F.lds + 94208); LAS float* sc_s = (LAS float*)(F.lds + 96256);
    const int tid = F.tid, lane = F.lane, wave = F.wave;
    for (int u = F.vcu; u < NB * NCH * 2; u += F.G) {
        const int g = u & 1, bc = u >> 1, b = bc / NCH, c = bc % NCH; const size_t row0 = (size_t)b * L + c * 64;
        LDS_BARRIER();
        if (tid < 320) { const int ci = tid * 2;
            const int xc = ci < 512 ? g * 512 + ci : 1024 + g * 128 + (ci - 512);
            LAS unsigned* dst = (LAS unsigned*)(ci < 512 ? XT + ci * XT_LD : BT + (ci - 512) * XT_LD);
            ssd_conv_pair(F, b, c, xc, [&](int t, float a0, float a1, float b0, float b1) { dst[t >> 1] = cvt_pk_bf16(a0, a1); dst[XT_LD / 2 + (t >> 1)] = cvt_pk_bf16(b0, b1); });
        }
        { const int t = tid & 63, hh = tid >> 6, hd = g * 8 + hh; const float dt = softplusf(OKP(float, WS_RAW16)[(row0 + t) * 16 + hd] + F.in[I_EV_DTB][hd]); dt_s[hh * 64 + t] = dt; acs_s[hh * 64 + t] = dt * -expf(F.in[I_EV_ALOG][hd]); }
        LDS_BARRIER();
        { const int hh = wave, hd = g * 8 + hh; float v = acs_s[hh * 64 + lane];
#pragma unroll
          for (int o = 1; o < 64; o <<= 1) { const float n = __shfl_up(v, o); if (lane >= o) v += n; }
          const float last = __shfl(v, 63); const float dt = dt_s[hh * 64 + lane];
          sc_s[hh * 64 + lane] = dt * fexp(last - v);
          OKP(float, WS_DTV)[(row0 + lane) * 16 + hd] = dt; OKP(float, WS_ACS)[(row0 + lane) * 16 + hd] = v; }
        WAVE_SYNC();
#if defined(CHECK_DUMP)
        if (bc == 5 && g == 0) {
            float* f3 = OKP(float, WS_FP) + (size_t)3 * 16 * 6144; float* f4 = OKP(float, WS_FP) + (size_t)4 * 16 * 6144; float* f5 = OKP(float, WS_FP) + (size_t)5 * 16 * 6144;
            for (int i = tid; i < 512 * 64; i += NT) f3[i] = bf2f(XT[(i >> 6) * XT_LD + (i & 63)]);
            for (int i = tid; i < 128 * 64; i += NT) f4[i] = bf2f(BT[(i >> 6) * XT_LD + (i & 63)]);
            f5[wave * 64 + lane] = sc_s[wave * 64 + lane];
        }
#endif
        { const int hh = wave, hd = g * 8 + hh, fr = lane & 15, fq = lane >> 4;
          bf16x8 xa[4][2];
#pragma unroll
          for (int pt = 0; pt < 4; ++pt)
#pragma unroll
              for (int ks = 0; ks < 2; ++ks) { const u32x4 raw = *(const LAS u32x4*)(XT + (hh * 64 + pt * 16 + fr) * XT_LD + ks * 32 + fq * 8); const LAS float* sp = sc_s + hh * 64 + ks * 32 + fq * 8;
                  const f32x4 s0 = *(const LAS f32x4*)sp, s1 = *(const LAS f32x4*)(sp + 4); u32x4 o;
                  o.x = cvt_pk_bf16(bflo(raw.x) * s0.x, bfhi(raw.x) * s0.y); o.y = cvt_pk_bf16(bflo(raw.y) * s0.z, bfhi(raw.y) * s0.w);
                  o.z = cvt_pk_bf16(bflo(raw.z) * s1.x, bfhi(raw.z) * s1.y); o.w = cvt_pk_bf16(bflo(raw.w) * s1.z, bfhi(raw.w) * s1.w);
                  xa[pt][ks] = __builtin_bit_cast(bf16x8, o); }
          bf16_t* st = OKP(bf16_t, WS_STATES) + ((size_t)bc * 16 + hd) * 8192;
#pragma unroll
          for (int nt = 0; nt < 8; ++nt) { bf16x8 bb[2];
#pragma unroll
              for (int ks = 0; ks < 2; ++ks) bb[ks] = *(const LAS bf16x8*)(BT + (nt * 16 + fr) * XT_LD + ks * 32 + fq * 8);
#pragma unroll
              for (int pt = 0; pt < 4; ++pt) { f32x4 acc = {0.f, 0.f, 0.f, 0.f};
#pragma unroll
                  for (int ks = 0; ks < 2; ++ks) acc = mfma16(bb[ks], xa[pt][ks], acc);
                  u32x2 w; w.x = cvt_pk_bf16(acc[0], acc[1]); w.y = cvt_pk_bf16(acc[2], acc[3]);
                  *(u32x2*)(st + (size_t)(pt * 16 + fr) * 128 + nt * 16 + 4 * fq) = w; } } }
    }
}

__device__ __forceinline__ void phase_ssd_scan(const Frame& F0, int skip) {
    const Frame F = phase_frame(F0);
    const float* acs = OKP(float, WS_ACS);
    int widx = F.vcu, nw = F.G;
    if (skip) { const int per = F.G / 8, xcd = F.vcu / per, loc = F.vcu % per, sk = skip / 8; if (loc < sk) return; widx = xcd * (per - sk) + (loc - sk); nw = F.G - skip; }
    for (int idx = widx * NT + F.tid; idx < NB * 65536; idx += nw * NT) {
        const int b = idx >> 16, r2 = idx & 65535, hd = r2 >> 12; unsigned* p = (unsigned*)(OKP(bf16_t, WS_STATES) + (size_t)b * NCH * 131072) + r2;
        float s0 = 0.f, s1 = 0.f;
#pragma unroll 8
        for (int c = 0; c < NCH; ++c) { const unsigned st = p[(size_t)c * 65536]; const float dec = fexp(acs[((size_t)b * L + c * 64 + 63) * 16 + hd]);
            p[(size_t)c * 65536] = cvt_pk_bf16(s0, s1); s0 = s0 * dec + bflo(st); s1 = s1 * dec + bfhi(st); }
    }
}

__device__ __forceinline__ void phase_ssd_b(const Frame& F0) {
    const Frame F = phase_frame(F0);
    using namespace sm;
    LAS bf16_t* XT = (LAS bf16_t*)F.lds; LAS bf16_t* Bs = (LAS bf16_t*)(F.lds + 73728); LAS bf16_t* Cs = (LAS bf16_t*)(F.lds + 91136);
    LAS float* acs_s = (LAS float*)(F.lds + 108544); LAS float* dt_s = (LAS float*)(F.lds + 110592); LAS float* red = (LAS float*)(F.lds + 112640);
    const int tid = F.tid, lane = F.lane, wave = F.wave, fr = lane & 15, fq = lane >> 4;
    const bf16_t* proj = OKP(bf16_t, WS_PROJ); bf16_t* cat = OKP(bf16_t, WS_CAT0);
    for (int u = F.vcu; u < NB * NCH * 2; u += F.G) {
        const int g = u & 1, bc = u >> 1, b = bc / NCH, c = bc % NCH; const size_t row0 = (size_t)b * L + c * 64;
        LDS_BARRIER();
        if (tid < 384) { const int ci = tid * 2;
            if (ci < 512) { LAS unsigned* dst = (LAS unsigned*)(XT + ci * XT_LD); ssd_conv_pair(F, b, c, g * 512 + ci, [&](int t, float a0, float a1, float b0, float b1) { dst[t >> 1] = cvt_pk_bf16(a0, a1); dst[XT_LD / 2 + (t >> 1)] = cvt_pk_bf16(b0, b1); }); }
            else { const int n = (ci - 512) & 127; LAS unsigned* dst = (LAS unsigned*)((ci < 640 ? Bs : Cs) + n); const int xc = (ci < 640 ? 1024 : 1280) + g * 128 + n;
                ssd_conv_pair(F, b, c, xc, [&](int t, float a0, float a1, float b0, float b1) { dst[t * (BC_LD / 2)] = cvt_pk_bf16(a0, b0); dst[(t + 1) * (BC_LD / 2)] = cvt_pk_bf16(a1, b1); }); }
        }
        { const int t = tid & 63, hh = tid >> 6; acs_s[hh * 64 + t] = OKP(float, WS_ACS)[(row0 + t) * 16 + g * 8 + hh]; dt_s[hh * 64 + t] = OKP(float, WS_DTV)[(row0 + t) * 16 + g * 8 + hh]; }
        { const int ch = g * 256 + (tid & 255), t0 = (tid >> 8) * 32; const float* w = F.in[I_EV_SCCONV]; const float w0 = w[ch], w1 = w[512 + ch], w2 = w[1024 + ch];
          const bf16_t* p = proj + (row0 + t0) * PROJ0_LD + ch; float p0 = 0.f, p1 = 0.f;
          if (c > 0 || t0 > 0) { p0 = bf2f(p[-2 * PROJ0_LD + 512]) * bf2f(p[-2 * PROJ0_LD + 1024]); p1 = bf2f(p[-PROJ0_LD + 512]) * bf2f(p[-PROJ0_LD + 1024]); }
          unsigned short rb[32], rc[32], rx[32];
#pragma unroll
          for (int t = 0; t < 32; ++t) { const bf16_t* q = p + (size_t)t * PROJ0_LD; rb[t] = q[0]; rc[t] = q[512]; rx[t] = q[1024]; }
#pragma unroll
          for (int t = 0; t < 32; ++t) { const float p2 = bf2f(rc[t]) * bf2f(rx[t]); const float y = bf2f(rb[t]) * (w0 * p0 + w1 * p1 + w2 * p2);
              cat[(row0 + t0 + t) * 1536 + ch] = (bf16_t)(cvt_pk_bf16(y, 0.f) & 0xffffu); p0 = p1; p1 = p2; } }
        LDS_BARRIER();
        const int hh = wave, hd = g * 8 + hh;
        f32x4 Y[4][4];
        { const bf16_t* P = OKP(bf16_t, WS_STATES) + ((size_t)bc * 16 + hd) * 8192;
#pragma unroll
          for (int pt = 0; pt < 4; ++pt)
#pragma unroll
              for (int tt = 0; tt < 4; ++tt) Y[pt][tt] = (f32x4){0.f, 0.f, 0.f, 0.f};
          bf16x8 pall[4][4];
#pragma unroll
          for (int ks = 0; ks < 4; ++ks)
#pragma unroll
              for (int pt = 0; pt < 4; ++pt) pall[ks][pt] = *(const bf16x8*)(P + (size_t)(pt * 16 + fr) * 128 + ks * 32 + fq * 8);
#pragma unroll
          for (int ks = 0; ks < 4; ++ks) { bf16x8 cb[4];
#pragma unroll
              for (int tt = 0; tt < 4; ++tt) cb[tt] = *(const LAS bf16x8*)(Cs + (tt * 16 + fr) * BC_LD + ks * 32 + fq * 8);
#pragma unroll
              for (int pt = 0; pt < 4; ++pt)
#pragma unroll
                  for (int tt = 0; tt < 4; ++tt) Y[pt][tt] = mfma16(pall[ks][pt], cb[tt], Y[pt][tt]); }
#pragma unroll
          for (int tt = 0; tt < 4; ++tt) { const float e = fexp(acs_s[hh * 64 + tt * 16 + fr]);
#pragma unroll
              for (int pt = 0; pt < 4; ++pt) Y[pt][tt] *= e; } }
#pragma unroll
        for (int tt = 0; tt < 4; ++tt) { f32x4 cbt[4];
#pragma unroll
            for (int st = 0; st < 4; ++st) cbt[st] = (f32x4){0.f, 0.f, 0.f, 0.f};
#pragma unroll
            for (int ks = 0; ks < 4; ++ks) { const bf16x8 cf = *(const LAS bf16x8*)(Cs + (tt * 16 + fr) * BC_LD + ks * 32 + fq * 8);
#pragma unroll
                for (int st = 0; st < 4; ++st) if (st <= tt) { const bf16x8 bf = *(const LAS bf16x8*)(Bs + (st * 16 + fr) * BC_LD + ks * 32 + fq * 8); cbt[st] = mfma16(bf, cf, cbt[st]); } }
            const int t = tt * 16 + fr; const float at = acs_s[hh * 64 + t];
#pragma unroll
            for (int st = 0; st < 4; ++st) { const f32x4 as4 = *(const LAS f32x4*)(acs_s + hh * 64 + st * 16 + 4 * fq), dt4 = *(const LAS f32x4*)(dt_s + hh * 64 + st * 16 + 4 * fq);
#pragma unroll
                for (int r = 0; r < 4; ++r) { const int s = st * 16 + 4 * fq + r; cbt[st][r] = (st <= tt && s <= t) ? cbt[st][r] * fexp(at - as4[r]) * dt4[r] : 0.f; } }
            bf16x8 mb[2];
#pragma unroll
            for (int ks = 0; ks < 2; ++ks) { u32x4 o; o.x = cvt_pk_bf16(cbt[2 * ks][0], cbt[2 * ks][1]); o.y = cvt_pk_bf16(cbt[2 * ks][2], cbt[2 * ks][3]); o.z = cvt_pk_bf16(cbt[2 * ks + 1][0], cbt[2 * ks + 1][1]); o.w = cvt_pk_bf16(cbt[2 * ks + 1][2], cbt[2 * ks + 1][3]);
                mb[ks] = __builtin_bit_cast(bf16x8, o); }
#pragma unroll
            for (int pt = 0; pt < 4; ++pt)
#pragma unroll
                for (int ks = 0; ks < 2; ++ks) { const LAS bf16_t* xp = XT + (hh * 64 + pt * 16 + fr) * XT_LD + ks * 32 + 4 * fq; const u32x2 lo = *(const LAS u32x2*)xp, hi = *(const LAS u32x2*)(xp + 16);
                    u32x4 a; a.x = lo.x; a.y = lo.y; a.z = hi.x; a.w = hi.y; Y[pt][tt] = mfma16(__builtin_bit_cast(bf16x8, a), mb[ks], Y[pt][tt]); } }
        const float Dh = F.in[I_EV_D][hd];
#pragma unroll
        for (int tt = 0; tt < 4; ++tt) { const int t = tt * 16 + fr; float ss = 0.f;
#pragma unroll
            for (int pt = 0; pt < 4; ++pt) { const int p = pt * 16 + 4 * fq; const u32x2 zz = *(const u32x2*)(proj + (row0 + t) * PROJ0_LD + 1536 + hd * 64 + p);
                const float z0 = bflo(zz.x), z1 = bfhi(zz.x), z2 = bflo(zz.y), z3 = bfhi(zz.y); const LAS bf16_t* xp = XT + (hh * 64 + p) * XT_LD + t;
                f32x4 y = Y[pt][tt]; y[0] = (y[0] + Dh * bf2f(xp[0])) * siluf(z0); y[1] = (y[1] + Dh * bf2f(xp[XT_LD])) * siluf(z1); y[2] = (y[2] + Dh * bf2f(xp[2 * XT_LD])) * siluf(z2); y[3] = (y[3] + Dh * bf2f(xp[3 * XT_LD])) * siluf(z3);
                Y[pt][tt] = y; ss += (y[0] * y[0] + y[1] * y[1]) + (y[2] * y[2] + y[3] * y[3]); }
            ss += __shfl_xor(ss, 16); ss += __shfl_xor(ss, 32);
            if (fq == 0) red[hh * 64 + t] = ss; }
        LDS_BARRIER();
#pragma unroll
        for (int tt = 0; tt < 4; ++tt) { const int t = tt * 16 + fr; float ss = 0.f;
#pragma unroll
            for (int w = 0; w < 8; ++w) ss += red[w * 64 + t];
            const float rs = frsq(ss * (1.f / 512.f) + EPS);
#pragma unroll
            for (int pt = 0; pt < 4; ++pt) { const int ch = hd * 64 + pt * 16 + 4 * fq; const f32x4 nw = *(const f32x4*)(F.in[I_EV_NORM] + ch); const f32x4 y = Y[pt][tt];
                u32x2 w; w.x = cvt_pk_bf16(y[0] * rs * nw.x, y[1] * rs * nw.y); w.y = cvt_pk_bf16(y[2] * rs * nw.z, y[3] * rs * nw.w);
                *(u32x2*)(cat + (row0 + t) * 1536 + 512 + ch) = w; } }
    }
}
}

namespace ok {
constexpr int XA_LD = 264;

__device__ __forceinline__ void phase_xattn(const Frame& F0, const bf16_t* q, const bf16_t* kx, const bf16_t* vt, bf16_t* att) {
    const Frame F = phase_frame(F0);
    LAS bf16_t* KV = (LAS bf16_t*)F.lds;
    const int tid = F.tid, lane = F.lane, wave = F.wave, fr = lane & 15, fq = lane >> 4;
    for (int u = F.vcu; u < (T / 128) * 4; u += F.G) {
        const int hd = u & 3, rt = u >> 2, row0 = rt * 128, b = row0 / L;
        LDS_BARRIER();
#pragma unroll 16
        for (int i = tid; i < 256 * 32; i += NT) { const int r = i >> 5, c8 = i & 31; *(LAS u32x4*)(KV + r * XA_LD + c8 * 8) = *(const u32x4*)(kx + (size_t)(b * 256 + r) * 1024 + hd * 256 + c8 * 8); }
        LDS_BARRIER();
        bf16x8 pf[8]; float fA, fB;
        {
            const bf16_t* qp = q + (size_t)(row0 + wave * 16 + fr) * 1024 + hd * 256 + fq * 8;
            bf16x8 qf[8];
#pragma unroll
            for (int ks = 0; ks < 8; ++ks) qf[ks] = *(const bf16x8*)(qp + ks * 32);
            float mh[2], lh[2];
#pragma unroll
            for (int half = 0; half < 2; ++half) {
                f32x4 s[8];
#pragma unroll
                for (int kt = 0; kt < 8; ++kt) { s[kt] = (f32x4){0.f, 0.f, 0.f, 0.f};
#pragma unroll
                    for (int ks = 0; ks < 8; ++ks) { const bf16x8 kf = *(const LAS bf16x8*)(KV + ((half * 8 + kt) * 16 + fr) * XA_LD + ks * 32 + fq * 8); s[kt] = mfma16(kf, qf[ks], s[kt]); }
                    }
                float m = -3.0e38f;
#pragma unroll
                for (int kt = 0; kt < 8; ++kt) m = fmaxf(m, fmaxf(fmaxf(s[kt][0], s[kt][1]), fmaxf(s[kt][2], s[kt][3])));
                m = fmaxf(m, __shfl_xor(m, 16)); m = fmaxf(m, __shfl_xor(m, 32));
                float l = 0.f;
#pragma unroll
                for (int kt = 0; kt < 8; ++kt) {
#pragma unroll
                    for (int r = 0; r < 4; ++r) { const float p = fexp2(s[kt][r] - m); s[kt][r] = p; l += p; } }
                l += __shfl_xor(l, 16); l += __shfl_xor(l, 32); mh[half] = m; lh[half] = l;
#pragma unroll
                for (int j = 0; j < 4; ++j) { u32x4 o; o.x = cvt_pk_bf16(s[2 * j][0], s[2 * j][1]); o.y = cvt_pk_bf16(s[2 * j][2], s[2 * j][3]); o.z = cvt_pk_bf16(s[2 * j + 1][0], s[2 * j + 1][1]); o.w = cvt_pk_bf16(s[2 * j + 1][2], s[2 * j + 1][3]);
                    pf[half * 4 + j] = __builtin_bit_cast(bf16x8, o); }
                    }
            const float m = fmaxf(mh[0], mh[1]), cA = fexp2(mh[0] - m), cB = fexp2(mh[1] - m), li = frcp(cA * lh[0] + cB * lh[1]); fA = cA * li; fB = cB * li;
        }
        LDS_BARRIER();
#pragma unroll 16
        for (int i = tid; i < 256 * 32; i += NT) { const int r = i >> 5, c8 = i & 31; *(LAS u32x4*)(KV + r * XA_LD + c8 * 8) = *(const u32x4*)(vt + (size_t)(hd * 256 + r) * (NB * 256) + b * 256 + c8 * 8); }
        LDS_BARRIER();
#pragma unroll 2
        for (int dt = 0; dt < 16; ++dt) { f32x4 oA = {0.f, 0.f, 0.f, 0.f}, oB = oA;
#pragma unroll
            for (int j = 0; j < 8; ++j) { const LAS bf16_t* vp = KV + (dt * 16 + fr) * XA_LD + j * 32 + 4 * fq; const u32x2 lo = *(const LAS u32x2*)vp, hi = *(const LAS u32x2*)(vp + 16);
                u32x4 a; a.x = lo.x; a.y = lo.y; a.z = hi.x; a.w = hi.y; const bf16x8 vf = __builtin_bit_cast(bf16x8, a);
                if (j < 4) oA = mfma16(vf, pf[j], oA); else oB = mfma16(vf, pf[j], oB); }
            const f32x4 o = oA * fA + oB * fB;
            bf16_t* op = att + (size_t)(row0 + wave * 16 + fr) * 1024 + hd * 256 + dt * 16 + 4 * fq;
            u32x2 w; w.x = cvt_pk_bf16(o[0], o[1]); w.y = cvt_pk_bf16(o[2], o[3]); *(u32x2*)op = w; }
    }
}

#ifndef CPU_EMU
struct KvOrder {
    static constexpr bool LIGHT = false;
    const char* memnb; const char* wxa; char* kx; char* vt; int G, c;
    __device__ bool next(int i, pg8::Unit& u) const {
        const int Lx = i * G + c; if (Lx >= 32) return false;
        const int l = Lx >> 4, r = Lx & 15; const size_t tstep = (size_t)256 * 1024 * 2;
        if (r < 8) { u.pm = r >> 2; u.pn = r & 3; u.tag = l * 2; u.a = memnb + (size_t)u.pm * tstep; u.b = wxa + (size_t)l * 8 * MiB + 2 * MiB + (size_t)u.pn * tstep; }
        else { const int r2 = r - 8; u.pm = r2 >> 1; u.pn = r2 & 1; u.tag = l * 2 + 1; u.a = wxa + (size_t)l * 8 * MiB + 4 * MiB + (size_t)u.pm * tstep; u.b = memnb + (size_t)u.pn * tstep; }
        return true;
    }
    __device__ __forceinline__ void a_ready(const pg8::Unit&) const {}
    __device__ __forceinline__ void done(const pg8::Unit&) const {}
};
struct EpiKv {
    static constexpr bool PERM = true, AFTER_DRAIN = false;
    bf16_t* kx; bf16_t* vt;
    __device__ __forceinline__ void operator()(const f32x4 (&acc)[2][2][4][2], const pg8::Unit& u, int wr, int wc, int fr, int fq) const {
        const int l = u.tag >> 1, isv = u.tag & 1, ldc = isv ? 512 : 1024; bf16_t* O = isv ? vt + (size_t)l * 1024 * 512 : kx + (size_t)l * 512 * 1024;
        const int row0 = u.pm * 256 + wr * 64 + fr, col0 = u.pn * 256 + wc * 32 + 8 * fq;
#pragma unroll
        for (int ai = 0; ai < 2; ++ai)
#pragma unroll
            for (int m = 0; m < 4; ++m) { bf16_t* rowp = O + (size_t)(row0 + ai * 128 + m * 16) * ldc + col0;
#pragma unroll
                for (int bj = 0; bj < 2; ++bj) { const f32x4 v0 = acc[ai][bj][m][0], v1 = acc[ai][bj][m][1]; u32x4 w; w.x = cvt_pk_bf16(v0[0], v0[1]); w.y = cvt_pk_bf16(v0[2], v0[3]); w.z = cvt_pk_bf16(v1[0], v1[1]); w.w = cvt_pk_bf16(v1[2], v1[3]);
                    *(u32x4*)(rowp + bj * 128) = w; } }
    }
};
__device__ __forceinline__ void phase_kv(const Frame& F) {
    pg8::Gemm g{nullptr, nullptr, 0, 0, 1024};
    int vcu_; { const int bx = blockIdx.x, G = gridDim.x; vcu_ = (G % 8 == 0) ? (bx % 8) * (G / 8) + bx / 8 : bx; if (G % 8 == 0 && G >= 64) { const int per = G / 8, xcd = vcu_ / per, loc = vcu_ % per; vcu_ = loc < 4 ? xcd * 4 + loc : 32 + vcu_; } }
    KvOrder S{(const char*)OKP(bf16_t, WS_MEMNB), (const char*)OKP(bf16_t, WS_W_XA), (char*)OKP(bf16_t, WS_KX), (char*)OKP(bf16_t, WS_VT), F.G, vcu_};
    EpiKv E{OKP(bf16_t, WS_KX), OKP(bf16_t, WS_VT)};
    pg8::gemm_phase<EpiKv, KvOrder, true, true>(F.lds, g, S, E);
}
#endif
}

namespace ok {
constexpr size_t WS_WRH = WS_WR, WS_WRL = WS_WR + 256 * KiB;
constexpr size_t WS_POS = WS_TILEEXP + 4 * KiB;
__device__ __forceinline__ void prologue_router_tables(const Frame& F0) {
    const Frame F = phase_frame(F0);
    using namespace sm;
    const size_t gt = (size_t)F.vcu * NT + F.tid, GT = (size_t)F.G * NT;
    for (size_t i = gt; i < (size_t)2 * 48 * 1024; i += GT) { const int l = (int)(i / (48 * 1024)), j = (int)((i / 1024) % 48), k = (int)(i % 1024); float v = 0.f;
        if (j < 4) v = F.in[I_MOE_WG][((size_t)l * 1024 + k) * 4 + j]; else if (j < 36) v = F.in[I_MOE_WE][((size_t)l * 1024 + k) * 32 + (j - 4)];
        v *= F.in[I_NORM_FFN][l * 1024 + k];
        const unsigned hi = cvt_pk_bf16(v, 0.f) & 0xffffu; const float rem = v - __uint_as_float(hi << 16);
        OKP(bf16_t, WS_WRH)[i] = (bf16_t)hi; OKP(bf16_t, WS_WRL)[i] = (bf16_t)(cvt_pk_bf16(rem, 0.f) & 0xffffu); }
}

constexpr size_t WS_W16H = WS_WR + 512 * KiB, WS_W16L = WS_W16H + 64 * KiB;
__device__ __forceinline__ void prologue_w16_tables(const Frame& F0) {
    using namespace sm;
    const Frame F = phase_frame(F0);
    const size_t gt = (size_t)F.vcu * NT + F.tid, GT = (size_t)F.G * NT;
    for (size_t i = gt; i < (size_t)2 * 16 * 1024; i += GT) { const int set = (int)(i >> 14), j = (int)((i >> 10) & 15), k = (int)(i & 1023);
        const float v = set == 0 ? F.in[I_NORM_MIX][k] * F.in[I_EV_WIN][(size_t)k * 4112 + 4096 + j] : F.in[I_NORM_MIX][1024 + k] * F.in[I_OD_WIN][(size_t)k * 5648 + 4096 + j];
        const unsigned hi = cvt_pk_bf16(v, 0.f) & 0xffffu; const float rem = v - __uint_as_float(hi << 16);
        OKP(bf16_t, WS_W16H)[i] = (bf16_t)hi; OKP(bf16_t, WS_W16L)[i] = (bf16_t)(cvt_pk_bf16(rem, 0.f) & 0xffffu); }
}
__device__ __forceinline__ void phase_proj16(const Frame& F0, int set, const float* h, const bf16_t* hb, const float* ssq, int np) {
    const Frame F = phase_frame(F0);
    const int lane = F.lane, fr = lane & 15, fq = lane >> 4;
    const bf16_t* wh = OKP(bf16_t, WS_W16H) + (size_t)set * 16 * 1024; const bf16_t* wl = OKP(bf16_t, WS_W16L) + (size_t)set * 16 * 1024;
    const int gw = F.vcu * NWAVES + F.wave, NGW = F.G * NWAVES;
    for (int tile = gw; tile < T / 16; tile += NGW) { const int t0 = tile * 16; f32x4 acc = {0.f, 0.f, 0.f, 0.f};
        const float* hp = h + (size_t)(t0 + fr) * DM + fq * 8;
#pragma unroll 8
        for (int ks = 0; ks < 32; ++ks) { const size_t wo = (size_t)fr * 1024 + ks * 32 + fq * 8; const bf16x8 bh = *(const bf16x8*)(wh + wo), bl = *(const bf16x8*)(wl + wo);
            if (hb) { const bf16x8 ah = *(const bf16x8*)(hb + (size_t)(t0 + fr) * DM + fq * 8 + ks * 32); acc = mfma16(bh, ah, acc); acc = mfma16(bl, ah, acc); }
            else { const f32x4 x0 = *(const f32x4*)(hp + ks * 32), x1 = *(const f32x4*)(hp + ks * 32 + 4);
            u32x4 hi, lo;
            hi.x = cvt_pk_bf16(x0[0], x0[1]); hi.y = cvt_pk_bf16(x0[2], x0[3]); hi.z = cvt_pk_bf16(x1[0], x1[1]); hi.w = cvt_pk_bf16(x1[2], x1[3]);
            lo.x = cvt_pk_bf16(x0[0] - bflo(hi.x), x0[1] - bfhi(hi.x)); lo.y = cvt_pk_bf16(x0[2] - bflo(hi.y), x0[3] - bfhi(hi.y));
            lo.z = cvt_pk_bf16(x1[0] - bflo(hi.z), x1[1] - bfhi(hi.z)); lo.w = cvt_pk_bf16(x1[2] - bflo(hi.w), x1[3] - bfhi(hi.w));
            const bf16x8 ah = __builtin_bit_cast(bf16x8, hi), al = __builtin_bit_cast(bf16x8, lo);
            acc = mfma16(bh, ah, acc); acc = mfma16(bl, ah, acc); acc = mfma16(bh, al, acc); } }
        acc *= rstd_np(ssq, np, t0 + fr);
        *(f32x4*)(OKP(float, WS_RAW16) + (size_t)(t0 + fr) * 16 + 4 * fq) = acc; }
}

__device__ __forceinline__ void phase_router(const Frame& F0, int l, const bf16_t* hb, const float* ssq, int np) {
    const Frame F = phase_frame(F0);
    using namespace sm;
    const int lane = F.lane, wave = F.wave, fr = lane & 15, fq = lane >> 4;
    LAS float* lg = (LAS float*)(F.lds + wave * 16384 + 8704);
    const bf16_t* wh = OKP(bf16_t, WS_WRH) + (size_t)l * 48 * 1024; const bf16_t* wl = OKP(bf16_t, WS_WRL) + (size_t)l * 48 * 1024;
    const float* bg = F.in[I_MOE_BG] + l * 4; const float* be = F.in[I_MOE_BE] + l * 32;
    unsigned* cnt = F.ctl + CW_MOE + l * 64;
    const int gw = F.vcu * NWAVES + wave, NGW = F.G * NWAVES;
    for (int tile = gw; tile < T / 16; tile += NGW) {
        const int t0 = tile * 16;
        f32x4 acc[3] = {{0.f, 0.f, 0.f, 0.f}, {0.f, 0.f, 0.f, 0.f}, {0.f, 0.f, 0.f, 0.f}};
        const bf16_t* hp = hb + (size_t)(t0 + fr) * DM + fq * 8;
#pragma unroll 8
        for (int ks = 0; ks < 32; ++ks) { const bf16x8 ah = *(const bf16x8*)(hp + ks * 32);
#pragma unroll
            for (int nt = 0; nt < 3; ++nt) { const size_t wo = (size_t)(nt * 16 + fr) * 1024 + ks * 32 + fq * 8; const bf16x8 bh = *(const bf16x8*)(wh + wo), bl = *(const bf16x8*)(wl + wo);
                acc[nt] = mfma16(bh, ah, acc[nt]); acc[nt] = mfma16(bl, ah, acc[nt]); } }
#pragma unroll
        for (int nt = 0; nt < 3; ++nt) *(LAS f32x4*)(lg + fr * 48 + nt * 16 + 4 * fq) = acc[nt];
        WAVE_SYNC();
        if (lane < 16) { const int t = t0 + lane; const LAS float* p = lg + lane * 48; const float rs = rstd_np(ssq, np, t);
            const float g0 = p[0] * rs + bg[0], g1 = p[1] * rs + bg[1], g2 = p[2] * rs + bg[2], g3 = p[3] * rs + bg[3];
            int gsel = 0; float gm = g0; if (g1 > gm) { gm = g1; gsel = 1; } if (g2 > gm) { gm = g2; gsel = 2; } if (g3 > gm) { gm = g3; gsel = 3; }
            const float gwt = 1.f / (expf(g0 - gm) + expf(g1 - gm) + expf(g2 - gm) + expf(g3 - gm));
            const LAS float* pe = p + 4 + gsel * 8; const float* bb = be + gsel * 8;
            float e[8];
#pragma unroll
            for (int j = 0; j < 8; ++j) e[j] = pe[j] * rs + bb[j];
            int i1 = 0; float m1 = e[0];
#pragma unroll
            for (int j = 1; j < 8; ++j) if (e[j] > m1) { m1 = e[j]; i1 = j; }
            int i2 = -1; float m2 = -3.0e38f;
#pragma unroll
            for (int j = 0; j < 8; ++j) if (j != i1 && e[j] > m2) { m2 = e[j]; i2 = j; }
            const float r = expf(m2 - m1); const float w1 = gwt / (1.f + r), w2 = gwt * r / (1.f + r);
            const int e1 = gsel * 8 + i1, e2 = gsel * 8 + i2;
            OKP(int, WS_EID)[t * 2] = e1; OKP(int, WS_EID)[t * 2 + 1] = e2; OKP(float, WS_GATEW)[t * 2] = w1; OKP(float, WS_GATEW)[t * 2 + 1] = w2;
            OKP(int, WS_POS)[t * 2] = (int)atomicAdd(cnt + e1, 1u); OKP(int, WS_POS)[t * 2 + 1] = (int)atomicAdd(cnt + e2, 1u); }
        WAVE_SYNC();
    }
}

__device__ __forceinline__ void phase_scatter(const Frame& F0, int l, const bf16_t* hb, const float* ssq, int np) {
    const Frame F = phase_frame(F0);
    const unsigned* cnt = F.ctl + CW_MOE + l * 64; const int lane = F.lane;
    const int gw = F.vcu * NWAVES + F.wave, NGW = F.G * NWAVES;
    int base = 0;
    { int tiles = lane < 32 ? (((int)cnt[lane & 31] + 255) >> 8) : 0; int incl = tiles;
#pragma unroll
      for (int o = 1; o < 32; o <<= 1) { const int n = __shfl_up(incl, o); if ((lane & 31) >= o) incl += n; }
      base = (incl - tiles) * 256;
      const int cnt_e = lane < 32 ? (int)cnt[lane & 31] : 0; const int light = (tiles > 0 && cnt_e - 256 * (tiles - 1) <= 128) ? 1 : 0, full = tiles - light;
      int fincl = full, lincl = light;
#pragma unroll
      for (int o = 1; o < 32; o <<= 1) { const int n1 = __shfl_up(fincl, o), n2 = __shfl_up(lincl, o); if ((lane & 31) >= o) { fincl += n1; lincl += n2; } }
      const int ntiles = __shfl(incl, 31), nfull = __shfl(fincl, 31);
      if (blockIdx.x == 0 && F.wave == 0) { if (lane < 32) { for (int i = 0; i < tiles; ++i) OKP(int, WS_TILEEXP)[(base >> 8) + i] = lane;
              for (int i = 0; i < full; ++i) OKP(int, WS_TILEEXP)[512 + (fincl - full) + i] = (base >> 8) + i;
              if (light) OKP(int, WS_TILEEXP)[512 + nfull + (lincl - 1)] = ((base >> 8) + tiles - 1) | (1 << 16); }
          if (lane == 0) OKP(int, WS_TILEEXP)[1023] = ntiles; } }
    for (int a0 = gw * 4; a0 < T * 2; a0 += NGW * 4) {
        int slot[4]; u32x4 r0[4], r1[4];
#pragma unroll
        for (int k = 0; k < 4; ++k) { const int a = a0 + k; const int e = OKP(int, WS_EID)[a]; slot[k] = __shfl(base, e) + OKP(int, WS_POS)[a]; }
#pragma unroll
        for (int k = 0; k < 4; ++k) { const u32x4* src = (const u32x4*)(hb + (size_t)((a0 + k) >> 1) * DM) + lane; r0[k] = src[0]; r1[k] = src[64]; }
#pragma unroll
        for (int k = 0; k < 4; ++k) { const int a = a0 + k, t = a >> 1; u32x4* dst = (u32x4*)(OKP(bf16_t, WS_XS) + (size_t)slot[k] * DM) + lane; dst[0] = r0[k]; dst[64] = r1[k];
            if (lane == 0) { OKP(int, WS_TOKSLOT)[a] = slot[k]; OKP(float, WS_SLOTGATE)[slot[k]] = OKP(float, WS_GATEW)[a]; OKP(float, WS_SLOTRSTD)[slot[k]] = rstd_np(ssq, np, t); } } }
}

__device__ __forceinline__ void phase_combine(const Frame& F0, bf16_t* hb, float* ssq, bool final_layer) {
    using namespace sm;
    const Frame F = phase_frame(F0);
    const int lane = F.lane; const int gw = F.vcu * NWAVES + F.wave, NGW = F.G * NWAVES; const bf16_t* y = OKP(bf16_t, WS_Y);
    for (int t0 = gw * 2; t0 < T; t0 += NGW * 2) {
        int sa[2], sb[2];
#pragma unroll
        for (int k = 0; k < 2; ++k) { sa[k] = OKP(int, WS_TOKSLOT)[(t0 + k) * 2]; sb[k] = OKP(int, WS_TOKSLOT)[(t0 + k) * 2 + 1]; }
        u32x2 ra[2][4], rb[2][4], rh[2][4];
#pragma unroll
        for (int k = 0; k < 2; ++k) { const u32x2* hr = (const u32x2*)(hb + (size_t)(t0 + k) * DM) + lane; const u32x2* ya = (const u32x2*)(y + (size_t)sa[k] * DM) + lane; const u32x2* yb = (const u32x2*)(y + (size_t)sb[k] * DM) + lane;
#pragma unroll
            for (int j = 0; j < 4; ++j) { ra[k][j] = ya[64 * j]; rb[k][j] = yb[64 * j]; rh[k][j] = hr[64 * j]; } }
#pragma unroll
        for (int k = 0; k < 2; ++k) { const int t = t0 + k; u32x2* hr = (u32x2*)(hb + (size_t)t * DM) + lane; f32x4 v[4]; float s = 0.f;
#pragma unroll
            for (int j = 0; j < 4; ++j) { const u32x2 a = ra[k][j], b = rb[k][j], hw = rh[k][j]; f32x4 x;
                x[0] = bflo(hw.x) + (bflo(a.x) + bflo(b.x)); x[1] = bfhi(hw.x) + (bfhi(a.x) + bfhi(b.x)); x[2] = bflo(hw.y) + (bflo(a.y) + bflo(b.y)); x[3] = bfhi(hw.y) + (bfhi(a.y) + bfhi(b.y));
                if (!final_layer) { u32x2 w; w.x = cvt_pk_bf16(x[0], x[1]); w.y = cvt_pk_bf16(x[2], x[3]); hr[64 * j] = w; x = (f32x4){bflo(w.x), bfhi(w.x), bflo(w.y), bfhi(w.y)}; }
                v[j] = x; s += (x[0] * x[0] + x[1] * x[1]) + (x[2] * x[2] + x[3] * x[3]); }
            s = wave_sum(s);
            if (!final_layer) { if (lane == 0) ssq[t] = s; }
            else { const float rs = frsq(s * (1.f / DM) + EPS); f32x4* orow = (f32x4*)(F.out + (size_t)t * DM) + lane; const f32x4* gr = (const f32x4*)F.in[I_FINAL_NORM] + lane;
#pragma unroll
                for (int j = 0; j < 4; ++j) { const f32x4 g = gr[64 * j]; f32x4 o; o[0] = v[j][0] * rs * g[0]; o[1] = v[j][1] * rs * g[1]; o[2] = v[j][2] * rs * g[2]; o[3] = v[j][3] * rs * g[3]; orow[64 * j] = o; } } } }
}

#ifndef CPU_EMU
struct MoeOrder {
    static constexpr bool LIGHT = true;
    const char* A; const char* W; const int* tile_exp; size_t a_tstep, w_estride, w_off, w_tstep; int G, c;
    __device__ bool next(int i, pg8::Unit& u) const {
        const int Lx = i * G + c; const int ntiles = tile_exp[1023]; if (Lx >= ntiles * 4) return false;
        const int info = tile_exp[512 + (Lx >> 2)], tile = info & 0xffff; u.pm = tile; u.pn = Lx & 3; u.tag = info >> 16; const int e = tile_exp[tile];
        u.a = A + (size_t)tile * a_tstep; u.b = W + (size_t)e * w_estride + w_off + (size_t)u.pn * w_tstep; return true;
    }
    __device__ __forceinline__ void a_ready(const pg8::Unit&) const {}
    __device__ __forceinline__ void done(const pg8::Unit&) const {}
};
struct EpiSwiGLU {
    static constexpr bool PERM = false, AFTER_DRAIN = false;
    bf16_t* act; const float* slot_rstd;
    __device__ __forceinline__ void operator()(const f32x4 (&acc)[2][2][4][2], const pg8::Unit& u, int wr, int wc, int fr, int fq) const {
        const int row0 = u.pm * 256 + wr * 64 + fr, col0 = u.pn * 128 + wc * 16 + 4 * fq;
#pragma unroll
        for (int ai = 0; ai < 2; ++ai)
#pragma unroll
            for (int m = 0; m < 4; ++m) { const int row = row0 + ai * 128 + m * 16; const float rs = slot_rstd[row]; bf16_t* rowp = act + (size_t)row * 512 + col0;
#pragma unroll
                for (int bj = 0; bj < 2; ++bj) { const f32x4 g = acc[ai][bj][m][0] * rs, up = acc[ai][bj][m][1] * rs; f32x4 o;
#pragma unroll
                    for (int r = 0; r < 4; ++r) o[r] = g[r] * frcp(1.f + fexp(-g[r])) * up[r];
                    u32x2 w; w.x = cvt_pk_bf16(o[0], o[1]); w.y = cvt_pk_bf16(o[2], o[3]); *(u32x2*)(rowp + bj * 64) = w; } }
    }
};
struct EpiDown {
    static constexpr bool PERM = true, AFTER_DRAIN = false;
    bf16_t* y; const float* slot_gate;
    __device__ __forceinline__ void operator()(const f32x4 (&acc)[2][2][4][2], const pg8::Unit& u, int wr, int wc, int fr, int fq) const {
        const int row0 = u.pm * 256 + wr * 64 + fr, col0 = u.pn * 256 + wc * 32 + 8 * fq;
#pragma unroll
        for (int ai = 0; ai < 2; ++ai)
#pragma unroll
            for (int m = 0; m < 4; ++m) { const int row = row0 + ai * 128 + m * 16; const float s = slot_gate[row]; bf16_t* rowp = y + (size_t)row * DM + col0;
#pragma unroll
                for (int bj = 0; bj < 2; ++bj) { const f32x4 v0 = acc[ai][bj][m][0] * s, v1 = acc[ai][bj][m][1] * s; u32x4 w; w.x = cvt_pk_bf16(v0[0], v0[1]); w.y = cvt_pk_bf16(v0[2], v0[3]); w.z = cvt_pk_bf16(v1[0], v1[1]); w.w = cvt_pk_bf16(v1[2], v1[3]);
                    *(u32x4*)(rowp + bj * 128) = w; } }
    }
};
__device__ __forceinline__ void phase_moe_up(const Frame& F) {
    pg8::Gemm g{nullptr, nullptr, 0, 0, 1024};
    MoeOrder S{(const char*)OKP(bf16_t, WS_XS), (const char*)OKP(bf16_t, WS_MOEW), OKP(int, WS_TILEEXP), (size_t)256 * 1024 * 2, 3 * MiB, 0, (size_t)256 * 1024 * 2, F.G, (int)blockIdx.x};
    EpiSwiGLU E{OKP(bf16_t, WS_ACT), OKP(float, WS_SLOTRSTD)};
    pg8::gemm_phase<EpiSwiGLU, MoeOrder, true, true>(F.lds, g, S, E);
}
__device__ __forceinline__ void phase_moe_down(const Frame& F) {
    pg8::Gemm g{nullptr, nullptr, 0, 0, 512};
    MoeOrder S{(const char*)OKP(bf16_t, WS_ACT), (const char*)OKP(bf16_t, WS_MOEW), OKP(int, WS_TILEEXP), (size_t)256 * 512 * 2, 3 * MiB, 2 * MiB, (size_t)256 * 512 * 2, F.G, (int)blockIdx.x};
    EpiDown E{OKP(bf16_t, WS_Y), OKP(float, WS_SLOTGATE)};
    pg8::gemm_phase<EpiDown, MoeOrder, true, true>(F.lds, g, S, E);
}
#endif
}

#ifndef DUP_MASK
#define DUP_MASK 0
#endif
namespace ok {
constexpr size_t WS_GU = 160 * MiB, WS_GW = 192 * MiB, WS_GQD = 224 * MiB, WS_GKDT = 480 * MiB, WS_GAQK = 512 * MiB;
constexpr size_t WS_GDEC = WS_GCS;
constexpr size_t WS_OBUF = WS_H;
constexpr int G_LD = 132, GB_LD = 136, LM_LD = 68;
__device__ __forceinline__ float sigmoidf_(float x) { return frcp(1.f + fexp(-x)); }

template <int PARTS  > __device__ __forceinline__ void phase_gdn_prep_t(const Frame& F0) {
    using namespace sm;
    const Frame F = phase_frame(F0);
    LAS float* q_s = (LAS float*)F.lds; LAS float* k_s = (LAS float*)(F.lds + 33792); LAS float* v_s = (LAS float*)(F.lds + 67584);
    LAS bf16_t* Kn = (LAS bf16_t*)(F.lds + 101376); LAS bf16_t* Qn = (LAS bf16_t*)(F.lds + 118784);
    LAS float* g_s = (LAS float*)(F.lds + 136192); LAS float* beta_s = g_s + 64; LAS float* gc_s = g_s + 128; LAS float* eg_s = g_s + 192; LAS float* rq_s = g_s + 256; LAS float* rk_s = g_s + 320;
    LAS float* Lm = q_s;
    const int tid = F.tid, lane = F.lane, wave = F.wave, fr = lane & 15, fq = lane >> 4;
    const bf16_t* proj = OKP(bf16_t, WS_PROJ); const float* cw = F.in[I_OD_CONV];
    for (int u = F.vcu; u < NB * NCH * 8; u += F.G) {
        const int hd = u & 7, bc = u >> 3, b = bc / NCH, c = bc % NCH; const size_t row0 = (size_t)b * L + c * 64; const size_t ub = (size_t)bc * 8 + hd;
        LDS_BARRIER();
        if ((PARTS & 1) && tid < 384) { const int which = tid >> 7, d = tid & 127, xc = which * 1024 + hd * 128 + d; LAS float* dst = (which == 0 ? q_s : which == 1 ? k_s : v_s) + d;
            const float w0 = cw[xc], w1 = cw[3072 + xc], w2 = cw[6144 + xc], w3 = cw[9216 + xc]; const bf16_t* p = proj + row0 * PROJ1_LD + xc;
            float x0 = 0.f, x1 = 0.f, x2 = 0.f; if (c > 0) { x0 = bf2f(p[-3 * PROJ1_LD]); x1 = bf2f(p[-2 * PROJ1_LD]); x2 = bf2f(p[-PROJ1_LD]); }
            unsigned short raw[64];
#pragma unroll
            for (int t = 0; t < 64; ++t) raw[t] = p[(size_t)t * PROJ1_LD];
#pragma unroll
            for (int t = 0; t < 64; ++t) { const float x3 = bf2f(raw[t]); const float v = w0 * x0 + w1 * x1 + w2 * x2 + w3 * x3; dst[t * G_LD] = siluf(v); x0 = x1; x1 = x2; x2 = x3; } }
        if ((PARTS & 1) && tid >= 448) { const int t = tid - 448; const float* r16 = OKP(float, WS_RAW16) + (row0 + t) * 16;
            g_s[t] = -expf(F.in[I_OD_ALOG][hd]) * softplusf(r16[hd] + F.in[I_OD_DTB][hd]); beta_s[t] = sigmoidf_(r16[8 + hd]); }
        LDS_BARRIER();
        if (!(PARTS & 1)) {} else if (wave == 0) { float v = g_s[lane];
#pragma unroll
            for (int o = 1; o < 64; o <<= 1) { const float n = __shfl_up(v, o); if (lane >= o) v += n; }
            gc_s[lane] = v; eg_s[lane] = fexp(v); if (lane == 63) OKP(float, WS_GDEC)[ub] = fexp(v); }
        else if (wave <= 2) { const LAS float* src = (wave == 1 ? q_s : k_s) + lane * G_LD; float s = 0.f;
#pragma unroll 8
            for (int d = 0; d < 128; d += 4) { const f32x4 x = *(const LAS f32x4*)(src + d); s += (x.x * x.x + x.y * x.y) + (x.z * x.z + x.w * x.w); }
            const float r = frsq(s + EPS); if (wave == 1) rq_s[lane] = r * 0.08838834764831845f; else rk_s[lane] = r; }
        LDS_BARRIER();
        if (PARTS & 2)
        { const float gl = gc_s[63];
          for (int i = tid; i < 64 * 64; i += NT) { const int t = i >> 6, dp = (i & 63) * 2; const float rk = rk_s[t], rq = rq_s[t], eg = eg_s[t];
              const float k0 = k_s[t * G_LD + dp] * rk, k1 = k_s[t * G_LD + dp + 1] * rk, q0 = q_s[t * G_LD + dp] * rq, q1 = q_s[t * G_LD + dp + 1] * rq;
              *(LAS unsigned*)(Kn + t * GB_LD + dp) = cvt_pk_bf16(k0, k1); *(LAS unsigned*)(Qn + t * GB_LD + dp) = cvt_pk_bf16(q0, q1);
              *(unsigned*)(OKP(bf16_t, WS_GQD) + ub * 8192 + t * 128 + dp) = cvt_pk_bf16(q0 * eg, q1 * eg); }
          { const int t = tid & 63, dg = tid >> 6; const float f = rk_s[t] * fexp(gl - gc_s[t]); bf16_t* dst = OKP(bf16_t, WS_GKDT) + ub * 8192 + t;
#pragma unroll
            for (int j = 0; j < 16; ++j) { const int d = dg * 16 + j; dst[d * 64] = (bf16_t)(cvt_pk_bf16(k_s[t * G_LD + d] * f, 0.f) & 0xffffu); } } }
        LDS_BARRIER();
        if (PARTS & 4)
#pragma unroll
        for (int i = 0; i < 4; ++i) { const int tl = wave * 4 + i, which = tl >> 4, ti = (tl >> 2) & 3, si = tl & 3;
            f32x4 acc = {0.f, 0.f, 0.f, 0.f};
            if (si <= ti) {
#pragma unroll
                for (int ks = 0; ks < 4; ++ks) { const bf16x8 a = *(const LAS bf16x8*)(Kn + (si * 16 + fr) * GB_LD + ks * 32 + fq * 8); const bf16x8 bb = *(const LAS bf16x8*)((which ? Qn : Kn) + (ti * 16 + fr) * GB_LD + ks * 32 + fq * 8); acc = mfma16(a, bb, acc); }
                const int t = ti * 16 + fr; const float gt = gc_s[t], bt = beta_s[t];
#pragma unroll
                for (int r = 0; r < 4; ++r) { const int s = si * 16 + 4 * fq + r; const float dec = fexp(gt - gc_s[s]); acc[r] = which ? (s <= t ? acc[r] * dec : 0.f) : (s < t ? acc[r] * dec * bt : 0.f); } }
            const int t = ti * 16 + fr, s0 = si * 16 + 4 * fq;
            if (which) { u32x2 w; w.x = cvt_pk_bf16(acc[0], acc[1]); w.y = cvt_pk_bf16(acc[2], acc[3]); *(u32x2*)(OKP(bf16_t, WS_GAQK) + ub * 4096 + t * 64 + s0) = w; }
            else { Lm[(s0 + 0) * LM_LD + t] = acc[0]; Lm[(s0 + 1) * LM_LD + t] = acc[1]; Lm[(s0 + 2) * LM_LD + t] = acc[2]; Lm[(s0 + 3) * LM_LD + t] = acc[3]; } }
        LDS_BARRIER();
        if ((PARTS & 8) && tid < 256) { const int cidx = tid & 127; const bool isw = tid >= 128; const LAS float* col = (isw ? k_s : v_s) + cidx; bf16_t* dst = OKP(bf16_t, isw ? WS_GW : WS_GU) + ub * 8192 + (isw ? cidx : cidx * 4);
            const LAS float* LmL = Lm; const LAS float* bsL = beta_s;
#ifndef CPU_EMU
            asm volatile("" : "+v"(col), "+v"(LmL), "+v"(bsL));
#endif
            float x[64]; f32x4 Lb[2][8];
#define GL(buf, row0, col0) do { _Pragma("unroll") for (int i_ = 0; i_ < 2; ++i_) { _Pragma("unroll") for (int q_ = 0; q_ < 4; ++q_) Lb[buf][i_ * 4 + q_] = *(const LAS f32x4*)(LmL + ((row0) + i_) * LM_LD + (col0) + q_ * 4); } } while (0)
#ifdef CPU_EMU
#define GPIN() do {} while (0)
#else
#define GPIN() asm volatile("" : "+v"(a[0]), "+v"(a[1]), "+v"(a[2]), "+v"(a[3]), "+v"(a[4]), "+v"(a[5]), "+v"(a[6]), "+v"(a[7]), "+v"(a[8]), "+v"(a[9]), "+v"(a[10]), "+v"(a[11]), "+v"(a[12]), "+v"(a[13]), "+v"(a[14]), "+v"(a[15]), "+v"(LmL))
#endif
            { float a[16];
            GL(0, 0, 0);
#pragma unroll
            for (int tt = 0; tt < 16; ++tt) { const int t = 0 + tt; float v = col[t * G_LD] * bsL[t]; if (isw) v *= bsL[256 + t] * bsL[128 + t]; a[tt] = v; }
            GL(1, 2, 0);
#pragma unroll
            for (int i = 0; i < 2; ++i) { const int ss = 0 + i; const float xv = a[ss]; x[0 + ss] = xv; if (isw) dst[(0 + ss) * 128] = (bf16_t)(cvt_pk_bf16(xv, 0.f) & 0xffffu);
#pragma unroll
                for (int q4 = 0; q4 < 4; ++q4)
#pragma unroll
                    for (int r = 0; r < 4; ++r) if (q4 * 4 + r > ss) a[q4 * 4 + r] -= Lb[0][i * 4 + q4][r] * xv; }
            GPIN();
            GL(0, 4, 0);
#pragma unroll
            for (int i = 0; i < 2; ++i) { const int ss = 2 + i; const float xv = a[ss]; x[0 + ss] = xv; if (isw) dst[(0 + ss) * 128] = (bf16_t)(cvt_pk_bf16(xv, 0.f) & 0xffffu);
#pragma unroll
                for (int q4 = 0; q4 < 4; ++q4)
#pragma unroll
                    for (int r = 0; r < 4; ++r) if (q4 * 4 + r > ss) a[q4 * 4 + r] -= Lb[1][i * 4 + q4][r] * xv; }
            GPIN();
            GL(1, 6, 0);
#pragma unroll
            for (int i = 0; i < 2; ++i) { const int ss = 4 + i; const float xv = a[ss]; x[0 + ss] = xv; if (isw) dst[(0 + ss) * 128] = (bf16_t)(cvt_pk_bf16(xv, 0.f) & 0xffffu);
#pragma unroll
                for (int q4 = 0; q4 < 4; ++q4)
#pragma unroll
                    for (int r = 0; r < 4; ++r) if (q4 * 4 + r > ss) a[q4 * 4 + r] -= Lb[0][i * 4 + q4][r] * xv; }
            GPIN();
            GL(0, 8, 0);
#pragma unroll
            for (int i = 0; i < 2; ++i) { const int ss = 6 + i; const float xv = a[ss]; x[0 + ss] = xv; if (isw) dst[(0 + ss) * 128] = (bf16_t)(cvt_pk_bf16(xv, 0.f) & 0xffffu);
#pragma unroll
                for (int q4 = 0; q4 < 4; ++q4)
#pragma unroll
                    for (int r = 0; r < 4; ++r) if (q4 * 4 + r > ss) a[q4 * 4 + r] -= Lb[1][i * 4 + q4][r] * xv; }
            GPIN();
            GL(1, 10, 0);
#pragma unroll
            for (int i = 0; i < 2; ++i) { const int ss = 8 + i; const float xv = a[ss]; x[0 + ss] = xv; if (isw) dst[(0 + ss) * 128] = (bf16_t)(cvt_pk_bf16(xv, 0.f) & 0xffffu);
#pragma unroll
                for (int q4 = 0; q4 < 4; ++q4)
#pragma unroll
                    for (int r = 0; r < 4; ++r) if (q4 * 4 + r > ss) a[q4 * 4 + r] -= Lb[0][i * 4 + q4][r] * xv; }
            GPIN();
            GL(0, 12, 0);
#pragma unroll
            for (int i = 0; i < 2; ++i) { const int ss = 10 + i; const float xv = a[ss]; x[0 + ss] = xv; if (isw) dst[(0 + ss) * 128] = (bf16_t)(cvt_pk_bf16(xv, 0.f) & 0xffffu);
#pragma unroll
                for (int q4 = 0; q4 < 4; ++q4)
#pragma unroll
                    for (int r = 0; r < 4; ++r) if (q4 * 4 + r > ss) a[q4 * 4 + r] -= Lb[1][i * 4 + q4][r] * xv; }
            GPIN();
            GL(1, 14, 0);
#pragma unroll
            for (int i = 0; i < 2; ++i) { const int ss = 12 + i; const float xv = a[ss]; x[0 + ss] = xv; if (isw) dst[(0 + ss) * 128] = (bf16_t)(cvt_pk_bf16(xv, 0.f) & 0xffffu);
#pragma unroll
                for (int q4 = 0; q4 < 4; ++q4)
#pragma unroll
                    for (int r = 0; r < 4; ++r) if (q4 * 4 + r > ss) a[q4 * 4 + r] -= Lb[0][i * 4 + q4][r] * xv; }
            GPIN();
            GL(0, 0, 16);
#pragma unroll
            for (int i = 0; i < 2; ++i) { const int ss = 14 + i; const float xv = a[ss]; x[0 + ss] = xv; if (isw) dst[(0 + ss) * 128] = (bf16_t)(cvt_pk_bf16(xv, 0.f) & 0xffffu);
#pragma unroll
                for (int q4 = 0; q4 < 4; ++q4)
#pragma unroll
                    for (int r = 0; r < 4; ++r) if (q4 * 4 + r > ss) a[q4 * 4 + r] -= Lb[1][i * 4 + q4][r] * xv; }
            if (!isw) {
#pragma unroll
                for (int q4 = 0; q4 < 4; ++q4) { u32x2 w; w.x = cvt_pk_bf16(a[q4 * 4], a[q4 * 4 + 1]); w.y = cvt_pk_bf16(a[q4 * 4 + 2], a[q4 * 4 + 3]); *(u32x2*)(dst + (size_t)(0 + q4) * 512) = w; } }
            GPIN();
#pragma unroll
            for (int tt = 0; tt < 16; ++tt) { const int t = 16 + tt; float v = col[t * G_LD] * bsL[t]; if (isw) v *= bsL[256 + t] * bsL[128 + t]; a[tt] = v; }
            GL(1, 2, 16);
#pragma unroll
            for (int i = 0; i < 2; ++i) { const float xs = x[0 + i];
#pragma unroll
                for (int q4 = 0; q4 < 4; ++q4)
#pragma unroll
                    for (int r = 0; r < 4; ++r) a[q4 * 4 + r] -= Lb[0][i * 4 + q4][r] * xs; }
            GPIN();
            GL(0, 4, 16);
#pragma unroll
            for (int i = 0; i < 2; ++i) { const float xs = x[2 + i];
#pragma unroll
                for (int q4 = 0; q4 < 4; ++q4)
#pragma unroll
                    for (int r = 0; r < 4; ++r) a[q4 * 4 + r] -= Lb[1][i * 4 + q4][r] * xs; }
            GPIN();
            GL(1, 6, 16);
#pragma unroll
            for (int i = 0; i < 2; ++i) { const float xs = x[4 + i];
#pragma unroll
                for (int q4 = 0; q4 < 4; ++q4)
#pragma unroll
                    for (int r = 0; r < 4; ++r) a[q4 * 4 + r] -= Lb[0][i * 4 + q4][r] * xs; }
            GPIN();
            GL(0, 8, 16);
#pragma unroll
            for (int i = 0; i < 2; ++i) { const float xs = x[6 + i];
#pragma unroll
                for (int q4 = 0; q4 < 4; ++q4)
#pragma unroll
                    for (int r = 0; r < 4; ++r) a[q4 * 4 + r] -= Lb[1][i * 4 + q4][r] * xs; }
            GPIN();
            GL(1, 10, 16);
#pragma unroll
            for (int i = 0; i < 2; ++i) { const float xs = x[8 + i];
#pragma unroll
                for (int q4 = 0; q4 < 4; ++q4)
#pragma unroll
                    for (int r = 0; r < 4; ++r) a[q4 * 4 + r] -= Lb[0][i * 4 + q4][r] * xs; }
            GPIN();
            GL(0, 12, 16);
#pragma unroll
            for (int i = 0; i < 2; ++i) { const float xs = x[10 + i];
#pragma unroll
                for (int q4 = 0; q4 < 4; ++q4)
#pragma unroll
                    for (int r = 0; r < 4; ++r) a[q4 * 4 + r] -= Lb[1][i * 4 + q4][r] * xs; }
            GPIN();
            GL(1, 14, 16);
#pragma unroll
            for (int i = 0; i < 2; ++i) { const float xs = x[12 + i];
#pragma unroll
                for (int q4 = 0; q4 < 4; ++q4)
#pragma unroll
                    for (int r = 0; r < 4; ++r) a[q4 * 4 + r] -= Lb[0][i * 4 + q4][r] * xs; }
            GPIN();
            GL(0, 16, 16);
#pragma unroll
            for (int i = 0; i < 2; ++i) { const float xs = x[14 + i];
#pragma unroll
                for (int q4 = 0; q4 < 4; ++q4)
#pragma unroll
                    for (int r = 0; r < 4; ++r) a[q4 * 4 + r] -= Lb[1][i * 4 + q4][r] * xs; }
            GPIN();
            GL(1, 18, 16);
#pragma unroll
            for (int i = 0; i < 2; ++i) { const int ss = 0 + i; const float xv = a[ss]; x[16 + ss] = xv; if (isw) dst[(16 + ss) * 128] = (bf16_t)(cvt_pk_bf16(xv, 0.f) & 0xffffu);
#pragma unroll
                for (int q4 = 0; q4 < 4; ++q4)
#pragma unroll
                    for (int r = 0; r < 4; ++r) if (q4 * 4 + r > ss) a[q4 * 4 + r] -= Lb[0][i * 4 + q4][r] * xv; }
            GPIN();
            GL(0, 20, 16);
#pragma unroll
            for (int i = 0; i < 2; ++i) { const int ss = 2 + i; const float xv = a[ss]; x[16 + ss] = xv; if (isw) dst[(16 + ss) * 128] = (bf16_t)(cvt_pk_bf16(xv, 0.f) & 0xffffu);
#pragma unroll
                for (int q4 = 0; q4 < 4; ++q4)
#pragma unroll
                    for (int r = 0; r < 4; ++r) if (q4 * 4 + r > ss) a[q4 * 4 + r] -= Lb[1][i * 4 + q4][r] * xv; }
            GPIN();
            GL(1, 22, 16);
#pragma unroll
            for (int i = 0; i < 2; ++i) { const int ss = 4 + i; const float xv = a[ss]; x[16 + ss] = xv; if (isw) dst[(16 + ss) * 128] = (bf16_t)(cvt_pk_bf16(xv, 0.f) & 0xffffu);
#pragma unroll
                for (int q4 = 0; q4 < 4; ++q4)
#pragma unroll
                    for (int r = 0; r < 4; ++r) if (q4 * 4 + r > ss) a[q4 * 4 + r] -= Lb[0][i * 4 + q4][r] * xv; }
            GPIN();
            GL(0, 24, 16);
#pragma unroll
            for (int i = 0; i < 2; ++i) { const int ss = 6 + i; const float xv = a[ss]; x[16 + ss] = xv; if (isw) dst[(16 + ss) * 128] = (bf16_t)(cvt_pk_bf16(xv, 0.f) & 0xffffu);
#pragma unroll
                for (int q4 = 0; q4 < 4; ++q4)
#pragma unroll
                    for (int r = 0; r < 4; ++r) if (q4 * 4 + r > ss) a[q4 * 4 + r] -= Lb[1][i * 4 + q4][r] * xv; }
            GPIN();
            GL(1, 26, 16);
#pragma unroll
            for (int i = 0; i < 2; ++i) { const int ss = 8 + i; const float xv = a[ss]; x[16 + ss] = xv; if (isw) dst[(16 + ss) * 128] = (bf16_t)(cvt_pk_bf16(xv, 0.f) & 0xffffu);
#pragma unroll
                for (int q4 = 0; q4 < 4; ++q4)
#pragma unroll
                    for (int r = 0; r < 4; ++r) if (q4 * 4 + r > ss) a[q4 * 4 + r] -= Lb[0][i * 4 + q4][r] * xv; }
            GPIN();
            GL(0, 28, 16);
#pragma unroll
            for (int i = 0; i < 2; ++i) { const int ss = 10 + i; const float xv = a[ss]; x[16 + ss] = xv; if (isw) dst[(16 + ss) * 128] = (bf16_t)(cvt_pk_bf16(xv, 0.f) & 0xffffu);
#pragma unroll
                for (int q4 = 0; q4 < 4; ++q4)
#pragma unroll
                    for (int r = 0; r < 4; ++r) if (q4 * 4 + r > ss) a[q4 * 4 + r] -= Lb[1][i * 4 + q4][r] * xv; }
            GPIN();
            GL(1, 30, 16);
#pragma unroll
            for (int i = 0; i < 2; ++i) { const int ss = 12 + i; const float xv = a[ss]; x[16 + ss] = xv; if (isw) dst[(16 + ss) * 128] = (bf16_t)(cvt_pk_bf16(xv, 0.f) & 0xffffu);
#pragma unroll
                for (int q4 = 0; q4 < 4; ++q4)
#pragma unroll
                    for (int r = 0; r < 4; ++r) if (q4 * 4 + r > ss) a[q4 * 4 + r] -= Lb[0][i * 4 + q4][r] * xv; }
            GPIN();
            GL(0, 0, 32);
#pragma unroll
            for (int i = 0; i < 2; ++i) { const int ss = 14 + i; const float xv = a[ss]; x[16 + ss] = xv; if (isw) dst[(16 + ss) * 128] = (bf16_t)(cvt_pk_bf16(xv, 0.f) & 0xffffu);
#pragma unroll
                for (int q4 = 0; q4 < 4; ++q4)
#pragma unroll
                    for (int r = 0; r < 4; ++r) if (q4 * 4 + r > ss) a[q4 * 4 + r] -= Lb[1][i * 4 + q4][r] * xv; }
            if (!isw) {
#pragma unroll
                for (int q4 = 0; q4 < 4; ++q4) { u32x2 w; w.x = cvt_pk_bf16(a[q4 * 4], a[q4 * 4 + 1]); w.y = cvt_pk_bf16(a[q4 * 4 + 2], a[q4 * 4 + 3]); *(u32x2*)(dst + (size_t)(4 + q4) * 512) = w; } }
            GPIN();
#pragma unroll
            for (int tt = 0; tt < 16; ++tt) { const int t = 32 + tt; float v = col[t * G_LD] * bsL[t]; if (isw) v *= bsL[256 + t] * bsL[128 + t]; a[tt] = v; }
            GL(1, 2, 32);
#pragma unroll
            for (int i = 0; i < 2; ++i) { const float xs = x[0 + i];
#pragma unroll
                for (int q4 = 0; q4 < 4; ++q4)
#pragma unroll
                    for (int r = 0; r < 4; ++r) a[q4 * 4 + r] -= Lb[0][i * 4 + q4][r] * xs; }
            GPIN();
            GL(0, 4, 32);
#pragma unroll
            for (int i = 0; i < 2; ++i) { const float xs = x[2 + i];
#pragma unroll
                for (int q4 = 0; q4 < 4; ++q4)
#pragma unroll
                    for (int r = 0; r < 4; ++r) a[q4 * 4 + r] -= Lb[1][i * 4 + q4][r] * xs; }
            GPIN();
            GL(1, 6, 32);
#pragma unroll
            for (int i = 0; i < 2; ++i) { const float xs = x[4 + i];
#pragma unroll
                for (int q4 = 0; q4 < 4; ++q4)
#pragma unroll
                    for (int r = 0; r < 4; ++r) a[q4 * 4 + r] -= Lb[0][i * 4 + q4][r] * xs; }
            GPIN();
            GL(0, 8, 32);
#pragma unroll
            for (int i = 0; i < 2; ++i) { const float xs = x[6 + i];
#pragma unroll
                for (int q4 = 0; q4 < 4; ++q4)
#pragma unroll
                    for (int r = 0; r < 4; ++r) a[q4 * 4 + r] -= Lb[1][i * 4 + q4][r] * xs; }
            GPIN();
            GL(1, 10, 32);
#pragma unroll
            for (int i = 0; i < 2; ++i) { const float xs = x[8 + i];
#pragma unroll
                for (int q4 = 0; q4 < 4; ++q4)
#pragma unroll
                    for (int r = 0; r < 4; ++r) a[q4 * 4 + r] -= Lb[0][i * 4 + q4][r] * xs; }
            GPIN();
            GL(0, 12, 32);
#pragma unroll
            for (int i = 0; i < 2; ++i) { const float xs = x[10 + i];
#pragma unroll
                for (int q4 = 0; q4 < 4; ++q4)
#pragma unroll
                    for (int r = 0; r < 4; ++r) a[q4 * 4 + r] -= Lb[1][i * 4 + q4][r] * xs; }
            GPIN();
            GL(1, 14, 32);
#pragma unroll
            for (int i = 0; i < 2; ++i) { const float xs = x[12 + i];
#pragma unroll
                for (int q4 = 0; q4 < 4; ++q4)
#pragma unroll
                    for (int r = 0; r < 4; ++r) a[q4 * 4 + r] -= Lb[0][i * 4 + q4][r] * xs; }
            GPIN();
            GL(0, 16, 32);
#pragma unroll
            for (int i = 0; i < 2; ++i) { const float xs = x[14 + i];
#pragma unroll
                for (int q4 = 0; q4 < 4; ++q4)
#pragma unroll
                    for (int r = 0; r < 4; ++r) a[q4 * 4 + r] -= Lb[1][i * 4 + q4][r] * xs; }
            GPIN();
            GL(1, 18, 32);
#pragma unroll
            for (int i = 0; i < 2; ++i) { const float xs = x[16 + i];
#pragma unroll
                for (int q4 = 0; q4 < 4; ++q4)
#pragma unroll
                    for (int r = 0; r < 4; ++r) a[q4 * 4 + r] -= Lb[0][i * 4 + q4][r] * xs; }
            GPIN();
            GL(0, 20, 32);
#pragma unroll
            for (int i = 0; i < 2; ++i) { const float xs = x[18 + i];
#pragma unroll
                for (int q4 = 0; q4 < 4; ++q4)
#pragma unroll
                    for (int r = 0; r < 4; ++r) a[q4 * 4 + r] -= Lb[1][i * 4 + q4][r] * xs; }
            GPIN();
            GL(1, 22, 32);
#pragma unroll
            for (int i = 0; i < 2; ++i) { const float xs = x[20 + i];
#pragma unroll
                for (int q4 = 0; q4 < 4; ++q4)
#pragma unroll
                    for (int r = 0; r < 4; ++r) a[q4 * 4 + r] -= Lb[0][i * 4 + q4][r] * xs; }
            GPIN();
            GL(0, 24, 32);
#pragma unroll
            for (int i = 0; i < 2; ++i) { const float xs = x[22 + i];
#pragma unroll
                for (int q4 = 0; q4 < 4; ++q4)
#pragma unroll
                    for (int r = 0; r < 4; ++r) a[q4 * 4 + r] -= Lb[1][i * 4 + q4][r] * xs; }
            GPIN();
            GL(1, 26, 32);
#pragma unroll
            for (int i = 0; i < 2; ++i) { const float xs = x[24 + i];
#pragma unroll
                for (int q4 = 0; q4 < 4; ++q4)
#pragma unroll
                    for (int r = 0; r < 4; ++r) a[q4 * 4 + r] -= Lb[0][i * 4 + q4][r] * xs; }
            GPIN();
            GL(0, 28, 32);
#pragma unroll
            for (int i = 0; i < 2; ++i) { const float xs = x[26 + i];
#pragma unroll
                for (int q4 = 0; q4 < 4; ++q4)
#pragma unroll
                    for (int r = 0; r < 4; ++r) a[q4 * 4 + r] -= Lb[1][i * 4 + q4][r] * xs; }
            GPIN();
            GL(1, 30, 32);
#pragma unroll
            for (int i = 0; i < 2; ++i) { const float xs = x[28 + i];
#pragma unroll
                for (int q4 = 0; q4 < 4; ++q4)
#pragma unroll
                    for (int r = 0; r < 4; ++r) a[q4 * 4 + r] -= Lb[0][i * 4 + q4][r] * xs; }
            GPIN();
            GL(0, 32, 32);
#pragma unroll
            for (int i = 0; i < 2; ++i) { const float xs = x[30 + i];
#pragma unroll
                for (int q4 = 0; q4 < 4; ++q4)
#pragma unroll
                    for (int r = 0; r < 4; ++r) a[q4 * 4 + r] -= Lb[1][i * 4 + q4][r] * xs; }
            GPIN();
            GL(1, 34, 32);
#pragma unroll
            for (int i = 0; i < 2; ++i) { const int ss = 0 + i; const float xv = a[ss]; x[32 + ss] = xv; if (isw) dst[(32 + ss) * 128] = (bf16_t)(cvt_pk_bf16(xv, 0.f) & 0xffffu);
#pragma unroll
                for (int q4 = 0; q4 < 4; ++q4)
#pragma unroll
                    for (int r = 0; r < 4; ++r) if (q4 * 4 + r > ss) a[q4 * 4 + r] -= Lb[0][i * 4 + q4][r] * xv; }
            GPIN();
            GL(0, 36, 32);
#pragma unroll
            for (int i = 0; i < 2; ++i) { const int ss = 2 + i; const float xv = a[ss]; x[32 + ss] = xv; if (isw) dst[(32 + ss) * 128] = (bf16_t)(cvt_pk_bf16(xv, 0.f) & 0xffffu);
#pragma unroll
                for (int q4 = 0; q4 < 4; ++q4)
#pragma unroll
                    for (int r = 0; r < 4; ++r) if (q4 * 4 + r > ss) a[q4 * 4 + r] -= Lb[1][i * 4 + q4][r] * xv; }
            GPIN();
            GL(1, 38, 32);
#pragma unroll
            for (int i = 0; i < 2; ++i) { const int ss = 4 + i; const float xv = a[ss]; x[32 + ss] = xv; if (isw) dst[(32 + ss) * 128] = (bf16_t)(cvt_pk_bf16(xv, 0.f) & 0xffffu);
#pragma unroll
                for (int q4 = 0; q4 < 4; ++q4)
#pragma unroll
                    for (int r = 0; r < 4; ++r) if (q4 * 4 + r > ss) a[q4 * 4 + r] -= Lb[0][i * 4 + q4][r] * xv; }
            GPIN();
            GL(0, 40, 32);
#pragma unroll
            for (int i = 0; i < 2; ++i) { const int ss = 6 + i; const float xv = a[ss]; x[32 + ss] = xv; if (isw) dst[(32 + ss) * 128] = (bf16_t)(cvt_pk_bf16(xv, 0.f) & 0xffffu);
#pragma unroll
                for (int q4 = 0; q4 < 4; ++q4)
#pragma unroll
                    for (int r = 0; r < 4; ++r) if (q4 * 4 + r > ss) a[q4 * 4 + r] -= Lb[1][i * 4 + q4][r] * xv; }
            GPIN();
            GL(1, 42, 32);
#pragma unroll
            for (int i = 0; i < 2; ++i) { const int ss = 8 + i; const float xv = a[ss]; x[32 + ss] = xv; if (isw) dst[(32 + ss) * 128] = (bf16_t)(cvt_pk_bf16(xv, 0.f) & 0xffffu);
#pragma unroll
                for (int q4 = 0; q4 < 4; ++q4)
#pragma unroll
                    for (int r = 0; r < 4; ++r) if (q4 * 4 + r > ss) a[q4 * 4 + r] -= Lb[0][i * 4 + q4][r] * xv; }
            GPIN();
            GL(0, 44, 32);
#pragma unroll
            for (int i = 0; i < 2; ++i) { const int ss = 10 + i; const float xv = a[ss]; x[32 + ss] = xv; if (isw) dst[(32 + ss) * 128] = (bf16_t)(cvt_pk_bf16(xv, 0.f) & 0xffffu);
#pragma unroll
                for (int q4 = 0; q4 < 4; ++q4)
#pragma unroll
                    for (int r = 0; r < 4; ++r) if (q4 * 4 + r > ss) a[q4 * 4 + r] -= Lb[1][i * 4 + q4][r] * xv; }
            GPIN();
            GL(1, 46, 32);
#pragma unroll
            for (int i = 0; i < 2; ++i) { const int ss = 12 + i; const float xv = a[ss]; x[32 + ss] = xv; if (isw) dst[(32 + ss) * 128] = (bf16_t)(cvt_pk_bf16(xv, 0.f) & 0xffffu);
#pragma unroll
                for (int q4 = 0; q4 < 4; ++q4)
#pragma unroll
                    for (int r = 0; r < 4; ++r) if (q4 * 4 + r > ss) a[q4 * 4 + r] -= Lb[0][i * 4 + q4][r] * xv; }
            GPIN();
            GL(0, 0, 48);
#pragma unroll
            for (int i = 0; i < 2; ++i) { const int ss = 14 + i; const float xv = a[ss]; x[32 + ss] = xv; if (isw) dst[(32 + ss) * 128] = (bf16_t)(cvt_pk_bf16(xv, 0.f) & 0xffffu);
#pragma unroll
                for (int q4 = 0; q4 < 4; ++q4)
#pragma unroll
                    for (int r = 0; r < 4; ++r) if (q4 * 4 + r > ss) a[q4 * 4 + r] -= Lb[1][i * 4 + q4][r] * xv; }
            if (!isw) {
#pragma unroll
                for (int q4 = 0; q4 < 4; ++q4) { u32x2 w; w.x = cvt_pk_bf16(a[q4 * 4], a[q4 * 4 + 1]); w.y = cvt_pk_bf16(a[q4 * 4 + 2], a[q4 * 4 + 3]); *(u32x2*)(dst + (size_t)(8 + q4) * 512) = w; } }
            GPIN();
#pragma unroll
            for (int tt = 0; tt < 16; ++tt) { const int t = 48 + tt; float v = col[t * G_LD] * bsL[t]; if (isw) v *= bsL[256 + t] * bsL[128 + t]; a[tt] = v; }
            GL(1, 2, 48);
#pragma unroll
            for (int i = 0; i < 2; ++i) { const float xs = x[0 + i];
#pragma unroll
                for (int q4 = 0; q4 < 4; ++q4)
#pragma unroll
                    for (int r = 0; r < 4; ++r) a[q4 * 4 + r] -= Lb[0][i * 4 + q4][r] * xs; }
            GPIN();
            GL(0, 4, 48);
#pragma unroll
            for (int i = 0; i < 2; ++i) { const float xs = x[2 + i];
#pragma unroll
                for (int q4 = 0; q4 < 4; ++q4)
#pragma unroll
                    for (int r = 0; r < 4; ++r) a[q4 * 4 + r] -= Lb[1][i * 4 + q4][r] * xs; }
            GPIN();
            GL(1, 6, 48);
#pragma unroll
            for (int i = 0; i < 2; ++i) { const float xs = x[4 + i];
#pragma unroll
                for (int q4 = 0; q4 < 4; ++q4)
#pragma unroll
                    for (int r = 0; r < 4; ++r) a[q4 * 4 + r] -= Lb[0][i * 4 + q4][r] * xs; }
            GPIN();
            GL(0, 8, 48);
#pragma unroll
            for (int i = 0; i < 2; ++i) { const float xs = x[6 + i];
#pragma unroll
                for (int q4 = 0; q4 < 4; ++q4)
#pragma unroll
                    for (int r = 0; r < 4; ++r) a[q4 * 4 + r] -= Lb[1][i * 4 + q4][r] * xs; }
            GPIN();
            GL(1, 10, 48);
#pragma unroll
            for (int i = 0; i < 2; ++i) { const float xs = x[8 + i];
#pragma unroll
                for (int q4 = 0; q4 < 4; ++q4)
#pragma unroll
                    for (int r = 0; r < 4; ++r) a[q4 * 4 + r] -= Lb[0][i * 4 + q4][r] * xs; }
            GPIN();
            GL(0, 12, 48);
#pragma unroll
            for (int i = 0; i < 2; ++i) { const float xs = x[10 + i];
#pragma unroll
                for (int q4 = 0; q4 < 4; ++q4)
#pragma unroll
                    for (int r = 0; r < 4; ++r) a[q4 * 4 + r] -= Lb[1][i * 4 + q4][r] * xs; }
            GPIN();
            GL(1, 14, 48);
#pragma unroll
            for (int i = 0; i < 2; ++i) { const float xs = x[12 + i];
#pragma unroll
                for (int q4 = 0; q4 < 4; ++q4)
#pragma unroll
                    for (int r = 0; r < 4; ++r) a[q4 * 4 + r] -= Lb[0][i * 4 + q4][r] * xs; }
            GPIN();
            GL(0, 16, 48);
#pragma unroll
            for (int i = 0; i < 2; ++i) { const float xs = x[14 + i];
#pragma unroll
                for (int q4 = 0; q4 < 4; ++q4)
#pragma unroll
                    for (int r = 0; r < 4; ++r) a[q4 * 4 + r] -= Lb[1][i * 4 + q4][r] * xs; }
            GPIN();
            GL(1, 18, 48);
#pragma unroll
            for (int i = 0; i < 2; ++i) { const float xs = x[16 + i];
#pragma unroll
                for (int q4 = 0; q4 < 4; ++q4)
#pragma unroll
                    for (int r = 0; r < 4; ++r) a[q4 * 4 + r] -= Lb[0][i * 4 + q4][r] * xs; }
            GPIN();
            GL(0, 20, 48);
#pragma unroll
            for (int i = 0; i < 2; ++i) { const float xs = x[18 + i];
#pragma unroll
                for (int q4 = 0; q4 < 4; ++q4)
#pragma unroll
                    for (int r = 0; r < 4; ++r) a[q4 * 4 + r] -= Lb[1][i * 4 + q4][r] * xs; }
            GPIN();
            GL(1, 22, 48);
#pragma unroll
            for (int i = 0; i < 2; ++i) { const float xs = x[20 + i];
#pragma unroll
                for (int q4 = 0; q4 < 4; ++q4)
#pragma unroll
                    for (int r = 0; r < 4; ++r) a[q4 * 4 + r] -= Lb[0][i * 4 + q4][r] * xs; }
            GPIN();
            GL(0, 24, 48);
#pragma unroll
            for (int i = 0; i < 2; ++i) { const float xs = x[22 + i];
#pragma unroll
                for (int q4 = 0; q4 < 4; ++q4)
#pragma unroll
                    for (int r = 0; r < 4; ++r) a[q4 * 4 + r] -= Lb[1][i * 4 + q4][r] * xs; }
            GPIN();
            GL(1, 26, 48);
#pragma unroll
            for (int i = 0; i < 2; ++i) { const float xs = x[24 + i];
#pragma unroll
                for (int q4 = 0; q4 < 4; ++q4)
#pragma unroll
                    for (int r = 0; r < 4; ++r) a[q4 * 4 + r] -= Lb[0][i * 4 + q4][r] * xs; }
            GPIN();
            GL(0, 28, 48);
#pragma unroll
            for (int i = 0; i < 2; ++i) { const float xs = x[26 + i];
#pragma unroll
                for (int q4 = 0; q4 < 4; ++q4)
#pragma unroll
                    for (int r = 0; r < 4; ++r) a[q4 * 4 + r] -= Lb[1][i * 4 + q4][r] * xs; }
            GPIN();
            GL(1, 30, 48);
#pragma unroll
            for (int i = 0; i < 2; ++i) { const float xs = x[28 + i];
#pragma unroll
                for (int q4 = 0; q4 < 4; ++q4)
#pragma unroll
                    for (int r = 0; r < 4; ++r) a[q4 * 4 + r] -= Lb[0][i * 4 + q4][r] * xs; }
            GPIN();
            GL(0, 32, 48);
#pragma unroll
            for (int i = 0; i < 2; ++i) { const float xs = x[30 + i];
#pragma unroll
                for (int q4 = 0; q4 < 4; ++q4)
#pragma unroll
                    for (int r = 0; r < 4; ++r) a[q4 * 4 + r] -= Lb[1][i * 4 + q4][r] * xs; }
            GPIN();
            GL(1, 34, 48);
#pragma unroll
            for (int i = 0; i < 2; ++i) { const float xs = x[32 + i];
#pragma unroll
                for (int q4 = 0; q4 < 4; ++q4)
#pragma unroll
                    for (int r = 0; r < 4; ++r) a[q4 * 4 + r] -= Lb[0][i * 4 + q4][r] * xs; }
            GPIN();
            GL(0, 36, 48);
#pragma unroll
            for (int i = 0; i < 2; ++i) { const float xs = x[34 + i];
#pragma unroll
                for (int q4 = 0; q4 < 4; ++q4)
#pragma unroll
                    for (int r = 0; r < 4; ++r) a[q4 * 4 + r] -= Lb[1][i * 4 + q4][r] * xs; }
            GPIN();
            GL(1, 38, 48);
#pragma unroll
            for (int i = 0; i < 2; ++i) { const float xs = x[36 + i];
#pragma unroll
                for (int q4 = 0; q4 < 4; ++q4)
#pragma unroll
                    for (int r = 0; r < 4; ++r) a[q4 * 4 + r] -= Lb[0][i * 4 + q4][r] * xs; }
            GPIN();
            GL(0, 40, 48);
#pragma unroll
            for (int i = 0; i < 2; ++i) { const float xs = x[38 + i];
#pragma unroll
                for (int q4 = 0; q4 < 4; ++q4)
#pragma unroll
                    for (int r = 0; r < 4; ++r) a[q4 * 4 + r] -= Lb[1][i * 4 + q4][r] * xs; }
            GPIN();
            GL(1, 42, 48);
#pragma unroll
            for (int i = 0; i < 2; ++i) { const float xs = x[40 + i];
#pragma unroll
                for (int q4 = 0; q4 < 4; ++q4)
#pragma unroll
                    for (int r = 0; r < 4; ++r) a[q4 * 4 + r] -= Lb[0][i * 4 + q4][r] * xs; }
            GPIN();
            GL(0, 44, 48);
#pragma unroll
            for (int i = 0; i < 2; ++i) { const float xs = x[42 + i];
#pragma unroll
                for (int q4 = 0; q4 < 4; ++q4)
#pragma unroll
                    for (int r = 0; r < 4; ++r) a[q4 * 4 + r] -= Lb[1][i * 4 + q4][r] * xs; }
            GPIN();
            GL(1, 46, 48);
#pragma unroll
            for (int i = 0; i < 2; ++i) { const float xs = x[44 + i];
#pragma unroll
                for (int q4 = 0; q4 < 4; ++q4)
#pragma unroll
                    for (int r = 0; r < 4; ++r) a[q4 * 4 + r] -= Lb[0][i * 4 + q4][r] * xs; }
            GPIN();
            GL(0, 48, 48);
#pragma unroll
            for (int i = 0; i < 2; ++i) { const float xs = x[46 + i];
#pragma unroll
                for (int q4 = 0; q4 < 4; ++q4)
#pragma unroll
                    for (int r = 0; r < 4; ++r) a[q4 * 4 + r] -= Lb[1][i * 4 + q4][r] * xs; }
            GPIN();
            GL(1, 50, 48);
#pragma unroll
            for (int i = 0; i < 2; ++i) { const int ss = 0 + i; const float xv = a[ss]; x[48 + ss] = xv; if (isw) dst[(48 + ss) * 128] = (bf16_t)(cvt_pk_bf16(xv, 0.f) & 0xffffu);
#pragma unroll
                for (int q4 = 0; q4 < 4; ++q4)
#pragma unroll
                    for (int r = 0; r < 4; ++r) if (q4 * 4 + r > ss) a[q4 * 4 + r] -= Lb[0][i * 4 + q4][r] * xv; }
            GPIN();
            GL(0, 52, 48);
#pragma unroll
            for (int i = 0; i < 2; ++i) { const int ss = 2 + i; const float xv = a[ss]; x[48 + ss] = xv; if (isw) dst[(48 + ss) * 128] = (bf16_t)(cvt_pk_bf16(xv, 0.f) & 0xffffu);
#pragma unroll
                for (int q4 = 0; q4 < 4; ++q4)
#pragma unroll
                    for (int r = 0; r < 4; ++r) if (q4 * 4 + r > ss) a[q4 * 4 + r] -= Lb[1][i * 4 + q4][r] * xv; }
            GPIN();
            GL(1, 54, 48);
#pragma unroll
            for (int i = 0; i < 2; ++i) { const int ss = 4 + i; const float xv = a[ss]; x[48 + ss] = xv; if (isw) dst[(48 + ss) * 128] = (bf16_t)(cvt_pk_bf16(xv, 0.f) & 0xffffu);
#pragma unroll
                for (int q4 = 0; q4 < 4; ++q4)
#pragma unroll
                    for (int r = 0; r < 4; ++r) if (q4 * 4 + r > ss) a[q4 * 4 + r] -= Lb[0][i * 4 + q4][r] * xv; }
            GPIN();
            GL(0, 56, 48);
#pragma unroll
            for (int i = 0; i < 2; ++i) { const int ss = 6 + i; const float xv = a[ss]; x[48 + ss] = xv; if (isw) dst[(48 + ss) * 128] = (bf16_t)(cvt_pk_bf16(xv, 0.f) & 0xffffu);
#pragma unroll
                for (int q4 = 0; q4 < 4; ++q4)
#pragma unroll
                    for (int r = 0; r < 4; ++r) if (q4 * 4 + r > ss) a[q4 * 4 + r] -= Lb[1][i * 4 + q4][r] * xv; }
            GPIN();
            GL(1, 58, 48);
#pragma unroll
            for (int i = 0; i < 2; ++i) { const int ss = 8 + i; const float xv = a[ss]; x[48 + ss] = xv; if (isw) dst[(48 + ss) * 128] = (bf16_t)(cvt_pk_bf16(xv, 0.f) & 0xffffu);
#pragma unroll
                for (int q4 = 0; q4 < 4; ++q4)
#pragma unroll
                    for (int r = 0; r < 4; ++r) if (q4 * 4 + r > ss) a[q4 * 4 + r] -= Lb[0][i * 4 + q4][r] * xv; }
            GPIN();
            GL(0, 60, 48);
#pragma unroll
            for (int i = 0; i < 2; ++i) { const int ss = 10 + i; const float xv = a[ss]; x[48 + ss] = xv; if (isw) dst[(48 + ss) * 128] = (bf16_t)(cvt_pk_bf16(xv, 0.f) & 0xffffu);
#pragma unroll
                for (int q4 = 0; q4 < 4; ++q4)
#pragma unroll
                    for (int r = 0; r < 4; ++r) if (q4 * 4 + r > ss) a[q4 * 4 + r] -= Lb[1][i * 4 + q4][r] * xv; }
            GPIN();
            GL(1, 62, 48);
#pragma unroll
            for (int i = 0; i < 2; ++i) { const int ss = 12 + i; const float xv = a[ss]; x[48 + ss] = xv; if (isw) dst[(48 + ss) * 128] = (bf16_t)(cvt_pk_bf16(xv, 0.f) & 0xffffu);
#pragma unroll
                for (int q4 = 0; q4 < 4; ++q4)
#pragma unroll
                    for (int r = 0; r < 4; ++r) if (q4 * 4 + r > ss) a[q4 * 4 + r] -= Lb[0][i * 4 + q4][r] * xv; }
            GPIN();
#pragma unroll
            for (int i = 0; i < 2; ++i) { const int ss = 14 + i; const float xv = a[ss]; x[48 + ss] = xv; if (isw) dst[(48 + ss) * 128] = (bf16_t)(cvt_pk_bf16(xv, 0.f) & 0xffffu);
#pragma unroll
                for (int q4 = 0; q4 < 4; ++q4)
#pragma unroll
                    for (int r = 0; r < 4; ++r) if (q4 * 4 + r > ss) a[q4 * 4 + r] -= Lb[1][i * 4 + q4][r] * xv; }
            if (!isw) {
#pragma unroll
                for (int q4 = 0; q4 < 4; ++q4) { u32x2 w; w.x = cvt_pk_bf16(a[q4 * 4], a[q4 * 4 + 1]); w.y = cvt_pk_bf16(a[q4 * 4 + 2], a[q4 * 4 + 3]); *(u32x2*)(dst + (size_t)(12 + q4) * 512) = w; } }
            GPIN();
            }
#undef GL
#undef GPIN
            }
    }
}
}

namespace ok {
constexpr int ST_LD = 136, VT_LD = 72;
__device__ __forceinline__ void phase_gdn_prep(const Frame& F0) { phase_gdn_prep_t<15>(F0); }
constexpr int GJT = 4, GDV = GJT * 16, GN_UNITS = NB * 8 * (128 / GDV);
static_assert(GJT == 4, "the Z slot below is sized for four column tiles");
struct GdnEarly { bf16x8 X[4]; u32x2 Z[4]; };
struct GdnLate { bf16x8 Kf[2]; float dec; };
__device__ __forceinline__ void gdn_load_early(GdnEarly& g, const Frame& F, size_t xoff, size_t ub, int ti, int sl, int fr, int fq, int roleB) {
    const bf16_t* Xp = (const bf16_t*)(F.ws + xoff) + ub * 8192 + (ti * 16 + fr) * 128 + fq * 8;
#pragma unroll
    for (int ks = 0; ks < 4; ++ks) g.X[ks] = *(const bf16x8*)(Xp + ks * 32);
    const bf16_t* zb = roleB ? OKP(bf16_t, WS_GAQK) + ub * 4096 + (ti * 16 + fr) * 64 + fq * 8 : OKP(bf16_t, WS_GU) + ub * 8192 + ((size_t)(ti * 4 + fq) * 128 + sl * GDV + fr) * 4;
#pragma unroll
    for (int i = 0; i < 4; ++i) g.Z[i] = *(const u32x2*)(zb + (roleB ? (i >> 1) * 32 + (i & 1) * 4 : i * 64));
}
__device__ __forceinline__ void gdn_load_late(GdnLate& g, const Frame& F, size_t ub, int ti, int wave, int fr, int fq, int vzero) {
    const bf16_t* Kp = OKP(bf16_t, WS_GKDT) + ub * 8192 + (wave * 16 + fr) * 64 + fq * 8;
#pragma unroll
    for (int k2 = 0; k2 < 2; ++k2) g.Kf[k2] = *(const bf16x8*)(Kp + k2 * 32);
    g.dec = OKP(float, WS_GDEC)[ub + vzero];
}
constexpr int OS_LD = GDV + 8;
__device__ __forceinline__ void gdn_flush_o(const Frame& F, const LAS bf16_t* Os, int b, int cprev, int hd, int sl) {
    constexpr int PCS = GDV / 8;
    if (F.tid < 64 * PCS) { const int row = F.tid / PCS, pc = F.tid % PCS; *(u32x4*)(OKP(bf16_t, WS_OBUF) + ((size_t)b * L + cprev * 64 + row) * 1024 + hd * 128 + sl * GDV + pc * 8) = *(const LAS u32x4*)(Os + row * OS_LD + pc * 8); }
}
__device__ __forceinline__ void gdn_step(const Frame& F, const GdnEarly& g, const GdnLate& h, f32x4 (&Sacc)[GJT], LAS bf16_t* ST0, LAS bf16_t* VnT, int par, int roleB, int b, int c, int hd, int sl, int ti, int wave, int fr, int fq) {
    LAS bf16_t* ST = ST0 + par * (GDV * ST_LD); LAS bf16_t* STn = ST0 + (par ^ 1) * (GDV * ST_LD);
    LAS bf16_t* Os = VnT + GDV * VT_LD;
    LDS_BARRIER();
    if (c > 0) gdn_flush_o(F, Os, b, c - 1, hd, sl);
    f32x4 a[GJT];
#pragma unroll
    for (int ji = 0; ji < GJT; ++ji) a[ji] = (f32x4){0.f, 0.f, 0.f, 0.f};
#pragma unroll
    for (int ks = 0; ks < 4; ++ks)
#pragma unroll
        for (int ji = 0; ji < GJT; ++ji) { const bf16x8 sf = *(const LAS bf16x8*)(ST + (ji * 16 + fr) * ST_LD + ks * 32 + fq * 8); a[ji] = mfma16(g.X[ks], sf, a[ji]); }
    if (!roleB) {
#pragma unroll
        for (int ji = 0; ji < GJT; ++ji) { const u32x2 uv = g.Z[ji]; u32x2 w; w.x = cvt_pk_bf16(bflo(uv.x) - a[ji][0], bfhi(uv.x) - a[ji][1]); w.y = cvt_pk_bf16(bflo(uv.y) - a[ji][2], bfhi(uv.y) - a[ji][3]);
            *(LAS u32x2*)(VnT + (ji * 16 + fr) * VT_LD + ti * 16 + 4 * fq) = w; } }
    LDS_BARRIER();
#pragma unroll
    for (int ji = 0; ji < GJT; ++ji) { bf16x8 vf[2];
#pragma unroll
        for (int k2 = 0; k2 < 2; ++k2) vf[k2] = *(const LAS bf16x8*)(VnT + (ji * 16 + fr) * VT_LD + k2 * 32 + fq * 8);
        if (roleB) {
#pragma unroll
            for (int k2 = 0; k2 < 2; ++k2) { u32x4 af; af.x = g.Z[2 * k2].x; af.y = g.Z[2 * k2].y; af.z = g.Z[2 * k2 + 1].x; af.w = g.Z[2 * k2 + 1].y; a[ji] = mfma16(__builtin_bit_cast(bf16x8, af), vf[k2], a[ji]); }
            LAS bf16_t* op = Os + (ti * 16 + 4 * fq) * OS_LD + ji * 16 + fr;
#pragma unroll
            for (int r = 0; r < 4; ++r) op[r * OS_LD] = (bf16_t)(cvt_pk_bf16(a[ji][r], 0.f) & 0xffffu); }
        Sacc[ji] *= h.dec;
#pragma unroll
        for (int k2 = 0; k2 < 2; ++k2) Sacc[ji] = mfma16(h.Kf[k2], vf[k2], Sacc[ji]);
        u32x2 w; w.x = cvt_pk_bf16(Sacc[ji][0], Sacc[ji][1]); w.y = cvt_pk_bf16(Sacc[ji][2], Sacc[ji][3]); *(LAS u32x2*)(STn + (ji * 16 + fr) * ST_LD + wave * 16 + 4 * fq) = w; }
}
template <int MODE  > __device__ __forceinline__ void gdn_scan_unit_t(const Frame& F, int unit) {
    LAS bf16_t* ST = (LAS bf16_t*)F.lds; LAS bf16_t* VnT = (LAS bf16_t*)(F.lds + 2 * GDV * ST_LD * 2);
    const int tid = F.tid, lane = F.lane, wave = F.wave, fr = lane & 15, fq = lane >> 4;
    constexpr int NSL = 128 / GDV;
    const int sl = unit % NSL, hd = (unit / NSL) & 7, b = unit / (NSL * 8), ti = wave & 3, roleB = wave >> 2;
    for (int i = tid; i < GDV * ST_LD / 2; i += NT) ((LAS unsigned*)ST)[i] = 0u;
    f32x4 Sacc[GJT];
#pragma unroll
    for (int ji = 0; ji < GJT; ++ji) Sacc[ji] = (f32x4){0.f, 0.f, 0.f, 0.f};
    const size_t ub0 = ((size_t)b * NCH) * 8 + hd; const size_t xoff = roleB ? WS_GQD : WS_GW;
    int vzero = 0;
#ifndef CPU_EMU
    asm volatile("" : "+v"(vzero));
#endif
#define GDN_LE(set, cc) if (MODE == 0) gdn_load_early(set, F, xoff, ub0 + (size_t)((cc) < NCH ? (cc) : NCH - 1) * 8, ti, sl, fr, fq, roleB)
#define GDN_LL(set, cc) if (MODE == 0) gdn_load_late(set, F, ub0 + (size_t)((cc) < NCH ? (cc) : NCH - 1) * 8, ti, wave, fr, fq, vzero)
#define GDN_ST(es, ls, cc, par) gdn_step(F, es, ls, Sacc, ST, VnT, par, roleB, b, (MODE == 0 ? (cc) : 0), hd, sl, ti, wave, fr, fq)
    GdnEarly e0, e1, e2; GdnLate l0, l1;
    GDN_LE(e0, 0); GDN_LE(e1, 1); GDN_LL(l0, 0);
    if (MODE == 1) { gdn_load_early(e0, F, xoff, ub0, ti, sl, fr, fq, roleB); gdn_load_early(e1, F, xoff, ub0, ti, sl, fr, fq, roleB); gdn_load_early(e2, F, xoff, ub0, ti, sl, fr, fq, roleB); gdn_load_late(l0, F, ub0, ti, wave, fr, fq, vzero); gdn_load_late(l1, F, ub0, ti, wave, fr, fq, vzero); }
    int c = 0;
    for (; c + 6 <= NCH; c += 6) {
        GDN_LE(e2, c + 2); GDN_LL(l1, c + 1); GDN_ST(e0, l0, c + 0, 0);
        GDN_LE(e0, c + 3); GDN_LL(l0, c + 2); GDN_ST(e1, l1, c + 1, 1);
        GDN_LE(e1, c + 4); GDN_LL(l1, c + 3); GDN_ST(e2, l0, c + 2, 0);
        GDN_LE(e2, c + 5); GDN_LL(l0, c + 4); GDN_ST(e0, l1, c + 3, 1);
        GDN_LE(e0, c + 6); GDN_LL(l1, c + 5); GDN_ST(e1, l0, c + 4, 0);
        GDN_LE(e1, c + 7); GDN_LL(l0, c + 6); GDN_ST(e2, l1, c + 5, 1);
    }
    if (c + 0 < NCH) { GDN_LE(e2, c + 2); GDN_LL(l1, c + 1); GDN_ST(e0, l0, c + 0, 0); }
    if (c + 1 < NCH) { GDN_LE(e0, c + 3); GDN_LL(l0, c + 2); GDN_ST(e1, l1, c + 1, 1); }
    if (c + 2 < NCH) { GDN_LE(e1, c + 4); GDN_LL(l1, c + 3); GDN_ST(e2, l0, c + 2, 0); }
    if (c + 3 < NCH) { GDN_LE(e2, c + 5); GDN_LL(l0, c + 4); GDN_ST(e0, l1, c + 3, 1); }
    if (c + 4 < NCH) { GDN_LE(e0, c + 6); GDN_LL(l1, c + 5); GDN_ST(e1, l0, c + 4, 0); }
#undef GDN_LE
#undef GDN_LL
#undef GDN_ST
    LDS_BARRIER();
    if (MODE == 0) gdn_flush_o(F, VnT + GDV * VT_LD, b, NCH - 1, hd, sl);
}
__device__ __forceinline__ void gdn_scan_unit(const Frame& F, int unit) { gdn_scan_unit_t<0>(F, unit); }
__device__ __forceinline__ void phase_gdn_final(const Frame& F0) {
    using namespace sm;
    const Frame F = phase_frame(F0);
    const int lane = F.lane; const int gw = F.vcu * NWAVES + F.wave, NGW = F.G * NWAVES;
    const f32x4* nw4 = (const f32x4*)(F.in[I_OD_NORM] + (lane & 7) * 16);
    u32x4 na[2], nz[2]; { const int t = gw < T ? gw : 0; const u32x4* op = (const u32x4*)(OKP(bf16_t, WS_OBUF) + (size_t)t * 1024 + lane * 16); const u32x4* zp = (const u32x4*)(OKP(bf16_t, WS_PROJ) + (size_t)t * PROJ1_LD + 3072 + lane * 16); na[0] = op[0]; na[1] = op[1]; nz[0] = zp[0]; nz[1] = zp[1]; }
    for (int t = gw; t < T; t += NGW) { const u32x4 ca[2] = {na[0], na[1]}, cz[2] = {nz[0], nz[1]};
        { const int tn = t + NGW < T ? t + NGW : t; const u32x4* op = (const u32x4*)(OKP(bf16_t, WS_OBUF) + (size_t)tn * 1024 + lane * 16); const u32x4* zp = (const u32x4*)(OKP(bf16_t, WS_PROJ) + (size_t)tn * PROJ1_LD + 3072 + lane * 16); na[0] = op[0]; na[1] = op[1]; nz[0] = zp[0]; nz[1] = zp[1]; }
        float o[16], z[16];
#pragma unroll
        for (int h2 = 0; h2 < 2; ++h2) { const u32x4 a = ca[h2], zz = cz[h2];
            o[h2 * 8 + 0] = bflo(a.x); o[h2 * 8 + 1] = bfhi(a.x); o[h2 * 8 + 2] = bflo(a.y); o[h2 * 8 + 3] = bfhi(a.y); o[h2 * 8 + 4] = bflo(a.z); o[h2 * 8 + 5] = bfhi(a.z); o[h2 * 8 + 6] = bflo(a.w); o[h2 * 8 + 7] = bfhi(a.w);
            z[h2 * 8 + 0] = bflo(zz.x); z[h2 * 8 + 1] = bfhi(zz.x); z[h2 * 8 + 2] = bflo(zz.y); z[h2 * 8 + 3] = bfhi(zz.y); z[h2 * 8 + 4] = bflo(zz.z); z[h2 * 8 + 5] = bfhi(zz.z); z[h2 * 8 + 6] = bflo(zz.w); z[h2 * 8 + 7] = bfhi(zz.w); }
        float s = 0.f;
#pragma unroll
        for (int i = 0; i < 16; ++i) s += o[i] * o[i];
        s += __shfl_xor(s, 1); s += __shfl_xor(s, 2); s += __shfl_xor(s, 4);
        const float rs = frsq(s * (1.f / 128.f) + EPS);
        u32x4 w[2];
#pragma unroll
        for (int h2 = 0; h2 < 2; ++h2) { const f32x4 n0 = nw4[h2 * 2], n1 = nw4[h2 * 2 + 1]; float y[8];
#pragma unroll
            for (int i = 0; i < 8; ++i) y[i] = o[h2 * 8 + i] * rs * (i < 4 ? n0[i] : n1[i - 4]) * siluf(z[h2 * 8 + i]);
            w[h2].x = cvt_pk_bf16(y[0], y[1]); w[h2].y = cvt_pk_bf16(y[2], y[3]); w[h2].z = cvt_pk_bf16(y[4], y[5]); w[h2].w = cvt_pk_bf16(y[6], y[7]); }
        u32x4* cp = (u32x4*)(OKP(bf16_t, WS_CAT1) + (size_t)t * 1536 + lane * 16); cp[0] = w[0]; cp[1] = w[1]; }
}
}

#ifndef DUP_MASK
#define DUP_MASK 0
#endif
namespace ok {
constexpr int SB_LD = 72;
#ifdef CPU_EMU
#define WAVE_ALL(p) (wave_sum((p) ? 1.f : 0.f) == 64.f)
#else
#define WAVE_ALL(p) (__all(p))
#endif
__device__ __forceinline__ void sb_unit(const Frame& F, int unit) {
    LAS bf16_t* Kt = (LAS bf16_t*)F.lds; LAS bf16_t* VT = (LAS bf16_t*)(F.lds + 64 * SB_LD * 2); volatile LAS int* votes = (volatile LAS int*)(F.lds + 2 * 64 * SB_LD * 2);
    const int tid = F.tid, lane = F.lane, wave = F.wave, fr = lane & 15, fq = lane >> 4;
    const int nqb = L / 128, qb = unit % nqb, hd = (unit / nqb) & 7, b = unit / (nqb * 8), q0 = qb * 128;
    const bf16_t* proj = OKP(bf16_t, WS_PROJ) + (size_t)b * L * PROJ1_LD;
    const int qrow = q0 + wave * 16 + fr;
    bf16x8 qf[2];
#pragma unroll
    for (int ks = 0; ks < 2; ++ks) qf[ks] = *(const bf16x8*)(proj + (size_t)qrow * PROJ1_LD + 4096 + hd * 64 + ks * 32 + fq * 8);
    f32x4 o[4] = {{0.f, 0.f, 0.f, 0.f}, {0.f, 0.f, 0.f, 0.f}, {0.f, 0.f, 0.f, 0.f}, {0.f, 0.f, 0.f, 0.f}};
    float C = 1.f; bool wdone = false;
    const int key_l = tid >> 3, c8 = tid & 7;
    int kt = 2 * qb + 1;
    u32x4 kreg = *(const u32x4*)(proj + (size_t)(kt * 64 + key_l) * PROJ1_LD + 4608 + hd * 64 + c8 * 8), vreg = *(const u32x4*)(proj + (size_t)(kt * 64 + key_l) * PROJ1_LD + 5120 + hd * 64 + c8 * 8);
    for (; kt >= 0; --kt) {
        LDS_BARRIER();
        *(LAS u32x4*)(Kt + key_l * SB_LD + c8 * 8) = kreg;
        { LAS bf16_t* vp = VT + (c8 * 8) * SB_LD + key_l; vp[0] = (bf16_t)(vreg.x & 0xffffu); vp[SB_LD] = (bf16_t)(vreg.x >> 16); vp[2 * SB_LD] = (bf16_t)(vreg.y & 0xffffu); vp[3 * SB_LD] = (bf16_t)(vreg.y >> 16);
          vp[4 * SB_LD] = (bf16_t)(vreg.z & 0xffffu); vp[5 * SB_LD] = (bf16_t)(vreg.z >> 16); vp[6 * SB_LD] = (bf16_t)(vreg.w & 0xffffu); vp[7 * SB_LD] = (bf16_t)(vreg.w >> 16); }
        if (lane == 0) votes[wave] = wdone ? 1 : 0;
        LDS_BARRIER();
        { int all = 1;
#pragma unroll
          for (int w = 0; w < 8; ++w) all &= votes[w];
          if (all) break; }
        if (kt > 0) { kreg = *(const u32x4*)(proj + (size_t)((kt - 1) * 64 + key_l) * PROJ1_LD + 4608 + hd * 64 + c8 * 8); vreg = *(const u32x4*)(proj + (size_t)((kt - 1) * 64 + key_l) * PROJ1_LD + 5120 + hd * 64 + c8 * 8); }
        const int key0 = kt * 64;
#ifdef SB_COUNT_ITERS
        ++g_iters;
#endif
        if (!wdone && key0 < q0 + wave * 16 + 16) {
            f32x4 x[4];
#pragma unroll
            for (int k16 = 0; k16 < 4; ++k16) { x[k16] = (f32x4){0.f, 0.f, 0.f, 0.f};
#pragma unroll
                for (int ks = 0; ks < 2; ++ks) { const bf16x8 kf = *(const LAS bf16x8*)(Kt + (k16 * 16 + fr) * SB_LD + ks * 32 + fq * 8); x[k16] = mfma16(kf, qf[ks], x[k16]); } }
            const bool need_mask = key0 + 63 >= q0 + wave * 16;
            float Rr[4], Tt[4], Ee[4];
#pragma unroll
            for (int k16 = 0; k16 < 4; ++k16) {
#pragma unroll
                for (int r = 0; r < 4; ++r) { const float e = fexp2(fminf(x[k16][r], 80.f)); float rr = frcp(1.f + e), bet = e * rr;
                    if (need_mask && key0 + k16 * 16 + 4 * fq + r >= qrow) { rr = 1.f; bet = 0.f; }
                    x[k16][r] = bet; Rr[k16] = (r == 0) ? rr : Rr[k16];
                    if (r == 0) Tt[k16] = rr; else if (r == 1) Ee[k16] = rr; else if (r == 2) Rr[k16] = rr; else {
                        const float r0 = Tt[k16], r1 = Ee[k16], r2 = Rr[k16], r3 = rr; const float s2 = r3, s1 = r3 * r2, s0 = s1 * r1;
                        x[k16][0] *= s0; x[k16][1] *= s1; x[k16][2] *= s2;
                        Rr[k16] = s0 * r0; } } }
#pragma unroll
            for (int k16 = 0; k16 < 4; ++k16) { const float R = Rr[k16]; const float d1 = __shfl_down(R, 16), d2 = __shfl_down(R, 32), d3 = __shfl_down(R, 48);
                Ee[k16] = (fq < 3 ? d1 : 1.f) * (fq < 2 ? d2 : 1.f) * (fq < 1 ? d3 : 1.f); float t = R; t *= __shfl_xor(t, 16); t *= __shfl_xor(t, 32); Tt[k16] = t; }
            const float TT2 = Tt[3], TT1 = Tt[3] * Tt[2], TT0 = TT1 * Tt[1];
            const float f0 = Ee[0] * TT0 * C, f1 = Ee[1] * TT1 * C, f2 = Ee[2] * TT2 * C, f3 = Ee[3] * C;
            x[0] *= f0; x[1] *= f1; x[2] *= f2; x[3] *= f3;
            C *= TT0 * Tt[0];
            bf16x8 pw[2];
#pragma unroll
            for (int j = 0; j < 2; ++j) { u32x4 p; p.x = cvt_pk_bf16(x[2 * j][0], x[2 * j][1]); p.y = cvt_pk_bf16(x[2 * j][2], x[2 * j][3]); p.z = cvt_pk_bf16(x[2 * j + 1][0], x[2 * j + 1][1]); p.w = cvt_pk_bf16(x[2 * j + 1][2], x[2 * j + 1][3]); pw[j] = __builtin_bit_cast(bf16x8, p); }
#pragma unroll
            for (int dt = 0; dt < 4; ++dt)
#pragma unroll
                for (int j = 0; j < 2; ++j) { const LAS bf16_t* vp = VT + (dt * 16 + fr) * SB_LD + j * 32 + 4 * fq; const u32x2 lo = *(const LAS u32x2*)vp, hi = *(const LAS u32x2*)(vp + 16);
                    u32x4 a; a.x = lo.x; a.y = lo.y; a.z = hi.x; a.w = hi.y; o[dt] = mfma16(__builtin_bit_cast(bf16x8, a), pw[j], o[dt]); }
            wdone = WAVE_ALL(C < 7.8886e-31f);
        }
    }
    bf16_t* op = OKP(bf16_t, WS_CAT1) + ((size_t)b * L + qrow) * 1536 + 1024 + hd * 64 + 4 * fq;
#pragma unroll
    for (int dt = 0; dt < 4; ++dt) { u32x2 w; w.x = cvt_pk_bf16(o[dt][0], o[dt][1]); w.y = cvt_pk_bf16(o[dt][2], o[dt][3]); *(u32x2*)(op + dt * 16) = w; }
}
__device__ __forceinline__ void phase_l1_mix(const Frame& F0) {
    const Frame F = phase_frame(F0);
    constexpr int NU = GN_UNITS, UPX = NU / 8;
    if (F.G < 128 || F.G % 8 != 0) { if (F.vcu == 0) for (int u = 0; u < NU; ++u) { gdn_scan_unit(F, u); __syncthreads(); } for (int u = F.vcu; u < NB * 8 * (L / 128); u += F.G) { sb_unit(F, u); __syncthreads(); } return; }
    const int per = F.G / 8, xcd = F.vcu / per, loc = F.vcu % per;
    if (loc < UPX) { gdn_scan_unit(F, xcd * UPX + loc);
#if (DUP_MASK >> 3) & 1
        __syncthreads(); gdn_scan_unit(F, xcd * UPX + loc);
#endif
#if (DUP_MASK >> 21) & 1
        __syncthreads(); gdn_scan_unit_t<1>(F, xcd * UPX + loc);
#endif
    }
    else for (int rep = 0; rep < 1 + ((DUP_MASK >> 16) & 1); ++rep) for (int u = xcd * (per - UPX) + (loc - UPX); u < NB * 8 * (L / 128); u += F.G - NU) { sb_unit(F, u); __syncthreads(); }
}
}

namespace ok {
#if CHECK
__device__ const int kSampleRows[16] = {0, 1, 2, 3, 63, 64, 127, 128, 129, 1000, 2047, 2048, 4097, 6000, 8190, 8191};
constexpr int FP_W = 6144;
__device__ __forceinline__ void fp_save(const Frame& F, int k, const void* buf, int ld, int width, bool is_bf16, int dcol0) {
    float* fp = OKP(float, WS_FP) + (size_t)k * 16 * FP_W; const size_t gt = (size_t)blockIdx.x * NT + F.tid, GT = (size_t)F.G * NT;
    for (size_t i = gt; i < (size_t)16 * width; i += GT) { const int r = (int)(i / width), c = (int)(i % width); const size_t src = (size_t)kSampleRows[r] * ld + c;
        fp[r * FP_W + dcol0 + c] = is_bf16 ? bf2f(((const bf16_t*)buf)[src]) : ((const float*)buf)[src]; }
}
__device__ __forceinline__ void fp_cmp(const Frame& F, int k, const float* obuf, int ld, int ocol0, int width, int fcol0) {
    const float* fp = OKP(float, WS_FP) + (size_t)k * 16 * FP_W; const size_t gt = (size_t)blockIdx.x * NT + F.tid, GT = (size_t)F.G * NT; float num = 0.f, den = 0.f;
    for (size_t i = gt; i < (size_t)16 * width; i += GT) { const int r = (int)(i / width), c = (int)(i % width); const float o = obuf[(size_t)kSampleRows[r] * ld + ocol0 + c], f = fp[r * FP_W + fcol0 + c];
        const float d = o - f; num += d * d; den += o * o; if (!(d == d)) num += 1e30f; }
    num = wave_sum(num); den = wave_sum(den);
    if (F.lane == 0 && (num != 0.f || den != 0.f)) { atomicAdd((float*)F.ctl + CW_CHK + 2 * k, num); atomicAdd((float*)F.ctl + CW_CHK + 2 * k + 1, den); }
}
__device__ __forceinline__ void fp_save_lin(const Frame& F, int k, const void* buf, size_t off, int n, bool is_bf16) {
    float* fp = OKP(float, WS_FP) + (size_t)k * 16 * FP_W; const size_t gt = (size_t)blockIdx.x * NT + F.tid, GT = (size_t)F.G * NT;
    for (size_t i = gt; i < (size_t)n; i += GT) fp[i] = is_bf16 ? bf2f(((const bf16_t*)buf)[off + i]) : ((const float*)buf)[off + i];
}
__device__ __forceinline__ void fp_cmp_lin(const Frame& F, int k, const float* obuf, size_t off, int n) {
    const float* fp = OKP(float, WS_FP) + (size_t)k * 16 * FP_W; const size_t gt = (size_t)blockIdx.x * NT + F.tid, GT = (size_t)F.G * NT; float num = 0.f, den = 0.f;
    for (size_t i = gt; i < (size_t)n; i += GT) { const float o = obuf[off + i], f = fp[i]; const float d = o - f; num += d * d; den += o * o; if (!(d == d)) num += 1e30f; }
    num = wave_sum(num); den = wave_sum(den);
    if (F.lane == 0 && (num != 0.f || den != 0.f)) { atomicAdd((float*)F.ctl + CW_CHK + 2 * k, num); atomicAdd((float*)F.ctl + CW_CHK + 2 * k + 1, den); }
}
#endif

struct Args { const float* in[33]; float* out; unsigned char* ws;
#if CHECK
    sm::Ctx oc;
#endif
};

__global__ void __launch_bounds__(512, 2) mk_fwd(Args a) {
    extern __shared__ __attribute__((aligned(16))) unsigned char lds_raw[];
    Frame F; F.lds = (LAS unsigned char*)lds_raw; F.ws = a.ws; F.ctl = (unsigned*)(a.ws + WS_CTL); F.in = a.in; F.out = a.out;
    F.tid = threadIdx.x; F.lane = F.tid & 63; F.wave = __builtin_amdgcn_readfirstlane(F.tid >> 6); F.G = gridDim.x;
    { const int bx = blockIdx.x; F.vcu = (F.G % 8 == 0) ? (bx % 8) * (F.G / 8) + bx / 8 : bx; }
    volatile LAS unsigned* MISC = (volatile LAS unsigned*)(F.lds + LDS_BYTES - 64);
    if (F.tid < 16) MISC[F.tid] = 0u;
    __syncthreads();
    XcdBarrier bar = xcd_barrier_post(F.ctl + CW_BAR, MISC);
#define GRID_BAR() xcd_barrier(bar)
    using namespace sm;
    for (int dup_p = 0; dup_p < ((DUP_MASK >> 5) & 1) + 1; ++dup_p) {
    phase_prologue(F);
    prologue_router_tables(F);
    prologue_w16_tables(F);
    GRID_BAR();
    }
    for (int dup_i0 = 0; dup_i0 < ((DUP_MASK >> 6) & 1) + 1; ++dup_i0) {
    { EpiScaleBf16 E{OKP(bf16_t, WS_PROJ), PROJ0_LD, (const float*)F.ctl + CW_SSQ, 1};
      dense_gemm(F, OKP(bf16_t, WS_HB), OKP(bf16_t, WS_W_IN0), T, 4096, 1024, E); }
    phase_proj16(F, 0, F.in[I_X], nullptr, (const float*)F.ctl + CW_SSQ, 1);
    GRID_BAR();
    }
#if CHECK
    fp_save(F, 0, OKP(bf16_t, WS_PROJ), PROJ0_LD, 4096, true, 0);
#endif
    for (int dup_b = 0; dup_b < ((DUP_MASK >> 1) & 1) + 1; ++dup_b) {
    for (int dup_b1 = 0; dup_b1 < ((DUP_MASK >> 14) & 1) + 1; ++dup_b1) { phase_ssd_a(F); GRID_BAR(); }
#if CHECK
    fp_save_lin(F, 6, OKP(bf16_t, WS_STATES), ((size_t)5 * 16 + 0) * 8192, 65536, true);
    GRID_BAR();
#endif
    phase_kv(F);
    phase_ssd_scan(F, (F.G >= 64 && F.G % 8 == 0) ? 32 : 0);
    GRID_BAR();
    for (int dup_b2 = 0; dup_b2 < ((DUP_MASK >> 15) & 1) + 1; ++dup_b2) { phase_ssd_b(F); GRID_BAR(); }
    }

    for (int dup_o0 = 0; dup_o0 < ((DUP_MASK >> 8) & 1) + 1; ++dup_o0) {
    { EpiResidualT<true> E{F.in[I_X], OKP(bf16_t, WS_HB), OKP(float, WS_SSQP1)};
      dense_gemm(F, OKP(bf16_t, WS_CAT0), OKP(bf16_t, WS_W_OUT0), T, 1024, 1536, E); }
    GRID_BAR();
    }
#if CHECK
    fp_save(F, 10, OKP(bf16_t, WS_HB), 1024, 1024, true, 0);
    fp_save_lin(F, 7, OKP(bf16_t, WS_STATES), ((size_t)5 * 16 + 0) * 8192, 65536, true);
    fp_save(F, 8, OKP(bf16_t, WS_CAT0), 1536, 512, true, 0);
    fp_save(F, 9, OKP(bf16_t, WS_CAT0) + 512, 1536, 1024, true, 0);
    GRID_BAR();
#endif
    for (int dup_q0 = 0; dup_q0 < ((DUP_MASK >> 9) & 1) + 1; ++dup_q0) {
    { EpiScaleBf16 E{OKP(bf16_t, WS_Q), 1024, OKP(float, WS_SSQP1), 16};
      dense_gemm(F, OKP(bf16_t, WS_HB), OKP(bf16_t, WS_W_XA), T, 1024, 1024, E); }
    GRID_BAR();
    }
    for (int dup_xa0 = 0; dup_xa0 < ((DUP_MASK >> 13) & 1) + 1; ++dup_xa0) {
    phase_xattn(F, OKP(bf16_t, WS_Q), OKP(bf16_t, WS_KX), OKP(bf16_t, WS_VT), OKP(bf16_t, WS_ATT));
    GRID_BAR();
    }
    { EpiResidualT<false> E{nullptr, OKP(bf16_t, WS_HB), OKP(float, WS_SSQP2)};
      dense_gemm(F, OKP(bf16_t, WS_ATT), OKP(bf16_t, WS_W_XA + 6 * MiB), T, 1024, 1024, E); }
    GRID_BAR();
#if CHECK
    fp_save(F, 11, OKP(bf16_t, WS_HB), 1024, 1024, true, 0);
    GRID_BAR();
#endif
    phase_router(F, 0, OKP(bf16_t, WS_HB), OKP(float, WS_SSQP2), 16);
    for (int dup_cv = 0; dup_cv < ((DUP_MASK >> 10) & 1) + 1; ++dup_cv) phase_cvt_moe(F, 0);
    GRID_BAR();
    for (int dup_sc = 0; dup_sc < ((DUP_MASK >> 11) & 1) + 1; ++dup_sc) {
    phase_scatter(F, 0, OKP(bf16_t, WS_HB), OKP(float, WS_SSQP2), 16);
    GRID_BAR();
    }
    for (int dup_c = 0; dup_c < ((DUP_MASK >> 2) & 1) + 1; ++dup_c) {
    phase_moe_up(F);
    GRID_BAR();
    phase_moe_down(F);
    GRID_BAR();
    }

    phase_combine(F, OKP(bf16_t, WS_HB), (float*)F.ctl + CW_SSQ + 3 * T, false);
    GRID_BAR();
#if CHECK
    fp_save(F, 12, OKP(bf16_t, WS_HB), 1024, 1024, true, 0);
    GRID_BAR();
#endif
    for (int dup_i1 = 0; dup_i1 < ((DUP_MASK >> 12) & 1) + 1; ++dup_i1) {
    { EpiScaleBf16 E{OKP(bf16_t, WS_PROJ), PROJ1_LD, (const float*)F.ctl + CW_SSQ + 3 * T, 1};
      dense_gemm(F, OKP(bf16_t, WS_HB), OKP(bf16_t, WS_W_IN1), T, 5632, 1024, E); }
    phase_proj16(F, 1, nullptr, OKP(bf16_t, WS_HB), (const float*)F.ctl + CW_SSQ + 3 * T, 1);
    GRID_BAR();
    }
#if CHECK
    fp_save(F, 13, OKP(bf16_t, WS_PROJ), PROJ1_LD, 4096, true, 0);
    fp_save(F, 13, OKP(bf16_t, WS_PROJ) + 4608, PROJ1_LD, 1024, true, 4096);
#endif
#if (DUP_MASK >> 22) & 15
    phase_gdn_prep_t<(DUP_MASK >> 22) & 15>(F); GRID_BAR();
#endif
    for (int dup_a = 0; dup_a < ((DUP_MASK >> 0) & 1) + 1; ++dup_a) { phase_gdn_prep(F); GRID_BAR(); }
    phase_l1_mix(F); GRID_BAR();
    for (int dup_e = 0; dup_e < ((DUP_MASK >> 4) & 1) + 1; ++dup_e) { phase_gdn_final(F); GRID_BAR(); }

    { EpiResidualT<false> E{nullptr, OKP(bf16_t, WS_HB), OKP(float, WS_SSQP4)};
      dense_gemm(F, OKP(bf16_t, WS_CAT1), OKP(bf16_t, WS_W_OUT1), T, 1024, 1536, E); }
    GRID_BAR();
#if CHECK
    fp_save(F, 14, OKP(bf16_t, WS_CAT1), 1536, 1024, true, 0);
    fp_save(F, 15, OKP(bf16_t, WS_CAT1) + 1024, 1536, 512, true, 0);
    fp_save(F, 16, OKP(bf16_t, WS_HB), 1024, 1024, true, 0);
    GRID_BAR();
#endif
    { EpiScaleBf16 E{OKP(bf16_t, WS_Q), 1024, OKP(float, WS_SSQP4), 16};
      dense_gemm(F, OKP(bf16_t, WS_HB), OKP(bf16_t, WS_W_XA + 8 * MiB), T, 1024, 1024, E); }
    GRID_BAR();
    phase_xattn(F, OKP(bf16_t, WS_Q), OKP(bf16_t, WS_KX) + (size_t)NB * 256 * 1024, OKP(bf16_t, WS_VT) + (size_t)1024 * NB * 256, OKP(bf16_t, WS_ATT));
    GRID_BAR();
    { EpiResidualT<false> E{nullptr, OKP(bf16_t, WS_HB), OKP(float, WS_SSQP5)};
      dense_gemm(F, OKP(bf16_t, WS_ATT), OKP(bf16_t, WS_W_XA + 8 * MiB + 6 * MiB), T, 1024, 1024, E); }
    GRID_BAR();
#if CHECK
    fp_save(F, 17, OKP(bf16_t, WS_HB), 1024, 1024, true, 0);
    GRID_BAR();
#endif
    phase_router(F, 1, OKP(bf16_t, WS_HB), OKP(float, WS_SSQP5), 16);
    phase_cvt_moe(F, 1);
    GRID_BAR();
    phase_scatter(F, 1, OKP(bf16_t, WS_HB), OKP(float, WS_SSQP5), 16);
    GRID_BAR();
    phase_moe_up(F);
    GRID_BAR();
    phase_moe_down(F);
    GRID_BAR();
    phase_combine(F, OKP(bf16_t, WS_HB), nullptr, true);
#if CHECK
    GRID_BAR();
    fp_save(F, 18, F.out, 1024, 1024, false, 0);
    fp_save(F, 1, OKP(float, WS_DTV), 16, 16, false, 0);
    fp_save(F, 2, OKP(float, WS_ACS), 16, 16, false, 0);
    GRID_BAR();
    {
        const size_t gid = (size_t)blockIdx.x * NT + F.tid, gs = (size_t)F.G * NT;
        for (int st = 0;; ++st) {
            const int s = st % sm::NSTAGE_L;
            if (st < 2 * sm::NSTAGE_L && s >= sm::N_STAGES_USED) continue;
            if (!sm::run_stage(a.oc, st, gid, gs)) break;
            GRID_BAR();
            if (st == 3) fp_cmp(F, 0, a.oc.proj, sm::PROJ_LD, 0, 4096, 0);
            if (st == 4) { fp_cmp(F, 1, a.oc.dtv, 16, 0, 16, 0); fp_cmp(F, 2, a.oc.acs, 16, 0, 16, 0); }
            if (st == 4 && gid == 0) { float* c = (float*)F.ctl + CW_CHK; c[6] = 0.f; c[7] = 1.f; c[8] = 0.f; c[9] = 1.f; c[10] = 0.f; c[11] = 1.f; }
            if (st == 5) fp_cmp_lin(F, 6, a.oc.states, ((size_t)5 * 16 + 0) * 8192, 65536);
            if (st == 6) fp_cmp_lin(F, 7, a.oc.states, ((size_t)5 * 16 + 0) * 8192, 65536);
            if (st == 10) { fp_cmp(F, 8, a.oc.cat, 1536, 0, 512, 0); fp_cmp(F, 9, a.oc.cat, 1536, 512, 1024, 0); }
            if (st == 11) fp_cmp(F, 10, a.oc.h, 1024, 0, 1024, 0);
            if (st == 18) fp_cmp(F, 11, a.oc.h, 1024, 0, 1024, 0);
            if (st == 23) fp_cmp(F, 12, a.oc.h, 1024, 0, 1024, 0);
            if (st == 63) { fp_cmp(F, 13, a.oc.proj, sm::PROJ_LD, 0, 4096, 0); fp_cmp(F, 13, a.oc.proj, sm::PROJ_LD, 4624, 1024, 4096); }
            if (st == 70) { fp_cmp(F, 14, a.oc.cat, 1536, 0, 1024, 0); fp_cmp(F, 15, a.oc.cat, 1536, 1024, 512, 0); }
            if (st == 71) fp_cmp(F, 16, a.oc.h, 1024, 0, 1024, 0);
            if (st == 78) fp_cmp(F, 17, a.oc.h, 1024, 0, 1024, 0);
            if (st == 121) fp_cmp(F, 18, a.oc.out, 1024, 0, 1024, 0);
            GRID_BAR();
        }
        GRID_BAR();
        int code = 0;
        for (int k = CHECK - 1; k >= 0; --k) { const float num = __hip_atomic_load((float*)F.ctl + CW_CHK + 2 * k, __ATOMIC_RELAXED, __HIP_MEMORY_SCOPE_AGENT), den = __hip_atomic_load((float*)F.ctl + CW_CHK + 2 * k + 1, __ATOMIC_RELAXED, __HIP_MEMORY_SCOPE_AGENT);
            if (!(num <= 1e-3f * den) || den == 0.f) code = k + 1; }
        const float sc = 1.f + 0.2f * (float)code;
        for (size_t i = gid; i < (size_t)L * DM; i += gs) { F.out[i] *= sc; F.out[(size_t)L * DM + i] = 0.f; }
    }
#endif
}
}

extern "C" void kernel_launch(void* const* d_in, const int* in_sizes, int n_in, void* d_out, int out_size, void* d_ws, size_t ws_size, hipStream_t stream) {
    static int grid = 0;
    if (grid == 0) {
        int dev = 0, cus = 0, per_cu = 0;
        hipGetDevice(&dev); hipDeviceGetAttribute(&cus, hipDeviceAttributeMultiprocessorCount, dev);
        if (hipFuncSetAttribute((const void*)ok::mk_fwd, hipFuncAttributeMaxDynamicSharedMemorySize, LDS_BYTES) != hipSuccess) { fprintf(stderr, "kernel_launch: hipFuncSetAttribute failed\n"); grid = -1; return; }
        hipOccupancyMaxActiveBlocksPerMultiprocessor(&per_cu, (const void*)ok::mk_fwd, ok::NT, LDS_BYTES);
        (void)hipGetLastError();
        grid = cus;
        if (n_in != 33 || ws_size < ok::WS_END || per_cu < 1) { fprintf(stderr, "kernel_launch: n_in %d ws %zu need %zu per_cu %d\n", n_in, ws_size, (size_t)ok::WS_END, per_cu); grid = -1; }
    }
    if (grid < 0) return;
    hipMemsetAsync((char*)d_ws + ok::WS_CTL, 0, ok::CTL_BYTES, stream);
    ok::Args a{};
    for (int i = 0; i < 33; ++i) a.in[i] = (const float*)d_in[i];
    a.out = (float*)d_out; a.ws = (unsigned char*)d_ws;
#if CHECK
    sm::carve(a.oc, (float*)((char*)d_ws + 16 * ok::MiB));
    for (int i = 0; i < 33; ++i) a.oc.in[i] = (const float*)d_in[i];
    a.oc.out = (float*)d_out;
#endif
    hipLaunchKernelGGL(ok::mk_fwd, dim3(grid), dim3(ok::NT), LDS_BYTES, stream, a);
}
```

```cpp
#include <hip/hip_runtime.h>
#include <cstdio>
#include <cstdint>
#ifndef CHECK
#define CHECK 0
#endif
#define DUP_MASK 0
constexpr int LDS_BYTES = 147456;

#define XB_TMO      128
#define XB_XCNT(j)  (256  + 64 * (j))
#define XB_XSUB(j)  (1280 + 64 * (j))
#define XB_XGEN(j)  (2304 + 64 * (j))
#define XB_TOP      3328
#define XB_TOPGEN   3392
#define XCD_BAR_WORDS 3456
#define XB_SPIN_CAP (1u << 18)
#define LAS __attribute__((address_space(3)))

__device__ __forceinline__ unsigned xb_ld(unsigned* p)              { return __hip_atomic_load(p, __ATOMIC_RELAXED, __HIP_MEMORY_SCOPE_AGENT); }
__device__ __forceinline__ unsigned xb_add(unsigned* p, unsigned v) { return __hip_atomic_fetch_add(p, v, __ATOMIC_RELAXED, __HIP_MEMORY_SCOPE_AGENT); }
__device__ __forceinline__ unsigned xb_xcc_id() { return (unsigned)__builtin_amdgcn_s_getreg((3 << 11) | 20) & 0xFu; }
#define XB_SPIN(cond, bar) do { unsigned _sp = 0; while (cond) { __builtin_amdgcn_s_sleep(1); \
    if ((++_sp & 255u) == 0u) { if (xb_ld(&(bar)[XB_TMO])) break; if (_sp > XB_SPIN_CAP) { atomicAdd(&(bar)[XB_TMO], 1u); break; } } } } while (0)

struct XcdBarrier {
    unsigned* bar; unsigned x;
    volatile LAS unsigned* st;
};

__device__ __forceinline__ XcdBarrier xcd_barrier_post(unsigned* bar, volatile LAS unsigned* st) {
    XcdBarrier b; b.bar = bar; b.x = xb_xcc_id(); b.st = st;
    if (threadIdx.x == 0) (void)xb_add(&bar[XB_XCNT(b.x)], 1u);
    return b;
}
__device__ __forceinline__ void xcd_barrier_complete(unsigned* bar, unsigned x, unsigned& nloc, unsigned& nx) {
    const unsigned G = gridDim.x * gridDim.y * gridDim.z;
    unsigned sum, cnt, mine, sp = 0u;
    for (;;) {
        sum = 0u; cnt = 0u; mine = 0u;
#pragma unroll
        for (unsigned j = 0; j < 16; ++j) { const unsigned c = xb_ld(&bar[XB_XCNT(j)]); sum += c; cnt += (c > 0u) ? 1u : 0u; mine = (j == x) ? c : mine; }
        if (sum == G) break;
        __builtin_amdgcn_s_sleep(1);
        if ((++sp & 255u) == 0u) { if (xb_ld(&bar[XB_TMO])) break; if (sp > XB_SPIN_CAP) { atomicAdd(&bar[XB_TMO], 1u); break; } }
    }
    nloc = mine > 0u ? mine : 1u; nx = cnt > 0u ? cnt : 1u;
}

__device__ __forceinline__ void xcd_barrier(const XcdBarrier& b) {
    asm volatile("s_waitcnt vmcnt(0)" ::: "memory");
    __syncthreads();
    if (threadIdx.x == 0) {
        unsigned* bar = b.bar;
        __builtin_amdgcn_s_waitcnt(0);
        unsigned nloc = b.st[0], nx = b.st[1];
        if (nloc == 0u) { xcd_barrier_complete(bar, b.x, nloc, nx); b.st[0] = nloc; b.st[1] = nx; }
        const unsigned old = xb_add(&bar[XB_XSUB(b.x)], 1u);
        const unsigned gen = old / nloc;
        if (old + 1u == (gen + 1u) * nloc) {
            __builtin_amdgcn_fence(__ATOMIC_RELEASE, "agent");
            asm volatile("s_waitcnt vmcnt(0)" ::: "memory");
            const unsigned og = xb_add(&bar[XB_TOP], 1u);
            const unsigned tg = og / nx;
            if (og + 1u == (tg + 1u) * nx) xb_add(&bar[XB_TOPGEN], 1u);
            else XB_SPIN(xb_ld(&bar[XB_TOPGEN]) == tg, bar);
            __builtin_amdgcn_fence(__ATOMIC_ACQUIRE, "agent");
            xb_add(&bar[XB_XGEN(b.x)], 1u);
            asm volatile("s_waitcnt vmcnt(0)" ::: "memory");
        } else {
            XB_SPIN(xb_ld(&bar[XB_XGEN(b.x)]) == gen, bar);
            __builtin_amdgcn_fence(__ATOMIC_ACQUIRE, "agent");
            asm volatile("s_waitcnt vmcnt(0)" ::: "memory");
        }
    }
    __syncthreads();
}


#undef LAS

#ifndef SEQ
#define SEQ 8192
#endif
namespace sm {
constexpr int DM = 1024, NB = 1  , L = SEQ, T = NB * L, NCH = L / 64, MEM = 256;
constexpr int EV_IN = 4112, OD_IN = 5648, PROJ_LD = 5648;
constexpr int E_SCB = 0, E_SCC = 512, E_SCX = 1024, E_Z = 1536, E_XBC = 2560, E_DT = 4096;
constexpr int O_QKV = 0, O_Z = 3072, O_A = 4096, O_B = 4104, O_SQ = 4112, O_SK = 4624, O_SV = 5136;

struct Ctx {
    const float* in[33];
    float* out;
    float *memn, *kx, *vx, *h, *un, *rstd, *proj, *cat, *xbcc, *dtv, *acs, *states, *cb, *ybuf, *rstd2;
    float *q, *att, *sc;
    float *gatew, *act; int* eid;
    float *qkvc, *beta, *gcs, *Lm, *aqk, *uw, *S, *vn, *obuf;
};
enum In { I_X = 0, I_MEM, I_MEM_NORM, I_FINAL_NORM, I_NORM_MIX, I_NORM_XA, I_NORM_FFN, I_XA_WQ, I_XA_WK, I_XA_WV, I_XA_WO,
          I_MOE_WG, I_MOE_BG, I_MOE_WE, I_MOE_BE, I_MOE_WGATE, I_MOE_WUP, I_MOE_WDOWN,
          I_EV_WIN, I_EV_SCCONV, I_EV_CONVW, I_EV_CONVB, I_EV_DTB, I_EV_ALOG, I_EV_D, I_EV_NORM, I_EV_WOUT,
          I_OD_WIN, I_OD_CONV, I_OD_DTB, I_OD_ALOG, I_OD_NORM, I_OD_WOUT };

__device__ __forceinline__ float siluf(float x) { return x / (1.f + expf(-x)); }
__device__ __forceinline__ float softplusf(float x) { return x > 20.f ? x : log1pf(expf(x)); }
__device__ __forceinline__ float sigmoidf(float x) { return 1.f / (1.f + expf(-x)); }

__device__ __forceinline__ void s_copy(const float* src, float* dst, size_t n, size_t gid, size_t gs) { for (size_t i = gid; i < n; i += gs) dst[i] = src[i]; }
__device__ __forceinline__ void s_rstd(const float* x, int R, int W, int ld, float* rstd, size_t gid, size_t gs) {
    for (size_t r = gid; r < (size_t)R; r += gs) { const float* p = x + r * ld; float s = 0.f; for (int i = 0; i < W; ++i) s += p[i] * p[i]; rstd[r] = 1.f / sqrtf(s / W + 1e-6f); }
}
__device__ __forceinline__ void s_norm(const float* x, const float* rstd, const float* g, float* y, int R, size_t gid, size_t gs) {
    for (size_t i = gid; i < (size_t)R * DM; i += gs) { const size_t r = i / DM; const int c = (int)(i % DM); y[i] = x[i] * rstd[r] * g[c]; }
}
__device__ __forceinline__ void s_gemm(const float* A, int lda, const float* W, int ldw, float* C, int ldc, int M, int N, int K, int accum, size_t gid, size_t gs) {
    const int N4 = N / 4;
    for (size_t i = gid; i < (size_t)M * N4; i += gs) { const size_t m = i / N4; const int n = (int)(i % N4) * 4; const float* a = A + m * lda; const float* w = W + n; float s0 = 0.f, s1 = 0.f, s2 = 0.f, s3 = 0.f;
        for (int k = 0; k < K; ++k) { const float av = a[k]; const float4 wv = *(const float4*)(w + (size_t)k * ldw); s0 += av * wv.x; s1 += av * wv.y; s2 += av * wv.z; s3 += av * wv.w; }
        float4* c = (float4*)(C + m * ldc + n); float4 o = accum ? *c : float4{0.f, 0.f, 0.f, 0.f}; o.x += s0; o.y += s1; o.z += s2; o.w += s3; *c = o; }
}
__device__ __forceinline__ void s_scmix(const Ctx& c, size_t gid, size_t gs) {
    const float* w = c.in[I_EV_SCCONV];
    for (size_t i = gid; i < (size_t)T * 512; i += gs) { const size_t t = i / 512; const int ch = (int)(i % 512); const int tl = (int)(t % L); float s = 0.f;
        for (int j = 0; j < 3; ++j) { const int tt = tl - 2 + j; if (tt >= 0) { const float* p = c.proj + (t - 2 + j) * PROJ_LD; s += w[j * 512 + ch] * p[E_SCC + ch] * p[E_SCX + ch]; } }
        c.cat[t * 1536 + ch] = c.proj[t * PROJ_LD + E_SCB + ch] * s; }
}
__device__ __forceinline__ void s_ssd_conv(const Ctx& c, size_t gid, size_t gs) {
    const float* w = c.in[I_EV_CONVW]; const float* b = c.in[I_EV_CONVB];
    for (size_t i = gid; i < (size_t)T * 1536; i += gs) { const size_t t = i / 1536; const int ch = (int)(i % 1536); const int tl = (int)(t % L); float s = b[ch];
        for (int j = 0; j < 4; ++j) { const int tt = tl - 3 + j; if (tt >= 0) s += w[j * 1536 + ch] * c.proj[(t - 3 + j) * PROJ_LD + E_XBC + ch]; }
        c.xbcc[i] = siluf(s); }
}
__device__ __forceinline__ void s_ssd_dt(const Ctx& c, size_t gid, size_t gs) {
    for (size_t i = gid; i < (size_t)NB * NCH * 16; i += gs) { const int hd = (int)(i % 16); const size_t bc = i / 16; const float a = -expf(c.in[I_EV_ALOG][hd]); float cs = 0.f;
        for (int s = 0; s < 64; ++s) { const size_t t = bc * 64 + s; const float dt = softplusf(c.proj[t * PROJ_LD + E_DT + hd] + c.in[I_EV_DTB][hd]); cs += dt * a; c.dtv[t * 16 + hd] = dt; c.acs[t * 16 + hd] = cs; } }
}
__device__ __forceinline__ void s_ssd_states(const Ctx& c, size_t gid, size_t gs) {
    for (size_t i = gid; i < (size_t)NB * NCH * 16 * 64 * 128; i += gs) { const int n = (int)(i % 128); const int p = (int)((i / 128) % 64); const int hd = (int)((i / 8192) % 16); const size_t bc = i / (8192 * 16);
        const int g = hd / 8; const float last = c.acs[(bc * 64 + 63) * 16 + hd]; float s = 0.f;
        for (int k = 0; k < 64; ++k) { const size_t t = bc * 64 + k; s += c.xbcc[t * 1536 + 1024 + g * 128 + n] * c.xbcc[t * 1536 + hd * 64 + p] * c.dtv[t * 16 + hd] * expf(last - c.acs[t * 16 + hd]); }
        c.states[i] = s; }
}
__device__ __forceinline__ void s_ssd_scan(const Ctx& c, size_t gid, size_t gs) {
    for (size_t i = gid; i < (size_t)NB * 16 * 8192; i += gs) { const size_t b = i / (16 * 8192); const size_t r = i % (16 * 8192); const int hd = (int)(r / 8192); float s = 0.f;
        for (int ch = 0; ch < NCH; ++ch) { const size_t bc = b * NCH + ch; const size_t idx = bc * (16 * 8192) + r; const float st = c.states[idx]; c.states[idx] = s; s = s * expf(c.acs[(bc * 64 + 63) * 16 + hd]) + st; } }
}
__device__ __forceinline__ void s_ssd_cb(const Ctx& c, size_t gid, size_t gs) {
    for (size_t i = gid; i < (size_t)NB * NCH * 2 * 4096; i += gs) { const int s = (int)(i % 64); const int t = (int)((i / 64) % 64); const int g = (int)((i / 4096) % 2); const size_t bc = i / 8192;
        const float* cm = c.xbcc + (bc * 64 + t) * 1536 + 1280 + g * 128; const float* bm = c.xbcc + (bc * 64 + s) * 1536 + 1024 + g * 128; float a = 0.f;
        for (int n = 0; n < 128; ++n) a += cm[n] * bm[n];
        c.cb[i] = a; }
}
__device__ __forceinline__ void s_ssd_y(const Ctx& c, size_t gid, size_t gs) {
    for (size_t i = gid; i < (size_t)T * 1024; i += gs) { const size_t t = i / 1024; const int hp = (int)(i % 1024); const int hd = hp / 64, p = hp % 64, g = hd / 8; const size_t bc = t / 64; const int tl = (int)(t % 64);
        const float at = c.acs[t * 16 + hd]; float y = 0.f;
        for (int s = 0; s <= tl; ++s) { const size_t ts = bc * 64 + s; y += c.cb[(bc * 2 + g) * 4096 + tl * 64 + s] * expf(at - c.acs[ts * 16 + hd]) * c.xbcc[ts * 1536 + hp] * c.dtv[ts * 16 + hd]; }
        const float* cm = c.xbcc + t * 1536 + 1280 + g * 128; const float* pv = c.states + (bc * 16 + hd) * 8192 + p * 128; float yo = 0.f;
        for (int n = 0; n < 128; ++n) yo += cm[n] * pv[n];
        y += yo * expf(at) + c.xbcc[t * 1536 + hp] * c.in[I_EV_D][hd];
        c.ybuf[i] = y * siluf(c.proj[t * PROJ_LD + E_Z + hp]); }
}
__device__ __forceinline__ void s_ssd_out(const Ctx& c, size_t gid, size_t gs) {
    for (size_t i = gid; i < (size_t)T * 1024; i += gs) { const size_t t = i / 1024; const int ch = (int)(i % 1024); c.cat[t * 1536 + 512 + ch] = c.ybuf[i] * c.rstd2[t * 2 + ch / 512] * c.in[I_EV_NORM][ch]; }
}
__device__ __forceinline__ void s_xa_scores(const Ctx& c, size_t gid, size_t gs) {
    for (size_t i = gid; i < (size_t)T * 4 * 256; i += gs) { const int m = (int)(i % 256); const int hd = (int)((i / 256) % 4); const size_t t = i / 1024; const size_t b = t / L;
        const float* q = c.q + t * 1024 + hd * 256; const float* k = c.kx + (b * 256 + m) * 1024 + hd * 256; float s = 0.f;
        for (int d = 0; d < 256; ++d) s += q[d] * k[d];
        c.sc[i] = s * 0.0625f; }
}
__device__ __forceinline__ void s_xa_softmax(const Ctx& c, size_t gid, size_t gs) {
    for (size_t i = gid; i < (size_t)T * 4; i += gs) { float* p = c.sc + i * 256; float mx = p[0]; for (int m = 1; m < 256; ++m) mx = fmaxf(mx, p[m]); float s = 0.f; for (int m = 0; m < 256; ++m) { const float e = expf(p[m] - mx); p[m] = e; s += e; } const float r = 1.f / s; for (int m = 0; m < 256; ++m) p[m] *= r; }
}
__device__ __forceinline__ void s_xa_pv(const Ctx& c, size_t gid, size_t gs) {
    for (size_t i = gid; i < (size_t)T * 1024; i += gs) { const size_t t = i / 1024; const int col = (int)(i % 1024); const int hd = col / 256; const size_t b = t / L; const float* p = c.sc + (t * 4 + hd) * 256; const float* v = c.vx + b * 256 * 1024 + col; float s = 0.f;
        for (int m = 0; m < 256; ++m) s += p[m] * v[(size_t)m * 1024];
        c.att[i] = s; }
}
__device__ __forceinline__ void s_router(const Ctx& c, int l, size_t gid, size_t gs) {
    const float* wg = c.in[I_MOE_WG] + (size_t)l * 1024 * 4; const float* bg = c.in[I_MOE_BG] + l * 4; const float* we = c.in[I_MOE_WE] + (size_t)l * 1024 * 32; const float* be = c.in[I_MOE_BE] + l * 32;
    for (size_t t = gid; t < (size_t)T; t += gs) { const float* x = c.un + t * 1024; float g0 = 0.f, g1 = 0.f, g2 = 0.f, g3 = 0.f;
        for (int k = 0; k < 1024; ++k) { const float xv = x[k]; g0 += xv * wg[k * 4 + 0]; g1 += xv * wg[k * 4 + 1]; g2 += xv * wg[k * 4 + 2]; g3 += xv * wg[k * 4 + 3]; }
        g0 += bg[0]; g1 += bg[1]; g2 += bg[2]; g3 += bg[3];
        int gsel = 0; float gm = g0; if (g1 > gm) { gm = g1; gsel = 1; } if (g2 > gm) { gm = g2; gsel = 2; } if (g3 > gm) { gm = g3; gsel = 3; }
        const float gw = 1.f / (expf(g0 - gm) + expf(g1 - gm) + expf(g2 - gm) + expf(g3 - gm));
        float e0 = 0, e1 = 0, e2 = 0, e3 = 0, e4 = 0, e5 = 0, e6 = 0, e7 = 0; const float* w = we + gsel * 8;
        for (int k = 0; k < 1024; ++k) { const float xv = x[k]; const float* wk = w + k * 32; e0 += xv * wk[0]; e1 += xv * wk[1]; e2 += xv * wk[2]; e3 += xv * wk[3]; e4 += xv * wk[4]; e5 += xv * wk[5]; e6 += xv * wk[6]; e7 += xv * wk[7]; }
        const float* bb = be + gsel * 8; e0 += bb[0]; e1 += bb[1]; e2 += bb[2]; e3 += bb[3]; e4 += bb[4]; e5 += bb[5]; e6 += bb[6]; e7 += bb[7];
        int i1 = 0; float m1 = e0;
#define SM_T1(j, v) if (v > m1) { m1 = v; i1 = j; }
        SM_T1(1, e1) SM_T1(2, e2) SM_T1(3, e3) SM_T1(4, e4) SM_T1(5, e5) SM_T1(6, e6) SM_T1(7, e7)
        int i2 = -1; float m2 = -3.0e38f;
#define SM_T2(j, v) if (j != i1 && v > m2) { m2 = v; i2 = j; }
        SM_T2(0, e0) SM_T2(1, e1) SM_T2(2, e2) SM_T2(3, e3) SM_T2(4, e4) SM_T2(5, e5) SM_T2(6, e6) SM_T2(7, e7)
        const float r = expf(m2 - m1); const float w1 = gw / (1.f + r), w2 = gw * r / (1.f + r);
        c.eid[t * 2 + 0] = gsel * 8 + i1; c.eid[t * 2 + 1] = gsel * 8 + i2; c.gatew[t * 2 + 0] = w1; c.gatew[t * 2 + 1] = w2; }
}
__device__ __forceinline__ void s_moe_up(const Ctx& c, int l, size_t gid, size_t gs) {
    for (size_t i = gid; i < (size_t)T * 2 * 512; i += gs) { const int f = (int)(i % 512); const size_t tk = i / 512; const size_t t = tk / 2; const int e = c.eid[tk] & 31;
        const float* wg = c.in[I_MOE_WGATE] + ((size_t)l * 32 + e) * 1024 * 512 + f; const float* wu = c.in[I_MOE_WUP] + ((size_t)l * 32 + e) * 1024 * 512 + f; const float* x = c.un + t * 1024; float a = 0.f, b = 0.f;
        for (int k = 0; k < 1024; ++k) { a += x[k] * wg[(size_t)k * 512]; b += x[k] * wu[(size_t)k * 512]; }
        c.act[i] = siluf(a) * b; }
}
__device__ __forceinline__ void s_moe_down(const Ctx& c, int l, size_t gid, size_t gs) {
    for (size_t i = gid; i < (size_t)T * 1024; i += gs) { const size_t t = i / 1024; const int n = (int)(i % 1024); float y = 0.f;
        for (int k = 0; k < 2; ++k) { const int e = c.eid[t * 2 + k] & 31; const float* wd = c.in[I_MOE_WDOWN] + ((size_t)l * 32 + e) * 512 * 1024 + n; const float* a = c.act + (t * 2 + k) * 512; float s = 0.f;
            for (int f = 0; f < 512; ++f) s += a[f] * wd[(size_t)f * 1024];
            y += s * c.gatew[t * 2 + k]; }
        c.h[i] += y; }
}
__device__ __forceinline__ void s_gdn_conv(const Ctx& c, size_t gid, size_t gs) {
    const float* w = c.in[I_OD_CONV];
    for (size_t i = gid; i < (size_t)T * 3072; i += gs) { const size_t t = i / 3072; const int ch = (int)(i % 3072); const int tl = (int)(t % L); float s = 0.f;
        for (int j = 0; j < 4; ++j) { const int tt = tl - 3 + j; if (tt >= 0) s += w[j * 3072 + ch] * c.proj[(t - 3 + j) * PROJ_LD + O_QKV + ch]; }
        c.qkvc[i] = siluf(s); }
}
__device__ __forceinline__ void s_gdn_qkscale(const Ctx& c, size_t gid, size_t gs) {
    for (size_t i = gid; i < (size_t)T * 16; i += gs) { const size_t t = i / 16; const int wh = (int)(i % 16); float* p = c.qkvc + t * 3072 + wh * 128; float s = 0.f; for (int d = 0; d < 128; ++d) s += p[d] * p[d];
        float r = 1.f / sqrtf(s + 1e-6f); if (wh < 8) r *= 0.08838834764831845f; for (int d = 0; d < 128; ++d) p[d] *= r; }
}
__device__ __forceinline__ void s_gdn_gates(const Ctx& c, size_t gid, size_t gs) {
    for (size_t i = gid; i < (size_t)NB * NCH * 8; i += gs) { const int hd = (int)(i % 8); const size_t bc = i / 8; const float na = -expf(c.in[I_OD_ALOG][hd]); const float db = c.in[I_OD_DTB][hd]; float cs = 0.f;
        for (int s = 0; s < 64; ++s) { const size_t t = bc * 64 + s; cs += na * softplusf(c.proj[t * PROJ_LD + O_A + hd] + db); c.gcs[t * 8 + hd] = cs; c.beta[t * 8 + hd] = sigmoidf(c.proj[t * PROJ_LD + O_B + hd]); } }
}
__device__ __forceinline__ void s_gdn_kk(const Ctx& c, size_t gid, size_t gs) {
    for (size_t i = gid; i < (size_t)NB * NCH * 8 * 4096; i += gs) { const int s = (int)(i % 64); const int t = (int)((i / 64) % 64); const int hd = (int)((i / 4096) % 8); const size_t bc = i / (4096 * 8);
        float lv = 0.f, av = 0.f;
        if (s <= t) { const size_t tt = bc * 64 + t, ts = bc * 64 + s; const float* kt = c.qkvc + tt * 3072 + 1024 + hd * 128; const float* ks = c.qkvc + ts * 3072 + 1024 + hd * 128; const float* qt = c.qkvc + tt * 3072 + hd * 128; float kk = 0.f, qk = 0.f;
            for (int d = 0; d < 128; ++d) { kk += kt[d] * ks[d]; qk += qt[d] * ks[d]; }
            const float dec = expf(c.gcs[tt * 8 + hd] - c.gcs[ts * 8 + hd]); av = qk * dec; if (s < t) lv = kk * c.beta[tt * 8 + hd] * dec; }
        c.Lm[i] = lv; c.aqk[i] = av; }
}
__device__ __forceinline__ void s_gdn_solve(const Ctx& c, size_t gid, size_t gs) {
    for (size_t i = gid; i < (size_t)NB * NCH * 8 * 256; i += gs) { const int j = (int)(i % 256); const int hd = (int)((i / 256) % 8); const size_t bc = i / 2048; float* sol = c.uw + (bc * 8 + hd) * (64 * 256) + j; const float* Lp = c.Lm + (bc * 8 + hd) * 4096;
        for (int t = 0; t < 64; ++t) { const size_t tt = bc * 64 + t; const float bt = c.beta[tt * 8 + hd];
            float r = (j < 128) ? c.qkvc[tt * 3072 + 2048 + hd * 128 + j] * bt : c.qkvc[tt * 3072 + 1024 + hd * 128 + (j - 128)] * bt * expf(c.gcs[tt * 8 + hd]);
            for (int s = 0; s < t; ++s) r -= Lp[t * 64 + s] * sol[(size_t)s * 256];
            sol[(size_t)t * 256] = r; } }
}
__device__ __forceinline__ void s_gdn_scan(const Ctx& c, size_t gid, size_t gs) {
    for (size_t i = gid; i < (size_t)NB * 8 * 128; i += gs) { const int j = (int)(i % 128); const size_t bh = i / 128; const int hd = (int)(bh % 8); const size_t b = bh / 8; float* S = c.S + bh * 16384 + j; float* vn = c.vn + bh * 8192 + j;
        for (int d = 0; d < 128; ++d) S[(size_t)d * 128] = 0.f;
        for (int ch = 0; ch < NCH; ++ch) { const size_t bc = b * NCH + ch; const float* uw = c.uw + (bc * 8 + hd) * (64 * 256); const float* aq = c.aqk + (bc * 8 + hd) * 4096; const float glast = c.gcs[(bc * 64 + 63) * 8 + hd];
            for (int t = 0; t < 64; ++t) { float v = uw[t * 256 + j]; const float* w = uw + t * 256 + 128; for (int d = 0; d < 128; ++d) v -= w[d] * S[(size_t)d * 128]; vn[(size_t)t * 128] = v; }
            for (int t = 0; t < 64; ++t) { const size_t tt = bc * 64 + t; const float* q = c.qkvc + tt * 3072 + hd * 128; float o = 0.f; for (int d = 0; d < 128; ++d) o += q[d] * S[(size_t)d * 128];
                o *= expf(c.gcs[tt * 8 + hd]); for (int s = 0; s <= t; ++s) o += aq[t * 64 + s] * vn[(size_t)s * 128];
                c.obuf[tt * 1024 + hd * 128 + j] = o; }
            const float dl = expf(glast);
            for (int d = 0; d < 128; ++d) { float a = S[(size_t)d * 128] * dl; for (int t = 0; t < 64; ++t) { const size_t tt = bc * 64 + t; a += c.qkvc[tt * 3072 + 1024 + hd * 128 + d] * expf(glast - c.gcs[tt * 8 + hd]) * vn[(size_t)t * 128]; } S[(size_t)d * 128] = a; } } }
}
__device__ __forceinline__ void s_gdn_out(const Ctx& c, size_t gid, size_t gs) {
    for (size_t i = gid; i < (size_t)T * 1024; i += gs) { const size_t t = i / 1024; const int col = (int)(i % 1024); c.cat[t * 1536 + col] = c.obuf[i] * c.rstd2[t * 8 + col / 128] * c.in[I_OD_NORM][col % 128] * siluf(c.proj[t * PROJ_LD + O_Z + col]); }
}
__device__ __forceinline__ void s_sb(const Ctx& c, size_t gid, size_t gs) {
    for (size_t i = gid; i < (size_t)T * 32; i += gs) { const int qd = (int)(i % 4); const int hd = (int)((i / 4) % 8); const size_t t = i / 32; const int tl = (int)(t % L); const float* q = c.proj + t * PROJ_LD + O_SQ + hd * 64;
        float o[16];
#pragma unroll
        for (int d = 0; d < 16; ++d) o[d] = 0.f;
        float carry = 0.f;
        for (int s = tl - 1; s >= 0 && carry > -150.f; --s) { const size_t ts = t - (size_t)(tl - s); const float* k = c.proj + ts * PROJ_LD + O_SK + hd * 64; const float* v = c.proj + ts * PROJ_LD + O_SV + hd * 64 + qd * 16; float lg = 0.f;
            for (int d = 0; d < 64; ++d) lg += q[d] * k[d];
            lg *= 0.125f; const float wgt = expf(-softplusf(-lg) + carry); carry -= softplusf(lg);
#pragma unroll
            for (int d = 0; d < 16; ++d) o[d] += wgt * v[d]; }
#pragma unroll
        for (int d = 0; d < 16; ++d) c.cat[t * 1536 + 1024 + hd * 64 + qd * 16 + d] = o[d]; }
}
__device__ __forceinline__ void s_final(const Ctx& c, size_t gid, size_t gs) { s_norm(c.h, c.rstd, c.in[I_FINAL_NORM], c.out, T, gid, gs); }

constexpr int XA_BASE = 20, MOE_BASE = 30, L1_BASE = 40, NSTAGE_L = 60;
__device__ __forceinline__ bool run_stage(const Ctx& c, int st, size_t gid, size_t gs) {
    const int layer = st / NSTAGE_L, s = st % NSTAGE_L;
    if (st >= 2 * NSTAGE_L + 2) return false;
    if (st == 2 * NSTAGE_L) { s_rstd(c.h, T, DM, DM, c.rstd, gid, gs); return true; }
    if (st == 2 * NSTAGE_L + 1) { s_final(c, gid, gs); return true; }
    const int l = layer;
    switch (s) {
    case 0: if (l == 0) { s_copy(c.in[I_X], c.h, (size_t)T * DM, gid, gs); s_rstd(c.in[I_MEM], NB * MEM, DM, DM, c.rstd2, gid, gs); } break;
    case 1: if (l == 0) s_norm(c.in[I_MEM], c.rstd2, c.in[I_MEM_NORM], c.memn, NB * MEM, gid, gs); s_rstd(c.h, T, DM, DM, c.rstd, gid, gs); break;
    case 2: s_norm(c.h, c.rstd, c.in[I_NORM_MIX] + l * DM, c.un, T, gid, gs); break;
    case 3: if (l == 0) s_gemm(c.un, DM, c.in[I_EV_WIN], EV_IN, c.proj, PROJ_LD, T, EV_IN, DM, 0, gid, gs); else s_gemm(c.un, DM, c.in[I_OD_WIN], OD_IN, c.proj, PROJ_LD, T, OD_IN, DM, 0, gid, gs); break;
    case 4: if (l == 0) { s_scmix(c, gid, gs); s_ssd_conv(c, gid, gs); s_ssd_dt(c, gid, gs); } else { s_gdn_conv(c, gid, gs); s_gdn_gates(c, gid, gs); s_sb(c, gid, gs); } break;
    case 5: if (l == 0) { s_ssd_states(c, gid, gs); s_ssd_cb(c, gid, gs); } else s_gdn_qkscale(c, gid, gs); break;
    case 6: if (l == 0) s_ssd_scan(c, gid, gs); else s_gdn_kk(c, gid, gs); break;
    case 7: if (l == 0) s_ssd_y(c, gid, gs); else s_gdn_solve(c, gid, gs); break;
    case 8: if (l == 0) s_rstd(c.ybuf, T * 2, 512, 512, c.rstd2, gid, gs); else s_gdn_scan(c, gid, gs); break;
    case 9: if (l == 0) s_ssd_out(c, gid, gs); else s_rstd(c.obuf, T * 8, 128, 128, c.rstd2, gid, gs); break;
    case 10: if (l == 1) s_gdn_out(c, gid, gs); break;
    case 11: s_gemm(c.cat, 1536, l == 0 ? c.in[I_EV_WOUT] : c.in[I_OD_WOUT], DM, c.h, DM, T, DM, 1536, 1, gid, gs); break;
    case 12: s_rstd(c.h, T, DM, DM, c.rstd, gid, gs); break;
    case 13: s_norm(c.h, c.rstd, c.in[I_NORM_XA] + l * DM, c.un, T, gid, gs); break;
    case 14: s_gemm(c.un, DM, c.in[I_XA_WQ] + (size_t)l * DM * DM, DM, c.q, DM, T, DM, DM, 0, gid, gs);
             s_gemm(c.memn, DM, c.in[I_XA_WK] + (size_t)l * DM * DM, DM, c.kx, DM, NB * MEM, DM, DM, 0, gid, gs);
             s_gemm(c.memn, DM, c.in[I_XA_WV] + (size_t)l * DM * DM, DM, c.vx, DM, NB * MEM, DM, DM, 0, gid, gs); break;
    case 15: s_xa_scores(c, gid, gs); break;
    case 16: s_xa_softmax(c, gid, gs); break;
    case 17: s_xa_pv(c, gid, gs); break;
    case 18: s_gemm(c.att, DM, c.in[I_XA_WO] + (size_t)l * DM * DM, DM, c.h, DM, T, DM, DM, 1, gid, gs); break;
    case 19: s_rstd(c.h, T, DM, DM, c.rstd, gid, gs); break;
    case 20: s_norm(c.h, c.rstd, c.in[I_NORM_FFN] + l * DM, c.un, T, gid, gs); break;
    case 21: s_router(c, l, gid, gs); break;
    case 22: s_moe_up(c, l, gid, gs); break;
    case 23: s_moe_down(c, l, gid, gs); break;
    default: break;
    }
    return true;
}
constexpr int N_STAGES_USED = 24;

__host__ __device__ __forceinline__ size_t carve(Ctx& c, float* w) {
    size_t o = 0;
    auto take = [&](size_t n) { float* p = w + o; o += (n + 63) & ~(size_t)63; return p; };
    c.h = take((size_t)T * DM); c.rstd = take(T); c.rstd2 = take((size_t)T * 8); c.memn = take((size_t)MEM * DM); c.kx = take((size_t)MEM * DM); c.vx = take((size_t)MEM * DM);
    c.eid = (int*)take((size_t)T * 2); c.gatew = take((size_t)T * 2); c.dtv = take((size_t)T * 16); c.acs = take((size_t)T * 16); c.beta = take((size_t)T * 8); c.gcs = take((size_t)T * 8);
    c.S = take(8 * 16384); c.vn = take(8 * 8192);
    c.un = take((size_t)T * DM); c.ybuf = c.un; c.obuf = c.un;
    c.proj = take((size_t)T * PROJ_LD);
    c.cat = take((size_t)T * 1536);
    const size_t d0 = o;
    c.xbcc = take((size_t)T * 1536); c.states = take((size_t)NCH * 16 * 8192); c.cb = take((size_t)NCH * 2 * 4096); size_t dmax = o;
    o = d0; c.qkvc = take((size_t)T * 3072); c.Lm = take((size_t)NCH * 8 * 4096); c.aqk = take((size_t)NCH * 8 * 4096); c.uw = take((size_t)NCH * 8 * 64 * 256); if (o > dmax) dmax = o;
    o = d0; c.q = take((size_t)T * DM); c.sc = take((size_t)T * DM); c.att = take((size_t)T * DM); if (o > dmax) dmax = o;
    o = d0; c.act = take((size_t)T * 2 * 512); if (o > dmax) dmax = o;
    return dmax;
}
}

namespace pg8 {
#define PG8_LAS __attribute__((address_space(3)))
typedef unsigned short bf16_t;
typedef short bf16x8 __attribute__((ext_vector_type(8)));
typedef float f32x4 __attribute__((ext_vector_type(4)));
typedef unsigned u32x4 __attribute__((ext_vector_type(4)));
constexpr int BM = 256, BK = 64, HALF = 128, HTB = HALF * BK * 2  , STAGE_BYTES = 8 * HTB, NXCD = 8, WGM = 8;

__host__ __device__ __forceinline__ int lds_byte(int r, int c) { const int st = (r >> 4) * 2 + (c >> 5), rr = r & 15, cc = c & 31, ob = rr * 64 + cc * 2; return st * 1024 + (ob ^ (((ob >> 9) & 1) << 5)); }
__host__ __device__ __forceinline__ void stage_rc(int b, int& R, int& C) { const int st = b / 1024, sb = b % 1024, swz = sb ^ (((sb >> 9) & 1) << 5); R = (st >> 1) * 16 + swz / 64; C = (st & 1) * 32 + (swz % 64) / 2; }
__host__ __device__ __forceinline__ int perm32(int rho) { const int n = rho >> 4, i = rho & 15; return 8 * (i >> 2) + 4 * n + (i & 3); }

struct Unit { int pm, pn, tag; const char* a; const char* b; };
struct Gemm { const bf16_t* A; const bf16_t* Bt; int M, N, K; };

struct StaticOrder {
    static constexpr bool LIGHT = false;
    int nM, nN, nwg, G, c; const char* A; const char* B; size_t tstep;
    __host__ __device__ void init(const Gemm& g, int G_, int c_) { nM = g.M / BM; nN = g.N / BM; nwg = nM * nN; G = G_; c = c_; A = (const char*)g.A; B = (const char*)g.Bt; tstep = (size_t)BM * g.K * 2; }
    __host__ __device__ bool next(int i, Unit& u) const {
        const long L = (long)i * G + c; if (L >= nwg) return false;
        int wgid = (int)L; { const int q = nwg / NXCD, r = nwg % NXCD, xcd = wgid % NXCD, off = wgid / NXCD; wgid = (xcd < r ? xcd * (q + 1) : r * (q + 1) + (xcd - r) * q) + off; }
        const int nig = WGM * nN, gid = wgid / nig, fm = gid * WGM, gsz = (nM - fm) < WGM ? (nM - fm) : WGM;
        u.pm = fm + ((wgid % nig) % gsz); u.pn = (wgid % nig) / gsz; u.a = A + (size_t)u.pm * tstep; u.b = B + (size_t)u.pn * tstep; return true;
    }
    __device__ __forceinline__ void a_ready(const Unit&) const {}
    __device__ __forceinline__ void done(const Unit&) const {}
};

template <class Epi, class Sched, bool ALIGN_EPI = false, bool SP2 = false>
__device__ __forceinline__ void gemm_phase(PG8_LAS unsigned char* lds, const Gemm g, const Sched& S, const Epi& E) {
    int tid_ = threadIdx.x; asm volatile("" : "+v"(tid_));
    const int tid = tid_, wid = __builtin_amdgcn_readfirstlane(tid >> 6), lane = tid & 63, wr = wid >> 2, wc = wid & 3, fr = lane & 15, fq = lane >> 4;
    const int K = g.K, nt = K / BK;
    unsigned voffA[2], voffB[2];
#pragma unroll
    for (int i = 0; i < 2; ++i) { int R, C; stage_rc(tid * 16 + i * 8192, R, C); const int Rb = Epi::PERM ? ((R & ~31) + perm32(R & 31)) : R;
        voffA[i] = (unsigned)(R * K + C) * 2u; voffB[i] = (unsigned)(Rb * K + C) * 2u; }
    const size_t kstep = (size_t)(BK * 2);
    const size_t hstep = (size_t)HALF * K * 2;
    const unsigned ldsw = (unsigned)wid * 1024u;
    const int aoff = lds_byte(wr * 64 + fr, fq * 8), boff = lds_byte(wc * 32 + fr, fq * 8);
#define PG8_SA(b, h) (((b) * 2 + (h)) * HTB)
#define PG8_SB(b, h) ((4 + (b) * 2 + (h)) * HTB)
#define PG8_STAGE(bufoff, gbase, voff) do { _Pragma("unroll") for (int _i = 0; _i < 2; ++_i) \
        __builtin_amdgcn_global_load_lds((const unsigned*)((const char*)(gbase) + (voff)[_i]), (PG8_LAS unsigned*)(lds + (bufoff) + ldsw + _i * 8192), 16, 0, 0); } while (0)
#define PG8_LDA(dst, b, h) do { _Pragma("unroll") for (int m = 0; m < 4; ++m) _Pragma("unroll") for (int k = 0; k < 2; ++k) dst[m][k] = *(const PG8_LAS bf16x8*)(lds + PG8_SA(b, h) + aoff + m * 2048 + k * 1024); } while (0)
#define PG8_LDB(dst, b, h) do { _Pragma("unroll") for (int n = 0; n < 2; ++n) _Pragma("unroll") for (int k = 0; k < 2; ++k) dst[n][k] = *(const PG8_LAS bf16x8*)(lds + PG8_SB(b, h) + boff + n * 2048 + k * 1024); } while (0)
#define PG8_MMA(ai, bj, At, Bt) do { __builtin_amdgcn_s_setprio(1); _Pragma("unroll") for (int m = 0; m < 4; ++m) _Pragma("unroll") for (int n = 0; n < 2; ++n) _Pragma("unroll") for (int k = 0; k < 2; ++k) \
        acc[ai][bj][m][n] = __builtin_amdgcn_mfma_f32_16x16x32_bf16(Bt[n][k], At[m][k], acc[ai][bj][m][n], 0, 0, 0); __builtin_amdgcn_s_setprio(0); } while (0)
#define PG8_WAIT_V(n) asm volatile("s_waitcnt vmcnt(" #n ")" ::: "memory")
#define PG8_WAIT_L(n) asm volatile("s_waitcnt lgkmcnt(" #n ")" ::: "memory")
#define PG8_BAR __builtin_amdgcn_s_barrier()
#define PG8_SCHED __builtin_amdgcn_sched_barrier(0)
    Unit cur, nxt; int ui = 0;
    if (!S.next(0, cur)) return;
    f32x4 acc[2][2][4][2];
#pragma unroll
    for (int a = 0; a < 2; ++a)
#pragma unroll
        for (int b = 0; b < 2; ++b)
#pragma unroll
            for (int m = 0; m < 4; ++m)
#pragma unroll
                for (int n = 0; n < 2; ++n) acc[a][b][m][n] = (f32x4){0.f, 0.f, 0.f, 0.f};
    bf16x8 At[4][2], B0[2][2], B1[2][2];
    const char* cA = cur.a; const char* cB = cur.b;
    S.a_ready(cur);
    if constexpr (SP2) {
        PG8_STAGE(PG8_SB(0, 0), cB, voffB); PG8_STAGE(PG8_SB(0, 1), cB + hstep, voffB); PG8_STAGE(PG8_SA(0, 0), cA, voffA); PG8_STAGE(PG8_SA(0, 1), cA + hstep, voffA);
        if (wr == 1) PG8_BAR;
        PG8_WAIT_V(2); PG8_BAR;
        PG8_STAGE(PG8_SB(1, 0), cB + kstep, voffB); PG8_STAGE(PG8_SA(1, 0), cA + kstep, voffA); PG8_STAGE(PG8_SB(1, 1), cB + hstep + kstep, voffB);
        PG8_WAIT_V(6); PG8_BAR;
    } else {
        PG8_STAGE(PG8_SB(0, 0), cB, voffB); PG8_STAGE(PG8_SA(0, 0), cA, voffA); PG8_STAGE(PG8_SB(0, 1), cB + hstep, voffB); PG8_STAGE(PG8_SA(0, 1), cA + hstep, voffA);
        if (wr == 1) PG8_BAR;
        PG8_WAIT_V(4); PG8_BAR;
        PG8_STAGE(PG8_SB(1, 0), cB + kstep, voffB); PG8_STAGE(PG8_SA(1, 0), cA + kstep, voffA); PG8_STAGE(PG8_SB(1, 1), cB + hstep + kstep, voffB);
        PG8_WAIT_V(6); PG8_BAR;
    }
    for (;;) {
        const bool has_next = S.next(ui + 1, nxt);
        const char* nA = has_next ? nxt.a : cA; const char* nB = has_next ? nxt.b : cB;
        for (int t = 0; t < nt; t += 2) {
            const bool last = (t == nt - 2);
            const char* a1 = cA + (size_t)(t + 1) * kstep;
            const char* a2 = last ? nA : cA + (size_t)(t + 2) * kstep; const char* b2 = last ? nB : cB + (size_t)(t + 2) * kstep;
            const char* a3 = a2 + kstep; const char* b3 = b2 + kstep;
            if (last && has_next) S.a_ready(nxt);
            if constexpr (SP2) {
            PG8_LDB(B0, 0, 0); PG8_LDB(B1, 0, 1); PG8_SCHED; PG8_LDA(At, 0, 0); PG8_STAGE(PG8_SA(1, 1), a1 + hstep, voffA);
            PG8_WAIT_V(8); PG8_WAIT_L(0); PG8_BAR; PG8_MMA(0, 0, At, B0); PG8_MMA(0, 1, At, B1); PG8_BAR; PG8_SCHED;
            PG8_LDA(At, 0, 1); PG8_STAGE(PG8_SB(0, 0), b2, voffB); PG8_STAGE(PG8_SB(0, 1), b2 + hstep, voffB); PG8_STAGE(PG8_SA(0, 0), a2, voffA);
            PG8_WAIT_V(8); PG8_WAIT_L(0); PG8_BAR; if (!(Sched::LIGHT && (cur.tag & 1))) { PG8_MMA(1, 0, At, B0); PG8_MMA(1, 1, At, B1); } PG8_BAR; PG8_SCHED;
            PG8_LDB(B0, 1, 0); PG8_LDB(B1, 1, 1); PG8_SCHED; PG8_LDA(At, 1, 0); PG8_STAGE(PG8_SA(0, 1), a2 + hstep, voffA);
            PG8_WAIT_V(8); PG8_WAIT_L(0); PG8_BAR; PG8_MMA(0, 0, At, B0); PG8_MMA(0, 1, At, B1); PG8_BAR; PG8_SCHED;
            PG8_LDA(At, 1, 1); PG8_STAGE(PG8_SB(1, 0), b3, voffB); PG8_STAGE(PG8_SB(1, 1), b3 + hstep, voffB); PG8_STAGE(PG8_SA(1, 0), a3, voffA);
            PG8_WAIT_V(8); PG8_WAIT_L(0); PG8_BAR; if (!(Sched::LIGHT && (cur.tag & 1))) { PG8_MMA(1, 0, At, B0); PG8_MMA(1, 1, At, B1); } PG8_BAR; PG8_SCHED;
            } else {
            PG8_LDB(B0, 0, 0); PG8_SCHED; PG8_LDA(At, 0, 0); PG8_STAGE(PG8_SA(1, 1), a1 + hstep, voffA);
            PG8_WAIT_L(8); PG8_BAR; PG8_WAIT_L(0); PG8_MMA(0, 0, At, B0); PG8_BAR; PG8_SCHED;
            PG8_LDB(B1, 0, 1); PG8_STAGE(PG8_SB(0, 0), b2, voffB);
            PG8_BAR; PG8_WAIT_L(0); PG8_MMA(0, 1, At, B1); PG8_BAR;
            PG8_LDA(At, 0, 1); PG8_STAGE(PG8_SA(0, 0), a2, voffA);
            PG8_BAR; PG8_WAIT_L(0); PG8_MMA(1, 0, At, B0); PG8_BAR; PG8_SCHED;
            PG8_STAGE(PG8_SB(0, 1), b2 + hstep, voffB);
            PG8_WAIT_V(6); PG8_BAR; PG8_MMA(1, 1, At, B1); PG8_BAR;
            PG8_LDB(B0, 1, 0); PG8_SCHED; PG8_LDA(At, 1, 0); PG8_STAGE(PG8_SA(0, 1), a2 + hstep, voffA);
            PG8_WAIT_L(8); PG8_BAR; PG8_WAIT_L(0); PG8_MMA(0, 0, At, B0); PG8_BAR; PG8_SCHED;
            PG8_LDB(B1, 1, 1); PG8_STAGE(PG8_SB(1, 0), b3, voffB);
            PG8_BAR; PG8_WAIT_L(0); PG8_MMA(0, 1, At, B1); PG8_BAR;
            PG8_LDA(At, 1, 1); PG8_STAGE(PG8_SA(1, 0), a3, voffA);
            PG8_BAR; PG8_WAIT_L(0); PG8_MMA(1, 0, At, B0); PG8_BAR; PG8_SCHED;
            PG8_STAGE(PG8_SB(1, 1), b3 + hstep, voffB);
            PG8_WAIT_V(6); PG8_BAR; PG8_MMA(1, 1, At, B1); PG8_BAR;
            }
        }
        if constexpr (ALIGN_EPI) { if (wr == 0) PG8_BAR; }
        if constexpr (!Epi::AFTER_DRAIN) { E(acc, cur, wr, wc, fr, fq); S.done(cur); }
        if (!has_next) break;
#pragma unroll
        for (int a = 0; a < 2; ++a)
#pragma unroll
            for (int b = 0; b < 2; ++b)
#pragma unroll
                for (int m = 0; m < 4; ++m)
#pragma unroll
                    for (int n = 0; n < 2; ++n) acc[a][b][m][n] = (f32x4){0.f, 0.f, 0.f, 0.f};
        cur = nxt; cA = nA; cB = nB; ++ui;
        if constexpr (ALIGN_EPI) { if (wr == 1) PG8_BAR; }
    }
    PG8_WAIT_V(0);
    if constexpr (!ALIGN_EPI) { if (wr == 0) PG8_BAR; }
    PG8_BAR;
    if constexpr (Epi::AFTER_DRAIN) { E.fused(acc, cur, wr, wc, fr, fq, lds, wid, lane); S.done(cur); }
#undef PG8_SA
#undef PG8_SB
#undef PG8_STAGE
#undef PG8_LDA
#undef PG8_LDB
#undef PG8_MMA
#undef PG8_WAIT_V
#undef PG8_WAIT_L
#undef PG8_BAR
#undef PG8_SCHED
}
}

namespace ok {
using pg8::bf16_t; using pg8::bf16x8; using pg8::f32x4; using pg8::u32x4;
typedef unsigned u32x2 __attribute__((ext_vector_type(2)));
typedef float f32x2 __attribute__((ext_vector_type(2)));
#ifndef SEQ
#define SEQ 8192
#endif
constexpr int NB = 2, L = SEQ, NCH = L / 64, T = NB * L, DM = 1024, NWAVES = 8, NT = 512;
constexpr float EPS = 1e-6f, LOG2E = 1.4426950408889634f;
constexpr size_t MiB = 1u << 20, KiB = 1024;
constexpr size_t WS_CTL = 0, CTL_BYTES = 1 * MiB;
constexpr int CW_BAR = 0;
constexpr int CW_SSQ = 16384;
constexpr int CW_MOE = 16384 + 6 * T;
constexpr int CW_CHK = CW_MOE + 256;
static_assert((CW_CHK + 64) * 4 <= (int)CTL_BYTES, "ctl");
constexpr size_t WS_WDT = 1 * MiB, WS_WAB = WS_WDT + 64 * KiB, WS_WR = WS_WAB + 64 * KiB;
constexpr size_t WS_DTV = 2 * MiB, WS_ACS = 3 * MiB, WS_GCS = 4 * MiB, WS_BETA = 4 * MiB + 512 * KiB;
constexpr size_t WS_RAW16 = WS_DTV;
constexpr size_t WS_EID = 5 * MiB, WS_GATEW = WS_EID + 128 * KiB, WS_TOKSLOT = WS_GATEW + 128 * KiB, WS_SLOTTOK = WS_TOKSLOT + 128 * KiB, WS_SLOTGATE = WS_SLOTTOK + 160 * KiB,
                 WS_SLOTRSTD = WS_SLOTGATE + 160 * KiB, WS_TILEEXP = WS_SLOTRSTD + 160 * KiB;
constexpr size_t WS_FP = 8 * MiB;
constexpr size_t WS_W_IN0 = 16 * MiB, WS_W_IN1 = 24 * MiB, WS_W_OUT0 = 35 * MiB, WS_W_OUT1 = 38 * MiB, WS_W_XA = 41 * MiB  ;
constexpr size_t WS_MEMNB = 57 * MiB, WS_KX = 58 * MiB  , WS_VT = 60 * MiB  ;
constexpr size_t WS_H = 64 * MiB, WS_HB = 128 * MiB, WS_MOEW = 160 * MiB, WS_BIG = 256 * MiB;
constexpr size_t WS_PROJ = WS_BIG;
constexpr size_t WS_CAT0 = 384 * MiB, WS_STATES = 432 * MiB;
constexpr size_t WS_CAT1 = 432 * MiB;
constexpr size_t WS_Q = WS_BIG, WS_ATT = WS_BIG + 32 * MiB;
constexpr size_t WS_XS = WS_BIG, WS_ACT = WS_BIG + 80 * MiB, WS_Y = WS_BIG + 120 * MiB;
constexpr size_t WS_END = 528 * MiB;
constexpr int PROJ0_LD = 4096, PROJ1_LD = 5632, MAXSLOT = 40960;

#ifdef CPU_EMU
__device__ __forceinline__ float fexp(float x) { return expf(x); }
__device__ __forceinline__ float fexp2(float x) { return exp2f(x); }
__device__ __forceinline__ float frcp(float x) { return 1.f / x; }
__device__ __forceinline__ float frsq(float x) { return 1.f / sqrtf(x); }
#else
__device__ __forceinline__ float fexp(float x) { return __builtin_amdgcn_exp2f(x * 1.4426950408889634f); }
__device__ __forceinline__ float fexp2(float x) { return __builtin_amdgcn_exp2f(x); }
__device__ __forceinline__ float frcp(float x) { return __builtin_amdgcn_rcpf(x); }
__device__ __forceinline__ float frsq(float x) { return __builtin_amdgcn_rsqf(x); }
#endif
#ifdef CPU_EMU
#define LAS
#define GAS
#define LDS_WAIT() do {} while (0)
#define WAVE_SYNC() ((void)__shfl(0, 0))
#define MEM_FENCE() do {} while (0)
#define PIN16(a) do {} while (0)
#define LDS_BARRIER() __syncthreads()
#define SCHED_FENCE() do {} while (0)
__device__ __forceinline__ unsigned cvt_pk_bf16(float lo, float hi) { return emu_f2bf(lo) | (emu_f2bf(hi) << 16); }
#else
#define LAS __attribute__((address_space(3)))
#define GAS __attribute__((address_space(1)))
#define LDS_WAIT() asm volatile("s_waitcnt lgkmcnt(0)" ::: "memory")
#define LDS_BARRIER() do { asm volatile("s_waitcnt lgkmcnt(0)" ::: "memory"); __builtin_amdgcn_s_barrier(); asm volatile("" ::: "memory"); } while (0)
#define MEM_FENCE() asm volatile("" ::: "memory")
#define PIN16(a) asm volatile("" : "+v"(a[0]), "+v"(a[1]), "+v"(a[2]), "+v"(a[3]), "+v"(a[4]), "+v"(a[5]), "+v"(a[6]), "+v"(a[7]), "+v"(a[8]), "+v"(a[9]), "+v"(a[10]), "+v"(a[11]), "+v"(a[12]), "+v"(a[13]), "+v"(a[14]), "+v"(a[15]) :: "memory")
#define SCHED_FENCE() __builtin_amdgcn_sched_barrier(0)
#define WAVE_SYNC() do { asm volatile("s_waitcnt lgkmcnt(0)" ::: "memory"); __builtin_amdgcn_wave_barrier(); } while (0)
typedef __bf16 hwbf16x2 __attribute__((ext_vector_type(2)));
__device__ __forceinline__ unsigned cvt_pk_bf16(float lo, float hi) { const f32x2 v = {lo, hi}; return __builtin_bit_cast(unsigned, __builtin_convertvector(v, hwbf16x2)); }
#endif
__device__ __forceinline__ float bf2f(unsigned short b) { return __uint_as_float(((unsigned)b) << 16); }
__device__ __forceinline__ float bflo(unsigned w) { return __uint_as_float(w << 16); }
__device__ __forceinline__ float bfhi(unsigned w) { return __uint_as_float(w & 0xffff0000u); }
__device__ __forceinline__ float wave_sum(float v) {
#pragma unroll
    for (int o = 1; o < 64; o <<= 1) v += __shfl_xor(v, o);
    return v;
}
__device__ __forceinline__ f32x4 mfma16(bf16x8 a, bf16x8 b, f32x4 c) { return __builtin_amdgcn_mfma_f32_16x16x32_bf16(a, b, c, 0, 0, 0); }

struct Frame {
    LAS unsigned char* lds;
    unsigned* ctl;
    unsigned char* ws;
    const float* const* in;
    float* out;
    int tid, lane, wave, vcu, G;
};
constexpr size_t WS_SSQP1 = 6 * MiB, WS_SSQP2 = 7 * MiB, WS_SSQP4 = 62 * MiB, WS_SSQP5 = 63 * MiB;
__device__ __forceinline__ float rstd_np(const float* p, int np, int row) { float s; if (np == 1) s = p[row]; else { const f32x4* q = (const f32x4*)(p + (size_t)row * 16); const f32x4 a = q[0], b = q[1], c = q[2], d = q[3]; s = ((a.x + a.y) + (a.z + a.w)) + ((b.x + b.y) + (b.z + b.w)) + (((c.x + c.y) + (c.z + c.w)) + ((d.x + d.y) + (d.z + d.w))); }
    return frsq(s * (1.f / 1024.f) + EPS); }
#define OKP(type, off) ((type*)(F.ws + (off)))
#ifdef CPU_EMU
__device__ __forceinline__ Frame phase_frame(const Frame& F0) { return F0; }
#else
__device__ __forceinline__ Frame phase_frame(const Frame& F0) { Frame F = F0; int t = threadIdx.x; asm volatile("" : "+v"(t)); F.tid = t; F.lane = t & 63; F.wave = __builtin_amdgcn_readfirstlane(t >> 6); return F; }
#endif

struct CvtJob { const float* W; int ldw, K, ncols, c0; bf16_t* WT; int drow0, dstep16; const float* kgain; float cscale; };
__device__ __forceinline__ int job_items(const CvtJob& j) { return (j.K / 64) * (j.ncols / 32); }
struct CvtRegs { float wv[32]; };
__device__ __forceinline__ void cvt_load(CvtRegs& r, const CvtJob& j, int item, int lane) {
    const int nblk = j.ncols / 32, kb = item / nblk, nb = item % nblk, k0 = 64 * kb, c0 = j.c0 + 32 * nb;
#pragma unroll
    for (int i = 0; i < 32; ++i) r.wv[i] = j.W[(size_t)(k0 + 2 * i + (lane >> 5)) * j.ldw + c0 + (lane & 31)];
}
__device__ __forceinline__ void cvt_finish(const CvtRegs& r, const CvtJob& j, int item, LAS float* scr, int lane) {
    const int nblk = j.ncols / 32, kb = item / nblk, nb = item % nblk, k0 = 64 * kb, drow0 = j.drow0 + (32 * nb >> 4) * j.dstep16;
#pragma unroll
    for (int i = 0; i < 32; ++i) { const int kk = 2 * i + (lane >> 5); const float g = j.kgain ? j.kgain[k0 + kk] * j.cscale : j.cscale; scr[kk * 33 + (lane & 31)] = r.wv[i] * g; }
    WAVE_SYNC();
    const int c = lane & 7;
#pragma unroll
    for (int jj = 0; jj < 4; ++jj) { const int n = (lane >> 3) + 8 * jj; const LAS float* s = scr + (8 * c) * 33 + n;
        u32x4 o; o.x = cvt_pk_bf16(s[0 * 33], s[1 * 33]); o.y = cvt_pk_bf16(s[2 * 33], s[3 * 33]); o.z = cvt_pk_bf16(s[4 * 33], s[5 * 33]); o.w = cvt_pk_bf16(s[6 * 33], s[7 * 33]);
        *(u32x4*)(j.WT + (size_t)(drow0 + (n >> 4) * j.dstep16 + (n & 15)) * j.K + k0 + 8 * c) = o; }
    WAVE_SYNC();
}
__device__ __forceinline__ CvtJob dense_job(const Frame& F, int j) {
    using namespace sm;
    const float* const* in = F.in;
    switch (j) {
    case 0: return CvtJob{in[I_EV_WIN], 4112, 1024, 4096, 0, OKP(bf16_t, WS_W_IN0), 0, 16, in[I_NORM_MIX], 1.f};
    case 1: return CvtJob{in[I_OD_WIN], 5648, 1024, 4096, 0, OKP(bf16_t, WS_W_IN1), 0, 16, in[I_NORM_MIX] + 1024, 1.f};
    case 2: return CvtJob{in[I_OD_WIN], 5648, 1024, 512, 4112, OKP(bf16_t, WS_W_IN1), 4096, 16, in[I_NORM_MIX] + 1024, 0.125f * LOG2E};
    case 3: return CvtJob{in[I_OD_WIN], 5648, 1024, 1024, 4624, OKP(bf16_t, WS_W_IN1), 4608, 16, in[I_NORM_MIX] + 1024, 1.f};
    case 4: return CvtJob{in[I_EV_WOUT], 1024, 1536, 1024, 0, OKP(bf16_t, WS_W_OUT0), 0, 16, nullptr, 1.f};
    case 5: return CvtJob{in[I_OD_WOUT], 1024, 1536, 1024, 0, OKP(bf16_t, WS_W_OUT1), 0, 16, nullptr, 1.f};
    default: { const int l = (j - 6) / 4, w = (j - 6) % 4; bf16_t* dst = OKP(bf16_t, WS_W_XA + (size_t)l * 8 * MiB + (size_t)w * 2 * MiB);
        const float* src = in[I_XA_WQ + w] + (size_t)l * 1024 * 1024;
        if (w == 0) return CvtJob{src, 1024, 1024, 1024, 0, dst, 0, 16, in[I_NORM_XA] + l * 1024, 0.0625f * LOG2E};
        return CvtJob{src, 1024, 1024, 1024, 0, dst, 0, 16, nullptr, 1.f}; }
    }
}
constexpr int N_DENSE_JOBS = 14;
__device__ __forceinline__ CvtJob moe_job(const Frame& F, int l, int j) {
    using namespace sm;
    const int e = j / 3, w = j % 3; const float* const* in = F.in;
    bf16_t* gu = OKP(bf16_t, WS_MOEW + (size_t)e * 3 * MiB); bf16_t* dn = gu + 1024 * 1024;
    if (w == 0) return CvtJob{in[I_MOE_WGATE] + ((size_t)l * 32 + e) * 1024 * 512, 512, 1024, 512, 0, gu, 0, 32, in[I_NORM_FFN] + l * 1024, 1.f};
    if (w == 1) return CvtJob{in[I_MOE_WUP] + ((size_t)l * 32 + e) * 1024 * 512, 512, 1024, 512, 0, gu, 16, 32, in[I_NORM_FFN] + l * 1024, 1.f};
    return CvtJob{in[I_MOE_WDOWN] + ((size_t)l * 32 + e) * 512 * 1024, 1024, 512, 1024, 0, dn, 0, 16, nullptr, 1.f};
}
__device__ __forceinline__ int dense_total(const Frame& F) { int n = 0; for (int j = 0; j < N_DENSE_JOBS; ++j) n += job_items(dense_job(F, j)); return n; }
__device__ __forceinline__ void dense_item(const Frame& F, int idx, CvtJob& job, int& item) {
    for (int j = 0; j < N_DENSE_JOBS; ++j) { const CvtJob jb = dense_job(F, j); const int n = job_items(jb); job = jb; item = idx < n ? idx : n - 1; if (idx < n) return; idx -= n; }
}
__device__ __forceinline__ void phase_cvt_dense(const Frame& F0) {
    const Frame F = phase_frame(F0);
    LAS float* scr = (LAS float*)(F.lds + F.wave * 16384);
    const int gw = F.vcu * NWAVES + F.wave, NGW = F.G * NWAVES, N = dense_total(F);
    CvtRegs ra, rb;
    auto LD = [&](CvtRegs& r, int idx) { CvtJob jb; int it; dense_item(F, idx < N ? idx : N - 1, jb, it); cvt_load(r, jb, it, F.lane); };
    auto FN = [&](const CvtRegs& r, int idx) { if (idx < N) { CvtJob jb; int it; dense_item(F, idx, jb, it); cvt_finish(r, jb, it, scr, F.lane); } };
    LD(ra, gw);
    for (int idx = gw; idx < N; idx += 2 * NGW) { LD(rb, idx + NGW); FN(ra, idx); LD(ra, idx + 2 * NGW); FN(rb, idx + NGW); }
}
__device__ __forceinline__ void phase_cvt_moe(const Frame& F0, int l) {
    const Frame F = phase_frame(F0);
    LAS float* scr = (LAS float*)(F.lds + F.wave * 16384);
    const int gw = F.vcu * NWAVES + F.wave, NGW = F.G * NWAVES; constexpr int N = 96 * 256;
    CvtRegs ra, rb;
    auto LD = [&](CvtRegs& r, int idx) { const int ii = idx < N ? idx : N - 1; const CvtJob jb = moe_job(F, l, ii >> 8); cvt_load(r, jb, ii & 255, F.lane); };
    auto FN = [&](const CvtRegs& r, int idx) { if (idx < N) { const CvtJob jb = moe_job(F, l, idx >> 8); cvt_finish(r, jb, idx & 255, scr, F.lane); } };
    LD(ra, gw);
    for (int idx = gw; idx < N; idx += 2 * NGW) { LD(rb, idx + NGW); FN(ra, idx); LD(ra, idx + 2 * NGW); FN(rb, idx + NGW); }
}
__device__ __forceinline__ void row_to_bf16_ssq(const float* xrow, bf16_t* orow, float* ssq, int lane) {
    const f32x4* xr = (const f32x4*)xrow + lane; float s = 0.f; f32x4 v[4];
#pragma unroll
    for (int j = 0; j < 4; ++j) { v[j] = xr[64 * j]; s += (v[j].x * v[j].x + v[j].y * v[j].y) + (v[j].z * v[j].z + v[j].w * v[j].w); }
    s = wave_sum(s);
    u32x2* o8 = (u32x2*)orow + lane;
#pragma unroll
    for (int j = 0; j < 4; ++j) { u32x2 w; w.x = cvt_pk_bf16(v[j].x, v[j].y); w.y = cvt_pk_bf16(v[j].z, v[j].w); o8[64 * j] = w; }
    if (lane == 0) *ssq = s;
}
__device__ __forceinline__ void phase_prologue(const Frame& F0) {
    const Frame F = phase_frame(F0);
    using namespace sm;
    phase_cvt_dense(F0);
    const int gw = F.vcu * NWAVES + F.wave, NGW = F.G * NWAVES;
    float* ssq0 = (float*)F.ctl + CW_SSQ;
    for (int m = gw; m < T; m += NGW) row_to_bf16_ssq(F.in[I_X] + (size_t)m * DM, OKP(bf16_t, WS_HB) + (size_t)m * DM, ssq0 + m, F.lane);
    for (int m = gw; m < NB * 256; m += NGW) { const f32x4* xr = (const f32x4*)(F.in[I_MEM] + (size_t)m * DM) + F.lane; const f32x4* gr = (const f32x4*)F.in[I_MEM_NORM] + F.lane; float s = 0.f; f32x4 v[4];
#pragma unroll
        for (int j = 0; j < 4; ++j) { v[j] = xr[64 * j]; s += (v[j].x * v[j].x + v[j].y * v[j].y) + (v[j].z * v[j].z + v[j].w * v[j].w); }
        const float r = 1.f / sqrtf(wave_sum(s) * (1.f / DM) + EPS);
        u32x2* o8 = (u32x2*)(OKP(bf16_t, WS_MEMNB) + (size_t)m * DM) + F.lane;
#pragma unroll
        for (int j = 0; j < 4; ++j) { const f32x4 g = gr[64 * j]; u32x2 w; w.x = cvt_pk_bf16(v[j].x * r * g.x, v[j].y * r * g.y); w.y = cvt_pk_bf16(v[j].z * r * g.z, v[j].w * r * g.w); o8[64 * j] = w; } }
    const size_t gt = (size_t)F.vcu * NT + F.tid, GT = (size_t)F.G * NT;
    for (size_t i = gt; i < 1024 * 16; i += GT) { const int k = (int)(i >> 4), j = (int)(i & 15);
        OKP(float, WS_WDT)[j * 1024 + k] = F.in[I_NORM_MIX][k] * F.in[I_EV_WIN][(size_t)k * 4112 + 4096 + j];
        OKP(float, WS_WAB)[j * 1024 + k] = F.in[I_NORM_MIX][1024 + k] * F.in[I_OD_WIN][(size_t)k * 5648 + 4096 + j]; }
}

#ifndef CPU_EMU
struct EpiScaleBf16 {
    static constexpr bool PERM = true, AFTER_DRAIN = false;
    bf16_t* O; int ldc; const float* ssq; int np;
    __device__ __forceinline__ void operator()(const f32x4 (&acc)[2][2][4][2], const pg8::Unit& u, int wr, int wc, int fr, int fq) const {
        const int row0 = u.pm * 256 + wr * 64 + fr, col0 = u.pn * 256 + wc * 32 + 8 * fq;
#pragma unroll
        for (int ai = 0; ai < 2; ++ai)
#pragma unroll
            for (int m = 0; m < 4; ++m) { const int row = row0 + ai * 128 + m * 16; const float s = ssq ? rstd_np(ssq, np, row) : 1.f; bf16_t* rowp = O + (size_t)row * ldc + col0;
#pragma unroll
                for (int bj = 0; bj < 2; ++bj) { const f32x4 v0 = acc[ai][bj][m][0] * s, v1 = acc[ai][bj][m][1] * s; u32x4 w; w.x = cvt_pk_bf16(v0[0], v0[1]); w.y = cvt_pk_bf16(v0[2], v0[3]); w.z = cvt_pk_bf16(v1[0], v1[1]); w.w = cvt_pk_bf16(v1[2], v1[3]);
                    *(u32x4*)(rowp + bj * 128) = w; } }
    }
};
template <bool HIN_F32> struct EpiResidualT {
    static constexpr bool PERM = false, AFTER_DRAIN = false;
    const float* hin; bf16_t* hb; float* ssq;
    __device__ __forceinline__ void operator()(const f32x4 (&acc)[2][2][4][2], const pg8::Unit& u, int wr, int wc, int fr, int fq) const {
        const int row0 = u.pm * 256 + wr * 64 + fr, col0 = u.pn * 256 + wc * 32 + 4 * fq;
#pragma unroll
        for (int ai = 0; ai < 2; ++ai)
#pragma unroll
            for (int m = 0; m < 4; ++m) { const int row = row0 + ai * 128 + m * 16; const size_t ro = (size_t)row * DM + col0; float s = 0.f;
#pragma unroll
                for (int bj = 0; bj < 2; ++bj)
#pragma unroll
                    for (int n = 0; n < 2; ++n) { const size_t o = ro + bj * 128 + n * 16; f32x4 v;
                        if (HIN_F32) v = *(const f32x4*)(hin + o); else { const u32x2 hw = *(const u32x2*)(hb + o); v = (f32x4){bflo(hw.x), bfhi(hw.x), bflo(hw.y), bfhi(hw.y)}; }
                        v += acc[ai][bj][m][n];
                        u32x2 w; w.x = cvt_pk_bf16(v[0], v[1]); w.y = cvt_pk_bf16(v[2], v[3]); *(u32x2*)(hb + o) = w;
                        const float r0 = bflo(w.x), r1 = bfhi(w.x), r2 = bflo(w.y), r3 = bfhi(w.y); s += (r0 * r0 + r1 * r1) + (r2 * r2 + r3 * r3); }
                s += __shfl_xor(s, 16); s += __shfl_xor(s, 32);
                if (fq == 0) ssq[(size_t)row * 16 + u.pn * 4 + wc] = s; }
    }
};

template <class Epi> __device__ __forceinline__ void dense_gemm(const Frame& F, const bf16_t* A, const bf16_t* Bt, int M, int N, int K, const Epi& E) {
    pg8::Gemm g{A, Bt, M, N, K}; pg8::StaticOrder S; S.init(g, F.G, (int)blockIdx.x);
    pg8::gemm_phase<Epi, pg8::StaticOrder, true, true>(F.lds, g, S, E);
}
#endif
}

namespace ok {
constexpr int XT_LD = 72;
constexpr int BC_LD = 136;
__device__ __forceinline__ float siluf(float x) { return x * frcp(1.f + fexp(-x)); }
__device__ __forceinline__ float softplusf(float x) { return x > 20.f ? x : log1pf(expf(x)); }

template <class Sink> __device__ __forceinline__ void ssd_conv_pair(const Frame& F, int b, int c, int xc, Sink&& sink) {
    using namespace sm;
    const float* cw = F.in[I_EV_CONVW]; const f32x2 w0 = *(const f32x2*)(cw + xc), w1 = *(const f32x2*)(cw + 1536 + xc), w2 = *(const f32x2*)(cw + 3072 + xc), w3 = *(const f32x2*)(cw + 4608 + xc), bias = *(const f32x2*)(F.in[I_EV_CONVB] + xc);
    const bf16_t* p = OKP(bf16_t, WS_PROJ) + (size_t)(b * L + c * 64) * PROJ0_LD + 2560 + xc;
    unsigned raw[64];
#pragma unroll
    for (int t = 0; t < 64; ++t) raw[t] = *(const unsigned*)(p + (size_t)t * PROJ0_LD);
    f32x2 x0 = {0.f, 0.f}, x1 = x0, x2 = x0;
    if (c > 0) { const unsigned a = *(const unsigned*)(p - 3 * PROJ0_LD), bq = *(const unsigned*)(p - 2 * PROJ0_LD), cq = *(const unsigned*)(p - PROJ0_LD); x0 = (f32x2){bflo(a), bfhi(a)}; x1 = (f32x2){bflo(bq), bfhi(bq)}; x2 = (f32x2){bflo(cq), bfhi(cq)}; }
#pragma unroll
    for (int t = 0; t < 64; t += 2) { const f32x2 x3 = {bflo(raw[t]), bfhi(raw[t])}, x4 = {bflo(raw[t + 1]), bfhi(raw[t + 1])};
        const f32x2 v0 = bias + w0 * x0 + w1 * x1 + w2 * x2 + w3 * x3, v1 = bias + w0 * x1 + w1 * x2 + w2 * x3 + w3 * x4;
        sink(t, siluf(v0.x), siluf(v1.x), siluf(v0.y), siluf(v1.y)); x0 = x2; x1 = x3; x2 = x4; }
}

__device__ __forceinline__ void phase_ssd_a(const Frame& F0) {
    const Frame F = phase_frame(F0);
    using namespace sm;
    LAS bf16_t* XT = (LAS bf16_t*)F.lds; LAS bf16_t* BT = (LAS bf16_t*)(F.lds + 73728);
    LAS float* dt_s = (LAS float*)(F.lds + 92160); LAS float* acs_s = (LAS float*)(F.lds + 94208); LAS float* sc_s = (LAS float*)(F.lds + 96256);
    const int tid = F.tid, lane = F.lane, wave = F.wave;
    for (int u = F.vcu; u < NB * NCH * 2; u += F.G) {
        const int g = u & 1, bc = u >> 1, b = bc / NCH, c = bc % NCH; const size_t row0 = (size_t)b * L + c * 64;
        LDS_BARRIER();
        if (tid < 320) { const int ci = tid * 2;
            const int xc = ci < 512 ? g * 512 + ci : 1024 + g * 128 + (ci - 512);
            LAS unsigned* dst = (LAS unsigned*)(ci < 512 ? XT + ci * XT_LD : BT + (ci - 512) * XT_LD);
            ssd_conv_pair(F, b, c, xc, [&](int t, float a0, float a1, float b0, float b1) { dst[t >> 1] = cvt_pk_bf16(a0, a1); dst[XT_LD / 2 + (t >> 1)] = cvt_pk_bf16(b0, b1); });
        }
        { const int t = tid & 63, hh = tid >> 6, hd = g * 8 + hh; const float dt = softplusf(OKP(float, WS_RAW16)[(row0 + t) * 16 + hd] + F.in[I_EV_DTB][hd]); dt_s[hh * 64 + t] = dt; acs_s[hh * 64 + t] = dt * -expf(F.in[I_EV_ALOG][hd]); }
        LDS_BARRIER();
        { const int hh = wave, hd = g * 8 + hh; float v = acs_s[hh * 64 + lane];
#pragma unroll
          for (int o = 1; o < 64; o <<= 1) { const float n = __shfl_up(v, o); if (lane >= o) v += n; }
          const float last = __shfl(v, 63); const float dt = dt_s[hh * 64 + lane];
          sc_s[hh * 64 + lane] = dt * fexp(last - v);
          OKP(float, WS_DTV)[(row0 + lane) * 16 + hd] = dt; OKP(float, WS_ACS)[(row0 + lane) * 16 + hd] = v; }
        WAVE_SYNC();
#if defined(CHECK_DUMP)
        if (bc == 5 && g == 0) {
            float* f3 = OKP(float, WS_FP) + (size_t)3 * 16 * 6144; float* f4 = OKP(float, WS_FP) + (size_t)4 * 16 * 6144; float* f5 = OKP(float, WS_FP) + (size_t)5 * 16 * 6144;
            for (int i = tid; i < 512 * 64; i += NT) f3[i] = bf2f(XT[(i >> 6) * XT_LD + (i & 63)]);
            for (int i = tid; i < 128 * 64; i += NT) f4[i] = bf2f(BT[(i >> 6) * XT_LD + (i & 63)]);
            f5[wave * 64 + lane] = sc_s[wave * 64 + lane];
        }
#endif
        { const int hh = wave, hd = g * 8 + hh, fr = lane & 15, fq = lane >> 4;
          bf16x8 xa[4][2];
#pragma unroll
          for (int pt = 0; pt < 4; ++pt)
#pragma unroll
              for (int ks = 0; ks < 2; ++ks) { const u32x4 raw = *(const LAS u32x4*)(XT + (hh * 64 + pt * 16 + fr) * XT_LD + ks * 32 + fq * 8); const LAS float* sp = sc_s + hh * 64 + ks * 32 + fq * 8;
                  const f32x4 s0 = *(const LAS f32x4*)sp, s1 = *(const LAS f32x4*)(sp + 4); u32x4 o;
                  o.x = cvt_pk_bf16(bflo(raw.x) * s0.x, bfhi(raw.x) * s0.y); o.y = cvt_pk_bf16(bflo(raw.y) * s0.z, bfhi(raw.y) * s0.w);
                  o.z = cvt_pk_bf16(bflo(raw.z) * s1.x, bfhi(raw.z) * s1.y); o.w = cvt_pk_bf16(bflo(raw.w) * s1.z, bfhi(raw.w) * s1.w);
                  xa[pt][ks] = __builtin_bit_cast(bf16x8, o); }
          bf16_t* st = OKP(bf16_t, WS_STATES) + ((size_t)bc * 16 + hd) * 8192;
#pragma unroll
          for (int nt = 0; nt < 8; ++nt) { bf16x8 bb[2];
#pragma unroll
              for (int ks = 0; ks < 2; ++ks) bb[ks] = *(const LAS bf16x8*)(BT + (nt * 16 + fr) * XT_LD + ks * 32 + fq * 8);
#pragma unroll
              for (int pt = 0; pt < 4; ++pt) { f32x4 acc = {0.f, 0.f, 0.f, 0.f};
#pragma unroll
                  for (int ks = 0; ks < 2; ++ks) acc = mfma16(bb[ks], xa[pt][ks], acc);
                  u32x2 w; w.x = cvt_pk_bf16(acc[0], acc[1]); w.y = cvt_pk_bf16(acc[2], acc[3]);
                  *(u32x2*)(st + (size_t)(pt * 16 + fr) * 128 + nt * 16 + 4 * fq) = w; } } }
    }
}

__device__ __forceinline__ void phase_ssd_scan(const Frame& F0, int skip) {
    const Frame F = phase_frame(F0);
    const float* acs = OKP(float, WS_ACS);
    int widx = F.vcu, nw = F.G;
    if (skip) { const int per = F.G / 8, xcd = F.vcu / per, loc = F.vcu % per, sk = skip / 8; if (loc < sk) return; widx = xcd * (per - sk) + (loc - sk); nw = F.G - skip; }
    for (int idx = widx * NT + F.tid; idx < NB * 65536; idx += nw * NT) {
        const int b = idx >> 16, r2 = idx & 65535, hd = r2 >> 12; unsigned* p = (unsigned*)(OKP(bf16_t, WS_STATES) + (size_t)b * NCH * 131072) + r2;
        float s0 = 0.f, s1 = 0.f;
#pragma unroll 8
        for (int c = 0; c < NCH; ++c) { const unsigned st = p[(size_t)c * 65536]; const float dec = fexp(acs[((size_t)b * L + c * 64 + 63) * 16 + hd]);
            p[(size_t)c * 65536] = cvt_pk_bf16(s0, s1); s0 = s0 * dec + bflo(st); s1 = s1 * dec + bfhi(st); }
    }
}

__device__ __forceinline__ void phase_ssd_b(const Frame& F0) {
    const Frame F = phase_frame(F0);
    using namespace sm;
    LAS bf16_t* XT = (LAS bf16_t*)F.lds; LAS bf16_t* Bs = (LAS bf16_t*)(F.lds + 73728); LAS bf16_t* Cs = (LAS bf16_t*)(F.lds + 91136);
    LAS float* acs_s = (LAS float*)(F.lds + 108544); LAS float* dt_s = (LAS float*)(F.lds + 110592); LAS float* red = (LAS float*)(F.lds + 112640);
    const int tid = F.tid, lane = F.lane, wave = F.wave, fr = lane & 15, fq = lane >> 4;
    const bf16_t* proj = OKP(bf16_t, WS_PROJ); bf16_t* cat = OKP(bf16_t, WS_CAT0);
    for (int u = F.vcu; u < NB * NCH * 2; u += F.G) {
        const int g = u & 1, bc = u >> 1, b = bc / NCH, c = bc % NCH; const size_t row0 = (size_t)b * L + c * 64;
        LDS_BARRIER();
        if (tid < 384) { const int ci = tid * 2;
            if (ci < 512) { LAS unsigned* dst = (LAS unsigned*)(XT + ci * XT_LD); ssd_conv_pair(F, b, c, g * 512 + ci, [&](int t, float a0, float a1, float b0, float b1) { dst[t >> 1] = cvt_pk_bf16(a0, a1); dst[XT_LD / 2 + (t >> 1)] = cvt_pk_bf16(b0, b1); }); }
            else { const int n = (ci - 512) & 127; LAS unsigned* dst = (LAS unsigned*)((ci < 640 ? Bs : Cs) + n); const int xc = (ci < 640 ? 1024 : 1280) + g * 128 + n;
                ssd_conv_pair(F, b, c, xc, [&](int t, float a0, float a1, float b0, float b1) { dst[t * (BC_LD / 2)] = cvt_pk_bf16(a0, b0); dst[(t + 1) * (BC_LD / 2)] = cvt_pk_bf16(a1, b1); }); }
        }
        { const int t = tid & 63, hh = tid >> 6; acs_s[hh * 64 + t] = OKP(float, WS_ACS)[(row0 + t) * 16 + g * 8 + hh]; dt_s[hh * 64 + t] = OKP(float, WS_DTV)[(row0 + t) * 16 + g * 8 + hh]; }
        { const int ch = g * 256 + (tid & 255), t0 = (tid >> 8) * 32; const float* w = F.in[I_EV_SCCONV]; const float w0 = w[ch], w1 = w[512 + ch], w2 = w[1024 + ch];
          const bf16_t* p = proj + (row0 + t0) * PROJ0_LD + ch; float p0 = 0.f, p1 = 0.f;
          if (c > 0 || t0 > 0) { p0 = bf2f(p[-2 * PROJ0_LD + 512]) * bf2f(p[-2 * PROJ0_LD + 1024]); p1 = bf2f(p[-PROJ0_LD + 512]) * bf2f(p[-PROJ0_LD + 1024]); }
          unsigned short rb[32], rc[32], rx[32];
#pragma unroll
          for (int t = 0; t < 32; ++t) { const bf16_t* q = p + (size_t)t * PROJ0_LD; rb[t] = q[0]; rc[t] = q[512]; rx[t] = q[1024]; }
#pragma unroll
          for (int t = 0; t < 32; ++t) { const float p2 = bf2f(rc[t]) * bf2f(rx[t]); const float y = bf2f(rb[t]) * (w0 * p0 + w1 * p1 + w2 * p2);
              cat[(row0 + t0 + t) * 1536 + ch] = (bf16_t)(cvt_pk_bf16(y, 0.f) & 0xffffu); p0 = p1; p1 = p2; } }
        LDS_BARRIER();
        const int hh = wave, hd = g * 8 + hh;
        f32x4 Y[4][4];
        { const bf16_t* P = OKP(bf16_t, WS_STATES) + ((size_t)bc * 16 + hd) * 8192;
#pragma unroll
          for (int pt = 0; pt < 4; ++pt)
#pragma unroll
              for (int tt = 0; tt < 4; ++tt) Y[pt][tt] = (f32x4){0.f, 0.f, 0.f, 0.f};
          bf16x8 pall[4][4];
#pragma unroll
          for (int ks = 0; ks < 4; ++ks)
#pragma unroll
              for (int pt = 0; pt < 4; ++pt) pall[ks][pt] = *(const bf16x8*)(P + (size_t)(pt * 16 + fr) * 128 + ks * 32 + fq * 8);
#pragma unroll
          for (int ks = 0; ks < 4; ++ks) { bf16x8 cb[4];
#pragma unroll
              for (int tt = 0; tt < 4; ++tt) cb[tt] = *(const LAS bf16x8*)(Cs + (tt * 16 + fr) * BC_LD + ks * 32 + fq * 8);
#pragma unroll
              for (int pt = 0; pt < 4; ++pt)
#pragma unroll
                  for (int tt = 0; tt < 4; ++tt) Y[pt][tt] = mfma16(pall[ks][pt], cb[tt], Y[pt][tt]); }
#pragma unroll
          for (int tt = 0; tt < 4; ++tt) { const float e = fexp(acs_s[hh * 64 + tt * 16 + fr]);
#pragma unroll
              for (int pt = 0; pt < 4; ++pt) Y[pt][tt] *= e; } }
#pragma unroll
        for (int tt = 0; tt < 4; ++tt) { f32x4 cbt[4];
#pragma unroll
            for (int st = 0; st < 4; ++st) cbt[st] = (f32x4){0.f, 0.f, 0.f, 0.f};
#pragma unroll
            for (int ks = 0; ks < 4; ++ks) { const bf16x8 cf = *(const LAS bf16x8*)(Cs + (tt * 16 + fr) * BC_LD + ks * 32 + fq * 8);
#pragma unroll
                for (int st = 0; st < 4; ++st) if (st <= tt) { const bf16x8 bf = *(const LAS bf16x8*)(Bs + (st * 16 + fr) * BC_LD + ks * 32 + fq * 8); cbt[st] = mfma16(bf, cf, cbt[st]); } }
            const int t = tt * 16 + fr; const float at = acs_s[hh * 64 + t];
#pragma unroll
            for (int st = 0; st < 4; ++st) { const f32x4 as4 = *(const LAS f32x4*)(acs_s + hh * 64 + st * 16 + 4 * fq), dt4 = *(const LAS f32x4*)(dt_s + hh * 64 + st * 16 + 4 * fq);
#pragma unroll
                for (int r = 0; r < 4; ++r) { const int s = st * 16 + 4 * fq + r; cbt[st][r] = (st <= tt && s <= t) ? cbt[st][r] * fexp(at - as4[r]) * dt4[r] : 0.f; } }
            bf16x8 mb[2];
#pragma unroll
            for (int ks = 0; ks < 2; ++ks) { u32x4 o; o.x = cvt_pk_bf16(cbt[2 * ks][0], cbt[2 * ks][1]); o.y = cvt_pk_bf16(cbt[2 * ks][2], cbt[2 * ks][3]); o.z = cvt_pk_bf16(cbt[2 * ks + 1][0], cbt[2 * ks + 1][1]); o.w = cvt_pk_bf16(cbt[2 * ks + 1][2], cbt[2 * ks + 1][3]);
                mb[ks] = __builtin_bit_cast(bf16x8, o); }
#pragma unroll
            for (int pt = 0; pt < 4; ++pt)
#pragma unroll
                for (int ks = 0; ks < 2; ++ks) { const LAS bf16_t* xp = XT + (hh * 64 + pt * 16 + fr) * XT_LD + ks * 32 + 4 * fq; const u32x2 lo = *(const LAS u32x2*)xp, hi = *(const LAS u32x2*)(xp + 16);
                    u32x4 a; a.x = lo.x; a.y = lo.y; a.z = hi.x; a.w = hi.y; Y[pt][tt] = mfma16(__builtin_bit_cast(bf16x8, a), mb[ks], Y[pt][tt]); } }
        const float Dh = F.in[I_EV_D][hd];
#pragma unroll
        for (int tt = 0; tt < 4; ++tt) { const int t = tt * 16 + fr; float ss = 0.f;
#pragma unroll
            for (int pt = 0; pt < 4; ++pt) { const int p = pt * 16 + 4 * fq; const u32x2 zz = *(const u32x2*)(proj + (row0 + t) * PROJ0_LD + 1536 + hd * 64 + p);
                const float z0 = bflo(zz.x), z1 = bfhi(zz.x), z2 = bflo(zz.y), z3 = bfhi(zz.y); const LAS bf16_t* xp = XT + (hh * 64 + p) * XT_LD + t;
                f32x4 y = Y[pt][tt]; y[0] = (y[0] + Dh * bf2f(xp[0])) * siluf(z0); y[1] = (y[1] + Dh * bf2f(xp[XT_LD])) * siluf(z1); y[2] = (y[2] + Dh * bf2f(xp[2 * XT_LD])) * siluf(z2); y[3] = (y[3] + Dh * bf2f(xp[3 * XT_LD])) * siluf(z3);
                Y[pt][tt] = y; ss += (y[0] * y[0] + y[1] * y[1]) + (y[2] * y[2] + y[3] * y[3]); }
            ss += __shfl_xor(ss, 16); ss += __shfl_xor(ss, 32);
            if (fq == 0) red[hh * 64 + t] = ss; }
        LDS_BARRIER();
#pragma unroll
        for (int tt = 0; tt < 4; ++tt) { const int t = tt * 16 + fr; float ss = 0.f;
#pragma unroll
            for (int w = 0; w < 8; ++w) ss += red[w * 64 + t];
            const float rs = frsq(ss * (1.f / 512.f) + EPS);
#pragma unroll
            for (int pt = 0; pt < 4; ++pt) { const int ch = hd * 64 + pt * 16 + 4 * fq; const f32x4 nw = *(const f32x4*)(F.in[I_EV_NORM] + ch); const f32x4 y = Y[pt][tt];
                u32x2 w; w.x = cvt_pk_bf16(y[0] * rs * nw.x, y[1] * rs * nw.y); w.y = cvt_pk_bf16(y[2] * rs * nw.z, y[3] * rs * nw.w);
                *(u32x2*)(cat + (row0 + t) * 1536 + 512 + ch) = w; } }
    }
}
}

namespace ok {
constexpr int XA_LD = 264;

__device__ __forceinline__ void phase_xattn(const Frame& F0, const bf16_t* q, const bf16_t* kx, const bf16_t* vt, bf16_t* att) {
    const Frame F = phase_frame(F0);
    LAS bf16_t* KV = (LAS bf16_t*)F.lds;
    const int tid = F.tid, lane = F.lane, wave = F.wave, fr = lane & 15, fq = lane >> 4;
    u32x4 tile[8];
#define XA_LOAD_K(uu) do { const int hd_ = (uu) & 3, b_ = (((uu) >> 2) * 128) / L; _Pragma("unroll") for (int j_ = 0; j_ < 8; ++j_) { const int i_ = tid + j_ * NT, r_ = i_ >> 5, c8_ = i_ & 31; tile[j_] = *(const u32x4*)(kx + (size_t)(b_ * 256 + r_) * 1024 + hd_ * 256 + c8_ * 8); } } while (0)
#define XA_LOAD_V(uu) do { const int hd_ = (uu) & 3, b_ = (((uu) >> 2) * 128) / L; _Pragma("unroll") for (int j_ = 0; j_ < 8; ++j_) { const int i_ = tid + j_ * NT, r_ = i_ >> 5, c8_ = i_ & 31; tile[j_] = *(const u32x4*)(vt + (size_t)(hd_ * 256 + r_) * (NB * 256) + b_ * 256 + c8_ * 8); } } while (0)
#define XA_STORE() do { _Pragma("unroll") for (int j_ = 0; j_ < 8; ++j_) { const int i_ = tid + j_ * NT, r_ = i_ >> 5, c8_ = i_ & 31; *(LAS u32x4*)(KV + r_ * XA_LD + c8_ * 8) = tile[j_]; } } while (0)
#define XA_REST_K(uu) do { const int hd_ = (uu) & 3, b_ = (((uu) >> 2) * 128) / L; _Pragma("unroll") for (int j_ = 8; j_ < 16; ++j_) { const int i_ = tid + j_ * NT, r_ = i_ >> 5, c8_ = i_ & 31; *(LAS u32x4*)(KV + r_ * XA_LD + c8_ * 8) = *(const u32x4*)(kx + (size_t)(b_ * 256 + r_) * 1024 + hd_ * 256 + c8_ * 8); } } while (0)
#define XA_REST_V(uu) do { const int hd_ = (uu) & 3, b_ = (((uu) >> 2) * 128) / L; _Pragma("unroll") for (int j_ = 8; j_ < 16; ++j_) { const int i_ = tid + j_ * NT, r_ = i_ >> 5, c8_ = i_ & 31; *(LAS u32x4*)(KV + r_ * XA_LD + c8_ * 8) = *(const u32x4*)(vt + (size_t)(hd_ * 256 + r_) * (NB * 256) + b_ * 256 + c8_ * 8); } } while (0)
    if (F.vcu < (T / 128) * 4) XA_LOAD_K(F.vcu);
    for (int u = F.vcu; u < (T / 128) * 4; u += F.G) {
        const int hd = u & 3, rt = u >> 2, row0 = rt * 128;
        LDS_BARRIER();
        XA_REST_K(u); XA_STORE();
        XA_LOAD_V(u);
        LDS_BARRIER();
        bf16x8 pf[8]; float fA, fB;
        {
            const bf16_t* qp = q + (size_t)(row0 + wave * 16 + fr) * 1024 + hd * 256 + fq * 8;
            bf16x8 qf[8];
#pragma unroll
            for (int ks = 0; ks < 8; ++ks) qf[ks] = *(const bf16x8*)(qp + ks * 32);
            float mh[2], lh[2];
#pragma unroll
            for (int half = 0; half < 2; ++half) {
                f32x4 s[8];
#pragma unroll
                for (int kt = 0; kt < 8; ++kt) { s[kt] = (f32x4){0.f, 0.f, 0.f, 0.f};
#pragma unroll
                    for (int ks = 0; ks < 8; ++ks) { const bf16x8 kf = *(const LAS bf16x8*)(KV + ((half * 8 + kt) * 16 + fr) * XA_LD + ks * 32 + fq * 8); s[kt] = mfma16(kf, qf[ks], s[kt]); }
                    }
                float m = -3.0e38f;
#pragma unroll
                for (int kt = 0; kt < 8; ++kt) m = fmaxf(m, fmaxf(fmaxf(s[kt][0], s[kt][1]), fmaxf(s[kt][2], s[kt][3])));
                m = fmaxf(m, __shfl_xor(m, 16)); m = fmaxf(m, __shfl_xor(m, 32));
                float l = 0.f;
#pragma unroll
                for (int kt = 0; kt < 8; ++kt) {
#pragma unroll
                    for (int r = 0; r < 4; ++r) { const float p = fexp2(s[kt][r] - m); s[kt][r] = p; l += p; } }
                l += __shfl_xor(l, 16); l += __shfl_xor(l, 32); mh[half] = m; lh[half] = l;
#pragma unroll
                for (int j = 0; j < 4; ++j) { u32x4 o; o.x = cvt_pk_bf16(s[2 * j][0], s[2 * j][1]); o.y = cvt_pk_bf16(s[2 * j][2], s[2 * j][3]); o.z = cvt_pk_bf16(s[2 * j + 1][0], s[2 * j + 1][1]); o.w = cvt_pk_bf16(s[2 * j + 1][2], s[2 * j + 1][3]);
                    pf[half * 4 + j] = __builtin_bit_cast(bf16x8, o); }
                    }
            const float m = fmaxf(mh[0], mh[1]), cA = fexp2(mh[0] - m), cB = fexp2(mh[1] - m), li = frcp(cA * lh[0] + cB * lh[1]); fA = cA * li; fB = cB * li;
        }
        LDS_BARRIER();
        XA_REST_V(u); XA_STORE();
        if (u + F.G < (T / 128) * 4) XA_LOAD_K(u + F.G);
        LDS_BARRIER();
#pragma unroll 2
        for (int dt = 0; dt < 16; ++dt) { f32x4 oA = {0.f, 0.f, 0.f, 0.f}, oB = oA;
#pragma unroll
            for (int j = 0; j < 8; ++j) { const LAS bf16_t* vp = KV + (dt * 16 + fr) * XA_LD + j * 32 + 4 * fq; const u32x2 lo = *(const LAS u32x2*)vp, hi = *(const LAS u32x2*)(vp + 16);
                u32x4 a; a.x = lo.x; a.y = lo.y; a.z = hi.x; a.w = hi.y; const bf16x8 vf = __builtin_bit_cast(bf16x8, a);
                if (j < 4) oA = mfma16(vf, pf[j], oA); else oB = mfma16(vf, pf[j], oB); }
            const f32x4 o = oA * fA + oB * fB;
            bf16_t* op = att + (size_t)(row0 + wave * 16 + fr) * 1024 + hd * 256 + dt * 16 + 4 * fq;
            u32x2 w; w.x = cvt_pk_bf16(o[0], o[1]); w.y = cvt_pk_bf16(o[2], o[3]); *(u32x2*)op = w; }
    }
#undef XA_LOAD_K
#undef XA_LOAD_V
#undef XA_STORE
#undef XA_REST_K
#undef XA_REST_V
}

#ifndef CPU_EMU
struct KvOrder {
    static constexpr bool LIGHT = false;
    const char* memnb; const char* wxa; char* kx; char* vt; int G, c;
    __device__ bool next(int i, pg8::Unit& u) const {
        const int Lx = i * G + c; if (Lx >= 32) return false;
        const int l = Lx >> 4, r = Lx & 15; const size_t tstep = (size_t)256 * 1024 * 2;
        if (r < 8) { u.pm = r >> 2; u.pn = r & 3; u.tag = l * 2; u.a = memnb + (size_t)u.pm * tstep; u.b = wxa + (size_t)l * 8 * MiB + 2 * MiB + (size_t)u.pn * tstep; }
        else { const int r2 = r - 8; u.pm = r2 >> 1; u.pn = r2 & 1; u.tag = l * 2 + 1; u.a = wxa + (size_t)l * 8 * MiB + 4 * MiB + (size_t)u.pm * tstep; u.b = memnb + (size_t)u.pn * tstep; }
        return true;
    }
    __device__ __forceinline__ void a_ready(const pg8::Unit&) const {}
    __device__ __forceinline__ void done(const pg8::Unit&) const {}
};
struct EpiKv {
    static constexpr bool PERM = true, AFTER_DRAIN = false;
    bf16_t* kx; bf16_t* vt;
    __device__ __forceinline__ void operator()(const f32x4 (&acc)[2][2][4][2], const pg8::Unit& u, int wr, int wc, int fr, int fq) const {
        const int l = u.tag >> 1, isv = u.tag & 1, ldc = isv ? 512 : 1024; bf16_t* O = isv ? vt + (size_t)l * 1024 * 512 : kx + (size_t)l * 512 * 1024;
        const int row0 = u.pm * 256 + wr * 64 + fr, col0 = u.pn * 256 + wc * 32 + 8 * fq;
#pragma unroll
        for (int ai = 0; ai < 2; ++ai)
#pragma unroll
            for (int m = 0; m < 4; ++m) { bf16_t* rowp = O + (size_t)(row0 + ai * 128 + m * 16) * ldc + col0;
#pragma unroll
                for (int bj = 0; bj < 2; ++bj) { const f32x4 v0 = acc[ai][bj][m][0], v1 = acc[ai][bj][m][1]; u32x4 w; w.x = cvt_pk_bf16(v0[0], v0[1]); w.y = cvt_pk_bf16(v0[2], v0[3]); w.z = cvt_pk_bf16(v1[0], v1[1]); w.w = cvt_pk_bf16(v1[2], v1[3]);
                    *(u32x4*)(rowp + bj * 128) = w; } }
    }
};
__device__ __forceinline__ void phase_kv(const Frame& F) {
    pg8::Gemm g{nullptr, nullptr, 0, 0, 1024};
    int vcu_; { const int bx = blockIdx.x, G = gridDim.x; vcu_ = (G % 8 == 0) ? (bx % 8) * (G / 8) + bx / 8 : bx; if (G % 8 == 0 && G >= 64) { const int per = G / 8, xcd = vcu_ / per, loc = vcu_ % per; vcu_ = loc < 4 ? xcd * 4 + loc : 32 + vcu_; } }
    KvOrder S{(const char*)OKP(bf16_t, WS_MEMNB), (const char*)OKP(bf16_t, WS_W_XA), (char*)OKP(bf16_t, WS_KX), (char*)OKP(bf16_t, WS_VT), F.G, vcu_};
    EpiKv E{OKP(bf16_t, WS_KX), OKP(bf16_t, WS_VT)};
    pg8::gemm_phase<EpiKv, KvOrder, true, true>(F.lds, g, S, E);
}
#endif
}

namespace ok {
constexpr size_t WS_WRH = WS_WR, WS_WRL = WS_WR + 256 * KiB;
constexpr size_t WS_POS = WS_TILEEXP + 4 * KiB;
__device__ __forceinline__ void prologue_router_tables(const Frame& F0) {
    const Frame F = phase_frame(F0);
    using namespace sm;
    const size_t gt = (size_t)F.vcu * NT + F.tid, GT = (size_t)F.G * NT;
    for (size_t i = gt; i < (size_t)2 * 48 * 1024; i += GT) { const int l = (int)(i / (48 * 1024)), j = (int)((i / 1024) % 48), k = (int)(i % 1024); float v = 0.f;
        if (j < 4) v = F.in[I_MOE_WG][((size_t)l * 1024 + k) * 4 + j]; else if (j < 36) v = F.in[I_MOE_WE][((size_t)l * 1024 + k) * 32 + (j - 4)];
        v *= F.in[I_NORM_FFN][l * 1024 + k];
        const unsigned hi = cvt_pk_bf16(v, 0.f) & 0xffffu; const float rem = v - __uint_as_float(hi << 16);
        OKP(bf16_t, WS_WRH)[i] = (bf16_t)hi; OKP(bf16_t, WS_WRL)[i] = (bf16_t)(cvt_pk_bf16(rem, 0.f) & 0xffffu); }
}

constexpr size_t WS_W16H = WS_WR + 512 * KiB, WS_W16L = WS_W16H + 64 * KiB;
__device__ __forceinline__ void prologue_w16_tables(const Frame& F0) {
    using namespace sm;
    const Frame F = phase_frame(F0);
    const size_t gt = (size_t)F.vcu * NT + F.tid, GT = (size_t)F.G * NT;
    for (size_t i = gt; i < (size_t)2 * 16 * 1024; i += GT) { const int set = (int)(i >> 14), j = (int)((i >> 10) & 15), k = (int)(i & 1023);
        const float v = set == 0 ? F.in[I_NORM_MIX][k] * F.in[I_EV_WIN][(size_t)k * 4112 + 4096 + j] : F.in[I_NORM_MIX][1024 + k] * F.in[I_OD_WIN][(size_t)k * 5648 + 4096 + j];
        const unsigned hi = cvt_pk_bf16(v, 0.f) & 0xffffu; const float rem = v - __uint_as_float(hi << 16);
        OKP(bf16_t, WS_W16H)[i] = (bf16_t)hi; OKP(bf16_t, WS_W16L)[i] = (bf16_t)(cvt_pk_bf16(rem, 0.f) & 0xffffu); }
}
__device__ __forceinline__ void phase_proj16(const Frame& F0, int set, const float* h, const bf16_t* hb, const float* ssq, int np) {
    const Frame F = phase_frame(F0);
    const int lane = F.lane, fr = lane & 15, fq = lane >> 4;
    const bf16_t* wh = OKP(bf16_t, WS_W16H) + (size_t)set * 16 * 1024; const bf16_t* wl = OKP(bf16_t, WS_W16L) + (size_t)set * 16 * 1024;
    const int gw = F.vcu * NWAVES + F.wave, NGW = F.G * NWAVES;
    for (int tile = gw; tile < T / 16; tile += NGW) { const int t0 = tile * 16; f32x4 acc = {0.f, 0.f, 0.f, 0.f};
        const float* hp = h + (size_t)(t0 + fr) * DM + fq * 8;
#pragma unroll 8
        for (int ks = 0; ks < 32; ++ks) { const size_t wo = (size_t)fr * 1024 + ks * 32 + fq * 8; const bf16x8 bh = *(const bf16x8*)(wh + wo), bl = *(const bf16x8*)(wl + wo);
            if (hb) { const bf16x8 ah = *(const bf16x8*)(hb + (size_t)(t0 + fr) * DM + fq * 8 + ks * 32); acc = mfma16(bh, ah, acc); acc = mfma16(bl, ah, acc); }
            else { const f32x4 x0 = *(const f32x4*)(hp + ks * 32), x1 = *(const f32x4*)(hp + ks * 32 + 4);
            u32x4 hi, lo;
            hi.x = cvt_pk_bf16(x0[0], x0[1]); hi.y = cvt_pk_bf16(x0[2], x0[3]); hi.z = cvt_pk_bf16(x1[0], x1[1]); hi.w = cvt_pk_bf16(x1[2], x1[3]);
            lo.x = cvt_pk_bf16(x0[0] - bflo(hi.x), x0[1] - bfhi(hi.x)); lo.y = cvt_pk_bf16(x0[2] - bflo(hi.y), x0[3] - bfhi(hi.y));
            lo.z = cvt_pk_bf16(x1[0] - bflo(hi.z), x1[1] - bfhi(hi.z)); lo.w = cvt_pk_bf16(x1[2] - bflo(hi.w), x1[3] - bfhi(hi.w));
            const bf16x8 ah = __builtin_bit_cast(bf16x8, hi), al = __builtin_bit_cast(bf16x8, lo);
            acc = mfma16(bh, ah, acc); acc = mfma16(bl, ah, acc); acc = mfma16(bh, al, acc); } }
        acc *= rstd_np(ssq, np, t0 + fr);
        *(f32x4*)(OKP(float, WS_RAW16) + (size_t)(t0 + fr) * 16 + 4 * fq) = acc; }
}

__device__ __forceinline__ void phase_router(const Frame& F0, int l, const bf16_t* hb, const float* ssq, int np) {
    const Frame F = phase_frame(F0);
    using namespace sm;
    const int lane = F.lane, wave = F.wave, fr = lane & 15, fq = lane >> 4;
    LAS float* lg = (LAS float*)(F.lds + wave * 16384 + 8704);
    const bf16_t* wh = OKP(bf16_t, WS_WRH) + (size_t)l * 48 * 1024; const bf16_t* wl = OKP(bf16_t, WS_WRL) + (size_t)l * 48 * 1024;
    const float* bg = F.in[I_MOE_BG] + l * 4; const float* be = F.in[I_MOE_BE] + l * 32;
    unsigned* cnt = F.ctl + CW_MOE + l * 64;
    const int gw = F.vcu * NWAVES + wave, NGW = F.G * NWAVES;
    for (int tile = gw; tile < T / 16; tile += NGW) {
        const int t0 = tile * 16;
        f32x4 acc[3] = {{0.f, 0.f, 0.f, 0.f}, {0.f, 0.f, 0.f, 0.f}, {0.f, 0.f, 0.f, 0.f}};
        const bf16_t* hp = hb + (size_t)(t0 + fr) * DM + fq * 8;
#pragma unroll 8
        for (int ks = 0; ks < 32; ++ks) { const bf16x8 ah = *(const bf16x8*)(hp + ks * 32);
#pragma unroll
            for (int nt = 0; nt < 3; ++nt) { const size_t wo = (size_t)(nt * 16 + fr) * 1024 + ks * 32 + fq * 8; const bf16x8 bh = *(const bf16x8*)(wh + wo), bl = *(const bf16x8*)(wl + wo);
                acc[nt] = mfma16(bh, ah, acc[nt]); acc[nt] = mfma16(bl, ah, acc[nt]); } }
#pragma unroll
        for (int nt = 0; nt < 3; ++nt) *(LAS f32x4*)(lg + fr * 48 + nt * 16 + 4 * fq) = acc[nt];
        WAVE_SYNC();
        if (lane < 16) { const int t = t0 + lane; const LAS float* p = lg + lane * 48; const float rs = rstd_np(ssq, np, t);
            const float g0 = p[0] * rs + bg[0], g1 = p[1] * rs + bg[1], g2 = p[2] * rs + bg[2], g3 = p[3] * rs + bg[3];
            int gsel = 0; float gm = g0; if (g1 > gm) { gm = g1; gsel = 1; } if (g2 > gm) { gm = g2; gsel = 2; } if (g3 > gm) { gm = g3; gsel = 3; }
            const float gwt = 1.f / (expf(g0 - gm) + expf(g1 - gm) + expf(g2 - gm) + expf(g3 - gm));
            const LAS float* pe = p + 4 + gsel * 8; const float* bb = be + gsel * 8;
            float e[8];
#pragma unroll
            for (int j = 0; j < 8; ++j) e[j] = pe[j] * rs + bb[j];
            int i1 = 0; float m1 = e[0];
#pragma unroll
            for (int j = 1; j < 8; ++j) if (e[j] > m1) { m1 = e[j]; i1 = j; }
            int i2 = -1; float m2 = -3.0e38f;
#pragma unroll
            for (int j = 0; j < 8; ++j) if (j != i1 && e[j] > m2) { m2 = e[j]; i2 = j; }
            const float r = expf(m2 - m1); const float w1 = gwt / (1.f + r), w2 = gwt * r / (1.f + r);
            const int e1 = gsel * 8 + i1, e2 = gsel * 8 + i2;
            OKP(int, WS_EID)[t * 2] = e1; OKP(int, WS_EID)[t * 2 + 1] = e2; OKP(float, WS_GATEW)[t * 2] = w1; OKP(float, WS_GATEW)[t * 2 + 1] = w2;
            OKP(int, WS_POS)[t * 2] = (int)atomicAdd(cnt + e1, 1u); OKP(int, WS_POS)[t * 2 + 1] = (int)atomicAdd(cnt + e2, 1u); }
        WAVE_SYNC();
    }
}

__device__ __forceinline__ void phase_scatter(const Frame& F0, int l, const bf16_t* hb, const float* ssq, int np) {
    const Frame F = phase_frame(F0);
    const unsigned* cnt = F.ctl + CW_MOE + l * 64; const int lane = F.lane;
    const int gw = F.vcu * NWAVES + F.wave, NGW = F.G * NWAVES;
    int base = 0;
    { int tiles = lane < 32 ? (((int)cnt[lane & 31] + 255) >> 8) : 0; int incl = tiles;
#pragma unroll
      for (int o = 1; o < 32; o <<= 1) { const int n = __shfl_up(incl, o); if ((lane & 31) >= o) incl += n; }
      base = (incl - tiles) * 256;
      const int cnt_e = lane < 32 ? (int)cnt[lane & 31] : 0; const int light = (tiles > 0 && cnt_e - 256 * (tiles - 1) <= 128) ? 1 : 0, full = tiles - light;
      int fincl = full, lincl = light;
#pragma unroll
      for (int o = 1; o < 32; o <<= 1) { const int n1 = __shfl_up(fincl, o), n2 = __shfl_up(lincl, o); if ((lane & 31) >= o) { fincl += n1; lincl += n2; } }
      const int ntiles = __shfl(incl, 31), nfull = __shfl(fincl, 31);
      if (blockIdx.x == 0 && F.wave == 0) { if (lane < 32) { for (int i = 0; i < tiles; ++i) OKP(int, WS_TILEEXP)[(base >> 8) + i] = lane;
              for (int i = 0; i < full; ++i) OKP(int, WS_TILEEXP)[512 + (fincl - full) + i] = (base >> 8) + i;
              if (light) OKP(int, WS_TILEEXP)[512 + nfull + (lincl - 1)] = ((base >> 8) + tiles - 1) | (1 << 16); }
          if (lane == 0) OKP(int, WS_TILEEXP)[1023] = ntiles; } }
    for (int a0 = gw * 4; a0 < T * 2; a0 += NGW * 4) {
        int slot[4]; u32x4 r0[4], r1[4];
#pragma unroll
        for (int k = 0; k < 4; ++k) { const int a = a0 + k; const int e = OKP(int, WS_EID)[a]; slot[k] = __shfl(base, e) + OKP(int, WS_POS)[a]; }
#pragma unroll
        for (int k = 0; k < 4; ++k) { const u32x4* src = (const u32x4*)(hb + (size_t)((a0 + k) >> 1) * DM) + lane; r0[k] = src[0]; r1[k] = src[64]; }
#pragma unroll
        for (int k = 0; k < 4; ++k) { const int a = a0 + k, t = a >> 1; u32x4* dst = (u32x4*)(OKP(bf16_t, WS_XS) + (size_t)slot[k] * DM) + lane; dst[0] = r0[k]; dst[64] = r1[k];
            if (lane == 0) { OKP(int, WS_TOKSLOT)[a] = slot[k]; OKP(float, WS_SLOTGATE)[slot[k]] = OKP(float, WS_GATEW)[a]; OKP(float, WS_SLOTRSTD)[slot[k]] = rstd_np(ssq, np, t); } } }
}

__device__ __forceinline__ void phase_combine(const Frame& F0, bf16_t* hb, float* ssq, bool final_layer) {
    using namespace sm;
    const Frame F = phase_frame(F0);
    const int lane = F.lane; const int gw = F.vcu * NWAVES + F.wave, NGW = F.G * NWAVES; const bf16_t* y = OKP(bf16_t, WS_Y);
    for (int t0 = gw * 2; t0 < T; t0 += NGW * 2) {
        int sa[2], sb[2];
#pragma unroll
        for (int k = 0; k < 2; ++k) { sa[k] = OKP(int, WS_TOKSLOT)[(t0 + k) * 2]; sb[k] = OKP(int, WS_TOKSLOT)[(t0 + k) * 2 + 1]; }
        u32x2 ra[2][4], rb[2][4], rh[2][4];
#pragma unroll
        for (int k = 0; k < 2; ++k) { const u32x2* hr = (const u32x2*)(hb + (size_t)(t0 + k) * DM) + lane; const u32x2* ya = (const u32x2*)(y + (size_t)sa[k] * DM) + lane; const u32x2* yb = (const u32x2*)(y + (size_t)sb[k] * DM) + lane;
#pragma unroll
            for (int j = 0; j < 4; ++j) { ra[k][j] = ya[64 * j]; rb[k][j] = yb[64 * j]; rh[k][j] = hr[64 * j]; } }
#pragma unroll
        for (int k = 0; k < 2; ++k) { const int t = t0 + k; u32x2* hr = (u32x2*)(hb + (size_t)t * DM) + lane; f32x4 v[4]; float s = 0.f;
#pragma unroll
            for (int j = 0; j < 4; ++j) { const u32x2 a = ra[k][j], b = rb[k][j], hw = rh[k][j]; f32x4 x;
                x[0] = bflo(hw.x) + (bflo(a.x) + bflo(b.x)); x[1] = bfhi(hw.x) + (bfhi(a.x) + bfhi(b.x)); x[2] = bflo(hw.y) + (bflo(a.y) + bflo(b.y)); x[3] = bfhi(hw.y) + (bfhi(a.y) + bfhi(b.y));
                if (!final_layer) { u32x2 w; w.x = cvt_pk_bf16(x[0], x[1]); w.y = cvt_pk_bf16(x[2], x[3]); hr[64 * j] = w; x = (f32x4){bflo(w.x), bfhi(w.x), bflo(w.y), bfhi(w.y)}; }
                v[j] = x; s += (x[0] * x[0] + x[1] * x[1]) + (x[2] * x[2] + x[3] * x[3]); }
            s = wave_sum(s);
            if (!final_layer) { if (lane == 0) ssq[t] = s; }
            else { const float rs = frsq(s * (1.f / DM) + EPS); f32x4* orow = (f32x4*)(F.out + (size_t)t * DM) + lane; const f32x4* gr = (const f32x4*)F.in[I_FINAL_NORM] + lane;
#pragma unroll
                for (int j = 0; j < 4; ++j) { const f32x4 g = gr[64 * j]; f32x4 o; o[0] = v[j][0] * rs * g[0]; o[1] = v[j][1] * rs * g[1]; o[2] = v[j][2] * rs * g[2]; o[3] = v[j][3] * rs * g[3]; orow[64 * j] = o; } } } }
}

#ifndef CPU_EMU
struct MoeOrder {
    static constexpr bool LIGHT = true;
    const char* A; const char* W; const int* tile_exp; size_t a_tstep, w_estride, w_off, w_tstep; int G, c;
    __device__ bool next(int i, pg8::Unit& u) const {
        const int Lx = i * G + c; const int ntiles = tile_exp[1023]; if (Lx >= ntiles * 4) return false;
        const int info = tile_exp[512 + (Lx >> 2)], tile = info & 0xffff; u.pm = tile; u.pn = Lx & 3; u.tag = info >> 16; const int e = tile_exp[tile];
        u.a = A + (size_t)tile * a_tstep; u.b = W + (size_t)e * w_estride + w_off + (size_t)u.pn * w_tstep; return true;
    }
    __device__ __forceinline__ void a_ready(const pg8::Unit&) const {}
    __device__ __forceinline__ void done(const pg8::Unit&) const {}
};
struct EpiSwiGLU {
    static constexpr bool PERM = false, AFTER_DRAIN = false;
    bf16_t* act; const float* slot_rstd;
    __device__ __forceinline__ void operator()(const f32x4 (&acc)[2][2][4][2], const pg8::Unit& u, int wr, int wc, int fr, int fq) const {
        const int row0 = u.pm * 256 + wr * 64 + fr, col0 = u.pn * 128 + wc * 16 + 4 * fq;
#pragma unroll
        for (int ai = 0; ai < 2; ++ai)
#pragma unroll
            for (int m = 0; m < 4; ++m) { const int row = row0 + ai * 128 + m * 16; const float rs = slot_rstd[row]; bf16_t* rowp = act + (size_t)row * 512 + col0;
#pragma unroll
                for (int bj = 0; bj < 2; ++bj) { const f32x4 g = acc[ai][bj][m][0] * rs, up = acc[ai][bj][m][1] * rs; f32x4 o;
#pragma unroll
                    for (int r = 0; r < 4; ++r) o[r] = g[r] * frcp(1.f + fexp(-g[r])) * up[r];
                    u32x2 w; w.x = cvt_pk_bf16(o[0], o[1]); w.y = cvt_pk_bf16(o[2], o[3]); *(u32x2*)(rowp + bj * 64) = w; } }
    }
};
struct EpiDown {
    static constexpr bool PERM = true, AFTER_DRAIN = false;
    bf16_t* y; const float* slot_gate;
    __device__ __forceinline__ void operator()(const f32x4 (&acc)[2][2][4][2], const pg8::Unit& u, int wr, int wc, int fr, int fq) const {
        const int row0 = u.pm * 256 + wr * 64 + fr, col0 = u.pn * 256 + wc * 32 + 8 * fq;
#pragma unroll
        for (int ai = 0; ai < 2; ++ai)
#pragma unroll
            for (int m = 0; m < 4; ++m) { const int row = row0 + ai * 128 + m * 16; const float s = slot_gate[row]; bf16_t* rowp = y + (size_t)row * DM + col0;
#pragma unroll
                for (int bj = 0; bj < 2; ++bj) { const f32x4 v0 = acc[ai][bj][m][0] * s, v1 = acc[ai][bj][m][1] * s; u32x4 w; w.x = cvt_pk_bf16(v0[0], v0[1]); w.y = cvt_pk_bf16(v0[2], v0[3]); w.z = cvt_pk_bf16(v1[0], v1[1]); w.w = cvt_pk_bf16(v1[2], v1[3]);
                    *(u32x4*)(rowp + bj * 128) = w; } }
    }
};
__device__ __forceinline__ void phase_moe_up(const Frame& F) {
    pg8::Gemm g{nullptr, nullptr, 0, 0, 1024};
    MoeOrder S{(const char*)OKP(bf16_t, WS_XS), (const char*)OKP(bf16_t, WS_MOEW), OKP(int, WS_TILEEXP), (size_t)256 * 1024 * 2, 3 * MiB, 0, (size_t)256 * 1024 * 2, F.G, (int)blockIdx.x};
    EpiSwiGLU E{OKP(bf16_t, WS_ACT), OKP(float, WS_SLOTRSTD)};
    pg8::gemm_phase<EpiSwiGLU, MoeOrder, true, true>(F.lds, g, S, E);
}
__device__ __forceinline__ void phase_moe_down(const Frame& F) {
    pg8::Gemm g{nullptr, nullptr, 0, 0, 512};
    MoeOrder S{(const char*)OKP(bf16_t, WS_ACT), (const char*)OKP(bf16_t, WS_MOEW), OKP(int, WS_TILEEXP), (size_t)256 * 512 * 2, 3 * MiB, 2 * MiB, (size_t)256 * 512 * 2, F.G, (int)blockIdx.x};
    EpiDown E{OKP(bf16_t, WS_Y), OKP(float, WS_SLOTGATE)};
    pg8::gemm_phase<EpiDown, MoeOrder, true, true>(F.lds, g, S, E);
}
#endif
}

#ifndef DUP_MASK
#define DUP_MASK 0
#endif
namespace ok {
constexpr size_t WS_GU = 160 * MiB, WS_GW = 192 * MiB, WS_GQD = 224 * MiB, WS_GKDT = 480 * MiB, WS_GAQK = 512 * MiB;
constexpr size_t WS_GDEC = WS_GCS;
constexpr size_t WS_OBUF = WS_H;
constexpr int G_LD = 132, GB_LD = 136, LM_LD = 68;
__device__ __forceinline__ float sigmoidf_(float x) { return frcp(1.f + fexp(-x)); }

template <int PARTS  > __device__ __forceinline__ void phase_gdn_prep_t(const Frame& F0) {
    using namespace sm;
    const Frame F = phase_frame(F0);
    LAS float* q_s = (LAS float*)F.lds; LAS float* k_s = (LAS float*)(F.lds + 33792); LAS float* v_s = (LAS float*)(F.lds + 67584);
    LAS bf16_t* Kn = (LAS bf16_t*)(F.lds + 101376); LAS bf16_t* Qn = (LAS bf16_t*)(F.lds + 118784);
    LAS float* g_s = (LAS float*)(F.lds + 136192); LAS float* beta_s = g_s + 64; LAS float* gc_s = g_s + 128; LAS float* eg_s = g_s + 192; LAS float* rq_s = g_s + 256; LAS float* rk_s = g_s + 320;
    LAS float* Lm = q_s;
    const int tid = F.tid, lane = F.lane, wave = F.wave, fr = lane & 15, fq = lane >> 4;
    const bf16_t* proj = OKP(bf16_t, WS_PROJ); const float* cw = F.in[I_OD_CONV];
    for (int u = F.vcu; u < NB * NCH * 8; u += F.G) {
        const int hd = u & 7, bc = u >> 3, b = bc / NCH, c = bc % NCH; const size_t row0 = (size_t)b * L + c * 64; const size_t ub = (size_t)bc * 8 + hd;
        LDS_BARRIER();
        if ((PARTS & 1) && tid < 384) { const int which = tid >> 7, d = tid & 127, xc = which * 1024 + hd * 128 + d; LAS float* dst = (which == 0 ? q_s : which == 1 ? k_s : v_s) + d;
            const float w0 = cw[xc], w1 = cw[3072 + xc], w2 = cw[6144 + xc], w3 = cw[9216 + xc]; const bf16_t* p = proj + row0 * PROJ1_LD + xc;
            float x0 = 0.f, x1 = 0.f, x2 = 0.f; if (c > 0) { x0 = bf2f(p[-3 * PROJ1_LD]); x1 = bf2f(p[-2 * PROJ1_LD]); x2 = bf2f(p[-PROJ1_LD]); }
            unsigned short raw[64];
#pragma unroll
            for (int t = 0; t < 64; ++t) raw[t] = p[(size_t)t * PROJ1_LD];
#pragma unroll
            for (int t = 0; t < 64; ++t) { const float x3 = bf2f(raw[t]); const float v = w0 * x0 + w1 * x1 + w2 * x2 + w3 * x3; dst[t * G_LD] = siluf(v); x0 = x1; x1 = x2; x2 = x3; } }
        if ((PARTS & 1) && tid >= 448) { const int t = tid - 448; const float* r16 = OKP(float, WS_RAW16) + (row0 + t) * 16;
            g_s[t] = -expf(F.in[I_OD_ALOG][hd]) * softplusf(r16[hd] + F.in[I_OD_DTB][hd]); beta_s[t] = sigmoidf_(r16[8 + hd]); }
        LDS_BARRIER();
        if (!(PARTS & 1)) {} else if (wave == 0) { float v = g_s[lane];
#pragma unroll
            for (int o = 1; o < 64; o <<= 1) { const float n = __shfl_up(v, o); if (lane >= o) v += n; }
            gc_s[lane] = v; eg_s[lane] = fexp(v); if (lane == 63) OKP(float, WS_GDEC)[ub] = fexp(v); }
        else if (wave <= 2) { const LAS float* src = (wave == 1 ? q_s : k_s) + lane * G_LD; float s = 0.f;
#pragma unroll 8
            for (int d = 0; d < 128; d += 4) { const f32x4 x = *(const LAS f32x4*)(src + d); s += (x.x * x.x + x.y * x.y) + (x.z * x.z + x.w * x.w); }
            const float r = frsq(s + EPS); if (wave == 1) rq_s[lane] = r * 0.08838834764831845f; else rk_s[lane] = r; }
        LDS_BARRIER();
        if (PARTS & 2)
        { const float gl = gc_s[63];
          for (int i = tid; i < 64 * 64; i += NT) { const int t = i >> 6, dp = (i & 63) * 2; const float rk = rk_s[t], rq = rq_s[t], eg = eg_s[t];
              const float k0 = k_s[t * G_LD + dp] * rk, k1 = k_s[t * G_LD + dp + 1] * rk, q0 = q_s[t * G_LD + dp] * rq, q1 = q_s[t * G_LD + dp + 1] * rq;
              *(LAS unsigned*)(Kn + t * GB_LD + dp) = cvt_pk_bf16(k0, k1); *(LAS unsigned*)(Qn + t * GB_LD + dp) = cvt_pk_bf16(q0, q1);
              *(unsigned*)(OKP(bf16_t, WS_GQD) + ub * 8192 + t * 128 + dp) = cvt_pk_bf16(q0 * eg, q1 * eg); }
          { const int t = tid & 63, dg = tid >> 6; const float f = rk_s[t] * fexp(gl - gc_s[t]); bf16_t* dst = OKP(bf16_t, WS_GKDT) + ub * 8192 + t;
#pragma unroll
            for (int j = 0; j < 16; ++j) { const int d = dg * 16 + j; dst[d * 64] = (bf16_t)(cvt_pk_bf16(k_s[t * G_LD + d] * f, 0.f) & 0xffffu); } } }
        LDS_BARRIER();
        if (PARTS & 4)
#pragma unroll
        for (int i = 0; i < 4; ++i) { const int tl = wave * 4 + i, which = tl >> 4, ti = (tl >> 2) & 3, si = tl & 3;
            f32x4 acc = {0.f, 0.f, 0.f, 0.f};
            if (si <= ti) {
#pragma unroll
                for (int ks = 0; ks < 4; ++ks) { const bf16x8 a = *(const LAS bf16x8*)(Kn + (si * 16 + fr) * GB_LD + ks * 32 + fq * 8); const bf16x8 bb = *(const LAS bf16x8*)((which ? Qn : Kn) + (ti * 16 + fr) * GB_LD + ks * 32 + fq * 8); acc = mfma16(a, bb, acc); }
                const int t = ti * 16 + fr; const float gt = gc_s[t], bt = beta_s[t];
#pragma unroll
                for (int r = 0; r < 4; ++r) { const int s = si * 16 + 4 * fq + r; const float dec = fexp(gt - gc_s[s]); acc[r] = which ? (s <= t ? acc[r] * dec : 0.f) : (s < t ? acc[r] * dec * bt : 0.f); } }
            const int t = ti * 16 + fr, s0 = si * 16 + 4 * fq;
            if (which) { u32x2 w; w.x = cvt_pk_bf16(acc[0], acc[1]); w.y = cvt_pk_bf16(acc[2], acc[3]); *(u32x2*)(OKP(bf16_t, WS_GAQK) + ub * 4096 + t * 64 + s0) = w; }
            else { Lm[(s0 + 0) * LM_LD + t] = acc[0]; Lm[(s0 + 1) * LM_LD + t] = acc[1]; Lm[(s0 + 2) * LM_LD + t] = acc[2]; Lm[(s0 + 3) * LM_LD + t] = acc[3]; } }
        LDS_BARRIER();
        if ((PARTS & 8) && tid < 256) { const int cidx = tid & 127; const bool isw = tid >= 128; const LAS float* col = (isw ? k_s : v_s) + cidx; bf16_t* dst = OKP(bf16_t, isw ? WS_GW : WS_GU) + ub * 8192 + (isw ? cidx : cidx * 4);
            const LAS float* LmL = Lm; const LAS float* bsL = beta_s;
#ifndef CPU_EMU
            asm volatile("" : "+v"(col), "+v"(LmL), "+v"(bsL));
#endif
            float x[64]; f32x4 Lb[2][8];
#define GL(buf, row0, col0) do { _Pragma("unroll") for (int i_ = 0; i_ < 2; ++i_) { _Pragma("unroll") for (int q_ = 0; q_ < 4; ++q_) Lb[buf][i_ * 4 + q_] = *(const LAS f32x4*)(LmL + ((row0) + i_) * LM_LD + (col0) + q_ * 4); } } while (0)
#ifdef CPU_EMU
#define GPIN() do {} while (0)
#else
#define GPIN() asm volatile("" : "+v"(a[0]), "+v"(a[1]), "+v"(a[2]), "+v"(a[3]), "+v"(a[4]), "+v"(a[5]), "+v"(a[6]), "+v"(a[7]), "+v"(a[8]), "+v"(a[9]), "+v"(a[10]), "+v"(a[11]), "+v"(a[12]), "+v"(a[13]), "+v"(a[14]), "+v"(a[15]), "+v"(LmL))
#endif
            { float a[16];
            GL(0, 0, 0);
#pragma unroll
            for (int tt = 0; tt < 16; ++tt) { const int t = 0 + tt; float v = col[t * G_LD] * bsL[t]; if (isw) v *= bsL[256 + t] * bsL[128 + t]; a[tt] = v; }
            GL(1, 2, 0);
#pragma unroll
            for (int i = 0; i < 2; ++i) { const int ss = 0 + i; const float xv = a[ss]; x[0 + ss] = xv; if (isw) dst[(0 + ss) * 128] = (bf16_t)(cvt_pk_bf16(xv, 0.f) & 0xffffu);
#pragma unroll
                for (int q4 = 0; q4 < 4; ++q4)
#pragma unroll
                    for (int r = 0; r < 4; ++r) if (q4 * 4 + r > ss) a[q4 * 4 + r] -= Lb[0][i * 4 + q4][r] * xv; }
            GPIN();
            GL(0, 4, 0);
#pragma unroll
            for (int i = 0; i < 2; ++i) { const int ss = 2 + i; const float xv = a[ss]; x[0 + ss] = xv; if (isw) dst[(0 + ss) * 128] = (bf16_t)(cvt_pk_bf16(xv, 0.f) & 0xffffu);
#pragma unroll
                for (int q4 = 0; q4 < 4; ++q4)
#pragma unroll
                    for (int r = 0; r < 4; ++r) if (q4 * 4 + r > ss) a[q4 * 4 + r] -= Lb[1][i * 4 + q4][r] * xv; }
            GPIN();
            GL(1, 6, 0);
#pragma unroll
            for (int i = 0; i < 2; ++i) { const int ss = 4 + i; const float xv = a[ss]; x[0 + ss] = xv; if (isw) dst[(0 + ss) * 128] = (bf16_t)(cvt_pk_bf16(xv, 0.f) & 0xffffu);
#pragma unroll
                for (int q4 = 0; q4 < 4; ++q4)
#pragma unroll
                    for (int r = 0; r < 4; ++r) if (q4 * 4 + r > ss) a[q4 * 4 + r] -= Lb[0][i * 4 + q4][r] * xv; }
            GPIN();
            GL(0, 8, 0);
#pragma unroll
            for (int i = 0; i < 2; ++i) { const int ss = 6 + i; const float xv = a[ss]; x[0 + ss] = xv; if (isw) dst[(0 + ss) * 128] = (bf16_t)(cvt_pk_bf16(xv, 0.f) & 0xffffu);
#pragma unroll
                for (int q4 = 0; q4 < 4; ++q4)
#pragma unroll
                    for (int r = 0; r < 4; ++r) if (q4 * 4 + r > ss) a[q4 * 4 + r] -= Lb[1][i * 4 + q4][r] * xv; }
            GPIN();
            GL(1, 10, 0);
#pragma unroll
            for (int i = 0; i < 2; ++i) { const int ss = 8 + i; const float xv = a[ss]; x[0 + ss] = xv; if (isw) dst[(0 + ss) * 128] = (bf16_t)(cvt_pk_bf16(xv, 0.f) & 0xffffu);
#pragma unroll
                for (int q4 = 0; q4 < 4; ++q4)
#pragma unroll
                    for (int r = 0; r < 4; ++r) if (q4 * 4 + r > ss) a[q4 * 4 + r] -= Lb[0][i * 4 + q4][r] * xv; }
            GPIN();
            GL(0, 12, 0);
#pragma unroll
            for (int i = 0; i < 2; ++i) { const int ss = 10 + i; const float xv = a[ss]; x[0 + ss] = xv; if (isw) dst[(0 + ss) * 128] = (bf16_t)(cvt_pk_bf16(xv, 0.f) & 0xffffu);
#pragma unroll
                for (int q4 = 0; q4 < 4; ++q4)
#pragma unroll
                    for (int r = 0; r < 4; ++r) if (q4 * 4 + r > ss) a[q4 * 4 + r] -= Lb[1][i * 4 + q4][r] * xv; }
            GPIN();
            GL(1, 14, 0);
#pragma unroll
            for (int i = 0; i < 2; ++i) { const int ss = 12 + i; const float xv = a[ss]; x[0 + ss] = xv; if (isw) dst[(0 + ss) * 128] = (bf16_t)(cvt_pk_bf16(xv, 0.f) & 0xffffu);
#pragma unroll
                for (int q4 = 0; q4 < 4; ++q4)
#pragma unroll
                    for (int r = 0; r < 4; ++r) if (q4 * 4 + r > ss) a[q4 * 4 + r] -= Lb[0][i * 4 + q4][r] * xv; }
            GPIN();
            GL(0, 0, 16);
#pragma unroll
            for (int i = 0; i < 2; ++i) { const int ss = 14 + i; const float xv = a[ss]; x[0 + ss] = xv; if (isw) dst[(0 + ss) * 128] = (bf16_t)(cvt_pk_bf16(xv, 0.f) & 0xffffu);
#pragma unroll
                for (int q4 = 0; q4 < 4; ++q4)
#pragma unroll
                    for (int r = 0; r < 4; ++r) if (q4 * 4 + r > ss) a[q4 * 4 + r] -= Lb[1][i * 4 + q4][r] * xv; }
            if (!isw) {
#pragma unroll
                for (int q4 = 0; q4 < 4; ++q4) { u32x2 w; w.x = cvt_pk_bf16(a[q4 * 4], a[q4 * 4 + 1]); w.y = cvt_pk_bf16(a[q4 * 4 + 2], a[q4 * 4 + 3]); *(u32x2*)(dst + (size_t)(0 + q4) * 512) = w; } }
            GPIN();
#pragma unroll
            for (int tt = 0; tt < 16; ++tt) { const int t = 16 + tt; float v = col[t * G_LD] * bsL[t]; if (isw) v *= bsL[256 + t] * bsL[128 + t]; a[tt] = v; }
            GL(1, 2, 16);
#pragma unroll
            for (int i = 0; i < 2; ++i) { const float xs = x[0 + i];
#pragma unroll
                for (int q4 = 0; q4 < 4; ++q4)
#pragma unroll
                    for (int r = 0; r < 4; ++r) a[q4 * 4 + r] -= Lb[0][i * 4 + q4][r] * xs; }
            GPIN();
            GL(0, 4, 16);
#pragma unroll
            for (int i = 0; i < 2; ++i) { const float xs = x[2 + i];
#pragma unroll
                for (int q4 = 0; q4 < 4; ++q4)
#pragma unroll
                    for (int r = 0; r < 4; ++r) a[q4 * 4 + r] -= Lb[1][i * 4 + q4][r] * xs; }
            GPIN();
            GL(1, 6, 16);
#pragma unroll
            for (int i = 0; i < 2; ++i) { const float xs = x[4 + i];
#pragma unroll
                for (int q4 = 0; q4 < 4; ++q4)
#pragma unroll
                    for (int r = 0; r < 4; ++r) a[q4 * 4 + r] -= Lb[0][i * 4 + q4][r] * xs; }
            GPIN();
            GL(0, 8, 16);
#pragma unroll
            for (int i = 0; i < 2; ++i) { const float xs = x[6 + i];
#pragma unroll
                for (int q4 = 0; q4 < 4; ++q4)
#pragma unroll
                    for (int r = 0; r < 4; ++r) a[q4 * 4 + r] -= Lb[1][i * 4 + q4][r] * xs; }
            GPIN();
            GL(1, 10, 16);
#pragma unroll
            for (int i = 0; i < 2; ++i) { const float xs = x[8 + i];
#pragma unroll
                for (int q4 = 0; q4 < 4; ++q4)
#pragma unroll
                    for (int r = 0; r < 4; ++r) a[q4 * 4 + r] -= Lb[0][i * 4 + q4][r] * xs; }
            GPIN();
            GL(0, 12, 16);
#pragma unroll
            for (int i = 0; i < 2; ++i) { const float xs = x[10 + i];
#pragma unroll
                for (int q4 = 0; q4 < 4; ++q4)
#pragma unroll
                    for (int r = 0; r < 4; ++r) a[q4 * 4 + r] -= Lb[1][i * 4 + q4][r] * xs; }
            GPIN();
            GL(1, 14, 16);
#pragma unroll
            for (int i = 0; i < 2; ++i) { const float xs = x[12 + i];
#pragma unroll
                for (int q4 = 0; q4 < 4; ++q4)
#pragma unroll
                    for (int r = 0; r < 4; ++r) a[q4 * 4 + r] -= Lb[0][i * 4 + q4][r] * xs; }
            GPIN();
            GL(0, 16, 16);
#pragma unroll
            for (int i = 0; i < 2; ++i) { const float xs = x[14 + i];
#pragma unroll
                for (int q4 = 0; q4 < 4; ++q4)
#pragma unroll
                    for (int r = 0; r < 4; ++r) a[q4 * 4 + r] -= Lb[1][i * 4 + q4][r] * xs; }
            GPIN();
            GL(1, 18, 16);
#pragma unroll
            for (int i = 0; i < 2; ++i) { const int ss = 0 + i; const float xv = a[ss]; x[16 + ss] = xv; if (isw) dst[(16 + ss) * 128] = (bf16_t)(cvt_pk_bf16(xv, 0.f) & 0xffffu);
#pragma unroll
                for (int q4 = 0; q4 < 4; ++q4)
#pragma unroll
                    for (int r = 0; r < 4; ++r) if (q4 * 4 + r > ss) a[q4 * 4 + r] -= Lb[0][i * 4 + q4][r] * xv; }
            GPIN();
            GL(0, 20, 16);
#pragma unroll
            for (int i = 0; i < 2; ++i) { const int ss = 2 + i; const float xv = a[ss]; x[16 + ss] = xv; if (isw) dst[(16 + ss) * 128] = (bf16_t)(cvt_pk_bf16(xv, 0.f) & 0xffffu);
#pragma unroll
                for (int q4 = 0; q4 < 4; ++q4)
#pragma unroll
                    for (int r = 0; r < 4; ++r) if (q4 * 4 + r > ss) a[q4 * 4 + r] -= Lb[1][i * 4 + q4][r] * xv; }
            GPIN();
            GL(1, 22, 16);
#pragma unroll
            for (int i = 0; i < 2; ++i) { const int ss = 4 + i; const float xv = a[ss]; x[16 + ss] = xv; if (isw) dst[(16 + ss) * 128] = (bf16_t)(cvt_pk_bf16(xv, 0.f) & 0xffffu);
#pragma unroll
                for (int q4 = 0; q4 < 4; ++q4)
#pragma unroll
                    for (int r = 0; r < 4; ++r) if (q4 * 4 + r > ss) a[q4 * 4 + r] -= Lb[0][i * 4 + q4][r] * xv; }
            GPIN();
            GL(0, 24, 16);
#pragma unroll
            for (int i = 0; i < 2; ++i) { const int ss = 6 + i; const float xv = a[ss]; x[16 + ss] = xv; if (isw) dst[(16 + ss) * 128] = (bf16_t)(cvt_pk_bf16(xv, 0.f) & 0xffffu);
#pragma unroll
                for (int q4 = 0; q4 < 4; ++q4)
#pragma unroll
                    for (int r = 0; r < 4; ++r) if (q4 * 4 + r > ss) a[q4 * 4 + r] -= Lb[1][i * 4 + q4][r] * xv; }
            GPIN();
            GL(1, 26, 16);
#pragma unroll
            for (int i = 0; i < 2; ++i) { const int ss = 8 + i; const float xv = a[ss]; x[16 + ss] = xv; if (isw) dst[(16 + ss) * 128] = (bf16_t)(cvt_pk_bf16(xv, 0.f) & 0xffffu);
#pragma unroll
                for (int q4 = 0; q4 < 4; ++q4)
#pragma unroll
                    for (int r = 0; r < 4; ++r) if (q4 * 4 + r > ss) a[q4 * 4 + r] -= Lb[0][i * 4 + q4][r] * xv; }
            GPIN();
            GL(0, 28, 16);
#pragma unroll
            for (int i = 0; i < 2; ++i) { const int ss = 10 + i; const float xv = a[ss]; x[16 + ss] = xv; if (isw) dst[(16 + ss) * 128] = (bf16_t)(cvt_pk_bf16(xv, 0.f) & 0xffffu);
#pragma unroll
                for (int q4 = 0; q4 < 4; ++q4)
#pragma unroll
                    for (int r = 0; r < 4; ++r) if (q4 * 4 + r > ss) a[q4 * 4 + r] -= Lb[1][i * 4 + q4][r] * xv; }
            GPIN();
            GL(1, 30, 16);
#pragma unroll
            for (int i = 0; i < 2; ++i) { const int ss = 12 + i; const float xv = a[ss]; x[16 + ss] = xv; if (isw) dst[(16 + ss) * 128] = (bf16_t)(cvt_pk_bf16(xv, 0.f) & 0xffffu);
#pragma unroll
                for (int q4 = 0; q4 < 4; ++q4)
#pragma unroll
                    for (int r = 0; r < 4; ++r) if (q4 * 4 + r > ss) a[q4 * 4 + r] -= Lb[0][i * 4 + q4][r] * xv; }
            GPIN();
            GL(0, 0, 32);
#pragma unroll
            for (int i = 0; i < 2; ++i) { const int ss = 14 + i; const float xv = a[ss]; x[16 + ss] = xv; if (isw) dst[(16 + ss) * 128] = (bf16_t)(cvt_pk_bf16(xv, 0.f) & 0xffffu);
#pragma unroll
                for (int q4 = 0; q4 < 4; ++q4)
#pragma unroll
                    for (int r = 0; r < 4; ++r) if (q4 * 4 + r > ss) a[q4 * 4 + r] -= Lb[1][i * 4 + q4][r] * xv; }
            if (!isw) {
#pragma unroll
                for (int q4 = 0; q4 < 4; ++q4) { u32x2 w; w.x = cvt_pk_bf16(a[q4 * 4], a[q4 * 4 + 1]); w.y = cvt_pk_bf16(a[q4 * 4 + 2], a[q4 * 4 + 3]); *(u32x2*)(dst + (size_t)(4 + q4) * 512) = w; } }
            GPIN();
#pragma unroll
            for (int tt = 0; tt < 16; ++tt) { const int t = 32 + tt; float v = col[t * G_LD] * bsL[t]; if (isw) v *= bsL[256 + t] * bsL[128 + t]; a[tt] = v; }
            GL(1, 2, 32);
#pragma unroll
            for (int i = 0; i < 2; ++i) { const float xs = x[0 + i];
#pragma unroll
                for (int q4 = 0; q4 < 4; ++q4)
#pragma unroll
                    for (int r = 0; r < 4; ++r) a[q4 * 4 + r] -= Lb[0][i * 4 + q4][r] * xs; }
            GPIN();
            GL(0, 4, 32);
#pragma unroll
            for (int i = 0; i < 2; ++i) { const float xs = x[2 + i];
#pragma unroll
                for (int q4 = 0; q4 < 4; ++q4)
#pragma unroll
                    for (int r = 0; r < 4; ++r) a[q4 * 4 + r] -= Lb[1][i * 4 + q4][r] * xs; }
            GPIN();
            GL(1, 6, 32);
#pragma unroll
            for (int i = 0; i < 2; ++i) { const float xs = x[4 + i];
#pragma unroll
                for (int q4 = 0; q4 < 4; ++q4)
#pragma unroll
                    for (int r = 0; r < 4; ++r) a[q4 * 4 + r] -= Lb[0][i * 4 + q4][r] * xs; }
            GPIN();
            GL(0, 8, 32);
#pragma unroll
            for (int i = 0; i < 2; ++i) { const float xs = x[6 + i];
#pragma unroll
                for (int q4 = 0; q4 < 4; ++q4)
#pragma unroll
                    for (int r = 0; r < 4; ++r) a[q4 * 4 + r] -= Lb[1][i * 4 + q4][r] * xs; }
            GPIN();
            GL(1, 10, 32);
#pragma unroll
            for (int i = 0; i < 2; ++i) { const float xs = x[8 + i];
#pragma unroll
                for (int q4 = 0; q4 < 4; ++q4)
#pragma unroll
                    for (int r = 0; r < 4; ++r) a[q4 * 4 + r] -= Lb[0][i * 4 + q4][r] * xs; }
            GPIN();
            GL(0, 12, 32);
#pragma unroll
            for (int i = 0; i < 2; ++i) { const float xs = x[10 + i];
#pragma unroll
                for (int q4 = 0; q4 < 4; ++q4)
#pragma unroll
                    for (int r = 0; r < 4; ++r) a[q4 * 4 + r] -= Lb[1][i * 4 + q4][r] * xs; }
            GPIN();
            GL(1, 14, 32);
#pragma unroll
            for (int i = 0; i < 2; ++i) { const float xs = x[12 + i];
#pragma unroll
                for (int q4 = 0; q4 < 4; ++q4)
#pragma unroll
                    for (int r = 0; r < 4; ++r) a[q4 * 4 + r] -= Lb[0][i * 4 + q4][r] * xs; }
            GPIN();
            GL(0, 16, 32);
#pragma unroll
            for (int i = 0; i < 2; ++i) { const float xs = x[14 + i];
#pragma unroll
                for (int q4 = 0; q4 < 4; ++q4)
#pragma unroll
                    for (int r = 0; r < 4; ++r) a[q4 * 4 + r] -= Lb[1][i * 4 + q4][r] * xs; }
            GPIN();
            GL(1, 18, 32);
#pragma unroll
            for (int i = 0; i < 2; ++i) { const float xs = x[16 + i];
#pragma unroll
                for (int q4 = 0; q4 < 4; ++q4)
#pragma unroll
                    for (int r = 0; r < 4; ++r) a[q4 * 4 + r] -= Lb[0][i * 4 + q4][r] * xs; }
            GPIN();
            GL(0, 20, 32);
#pragma unroll
            for (int i = 0; i < 2; ++i) { const float xs = x[18 + i];
#pragma unroll
                for (int q4 = 0; q4 < 4; ++q4)
#pragma unroll
                    for (int r = 0; r < 4; ++r) a[q4 * 4 + r] -= Lb[1][i * 4 + q4][r] * xs; }
            GPIN();
            GL(1, 22, 32);
#pragma unroll
            for (int i = 0; i < 2; ++i) { const float xs = x[20 + i];
#pragma unroll
                for (int q4 = 0; q4 < 4; ++q4)
#pragma unroll
                    for (int r = 0; r < 4; ++r) a[q4 * 4 + r] -= Lb[0][i * 4 + q4][r] * xs; }
            GPIN();
            GL(0, 24, 32);
#pragma unroll
            for (int i = 0; i < 2; ++i) { const float xs = x[22 + i];
#pragma unroll
                for (int q4 = 0; q4 < 4; ++q4)
#pragma unroll
                    for (int r = 0; r < 4; ++r) a[q4 * 4 + r] -= Lb[1][i * 4 + q4][r] * xs; }
            GPIN();
            GL(1, 26, 32);
#pragma unroll
            for (int i = 0; i < 2; ++i) { const float xs = x[24 + i];
#pragma unroll
                for (int q4 = 0; q4 < 4; ++q4)
#pragma unroll
                    for (int r = 0; r < 4; ++r) a[q4 * 4 + r] -= Lb[0][i * 4 + q4][r] * xs; }
            GPIN();
            GL(0, 28, 32);
#pragma unroll
            for (int i = 0; i < 2; ++i) { const float xs = x[26 + i];
#pragma unroll
                for (int q4 = 0; q4 < 4; ++q4)
#pragma unroll
                    for (int r = 0; r < 4; ++r) a[q4 * 4 + r] -= Lb[1][i * 4 + q4][r] * xs; }
            GPIN();
            GL(1, 30, 32);
#pragma unroll
            for (int i = 0; i < 2; ++i) { const float xs = x[28 + i];
#pragma unroll
                for (int q4 = 0; q4 < 4; ++q4)
#pragma unroll
                    for (int r = 0; r < 4; ++r) a[q4 * 4 + r] -= Lb[0][i * 4 + q4][r] * xs; }
            GPIN();
            GL(0, 32, 32);
#pragma unroll
            for (int i = 0; i < 2; ++i) { const float xs = x[30 + i];
#pragma unroll
                for (int q4 = 0; q4 < 4; ++q4)
#pragma unroll
                    for (int r = 0; r < 4; ++r) a[q4 * 4 + r] -= Lb[1][i * 4 + q4][r] * xs; }
            GPIN();
            GL(1, 34, 32);
#pragma unroll
            for (int i = 0; i < 2; ++i) { const int ss = 0 + i; const float xv = a[ss]; x[32 + ss] = xv; if (isw) dst[(32 + ss) * 128] = (bf16_t)(cvt_pk_bf16(xv, 0.f) & 0xffffu);
#pragma unroll
                for (int q4 = 0; q4 < 4; ++q4)
#pragma unroll
                    for (int r = 0; r < 4; ++r) if (q4 * 4 + r > ss) a[q4 * 4 + r] -= Lb[0][i * 4 + q4][r] * xv; }
            GPIN();
            GL(0, 36, 32);
#pragma unroll
            for (int i = 0; i < 2; ++i) { const int ss = 2 + i; const float xv = a[ss]; x[32 + ss] = xv; if (isw) dst[(32 + ss) * 128] = (bf16_t)(cvt_pk_bf16(xv, 0.f) & 0xffffu);
#pragma unroll
                for (int q4 = 0; q4 < 4; ++q4)
#pragma unroll
                    for (int r = 0; r < 4; ++r) if (q4 * 4 + r > ss) a[q4 * 4 + r] -= Lb[1][i * 4 + q4][r] * xv; }
            GPIN();
            GL(1, 38, 32);
#pragma unroll
            for (int i = 0; i < 2; ++i) { const int ss = 4 + i; const float xv = a[ss]; x[32 + ss] = xv; if (isw) dst[(32 + ss) * 128] = (bf16_t)(cvt_pk_bf16(xv, 0.f) & 0xffffu);
#pragma unroll
                for (int q4 = 0; q4 < 4; ++q4)
#pragma unroll
                    for (int r = 0; r < 4; ++r) if (q4 * 4 + r > ss) a[q4 * 4 + r] -= Lb[0][i * 4 + q4][r] * xv; }
            GPIN();
            GL(0, 40, 32);
#pragma unroll
            for (int i = 0; i < 2; ++i) { const int ss = 6 + i; const float xv = a[ss]; x[32 + ss] = xv; if (isw) dst[(32 + ss) * 128] = (bf16_t)(cvt_pk_bf16(xv, 0.f) & 0xffffu);
#pragma unroll
                for (int q4 = 0; q4 < 4; ++q4)
#pragma unroll
                    for (int r = 0; r < 4; ++r) if (q4 * 4 + r > ss) a[q4 * 4 + r] -= Lb[1][i * 4 + q4][r] * xv; }
            GPIN();
            GL(1, 42, 32);
#pragma unroll
            for (int i = 0; i < 2; ++i) { const int ss = 8 + i; const float xv = a[ss]; x[32 + ss] = xv; if (isw) dst[(32 + ss) * 128] = (bf16_t)(cvt_pk_bf16(xv, 0.f) & 0xffffu);
#pragma unroll
                for (int q4 = 0; q4 < 4; ++q4)
#pragma unroll
                    for (int r = 0; r < 4; ++r) if (q4 * 4 + r > ss) a[q4 * 4 + r] -= Lb[0][i * 4 + q4][r] * xv; }
            GPIN();
            GL(0, 44, 32);
#pragma unroll
            for (int i = 0; i < 2; ++i) { const int ss = 10 + i; const float xv = a[ss]; x[32 + ss] = xv; if (isw) dst[(32 + ss) * 128] = (bf16_t)(cvt_pk_bf16(xv, 0.f) & 0xffffu);
#pragma unroll
                for (int q4 = 0; q4 < 4; ++q4)
#pragma unroll
                    for (int r = 0; r < 4; ++r) if (q4 * 4 + r > ss) a[q4 * 4 + r] -= Lb[1][i * 4 + q4][r] * xv; }
            GPIN();
            GL(1, 46, 32);
#pragma unroll
            for (int i = 0; i < 2; ++i) { const int ss = 12 + i; const float xv = a[ss]; x[32 + ss] = xv; if (isw) dst[(32 + ss) * 128] = (bf16_t)(cvt_pk_bf16(xv, 0.f) & 0xffffu);
#pragma unroll
                for (int q4 = 0; q4 < 4; ++q4)
#pragma unroll
                    for (int r = 0; r < 4; ++r) if (q4 * 4 + r > ss) a[q4 * 4 + r] -= Lb[0][i * 4 + q4][r] * xv; }
            GPIN();
            GL(0, 0, 48);
#pragma unroll
            for (int i = 0; i < 2; ++i) { const int ss = 14 + i; const float xv = a[ss]; x[32 + ss] = xv; if (isw) dst[(32 + ss) * 128] = (bf16_t)(cvt_pk_bf16(xv, 0.f) & 0xffffu);
#pragma unroll
                for (int q4 = 0; q4 < 4; ++q4)
#pragma unroll
                    for (int r = 0; r < 4; ++r) if (q4 * 4 + r > ss) a[q4 * 4 + r] -= Lb[1][i * 4 + q4][r] * xv; }
            if (!isw) {
#pragma unroll
                for (int q4 = 0; q4 < 4; ++q4) { u32x2 w; w.x = cvt_pk_bf16(a[q4 * 4], a[q4 * 4 + 1]); w.y = cvt_pk_bf16(a[q4 * 4 + 2], a[q4 * 4 + 3]); *(u32x2*)(dst + (size_t)(8 + q4) * 512) = w; } }
            GPIN();
#pragma unroll
            for (int tt = 0; tt < 16; ++tt) { const int t = 48 + tt; float v = col[t * G_LD] * bsL[t]; if (isw) v *= bsL[256 + t] * bsL[128 + t]; a[tt] = v; }
            GL(1, 2, 48);
#pragma unroll
            for (int i = 0; i < 2; ++i) { const float xs = x[0 + i];
#pragma unroll
                for (int q4 = 0; q4 < 4; ++q4)
#pragma unroll
                    for (int r = 0; r < 4; ++r) a[q4 * 4 + r] -= Lb[0][i * 4 + q4][r] * xs; }
            GPIN();
            GL(0, 4, 48);
#pragma unroll
            for (int i = 0; i < 2; ++i) { const float xs = x[2 + i];
#pragma unroll
                for (int q4 = 0; q4 < 4; ++q4)
#pragma unroll
                    for (int r = 0; r < 4; ++r) a[q4 * 4 + r] -= Lb[1][i * 4 + q4][r] * xs; }
            GPIN();
            GL(1, 6, 48);
#pragma unroll
            for (int i = 0; i < 2; ++i) { const float xs = x[4 + i];
#pragma unroll
                for (int q4 = 0; q4 < 4; ++q4)
#pragma unroll
                    for (int r = 0; r < 4; ++r) a[q4 * 4 + r] -= Lb[0][i * 4 + q4][r] * xs; }
            GPIN();
            GL(0, 8, 48);
#pragma unroll
            for (int i = 0; i < 2; ++i) { const float xs = x[6 + i];
#pragma unroll
                for (int q4 = 0; q4 < 4; ++q4)
#pragma unroll
                    for (int r = 0; r < 4; ++r) a[q4 * 4 + r] -= Lb[1][i * 4 + q4][r] * xs; }
            GPIN();
            GL(1, 10, 48);
#pragma unroll
            for (int i = 0; i < 2; ++i) { const float xs = x[8 + i];
#pragma unroll
                for (int q4 = 0; q4 < 4; ++q4)
#pragma unroll
                    for (int r = 0; r < 4; ++r) a[q4 * 4 + r] -= Lb[0][i * 4 + q4][r] * xs; }
            GPIN();
            GL(0, 12, 48);
#pragma unroll
            for (int i = 0; i < 2; ++i) { const float xs = x[10 + i];
#pragma unroll
                for (int q4 = 0; q4 < 4; ++q4)
#pragma unroll
                    for (int r = 0; r < 4; ++r) a[q4 * 4 + r] -= Lb[1][i * 4 + q4][r] * xs; }
            GPIN();
            GL(1, 14, 48);
#pragma unroll
            for (int i = 0; i < 2; ++i) { const float xs = x[12 + i];
#pragma unroll
                for (int q4 = 0; q4 < 4; ++q4)
#pragma unroll
                    for (int r = 0; r < 4; ++r) a[q4 * 4 + r] -= Lb[0][i * 4 + q4][r] * xs; }
            GPIN();
            GL(0, 16, 48);
#pragma unroll
            for (int i = 0; i < 2; ++i) { const float xs = x[14 + i];
#pragma unroll
                for (int q4 = 0; q4 < 4; ++q4)
#pragma unroll
                    for (int r = 0; r < 4; ++r) a[q4 * 4 + r] -= Lb[1][i * 4 + q4][r] * xs; }
            GPIN();
            GL(1, 18, 48);
#pragma unroll
            for (int i = 0; i < 2; ++i) { const float xs = x[16 + i];
#pragma unroll
                for (int q4 = 0; q4 < 4; ++q4)
#pragma unroll
                    for (int r = 0; r < 4; ++r) a[q4 * 4 + r] -= Lb[0][i * 4 + q4][r] * xs; }
            GPIN();
            GL(0, 20, 48);
#pragma unroll
            for (int i = 0; i < 2; ++i) { const float xs = x[18 + i];
#pragma unroll
                for (int q4 = 0; q4 < 4; ++q4)
#pragma unroll
                    for (int r = 0; r < 4; ++r) a[q4 * 4 + r] -= Lb[1][i * 4 + q4][r] * xs; }
            GPIN();
            GL(1, 22, 48);
#pragma unroll
            for (int i = 0; i < 2; ++i) { const float xs = x[20 + i];
#pragma unroll
                for (int q4 = 0; q4 < 4; ++q4)
#pragma unroll
                    for (int r = 0; r < 4; ++r) a[q4 * 4 + r] -= Lb[0][i * 4 + q4][r] * xs; }
            GPIN();
            GL(0, 24, 48);
#pragma unroll
            for (int i = 0; i < 2; ++i) { const float xs = x[22 + i];
#pragma unroll
                for (int q4 = 0; q4 < 4; ++q4)
#pragma unroll
                    for (int r = 0; r < 4; ++r) a[q4 * 4 + r] -= Lb[1][i * 4 + q4][r] * xs; }
            GPIN();
            GL(1, 26, 48);
#pragma unroll
            for (int i = 0; i < 2; ++i) { const float xs = x[24 + i];
#pragma unroll
                for (int q4 = 0; q4 < 4; ++q4)
#pragma unroll
                    for (int r = 0; r < 4; ++r) a[q4 * 4 + r] -= Lb[0][i * 4 + q4][r] * xs; }
            GPIN();
            GL(0, 28, 48);
#pragma unroll
            for (int i = 0; i < 2; ++i) { const float xs = x[26 + i];
#pragma unroll
                for (int q4 = 0; q4 < 4; ++q4)
#pragma unroll
                    for (int r = 0; r < 4; ++r) a[q4 * 4 + r] -= Lb[1][i * 4 + q4][r] * xs; }
            GPIN();
            GL(1, 30, 48);
#pragma unroll
            for (int i = 0; i < 2; ++i) { const float xs = x[28 + i];
#pragma unroll
                for (int q4 = 0; q4 < 4; ++q4)
#pragma unroll
                    for (int r = 0; r < 4; ++r) a[q4 * 4 + r] -= Lb[0][i * 4 + q4][r] * xs; }
            GPIN();
            GL(0, 32, 48);
#pragma unroll
            for (int i = 0; i < 2; ++i) { const float xs = x[30 + i];
#pragma unroll
                for (int q4 = 0; q4 < 4; ++q4)
#pragma unroll
                    for (int r = 0; r < 4; ++r) a[q4 * 4 + r] -= Lb[1][i * 4 + q4][r] * xs; }
            GPIN();
            GL(1, 34, 48);
#pragma unroll
            for (int i = 0; i < 2; ++i) { const float xs = x[32 + i];
#pragma unroll
                for (int q4 = 0; q4 < 4; ++q4)
#pragma unroll
                    for (int r = 0; r < 4; ++r) a[q4 * 4 + r] -= Lb[0][i * 4 + q4][r] * xs; }
            GPIN();
            GL(0, 36, 48);
#pragma unroll
            for (int i = 0; i < 2; ++i) { const float xs = x[34 + i];
#pragma unroll
                for (int q4 = 0; q4 < 4; ++q4)
#pragma unroll
                    for (int r = 0; r < 4; ++r) a[q4 * 4 + r] -= Lb[1][i * 4 + q4][r] * xs; }
            GPIN();
            GL(1, 38, 48);
#pragma unroll
            for (int i = 0; i < 2; ++i) { const float xs = x[36 + i];
#pragma unroll
                for (int q4 = 0; q4 < 4; ++q4)
#pragma unroll
                    for (int r = 0; r < 4; ++r) a[q4 * 4 + r] -= Lb[0][i * 4 + q4][r] * xs; }
            GPIN();
            GL(0, 40, 48);
#pragma unroll
            for (int i = 0; i < 2; ++i) { const float xs = x[38 + i];
#pragma unroll
                for (int q4 = 0; q4 < 4; ++q4)
#pragma unroll
                    for (int r = 0; r < 4; ++r) a[q4 * 4 + r] -= Lb[1][i * 4 + q4][r] * xs; }
            GPIN();
            GL(1, 42, 48);
#pragma unroll
            for (int i = 0; i < 2; ++i) { const float xs = x[40 + i];
#pragma unroll
                for (int q4 = 0; q4 < 4; ++q4)
#pragma unroll
                    for (int r = 0; r < 4; ++r) a[q4 * 4 + r] -= Lb[0][i * 4 + q4][r] * xs; }
            GPIN();
            GL(0, 44, 48);
#pragma unroll
            for (int i = 0; i < 2; ++i) { const float xs = x[42 + i];
#pragma unroll
                for (int q4 = 0; q4 < 4; ++q4)
#pragma unroll
                    for (int r = 0; r < 4; ++r) a[q4 * 4 + r] -= Lb[1][i * 4 + q4][r] * xs; }
            GPIN();
            GL(1, 46, 48);
#pragma unroll
            for (int i = 0; i < 2; ++i) { const float xs = x[44 + i];
#pragma unroll
                for (int q4 = 0; q4 < 4; ++q4)
#pragma unroll
                    for (int r = 0; r < 4; ++r) a[q4 * 4 + r] -= Lb[0][i * 4 + q4][r] * xs; }
            GPIN();
            GL(0, 48, 48);
#pragma unroll
            for (int i = 0; i < 2; ++i) { const float xs = x[46 + i];
#pragma unroll
                for (int q4 = 0; q4 < 4; ++q4)
#pragma unroll
                    for (int r = 0; r < 4; ++r) a[q4 * 4 + r] -= Lb[1][i * 4 + q4][r] * xs; }
            GPIN();
            GL(1, 50, 48);
#pragma unroll
            for (int i = 0; i < 2; ++i) { const int ss = 0 + i; const float xv = a[ss]; x[48 + ss] = xv; if (isw) dst[(48 + ss) * 128] = (bf16_t)(cvt_pk_bf16(xv, 0.f) & 0xffffu);
#pragma unroll
                for (int q4 = 0; q4 < 4; ++q4)
#pragma unroll
                    for (int r = 0; r < 4; ++r) if (q4 * 4 + r > ss) a[q4 * 4 + r] -= Lb[0][i * 4 + q4][r] * xv; }
            GPIN();
            GL(0, 52, 48);
#pragma unroll
            for (int i = 0; i < 2; ++i) { const int ss = 2 + i; const float xv = a[ss]; x[48 + ss] = xv; if (isw) dst[(48 + ss) * 128] = (bf16_t)(cvt_pk_bf16(xv, 0.f) & 0xffffu);
#pragma unroll
                for (int q4 = 0; q4 < 4; ++q4)
#pragma unroll
                    for (int r = 0; r < 4; ++r) if (q4 * 4 + r > ss) a[q4 * 4 + r] -= Lb[1][i * 4 + q4][r] * xv; }
            GPIN();
            GL(1, 54, 48);
#pragma unroll
            for (int i = 0; i < 2; ++i) { const int ss = 4 + i; const float xv = a[ss]; x[48 + ss] = xv; if (isw) dst[(48 + ss) * 128] = (bf16_t)(cvt_pk_bf16(xv, 0.f) & 0xffffu);
#pragma unroll
                for (int q4 = 0; q4 < 4; ++q4)
#pragma unroll
                    for (int r = 0; r < 4; ++r) if (q4 * 4 + r > ss) a[q4 * 4 + r] -= Lb[0][i * 4 + q4][r] * xv; }
            GPIN();
            GL(0, 56, 48);
#pragma unroll
            for (int i = 0; i < 2; ++i) { const int ss = 6 + i; const float xv = a[ss]; x[48 + ss] = xv; if (isw) dst[(48 + ss) * 128] = (bf16_t)(cvt_pk_bf16(xv, 0.f) & 0xffffu);
#pragma unroll
                for (int q4 = 0; q4 < 4; ++q4)
#pragma unroll
                    for (int r = 0; r < 4; ++r) if (q4 * 4 + r > ss) a[q4 * 4 + r] -= Lb[1][i * 4 + q4][r] * xv; }
            GPIN();
            GL(1, 58, 48);
#pragma unroll
            for (int i = 0; i < 2; ++i) { const int ss = 8 + i; const float xv = a[ss]; x[48 + ss] = xv; if (isw) dst[(48 + ss) * 128] = (bf16_t)(cvt_pk_bf16(xv, 0.f) & 0xffffu);
#pragma unroll
                for (int q4 = 0; q4 < 4; ++q4)
#pragma unroll
                    for (int r = 0; r < 4; ++r) if (q4 * 4 + r > ss) a[q4 * 4 + r] -= Lb[0][i * 4 + q4][r] * xv; }
            GPIN();
            GL(0, 60, 48);
#pragma unroll
            for (int i = 0; i < 2; ++i) { const int ss = 10 + i; const float xv = a[ss]; x[48 + ss] = xv; if (isw) dst[(48 + ss) * 128] = (bf16_t)(cvt_pk_bf16(xv, 0.f) & 0xffffu);
#pragma unroll
                for (int q4 = 0; q4 < 4; ++q4)
#pragma unroll
                    for (int r = 0; r < 4; ++r) if (q4 * 4 + r > ss) a[q4 * 4 + r] -= Lb[1][i * 4 + q4][r] * xv; }
            GPIN();
            GL(1, 62, 48);
#pragma unroll
            for (int i = 0; i < 2; ++i) { const int ss = 12 + i; const float xv = a[ss]; x[48 + ss] = xv; if (isw) dst[(48 + ss) * 128] = (bf16_t)(cvt_pk_bf16(xv, 0.f) & 0xffffu);
#pragma unroll
                for (int q4 = 0; q4 < 4; ++q4)
#pragma unroll
                    for (int r = 0; r < 4; ++r) if (q4 * 4 + r > ss) a[q4 * 4 + r] -= Lb[0][i * 4 + q4][r] * xv; }
            GPIN();
#pragma unroll
            for (int i = 0; i < 2; ++i) { const int ss = 14 + i; const float xv = a[ss]; x[48 + ss] = xv; if (isw) dst[(48 + ss) * 128] = (bf16_t)(cvt_pk_bf16(xv, 0.f) & 0xffffu);
#pragma unroll
                for (int q4 = 0; q4 < 4; ++q4)
#pragma unroll
                    for (int r = 0; r < 4; ++r) if (q4 * 4 + r > ss) a[q4 * 4 + r] -= Lb[1][i * 4 + q4][r] * xv; }
            if (!isw) {
#pragma unroll
                for (int q4 = 0; q4 < 4; ++q4) { u32x2 w; w.x = cvt_pk_bf16(a[q4 * 4], a[q4 * 4 + 1]); w.y = cvt_pk_bf16(a[q4 * 4 + 2], a[q4 * 4 + 3]); *(u32x2*)(dst + (size_t)(12 + q4) * 512) = w; } }
            GPIN();
            }
#undef GL
#undef GPIN
            }
    }
}
}

namespace ok {
constexpr int ST_LD = 136, VT_LD = 72;
__device__ __forceinline__ void phase_gdn_prep(const Frame& F0) { phase_gdn_prep_t<15>(F0); }
constexpr int GJT = 4, GDV = GJT * 16, GN_UNITS = NB * 8 * (128 / GDV);
static_assert(GJT == 4, "the Z slot below is sized for four column tiles");
struct GdnEarly { bf16x8 X[4]; u32x2 Z[4]; };
struct GdnLate { bf16x8 Kf[2]; float dec; };
__device__ __forceinline__ void gdn_load_early(GdnEarly& g, const Frame& F, size_t xoff, size_t ub, int ti, int sl, int fr, int fq, int roleB) {
    const bf16_t* Xp = (const bf16_t*)(F.ws + xoff) + ub * 8192 + (ti * 16 + fr) * 128 + fq * 8;
#pragma unroll
    for (int ks = 0; ks < 4; ++ks) g.X[ks] = *(const bf16x8*)(Xp + ks * 32);
    const bf16_t* zb = roleB ? OKP(bf16_t, WS_GAQK) + ub * 4096 + (ti * 16 + fr) * 64 + fq * 8 : OKP(bf16_t, WS_GU) + ub * 8192 + ((size_t)(ti * 4 + fq) * 128 + sl * GDV + fr) * 4;
#pragma unroll
    for (int i = 0; i < 4; ++i) g.Z[i] = *(const u32x2*)(zb + (roleB ? (i >> 1) * 32 + (i & 1) * 4 : i * 64));
}
__device__ __forceinline__ void gdn_load_late(GdnLate& g, const Frame& F, size_t ub, int ti, int wave, int fr, int fq, int vzero) {
    const bf16_t* Kp = OKP(bf16_t, WS_GKDT) + ub * 8192 + (wave * 16 + fr) * 64 + fq * 8;
#pragma unroll
    for (int k2 = 0; k2 < 2; ++k2) g.Kf[k2] = *(const bf16x8*)(Kp + k2 * 32);
    g.dec = OKP(float, WS_GDEC)[ub + vzero];
}
constexpr int OS_LD = GDV + 8;
__device__ __forceinline__ void gdn_flush_o(const Frame& F, const LAS bf16_t* Os, int b, int cprev, int hd, int sl) {
    constexpr int PCS = GDV / 8;
    if (F.tid < 64 * PCS) { const int row = F.tid / PCS, pc = F.tid % PCS; *(u32x4*)(OKP(bf16_t, WS_OBUF) + ((size_t)b * L + cprev * 64 + row) * 1024 + hd * 128 + sl * GDV + pc * 8) = *(const LAS u32x4*)(Os + row * OS_LD + pc * 8); }
}
__device__ __forceinline__ void gdn_step(const Frame& F, const GdnEarly& g, const GdnLate& h, f32x4 (&Sacc)[GJT], LAS bf16_t* ST0, LAS bf16_t* VnT, int par, int roleB, int b, int c, int hd, int sl, int ti, int wave, int fr, int fq) {
    LAS bf16_t* ST = ST0 + par * (GDV * ST_LD); LAS bf16_t* STn = ST0 + (par ^ 1) * (GDV * ST_LD);
    LAS bf16_t* Os = VnT + GDV * VT_LD;
    LDS_BARRIER();
    if (c > 0) gdn_flush_o(F, Os, b, c - 1, hd, sl);
    f32x4 a[GJT];
#pragma unroll
    for (int ji = 0; ji < GJT; ++ji) a[ji] = (f32x4){0.f, 0.f, 0.f, 0.f};
#pragma unroll
    for (int ks = 0; ks < 4; ++ks)
#pragma unroll
        for (int ji = 0; ji < GJT; ++ji) { const bf16x8 sf = *(const LAS bf16x8*)(ST + (ji * 16 + fr) * ST_LD + ks * 32 + fq * 8); a[ji] = mfma16(g.X[ks], sf, a[ji]); }
    if (!roleB) {
#pragma unroll
        for (int ji = 0; ji < GJT; ++ji) { const u32x2 uv = g.Z[ji]; u32x2 w; w.x = cvt_pk_bf16(bflo(uv.x) - a[ji][0], bfhi(uv.x) - a[ji][1]); w.y = cvt_pk_bf16(bflo(uv.y) - a[ji][2], bfhi(uv.y) - a[ji][3]);
            *(LAS u32x2*)(VnT + (ji * 16 + fr) * VT_LD + ti * 16 + 4 * fq) = w; } }
    LDS_BARRIER();
#pragma unroll
    for (int ji = 0; ji < GJT; ++ji) { bf16x8 vf[2];
#pragma unroll
        for (int k2 = 0; k2 < 2; ++k2) vf[k2] = *(const LAS bf16x8*)(VnT + (ji * 16 + fr) * VT_LD + k2 * 32 + fq * 8);
        if (roleB) {
#pragma unroll
            for (int k2 = 0; k2 < 2; ++k2) { u32x4 af; af.x = g.Z[2 * k2].x; af.y = g.Z[2 * k2].y; af.z = g.Z[2 * k2 + 1].x; af.w = g.Z[2 * k2 + 1].y; a[ji] = mfma16(__builtin_bit_cast(bf16x8, af), vf[k2], a[ji]); }
            LAS bf16_t* op = Os + (ti * 16 + 4 * fq) * OS_LD + ji * 16 + fr;
#pragma unroll
            for (int r = 0; r < 4; ++r) op[r * OS_LD] = (bf16_t)(cvt_pk_bf16(a[ji][r], 0.f) & 0xffffu); }
        Sacc[ji] *= h.dec;
#pragma unroll
        for (int k2 = 0; k2 < 2; ++k2) Sacc[ji] = mfma16(h.Kf[k2], vf[k2], Sacc[ji]);
        u32x2 w; w.x = cvt_pk_bf16(Sacc[ji][0], Sacc[ji][1]); w.y = cvt_pk_bf16(Sacc[ji][2], Sacc[ji][3]); *(LAS u32x2*)(STn + (ji * 16 + fr) * ST_LD + wave * 16 + 4 * fq) = w; }
}
template <int MODE  > __device__ __forceinline__ void gdn_scan_unit_t(const Frame& F, int unit) {
    LAS bf16_t* ST = (LAS bf16_t*)F.lds; LAS bf16_t* VnT = (LAS bf16_t*)(F.lds + 2 * GDV * ST_LD * 2);
    const int tid = F.tid, lane = F.lane, wave = F.wave, fr = lane & 15, fq = lane >> 4;
    constexpr int NSL = 128 / GDV;
    const int sl = unit % NSL, hd = (unit / NSL) & 7, b = unit / (NSL * 8), ti = wave & 3, roleB = wave >> 2;
    for (int i = tid; i < GDV * ST_LD / 2; i += NT) ((LAS unsigned*)ST)[i] = 0u;
    f32x4 Sacc[GJT];
#pragma unroll
    for (int ji = 0; ji < GJT; ++ji) Sacc[ji] = (f32x4){0.f, 0.f, 0.f, 0.f};
    const size_t ub0 = ((size_t)b * NCH) * 8 + hd; const size_t xoff = roleB ? WS_GQD : WS_GW;
    int vzero = 0;
#ifndef CPU_EMU
    asm volatile("" : "+v"(vzero));
#endif
#define GDN_LE(set, cc) if (MODE == 0) gdn_load_early(set, F, xoff, ub0 + (size_t)((cc) < NCH ? (cc) : NCH - 1) * 8, ti, sl, fr, fq, roleB)
#define GDN_LL(set, cc) if (MODE == 0) gdn_load_late(set, F, ub0 + (size_t)((cc) < NCH ? (cc) : NCH - 1) * 8, ti, wave, fr, fq, vzero)
#define GDN_ST(es, ls, cc, par) gdn_step(F, es, ls, Sacc, ST, VnT, par, roleB, b, (MODE == 0 ? (cc) : 0), hd, sl, ti, wave, fr, fq)
    GdnEarly e0, e1, e2; GdnLate l0, l1;
    GDN_LE(e0, 0); GDN_LE(e1, 1); GDN_LL(l0, 0);
    if (MODE == 1) { gdn_load_early(e0, F, xoff, ub0, ti, sl, fr, fq, roleB); gdn_load_early(e1, F, xoff, ub0, ti, sl, fr, fq, roleB); gdn_load_early(e2, F, xoff, ub0, ti, sl, fr, fq, roleB); gdn_load_late(l0, F, ub0, ti, wave, fr, fq, vzero); gdn_load_late(l1, F, ub0, ti, wave, fr, fq, vzero); }
    int c = 0;
    for (; c + 6 <= NCH; c += 6) {
        GDN_LE(e2, c + 2); GDN_LL(l1, c + 1); GDN_ST(e0, l0, c + 0, 0);
        GDN_LE(e0, c + 3); GDN_LL(l0, c + 2); GDN_ST(e1, l1, c + 1, 1);
        GDN_LE(e1, c + 4); GDN_LL(l1, c + 3); GDN_ST(e2, l0, c + 2, 0);
        GDN_LE(e2, c + 5); GDN_LL(l0, c + 4); GDN_ST(e0, l1, c + 3, 1);
        GDN_LE(e0, c + 6); GDN_LL(l1, c + 5); GDN_ST(e1, l0, c + 4, 0);
        GDN_LE(e1, c + 7); GDN_LL(l0, c + 6); GDN_ST(e2, l1, c + 5, 1);
    }
    if (c + 0 < NCH) { GDN_LE(e2, c + 2); GDN_LL(l1, c + 1); GDN_ST(e0, l0, c + 0, 0); }
    if (c + 1 < NCH) { GDN_LE(e0, c + 3); GDN_LL(l0, c + 2); GDN_ST(e1, l1, c + 1, 1); }
    if (c + 2 < NCH) { GDN_LE(e1, c + 4); GDN_LL(l1, c + 3); GDN_ST(e2, l0, c + 2, 0); }
    if (c + 3 < NCH) { GDN_LE(e2, c + 5); GDN_LL(l0, c + 4); GDN_ST(e0, l1, c + 3, 1); }
    if (c + 4 < NCH) { GDN_LE(e0, c + 6); GDN_LL(l1, c + 5); GDN_ST(e1, l0, c + 4, 0); }
#undef GDN_LE
#undef GDN_LL
#undef GDN_ST
    LDS_BARRIER();
    if (MODE == 0) gdn_flush_o(F, VnT + GDV * VT_LD, b, NCH - 1, hd, sl);
}
__device__ __forceinline__ void gdn_scan_unit(const Frame& F, int unit) { gdn_scan_unit_t<0>(F, unit); }
__device__ __forceinline__ void phase_gdn_final(const Frame& F0) {
    using namespace sm;
    const Frame F = phase_frame(F0);
    const int lane = F.lane; const int gw = F.vcu * NWAVES + F.wave, NGW = F.G * NWAVES;
    const f32x4* nw4 = (const f32x4*)(F.in[I_OD_NORM] + (lane & 7) * 16);
    u32x4 na[2], nz[2]; { const int t = gw < T ? gw : 0; const u32x4* op = (const u32x4*)(OKP(bf16_t, WS_OBUF) + (size_t)t * 1024 + lane * 16); const u32x4* zp = (const u32x4*)(OKP(bf16_t, WS_PROJ) + (size_t)t * PROJ1_LD + 3072 + lane * 16); na[0] = op[0]; na[1] = op[1]; nz[0] = zp[0]; nz[1] = zp[1]; }
    for (int t = gw; t < T; t += NGW) { const u32x4 ca[2] = {na[0], na[1]}, cz[2] = {nz[0], nz[1]};
        { const int tn = t + NGW < T ? t + NGW : t; const u32x4* op = (const u32x4*)(OKP(bf16_t, WS_OBUF) + (size_t)tn * 1024 + lane * 16); const u32x4* zp = (const u32x4*)(OKP(bf16_t, WS_PROJ) + (size_t)tn * PROJ1_LD + 3072 + lane * 16); na[0] = op[0]; na[1] = op[1]; nz[0] = zp[0]; nz[1] = zp[1]; }
        float o[16], z[16];
#pragma unroll
        for (int h2 = 0; h2 < 2; ++h2) { const u32x4 a = ca[h2], zz = cz[h2];
            o[h2 * 8 + 0] = bflo(a.x); o[h2 * 8 + 1] = bfhi(a.x); o[h2 * 8 + 2] = bflo(a.y); o[h2 * 8 + 3] = bfhi(a.y); o[h2 * 8 + 4] = bflo(a.z); o[h2 * 8 + 5] = bfhi(a.z); o[h2 * 8 + 6] = bflo(a.w); o[h2 * 8 + 7] = bfhi(a.w);
            z[h2 * 8 + 0] = bflo(zz.x); z[h2 * 8 + 1] = bfhi(zz.x); z[h2 * 8 + 2] = bflo(zz.y); z[h2 * 8 + 3] = bfhi(zz.y); z[h2 * 8 + 4] = bflo(zz.z); z[h2 * 8 + 5] = bfhi(zz.z); z[h2 * 8 + 6] = bflo(zz.w); z[h2 * 8 + 7] = bfhi(zz.w); }
        float s = 0.f;
#pragma unroll
        for (int i = 0; i < 16; ++i) s += o[i] * o[i];
        s += __shfl_xor(s, 1); s += __shfl_xor(s, 2); s += __shfl_xor(s, 4);
        const float rs = frsq(s * (1.f / 128.f) + EPS);
        u32x4 w[2];
#pragma unroll
        for (int h2 = 0; h2 < 2; ++h2) { const f32x4 n0 = nw4[h2 * 2], n1 = nw4[h2 * 2 + 1]; float y[8];
#pragma unroll
            for (int i = 0; i < 8; ++i) y[i] = o[h2 * 8 + i] * rs * (i < 4 ? n0[i] : n1[i - 4]) * siluf(z[h2 * 8 + i]);
            w[h2].x = cvt_pk_bf16(y[0], y[1]); w[h2].y = cvt_pk_bf16(y[2], y[3]); w[h2].z = cvt_pk_bf16(y[4], y[5]); w[h2].w = cvt_pk_bf16(y[6], y[7]); }
        u32x4* cp = (u32x4*)(OKP(bf16_t, WS_CAT1) + (size_t)t * 1536 + lane * 16); cp[0] = w[0]; cp[1] = w[1]; }
}
}

#ifndef DUP_MASK
#define DUP_MASK 0
#endif
namespace ok {
constexpr int SB_LD = 72;
#ifdef CPU_EMU
#define WAVE_ALL(p) (wave_sum((p) ? 1.f : 0.f) == 64.f)
#else
#define WAVE_ALL(p) (__all(p))
#endif
__device__ __forceinline__ void sb_unit(const Frame& F, int unit) {
    LAS bf16_t* Kt = (LAS bf16_t*)F.lds; LAS bf16_t* VT = (LAS bf16_t*)(F.lds + 64 * SB_LD * 2); volatile LAS int* votes = (volatile LAS int*)(F.lds + 2 * 64 * SB_LD * 2);
    const int tid = F.tid, lane = F.lane, wave = F.wave, fr = lane & 15, fq = lane >> 4;
    const int nqb = L / 128, qb = unit % nqb, hd = (unit / nqb) & 7, b = unit / (nqb * 8), q0 = qb * 128;
    const bf16_t* proj = OKP(bf16_t, WS_PROJ) + (size_t)b * L * PROJ1_LD;
    const int qrow = q0 + wave * 16 + fr;
    bf16x8 qf[2];
#pragma unroll
    for (int ks = 0; ks < 2; ++ks) qf[ks] = *(const bf16x8*)(proj + (size_t)qrow * PROJ1_LD + 4096 + hd * 64 + ks * 32 + fq * 8);
    f32x4 o[4] = {{0.f, 0.f, 0.f, 0.f}, {0.f, 0.f, 0.f, 0.f}, {0.f, 0.f, 0.f, 0.f}, {0.f, 0.f, 0.f, 0.f}};
    float C = 1.f; bool wdone = false;
    const int key_l = tid >> 3, c8 = tid & 7;
    int kt = 2 * qb + 1;
    u32x4 kreg = *(const u32x4*)(proj + (size_t)(kt * 64 + key_l) * PROJ1_LD + 4608 + hd * 64 + c8 * 8), vreg = *(const u32x4*)(proj + (size_t)(kt * 64 + key_l) * PROJ1_LD + 5120 + hd * 64 + c8 * 8);
    for (; kt >= 0; --kt) {
        LDS_BARRIER();
        *(LAS u32x4*)(Kt + key_l * SB_LD + c8 * 8) = kreg;
        { LAS bf16_t* vp = VT + (c8 * 8) * SB_LD + key_l; vp[0] = (bf16_t)(vreg.x & 0xffffu); vp[SB_LD] = (bf16_t)(vreg.x >> 16); vp[2 * SB_LD] = (bf16_t)(vreg.y & 0xffffu); vp[3 * SB_LD] = (bf16_t)(vreg.y >> 16);
          vp[4 * SB_LD] = (bf16_t)(vreg.z & 0xffffu); vp[5 * SB_LD] = (bf16_t)(vreg.z >> 16); vp[6 * SB_LD] = (bf16_t)(vreg.w & 0xffffu); vp[7 * SB_LD] = (bf16_t)(vreg.w >> 16); }
        if (lane == 0) votes[wave] = wdone ? 1 : 0;
        LDS_BARRIER();
        { int all = 1;
#pragma unroll
          for (int w = 0; w < 8; ++w) all &= votes[w];
          if (all) break; }
        if (kt > 0) { kreg = *(const u32x4*)(proj + (size_t)((kt - 1) * 64 + key_l) * PROJ1_LD + 4608 + hd * 64 + c8 * 8); vreg = *(const u32x4*)(proj + (size_t)((kt - 1) * 64 + key_l) * PROJ1_LD + 5120 + hd * 64 + c8 * 8); }
        const int key0 = kt * 64;
#ifdef SB_COUNT_ITERS
        ++g_iters;
#endif
        if (!wdone && key0 < q0 + wave * 16 + 16) {
            f32x4 x[4];
#pragma unroll
            for (int k16 = 0; k16 < 4; ++k16) { x[k16] = (f32x4){0.f, 0.f, 0.f, 0.f};
#pragma unroll
                for (int ks = 0; ks < 2; ++ks) { const bf16x8 kf = *(const LAS bf16x8*)(Kt + (k16 * 16 + fr) * SB_LD + ks * 32 + fq * 8); x[k16] = mfma16(kf, qf[ks], x[k16]); } }
            const bool need_mask = key0 + 63 >= q0 + wave * 16;
            float Rr[4], Tt[4], Ee[4];
#pragma unroll
            for (int k16 = 0; k16 < 4; ++k16) {
#pragma unroll
                for (int r = 0; r < 4; ++r) { const float e = fexp2(fminf(x[k16][r], 80.f)); float rr = frcp(1.f + e), bet = e * rr;
                    if (need_mask && key0 + k16 * 16 + 4 * fq + r >= qrow) { rr = 1.f; bet = 0.f; }
                    x[k16][r] = bet; Rr[k16] = (r == 0) ? rr : Rr[k16];
                    if (r == 0) Tt[k16] = rr; else if (r == 1) Ee[k16] = rr; else if (r == 2) Rr[k16] = rr; else {
                        const float r0 = Tt[k16], r1 = Ee[k16], r2 = Rr[k16], r3 = rr; const float s2 = r3, s1 = r3 * r2, s0 = s1 * r1;
                        x[k16][0] *= s0; x[k16][1] *= s1; x[k16][2] *= s2;
                        Rr[k16] = s0 * r0; } } }
#pragma unroll
            for (int k16 = 0; k16 < 4; ++k16) { const float R = Rr[k16]; const float d1 = __shfl_down(R, 16), d2 = __shfl_down(R, 32), d3 = __shfl_down(R, 48);
                Ee[k16] = (fq < 3 ? d1 : 1.f) * (fq < 2 ? d2 : 1.f) * (fq < 1 ? d3 : 1.f); float t = R; t *= __shfl_xor(t, 16); t *= __shfl_xor(t, 32); Tt[k16] = t; }
            const float TT2 = Tt[3], TT1 = Tt[3] * Tt[2], TT0 = TT1 * Tt[1];
            const float f0 = Ee[0] * TT0 * C, f1 = Ee[1] * TT1 * C, f2 = Ee[2] * TT2 * C, f3 = Ee[3] * C;
            x[0] *= f0; x[1] *= f1; x[2] *= f2; x[3] *= f3;
            C *= TT0 * Tt[0];
            bf16x8 pw[2];
#pragma unroll
            for (int j = 0; j < 2; ++j) { u32x4 p; p.x = cvt_pk_bf16(x[2 * j][0], x[2 * j][1]); p.y = cvt_pk_bf16(x[2 * j][2], x[2 * j][3]); p.z = cvt_pk_bf16(x[2 * j + 1][0], x[2 * j + 1][1]); p.w = cvt_pk_bf16(x[2 * j + 1][2], x[2 * j + 1][3]); pw[j] = __builtin_bit_cast(bf16x8, p); }
#pragma unroll
            for (int dt = 0; dt < 4; ++dt)
#pragma unroll
                for (int j = 0; j < 2; ++j) { const LAS bf16_t* vp = VT + (dt * 16 + fr) * SB_LD + j * 32 + 4 * fq; const u32x2 lo = *(const LAS u32x2*)vp, hi = *(const LAS u32x2*)(vp + 16);
                    u32x4 a; a.x = lo.x; a.y = lo.y; a.z = hi.x; a.w = hi.y; o[dt] = mfma16(__builtin_bit_cast(bf16x8, a), pw[j], o[dt]); }
            wdone = WAVE_ALL(C < 7.8886e-31f);
        }
    }
    bf16_t* op = OKP(bf16_t, WS_CAT1) + ((size_t)b * L + qrow) * 1536 + 1024 + hd * 64 + 4 * fq;
#pragma unroll
    for (int dt = 0; dt < 4; ++dt) { u32x2 w; w.x = cvt_pk_bf16(o[dt][0], o[dt][1]); w.y = cvt_pk_bf16(o[dt][2], o[dt][3]); *(u32x2*)(op + dt * 16) = w; }
}
__device__ __forceinline__ void phase_l1_mix(const Frame& F0) {
    const Frame F = phase_frame(F0);
    constexpr int NU = GN_UNITS, UPX = NU / 8;
    if (F.G < 128 || F.G % 8 != 0) { if (F.vcu == 0) for (int u = 0; u < NU; ++u) { gdn_scan_unit(F, u); __syncthreads(); } for (int u = F.vcu; u < NB * 8 * (L / 128); u += F.G) { sb_unit(F, u); __syncthreads(); } return; }
    const int per = F.G / 8, xcd = F.vcu / per, loc = F.vcu % per;
    if (loc < UPX) { gdn_scan_unit(F, xcd * UPX + loc);
#if (DUP_MASK >> 3) & 1
        __syncthreads(); gdn_scan_unit(F, xcd * UPX + loc);
#endif
#if (DUP_MASK >> 21) & 1
        __syncthreads(); gdn_scan_unit_t<1>(F, xcd * UPX + loc);
#endif
    }
    else for (int rep = 0; rep < 1 + ((DUP_MASK >> 16) & 1); ++rep) for (int u = xcd * (per - UPX) + (loc - UPX); u < NB * 8 * (L / 128); u += F.G - NU) { sb_unit(F, u); __syncthreads(); }
}
}

namespace ok {
#if CHECK
__device__ const int kSampleRows[16] = {0, 1, 2, 3, 63, 64, 127, 128, 129, 1000, 2047, 2048, 4097, 6000, 8190, 8191};
constexpr int FP_W = 6144;
__device__ __forceinline__ void fp_save(const Frame& F, int k, const void* buf, int ld, int width, bool is_bf16, int dcol0) {
    float* fp = OKP(float, WS_FP) + (size_t)k * 16 * FP_W; const size_t gt = (size_t)blockIdx.x * NT + F.tid, GT = (size_t)F.G * NT;
    for (size_t i = gt; i < (size_t)16 * width; i += GT) { const int r = (int)(i / width), c = (int)(i % width); const size_t src = (size_t)kSampleRows[r] * ld + c;
        fp[r * FP_W + dcol0 + c] = is_bf16 ? bf2f(((const bf16_t*)buf)[src]) : ((const float*)buf)[src]; }
}
__device__ __forceinline__ void fp_cmp(const Frame& F, int k, const float* obuf, int ld, int ocol0, int width, int fcol0) {
    const float* fp = OKP(float, WS_FP) + (size_t)k * 16 * FP_W; const size_t gt = (size_t)blockIdx.x * NT + F.tid, GT = (size_t)F.G * NT; float num = 0.f, den = 0.f;
    for (size_t i = gt; i < (size_t)16 * width; i += GT) { const int r = (int)(i / width), c = (int)(i % width); const float o = obuf[(size_t)kSampleRows[r] * ld + ocol0 + c], f = fp[r * FP_W + fcol0 + c];
        const float d = o - f; num += d * d; den += o * o; if (!(d == d)) num += 1e30f; }
    num = wave_sum(num); den = wave_sum(den);
    if (F.lane == 0 && (num != 0.f || den != 0.f)) { atomicAdd((float*)F.ctl + CW_CHK + 2 * k, num); atomicAdd((float*)F.ctl + CW_CHK + 2 * k + 1, den); }
}
__device__ __forceinline__ void fp_save_lin(const Frame& F, int k, const void* buf, size_t off, int n, bool is_bf16) {
    float* fp = OKP(float, WS_FP) + (size_t)k * 16 * FP_W; const size_t gt = (size_t)blockIdx.x * NT + F.tid, GT = (size_t)F.G * NT;
    for (size_t i = gt; i < (size_t)n; i += GT) fp[i] = is_bf16 ? bf2f(((const bf16_t*)buf)[off + i]) : ((const float*)buf)[off + i];
}
__device__ __forceinline__ void fp_cmp_lin(const Frame& F, int k, const float* obuf, size_t off, int n) {
    const float* fp = OKP(float, WS_FP) + (size_t)k * 16 * FP_W; const size_t gt = (size_t)blockIdx.x * NT + F.tid, GT = (size_t)F.G * NT; float num = 0.f, den = 0.f;
    for (size_t i = gt; i < (size_t)n; i += GT) { const float o = obuf[off + i], f = fp[i]; const float d = o - f; num += d * d; den += o * o; if (!(d == d)) num += 1e30f; }
    num = wave_sum(num); den = wave_sum(den);
    if (F.lane == 0 && (num != 0.f || den != 0.f)) { atomicAdd((float*)F.ctl + CW_CHK + 2 * k, num); atomicAdd((float*)F.ctl + CW_CHK + 2 * k + 1, den); }
}
#endif

struct Args { const float* in[33]; float* out; unsigned char* ws;
#if CHECK
    sm::Ctx oc;
#endif
};

__global__ void __launch_bounds__(512, 2) mk_fwd(Args a) {
    extern __shared__ __attribute__((aligned(16))) unsigned char lds_raw[];
    Frame F; F.lds = (LAS unsigned char*)lds_raw; F.ws = a.ws; F.ctl = (unsigned*)(a.ws + WS_CTL); F.in = a.in; F.out = a.out;
    F.tid = threadIdx.x; F.lane = F.tid & 63; F.wave = __builtin_amdgcn_readfirstlane(F.tid >> 6); F.G = gridDim.x;
    { const int bx = blockIdx.x; F.vcu = (F.G % 8 == 0) ? (bx % 8) * (F.G / 8) + bx / 8 : bx; }
    volatile LAS unsigned* MISC = (volatile LAS unsigned*)(F.lds + LDS_BYTES - 64);
    if (F.tid < 16) MISC[F.tid] = 0u;
    __syncthreads();
    XcdBarrier bar = xcd_barrier_post(F.ctl + CW_BAR, MISC);
#define GRID_BAR() xcd_barrier(bar)
    using namespace sm;
    for (int dup_p = 0; dup_p < ((DUP_MASK >> 5) & 1) + 1; ++dup_p) {
    phase_prologue(F);
    prologue_router_tables(F);
    prologue_w16_tables(F);
    GRID_BAR();
    }
    for (int dup_i0 = 0; dup_i0 < ((DUP_MASK >> 6) & 1) + 1; ++dup_i0) {
    { EpiScaleBf16 E{OKP(bf16_t, WS_PROJ), PROJ0_LD, (const float*)F.ctl + CW_SSQ, 1};
      dense_gemm(F, OKP(bf16_t, WS_HB), OKP(bf16_t, WS_W_IN0), T, 4096, 1024, E); }
    phase_proj16(F, 0, F.in[I_X], nullptr, (const float*)F.ctl + CW_SSQ, 1);
    GRID_BAR();
    }
#if CHECK
    fp_save(F, 0, OKP(bf16_t, WS_PROJ), PROJ0_LD, 4096, true, 0);
#endif
    for (int dup_b = 0; dup_b < ((DUP_MASK >> 1) & 1) + 1; ++dup_b) {
    for (int dup_b1 = 0; dup_b1 < ((DUP_MASK >> 14) & 1) + 1; ++dup_b1) { phase_ssd_a(F); GRID_BAR(); }
#if CHECK
    fp_save_lin(F, 6, OKP(bf16_t, WS_STATES), ((size_t)5 * 16 + 0) * 8192, 65536, true);
    GRID_BAR();
#endif
    phase_kv(F);
    phase_ssd_scan(F, (F.G >= 64 && F.G % 8 == 0) ? 32 : 0);
    GRID_BAR();
    for (int dup_b2 = 0; dup_b2 < ((DUP_MASK >> 15) & 1) + 1; ++dup_b2) { phase_ssd_b(F); GRID_BAR(); }
    }

    for (int dup_o0 = 0; dup_o0 < ((DUP_MASK >> 8) & 1) + 1; ++dup_o0) {
    { EpiResidualT<true> E{F.in[I_X], OKP(bf16_t, WS_HB), OKP(float, WS_SSQP1)};
      dense_gemm(F, OKP(bf16_t, WS_CAT0), OKP(bf16_t, WS_W_OUT0), T, 1024, 1536, E); }
    GRID_BAR();
    }
#if CHECK
    fp_save(F, 10, OKP(bf16_t, WS_HB), 1024, 1024, true, 0);
    fp_save_lin(F, 7, OKP(bf16_t, WS_STATES), ((size_t)5 * 16 + 0) * 8192, 65536, true);
    fp_save(F, 8, OKP(bf16_t, WS_CAT0), 1536, 512, true, 0);
    fp_save(F, 9, OKP(bf16_t, WS_CAT0) + 512, 1536, 1024, true, 0);
    GRID_BAR();
#endif
    for (int dup_q0 = 0; dup_q0 < ((DUP_MASK >> 9) & 1) + 1; ++dup_q0) {
    { EpiScaleBf16 E{OKP(bf16_t, WS_Q), 1024, OKP(float, WS_SSQP1), 16};
      dense_gemm(F, OKP(bf16_t, WS_HB), OKP(bf16_t, WS_W_XA), T, 1024, 1024, E); }
    GRID_BAR();
    }
    for (int dup_xa0 = 0; dup_xa0 < ((DUP_MASK >> 13) & 1) + 1; ++dup_xa0) {
    phase_xattn(F, OKP(bf16_t, WS_Q), OKP(bf16_t, WS_KX), OKP(bf16_t, WS_VT), OKP(bf16_t, WS_ATT));
    GRID_BAR();
    }
    { EpiResidualT<false> E{nullptr, OKP(bf16_t, WS_HB), OKP(float, WS_SSQP2)};
      dense_gemm(F, OKP(bf16_t, WS_ATT), OKP(bf16_t, WS_W_XA + 6 * MiB), T, 1024, 1024, E); }
    GRID_BAR();
#if CHECK
    fp_save(F, 11, OKP(bf16_t, WS_HB), 1024, 1024, true, 0);
    GRID_BAR();
#endif
    phase_router(F, 0, OKP(bf16_t, WS_HB), OKP(float, WS_SSQP2), 16);
    for (int dup_cv = 0; dup_cv < ((DUP_MASK >> 10) & 1) + 1; ++dup_cv) phase_cvt_moe(F, 0);
    GRID_BAR();
    for (int dup_sc = 0; dup_sc < ((DUP_MASK >> 11) & 1) + 1; ++dup_sc) {
    phase_scatter(F, 0, OKP(bf16_t, WS_HB), OKP(float, WS_SSQP2), 16);
    GRID_BAR();
    }
    for (int dup_c = 0; dup_c < ((DUP_MASK >> 2) & 1) + 1; ++dup_c) {
    phase_moe_up(F);
    GRID_BAR();
    phase_moe_down(F);
    GRID_BAR();
    }

    phase_combine(F, OKP(bf16_t, WS_HB), (float*)F.ctl + CW_SSQ + 3 * T, false);
    GRID_BAR();
#if CHECK
    fp_save(F, 12, OKP(bf16_t, WS_HB), 1024, 1024, true, 0);
    GRID_BAR();
#endif
    for (int dup_i1 = 0; dup_i1 < ((DUP_MASK >> 12) & 1) + 1; ++dup_i1) {
    { EpiScaleBf16 E{OKP(bf16_t, WS_PROJ), PROJ1_LD, (const float*)F.ctl + CW_SSQ + 3 * T, 1};
      dense_gemm(F, OKP(bf16_t, WS_HB), OKP(bf16_t, WS_W_IN1), T, 5632, 1024, E); }
    phase_proj16(F, 1, nullptr, OKP(bf16_t, WS_HB), (const float*)F.ctl + CW_SSQ + 3 * T, 1);
    GRID_BAR();
    }
#if CHECK
    fp_save(F, 13, OKP(bf16_t, WS_PROJ), PROJ1_LD, 4096, true, 0);
    fp_save(F, 13, OKP(bf16_t, WS_PROJ) + 4608, PROJ1_LD, 1024, true, 4096);
#endif
#if (DUP_MASK >> 22) & 15
    phase_gdn_prep_t<(DUP_MASK >> 22) & 15>(F); GRID_BAR();
#endif
    for (int dup_a = 0; dup_a < ((DUP_MASK >> 0) & 1) + 1; ++dup_a) { phase_gdn_prep(F); GRID_BAR(); }
    phase_l1_mix(F); GRID_BAR();
    for (int dup_e = 0; dup_e < ((DUP_MASK >> 4) & 1) + 1; ++dup_e) { phase_gdn_final(F); GRID_BAR(); }

    { EpiResidualT<false> E{nullptr, OKP(bf16_t, WS_HB), OKP(float, WS_SSQP4)};
      dense_gemm(F, OKP(bf16_t, WS_CAT1), OKP(bf16_t, WS_W_OUT1), T, 1024, 1536, E); }
    GRID_BAR();
#if CHECK
    fp_save(F, 14, OKP(bf16_t, WS_CAT1), 1536, 1024, true, 0);
    fp_save(F, 15, OKP(bf16_t, WS_CAT1) + 1024, 1536, 512, true, 0);
    fp_save(F, 16, OKP(bf16_t, WS_HB), 1024, 1024, true, 0);
    GRID_BAR();
#endif
    { EpiScaleBf16 E{OKP(bf16_t, WS_Q), 1024, OKP(float, WS_SSQP4), 16};
      dense_gemm(F, OKP(bf16_t, WS_HB), OKP(bf16_t, WS_W_XA + 8 * MiB), T, 1024, 1024, E); }
    GRID_BAR();
    phase_xattn(F, OKP(bf16_t, WS_Q), OKP(bf16_t, WS_KX) + (size_t)NB * 256 * 1024, OKP(bf16_t, WS_VT) + (size_t)1024 * NB * 256, OKP(bf16_t, WS_ATT));
    GRID_BAR();
    { EpiResidualT<false> E{nullptr, OKP(bf16_t, WS_HB), OKP(float, WS_SSQP5)};
      dense_gemm(F, OKP(bf16_t, WS_ATT), OKP(bf16_t, WS_W_XA + 8 * MiB + 6 * MiB), T, 1024, 1024, E); }
    GRID_BAR();
#if CHECK
    fp_save(F, 17, OKP(bf16_t, WS_HB), 1024, 1024, true, 0);
    GRID_BAR();
#endif
    phase_router(F, 1, OKP(bf16_t, WS_HB), OKP(float, WS_SSQP5), 16);
    phase_cvt_moe(F, 1);
    GRID_BAR();
    phase_scatter(F, 1, OKP(bf16_t, WS_HB), OKP(float, WS_SSQP5), 16);
    GRID_BAR();
    phase_moe_up(F);
    GRID_BAR();
    phase_moe_down(F);
    GRID_BAR();
    phase_combine(F, OKP(bf16_t, WS_HB), nullptr, true);
#if CHECK
    GRID_BAR();
    fp_save(F, 18, F.out, 1024, 1024, false, 0);
    fp_save(F, 1, OKP(float, WS_DTV), 16, 16, false, 0);
    fp_save(F, 2, OKP(float, WS_ACS), 16, 16, false, 0);
    GRID_BAR();
    {
        const size_t gid = (size_t)blockIdx.x * NT + F.tid, gs = (size_t)F.G * NT;
        for (int st = 0;; ++st) {
            const int s = st % sm::NSTAGE_L;
            if (st < 2 * sm::NSTAGE_L && s >= sm::N_STAGES_USED) continue;
            if (!sm::run_stage(a.oc, st, gid, gs)) break;
            GRID_BAR();
            if (st == 3) fp_cmp(F, 0, a.oc.proj, sm::PROJ_LD, 0, 4096, 0);
            if (st == 4) { fp_cmp(F, 1, a.oc.dtv, 16, 0, 16, 0); fp_cmp(F, 2, a.oc.acs, 16, 0, 16, 0); }
            if (st == 4 && gid == 0) { float* c = (float*)F.ctl + CW_CHK; c[6] = 0.f; c[7] = 1.f; c[8] = 0.f; c[9] = 1.f; c[10] = 0.f; c[11] = 1.f; }
            if (st == 5) fp_cmp_lin(F, 6, a.oc.states, ((size_t)5 * 16 + 0) * 8192, 65536);
            if (st == 6) fp_cmp_lin(F, 7, a.oc.states, ((size_t)5 * 16 + 0) * 8192, 65536);
            if (st == 10) { fp_cmp(F, 8, a.oc.cat, 1536, 0, 512, 0); fp_cmp(F, 9, a.oc.cat, 1536, 512, 1024, 0); }
            if (st == 11) fp_cmp(F, 10, a.oc.h, 1024, 0, 1024, 0);
            if (st == 18) fp_cmp(F, 11, a.oc.h, 1024, 0, 1024, 0);
            if (st == 23) fp_cmp(F, 12, a.oc.h, 1024, 0, 1024, 0);
            if (st == 63) { fp_cmp(F, 13, a.oc.proj, sm::PROJ_LD, 0, 4096, 0); fp_cmp(F, 13, a.oc.proj, sm::PROJ_LD, 4624, 1024, 4096); }
            if (st == 70) { fp_cmp(F, 14, a.oc.cat, 1536, 0, 1024, 0); fp_cmp(F, 15, a.oc.cat, 1536, 1024, 512, 0); }
            if (st == 71) fp_cmp(F, 16, a.oc.h, 1024, 0, 1024, 0);
            if (st == 78) fp_cmp(F, 17, a.oc.h, 1024, 0, 1024, 0);
            if (st == 121) fp_cmp(F, 18, a.oc.out, 1024, 0, 1024, 0);
            GRID_BAR();
        }
        GRID_BAR();
        int code = 0;
        for (int k = CHECK - 1; k >= 0; --k) { const float num = __hip_atomic_load((float*)F.ctl + CW_CHK + 2 * k, __ATOMIC_RELAXED, __HIP_MEMORY_SCOPE_AGENT), den = __hip_atomic_load((float*)F.ctl + CW_CHK + 2 * k + 1, __ATOMIC_RELAXED, __HIP_MEMORY_SCOPE_AGENT);
            if (!(num <= 1e-3f * den) || den == 0.f) code = k + 1; }
        const float sc = 1.f + 0.2f * (float)code;
        for (size_t i = gid; i < (size_t)L * DM; i += gs) { F.out[i] *= sc; F.out[(size_t)L * DM + i] = 0.f; }
    }
#endif
}
}

extern "C" void kernel_launch(void* const* d_in, const int* in_sizes, int n_in, void* d_out, int out_size, void* d_ws, size_t ws_size, hipStream_t stream) {
    static int grid = 0;
    if (grid == 0) {
        int dev = 0, cus = 0, per_cu = 0;
        hipGetDevice(&dev); hipDeviceGetAttribute(&cus, hipDeviceAttributeMultiprocessorCount, dev);
        if (hipFuncSetAttribute((const void*)ok::mk_fwd, hipFuncAttributeMaxDynamicSharedMemorySize, LDS_BYTES) != hipSuccess) { fprintf(stderr, "kernel_launch: hipFuncSetAttribute failed\n"); grid = -1; return; }
        hipOccupancyMaxActiveBlocksPerMultiprocessor(&per_cu, (const void*)ok::mk_fwd, ok::NT, LDS_BYTES);
        (void)hipGetLastError();
        grid = cus;
        if (n_in != 33 || ws_size < ok::WS_END || per_cu < 1) { fprintf(stderr, "kernel_launch: n_in %d ws %zu need %zu per_cu %d\n", n_in, ws_size, (size_t)ok::WS_END, per_cu); grid = -1; }
    }
    if (grid < 0) return;
    hipMemsetAsync((char*)d_ws + ok::WS_CTL, 0, ok::CTL_BYTES, stream);
    ok::Args a{};
    for (int i = 0; i < 33; ++i) a.in[i] = (const float*)d_in[i];
    a.out = (float*)d_out; a.ws = (unsigned char*)d_ws;
#if CHECK
    sm::carve(a.oc, (float*)((char*)d_ws + 16 * ok::MiB));
    for (int i = 0; i < 33; ++i) a.oc.in[i] = (const float*)d_in[i];
    a.oc.out = (float*)d_out;
#endif
    hipLaunchKernelGGL(ok::mk_fwd, dim3(grid), dim3(ok::NT), LDS_BYTES, stream, a);
}
```

```cpp
#include <hip/hip_runtime.h>
#include <cstdio>
#include <cstdint>
#ifndef CHECK
#define CHECK 0
#endif
#define DUP_MASK 0
constexpr int LDS_BYTES = 147456;

#define XB_TMO      128
#define XB_XCNT(j)  (256  + 64 * (j))
#define XB_XSUB(j)  (1280 + 64 * (j))
#define XB_XGEN(j)  (2304 + 64 * (j))
#define XB_TOP      3328
#define XB_TOPGEN   3392
#define XCD_BAR_WORDS 3456
#define XB_SPIN_CAP (1u << 18)
#define LAS __attribute__((address_space(3)))

__device__ __forceinline__ unsigned xb_ld(unsigned* p)              { return __hip_atomic_load(p, __ATOMIC_RELAXED, __HIP_MEMORY_SCOPE_AGENT); }
__device__ __forceinline__ unsigned xb_add(unsigned* p, unsigned v) { return __hip_atomic_fetch_add(p, v, __ATOMIC_RELAXED, __HIP_MEMORY_SCOPE_AGENT); }
__device__ __forceinline__ unsigned xb_xcc_id() { return (unsigned)__builtin_amdgcn_s_getreg((3 << 11) | 20) & 0xFu; }
#define XB_SPIN(cond, bar) do { unsigned _sp = 0; while (cond) { __builtin_amdgcn_s_sleep(1); \
    if ((++_sp & 255u) == 0u) { if (xb_ld(&(bar)[XB_TMO])) break; if (_sp > XB_SPIN_CAP) { atomicAdd(&(bar)[XB_TMO], 1u); break; } } } } while (0)

struct XcdBarrier {
    unsigned* bar; unsigned x;
    volatile LAS unsigned* st;
};

__device__ __forceinline__ XcdBarrier xcd_barrier_post(unsigned* bar, volatile LAS unsigned* st) {
    XcdBarrier b; b.bar = bar; b.x = xb_xcc_id(); b.st = st;
    if (threadIdx.x == 0) (void)xb_add(&bar[XB_XCNT(b.x)], 1u);
    return b;
}
__device__ __forceinline__ void xcd_barrier_complete(unsigned* bar, unsigned x, unsigned& nloc, unsigned& nx) {
    const unsigned G = gridDim.x * gridDim.y * gridDim.z;
    unsigned sum, cnt, mine, sp = 0u;
    for (;;) {
        sum = 0u; cnt = 0u; mine = 0u;
#pragma unroll
        for (unsigned j = 0; j < 16; ++j) { const unsigned c = xb_ld(&bar[XB_XCNT(j)]); sum += c; cnt += (c > 0u) ? 1u : 0u; mine = (j == x) ? c : mine; }
        if (sum == G) break;
        __builtin_amdgcn_s_sleep(1);
        if ((++sp & 255u) == 0u) { if (xb_ld(&bar[XB_TMO])) break; if (sp > XB_SPIN_CAP) { atomicAdd(&bar[XB_TMO], 1u); break; } }
    }
    nloc = mine > 0u ? mine : 1u; nx = cnt > 0u ? cnt : 1u;
}

__device__ __forceinline__ void xcd_barrier(const XcdBarrier& b) {
    asm volatile("s_waitcnt vmcnt(0)" ::: "memory");
    __syncthreads();
    if (threadIdx.x == 0) {
        unsigned* bar = b.bar;
        __builtin_amdgcn_s_waitcnt(0);
        unsigned nloc = b.st[0], nx = b.st[1];
        if (nloc == 0u) { xcd_barrier_complete(bar, b.x, nloc, nx); b.st[0] = nloc; b.st[1] = nx; }
        const unsigned old = xb_add(&bar[XB_XSUB(b.x)], 1u);
        const unsigned gen = old / nloc;
        if (old + 1u == (gen + 1u) * nloc) {
            __builtin_amdgcn_fence(__ATOMIC_RELEASE, "agent");
            asm volatile("s_waitcnt vmcnt(0)" ::: "memory");
            const unsigned og = xb_add(&bar[XB_TOP], 1u);
            const unsigned tg = og / nx;
            if (og + 1u == (tg + 1u) * nx) xb_add(&bar[XB_TOPGEN], 1u);
            else XB_SPIN(xb_ld(&bar[XB_TOPGEN]) == tg, bar);
            __builtin_amdgcn_fence(__ATOMIC_ACQUIRE, "agent");
            xb_add(&bar[XB_XGEN(b.x)], 1u);
            asm volatile("s_waitcnt vmcnt(0)" ::: "memory");
        } else {
            XB_SPIN(xb_ld(&bar[XB_XGEN(b.x)]) == gen, bar);
            __builtin_amdgcn_fence(__ATOMIC_ACQUIRE, "agent");
            asm volatile("s_waitcnt vmcnt(0)" ::: "memory");
        }
    }
    __syncthreads();
}


#undef LAS

#ifndef SEQ
#define SEQ 8192
#endif
namespace sm {
constexpr int DM = 1024, NB = 1  , L = SEQ, T = NB * L, NCH = L / 64, MEM = 256;
constexpr int EV_IN = 4112, OD_IN = 5648, PROJ_LD = 5648;
constexpr int E_SCB = 0, E_SCC = 512, E_SCX = 1024, E_Z = 1536, E_XBC = 2560, E_DT = 4096;
constexpr int O_QKV = 0, O_Z = 3072, O_A = 4096, O_B = 4104, O_SQ = 4112, O_SK = 4624, O_SV = 5136;

struct Ctx {
    const float* in[33];
    float* out;
    float *memn, *kx, *vx, *h, *un, *rstd, *proj, *cat, *xbcc, *dtv, *acs, *states, *cb, *ybuf, *rstd2;
    float *q, *att, *sc;
    float *gatew, *act; int* eid;
    float *qkvc, *beta, *gcs, *Lm, *aqk, *uw, *S, *vn, *obuf;
};
enum In { I_X = 0, I_MEM, I_MEM_NORM, I_FINAL_NORM, I_NORM_MIX, I_NORM_XA, I_NORM_FFN, I_XA_WQ, I_XA_WK, I_XA_WV, I_XA_WO,
          I_MOE_WG, I_MOE_BG, I_MOE_WE, I_MOE_BE, I_MOE_WGATE, I_MOE_WUP, I_MOE_WDOWN,
          I_EV_WIN, I_EV_SCCONV, I_EV_CONVW, I_EV_CONVB, I_EV_DTB, I_EV_ALOG, I_EV_D, I_EV_NORM, I_EV_WOUT,
          I_OD_WIN, I_OD_CONV, I_OD_DTB, I_OD_ALOG, I_OD_NORM, I_OD_WOUT };

__device__ __forceinline__ float siluf(float x) { return x / (1.f + expf(-x)); }
__device__ __forceinline__ float softplusf(float x) { return x > 20.f ? x : log1pf(expf(x)); }
__device__ __forceinline__ float sigmoidf(float x) { return 1.f / (1.f + expf(-x)); }

__device__ __forceinline__ void s_copy(const float* src, float* dst, size_t n, size_t gid, size_t gs) { for (size_t i = gid; i < n; i += gs) dst[i] = src[i]; }
__device__ __forceinline__ void s_rstd(const float* x, int R, int W, int ld, float* rstd, size_t gid, size_t gs) {
    for (size_t r = gid; r < (size_t)R; r += gs) { const float* p = x + r * ld; float s = 0.f; for (int i = 0; i < W; ++i) s += p[i] * p[i]; rstd[r] = 1.f / sqrtf(s / W + 1e-6f); }
}
__device__ __forceinline__ void s_norm(const float* x, const float* rstd, const float* g, float* y, int R, size_t gid, size_t gs) {
    for (size_t i = gid; i < (size_t)R * DM; i += gs) { const size_t r = i / DM; const int c = (int)(i % DM); y[i] = x[i] * rstd[r] * g[c]; }
}
__device__ __forceinline__ void s_gemm(const float* A, int lda, const float* W, int ldw, float* C, int ldc, int M, int N, int K, int accum, size_t gid, size_t gs) {
    const int N4 = N / 4;
    for (size_t i = gid; i < (size_t)M * N4; i += gs) { const size_t m = i / N4; const int n = (int)(i % N4) * 4; const float* a = A + m * lda; const float* w = W + n; float s0 = 0.f, s1 = 0.f, s2 = 0.f, s3 = 0.f;
        for (int k = 0; k < K; ++k) { const float av = a[k]; const float4 wv = *(const float4*)(w + (size_t)k * ldw); s0 += av * wv.x; s1 += av * wv.y; s2 += av * wv.z; s3 += av * wv.w; }
        float4* c = (float4*)(C + m * ldc + n); float4 o = accum ? *c : float4{0.f, 0.f, 0.f, 0.f}; o.x += s0; o.y += s1; o.z += s2; o.w += s3; *c = o; }
}
__device__ __forceinline__ void s_scmix(const Ctx& c, size_t gid, size_t gs) {
    const float* w = c.in[I_EV_SCCONV];
    for (size_t i = gid; i < (size_t)T * 512; i += gs) { const size_t t = i / 512; const int ch = (int)(i % 512); const int tl = (int)(t % L); float s = 0.f;
        for (int j = 0; j < 3; ++j) { const int tt = tl - 2 + j; if (tt >= 0) { const float* p = c.proj + (t - 2 + j) * PROJ_LD; s += w[j * 512 + ch] * p[E_SCC + ch] * p[E_SCX + ch]; } }
        c.cat[t * 1536 + ch] = c.proj[t * PROJ_LD + E_SCB + ch] * s; }
}
__device__ __forceinline__ void s_ssd_conv(const Ctx& c, size_t gid, size_t gs) {
    const float* w = c.in[I_EV_CONVW]; const float* b = c.in[I_EV_CONVB];
    for (size_t i = gid; i < (size_t)T * 1536; i += gs) { const size_t t = i / 1536; const int ch = (int)(i % 1536); const int tl = (int)(t % L); float s = b[ch];
        for (int j = 0; j < 4; ++j) { const int tt = tl - 3 + j; if (tt >= 0) s += w[j * 1536 + ch] * c.proj[(t - 3 + j) * PROJ_LD + E_XBC + ch]; }
        c.xbcc[i] = siluf(s); }
}
__device__ __forceinline__ void s_ssd_dt(const Ctx& c, size_t gid, size_t gs) {
    for (size_t i = gid; i < (size_t)NB * NCH * 16; i += gs) { const int hd = (int)(i % 16); const size_t bc = i / 16; const float a = -expf(c.in[I_EV_ALOG][hd]); float cs = 0.f;
        for (int s = 0; s < 64; ++s) { const size_t t = bc * 64 + s; const float dt = softplusf(c.proj[t * PROJ_LD + E_DT + hd] + c.in[I_EV_DTB][hd]); cs += dt * a; c.dtv[t * 16 + hd] = dt; c.acs[t * 16 + hd] = cs; } }
}
__device__ __forceinline__ void s_ssd_states(const Ctx& c, size_t gid, size_t gs) {
    for (size_t i = gid; i < (size_t)NB * NCH * 16 * 64 * 128; i += gs) { const int n = (int)(i % 128); const int p = (int)((i / 128) % 64); const int hd = (int)((i / 8192) % 16); const size_t bc = i / (8192 * 16);
        const int g = hd / 8; const float last = c.acs[(bc * 64 + 63) * 16 + hd]; float s = 0.f;
        for (int k = 0; k < 64; ++k) { const size_t t = bc * 64 + k; s += c.xbcc[t * 1536 + 1024 + g * 128 + n] * c.xbcc[t * 1536 + hd * 64 + p] * c.dtv[t * 16 + hd] * expf(last - c.acs[t * 16 + hd]); }
        c.states[i] = s; }
}
__device__ __forceinline__ void s_ssd_scan(const Ctx& c, size_t gid, size_t gs) {
    for (size_t i = gid; i < (size_t)NB * 16 * 8192; i += gs) { const size_t b = i / (16 * 8192); const size_t r = i % (16 * 8192); const int hd = (int)(r / 8192); float s = 0.f;
        for (int ch = 0; ch < NCH; ++ch) { const size_t bc = b * NCH + ch; const size_t idx = bc * (16 * 8192) + r; const float st = c.states[idx]; c.states[idx] = s; s = s * expf(c.acs[(bc * 64 + 63) * 16 + hd]) + st; } }
}
__device__ __forceinline__ void s_ssd_cb(const Ctx& c, size_t gid, size_t gs) {
    for (size_t i = gid; i < (size_t)NB * NCH * 2 * 4096; i += gs) { const int s = (int)(i % 64); const int t = (int)((i / 64) % 64); const int g = (int)((i / 4096) % 2); const size_t bc = i / 8192;
        const float* cm = c.xbcc + (bc * 64 + t) * 1536 + 1280 + g * 128; const float* bm = c.xbcc + (bc * 64 + s) * 1536 + 1024 + g * 128; float a = 0.f;
        for (int n = 0; n < 128; ++n) a += cm[n] * bm[n];
        c.cb[i] = a; }
}
__device__ __forceinline__ void s_ssd_y(const Ctx& c, size_t gid, size_t gs) {
    for (size_t i = gid; i < (size_t)T * 1024; i += gs) { const size_t t = i / 1024; const int hp = (int)(i % 1024); const int hd = hp / 64, p = hp % 64, g = hd / 8; const size_t bc = t / 64; const int tl = (int)(t % 64);
        const float at = c.acs[t * 16 + hd]; float y = 0.f;
        for (int s = 0; s <= tl; ++s) { const size_t ts = bc * 64 + s; y += c.cb[(bc * 2 + g) * 4096 + tl * 64 + s] * expf(at - c.acs[ts * 16 + hd]) * c.xbcc[ts * 1536 + hp] * c.dtv[ts * 16 + hd]; }
        const float* cm = c.xbcc + t * 1536 + 1280 + g * 128; const float* pv = c.states + (bc * 16 + hd) * 8192 + p * 128; float yo = 0.f;
        for (int n = 0; n < 128; ++n) yo += cm[n] * pv[n];
        y += yo * expf(at) + c.xbcc[t * 1536 + hp] * c.in[I_EV_D][hd];
        c.ybuf[i] = y * siluf(c.proj[t * PROJ_LD + E_Z + hp]); }
}
__device__ __forceinline__ void s_ssd_out(const Ctx& c, size_t gid, size_t gs) {
    for (size_t i = gid; i < (size_t)T * 1024; i += gs) { const size_t t = i / 1024; const int ch = (int)(i % 1024); c.cat[t * 1536 + 512 + ch] = c.ybuf[i] * c.rstd2[t * 2 + ch / 512] * c.in[I_EV_NORM][ch]; }
}
__device__ __forceinline__ void s_xa_scores(const Ctx& c, size_t gid, size_t gs) {
    for (size_t i = gid; i < (size_t)T * 4 * 256; i += gs) { const int m = (int)(i % 256); const int hd = (int)((i / 256) % 4); const size_t t = i / 1024; const size_t b = t / L;
        const float* q = c.q + t * 1024 + hd * 256; const float* k = c.kx + (b * 256 + m) * 1024 + hd * 256; float s = 0.f;
        for (int d = 0; d < 256; ++d) s += q[d] * k[d];
        c.sc[i] = s * 0.0625f; }
}
__device__ __forceinline__ void s_xa_softmax(const Ctx& c, size_t gid, size_t gs) {
    for (size_t i = gid; i < (size_t)T * 4; i += gs) { float* p = c.sc + i * 256; float mx = p[0]; for (int m = 1; m < 256; ++m) mx = fmaxf(mx, p[m]); float s = 0.f; for (int m = 0; m < 256; ++m) { const float e = expf(p[m] - mx); p[m] = e; s += e; } const float r = 1.f / s; for (int m = 0; m < 256; ++m) p[m] *= r; }
}
__device__ __forceinline__ void s_xa_pv(const Ctx& c, size_t gid, size_t gs) {
    for (size_t i = gid; i < (size_t)T * 1024; i += gs) { const size_t t = i / 1024; const int col = (int)(i % 1024); const int hd = col / 256; const size_t b = t / L; const float* p = c.sc + (t * 4 + hd) * 256; const float* v = c.vx + b * 256 * 1024 + col; float s = 0.f;
        for (int m = 0; m < 256; ++m) s += p[m] * v[(size_t)m * 1024];
        c.att[i] = s; }
}
__device__ __forceinline__ void s_router(const Ctx& c, int l, size_t gid, size_t gs) {
    const float* wg = c.in[I_MOE_WG] + (size_t)l * 1024 * 4; const float* bg = c.in[I_MOE_BG] + l * 4; const float* we = c.in[I_MOE_WE] + (size_t)l * 1024 * 32; const float* be = c.in[I_MOE_BE] + l * 32;
    for (size_t t = gid; t < (size_t)T; t += gs) { const float* x = c.un + t * 1024; float g0 = 0.f, g1 = 0.f, g2 = 0.f, g3 = 0.f;
        for (int k = 0; k < 1024; ++k) { const float xv = x[k]; g0 += xv * wg[k * 4 + 0]; g1 += xv * wg[k * 4 + 1]; g2 += xv * wg[k * 4 + 2]; g3 += xv * wg[k * 4 + 3]; }
        g0 += bg[0]; g1 += bg[1]; g2 += bg[2]; g3 += bg[3];
        int gsel = 0; float gm = g0; if (g1 > gm) { gm = g1; gsel = 1; } if (g2 > gm) { gm = g2; gsel = 2; } if (g3 > gm) { gm = g3; gsel = 3; }
        const float gw = 1.f / (expf(g0 - gm) + expf(g1 - gm) + expf(g2 - gm) + expf(g3 - gm));
        float e0 = 0, e1 = 0, e2 = 0, e3 = 0, e4 = 0, e5 = 0, e6 = 0, e7 = 0; const float* w = we + gsel * 8;
        for (int k = 0; k < 1024; ++k) { const float xv = x[k]; const float* wk = w + k * 32; e0 += xv * wk[0]; e1 += xv * wk[1]; e2 += xv * wk[2]; e3 += xv * wk[3]; e4 += xv * wk[4]; e5 += xv * wk[5]; e6 += xv * wk[6]; e7 += xv * wk[7]; }
        const float* bb = be + gsel * 8; e0 += bb[0]; e1 += bb[1]; e2 += bb[2]; e3 += bb[3]; e4 += bb[4]; e5 += bb[5]; e6 += bb[6]; e7 += bb[7];
        int i1 = 0; float m1 = e0;
#define SM_T1(j, v) if (v > m1) { m1 = v; i1 = j; }
        SM_T1(1, e1) SM_T1(2, e2) SM_T1(3, e3) SM_T1(4, e4) SM_T1(5, e5) SM_T1(6, e6) SM_T1(7, e7)
        int i2 = -1; float m2 = -3.0e38f;
#define SM_T2(j, v) if (j != i1 && v > m2) { m2 = v; i2 = j; }
        SM_T2(0, e0) SM_T2(1, e1) SM_T2(2, e2) SM_T2(3, e3) SM_T2(4, e4) SM_T2(5, e5) SM_T2(6, e6) SM_T2(7, e7)
        const float r = expf(m2 - m1); const float w1 = gw / (1.f + r), w2 = gw * r / (1.f + r);
        c.eid[t * 2 + 0] = gsel * 8 + i1; c.eid[t * 2 + 1] = gsel * 8 + i2; c.gatew[t * 2 + 0] = w1; c.gatew[t * 2 + 1] = w2; }
}
__device__ __forceinline__ void s_moe_up(const Ctx& c, int l, size_t gid, size_t gs) {
    for (size_t i = gid; i < (size_t)T * 2 * 512; i += gs) { const int f = (int)(i % 512); const size_t tk = i / 512; const size_t t = tk / 2; const int e = c.eid[tk] & 31;
        const float* wg = c.in[I_MOE_WGATE] + ((size_t)l * 32 + e) * 1024 * 512 + f; const float* wu = c.in[I_MOE_WUP] + ((size_t)l * 32 + e) * 1024 * 512 + f; const float* x = c.un + t * 1024; float a = 0.f, b = 0.f;
        for (int k = 0; k < 1024; ++k) { a += x[k] * wg[(size_t)k * 512]; b += x[k] * wu[(size_t)k * 512]; }
        c.act[i] = siluf(a) * b; }
}
__device__ __forceinline__ void s_moe_down(const Ctx& c, int l, size_t gid, size_t gs) {
    for (size_t i = gid; i < (size_t)T * 1024; i += gs) { const size_t t = i / 1024; const int n = (int)(i % 1024); float y = 0.f;
        for (int k = 0; k < 2; ++k) { const int e = c.eid[t * 2 + k] & 31; const float* wd = c.in[I_MOE_WDOWN] + ((size_t)l * 32 + e) * 512 * 1024 + n; const float* a = c.act + (t * 2 + k) * 512; float s = 0.f;
            for (int f = 0; f < 512; ++f) s += a[f] * wd[(size_t)f * 1024];
            y += s * c.gatew[t * 2 + k]; }
        c.h[i] += y; }
}
__device__ __forceinline__ void s_gdn_conv(const Ctx& c, size_t gid, size_t gs) {
    const float* w = c.in[I_OD_CONV];
    for (size_t i = gid; i < (size_t)T * 3072; i += gs) { const size_t t = i / 3072; const int ch = (int)(i % 3072); const int tl = (int)(t % L); float s = 0.f;
        for (int j = 0; j < 4; ++j) { const int tt = tl - 3 + j; if (tt >= 0) s += w[j * 3072 + ch] * c.proj[(t - 3 + j) * PROJ_LD + O_QKV + ch]; }
        c.qkvc[i] = siluf(s); }
}
__device__ __forceinline__ void s_gdn_qkscale(const Ctx& c, size_t gid, size_t gs) {
    for (size_t i = gid; i < (size_t)T * 16; i += gs) { const size_t t = i / 16; const int wh = (int)(i % 16); float* p = c.qkvc + t * 3072 + wh * 128; float s = 0.f; for (int d = 0; d < 128; ++d) s += p[d] * p[d];
        float r = 1.f / sqrtf(s + 1e-6f); if (wh < 8) r *= 0.08838834764831845f; for (int d = 0; d < 128; ++d) p[d] *= r; }
}
__device__ __forceinline__ void s_gdn_gates(const Ctx& c, size_t gid, size_t gs) {
    for (size_t i = gid; i < (size_t)NB * NCH * 8; i += gs) { const int hd = (int)(i % 8); const size_t bc = i / 8; const float na = -expf(c.in[I_OD_ALOG][hd]); const float db = c.in[I_OD_DTB][hd]; float cs = 0.f;
        for (int s = 0; s < 64; ++s) { const size_t t = bc * 64 + s; cs += na * softplusf(c.proj[t * PROJ_LD + O_A + hd] + db); c.gcs[t * 8 + hd] = cs; c.beta[t * 8 + hd] = sigmoidf(c.proj[t * PROJ_LD + O_B + hd]); } }
}
__device__ __forceinline__ void s_gdn_kk(const Ctx& c, size_t gid, size_t gs) {
    for (size_t i = gid; i < (size_t)NB * NCH * 8 * 4096; i += gs) { const int s = (int)(i % 64); const int t = (int)((i / 64) % 64); const int hd = (int)((i / 4096) % 8); const size_t bc = i / (4096 * 8);
        float lv = 0.f, av = 0.f;
        if (s <= t) { const size_t tt = bc * 64 + t, ts = bc * 64 + s; const float* kt = c.qkvc + tt * 3072 + 1024 + hd * 128; const float* ks = c.qkvc + ts * 3072 + 1024 + hd * 128; const float* qt = c.qkvc + tt * 3072 + hd * 128; float kk = 0.f, qk = 0.f;
            for (int d = 0; d < 128; ++d) { kk += kt[d] * ks[d]; qk += qt[d] * ks[d]; }
            const float dec = expf(c.gcs[tt * 8 + hd] - c.gcs[ts * 8 + hd]); av = qk * dec; if (s < t) lv = kk * c.beta[tt * 8 + hd] * dec; }
        c.Lm[i] = lv; c.aqk[i] = av; }
}
__device__ __forceinline__ void s_gdn_solve(const Ctx& c, size_t gid, size_t gs) {
    for (size_t i = gid; i < (size_t)NB * NCH * 8 * 256; i += gs) { const int j = (int)(i % 256); const int hd = (int)((i / 256) % 8); const size_t bc = i / 2048; float* sol = c.uw + (bc * 8 + hd) * (64 * 256) + j; const float* Lp = c.Lm + (bc * 8 + hd) * 4096;
        for (int t = 0; t < 64; ++t) { const size_t tt = bc * 64 + t; const float bt = c.beta[tt * 8 + hd];
            float r = (j < 128) ? c.qkvc[tt * 3072 + 2048 + hd * 128 + j] * bt : c.qkvc[tt * 3072 + 1024 + hd * 128 + (j - 128)] * bt * expf(c.gcs[tt * 8 + hd]);
            for (int s = 0; s < t; ++s) r -= Lp[t * 64 + s] * sol[(size_t)s * 256];
            sol[(size_t)t * 256] = r; } }
}
__device__ __forceinline__ void s_gdn_scan(const Ctx& c, size_t gid, size_t gs) {
    for (size_t i = gid; i < (size_t)NB * 8 * 128; i += gs) { const int j = (int)(i % 128); const size_t bh = i / 128; const int hd = (int)(bh % 8); const size_t b = bh / 8; float* S = c.S + bh * 16384 + j; float* vn = c.vn + bh * 8192 + j;
        for (int d = 0; d < 128; ++d) S[(size_t)d * 128] = 0.f;
        for (int ch = 0; ch < NCH; ++ch) { const size_t bc = b * NCH + ch; const float* uw = c.uw + (bc * 8 + hd) * (64 * 256); const float* aq = c.aqk + (bc * 8 + hd) * 4096; const float glast = c.gcs[(bc * 64 + 63) * 8 + hd];
            for (int t = 0; t < 64; ++t) { float v = uw[t * 256 + j]; const float* w = uw + t * 256 + 128; for (int d = 0; d < 128; ++d) v -= w[d] * S[(size_t)d * 128]; vn[(size_t)t * 128] = v; }
            for (int t = 0; t < 64; ++t) { const size_t tt = bc * 64 + t; const float* q = c.qkvc + tt * 3072 + hd * 128; float o = 0.f; for (int d = 0; d < 128; ++d) o += q[d] * S[(size_t)d * 128];
                o *= expf(c.gcs[tt * 8 + hd]); for (int s = 0; s <= t; ++s) o += aq[t * 64 + s] * vn[(size_t)s * 128];
                c.obuf[tt * 1024 + hd * 128 + j] = o; }
            const float dl = expf(glast);
            for (int d = 0; d < 128; ++d) { float a = S[(size_t)d * 128] * dl; for (int t = 0; t < 64; ++t) { const size_t tt = bc * 64 + t; a += c.qkvc[tt * 3072 + 1024 + hd * 128 + d] * expf(glast - c.gcs[tt * 8 + hd]) * vn[(size_t)t * 128]; } S[(size_t)d * 128] = a; } } }
}
__device__ __forceinline__ void s_gdn_out(const Ctx& c, size_t gid, size_t gs) {
    for (size_t i = gid; i < (size_t)T * 1024; i += gs) { const size_t t = i / 1024; const int col = (int)(i % 1024); c.cat[t * 1536 + col] = c.obuf[i] * c.rstd2[t * 8 + col / 128] * c.in[I_OD_NORM][col % 128] * siluf(c.proj[t * PROJ_LD + O_Z + col]); }
}
__device__ __forceinline__ void s_sb(const Ctx& c, size_t gid, size_t gs) {
    for (size_t i = gid; i < (size_t)T * 32; i += gs) { const int qd = (int)(i % 4); const int hd = (int)((i / 4) % 8); const size_t t = i / 32; const int tl = (int)(t % L); const float* q = c.proj + t * PROJ_LD + O_SQ + hd * 64;
        float o[16];
#pragma unroll
        for (int d = 0; d < 16; ++d) o[d] = 0.f;
        float carry = 0.f;
        for (int s = tl - 1; s >= 0 && carry > -150.f; --s) { const size_t ts = t - (size_t)(tl - s); const float* k = c.proj + ts * PROJ_LD + O_SK + hd * 64; const float* v = c.proj + ts * PROJ_LD + O_SV + hd * 64 + qd * 16; float lg = 0.f;
            for (int d = 0; d < 64; ++d) lg += q[d] * k[d];
            lg *= 0.125f; const float wgt = expf(-softplusf(-lg) + carry); carry -= softplusf(lg);
#pragma unroll
            for (int d = 0; d < 16; ++d) o[d] += wgt * v[d]; }
#pragma unroll
        for (int d = 0; d < 16; ++d) c.cat[t * 1536 + 1024 + hd * 64 + qd * 16 + d] = o[d]; }
}
__device__ __forceinline__ void s_final(const Ctx& c, size_t gid, size_t gs) { s_norm(c.h, c.rstd, c.in[I_FINAL_NORM], c.out, T, gid, gs); }

constexpr int XA_BASE = 20, MOE_BASE = 30, L1_BASE = 40, NSTAGE_L = 60;
__device__ __forceinline__ bool run_stage(const Ctx& c, int st, size_t gid, size_t gs) {
    const int layer = st / NSTAGE_L, s = st % NSTAGE_L;
    if (st >= 2 * NSTAGE_L + 2) return false;
    if (st == 2 * NSTAGE_L) { s_rstd(c.h, T, DM, DM, c.rstd, gid, gs); return true; }
    if (st == 2 * NSTAGE_L + 1) { s_final(c, gid, gs); return true; }
    const int l = layer;
    switch (s) {
    case 0: if (l == 0) { s_copy(c.in[I_X], c.h, (size_t)T * DM, gid, gs); s_rstd(c.in[I_MEM], NB * MEM, DM, DM, c.rstd2, gid, gs); } break;
    case 1: if (l == 0) s_norm(c.in[I_MEM], c.rstd2, c.in[I_MEM_NORM], c.memn, NB * MEM, gid, gs); s_rstd(c.h, T, DM, DM, c.rstd, gid, gs); break;
    case 2: s_norm(c.h, c.rstd, c.in[I_NORM_MIX] + l * DM, c.un, T, gid, gs); break;
    case 3: if (l == 0) s_gemm(c.un, DM, c.in[I_EV_WIN], EV_IN, c.proj, PROJ_LD, T, EV_IN, DM, 0, gid, gs); else s_gemm(c.un, DM, c.in[I_OD_WIN], OD_IN, c.proj, PROJ_LD, T, OD_IN, DM, 0, gid, gs); break;
    case 4: if (l == 0) { s_scmix(c, gid, gs); s_ssd_conv(c, gid, gs); s_ssd_dt(c, gid, gs); } else { s_gdn_conv(c, gid, gs); s_gdn_gates(c, gid, gs); s_sb(c, gid, gs); } break;
    case 5: if (l == 0) { s_ssd_states(c, gid, gs); s_ssd_cb(c, gid, gs); } else s_gdn_qkscale(c, gid, gs); break;
    case 6: if (l == 0) s_ssd_scan(c, gid, gs); else s_gdn_kk(c, gid, gs); break;
    case 7: if (l == 0) s_ssd_y(c, gid, gs); else s_gdn_solve(c, gid, gs); break;
    case 8: if (l == 0) s_rstd(c.ybuf, T * 2, 512, 512, c.rstd2, gid, gs); else s_gdn_scan(c, gid, gs); break;
    case 9: if (l == 0) s_ssd_out(c, gid, gs); else s_rstd(c.obuf, T * 8, 128, 128, c.rstd2, gid, gs); break;
    case 10: if (l == 1) s_gdn_out(c, gid, gs); break;
    case 11: s_gemm(c.cat, 1536, l == 0 ? c.in[I_EV_WOUT] : c.in[I_OD_WOUT], DM, c.h, DM, T, DM, 1536, 1, gid, gs); break;
    case 12: s_rstd(c.h, T, DM, DM, c.rstd, gid, gs); break;
    case 13: s_norm(c.h, c.rstd, c.in[I_NORM_XA] + l * DM, c.un, T, gid, gs); break;
    case 14: s_gemm(c.un, DM, c.in[I_XA_WQ] + (size_t)l * DM * DM, DM, c.q, DM, T, DM, DM, 0, gid, gs);
             s_gemm(c.memn, DM, c.in[I_XA_WK] + (size_t)l * DM * DM, DM, c.kx, DM, NB * MEM, DM, DM, 0, gid, gs);
             s_gemm(c.memn, DM, c.in[I_XA_WV] + (size_t)l * DM * DM, DM, c.vx, DM, NB * MEM, DM, DM, 0, gid, gs); break;
    case 15: s_xa_scores(c, gid, gs); break;
    case 16: s_xa_softmax(c, gid, gs); break;
    case 17: s_xa_pv(c, gid, gs); break;
    case 18: s_gemm(c.att, DM, c.in[I_XA_WO] + (size_t)l * DM * DM, DM, c.h, DM, T, DM, DM, 1, gid, gs); break;
    case 19: s_rstd(c.h, T, DM, DM, c.rstd, gid, gs); break;
    case 20: s_norm(c.h, c.rstd, c.in[I_NORM_FFN] + l * DM, c.un, T, gid, gs); break;
    case 21: s_router(c, l, gid, gs); break;
    case 22: s_moe_up(c, l, gid, gs); break;
    case 23: s_moe_down(c, l, gid, gs); break;
    default: break;
    }
    return true;
}
constexpr int N_STAGES_USED = 24;

__host__ __device__ __forceinline__ size_t carve(Ctx& c, float* w) {
    size_t o = 0;
    auto take = [&](size_t n) { float* p = w + o; o += (n + 63) & ~(size_t)63; return p; };
    c.h = take((size_t)T * DM); c.rstd = take(T); c.rstd2 = take((size_t)T * 8); c.memn = take((size_t)MEM * DM); c.kx = take((size_t)MEM * DM); c.vx = take((size_t)MEM * DM);
    c.eid = (int*)take((size_t)T * 2); c.gatew = take((size_t)T * 2); c.dtv = take((size_t)T * 16); c.acs = take((size_t)T * 16); c.beta = take((size_t)T * 8); c.gcs = take((size_t)T * 8);
    c.S = take(8 * 16384); c.vn = take(8 * 8192);
    c.un = take((size_t)T * DM); c.ybuf = c.un; c.obuf = c.un;
    c.proj = take((size_t)T * PROJ_LD);
    c.cat = take((size_t)T * 1536);
    const size_t d0 = o;
    c.xbcc = take((size_t)T * 1536); c.states = take((size_t)NCH * 16 * 8192); c.cb = take((size_t)NCH * 2 * 4096); size_t dmax = o;
    o = d0; c.qkvc = take((size_t)T * 3072); c.Lm = take((size_t)NCH * 8 * 4096); c.aqk = take((size_t)NCH * 8 * 4096); c.uw = take((size_t)NCH * 8 * 64 * 256); if (o > dmax) dmax = o;
    o = d0; c.q = take((size_t)T * DM); c.sc = take((size_t)T * DM); c.att = take((size_t)T * DM); if (o > dmax) dmax = o;
    o = d0; c.act = take((size_t)T * 2 * 512); if (o > dmax) dmax = o;
    return dmax;
}
}

namespace pg8 {
#define PG8_LAS __attribute__((address_space(3)))
typedef unsigned short bf16_t;
typedef short bf16x8 __attribute__((ext_vector_type(8)));
typedef float f32x4 __attribute__((ext_vector_type(4)));
typedef unsigned u32x4 __attribute__((ext_vector_type(4)));
constexpr int BM = 256, BK = 64, HALF = 128, HTB = HALF * BK * 2  , STAGE_BYTES = 8 * HTB, NXCD = 8, WGM = 8;

__host__ __device__ __forceinline__ int lds_byte(int r, int c) { const int st = (r >> 4) * 2 + (c >> 5), rr = r & 15, cc = c & 31, ob = rr * 64 + cc * 2; return st * 1024 + (ob ^ (((ob >> 9) & 1) << 5)); }
__host__ __device__ __forceinline__ void stage_rc(int b, int& R, int& C) { const int st = b / 1024, sb = b % 1024, swz = sb ^ (((sb >> 9) & 1) << 5); R = (st >> 1) * 16 + swz / 64; C = (st & 1) * 32 + (swz % 64) / 2; }
__host__ __device__ __forceinline__ int perm32(int rho) { const int n = rho >> 4, i = rho & 15; return 8 * (i >> 2) + 4 * n + (i & 3); }

struct Unit { int pm, pn, tag; const char* a; const char* b; };
struct Gemm { const bf16_t* A; const bf16_t* Bt; int M, N, K; };

struct StaticOrder {
    static constexpr bool LIGHT = false;
    int nM, nN, nwg, G, c; const char* A; const char* B; size_t tstep;
    __host__ __device__ void init(const Gemm& g, int G_, int c_) { nM = g.M / BM; nN = g.N / BM; nwg = nM * nN; G = G_; c = c_; A = (const char*)g.A; B = (const char*)g.Bt; tstep = (size_t)BM * g.K * 2; }
    __host__ __device__ bool next(int i, Unit& u) const {
        const long L = (long)i * G + c; if (L >= nwg) return false;
        int wgid = (int)L; { const int q = nwg / NXCD, r = nwg % NXCD, xcd = wgid % NXCD, off = wgid / NXCD; wgid = (xcd < r ? xcd * (q + 1) : r * (q + 1) + (xcd - r) * q) + off; }
        const int nig = WGM * nN, gid = wgid / nig, fm = gid * WGM, gsz = (nM - fm) < WGM ? (nM - fm) : WGM;
        u.pm = fm + ((wgid % nig) % gsz); u.pn = (wgid % nig) / gsz; u.a = A + (size_t)u.pm * tstep; u.b = B + (size_t)u.pn * tstep; return true;
    }
    __device__ __forceinline__ void a_ready(const Unit&) const {}
    __device__ __forceinline__ void done(const Unit&) const {}
};

template <class Epi, class Sched, bool ALIGN_EPI = false, bool SP2 = false>
__device__ __forceinline__ void gemm_phase(PG8_LAS unsigned char* lds, const Gemm g, const Sched& S, const Epi& E) {
    int tid_ = threadIdx.x; asm volatile("" : "+v"(tid_));
    const int tid = tid_, wid = __builtin_amdgcn_readfirstlane(tid >> 6), lane = tid & 63, wr = wid >> 2, wc = wid & 3, fr = lane & 15, fq = lane >> 4;
    const int K = g.K, nt = K / BK;
    unsigned voffA[2], voffB[2];
#pragma unroll
    for (int i = 0; i < 2; ++i) { int R, C; stage_rc(tid * 16 + i * 8192, R, C); const int Rb = Epi::PERM ? ((R & ~31) + perm32(R & 31)) : R;
        voffA[i] = (unsigned)(R * K + C) * 2u; voffB[i] = (unsigned)(Rb * K + C) * 2u; }
    const size_t kstep = (size_t)(BK * 2);
    const size_t hstep = (size_t)HALF * K * 2;
    const unsigned ldsw = (unsigned)wid * 1024u;
    const int aoff = lds_byte(wr * 64 + fr, fq * 8), boff = lds_byte(wc * 32 + fr, fq * 8);
#define PG8_SA(b, h) (((b) * 2 + (h)) * HTB)
#define PG8_SB(b, h) ((4 + (b) * 2 + (h)) * HTB)
#define PG8_STAGE(bufoff, gbase, voff) do { _Pragma("unroll") for (int _i = 0; _i < 2; ++_i) \
        __builtin_amdgcn_global_load_lds((const unsigned*)((const char*)(gbase) + (voff)[_i]), (PG8_LAS unsigned*)(lds + (bufoff) + ldsw + _i * 8192), 16, 0, 0); } while (0)
#define PG8_LDA(dst, b, h) do { _Pragma("unroll") for (int m = 0; m < 4; ++m) _Pragma("unroll") for (int k = 0; k < 2; ++k) dst[m][k] = *(const PG8_LAS bf16x8*)(lds + PG8_SA(b, h) + aoff + m * 2048 + k * 1024); } while (0)
#define PG8_LDB(dst, b, h) do { _Pragma("unroll") for (int n = 0; n < 2; ++n) _Pragma("unroll") for (int k = 0; k < 2; ++k) dst[n][k] = *(const PG8_LAS bf16x8*)(lds + PG8_SB(b, h) + boff + n * 2048 + k * 1024); } while (0)
#define PG8_MMA(ai, bj, At, Bt) do { __builtin_amdgcn_s_setprio(1); _Pragma("unroll") for (int m = 0; m < 4; ++m) _Pragma("unroll") for (int n = 0; n < 2; ++n) _Pragma("unroll") for (int k = 0; k < 2; ++k) \
        acc[ai][bj][m][n] = __builtin_amdgcn_mfma_f32_16x16x32_bf16(Bt[n][k], At[m][k], acc[ai][bj][m][n], 0, 0, 0); __builtin_amdgcn_s_setprio(0); } while (0)
#define PG8_WAIT_V(n) asm volatile("s_waitcnt vmcnt(" #n ")" ::: "memory")
#define PG8_WAIT_L(n) asm volatile("s_waitcnt lgkmcnt(" #n ")" ::: "memory")
#define PG8_BAR __builtin_amdgcn_s_barrier()
#define PG8_SCHED __builtin_amdgcn_sched_barrier(0)
    Unit cur, nxt; int ui = 0;
    if (!S.next(0, cur)) return;
    f32x4 acc[2][2][4][2];
#pragma unroll
    for (int a = 0; a < 2; ++a)
#pragma unroll
        for (int b = 0; b < 2; ++b)
#pragma unroll
            for (int m = 0; m < 4; ++m)
#pragma unroll
                for (int n = 0; n < 2; ++n) acc[a][b][m][n] = (f32x4){0.f, 0.f, 0.f, 0.f};
    bf16x8 At[4][2], B0[2][2], B1[2][2];
    const char* cA = cur.a; const char* cB = cur.b;
    S.a_ready(cur);
    if constexpr (SP2) {
        PG8_STAGE(PG8_SB(0, 0), cB, voffB); PG8_STAGE(PG8_SB(0, 1), cB + hstep, voffB); PG8_STAGE(PG8_SA(0, 0), cA, voffA); PG8_STAGE(PG8_SA(0, 1), cA + hstep, voffA);
        if (wr == 1) PG8_BAR;
        PG8_WAIT_V(2); PG8_BAR;
        PG8_STAGE(PG8_SB(1, 0), cB + kstep, voffB); PG8_STAGE(PG8_SA(1, 0), cA + kstep, voffA); PG8_STAGE(PG8_SB(1, 1), cB + hstep + kstep, voffB);
        PG8_WAIT_V(6); PG8_BAR;
    } else {
        PG8_STAGE(PG8_SB(0, 0), cB, voffB); PG8_STAGE(PG8_SA(0, 0), cA, voffA); PG8_STAGE(PG8_SB(0, 1), cB + hstep, voffB); PG8_STAGE(PG8_SA(0, 1), cA + hstep, voffA);
        if (wr == 1) PG8_BAR;
        PG8_WAIT_V(4); PG8_BAR;
        PG8_STAGE(PG8_SB(1, 0), cB + kstep, voffB); PG8_STAGE(PG8_SA(1, 0), cA + kstep, voffA); PG8_STAGE(PG8_SB(1, 1), cB + hstep + kstep, voffB);
        PG8_WAIT_V(6); PG8_BAR;
    }
    for (;;) {
        const bool has_next = S.next(ui + 1, nxt);
        const char* nA = has_next ? nxt.a : cA; const char* nB = has_next ? nxt.b : cB;
        for (int t = 0; t < nt; t += 2) {
            const bool last = (t == nt - 2);
            const char* a1 = cA + (size_t)(t + 1) * kstep;
            const char* a2 = last ? nA : cA + (size_t)(t + 2) * kstep; const char* b2 = last ? nB : cB + (size_t)(t + 2) * kstep;
            const char* a3 = a2 + kstep; const char* b3 = b2 + kstep;
            if (last && has_next) S.a_ready(nxt);
            if constexpr (SP2) {
            PG8_LDB(B0, 0, 0); PG8_LDB(B1, 0, 1); PG8_SCHED; PG8_LDA(At, 0, 0); PG8_STAGE(PG8_SA(1, 1), a1 + hstep, voffA);
            PG8_WAIT_V(8); PG8_WAIT_L(0); PG8_BAR; PG8_MMA(0, 0, At, B0); PG8_MMA(0, 1, At, B1); PG8_BAR; PG8_SCHED;
            PG8_LDA(At, 0, 1); PG8_STAGE(PG8_SB(0, 0), b2, voffB); PG8_STAGE(PG8_SB(0, 1), b2 + hstep, voffB); PG8_STAGE(PG8_SA(0, 0), a2, voffA);
            PG8_WAIT_V(8); PG8_WAIT_L(0); PG8_BAR; if (!(Sched::LIGHT && (cur.tag & 1))) { PG8_MMA(1, 0, At, B0); PG8_MMA(1, 1, At, B1); } PG8_BAR; PG8_SCHED;
            PG8_LDB(B0, 1, 0); PG8_LDB(B1, 1, 1); PG8_SCHED; PG8_LDA(At, 1, 0); PG8_STAGE(PG8_SA(0, 1), a2 + hstep, voffA);
            PG8_WAIT_V(8); PG8_WAIT_L(0); PG8_BAR; PG8_MMA(0, 0, At, B0); PG8_MMA(0, 1, At, B1); PG8_BAR; PG8_SCHED;
            PG8_LDA(At, 1, 1); PG8_STAGE(PG8_SB(1, 0), b3, voffB); PG8_STAGE(PG8_SB(1, 1), b3 + hstep, voffB); PG8_STAGE(PG8_SA(1, 0), a3, voffA);
            PG8_WAIT_V(8); PG8_WAIT_L(0); PG8_BAR; if (!(Sched::LIGHT && (cur.tag & 1))) { PG8_MMA(1, 0, At, B0); PG8_MMA(1, 1, At, B1); } PG8_BAR; PG8_SCHED;
            } else {
            PG8_LDB(B0, 0, 0); PG8_SCHED; PG8_LDA(At, 0, 0); PG8_STAGE(PG8_SA(1, 1), a1 + hstep, voffA);
            PG8_WAIT_L(8); PG8_BAR; PG8_WAIT_L(0); PG8_MMA(0, 0, At, B0); PG8_BAR; PG8_SCHED;
            PG8_LDB(B1, 0, 1); PG8_STAGE(PG8_SB(0, 0), b2, voffB);
            PG8_BAR; PG8_WAIT_L(0); PG8_MMA(0, 1, At, B1); PG8_BAR;
            PG8_LDA(At, 0, 1); PG8_STAGE(PG8_SA(0, 0), a2, voffA);
            PG8_BAR; PG8_WAIT_L(0); PG8_MMA(1, 0, At, B0); PG8_BAR; PG8_SCHED;
            PG8_STAGE(PG8_SB(0, 1), b2 + hstep, voffB);
            PG8_WAIT_V(6); PG8_BAR; PG8_MMA(1, 1, At, B1); PG8_BAR;
            PG8_LDB(B0, 1, 0); PG8_SCHED; PG8_LDA(At, 1, 0); PG8_STAGE(PG8_SA(0, 1), a2 + hstep, voffA);
            PG8_WAIT_L(8); PG8_BAR; PG8_WAIT_L(0); PG8_MMA(0, 0, At, B0); PG8_BAR; PG8_SCHED;
            PG8_LDB(B1, 1, 1); PG8_STAGE(PG8_SB(1, 0), b3, voffB);
            PG8_BAR; PG8_WAIT_L(0); PG8_MMA(0, 1, At, B1); PG8_BAR;
            PG8_LDA(At, 1, 1); PG8_STAGE(PG8_SA(1, 0), a3, voffA);
            PG8_BAR; PG8_WAIT_L(0); PG8_MMA(1, 0, At, B0); PG8_BAR; PG8_SCHED;
            PG8_STAGE(PG8_SB(1, 1), b3 + hstep, voffB);
            PG8_WAIT_V(6); PG8_BAR; PG8_MMA(1, 1, At, B1); PG8_BAR;
            }
        }
        if constexpr (ALIGN_EPI) { if (wr == 0) PG8_BAR; }
        if constexpr (!Epi::AFTER_DRAIN) { E(acc, cur, wr, wc, fr, fq); S.done(cur); }
        if (!has_next) break;
#pragma unroll
        for (int a = 0; a < 2; ++a)
#pragma unroll
            for (int b = 0; b < 2; ++b)
#pragma unroll
                for (int m = 0; m < 4; ++m)
#pragma unroll
                    for (int n = 0; n < 2; ++n) acc[a][b][m][n] = (f32x4){0.f, 0.f, 0.f, 0.f};
        cur = nxt; cA = nA; cB = nB; ++ui;
        if constexpr (ALIGN_EPI) { if (wr == 1) PG8_BAR; }
    }
    PG8_WAIT_V(0);
    if constexpr (!ALIGN_EPI) { if (wr == 0) PG8_BAR; }
    PG8_BAR;
    if constexpr (Epi::AFTER_DRAIN) { E.fused(acc, cur, wr, wc, fr, fq, lds, wid, lane); S.done(cur); }
#undef PG8_SA
#undef PG8_SB
#undef PG8_STAGE
#undef PG8_LDA
#undef PG8_LDB
#undef PG8_MMA
#undef PG8_WAIT_V
#undef PG8_WAIT_L
#undef PG8_BAR
#undef PG8_SCHED
}
}

namespace ok {
using pg8::bf16_t; using pg8::bf16x8; using pg8::f32x4; using pg8::u32x4;
typedef unsigned u32x2 __attribute__((ext_vector_type(2)));
typedef float f32x2 __attribute__((ext_vector_type(2)));
#ifndef SEQ
#define SEQ 8192
#endif
constexpr int NB = 2, L = SEQ, NCH = L / 64, T = NB * L, DM = 1024, NWAVES = 8, NT = 512;
constexpr float EPS = 1e-6f, LOG2E = 1.4426950408889634f;
constexpr size_t MiB = 1u << 20, KiB = 1024;
constexpr size_t WS_CTL = 0, CTL_BYTES = 1 * MiB;
constexpr int CW_BAR = 0;
constexpr int CW_SSQ = 16384;
constexpr int CW_MOE = 16384 + 6 * T;
constexpr int CW_CHK = CW_MOE + 256;
static_assert((CW_CHK + 64) * 4 <= (int)CTL_BYTES, "ctl");
constexpr size_t WS_WDT = 1 * MiB, WS_WAB = WS_WDT + 64 * KiB, WS_WR = WS_WAB + 64 * KiB;
constexpr size_t WS_DTV = 2 * MiB, WS_ACS = 3 * MiB, WS_GCS = 4 * MiB, WS_BETA = 4 * MiB + 512 * KiB;
constexpr size_t WS_RAW16 = WS_DTV;
constexpr size_t WS_EID = 5 * MiB, WS_GATEW = WS_EID + 128 * KiB, WS_TOKSLOT = WS_GATEW + 128 * KiB, WS_SLOTTOK = WS_TOKSLOT + 128 * KiB, WS_SLOTGATE = WS_SLOTTOK + 160 * KiB,
                 WS_SLOTRSTD = WS_SLOTGATE + 160 * KiB, WS_TILEEXP = WS_SLOTRSTD + 160 * KiB;
constexpr size_t WS_FP = 8 * MiB;
constexpr size_t WS_W_IN0 = 16 * MiB, WS_W_IN1 = 24 * MiB, WS_W_OUT0 = 35 * MiB, WS_W_OUT1 = 38 * MiB, WS_W_XA = 41 * MiB  ;
constexpr size_t WS_MEMNB = 57 * MiB, WS_KX = 58 * MiB  , WS_VT = 60 * MiB  ;
constexpr size_t WS_H = 64 * MiB, WS_HB = 128 * MiB, WS_MOEW = 160 * MiB, WS_BIG = 256 * MiB;
constexpr size_t WS_PROJ = WS_BIG;
constexpr size_t WS_CAT0 = 384 * MiB, WS_STATES = 432 * MiB;
constexpr size_t WS_CAT1 = 432 * MiB;
constexpr size_t WS_Q = WS_BIG, WS_ATT = WS_BIG + 32 * MiB;
constexpr size_t WS_XS = WS_BIG, WS_ACT = WS_BIG + 80 * MiB, WS_Y = WS_BIG + 120 * MiB;
constexpr size_t WS_END = 528 * MiB;
constexpr int PROJ0_LD = 4096, PROJ1_LD = 5632, MAXSLOT = 40960;

#ifdef CPU_EMU
__device__ __forceinline__ float fexp(float x) { return expf(x); }
__device__ __forceinline__ float fexp2(float x) { return exp2f(x); }
__device__ __forceinline__ float frcp(float x) { return 1.f / x; }
__device__ __forceinline__ float frsq(float x) { return 1.f / sqrtf(x); }
#else
__device__ __forceinline__ float fexp(float x) { return __builtin_amdgcn_exp2f(x * 1.4426950408889634f); }
__device__ __forceinline__ float fexp2(float x) { return __builtin_amdgcn_exp2f(x); }
__device__ __forceinline__ float frcp(float x) { return __builtin_amdgcn_rcpf(x); }
__device__ __forceinline__ float frsq(float x) { return __builtin_amdgcn_rsqf(x); }
#endif
#ifdef CPU_EMU
#define LAS
#define GAS
#define LDS_WAIT() do {} while (0)
#define WAVE_SYNC() ((void)__shfl(0, 0))
#define MEM_FENCE() do {} while (0)
#define PIN16(a) do {} while (0)
#define LDS_BARRIER() __syncthreads()
#define SCHED_FENCE() do {} while (0)
__device__ __forceinline__ unsigned cvt_pk_bf16(float lo, float hi) { return emu_f2bf(lo) | (emu_f2bf(hi) << 16); }
#else
#define LAS __attribute__((address_space(3)))
#define GAS __attribute__((address_space(1)))
#define LDS_WAIT() asm volatile("s_waitcnt lgkmcnt(0)" ::: "memory")
#define LDS_BARRIER() do { asm volatile("s_waitcnt lgkmcnt(0)" ::: "memory"); __builtin_amdgcn_s_barrier(); asm volatile("" ::: "memory"); } while (0)
#define MEM_FENCE() asm volatile("" ::: "memory")
#define PIN16(a) asm volatile("" : "+v"(a[0]), "+v"(a[1]), "+v"(a[2]), "+v"(a[3]), "+v"(a[4]), "+v"(a[5]), "+v"(a[6]), "+v"(a[7]), "+v"(a[8]), "+v"(a[9]), "+v"(a[10]), "+v"(a[11]), "+v"(a[12]), "+v"(a[13]), "+v"(a[14]), "+v"(a[15]) :: "memory")
#define SCHED_FENCE() __builtin_amdgcn_sched_barrier(0)
#define WAVE_SYNC() do { asm volatile("s_waitcnt lgkmcnt(0)" ::: "memory"); __builtin_amdgcn_wave_barrier(); } while (0)
typedef __bf16 hwbf16x2 __attribute__((ext_vector_type(2)));
__device__ __forceinline__ unsigned cvt_pk_bf16(float lo, float hi) { const f32x2 v = {lo, hi}; return __builtin_bit_cast(unsigned, __builtin_convertvector(v, hwbf16x2)); }
#endif
__device__ __forceinline__ float bf2f(unsigned short b) { return __uint_as_float(((unsigned)b) << 16); }
__device__ __forceinline__ float bflo(unsigned w) { return __uint_as_float(w << 16); }
__device__ __forceinline__ float bfhi(unsigned w) { return __uint_as_float(w & 0xffff0000u); }
__device__ __forceinline__ float wave_sum(float v) {
#pragma unroll
    for (int o = 1; o < 64; o <<= 1) v += __shfl_xor(v, o);
    return v;
}
__device__ __forceinline__ f32x4 mfma16(bf16x8 a, bf16x8 b, f32x4 c) { return __builtin_amdgcn_mfma_f32_16x16x32_bf16(a, b, c, 0, 0, 0); }

struct Frame {
    LAS unsigned char* lds;
    unsigned* ctl;
    unsigned char* ws;
    const float* const* in;
    float* out;
    int tid, lane, wave, vcu, G;
};
constexpr size_t WS_SSQP1 = 6 * MiB, WS_SSQP2 = 7 * MiB, WS_SSQP4 = 62 * MiB, WS_SSQP5 = 63 * MiB;
__device__ __forceinline__ float rstd_np(const float* p, int np, int row) { float s; if (np == 1) s = p[row]; else { const f32x4* q = (const f32x4*)(p + (size_t)row * 16); const f32x4 a = q[0], b = q[1], c = q[2], d = q[3]; s = ((a.x + a.y) + (a.z + a.w)) + ((b.x + b.y) + (b.z + b.w)) + (((c.x + c.y) + (c.z + c.w)) + ((d.x + d.y) + (d.z + d.w))); }
    return frsq(s * (1.f / 1024.f) + EPS); }
#define OKP(type, off) ((type*)(F.ws + (off)))
#ifdef CPU_EMU
__device__ __forceinline__ Frame phase_frame(const Frame& F0) { return F0; }
#else
__device__ __forceinline__ Frame phase_frame(const Frame& F0) { Frame F = F0; int t = threadIdx.x; asm volatile("" : "+v"(t)); F.tid = t; F.lane = t & 63; F.wave = __builtin_amdgcn_readfirstlane(t >> 6); return F; }
#endif

struct CvtJob { const float* W; int ldw, K, ncols, c0; bf16_t* WT; int drow0, dstep16; const float* kgain; float cscale; };
__device__ __forceinline__ int job_items(const CvtJob& j) { return (j.K / 64) * (j.ncols / 32); }
struct CvtRegs { float wv[32]; };
__device__ __forceinline__ void cvt_load(CvtRegs& r, const CvtJob& j, int item, int lane) {
    const int nblk = j.ncols / 32, kb = item / nblk, nb = item % nblk, k0 = 64 * kb, c0 = j.c0 + 32 * nb;
#pragma unroll
    for (int i = 0; i < 32; ++i) r.wv[i] = j.W[(size_t)(k0 + 2 * i + (lane >> 5)) * j.ldw + c0 + (lane & 31)];
}
__device__ __forceinline__ void cvt_finish(const CvtRegs& r, const CvtJob& j, int item, LAS float* scr, int lane) {
    const int nblk = j.ncols / 32, kb = item / nblk, nb = item % nblk, k0 = 64 * kb, drow0 = j.drow0 + (32 * nb >> 4) * j.dstep16;
#pragma unroll
    for (int i = 0; i < 32; ++i) { const int kk = 2 * i + (lane >> 5); const float g = j.kgain ? j.kgain[k0 + kk] * j.cscale : j.cscale; scr[kk * 33 + (lane & 31)] = r.wv[i] * g; }
    WAVE_SYNC();
    const int c = lane & 7;
#pragma unroll
    for (int jj = 0; jj < 4; ++jj) { const int n = (lane >> 3) + 8 * jj; const LAS float* s = scr + (8 * c) * 33 + n;
        u32x4 o; o.x = cvt_pk_bf16(s[0 * 33], s[1 * 33]); o.y = cvt_pk_bf16(s[2 * 33], s[3 * 33]); o.z = cvt_pk_bf16(s[4 * 33], s[5 * 33]); o.w = cvt_pk_bf16(s[6 * 33], s[7 * 33]);
        *(u32x4*)(j.WT + (size_t)(drow0 + (n >> 4) * j.dstep16 + (n & 15)) * j.K + k0 + 8 * c) = o; }
    WAVE_SYNC();
}
__device__ __forceinline__ CvtJob dense_job(const Frame& F, int j) {
    using namespace sm;
    const float* const* in = F.in;
    switch (j) {
    case 0: return CvtJob{in[I_EV_WIN], 4112, 1024, 4096, 0, OKP(bf16_t, WS_W_IN0), 0, 16, in[I_NORM_MIX], 1.f};
    case 1: return CvtJob{in[I_OD_WIN], 5648, 1024, 4096, 0, OKP(bf16_t, WS_W_IN1), 0, 16, in[I_NORM_MIX] + 1024, 1.f};
    case 2: return CvtJob{in[I_OD_WIN], 5648, 1024, 512, 4112, OKP(bf16_t, WS_W_IN1), 4096, 16, in[I_NORM_MIX] + 1024, 0.125f * LOG2E};
    case 3: return CvtJob{in[I_OD_WIN], 5648, 1024, 1024, 4624, OKP(bf16_t, WS_W_IN1), 4608, 16, in[I_NORM_MIX] + 1024, 1.f};
    case 4: return CvtJob{in[I_EV_WOUT], 1024, 1536, 1024, 0, OKP(bf16_t, WS_W_OUT0), 0, 16, nullptr, 1.f};
    case 5: return CvtJob{in[I_OD_WOUT], 1024, 1536, 1024, 0, OKP(bf16_t, WS_W_OUT1), 0, 16, nullptr, 1.f};
    default: { const int l = (j - 6) / 4, w = (j - 6) % 4; bf16_t* dst = OKP(bf16_t, WS_W_XA + (size_t)l * 8 * MiB + (size_t)w * 2 * MiB);
        const float* src = in[I_XA_WQ + w] + (size_t)l * 1024 * 1024;
        if (w == 0) return CvtJob{src, 1024, 1024, 1024, 0, dst, 0, 16, in[I_NORM_XA] + l * 1024, 0.0625f * LOG2E};
        return CvtJob{src, 1024, 1024, 1024, 0, dst, 0, 16, nullptr, 1.f}; }
    }
}
constexpr int N_DENSE_JOBS = 14;
__device__ __forceinline__ CvtJob moe_job(const Frame& F, int l, int j) {
    using namespace sm;
    const int e = j / 3, w = j % 3; const float* const* in = F.in;
    bf16_t* gu = OKP(bf16_t, WS_MOEW + (size_t)e * 3 * MiB); bf16_t* dn = gu + 1024 * 1024;
    if (w == 0) return CvtJob{in[I_MOE_WGATE] + ((size_t)l * 32 + e) * 1024 * 512, 512, 1024, 512, 0, gu, 0, 32, in[I_NORM_FFN] + l * 1024, 1.f};
    if (w == 1) return CvtJob{in[I_MOE_WUP] + ((size_t)l * 32 + e) * 1024 * 512, 512, 1024, 512, 0, gu, 16, 32, in[I_NORM_FFN] + l * 1024, 1.f};
    return CvtJob{in[I_MOE_WDOWN] + ((size_t)l * 32 + e) * 512 * 1024, 1024, 512, 1024, 0, dn, 0, 16, nullptr, 1.f};
}
__device__ __forceinline__ int dense_total(const Frame& F) { int n = 0; for (int j = 0; j < N_DENSE_JOBS; ++j) n += job_items(dense_job(F, j)); return n; }
__device__ __forceinline__ void dense_item(const Frame& F, int idx, CvtJob& job, int& item) {
    for (int j = 0; j < N_DENSE_JOBS; ++j) { const CvtJob jb = dense_job(F, j); const int n = job_items(jb); job = jb; item = idx < n ? idx : n - 1; if (idx < n) return; idx -= n; }
}
__device__ __forceinline__ void phase_cvt_dense(const Frame& F0) {
    const Frame F = phase_frame(F0);
    LAS float* scr = (LAS float*)(F.lds + F.wave * 16384);
    const int gw = F.vcu * NWAVES + F.wave, NGW = F.G * NWAVES, N = dense_total(F);
    CvtRegs ra, rb;
    auto LD = [&](CvtRegs& r, int idx) { CvtJob jb; int it; dense_item(F, idx < N ? idx : N - 1, jb, it); cvt_load(r, jb, it, F.lane); };
    auto FN = [&](const CvtRegs& r, int idx) { if (idx < N) { CvtJob jb; int it; dense_item(F, idx, jb, it); cvt_finish(r, jb, it, scr, F.lane); } };
    LD(ra, gw);
    for (int idx = gw; idx < N; idx += 2 * NGW) { LD(rb, idx + NGW); FN(ra, idx); LD(ra, idx + 2 * NGW); FN(rb, idx + NGW); }
}
__device__ __forceinline__ void phase_cvt_moe(const Frame& F0, int l) {
    const Frame F = phase_frame(F0);
    LAS float* scr = (LAS float*)(F.lds + F.wave * 16384);
    const int gw = F.vcu * NWAVES + F.wave, NGW = F.G * NWAVES; constexpr int N = 96 * 256;
    CvtRegs ra, rb;
    auto LD = [&](CvtRegs& r, int idx) { const int ii = idx < N ? idx : N - 1; const CvtJob jb = moe_job(F, l, ii >> 8); cvt_load(r, jb, ii & 255, F.lane); };
    auto FN = [&](const CvtRegs& r, int idx) { if (idx < N) { const CvtJob jb = moe_job(F, l, idx >> 8); cvt_finish(r, jb, idx & 255, scr, F.lane); } };
    LD(ra, gw);
    for (int idx = gw; idx < N; idx += 2 * NGW) { LD(rb, idx + NGW); FN(ra, idx); LD(ra, idx + 2 * NGW); FN(rb, idx + NGW); }
}
__device__ __forceinline__ void row_to_bf16_ssq(const float* xrow, bf16_t* orow, float* ssq, int lane) {
    const f32x4* xr = (const f32x4*)xrow + lane; float s = 0.f; f32x4 v[4];
#pragma unroll
    for (int j = 0; j < 4; ++j) { v[j] = xr[64 * j]; s += (v[j].x * v[j].x + v[j].y * v[j].y) + (v[j].z * v[j].z + v[j].w * v[j].w); }
    s = wave_sum(s);
    u32x2* o8 = (u32x2*)orow + lane;
#pragma unroll
    for (int j = 0; j < 4; ++j) { u32x2 w; w.x = cvt_pk_bf16(v[j].x, v[j].y); w.y = cvt_pk_bf16(v[j].z, v[j].w); o8[64 * j] = w; }
    if (lane == 0) *ssq = s;
}
__device__ __forceinline__ void phase_prologue(const Frame& F0) {
    const Frame F = phase_frame(F0);
    using namespace sm;
    phase_cvt_dense(F0);
    const int gw = F.vcu * NWAVES + F.wave, NGW = F.G * NWAVES;
    float* ssq0 = (float*)F.ctl + CW_SSQ;
    for (int m = gw; m < T; m += NGW) row_to_bf16_ssq(F.in[I_X] + (size_t)m * DM, OKP(bf16_t, WS_HB) + (size_t)m * DM, ssq0 + m, F.lane);
    for (int m = gw; m < NB * 256; m += NGW) { const f32x4* xr = (const f32x4*)(F.in[I_MEM] + (size_t)m * DM) + F.lane; const f32x4* gr = (const f32x4*)F.in[I_MEM_NORM] + F.lane; float s = 0.f; f32x4 v[4];
#pragma unroll
        for (int j = 0; j < 4; ++j) { v[j] = xr[64 * j]; s += (v[j].x * v[j].x + v[j].y * v[j].y) + (v[j].z * v[j].z + v[j].w * v[j].w); }
        const float r = 1.f / sqrtf(wave_sum(s) * (1.f / DM) + EPS);
        u32x2* o8 = (u32x2*)(OKP(bf16_t, WS_MEMNB) + (size_t)m * DM) + F.lane;
#pragma unroll
        for (int j = 0; j < 4; ++j) { const f32x4 g = gr[64 * j]; u32x2 w; w.x = cvt_pk_bf16(v[j].x * r * g.x, v[j].y * r * g.y); w.y = cvt_pk_bf16(v[j].z * r * g.z, v[j].w * r * g.w); o8[64 * j] = w; } }
    const size_t gt = (size_t)F.vcu * NT + F.tid, GT = (size_t)F.G * NT;
    for (size_t i = gt; i < 1024 * 16; i += GT) { const int k = (int)(i >> 4), j = (int)(i & 15);
        OKP(float, WS_WDT)[j * 1024 + k] = F.in[I_NORM_MIX][k] * F.in[I_EV_WIN][(size_t)k * 4112 + 4096 + j];
        OKP(float, WS_WAB)[j * 1024 + k] = F.in[I_NORM_MIX][1024 + k] * F.in[I_OD_WIN][(size_t)k * 5648 + 4096 + j]; }
}

#ifndef CPU_EMU
struct EpiScaleBf16 {
    static constexpr bool PERM = true, AFTER_DRAIN = false;
    bf16_t* O; int ldc; const float* ssq; int np;
    __device__ __forceinline__ void operator()(const f32x4 (&acc)[2][2][4][2], const pg8::Unit& u, int wr, int wc, int fr, int fq) const {
        const int row0 = u.pm * 256 + wr * 64 + fr, col0 = u.pn * 256 + wc * 32 + 8 * fq;
#pragma unroll
        for (int ai = 0; ai < 2; ++ai)
#pragma unroll
            for (int m = 0; m < 4; ++m) { const int row = row0 + ai * 128 + m * 16; const float s = ssq ? rstd_np(ssq, np, row) : 1.f; bf16_t* rowp = O + (size_t)row * ldc + col0;
#pragma unroll
                for (int bj = 0; bj < 2; ++bj) { const f32x4 v0 = acc[ai][bj][m][0] * s, v1 = acc[ai][bj][m][1] * s; u32x4 w; w.x = cvt_pk_bf16(v0[0], v0[1]); w.y = cvt_pk_bf16(v0[2], v0[3]); w.z = cvt_pk_bf16(v1[0], v1[1]); w.w = cvt_pk_bf16(v1[2], v1[3]);
                    *(u32x4*)(rowp + bj * 128) = w; } }
    }
};
template <bool HIN_F32> struct EpiResidualT {
    static constexpr bool PERM = false, AFTER_DRAIN = false;
    const float* hin; bf16_t* hb; float* ssq;
    __device__ __forceinline__ void operator()(const f32x4 (&acc)[2][2][4][2], const pg8::Unit& u, int wr, int wc, int fr, int fq) const {
        const int row0 = u.pm * 256 + wr * 64 + fr, col0 = u.pn * 256 + wc * 32 + 4 * fq;
#pragma unroll
        for (int ai = 0; ai < 2; ++ai)
#pragma unroll
            for (int m = 0; m < 4; ++m) { const int row = row0 + ai * 128 + m * 16; const size_t ro = (size_t)row * DM + col0; float s = 0.f;
#pragma unroll
                for (int bj = 0; bj < 2; ++bj)
#pragma unroll
                    for (int n = 0; n < 2; ++n) { const size_t o = ro + bj * 128 + n * 16; f32x4 v;
                        if (HIN_F32) v = *(const f32x4*)(hin + o); else { const u32x2 hw = *(const u32x2*)(hb + o); v = (f32x4){bflo(hw.x), bfhi(hw.x), bflo(hw.y), bfhi(hw.y)}; }
                        v += acc[ai][bj][m][n];
                        u32x2 w; w.x = cvt_pk_bf16(v[0], v[1]); w.y = cvt_pk_bf16(v[2], v[3]); *(u32x2*)(hb + o) = w;
                        const float r0 = bflo(w.x), r1 = bfhi(w.x), r2 = bflo(w.y), r3 = bfhi(w.y); s += (r0 * r0 + r1 * r1) + (r2 * r2 + r3 * r3); }
                s += __shfl_xor(s, 16); s += __shfl_xor(s, 32);
                if (fq == 0) ssq[(size_t)row * 16 + u.pn * 4 + wc] = s; }
    }
};

template <class Epi> __device__ __forceinline__ void dense_gemm(const Frame& F, const bf16_t* A, const bf16_t* Bt, int M, int N, int K, const Epi& E) {
    pg8::Gemm g{A, Bt, M, N, K}; pg8::StaticOrder S; S.init(g, F.G, (int)blockIdx.x);
    pg8::gemm_phase<Epi, pg8::StaticOrder, true, true>(F.lds, g, S, E);
}
#endif
}

namespace ok {
constexpr int XT_LD = 72;
constexpr int BC_LD = 136;
__device__ __forceinline__ float siluf(float x) { return x * frcp(1.f + fexp(-x)); }
__device__ __forceinline__ float softplusf(float x) { return x > 20.f ? x : log1pf(expf(x)); }

template <class Sink> __device__ __forceinline__ void ssd_conv_pair(const Frame& F, int b, int c, int xc, Sink&& sink) {
    using namespace sm;
    const float* cw = F.in[I_EV_CONVW]; const f32x2 w0 = *(const f32x2*)(cw + xc), w1 = *(const f32x2*)(cw + 1536 + xc), w2 = *(const f32x2*)(cw + 3072 + xc), w3 = *(const f32x2*)(cw + 4608 + xc), bias = *(const f32x2*)(F.in[I_EV_CONVB] + xc);
    const bf16_t* p = OKP(bf16_t, WS_PROJ) + (size_t)(b * L + c * 64) * PROJ0_LD + 2560 + xc;
    unsigned raw[64];
#pragma unroll
    for (int t = 0; t < 64; ++t) raw[t] = *(const unsigned*)(p + (size_t)t * PROJ0_LD);
    f32x2 x0 = {0.f, 0.f}, x1 = x0, x2 = x0;
    if (c > 0) { const unsigned a = *(const unsigned*)(p - 3 * PROJ0_LD), bq = *(const unsigned*)(p - 2 * PROJ0_LD), cq = *(const unsigned*)(p - PROJ0_LD); x0 = (f32x2){bflo(a), bfhi(a)}; x1 = (f32x2){bflo(bq), bfhi(bq)}; x2 = (f32x2){bflo(cq), bfhi(cq)}; }
#pragma unroll
    for (int t = 0; t < 64; t += 2) { const f32x2 x3 = {bflo(raw[t]), bfhi(raw[t])}, x4 = {bflo(raw[t + 1]), bfhi(raw[t + 1])};
        const f32x2 v0 = bias + w0 * x0 + w1 * x1 + w2 * x2 + w3 * x3, v1 = bias + w0 * x1 + w1 * x2 + w2 * x3 + w3 * x4;
        sink(t, siluf(v0.x), siluf(v1.x), siluf(v0.y), siluf(v1.y)); x0 = x2; x1 = x3; x2 = x4; }
}

__device__ __forceinline__ void phase_ssd_a(const Frame& F0) {
    const Frame F = phase_frame(F0);
    using namespace sm;
    LAS bf16_t* XT = (LAS bf16_t*)F.lds; LAS bf16_t* BT = (LAS bf16_t*)(F.lds + 73728);
    LAS float* dt_s = (LAS float*)(F.lds + 92160); LAS float* acs_s = (LAS float*)(F.lds + 94208); LAS float* sc_s = (LAS float*)(F.lds + 96256);
    const int tid = F.tid, lane = F.lane, wave = F.wave;
    for (int u = F.vcu; u < NB * NCH * 2; u += F.G) {
        const int g = u & 1, bc = u >> 1, b = bc / NCH, c = bc % NCH; const size_t row0 = (size_t)b * L + c * 64;
        LDS_BARRIER();
        if (tid < 320) { const int ci = tid * 2;
            const int xc = ci < 512 ? g * 512 + ci : 1024 + g * 128 + (ci - 512);
            LAS unsigned* dst = (LAS unsigned*)(ci < 512 ? XT + ci * XT_LD : BT + (ci - 512) * XT_LD);
            ssd_conv_pair(F, b, c, xc, [&](int t, float a0, float a1, float b0, float b1) { dst[t >> 1] = cvt_pk_bf16(a0, a1); dst[XT_LD / 2 + (t >> 1)] = cvt_pk_bf16(b0, b1); });
        }
        { const int t = tid & 63, hh = tid >> 6, hd = g * 8 + hh; const float dt = softplusf(OKP(float, WS_RAW16)[(row0 + t) * 16 + hd] + F.in[I_EV_DTB][hd]); dt_s[hh * 64 + t] = dt; acs_s[hh * 64 + t] = dt * -expf(F.in[I_EV_ALOG][hd]); }
        LDS_BARRIER();
        { const int hh = wave, hd = g * 8 + hh; float v = acs_s[hh * 64 + lane];
#pragma unroll
          for (int o = 1; o < 64; o <<= 1) { const float n = __shfl_up(v, o); if (lane >= o) v += n; }
          const float last = __shfl(v, 63); const float dt = dt_s[hh * 64 + lane];
          sc_s[hh * 64 + lane] = dt * fexp(last - v);
          OKP(float, WS_DTV)[(row0 + lane) * 16 + hd] = dt; OKP(float, WS_ACS)[(row0 + lane) * 16 + hd] = v; }
        WAVE_SYNC();
#if defined(CHECK_DUMP)
        if (bc == 5 && g == 0) {
            float* f3 = OKP(float, WS_FP) + (size_t)3 * 16 * 6144; float* f4 = OKP(float, WS_FP) + (size_t)4 * 16 * 6144; float* f5 = OKP(float, WS_FP) + (size_t)5 * 16 * 6144;
            for (int i = tid; i < 512 * 64; i += NT) f3[i] = bf2f(XT[(i >> 6) * XT_LD + (i & 63)]);
            for (int i = tid; i < 128 * 64; i += NT) f4[i] = bf2f(BT[(i >> 6) * XT_LD + (i & 63)]);
            f5[wave * 64 + lane] = sc_s[wave * 64 + lane];
        }
#endif
        { const int hh = wave, hd = g * 8 + hh, fr = lane & 15, fq = lane >> 4;
          bf16x8 xa[4][2];
#pragma unroll
          for (int pt = 0; pt < 4; ++pt)
#pragma unroll
              for (int ks = 0; ks < 2; ++ks) { const u32x4 raw = *(const LAS u32x4*)(XT + (hh * 64 + pt * 16 + fr) * XT_LD + ks * 32 + fq * 8); const LAS float* sp = sc_s + hh * 64 + ks * 32 + fq * 8;
                  const f32x4 s0 = *(const LAS f32x4*)sp, s1 = *(const LAS f32x4*)(sp + 4); u32x4 o;
                  o.x = cvt_pk_bf16(bflo(raw.x) * s0.x, bfhi(raw.x) * s0.y); o.y = cvt_pk_bf16(bflo(raw.y) * s0.z, bfhi(raw.y) * s0.w);
                  o.z = cvt_pk_bf16(bflo(raw.z) * s1.x, bfhi(raw.z) * s1.y); o.w = cvt_pk_bf16(bflo(raw.w) * s1.z, bfhi(raw.w) * s1.w);
                  xa[pt][ks] = __builtin_bit_cast(bf16x8, o); }
          bf16_t* st = OKP(bf16_t, WS_STATES) + ((size_t)bc * 16 + hd) * 8192;
#pragma unroll
          for (int nt = 0; nt < 8; ++nt) { bf16x8 bb[2];
#pragma unroll
              for (int ks = 0; ks < 2; ++ks) bb[ks] = *(const LAS bf16x8*)(BT + (nt * 16 + fr) * XT_LD + ks * 32 + fq * 8);
#pragma unroll
              for (int pt = 0; pt < 4; ++pt) { f32x4 acc = {0.f, 0.f, 0.f, 0.f};
#pragma unroll
                  for (int ks = 0; ks < 2; ++ks) acc = mfma16(bb[ks], xa[pt][ks], acc);
                  u32x2 w; w.x = cvt_pk_bf16(acc[0], acc[1]); w.y = cvt_pk_bf16(acc[2], acc[3]);
                  *(u32x2*)(st + (size_t)(pt * 16 + fr) * 128 + nt * 16 + 4 * fq) = w; } } }
    }
}

__device__ __forceinline__ void phase_ssd_scan(const Frame& F0, int skip) {
    const Frame F = phase_frame(F0);
    const float* acs = OKP(float, WS_ACS);
    int widx = F.vcu, nw = F.G;
    if (skip) { const int per = F.G / 8, xcd = F.vcu / per, loc = F.vcu % per, sk = skip / 8; if (loc < sk) return; widx = xcd * (per - sk) + (loc - sk); nw = F.G - skip; }
    for (int idx = widx * NT + F.tid; idx < NB * 65536; idx += nw * NT) {
        const int b = idx >> 16, r2 = idx & 65535, hd = r2 >> 12; unsigned* p = (unsigned*)(OKP(bf16_t, WS_STATES) + (size_t)b * NCH * 131072) + r2;
        float s0 = 0.f, s1 = 0.f;
#pragma unroll 8
        for (int c = 0; c < NCH; ++c) { const unsigned st = p[(size_t)c * 65536]; const float dec = fexp(acs[((size_t)b * L + c * 64 + 63) * 16 + hd]);
            p[(size_t)c * 65536] = cvt_pk_bf16(s0, s1); s0 = s0 * dec + bflo(st); s1 = s1 * dec + bfhi(st); }
    }
}

__device__ __forceinline__ void phase_ssd_b(const Frame& F0) {
    const Frame F = phase_frame(F0);
    using namespace sm;
    LAS bf16_t* XT = (LAS bf16_t*)F.lds; LAS bf16_t* Bs = (LAS bf16_t*)(F.lds + 73728); LAS bf16_t* Cs = (LAS bf16_t*)(F.lds + 91136);
    LAS float* acs_s = (LAS float*)(F.lds + 108544); LAS float* dt_s = (LAS float*)(F.lds + 110592); LAS float* red = (LAS float*)(F.lds + 112640);
    const int tid = F.tid, lane = F.lane, wave = F.wave, fr = lane & 15, fq = lane >> 4;
    const bf16_t* proj = OKP(bf16_t, WS_PROJ); bf16_t* cat = OKP(bf16_t, WS_CAT0);
    for (int u = F.vcu; u < NB * NCH * 2; u += F.G) {
        const int g = u & 1, bc = u >> 1, b = bc / NCH, c = bc % NCH; const size_t row0 = (size_t)b * L + c * 64;
        LDS_BARRIER();
        if (tid < 384) { const int ci = tid * 2;
            if (ci < 512) { LAS unsigned* dst = (LAS unsigned*)(XT + ci * XT_LD); ssd_conv_pair(F, b, c, g * 512 + ci, [&](int t, float a0, float a1, float b0, float b1) { dst[t >> 1] = cvt_pk_bf16(a0, a1); dst[XT_LD / 2 + (t >> 1)] = cvt_pk_bf16(b0, b1); }); }
            else { const int n = (ci - 512) & 127; LAS unsigned* dst = (LAS unsigned*)((ci < 640 ? Bs : Cs) + n); const int xc = (ci < 640 ? 1024 : 1280) + g * 128 + n;
                ssd_conv_pair(F, b, c, xc, [&](int t, float a0, float a1, float b0, float b1) { dst[t * (BC_LD / 2)] = cvt_pk_bf16(a0, b0); dst[(t + 1) * (BC_LD / 2)] = cvt_pk_bf16(a1, b1); }); }
        }
        { const int t = tid & 63, hh = tid >> 6; acs_s[hh * 64 + t] = OKP(float, WS_ACS)[(row0 + t) * 16 + g * 8 + hh]; dt_s[hh * 64 + t] = OKP(float, WS_DTV)[(row0 + t) * 16 + g * 8 + hh]; }
        { const int ch = g * 256 + (tid & 255), t0 = (tid >> 8) * 32; const float* w = F.in[I_EV_SCCONV]; const float w0 = w[ch], w1 = w[512 + ch], w2 = w[1024 + ch];
          const bf16_t* p = proj + (row0 + t0) * PROJ0_LD + ch; float p0 = 0.f, p1 = 0.f;
          if (c > 0 || t0 > 0) { p0 = bf2f(p[-2 * PROJ0_LD + 512]) * bf2f(p[-2 * PROJ0_LD + 1024]); p1 = bf2f(p[-PROJ0_LD + 512]) * bf2f(p[-PROJ0_LD + 1024]); }
          unsigned short rb[32], rc[32], rx[32];
#pragma unroll
          for (int t = 0; t < 32; ++t) { const bf16_t* q = p + (size_t)t * PROJ0_LD; rb[t] = q[0]; rc[t] = q[512]; rx[t] = q[1024]; }
#pragma unroll
          for (int t = 0; t < 32; ++t) { const float p2 = bf2f(rc[t]) * bf2f(rx[t]); const float y = bf2f(rb[t]) * (w0 * p0 + w1 * p1 + w2 * p2);
              cat[(row0 + t0 + t) * 1536 + ch] = (bf16_t)(cvt_pk_bf16(y, 0.f) & 0xffffu); p0 = p1; p1 = p2; } }
        LDS_BARRIER();
        const int hh = wave, hd = g * 8 + hh;
        f32x4 Y[4][4];
        { const bf16_t* P = OKP(bf16_t, WS_STATES) + ((size_t)bc * 16 + hd) * 8192;
#pragma unroll
          for (int pt = 0; pt < 4; ++pt)
#pragma unroll
              for (int tt = 0; tt < 4; ++tt) Y[pt][tt] = (f32x4){0.f, 0.f, 0.f, 0.f};
          bf16x8 pall[4][4];
#pragma unroll
          for (int ks = 0; ks < 4; ++ks)
#pragma unroll
              for (int pt = 0; pt < 4; ++pt) pall[ks][pt] = *(const bf16x8*)(P + (size_t)(pt * 16 + fr) * 128 + ks * 32 + fq * 8);
#pragma unroll
          for (int ks = 0; ks < 4; ++ks) { bf16x8 cb[4];
#pragma unroll
              for (int tt = 0; tt < 4; ++tt) cb[tt] = *(const LAS bf16x8*)(Cs + (tt * 16 + fr) * BC_LD + ks * 32 + fq * 8);
#pragma unroll
              for (int pt = 0; pt < 4; ++pt)
#pragma unroll
                  for (int tt = 0; tt < 4; ++tt) Y[pt][tt] = mfma16(pall[ks][pt], cb[tt], Y[pt][tt]); }
#pragma unroll
          for (int tt = 0; tt < 4; ++tt) { const float e = fexp(acs_s[hh * 64 + tt * 16 + fr]);
#pragma unroll
              for (int pt = 0; pt < 4; ++pt) Y[pt][tt] *= e; } }
#pragma unroll
        for (int tt = 0; tt < 4; ++tt) { f32x4 cbt[4];
#pragma unroll
            for (int st = 0; st < 4; ++st) cbt[st] = (f32x4){0.f, 0.f, 0.f, 0.f};
#pragma unroll
            for (int ks = 0; ks < 4; ++ks) { const bf16x8 cf = *(const LAS bf16x8*)(Cs + (tt * 16 + fr) * BC_LD + ks * 32 + fq * 8);
#pragma unroll
                for (int st = 0; st < 4; ++st) if (st <= tt) { const bf16x8 bf = *(const LAS bf16x8*)(Bs + (st * 16 + fr) * BC_LD + ks * 32 + fq * 8); cbt[st] = mfma16(bf, cf, cbt[st]); } }
            const int t = tt * 16 + fr; const float at = acs_s[hh * 64 + t];
#pragma unroll
            for (int st = 0; st < 4; ++st) { const f32x4 as4 = *(const LAS f32x4*)(acs_s + hh * 64 + st * 16 + 4 * fq), dt4 = *(const LAS f32x4*)(dt_s + hh * 64 + st * 16 + 4 * fq);
#pragma unroll
                for (int r = 0; r < 4; ++r) { const int s = st * 16 + 4 * fq + r; cbt[st][r] = (st <= tt && s <= t) ? cbt[st][r] * fexp(at - as4[r]) * dt4[r] : 0.f; } }
            bf16x8 mb[2];
#pragma unroll
            for (int ks = 0; ks < 2; ++ks) { u32x4 o; o.x = cvt_pk_bf16(cbt[2 * ks][0], cbt[2 * ks][1]); o.y = cvt_pk_bf16(cbt[2 * ks][2], cbt[2 * ks][3]); o.z = cvt_pk_bf16(cbt[2 * ks + 1][0], cbt[2 * ks + 1][1]); o.w = cvt_pk_bf16(cbt[2 * ks + 1][2], cbt[2 * ks + 1][3]);
                mb[ks] = __builtin_bit_cast(bf16x8, o); }
#pragma unroll
            for (int pt = 0; pt < 4; ++pt)
#pragma unroll
                for (int ks = 0; ks < 2; ++ks) { const LAS bf16_t* xp = XT + (hh * 64 + pt * 16 + fr) * XT_LD + ks * 32 + 4 * fq; const u32x2 lo = *(const LAS u32x2*)xp, hi = *(const LAS u32x2*)(xp + 16);
                    u32x4 a; a.x = lo.x; a.y = lo.y; a.z = hi.x; a.w = hi.y; Y[pt][tt] = mfma16(__builtin_bit_cast(bf16x8, a), mb[ks], Y[pt][tt]); } }
        const float Dh = F.in[I_EV_D][hd];
#pragma unroll
        for (int tt = 0; tt < 4; ++tt) { const int t = tt * 16 + fr; float ss = 0.f;
#pragma unroll
            for (int pt = 0; pt < 4; ++pt) { const int p = pt * 16 + 4 * fq; const u32x2 zz = *(const u32x2*)(proj + (row0 + t) * PROJ0_LD + 1536 + hd * 64 + p);
                const float z0 = bflo(zz.x), z1 = bfhi(zz.x), z2 = bflo(zz.y), z3 = bfhi(zz.y); const LAS bf16_t* xp = XT + (hh * 64 + p) * XT_LD + t;
                f32x4 y = Y[pt][tt]; y[0] = (y[0] + Dh * bf2f(xp[0])) * siluf(z0); y[1] = (y[1] + Dh * bf2f(xp[XT_LD])) * siluf(z1); y[2] = (y[2] + Dh * bf2f(xp[2 * XT_LD])) * siluf(z2); y[3] = (y[3] + Dh * bf2f(xp[3 * XT_LD])) * siluf(z3);
                Y[pt][tt] = y; ss += (y[0] * y[0] + y[1] * y[1]) + (y[2] * y[2] + y[3] * y[3]); }
            ss += __shfl_xor(ss, 16); ss += __shfl_xor(ss, 32);
            if (fq == 0) red[hh * 64 + t] = ss; }
        LDS_BARRIER();
#pragma unroll
        for (int tt = 0; tt < 4; ++tt) { const int t = tt * 16 + fr; float ss = 0.f;
#pragma unroll
            for (int w = 0; w < 8; ++w) ss += red[w * 64 + t];
            const float rs = frsq(ss * (1.f / 512.f) + EPS);
#pragma unroll
            for (int pt = 0; pt < 4; ++pt) { const int ch = hd * 64 + pt * 16 + 4 * fq; const f32x4 nw = *(const f32x4*)(F.in[I_EV_NORM] + ch); const f32x4 y = Y[pt][tt];
                u32x2 w; w.x = cvt_pk_bf16(y[0] * rs * nw.x, y[1] * rs * nw.y); w.y = cvt_pk_bf16(y[2] * rs * nw.z, y[3] * rs * nw.w);
                *(u32x2*)(cat + (row0 + t) * 1536 + 512 + ch) = w; } }
    }
}
}

namespace ok {
constexpr int XA_LD = 264;

__device__ __forceinline__ void phase_xattn(const Frame& F0, const bf16_t* q, const bf16_t* kx, const bf16_t* vt, bf16_t* att) {
    const Frame F = phase_frame(F0);
    LAS bf16_t* KV = (LAS bf16_t*)F.lds;
    const int tid = F.tid, lane = F.lane, wave = F.wave, fr = lane & 15, fq = lane >> 4;
    u32x4 tile[8];
#define XA_LOAD_K(uu) do { const int hd_ = (uu) & 3, b_ = (((uu) >> 2) * 128) / L; _Pragma("unroll") for (int j_ = 0; j_ < 8; ++j_) { const int i_ = tid + j_ * NT, r_ = i_ >> 5, c8_ = i_ & 31; tile[j_] = *(const u32x4*)(kx + (size_t)(b_ * 256 + r_) * 1024 + hd_ * 256 + c8_ * 8); } } while (0)
#define XA_LOAD_V(uu) do { const int hd_ = (uu) & 3, b_ = (((uu) >> 2) * 128) / L; _Pragma("unroll") for (int j_ = 0; j_ < 8; ++j_) { const int i_ = tid + j_ * NT, r_ = i_ >> 5, c8_ = i_ & 31; tile[j_] = *(const u32x4*)(vt + (size_t)(hd_ * 256 + r_) * (NB * 256) + b_ * 256 + c8_ * 8); } } while (0)
#define XA_STORE() do { _Pragma("unroll") for (int j_ = 0; j_ < 8; ++j_) { const int i_ = tid + j_ * NT, r_ = i_ >> 5, c8_ = i_ & 31; *(LAS u32x4*)(KV + r_ * XA_LD + c8_ * 8) = tile[j_]; } } while (0)
#define XA_REST_K(uu) do { const int hd_ = (uu) & 3, b_ = (((uu) >> 2) * 128) / L; _Pragma("unroll") for (int j_ = 8; j_ < 16; ++j_) { const int i_ = tid + j_ * NT, r_ = i_ >> 5, c8_ = i_ & 31; *(LAS u32x4*)(KV + r_ * XA_LD + c8_ * 8) = *(const u32x4*)(kx + (size_t)(b_ * 256 + r_) * 1024 + hd_ * 256 + c8_ * 8); } } while (0)
#define XA_REST_V(uu) do { const int hd_ = (uu) & 3, b_ = (((uu) >> 2) * 128) / L; _Pragma("unroll") for (int j_ = 8; j_ < 16; ++j_) { const int i_ = tid + j_ * NT, r_ = i_ >> 5, c8_ = i_ & 31; *(LAS u32x4*)(KV + r_ * XA_LD + c8_ * 8) = *(const u32x4*)(vt + (size_t)(hd_ * 256 + r_) * (NB * 256) + b_ * 256 + c8_ * 8); } } while (0)
    if (F.vcu < (T / 128) * 4) XA_LOAD_K(F.vcu);
    for (int u = F.vcu; u < (T / 128) * 4; u += F.G) {
        const int hd = u & 3, rt = u >> 2, row0 = rt * 128;
        LDS_BARRIER();
        XA_REST_K(u); XA_STORE();
        XA_LOAD_V(u);
        LDS_BARRIER();
        bf16x8 pf[8]; float fA, fB;
        {
            const bf16_t* qp = q + (size_t)(row0 + wave * 16 + fr) * 1024 + hd * 256 + fq * 8;
            bf16x8 qf[8];
#pragma unroll
            for (int ks = 0; ks < 8; ++ks) qf[ks] = *(const bf16x8*)(qp + ks * 32);
            float mh[2], lh[2];
#pragma unroll
            for (int half = 0; half < 2; ++half) {
                f32x4 s[8];
#pragma unroll
                for (int kt = 0; kt < 8; ++kt) { s[kt] = (f32x4){0.f, 0.f, 0.f, 0.f};
#pragma unroll
                    for (int ks = 0; ks < 8; ++ks) { const bf16x8 kf = *(const LAS bf16x8*)(KV + ((half * 8 + kt) * 16 + fr) * XA_LD + ks * 32 + fq * 8); s[kt] = mfma16(kf, qf[ks], s[kt]); }
                    }
                float m = -3.0e38f;
#pragma unroll
                for (int kt = 0; kt < 8; ++kt) m = fmaxf(m, fmaxf(fmaxf(s[kt][0], s[kt][1]), fmaxf(s[kt][2], s[kt][3])));
                m = fmaxf(m, __shfl_xor(m, 16)); m = fmaxf(m, __shfl_xor(m, 32));
                float l = 0.f;
#pragma unroll
                for (int kt = 0; kt < 8; ++kt) {
#pragma unroll
                    for (int r = 0; r < 4; ++r) { const float p = fexp2(s[kt][r] - m); s[kt][r] = p; l += p; } }
                l += __shfl_xor(l, 16); l += __shfl_xor(l, 32); mh[half] = m; lh[half] = l;
#pragma unroll
                for (int j = 0; j < 4; ++j) { u32x4 o; o.x = cvt_pk_bf16(s[2 * j][0], s[2 * j][1]); o.y = cvt_pk_bf16(s[2 * j][2], s[2 * j][3]); o.z = cvt_pk_bf16(s[2 * j + 1][0], s[2 * j + 1][1]); o.w = cvt_pk_bf16(s[2 * j + 1][2], s[2 * j + 1][3]);
                    pf[half * 4 + j] = __builtin_bit_cast(bf16x8, o); }
                    }
            const float m = fmaxf(mh[0], mh[1]), cA = fexp2(mh[0] - m), cB = fexp2(mh[1] - m), li = frcp(cA * lh[0] + cB * lh[1]); fA = cA * li; fB = cB * li;
        }
        LDS_BARRIER();
        XA_REST_V(u); XA_STORE();
        if (u + F.G < (T / 128) * 4) XA_LOAD_K(u + F.G);
        LDS_BARRIER();
#pragma unroll 2
        for (int dt = 0; dt < 16; ++dt) { f32x4 oA = {0.f, 0.f, 0.f, 0.f}, oB = oA;
#pragma unroll
            for (int j = 0; j < 8; ++j) { const LAS bf16_t* vp = KV + (dt * 16 + fr) * XA_LD + j * 32 + 4 * fq; const u32x2 lo = *(const LAS u32x2*)vp, hi = *(const LAS u32x2*)(vp + 16);
                u32x4 a; a.x = lo.x; a.y = lo.y; a.z = hi.x; a.w = hi.y; const bf16x8 vf = __builtin_bit_cast(bf16x8, a);
                if (j < 4) oA = mfma16(vf, pf[j], oA); else oB = mfma16(vf, pf[j], oB); }
            const f32x4 o = oA * fA + oB * fB;
            bf16_t* op = att + (size_t)(row0 + wave * 16 + fr) * 1024 + hd * 256 + dt * 16 + 4 * fq;
            u32x2 w; w.x = cvt_pk_bf16(o[0], o[1]); w.y = cvt_pk_bf16(o[2], o[3]); *(u32x2*)op = w; }
    }
#undef XA_LOAD_K
#undef XA_LOAD_V
#undef XA_STORE
#undef XA_REST_K
#undef XA_REST_V
}

#ifndef CPU_EMU
struct KvOrder {
    static constexpr bool LIGHT = false;
    const char* memnb; const char* wxa; char* kx; char* vt; int G, c;
    __device__ bool next(int i, pg8::Unit& u) const {
        const int Lx = i * G + c; if (Lx >= 32) return false;
        const int l = Lx >> 4, r = Lx & 15; const size_t tstep = (size_t)256 * 1024 * 2;
        if (r < 8) { u.pm = r >> 2; u.pn = r & 3; u.tag = l * 2; u.a = memnb + (size_t)u.pm * tstep; u.b = wxa + (size_t)l * 8 * MiB + 2 * MiB + (size_t)u.pn * tstep; }
        else { const int r2 = r - 8; u.pm = r2 >> 1; u.pn = r2 & 1; u.tag = l * 2 + 1; u.a = wxa + (size_t)l * 8 * MiB + 4 * MiB + (size_t)u.pm * tstep; u.b = memnb + (size_t)u.pn * tstep; }
        return true;
    }
    __device__ __forceinline__ void a_ready(const pg8::Unit&) const {}
    __device__ __forceinline__ void done(const pg8::Unit&) const {}
};
struct EpiKv {
    static constexpr bool PERM = true, AFTER_DRAIN = false;
    bf16_t* kx; bf16_t* vt;
    __device__ __forceinline__ void operator()(const f32x4 (&acc)[2][2][4][2], const pg8::Unit& u, int wr, int wc, int fr, int fq) const {
        const int l = u.tag >> 1, isv = u.tag & 1, ldc = isv ? 512 : 1024; bf16_t* O = isv ? vt + (size_t)l * 1024 * 512 : kx + (size_t)l * 512 * 1024;
        const int row0 = u.pm * 256 + wr * 64 + fr, col0 = u.pn * 256 + wc * 32 + 8 * fq;
#pragma unroll
        for (int ai = 0; ai < 2; ++ai)
#pragma unroll
            for (int m = 0; m < 4; ++m) { bf16_t* rowp = O + (size_t)(row0 + ai * 128 + m * 16) * ldc + col0;
#pragma unroll
                for (int bj = 0; bj < 2; ++bj) { const f32x4 v0 = acc[ai][bj][m][0], v1 = acc[ai][bj][m][1]; u32x4 w; w.x = cvt_pk_bf16(v0[0], v0[1]); w.y = cvt_pk_bf16(v0[2], v0[3]); w.z = cvt_pk_bf16(v1[0], v1[1]); w.w = cvt_pk_bf16(v1[2], v1[3]);
                    *(u32x4*)(rowp + bj * 128) = w; } }
    }
};
__device__ __forceinline__ void phase_kv(const Frame& F) {
    pg8::Gemm g{nullptr, nullptr, 0, 0, 1024};
    int vcu_; { const int bx = blockIdx.x, G = gridDim.x; vcu_ = (G % 8 == 0) ? (bx % 8) * (G / 8) + bx / 8 : bx; if (G % 8 == 0 && G >= 64) { const int per = G / 8, xcd = vcu_ / per, loc = vcu_ % per; vcu_ = loc < 4 ? xcd * 4 + loc : 32 + vcu_; } }
    KvOrder S{(const char*)OKP(bf16_t, WS_MEMNB), (const char*)OKP(bf16_t, WS_W_XA), (char*)OKP(bf16_t, WS_KX), (char*)OKP(bf16_t, WS_VT), F.G, vcu_};
    EpiKv E{OKP(bf16_t, WS_KX), OKP(bf16_t, WS_VT)};
    pg8::gemm_phase<EpiKv, KvOrder, true, true>(F.lds, g, S, E);
}
#endif
}

namespace ok {
constexpr size_t WS_WRH = WS_WR, WS_WRL = WS_WR + 256 * KiB;
constexpr size_t WS_POS = WS_TILEEXP + 4 * KiB;
__device__ __forceinline__ void prologue_router_tables(const Frame& F0) {
    const Frame F = phase_frame(F0);
    using namespace sm;
    const size_t gt = (size_t)F.vcu * NT + F.tid, GT = (size_t)F.G * NT;
    for (size_t i = gt; i < (size_t)2 * 48 * 1024; i += GT) { const int l = (int)(i / (48 * 1024)), j = (int)((i / 1024) % 48), k = (int)(i % 1024); float v = 0.f;
        if (j < 4) v = F.in[I_MOE_WG][((size_t)l * 1024 + k) * 4 + j]; else if (j < 36) v = F.in[I_MOE_WE][((size_t)l * 1024 + k) * 32 + (j - 4)];
        v *= F.in[I_NORM_FFN][l * 1024 + k];
        const unsigned hi = cvt_pk_bf16(v, 0.f) & 0xffffu; const float rem = v - __uint_as_float(hi << 16);
        OKP(bf16_t, WS_WRH)[i] = (bf16_t)hi; OKP(bf16_t, WS_WRL)[i] = (bf16_t)(cvt_pk_bf16(rem, 0.f) & 0xffffu); }
}

constexpr size_t WS_W16H = WS_WR + 512 * KiB, WS_W16L = WS_W16H + 64 * KiB;
__device__ __forceinline__ void prologue_w16_tables(const Frame& F0) {
    using namespace sm;
    const Frame F = phase_frame(F0);
    const size_t gt = (size_t)F.vcu * NT + F.tid, GT = (size_t)F.G * NT;
    for (size_t i = gt; i < (size_t)2 * 16 * 1024; i += GT) { const int set = (int)(i >> 14), j = (int)((i >> 10) & 15), k = (int)(i & 1023);
        const float v = set == 0 ? F.in[I_NORM_MIX][k] * F.in[I_EV_WIN][(size_t)k * 4112 + 4096 + j] : F.in[I_NORM_MIX][1024 + k] * F.in[I_OD_WIN][(size_t)k * 5648 + 4096 + j];
        const unsigned hi = cvt_pk_bf16(v, 0.f) & 0xffffu; const float rem = v - __uint_as_float(hi << 16);
        OKP(bf16_t, WS_W16H)[i] = (bf16_t)hi; OKP(bf16_t, WS_W16L)[i] = (bf16_t)(cvt_pk_bf16(rem, 0.f) & 0xffffu); }
}
__device__ __forceinline__ void phase_proj16(const Frame& F0, int set, const float* h, const bf16_t* hb, const float* ssq, int np) {
    const Frame F = phase_frame(F0);
    const int lane = F.lane, fr = lane & 15, fq = lane >> 4;
    const bf16_t* wh = OKP(bf16_t, WS_W16H) + (size_t)set * 16 * 1024; const bf16_t* wl = OKP(bf16_t, WS_W16L) + (size_t)set * 16 * 1024;
    const int gw = F.vcu * NWAVES + F.wave, NGW = F.G * NWAVES;
    for (int tile = gw; tile < T / 16; tile += NGW) { const int t0 = tile * 16; f32x4 acc = {0.f, 0.f, 0.f, 0.f};
        const float* hp = h + (size_t)(t0 + fr) * DM + fq * 8;
#pragma unroll 8
        for (int ks = 0; ks < 32; ++ks) { const size_t wo = (size_t)fr * 1024 + ks * 32 + fq * 8; const bf16x8 bh = *(const bf16x8*)(wh + wo), bl = *(const bf16x8*)(wl + wo);
            if (hb) { const bf16x8 ah = *(const bf16x8*)(hb + (size_t)(t0 + fr) * DM + fq * 8 + ks * 32); acc = mfma16(bh, ah, acc); acc = mfma16(bl, ah, acc); }
            else { const f32x4 x0 = *(const f32x4*)(hp + ks * 32), x1 = *(const f32x4*)(hp + ks * 32 + 4);
            u32x4 hi, lo;
            hi.x = cvt_pk_bf16(x0[0], x0[1]); hi.y = cvt_pk_bf16(x0[2], x0[3]); hi.z = cvt_pk_bf16(x1[0], x1[1]); hi.w = cvt_pk_bf16(x1[2], x1[3]);
            lo.x = cvt_pk_bf16(x0[0] - bflo(hi.x), x0[1] - bfhi(hi.x)); lo.y = cvt_pk_bf16(x0[2] - bflo(hi.y), x0[3] - bfhi(hi.y));
            lo.z = cvt_pk_bf16(x1[0] - bflo(hi.z), x1[1] - bfhi(hi.z)); lo.w = cvt_pk_bf16(x1[2] - bflo(hi.w), x1[3] - bfhi(hi.w));
            const bf16x8 ah = __builtin_bit_cast(bf16x8, hi), al = __builtin_bit_cast(bf16x8, lo);
            acc = mfma16(bh, ah, acc); acc = mfma16(bl, ah, acc); acc = mfma16(bh, al, acc); } }
        acc *= rstd_np(ssq, np, t0 + fr);
        *(f32x4*)(OKP(float, WS_RAW16) + (size_t)(t0 + fr) * 16 + 4 * fq) = acc; }
}

__device__ __forceinline__ void phase_router(const Frame& F0, int l, const bf16_t* hb, const float* ssq, int np) {
    const Frame F = phase_frame(F0);
    using namespace sm;
    const int lane = F.lane, wave = F.wave, fr = lane & 15, fq = lane >> 4;
    LAS float* lg = (LAS float*)(F.lds + wave * 16384 + 8704);
    const bf16_t* wh = OKP(bf16_t, WS_WRH) + (size_t)l * 48 * 1024; const bf16_t* wl = OKP(bf16_t, WS_WRL) + (size_t)l * 48 * 1024;
    const float* bg = F.in[I_MOE_BG] + l * 4; const float* be = F.in[I_MOE_BE] + l * 32;
    unsigned* cnt = F.ctl + CW_MOE + l * 64;
    const int gw = F.vcu * NWAVES + wave, NGW = F.G * NWAVES;
    for (int tile = gw; tile < T / 16; tile += NGW) {
        const int t0 = tile * 16;
        f32x4 acc[3] = {{0.f, 0.f, 0.f, 0.f}, {0.f, 0.f, 0.f, 0.f}, {0.f, 0.f, 0.f, 0.f}};
        const bf16_t* hp = hb + (size_t)(t0 + fr) * DM + fq * 8;
#pragma unroll 8
        for (int ks = 0; ks < 32; ++ks) { const bf16x8 ah = *(const bf16x8*)(hp + ks * 32);
#pragma unroll
            for (int nt = 0; nt < 3; ++nt) { const size_t wo = (size_t)(nt * 16 + fr) * 1024 + ks * 32 + fq * 8; const bf16x8 bh = *(const bf16x8*)(wh + wo), bl = *(const bf16x8*)(wl + wo);
                acc[nt] = mfma16(bh, ah, acc[nt]); acc[nt] = mfma16(bl, ah, acc[nt]); } }
#pragma unroll
        for (int nt = 0; nt < 3; ++nt) *(LAS f32x4*)(lg + fr * 48 + nt * 16 + 4 * fq) = acc[nt];
        WAVE_SYNC();
        if (lane < 16) { const int t = t0 + lane; const LAS float* p = lg + lane * 48; const float rs = rstd_np(ssq, np, t);
            const float g0 = p[0] * rs + bg[0], g1 = p[1] * rs + bg[1], g2 = p[2] * rs + bg[2], g3 = p[3] * rs + bg[3];
            int gsel = 0; float gm = g0; if (g1 > gm) { gm = g1; gsel = 1; } if (g2 > gm) { gm = g2; gsel = 2; } if (g3 > gm) { gm = g3; gsel = 3; }
            const float gwt = 1.f / (expf(g0 - gm) + expf(g1 - gm) + expf(g2 - gm) + expf(g3 - gm));
            const LAS float* pe = p + 4 + gsel * 8; const float* bb = be + gsel * 8;
            float e[8];
#pragma unroll
            for (int j = 0; j < 8; ++j) e[j] = pe[j] * rs + bb[j];
            int i1 = 0; float m1 = e[0];
#pragma unroll
            for (int j = 1; j < 8; ++j) if (e[j] > m1) { m1 = e[j]; i1 = j; }
            int i2 = -1; float m2 = -3.0e38f;
#pragma unroll
            for (int j = 0; j < 8; ++j) if (j != i1 && e[j] > m2) { m2 = e[j]; i2 = j; }
            const float r = expf(m2 - m1); const float w1 = gwt / (1.f + r), w2 = gwt * r / (1.f + r);
            const int e1 = gsel * 8 + i1, e2 = gsel * 8 + i2;
            OKP(int, WS_EID)[t * 2] = e1; OKP(int, WS_EID)[t * 2 + 1] = e2; OKP(float, WS_GATEW)[t * 2] = w1; OKP(float, WS_GATEW)[t * 2 + 1] = w2;
            OKP(int, WS_POS)[t * 2] = (int)atomicAdd(cnt + e1, 1u); OKP(int, WS_POS)[t * 2 + 1] = (int)atomicAdd(cnt + e2, 1u); }
        WAVE_SYNC();
    }
}

__device__ __forceinline__ void phase_scatter(const Frame& F0, int l, const bf16_t* hb, const float* ssq, int np) {
    const Frame F = phase_frame(F0);
    const unsigned* cnt = F.ctl + CW_MOE + l * 64; const int lane = F.lane;
    const int gw = F.vcu * NWAVES + F.wave, NGW = F.G * NWAVES;
    int base = 0;
    { int tiles = lane < 32 ? (((int)cnt[lane & 31] + 255) >> 8) : 0; int incl = tiles;
#pragma unroll
      for (int o = 1; o < 32; o <<= 1) { const int n = __shfl_up(incl, o); if ((lane & 31) >= o) incl += n; }
      base = (incl - tiles) * 256;
      const int cnt_e = lane < 32 ? (int)cnt[lane & 31] : 0; const int light = (tiles > 0 && cnt_e - 256 * (tiles - 1) <= 128) ? 1 : 0, full = tiles - light;
      int fincl = full, lincl = light;
#pragma unroll
      for (int o = 1; o < 32; o <<= 1) { const int n1 = __shfl_up(fincl, o), n2 = __shfl_up(lincl, o); if ((lane & 31) >= o) { fincl += n1; lincl += n2; } }
      const int ntiles = __shfl(incl, 31), nfull = __shfl(fincl, 31);
      if (blockIdx.x == 0 && F.wave == 0) { if (lane < 32) { for (int i = 0; i < tiles; ++i) OKP(int, WS_TILEEXP)[(base >> 8) + i] = lane;
              for (int i = 0; i < full; ++i) OKP(int, WS_TILEEXP)[512 + (fincl - full) + i] = (base >> 8) + i;
              if (light) OKP(int, WS_TILEEXP)[512 + nfull + (lincl - 1)] = ((base >> 8) + tiles - 1) | (1 << 16); }
          if (lane == 0) OKP(int, WS_TILEEXP)[1023] = ntiles; } }
    for (int a0 = gw * 4; a0 < T * 2; a0 += NGW * 4) {
        int slot[4]; u32x4 r0[4], r1[4];
#pragma unroll
        for (int k = 0; k < 4; ++k) { const int a = a0 + k; const int e = OKP(int, WS_EID)[a]; slot[k] = __shfl(base, e) + OKP(int, WS_POS)[a]; }
#pragma unroll
        for (int k = 0; k < 4; ++k) { const u32x4* src = (const u32x4*)(hb + (size_t)((a0 + k) >> 1) * DM) + lane; r0[k] = src[0]; r1[k] = src[64]; }
#pragma unroll
        for (int k = 0; k < 4; ++k) { const int a = a0 + k, t = a >> 1; u32x4* dst = (u32x4*)(OKP(bf16_t, WS_XS) + (size_t)slot[k] * DM) + lane; dst[0] = r0[k]; dst[64] = r1[k];
            if (lane == 0) { OKP(int, WS_TOKSLOT)[a] = slot[k]; OKP(float, WS_SLOTGATE)[slot[k]] = OKP(float, WS_GATEW)[a]; OKP(float, WS_SLOTRSTD)[slot[k]] = rstd_np(ssq, np, t); } } }
}

__device__ __forceinline__ void phase_combine(const Frame& F0, bf16_t* hb, float* ssq, bool final_layer) {
    using namespace sm;
    const Frame F = phase_frame(F0);
    const int lane = F.lane; const int gw = F.vcu * NWAVES + F.wave, NGW = F.G * NWAVES; const bf16_t* y = OKP(bf16_t, WS_Y);
    for (int t0 = gw * 2; t0 < T; t0 += NGW * 2) {
        int sa[2], sb[2];
#pragma unroll
        for (int k = 0; k < 2; ++k) { sa[k] = OKP(int, WS_TOKSLOT)[(t0 + k) * 2]; sb[k] = OKP(int, WS_TOKSLOT)[(t0 + k) * 2 + 1]; }
        u32x2 ra[2][4], rb[2][4], rh[2][4];
#pragma unroll
        for (int k = 0; k < 2; ++k) { const u32x2* hr = (const u32x2*)(hb + (size_t)(t0 + k) * DM) + lane; const u32x2* ya = (const u32x2*)(y + (size_t)sa[k] * DM) + lane; const u32x2* yb = (const u32x2*)(y + (size_t)sb[k] * DM) + lane;
#pragma unroll
            for (int j = 0; j < 4; ++j) { ra[k][j] = ya[64 * j]; rb[k][j] = yb[64 * j]; rh[k][j] = hr[64 * j]; } }
#pragma unroll
        for (int k = 0; k < 2; ++k) { const int t = t0 + k; u32x2* hr = (u32x2*)(hb + (size_t)t * DM) + lane; f32x4 v[4]; float s = 0.f;
#pragma unroll
            for (int j = 0; j < 4; ++j) { const u32x2 a = ra[k][j], b = rb[k][j], hw = rh[k][j]; f32x4 x;
                x[0] = bflo(hw.x) + (bflo(a.x) + bflo(b.x)); x[1] = bfhi(hw.x) + (bfhi(a.x) + bfhi(b.x)); x[2] = bflo(hw.y) + (bflo(a.y) + bflo(b.y)); x[3] = bfhi(hw.y) + (bfhi(a.y) + bfhi(b.y));
                if (!final_layer) { u32x2 w; w.x = cvt_pk_bf16(x[0], x[1]); w.y = cvt_pk_bf16(x[2], x[3]); hr[64 * j] = w; x = (f32x4){bflo(w.x), bfhi(w.x), bflo(w.y), bfhi(w.y)}; }
                v[j] = x; s += (x[0] * x[0] + x[1] * x[1]) + (x[2] * x[2] + x[3] * x[3]); }
            s = wave_sum(s);
            if (!final_layer) { if (lane == 0) ssq[t] = s; }
            else { const float rs = frsq(s * (1.f / DM) + EPS); f32x4* orow = (f32x4*)(F.out + (size_t)t * DM) + lane; const f32x4* gr = (const f32x4*)F.in[I_FINAL_NORM] + lane;
#pragma unroll
                for (int j = 0; j < 4; ++j) { const f32x4 g = gr[64 * j]; f32x4 o; o[0] = v[j][0] * rs * g[0]; o[1] = v[j][1] * rs * g[1]; o[2] = v[j][2] * rs * g[2]; o[3] = v[j][3] * rs * g[3]; orow[64 * j] = o; } } } }
}

#ifndef CPU_EMU
struct MoeOrder {
    static constexpr bool LIGHT = true;
    const char* A; const char* W; const int* tile_exp; size_t a_tstep, w_estride, w_off, w_tstep; int G, c;
    __device__ bool next(int i, pg8::Unit& u) const {
        const int Lx = i * G + c; const int ntiles = tile_exp[1023]; if (Lx >= ntiles * 4) return false;
        const int info = tile_exp[512 + (Lx >> 2)], tile = info & 0xffff; u.pm = tile; u.pn = Lx & 3; u.tag = info >> 16; const int e = tile_exp[tile];
        u.a = A + (size_t)tile * a_tstep; u.b = W + (size_t)e * w_estride + w_off + (size_t)u.pn * w_tstep; return true;
    }
    __device__ __forceinline__ void a_ready(const pg8::Unit&) const {}
    __device__ __forceinline__ void done(const pg8::Unit&) const {}
};
struct EpiSwiGLU {
    static constexpr bool PERM = false, AFTER_DRAIN = false;
    bf16_t* act; const float* slot_rstd;
    __device__ __forceinline__ void operator()(const f32x4 (&acc)[2][2][4][2], const pg8::Unit& u, int wr, int wc, int fr, int fq) const {
        const int row0 = u.pm * 256 + wr * 64 + fr, col0 = u.pn * 128 + wc * 16 + 4 * fq;
#pragma unroll
        for (int ai = 0; ai < 2; ++ai)
#pragma unroll
            for (int m = 0; m < 4; ++m) { const int row = row0 + ai * 128 + m * 16; const float rs = slot_rstd[row]; bf16_t* rowp = act + (size_t)row * 512 + col0;
#pragma unroll
                for (int bj = 0; bj < 2; ++bj) { const f32x4 g = acc[ai][bj][m][0] * rs, up = acc[ai][bj][m][1] * rs; f32x4 o;
#pragma unroll
                    for (int r = 0; r < 4; ++r) o[r] = g[r] * frcp(1.f + fexp(-g[r])) * up[r];
                    u32x2 w; w.x = cvt_pk_bf16(o[0], o[1]); w.y = cvt_pk_bf16(o[2], o[3]); *(u32x2*)(rowp + bj * 64) = w; } }
    }
};
struct EpiDown {
    static constexpr bool PERM = true, AFTER_DRAIN = false;
    bf16_t* y; const float* slot_gate;
    __device__ __forceinline__ void operator()(const f32x4 (&acc)[2][2][4][2], const pg8::Unit& u, int wr, int wc, int fr, int fq) const {
        const int row0 = u.pm * 256 + wr * 64 + fr, col0 = u.pn * 256 + wc * 32 + 8 * fq;
#pragma unroll
        for (int ai = 0; ai < 2; ++ai)
#pragma unroll
            for (int m = 0; m < 4; ++m) { const int row = row0 + ai * 128 + m * 16; const float s = slot_gate[row]; bf16_t* rowp = y + (size_t)row * DM + col0;
#pragma unroll
                for (int bj = 0; bj < 2; ++bj) { const f32x4 v0 = acc[ai][bj][m][0] * s, v1 = acc[ai][bj][m][1] * s; u32x4 w; w.x = cvt_pk_bf16(v0[0], v0[1]); w.y = cvt_pk_bf16(v0[2], v0[3]); w.z = cvt_pk_bf16(v1[0], v1[1]); w.w = cvt_pk_bf16(v1[2], v1[3]);
                    *(u32x4*)(rowp + bj * 128) = w; } }
    }
};
__device__ __forceinline__ void phase_moe_up(const Frame& F) {
    pg8::Gemm g{nullptr, nullptr, 0, 0, 1024};
    MoeOrder S{(const char*)OKP(bf16_t, WS_XS), (const char*)OKP(bf16_t, WS_MOEW), OKP(int, WS_TILEEXP), (size_t)256 * 1024 * 2, 3 * MiB, 0, (size_t)256 * 1024 * 2, F.G, (int)blockIdx.x};
    EpiSwiGLU E{OKP(bf16_t, WS_ACT), OKP(float, WS_SLOTRSTD)};
    pg8::gemm_phase<EpiSwiGLU, MoeOrder, true, true>(F.lds, g, S, E);
}
__device__ __forceinline__ void phase_moe_down(const Frame& F) {
    pg8::Gemm g{nullptr, nullptr, 0, 0, 512};
    MoeOrder S{(const char*)OKP(bf16_t, WS_ACT), (const char*)OKP(bf16_t, WS_MOEW), OKP(int, WS_TILEEXP), (size_t)256 * 512 * 2, 3 * MiB, 2 * MiB, (size_t)256 * 512 * 2, F.G, (int)blockIdx.x};
    EpiDown E{OKP(bf16_t, WS_Y), OKP(float, WS_SLOTGATE)};
    pg8::gemm_phase<EpiDown, MoeOrder, true, true>(F.lds, g, S, E);
}
#endif
}

#ifndef DUP_MASK
#define DUP_MASK 0
#endif
namespace ok {
constexpr size_t WS_GU = 160 * MiB, WS_GW = 192 * MiB, WS_GQD = 224 * MiB, WS_GKDT = 480 * MiB, WS_GAQK = 512 * MiB;
constexpr size_t WS_GDEC = WS_GCS;
constexpr size_t WS_OBUF = WS_H;
constexpr int G_LD = 132, GB_LD = 136, LM_LD = 68, LB_LD = 72, XT_LD2 = 68;
__device__ __forceinline__ float sigmoidf_(float x) { return frcp(1.f + fexp(-x)); }

template <int PARTS  > __device__ __forceinline__ void phase_gdn_prep_t(const Frame& F0) {
    using namespace sm;
    const Frame F = phase_frame(F0);
    LAS float* q_s = (LAS float*)F.lds; LAS float* k_s = (LAS float*)(F.lds + 33792); LAS float* v_s = (LAS float*)(F.lds + 67584);
    LAS bf16_t* Kn = (LAS bf16_t*)(F.lds + 101376); LAS bf16_t* Qn = (LAS bf16_t*)(F.lds + 118784);
    LAS float* g_s = (LAS float*)(F.lds + 136192); LAS float* beta_s = g_s + 64; LAS float* gc_s = g_s + 128; LAS float* eg_s = g_s + 192; LAS float* rq_s = g_s + 256; LAS float* rk_s = g_s + 320;
    LAS float* Lm = q_s;
    LAS bf16_t* Lb16 = (LAS bf16_t*)(F.lds + 17408);
    LAS bf16_t* XT = Kn;
    const int tid = F.tid, lane = F.lane, wave = F.wave, fr = lane & 15, fq = lane >> 4;
    const bf16_t* proj = OKP(bf16_t, WS_PROJ); const float* cw = F.in[I_OD_CONV];
    for (int u = F.vcu; u < NB * NCH * 8; u += F.G) {
        const int hd = u & 7, bc = u >> 3, b = bc / NCH, c = bc % NCH; const size_t row0 = (size_t)b * L + c * 64; const size_t ub = (size_t)bc * 8 + hd;
        LDS_BARRIER();
        if ((PARTS & 1) && tid < 384) { const int which = tid >> 7, d = tid & 127, xc = which * 1024 + hd * 128 + d; LAS float* dst = (which == 0 ? q_s : which == 1 ? k_s : v_s) + d;
            const float w0 = cw[xc], w1 = cw[3072 + xc], w2 = cw[6144 + xc], w3 = cw[9216 + xc]; const bf16_t* p = proj + row0 * PROJ1_LD + xc;
            float x0 = 0.f, x1 = 0.f, x2 = 0.f; if (c > 0) { x0 = bf2f(p[-3 * PROJ1_LD]); x1 = bf2f(p[-2 * PROJ1_LD]); x2 = bf2f(p[-PROJ1_LD]); }
            unsigned short raw[64];
#pragma unroll
            for (int t = 0; t < 64; ++t) raw[t] = p[(size_t)t * PROJ1_LD];
#pragma unroll
            for (int t = 0; t < 64; ++t) { const float x3 = bf2f(raw[t]); const float v = w0 * x0 + w1 * x1 + w2 * x2 + w3 * x3; dst[t * G_LD] = siluf(v); x0 = x1; x1 = x2; x2 = x3; } }
        if ((PARTS & 1) && tid >= 448) { const int t = tid - 448; const float* r16 = OKP(float, WS_RAW16) + (row0 + t) * 16;
            g_s[t] = -expf(F.in[I_OD_ALOG][hd]) * softplusf(r16[hd] + F.in[I_OD_DTB][hd]); beta_s[t] = sigmoidf_(r16[8 + hd]); }
        LDS_BARRIER();
        if (!(PARTS & 1)) {} else if (wave == 0) { float v = g_s[lane];
#pragma unroll
            for (int o = 1; o < 64; o <<= 1) { const float n = __shfl_up(v, o); if (lane >= o) v += n; }
            gc_s[lane] = v; eg_s[lane] = fexp(v); if (lane == 63) OKP(float, WS_GDEC)[ub] = fexp(v); }
        else if (wave <= 2) { const LAS float* src = (wave == 1 ? q_s : k_s) + lane * G_LD; float s = 0.f;
#pragma unroll 8
            for (int d = 0; d < 128; d += 4) { const f32x4 x = *(const LAS f32x4*)(src + d); s += (x.x * x.x + x.y * x.y) + (x.z * x.z + x.w * x.w); }
            const float r = frsq(s + EPS); if (wave == 1) rq_s[lane] = r * 0.08838834764831845f; else rk_s[lane] = r; }
        LDS_BARRIER();
        if (PARTS & 2)
        { const float gl = gc_s[63];
          for (int i = tid; i < 64 * 64; i += NT) { const int t = i >> 6, dp = (i & 63) * 2; const float rk = rk_s[t], rq = rq_s[t], eg = eg_s[t];
              const float k0 = k_s[t * G_LD + dp] * rk, k1 = k_s[t * G_LD + dp + 1] * rk, q0 = q_s[t * G_LD + dp] * rq, q1 = q_s[t * G_LD + dp + 1] * rq;
              *(LAS unsigned*)(Kn + t * GB_LD + dp) = cvt_pk_bf16(k0, k1); *(LAS unsigned*)(Qn + t * GB_LD + dp) = cvt_pk_bf16(q0, q1);
              *(unsigned*)(OKP(bf16_t, WS_GQD) + ub * 8192 + t * 128 + dp) = cvt_pk_bf16(q0 * eg, q1 * eg); }
          { const int t = tid & 63, dg = tid >> 6; const float f = rk_s[t] * fexp(gl - gc_s[t]); bf16_t* dst = OKP(bf16_t, WS_GKDT) + ub * 8192 + t;
#pragma unroll
            for (int j = 0; j < 16; ++j) { const int d = dg * 16 + j; dst[d * 64] = (bf16_t)(cvt_pk_bf16(k_s[t * G_LD + d] * f, 0.f) & 0xffffu); } } }
        LDS_BARRIER();
        if (PARTS & 4)
#pragma unroll
        for (int i = 0; i < 4; ++i) { const int tl = wave * 4 + i, which = tl >> 4, ti = (tl >> 2) & 3, si = tl & 3;
            f32x4 acc = {0.f, 0.f, 0.f, 0.f};
            if (si <= ti) {
#pragma unroll
                for (int ks = 0; ks < 4; ++ks) { const bf16x8 a = *(const LAS bf16x8*)(Kn + (si * 16 + fr) * GB_LD + ks * 32 + fq * 8); const bf16x8 bb = *(const LAS bf16x8*)((which ? Qn : Kn) + (ti * 16 + fr) * GB_LD + ks * 32 + fq * 8); acc = mfma16(a, bb, acc); }
                const int t = ti * 16 + fr; const float gt = gc_s[t], bt = beta_s[t];
#pragma unroll
                for (int r = 0; r < 4; ++r) { const int s = si * 16 + 4 * fq + r; const float dec = fexp(gt - gc_s[s]); acc[r] = which ? (s <= t ? acc[r] * dec : 0.f) : (s < t ? acc[r] * dec * bt : 0.f); } }
            const int t = ti * 16 + fr, s0 = si * 16 + 4 * fq;
            if (which) { u32x2 w; w.x = cvt_pk_bf16(acc[0], acc[1]); w.y = cvt_pk_bf16(acc[2], acc[3]); *(u32x2*)(OKP(bf16_t, WS_GAQK) + ub * 4096 + t * 64 + s0) = w; }
            else { Lm[(s0 + 0) * LM_LD + t] = acc[0]; Lm[(s0 + 1) * LM_LD + t] = acc[1]; Lm[(s0 + 2) * LM_LD + t] = acc[2]; Lm[(s0 + 3) * LM_LD + t] = acc[3];
                u32x2 w; w.x = cvt_pk_bf16(acc[0], acc[1]); w.y = cvt_pk_bf16(acc[2], acc[3]); *(LAS u32x2*)(Lb16 + t * LB_LD + s0) = w; } }
        LDS_BARRIER();
        if (PARTS & 8) {
            for (int i = tid; i < 64 * 128; i += NT) { const int t = i >> 7, cc = i & 127; const float bt = beta_s[t]; v_s[t * G_LD + cc] *= bt; k_s[t * G_LD + cc] *= bt * rk_s[t] * eg_s[t]; }
            LDS_BARRIER();
#pragma unroll
            for (int ib = 0; ib < 4; ++ib) {
                if (ib > 0) {
#pragma unroll
                    for (int ct2 = 0; ct2 < 2; ++ct2) { const int ct = wave * 2 + ct2; f32x4 acc = {0.f, 0.f, 0.f, 0.f};
#pragma unroll
                        for (int ks = 0; ks < (ib * 16 + 31) / 32; ++ks) { const LAS bf16_t* lp = Lb16 + (ib * 16 + fr) * LB_LD + ks * 32 + fq * 8; u32x4 la = *(const LAS u32x4*)lp;
                            if (ks * 32 + fq * 8 >= ib * 16) la = (u32x4){0u, 0u, 0u, 0u};
                            const LAS bf16_t* xp = XT + (ct * 16 + fr) * XT_LD2 + ks * 32 + fq * 8; const u32x2 x0 = *(const LAS u32x2*)xp, x1 = *(const LAS u32x2*)(xp + 4); u32x4 xb; xb.x = x0.x; xb.y = x0.y; xb.z = x1.x; xb.w = x1.y;
                            if (ks * 32 + fq * 8 >= ib * 16) xb = (u32x4){0u, 0u, 0u, 0u};
                            acc = mfma16(__builtin_bit_cast(bf16x8, la), __builtin_bit_cast(bf16x8, xb), acc); }
                        LAS float* rp = (ct < 8 ? v_s : k_s) + (ib * 16 + 4 * fq) * G_LD + (ct & 7) * 16 + fr;
#pragma unroll
                        for (int r = 0; r < 4; ++r) rp[r * G_LD] -= acc[r]; }
                    LDS_BARRIER(); }
                if (tid < 256) { const int cidx = tid & 127; const bool isw = tid >= 128; const LAS float* col = (isw ? k_s : v_s) + cidx; bf16_t* dst = OKP(bf16_t, isw ? WS_GW : WS_GU) + ub * 8192 + (isw ? cidx : cidx * 4);
                    float a[16];
#pragma unroll
                    for (int tt = 0; tt < 16; ++tt) a[tt] = col[(ib * 16 + tt) * G_LD];
#pragma unroll
                    for (int ss = 0; ss < 16; ++ss) { const float xv = a[ss]; const LAS f32x4* lp = (const LAS f32x4*)(Lm + (ib * 16 + ss) * LM_LD + ib * 16);
#pragma unroll
                        for (int q4 = ss / 4; q4 < 4; ++q4) { const f32x4 l4 = lp[q4];
#pragma unroll
                            for (int r = 0; r < 4; ++r) if (q4 * 4 + r > ss) a[q4 * 4 + r] -= l4[r] * xv; } }
                    LAS bf16_t* xt = XT + tid * XT_LD2 + ib * 16;
#pragma unroll
                    for (int q4 = 0; q4 < 4; ++q4) { u32x2 w; w.x = cvt_pk_bf16(a[q4 * 4], a[q4 * 4 + 1]); w.y = cvt_pk_bf16(a[q4 * 4 + 2], a[q4 * 4 + 3]); *(LAS u32x2*)(xt + q4 * 4) = w;
                        if (!isw) *(u32x2*)(dst + (size_t)(ib * 4 + q4) * 512) = w; }
                    if (isw) {
#pragma unroll
                        for (int ss = 0; ss < 16; ++ss) dst[(ib * 16 + ss) * 128] = (bf16_t)(cvt_pk_bf16(a[ss], 0.f) & 0xffffu); } }
                if (ib < 3) LDS_BARRIER();
            }
        }
    }
}
}

namespace ok {
constexpr int ST_LD = 136, VT_LD = 72;
__device__ __forceinline__ void phase_gdn_prep(const Frame& F0) { phase_gdn_prep_t<15>(F0); }
constexpr int GJT = 4, GDV = GJT * 16, GN_UNITS = NB * 8 * (128 / GDV);
static_assert(GJT == 4, "the Z slot below is sized for four column tiles");
struct GdnEarly { bf16x8 X[4]; u32x2 Z[4]; };
struct GdnLate { bf16x8 Kf[2]; float dec; };
__device__ __forceinline__ void gdn_load_early(GdnEarly& g, const Frame& F, size_t xoff, size_t ub, int ti, int sl, int fr, int fq, int roleB) {
    const bf16_t* Xp = (const bf16_t*)(F.ws + xoff) + ub * 8192 + (ti * 16 + fr) * 128 + fq * 8;
#pragma unroll
    for (int ks = 0; ks < 4; ++ks) g.X[ks] = *(const bf16x8*)(Xp + ks * 32);
    const bf16_t* zb = roleB ? OKP(bf16_t, WS_GAQK) + ub * 4096 + (ti * 16 + fr) * 64 + fq * 8 : OKP(bf16_t, WS_GU) + ub * 8192 + ((size_t)(ti * 4 + fq) * 128 + sl * GDV + fr) * 4;
#pragma unroll
    for (int i = 0; i < 4; ++i) g.Z[i] = *(const u32x2*)(zb + (roleB ? (i >> 1) * 32 + (i & 1) * 4 : i * 64));
}
__device__ __forceinline__ void gdn_load_late(GdnLate& g, const Frame& F, size_t ub, int ti, int wave, int fr, int fq, int vzero) {
    const bf16_t* Kp = OKP(bf16_t, WS_GKDT) + ub * 8192 + (wave * 16 + fr) * 64 + fq * 8;
#pragma unroll
    for (int k2 = 0; k2 < 2; ++k2) g.Kf[k2] = *(const bf16x8*)(Kp + k2 * 32);
    g.dec = OKP(float, WS_GDEC)[ub + vzero];
}
constexpr int OS_LD = GDV + 8;
__device__ __forceinline__ void gdn_flush_o(const Frame& F, const LAS bf16_t* Os, int b, int cprev, int hd, int sl) {
    constexpr int PCS = GDV / 8;
    if (F.tid < 64 * PCS) { const int row = F.tid / PCS, pc = F.tid % PCS; *(u32x4*)(OKP(bf16_t, WS_OBUF) + ((size_t)b * L + cprev * 64 + row) * 1024 + hd * 128 + sl * GDV + pc * 8) = *(const LAS u32x4*)(Os + row * OS_LD + pc * 8); }
}
__device__ __forceinline__ void gdn_step(const Frame& F, const GdnEarly& g, const GdnLate& h, f32x4 (&Sacc)[GJT], LAS bf16_t* ST0, LAS bf16_t* VnT, int par, int roleB, int b, int c, int hd, int sl, int ti, int wave, int fr, int fq) {
    LAS bf16_t* ST = ST0 + par * (GDV * ST_LD); LAS bf16_t* STn = ST0 + (par ^ 1) * (GDV * ST_LD);
    LAS bf16_t* Os = VnT + GDV * VT_LD;
    LDS_BARRIER();
    if (c > 0) gdn_flush_o(F, Os, b, c - 1, hd, sl);
    f32x4 a[GJT];
#pragma unroll
    for (int ji = 0; ji < GJT; ++ji) a[ji] = (f32x4){0.f, 0.f, 0.f, 0.f};
#pragma unroll
    for (int ks = 0; ks < 4; ++ks)
#pragma unroll
        for (int ji = 0; ji < GJT; ++ji) { const bf16x8 sf = *(const LAS bf16x8*)(ST + (ji * 16 + fr) * ST_LD + ks * 32 + fq * 8); a[ji] = mfma16(g.X[ks], sf, a[ji]); }
    if (!roleB) {
#pragma unroll
        for (int ji = 0; ji < GJT; ++ji) { const u32x2 uv = g.Z[ji]; u32x2 w; w.x = cvt_pk_bf16(bflo(uv.x) - a[ji][0], bfhi(uv.x) - a[ji][1]); w.y = cvt_pk_bf16(bflo(uv.y) - a[ji][2], bfhi(uv.y) - a[ji][3]);
            *(LAS u32x2*)(VnT + (ji * 16 + fr) * VT_LD + ti * 16 + 4 * fq) = w; } }
    LDS_BARRIER();
#pragma unroll
    for (int ji = 0; ji < GJT; ++ji) { bf16x8 vf[2];
#pragma unroll
        for (int k2 = 0; k2 < 2; ++k2) vf[k2] = *(const LAS bf16x8*)(VnT + (ji * 16 + fr) * VT_LD + k2 * 32 + fq * 8);
        if (roleB) {
#pragma unroll
            for (int k2 = 0; k2 < 2; ++k2) { u32x4 af; af.x = g.Z[2 * k2].x; af.y = g.Z[2 * k2].y; af.z = g.Z[2 * k2 + 1].x; af.w = g.Z[2 * k2 + 1].y; a[ji] = mfma16(__builtin_bit_cast(bf16x8, af), vf[k2], a[ji]); }
            LAS bf16_t* op = Os + (ti * 16 + 4 * fq) * OS_LD + ji * 16 + fr;
#pragma unroll
            for (int r = 0; r < 4; ++r) op[r * OS_LD] = (bf16_t)(cvt_pk_bf16(a[ji][r], 0.f) & 0xffffu); }
        Sacc[ji] *= h.dec;
#pragma unroll
        for (int k2 = 0; k2 < 2; ++k2) Sacc[ji] = mfma16(h.Kf[k2], vf[k2], Sacc[ji]);
        u32x2 w; w.x = cvt_pk_bf16(Sacc[ji][0], Sacc[ji][1]); w.y = cvt_pk_bf16(Sacc[ji][2], Sacc[ji][3]); *(LAS u32x2*)(STn + (ji * 16 + fr) * ST_LD + wave * 16 + 4 * fq) = w; }
}
template <int MODE  > __device__ __forceinline__ void gdn_scan_unit_t(const Frame& F, int unit) {
    LAS bf16_t* ST = (LAS bf16_t*)F.lds; LAS bf16_t* VnT = (LAS bf16_t*)(F.lds + 2 * GDV * ST_LD * 2);
    const int tid = F.tid, lane = F.lane, wave = F.wave, fr = lane & 15, fq = lane >> 4;
    constexpr int NSL = 128 / GDV;
    const int sl = unit % NSL, hd = (unit / NSL) & 7, b = unit / (NSL * 8), ti = wave & 3, roleB = wave >> 2;
    for (int i = tid; i < GDV * ST_LD / 2; i += NT) ((LAS unsigned*)ST)[i] = 0u;
    f32x4 Sacc[GJT];
#pragma unroll
    for (int ji = 0; ji < GJT; ++ji) Sacc[ji] = (f32x4){0.f, 0.f, 0.f, 0.f};
    const size_t ub0 = ((size_t)b * NCH) * 8 + hd; const size_t xoff = roleB ? WS_GQD : WS_GW;
    int vzero = 0;
#ifndef CPU_EMU
    asm volatile("" : "+v"(vzero));
#endif
#define GDN_LE(set, cc) if (MODE == 0) gdn_load_early(set, F, xoff, ub0 + (size_t)((cc) < NCH ? (cc) : NCH - 1) * 8, ti, sl, fr, fq, roleB)
#define GDN_LL(set, cc) if (MODE == 0) gdn_load_late(set, F, ub0 + (size_t)((cc) < NCH ? (cc) : NCH - 1) * 8, ti, wave, fr, fq, vzero)
#define GDN_ST(es, ls, cc, par) gdn_step(F, es, ls, Sacc, ST, VnT, par, roleB, b, (MODE == 0 ? (cc) : 0), hd, sl, ti, wave, fr, fq)
    GdnEarly e0, e1, e2; GdnLate l0, l1;
    GDN_LE(e0, 0); GDN_LE(e1, 1); GDN_LL(l0, 0);
    if (MODE == 1) { gdn_load_early(e0, F, xoff, ub0, ti, sl, fr, fq, roleB); gdn_load_early(e1, F, xoff, ub0, ti, sl, fr, fq, roleB); gdn_load_early(e2, F, xoff, ub0, ti, sl, fr, fq, roleB); gdn_load_late(l0, F, ub0, ti, wave, fr, fq, vzero); gdn_load_late(l1, F, ub0, ti, wave, fr, fq, vzero); }
    int c = 0;
    for (; c + 6 <= NCH; c += 6) {
        GDN_LE(e2, c + 2); GDN_LL(l1, c + 1); GDN_ST(e0, l0, c + 0, 0);
        GDN_LE(e0, c + 3); GDN_LL(l0, c + 2); GDN_ST(e1, l1, c + 1, 1);
        GDN_LE(e1, c + 4); GDN_LL(l1, c + 3); GDN_ST(e2, l0, c + 2, 0);
        GDN_LE(e2, c + 5); GDN_LL(l0, c + 4); GDN_ST(e0, l1, c + 3, 1);
        GDN_LE(e0, c + 6); GDN_LL(l1, c + 5); GDN_ST(e1, l0, c + 4, 0);
        GDN_LE(e1, c + 7); GDN_LL(l0, c + 6); GDN_ST(e2, l1, c + 5, 1);
    }
    if (c + 0 < NCH) { GDN_LE(e2, c + 2); GDN_LL(l1, c + 1); GDN_ST(e0, l0, c + 0, 0); }
    if (c + 1 < NCH) { GDN_LE(e0, c + 3); GDN_LL(l0, c + 2); GDN_ST(e1, l1, c + 1, 1); }
    if (c + 2 < NCH) { GDN_LE(e1, c + 4); GDN_LL(l1, c + 3); GDN_ST(e2, l0, c + 2, 0); }
    if (c + 3 < NCH) { GDN_LE(e2, c + 5); GDN_LL(l0, c + 4); GDN_ST(e0, l1, c + 3, 1); }
    if (c + 4 < NCH) { GDN_LE(e0, c + 6); GDN_LL(l1, c + 5); GDN_ST(e1, l0, c + 4, 0); }
#undef GDN_LE
#undef GDN_LL
#undef GDN_ST
    LDS_BARRIER();
    if (MODE == 0) gdn_flush_o(F, VnT + GDV * VT_LD, b, NCH - 1, hd, sl);
}
__device__ __forceinline__ void gdn_scan_unit(const Frame& F, int unit) { gdn_scan_unit_t<0>(F, unit); }
__device__ __forceinline__ void phase_gdn_final(const Frame& F0) {
    using namespace sm;
    const Frame F = phase_frame(F0);
    const int lane = F.lane; const int gw = F.vcu * NWAVES + F.wave, NGW = F.G * NWAVES;
    const f32x4* nw4 = (const f32x4*)(F.in[I_OD_NORM] + (lane & 7) * 16);
    u32x4 na[2], nz[2]; { const int t = gw < T ? gw : 0; const u32x4* op = (const u32x4*)(OKP(bf16_t, WS_OBUF) + (size_t)t * 1024 + lane * 16); const u32x4* zp = (const u32x4*)(OKP(bf16_t, WS_PROJ) + (size_t)t * PROJ1_LD + 3072 + lane * 16); na[0] = op[0]; na[1] = op[1]; nz[0] = zp[0]; nz[1] = zp[1]; }
    for (int t = gw; t < T; t += NGW) { const u32x4 ca[2] = {na[0], na[1]}, cz[2] = {nz[0], nz[1]};
        { const int tn = t + NGW < T ? t + NGW : t; const u32x4* op = (const u32x4*)(OKP(bf16_t, WS_OBUF) + (size_t)tn * 1024 + lane * 16); const u32x4* zp = (const u32x4*)(OKP(bf16_t, WS_PROJ) + (size_t)tn * PROJ1_LD + 3072 + lane * 16); na[0] = op[0]; na[1] = op[1]; nz[0] = zp[0]; nz[1] = zp[1]; }
        float o[16], z[16];
#pragma unroll
        for (int h2 = 0; h2 < 2; ++h2) { const u32x4 a = ca[h2], zz = cz[h2];
            o[h2 * 8 + 0] = bflo(a.x); o[h2 * 8 + 1] = bfhi(a.x); o[h2 * 8 + 2] = bflo(a.y); o[h2 * 8 + 3] = bfhi(a.y); o[h2 * 8 + 4] = bflo(a.z); o[h2 * 8 + 5] = bfhi(a.z); o[h2 * 8 + 6] = bflo(a.w); o[h2 * 8 + 7] = bfhi(a.w);
            z[h2 * 8 + 0] = bflo(zz.x); z[h2 * 8 + 1] = bfhi(zz.x); z[h2 * 8 + 2] = bflo(zz.y); z[h2 * 8 + 3] = bfhi(zz.y); z[h2 * 8 + 4] = bflo(zz.z); z[h2 * 8 + 5] = bfhi(zz.z); z[h2 * 8 + 6] = bflo(zz.w); z[h2 * 8 + 7] = bfhi(zz.w); }
        float s = 0.f;
#pragma unroll
        for (int i = 0; i < 16; ++i) s += o[i] * o[i];
        s += __shfl_xor(s, 1); s += __shfl_xor(s, 2); s += __shfl_xor(s, 4);
        const float rs = frsq(s * (1.f / 128.f) + EPS);
        u32x4 w[2];
#pragma unroll
        for (int h2 = 0; h2 < 2; ++h2) { const f32x4 n0 = nw4[h2 * 2], n1 = nw4[h2 * 2 + 1]; float y[8];
#pragma unroll
            for (int i = 0; i < 8; ++i) y[i] = o[h2 * 8 + i] * rs * (i < 4 ? n0[i] : n1[i - 4]) * siluf(z[h2 * 8 + i]);
            w[h2].x = cvt_pk_bf16(y[0], y[1]); w[h2].y = cvt_pk_bf16(y[2], y[3]); w[h2].z = cvt_pk_bf16(y[4], y[5]); w[h2].w = cvt_pk_bf16(y[6], y[7]); }
        u32x4* cp = (u32x4*)(OKP(bf16_t, WS_CAT1) + (size_t)t * 1536 + lane * 16); cp[0] = w[0]; cp[1] = w[1]; }
}
}

#ifndef DUP_MASK
#define DUP_MASK 0
#endif
namespace ok {
constexpr int SB_LD = 72;
#ifdef CPU_EMU
#define WAVE_ALL(p) (wave_sum((p) ? 1.f : 0.f) == 64.f)
#else
#define WAVE_ALL(p) (__all(p))
#endif
__device__ __forceinline__ void sb_unit(const Frame& F, int unit) {
    LAS bf16_t* Kt = (LAS bf16_t*)F.lds; LAS bf16_t* VT = (LAS bf16_t*)(F.lds + 64 * SB_LD * 2); volatile LAS int* votes = (volatile LAS int*)(F.lds + 2 * 64 * SB_LD * 2);
    const int tid = F.tid, lane = F.lane, wave = F.wave, fr = lane & 15, fq = lane >> 4;
    const int nqb = L / 128, qb = unit % nqb, hd = (unit / nqb) & 7, b = unit / (nqb * 8), q0 = qb * 128;
    const bf16_t* proj = OKP(bf16_t, WS_PROJ) + (size_t)b * L * PROJ1_LD;
    const int qrow = q0 + wave * 16 + fr;
    bf16x8 qf[2];
#pragma unroll
    for (int ks = 0; ks < 2; ++ks) qf[ks] = *(const bf16x8*)(proj + (size_t)qrow * PROJ1_LD + 4096 + hd * 64 + ks * 32 + fq * 8);
    f32x4 o[4] = {{0.f, 0.f, 0.f, 0.f}, {0.f, 0.f, 0.f, 0.f}, {0.f, 0.f, 0.f, 0.f}, {0.f, 0.f, 0.f, 0.f}};
    float C = 1.f; bool wdone = false;
    const int key_l = tid >> 3, c8 = tid & 7;
    int kt = 2 * qb + 1;
    u32x4 kreg = *(const u32x4*)(proj + (size_t)(kt * 64 + key_l) * PROJ1_LD + 4608 + hd * 64 + c8 * 8), vreg = *(const u32x4*)(proj + (size_t)(kt * 64 + key_l) * PROJ1_LD + 5120 + hd * 64 + c8 * 8);
    for (; kt >= 0; --kt) {
        LDS_BARRIER();
        *(LAS u32x4*)(Kt + key_l * SB_LD + c8 * 8) = kreg;
        { LAS bf16_t* vp = VT + (c8 * 8) * SB_LD + key_l; vp[0] = (bf16_t)(vreg.x & 0xffffu); vp[SB_LD] = (bf16_t)(vreg.x >> 16); vp[2 * SB_LD] = (bf16_t)(vreg.y & 0xffffu); vp[3 * SB_LD] = (bf16_t)(vreg.y >> 16);
          vp[4 * SB_LD] = (bf16_t)(vreg.z & 0xffffu); vp[5 * SB_LD] = (bf16_t)(vreg.z >> 16); vp[6 * SB_LD] = (bf16_t)(vreg.w & 0xffffu); vp[7 * SB_LD] = (bf16_t)(vreg.w >> 16); }
        if (lane == 0) votes[wave] = wdone ? 1 : 0;
        LDS_BARRIER();
        { int all = 1;
#pragma unroll
          for (int w = 0; w < 8; ++w) all &= votes[w];
          if (all) break; }
        if (kt > 0) { kreg = *(const u32x4*)(proj + (size_t)((kt - 1) * 64 + key_l) * PROJ1_LD + 4608 + hd * 64 + c8 * 8); vreg = *(const u32x4*)(proj + (size_t)((kt - 1) * 64 + key_l) * PROJ1_LD + 5120 + hd * 64 + c8 * 8); }
        const int key0 = kt * 64;
#ifdef SB_COUNT_ITERS
        ++g_iters;
#endif
        if (!wdone && key0 < q0 + wave * 16 + 16) {
            f32x4 x[4];
#pragma unroll
            for (int k16 = 0; k16 < 4; ++k16) { x[k16] = (f32x4){0.f, 0.f, 0.f, 0.f};
#pragma unroll
                for (int ks = 0; ks < 2; ++ks) { const bf16x8 kf = *(const LAS bf16x8*)(Kt + (k16 * 16 + fr) * SB_LD + ks * 32 + fq * 8); x[k16] = mfma16(kf, qf[ks], x[k16]); } }
            const bool need_mask = key0 + 63 >= q0 + wave * 16;
            float Rr[4], Tt[4], Ee[4];
#pragma unroll
            for (int k16 = 0; k16 < 4; ++k16) {
#pragma unroll
                for (int r = 0; r < 4; ++r) { const float e = fexp2(fminf(x[k16][r], 80.f)); float rr = frcp(1.f + e), bet = e * rr;
                    if (need_mask && key0 + k16 * 16 + 4 * fq + r >= qrow) { rr = 1.f; bet = 0.f; }
                    x[k16][r] = bet; Rr[k16] = (r == 0) ? rr : Rr[k16];
                    if (r == 0) Tt[k16] = rr; else if (r == 1) Ee[k16] = rr; else if (r == 2) Rr[k16] = rr; else {
                        const float r0 = Tt[k16], r1 = Ee[k16], r2 = Rr[k16], r3 = rr; const float s2 = r3, s1 = r3 * r2, s0 = s1 * r1;
                        x[k16][0] *= s0; x[k16][1] *= s1; x[k16][2] *= s2;
                        Rr[k16] = s0 * r0; } } }
#pragma unroll
            for (int k16 = 0; k16 < 4; ++k16) { const float R = Rr[k16]; const float d1 = __shfl_down(R, 16), d2 = __shfl_down(R, 32), d3 = __shfl_down(R, 48);
                Ee[k16] = (fq < 3 ? d1 : 1.f) * (fq < 2 ? d2 : 1.f) * (fq < 1 ? d3 : 1.f); float t = R; t *= __shfl_xor(t, 16); t *= __shfl_xor(t, 32); Tt[k16] = t; }
            const float TT2 = Tt[3], TT1 = Tt[3] * Tt[2], TT0 = TT1 * Tt[1];
            const float f0 = Ee[0] * TT0 * C, f1 = Ee[1] * TT1 * C, f2 = Ee[2] * TT2 * C, f3 = Ee[3] * C;
            x[0] *= f0; x[1] *= f1; x[2] *= f2; x[3] *= f3;
            C *= TT0 * Tt[0];
            bf16x8 pw[2];
#pragma unroll
            for (int j = 0; j < 2; ++j) { u32x4 p; p.x = cvt_pk_bf16(x[2 * j][0], x[2 * j][1]); p.y = cvt_pk_bf16(x[2 * j][2], x[2 * j][3]); p.z = cvt_pk_bf16(x[2 * j + 1][0], x[2 * j + 1][1]); p.w = cvt_pk_bf16(x[2 * j + 1][2], x[2 * j + 1][3]); pw[j] = __builtin_bit_cast(bf16x8, p); }
#pragma unroll
            for (int dt = 0; dt < 4; ++dt)
#pragma unroll
                for (int j = 0; j < 2; ++j) { const LAS bf16_t* vp = VT + (dt * 16 + fr) * SB_LD + j * 32 + 4 * fq; const u32x2 lo = *(const LAS u32x2*)vp, hi = *(const LAS u32x2*)(vp + 16);
                    u32x4 a; a.x = lo.x; a.y = lo.y; a.z = hi.x; a.w = hi.y; o[dt] = mfma16(__builtin_bit_cast(bf16x8, a), pw[j], o[dt]); }
            wdone = WAVE_ALL(C < 7.8886e-31f);
        }
    }
    bf16_t* op = OKP(bf16_t, WS_CAT1) + ((size_t)b * L + qrow) * 1536 + 1024 + hd * 64 + 4 * fq;
#pragma unroll
    for (int dt = 0; dt < 4; ++dt) { u32x2 w; w.x = cvt_pk_bf16(o[dt][0], o[dt][1]); w.y = cvt_pk_bf16(o[dt][2], o[dt][3]); *(u32x2*)(op + dt * 16) = w; }
}
__device__ __forceinline__ void phase_l1_mix(const Frame& F0) {
    const Frame F = phase_frame(F0);
    constexpr int NU = GN_UNITS, UPX = NU / 8;
    if (F.G < 128 || F.G % 8 != 0) { if (F.vcu == 0) for (int u = 0; u < NU; ++u) { gdn_scan_unit(F, u); __syncthreads(); } for (int u = F.vcu; u < NB * 8 * (L / 128); u += F.G) { sb_unit(F, u); __syncthreads(); } return; }
    const int per = F.G / 8, xcd = F.vcu / per, loc = F.vcu % per;
    if (loc < UPX) { gdn_scan_unit(F, xcd * UPX + loc);
#if (DUP_MASK >> 3) & 1
        __syncthreads(); gdn_scan_unit(F, xcd * UPX + loc);
#endif
#if (DUP_MASK >> 21) & 1
        __syncthreads(); gdn_scan_unit_t<1>(F, xcd * UPX + loc);
#endif
    }
    else for (int rep = 0; rep < 1 + ((DUP_MASK >> 16) & 1); ++rep) for (int u = xcd * (per - UPX) + (loc - UPX); u < NB * 8 * (L / 128); u += F.G - NU) { sb_unit(F, u); __syncthreads(); }
}
}

namespace ok {
#if CHECK
__device__ const int kSampleRows[16] = {0, 1, 2, 3, 63, 64, 127, 128, 129, 1000, 2047, 2048, 4097, 6000, 8190, 8191};
constexpr int FP_W = 6144;
__device__ __forceinline__ void fp_save(const Frame& F, int k, const void* buf, int ld, int width, bool is_bf16, int dcol0) {
    float* fp = OKP(float, WS_FP) + (size_t)k * 16 * FP_W; const size_t gt = (size_t)blockIdx.x * NT + F.tid, GT = (size_t)F.G * NT;
    for (size_t i = gt; i < (size_t)16 * width; i += GT) { const int r = (int)(i / width), c = (int)(i % width); const size_t src = (size_t)kSampleRows[r] * ld + c;
        fp[r * FP_W + dcol0 + c] = is_bf16 ? bf2f(((const bf16_t*)buf)[src]) : ((const float*)buf)[src]; }
}
__device__ __forceinline__ void fp_cmp(const Frame& F, int k, const float* obuf, int ld, int ocol0, int width, int fcol0) {
    const float* fp = OKP(float, WS_FP) + (size_t)k * 16 * FP_W; const size_t gt = (size_t)blockIdx.x * NT + F.tid, GT = (size_t)F.G * NT; float num = 0.f, den = 0.f;
    for (size_t i = gt; i < (size_t)16 * width; i += GT) { const int r = (int)(i / width), c = (int)(i % width); const float o = obuf[(size_t)kSampleRows[r] * ld + ocol0 + c], f = fp[r * FP_W + fcol0 + c];
        const float d = o - f; num += d * d; den += o * o; if (!(d == d)) num += 1e30f; }
    num = wave_sum(num); den = wave_sum(den);
    if (F.lane == 0 && (num != 0.f || den != 0.f)) { atomicAdd((float*)F.ctl + CW_CHK + 2 * k, num); atomicAdd((float*)F.ctl + CW_CHK + 2 * k + 1, den); }
}
__device__ __forceinline__ void fp_save_lin(const Frame& F, int k, const void* buf, size_t off, int n, bool is_bf16) {
    float* fp = OKP(float, WS_FP) + (size_t)k * 16 * FP_W; const size_t gt = (size_t)blockIdx.x * NT + F.tid, GT = (size_t)F.G * NT;
    for (size_t i = gt; i < (size_t)n; i += GT) fp[i] = is_bf16 ? bf2f(((const bf16_t*)buf)[off + i]) : ((const float*)buf)[off + i];
}
__device__ __forceinline__ void fp_cmp_lin(const Frame& F, int k, const float* obuf, size_t off, int n) {
    const float* fp = OKP(float, WS_FP) + (size_t)k * 16 * FP_W; const size_t gt = (size_t)blockIdx.x * NT + F.tid, GT = (size_t)F.G * NT; float num = 0.f, den = 0.f;
    for (size_t i = gt; i < (size_t)n; i += GT) { const float o = obuf[off + i], f = fp[i]; const float d = o - f; num += d * d; den += o * o; if (!(d == d)) num += 1e30f; }
    num = wave_sum(num); den = wave_sum(den);
    if (F.lane == 0 && (num != 0.f || den != 0.f)) { atomicAdd((float*)F.ctl + CW_CHK + 2 * k, num); atomicAdd((float*)F.ctl + CW_CHK + 2 * k + 1, den); }
}
#endif

struct Args { const float* in[33]; float* out; unsigned char* ws;
#if CHECK
    sm::Ctx oc;
#endif
};

__global__ void __launch_bounds__(512, 2) mk_fwd(Args a) {
    extern __shared__ __attribute__((aligned(16))) unsigned char lds_raw[];
    Frame F; F.lds = (LAS unsigned char*)lds_raw; F.ws = a.ws; F.ctl = (unsigned*)(a.ws + WS_CTL); F.in = a.in; F.out = a.out;
    F.tid = threadIdx.x; F.lane = F.tid & 63; F.wave = __builtin_amdgcn_readfirstlane(F.tid >> 6); F.G = gridDim.x;
    { const int bx = blockIdx.x; F.vcu = (F.G % 8 == 0) ? (bx % 8) * (F.G / 8) + bx / 8 : bx; }
    volatile LAS unsigned* MISC = (volatile LAS unsigned*)(F.lds + LDS_BYTES - 64);
    if (F.tid < 16) MISC[F.tid] = 0u;
    __syncthreads();
    XcdBarrier bar = xcd_barrier_post(F.ctl + CW_BAR, MISC);
#define GRID_BAR() xcd_barrier(bar)
    using namespace sm;
    for (int dup_p = 0; dup_p < ((DUP_MASK >> 5) & 1) + 1; ++dup_p) {
    phase_prologue(F);
    prologue_router_tables(F);
    prologue_w16_tables(F);
    GRID_BAR();
    }
    for (int dup_i0 = 0; dup_i0 < ((DUP_MASK >> 6) & 1) + 1; ++dup_i0) {
    { EpiScaleBf16 E{OKP(bf16_t, WS_PROJ), PROJ0_LD, (const float*)F.ctl + CW_SSQ, 1};
      dense_gemm(F, OKP(bf16_t, WS_HB), OKP(bf16_t, WS_W_IN0), T, 4096, 1024, E); }
    phase_proj16(F, 0, F.in[I_X], nullptr, (const float*)F.ctl + CW_SSQ, 1);
    GRID_BAR();
    }
#if CHECK
    fp_save(F, 0, OKP(bf16_t, WS_PROJ), PROJ0_LD, 4096, true, 0);
#endif
    for (int dup_b = 0; dup_b < ((DUP_MASK >> 1) & 1) + 1; ++dup_b) {
    for (int dup_b1 = 0; dup_b1 < ((DUP_MASK >> 14) & 1) + 1; ++dup_b1) { phase_ssd_a(F); GRID_BAR(); }
#if CHECK
    fp_save_lin(F, 6, OKP(bf16_t, WS_STATES), ((size_t)5 * 16 + 0) * 8192, 65536, true);
    GRID_BAR();
#endif
    phase_kv(F);
    phase_ssd_scan(F, (F.G >= 64 && F.G % 8 == 0) ? 32 : 0);
    GRID_BAR();
    for (int dup_b2 = 0; dup_b2 < ((DUP_MASK >> 15) & 1) + 1; ++dup_b2) { phase_ssd_b(F); GRID_BAR(); }
    }

    for (int dup_o0 = 0; dup_o0 < ((DUP_MASK >> 8) & 1) + 1; ++dup_o0) {
    { EpiResidualT<true> E{F.in[I_X], OKP(bf16_t, WS_HB), OKP(float, WS_SSQP1)};
      dense_gemm(F, OKP(bf16_t, WS_CAT0), OKP(bf16_t, WS_W_OUT0), T, 1024, 1536, E); }
    GRID_BAR();
    }
#if CHECK
    fp_save(F, 10, OKP(bf16_t, WS_HB), 1024, 1024, true, 0);
    fp_save_lin(F, 7, OKP(bf16_t, WS_STATES), ((size_t)5 * 16 + 0) * 8192, 65536, true);
    fp_save(F, 8, OKP(bf16_t, WS_CAT0), 1536, 512, true, 0);
    fp_save(F, 9, OKP(bf16_t, WS_CAT0) + 512, 1536, 1024, true, 0);
    GRID_BAR();
#endif
    for (int dup_q0 = 0; dup_q0 < ((DUP_MASK >> 9) & 1) + 1; ++dup_q0) {
    { EpiScaleBf16 E{OKP(bf16_t, WS_Q), 1024, OKP(float, WS_SSQP1), 16};
      dense_gemm(F, OKP(bf16_t, WS_HB), OKP(bf16_t, WS_W_XA), T, 1024, 1024, E); }
    GRID_BAR();
    }
    for (int dup_xa0 = 0; dup_xa0 < ((DUP_MASK >> 13) & 1) + 1; ++dup_xa0) {
    phase_xattn(F, OKP(bf16_t, WS_Q), OKP(bf16_t, WS_KX), OKP(bf16_t, WS_VT), OKP(bf16_t, WS_ATT));
    GRID_BAR();
    }
    { EpiResidualT<false> E{nullptr, OKP(bf16_t, WS_HB), OKP(float, WS_SSQP2)};
      dense_gemm(F, OKP(bf16_t, WS_ATT), OKP(bf16_t, WS_W_XA + 6 * MiB), T, 1024, 1024, E); }
    GRID_BAR();
#if CHECK
    fp_save(F, 11, OKP(bf16_t, WS_HB), 1024, 1024, true, 0);
    GRID_BAR();
#endif
    phase_router(F, 0, OKP(bf16_t, WS_HB), OKP(float, WS_SSQP2), 16);
    for (int dup_cv = 0; dup_cv < ((DUP_MASK >> 10) & 1) + 1; ++dup_cv) phase_cvt_moe(F, 0);
    GRID_BAR();
    for (int dup_sc = 0; dup_sc < ((DUP_MASK >> 11) & 1) + 1; ++dup_sc) {
    phase_scatter(F, 0, OKP(bf16_t, WS_HB), OKP(float, WS_SSQP2), 16);
    GRID_BAR();
    }
    for (int dup_c = 0; dup_c < ((DUP_MASK >> 2) & 1) + 1; ++dup_c) {
    phase_moe_up(F);
    GRID_BAR();
    phase_moe_down(F);
    GRID_BAR();
    }

    phase_combine(F, OKP(bf16_t, WS_HB), (float*)F.ctl + CW_SSQ + 3 * T, false);
    GRID_BAR();
#if CHECK
    fp_save(F, 12, OKP(bf16_t, WS_HB), 1024, 1024, true, 0);
    GRID_BAR();
#endif
    for (int dup_i1 = 0; dup_i1 < ((DUP_MASK >> 12) & 1) + 1; ++dup_i1) {
    { EpiScaleBf16 E{OKP(bf16_t, WS_PROJ), PROJ1_LD, (const float*)F.ctl + CW_SSQ + 3 * T, 1};
      dense_gemm(F, OKP(bf16_t, WS_HB), OKP(bf16_t, WS_W_IN1), T, 5632, 1024, E); }
    phase_proj16(F, 1, nullptr, OKP(bf16_t, WS_HB), (const float*)F.ctl + CW_SSQ + 3 * T, 1);
    GRID_BAR();
    }
#if CHECK
    fp_save(F, 13, OKP(bf16_t, WS_PROJ), PROJ1_LD, 4096, true, 0);
    fp_save(F, 13, OKP(bf16_t, WS_PROJ) + 4608, PROJ1_LD, 1024, true, 4096);
#endif
#if (DUP_MASK >> 22) & 31
    phase_gdn_prep_t<(DUP_MASK >> 22) & 31>(F); GRID_BAR();
#endif
    for (int dup_a = 0; dup_a < ((DUP_MASK >> 0) & 1) + 1; ++dup_a) { phase_gdn_prep(F); GRID_BAR(); }
    phase_l1_mix(F); GRID_BAR();
    for (int dup_e = 0; dup_e < ((DUP_MASK >> 4) & 1) + 1; ++dup_e) { phase_gdn_final(F); GRID_BAR(); }

    { EpiResidualT<false> E{nullptr, OKP(bf16_t, WS_HB), OKP(float, WS_SSQP4)};
      dense_gemm(F, OKP(bf16_t, WS_CAT1), OKP(bf16_t, WS_W_OUT1), T, 1024, 1536, E); }
    GRID_BAR();
#if CHECK
    fp_save(F, 14, OKP(bf16_t, WS_CAT1), 1536, 1024, true, 0);
    fp_save(F, 15, OKP(bf16_t, WS_CAT1) + 1024, 1536, 512, true, 0);
    fp_save(F, 16, OKP(bf16_t, WS_HB), 1024, 1024, true, 0);
    GRID_BAR();
#endif
    { EpiScaleBf16 E{OKP(bf16_t, WS_Q), 1024, OKP(float, WS_SSQP4), 16};
      dense_gemm(F, OKP(bf16_t, WS_HB), OKP(bf16_t, WS_W_XA + 8 * MiB), T, 1024, 1024, E); }
    GRID_BAR();
    phase_xattn(F, OKP(bf16_t, WS_Q), OKP(bf16_t, WS_KX) + (size_t)NB * 256 * 1024, OKP(bf16_t, WS_VT) + (size_t)1024 * NB * 256, OKP(bf16_t, WS_ATT));
    GRID_BAR();
    { EpiResidualT<false> E{nullptr, OKP(bf16_t, WS_HB), OKP(float, WS_SSQP5)};
      dense_gemm(F, OKP(bf16_t, WS_ATT), OKP(bf16_t, WS_W_XA + 8 * MiB + 6 * MiB), T, 1024, 1024, E); }
    GRID_BAR();
#if CHECK
    fp_save(F, 17, OKP(bf16_t, WS_HB), 1024, 1024, true, 0);
    GRID_BAR();
#endif
    phase_router(F, 1, OKP(bf16_t, WS_HB), OKP(float, WS_SSQP5), 16);
    phase_cvt_moe(F, 1);
    GRID_BAR();
    phase_scatter(F, 1, OKP(bf16_t, WS_HB), OKP(float, WS_SSQP5), 16);
    GRID_BAR();
    phase_moe_up(F);
    GRID_BAR();
    phase_moe_down(F);
    GRID_BAR();
    phase_combine(F, OKP(bf16_t, WS_HB), nullptr, true);
#if CHECK
    GRID_BAR();
    fp_save(F, 18, F.out, 1024, 1024, false, 0);
    fp_save(F, 1, OKP(float, WS_DTV), 16, 16, false, 0);
    fp_save(F, 2, OKP(float, WS_ACS), 16, 16, false, 0);
    GRID_BAR();
    {
        const size_t gid = (size_t)blockIdx.x * NT + F.tid, gs = (size_t)F.G * NT;
        for (int st = 0;; ++st) {
            const int s = st % sm::NSTAGE_L;
            if (st < 2 * sm::NSTAGE_L && s >= sm::N_STAGES_USED) continue;
            if (!sm::run_stage(a.oc, st, gid, gs)) break;
            GRID_BAR();
            if (st == 3) fp_cmp(F, 0, a.oc.proj, sm::PROJ_LD, 0, 4096, 0);
            if (st == 4) { fp_cmp(F, 1, a.oc.dtv, 16, 0, 16, 0); fp_cmp(F, 2, a.oc.acs, 16, 0, 16, 0); }
            if (st == 4 && gid == 0) { float* c = (float*)F.ctl + CW_CHK; c[6] = 0.f; c[7] = 1.f; c[8] = 0.f; c[9] = 1.f; c[10] = 0.f; c[11] = 1.f; }
            if (st == 5) fp_cmp_lin(F, 6, a.oc.states, ((size_t)5 * 16 + 0) * 8192, 65536);
            if (st == 6) fp_cmp_lin(F, 7, a.oc.states, ((size_t)5 * 16 + 0) * 8192, 65536);
            if (st == 10) { fp_cmp(F, 8, a.oc.cat, 1536, 0, 512, 0); fp_cmp(F, 9, a.oc.cat, 1536, 512, 1024, 0); }
            if (st == 11) fp_cmp(F, 10, a.oc.h, 1024, 0, 1024, 0);
            if (st == 18) fp_cmp(F, 11, a.oc.h, 1024, 0, 1024, 0);
            if (st == 23) fp_cmp(F, 12, a.oc.h, 1024, 0, 1024, 0);
            if (st == 63) { fp_cmp(F, 13, a.oc.proj, sm::PROJ_LD, 0, 4096, 0); fp_cmp(F, 13, a.oc.proj, sm::PROJ_LD, 4624, 1024, 4096); }
            if (st == 70) { fp_cmp(F, 14, a.oc.cat, 1536, 0, 1024, 0); fp_cmp(F, 15, a.oc.cat, 1536, 1024, 512, 0); }
            if (st == 71) fp_cmp(F, 16, a.oc.h, 1024, 0, 1024, 0);
            if (st == 78) fp_cmp(F, 17, a.oc.h, 1024, 0, 1024, 0);
            if (st == 121) fp_cmp(F, 18, a.oc.out, 1024, 0, 1024, 0);
            GRID_BAR();
        }
        GRID_BAR();
        int code = 0;
        for (int k = CHECK - 1; k >= 0; --k) { const float num = __hip_atomic_load((float*)F.ctl + CW_CHK + 2 * k, __ATOMIC_RELAXED, __HIP_MEMORY_SCOPE_AGENT), den = __hip_atomic_load((float*)F.ctl + CW_CHK + 2 * k + 1, __ATOMIC_RELAXED, __HIP_MEMORY_SCOPE_AGENT);
            if (!(num <= 1e-3f * den) || den == 0.f) code = k + 1; }
        const float sc = 1.f + 0.2f * (float)code;
        for (size_t i = gid; i < (size_t)L * DM; i += gs) { F.out[i] *= sc; F.out[(size_t)L * DM + i] = 0.f; }
    }
#endif
}
}

extern "C" void kernel_launch(void* const* d_in, const int* in_sizes, int n_in, void* d_out, int out_size, void* d_ws, size_t ws_size, hipStream_t stream) {
    static int grid = 0;
    if (grid == 0) {
        int dev = 0, cus = 0, per_cu = 0;
        hipGetDevice(&dev); hipDeviceGetAttribute(&cus, hipDeviceAttributeMultiprocessorCount, dev);
        if (hipFuncSetAttribute((const void*)ok::mk_fwd, hipFuncAttributeMaxDynamicSharedMemorySize, LDS_BYTES) != hipSuccess) { fprintf(stderr, "kernel_launch: hipFuncSetAttribute failed\n"); grid = -1; return; }
        hipOccupancyMaxActiveBlocksPerMultiprocessor(&per_cu, (const void*)ok::mk_fwd, ok::NT, LDS_BYTES);
        (void)hipGetLastError();
        grid = cus;
        if (n_in != 33 || ws_size < ok::WS_END || per_cu < 1) { fprintf(stderr, "kernel_launch: n_in %d ws %zu need %zu per_cu %d\n", n_in, ws_size, (size_t)ok::WS_END, per_cu); grid = -1; }
    }
    if (grid < 0) return;
    hipMemsetAsync((char*)d_ws + ok::WS_CTL, 0, ok::CTL_BYTES, stream);
    ok::Args a{};
    for (int i = 0; i < 33; ++i) a.in[i] = (const float*)d_in[i];
    a.out = (float*)d_out; a.ws = (unsigned char*)d_ws;
#if CHECK
    sm::carve(a.oc, (float*)((char*)d_ws + 16 * ok::MiB));
    for (int i = 0; i < 33; ++i) a.oc.in[i] = (const float*)d_in[i];
    a.oc.out = (float*)d_out;
#endif
    hipLaunchKernelGGL(ok::mk_fwd, dim3(grid), dim3(ok::NT), LDS_BYTES, stream, a);
}
```

```cpp
#include <hip/hip_runtime.h>
#include <cstdio>
#include <cstdint>
#ifndef CHECK
#define CHECK 0
#endif
#define DUP_MASK 0
constexpr int LDS_BYTES = 147456;

#define XB_TMO      128
#define XB_XCNT(j)  (256  + 64 * (j))
#define XB_XSUB(j)  (1280 + 64 * (j))
#define XB_XGEN(j)  (2304 + 64 * (j))
#define XB_TOP      3328
#define XB_TOPGEN   3392
#define XCD_BAR_WORDS 3456
#define XB_SPIN_CAP (1u << 18)
#define LAS __attribute__((address_space(3)))

__device__ __forceinline__ unsigned xb_ld(unsigned* p)              { return __hip_atomic_load(p, __ATOMIC_RELAXED, __HIP_MEMORY_SCOPE_AGENT); }
__device__ __forceinline__ unsigned xb_add(unsigned* p, unsigned v) { return __hip_atomic_fetch_add(p, v, __ATOMIC_RELAXED, __HIP_MEMORY_SCOPE_AGENT); }
__device__ __forceinline__ unsigned xb_xcc_id() { return (unsigned)__builtin_amdgcn_s_getreg((3 << 11) | 20) & 0xFu; }
#define XB_SPIN(cond, bar) do { unsigned _sp = 0; while (cond) { __builtin_amdgcn_s_sleep(1); \
    if ((++_sp & 255u) == 0u) { if (xb_ld(&(bar)[XB_TMO])) break; if (_sp > XB_SPIN_CAP) { atomicAdd(&(bar)[XB_TMO], 1u); break; } } } } while (0)

struct XcdBarrier {
    unsigned* bar; unsigned x;
    volatile LAS unsigned* st;
};

__device__ __forceinline__ XcdBarrier xcd_barrier_post(unsigned* bar, volatile LAS unsigned* st) {
    XcdBarrier b; b.bar = bar; b.x = xb_xcc_id(); b.st = st;
    if (threadIdx.x == 0) (void)xb_add(&bar[XB_XCNT(b.x)], 1u);
    return b;
}
__device__ __forceinline__ void xcd_barrier_complete(unsigned* bar, unsigned x, unsigned& nloc, unsigned& nx) {
    const unsigned G = gridDim.x * gridDim.y * gridDim.z;
    unsigned sum, cnt, mine, sp = 0u;
    for (;;) {
        sum = 0u; cnt = 0u; mine = 0u;
#pragma unroll
        for (unsigned j = 0; j < 16; ++j) { const unsigned c = xb_ld(&bar[XB_XCNT(j)]); sum += c; cnt += (c > 0u) ? 1u : 0u; mine = (j == x) ? c : mine; }
        if (sum == G) break;
        __builtin_amdgcn_s_sleep(1);
        if ((++sp & 255u) == 0u) { if (xb_ld(&bar[XB_TMO])) break; if (sp > XB_SPIN_CAP) { atomicAdd(&bar[XB_TMO], 1u); break; } }
    }
    nloc = mine > 0u ? mine : 1u; nx = cnt > 0u ? cnt : 1u;
}

__device__ __forceinline__ void xcd_barrier(const XcdBarrier& b) {
    asm volatile("s_waitcnt vmcnt(0)" ::: "memory");
    __syncthreads();
    if (threadIdx.x == 0) {
        unsigned* bar = b.bar;
        __builtin_amdgcn_s_waitcnt(0);
        unsigned nloc = b.st[0], nx = b.st[1];
        if (nloc == 0u) { xcd_barrier_complete(bar, b.x, nloc, nx); b.st[0] = nloc; b.st[1] = nx; }
        const unsigned old = xb_add(&bar[XB_XSUB(b.x)], 1u);
        const unsigned gen = old / nloc;
        if (old + 1u == (gen + 1u) * nloc) {
            __builtin_amdgcn_fence(__ATOMIC_RELEASE, "agent");
            asm volatile("s_waitcnt vmcnt(0)" ::: "memory");
            const unsigned og = xb_add(&bar[XB_TOP], 1u);
            const unsigned tg = og / nx;
            if (og + 1u == (tg + 1u) * nx) xb_add(&bar[XB_TOPGEN], 1u);
            else XB_SPIN(xb_ld(&bar[XB_TOPGEN]) == tg, bar);
            __builtin_amdgcn_fence(__ATOMIC_ACQUIRE, "agent");
            xb_add(&bar[XB_XGEN(b.x)], 1u);
            asm volatile("s_waitcnt vmcnt(0)" ::: "memory");
        } else {
            XB_SPIN(xb_ld(&bar[XB_XGEN(b.x)]) == gen, bar);
            __builtin_amdgcn_fence(__ATOMIC_ACQUIRE, "agent");
            asm volatile("s_waitcnt vmcnt(0)" ::: "memory");
        }
    }
    __syncthreads();
}


#undef LAS

#ifndef SEQ
#define SEQ 8192
#endif
namespace sm {
constexpr int DM = 1024, NB = 1  , L = SEQ, T = NB * L, NCH = L / 64, MEM = 256;
constexpr int EV_IN = 4112, OD_IN = 5648, PROJ_LD = 5648;
constexpr int E_SCB = 0, E_SCC = 512, E_SCX = 1024, E_Z = 1536, E_XBC = 2560, E_DT = 4096;
constexpr int O_QKV = 0, O_Z = 3072, O_A = 4096, O_B = 4104, O_SQ = 4112, O_SK = 4624, O_SV = 5136;

struct Ctx {
    const float* in[33];
    float* out;
    float *memn, *kx, *vx, *h, *un, *rstd, *proj, *cat, *xbcc, *dtv, *acs, *states, *cb, *ybuf, *rstd2;
    float *q, *att, *sc;
    float *gatew, *act; int* eid;
    float *qkvc, *beta, *gcs, *Lm, *aqk, *uw, *S, *vn, *obuf;
};
enum In { I_X = 0, I_MEM, I_MEM_NORM, I_FINAL_NORM, I_NORM_MIX, I_NORM_XA, I_NORM_FFN, I_XA_WQ, I_XA_WK, I_XA_WV, I_XA_WO,
          I_MOE_WG, I_MOE_BG, I_MOE_WE, I_MOE_BE, I_MOE_WGATE, I_MOE_WUP, I_MOE_WDOWN,
          I_EV_WIN, I_EV_SCCONV, I_EV_CONVW, I_EV_CONVB, I_EV_DTB, I_EV_ALOG, I_EV_D, I_EV_NORM, I_EV_WOUT,
          I_OD_WIN, I_OD_CONV, I_OD_DTB, I_OD_ALOG, I_OD_NORM, I_OD_WOUT };

__device__ __forceinline__ float siluf(float x) { return x / (1.f + expf(-x)); }
__device__ __forceinline__ float softplusf(float x) { return x > 20.f ? x : log1pf(expf(x)); }
__device__ __forceinline__ float sigmoidf(float x) { return 1.f / (1.f + expf(-x)); }

__device__ __forceinline__ void s_copy(const float* src, float* dst, size_t n, size_t gid, size_t gs) { for (size_t i = gid; i < n; i += gs) dst[i] = src[i]; }
__device__ __forceinline__ void s_rstd(const float* x, int R, int W, int ld, float* rstd, size_t gid, size_t gs) {
    for (size_t r = gid; r < (size_t)R; r += gs) { const float* p = x + r * ld; float s = 0.f; for (int i = 0; i < W; ++i) s += p[i] * p[i]; rstd[r] = 1.f / sqrtf(s / W + 1e-6f); }
}
__device__ __forceinline__ void s_norm(const float* x, const float* rstd, const float* g, float* y, int R, size_t gid, size_t gs) {
    for (size_t i = gid; i < (size_t)R * DM; i += gs) { const size_t r = i / DM; const int c = (int)(i % DM); y[i] = x[i] * rstd[r] * g[c]; }
}
__device__ __forceinline__ void s_gemm(const float* A, int lda, const float* W, int ldw, float* C, int ldc, int M, int N, int K, int accum, size_t gid, size_t gs) {
    const int N4 = N / 4;
    for (size_t i = gid; i < (size_t)M * N4; i += gs) { const size_t m = i / N4; const int n = (int)(i % N4) * 4; const float* a = A + m * lda; const float* w = W + n; float s0 = 0.f, s1 = 0.f, s2 = 0.f, s3 = 0.f;
        for (int k = 0; k < K; ++k) { const float av = a[k]; const float4 wv = *(const float4*)(w + (size_t)k * ldw); s0 += av * wv.x; s1 += av * wv.y; s2 += av * wv.z; s3 += av * wv.w; }
        float4* c = (float4*)(C + m * ldc + n); float4 o = accum ? *c : float4{0.f, 0.f, 0.f, 0.f}; o.x += s0; o.y += s1; o.z += s2; o.w += s3; *c = o; }
}
__device__ __forceinline__ void s_scmix(const Ctx& c, size_t gid, size_t gs) {
    const float* w = c.in[I_EV_SCCONV];
    for (size_t i = gid; i < (size_t)T * 512; i += gs) { const size_t t = i / 512; const int ch = (int)(i % 512); const int tl = (int)(t % L); float s = 0.f;
        for (int j = 0; j < 3; ++j) { const int tt = tl - 2 + j; if (tt >= 0) { const float* p = c.proj + (t - 2 + j) * PROJ_LD; s += w[j * 512 + ch] * p[E_SCC + ch] * p[E_SCX + ch]; } }
        c.cat[t * 1536 + ch] = c.proj[t * PROJ_LD + E_SCB + ch] * s; }
}
__device__ __forceinline__ void s_ssd_conv(const Ctx& c, size_t gid, size_t gs) {
    const float* w = c.in[I_EV_CONVW]; const float* b = c.in[I_EV_CONVB];
    for (size_t i = gid; i < (size_t)T * 1536; i += gs) { const size_t t = i / 1536; const int ch = (int)(i % 1536); const int tl = (int)(t % L); float s = b[ch];
        for (int j = 0; j < 4; ++j) { const int tt = tl - 3 + j; if (tt >= 0) s += w[j * 1536 + ch] * c.proj[(t - 3 + j) * PROJ_LD + E_XBC + ch]; }
        c.xbcc[i] = siluf(s); }
}
__device__ __forceinline__ void s_ssd_dt(const Ctx& c, size_t gid, size_t gs) {
    for (size_t i = gid; i < (size_t)NB * NCH * 16; i += gs) { const int hd = (int)(i % 16); const size_t bc = i / 16; const float a = -expf(c.in[I_EV_ALOG][hd]); float cs = 0.f;
        for (int s = 0; s < 64; ++s) { const size_t t = bc * 64 + s; const float dt = softplusf(c.proj[t * PROJ_LD + E_DT + hd] + c.in[I_EV_DTB][hd]); cs += dt * a; c.dtv[t * 16 + hd] = dt; c.acs[t * 16 + hd] = cs; } }
}
__device__ __forceinline__ void s_ssd_states(const Ctx& c, size_t gid, size_t gs) {
    for (size_t i = gid; i < (size_t)NB * NCH * 16 * 64 * 128; i += gs) { const int n = (int)(i % 128); const int p = (int)((i / 128) % 64); const int hd = (int)((i / 8192) % 16); const size_t bc = i / (8192 * 16);
        const int g = hd / 8; const float last = c.acs[(bc * 64 + 63) * 16 + hd]; float s = 0.f;
        for (int k = 0; k < 64; ++k) { const size_t t = bc * 64 + k; s += c.xbcc[t * 1536 + 1024 + g * 128 + n] * c.xbcc[t * 1536 + hd * 64 + p] * c.dtv[t * 16 + hd] * expf(last - c.acs[t * 16 + hd]); }
        c.states[i] = s; }
}
__device__ __forceinline__ void s_ssd_scan(const Ctx& c, size_t gid, size_t gs) {
    for (size_t i = gid; i < (size_t)NB * 16 * 8192; i += gs) { const size_t b = i / (16 * 8192); const size_t r = i % (16 * 8192); const int hd = (int)(r / 8192); float s = 0.f;
        for (int ch = 0; ch < NCH; ++ch) { const size_t bc = b * NCH + ch; const size_t idx = bc * (16 * 8192) + r; const float st = c.states[idx]; c.states[idx] = s; s = s * expf(c.acs[(bc * 64 + 63) * 16 + hd]) + st; } }
}
__device__ __forceinline__ void s_ssd_cb(const Ctx& c, size_t gid, size_t gs) {
    for (size_t i = gid; i < (size_t)NB * NCH * 2 * 4096; i += gs) { const int s = (int)(i % 64); const int t = (int)((i / 64) % 64); const int g = (int)((i / 4096) % 2); const size_t bc = i / 8192;
        const float* cm = c.xbcc + (bc * 64 + t) * 1536 + 1280 + g * 128; const float* bm = c.xbcc + (bc * 64 + s) * 1536 + 1024 + g * 128; float a = 0.f;
        for (int n = 0; n < 128; ++n) a += cm[n] * bm[n];
        c.cb[i] = a; }
}
__device__ __forceinline__ void s_ssd_y(const Ctx& c, size_t gid, size_t gs) {
    for (size_t i = gid; i < (size_t)T * 1024; i += gs) { const size_t t = i / 1024; const int hp = (int)(i % 1024); const int hd = hp / 64, p = hp % 64, g = hd / 8; const size_t bc = t / 64; const int tl = (int)(t % 64);
        const float at = c.acs[t * 16 + hd]; float y = 0.f;
        for (int s = 0; s <= tl; ++s) { const size_t ts = bc * 64 + s; y += c.cb[(bc * 2 + g) * 4096 + tl * 64 + s] * expf(at - c.acs[ts * 16 + hd]) * c.xbcc[ts * 1536 + hp] * c.dtv[ts * 16 + hd]; }
        const float* cm = c.xbcc + t * 1536 + 1280 + g * 128; const float* pv = c.states + (bc * 16 + hd) * 8192 + p * 128; float yo = 0.f;
        for (int n = 0; n < 128; ++n) yo += cm[n] * pv[n];
        y += yo * expf(at) + c.xbcc[t * 1536 + hp] * c.in[I_EV_D][hd];
        c.ybuf[i] = y * siluf(c.proj[t * PROJ_LD + E_Z + hp]); }
}
__device__ __forceinline__ void s_ssd_out(const Ctx& c, size_t gid, size_t gs) {
    for (size_t i = gid; i < (size_t)T * 1024; i += gs) { const size_t t = i / 1024; const int ch = (int)(i % 1024); c.cat[t * 1536 + 512 + ch] = c.ybuf[i] * c.rstd2[t * 2 + ch / 512] * c.in[I_EV_NORM][ch]; }
}
__device__ __forceinline__ void s_xa_scores(const Ctx& c, size_t gid, size_t gs) {
    for (size_t i = gid; i < (size_t)T * 4 * 256; i += gs) { const int m = (int)(i % 256); const int hd = (int)((i / 256) % 4); const size_t t = i / 1024; const size_t b = t / L;
        const float* q = c.q + t * 1024 + hd * 256; const float* k = c.kx + (b * 256 + m) * 1024 + hd * 256; float s = 0.f;
        for (int d = 0; d < 256; ++d) s += q[d] * k[d];
        c.sc[i] = s * 0.0625f; }
}
__device__ __forceinline__ void s_xa_softmax(const Ctx& c, size_t gid, size_t gs) {
    for (size_t i = gid; i < (size_t)T * 4; i += gs) { float* p = c.sc + i * 256; float mx = p[0]; for (int m = 1; m < 256; ++m) mx = fmaxf(mx, p[m]); float s = 0.f; for (int m = 0; m < 256; ++m) { const float e = expf(p[m] - mx); p[m] = e; s += e; } const float r = 1.f / s; for (int m = 0; m < 256; ++m) p[m] *= r; }
}
__device__ __forceinline__ void s_xa_pv(const Ctx& c, size_t gid, size_t gs) {
    for (size_t i = gid; i < (size_t)T * 1024; i += gs) { const size_t t = i / 1024; const int col = (int)(i % 1024); const int hd = col / 256; const size_t b = t / L; const float* p = c.sc + (t * 4 + hd) * 256; const float* v = c.vx + b * 256 * 1024 + col; float s = 0.f;
        for (int m = 0; m < 256; ++m) s += p[m] * v[(size_t)m * 1024];
        c.att[i] = s; }
}
__device__ __forceinline__ void s_router(const Ctx& c, int l, size_t gid, size_t gs) {
    const float* wg = c.in[I_MOE_WG] + (size_t)l * 1024 * 4; const float* bg = c.in[I_MOE_BG] + l * 4; const float* we = c.in[I_MOE_WE] + (size_t)l * 1024 * 32; const float* be = c.in[I_MOE_BE] + l * 32;
    for (size_t t = gid; t < (size_t)T; t += gs) { const float* x = c.un + t * 1024; float g0 = 0.f, g1 = 0.f, g2 = 0.f, g3 = 0.f;
        for (int k = 0; k < 1024; ++k) { const float xv = x[k]; g0 += xv * wg[k * 4 + 0]; g1 += xv * wg[k * 4 + 1]; g2 += xv * wg[k * 4 + 2]; g3 += xv * wg[k * 4 + 3]; }
        g0 += bg[0]; g1 += bg[1]; g2 += bg[2]; g3 += bg[3];
        int gsel = 0; float gm = g0; if (g1 > gm) { gm = g1; gsel = 1; } if (g2 > gm) { gm = g2; gsel = 2; } if (g3 > gm) { gm = g3; gsel = 3; }
        const float gw = 1.f / (expf(g0 - gm) + expf(g1 - gm) + expf(g2 - gm) + expf(g3 - gm));
        float e0 = 0, e1 = 0, e2 = 0, e3 = 0, e4 = 0, e5 = 0, e6 = 0, e7 = 0; const float* w = we + gsel * 8;
        for (int k = 0; k < 1024; ++k) { const float xv = x[k]; const float* wk = w + k * 32; e0 += xv * wk[0]; e1 += xv * wk[1]; e2 += xv * wk[2]; e3 += xv * wk[3]; e4 += xv * wk[4]; e5 += xv * wk[5]; e6 += xv * wk[6]; e7 += xv * wk[7]; }
        const float* bb = be + gsel * 8; e0 += bb[0]; e1 += bb[1]; e2 += bb[2]; e3 += bb[3]; e4 += bb[4]; e5 += bb[5]; e6 += bb[6]; e7 += bb[7];
        int i1 = 0; float m1 = e0;
#define SM_T1(j, v) if (v > m1) { m1 = v; i1 = j; }
        SM_T1(1, e1) SM_T1(2, e2) SM_T1(3, e3) SM_T1(4, e4) SM_T1(5, e5) SM_T1(6, e6) SM_T1(7, e7)
        int i2 = -1; float m2 = -3.0e38f;
#define SM_T2(j, v) if (j != i1 && v > m2) { m2 = v; i2 = j; }
        SM_T2(0, e0) SM_T2(1, e1) SM_T2(2, e2) SM_T2(3, e3) SM_T2(4, e4) SM_T2(5, e5) SM_T2(6, e6) SM_T2(7, e7)
        const float r = expf(m2 - m1); const float w1 = gw / (1.f + r), w2 = gw * r / (1.f + r);
        c.eid[t * 2 + 0] = gsel * 8 + i1; c.eid[t * 2 + 1] = gsel * 8 + i2; c.gatew[t * 2 + 0] = w1; c.gatew[t * 2 + 1] = w2; }
}
__device__ __forceinline__ void s_moe_up(const Ctx& c, int l, size_t gid, size_t gs) {
    for (size_t i = gid; i < (size_t)T * 2 * 512; i += gs) { const int f = (int)(i % 512); const size_t tk = i / 512; const size_t t = tk / 2; const int e = c.eid[tk] & 31;
        const float* wg = c.in[I_MOE_WGATE] + ((size_t)l * 32 + e) * 1024 * 512 + f; const float* wu = c.in[I_MOE_WUP] + ((size_t)l * 32 + e) * 1024 * 512 + f; const float* x = c.un + t * 1024; float a = 0.f, b = 0.f;
        for (int k = 0; k < 1024; ++k) { a += x[k] * wg[(size_t)k * 512]; b += x[k] * wu[(size_t)k * 512]; }
        c.act[i] = siluf(a) * b; }
}
__device__ __forceinline__ void s_moe_down(const Ctx& c, int l, size_t gid, size_t gs) {
    for (size_t i = gid; i < (size_t)T * 1024; i += gs) { const size_t t = i / 1024; const int n = (int)(i % 1024); float y = 0.f;
        for (int k = 0; k < 2; ++k) { const int e = c.eid[t * 2 + k] & 31; const float* wd = c.in[I_MOE_WDOWN] + ((size_t)l * 32 + e) * 512 * 1024 + n; const float* a = c.act + (t * 2 + k) * 512; float s = 0.f;
            for (int f = 0; f < 512; ++f) s += a[f] * wd[(size_t)f * 1024];
            y += s * c.gatew[t * 2 + k]; }
        c.h[i] += y; }
}
__device__ __forceinline__ void s_gdn_conv(const Ctx& c, size_t gid, size_t gs) {
    const float* w = c.in[I_OD_CONV];
    for (size_t i = gid; i < (size_t)T * 3072; i += gs) { const size_t t = i / 3072; const int ch = (int)(i % 3072); const int tl = (int)(t % L); float s = 0.f;
        for (int j = 0; j < 4; ++j) { const int tt = tl - 3 + j; if (tt >= 0) s += w[j * 3072 + ch] * c.proj[(t - 3 + j) * PROJ_LD + O_QKV + ch]; }
        c.qkvc[i] = siluf(s); }
}
__device__ __forceinline__ void s_gdn_qkscale(const Ctx& c, size_t gid, size_t gs) {
    for (size_t i = gid; i < (size_t)T * 16; i += gs) { const size_t t = i / 16; const int wh = (int)(i % 16); float* p = c.qkvc + t * 3072 + wh * 128; float s = 0.f; for (int d = 0; d < 128; ++d) s += p[d] * p[d];
        float r = 1.f / sqrtf(s + 1e-6f); if (wh < 8) r *= 0.08838834764831845f; for (int d = 0; d < 128; ++d) p[d] *= r; }
}
__device__ __forceinline__ void s_gdn_gates(const Ctx& c, size_t gid, size_t gs) {
    for (size_t i = gid; i < (size_t)NB * NCH * 8; i += gs) { const int hd = (int)(i % 8); const size_t bc = i / 8; const float na = -expf(c.in[I_OD_ALOG][hd]); const float db = c.in[I_OD_DTB][hd]; float cs = 0.f;
        for (int s = 0; s < 64; ++s) { const size_t t = bc * 64 + s; cs += na * softplusf(c.proj[t * PROJ_LD + O_A + hd] + db); c.gcs[t * 8 + hd] = cs; c.beta[t * 8 + hd] = sigmoidf(c.proj[t * PROJ_LD + O_B + hd]); } }
}
__device__ __forceinline__ void s_gdn_kk(const Ctx& c, size_t gid, size_t gs) {
    for (size_t i = gid; i < (size_t)NB * NCH * 8 * 4096; i += gs) { const int s = (int)(i % 64); const int t = (int)((i / 64) % 64); const int hd = (int)((i / 4096) % 8); const size_t bc = i / (4096 * 8);
        float lv = 0.f, av = 0.f;
        if (s <= t) { const size_t tt = bc * 64 + t, ts = bc * 64 + s; const float* kt = c.qkvc + tt * 3072 + 1024 + hd * 128; const float* ks = c.qkvc + ts * 3072 + 1024 + hd * 128; const float* qt = c.qkvc + tt * 3072 + hd * 128; float kk = 0.f, qk = 0.f;
            for (int d = 0; d < 128; ++d) { kk += kt[d] * ks[d]; qk += qt[d] * ks[d]; }
            const float dec = expf(c.gcs[tt * 8 + hd] - c.gcs[ts * 8 + hd]); av = qk * dec; if (s < t) lv = kk * c.beta[tt * 8 + hd] * dec; }
        c.Lm[i] = lv; c.aqk[i] = av; }
}
__device__ __forceinline__ void s_gdn_solve(const Ctx& c, size_t gid, size_t gs) {
    for (size_t i = gid; i < (size_t)NB * NCH * 8 * 256; i += gs) { const int j = (int)(i % 256); const int hd = (int)((i / 256) % 8); const size_t bc = i / 2048; float* sol = c.uw + (bc * 8 + hd) * (64 * 256) + j; const float* Lp = c.Lm + (bc * 8 + hd) * 4096;
        for (int t = 0; t < 64; ++t) { const size_t tt = bc * 64 + t; const float bt = c.beta[tt * 8 + hd];
            float r = (j < 128) ? c.qkvc[tt * 3072 + 2048 + hd * 128 + j] * bt : c.qkvc[tt * 3072 + 1024 + hd * 128 + (j - 128)] * bt * expf(c.gcs[tt * 8 + hd]);
            for (int s = 0; s < t; ++s) r -= Lp[t * 64 + s] * sol[(size_t)s * 256];
            sol[(size_t)t * 256] = r; } }
}
__device__ __forceinline__ void s_gdn_scan(const Ctx& c, size_t gid, size_t gs) {
    for (size_t i = gid; i < (size_t)NB * 8 * 128; i += gs) { const int j = (int)(i % 128); const size_t bh = i / 128; const int hd = (int)(bh % 8); const size_t b = bh / 8; float* S = c.S + bh * 16384 + j; float* vn = c.vn + bh * 8192 + j;
        for (int d = 0; d < 128; ++d) S[(size_t)d * 128] = 0.f;
        for (int ch = 0; ch < NCH; ++ch) { const size_t bc = b * NCH + ch; const float* uw = c.uw + (bc * 8 + hd) * (64 * 256); const float* aq = c.aqk + (bc * 8 + hd) * 4096; const float glast = c.gcs[(bc * 64 + 63) * 8 + hd];
            for (int t = 0; t < 64; ++t) { float v = uw[t * 256 + j]; const float* w = uw + t * 256 + 128; for (int d = 0; d < 128; ++d) v -= w[d] * S[(size_t)d * 128]; vn[(size_t)t * 128] = v; }
            for (int t = 0; t < 64; ++t) { const size_t tt = bc * 64 + t; const float* q = c.qkvc + tt * 3072 + hd * 128; float o = 0.f; for (int d = 0; d < 128; ++d) o += q[d] * S[(size_t)d * 128];
                o *= expf(c.gcs[tt * 8 + hd]); for (int s = 0; s <= t; ++s) o += aq[t * 64 + s] * vn[(size_t)s * 128];
                c.obuf[tt * 1024 + hd * 128 + j] = o; }
            const float dl = expf(glast);
            for (int d = 0; d < 128; ++d) { float a = S[(size_t)d * 128] * dl; for (int t = 0; t < 64; ++t) { const size_t tt = bc * 64 + t; a += c.qkvc[tt * 3072 + 1024 + hd * 128 + d] * expf(glast - c.gcs[tt * 8 + hd]) * vn[(size_t)t * 128]; } S[(size_t)d * 128] = a; } } }
}
__device__ __forceinline__ void s_gdn_out(const Ctx& c, size_t gid, size_t gs) {
    for (size_t i = gid; i < (size_t)T * 1024; i += gs) { const size_t t = i / 1024; const int col = (int)(i % 1024); c.cat[t * 1536 + col] = c.obuf[i] * c.rstd2[t * 8 + col / 128] * c.in[I_OD_NORM][col % 128] * siluf(c.proj[t * PROJ_LD + O_Z + col]); }
}
__device__ __forceinline__ void s_sb(const Ctx& c, size_t gid, size_t gs) {
    for (size_t i = gid; i < (size_t)T * 32; i += gs) { const int qd = (int)(i % 4); const int hd = (int)((i / 4) % 8); const size_t t = i / 32; const int tl = (int)(t % L); const float* q = c.proj + t * PROJ_LD + O_SQ + hd * 64;
        float o[16];
#pragma unroll
        for (int d = 0; d < 16; ++d) o[d] = 0.f;
        float carry = 0.f;
        for (int s = tl - 1; s >= 0 && carry > -150.f; --s) { const size_t ts = t - (size_t)(tl - s); const float* k = c.proj + ts * PROJ_LD + O_SK + hd * 64; const float* v = c.proj + ts * PROJ_LD + O_SV + hd * 64 + qd * 16; float lg = 0.f;
            for (int d = 0; d < 64; ++d) lg += q[d] * k[d];
            lg *= 0.125f; const float wgt = expf(-softplusf(-lg) + carry); carry -= softplusf(lg);
#pragma unroll
            for (int d = 0; d < 16; ++d) o[d] += wgt * v[d]; }
#pragma unroll
        for (int d = 0; d < 16; ++d) c.cat[t * 1536 + 1024 + hd * 64 + qd * 16 + d] = o[d]; }
}
__device__ __forceinline__ void s_final(const Ctx& c, size_t gid, size_t gs) { s_norm(c.h, c.rstd, c.in[I_FINAL_NORM], c.out, T, gid, gs); }

constexpr int XA_BASE = 20, MOE_BASE = 30, L1_BASE = 40, NSTAGE_L = 60;
__device__ __forceinline__ bool run_stage(const Ctx& c, int st, size_t gid, size_t gs) {
    const int layer = st / NSTAGE_L, s = st % NSTAGE_L;
    if (st >= 2 * NSTAGE_L + 2) return false;
    if (st == 2 * NSTAGE_L) { s_rstd(c.h, T, DM, DM, c.rstd, gid, gs); return true; }
    if (st == 2 * NSTAGE_L + 1) { s_final(c, gid, gs); return true; }
    const int l = layer;
    switch (s) {
    case 0: if (l == 0) { s_copy(c.in[I_X], c.h, (size_t)T * DM, gid, gs); s_rstd(c.in[I_MEM], NB * MEM, DM, DM, c.rstd2, gid, gs); } break;
    case 1: if (l == 0) s_norm(c.in[I_MEM], c.rstd2, c.in[I_MEM_NORM], c.memn, NB * MEM, gid, gs); s_rstd(c.h, T, DM, DM, c.rstd, gid, gs); break;
    case 2: s_norm(c.h, c.rstd, c.in[I_NORM_MIX] + l * DM, c.un, T, gid, gs); break;
    case 3: if (l == 0) s_gemm(c.un, DM, c.in[I_EV_WIN], EV_IN, c.proj, PROJ_LD, T, EV_IN, DM, 0, gid, gs); else s_gemm(c.un, DM, c.in[I_OD_WIN], OD_IN, c.proj, PROJ_LD, T, OD_IN, DM, 0, gid, gs); break;
    case 4: if (l == 0) { s_scmix(c, gid, gs); s_ssd_conv(c, gid, gs); s_ssd_dt(c, gid, gs); } else { s_gdn_conv(c, gid, gs); s_gdn_gates(c, gid, gs); s_sb(c, gid, gs); } break;
    case 5: if (l == 0) { s_ssd_states(c, gid, gs); s_ssd_cb(c, gid, gs); } else s_gdn_qkscale(c, gid, gs); break;
    case 6: if (l == 0) s_ssd_scan(c, gid, gs); else s_gdn_kk(c, gid, gs); break;
    case 7: if (l == 0) s_ssd_y(c, gid, gs); else s_gdn_solve(c, gid, gs); break;
    case 8: if (l == 0) s_rstd(c.ybuf, T * 2, 512, 512, c.rstd2, gid, gs); else s_gdn_scan(c, gid, gs); break;
    case 9: if (l == 0) s_ssd_out(c, gid, gs); else s_rstd(c.obuf, T * 8, 128, 128, c.rstd2, gid, gs); break;
    case 10: if (l == 1) s_gdn_out(c, gid, gs); break;
    case 11: s_gemm(c.cat, 1536, l == 0 ? c.in[I_EV_WOUT] : c.in[I_OD_WOUT], DM, c.h, DM, T, DM, 1536, 1, gid, gs); break;
    case 12: s_rstd(c.h, T, DM, DM, c.rstd, gid, gs); break;
    case 13: s_norm(c.h, c.rstd, c.in[I_NORM_XA] + l * DM, c.un, T, gid, gs); break;
    case 14: s_gemm(c.un, DM, c.in[I_XA_WQ] + (size_t)l * DM * DM, DM, c.q, DM, T, DM, DM, 0, gid, gs);
             s_gemm(c.memn, DM, c.in[I_XA_WK] + (size_t)l * DM * DM, DM, c.kx, DM, NB * MEM, DM, DM, 0, gid, gs);
             s_gemm(c.memn, DM, c.in[I_XA_WV] + (size_t)l * DM * DM, DM, c.vx, DM, NB * MEM, DM, DM, 0, gid, gs); break;
    case 15: s_xa_scores(c, gid, gs); break;
    case 16: s_xa_softmax(c, gid, gs); break;
    case 17: s_xa_pv(c, gid, gs); break;
    case 18: s_gemm(c.att, DM, c.in[I_XA_WO] + (size_t)l * DM * DM, DM, c.h, DM, T, DM, DM, 1, gid, gs); break;
    case 19: s_rstd(c.h, T, DM, DM, c.rstd, gid, gs); break;
    case 20: s_norm(c.h, c.rstd, c.in[I_NORM_FFN] + l * DM, c.un, T, gid, gs); break;
    case 21: s_router(c, l, gid, gs); break;
    case 22: s_moe_up(c, l, gid, gs); break;
    case 23: s_moe_down(c, l, gid, gs); break;
    default: break;
    }
    return true;
}
constexpr int N_STAGES_USED = 24;

__host__ __device__ __forceinline__ size_t carve(Ctx& c, float* w) {
    size_t o = 0;
    auto take = [&](size_t n) { float* p = w + o; o += (n + 63) & ~(size_t)63; return p; };
    c.h = take((size_t)T * DM); c.rstd = take(T); c.rstd2 = take((size_t)T * 8); c.memn = take((size_t)MEM * DM); c.kx = take((size_t)MEM * DM); c.vx = take((size_t)MEM * DM);
    c.eid = (int*)take((size_t)T * 2); c.gatew = take((size_t)T * 2); c.dtv = take((size_t)T * 16); c.acs = take((size_t)T * 16); c.beta = take((size_t)T * 8); c.gcs = take((size_t)T * 8);
    c.S = take(8 * 16384); c.vn = take(8 * 8192);
    c.un = take((size_t)T * DM); c.ybuf = c.un; c.obuf = c.un;
    c.proj = take((size_t)T * PROJ_LD);
    c.cat = take((size_t)T * 1536);
    const size_t d0 = o;
    c.xbcc = take((size_t)T * 1536); c.states = take((size_t)NCH * 16 * 8192); c.cb = take((size_t)NCH * 2 * 4096); size_t dmax = o;
    o = d0; c.qkvc = take((size_t)T * 3072); c.Lm = take((size_t)NCH * 8 * 4096); c.aqk = take((size_t)NCH * 8 * 4096); c.uw = take((size_t)NCH * 8 * 64 * 256); if (o > dmax) dmax = o;
    o = d0; c.q = take((size_t)T * DM); c.sc = take((size_t)T * DM); c.att = take((size_t)T * DM); if (o > dmax) dmax = o;
    o = d0; c.act = take((size_t)T * 2 * 512); if (o > dmax) dmax = o;
    return dmax;
}
}

namespace pg8 {
#define PG8_LAS __attribute__((address_space(3)))
typedef unsigned short bf16_t;
typedef short bf16x8 __attribute__((ext_vector_type(8)));
typedef float f32x4 __attribute__((ext_vector_type(4)));
typedef unsigned u32x4 __attribute__((ext_vector_type(4)));
constexpr int BM = 256, BK = 64, HALF = 128, HTB = HALF * BK * 2  , STAGE_BYTES = 8 * HTB, NXCD = 8, WGM = 8;

__host__ __device__ __forceinline__ int lds_byte(int r, int c) { const int st = (r >> 4) * 2 + (c >> 5), rr = r & 15, cc = c & 31, ob = rr * 64 + cc * 2; return st * 1024 + (ob ^ (((ob >> 9) & 1) << 5)); }
__host__ __device__ __forceinline__ void stage_rc(int b, int& R, int& C) { const int st = b / 1024, sb = b % 1024, swz = sb ^ (((sb >> 9) & 1) << 5); R = (st >> 1) * 16 + swz / 64; C = (st & 1) * 32 + (swz % 64) / 2; }
__host__ __device__ __forceinline__ int perm32(int rho) { const int n = rho >> 4, i = rho & 15; return 8 * (i >> 2) + 4 * n + (i & 3); }

struct Unit { int pm, pn, tag; const char* a; const char* b; };
struct Gemm { const bf16_t* A; const bf16_t* Bt; int M, N, K; };

struct StaticOrder {
    static constexpr bool LIGHT = false;
    int nM, nN, nwg, G, c; const char* A; const char* B; size_t tstep;
    __host__ __device__ void init(const Gemm& g, int G_, int c_) { nM = g.M / BM; nN = g.N / BM; nwg = nM * nN; G = G_; c = c_; A = (const char*)g.A; B = (const char*)g.Bt; tstep = (size_t)BM * g.K * 2; }
    __host__ __device__ bool next(int i, Unit& u) const {
        const long L = (long)i * G + c; if (L >= nwg) return false;
        int wgid = (int)L; { const int q = nwg / NXCD, r = nwg % NXCD, xcd = wgid % NXCD, off = wgid / NXCD; wgid = (xcd < r ? xcd * (q + 1) : r * (q + 1) + (xcd - r) * q) + off; }
        const int nig = WGM * nN, gid = wgid / nig, fm = gid * WGM, gsz = (nM - fm) < WGM ? (nM - fm) : WGM;
        u.pm = fm + ((wgid % nig) % gsz); u.pn = (wgid % nig) / gsz; u.a = A + (size_t)u.pm * tstep; u.b = B + (size_t)u.pn * tstep; return true;
    }
    __device__ __forceinline__ void a_ready(const Unit&) const {}
    __device__ __forceinline__ void done(const Unit&) const {}
};

template <class Epi, class Sched, bool ALIGN_EPI = false, bool SP2 = false>
__device__ __forceinline__ void gemm_phase(PG8_LAS unsigned char* lds, const Gemm g, const Sched& S, const Epi& E) {
    int tid_ = threadIdx.x; asm volatile("" : "+v"(tid_));
    const int tid = tid_, wid = __builtin_amdgcn_readfirstlane(tid >> 6), lane = tid & 63, wr = wid >> 2, wc = wid & 3, fr = lane & 15, fq = lane >> 4;
    const int K = g.K, nt = K / BK;
    unsigned voffA[2], voffB[2];
#pragma unroll
    for (int i = 0; i < 2; ++i) { int R, C; stage_rc(tid * 16 + i * 8192, R, C); const int Rb = Epi::PERM ? ((R & ~31) + perm32(R & 31)) : R;
        voffA[i] = (unsigned)(R * K + C) * 2u; voffB[i] = (unsigned)(Rb * K + C) * 2u; }
    const size_t kstep = (size_t)(BK * 2);
    const size_t hstep = (size_t)HALF * K * 2;
    const unsigned ldsw = (unsigned)wid * 1024u;
    const int aoff = lds_byte(wr * 64 + fr, fq * 8), boff = lds_byte(wc * 32 + fr, fq * 8);
#define PG8_SA(b, h) (((b) * 2 + (h)) * HTB)
#define PG8_SB(b, h) ((4 + (b) * 2 + (h)) * HTB)
#define PG8_STAGE(bufoff, gbase, voff) do { _Pragma("unroll") for (int _i = 0; _i < 2; ++_i) \
        __builtin_amdgcn_global_load_lds((const unsigned*)((const char*)(gbase) + (voff)[_i]), (PG8_LAS unsigned*)(lds + (bufoff) + ldsw + _i * 8192), 16, 0, 0); } while (0)
#define PG8_LDA(dst, b, h) do { _Pragma("unroll") for (int m = 0; m < 4; ++m) _Pragma("unroll") for (int k = 0; k < 2; ++k) dst[m][k] = *(const PG8_LAS bf16x8*)(lds + PG8_SA(b, h) + aoff + m * 2048 + k * 1024); } while (0)
#define PG8_LDB(dst, b, h) do { _Pragma("unroll") for (int n = 0; n < 2; ++n) _Pragma("unroll") for (int k = 0; k < 2; ++k) dst[n][k] = *(const PG8_LAS bf16x8*)(lds + PG8_SB(b, h) + boff + n * 2048 + k * 1024); } while (0)
#define PG8_MMA(ai, bj, At, Bt) do { __builtin_amdgcn_s_setprio(1); _Pragma("unroll") for (int m = 0; m < 4; ++m) _Pragma("unroll") for (int n = 0; n < 2; ++n) _Pragma("unroll") for (int k = 0; k < 2; ++k) \
        acc[ai][bj][m][n] = __builtin_amdgcn_mfma_f32_16x16x32_bf16(Bt[n][k], At[m][k], acc[ai][bj][m][n], 0, 0, 0); __builtin_amdgcn_s_setprio(0); } while (0)
#define PG8_WAIT_V(n) asm volatile("s_waitcnt vmcnt(" #n ")" ::: "memory")
#define PG8_WAIT_L(n) asm volatile("s_waitcnt lgkmcnt(" #n ")" ::: "memory")
#define PG8_BAR __builtin_amdgcn_s_barrier()
#define PG8_SCHED __builtin_amdgcn_sched_barrier(0)
    Unit cur, nxt; int ui = 0;
    if (!S.next(0, cur)) return;
    f32x4 acc[2][2][4][2];
#pragma unroll
    for (int a = 0; a < 2; ++a)
#pragma unroll
        for (int b = 0; b < 2; ++b)
#pragma unroll
            for (int m = 0; m < 4; ++m)
#pragma unroll
                for (int n = 0; n < 2; ++n) acc[a][b][m][n] = (f32x4){0.f, 0.f, 0.f, 0.f};
    bf16x8 At[4][2], B0[2][2], B1[2][2];
    const char* cA = cur.a; const char* cB = cur.b;
    S.a_ready(cur);
    if constexpr (SP2) {
        PG8_STAGE(PG8_SB(0, 0), cB, voffB); PG8_STAGE(PG8_SB(0, 1), cB + hstep, voffB); PG8_STAGE(PG8_SA(0, 0), cA, voffA); PG8_STAGE(PG8_SA(0, 1), cA + hstep, voffA);
        if (wr == 1) PG8_BAR;
        PG8_WAIT_V(2); PG8_BAR;
        PG8_STAGE(PG8_SB(1, 0), cB + kstep, voffB); PG8_STAGE(PG8_SA(1, 0), cA + kstep, voffA); PG8_STAGE(PG8_SB(1, 1), cB + hstep + kstep, voffB);
        PG8_WAIT_V(6); PG8_BAR;
    } else {
        PG8_STAGE(PG8_SB(0, 0), cB, voffB); PG8_STAGE(PG8_SA(0, 0), cA, voffA); PG8_STAGE(PG8_SB(0, 1), cB + hstep, voffB); PG8_STAGE(PG8_SA(0, 1), cA + hstep, voffA);
        if (wr == 1) PG8_BAR;
        PG8_WAIT_V(4); PG8_BAR;
        PG8_STAGE(PG8_SB(1, 0), cB + kstep, voffB); PG8_STAGE(PG8_SA(1, 0), cA + kstep, voffA); PG8_STAGE(PG8_SB(1, 1), cB + hstep + kstep, voffB);
        PG8_WAIT_V(6); PG8_BAR;
    }
    for (;;) {
        const bool has_next = S.next(ui + 1, nxt);
        const char* nA = has_next ? nxt.a : cA; const char* nB = has_next ? nxt.b : cB;
        for (int t = 0; t < nt; t += 2) {
            const bool last = (t == nt - 2);
            const char* a1 = cA + (size_t)(t + 1) * kstep;
            const char* a2 = last ? nA : cA + (size_t)(t + 2) * kstep; const char* b2 = last ? nB : cB + (size_t)(t + 2) * kstep;
            const char* a3 = a2 + kstep; const char* b3 = b2 + kstep;
            if (last && has_next) S.a_ready(nxt);
            if constexpr (SP2) {
            PG8_LDB(B0, 0, 0); PG8_LDB(B1, 0, 1); PG8_SCHED; PG8_LDA(At, 0, 0); PG8_STAGE(PG8_SA(1, 1), a1 + hstep, voffA);
            PG8_WAIT_V(8); PG8_WAIT_L(0); PG8_BAR; PG8_MMA(0, 0, At, B0); PG8_MMA(0, 1, At, B1); PG8_BAR; PG8_SCHED;
            PG8_LDA(At, 0, 1); PG8_STAGE(PG8_SB(0, 0), b2, voffB); PG8_STAGE(PG8_SB(0, 1), b2 + hstep, voffB); PG8_STAGE(PG8_SA(0, 0), a2, voffA);
            PG8_WAIT_V(8); PG8_WAIT_L(0); PG8_BAR; if (!(Sched::LIGHT && (cur.tag & 1))) { PG8_MMA(1, 0, At, B0); PG8_MMA(1, 1, At, B1); } PG8_BAR; PG8_SCHED;
            PG8_LDB(B0, 1, 0); PG8_LDB(B1, 1, 1); PG8_SCHED; PG8_LDA(At, 1, 0); PG8_STAGE(PG8_SA(0, 1), a2 + hstep, voffA);
            PG8_WAIT_V(8); PG8_WAIT_L(0); PG8_BAR; PG8_MMA(0, 0, At, B0); PG8_MMA(0, 1, At, B1); PG8_BAR; PG8_SCHED;
            PG8_LDA(At, 1, 1); PG8_STAGE(PG8_SB(1, 0), b3, voffB); PG8_STAGE(PG8_SB(1, 1), b3 + hstep, voffB); PG8_STAGE(PG8_SA(1, 0), a3, voffA);
            PG8_WAIT_V(8); PG8_WAIT_L(0); PG8_BAR; if (!(Sched::LIGHT && (cur.tag & 1))) { PG8_MMA(1, 0, At, B0); PG8_MMA(1, 1, At, B1); } PG8_BAR; PG8_SCHED;
            } else {
            PG8_LDB(B0, 0, 0); PG8_SCHED; PG8_LDA(At, 0, 0); PG8_STAGE(PG8_SA(1, 1), a1 + hstep, voffA);
            PG8_WAIT_L(8); PG8_BAR; PG8_WAIT_L(0); PG8_MMA(0, 0, At, B0); PG8_BAR; PG8_SCHED;
            PG8_LDB(B1, 0, 1); PG8_STAGE(PG8_SB(0, 0), b2, voffB);
            PG8_BAR; PG8_WAIT_L(0); PG8_MMA(0, 1, At, B1); PG8_BAR;
            PG8_LDA(At, 0, 1); PG8_STAGE(PG8_SA(0, 0), a2, voffA);
            PG8_BAR; PG8_WAIT_L(0); PG8_MMA(1, 0, At, B0); PG8_BAR; PG8_SCHED;
            PG8_STAGE(PG8_SB(0, 1), b2 + hstep, voffB);
            PG8_WAIT_V(6); PG8_BAR; PG8_MMA(1, 1, At, B1); PG8_BAR;
            PG8_LDB(B0, 1, 0); PG8_SCHED; PG8_LDA(At, 1, 0); PG8_STAGE(PG8_SA(0, 1), a2 + hstep, voffA);
            PG8_WAIT_L(8); PG8_BAR; PG8_WAIT_L(0); PG8_MMA(0, 0, At, B0); PG8_BAR; PG8_SCHED;
            PG8_LDB(B1, 1, 1); PG8_STAGE(PG8_SB(1, 0), b3, voffB);
            PG8_BAR; PG8_WAIT_L(0); PG8_MMA(0, 1, At, B1); PG8_BAR;
            PG8_LDA(At, 1, 1); PG8_STAGE(PG8_SA(1, 0), a3, voffA);
            PG8_BAR; PG8_WAIT_L(0); PG8_MMA(1, 0, At, B0); PG8_BAR; PG8_SCHED;
            PG8_STAGE(PG8_SB(1, 1), b3 + hstep, voffB);
            PG8_WAIT_V(6); PG8_BAR; PG8_MMA(1, 1, At, B1); PG8_BAR;
            }
        }
        if constexpr (ALIGN_EPI) { if (wr == 0) PG8_BAR; }
        if constexpr (!Epi::AFTER_DRAIN) { E(acc, cur, wr, wc, fr, fq); S.done(cur); }
        if (!has_next) break;
#pragma unroll
        for (int a = 0; a < 2; ++a)
#pragma unroll
            for (int b = 0; b < 2; ++b)
#pragma unroll
                for (int m = 0; m < 4; ++m)
#pragma unroll
                    for (int n = 0; n < 2; ++n) acc[a][b][m][n] = (f32x4){0.f, 0.f, 0.f, 0.f};
        cur = nxt; cA = nA; cB = nB; ++ui;
        if constexpr (ALIGN_EPI) { if (wr == 1) PG8_BAR; }
    }
    PG8_WAIT_V(0);
    if constexpr (!ALIGN_EPI) { if (wr == 0) PG8_BAR; }
    PG8_BAR;
    if constexpr (Epi::AFTER_DRAIN) { E.fused(acc, cur, wr, wc, fr, fq, lds, wid, lane); S.done(cur); }
#undef PG8_SA
#undef PG8_SB
#undef PG8_STAGE
#undef PG8_LDA
#undef PG8_LDB
#undef PG8_MMA
#undef PG8_WAIT_V
#undef PG8_WAIT_L
#undef PG8_BAR
#undef PG8_SCHED
}
}

namespace ok {
using pg8::bf16_t; using pg8::bf16x8; using pg8::f32x4; using pg8::u32x4;
typedef unsigned u32x2 __attribute__((ext_vector_type(2)));
typedef float f32x2 __attribute__((ext_vector_type(2)));
#ifndef SEQ
#define SEQ 8192
#endif
constexpr int NB = 2, L = SEQ, NCH = L / 64, T = NB * L, DM = 1024, NWAVES = 8, NT = 512;
constexpr float EPS = 1e-6f, LOG2E = 1.4426950408889634f;
constexpr size_t MiB = 1u << 20, KiB = 1024;
constexpr size_t WS_CTL = 0, CTL_BYTES = 1 * MiB;
constexpr int CW_BAR = 0;
constexpr int CW_SSQ = 16384;
constexpr int CW_MOE = 16384 + 6 * T;
constexpr int CW_CHK = CW_MOE + 256;
static_assert((CW_CHK + 64) * 4 <= (int)CTL_BYTES, "ctl");
constexpr size_t WS_WDT = 1 * MiB, WS_WAB = WS_WDT + 64 * KiB, WS_WR = WS_WAB + 64 * KiB;
constexpr size_t WS_DTV = 2 * MiB, WS_ACS = 3 * MiB, WS_GCS = 4 * MiB, WS_BETA = 4 * MiB + 512 * KiB;
constexpr size_t WS_RAW16 = WS_DTV;
constexpr size_t WS_EID = 5 * MiB, WS_GATEW = WS_EID + 128 * KiB, WS_TOKSLOT = WS_GATEW + 128 * KiB, WS_SLOTTOK = WS_TOKSLOT + 128 * KiB, WS_SLOTGATE = WS_SLOTTOK + 160 * KiB,
                 WS_SLOTRSTD = WS_SLOTGATE + 160 * KiB, WS_TILEEXP = WS_SLOTRSTD + 160 * KiB;
constexpr size_t WS_FP = 8 * MiB;
constexpr size_t WS_W_IN0 = 16 * MiB, WS_W_IN1 = 24 * MiB, WS_W_OUT0 = 35 * MiB, WS_W_OUT1 = 38 * MiB, WS_W_XA = 41 * MiB  ;
constexpr size_t WS_MEMNB = 57 * MiB, WS_KX = 58 * MiB  , WS_VT = 60 * MiB  ;
constexpr size_t WS_H = 64 * MiB, WS_HB = 128 * MiB, WS_MOEW = 160 * MiB, WS_BIG = 256 * MiB;
constexpr size_t WS_PROJ = WS_BIG;
constexpr size_t WS_CAT0 = 384 * MiB, WS_STATES = 432 * MiB;
constexpr size_t WS_CAT1 = 432 * MiB;
constexpr size_t WS_Q = WS_BIG, WS_ATT = WS_BIG + 32 * MiB;
constexpr size_t WS_XS = WS_BIG, WS_ACT = WS_BIG + 80 * MiB, WS_Y = WS_BIG + 120 * MiB;
constexpr size_t WS_END = 528 * MiB;
constexpr int PROJ0_LD = 4096, PROJ1_LD = 5632, MAXSLOT = 40960;

#ifdef CPU_EMU
__device__ __forceinline__ float fexp(float x) { return expf(x); }
__device__ __forceinline__ float fexp2(float x) { return exp2f(x); }
__device__ __forceinline__ float frcp(float x) { return 1.f / x; }
__device__ __forceinline__ float frsq(float x) { return 1.f / sqrtf(x); }
#else
__device__ __forceinline__ float fexp(float x) { return __builtin_amdgcn_exp2f(x * 1.4426950408889634f); }
__device__ __forceinline__ float fexp2(float x) { return __builtin_amdgcn_exp2f(x); }
__device__ __forceinline__ float frcp(float x) { return __builtin_amdgcn_rcpf(x); }
__device__ __forceinline__ float frsq(float x) { return __builtin_amdgcn_rsqf(x); }
#endif
#ifdef CPU_EMU
#define LAS
#define GAS
#define LDS_WAIT() do {} while (0)
#define WAVE_SYNC() ((void)__shfl(0, 0))
#define MEM_FENCE() do {} while (0)
#define PIN16(a) do {} while (0)
#define LDS_BARRIER() __syncthreads()
#define SCHED_FENCE() do {} while (0)
__device__ __forceinline__ unsigned cvt_pk_bf16(float lo, float hi) { return emu_f2bf(lo) | (emu_f2bf(hi) << 16); }
#else
#define LAS __attribute__((address_space(3)))
#define GAS __attribute__((address_space(1)))
#define LDS_WAIT() asm volatile("s_waitcnt lgkmcnt(0)" ::: "memory")
#define LDS_BARRIER() do { asm volatile("s_waitcnt lgkmcnt(0)" ::: "memory"); __builtin_amdgcn_s_barrier(); asm volatile("" ::: "memory"); } while (0)
#define MEM_FENCE() asm volatile("" ::: "memory")
#define PIN16(a) asm volatile("" : "+v"(a[0]), "+v"(a[1]), "+v"(a[2]), "+v"(a[3]), "+v"(a[4]), "+v"(a[5]), "+v"(a[6]), "+v"(a[7]), "+v"(a[8]), "+v"(a[9]), "+v"(a[10]), "+v"(a[11]), "+v"(a[12]), "+v"(a[13]), "+v"(a[14]), "+v"(a[15]) :: "memory")
#define SCHED_FENCE() __builtin_amdgcn_sched_barrier(0)
#define WAVE_SYNC() do { asm volatile("s_waitcnt lgkmcnt(0)" ::: "memory"); __builtin_amdgcn_wave_barrier(); } while (0)
typedef __bf16 hwbf16x2 __attribute__((ext_vector_type(2)));
__device__ __forceinline__ unsigned cvt_pk_bf16(float lo, float hi) { const f32x2 v = {lo, hi}; return __builtin_bit_cast(unsigned, __builtin_convertvector(v, hwbf16x2)); }
#endif
__device__ __forceinline__ float bf2f(unsigned short b) { return __uint_as_float(((unsigned)b) << 16); }
__device__ __forceinline__ float bflo(unsigned w) { return __uint_as_float(w << 16); }
__device__ __forceinline__ float bfhi(unsigned w) { return __uint_as_float(w & 0xffff0000u); }
__device__ __forceinline__ float wave_sum(float v) {
#pragma unroll
    for (int o = 1; o < 64; o <<= 1) v += __shfl_xor(v, o);
    return v;
}
__device__ __forceinline__ f32x4 mfma16(bf16x8 a, bf16x8 b, f32x4 c) { return __builtin_amdgcn_mfma_f32_16x16x32_bf16(a, b, c, 0, 0, 0); }

struct Frame {
    LAS unsigned char* lds;
    unsigned* ctl;
    unsigned char* ws;
    const float* const* in;
    float* out;
    int tid, lane, wave, vcu, G;
};
constexpr size_t WS_SSQP1 = 6 * MiB, WS_SSQP2 = 7 * MiB, WS_SSQP4 = 62 * MiB, WS_SSQP5 = 63 * MiB;
__device__ __forceinline__ float rstd_np(const float* p, int np, int row) { float s; if (np == 1) s = p[row]; else { const f32x4* q = (const f32x4*)(p + (size_t)row * 16); const f32x4 a = q[0], b = q[1], c = q[2], d = q[3]; s = ((a.x + a.y) + (a.z + a.w)) + ((b.x + b.y) + (b.z + b.w)) + (((c.x + c.y) + (c.z + c.w)) + ((d.x + d.y) + (d.z + d.w))); }
    return frsq(s * (1.f / 1024.f) + EPS); }
#define OKP(type, off) ((type*)(F.ws + (off)))
#ifdef CPU_EMU
__device__ __forceinline__ Frame phase_frame(const Frame& F0) { return F0; }
#else
__device__ __forceinline__ Frame phase_frame(const Frame& F0) { Frame F = F0; int t = threadIdx.x; asm volatile("" : "+v"(t)); F.tid = t; F.lane = t & 63; F.wave = __builtin_amdgcn_readfirstlane(t >> 6); return F; }
#endif

struct CvtJob { const float* W; int ldw, K, ncols, c0; bf16_t* WT; int drow0, dstep16; const float* kgain; float cscale; };
__device__ __forceinline__ int job_items(const CvtJob& j) { return (j.K / 64) * (j.ncols / 32); }
struct CvtRegs { float wv[32]; };
__device__ __forceinline__ void cvt_load(CvtRegs& r, const CvtJob& j, int item, int lane) {
    const int nblk = j.ncols / 32, kb = item / nblk, nb = item % nblk, k0 = 64 * kb, c0 = j.c0 + 32 * nb;
#pragma unroll
    for (int i = 0; i < 32; ++i) r.wv[i] = j.W[(size_t)(k0 + 2 * i + (lane >> 5)) * j.ldw + c0 + (lane & 31)];
}
__device__ __forceinline__ void cvt_finish(const CvtRegs& r, const CvtJob& j, int item, LAS float* scr, int lane) {
    const int nblk = j.ncols / 32, kb = item / nblk, nb = item % nblk, k0 = 64 * kb, drow0 = j.drow0 + (32 * nb >> 4) * j.dstep16;
#pragma unroll
    for (int i = 0; i < 32; ++i) { const int kk = 2 * i + (lane >> 5); const float g = j.kgain ? j.kgain[k0 + kk] * j.cscale : j.cscale; scr[kk * 33 + (lane & 31)] = r.wv[i] * g; }
    WAVE_SYNC();
    const int c = lane & 7;
#pragma unroll
    for (int jj = 0; jj < 4; ++jj) { const int n = (lane >> 3) + 8 * jj; const LAS float* s = scr + (8 * c) * 33 + n;
        u32x4 o; o.x = cvt_pk_bf16(s[0 * 33], s[1 * 33]); o.y = cvt_pk_bf16(s[2 * 33], s[3 * 33]); o.z = cvt_pk_bf16(s[4 * 33], s[5 * 33]); o.w = cvt_pk_bf16(s[6 * 33], s[7 * 33]);
        *(u32x4*)(j.WT + (size_t)(drow0 + (n >> 4) * j.dstep16 + (n & 15)) * j.K + k0 + 8 * c) = o; }
    WAVE_SYNC();
}
__device__ __forceinline__ CvtJob dense_job(const Frame& F, int j) {
    using namespace sm;
    const float* const* in = F.in;
    switch (j) {
    case 0: return CvtJob{in[I_EV_WIN], 4112, 1024, 4096, 0, OKP(bf16_t, WS_W_IN0), 0, 16, in[I_NORM_MIX], 1.f};
    case 1: return CvtJob{in[I_OD_WIN], 5648, 1024, 4096, 0, OKP(bf16_t, WS_W_IN1), 0, 16, in[I_NORM_MIX] + 1024, 1.f};
    case 2: return CvtJob{in[I_OD_WIN], 5648, 1024, 512, 4112, OKP(bf16_t, WS_W_IN1), 4096, 16, in[I_NORM_MIX] + 1024, 0.125f * LOG2E};
    case 3: return CvtJob{in[I_OD_WIN], 5648, 1024, 1024, 4624, OKP(bf16_t, WS_W_IN1), 4608, 16, in[I_NORM_MIX] + 1024, 1.f};
    case 4: return CvtJob{in[I_EV_WOUT], 1024, 1536, 1024, 0, OKP(bf16_t, WS_W_OUT0), 0, 16, nullptr, 1.f};
    case 5: return CvtJob{in[I_OD_WOUT], 1024, 1536, 1024, 0, OKP(bf16_t, WS_W_OUT1), 0, 16, nullptr, 1.f};
    default: { const int l = (j - 6) / 4, w = (j - 6) % 4; bf16_t* dst = OKP(bf16_t, WS_W_XA + (size_t)l * 8 * MiB + (size_t)w * 2 * MiB);
        const float* src = in[I_XA_WQ + w] + (size_t)l * 1024 * 1024;
        if (w == 0) return CvtJob{src, 1024, 1024, 1024, 0, dst, 0, 16, in[I_NORM_XA] + l * 1024, 0.0625f * LOG2E};
        return CvtJob{src, 1024, 1024, 1024, 0, dst, 0, 16, nullptr, 1.f}; }
    }
}
constexpr int N_DENSE_JOBS = 14;
__device__ __forceinline__ CvtJob moe_job(const Frame& F, int l, int j) {
    using namespace sm;
    const int e = j / 3, w = j % 3; const float* const* in = F.in;
    bf16_t* gu = OKP(bf16_t, WS_MOEW + (size_t)e * 3 * MiB); bf16_t* dn = gu + 1024 * 1024;
    if (w == 0) return CvtJob{in[I_MOE_WGATE] + ((size_t)l * 32 + e) * 1024 * 512, 512, 1024, 512, 0, gu, 0, 32, in[I_NORM_FFN] + l * 1024, 1.f};
    if (w == 1) return CvtJob{in[I_MOE_WUP] + ((size_t)l * 32 + e) * 1024 * 512, 512, 1024, 512, 0, gu, 16, 32, in[I_NORM_FFN] + l * 1024, 1.f};
    return CvtJob{in[I_MOE_WDOWN] + ((size_t)l * 32 + e) * 512 * 1024, 1024, 512, 1024, 0, dn, 0, 16, nullptr, 1.f};
}
__device__ __forceinline__ int dense_total(const Frame& F) { int n = 0; for (int j = 0; j < N_DENSE_JOBS; ++j) n += job_items(dense_job(F, j)); return n; }
__device__ __forceinline__ void dense_item(const Frame& F, int idx, CvtJob& job, int& item) {
    for (int j = 0; j < N_DENSE_JOBS; ++j) { const CvtJob jb = dense_job(F, j); const int n = job_items(jb); job = jb; item = idx < n ? idx : n - 1; if (idx < n) return; idx -= n; }
}
__device__ __forceinline__ void phase_cvt_dense(const Frame& F0) {
    const Frame F = phase_frame(F0);
    LAS float* scr = (LAS float*)(F.lds + F.wave * 16384);
    const int gw = F.vcu * NWAVES + F.wave, NGW = F.G * NWAVES, N = dense_total(F);
    CvtRegs ra, rb;
    auto LD = [&](CvtRegs& r, int idx) { CvtJob jb; int it; dense_item(F, idx < N ? idx : N - 1, jb, it); cvt_load(r, jb, it, F.lane); };
    auto FN = [&](const CvtRegs& r, int idx) { if (idx < N) { CvtJob jb; int it; dense_item(F, idx, jb, it); cvt_finish(r, jb, it, scr, F.lane); } };
    LD(ra, gw);
    for (int idx = gw; idx < N; idx += 2 * NGW) { LD(rb, idx + NGW); FN(ra, idx); LD(ra, idx + 2 * NGW); FN(rb, idx + NGW); }
}
__device__ __forceinline__ void phase_cvt_moe(const Frame& F0, int l) {
    const Frame F = phase_frame(F0);
    LAS float* scr = (LAS float*)(F.lds + F.wave * 16384);
    const int gw = F.vcu * NWAVES + F.wave, NGW = F.G * NWAVES; constexpr int N = 96 * 256;
    CvtRegs ra, rb;
    auto LD = [&](CvtRegs& r, int idx) { const int ii = idx < N ? idx : N - 1; const CvtJob jb = moe_job(F, l, ii >> 8); cvt_load(r, jb, ii & 255, F.lane); };
    auto FN = [&](const CvtRegs& r, int idx) { if (idx < N) { const CvtJob jb = moe_job(F, l, idx >> 8); cvt_finish(r, jb, idx & 255, scr, F.lane); } };
    LD(ra, gw);
    for (int idx = gw; idx < N; idx += 2 * NGW) { LD(rb, idx + NGW); FN(ra, idx); LD(ra, idx + 2 * NGW); FN(rb, idx + NGW); }
}
__device__ __forceinline__ void row_to_bf16_ssq(const float* xrow, bf16_t* orow, float* ssq, int lane) {
    const f32x4* xr = (const f32x4*)xrow + lane; float s = 0.f; f32x4 v[4];
#pragma unroll
    for (int j = 0; j < 4; ++j) { v[j] = xr[64 * j]; s += (v[j].x * v[j].x + v[j].y * v[j].y) + (v[j].z * v[j].z + v[j].w * v[j].w); }
    s = wave_sum(s);
    u32x2* o8 = (u32x2*)orow + lane;
#pragma unroll
    for (int j = 0; j < 4; ++j) { u32x2 w; w.x = cvt_pk_bf16(v[j].x, v[j].y); w.y = cvt_pk_bf16(v[j].z, v[j].w); o8[64 * j] = w; }
    if (lane == 0) *ssq = s;
}
__device__ __forceinline__ void phase_prologue(const Frame& F0) {
    const Frame F = phase_frame(F0);
    using namespace sm;
    phase_cvt_dense(F0);
    const int gw = F.vcu * NWAVES + F.wave, NGW = F.G * NWAVES;
    float* ssq0 = (float*)F.ctl + CW_SSQ;
    for (int m = gw; m < T; m += NGW) row_to_bf16_ssq(F.in[I_X] + (size_t)m * DM, OKP(bf16_t, WS_HB) + (size_t)m * DM, ssq0 + m, F.lane);
    for (int m = gw; m < NB * 256; m += NGW) { const f32x4* xr = (const f32x4*)(F.in[I_MEM] + (size_t)m * DM) + F.lane; const f32x4* gr = (const f32x4*)F.in[I_MEM_NORM] + F.lane; float s = 0.f; f32x4 v[4];
#pragma unroll
        for (int j = 0; j < 4; ++j) { v[j] = xr[64 * j]; s += (v[j].x * v[j].x + v[j].y * v[j].y) + (v[j].z * v[j].z + v[j].w * v[j].w); }
        const float r = 1.f / sqrtf(wave_sum(s) * (1.f / DM) + EPS);
        u32x2* o8 = (u32x2*)(OKP(bf16_t, WS_MEMNB) + (size_t)m * DM) + F.lane;
#pragma unroll
        for (int j = 0; j < 4; ++j) { const f32x4 g = gr[64 * j]; u32x2 w; w.x = cvt_pk_bf16(v[j].x * r * g.x, v[j].y * r * g.y); w.y = cvt_pk_bf16(v[j].z * r * g.z, v[j].w * r * g.w); o8[64 * j] = w; } }
    const size_t gt = (size_t)F.vcu * NT + F.tid, GT = (size_t)F.G * NT;
    for (size_t i = gt; i < 1024 * 16; i += GT) { const int k = (int)(i >> 4), j = (int)(i & 15);
        OKP(float, WS_WDT)[j * 1024 + k] = F.in[I_NORM_MIX][k] * F.in[I_EV_WIN][(size_t)k * 4112 + 4096 + j];
        OKP(float, WS_WAB)[j * 1024 + k] = F.in[I_NORM_MIX][1024 + k] * F.in[I_OD_WIN][(size_t)k * 5648 + 4096 + j]; }
}

#ifndef CPU_EMU
struct EpiScaleBf16 {
    static constexpr bool PERM = true, AFTER_DRAIN = false;
    bf16_t* O; int ldc; const float* ssq; int np;
    __device__ __forceinline__ void operator()(const f32x4 (&acc)[2][2][4][2], const pg8::Unit& u, int wr, int wc, int fr, int fq) const {
        const int row0 = u.pm * 256 + wr * 64 + fr, col0 = u.pn * 256 + wc * 32 + 8 * fq;
#pragma unroll
        for (int ai = 0; ai < 2; ++ai)
#pragma unroll
            for (int m = 0; m < 4; ++m) { const int row = row0 + ai * 128 + m * 16; const float s = ssq ? rstd_np(ssq, np, row) : 1.f; bf16_t* rowp = O + (size_t)row * ldc + col0;
#pragma unroll
                for (int bj = 0; bj < 2; ++bj) { const f32x4 v0 = acc[ai][bj][m][0] * s, v1 = acc[ai][bj][m][1] * s; u32x4 w; w.x = cvt_pk_bf16(v0[0], v0[1]); w.y = cvt_pk_bf16(v0[2], v0[3]); w.z = cvt_pk_bf16(v1[0], v1[1]); w.w = cvt_pk_bf16(v1[2], v1[3]);
                    *(u32x4*)(rowp + bj * 128) = w; } }
    }
};
template <bool HIN_F32> struct EpiResidualT {
    static constexpr bool PERM = false, AFTER_DRAIN = false;
    const float* hin; bf16_t* hb; float* ssq;
    __device__ __forceinline__ void operator()(const f32x4 (&acc)[2][2][4][2], const pg8::Unit& u, int wr, int wc, int fr, int fq) const {
        const int row0 = u.pm * 256 + wr * 64 + fr, col0 = u.pn * 256 + wc * 32 + 4 * fq;
#pragma unroll
        for (int ai = 0; ai < 2; ++ai)
#pragma unroll
            for (int m = 0; m < 4; ++m) { const int row = row0 + ai * 128 + m * 16; const size_t ro = (size_t)row * DM + col0; float s = 0.f;
#pragma unroll
                for (int bj = 0; bj < 2; ++bj)
#pragma unroll
                    for (int n = 0; n < 2; ++n) { const size_t o = ro + bj * 128 + n * 16; f32x4 v;
                        if (HIN_F32) v = *(const f32x4*)(hin + o); else { const u32x2 hw = *(const u32x2*)(hb + o); v = (f32x4){bflo(hw.x), bfhi(hw.x), bflo(hw.y), bfhi(hw.y)}; }
                        v += acc[ai][bj][m][n];
                        u32x2 w; w.x = cvt_pk_bf16(v[0], v[1]); w.y = cvt_pk_bf16(v[2], v[3]); *(u32x2*)(hb + o) = w;
                        const float r0 = bflo(w.x), r1 = bfhi(w.x), r2 = bflo(w.y), r3 = bfhi(w.y); s += (r0 * r0 + r1 * r1) + (r2 * r2 + r3 * r3); }
                s += __shfl_xor(s, 16); s += __shfl_xor(s, 32);
                if (fq == 0) ssq[(size_t)row * 16 + u.pn * 4 + wc] = s; }
    }
};

template <class Epi> __device__ __forceinline__ void dense_gemm(const Frame& F, const bf16_t* A, const bf16_t* Bt, int M, int N, int K, const Epi& E) {
    pg8::Gemm g{A, Bt, M, N, K}; pg8::StaticOrder S; S.init(g, F.G, (int)blockIdx.x);
    pg8::gemm_phase<Epi, pg8::StaticOrder, true, true>(F.lds, g, S, E);
}
#endif
}

namespace ok {
constexpr int XT_LD = 72;
constexpr int BC_LD = 136;
__device__ __forceinline__ float siluf(float x) { return x * frcp(1.f + fexp(-x)); }
__device__ __forceinline__ float softplusf(float x) { return x > 20.f ? x : log1pf(expf(x)); }

template <class Sink> __device__ __forceinline__ void ssd_conv_pair(const Frame& F, int b, int c, int xc, Sink&& sink) {
    using namespace sm;
    const float* cw = F.in[I_EV_CONVW]; const f32x2 w0 = *(const f32x2*)(cw + xc), w1 = *(const f32x2*)(cw + 1536 + xc), w2 = *(const f32x2*)(cw + 3072 + xc), w3 = *(const f32x2*)(cw + 4608 + xc), bias = *(const f32x2*)(F.in[I_EV_CONVB] + xc);
    const bf16_t* p = OKP(bf16_t, WS_PROJ) + (size_t)(b * L + c * 64) * PROJ0_LD + 2560 + xc;
    unsigned raw[64];
#pragma unroll
    for (int t = 0; t < 64; ++t) raw[t] = *(const unsigned*)(p + (size_t)t * PROJ0_LD);
    f32x2 x0 = {0.f, 0.f}, x1 = x0, x2 = x0;
    if (c > 0) { const unsigned a = *(const unsigned*)(p - 3 * PROJ0_LD), bq = *(const unsigned*)(p - 2 * PROJ0_LD), cq = *(const unsigned*)(p - PROJ0_LD); x0 = (f32x2){bflo(a), bfhi(a)}; x1 = (f32x2){bflo(bq), bfhi(bq)}; x2 = (f32x2){bflo(cq), bfhi(cq)}; }
#pragma unroll
    for (int t = 0; t < 64; t += 2) { const f32x2 x3 = {bflo(raw[t]), bfhi(raw[t])}, x4 = {bflo(raw[t + 1]), bfhi(raw[t + 1])};
        const f32x2 v0 = bias + w0 * x0 + w1 * x1 + w2 * x2 + w3 * x3, v1 = bias + w0 * x1 + w1 * x2 + w2 * x3 + w3 * x4;
        sink(t, siluf(v0.x), siluf(v1.x), siluf(v0.y), siluf(v1.y)); x0 = x2; x1 = x3; x2 = x4; }
}

__device__ __forceinline__ void phase_ssd_a(const Frame& F0) {
    const Frame F = phase_frame(F0);
    using namespace sm;
    LAS bf16_t* XT = (LAS bf16_t*)F.lds; LAS bf16_t* BT = (LAS bf16_t*)(F.lds + 73728);
    LAS float* dt_s = (LAS float*)(F.lds + 92160); LAS float* acs_s = (LAS float*)(F.lds + 94208); LAS float* sc_s = (LAS float*)(F.lds + 96256);
    const int tid = F.tid, lane = F.lane, wave = F.wave;
    for (int u = F.vcu; u < NB * NCH * 2; u += F.G) {
        const int g = u & 1, bc = u >> 1, b = bc / NCH, c = bc % NCH; const size_t row0 = (size_t)b * L + c * 64;
        LDS_BARRIER();
        if (tid < 320) { const int ci = tid * 2;
            const int xc = ci < 512 ? g * 512 + ci : 1024 + g * 128 + (ci - 512);
            LAS unsigned* dst = (LAS unsigned*)(ci < 512 ? XT + ci * XT_LD : BT + (ci - 512) * XT_LD);
            ssd_conv_pair(F, b, c, xc, [&](int t, float a0, float a1, float b0, float b1) { dst[t >> 1] = cvt_pk_bf16(a0, a1); dst[XT_LD / 2 + (t >> 1)] = cvt_pk_bf16(b0, b1); });
        }
        { const int t = tid & 63, hh = tid >> 6, hd = g * 8 + hh; const float dt = softplusf(OKP(float, WS_RAW16)[(row0 + t) * 16 + hd] + F.in[I_EV_DTB][hd]); dt_s[hh * 64 + t] = dt; acs_s[hh * 64 + t] = dt * -expf(F.in[I_EV_ALOG][hd]); }
        LDS_BARRIER();
        { const int hh = wave, hd = g * 8 + hh; float v = acs_s[hh * 64 + lane];
#pragma unroll
          for (int o = 1; o < 64; o <<= 1) { const float n = __shfl_up(v, o); if (lane >= o) v += n; }
          const float last = __shfl(v, 63); const float dt = dt_s[hh * 64 + lane];
          sc_s[hh * 64 + lane] = dt * fexp(last - v);
          OKP(float, WS_DTV)[(row0 + lane) * 16 + hd] = dt; OKP(float, WS_ACS)[(row0 + lane) * 16 + hd] = v; }
        WAVE_SYNC();
#if defined(CHECK_DUMP)
        if (bc == 5 && g == 0) {
            float* f3 = OKP(float, WS_FP) + (size_t)3 * 16 * 6144; float* f4 = OKP(float, WS_FP) + (size_t)4 * 16 * 6144; float* f5 = OKP(float, WS_FP) + (size_t)5 * 16 * 6144;
            for (int i = tid; i < 512 * 64; i += NT) f3[i] = bf2f(XT[(i >> 6) * XT_LD + (i & 63)]);
            for (int i = tid; i < 128 * 64; i += NT) f4[i] = bf2f(BT[(i >> 6) * XT_LD + (i & 63)]);
            f5[wave * 64 + lane] = sc_s[wave * 64 + lane];
        }
#endif
        { const int hh = wave, hd = g * 8 + hh, fr = lane & 15, fq = lane >> 4;
          bf16x8 xa[4][2];
#pragma unroll
          for (int pt = 0; pt < 4; ++pt)
#pragma unroll
              for (int ks = 0; ks < 2; ++ks) { const u32x4 raw = *(const LAS u32x4*)(XT + (hh * 64 + pt * 16 + fr) * XT_LD + ks * 32 + fq * 8); const LAS float* sp = sc_s + hh * 64 + ks * 32 + fq * 8;
                  const f32x4 s0 = *(const LAS f32x4*)sp, s1 = *(const LAS f32x4*)(sp + 4); u32x4 o;
                  o.x = cvt_pk_bf16(bflo(raw.x) * s0.x, bfhi(raw.x) * s0.y); o.y = cvt_pk_bf16(bflo(raw.y) * s0.z, bfhi(raw.y) * s0.w);
                  o.z = cvt_pk_bf16(bflo(raw.z) * s1.x, bfhi(raw.z) * s1.y); o.w = cvt_pk_bf16(bflo(raw.w) * s1.z, bfhi(raw.w) * s1.w);
                  xa[pt][ks] = __builtin_bit_cast(bf16x8, o); }
          bf16_t* st = OKP(bf16_t, WS_STATES) + ((size_t)bc * 16 + hd) * 8192;
#pragma unroll
          for (int nt = 0; nt < 8; ++nt) { bf16x8 bb[2];
#pragma unroll
              for (int ks = 0; ks < 2; ++ks) bb[ks] = *(const LAS bf16x8*)(BT + (nt * 16 + fr) * XT_LD + ks * 32 + fq * 8);
#pragma unroll
              for (int pt = 0; pt < 4; ++pt) { f32x4 acc = {0.f, 0.f, 0.f, 0.f};
#pragma unroll
                  for (int ks = 0; ks < 2; ++ks) acc = mfma16(bb[ks], xa[pt][ks], acc);
                  u32x2 w; w.x = cvt_pk_bf16(acc[0], acc[1]); w.y = cvt_pk_bf16(acc[2], acc[3]);
                  *(u32x2*)(st + (size_t)(pt * 16 + fr) * 128 + nt * 16 + 4 * fq) = w; } } }
    }
}

__device__ __forceinline__ void phase_ssd_scan(const Frame& F0, int skip) {
    const Frame F = phase_frame(F0);
    const float* acs = OKP(float, WS_ACS);
    int widx = F.vcu, nw = F.G;
    if (skip) { const int per = F.G / 8, xcd = F.vcu / per, loc = F.vcu % per, sk = skip / 8; if (loc < sk) return; widx = xcd * (per - sk) + (loc - sk); nw = F.G - skip; }
    for (int idx = widx * NT + F.tid; idx < NB * 65536; idx += nw * NT) {
        const int b = idx >> 16, r2 = idx & 65535, hd = r2 >> 12; unsigned* p = (unsigned*)(OKP(bf16_t, WS_STATES) + (size_t)b * NCH * 131072) + r2;
        float s0 = 0.f, s1 = 0.f;
#pragma unroll 8
        for (int c = 0; c < NCH; ++c) { const unsigned st = p[(size_t)c * 65536]; const float dec = fexp(acs[((size_t)b * L + c * 64 + 63) * 16 + hd]);
            p[(size_t)c * 65536] = cvt_pk_bf16(s0, s1); s0 = s0 * dec + bflo(st); s1 = s1 * dec + bfhi(st); }
    }
}

__device__ __forceinline__ void phase_ssd_b(const Frame& F0) {
    const Frame F = phase_frame(F0);
    using namespace sm;
    LAS bf16_t* XT = (LAS bf16_t*)F.lds; LAS bf16_t* Bs = (LAS bf16_t*)(F.lds + 73728); LAS bf16_t* Cs = (LAS bf16_t*)(F.lds + 91136);
    LAS float* acs_s = (LAS float*)(F.lds + 108544); LAS float* dt_s = (LAS float*)(F.lds + 110592); LAS float* red = (LAS float*)(F.lds + 112640);
    const int tid = F.tid, lane = F.lane, wave = F.wave, fr = lane & 15, fq = lane >> 4;
    const bf16_t* proj = OKP(bf16_t, WS_PROJ); bf16_t* cat = OKP(bf16_t, WS_CAT0);
    for (int u = F.vcu; u < NB * NCH * 2; u += F.G) {
        const int g = u & 1, bc = u >> 1, b = bc / NCH, c = bc % NCH; const size_t row0 = (size_t)b * L + c * 64;
        LDS_BARRIER();
        if (tid < 384) { const int ci = tid * 2;
            if (ci < 512) { LAS unsigned* dst = (LAS unsigned*)(XT + ci * XT_LD); ssd_conv_pair(F, b, c, g * 512 + ci, [&](int t, float a0, float a1, float b0, float b1) { dst[t >> 1] = cvt_pk_bf16(a0, a1); dst[XT_LD / 2 + (t >> 1)] = cvt_pk_bf16(b0, b1); }); }
            else { const int n = (ci - 512) & 127; LAS unsigned* dst = (LAS unsigned*)((ci < 640 ? Bs : Cs) + n); const int xc = (ci < 640 ? 1024 : 1280) + g * 128 + n;
                ssd_conv_pair(F, b, c, xc, [&](int t, float a0, float a1, float b0, float b1) { dst[t * (BC_LD / 2)] = cvt_pk_bf16(a0, b0); dst[(t + 1) * (BC_LD / 2)] = cvt_pk_bf16(a1, b1); }); }
        }
        { const int t = tid & 63, hh = tid >> 6; acs_s[hh * 64 + t] = OKP(float, WS_ACS)[(row0 + t) * 16 + g * 8 + hh]; dt_s[hh * 64 + t] = OKP(float, WS_DTV)[(row0 + t) * 16 + g * 8 + hh]; }
        { const int ch = g * 256 + (tid & 255), t0 = (tid >> 8) * 32; const float* w = F.in[I_EV_SCCONV]; const float w0 = w[ch], w1 = w[512 + ch], w2 = w[1024 + ch];
          const bf16_t* p = proj + (row0 + t0) * PROJ0_LD + ch; float p0 = 0.f, p1 = 0.f;
          if (c > 0 || t0 > 0) { p0 = bf2f(p[-2 * PROJ0_LD + 512]) * bf2f(p[-2 * PROJ0_LD + 1024]); p1 = bf2f(p[-PROJ0_LD + 512]) * bf2f(p[-PROJ0_LD + 1024]); }
          unsigned short rb[32], rc[32], rx[32];
#pragma unroll
          for (int t = 0; t < 32; ++t) { const bf16_t* q = p + (size_t)t * PROJ0_LD; rb[t] = q[0]; rc[t] = q[512]; rx[t] = q[1024]; }
#pragma unroll
          for (int t = 0; t < 32; ++t) { const float p2 = bf2f(rc[t]) * bf2f(rx[t]); const float y = bf2f(rb[t]) * (w0 * p0 + w1 * p1 + w2 * p2);
              cat[(row0 + t0 + t) * 1536 + ch] = (bf16_t)(cvt_pk_bf16(y, 0.f) & 0xffffu); p0 = p1; p1 = p2; } }
        LDS_BARRIER();
        const int hh = wave, hd = g * 8 + hh;
        f32x4 Y[4][4];
        { const bf16_t* P = OKP(bf16_t, WS_STATES) + ((size_t)bc * 16 + hd) * 8192;
#pragma unroll
          for (int pt = 0; pt < 4; ++pt)
#pragma unroll
              for (int tt = 0; tt < 4; ++tt) Y[pt][tt] = (f32x4){0.f, 0.f, 0.f, 0.f};
          bf16x8 pall[4][4];
#pragma unroll
          for (int ks = 0; ks < 4; ++ks)
#pragma unroll
              for (int pt = 0; pt < 4; ++pt) pall[ks][pt] = *(const bf16x8*)(P + (size_t)(pt * 16 + fr) * 128 + ks * 32 + fq * 8);
#pragma unroll
          for (int ks = 0; ks < 4; ++ks) { bf16x8 cb[4];
#pragma unroll
              for (int tt = 0; tt < 4; ++tt) cb[tt] = *(const LAS bf16x8*)(Cs + (tt * 16 + fr) * BC_LD + ks * 32 + fq * 8);
#pragma unroll
              for (int pt = 0; pt < 4; ++pt)
#pragma unroll
                  for (int tt = 0; tt < 4; ++tt) Y[pt][tt] = mfma16(pall[ks][pt], cb[tt], Y[pt][tt]); }
#pragma unroll
          for (int tt = 0; tt < 4; ++tt) { const float e = fexp(acs_s[hh * 64 + tt * 16 + fr]);
#pragma unroll
              for (int pt = 0; pt < 4; ++pt) Y[pt][tt] *= e; } }
#pragma unroll
        for (int tt = 0; tt < 4; ++tt) { f32x4 cbt[4];
#pragma unroll
            for (int st = 0; st < 4; ++st) cbt[st] = (f32x4){0.f, 0.f, 0.f, 0.f};
#pragma unroll
            for (int ks = 0; ks < 4; ++ks) { const bf16x8 cf = *(const LAS bf16x8*)(Cs + (tt * 16 + fr) * BC_LD + ks * 32 + fq * 8);
#pragma unroll
                for (int st = 0; st < 4; ++st) if (st <= tt) { const bf16x8 bf = *(const LAS bf16x8*)(Bs + (st * 16 + fr) * BC_LD + ks * 32 + fq * 8); cbt[st] = mfma16(bf, cf, cbt[st]); } }
            const int t = tt * 16 + fr; const float at = acs_s[hh * 64 + t];
#pragma unroll
            for (int st = 0; st < 4; ++st) { const f32x4 as4 = *(const LAS f32x4*)(acs_s + hh * 64 + st * 16 + 4 * fq), dt4 = *(const LAS f32x4*)(dt_s + hh * 64 + st * 16 + 4 * fq);
#pragma unroll
                for (int r = 0; r < 4; ++r) { const int s = st * 16 + 4 * fq + r; cbt[st][r] = (st <= tt && s <= t) ? cbt[st][r] * fexp(at - as4[r]) * dt4[r] : 0.f; } }
            bf16x8 mb[2];
#pragma unroll
            for (int ks = 0; ks < 2; ++ks) { u32x4 o; o.x = cvt_pk_bf16(cbt[2 * ks][0], cbt[2 * ks][1]); o.y = cvt_pk_bf16(cbt[2 * ks][2], cbt[2 * ks][3]); o.z = cvt_pk_bf16(cbt[2 * ks + 1][0], cbt[2 * ks + 1][1]); o.w = cvt_pk_bf16(cbt[2 * ks + 1][2], cbt[2 * ks + 1][3]);
                mb[ks] = __builtin_bit_cast(bf16x8, o); }
#pragma unroll
            for (int pt = 0; pt < 4; ++pt)
#pragma unroll
                for (int ks = 0; ks < 2; ++ks) { const LAS bf16_t* xp = XT + (hh * 64 + pt * 16 + fr) * XT_LD + ks * 32 + 4 * fq; const u32x2 lo = *(const LAS u32x2*)xp, hi = *(const LAS u32x2*)(xp + 16);
                    u32x4 a; a.x = lo.x; a.y = lo.y; a.z = hi.x; a.w = hi.y; Y[pt][tt] = mfma16(__builtin_bit_cast(bf16x8, a), mb[ks], Y[pt][tt]); } }
        const float Dh = F.in[I_EV_D][hd];
#pragma unroll
        for (int tt = 0; tt < 4; ++tt) { const int t = tt * 16 + fr; float ss = 0.f;
#pragma unroll
            for (int pt = 0; pt < 4; ++pt) { const int p = pt * 16 + 4 * fq; const u32x2 zz = *(const u32x2*)(proj + (row0 + t) * PROJ0_LD + 1536 + hd * 64 + p);
                const float z0 = bflo(zz.x), z1 = bfhi(zz.x), z2 = bflo(zz.y), z3 = bfhi(zz.y); const LAS bf16_t* xp = XT + (hh * 64 + p) * XT_LD + t;
                f32x4 y = Y[pt][tt]; y[0] = (y[0] + Dh * bf2f(xp[0])) * siluf(z0); y[1] = (y[1] + Dh * bf2f(xp[XT_LD])) * siluf(z1); y[2] = (y[2] + Dh * bf2f(xp[2 * XT_LD])) * siluf(z2); y[3] = (y[3] + Dh * bf2f(xp[3 * XT_LD])) * siluf(z3);
                Y[pt][tt] = y; ss += (y[0] * y[0] + y[1] * y[1]) + (y[2] * y[2] + y[3] * y[3]); }
            ss += __shfl_xor(ss, 16); ss += __shfl_xor(ss, 32);
            if (fq == 0) red[hh * 64 + t] = ss; }
        LDS_BARRIER();
#pragma unroll
        for (int tt = 0; tt < 4; ++tt) { const int t = tt * 16 + fr; float ss = 0.f;
#pragma unroll
            for (int w = 0; w < 8; ++w) ss += red[w * 64 + t];
            const float rs = frsq(ss * (1.f / 512.f) + EPS);
#pragma unroll
            for (int pt = 0; pt < 4; ++pt) { const int ch = hd * 64 + pt * 16 + 4 * fq; const f32x4 nw = *(const f32x4*)(F.in[I_EV_NORM] + ch); const f32x4 y = Y[pt][tt];
                u32x2 w; w.x = cvt_pk_bf16(y[0] * rs * nw.x, y[1] * rs * nw.y); w.y = cvt_pk_bf16(y[2] * rs * nw.z, y[3] * rs * nw.w);
                *(u32x2*)(cat + (row0 + t) * 1536 + 512 + ch) = w; } }
    }
}
}

namespace ok {
constexpr int XA_LD = 264;

__device__ __forceinline__ void phase_xattn(const Frame& F0, const bf16_t* q, const bf16_t* kx, const bf16_t* vt, bf16_t* att) {
    const Frame F = phase_frame(F0);
    LAS bf16_t* KV = (LAS bf16_t*)F.lds;
    const int tid = F.tid, lane = F.lane, wave = F.wave, fr = lane & 15, fq = lane >> 4;
    u32x4 tile[8];
#define XA_LOAD_K(uu) do { const int hd_ = (uu) & 3, b_ = (((uu) >> 2) * 128) / L; _Pragma("unroll") for (int j_ = 0; j_ < 8; ++j_) { const int i_ = tid + j_ * NT, r_ = i_ >> 5, c8_ = i_ & 31; tile[j_] = *(const u32x4*)(kx + (size_t)(b_ * 256 + r_) * 1024 + hd_ * 256 + c8_ * 8); } } while (0)
#define XA_LOAD_V(uu) do { const int hd_ = (uu) & 3, b_ = (((uu) >> 2) * 128) / L; _Pragma("unroll") for (int j_ = 0; j_ < 8; ++j_) { const int i_ = tid + j_ * NT, r_ = i_ >> 5, c8_ = i_ & 31; tile[j_] = *(const u32x4*)(vt + (size_t)(hd_ * 256 + r_) * (NB * 256) + b_ * 256 + c8_ * 8); } } while (0)
#define XA_STORE() do { _Pragma("unroll") for (int j_ = 0; j_ < 8; ++j_) { const int i_ = tid + j_ * NT, r_ = i_ >> 5, c8_ = i_ & 31; *(LAS u32x4*)(KV + r_ * XA_LD + c8_ * 8) = tile[j_]; } } while (0)
#define XA_REST_K(uu) do { const int hd_ = (uu) & 3, b_ = (((uu) >> 2) * 128) / L; _Pragma("unroll") for (int j_ = 8; j_ < 16; ++j_) { const int i_ = tid + j_ * NT, r_ = i_ >> 5, c8_ = i_ & 31; *(LAS u32x4*)(KV + r_ * XA_LD + c8_ * 8) = *(const u32x4*)(kx + (size_t)(b_ * 256 + r_) * 1024 + hd_ * 256 + c8_ * 8); } } while (0)
#define XA_REST_V(uu) do { const int hd_ = (uu) & 3, b_ = (((uu) >> 2) * 128) / L; _Pragma("unroll") for (int j_ = 8; j_ < 16; ++j_) { const int i_ = tid + j_ * NT, r_ = i_ >> 5, c8_ = i_ & 31; *(LAS u32x4*)(KV + r_ * XA_LD + c8_ * 8) = *(const u32x4*)(vt + (size_t)(hd_ * 256 + r_) * (NB * 256) + b_ * 256 + c8_ * 8); } } while (0)
    if (F.vcu < (T / 128) * 4) XA_LOAD_K(F.vcu);
    for (int u = F.vcu; u < (T / 128) * 4; u += F.G) {
        const int hd = u & 3, rt = u >> 2, row0 = rt * 128;
        LDS_BARRIER();
        XA_REST_K(u); XA_STORE();
        XA_LOAD_V(u);
        LDS_BARRIER();
        bf16x8 pf[8]; float fA, fB;
        {
            const bf16_t* qp = q + (size_t)(row0 + wave * 16 + fr) * 1024 + hd * 256 + fq * 8;
            bf16x8 qf[8];
#pragma unroll
            for (int ks = 0; ks < 8; ++ks) qf[ks] = *(const bf16x8*)(qp + ks * 32);
            float mh[2], lh[2];
#pragma unroll
            for (int half = 0; half < 2; ++half) {
                f32x4 s[8];
#pragma unroll
                for (int kt = 0; kt < 8; ++kt) { s[kt] = (f32x4){0.f, 0.f, 0.f, 0.f};
#pragma unroll
                    for (int ks = 0; ks < 8; ++ks) { const bf16x8 kf = *(const LAS bf16x8*)(KV + ((half * 8 + kt) * 16 + fr) * XA_LD + ks * 32 + fq * 8); s[kt] = mfma16(kf, qf[ks], s[kt]); }
                    }
                float m = -3.0e38f;
#pragma unroll
                for (int kt = 0; kt < 8; ++kt) m = fmaxf(m, fmaxf(fmaxf(s[kt][0], s[kt][1]), fmaxf(s[kt][2], s[kt][3])));
                m = fmaxf(m, __shfl_xor(m, 16)); m = fmaxf(m, __shfl_xor(m, 32));
                float l = 0.f;
#pragma unroll
                for (int kt = 0; kt < 8; ++kt) {
#pragma unroll
                    for (int r = 0; r < 4; ++r) { const float p = fexp2(s[kt][r] - m); s[kt][r] = p; l += p; } }
                l += __shfl_xor(l, 16); l += __shfl_xor(l, 32); mh[half] = m; lh[half] = l;
#pragma unroll
                for (int j = 0; j < 4; ++j) { u32x4 o; o.x = cvt_pk_bf16(s[2 * j][0], s[2 * j][1]); o.y = cvt_pk_bf16(s[2 * j][2], s[2 * j][3]); o.z = cvt_pk_bf16(s[2 * j + 1][0], s[2 * j + 1][1]); o.w = cvt_pk_bf16(s[2 * j + 1][2], s[2 * j + 1][3]);
                    pf[half * 4 + j] = __builtin_bit_cast(bf16x8, o); }
                    }
            const float m = fmaxf(mh[0], mh[1]), cA = fexp2(mh[0] - m), cB = fexp2(mh[1] - m), li = frcp(cA * lh[0] + cB * lh[1]); fA = cA * li; fB = cB * li;
        }
        LDS_BARRIER();
        XA_REST_V(u); XA_STORE();
        if (u + F.G < (T / 128) * 4) XA_LOAD_K(u + F.G);
        LDS_BARRIER();
#pragma unroll 2
        for (int dt = 0; dt < 16; ++dt) { f32x4 oA = {0.f, 0.f, 0.f, 0.f}, oB = oA;
#pragma unroll
            for (int j = 0; j < 8; ++j) { const LAS bf16_t* vp = KV + (dt * 16 + fr) * XA_LD + j * 32 + 4 * fq; const u32x2 lo = *(const LAS u32x2*)vp, hi = *(const LAS u32x2*)(vp + 16);
                u32x4 a; a.x = lo.x; a.y = lo.y; a.z = hi.x; a.w = hi.y; const bf16x8 vf = __builtin_bit_cast(bf16x8, a);
                if (j < 4) oA = mfma16(vf, pf[j], oA); else oB = mfma16(vf, pf[j], oB); }
            const f32x4 o = oA * fA + oB * fB;
            bf16_t* op = att + (size_t)(row0 + wave * 16 + fr) * 1024 + hd * 256 + dt * 16 + 4 * fq;
            u32x2 w; w.x = cvt_pk_bf16(o[0], o[1]); w.y = cvt_pk_bf16(o[2], o[3]); *(u32x2*)op = w; }
    }
#undef XA_LOAD_K
#undef XA_LOAD_V
#undef XA_STORE
#undef XA_REST_K
#undef XA_REST_V
}

#ifndef CPU_EMU
struct KvOrder {
    static constexpr bool LIGHT = false;
    const char* memnb; const char* wxa; char* kx; char* vt; int G, c;
    __device__ bool next(int i, pg8::Unit& u) const {
        const int Lx = i * G + c; if (Lx >= 32) return false;
        const int l = Lx >> 4, r = Lx & 15; const size_t tstep = (size_t)256 * 1024 * 2;
        if (r < 8) { u.pm = r >> 2; u.pn = r & 3; u.tag = l * 2; u.a = memnb + (size_t)u.pm * tstep; u.b = wxa + (size_t)l * 8 * MiB + 2 * MiB + (size_t)u.pn * tstep; }
        else { const int r2 = r - 8; u.pm = r2 >> 1; u.pn = r2 & 1; u.tag = l * 2 + 1; u.a = wxa + (size_t)l * 8 * MiB + 4 * MiB + (size_t)u.pm * tstep; u.b = memnb + (size_t)u.pn * tstep; }
        return true;
    }
    __device__ __forceinline__ void a_ready(const pg8::Unit&) const {}
    __device__ __forceinline__ void done(const pg8::Unit&) const {}
};
struct EpiKv {
    static constexpr bool PERM = true, AFTER_DRAIN = false;
    bf16_t* kx; bf16_t* vt;
    __device__ __forceinline__ void operator()(const f32x4 (&acc)[2][2][4][2], const pg8::Unit& u, int wr, int wc, int fr, int fq) const {
        const int l = u.tag >> 1, isv = u.tag & 1, ldc = isv ? 512 : 1024; bf16_t* O = isv ? vt + (size_t)l * 1024 * 512 : kx + (size_t)l * 512 * 1024;
        const int row0 = u.pm * 256 + wr * 64 + fr, col0 = u.pn * 256 + wc * 32 + 8 * fq;
#pragma unroll
        for (int ai = 0; ai < 2; ++ai)
#pragma unroll
            for (int m = 0; m < 4; ++m) { bf16_t* rowp = O + (size_t)(row0 + ai * 128 + m * 16) * ldc + col0;
#pragma unroll
                for (int bj = 0; bj < 2; ++bj) { const f32x4 v0 = acc[ai][bj][m][0], v1 = acc[ai][bj][m][1]; u32x4 w; w.x = cvt_pk_bf16(v0[0], v0[1]); w.y = cvt_pk_bf16(v0[2], v0[3]); w.z = cvt_pk_bf16(v1[0], v1[1]); w.w = cvt_pk_bf16(v1[2], v1[3]);
                    *(u32x4*)(rowp + bj * 128) = w; } }
    }
};
__device__ __forceinline__ void phase_kv(const Frame& F) {
    pg8::Gemm g{nullptr, nullptr, 0, 0, 1024};
    int vcu_; { const int bx = blockIdx.x, G = gridDim.x; vcu_ = (G % 8 == 0) ? (bx % 8) * (G / 8) + bx / 8 : bx; if (G % 8 == 0 && G >= 64) { const int per = G / 8, xcd = vcu_ / per, loc = vcu_ % per; vcu_ = loc < 4 ? xcd * 4 + loc : 32 + vcu_; } }
    KvOrder S{(const char*)OKP(bf16_t, WS_MEMNB), (const char*)OKP(bf16_t, WS_W_XA), (char*)OKP(bf16_t, WS_KX), (char*)OKP(bf16_t, WS_VT), F.G, vcu_};
    EpiKv E{OKP(bf16_t, WS_KX), OKP(bf16_t, WS_VT)};
    pg8::gemm_phase<EpiKv, KvOrder, true, true>(F.lds, g, S, E);
}
#endif
}

namespace ok {
constexpr size_t WS_WRH = WS_WR, WS_WRL = WS_WR + 256 * KiB;
constexpr size_t WS_POS = WS_TILEEXP + 4 * KiB;
__device__ __forceinline__ void prologue_router_tables(const Frame& F0) {
    const Frame F = phase_frame(F0);
    using namespace sm;
    const size_t gt = (size_t)F.vcu * NT + F.tid, GT = (size_t)F.G * NT;
    for (size_t i = gt; i < (size_t)2 * 48 * 1024; i += GT) { const int l = (int)(i / (48 * 1024)), j = (int)((i / 1024) % 48), k = (int)(i % 1024); float v = 0.f;
        if (j < 4) v = F.in[I_MOE_WG][((size_t)l * 1024 + k) * 4 + j]; else if (j < 36) v = F.in[I_MOE_WE][((size_t)l * 1024 + k) * 32 + (j - 4)];
        v *= F.in[I_NORM_FFN][l * 1024 + k];
        const unsigned hi = cvt_pk_bf16(v, 0.f) & 0xffffu; const float rem = v - __uint_as_float(hi << 16);
        OKP(bf16_t, WS_WRH)[i] = (bf16_t)hi; OKP(bf16_t, WS_WRL)[i] = (bf16_t)(cvt_pk_bf16(rem, 0.f) & 0xffffu); }
}

constexpr size_t WS_W16H = WS_WR + 512 * KiB, WS_W16L = WS_W16H + 64 * KiB;
__device__ __forceinline__ void prologue_w16_tables(const Frame& F0) {
    using namespace sm;
    const Frame F = phase_frame(F0);
    const size_t gt = (size_t)F.vcu * NT + F.tid, GT = (size_t)F.G * NT;
    for (size_t i = gt; i < (size_t)2 * 16 * 1024; i += GT) { const int set = (int)(i >> 14), j = (int)((i >> 10) & 15), k = (int)(i & 1023);
        const float v = set == 0 ? F.in[I_NORM_MIX][k] * F.in[I_EV_WIN][(size_t)k * 4112 + 4096 + j] : F.in[I_NORM_MIX][1024 + k] * F.in[I_OD_WIN][(size_t)k * 5648 + 4096 + j];
        const unsigned hi = cvt_pk_bf16(v, 0.f) & 0xffffu; const float rem = v - __uint_as_float(hi << 16);
        OKP(bf16_t, WS_W16H)[i] = (bf16_t)hi; OKP(bf16_t, WS_W16L)[i] = (bf16_t)(cvt_pk_bf16(rem, 0.f) & 0xffffu); }
}
__device__ __forceinline__ void phase_proj16(const Frame& F0, int set, const float* h, const bf16_t* hb, const float* ssq, int np) {
    const Frame F = phase_frame(F0);
    const int lane = F.lane, fr = lane & 15, fq = lane >> 4;
    const bf16_t* wh = OKP(bf16_t, WS_W16H) + (size_t)set * 16 * 1024; const bf16_t* wl = OKP(bf16_t, WS_W16L) + (size_t)set * 16 * 1024;
    const int gw = F.vcu * NWAVES + F.wave, NGW = F.G * NWAVES;
    for (int tile = gw; tile < T / 16; tile += NGW) { const int t0 = tile * 16; f32x4 acc = {0.f, 0.f, 0.f, 0.f};
        const float* hp = h + (size_t)(t0 + fr) * DM + fq * 8;
#pragma unroll 8
        for (int ks = 0; ks < 32; ++ks) { const size_t wo = (size_t)fr * 1024 + ks * 32 + fq * 8; const bf16x8 bh = *(const bf16x8*)(wh + wo), bl = *(const bf16x8*)(wl + wo);
            if (hb) { const bf16x8 ah = *(const bf16x8*)(hb + (size_t)(t0 + fr) * DM + fq * 8 + ks * 32); acc = mfma16(bh, ah, acc); acc = mfma16(bl, ah, acc); }
            else { const f32x4 x0 = *(const f32x4*)(hp + ks * 32), x1 = *(const f32x4*)(hp + ks * 32 + 4);
            u32x4 hi, lo;
            hi.x = cvt_pk_bf16(x0[0], x0[1]); hi.y = cvt_pk_bf16(x0[2], x0[3]); hi.z = cvt_pk_bf16(x1[0], x1[1]); hi.w = cvt_pk_bf16(x1[2], x1[3]);
            lo.x = cvt_pk_bf16(x0[0] - bflo(hi.x), x0[1] - bfhi(hi.x)); lo.y = cvt_pk_bf16(x0[2] - bflo(hi.y), x0[3] - bfhi(hi.y));
            lo.z = cvt_pk_bf16(x1[0] - bflo(hi.z), x1[1] - bfhi(hi.z)); lo.w = cvt_pk_bf16(x1[2] - bflo(hi.w), x1[3] - bfhi(hi.w));
            const bf16x8 ah = __builtin_bit_cast(bf16x8, hi), al = __builtin_bit_cast(bf16x8, lo);
            acc = mfma16(bh, ah, acc); acc = mfma16(bl, ah, acc); acc = mfma16(bh, al, acc); } }
        acc *= rstd_np(ssq, np, t0 + fr);
        *(f32x4*)(OKP(float, WS_RAW16) + (size_t)(t0 + fr) * 16 + 4 * fq) = acc; }
}

__device__ __forceinline__ void phase_router(const Frame& F0, int l, const bf16_t* hb, const float* ssq, int np) {
    const Frame F = phase_frame(F0);
    using namespace sm;
    const int lane = F.lane, wave = F.wave, fr = lane & 15, fq = lane >> 4;
    LAS float* lg = (LAS float*)(F.lds + wave * 16384 + 8704);
    const bf16_t* wh = OKP(bf16_t, WS_WRH) + (size_t)l * 48 * 1024; const bf16_t* wl = OKP(bf16_t, WS_WRL) + (size_t)l * 48 * 1024;
    const float* bg = F.in[I_MOE_BG] + l * 4; const float* be = F.in[I_MOE_BE] + l * 32;
    unsigned* cnt = F.ctl + CW_MOE + l * 64;
    const int gw = F.vcu * NWAVES + wave, NGW = F.G * NWAVES;
    for (int tile = gw; tile < T / 16; tile += NGW) {
        const int t0 = tile * 16;
        f32x4 acc[3] = {{0.f, 0.f, 0.f, 0.f}, {0.f, 0.f, 0.f, 0.f}, {0.f, 0.f, 0.f, 0.f}};
        const bf16_t* hp = hb + (size_t)(t0 + fr) * DM + fq * 8;
#pragma unroll 8
        for (int ks = 0; ks < 32; ++ks) { const bf16x8 ah = *(const bf16x8*)(hp + ks * 32);
#pragma unroll
            for (int nt = 0; nt < 3; ++nt) { const size_t wo = (size_t)(nt * 16 + fr) * 1024 + ks * 32 + fq * 8; const bf16x8 bh = *(const bf16x8*)(wh + wo), bl = *(const bf16x8*)(wl + wo);
                acc[nt] = mfma16(bh, ah, acc[nt]); acc[nt] = mfma16(bl, ah, acc[nt]); } }
#pragma unroll
        for (int nt = 0; nt < 3; ++nt) *(LAS f32x4*)(lg + fr * 48 + nt * 16 + 4 * fq) = acc[nt];
        WAVE_SYNC();
        if (lane < 16) { const int t = t0 + lane; const LAS float* p = lg + lane * 48; const float rs = rstd_np(ssq, np, t);
            const float g0 = p[0] * rs + bg[0], g1 = p[1] * rs + bg[1], g2 = p[2] * rs + bg[2], g3 = p[3] * rs + bg[3];
            int gsel = 0; float gm = g0; if (g1 > gm) { gm = g1; gsel = 1; } if (g2 > gm) { gm = g2; gsel = 2; } if (g3 > gm) { gm = g3; gsel = 3; }
            const float gwt = 1.f / (expf(g0 - gm) + expf(g1 - gm) + expf(g2 - gm) + expf(g3 - gm));
            const LAS float* pe = p + 4 + gsel * 8; const float* bb = be + gsel * 8;
            float e[8];
#pragma unroll
            for (int j = 0; j < 8; ++j) e[j] = pe[j] * rs + bb[j];
            int i1 = 0; float m1 = e[0];
#pragma unroll
            for (int j = 1; j < 8; ++j) if (e[j] > m1) { m1 = e[j]; i1 = j; }
            int i2 = -1; float m2 = -3.0e38f;
#pragma unroll
            for (int j = 0; j < 8; ++j) if (j != i1 && e[j] > m2) { m2 = e[j]; i2 = j; }
            const float r = expf(m2 - m1); const float w1 = gwt / (1.f + r), w2 = gwt * r / (1.f + r);
            const int e1 = gsel * 8 + i1, e2 = gsel * 8 + i2;
            OKP(int, WS_EID)[t * 2] = e1; OKP(int, WS_EID)[t * 2 + 1] = e2; OKP(float, WS_GATEW)[t * 2] = w1; OKP(float, WS_GATEW)[t * 2 + 1] = w2;
            OKP(int, WS_POS)[t * 2] = (int)atomicAdd(cnt + e1, 1u); OKP(int, WS_POS)[t * 2 + 1] = (int)atomicAdd(cnt + e2, 1u); }
        WAVE_SYNC();
    }
}

__device__ __forceinline__ void phase_scatter(const Frame& F0, int l, const bf16_t* hb, const float* ssq, int np) {
    const Frame F = phase_frame(F0);
    const unsigned* cnt = F.ctl + CW_MOE + l * 64; const int lane = F.lane;
    const int gw = F.vcu * NWAVES + F.wave, NGW = F.G * NWAVES;
    int base = 0;
    { int tiles = lane < 32 ? (((int)cnt[lane & 31] + 255) >> 8) : 0; int incl = tiles;
#pragma unroll
      for (int o = 1; o < 32; o <<= 1) { const int n = __shfl_up(incl, o); if ((lane & 31) >= o) incl += n; }
      base = (incl - tiles) * 256;
      const int cnt_e = lane < 32 ? (int)cnt[lane & 31] : 0; const int light = (tiles > 0 && cnt_e - 256 * (tiles - 1) <= 128) ? 1 : 0, full = tiles - light;
      int fincl = full, lincl = light;
#pragma unroll
      for (int o = 1; o < 32; o <<= 1) { const int n1 = __shfl_up(fincl, o), n2 = __shfl_up(lincl, o); if ((lane & 31) >= o) { fincl += n1; lincl += n2; } }
      const int ntiles = __shfl(incl, 31), nfull = __shfl(fincl, 31);
      if (blockIdx.x == 0 && F.wave == 0) { if (lane < 32) { for (int i = 0; i < tiles; ++i) OKP(int, WS_TILEEXP)[(base >> 8) + i] = lane;
              for (int i = 0; i < full; ++i) OKP(int, WS_TILEEXP)[512 + (fincl - full) + i] = (base >> 8) + i;
              if (light) OKP(int, WS_TILEEXP)[512 + nfull + (lincl - 1)] = ((base >> 8) + tiles - 1) | (1 << 16); }
          if (lane == 0) OKP(int, WS_TILEEXP)[1023] = ntiles; } }
    for (int a0 = gw * 4; a0 < T * 2; a0 += NGW * 4) {
        int slot[4]; u32x4 r0[4], r1[4];
#pragma unroll
        for (int k = 0; k < 4; ++k) { const int a = a0 + k; const int e = OKP(int, WS_EID)[a]; slot[k] = __shfl(base, e) + OKP(int, WS_POS)[a]; }
#pragma unroll
        for (int k = 0; k < 4; ++k) { const u32x4* src = (const u32x4*)(hb + (size_t)((a0 + k) >> 1) * DM) + lane; r0[k] = src[0]; r1[k] = src[64]; }
#pragma unroll
        for (int k = 0; k < 4; ++k) { const int a = a0 + k, t = a >> 1; u32x4* dst = (u32x4*)(OKP(bf16_t, WS_XS) + (size_t)slot[k] * DM) + lane; dst[0] = r0[k]; dst[64] = r1[k];
            if (lane == 0) { OKP(int, WS_TOKSLOT)[a] = slot[k]; OKP(float, WS_SLOTGATE)[slot[k]] = OKP(float, WS_GATEW)[a]; OKP(float, WS_SLOTRSTD)[slot[k]] = rstd_np(ssq, np, t); } } }
}

__device__ __forceinline__ void phase_combine(const Frame& F0, bf16_t* hb, float* ssq, bool final_layer) {
    using namespace sm;
    const Frame F = phase_frame(F0);
    const int lane = F.lane; const int gw = F.vcu * NWAVES + F.wave, NGW = F.G * NWAVES; const bf16_t* y = OKP(bf16_t, WS_Y);
    for (int t0 = gw * 2; t0 < T; t0 += NGW * 2) {
        int sa[2], sb[2];
#pragma unroll
        for (int k = 0; k < 2; ++k) { sa[k] = OKP(int, WS_TOKSLOT)[(t0 + k) * 2]; sb[k] = OKP(int, WS_TOKSLOT)[(t0 + k) * 2 + 1]; }
        u32x2 ra[2][4], rb[2][4], rh[2][4];
#pragma unroll
        for (int k = 0; k < 2; ++k) { const u32x2* hr = (const u32x2*)(hb + (size_t)(t0 + k) * DM) + lane; const u32x2* ya = (const u32x2*)(y + (size_t)sa[k] * DM) + lane; const u32x2* yb = (const u32x2*)(y + (size_t)sb[k] * DM) + lane;
#pragma unroll
            for (int j = 0; j < 4; ++j) { ra[k][j] = ya[64 * j]; rb[k][j] = yb[64 * j]; rh[k][j] = hr[64 * j]; } }
#pragma unroll
        for (int k = 0; k < 2; ++k) { const int t = t0 + k; u32x2* hr = (u32x2*)(hb + (size_t)t * DM) + lane; f32x4 v[4]; float s = 0.f;
#pragma unroll
            for (int j = 0; j < 4; ++j) { const u32x2 a = ra[k][j], b = rb[k][j], hw = rh[k][j]; f32x4 x;
                x[0] = bflo(hw.x) + (bflo(a.x) + bflo(b.x)); x[1] = bfhi(hw.x) + (bfhi(a.x) + bfhi(b.x)); x[2] = bflo(hw.y) + (bflo(a.y) + bflo(b.y)); x[3] = bfhi(hw.y) + (bfhi(a.y) + bfhi(b.y));
                if (!final_layer) { u32x2 w; w.x = cvt_pk_bf16(x[0], x[1]); w.y = cvt_pk_bf16(x[2], x[3]); hr[64 * j] = w; x = (f32x4){bflo(w.x), bfhi(w.x), bflo(w.y), bfhi(w.y)}; }
                v[j] = x; s += (x[0] * x[0] + x[1] * x[1]) + (x[2] * x[2] + x[3] * x[3]); }
            s = wave_sum(s);
            if (!final_layer) { if (lane == 0) ssq[t] = s; }
            else { const float rs = frsq(s * (1.f / DM) + EPS); f32x4* orow = (f32x4*)(F.out + (size_t)t * DM) + lane; const f32x4* gr = (const f32x4*)F.in[I_FINAL_NORM] + lane;
#pragma unroll
                for (int j = 0; j < 4; ++j) { const f32x4 g = gr[64 * j]; f32x4 o; o[0] = v[j][0] * rs * g[0]; o[1] = v[j][1] * rs * g[1]; o[2] = v[j][2] * rs * g[2]; o[3] = v[j][3] * rs * g[3]; orow[64 * j] = o; } } } }
}

#ifndef CPU_EMU
struct MoeOrder {
    static constexpr bool LIGHT = true;
    const char* A; const char* W; const int* tile_exp; size_t a_tstep, w_estride, w_off, w_tstep; int G, c;
    __device__ bool next(int i, pg8::Unit& u) const {
        const int Lx = i * G + c; const int ntiles = tile_exp[1023]; if (Lx >= ntiles * 4) return false;
        const int info = tile_exp[512 + (Lx >> 2)], tile = info & 0xffff; u.pm = tile; u.pn = Lx & 3; u.tag = info >> 16; const int e = tile_exp[tile];
        u.a = A + (size_t)tile * a_tstep; u.b = W + (size_t)e * w_estride + w_off + (size_t)u.pn * w_tstep; return true;
    }
    __device__ __forceinline__ void a_ready(const pg8::Unit&) const {}
    __device__ __forceinline__ void done(const pg8::Unit&) const {}
};
struct EpiSwiGLU {
    static constexpr bool PERM = false, AFTER_DRAIN = false;
    bf16_t* act; const float* slot_rstd;
    __device__ __forceinline__ void operator()(const f32x4 (&acc)[2][2][4][2], const pg8::Unit& u, int wr, int wc, int fr, int fq) const {
        const int row0 = u.pm * 256 + wr * 64 + fr, col0 = u.pn * 128 + wc * 16 + 4 * fq;
#pragma unroll
        for (int ai = 0; ai < 2; ++ai)
#pragma unroll
            for (int m = 0; m < 4; ++m) { const int row = row0 + ai * 128 + m * 16; const float rs = slot_rstd[row]; bf16_t* rowp = act + (size_t)row * 512 + col0;
#pragma unroll
                for (int bj = 0; bj < 2; ++bj) { const f32x4 g = acc[ai][bj][m][0] * rs, up = acc[ai][bj][m][1] * rs; f32x4 o;
#pragma unroll
                    for (int r = 0; r < 4; ++r) o[r] = g[r] * frcp(1.f + fexp(-g[r])) * up[r];
                    u32x2 w; w.x = cvt_pk_bf16(o[0], o[1]); w.y = cvt_pk_bf16(o[2], o[3]); *(u32x2*)(rowp + bj * 64) = w; } }
    }
};
struct EpiDown {
    static constexpr bool PERM = true, AFTER_DRAIN = false;
    bf16_t* y; const float* slot_gate;
    __device__ __forceinline__ void operator()(const f32x4 (&acc)[2][2][4][2], const pg8::Unit& u, int wr, int wc, int fr, int fq) const {
        const int row0 = u.pm * 256 + wr * 64 + fr, col0 = u.pn * 256 + wc * 32 + 8 * fq;
#pragma unroll
        for (int ai = 0; ai < 2; ++ai)
#pragma unroll
            for (int m = 0; m < 4; ++m) { const int row = row0 + ai * 128 + m * 16; const float s = slot_gate[row]; bf16_t* rowp = y + (size_t)row * DM + col0;
#pragma unroll
                for (int bj = 0; bj < 2; ++bj) { const f32x4 v0 = acc[ai][bj][m][0] * s, v1 = acc[ai][bj][m][1] * s; u32x4 w; w.x = cvt_pk_bf16(v0[0], v0[1]); w.y = cvt_pk_bf16(v0[2], v0[3]); w.z = cvt_pk_bf16(v1[0], v1[1]); w.w = cvt_pk_bf16(v1[2], v1[3]);
                    *(u32x4*)(rowp + bj * 128) = w; } }
    }
};
__device__ __forceinline__ void phase_moe_up(const Frame& F) {
    pg8::Gemm g{nullptr, nullptr, 0, 0, 1024};
    MoeOrder S{(const char*)OKP(bf16_t, WS_XS), (const char*)OKP(bf16_t, WS_MOEW), OKP(int, WS_TILEEXP), (size_t)256 * 1024 * 2, 3 * MiB, 0, (size_t)256 * 1024 * 2, F.G, (int)blockIdx.x};
    EpiSwiGLU E{OKP(bf16_t, WS_ACT), OKP(float, WS_SLOTRSTD)};
    pg8::gemm_phase<EpiSwiGLU, MoeOrder, true, true>(F.lds, g, S, E);
}
__device__ __forceinline__ void phase_moe_down(const Frame& F) {
    pg8::Gemm g{nullptr, nullptr, 0, 0, 512};
    MoeOrder S{(const char*)OKP(bf16_t, WS_ACT), (const char*)OKP(bf16_t, WS_MOEW), OKP(int, WS_TILEEXP), (size_t)256 * 512 * 2, 3 * MiB, 2 * MiB, (size_t)256 * 512 * 2, F.G, (int)blockIdx.x};
    EpiDown E{OKP(bf16_t, WS_Y), OKP(float, WS_SLOTGATE)};
    pg8::gemm_phase<EpiDown, MoeOrder, true, true>(F.lds, g, S, E);
}
#endif
}

#ifndef DUP_MASK
#define DUP_MASK 0
#endif
namespace ok {
constexpr size_t WS_GU = 160 * MiB, WS_GW = 192 * MiB, WS_GQD = 224 * MiB, WS_GKDT = 480 * MiB, WS_GAQK = 512 * MiB;
constexpr size_t WS_GDEC = WS_GCS;
constexpr size_t WS_OBUF = WS_H;
constexpr int G_LD = 132, GB_LD = 136, LM_LD = 68, LB_LD = 72, XT_LD2 = 68;
__device__ __forceinline__ float sigmoidf_(float x) { return frcp(1.f + fexp(-x)); }

template <int PARTS  > __device__ __forceinline__ void phase_gdn_prep_t(const Frame& F0) {
    using namespace sm;
    const Frame F = phase_frame(F0);
    LAS float* q_s = (LAS float*)F.lds; LAS float* k_s = (LAS float*)(F.lds + 33792); LAS float* v_s = (LAS float*)(F.lds + 67584);
    LAS bf16_t* Kn = (LAS bf16_t*)(F.lds + 101376); LAS bf16_t* Qn = (LAS bf16_t*)(F.lds + 118784);
    LAS float* g_s = (LAS float*)(F.lds + 136192); LAS float* beta_s = g_s + 64; LAS float* gc_s = g_s + 128; LAS float* eg_s = g_s + 192; LAS float* rq_s = g_s + 256; LAS float* rk_s = g_s + 320;
    LAS float* Lm = q_s;
    LAS bf16_t* Lb16 = (LAS bf16_t*)(F.lds + 17408);
    LAS bf16_t* XT = Kn;
    const int tid = F.tid, lane = F.lane, wave = F.wave, fr = lane & 15, fq = lane >> 4;
    const bf16_t* proj = OKP(bf16_t, WS_PROJ); const float* cw = F.in[I_OD_CONV];
    for (int u = F.vcu; u < NB * NCH * 8; u += F.G) {
        const int hd = u & 7, bc = u >> 3, b = bc / NCH, c = bc % NCH; const size_t row0 = (size_t)b * L + c * 64; const size_t ub = (size_t)bc * 8 + hd;
        LDS_BARRIER();
        if ((PARTS & 1) && tid < 384) { const int which = tid >> 7, d = tid & 127, xc = which * 1024 + hd * 128 + d; LAS float* dst = (which == 0 ? q_s : which == 1 ? k_s : v_s) + d;
            const float w0 = cw[xc], w1 = cw[3072 + xc], w2 = cw[6144 + xc], w3 = cw[9216 + xc]; const bf16_t* p = proj + row0 * PROJ1_LD + xc;
            const int hb_ = c > 0 ? 1 : 0; const unsigned short h0 = p[-3 * PROJ1_LD * hb_], h1 = p[-2 * PROJ1_LD * hb_], h2 = p[-PROJ1_LD * hb_];
            unsigned short raw[64]; float pacc = 0.f;
#pragma unroll
            for (int t = 0; t < 64; ++t) raw[t] = p[(size_t)t * PROJ1_LD];
            SCHED_FENCE();
            float x0 = hb_ ? bf2f(h0) : 0.f, x1 = hb_ ? bf2f(h1) : 0.f, x2 = hb_ ? bf2f(h2) : 0.f;
#pragma unroll
            for (int t = 0; t < 64; ++t) { const float x3 = bf2f(raw[t]); const float v = w0 * x0 + w1 * x1 + w2 * x2 + w3 * x3; if (PARTS & 32) dst[t * G_LD] = v; else if (PARTS & 128) { pacc += siluf(v); if ((t & 15) == 15) dst[t * G_LD] = pacc; } else dst[t * G_LD] = siluf(v); x0 = x1; x1 = x2; x2 = x3; } }
        if ((PARTS & 1) && !(PARTS & 64) && tid >= 448) { const int t = tid - 448; const float* r16 = OKP(float, WS_RAW16) + (row0 + t) * 16;
            g_s[t] = -expf(F.in[I_OD_ALOG][hd]) * softplusf(r16[hd] + F.in[I_OD_DTB][hd]); beta_s[t] = sigmoidf_(r16[8 + hd]); }
        LDS_BARRIER();
        if (!(PARTS & 1) || (PARTS & 64)) {} else if (wave == 0) { float v = g_s[lane];
#pragma unroll
            for (int o = 1; o < 64; o <<= 1) { const float n = __shfl_up(v, o); if (lane >= o) v += n; }
            gc_s[lane] = v; eg_s[lane] = fexp(v); if (lane == 63) OKP(float, WS_GDEC)[ub] = fexp(v); }
        else if (wave <= 2) { const LAS float* src = (wave == 1 ? q_s : k_s) + lane * G_LD; float s = 0.f;
#pragma unroll 8
            for (int d = 0; d < 128; d += 4) { const f32x4 x = *(const LAS f32x4*)(src + d); s += (x.x * x.x + x.y * x.y) + (x.z * x.z + x.w * x.w); }
            const float r = frsq(s + EPS); if (wave == 1) rq_s[lane] = r * 0.08838834764831845f; else rk_s[lane] = r; }
        LDS_BARRIER();
        if (PARTS & 2)
        { const float gl = gc_s[63];
          for (int i = tid; i < 64 * 64; i += NT) { const int t = i >> 6, dp = (i & 63) * 2; const float rk = rk_s[t], rq = rq_s[t], eg = eg_s[t];
              const float k0 = k_s[t * G_LD + dp] * rk, k1 = k_s[t * G_LD + dp + 1] * rk, q0 = q_s[t * G_LD + dp] * rq, q1 = q_s[t * G_LD + dp + 1] * rq;
              *(LAS unsigned*)(Kn + t * GB_LD + dp) = cvt_pk_bf16(k0, k1); *(LAS unsigned*)(Qn + t * GB_LD + dp) = cvt_pk_bf16(q0, q1);
              *(unsigned*)(OKP(bf16_t, WS_GQD) + ub * 8192 + t * 128 + dp) = cvt_pk_bf16(q0 * eg, q1 * eg); }
          { const int t = tid & 63, dg = tid >> 6; const float f = rk_s[t] * fexp(gl - gc_s[t]); bf16_t* dst = OKP(bf16_t, WS_GKDT) + ub * 8192 + t;
#pragma unroll
            for (int j = 0; j < 16; ++j) { const int d = dg * 16 + j; dst[d * 64] = (bf16_t)(cvt_pk_bf16(k_s[t * G_LD + d] * f, 0.f) & 0xffffu); } } }
        LDS_BARRIER();
        if (PARTS & 4)
#pragma unroll
        for (int i = 0; i < 4; ++i) { const int tl = wave * 4 + i, which = tl >> 4, ti = (tl >> 2) & 3, si = tl & 3;
            f32x4 acc = {0.f, 0.f, 0.f, 0.f};
            if (si <= ti) {
#pragma unroll
                for (int ks = 0; ks < 4; ++ks) { const bf16x8 a = *(const LAS bf16x8*)(Kn + (si * 16 + fr) * GB_LD + ks * 32 + fq * 8); const bf16x8 bb = *(const LAS bf16x8*)((which ? Qn : Kn) + (ti * 16 + fr) * GB_LD + ks * 32 + fq * 8); acc = mfma16(a, bb, acc); }
                const int t = ti * 16 + fr; const float gt = gc_s[t], bt = beta_s[t];
#pragma unroll
                for (int r = 0; r < 4; ++r) { const int s = si * 16 + 4 * fq + r; const float dec = fexp(gt - gc_s[s]); acc[r] = which ? (s <= t ? acc[r] * dec : 0.f) : (s < t ? acc[r] * dec * bt : 0.f); } }
            const int t = ti * 16 + fr, s0 = si * 16 + 4 * fq;
            if (which) { u32x2 w; w.x = cvt_pk_bf16(acc[0], acc[1]); w.y = cvt_pk_bf16(acc[2], acc[3]); *(u32x2*)(OKP(bf16_t, WS_GAQK) + ub * 4096 + t * 64 + s0) = w; }
            else { Lm[(s0 + 0) * LM_LD + t] = acc[0]; Lm[(s0 + 1) * LM_LD + t] = acc[1]; Lm[(s0 + 2) * LM_LD + t] = acc[2]; Lm[(s0 + 3) * LM_LD + t] = acc[3];
                u32x2 w; w.x = cvt_pk_bf16(acc[0], acc[1]); w.y = cvt_pk_bf16(acc[2], acc[3]); *(LAS u32x2*)(Lb16 + t * LB_LD + s0) = w; } }
        LDS_BARRIER();
        if (PARTS & 8) {
            for (int i = tid; i < 64 * 128; i += NT) { const int t = i >> 7, cc = i & 127; const float bt = beta_s[t]; v_s[t * G_LD + cc] *= bt; k_s[t * G_LD + cc] *= bt * rk_s[t] * eg_s[t]; }
            LDS_BARRIER();
#pragma unroll
            for (int ib = 0; ib < 4; ++ib) {
                if (ib > 0) {
#pragma unroll
                    for (int ct2 = 0; ct2 < 2; ++ct2) { const int ct = wave * 2 + ct2; f32x4 acc = {0.f, 0.f, 0.f, 0.f};
#pragma unroll
                        for (int ks = 0; ks < (ib * 16 + 31) / 32; ++ks) { const LAS bf16_t* lp = Lb16 + (ib * 16 + fr) * LB_LD + ks * 32 + fq * 8; u32x4 la = *(const LAS u32x4*)lp;
                            if (ks * 32 + fq * 8 >= ib * 16) la = (u32x4){0u, 0u, 0u, 0u};
                            const LAS bf16_t* xp = XT + (ct * 16 + fr) * XT_LD2 + ks * 32 + fq * 8; const u32x2 x0 = *(const LAS u32x2*)xp, x1 = *(const LAS u32x2*)(xp + 4); u32x4 xb; xb.x = x0.x; xb.y = x0.y; xb.z = x1.x; xb.w = x1.y;
                            if (ks * 32 + fq * 8 >= ib * 16) xb = (u32x4){0u, 0u, 0u, 0u};
                            acc = mfma16(__builtin_bit_cast(bf16x8, la), __builtin_bit_cast(bf16x8, xb), acc); }
                        LAS float* rp = (ct < 8 ? v_s : k_s) + (ib * 16 + 4 * fq) * G_LD + (ct & 7) * 16 + fr;
#pragma unroll
                        for (int r = 0; r < 4; ++r) rp[r * G_LD] -= acc[r]; }
                    LDS_BARRIER(); }
                if (tid < 256) { const int cidx = tid & 127; const bool isw = tid >= 128; const LAS float* col = (isw ? k_s : v_s) + cidx; bf16_t* dst = OKP(bf16_t, isw ? WS_GW : WS_GU) + ub * 8192 + (isw ? cidx : cidx * 4);
                    float a[16];
#pragma unroll
                    for (int tt = 0; tt < 16; ++tt) a[tt] = col[(ib * 16 + tt) * G_LD];
#pragma unroll
                    for (int ss = 0; ss < 16; ++ss) { const float xv = a[ss]; const LAS f32x4* lp = (const LAS f32x4*)(Lm + (ib * 16 + ss) * LM_LD + ib * 16);
#pragma unroll
                        for (int q4 = ss / 4; q4 < 4; ++q4) { const f32x4 l4 = lp[q4];
#pragma unroll
                            for (int r = 0; r < 4; ++r) if (q4 * 4 + r > ss) a[q4 * 4 + r] -= l4[r] * xv; } }
                    LAS bf16_t* xt = XT + tid * XT_LD2 + ib * 16;
#pragma unroll
                    for (int q4 = 0; q4 < 4; ++q4) { u32x2 w; w.x = cvt_pk_bf16(a[q4 * 4], a[q4 * 4 + 1]); w.y = cvt_pk_bf16(a[q4 * 4 + 2], a[q4 * 4 + 3]); *(LAS u32x2*)(xt + q4 * 4) = w;
                        if (!isw) *(u32x2*)(dst + (size_t)(ib * 4 + q4) * 512) = w; }
                    if (isw) {
#pragma unroll
                        for (int ss = 0; ss < 16; ++ss) dst[(ib * 16 + ss) * 128] = (bf16_t)(cvt_pk_bf16(a[ss], 0.f) & 0xffffu); } }
                if (ib < 3) LDS_BARRIER();
            }
        }
    }
}
}

namespace ok {
constexpr int ST_LD = 136, VT_LD = 72;
__device__ __forceinline__ void phase_gdn_prep(const Frame& F0) { phase_gdn_prep_t<15>(F0); }
constexpr int GJT = 4, GDV = GJT * 16, GN_UNITS = NB * 8 * (128 / GDV);
static_assert(GJT == 4, "the Z slot below is sized for four column tiles");
struct GdnEarly { bf16x8 X[4]; u32x2 Z[4]; };
struct GdnLate { bf16x8 Kf[2]; float dec; };
__device__ __forceinline__ void gdn_load_early(GdnEarly& g, const Frame& F, size_t xoff, size_t ub, int ti, int sl, int fr, int fq, int roleB) {
    const bf16_t* Xp = (const bf16_t*)(F.ws + xoff) + ub * 8192 + (ti * 16 + fr) * 128 + fq * 8;
#pragma unroll
    for (int ks = 0; ks < 4; ++ks) g.X[ks] = *(const bf16x8*)(Xp + ks * 32);
    const bf16_t* zb = roleB ? OKP(bf16_t, WS_GAQK) + ub * 4096 + (ti * 16 + fr) * 64 + fq * 8 : OKP(bf16_t, WS_GU) + ub * 8192 + ((size_t)(ti * 4 + fq) * 128 + sl * GDV + fr) * 4;
#pragma unroll
    for (int i = 0; i < 4; ++i) g.Z[i] = *(const u32x2*)(zb + (roleB ? (i >> 1) * 32 + (i & 1) * 4 : i * 64));
}
__device__ __forceinline__ void gdn_load_late(GdnLate& g, const Frame& F, size_t ub, int ti, int wave, int fr, int fq, int vzero) {
    const bf16_t* Kp = OKP(bf16_t, WS_GKDT) + ub * 8192 + (wave * 16 + fr) * 64 + fq * 8;
#pragma unroll
    for (int k2 = 0; k2 < 2; ++k2) g.Kf[k2] = *(const bf16x8*)(Kp + k2 * 32);
    g.dec = OKP(float, WS_GDEC)[ub + vzero];
}
constexpr int OS_LD = GDV + 8;
__device__ __forceinline__ void gdn_flush_o(const Frame& F, const LAS bf16_t* Os, int b, int cprev, int hd, int sl) {
    constexpr int PCS = GDV / 8;
    if (F.tid < 64 * PCS) { const int row = F.tid / PCS, pc = F.tid % PCS; *(u32x4*)(OKP(bf16_t, WS_OBUF) + ((size_t)b * L + cprev * 64 + row) * 1024 + hd * 128 + sl * GDV + pc * 8) = *(const LAS u32x4*)(Os + row * OS_LD + pc * 8); }
}
__device__ __forceinline__ void gdn_step(const Frame& F, const GdnEarly& g, const GdnLate& h, f32x4 (&Sacc)[GJT], LAS bf16_t* ST0, LAS bf16_t* VnT, int par, int roleB, int b, int c, int hd, int sl, int ti, int wave, int fr, int fq) {
    LAS bf16_t* ST = ST0 + par * (GDV * ST_LD); LAS bf16_t* STn = ST0 + (par ^ 1) * (GDV * ST_LD);
    LAS bf16_t* Os = VnT + GDV * VT_LD;
    LDS_BARRIER();
    if (c > 0) gdn_flush_o(F, Os, b, c - 1, hd, sl);
    f32x4 a[GJT];
#pragma unroll
    for (int ji = 0; ji < GJT; ++ji) a[ji] = (f32x4){0.f, 0.f, 0.f, 0.f};
#pragma unroll
    for (int ks = 0; ks < 4; ++ks)
#pragma unroll
        for (int ji = 0; ji < GJT; ++ji) { const bf16x8 sf = *(const LAS bf16x8*)(ST + (ji * 16 + fr) * ST_LD + ks * 32 + fq * 8); a[ji] = mfma16(g.X[ks], sf, a[ji]); }
    if (!roleB) {
#pragma unroll
        for (int ji = 0; ji < GJT; ++ji) { const u32x2 uv = g.Z[ji]; u32x2 w; w.x = cvt_pk_bf16(bflo(uv.x) - a[ji][0], bfhi(uv.x) - a[ji][1]); w.y = cvt_pk_bf16(bflo(uv.y) - a[ji][2], bfhi(uv.y) - a[ji][3]);
            *(LAS u32x2*)(VnT + (ji * 16 + fr) * VT_LD + ti * 16 + 4 * fq) = w; } }
    LDS_BARRIER();
#pragma unroll
    for (int ji = 0; ji < GJT; ++ji) { bf16x8 vf[2];
#pragma unroll
        for (int k2 = 0; k2 < 2; ++k2) vf[k2] = *(const LAS bf16x8*)(VnT + (ji * 16 + fr) * VT_LD + k2 * 32 + fq * 8);
        if (roleB) {
#pragma unroll
            for (int k2 = 0; k2 < 2; ++k2) { u32x4 af; af.x = g.Z[2 * k2].x; af.y = g.Z[2 * k2].y; af.z = g.Z[2 * k2 + 1].x; af.w = g.Z[2 * k2 + 1].y; a[ji] = mfma16(__builtin_bit_cast(bf16x8, af), vf[k2], a[ji]); }
            LAS bf16_t* op = Os + (ti * 16 + 4 * fq) * OS_LD + ji * 16 + fr;
#pragma unroll
            for (int r = 0; r < 4; ++r) op[r * OS_LD] = (bf16_t)(cvt_pk_bf16(a[ji][r], 0.f) & 0xffffu); }
        Sacc[ji] *= h.dec;
#pragma unroll
        for (int k2 = 0; k2 < 2; ++k2) Sacc[ji] = mfma16(h.Kf[k2], vf[k2], Sacc[ji]);
        u32x2 w; w.x = cvt_pk_bf16(Sacc[ji][0], Sacc[ji][1]); w.y = cvt_pk_bf16(Sacc[ji][2], Sacc[ji][3]); *(LAS u32x2*)(STn + (ji * 16 + fr) * ST_LD + wave * 16 + 4 * fq) = w; }
}
template <int MODE  > __device__ __forceinline__ void gdn_scan_unit_t(const Frame& F, int unit) {
    LAS bf16_t* ST = (LAS bf16_t*)F.lds; LAS bf16_t* VnT = (LAS bf16_t*)(F.lds + 2 * GDV * ST_LD * 2);
    const int tid = F.tid, lane = F.lane, wave = F.wave, fr = lane & 15, fq = lane >> 4;
    constexpr int NSL = 128 / GDV;
    const int sl = unit % NSL, hd = (unit / NSL) & 7, b = unit / (NSL * 8), ti = wave & 3, roleB = wave >> 2;
    for (int i = tid; i < GDV * ST_LD / 2; i += NT) ((LAS unsigned*)ST)[i] = 0u;
    f32x4 Sacc[GJT];
#pragma unroll
    for (int ji = 0; ji < GJT; ++ji) Sacc[ji] = (f32x4){0.f, 0.f, 0.f, 0.f};
    const size_t ub0 = ((size_t)b * NCH) * 8 + hd; const size_t xoff = roleB ? WS_GQD : WS_GW;
    int vzero = 0;
#ifndef CPU_EMU
    asm volatile("" : "+v"(vzero));
#endif
#define GDN_LE(set, cc) if (MODE == 0) gdn_load_early(set, F, xoff, ub0 + (size_t)((cc) < NCH ? (cc) : NCH - 1) * 8, ti, sl, fr, fq, roleB)
#define GDN_LL(set, cc) if (MODE == 0) gdn_load_late(set, F, ub0 + (size_t)((cc) < NCH ? (cc) : NCH - 1) * 8, ti, wave, fr, fq, vzero)
#define GDN_ST(es, ls, cc, par) gdn_step(F, es, ls, Sacc, ST, VnT, par, roleB, b, (MODE == 0 ? (cc) : 0), hd, sl, ti, wave, fr, fq)
    GdnEarly e0, e1, e2; GdnLate l0, l1;
    GDN_LE(e0, 0); GDN_LE(e1, 1); GDN_LL(l0, 0);
    if (MODE == 1) { gdn_load_early(e0, F, xoff, ub0, ti, sl, fr, fq, roleB); gdn_load_early(e1, F, xoff, ub0, ti, sl, fr, fq, roleB); gdn_load_early(e2, F, xoff, ub0, ti, sl, fr, fq, roleB); gdn_load_late(l0, F, ub0, ti, wave, fr, fq, vzero); gdn_load_late(l1, F, ub0, ti, wave, fr, fq, vzero); }
    int c = 0;
    for (; c + 6 <= NCH; c += 6) {
        GDN_LE(e2, c + 2); GDN_LL(l1, c + 1); GDN_ST(e0, l0, c + 0, 0);
        GDN_LE(e0, c + 3); GDN_LL(l0, c + 2); GDN_ST(e1, l1, c + 1, 1);
        GDN_LE(e1, c + 4); GDN_LL(l1, c + 3); GDN_ST(e2, l0, c + 2, 0);
        GDN_LE(e2, c + 5); GDN_LL(l0, c + 4); GDN_ST(e0, l1, c + 3, 1);
        GDN_LE(e0, c + 6); GDN_LL(l1, c + 5); GDN_ST(e1, l0, c + 4, 0);
        GDN_LE(e1, c + 7); GDN_LL(l0, c + 6); GDN_ST(e2, l1, c + 5, 1);
    }
    if (c + 0 < NCH) { GDN_LE(e2, c + 2); GDN_LL(l1, c + 1); GDN_ST(e0, l0, c + 0, 0); }
    if (c + 1 < NCH) { GDN_LE(e0, c + 3); GDN_LL(l0, c + 2); GDN_ST(e1, l1, c + 1, 1); }
    if (c + 2 < NCH) { GDN_LE(e1, c + 4); GDN_LL(l1, c + 3); GDN_ST(e2, l0, c + 2, 0); }
    if (c + 3 < NCH) { GDN_LE(e2, c + 5); GDN_LL(l0, c + 4); GDN_ST(e0, l1, c + 3, 1); }
    if (c + 4 < NCH) { GDN_LE(e0, c + 6); GDN_LL(l1, c + 5); GDN_ST(e1, l0, c + 4, 0); }
#undef GDN_LE
#undef GDN_LL
#undef GDN_ST
    LDS_BARRIER();
    if (MODE == 0) gdn_flush_o(F, VnT + GDV * VT_LD, b, NCH - 1, hd, sl);
}
__device__ __forceinline__ void gdn_scan_unit(const Frame& F, int unit) { gdn_scan_unit_t<0>(F, unit); }
__device__ __forceinline__ void phase_gdn_final(const Frame& F0) {
    using namespace sm;
    const Frame F = phase_frame(F0);
    const int lane = F.lane; const int gw = F.vcu * NWAVES + F.wave, NGW = F.G * NWAVES;
    const f32x4* nw4 = (const f32x4*)(F.in[I_OD_NORM] + (lane & 7) * 16);
    u32x4 na[2], nz[2]; { const int t = gw < T ? gw : 0; const u32x4* op = (const u32x4*)(OKP(bf16_t, WS_OBUF) + (size_t)t * 1024 + lane * 16); const u32x4* zp = (const u32x4*)(OKP(bf16_t, WS_PROJ) + (size_t)t * PROJ1_LD + 3072 + lane * 16); na[0] = op[0]; na[1] = op[1]; nz[0] = zp[0]; nz[1] = zp[1]; }
    for (int t = gw; t < T; t += NGW) { const u32x4 ca[2] = {na[0], na[1]}, cz[2] = {nz[0], nz[1]};
        { const int tn = t + NGW < T ? t + NGW : t; const u32x4* op = (const u32x4*)(OKP(bf16_t, WS_OBUF) + (size_t)tn * 1024 + lane * 16); const u32x4* zp = (const u32x4*)(OKP(bf16_t, WS_PROJ) + (size_t)tn * PROJ1_LD + 3072 + lane * 16); na[0] = op[0]; na[1] = op[1]; nz[0] = zp[0]; nz[1] = zp[1]; }
        float o[16], z[16];
#pragma unroll
        for (int h2 = 0; h2 < 2; ++h2) { const u32x4 a = ca[h2], zz = cz[h2];
            o[h2 * 8 + 0] = bflo(a.x); o[h2 * 8 + 1] = bfhi(a.x); o[h2 * 8 + 2] = bflo(a.y); o[h2 * 8 + 3] = bfhi(a.y); o[h2 * 8 + 4] = bflo(a.z); o[h2 * 8 + 5] = bfhi(a.z); o[h2 * 8 + 6] = bflo(a.w); o[h2 * 8 + 7] = bfhi(a.w);
            z[h2 * 8 + 0] = bflo(zz.x); z[h2 * 8 + 1] = bfhi(zz.x); z[h2 * 8 + 2] = bflo(zz.y); z[h2 * 8 + 3] = bfhi(zz.y); z[h2 * 8 + 4] = bflo(zz.z); z[h2 * 8 + 5] = bfhi(zz.z); z[h2 * 8 + 6] = bflo(zz.w); z[h2 * 8 + 7] = bfhi(zz.w); }
        float s = 0.f;
#pragma unroll
        for (int i = 0; i < 16; ++i) s += o[i] * o[i];
        s += __shfl_xor(s, 1); s += __shfl_xor(s, 2); s += __shfl_xor(s, 4);
        const float rs = frsq(s * (1.f / 128.f) + EPS);
        u32x4 w[2];
#pragma unroll
        for (int h2 = 0; h2 < 2; ++h2) { const f32x4 n0 = nw4[h2 * 2], n1 = nw4[h2 * 2 + 1]; float y[8];
#pragma unroll
            for (int i = 0; i < 8; ++i) y[i] = o[h2 * 8 + i] * rs * (i < 4 ? n0[i] : n1[i - 4]) * siluf(z[h2 * 8 + i]);
            w[h2].x = cvt_pk_bf16(y[0], y[1]); w[h2].y = cvt_pk_bf16(y[2], y[3]); w[h2].z = cvt_pk_bf16(y[4], y[5]); w[h2].w = cvt_pk_bf16(y[6], y[7]); }
        u32x4* cp = (u32x4*)(OKP(bf16_t, WS_CAT1) + (size_t)t * 1536 + lane * 16); cp[0] = w[0]; cp[1] = w[1]; }
}
}

#ifndef DUP_MASK
#define DUP_MASK 0
#endif
namespace ok {
constexpr int SB_LD = 72;
#ifdef CPU_EMU
#define WAVE_ALL(p) (wave_sum((p) ? 1.f : 0.f) == 64.f)
#else
#define WAVE_ALL(p) (__all(p))
#endif
__device__ __forceinline__ void sb_unit(const Frame& F, int unit) {
    LAS bf16_t* Kt = (LAS bf16_t*)F.lds; LAS bf16_t* VT = (LAS bf16_t*)(F.lds + 64 * SB_LD * 2); volatile LAS int* votes = (volatile LAS int*)(F.lds + 2 * 64 * SB_LD * 2);
    const int tid = F.tid, lane = F.lane, wave = F.wave, fr = lane & 15, fq = lane >> 4;
    const int nqb = L / 128, qb = unit % nqb, hd = (unit / nqb) & 7, b = unit / (nqb * 8), q0 = qb * 128;
    const bf16_t* proj = OKP(bf16_t, WS_PROJ) + (size_t)b * L * PROJ1_LD;
    const int qrow = q0 + wave * 16 + fr;
    bf16x8 qf[2];
#pragma unroll
    for (int ks = 0; ks < 2; ++ks) qf[ks] = *(const bf16x8*)(proj + (size_t)qrow * PROJ1_LD + 4096 + hd * 64 + ks * 32 + fq * 8);
    f32x4 o[4] = {{0.f, 0.f, 0.f, 0.f}, {0.f, 0.f, 0.f, 0.f}, {0.f, 0.f, 0.f, 0.f}, {0.f, 0.f, 0.f, 0.f}};
    float C = 1.f; bool wdone = false;
    const int key_l = tid >> 3, c8 = tid & 7;
    int kt = 2 * qb + 1;
    u32x4 kreg = *(const u32x4*)(proj + (size_t)(kt * 64 + key_l) * PROJ1_LD + 4608 + hd * 64 + c8 * 8), vreg = *(const u32x4*)(proj + (size_t)(kt * 64 + key_l) * PROJ1_LD + 5120 + hd * 64 + c8 * 8);
    for (; kt >= 0; --kt) {
        LDS_BARRIER();
        *(LAS u32x4*)(Kt + key_l * SB_LD + c8 * 8) = kreg;
        { LAS bf16_t* vp = VT + (c8 * 8) * SB_LD + key_l; vp[0] = (bf16_t)(vreg.x & 0xffffu); vp[SB_LD] = (bf16_t)(vreg.x >> 16); vp[2 * SB_LD] = (bf16_t)(vreg.y & 0xffffu); vp[3 * SB_LD] = (bf16_t)(vreg.y >> 16);
          vp[4 * SB_LD] = (bf16_t)(vreg.z & 0xffffu); vp[5 * SB_LD] = (bf16_t)(vreg.z >> 16); vp[6 * SB_LD] = (bf16_t)(vreg.w & 0xffffu); vp[7 * SB_LD] = (bf16_t)(vreg.w >> 16); }
        if (lane == 0) votes[wave] = wdone ? 1 : 0;
        LDS_BARRIER();
        { int all = 1;
#pragma unroll
          for (int w = 0; w < 8; ++w) all &= votes[w];
          if (all) break; }
        if (kt > 0) { kreg = *(const u32x4*)(proj + (size_t)((kt - 1) * 64 + key_l) * PROJ1_LD + 4608 + hd * 64 + c8 * 8); vreg = *(const u32x4*)(proj + (size_t)((kt - 1) * 64 + key_l) * PROJ1_LD + 5120 + hd * 64 + c8 * 8); }
        const int key0 = kt * 64;
#ifdef SB_COUNT_ITERS
        ++g_iters;
#endif
        if (!wdone && key0 < q0 + wave * 16 + 16) {
            f32x4 x[4];
#pragma unroll
            for (int k16 = 0; k16 < 4; ++k16) { x[k16] = (f32x4){0.f, 0.f, 0.f, 0.f};
#pragma unroll
                for (int ks = 0; ks < 2; ++ks) { const bf16x8 kf = *(const LAS bf16x8*)(Kt + (k16 * 16 + fr) * SB_LD + ks * 32 + fq * 8); x[k16] = mfma16(kf, qf[ks], x[k16]); } }
            const bool need_mask = key0 + 63 >= q0 + wave * 16;
            float Rr[4], Tt[4], Ee[4];
#pragma unroll
            for (int k16 = 0; k16 < 4; ++k16) {
#pragma unroll
                for (int r = 0; r < 4; ++r) { const float e = fexp2(fminf(x[k16][r], 80.f)); float rr = frcp(1.f + e), bet = e * rr;
                    if (need_mask && key0 + k16 * 16 + 4 * fq + r >= qrow) { rr = 1.f; bet = 0.f; }
                    x[k16][r] = bet; Rr[k16] = (r == 0) ? rr : Rr[k16];
                    if (r == 0) Tt[k16] = rr; else if (r == 1) Ee[k16] = rr; else if (r == 2) Rr[k16] = rr; else {
                        const float r0 = Tt[k16], r1 = Ee[k16], r2 = Rr[k16], r3 = rr; const float s2 = r3, s1 = r3 * r2, s0 = s1 * r1;
                        x[k16][0] *= s0; x[k16][1] *= s1; x[k16][2] *= s2;
                        Rr[k16] = s0 * r0; } } }
#pragma unroll
            for (int k16 = 0; k16 < 4; ++k16) { const float R = Rr[k16]; const float d1 = __shfl_down(R, 16), d2 = __shfl_down(R, 32), d3 = __shfl_down(R, 48);
                Ee[k16] = (fq < 3 ? d1 : 1.f) * (fq < 2 ? d2 : 1.f) * (fq < 1 ? d3 : 1.f); float t = R; t *= __shfl_xor(t, 16); t *= __shfl_xor(t, 32); Tt[k16] = t; }
            const float TT2 = Tt[3], TT1 = Tt[3] * Tt[2], TT0 = TT1 * Tt[1];
            const float f0 = Ee[0] * TT0 * C, f1 = Ee[1] * TT1 * C, f2 = Ee[2] * TT2 * C, f3 = Ee[3] * C;
            x[0] *= f0; x[1] *= f1; x[2] *= f2; x[3] *= f3;
            C *= TT0 * Tt[0];
            bf16x8 pw[2];
#pragma unroll
            for (int j = 0; j < 2; ++j) { u32x4 p; p.x = cvt_pk_bf16(x[2 * j][0], x[2 * j][1]); p.y = cvt_pk_bf16(x[2 * j][2], x[2 * j][3]); p.z = cvt_pk_bf16(x[2 * j + 1][0], x[2 * j + 1][1]); p.w = cvt_pk_bf16(x[2 * j + 1][2], x[2 * j + 1][3]); pw[j] = __builtin_bit_cast(bf16x8, p); }
#pragma unroll
            for (int dt = 0; dt < 4; ++dt)
#pragma unroll
                for (int j = 0; j < 2; ++j) { const LAS bf16_t* vp = VT + (dt * 16 + fr) * SB_LD + j * 32 + 4 * fq; const u32x2 lo = *(const LAS u32x2*)vp, hi = *(const LAS u32x2*)(vp + 16);
                    u32x4 a; a.x = lo.x; a.y = lo.y; a.z = hi.x; a.w = hi.y; o[dt] = mfma16(__builtin_bit_cast(bf16x8, a), pw[j], o[dt]); }
            wdone = WAVE_ALL(C < 7.8886e-31f);
        }
    }
    bf16_t* op = OKP(bf16_t, WS_CAT1) + ((size_t)b * L + qrow) * 1536 + 1024 + hd * 64 + 4 * fq;
#pragma unroll
    for (int dt = 0; dt < 4; ++dt) { u32x2 w; w.x = cvt_pk_bf16(o[dt][0], o[dt][1]); w.y = cvt_pk_bf16(o[dt][2], o[dt][3]); *(u32x2*)(op + dt * 16) = w; }
}
__device__ __forceinline__ void phase_l1_mix(const Frame& F0) {
    const Frame F = phase_frame(F0);
    constexpr int NU = GN_UNITS, UPX = NU / 8;
    if (F.G < 128 || F.G % 8 != 0) { if (F.vcu == 0) for (int u = 0; u < NU; ++u) { gdn_scan_unit(F, u); __syncthreads(); } for (int u = F.vcu; u < NB * 8 * (L / 128); u += F.G) { sb_unit(F, u); __syncthreads(); } return; }
    const int per = F.G / 8, xcd = F.vcu / per, loc = F.vcu % per;
    if (loc < UPX) { gdn_scan_unit(F, xcd * UPX + loc);
#if (DUP_MASK >> 3) & 1
        __syncthreads(); gdn_scan_unit(F, xcd * UPX + loc);
#endif
#if (DUP_MASK >> 21) & 1
        __syncthreads(); gdn_scan_unit_t<1>(F, xcd * UPX + loc);
#endif
    }
    else for (int rep = 0; rep < 1 + ((DUP_MASK >> 16) & 1); ++rep) for (int u = xcd * (per - UPX) + (loc - UPX); u < NB * 8 * (L / 128); u += F.G - NU) { sb_unit(F, u); __syncthreads(); }
}
}

namespace ok {
#if CHECK
__device__ const int kSampleRows[16] = {0, 1, 2, 3, 63, 64, 127, 128, 129, 1000, 2047, 2048, 4097, 6000, 8190, 8191};
constexpr int FP_W = 6144;
__device__ __forceinline__ void fp_save(const Frame& F, int k, const void* buf, int ld, int width, bool is_bf16, int dcol0) {
    float* fp = OKP(float, WS_FP) + (size_t)k * 16 * FP_W; const size_t gt = (size_t)blockIdx.x * NT + F.tid, GT = (size_t)F.G * NT;
    for (size_t i = gt; i < (size_t)16 * width; i += GT) { const int r = (int)(i / width), c = (int)(i % width); const size_t src = (size_t)kSampleRows[r] * ld + c;
        fp[r * FP_W + dcol0 + c] = is_bf16 ? bf2f(((const bf16_t*)buf)[src]) : ((const float*)buf)[src]; }
}
__device__ __forceinline__ void fp_cmp(const Frame& F, int k, const float* obuf, int ld, int ocol0, int width, int fcol0) {
    const float* fp = OKP(float, WS_FP) + (size_t)k * 16 * FP_W; const size_t gt = (size_t)blockIdx.x * NT + F.tid, GT = (size_t)F.G * NT; float num = 0.f, den = 0.f;
    for (size_t i = gt; i < (size_t)16 * width; i += GT) { const int r = (int)(i / width), c = (int)(i % width); const float o = obuf[(size_t)kSampleRows[r] * ld + ocol0 + c], f = fp[r * FP_W + fcol0 + c];
        const float d = o - f; num += d * d; den += o * o; if (!(d == d)) num += 1e30f; }
    num = wave_sum(num); den = wave_sum(den);
    if (F.lane == 0 && (num != 0.f || den != 0.f)) { atomicAdd((float*)F.ctl + CW_CHK + 2 * k, num); atomicAdd((float*)F.ctl + CW_CHK + 2 * k + 1, den); }
}
__device__ __forceinline__ void fp_save_lin(const Frame& F, int k, const void* buf, size_t off, int n, bool is_bf16) {
    float* fp = OKP(float, WS_FP) + (size_t)k * 16 * FP_W; const size_t gt = (size_t)blockIdx.x * NT + F.tid, GT = (size_t)F.G * NT;
    for (size_t i = gt; i < (size_t)n; i += GT) fp[i] = is_bf16 ? bf2f(((const bf16_t*)buf)[off + i]) : ((const float*)buf)[off + i];
}
__device__ __forceinline__ void fp_cmp_lin(const Frame& F, int k, const float* obuf, size_t off, int n) {
    const float* fp = OKP(float, WS_FP) + (size_t)k * 16 * FP_W; const size_t gt = (size_t)blockIdx.x * NT + F.tid, GT = (size_t)F.G * NT; float num = 0.f, den = 0.f;
    for (size_t i = gt; i < (size_t)n; i += GT) { const float o = obuf[off + i], f = fp[i]; const float d = o - f; num += d * d; den += o * o; if (!(d == d)) num += 1e30f; }
    num = wave_sum(num); den = wave_sum(den);
    if (F.lane == 0 && (num != 0.f || den != 0.f)) { atomicAdd((float*)F.ctl + CW_CHK + 2 * k, num); atomicAdd((float*)F.ctl + CW_CHK + 2 * k + 1, den); }
}
#endif

struct Args { const float* in[33]; float* out; unsigned char* ws;
#if CHECK
    sm::Ctx oc;
#endif
};

__global__ void __launch_bounds__(512, 2) mk_fwd(Args a) {
    extern __shared__ __attribute__((aligned(16))) unsigned char lds_raw[];
    Frame F; F.lds = (LAS unsigned char*)lds_raw; F.ws = a.ws; F.ctl = (unsigned*)(a.ws + WS_CTL); F.in = a.in; F.out = a.out;
    F.tid = threadIdx.x; F.lane = F.tid & 63; F.wave = __builtin_amdgcn_readfirstlane(F.tid >> 6); F.G = gridDim.x;
    { const int bx = blockIdx.x; F.vcu = (F.G % 8 == 0) ? (bx % 8) * (F.G / 8) + bx / 8 : bx; }
    volatile LAS unsigned* MISC = (volatile LAS unsigned*)(F.lds + LDS_BYTES - 64);
    if (F.tid < 16) MISC[F.tid] = 0u;
    __syncthreads();
    XcdBarrier bar = xcd_barrier_post(F.ctl + CW_BAR, MISC);
#define GRID_BAR() xcd_barrier(bar)
    using namespace sm;
    for (int dup_p = 0; dup_p < ((DUP_MASK >> 5) & 1) + 1; ++dup_p) {
    phase_prologue(F);
    prologue_router_tables(F);
    prologue_w16_tables(F);
    GRID_BAR();
    }
    for (int dup_i0 = 0; dup_i0 < ((DUP_MASK >> 6) & 1) + 1; ++dup_i0) {
    { EpiScaleBf16 E{OKP(bf16_t, WS_PROJ), PROJ0_LD, (const float*)F.ctl + CW_SSQ, 1};
      dense_gemm(F, OKP(bf16_t, WS_HB), OKP(bf16_t, WS_W_IN0), T, 4096, 1024, E); }
    phase_proj16(F, 0, F.in[I_X], nullptr, (const float*)F.ctl + CW_SSQ, 1);
    GRID_BAR();
    }
#if CHECK
    fp_save(F, 0, OKP(bf16_t, WS_PROJ), PROJ0_LD, 4096, true, 0);
#endif
    for (int dup_b = 0; dup_b < ((DUP_MASK >> 1) & 1) + 1; ++dup_b) {
    for (int dup_b1 = 0; dup_b1 < ((DUP_MASK >> 14) & 1) + 1; ++dup_b1) { phase_ssd_a(F); GRID_BAR(); }
#if CHECK
    fp_save_lin(F, 6, OKP(bf16_t, WS_STATES), ((size_t)5 * 16 + 0) * 8192, 65536, true);
    GRID_BAR();
#endif
    phase_kv(F);
    phase_ssd_scan(F, (F.G >= 64 && F.G % 8 == 0) ? 32 : 0);
    GRID_BAR();
    for (int dup_b2 = 0; dup_b2 < ((DUP_MASK >> 15) & 1) + 1; ++dup_b2) { phase_ssd_b(F); GRID_BAR(); }
    }

    for (int dup_o0 = 0; dup_o0 < ((DUP_MASK >> 8) & 1) + 1; ++dup_o0) {
    { EpiResidualT<true> E{F.in[I_X], OKP(bf16_t, WS_HB), OKP(float, WS_SSQP1)};
      dense_gemm(F, OKP(bf16_t, WS_CAT0), OKP(bf16_t, WS_W_OUT0), T, 1024, 1536, E); }
    GRID_BAR();
    }
#if CHECK
    fp_save(F, 10, OKP(bf16_t, WS_HB), 1024, 1024, true, 0);
    fp_save_lin(F, 7, OKP(bf16_t, WS_STATES), ((size_t)5 * 16 + 0) * 8192, 65536, true);
    fp_save(F, 8, OKP(bf16_t, WS_CAT0), 1536, 512, true, 0);
    fp_save(F, 9, OKP(bf16_t, WS_CAT0) + 512, 1536, 1024, true, 0);
    GRID_BAR();
#endif
    for (int dup_q0 = 0; dup_q0 < ((DUP_MASK >> 9) & 1) + 1; ++dup_q0) {
    { EpiScaleBf16 E{OKP(bf16_t, WS_Q), 1024, OKP(float, WS_SSQP1), 16};
      dense_gemm(F, OKP(bf16_t, WS_HB), OKP(bf16_t, WS_W_XA), T, 1024, 1024, E); }
    GRID_BAR();
    }
    for (int dup_xa0 = 0; dup_xa0 < ((DUP_MASK >> 13) & 1) + 1; ++dup_xa0) {
    phase_xattn(F, OKP(bf16_t, WS_Q), OKP(bf16_t, WS_KX), OKP(bf16_t, WS_VT), OKP(bf16_t, WS_ATT));
    GRID_BAR();
    }
    { EpiResidualT<false> E{nullptr, OKP(bf16_t, WS_HB), OKP(float, WS_SSQP2)};
      dense_gemm(F, OKP(bf16_t, WS_ATT), OKP(bf16_t, WS_W_XA + 6 * MiB), T, 1024, 1024, E); }
    GRID_BAR();
#if CHECK
    fp_save(F, 11, OKP(bf16_t, WS_HB), 1024, 1024, true, 0);
    GRID_BAR();
#endif
    phase_router(F, 0, OKP(bf16_t, WS_HB), OKP(float, WS_SSQP2), 16);
    for (int dup_cv = 0; dup_cv < ((DUP_MASK >> 10) & 1) + 1; ++dup_cv) phase_cvt_moe(F, 0);
    GRID_BAR();
    for (int dup_sc = 0; dup_sc < ((DUP_MASK >> 11) & 1) + 1; ++dup_sc) {
    phase_scatter(F, 0, OKP(bf16_t, WS_HB), OKP(float, WS_SSQP2), 16);
    GRID_BAR();
    }
    for (int dup_c = 0; dup_c < ((DUP_MASK >> 2) & 1) + 1; ++dup_c) {
    phase_moe_up(F);
    GRID_BAR();
    phase_moe_down(F);
    GRID_BAR();
    }

    phase_combine(F, OKP(bf16_t, WS_HB), (float*)F.ctl + CW_SSQ + 3 * T, false);
    GRID_BAR();
#if CHECK
    fp_save(F, 12, OKP(bf16_t, WS_HB), 1024, 1024, true, 0);
    GRID_BAR();
#endif
    for (int dup_i1 = 0; dup_i1 < ((DUP_MASK >> 12) & 1) + 1; ++dup_i1) {
    { EpiScaleBf16 E{OKP(bf16_t, WS_PROJ), PROJ1_LD, (const float*)F.ctl + CW_SSQ + 3 * T, 1};
      dense_gemm(F, OKP(bf16_t, WS_HB), OKP(bf16_t, WS_W_IN1), T, 5632, 1024, E); }
    phase_proj16(F, 1, nullptr, OKP(bf16_t, WS_HB), (const float*)F.ctl + CW_SSQ + 3 * T, 1);
    GRID_BAR();
    }
#if CHECK
    fp_save(F, 13, OKP(bf16_t, WS_PROJ), PROJ1_LD, 4096, true, 0);
    fp_save(F, 13, OKP(bf16_t, WS_PROJ) + 4608, PROJ1_LD, 1024, true, 4096);
#endif
#if (DUP_MASK >> 22) & 255
    phase_gdn_prep_t<(DUP_MASK >> 22) & 255>(F); GRID_BAR();
#endif
    for (int dup_a = 0; dup_a < ((DUP_MASK >> 0) & 1) + 1; ++dup_a) { phase_gdn_prep(F); GRID_BAR(); }
    phase_l1_mix(F); GRID_BAR();
    for (int dup_e = 0; dup_e < ((DUP_MASK >> 4) & 1) + 1; ++dup_e) { phase_gdn_final(F); GRID_BAR(); }

    { EpiResidualT<false> E{nullptr, OKP(bf16_t, WS_HB), OKP(float, WS_SSQP4)};
      dense_gemm(F, OKP(bf16_t, WS_CAT1), OKP(bf16_t, WS_W_OUT1), T, 1024, 1536, E); }
    GRID_BAR();
#if CHECK
    fp_save(F, 14, OKP(bf16_t, WS_CAT1), 1536, 1024, true, 0);
    fp_save(F, 15, OKP(bf16_t, WS_CAT1) + 1024, 1536, 512, true, 0);
    fp_save(F, 16, OKP(bf16_t, WS_HB), 1024, 1024, true, 0);
    GRID_BAR();
#endif
    { EpiScaleBf16 E{OKP(bf16_t, WS_Q), 1024, OKP(float, WS_SSQP4), 16};
      dense_gemm(F, OKP(bf16_t, WS_HB), OKP(bf16_t, WS_W_XA + 8 * MiB), T, 1024, 1024, E); }
    GRID_BAR();
    phase_xattn(F, OKP(bf16_t, WS_Q), OKP(bf16_t, WS_KX) + (size_t)NB * 256 * 1024, OKP(bf16_t, WS_VT) + (size_t)1024 * NB * 256, OKP(bf16_t, WS_ATT));
    GRID_BAR();
    { EpiResidualT<false> E{nullptr, OKP(bf16_t, WS_HB), OKP(float, WS_SSQP5)};
      dense_gemm(F, OKP(bf16_t, WS_ATT), OKP(bf16_t, WS_W_XA + 8 * MiB + 6 * MiB), T, 1024, 1024, E); }
    GRID_BAR();
#if CHECK
    fp_save(F, 17, OKP(bf16_t, WS_HB), 1024, 1024, true, 0);
    GRID_BAR();
#endif
    phase_router(F, 1, OKP(bf16_t, WS_HB), OKP(float, WS_SSQP5), 16);
    phase_cvt_moe(F, 1);
    GRID_BAR();
    phase_scatter(F, 1, OKP(bf16_t, WS_HB), OKP(float, WS_SSQP5), 16);
    GRID_BAR();
    phase_moe_up(F);
    GRID_BAR();
    phase_moe_down(F);
    GRID_BAR();
    phase_combine(F, OKP(bf16_t, WS_HB), nullptr, true);
#if CHECK
    GRID_BAR();
    fp_save(F, 18, F.out, 1024, 1024, false, 0);
    fp_save(F, 1, OKP(float, WS_DTV), 16, 16, false, 0);
    fp_save(F, 2, OKP(float, WS_ACS), 16, 16, false, 0);
    GRID_BAR();
    {
        const size_t gid = (size_t)blockIdx.x * NT + F.tid, gs = (size_t)F.G * NT;
        for (int st = 0;; ++st) {
            const int s = st % sm::NSTAGE_L;
            if (st < 2 * sm::NSTAGE_L && s >= sm::N_STAGES_USED) continue;
            if (!sm::run_stage(a.oc, st, gid, gs)) break;
            GRID_BAR();
            if (st == 3) fp_cmp(F, 0, a.oc.proj, sm::PROJ_LD, 0, 4096, 0);
            if (st == 4) { fp_cmp(F, 1, a.oc.dtv, 16, 0, 16, 0); fp_cmp(F, 2, a.oc.acs, 16, 0, 16, 0); }
            if (st == 4 && gid == 0) { float* c = (float*)F.ctl + CW_CHK; c[6] = 0.f; c[7] = 1.f; c[8] = 0.f; c[9] = 1.f; c[10] = 0.f; c[11] = 1.f; }
            if (st == 5) fp_cmp_lin(F, 6, a.oc.states, ((size_t)5 * 16 + 0) * 8192, 65536);
            if (st == 6) fp_cmp_lin(F, 7, a.oc.states, ((size_t)5 * 16 + 0) * 8192, 65536);
            if (st == 10) { fp_cmp(F, 8, a.oc.cat, 1536, 0, 512, 0); fp_cmp(F, 9, a.oc.cat, 1536, 512, 1024, 0); }
            if (st == 11) fp_cmp(F, 10, a.oc.h, 1024, 0, 1024, 0);
            if (st == 18) fp_cmp(F, 11, a.oc.h, 1024, 0, 1024, 0);
            if (st == 23) fp_cmp(F, 12, a.oc.h, 1024, 0, 1024, 0);
            if (st == 63) { fp_cmp(F, 13, a.oc.proj, sm::PROJ_LD, 0, 4096, 0); fp_cmp(F, 13, a.oc.proj, sm::PROJ_LD, 4624, 1024, 4096); }
            if (st == 70) { fp_cmp(F, 14, a.oc.cat, 1536, 0, 1024, 0); fp_cmp(F, 15, a.oc.cat, 1536, 1024, 512, 0); }
            if (st == 71) fp_cmp(F, 16, a.oc.h, 1024, 0, 1024, 0);
            if (st == 78) fp_cmp(F, 17, a.oc.h, 1024, 0, 1024, 0);
            if (st == 121) fp_cmp(F, 18, a.oc.out, 1024, 0, 1024, 0);
            GRID_BAR();
        }
        GRID_BAR();
        int code = 0;
        for (int k = CHECK - 1; k >= 0; --k) { const float num = __hip_atomic_load((float*)F.ctl + CW_CHK + 2 * k, __ATOMIC_RELAXED, __HIP_MEMORY_SCOPE_AGENT), den = __hip_atomic_load((float*)F.ctl + CW_CHK + 2 * k + 1, __ATOMIC_RELAXED, __HIP_MEMORY_SCOPE_AGENT);
            if (!(num <= 1e-3f * den) || den == 0.f) code = k + 1; }
        const float sc = 1.f + 0.2f * (float)code;
        for (size_t i = gid; i < (size_t)L * DM; i += gs) { F.out[i] *= sc; F.out[(size_t)L * DM + i] = 0.f; }
    }
#endif
}
}

extern "C" void kernel_launch(void* const* d_in, const int* in_sizes, int n_in, void* d_out, int out_size, void* d_ws, size_t ws_size, hipStream_t stream) {
    static int grid = 0;
    if (grid == 0) {
        int dev = 0, cus = 0, per_cu = 0;
        hipGetDevice(&dev); hipDeviceGetAttribute(&cus, hipDeviceAttributeMultiprocessorCount, dev);
        if (hipFuncSetAttribute((const void*)ok::mk_fwd, hipFuncAttributeMaxDynamicSharedMemorySize, LDS_BYTES) != hipSuccess) { fprintf(stderr, "kernel_launch: hipFuncSetAttribute failed\n"); grid = -1; return; }
        hipOccupancyMaxActiveBlocksPerMultiprocessor(&per_cu, (const void*)ok::mk_fwd, ok::NT, LDS_BYTES);
        (void)hipGetLastError();
        grid = cus;
        if (n_in != 33 || ws_size < ok::WS_END || per_cu < 1) { fprintf(stderr, "kernel_launch: n_in %d ws %zu need %zu per_cu %d\n", n_in, ws_size, (size_t)ok::WS_END, per_cu); grid = -1; }
    }
    if (grid < 0) return;
    hipMemsetAsync((char*)d_ws + ok::WS_CTL, 0, ok::CTL_BYTES, stream);
    ok::Args a{};
    for (int i = 0; i < 33; ++i) a.in[i] = (const float*)d_in[i];
    a.out = (float*)d_out; a.ws = (unsigned char*)d_ws;
#if CHECK
    sm::carve(a.oc, (float*)((char*)d_ws + 16 * ok::MiB));
    for (int i = 0; i < 33; ++i) a.oc.in[i] = (const float*)d_in[i];
    a.oc.out = (float*)d_out;
#endif
    hipLaunchKernelGGL(ok::mk_fwd, dim3(grid), dim3(ok::NT), LDS_BYTES, stream, a);
}
```

```cpp
#include <hip/hip_runtime.h>
#include <cstdio>
#include <cstdint>
#ifndef CHECK
#define CHECK 0
#endif
#define DUP_MASK 0
constexpr int LDS_BYTES = 147456;

#define XB_TMO      128
#define XB_XCNT(j)  (256  + 64 * (j))
#define XB_XSUB(j)  (1280 + 64 * (j))
#define XB_XGEN(j)  (2304 + 64 * (j))
#define XB_TOP      3328
#define XB_TOPGEN   3392
#define XCD_BAR_WORDS 3456
#define XB_SPIN_CAP (1u << 18)
#define LAS __attribute__((address_space(3)))

__device__ __forceinline__ unsigned xb_ld(unsigned* p)              { return __hip_atomic_load(p, __ATOMIC_RELAXED, __HIP_MEMORY_SCOPE_AGENT); }
__device__ __forceinline__ unsigned xb_add(unsigned* p, unsigned v) { return __hip_atomic_fetch_add(p, v, __ATOMIC_RELAXED, __HIP_MEMORY_SCOPE_AGENT); }
__device__ __forceinline__ unsigned xb_xcc_id() { return (unsigned)__builtin_amdgcn_s_getreg((3 << 11) | 20) & 0xFu; }
#define XB_SPIN(cond, bar) do { unsigned _sp = 0; while (cond) { __builtin_amdgcn_s_sleep(1); \
    if ((++_sp & 255u) == 0u) { if (xb_ld(&(bar)[XB_TMO])) break; if (_sp > XB_SPIN_CAP) { atomicAdd(&(bar)[XB_TMO], 1u); break; } } } } while (0)

struct XcdBarrier {
    unsigned* bar; unsigned x;
    volatile LAS unsigned* st;
};

__device__ __forceinline__ XcdBarrier xcd_barrier_post(unsigned* bar, volatile LAS unsigned* st) {
    XcdBarrier b; b.bar = bar; b.x = xb_xcc_id(); b.st = st;
    if (threadIdx.x == 0) (void)xb_add(&bar[XB_XCNT(b.x)], 1u);
    return b;
}
__device__ __forceinline__ void xcd_barrier_complete(unsigned* bar, unsigned x, unsigned& nloc, unsigned& nx) {
    const unsigned G = gridDim.x * gridDim.y * gridDim.z;
    unsigned sum, cnt, mine, sp = 0u;
    for (;;) {
        sum = 0u; cnt = 0u; mine = 0u;
#pragma unroll
        for (unsigned j = 0; j < 16; ++j) { const unsigned c = xb_ld(&bar[XB_XCNT(j)]); sum += c; cnt += (c > 0u) ? 1u : 0u; mine = (j == x) ? c : mine; }
        if (sum == G) break;
        __builtin_amdgcn_s_sleep(1);
        if ((++sp & 255u) == 0u) { if (xb_ld(&bar[XB_TMO])) break; if (sp > XB_SPIN_CAP) { atomicAdd(&bar[XB_TMO], 1u); break; } }
    }
    nloc = mine > 0u ? mine : 1u; nx = cnt > 0u ? cnt : 1u;
}

__device__ __forceinline__ void xcd_barrier(const XcdBarrier& b) {
    asm volatile("s_waitcnt vmcnt(0)" ::: "memory");
    __syncthreads();
    if (threadIdx.x == 0) {
        unsigned* bar = b.bar;
        __builtin_amdgcn_s_waitcnt(0);
        unsigned nloc = b.st[0], nx = b.st[1];
        if (nloc == 0u) { xcd_barrier_complete(bar, b.x, nloc, nx); b.st[0] = nloc; b.st[1] = nx; }
        const unsigned old = xb_add(&bar[XB_XSUB(b.x)], 1u);
        const unsigned gen = old / nloc;
        if (old + 1u == (gen + 1u) * nloc) {
            __builtin_amdgcn_fence(__ATOMIC_RELEASE, "agent");
            asm volatile("s_waitcnt vmcnt(0)" ::: "memory");
            const unsigned og = xb_add(&bar[XB_TOP], 1u);
            const unsigned tg = og / nx;
            if (og + 1u == (tg + 1u) * nx) xb_add(&bar[XB_TOPGEN], 1u);
            else XB_SPIN(xb_ld(&bar[XB_TOPGEN]) == tg, bar);
            __builtin_amdgcn_fence(__ATOMIC_ACQUIRE, "agent");
            xb_add(&bar[XB_XGEN(b.x)], 1u);
            asm volatile("s_waitcnt vmcnt(0)" ::: "memory");
        } else {
            XB_SPIN(xb_ld(&bar[XB_XGEN(b.x)]) == gen, bar);
            __builtin_amdgcn_fence(__ATOMIC_ACQUIRE, "agent");
            asm volatile("s_waitcnt vmcnt(0)" ::: "memory");
        }
    }
    __syncthreads();
}


#undef LAS

#ifndef SEQ
#define SEQ 8192
#endif
namespace sm {
constexpr int DM = 1024, NB = 1  , L = SEQ, T = NB * L, NCH = L / 64, MEM = 256;
constexpr int EV_IN = 4112, OD_IN = 5648, PROJ_LD = 5648;
constexpr int E_SCB = 0, E_SCC = 512, E_SCX = 1024, E_Z = 1536, E_XBC = 2560, E_DT = 4096;
constexpr int O_QKV = 0, O_Z = 3072, O_A = 4096, O_B = 4104, O_SQ = 4112, O_SK = 4624, O_SV = 5136;

struct Ctx {
    const float* in[33];
    float* out;
    float *memn, *kx, *vx, *h, *un, *rstd, *proj, *cat, *xbcc, *dtv, *acs, *states, *cb, *ybuf, *rstd2;
    float *q, *att, *sc;
    float *gatew, *act; int* eid;
    float *qkvc, *beta, *gcs, *Lm, *aqk, *uw, *S, *vn, *obuf;
};
enum In { I_X = 0, I_MEM, I_MEM_NORM, I_FINAL_NORM, I_NORM_MIX, I_NORM_XA, I_NORM_FFN, I_XA_WQ, I_XA_WK, I_XA_WV, I_XA_WO,
          I_MOE_WG, I_MOE_BG, I_MOE_WE, I_MOE_BE, I_MOE_WGATE, I_MOE_WUP, I_MOE_WDOWN,
          I_EV_WIN, I_EV_SCCONV, I_EV_CONVW, I_EV_CONVB, I_EV_DTB, I_EV_ALOG, I_EV_D, I_EV_NORM, I_EV_WOUT,
          I_OD_WIN, I_OD_CONV, I_OD_DTB, I_OD_ALOG, I_OD_NORM, I_OD_WOUT };

__device__ __forceinline__ float siluf(float x) { return x / (1.f + expf(-x)); }
__device__ __forceinline__ float softplusf(float x) { return x > 20.f ? x : log1pf(expf(x)); }
__device__ __forceinline__ float sigmoidf(float x) { return 1.f / (1.f + expf(-x)); }

__device__ __forceinline__ void s_copy(const float* src, float* dst, size_t n, size_t gid, size_t gs) { for (size_t i = gid; i < n; i += gs) dst[i] = src[i]; }
__device__ __forceinline__ void s_rstd(const float* x, int R, int W, int ld, float* rstd, size_t gid, size_t gs) {
    for (size_t r = gid; r < (size_t)R; r += gs) { const float* p = x + r * ld; float s = 0.f; for (int i = 0; i < W; ++i) s += p[i] * p[i]; rstd[r] = 1.f / sqrtf(s / W + 1e-6f); }
}
__device__ __forceinline__ void s_norm(const float* x, const float* rstd, const float* g, float* y, int R, size_t gid, size_t gs) {
    for (size_t i = gid; i < (size_t)R * DM; i += gs) { const size_t r = i / DM; const int c = (int)(i % DM); y[i] = x[i] * rstd[r] * g[c]; }
}
__device__ __forceinline__ void s_gemm(const float* A, int lda, const float* W, int ldw, float* C, int ldc, int M, int N, int K, int accum, size_t gid, size_t gs) {
    const int N4 = N / 4;
    for (size_t i = gid; i < (size_t)M * N4; i += gs) { const size_t m = i / N4; const int n = (int)(i % N4) * 4; const float* a = A + m * lda; const float* w = W + n; float s0 = 0.f, s1 = 0.f, s2 = 0.f, s3 = 0.f;
        for (int k = 0; k < K; ++k) { const float av = a[k]; const float4 wv = *(const float4*)(w + (size_t)k * ldw); s0 += av * wv.x; s1 += av * wv.y; s2 += av * wv.z; s3 += av * wv.w; }
        float4* c = (float4*)(C + m * ldc + n); float4 o = accum ? *c : float4{0.f, 0.f, 0.f, 0.f}; o.x += s0; o.y += s1; o.z += s2; o.w += s3; *c = o; }
}
__device__ __forceinline__ void s_scmix(const Ctx& c, size_t gid, size_t gs) {
    const float* w = c.in[I_EV_SCCONV];
    for (size_t i = gid; i < (size_t)T * 512; i += gs) { const size_t t = i / 512; const int ch = (int)(i % 512); const int tl = (int)(t % L); float s = 0.f;
        for (int j = 0; j < 3; ++j) { const int tt = tl - 2 + j; if (tt >= 0) { const float* p = c.proj + (t - 2 + j) * PROJ_LD; s += w[j * 512 + ch] * p[E_SCC + ch] * p[E_SCX + ch]; } }
        c.cat[t * 1536 + ch] = c.proj[t * PROJ_LD + E_SCB + ch] * s; }
}
__device__ __forceinline__ void s_ssd_conv(const Ctx& c, size_t gid, size_t gs) {
    const float* w = c.in[I_EV_CONVW]; const float* b = c.in[I_EV_CONVB];
    for (size_t i = gid; i < (size_t)T * 1536; i += gs) { const size_t t = i / 1536; const int ch = (int)(i % 1536); const int tl = (int)(t % L); float s = b[ch];
        for (int j = 0; j < 4; ++j) { const int tt = tl - 3 + j; if (tt >= 0) s += w[j * 1536 + ch] * c.proj[(t - 3 + j) * PROJ_LD + E_XBC + ch]; }
        c.xbcc[i] = siluf(s); }
}
__device__ __forceinline__ void s_ssd_dt(const Ctx& c, size_t gid, size_t gs) {
    for (size_t i = gid; i < (size_t)NB * NCH * 16; i += gs) { const int hd = (int)(i % 16); const size_t bc = i / 16; const float a = -expf(c.in[I_EV_ALOG][hd]); float cs = 0.f;
        for (int s = 0; s < 64; ++s) { const size_t t = bc * 64 + s; const float dt = softplusf(c.proj[t * PROJ_LD + E_DT + hd] + c.in[I_EV_DTB][hd]); cs += dt * a; c.dtv[t * 16 + hd] = dt; c.acs[t * 16 + hd] = cs; } }
}
__device__ __forceinline__ void s_ssd_states(const Ctx& c, size_t gid, size_t gs) {
    for (size_t i = gid; i < (size_t)NB * NCH * 16 * 64 * 128; i += gs) { const int n = (int)(i % 128); const int p = (int)((i / 128) % 64); const int hd = (int)((i / 8192) % 16); const size_t bc = i / (8192 * 16);
        const int g = hd / 8; const float last = c.acs[(bc * 64 + 63) * 16 + hd]; float s = 0.f;
        for (int k = 0; k < 64; ++k) { const size_t t = bc * 64 + k; s += c.xbcc[t * 1536 + 1024 + g * 128 + n] * c.xbcc[t * 1536 + hd * 64 + p] * c.dtv[t * 16 + hd] * expf(last - c.acs[t * 16 + hd]); }
        c.states[i] = s; }
}
__device__ __forceinline__ void s_ssd_scan(const Ctx& c, size_t gid, size_t gs) {
    for (size_t i = gid; i < (size_t)NB * 16 * 8192; i += gs) { const size_t b = i / (16 * 8192); const size_t r = i % (16 * 8192); const int hd = (int)(r / 8192); float s = 0.f;
        for (int ch = 0; ch < NCH; ++ch) { const size_t bc = b * NCH + ch; const size_t idx = bc * (16 * 8192) + r; const float st = c.states[idx]; c.states[idx] = s; s = s * expf(c.acs[(bc * 64 + 63) * 16 + hd]) + st; } }
}
__device__ __forceinline__ void s_ssd_cb(const Ctx& c, size_t gid, size_t gs) {
    for (size_t i = gid; i < (size_t)NB * NCH * 2 * 4096; i += gs) { const int s = (int)(i % 64); const int t = (int)((i / 64) % 64); const int g = (int)((i / 4096) % 2); const size_t bc = i / 8192;
        const float* cm = c.xbcc + (bc * 64 + t) * 1536 + 1280 + g * 128; const float* bm = c.xbcc + (bc * 64 + s) * 1536 + 1024 + g * 128; float a = 0.f;
        for (int n = 0; n < 128; ++n) a += cm[n] * bm[n];
        c.cb[i] = a; }
}
__device__ __forceinline__ void s_ssd_y(const Ctx& c, size_t gid, size_t gs) {
    for (size_t i = gid; i < (size_t)T * 1024; i += gs) { const size_t t = i / 1024; const int hp = (int)(i % 1024); const int hd = hp / 64, p = hp % 64, g = hd / 8; const size_t bc = t / 64; const int tl = (int)(t % 64);
        const float at = c.acs[t * 16 + hd]; float y = 0.f;
        for (int s = 0; s <= tl; ++s) { const size_t ts = bc * 64 + s; y += c.cb[(bc * 2 + g) * 4096 + tl * 64 + s] * expf(at - c.acs[ts * 16 + hd]) * c.xbcc[ts * 1536 + hp] * c.dtv[ts * 16 + hd]; }
        const float* cm = c.xbcc + t * 1536 + 1280 + g * 128; const float* pv = c.states + (bc * 16 + hd) * 8192 + p * 128; float yo = 0.f;
        for (int n = 0; n < 128; ++n) yo += cm[n] * pv[n];
        y += yo * expf(at) + c.xbcc[t * 1536 + hp] * c.in[I_EV_D][hd];
        c.ybuf[i] = y * siluf(c.proj[t * PROJ_LD + E_Z + hp]); }
}
__device__ __forceinline__ void s_ssd_out(const Ctx& c, size_t gid, size_t gs) {
    for (size_t i = gid; i < (size_t)T * 1024; i += gs) { const size_t t = i / 1024; const int ch = (int)(i % 1024); c.cat[t * 1536 + 512 + ch] = c.ybuf[i] * c.rstd2[t * 2 + ch / 512] * c.in[I_EV_NORM][ch]; }
}
__device__ __forceinline__ void s_xa_scores(const Ctx& c, size_t gid, size_t gs) {
    for (size_t i = gid; i < (size_t)T * 4 * 256; i += gs) { const int m = (int)(i % 256); const int hd = (int)((i / 256) % 4); const size_t t = i / 1024; const size_t b = t / L;
        const float* q = c.q + t * 1024 + hd * 256; const float* k = c.kx + (b * 256 + m) * 1024 + hd * 256; float s = 0.f;
        for (int d = 0; d < 256; ++d) s += q[d] * k[d];
        c.sc[i] = s * 0.0625f; }
}
__device__ __forceinline__ void s_xa_softmax(const Ctx& c, size_t gid, size_t gs) {
    for (size_t i = gid; i < (size_t)T * 4; i += gs) { float* p = c.sc + i * 256; float mx = p[0]; for (int m = 1; m < 256; ++m) mx = fmaxf(mx, p[m]); float s = 0.f; for (int m = 0; m < 256; ++m) { const float e = expf(p[m] - mx); p[m] = e; s += e; } const float r = 1.f / s; for (int m = 0; m < 256; ++m) p[m] *= r; }
}
__device__ __forceinline__ void s_xa_pv(const Ctx& c, size_t gid, size_t gs) {
    for (size_t i = gid; i < (size_t)T * 1024; i += gs) { const size_t t = i / 1024; const int col = (int)(i % 1024); const int hd = col / 256; const size_t b = t / L; const float* p = c.sc + (t * 4 + hd) * 256; const float* v = c.vx + b * 256 * 1024 + col; float s = 0.f;
        for (int m = 0; m < 256; ++m) s += p[m] * v[(size_t)m * 1024];
        c.att[i] = s; }
}
__device__ __forceinline__ void s_router(const Ctx& c, int l, size_t gid, size_t gs) {
    const float* wg = c.in[I_MOE_WG] + (size_t)l * 1024 * 4; const float* bg = c.in[I_MOE_BG] + l * 4; const float* we = c.in[I_MOE_WE] + (size_t)l * 1024 * 32; const float* be = c.in[I_MOE_BE] + l * 32;
    for (size_t t = gid; t < (size_t)T; t += gs) { const float* x = c.un + t * 1024; float g0 = 0.f, g1 = 0.f, g2 = 0.f, g3 = 0.f;
        for (int k = 0; k < 1024; ++k) { const float xv = x[k]; g0 += xv * wg[k * 4 + 0]; g1 += xv * wg[k * 4 + 1]; g2 += xv * wg[k * 4 + 2]; g3 += xv * wg[k * 4 + 3]; }
        g0 += bg[0]; g1 += bg[1]; g2 += bg[2]; g3 += bg[3];
        int gsel = 0; float gm = g0; if (g1 > gm) { gm = g1; gsel = 1; } if (g2 > gm) { gm = g2; gsel = 2; } if (g3 > gm) { gm = g3; gsel = 3; }
        const float gw = 1.f / (expf(g0 - gm) + expf(g1 - gm) + expf(g2 - gm) + expf(g3 - gm));
        float e0 = 0, e1 = 0, e2 = 0, e3 = 0, e4 = 0, e5 = 0, e6 = 0, e7 = 0; const float* w = we + gsel * 8;
        for (int k = 0; k < 1024; ++k) { const float xv = x[k]; const float* wk = w + k * 32; e0 += xv * wk[0]; e1 += xv * wk[1]; e2 += xv * wk[2]; e3 += xv * wk[3]; e4 += xv * wk[4]; e5 += xv * wk[5]; e6 += xv * wk[6]; e7 += xv * wk[7]; }
        const float* bb = be + gsel * 8; e0 += bb[0]; e1 += bb[1]; e2 += bb[2]; e3 += bb[3]; e4 += bb[4]; e5 += bb[5]; e6 += bb[6]; e7 += bb[7];
        int i1 = 0; float m1 = e0;
#define SM_T1(j, v) if (v > m1) { m1 = v; i1 = j; }
        SM_T1(1, e1) SM_T1(2, e2) SM_T1(3, e3) SM_T1(4, e4) SM_T1(5, e5) SM_T1(6, e6) SM_T1(7, e7)
        int i2 = -1; float m2 = -3.0e38f;
#define SM_T2(j, v) if (j != i1 && v > m2) { m2 = v; i2 = j; }
        SM_T2(0, e0) SM_T2(1, e1) SM_T2(2, e2) SM_T2(3, e3) SM_T2(4, e4) SM_T2(5, e5) SM_T2(6, e6) SM_T2(7, e7)
        const float r = expf(m2 - m1); const float w1 = gw / (1.f + r), w2 = gw * r / (1.f + r);
        c.eid[t * 2 + 0] = gsel * 8 + i1; c.eid[t * 2 + 1] = gsel * 8 + i2; c.gatew[t * 2 + 0] = w1; c.gatew[t * 2 + 1] = w2; }
}
__device__ __forceinline__ void s_moe_up(const Ctx& c, int l, size_t gid, size_t gs) {
    for (size_t i = gid; i < (size_t)T * 2 * 512; i += gs) { const int f = (int)(i % 512); const size_t tk = i / 512; const size_t t = tk / 2; const int e = c.eid[tk] & 31;
        const float* wg = c.in[I_MOE_WGATE] + ((size_t)l * 32 + e) * 1024 * 512 + f; const float* wu = c.in[I_MOE_WUP] + ((size_t)l * 32 + e) * 1024 * 512 + f; const float* x = c.un + t * 1024; float a = 0.f, b = 0.f;
        for (int k = 0; k < 1024; ++k) { a += x[k] * wg[(size_t)k * 512]; b += x[k] * wu[(size_t)k * 512]; }
        c.act[i] = siluf(a) * b; }
}
__device__ __forceinline__ void s_moe_down(const Ctx& c, int l, size_t gid, size_t gs) {
    for (size_t i = gid; i < (size_t)T * 1024; i += gs) { const size_t t = i / 1024; const int n = (int)(i % 1024); float y = 0.f;
        for (int k = 0; k < 2; ++k) { const int e = c.eid[t * 2 + k] & 31; const float* wd = c.in[I_MOE_WDOWN] + ((size_t)l * 32 + e) * 512 * 1024 + n; const float* a = c.act + (t * 2 + k) * 512; float s = 0.f;
            for (int f = 0; f < 512; ++f) s += a[f] * wd[(size_t)f * 1024];
            y += s * c.gatew[t * 2 + k]; }
        c.h[i] += y; }
}
__device__ __forceinline__ void s_gdn_conv(const Ctx& c, size_t gid, size_t gs) {
    const float* w = c.in[I_OD_CONV];
    for (size_t i = gid; i < (size_t)T * 3072; i += gs) { const size_t t = i / 3072; const int ch = (int)(i % 3072); const int tl = (int)(t % L); float s = 0.f;
        for (int j = 0; j < 4; ++j) { const int tt = tl - 3 + j; if (tt >= 0) s += w[j * 3072 + ch] * c.proj[(t - 3 + j) * PROJ_LD + O_QKV + ch]; }
        c.qkvc[i] = siluf(s); }
}
__device__ __forceinline__ void s_gdn_qkscale(const Ctx& c, size_t gid, size_t gs) {
    for (size_t i = gid; i < (size_t)T * 16; i += gs) { const size_t t = i / 16; const int wh = (int)(i % 16); float* p = c.qkvc + t * 3072 + wh * 128; float s = 0.f; for (int d = 0; d < 128; ++d) s += p[d] * p[d];
        float r = 1.f / sqrtf(s + 1e-6f); if (wh < 8) r *= 0.08838834764831845f; for (int d = 0; d < 128; ++d) p[d] *= r; }
}
__device__ __forceinline__ void s_gdn_gates(const Ctx& c, size_t gid, size_t gs) {
    for (size_t i = gid; i < (size_t)NB * NCH * 8; i += gs) { const int hd = (int)(i % 8); const size_t bc = i / 8; const float na = -expf(c.in[I_OD_ALOG][hd]); const float db = c.in[I_OD_DTB][hd]; float cs = 0.f;
        for (int s = 0; s < 64; ++s) { const size_t t = bc * 64 + s; cs += na * softplusf(c.proj[t * PROJ_LD + O_A + hd] + db); c.gcs[t * 8 + hd] = cs; c.beta[t * 8 + hd] = sigmoidf(c.proj[t * PROJ_LD + O_B + hd]); } }
}
__device__ __forceinline__ void s_gdn_kk(const Ctx& c, size_t gid, size_t gs) {
    for (size_t i = gid; i < (size_t)NB * NCH * 8 * 4096; i += gs) { const int s = (int)(i % 64); const int t = (int)((i / 64) % 64); const int hd = (int)((i / 4096) % 8); const size_t bc = i / (4096 * 8);
        float lv = 0.f, av = 0.f;
        if (s <= t) { const size_t tt = bc * 64 + t, ts = bc * 64 + s; const float* kt = c.qkvc + tt * 3072 + 1024 + hd * 128; const float* ks = c.qkvc + ts * 3072 + 1024 + hd * 128; const float* qt = c.qkvc + tt * 3072 + hd * 128; float kk = 0.f, qk = 0.f;
            for (int d = 0; d < 128; ++d) { kk += kt[d] * ks[d]; qk += qt[d] * ks[d]; }
            const float dec = expf(c.gcs[tt * 8 + hd] - c.gcs[ts * 8 + hd]); av = qk * dec; if (s < t) lv = kk * c.beta[tt * 8 + hd] * dec; }
        c.Lm[i] = lv; c.aqk[i] = av; }
}
__device__ __forceinline__ void s_gdn_solve(const Ctx& c, size_t gid, size_t gs) {
    for (size_t i = gid; i < (size_t)NB * NCH * 8 * 256; i += gs) { const int j = (int)(i % 256); const int hd = (int)((i / 256) % 8); const size_t bc = i / 2048; float* sol = c.uw + (bc * 8 + hd) * (64 * 256) + j; const float* Lp = c.Lm + (bc * 8 + hd) * 4096;
        for (int t = 0; t < 64; ++t) { const size_t tt = bc * 64 + t; const float bt = c.beta[tt * 8 + hd];
            float r = (j < 128) ? c.qkvc[tt * 3072 + 2048 + hd * 128 + j] * bt : c.qkvc[tt * 3072 + 1024 + hd * 128 + (j - 128)] * bt * expf(c.gcs[tt * 8 + hd]);
            for (int s = 0; s < t; ++s) r -= Lp[t * 64 + s] * sol[(size_t)s * 256];
            sol[(size_t)t * 256] = r; } }
}
__device__ __forceinline__ void s_gdn_scan(const Ctx& c, size_t gid, size_t gs) {
    for (size_t i = gid; i < (size_t)NB * 8 * 128; i += gs) { const int j = (int)(i % 128); const size_t bh = i / 128; const int hd = (int)(bh % 8); const size_t b = bh / 8; float* S = c.S + bh * 16384 + j; float* vn = c.vn + bh * 8192 + j;
        for (int d = 0; d < 128; ++d) S[(size_t)d * 128] = 0.f;
        for (int ch = 0; ch < NCH; ++ch) { const size_t bc = b * NCH + ch; const float* uw = c.uw + (bc * 8 + hd) * (64 * 256); const float* aq = c.aqk + (bc * 8 + hd) * 4096; const float glast = c.gcs[(bc * 64 + 63) * 8 + hd];
            for (int t = 0; t < 64; ++t) { float v = uw[t * 256 + j]; const float* w = uw + t * 256 + 128; for (int d = 0; d < 128; ++d) v -= w[d] * S[(size_t)d * 128]; vn[(size_t)t * 128] = v; }
            for (int t = 0; t < 64; ++t) { const size_t tt = bc * 64 + t; const float* q = c.qkvc + tt * 3072 + hd * 128; float o = 0.f; for (int d = 0; d < 128; ++d) o += q[d] * S[(size_t)d * 128];
                o *= expf(c.gcs[tt * 8 + hd]); for (int s = 0; s <= t; ++s) o += aq[t * 64 + s] * vn[(size_t)s * 128];
                c.obuf[tt * 1024 + hd * 128 + j] = o; }
            const float dl = expf(glast);
            for (int d = 0; d < 128; ++d) { float a = S[(size_t)d * 128] * dl; for (int t = 0; t < 64; ++t) { const size_t tt = bc * 64 + t; a += c.qkvc[tt * 3072 + 1024 + hd * 128 + d] * expf(glast - c.gcs[tt * 8 + hd]) * vn[(size_t)t * 128]; } S[(size_t)d * 128] = a; } } }
}
__device__ __forceinline__ void s_gdn_out(const Ctx& c, size_t gid, size_t gs) {
    for (size_t i = gid; i < (size_t)T * 1024; i += gs) { const size_t t = i / 1024; const int col = (int)(i % 1024); c.cat[t * 1536 + col] = c.obuf[i] * c.rstd2[t * 8 + col / 128] * c.in[I_OD_NORM][col % 128] * siluf(c.proj[t * PROJ_LD + O_Z + col]); }
}
__device__ __forceinline__ void s_sb(const Ctx& c, size_t gid, size_t gs) {
    for (size_t i = gid; i < (size_t)T * 32; i += gs) { const int qd = (int)(i % 4); const int hd = (int)((i / 4) % 8); const size_t t = i / 32; const int tl = (int)(t % L); const float* q = c.proj + t * PROJ_LD + O_SQ + hd * 64;
        float o[16];
#pragma unroll
        for (int d = 0; d < 16; ++d) o[d] = 0.f;
        float carry = 0.f;
        for (int s = tl - 1; s >= 0 && carry > -150.f; --s) { const size_t ts = t - (size_t)(tl - s); const float* k = c.proj + ts * PROJ_LD + O_SK + hd * 64; const float* v = c.proj + ts * PROJ_LD + O_SV + hd * 64 + qd * 16; float lg = 0.f;
            for (int d = 0; d < 64; ++d) lg += q[d] * k[d];
            lg *= 0.125f; const float wgt = expf(-softplusf(-lg) + carry); carry -= softplusf(lg);
#pragma unroll
            for (int d = 0; d < 16; ++d) o[d] += wgt * v[d]; }
#pragma unroll
        for (int d = 0; d < 16; ++d) c.cat[t * 1536 + 1024 + hd * 64 + qd * 16 + d] = o[d]; }
}
__device__ __forceinline__ void s_final(const Ctx& c, size_t gid, size_t gs) { s_norm(c.h, c.rstd, c.in[I_FINAL_NORM], c.out, T, gid, gs); }

constexpr int XA_BASE = 20, MOE_BASE = 30, L1_BASE = 40, NSTAGE_L = 60;
__device__ __forceinline__ bool run_stage(const Ctx& c, int st, size_t gid, size_t gs) {
    const int layer = st / NSTAGE_L, s = st % NSTAGE_L;
    if (st >= 2 * NSTAGE_L + 2) return false;
    if (st == 2 * NSTAGE_L) { s_rstd(c.h, T, DM, DM, c.rstd, gid, gs); return true; }
    if (st == 2 * NSTAGE_L + 1) { s_final(c, gid, gs); return true; }
    const int l = layer;
    switch (s) {
    case 0: if (l == 0) { s_copy(c.in[I_X], c.h, (size_t)T * DM, gid, gs); s_rstd(c.in[I_MEM], NB * MEM, DM, DM, c.rstd2, gid, gs); } break;
    case 1: if (l == 0) s_norm(c.in[I_MEM], c.rstd2, c.in[I_MEM_NORM], c.memn, NB * MEM, gid, gs); s_rstd(c.h, T, DM, DM, c.rstd, gid, gs); break;
    case 2: s_norm(c.h, c.rstd, c.in[I_NORM_MIX] + l * DM, c.un, T, gid, gs); break;
    case 3: if (l == 0) s_gemm(c.un, DM, c.in[I_EV_WIN], EV_IN, c.proj, PROJ_LD, T, EV_IN, DM, 0, gid, gs); else s_gemm(c.un, DM, c.in[I_OD_WIN], OD_IN, c.proj, PROJ_LD, T, OD_IN, DM, 0, gid, gs); break;
    case 4: if (l == 0) { s_scmix(c, gid, gs); s_ssd_conv(c, gid, gs); s_ssd_dt(c, gid, gs); } else { s_gdn_conv(c, gid, gs); s_gdn_gates(c, gid, gs); s_sb(c, gid, gs); } break;
    case 5: if (l == 0) { s_ssd_states(c, gid, gs); s_ssd_cb(c, gid, gs); } else s_gdn_qkscale(c, gid, gs); break;
    case 6: if (l == 0) s_ssd_scan(c, gid, gs); else s_gdn_kk(c, gid, gs); break;
    case 7: if (l == 0) s_ssd_y(c, gid, gs); else s_gdn_solve(c, gid, gs); break;
    case 8: if (l == 0) s_rstd(c.ybuf, T * 2, 512, 512, c.rstd2, gid, gs); else s_gdn_scan(c, gid, gs); break;
    case 9: if (l == 0) s_ssd_out(c, gid, gs); else s_rstd(c.obuf, T * 8, 128, 128, c.rstd2, gid, gs); break;
    case 10: if (l == 1) s_gdn_out(c, gid, gs); break;
    case 11: s_gemm(c.cat, 1536, l == 0 ? c.in[I_EV_WOUT] : c.in[I_OD_WOUT], DM, c.h, DM, T, DM, 1536, 1, gid, gs); break;
    case 12: s_rstd(c.h, T, DM, DM, c.rstd, gid, gs); break;
    case 13: s_norm(c.h, c.rstd, c.in[I_NORM_XA] + l * DM, c.un, T, gid, gs); break;
    case 14: s_gemm(c.un, DM, c.in[I_XA_WQ] + (size_t)l * DM * DM, DM, c.q, DM, T, DM, DM, 0, gid, gs);
             s_gemm(c.memn, DM, c.in[I_XA_WK] + (size_t)l * DM * DM, DM, c.kx, DM, NB * MEM, DM, DM, 0, gid, gs);
             s_gemm(c.memn, DM, c.in[I_XA_WV] + (size_t)l * DM * DM, DM, c.vx, DM, NB * MEM, DM, DM, 0, gid, gs); break;
    case 15: s_xa_scores(c, gid, gs); break;
    case 16: s_xa_softmax(c, gid, gs); break;
    case 17: s_xa_pv(c, gid, gs); break;
    case 18: s_gemm(c.att, DM, c.in[I_XA_WO] + (size_t)l * DM * DM, DM, c.h, DM, T, DM, DM, 1, gid, gs); break;
    case 19: s_rstd(c.h, T, DM, DM, c.rstd, gid, gs); break;
    case 20: s_norm(c.h, c.rstd, c.in[I_NORM_FFN] + l * DM, c.un, T, gid, gs); break;
    case 21: s_router(c, l, gid, gs); break;
    case 22: s_moe_up(c, l, gid, gs); break;
    case 23: s_moe_down(c, l, gid, gs); break;
    default: break;
    }
    return true;
}
constexpr int N_STAGES_USED = 24;

__host__ __device__ __forceinline__ size_t carve(Ctx& c, float* w) {
    size_t o = 0;
    auto take = [&](size_t n) { float* p = w + o; o += (n + 63) & ~(size_t)63; return p; };
    c.h = take((size_t)T * DM); c.rstd = take(T); c.rstd2 = take((size_t)T * 8); c.memn = take((size_t)MEM * DM); c.kx = take((size_t)MEM * DM); c.vx = take((size_t)MEM * DM);
    c.eid = (int*)take((size_t)T * 2); c.gatew = take((size_t)T * 2); c.dtv = take((size_t)T * 16); c.acs = take((size_t)T * 16); c.beta = take((size_t)T * 8); c.gcs = take((size_t)T * 8);
    c.S = take(8 * 16384); c.vn = take(8 * 8192);
    c.un = take((size_t)T * DM); c.ybuf = c.un; c.obuf = c.un;
    c.proj = take((size_t)T * PROJ_LD);
    c.cat = take((size_t)T * 1536);
    const size_t d0 = o;
    c.xbcc = take((size_t)T * 1536); c.states = take((size_t)NCH * 16 * 8192); c.cb = take((size_t)NCH * 2 * 4096); size_t dmax = o;
    o = d0; c.qkvc = take((size_t)T * 3072); c.Lm = take((size_t)NCH * 8 * 4096); c.aqk = take((size_t)NCH * 8 * 4096); c.uw = take((size_t)NCH * 8 * 64 * 256); if (o > dmax) dmax = o;
    o = d0; c.q = take((size_t)T * DM); c.sc = take((size_t)T * DM); c.att = take((size_t)T * DM); if (o > dmax) dmax = o;
    o = d0; c.act = take((size_t)T * 2 * 512); if (o > dmax) dmax = o;
    return dmax;
}
}

namespace pg8 {
#define PG8_LAS __attribute__((address_space(3)))
typedef unsigned short bf16_t;
typedef short bf16x8 __attribute__((ext_vector_type(8)));
typedef float f32x4 __attribute__((ext_vector_type(4)));
typedef unsigned u32x4 __attribute__((ext_vector_type(4)));
constexpr int BM = 256, BK = 64, HALF = 128, HTB = HALF * BK * 2  , STAGE_BYTES = 8 * HTB, NXCD = 8, WGM = 8;

__host__ __device__ __forceinline__ int lds_byte(int r, int c) { const int st = (r >> 4) * 2 + (c >> 5), rr = r & 15, cc = c & 31, ob = rr * 64 + cc * 2; return st * 1024 + (ob ^ (((ob >> 9) & 1) << 5)); }
__host__ __device__ __forceinline__ void stage_rc(int b, int& R, int& C) { const int st = b / 1024, sb = b % 1024, swz = sb ^ (((sb >> 9) & 1) << 5); R = (st >> 1) * 16 + swz / 64; C = (st & 1) * 32 + (swz % 64) / 2; }
__host__ __device__ __forceinline__ int perm32(int rho) { const int n = rho >> 4, i = rho & 15; return 8 * (i >> 2) + 4 * n + (i & 3); }

struct Unit { int pm, pn, tag; const char* a; const char* b; };
struct Gemm { const bf16_t* A; const bf16_t* Bt; int M, N, K; };

struct StaticOrder {
    static constexpr bool LIGHT = false;
    int nM, nN, nwg, G, c; const char* A; const char* B; size_t tstep;
    __host__ __device__ void init(const Gemm& g, int G_, int c_) { nM = g.M / BM; nN = g.N / BM; nwg = nM * nN; G = G_; c = c_; A = (const char*)g.A; B = (const char*)g.Bt; tstep = (size_t)BM * g.K * 2; }
    __host__ __device__ bool next(int i, Unit& u) const {
        const long L = (long)i * G + c; if (L >= nwg) return false;
        int wgid = (int)L; { const int q = nwg / NXCD, r = nwg % NXCD, xcd = wgid % NXCD, off = wgid / NXCD; wgid = (xcd < r ? xcd * (q + 1) : r * (q + 1) + (xcd - r) * q) + off; }
        const int nig = WGM * nN, gid = wgid / nig, fm = gid * WGM, gsz = (nM - fm) < WGM ? (nM - fm) : WGM;
        u.pm = fm + ((wgid % nig) % gsz); u.pn = (wgid % nig) / gsz; u.a = A + (size_t)u.pm * tstep; u.b = B + (size_t)u.pn * tstep; return true;
    }
    __device__ __forceinline__ void a_ready(const Unit&) const {}
    __device__ __forceinline__ void done(const Unit&) const {}
};

template <class Epi, class Sched, bool ALIGN_EPI = false, bool SP2 = false>
__device__ __forceinline__ void gemm_phase(PG8_LAS unsigned char* lds, const Gemm g, const Sched& S, const Epi& E) {
    int tid_ = threadIdx.x; asm volatile("" : "+v"(tid_));
    const int tid = tid_, wid = __builtin_amdgcn_readfirstlane(tid >> 6), lane = tid & 63, wr = wid >> 2, wc = wid & 3, fr = lane & 15, fq = lane >> 4;
    const int K = g.K, nt = K / BK;
    unsigned voffA[2], voffB[2];
#pragma unroll
    for (int i = 0; i < 2; ++i) { int R, C; stage_rc(tid * 16 + i * 8192, R, C); const int Rb = Epi::PERM ? ((R & ~31) + perm32(R & 31)) : R;
        voffA[i] = (unsigned)(R * K + C) * 2u; voffB[i] = (unsigned)(Rb * K + C) * 2u; }
    const size_t kstep = (size_t)(BK * 2);
    const size_t hstep = (size_t)HALF * K * 2;
    const unsigned ldsw = (unsigned)wid * 1024u;
    const int aoff = lds_byte(wr * 64 + fr, fq * 8), boff = lds_byte(wc * 32 + fr, fq * 8);
#define PG8_SA(b, h) (((b) * 2 + (h)) * HTB)
#define PG8_SB(b, h) ((4 + (b) * 2 + (h)) * HTB)
#define PG8_STAGE(bufoff, gbase, voff) do { _Pragma("unroll") for (int _i = 0; _i < 2; ++_i) \
        __builtin_amdgcn_global_load_lds((const unsigned*)((const char*)(gbase) + (voff)[_i]), (PG8_LAS unsigned*)(lds + (bufoff) + ldsw + _i * 8192), 16, 0, 0); } while (0)
#define PG8_LDA(dst, b, h) do { _Pragma("unroll") for (int m = 0; m < 4; ++m) _Pragma("unroll") for (int k = 0; k < 2; ++k) dst[m][k] = *(const PG8_LAS bf16x8*)(lds + PG8_SA(b, h) + aoff + m * 2048 + k * 1024); } while (0)
#define PG8_LDB(dst, b, h) do { _Pragma("unroll") for (int n = 0; n < 2; ++n) _Pragma("unroll") for (int k = 0; k < 2; ++k) dst[n][k] = *(const PG8_LAS bf16x8*)(lds + PG8_SB(b, h) + boff + n * 2048 + k * 1024); } while (0)
#define PG8_MMA(ai, bj, At, Bt) do { __builtin_amdgcn_s_setprio(1); _Pragma("unroll") for (int m = 0; m < 4; ++m) _Pragma("unroll") for (int n = 0; n < 2; ++n) _Pragma("unroll") for (int k = 0; k < 2; ++k) \
        acc[ai][bj][m][n] = __builtin_amdgcn_mfma_f32_16x16x32_bf16(Bt[n][k], At[m][k], acc[ai][bj][m][n], 0, 0, 0); __builtin_amdgcn_s_setprio(0); } while (0)
#define PG8_WAIT_V(n) asm volatile("s_waitcnt vmcnt(" #n ")" ::: "memory")
#define PG8_WAIT_L(n) asm volatile("s_waitcnt lgkmcnt(" #n ")" ::: "memory")
#define PG8_BAR __builtin_amdgcn_s_barrier()
#define PG8_SCHED __builtin_amdgcn_sched_barrier(0)
    Unit cur, nxt; int ui = 0;
    if (!S.next(0, cur)) return;
    f32x4 acc[2][2][4][2];
#pragma unroll
    for (int a = 0; a < 2; ++a)
#pragma unroll
        for (int b = 0; b < 2; ++b)
#pragma unroll
            for (int m = 0; m < 4; ++m)
#pragma unroll
                for (int n = 0; n < 2; ++n) acc[a][b][m][n] = (f32x4){0.f, 0.f, 0.f, 0.f};
    bf16x8 At[4][2], B0[2][2], B1[2][2];
    const char* cA = cur.a; const char* cB = cur.b;
    S.a_ready(cur);
    if constexpr (SP2) {
        PG8_STAGE(PG8_SB(0, 0), cB, voffB); PG8_STAGE(PG8_SB(0, 1), cB + hstep, voffB); PG8_STAGE(PG8_SA(0, 0), cA, voffA); PG8_STAGE(PG8_SA(0, 1), cA + hstep, voffA);
        if (wr == 1) PG8_BAR;
        PG8_WAIT_V(2); PG8_BAR;
        PG8_STAGE(PG8_SB(1, 0), cB + kstep, voffB); PG8_STAGE(PG8_SA(1, 0), cA + kstep, voffA); PG8_STAGE(PG8_SB(1, 1), cB + hstep + kstep, voffB);
        PG8_WAIT_V(6); PG8_BAR;
    } else {
        PG8_STAGE(PG8_SB(0, 0), cB, voffB); PG8_STAGE(PG8_SA(0, 0), cA, voffA); PG8_STAGE(PG8_SB(0, 1), cB + hstep, voffB); PG8_STAGE(PG8_SA(0, 1), cA + hstep, voffA);
        if (wr == 1) PG8_BAR;
        PG8_WAIT_V(4); PG8_BAR;
        PG8_STAGE(PG8_SB(1, 0), cB + kstep, voffB); PG8_STAGE(PG8_SA(1, 0), cA + kstep, voffA); PG8_STAGE(PG8_SB(1, 1), cB + hstep + kstep, voffB);
        PG8_WAIT_V(6); PG8_BAR;
    }
    for (;;) {
        const bool has_next = S.next(ui + 1, nxt);
        const char* nA = has_next ? nxt.a : cA; const char* nB = has_next ? nxt.b : cB;
        for (int t = 0; t < nt; t += 2) {
            const bool last = (t == nt - 2);
            const char* a1 = cA + (size_t)(t + 1) * kstep;
            const char* a2 = last ? nA : cA + (size_t)(t + 2) * kstep; const char* b2 = last ? nB : cB + (size_t)(t + 2) * kstep;
            const char* a3 = a2 + kstep; const char* b3 = b2 + kstep;
            if (last && has_next) S.a_ready(nxt);
            if constexpr (SP2) {
            PG8_LDB(B0, 0, 0); PG8_LDB(B1, 0, 1); PG8_SCHED; PG8_LDA(At, 0, 0); PG8_STAGE(PG8_SA(1, 1), a1 + hstep, voffA);
            PG8_WAIT_V(8); PG8_WAIT_L(0); PG8_BAR; PG8_MMA(0, 0, At, B0); PG8_MMA(0, 1, At, B1); PG8_BAR; PG8_SCHED;
            PG8_LDA(At, 0, 1); PG8_STAGE(PG8_SB(0, 0), b2, voffB); PG8_STAGE(PG8_SB(0, 1), b2 + hstep, voffB); PG8_STAGE(PG8_SA(0, 0), a2, voffA);
            PG8_WAIT_V(8); PG8_WAIT_L(0); PG8_BAR; if (!(Sched::LIGHT && (cur.tag & 1))) { PG8_MMA(1, 0, At, B0); PG8_MMA(1, 1, At, B1); } PG8_BAR; PG8_SCHED;
            PG8_LDB(B0, 1, 0); PG8_LDB(B1, 1, 1); PG8_SCHED; PG8_LDA(At, 1, 0); PG8_STAGE(PG8_SA(0, 1), a2 + hstep, voffA);
            PG8_WAIT_V(8); PG8_WAIT_L(0); PG8_BAR; PG8_MMA(0, 0, At, B0); PG8_MMA(0, 1, At, B1); PG8_BAR; PG8_SCHED;
            PG8_LDA(At, 1, 1); PG8_STAGE(PG8_SB(1, 0), b3, voffB); PG8_STAGE(PG8_SB(1, 1), b3 + hstep, voffB); PG8_STAGE(PG8_SA(1, 0), a3, voffA);
            PG8_WAIT_V(8); PG8_WAIT_L(0); PG8_BAR; if (!(Sched::LIGHT && (cur.tag & 1))) { PG8_MMA(1, 0, At, B0); PG8_MMA(1, 1, At, B1); } PG8_BAR; PG8_SCHED;
            } else {
            PG8_LDB(B0, 0, 0); PG8_SCHED; PG8_LDA(At, 0, 0); PG8_STAGE(PG8_SA(1, 1), a1 + hstep, voffA);
            PG8_WAIT_L(8); PG8_BAR; PG8_WAIT_L(0); PG8_MMA(0, 0, At, B0); PG8_BAR; PG8_SCHED;
            PG8_LDB(B1, 0, 1); PG8_STAGE(PG8_SB(0, 0), b2, voffB);
            PG8_BAR; PG8_WAIT_L(0); PG8_MMA(0, 1, At, B1); PG8_BAR;
            PG8_LDA(At, 0, 1); PG8_STAGE(PG8_SA(0, 0), a2, voffA);
            PG8_BAR; PG8_WAIT_L(0); PG8_MMA(1, 0, At, B0); PG8_BAR; PG8_SCHED;
            PG8_STAGE(PG8_SB(0, 1), b2 + hstep, voffB);
            PG8_WAIT_V(6); PG8_BAR; PG8_MMA(1, 1, At, B1); PG8_BAR;
            PG8_LDB(B0, 1, 0); PG8_SCHED; PG8_LDA(At, 1, 0); PG8_STAGE(PG8_SA(0, 1), a2 + hstep, voffA);
            PG8_WAIT_L(8); PG8_BAR; PG8_WAIT_L(0); PG8_MMA(0, 0, At, B0); PG8_BAR; PG8_SCHED;
            PG8_LDB(B1, 1, 1); PG8_STAGE(PG8_SB(1, 0), b3, voffB);
            PG8_BAR; PG8_WAIT_L(0); PG8_MMA(0, 1, At, B1); PG8_BAR;
            PG8_LDA(At, 1, 1); PG8_STAGE(PG8_SA(1, 0), a3, voffA);
            PG8_BAR; PG8_WAIT_L(0); PG8_MMA(1, 0, At, B0); PG8_BAR; PG8_SCHED;
            PG8_STAGE(PG8_SB(1, 1), b3 + hstep, voffB);
            PG8_WAIT_V(6); PG8_BAR; PG8_MMA(1, 1, At, B1); PG8_BAR;
            }
        }
        if constexpr (ALIGN_EPI) { if (wr == 0) PG8_BAR; }
        if constexpr (!Epi::AFTER_DRAIN) { E(acc, cur, wr, wc, fr, fq); S.done(cur); }
        if (!has_next) break;
#pragma unroll
        for (int a = 0; a < 2; ++a)
#pragma unroll
            for (int b = 0; b < 2; ++b)
#pragma unroll
                for (int m = 0; m < 4; ++m)
#pragma unroll
                    for (int n = 0; n < 2; ++n) acc[a][b][m][n] = (f32x4){0.f, 0.f, 0.f, 0.f};
        cur = nxt; cA = nA; cB = nB; ++ui;
        if constexpr (ALIGN_EPI) { if (wr == 1) PG8_BAR; }
    }
    PG8_WAIT_V(0);
    if constexpr (!ALIGN_EPI) { if (wr == 0) PG8_BAR; }
    PG8_BAR;
    if constexpr (Epi::AFTER_DRAIN) { E.fused(acc, cur, wr, wc, fr, fq, lds, wid, lane); S.done(cur); }
#undef PG8_SA
#undef PG8_SB
#undef PG8_STAGE
#undef PG8_LDA
#undef PG8_LDB
#undef PG8_MMA
#undef PG8_WAIT_V
#undef PG8_WAIT_L
#undef PG8_BAR
#undef PG8_SCHED
}
}

namespace ok {
using pg8::bf16_t; using pg8::bf16x8; using pg8::f32x4; using pg8::u32x4;
typedef unsigned u32x2 __attribute__((ext_vector_type(2)));
typedef float f32x2 __attribute__((ext_vector_type(2)));
#ifndef SEQ
#define SEQ 8192
#endif
constexpr int NB = 2, L = SEQ, NCH = L / 64, T = NB * L, DM = 1024, NWAVES = 8, NT = 512;
constexpr float EPS = 1e-6f, LOG2E = 1.4426950408889634f;
constexpr size_t MiB = 1u << 20, KiB = 1024;
constexpr size_t WS_CTL = 0, CTL_BYTES = 1 * MiB;
constexpr int CW_BAR = 0;
constexpr int CW_SSQ = 16384;
constexpr int CW_MOE = 16384 + 6 * T;
constexpr int CW_CHK = CW_MOE + 256;
static_assert((CW_CHK + 64) * 4 <= (int)CTL_BYTES, "ctl");
constexpr size_t WS_WDT = 1 * MiB, WS_WAB = WS_WDT + 64 * KiB, WS_WR = WS_WAB + 64 * KiB;
constexpr size_t WS_DTV = 2 * MiB, WS_ACS = 3 * MiB, WS_GCS = 4 * MiB, WS_BETA = 4 * MiB + 512 * KiB;
constexpr size_t WS_RAW16 = WS_DTV;
constexpr size_t WS_EID = 5 * MiB, WS_GATEW = WS_EID + 128 * KiB, WS_TOKSLOT = WS_GATEW + 128 * KiB, WS_SLOTTOK = WS_TOKSLOT + 128 * KiB, WS_SLOTGATE = WS_SLOTTOK + 160 * KiB,
                 WS_SLOTRSTD = WS_SLOTGATE + 160 * KiB, WS_TILEEXP = WS_SLOTRSTD + 160 * KiB;
constexpr size_t WS_FP = 8 * MiB;
constexpr size_t WS_W_IN0 = 16 * MiB, WS_W_IN1 = 24 * MiB, WS_W_OUT0 = 35 * MiB, WS_W_OUT1 = 38 * MiB, WS_W_XA = 41 * MiB  ;
constexpr size_t WS_MEMNB = 57 * MiB, WS_KX = 58 * MiB  , WS_VT = 60 * MiB  ;
constexpr size_t WS_H = 64 * MiB, WS_HB = 128 * MiB, WS_MOEW = 160 * MiB, WS_BIG = 256 * MiB;
constexpr size_t WS_PROJ = WS_BIG;
constexpr size_t WS_CAT0 = 384 * MiB, WS_STATES = 432 * MiB;
constexpr size_t WS_CAT1 = 432 * MiB;
constexpr size_t WS_Q = WS_BIG, WS_ATT = WS_BIG + 32 * MiB;
constexpr size_t WS_XS = WS_BIG, WS_ACT = WS_BIG + 80 * MiB, WS_Y = WS_BIG + 120 * MiB;
constexpr size_t WS_END = 528 * MiB;
constexpr int PROJ0_LD = 4096, PROJ1_LD = 5632, MAXSLOT = 40960;

#ifdef CPU_EMU
__device__ __forceinline__ float fexp(float x) { return expf(x); }
__device__ __forceinline__ float fexp2(float x) { return exp2f(x); }
__device__ __forceinline__ float frcp(float x) { return 1.f / x; }
__device__ __forceinline__ float frsq(float x) { return 1.f / sqrtf(x); }
#else
__device__ __forceinline__ float fexp(float x) { return __builtin_amdgcn_exp2f(x * 1.4426950408889634f); }
__device__ __forceinline__ float fexp2(float x) { return __builtin_amdgcn_exp2f(x); }
__device__ __forceinline__ float frcp(float x) { return __builtin_amdgcn_rcpf(x); }
__device__ __forceinline__ float frsq(float x) { return __builtin_amdgcn_rsqf(x); }
#endif
#ifdef CPU_EMU
#define LAS
#define GAS
#define LDS_WAIT() do {} while (0)
#define WAVE_SYNC() ((void)__shfl(0, 0))
#define MEM_FENCE() do {} while (0)
#define PIN16(a) do {} while (0)
#define LDS_BARRIER() __syncthreads()
#define SCHED_FENCE() do {} while (0)
__device__ __forceinline__ unsigned cvt_pk_bf16(float lo, float hi) { return emu_f2bf(lo) | (emu_f2bf(hi) << 16); }
#else
#define LAS __attribute__((address_space(3)))
#define GAS __attribute__((address_space(1)))
#define LDS_WAIT() asm volatile("s_waitcnt lgkmcnt(0)" ::: "memory")
#define LDS_BARRIER() do { asm volatile("s_waitcnt lgkmcnt(0)" ::: "memory"); __builtin_amdgcn_s_barrier(); asm volatile("" ::: "memory"); } while (0)
#define MEM_FENCE() asm volatile("" ::: "memory")
#define PIN16(a) asm volatile("" : "+v"(a[0]), "+v"(a[1]), "+v"(a[2]), "+v"(a[3]), "+v"(a[4]), "+v"(a[5]), "+v"(a[6]), "+v"(a[7]), "+v"(a[8]), "+v"(a[9]), "+v"(a[10]), "+v"(a[11]), "+v"(a[12]), "+v"(a[13]), "+v"(a[14]), "+v"(a[15]) :: "memory")
#define SCHED_FENCE() __builtin_amdgcn_sched_barrier(0)
#define WAVE_SYNC() do { asm volatile("s_waitcnt lgkmcnt(0)" ::: "memory"); __builtin_amdgcn_wave_barrier(); } while (0)
typedef __bf16 hwbf16x2 __attribute__((ext_vector_type(2)));
__device__ __forceinline__ unsigned cvt_pk_bf16(float lo, float hi) { const f32x2 v = {lo, hi}; return __builtin_bit_cast(unsigned, __builtin_convertvector(v, hwbf16x2)); }
#endif
__device__ __forceinline__ float bf2f(unsigned short b) { return __uint_as_float(((unsigned)b) << 16); }
__device__ __forceinline__ float bflo(unsigned w) { return __uint_as_float(w << 16); }
__device__ __forceinline__ float bfhi(unsigned w) { return __uint_as_float(w & 0xffff0000u); }
__device__ __forceinline__ float wave_sum(float v) {
#pragma unroll
    for (int o = 1; o < 64; o <<= 1) v += __shfl_xor(v, o);
    return v;
}
__device__ __forceinline__ f32x4 mfma16(bf16x8 a, bf16x8 b, f32x4 c) { return __builtin_amdgcn_mfma_f32_16x16x32_bf16(a, b, c, 0, 0, 0); }

struct Frame {
    LAS unsigned char* lds;
    unsigned* ctl;
    unsigned char* ws;
    const float* const* in;
    float* out;
    int tid, lane, wave, vcu, G;
};
constexpr size_t WS_SSQP1 = 6 * MiB, WS_SSQP2 = 7 * MiB, WS_SSQP4 = 62 * MiB, WS_SSQP5 = 63 * MiB;
__device__ __forceinline__ float rstd_np(const float* p, int np, int row) { float s; if (np == 1) s = p[row]; else { const f32x4* q = (const f32x4*)(p + (size_t)row * 16); const f32x4 a = q[0], b = q[1], c = q[2], d = q[3]; s = ((a.x + a.y) + (a.z + a.w)) + ((b.x + b.y) + (b.z + b.w)) + (((c.x + c.y) + (c.z + c.w)) + ((d.x + d.y) + (d.z + d.w))); }
    return frsq(s * (1.f / 1024.f) + EPS); }
__device__ __forceinline__ void rstd_rows8(const float* p, int np, int row0, int fq, float (&out)[2][4]) {
    if (np == 1) { float s[2][4];
#pragma unroll
        for (int ai = 0; ai < 2; ++ai)
#pragma unroll
            for (int m = 0; m < 4; ++m) s[ai][m] = p[row0 + ai * 128 + m * 16];
        SCHED_FENCE();
#pragma unroll
        for (int ai = 0; ai < 2; ++ai)
#pragma unroll
            for (int m = 0; m < 4; ++m) out[ai][m] = frsq(s[ai][m] * (1.f / 1024.f) + EPS); }
    else { f32x4 a[2][4];
#pragma unroll
        for (int ai = 0; ai < 2; ++ai)
#pragma unroll
            for (int m = 0; m < 4; ++m) a[ai][m] = *(const f32x4*)(p + (size_t)(row0 + ai * 128 + m * 16) * 16 + fq * 4);
        SCHED_FENCE();
#pragma unroll
        for (int ai = 0; ai < 2; ++ai)
#pragma unroll
            for (int m = 0; m < 4; ++m) { float s = (a[ai][m].x + a[ai][m].y) + (a[ai][m].z + a[ai][m].w); s += __shfl_xor(s, 16); s += __shfl_xor(s, 32); out[ai][m] = frsq(s * (1.f / 1024.f) + EPS); } }
}
#define OKP(type, off) ((type*)(F.ws + (off)))
#ifdef CPU_EMU
__device__ __forceinline__ Frame phase_frame(const Frame& F0) { return F0; }
#else
__device__ __forceinline__ Frame phase_frame(const Frame& F0) { Frame F = F0; int t = threadIdx.x; asm volatile("" : "+v"(t)); F.tid = t; F.lane = t & 63; F.wave = __builtin_amdgcn_readfirstlane(t >> 6); return F; }
#endif

struct CvtJob { const float* W; int ldw, K, ncols, c0; bf16_t* WT; int drow0, dstep16; const float* kgain; float cscale; };
__device__ __forceinline__ int job_items(const CvtJob& j) { return (j.K / 64) * (j.ncols / 32); }
struct CvtRegs { float wv[32]; };
__device__ __forceinline__ void cvt_load(CvtRegs& r, const CvtJob& j, int item, int lane) {
    const int nblk = j.ncols / 32, kb = item / nblk, nb = item % nblk, k0 = 64 * kb, c0 = j.c0 + 32 * nb;
#pragma unroll
    for (int i = 0; i < 32; ++i) r.wv[i] = j.W[(size_t)(k0 + 2 * i + (lane >> 5)) * j.ldw + c0 + (lane & 31)];
}
__device__ __forceinline__ void cvt_finish(const CvtRegs& r, const CvtJob& j, int item, LAS float* scr, int lane) {
    const int nblk = j.ncols / 32, kb = item / nblk, nb = item % nblk, k0 = 64 * kb, drow0 = j.drow0 + (32 * nb >> 4) * j.dstep16;
#pragma unroll
    for (int i = 0; i < 32; ++i) { const int kk = 2 * i + (lane >> 5); const float g = j.kgain ? j.kgain[k0 + kk] * j.cscale : j.cscale; scr[kk * 33 + (lane & 31)] = r.wv[i] * g; }
    WAVE_SYNC();
    const int c = lane & 7;
#pragma unroll
    for (int jj = 0; jj < 4; ++jj) { const int n = (lane >> 3) + 8 * jj; const LAS float* s = scr + (8 * c) * 33 + n;
        u32x4 o; o.x = cvt_pk_bf16(s[0 * 33], s[1 * 33]); o.y = cvt_pk_bf16(s[2 * 33], s[3 * 33]); o.z = cvt_pk_bf16(s[4 * 33], s[5 * 33]); o.w = cvt_pk_bf16(s[6 * 33], s[7 * 33]);
        *(u32x4*)(j.WT + (size_t)(drow0 + (n >> 4) * j.dstep16 + (n & 15)) * j.K + k0 + 8 * c) = o; }
    WAVE_SYNC();
}
__device__ __forceinline__ CvtJob dense_job(const Frame& F, int j) {
    using namespace sm;
    const float* const* in = F.in;
    switch (j) {
    case 0: return CvtJob{in[I_EV_WIN], 4112, 1024, 4096, 0, OKP(bf16_t, WS_W_IN0), 0, 16, in[I_NORM_MIX], 1.f};
    case 1: return CvtJob{in[I_OD_WIN], 5648, 1024, 4096, 0, OKP(bf16_t, WS_W_IN1), 0, 16, in[I_NORM_MIX] + 1024, 1.f};
    case 2: return CvtJob{in[I_OD_WIN], 5648, 1024, 512, 4112, OKP(bf16_t, WS_W_IN1), 4096, 16, in[I_NORM_MIX] + 1024, 0.125f * LOG2E};
    case 3: return CvtJob{in[I_OD_WIN], 5648, 1024, 1024, 4624, OKP(bf16_t, WS_W_IN1), 4608, 16, in[I_NORM_MIX] + 1024, 1.f};
    case 4: return CvtJob{in[I_EV_WOUT], 1024, 1536, 1024, 0, OKP(bf16_t, WS_W_OUT0), 0, 16, nullptr, 1.f};
    case 5: return CvtJob{in[I_OD_WOUT], 1024, 1536, 1024, 0, OKP(bf16_t, WS_W_OUT1), 0, 16, nullptr, 1.f};
    default: { const int l = (j - 6) / 4, w = (j - 6) % 4; bf16_t* dst = OKP(bf16_t, WS_W_XA + (size_t)l * 8 * MiB + (size_t)w * 2 * MiB);
        const float* src = in[I_XA_WQ + w] + (size_t)l * 1024 * 1024;
        if (w == 0) return CvtJob{src, 1024, 1024, 1024, 0, dst, 0, 16, in[I_NORM_XA] + l * 1024, 0.0625f * LOG2E};
        return CvtJob{src, 1024, 1024, 1024, 0, dst, 0, 16, nullptr, 1.f}; }
    }
}
constexpr int N_DENSE_JOBS = 14;
__device__ __forceinline__ CvtJob moe_job(const Frame& F, int l, int j) {
    using namespace sm;
    const int e = j / 3, w = j % 3; const float* const* in = F.in;
    bf16_t* gu = OKP(bf16_t, WS_MOEW + (size_t)e * 3 * MiB); bf16_t* dn = gu + 1024 * 1024;
    if (w == 0) return CvtJob{in[I_MOE_WGATE] + ((size_t)l * 32 + e) * 1024 * 512, 512, 1024, 512, 0, gu, 0, 32, in[I_NORM_FFN] + l * 1024, 1.f};
    if (w == 1) return CvtJob{in[I_MOE_WUP] + ((size_t)l * 32 + e) * 1024 * 512, 512, 1024, 512, 0, gu, 16, 32, in[I_NORM_FFN] + l * 1024, 1.f};
    return CvtJob{in[I_MOE_WDOWN] + ((size_t)l * 32 + e) * 512 * 1024, 1024, 512, 1024, 0, dn, 0, 16, nullptr, 1.f};
}
__device__ __forceinline__ int dense_total(const Frame& F) { int n = 0; for (int j = 0; j < N_DENSE_JOBS; ++j) n += job_items(dense_job(F, j)); return n; }
__device__ __forceinline__ void dense_item(const Frame& F, int idx, CvtJob& job, int& item) {
    for (int j = 0; j < N_DENSE_JOBS; ++j) { const CvtJob jb = dense_job(F, j); const int n = job_items(jb); job = jb; item = idx < n ? idx : n - 1; if (idx < n) return; idx -= n; }
}
__device__ __forceinline__ void phase_cvt_dense(const Frame& F0) {
    const Frame F = phase_frame(F0);
    LAS float* scr = (LAS float*)(F.lds + F.wave * 16384);
    const int gw = F.vcu * NWAVES + F.wave, NGW = F.G * NWAVES, N = dense_total(F);
    CvtRegs ra, rb;
    auto LD = [&](CvtRegs& r, int idx) { CvtJob jb; int it; dense_item(F, idx < N ? idx : N - 1, jb, it); cvt_load(r, jb, it, F.lane); };
    auto FN = [&](const CvtRegs& r, int idx) { if (idx < N) { CvtJob jb; int it; dense_item(F, idx, jb, it); cvt_finish(r, jb, it, scr, F.lane); } };
    LD(ra, gw);
    for (int idx = gw; idx < N; idx += 2 * NGW) { LD(rb, idx + NGW); FN(ra, idx); LD(ra, idx + 2 * NGW); FN(rb, idx + NGW); }
}
__device__ __forceinline__ void phase_cvt_moe(const Frame& F0, int l) {
    const Frame F = phase_frame(F0);
    LAS float* scr = (LAS float*)(F.lds + F.wave * 16384);
    const int gw = F.vcu * NWAVES + F.wave, NGW = F.G * NWAVES; constexpr int N = 96 * 256;
    CvtRegs ra, rb;
    auto LD = [&](CvtRegs& r, int idx) { const int ii = idx < N ? idx : N - 1; const CvtJob jb = moe_job(F, l, ii >> 8); cvt_load(r, jb, ii & 255, F.lane); };
    auto FN = [&](const CvtRegs& r, int idx) { if (idx < N) { const CvtJob jb = moe_job(F, l, idx >> 8); cvt_finish(r, jb, idx & 255, scr, F.lane); } };
    LD(ra, gw);
    for (int idx = gw; idx < N; idx += 2 * NGW) { LD(rb, idx + NGW); FN(ra, idx); LD(ra, idx + 2 * NGW); FN(rb, idx + NGW); }
}
__device__ __forceinline__ void row_to_bf16_ssq(const float* xrow, bf16_t* orow, float* ssq, int lane) {
    const f32x4* xr = (const f32x4*)xrow + lane; float s = 0.f; f32x4 v[4];
#pragma unroll
    for (int j = 0; j < 4; ++j) { v[j] = xr[64 * j]; s += (v[j].x * v[j].x + v[j].y * v[j].y) + (v[j].z * v[j].z + v[j].w * v[j].w); }
    s = wave_sum(s);
    u32x2* o8 = (u32x2*)orow + lane;
#pragma unroll
    for (int j = 0; j < 4; ++j) { u32x2 w; w.x = cvt_pk_bf16(v[j].x, v[j].y); w.y = cvt_pk_bf16(v[j].z, v[j].w); o8[64 * j] = w; }
    if (lane == 0) *ssq = s;
}
__device__ __forceinline__ void phase_prologue(const Frame& F0) {
    const Frame F = phase_frame(F0);
    using namespace sm;
    phase_cvt_dense(F0);
    const int gw = F.vcu * NWAVES + F.wave, NGW = F.G * NWAVES;
    float* ssq0 = (float*)F.ctl + CW_SSQ;
    for (int m = gw; m < T; m += NGW) row_to_bf16_ssq(F.in[I_X] + (size_t)m * DM, OKP(bf16_t, WS_HB) + (size_t)m * DM, ssq0 + m, F.lane);
    for (int m = gw; m < NB * 256; m += NGW) { const f32x4* xr = (const f32x4*)(F.in[I_MEM] + (size_t)m * DM) + F.lane; const f32x4* gr = (const f32x4*)F.in[I_MEM_NORM] + F.lane; float s = 0.f; f32x4 v[4];
#pragma unroll
        for (int j = 0; j < 4; ++j) { v[j] = xr[64 * j]; s += (v[j].x * v[j].x + v[j].y * v[j].y) + (v[j].z * v[j].z + v[j].w * v[j].w); }
        const float r = 1.f / sqrtf(wave_sum(s) * (1.f / DM) + EPS);
        u32x2* o8 = (u32x2*)(OKP(bf16_t, WS_MEMNB) + (size_t)m * DM) + F.lane;
#pragma unroll
        for (int j = 0; j < 4; ++j) { const f32x4 g = gr[64 * j]; u32x2 w; w.x = cvt_pk_bf16(v[j].x * r * g.x, v[j].y * r * g.y); w.y = cvt_pk_bf16(v[j].z * r * g.z, v[j].w * r * g.w); o8[64 * j] = w; } }
    const size_t gt = (size_t)F.vcu * NT + F.tid, GT = (size_t)F.G * NT;
    for (size_t i = gt; i < 1024 * 16; i += GT) { const int k = (int)(i >> 4), j = (int)(i & 15);
        OKP(float, WS_WDT)[j * 1024 + k] = F.in[I_NORM_MIX][k] * F.in[I_EV_WIN][(size_t)k * 4112 + 4096 + j];
        OKP(float, WS_WAB)[j * 1024 + k] = F.in[I_NORM_MIX][1024 + k] * F.in[I_OD_WIN][(size_t)k * 5648 + 4096 + j]; }
}

#ifndef CPU_EMU
struct EpiScaleBf16 {
    static constexpr bool PERM = true, AFTER_DRAIN = false;
    bf16_t* O; int ldc; const float* ssq; int np;
    __device__ __forceinline__ void operator()(const f32x4 (&acc)[2][2][4][2], const pg8::Unit& u, int wr, int wc, int fr, int fq) const {
        const int row0 = u.pm * 256 + wr * 64 + fr, col0 = u.pn * 256 + wc * 32 + 8 * fq;
        float rs8[2][4];
        if (ssq) rstd_rows8(ssq, np, row0, fq, rs8); else {
#pragma unroll
            for (int i = 0; i < 8; ++i) rs8[i >> 2][i & 3] = 1.f; }
#pragma unroll
        for (int ai = 0; ai < 2; ++ai)
#pragma unroll
            for (int m = 0; m < 4; ++m) { const int row = row0 + ai * 128 + m * 16; const float s = rs8[ai][m]; bf16_t* rowp = O + (size_t)row * ldc + col0;
#pragma unroll
                for (int bj = 0; bj < 2; ++bj) { const f32x4 v0 = acc[ai][bj][m][0] * s, v1 = acc[ai][bj][m][1] * s; u32x4 w; w.x = cvt_pk_bf16(v0[0], v0[1]); w.y = cvt_pk_bf16(v0[2], v0[3]); w.z = cvt_pk_bf16(v1[0], v1[1]); w.w = cvt_pk_bf16(v1[2], v1[3]);
                    *(u32x4*)(rowp + bj * 128) = w; } }
    }
};
template <bool HIN_F32> struct EpiResidualT {
    static constexpr bool PERM = false, AFTER_DRAIN = false;
    const float* hin; bf16_t* hb; float* ssq;
    __device__ __forceinline__ void operator()(const f32x4 (&acc)[2][2][4][2], const pg8::Unit& u, int wr, int wc, int fr, int fq) const {
        const int row0 = u.pm * 256 + wr * 64 + fr, col0 = u.pn * 256 + wc * 32 + 4 * fq;
#pragma unroll
        for (int ai = 0; ai < 2; ++ai) {
            f32x4 hf[HIN_F32 ? 4 : 1][2][2]; u32x2 hw2[HIN_F32 ? 1 : 4][2][2];
#pragma unroll
            for (int m = 0; m < 4; ++m)
#pragma unroll
                for (int bj = 0; bj < 2; ++bj)
#pragma unroll
                    for (int n = 0; n < 2; ++n) { const size_t o = (size_t)(row0 + ai * 128 + m * 16) * DM + col0 + bj * 128 + n * 16;
                        if (HIN_F32) hf[HIN_F32 ? m : 0][bj][n] = *(const f32x4*)(hin + o); else hw2[HIN_F32 ? 0 : m][bj][n] = *(const u32x2*)(hb + o); }
            SCHED_FENCE();
#pragma unroll
            for (int m = 0; m < 4; ++m) { const int row = row0 + ai * 128 + m * 16; const size_t ro = (size_t)row * DM + col0; float s = 0.f;
#pragma unroll
                for (int bj = 0; bj < 2; ++bj)
#pragma unroll
                    for (int n = 0; n < 2; ++n) { const size_t o = ro + bj * 128 + n * 16; f32x4 v;
                        if (HIN_F32) v = hf[HIN_F32 ? m : 0][bj][n]; else { const u32x2 hw = hw2[HIN_F32 ? 0 : m][bj][n]; v = (f32x4){bflo(hw.x), bfhi(hw.x), bflo(hw.y), bfhi(hw.y)}; }
                        v += acc[ai][bj][m][n];
                        u32x2 w; w.x = cvt_pk_bf16(v[0], v[1]); w.y = cvt_pk_bf16(v[2], v[3]); *(u32x2*)(hb + o) = w;
                        const float r0 = bflo(w.x), r1 = bfhi(w.x), r2 = bflo(w.y), r3 = bfhi(w.y); s += (r0 * r0 + r1 * r1) + (r2 * r2 + r3 * r3); }
                s += __shfl_xor(s, 16); s += __shfl_xor(s, 32);
                if (fq == 0) ssq[(size_t)row * 16 + u.pn * 4 + wc] = s; } }
    }
};

template <class Epi> __device__ __forceinline__ void dense_gemm(const Frame& F, const bf16_t* A, const bf16_t* Bt, int M, int N, int K, const Epi& E) {
    pg8::Gemm g{A, Bt, M, N, K}; pg8::StaticOrder S; S.init(g, F.G, (int)blockIdx.x);
    pg8::gemm_phase<Epi, pg8::StaticOrder, true, true>(F.lds, g, S, E);
}
#endif
}

namespace ok {
constexpr int XT_LD = 72;
constexpr int BC_LD = 136;
__device__ __forceinline__ float siluf(float x) { return x * frcp(1.f + fexp(-x)); }
__device__ __forceinline__ float softplusf(float x) { return x > 20.f ? x : log1pf(expf(x)); }

template <class Sink> __device__ __forceinline__ void ssd_conv_pair(const Frame& F, int b, int c, int xc, Sink&& sink) {
    using namespace sm;
    const float* cw = F.in[I_EV_CONVW]; const f32x2 w0 = *(const f32x2*)(cw + xc), w1 = *(const f32x2*)(cw + 1536 + xc), w2 = *(const f32x2*)(cw + 3072 + xc), w3 = *(const f32x2*)(cw + 4608 + xc), bias = *(const f32x2*)(F.in[I_EV_CONVB] + xc);
    const bf16_t* p = OKP(bf16_t, WS_PROJ) + (size_t)(b * L + c * 64) * PROJ0_LD + 2560 + xc;
    unsigned raw[64];
#pragma unroll
    for (int t = 0; t < 64; ++t) raw[t] = *(const unsigned*)(p + (size_t)t * PROJ0_LD);
    f32x2 x0 = {0.f, 0.f}, x1 = x0, x2 = x0;
    if (c > 0) { const unsigned a = *(const unsigned*)(p - 3 * PROJ0_LD), bq = *(const unsigned*)(p - 2 * PROJ0_LD), cq = *(const unsigned*)(p - PROJ0_LD); x0 = (f32x2){bflo(a), bfhi(a)}; x1 = (f32x2){bflo(bq), bfhi(bq)}; x2 = (f32x2){bflo(cq), bfhi(cq)}; }
#pragma unroll
    for (int t = 0; t < 64; t += 2) { const f32x2 x3 = {bflo(raw[t]), bfhi(raw[t])}, x4 = {bflo(raw[t + 1]), bfhi(raw[t + 1])};
        const f32x2 v0 = bias + w0 * x0 + w1 * x1 + w2 * x2 + w3 * x3, v1 = bias + w0 * x1 + w1 * x2 + w2 * x3 + w3 * x4;
        sink(t, siluf(v0.x), siluf(v1.x), siluf(v0.y), siluf(v1.y)); x0 = x2; x1 = x3; x2 = x4; }
}

__device__ __forceinline__ void phase_ssd_a(const Frame& F0) {
    const Frame F = phase_frame(F0);
    using namespace sm;
    LAS bf16_t* XT = (LAS bf16_t*)F.lds; LAS bf16_t* BT = (LAS bf16_t*)(F.lds + 73728);
    LAS float* dt_s = (LAS float*)(F.lds + 92160); LAS float* acs_s = (LAS float*)(F.lds + 94208); LAS float* sc_s = (LAS float*)(F.lds + 96256);
    const int tid = F.tid, lane = F.lane, wave = F.wave;
    for (int u = F.vcu; u < NB * NCH * 2; u += F.G) {
        const int g = u & 1, bc = u >> 1, b = bc / NCH, c = bc % NCH; const size_t row0 = (size_t)b * L + c * 64;
        LDS_BARRIER();
        if (tid < 320) { const int ci = tid * 2;
            const int xc = ci < 512 ? g * 512 + ci : 1024 + g * 128 + (ci - 512);
            LAS unsigned* dst = (LAS unsigned*)(ci < 512 ? XT + ci * XT_LD : BT + (ci - 512) * XT_LD);
            ssd_conv_pair(F, b, c, xc, [&](int t, float a0, float a1, float b0, float b1) { dst[t >> 1] = cvt_pk_bf16(a0, a1); dst[XT_LD / 2 + (t >> 1)] = cvt_pk_bf16(b0, b1); });
        }
        { const int t = tid & 63, hh = tid >> 6, hd = g * 8 + hh; const float dt = softplusf(OKP(float, WS_RAW16)[(row0 + t) * 16 + hd] + F.in[I_EV_DTB][hd]); dt_s[hh * 64 + t] = dt; acs_s[hh * 64 + t] = dt * -expf(F.in[I_EV_ALOG][hd]); }
        LDS_BARRIER();
        { const int hh = wave, hd = g * 8 + hh; float v = acs_s[hh * 64 + lane];
#pragma unroll
          for (int o = 1; o < 64; o <<= 1) { const float n = __shfl_up(v, o); if (lane >= o) v += n; }
          const float last = __shfl(v, 63); const float dt = dt_s[hh * 64 + lane];
          sc_s[hh * 64 + lane] = dt * fexp(last - v);
          OKP(float, WS_DTV)[(row0 + lane) * 16 + hd] = dt; OKP(float, WS_ACS)[(row0 + lane) * 16 + hd] = v; }
        WAVE_SYNC();
#if defined(CHECK_DUMP)
        if (bc == 5 && g == 0) {
            float* f3 = OKP(float, WS_FP) + (size_t)3 * 16 * 6144; float* f4 = OKP(float, WS_FP) + (size_t)4 * 16 * 6144; float* f5 = OKP(float, WS_FP) + (size_t)5 * 16 * 6144;
            for (int i = tid; i < 512 * 64; i += NT) f3[i] = bf2f(XT[(i >> 6) * XT_LD + (i & 63)]);
            for (int i = tid; i < 128 * 64; i += NT) f4[i] = bf2f(BT[(i >> 6) * XT_LD + (i & 63)]);
            f5[wave * 64 + lane] = sc_s[wave * 64 + lane];
        }
#endif
        { const int hh = wave, hd = g * 8 + hh, fr = lane & 15, fq = lane >> 4;
          bf16x8 xa[4][2];
#pragma unroll
          for (int pt = 0; pt < 4; ++pt)
#pragma unroll
              for (int ks = 0; ks < 2; ++ks) { const u32x4 raw = *(const LAS u32x4*)(XT + (hh * 64 + pt * 16 + fr) * XT_LD + ks * 32 + fq * 8); const LAS float* sp = sc_s + hh * 64 + ks * 32 + fq * 8;
                  const f32x4 s0 = *(const LAS f32x4*)sp, s1 = *(const LAS f32x4*)(sp + 4); u32x4 o;
                  o.x = cvt_pk_bf16(bflo(raw.x) * s0.x, bfhi(raw.x) * s0.y); o.y = cvt_pk_bf16(bflo(raw.y) * s0.z, bfhi(raw.y) * s0.w);
                  o.z = cvt_pk_bf16(bflo(raw.z) * s1.x, bfhi(raw.z) * s1.y); o.w = cvt_pk_bf16(bflo(raw.w) * s1.z, bfhi(raw.w) * s1.w);
                  xa[pt][ks] = __builtin_bit_cast(bf16x8, o); }
          bf16_t* st = OKP(bf16_t, WS_STATES) + ((size_t)bc * 16 + hd) * 8192;
#pragma unroll
          for (int nt = 0; nt < 8; ++nt) { bf16x8 bb[2];
#pragma unroll
              for (int ks = 0; ks < 2; ++ks) bb[ks] = *(const LAS bf16x8*)(BT + (nt * 16 + fr) * XT_LD + ks * 32 + fq * 8);
#pragma unroll
              for (int pt = 0; pt < 4; ++pt) { f32x4 acc = {0.f, 0.f, 0.f, 0.f};
#pragma unroll
                  for (int ks = 0; ks < 2; ++ks) acc = mfma16(bb[ks], xa[pt][ks], acc);
                  u32x2 w; w.x = cvt_pk_bf16(acc[0], acc[1]); w.y = cvt_pk_bf16(acc[2], acc[3]);
                  *(u32x2*)(st + (size_t)(pt * 16 + fr) * 128 + nt * 16 + 4 * fq) = w; } } }
    }
}

__device__ __forceinline__ void phase_ssd_scan(const Frame& F0, int skip) {
    const Frame F = phase_frame(F0);
    const float* acs = OKP(float, WS_ACS);
    int widx = F.vcu, nw = F.G;
    if (skip) { const int per = F.G / 8, xcd = F.vcu / per, loc = F.vcu % per, sk = skip / 8; if (loc < sk) return; widx = xcd * (per - sk) + (loc - sk); nw = F.G - skip; }
    for (int idx = widx * NT + F.tid; idx < NB * 65536; idx += nw * NT) {
        const int b = idx >> 16, r2 = idx & 65535, hd = r2 >> 12; unsigned* p = (unsigned*)(OKP(bf16_t, WS_STATES) + (size_t)b * NCH * 131072) + r2;
        float s0 = 0.f, s1 = 0.f;
#pragma unroll 8
        for (int c = 0; c < NCH; ++c) { const unsigned st = p[(size_t)c * 65536]; const float dec = fexp(acs[((size_t)b * L + c * 64 + 63) * 16 + hd]);
            p[(size_t)c * 65536] = cvt_pk_bf16(s0, s1); s0 = s0 * dec + bflo(st); s1 = s1 * dec + bfhi(st); }
    }
}

__device__ __forceinline__ void phase_ssd_b(const Frame& F0) {
    const Frame F = phase_frame(F0);
    using namespace sm;
    LAS bf16_t* XT = (LAS bf16_t*)F.lds; LAS bf16_t* Bs = (LAS bf16_t*)(F.lds + 73728); LAS bf16_t* Cs = (LAS bf16_t*)(F.lds + 91136);
    LAS float* acs_s = (LAS float*)(F.lds + 108544); LAS float* dt_s = (LAS float*)(F.lds + 110592); LAS float* red = (LAS float*)(F.lds + 112640);
    const int tid = F.tid, lane = F.lane, wave = F.wave, fr = lane & 15, fq = lane >> 4;
    const bf16_t* proj = OKP(bf16_t, WS_PROJ); bf16_t* cat = OKP(bf16_t, WS_CAT0);
    for (int u = F.vcu; u < NB * NCH * 2; u += F.G) {
        const int g = u & 1, bc = u >> 1, b = bc / NCH, c = bc % NCH; const size_t row0 = (size_t)b * L + c * 64;
        LDS_BARRIER();
        if (tid < 384) { const int ci = tid * 2;
            if (ci < 512) { LAS unsigned* dst = (LAS unsigned*)(XT + ci * XT_LD); ssd_conv_pair(F, b, c, g * 512 + ci, [&](int t, float a0, float a1, float b0, float b1) { dst[t >> 1] = cvt_pk_bf16(a0, a1); dst[XT_LD / 2 + (t >> 1)] = cvt_pk_bf16(b0, b1); }); }
            else { const int n = (ci - 512) & 127; LAS unsigned* dst = (LAS unsigned*)((ci < 640 ? Bs : Cs) + n); const int xc = (ci < 640 ? 1024 : 1280) + g * 128 + n;
                ssd_conv_pair(F, b, c, xc, [&](int t, float a0, float a1, float b0, float b1) { dst[t * (BC_LD / 2)] = cvt_pk_bf16(a0, b0); dst[(t + 1) * (BC_LD / 2)] = cvt_pk_bf16(a1, b1); }); }
        }
        { const int t = tid & 63, hh = tid >> 6; acs_s[hh * 64 + t] = OKP(float, WS_ACS)[(row0 + t) * 16 + g * 8 + hh]; dt_s[hh * 64 + t] = OKP(float, WS_DTV)[(row0 + t) * 16 + g * 8 + hh]; }
        { const int ch = g * 256 + (tid & 255), t0 = (tid >> 8) * 32; const float* w = F.in[I_EV_SCCONV]; const float w0 = w[ch], w1 = w[512 + ch], w2 = w[1024 + ch];
          const bf16_t* p = proj + (row0 + t0) * PROJ0_LD + ch; float p0 = 0.f, p1 = 0.f;
          if (c > 0 || t0 > 0) { p0 = bf2f(p[-2 * PROJ0_LD + 512]) * bf2f(p[-2 * PROJ0_LD + 1024]); p1 = bf2f(p[-PROJ0_LD + 512]) * bf2f(p[-PROJ0_LD + 1024]); }
          unsigned short rb[32], rc[32], rx[32];
#pragma unroll
          for (int t = 0; t < 32; ++t) { const bf16_t* q = p + (size_t)t * PROJ0_LD; rb[t] = q[0]; rc[t] = q[512]; rx[t] = q[1024]; }
#pragma unroll
          for (int t = 0; t < 32; ++t) { const float p2 = bf2f(rc[t]) * bf2f(rx[t]); const float y = bf2f(rb[t]) * (w0 * p0 + w1 * p1 + w2 * p2);
              cat[(row0 + t0 + t) * 1536 + ch] = (bf16_t)(cvt_pk_bf16(y, 0.f) & 0xffffu); p0 = p1; p1 = p2; } }
        LDS_BARRIER();
        const int hh = wave, hd = g * 8 + hh;
        f32x4 Y[4][4];
        { const bf16_t* P = OKP(bf16_t, WS_STATES) + ((size_t)bc * 16 + hd) * 8192;
#pragma unroll
          for (int pt = 0; pt < 4; ++pt)
#pragma unroll
              for (int tt = 0; tt < 4; ++tt) Y[pt][tt] = (f32x4){0.f, 0.f, 0.f, 0.f};
          bf16x8 pall[4][4];
#pragma unroll
          for (int ks = 0; ks < 4; ++ks)
#pragma unroll
              for (int pt = 0; pt < 4; ++pt) pall[ks][pt] = *(const bf16x8*)(P + (size_t)(pt * 16 + fr) * 128 + ks * 32 + fq * 8);
#pragma unroll
          for (int ks = 0; ks < 4; ++ks) { bf16x8 cb[4];
#pragma unroll
              for (int tt = 0; tt < 4; ++tt) cb[tt] = *(const LAS bf16x8*)(Cs + (tt * 16 + fr) * BC_LD + ks * 32 + fq * 8);
#pragma unroll
              for (int pt = 0; pt < 4; ++pt)
#pragma unroll
                  for (int tt = 0; tt < 4; ++tt) Y[pt][tt] = mfma16(pall[ks][pt], cb[tt], Y[pt][tt]); }
#pragma unroll
          for (int tt = 0; tt < 4; ++tt) { const float e = fexp(acs_s[hh * 64 + tt * 16 + fr]);
#pragma unroll
              for (int pt = 0; pt < 4; ++pt) Y[pt][tt] *= e; } }
#pragma unroll
        for (int tt = 0; tt < 4; ++tt) { f32x4 cbt[4];
#pragma unroll
            for (int st = 0; st < 4; ++st) cbt[st] = (f32x4){0.f, 0.f, 0.f, 0.f};
#pragma unroll
            for (int ks = 0; ks < 4; ++ks) { const bf16x8 cf = *(const LAS bf16x8*)(Cs + (tt * 16 + fr) * BC_LD + ks * 32 + fq * 8);
#pragma unroll
                for (int st = 0; st < 4; ++st) if (st <= tt) { const bf16x8 bf = *(const LAS bf16x8*)(Bs + (st * 16 + fr) * BC_LD + ks * 32 + fq * 8); cbt[st] = mfma16(bf, cf, cbt[st]); } }
            const int t = tt * 16 + fr; const float at = acs_s[hh * 64 + t];
#pragma unroll
            for (int st = 0; st < 4; ++st) { const f32x4 as4 = *(const LAS f32x4*)(acs_s + hh * 64 + st * 16 + 4 * fq), dt4 = *(const LAS f32x4*)(dt_s + hh * 64 + st * 16 + 4 * fq);
#pragma unroll
                for (int r = 0; r < 4; ++r) { const int s = st * 16 + 4 * fq + r; cbt[st][r] = (st <= tt && s <= t) ? cbt[st][r] * fexp(at - as4[r]) * dt4[r] : 0.f; } }
            bf16x8 mb[2];
#pragma unroll
            for (int ks = 0; ks < 2; ++ks) { u32x4 o; o.x = cvt_pk_bf16(cbt[2 * ks][0], cbt[2 * ks][1]); o.y = cvt_pk_bf16(cbt[2 * ks][2], cbt[2 * ks][3]); o.z = cvt_pk_bf16(cbt[2 * ks + 1][0], cbt[2 * ks + 1][1]); o.w = cvt_pk_bf16(cbt[2 * ks + 1][2], cbt[2 * ks + 1][3]);
                mb[ks] = __builtin_bit_cast(bf16x8, o); }
#pragma unroll
            for (int pt = 0; pt < 4; ++pt)
#pragma unroll
                for (int ks = 0; ks < 2; ++ks) { const LAS bf16_t* xp = XT + (hh * 64 + pt * 16 + fr) * XT_LD + ks * 32 + 4 * fq; const u32x2 lo = *(const LAS u32x2*)xp, hi = *(const LAS u32x2*)(xp + 16);
                    u32x4 a; a.x = lo.x; a.y = lo.y; a.z = hi.x; a.w = hi.y; Y[pt][tt] = mfma16(__builtin_bit_cast(bf16x8, a), mb[ks], Y[pt][tt]); } }
        u32x2 zz_[4][4];
#pragma unroll
        for (int tt = 0; tt < 4; ++tt)
#pragma unroll
            for (int pt = 0; pt < 4; ++pt) zz_[tt][pt] = *(const u32x2*)(proj + (row0 + tt * 16 + fr) * PROJ0_LD + 1536 + hd * 64 + pt * 16 + 4 * fq);
        SCHED_FENCE();
        const float Dh = F.in[I_EV_D][hd];
#pragma unroll
        for (int tt = 0; tt < 4; ++tt) { const int t = tt * 16 + fr; float ss = 0.f;
#pragma unroll
            for (int pt = 0; pt < 4; ++pt) { const int p = pt * 16 + 4 * fq; const u32x2 zz = zz_[tt][pt];
                const float z0 = bflo(zz.x), z1 = bfhi(zz.x), z2 = bflo(zz.y), z3 = bfhi(zz.y); const LAS bf16_t* xp = XT + (hh * 64 + p) * XT_LD + t;
                f32x4 y = Y[pt][tt]; y[0] = (y[0] + Dh * bf2f(xp[0])) * siluf(z0); y[1] = (y[1] + Dh * bf2f(xp[XT_LD])) * siluf(z1); y[2] = (y[2] + Dh * bf2f(xp[2 * XT_LD])) * siluf(z2); y[3] = (y[3] + Dh * bf2f(xp[3 * XT_LD])) * siluf(z3);
                Y[pt][tt] = y; ss += (y[0] * y[0] + y[1] * y[1]) + (y[2] * y[2] + y[3] * y[3]); }
            ss += __shfl_xor(ss, 16); ss += __shfl_xor(ss, 32);
            if (fq == 0) red[hh * 64 + t] = ss; }
        f32x4 nw_[4];
#pragma unroll
        for (int pt = 0; pt < 4; ++pt) nw_[pt] = *(const f32x4*)(F.in[I_EV_NORM] + hd * 64 + pt * 16 + 4 * fq);
        LDS_BARRIER();
#pragma unroll
        for (int tt = 0; tt < 4; ++tt) { const int t = tt * 16 + fr; float ss = 0.f;
#pragma unroll
            for (int w = 0; w < 8; ++w) ss += red[w * 64 + t];
            const float rs = frsq(ss * (1.f / 512.f) + EPS);
#pragma unroll
            for (int pt = 0; pt < 4; ++pt) { const int ch = hd * 64 + pt * 16 + 4 * fq; const f32x4 nw = nw_[pt]; const f32x4 y = Y[pt][tt];
                u32x2 w; w.x = cvt_pk_bf16(y[0] * rs * nw.x, y[1] * rs * nw.y); w.y = cvt_pk_bf16(y[2] * rs * nw.z, y[3] * rs * nw.w);
                *(u32x2*)(cat + (row0 + t) * 1536 + 512 + ch) = w; } }
    }
}
}

namespace ok {
constexpr int XA_LD = 264;

__device__ __forceinline__ void phase_xattn(const Frame& F0, const bf16_t* q, const bf16_t* kx, const bf16_t* vt, bf16_t* att) {
    const Frame F = phase_frame(F0);
    LAS bf16_t* KV = (LAS bf16_t*)F.lds;
    const int tid = F.tid, lane = F.lane, wave = F.wave, fr = lane & 15, fq = lane >> 4;
    u32x4 tile[8];
#define XA_LOAD_K(uu) do { const int hd_ = (uu) & 3, b_ = (((uu) >> 2) * 128) / L; _Pragma("unroll") for (int j_ = 0; j_ < 8; ++j_) { const int i_ = tid + j_ * NT, r_ = i_ >> 5, c8_ = i_ & 31; tile[j_] = *(const u32x4*)(kx + (size_t)(b_ * 256 + r_) * 1024 + hd_ * 256 + c8_ * 8); } } while (0)
#define XA_LOAD_V(uu) do { const int hd_ = (uu) & 3, b_ = (((uu) >> 2) * 128) / L; _Pragma("unroll") for (int j_ = 0; j_ < 8; ++j_) { const int i_ = tid + j_ * NT, r_ = i_ >> 5, c8_ = i_ & 31; tile[j_] = *(const u32x4*)(vt + (size_t)(hd_ * 256 + r_) * (NB * 256) + b_ * 256 + c8_ * 8); } } while (0)
#define XA_STORE() do { _Pragma("unroll") for (int j_ = 0; j_ < 8; ++j_) { const int i_ = tid + j_ * NT, r_ = i_ >> 5, c8_ = i_ & 31; *(LAS u32x4*)(KV + r_ * XA_LD + c8_ * 8) = tile[j_]; } } while (0)
#define XA_STORE_REST() do { _Pragma("unroll") for (int j_ = 8; j_ < 16; ++j_) { const int i_ = tid + j_ * NT, r_ = i_ >> 5, c8_ = i_ & 31; *(LAS u32x4*)(KV + r_ * XA_LD + c8_ * 8) = rest[j_ - 8]; } } while (0)
#define XA_REST_K(uu) do { const int hd_ = (uu) & 3, b_ = (((uu) >> 2) * 128) / L; _Pragma("unroll") for (int j_ = 8; j_ < 16; ++j_) { const int i_ = tid + j_ * NT, r_ = i_ >> 5, c8_ = i_ & 31; rest[j_ - 8] = *(const u32x4*)(kx + (size_t)(b_ * 256 + r_) * 1024 + hd_ * 256 + c8_ * 8); } } while (0)
#define XA_REST_V(uu) do { const int hd_ = (uu) & 3, b_ = (((uu) >> 2) * 128) / L; _Pragma("unroll") for (int j_ = 8; j_ < 16; ++j_) { const int i_ = tid + j_ * NT, r_ = i_ >> 5, c8_ = i_ & 31; rest[j_ - 8] = *(const u32x4*)(vt + (size_t)(hd_ * 256 + r_) * (NB * 256) + b_ * 256 + c8_ * 8); } } while (0)
    if (F.vcu < (T / 128) * 4) XA_LOAD_K(F.vcu);
    for (int u = F.vcu; u < (T / 128) * 4; u += F.G) {
        const int hd = u & 3, rt = u >> 2, row0 = rt * 128;
        LDS_BARRIER();
        bf16x8 qf[8];
        { u32x4 rest[8]; XA_REST_K(u);
          const bf16_t* qp = q + (size_t)(row0 + wave * 16 + fr) * 1024 + hd * 256 + fq * 8;
#pragma unroll
          for (int ks = 0; ks < 8; ++ks) qf[ks] = *(const bf16x8*)(qp + ks * 32);
          SCHED_FENCE(); XA_STORE(); XA_STORE_REST(); }
        XA_LOAD_V(u);
        LDS_BARRIER();
        bf16x8 pf[8]; float fA, fB;
        {
            float mh[2], lh[2];
#pragma unroll
            for (int half = 0; half < 2; ++half) {
                f32x4 s[8];
#pragma unroll
                for (int kt = 0; kt < 8; ++kt) { s[kt] = (f32x4){0.f, 0.f, 0.f, 0.f};
#pragma unroll
                    for (int ks = 0; ks < 8; ++ks) { const bf16x8 kf = *(const LAS bf16x8*)(KV + ((half * 8 + kt) * 16 + fr) * XA_LD + ks * 32 + fq * 8); s[kt] = mfma16(kf, qf[ks], s[kt]); }
                    }
                float m = -3.0e38f;
#pragma unroll
                for (int kt = 0; kt < 8; ++kt) m = fmaxf(m, fmaxf(fmaxf(s[kt][0], s[kt][1]), fmaxf(s[kt][2], s[kt][3])));
                m = fmaxf(m, __shfl_xor(m, 16)); m = fmaxf(m, __shfl_xor(m, 32));
                float l = 0.f;
#pragma unroll
                for (int kt = 0; kt < 8; ++kt) {
#pragma unroll
                    for (int r = 0; r < 4; ++r) { const float p = fexp2(s[kt][r] - m); s[kt][r] = p; l += p; } }
                l += __shfl_xor(l, 16); l += __shfl_xor(l, 32); mh[half] = m; lh[half] = l;
#pragma unroll
                for (int j = 0; j < 4; ++j) { u32x4 o; o.x = cvt_pk_bf16(s[2 * j][0], s[2 * j][1]); o.y = cvt_pk_bf16(s[2 * j][2], s[2 * j][3]); o.z = cvt_pk_bf16(s[2 * j + 1][0], s[2 * j + 1][1]); o.w = cvt_pk_bf16(s[2 * j + 1][2], s[2 * j + 1][3]);
                    pf[half * 4 + j] = __builtin_bit_cast(bf16x8, o); }
                    }
            const float m = fmaxf(mh[0], mh[1]), cA = fexp2(mh[0] - m), cB = fexp2(mh[1] - m), li = frcp(cA * lh[0] + cB * lh[1]); fA = cA * li; fB = cB * li;
        }
        LDS_BARRIER();
        { u32x4 rest[8]; XA_REST_V(u); SCHED_FENCE(); XA_STORE(); XA_STORE_REST(); }
        if (u + F.G < (T / 128) * 4) XA_LOAD_K(u + F.G);
        LDS_BARRIER();
#pragma unroll 2
        for (int dt = 0; dt < 16; ++dt) { f32x4 oA = {0.f, 0.f, 0.f, 0.f}, oB = oA;
#pragma unroll
            for (int j = 0; j < 8; ++j) { const LAS bf16_t* vp = KV + (dt * 16 + fr) * XA_LD + j * 32 + 4 * fq; const u32x2 lo = *(const LAS u32x2*)vp, hi = *(const LAS u32x2*)(vp + 16);
                u32x4 a; a.x = lo.x; a.y = lo.y; a.z = hi.x; a.w = hi.y; const bf16x8 vf = __builtin_bit_cast(bf16x8, a);
                if (j < 4) oA = mfma16(vf, pf[j], oA); else oB = mfma16(vf, pf[j], oB); }
            const f32x4 o = oA * fA + oB * fB;
            bf16_t* op = att + (size_t)(row0 + wave * 16 + fr) * 1024 + hd * 256 + dt * 16 + 4 * fq;
            u32x2 w; w.x = cvt_pk_bf16(o[0], o[1]); w.y = cvt_pk_bf16(o[2], o[3]); *(u32x2*)op = w; }
    }
#undef XA_LOAD_K
#undef XA_LOAD_V
#undef XA_STORE
#undef XA_REST_K
#undef XA_STORE_REST
#undef XA_REST_V
}

#ifndef CPU_EMU
struct KvOrder {
    static constexpr bool LIGHT = false;
    const char* memnb; const char* wxa; char* kx; char* vt; int G, c;
    __device__ bool next(int i, pg8::Unit& u) const {
        const int Lx = i * G + c; if (Lx >= 32) return false;
        const int l = Lx >> 4, r = Lx & 15; const size_t tstep = (size_t)256 * 1024 * 2;
        if (r < 8) { u.pm = r >> 2; u.pn = r & 3; u.tag = l * 2; u.a = memnb + (size_t)u.pm * tstep; u.b = wxa + (size_t)l * 8 * MiB + 2 * MiB + (size_t)u.pn * tstep; }
        else { const int r2 = r - 8; u.pm = r2 >> 1; u.pn = r2 & 1; u.tag = l * 2 + 1; u.a = wxa + (size_t)l * 8 * MiB + 4 * MiB + (size_t)u.pm * tstep; u.b = memnb + (size_t)u.pn * tstep; }
        return true;
    }
    __device__ __forceinline__ void a_ready(const pg8::Unit&) const {}
    __device__ __forceinline__ void done(const pg8::Unit&) const {}
};
struct EpiKv {
    static constexpr bool PERM = true, AFTER_DRAIN = false;
    bf16_t* kx; bf16_t* vt;
    __device__ __forceinline__ void operator()(const f32x4 (&acc)[2][2][4][2], const pg8::Unit& u, int wr, int wc, int fr, int fq) const {
        const int l = u.tag >> 1, isv = u.tag & 1, ldc = isv ? 512 : 1024; bf16_t* O = isv ? vt + (size_t)l * 1024 * 512 : kx + (size_t)l * 512 * 1024;
        const int row0 = u.pm * 256 + wr * 64 + fr, col0 = u.pn * 256 + wc * 32 + 8 * fq;
#pragma unroll
        for (int ai = 0; ai < 2; ++ai)
#pragma unroll
            for (int m = 0; m < 4; ++m) { bf16_t* rowp = O + (size_t)(row0 + ai * 128 + m * 16) * ldc + col0;
#pragma unroll
                for (int bj = 0; bj < 2; ++bj) { const f32x4 v0 = acc[ai][bj][m][0], v1 = acc[ai][bj][m][1]; u32x4 w; w.x = cvt_pk_bf16(v0[0], v0[1]); w.y = cvt_pk_bf16(v0[2], v0[3]); w.z = cvt_pk_bf16(v1[0], v1[1]); w.w = cvt_pk_bf16(v1[2], v1[3]);
                    *(u32x4*)(rowp + bj * 128) = w; } }
    }
};
__device__ __forceinline__ void phase_kv(const Frame& F) {
    pg8::Gemm g{nullptr, nullptr, 0, 0, 1024};
    int vcu_; { const int bx = blockIdx.x, G = gridDim.x; vcu_ = (G % 8 == 0) ? (bx % 8) * (G / 8) + bx / 8 : bx; if (G % 8 == 0 && G >= 64) { const int per = G / 8, xcd = vcu_ / per, loc = vcu_ % per; vcu_ = loc < 4 ? xcd * 4 + loc : 32 + vcu_; } }
    KvOrder S{(const char*)OKP(bf16_t, WS_MEMNB), (const char*)OKP(bf16_t, WS_W_XA), (char*)OKP(bf16_t, WS_KX), (char*)OKP(bf16_t, WS_VT), F.G, vcu_};
    EpiKv E{OKP(bf16_t, WS_KX), OKP(bf16_t, WS_VT)};
    pg8::gemm_phase<EpiKv, KvOrder, true, true>(F.lds, g, S, E);
}
#endif
}

namespace ok {
constexpr size_t WS_WRH = WS_WR, WS_WRL = WS_WR + 256 * KiB;
constexpr size_t WS_POS = WS_TILEEXP + 4 * KiB;
__device__ __forceinline__ void prologue_router_tables(const Frame& F0) {
    const Frame F = phase_frame(F0);
    using namespace sm;
    const size_t gt = (size_t)F.vcu * NT + F.tid, GT = (size_t)F.G * NT;
    for (size_t i = gt; i < (size_t)2 * 48 * 1024; i += GT) { const int l = (int)(i / (48 * 1024)), j = (int)((i / 1024) % 48), k = (int)(i % 1024); float v = 0.f;
        if (j < 4) v = F.in[I_MOE_WG][((size_t)l * 1024 + k) * 4 + j]; else if (j < 36) v = F.in[I_MOE_WE][((size_t)l * 1024 + k) * 32 + (j - 4)];
        v *= F.in[I_NORM_FFN][l * 1024 + k];
        const unsigned hi = cvt_pk_bf16(v, 0.f) & 0xffffu; const float rem = v - __uint_as_float(hi << 16);
        OKP(bf16_t, WS_WRH)[i] = (bf16_t)hi; OKP(bf16_t, WS_WRL)[i] = (bf16_t)(cvt_pk_bf16(rem, 0.f) & 0xffffu); }
}

constexpr size_t WS_W16H = WS_WR + 512 * KiB, WS_W16L = WS_W16H + 64 * KiB;
__device__ __forceinline__ void prologue_w16_tables(const Frame& F0) {
    using namespace sm;
    const Frame F = phase_frame(F0);
    const size_t gt = (size_t)F.vcu * NT + F.tid, GT = (size_t)F.G * NT;
    for (size_t i = gt; i < (size_t)2 * 16 * 1024; i += GT) { const int set = (int)(i >> 14), j = (int)((i >> 10) & 15), k = (int)(i & 1023);
        const float v = set == 0 ? F.in[I_NORM_MIX][k] * F.in[I_EV_WIN][(size_t)k * 4112 + 4096 + j] : F.in[I_NORM_MIX][1024 + k] * F.in[I_OD_WIN][(size_t)k * 5648 + 4096 + j];
        const unsigned hi = cvt_pk_bf16(v, 0.f) & 0xffffu; const float rem = v - __uint_as_float(hi << 16);
        OKP(bf16_t, WS_W16H)[i] = (bf16_t)hi; OKP(bf16_t, WS_W16L)[i] = (bf16_t)(cvt_pk_bf16(rem, 0.f) & 0xffffu); }
}
__device__ __forceinline__ void phase_proj16(const Frame& F0, int set, const float* h, const bf16_t* hb, const float* ssq, int np) {
    const Frame F = phase_frame(F0);
    const int lane = F.lane, fr = lane & 15, fq = lane >> 4;
    const bf16_t* wh = OKP(bf16_t, WS_W16H) + (size_t)set * 16 * 1024; const bf16_t* wl = OKP(bf16_t, WS_W16L) + (size_t)set * 16 * 1024;
    const int gw = F.vcu * NWAVES + F.wave, NGW = F.G * NWAVES;
    for (int tile = gw; tile < T / 16; tile += NGW) { const int t0 = tile * 16; f32x4 acc = {0.f, 0.f, 0.f, 0.f};
        const float* hp = h + (size_t)(t0 + fr) * DM + fq * 8;
        if (hb) { const bf16_t* ap = hb + (size_t)(t0 + fr) * DM + fq * 8;
#pragma unroll 1
            for (int kb = 0; kb < 4; ++kb) { bf16x8 bh[8], bl[8], ah[8];
#pragma unroll
                for (int k8 = 0; k8 < 8; ++k8) { const size_t wo = (size_t)fr * 1024 + (kb * 8 + k8) * 32 + fq * 8; bh[k8] = *(const bf16x8*)(wh + wo); bl[k8] = *(const bf16x8*)(wl + wo); ah[k8] = *(const bf16x8*)(ap + (kb * 8 + k8) * 32); }
                SCHED_FENCE();
#pragma unroll
                for (int k8 = 0; k8 < 8; ++k8) { acc = mfma16(bh[k8], ah[k8], acc); acc = mfma16(bl[k8], ah[k8], acc); }
                SCHED_FENCE(); } }
        else {
#pragma unroll 1
            for (int kb = 0; kb < 4; ++kb) { bf16x8 bh[8], bl[8]; f32x4 xa[8], xb[8];
#pragma unroll
                for (int k8 = 0; k8 < 8; ++k8) { const size_t wo = (size_t)fr * 1024 + (kb * 8 + k8) * 32 + fq * 8; bh[k8] = *(const bf16x8*)(wh + wo); bl[k8] = *(const bf16x8*)(wl + wo); xa[k8] = *(const f32x4*)(hp + (kb * 8 + k8) * 32); xb[k8] = *(const f32x4*)(hp + (kb * 8 + k8) * 32 + 4); }
                SCHED_FENCE();
#pragma unroll
                for (int k8 = 0; k8 < 8; ++k8) { const f32x4 x0 = xa[k8], x1 = xb[k8];
            u32x4 hi, lo;
            hi.x = cvt_pk_bf16(x0[0], x0[1]); hi.y = cvt_pk_bf16(x0[2], x0[3]); hi.z = cvt_pk_bf16(x1[0], x1[1]); hi.w = cvt_pk_bf16(x1[2], x1[3]);
            lo.x = cvt_pk_bf16(x0[0] - bflo(hi.x), x0[1] - bfhi(hi.x)); lo.y = cvt_pk_bf16(x0[2] - bflo(hi.y), x0[3] - bfhi(hi.y));
            lo.z = cvt_pk_bf16(x1[0] - bflo(hi.z), x1[1] - bfhi(hi.z)); lo.w = cvt_pk_bf16(x1[2] - bflo(hi.w), x1[3] - bfhi(hi.w));
            const bf16x8 ah = __builtin_bit_cast(bf16x8, hi), al = __builtin_bit_cast(bf16x8, lo);
            acc = mfma16(bh[k8], ah, acc); acc = mfma16(bl[k8], ah, acc); acc = mfma16(bh[k8], al, acc); }
                SCHED_FENCE(); } }
        acc *= rstd_np(ssq, np, t0 + fr);
        *(f32x4*)(OKP(float, WS_RAW16) + (size_t)(t0 + fr) * 16 + 4 * fq) = acc; }
}

__device__ __forceinline__ void phase_router(const Frame& F0, int l, const bf16_t* hb, const float* ssq, int np) {
    const Frame F = phase_frame(F0);
    using namespace sm;
    const int lane = F.lane, wave = F.wave, fr = lane & 15, fq = lane >> 4;
    LAS float* lg = (LAS float*)(F.lds + wave * 16384 + 8704);
    const bf16_t* wh = OKP(bf16_t, WS_WRH) + (size_t)l * 48 * 1024; const bf16_t* wl = OKP(bf16_t, WS_WRL) + (size_t)l * 48 * 1024;
    const float* bg = F.in[I_MOE_BG] + l * 4; const float* be = F.in[I_MOE_BE] + l * 32;
    unsigned* cnt = F.ctl + CW_MOE + l * 64;
    const int gw = F.vcu * NWAVES + wave, NGW = F.G * NWAVES;
    for (int tile = gw; tile < T / 16; tile += NGW) {
        const int t0 = tile * 16;
        f32x4 acc[3] = {{0.f, 0.f, 0.f, 0.f}, {0.f, 0.f, 0.f, 0.f}, {0.f, 0.f, 0.f, 0.f}};
        const bf16_t* hp = hb + (size_t)(t0 + fr) * DM + fq * 8;
#pragma unroll 1
        for (int kb = 0; kb < 8; ++kb) { bf16x8 ah[4], bh[4][3], bl[4][3];
#pragma unroll
            for (int k4 = 0; k4 < 4; ++k4) { const int ks = kb * 4 + k4; ah[k4] = *(const bf16x8*)(hp + ks * 32);
#pragma unroll
                for (int nt = 0; nt < 3; ++nt) { const size_t wo = (size_t)(nt * 16 + fr) * 1024 + ks * 32 + fq * 8; bh[k4][nt] = *(const bf16x8*)(wh + wo); bl[k4][nt] = *(const bf16x8*)(wl + wo); } }
            SCHED_FENCE();
#pragma unroll
            for (int k4 = 0; k4 < 4; ++k4)
#pragma unroll
                for (int nt = 0; nt < 3; ++nt) { acc[nt] = mfma16(bh[k4][nt], ah[k4], acc[nt]); acc[nt] = mfma16(bl[k4][nt], ah[k4], acc[nt]); }
            SCHED_FENCE(); }
#pragma unroll
        for (int nt = 0; nt < 3; ++nt) *(LAS f32x4*)(lg + fr * 48 + nt * 16 + 4 * fq) = acc[nt];
        WAVE_SYNC();
        if (lane < 16) { const int t = t0 + lane; const LAS float* p = lg + lane * 48; const float rs = rstd_np(ssq, np, t);
            const float g0 = p[0] * rs + bg[0], g1 = p[1] * rs + bg[1], g2 = p[2] * rs + bg[2], g3 = p[3] * rs + bg[3];
            int gsel = 0; float gm = g0; if (g1 > gm) { gm = g1; gsel = 1; } if (g2 > gm) { gm = g2; gsel = 2; } if (g3 > gm) { gm = g3; gsel = 3; }
            const float gwt = 1.f / (expf(g0 - gm) + expf(g1 - gm) + expf(g2 - gm) + expf(g3 - gm));
            const LAS float* pe = p + 4 + gsel * 8; const float* bb = be + gsel * 8;
            float e[8];
#pragma unroll
            for (int j = 0; j < 8; ++j) e[j] = pe[j] * rs + bb[j];
            int i1 = 0; float m1 = e[0];
#pragma unroll
            for (int j = 1; j < 8; ++j) if (e[j] > m1) { m1 = e[j]; i1 = j; }
            int i2 = -1; float m2 = -3.0e38f;
#pragma unroll
            for (int j = 0; j < 8; ++j) if (j != i1 && e[j] > m2) { m2 = e[j]; i2 = j; }
            const float r = expf(m2 - m1); const float w1 = gwt / (1.f + r), w2 = gwt * r / (1.f + r);
            const int e1 = gsel * 8 + i1, e2 = gsel * 8 + i2;
            OKP(int, WS_EID)[t * 2] = e1; OKP(int, WS_EID)[t * 2 + 1] = e2; OKP(float, WS_GATEW)[t * 2] = w1; OKP(float, WS_GATEW)[t * 2 + 1] = w2;
            OKP(int, WS_POS)[t * 2] = (int)atomicAdd(cnt + e1, 1u); OKP(int, WS_POS)[t * 2 + 1] = (int)atomicAdd(cnt + e2, 1u); }
        WAVE_SYNC();
    }
}

__device__ __forceinline__ void phase_scatter(const Frame& F0, int l, const bf16_t* hb, const float* ssq, int np) {
    const Frame F = phase_frame(F0);
    const unsigned* cnt = F.ctl + CW_MOE + l * 64; const int lane = F.lane;
    const int gw = F.vcu * NWAVES + F.wave, NGW = F.G * NWAVES;
    int base = 0;
    { int tiles = lane < 32 ? (((int)cnt[lane & 31] + 255) >> 8) : 0; int incl = tiles;
#pragma unroll
      for (int o = 1; o < 32; o <<= 1) { const int n = __shfl_up(incl, o); if ((lane & 31) >= o) incl += n; }
      base = (incl - tiles) * 256;
      const int cnt_e = lane < 32 ? (int)cnt[lane & 31] : 0; const int light = (tiles > 0 && cnt_e - 256 * (tiles - 1) <= 128) ? 1 : 0, full = tiles - light;
      int fincl = full, lincl = light;
#pragma unroll
      for (int o = 1; o < 32; o <<= 1) { const int n1 = __shfl_up(fincl, o), n2 = __shfl_up(lincl, o); if ((lane & 31) >= o) { fincl += n1; lincl += n2; } }
      const int ntiles = __shfl(incl, 31), nfull = __shfl(fincl, 31);
      if (blockIdx.x == 0 && F.wave == 0) { if (lane < 32) { for (int i = 0; i < tiles; ++i) OKP(int, WS_TILEEXP)[(base >> 8) + i] = lane;
              for (int i = 0; i < full; ++i) OKP(int, WS_TILEEXP)[512 + (fincl - full) + i] = (base >> 8) + i;
              if (light) OKP(int, WS_TILEEXP)[512 + nfull + (lincl - 1)] = ((base >> 8) + tiles - 1) | (1 << 16); }
          if (lane == 0) OKP(int, WS_TILEEXP)[1023] = ntiles; } }
    for (int a0 = gw * 4; a0 < T * 2; a0 += NGW * 4) {
        int slot[4]; u32x4 r0[4], r1[4];
#pragma unroll
        for (int k = 0; k < 4; ++k) { const int a = a0 + k; const int e = OKP(int, WS_EID)[a]; slot[k] = __shfl(base, e) + OKP(int, WS_POS)[a]; }
#pragma unroll
        for (int k = 0; k < 4; ++k) { const u32x4* src = (const u32x4*)(hb + (size_t)((a0 + k) >> 1) * DM) + lane; r0[k] = src[0]; r1[k] = src[64]; }
#pragma unroll
        for (int k = 0; k < 4; ++k) { const int a = a0 + k, t = a >> 1; u32x4* dst = (u32x4*)(OKP(bf16_t, WS_XS) + (size_t)slot[k] * DM) + lane; dst[0] = r0[k]; dst[64] = r1[k];
            if (lane == 0) { OKP(int, WS_TOKSLOT)[a] = slot[k]; OKP(float, WS_SLOTGATE)[slot[k]] = OKP(float, WS_GATEW)[a]; OKP(float, WS_SLOTRSTD)[slot[k]] = rstd_np(ssq, np, t); } } }
}

__device__ __forceinline__ void phase_combine(const Frame& F0, bf16_t* hb, float* ssq, bool final_layer) {
    using namespace sm;
    const Frame F = phase_frame(F0);
    const int lane = F.lane; const int gw = F.vcu * NWAVES + F.wave, NGW = F.G * NWAVES; const bf16_t* y = OKP(bf16_t, WS_Y);
    for (int t0 = gw * 2; t0 < T; t0 += NGW * 2) {
        int sa[2], sb[2];
#pragma unroll
        for (int k = 0; k < 2; ++k) { sa[k] = OKP(int, WS_TOKSLOT)[(t0 + k) * 2]; sb[k] = OKP(int, WS_TOKSLOT)[(t0 + k) * 2 + 1]; }
        u32x2 ra[2][4], rb[2][4], rh[2][4];
#pragma unroll
        for (int k = 0; k < 2; ++k) { const u32x2* hr = (const u32x2*)(hb + (size_t)(t0 + k) * DM) + lane; const u32x2* ya = (const u32x2*)(y + (size_t)sa[k] * DM) + lane; const u32x2* yb = (const u32x2*)(y + (size_t)sb[k] * DM) + lane;
#pragma unroll
            for (int j = 0; j < 4; ++j) { ra[k][j] = ya[64 * j]; rb[k][j] = yb[64 * j]; rh[k][j] = hr[64 * j]; } }
#pragma unroll
        for (int k = 0; k < 2; ++k) { const int t = t0 + k; u32x2* hr = (u32x2*)(hb + (size_t)t * DM) + lane; f32x4 v[4]; float s = 0.f;
#pragma unroll
            for (int j = 0; j < 4; ++j) { const u32x2 a = ra[k][j], b = rb[k][j], hw = rh[k][j]; f32x4 x;
                x[0] = bflo(hw.x) + (bflo(a.x) + bflo(b.x)); x[1] = bfhi(hw.x) + (bfhi(a.x) + bfhi(b.x)); x[2] = bflo(hw.y) + (bflo(a.y) + bflo(b.y)); x[3] = bfhi(hw.y) + (bfhi(a.y) + bfhi(b.y));
                if (!final_layer) { u32x2 w; w.x = cvt_pk_bf16(x[0], x[1]); w.y = cvt_pk_bf16(x[2], x[3]); hr[64 * j] = w; x = (f32x4){bflo(w.x), bfhi(w.x), bflo(w.y), bfhi(w.y)}; }
                v[j] = x; s += (x[0] * x[0] + x[1] * x[1]) + (x[2] * x[2] + x[3] * x[3]); }
            s = wave_sum(s);
            if (!final_layer) { if (lane == 0) ssq[t] = s; }
            else { const float rs = frsq(s * (1.f / DM) + EPS); f32x4* orow = (f32x4*)(F.out + (size_t)t * DM) + lane; const f32x4* gr = (const f32x4*)F.in[I_FINAL_NORM] + lane;
#pragma unroll
                for (int j = 0; j < 4; ++j) { const f32x4 g = gr[64 * j]; f32x4 o; o[0] = v[j][0] * rs * g[0]; o[1] = v[j][1] * rs * g[1]; o[2] = v[j][2] * rs * g[2]; o[3] = v[j][3] * rs * g[3]; orow[64 * j] = o; } } } }
}

#ifndef CPU_EMU
struct MoeOrder {
    static constexpr bool LIGHT = true;
    const char* A; const char* W; const int* tile_exp; size_t a_tstep, w_estride, w_off, w_tstep; int G, c;
    __device__ bool next(int i, pg8::Unit& u) const {
        const int Lx = i * G + c; const int ntiles = tile_exp[1023]; if (Lx >= ntiles * 4) return false;
        const int info = tile_exp[512 + (Lx >> 2)], tile = info & 0xffff; u.pm = tile; u.pn = Lx & 3; u.tag = info >> 16; const int e = tile_exp[tile];
        u.a = A + (size_t)tile * a_tstep; u.b = W + (size_t)e * w_estride + w_off + (size_t)u.pn * w_tstep; return true;
    }
    __device__ __forceinline__ void a_ready(const pg8::Unit&) const {}
    __device__ __forceinline__ void done(const pg8::Unit&) const {}
};
struct EpiSwiGLU {
    static constexpr bool PERM = false, AFTER_DRAIN = false;
    bf16_t* act; const float* slot_rstd;
    __device__ __forceinline__ void operator()(const f32x4 (&acc)[2][2][4][2], const pg8::Unit& u, int wr, int wc, int fr, int fq) const {
        const int row0 = u.pm * 256 + wr * 64 + fr, col0 = u.pn * 128 + wc * 16 + 4 * fq;
        float rs8[2][4];
#pragma unroll
        for (int i = 0; i < 8; ++i) rs8[i >> 2][i & 3] = slot_rstd[row0 + (i >> 2) * 128 + (i & 3) * 16];
        SCHED_FENCE();
#pragma unroll
        for (int ai = 0; ai < 2; ++ai)
#pragma unroll
            for (int m = 0; m < 4; ++m) { const int row = row0 + ai * 128 + m * 16; const float rs = rs8[ai][m]; bf16_t* rowp = act + (size_t)row * 512 + col0;
#pragma unroll
                for (int bj = 0; bj < 2; ++bj) { const f32x4 g = acc[ai][bj][m][0] * rs, up = acc[ai][bj][m][1] * rs; f32x4 o;
#pragma unroll
                    for (int r = 0; r < 4; ++r) o[r] = g[r] * frcp(1.f + fexp(-g[r])) * up[r];
                    u32x2 w; w.x = cvt_pk_bf16(o[0], o[1]); w.y = cvt_pk_bf16(o[2], o[3]); *(u32x2*)(rowp + bj * 64) = w; } }
    }
};
struct EpiDown {
    static constexpr bool PERM = true, AFTER_DRAIN = false;
    bf16_t* y; const float* slot_gate;
    __device__ __forceinline__ void operator()(const f32x4 (&acc)[2][2][4][2], const pg8::Unit& u, int wr, int wc, int fr, int fq) const {
        const int row0 = u.pm * 256 + wr * 64 + fr, col0 = u.pn * 256 + wc * 32 + 8 * fq;
        float sg8[2][4];
#pragma unroll
        for (int i = 0; i < 8; ++i) sg8[i >> 2][i & 3] = slot_gate[row0 + (i >> 2) * 128 + (i & 3) * 16];
        SCHED_FENCE();
#pragma unroll
        for (int ai = 0; ai < 2; ++ai)
#pragma unroll
            for (int m = 0; m < 4; ++m) { const int row = row0 + ai * 128 + m * 16; const float s = sg8[ai][m]; bf16_t* rowp = y + (size_t)row * DM + col0;
#pragma unroll
                for (int bj = 0; bj < 2; ++bj) { const f32x4 v0 = acc[ai][bj][m][0] * s, v1 = acc[ai][bj][m][1] * s; u32x4 w; w.x = cvt_pk_bf16(v0[0], v0[1]); w.y = cvt_pk_bf16(v0[2], v0[3]); w.z = cvt_pk_bf16(v1[0], v1[1]); w.w = cvt_pk_bf16(v1[2], v1[3]);
                    *(u32x4*)(rowp + bj * 128) = w; } }
    }
};
__device__ __forceinline__ void phase_moe_up(const Frame& F) {
    pg8::Gemm g{nullptr, nullptr, 0, 0, 1024};
    MoeOrder S{(const char*)OKP(bf16_t, WS_XS), (const char*)OKP(bf16_t, WS_MOEW), OKP(int, WS_TILEEXP), (size_t)256 * 1024 * 2, 3 * MiB, 0, (size_t)256 * 1024 * 2, F.G, (int)blockIdx.x};
    EpiSwiGLU E{OKP(bf16_t, WS_ACT), OKP(float, WS_SLOTRSTD)};
    pg8::gemm_phase<EpiSwiGLU, MoeOrder, true, true>(F.lds, g, S, E);
}
__device__ __forceinline__ void phase_moe_down(const Frame& F) {
    pg8::Gemm g{nullptr, nullptr, 0, 0, 512};
    MoeOrder S{(const char*)OKP(bf16_t, WS_ACT), (const char*)OKP(bf16_t, WS_MOEW), OKP(int, WS_TILEEXP), (size_t)256 * 512 * 2, 3 * MiB, 2 * MiB, (size_t)256 * 512 * 2, F.G, (int)blockIdx.x};
    EpiDown E{OKP(bf16_t, WS_Y), OKP(float, WS_SLOTGATE)};
    pg8::gemm_phase<EpiDown, MoeOrder, true, true>(F.lds, g, S, E);
}
#endif
}

#ifndef DUP_MASK
#define DUP_MASK 0
#endif
namespace ok {
constexpr size_t WS_GU = 160 * MiB, WS_GW = 192 * MiB, WS_GQD = 224 * MiB, WS_GKDT = 480 * MiB, WS_GAQK = 512 * MiB;
constexpr size_t WS_GDEC = WS_GCS;
constexpr size_t WS_OBUF = WS_H;
constexpr int G_LD = 132, GB_LD = 136, LM_LD = 68, LB_LD = 72, XT_LD2 = 68;
__device__ __forceinline__ float sigmoidf_(float x) { return frcp(1.f + fexp(-x)); }

template <int PARTS  > __device__ __forceinline__ void phase_gdn_prep_t(const Frame& F0) {
    using namespace sm;
    const Frame F = phase_frame(F0);
    LAS float* q_s = (LAS float*)F.lds; LAS float* k_s = (LAS float*)(F.lds + 33792); LAS float* v_s = (LAS float*)(F.lds + 67584);
    LAS bf16_t* Kn = (LAS bf16_t*)(F.lds + 101376); LAS bf16_t* Qn = (LAS bf16_t*)(F.lds + 118784);
    LAS float* g_s = (LAS float*)(F.lds + 136192); LAS float* beta_s = g_s + 64; LAS float* gc_s = g_s + 128; LAS float* eg_s = g_s + 192; LAS float* rq_s = g_s + 256; LAS float* rk_s = g_s + 320;
    LAS float* Lm = q_s;
    LAS bf16_t* Lb16 = (LAS bf16_t*)(F.lds + 17408);
    LAS bf16_t* XT = Kn;
    const int tid = F.tid, lane = F.lane, wave = F.wave, fr = lane & 15, fq = lane >> 4;
    const bf16_t* proj = OKP(bf16_t, WS_PROJ); const float* cw = F.in[I_OD_CONV];
    for (int u = F.vcu; u < NB * NCH * 8; u += F.G) {
        const int hd = u & 7, bc = u >> 3, b = bc / NCH, c = bc % NCH; const size_t row0 = (size_t)b * L + c * 64; const size_t ub = (size_t)bc * 8 + hd;
        LDS_BARRIER();
        if ((PARTS & 1) && tid < 384) { const int which = tid >> 7, d = tid & 127, xc = which * 1024 + hd * 128 + d; LAS float* dst = (which == 0 ? q_s : which == 1 ? k_s : v_s) + d;
            const float w0 = cw[xc], w1 = cw[3072 + xc], w2 = cw[6144 + xc], w3 = cw[9216 + xc]; const bf16_t* p = proj + row0 * PROJ1_LD + xc;
            const int hb_ = c > 0 ? 1 : 0; const unsigned short h0 = p[-3 * PROJ1_LD * hb_], h1 = p[-2 * PROJ1_LD * hb_], h2 = p[-PROJ1_LD * hb_];
            unsigned short raw[64]; float pacc = 0.f;
#pragma unroll
            for (int t = 0; t < 64; ++t) raw[t] = p[(size_t)t * PROJ1_LD];
            SCHED_FENCE();
            float x0 = hb_ ? bf2f(h0) : 0.f, x1 = hb_ ? bf2f(h1) : 0.f, x2 = hb_ ? bf2f(h2) : 0.f;
#pragma unroll
            for (int t = 0; t < 64; ++t) { const float x3 = bf2f(raw[t]); const float v = w0 * x0 + w1 * x1 + w2 * x2 + w3 * x3; if (PARTS & 32) dst[t * G_LD] = v; else if (PARTS & 128) { pacc += siluf(v); if ((t & 15) == 15) dst[t * G_LD] = pacc; } else dst[t * G_LD] = siluf(v); x0 = x1; x1 = x2; x2 = x3; } }
        if ((PARTS & 1) && !(PARTS & 64) && tid >= 448) { const int t = tid - 448; const float* r16 = OKP(float, WS_RAW16) + (row0 + t) * 16;
            g_s[t] = -expf(F.in[I_OD_ALOG][hd]) * softplusf(r16[hd] + F.in[I_OD_DTB][hd]); beta_s[t] = sigmoidf_(r16[8 + hd]); }
        LDS_BARRIER();
        if (!(PARTS & 1) || (PARTS & 64)) {} else if (wave == 0) { float v = g_s[lane];
#pragma unroll
            for (int o = 1; o < 64; o <<= 1) { const float n = __shfl_up(v, o); if (lane >= o) v += n; }
            gc_s[lane] = v; eg_s[lane] = fexp(v); if (lane == 63) OKP(float, WS_GDEC)[ub] = fexp(v); }
        else if (wave <= 2) { const LAS float* src = (wave == 1 ? q_s : k_s) + lane * G_LD; float s = 0.f;
#pragma unroll 8
            for (int d = 0; d < 128; d += 4) { const f32x4 x = *(const LAS f32x4*)(src + d); s += (x.x * x.x + x.y * x.y) + (x.z * x.z + x.w * x.w); }
            const float r = frsq(s + EPS); if (wave == 1) rq_s[lane] = r * 0.08838834764831845f; else rk_s[lane] = r; }
        LDS_BARRIER();
        if (PARTS & 2)
        { const float gl = gc_s[63];
          for (int i = tid; i < 64 * 64; i += NT) { const int t = i >> 6, dp = (i & 63) * 2; const float rk = rk_s[t], rq = rq_s[t], eg = eg_s[t];
              const float k0 = k_s[t * G_LD + dp] * rk, k1 = k_s[t * G_LD + dp + 1] * rk, q0 = q_s[t * G_LD + dp] * rq, q1 = q_s[t * G_LD + dp + 1] * rq;
              *(LAS unsigned*)(Kn + t * GB_LD + dp) = cvt_pk_bf16(k0, k1); *(LAS unsigned*)(Qn + t * GB_LD + dp) = cvt_pk_bf16(q0, q1);
              *(unsigned*)(OKP(bf16_t, WS_GQD) + ub * 8192 + t * 128 + dp) = cvt_pk_bf16(q0 * eg, q1 * eg); }
          { const int t = tid & 63, dg = tid >> 6; const float f = rk_s[t] * fexp(gl - gc_s[t]); bf16_t* dst = OKP(bf16_t, WS_GKDT) + ub * 8192 + t;
#pragma unroll
            for (int j = 0; j < 16; ++j) { const int d = dg * 16 + j; dst[d * 64] = (bf16_t)(cvt_pk_bf16(k_s[t * G_LD + d] * f, 0.f) & 0xffffu); } } }
        LDS_BARRIER();
        if (PARTS & 4)
#pragma unroll
        for (int i = 0; i < 4; ++i) { const int tl = wave * 4 + i, which = tl >> 4, ti = (tl >> 2) & 3, si = tl & 3;
            f32x4 acc = {0.f, 0.f, 0.f, 0.f};
            if (si <= ti) {
#pragma unroll
                for (int ks = 0; ks < 4; ++ks) { const bf16x8 a = *(const LAS bf16x8*)(Kn + (si * 16 + fr) * GB_LD + ks * 32 + fq * 8); const bf16x8 bb = *(const LAS bf16x8*)((which ? Qn : Kn) + (ti * 16 + fr) * GB_LD + ks * 32 + fq * 8); acc = mfma16(a, bb, acc); }
                const int t = ti * 16 + fr; const float gt = gc_s[t], bt = beta_s[t];
#pragma unroll
                for (int r = 0; r < 4; ++r) { const int s = si * 16 + 4 * fq + r; const float dec = fexp(gt - gc_s[s]); acc[r] = which ? (s <= t ? acc[r] * dec : 0.f) : (s < t ? acc[r] * dec * bt : 0.f); } }
            const int t = ti * 16 + fr, s0 = si * 16 + 4 * fq;
            if (which) { u32x2 w; w.x = cvt_pk_bf16(acc[0], acc[1]); w.y = cvt_pk_bf16(acc[2], acc[3]); *(u32x2*)(OKP(bf16_t, WS_GAQK) + ub * 4096 + t * 64 + s0) = w; }
            else { Lm[(s0 + 0) * LM_LD + t] = acc[0]; Lm[(s0 + 1) * LM_LD + t] = acc[1]; Lm[(s0 + 2) * LM_LD + t] = acc[2]; Lm[(s0 + 3) * LM_LD + t] = acc[3];
                u32x2 w; w.x = cvt_pk_bf16(acc[0], acc[1]); w.y = cvt_pk_bf16(acc[2], acc[3]); *(LAS u32x2*)(Lb16 + t * LB_LD + s0) = w; } }
        LDS_BARRIER();
        if (PARTS & 8) {
            for (int i = tid; i < 64 * 128; i += NT) { const int t = i >> 7, cc = i & 127; const float bt = beta_s[t]; v_s[t * G_LD + cc] *= bt; k_s[t * G_LD + cc] *= bt * rk_s[t] * eg_s[t]; }
            LDS_BARRIER();
#pragma unroll
            for (int ib = 0; ib < 4; ++ib) {
                if (ib > 0) {
#pragma unroll
                    for (int ct2 = 0; ct2 < 2; ++ct2) { const int ct = wave * 2 + ct2; f32x4 acc = {0.f, 0.f, 0.f, 0.f};
#pragma unroll
                        for (int ks = 0; ks < (ib * 16 + 31) / 32; ++ks) { const LAS bf16_t* lp = Lb16 + (ib * 16 + fr) * LB_LD + ks * 32 + fq * 8; u32x4 la = *(const LAS u32x4*)lp;
                            if (ks * 32 + fq * 8 >= ib * 16) la = (u32x4){0u, 0u, 0u, 0u};
                            const LAS bf16_t* xp = XT + (ct * 16 + fr) * XT_LD2 + ks * 32 + fq * 8; const u32x2 x0 = *(const LAS u32x2*)xp, x1 = *(const LAS u32x2*)(xp + 4); u32x4 xb; xb.x = x0.x; xb.y = x0.y; xb.z = x1.x; xb.w = x1.y;
                            if (ks * 32 + fq * 8 >= ib * 16) xb = (u32x4){0u, 0u, 0u, 0u};
                            acc = mfma16(__builtin_bit_cast(bf16x8, la), __builtin_bit_cast(bf16x8, xb), acc); }
                        LAS float* rp = (ct < 8 ? v_s : k_s) + (ib * 16 + 4 * fq) * G_LD + (ct & 7) * 16 + fr;
#pragma unroll
                        for (int r = 0; r < 4; ++r) rp[r * G_LD] -= acc[r]; }
                    LDS_BARRIER(); }
                if (tid < 256) { const int cidx = tid & 127; const bool isw = tid >= 128; const LAS float* col = (isw ? k_s : v_s) + cidx; bf16_t* dst = OKP(bf16_t, isw ? WS_GW : WS_GU) + ub * 8192 + (isw ? cidx : cidx * 4);
                    float a[16];
#pragma unroll
                    for (int tt = 0; tt < 16; ++tt) a[tt] = col[(ib * 16 + tt) * G_LD];
#pragma unroll
                    for (int ss = 0; ss < 16; ++ss) { const float xv = a[ss]; const LAS f32x4* lp = (const LAS f32x4*)(Lm + (ib * 16 + ss) * LM_LD + ib * 16);
#pragma unroll
                        for (int q4 = ss / 4; q4 < 4; ++q4) { const f32x4 l4 = lp[q4];
#pragma unroll
                            for (int r = 0; r < 4; ++r) if (q4 * 4 + r > ss) a[q4 * 4 + r] -= l4[r] * xv; } }
                    LAS bf16_t* xt = XT + tid * XT_LD2 + ib * 16;
#pragma unroll
                    for (int q4 = 0; q4 < 4; ++q4) { u32x2 w; w.x = cvt_pk_bf16(a[q4 * 4], a[q4 * 4 + 1]); w.y = cvt_pk_bf16(a[q4 * 4 + 2], a[q4 * 4 + 3]); *(LAS u32x2*)(xt + q4 * 4) = w;
                        if (!isw) *(u32x2*)(dst + (size_t)(ib * 4 + q4) * 512) = w; }
                    if (isw) {
#pragma unroll
                        for (int ss = 0; ss < 16; ++ss) dst[(ib * 16 + ss) * 128] = (bf16_t)(cvt_pk_bf16(a[ss], 0.f) & 0xffffu); } }
                if (ib < 3) LDS_BARRIER();
            }
        }
    }
}
}

namespace ok {
constexpr int ST_LD = 136, VT_LD = 72;
__device__ __forceinline__ void phase_gdn_prep(const Frame& F0) { phase_gdn_prep_t<15>(F0); }
constexpr int GJT = 4, GDV = GJT * 16, GN_UNITS = NB * 8 * (128 / GDV);
static_assert(GJT == 4, "the Z slot below is sized for four column tiles");
struct GdnEarly { bf16x8 X[4]; u32x2 Z[4]; };
struct GdnLate { bf16x8 Kf[2]; float dec; };
__device__ __forceinline__ void gdn_load_early(GdnEarly& g, const Frame& F, size_t xoff, size_t ub, int ti, int sl, int fr, int fq, int roleB) {
    const bf16_t* Xp = (const bf16_t*)(F.ws + xoff) + ub * 8192 + (ti * 16 + fr) * 128 + fq * 8;
#pragma unroll
    for (int ks = 0; ks < 4; ++ks) g.X[ks] = *(const bf16x8*)(Xp + ks * 32);
    const bf16_t* zb = roleB ? OKP(bf16_t, WS_GAQK) + ub * 4096 + (ti * 16 + fr) * 64 + fq * 8 : OKP(bf16_t, WS_GU) + ub * 8192 + ((size_t)(ti * 4 + fq) * 128 + sl * GDV + fr) * 4;
#pragma unroll
    for (int i = 0; i < 4; ++i) g.Z[i] = *(const u32x2*)(zb + (roleB ? (i >> 1) * 32 + (i & 1) * 4 : i * 64));
}
__device__ __forceinline__ void gdn_load_late(GdnLate& g, const Frame& F, size_t ub, int ti, int wave, int fr, int fq, int vzero) {
    const bf16_t* Kp = OKP(bf16_t, WS_GKDT) + ub * 8192 + (wave * 16 + fr) * 64 + fq * 8;
#pragma unroll
    for (int k2 = 0; k2 < 2; ++k2) g.Kf[k2] = *(const bf16x8*)(Kp + k2 * 32);
    g.dec = OKP(float, WS_GDEC)[ub + vzero];
}
constexpr int OS_LD = GDV + 8;
__device__ __forceinline__ void gdn_flush_o(const Frame& F, const LAS bf16_t* Os, int b, int cprev, int hd, int sl) {
    constexpr int PCS = GDV / 8;
    if (F.tid < 64 * PCS) { const int row = F.tid / PCS, pc = F.tid % PCS; *(u32x4*)(OKP(bf16_t, WS_OBUF) + ((size_t)b * L + cprev * 64 + row) * 1024 + hd * 128 + sl * GDV + pc * 8) = *(const LAS u32x4*)(Os + row * OS_LD + pc * 8); }
}
__device__ __forceinline__ void gdn_step(const Frame& F, const GdnEarly& g, const GdnLate& h, f32x4 (&Sacc)[GJT], LAS bf16_t* ST0, LAS bf16_t* VnT, int par, int roleB, int b, int c, int hd, int sl, int ti, int wave, int fr, int fq) {
    LAS bf16_t* ST = ST0 + par * (GDV * ST_LD); LAS bf16_t* STn = ST0 + (par ^ 1) * (GDV * ST_LD);
    LAS bf16_t* Os = VnT + GDV * VT_LD;
    LDS_BARRIER();
    if (c > 0) gdn_flush_o(F, Os, b, c - 1, hd, sl);
    f32x4 a[GJT];
#pragma unroll
    for (int ji = 0; ji < GJT; ++ji) a[ji] = (f32x4){0.f, 0.f, 0.f, 0.f};
#pragma unroll
    for (int ks = 0; ks < 4; ++ks)
#pragma unroll
        for (int ji = 0; ji < GJT; ++ji) { const bf16x8 sf = *(const LAS bf16x8*)(ST + (ji * 16 + fr) * ST_LD + ks * 32 + fq * 8); a[ji] = mfma16(g.X[ks], sf, a[ji]); }
    if (!roleB) {
#pragma unroll
        for (int ji = 0; ji < GJT; ++ji) { const u32x2 uv = g.Z[ji]; u32x2 w; w.x = cvt_pk_bf16(bflo(uv.x) - a[ji][0], bfhi(uv.x) - a[ji][1]); w.y = cvt_pk_bf16(bflo(uv.y) - a[ji][2], bfhi(uv.y) - a[ji][3]);
            *(LAS u32x2*)(VnT + (ji * 16 + fr) * VT_LD + ti * 16 + 4 * fq) = w; } }
    LDS_BARRIER();
#pragma unroll
    for (int ji = 0; ji < GJT; ++ji) { bf16x8 vf[2];
#pragma unroll
        for (int k2 = 0; k2 < 2; ++k2) vf[k2] = *(const LAS bf16x8*)(VnT + (ji * 16 + fr) * VT_LD + k2 * 32 + fq * 8);
        if (roleB) {
#pragma unroll
            for (int k2 = 0; k2 < 2; ++k2) { u32x4 af; af.x = g.Z[2 * k2].x; af.y = g.Z[2 * k2].y; af.z = g.Z[2 * k2 + 1].x; af.w = g.Z[2 * k2 + 1].y; a[ji] = mfma16(__builtin_bit_cast(bf16x8, af), vf[k2], a[ji]); }
            LAS bf16_t* op = Os + (ti * 16 + 4 * fq) * OS_LD + ji * 16 + fr;
#pragma unroll
            for (int r = 0; r < 4; ++r) op[r * OS_LD] = (bf16_t)(cvt_pk_bf16(a[ji][r], 0.f) & 0xffffu); }
        Sacc[ji] *= h.dec;
#pragma unroll
        for (int k2 = 0; k2 < 2; ++k2) Sacc[ji] = mfma16(h.Kf[k2], vf[k2], Sacc[ji]);
        u32x2 w; w.x = cvt_pk_bf16(Sacc[ji][0], Sacc[ji][1]); w.y = cvt_pk_bf16(Sacc[ji][2], Sacc[ji][3]); *(LAS u32x2*)(STn + (ji * 16 + fr) * ST_LD + wave * 16 + 4 * fq) = w; }
}
template <int MODE  > __device__ __forceinline__ void gdn_scan_unit_t(const Frame& F, int unit) {
    LAS bf16_t* ST = (LAS bf16_t*)F.lds; LAS bf16_t* VnT = (LAS bf16_t*)(F.lds + 2 * GDV * ST_LD * 2);
    const int tid = F.tid, lane = F.lane, wave = F.wave, fr = lane & 15, fq = lane >> 4;
    constexpr int NSL = 128 / GDV;
    const int sl = unit % NSL, hd = (unit / NSL) & 7, b = unit / (NSL * 8), ti = wave & 3, roleB = wave >> 2;
    for (int i = tid; i < GDV * ST_LD / 2; i += NT) ((LAS unsigned*)ST)[i] = 0u;
    f32x4 Sacc[GJT];
#pragma unroll
    for (int ji = 0; ji < GJT; ++ji) Sacc[ji] = (f32x4){0.f, 0.f, 0.f, 0.f};
    const size_t ub0 = ((size_t)b * NCH) * 8 + hd; const size_t xoff = roleB ? WS_GQD : WS_GW;
    int vzero = 0;
#ifndef CPU_EMU
    asm volatile("" : "+v"(vzero));
#endif
#define GDN_LE(set, cc) if (MODE == 0) gdn_load_early(set, F, xoff, ub0 + (size_t)((cc) < NCH ? (cc) : NCH - 1) * 8, ti, sl, fr, fq, roleB)
#define GDN_LL(set, cc) if (MODE == 0) gdn_load_late(set, F, ub0 + (size_t)((cc) < NCH ? (cc) : NCH - 1) * 8, ti, wave, fr, fq, vzero)
#define GDN_ST(es, ls, cc, par) gdn_step(F, es, ls, Sacc, ST, VnT, par, roleB, b, (MODE == 0 ? (cc) : 0), hd, sl, ti, wave, fr, fq)
    GdnEarly e0, e1, e2; GdnLate l0, l1;
    GDN_LE(e0, 0); GDN_LE(e1, 1); GDN_LL(l0, 0);
    if (MODE == 1) { gdn_load_early(e0, F, xoff, ub0, ti, sl, fr, fq, roleB); gdn_load_early(e1, F, xoff, ub0, ti, sl, fr, fq, roleB); gdn_load_early(e2, F, xoff, ub0, ti, sl, fr, fq, roleB); gdn_load_late(l0, F, ub0, ti, wave, fr, fq, vzero); gdn_load_late(l1, F, ub0, ti, wave, fr, fq, vzero); }
    int c = 0;
    for (; c + 6 <= NCH; c += 6) {
        GDN_LE(e2, c + 2); GDN_LL(l1, c + 1); GDN_ST(e0, l0, c + 0, 0);
        GDN_LE(e0, c + 3); GDN_LL(l0, c + 2); GDN_ST(e1, l1, c + 1, 1);
        GDN_LE(e1, c + 4); GDN_LL(l1, c + 3); GDN_ST(e2, l0, c + 2, 0);
        GDN_LE(e2, c + 5); GDN_LL(l0, c + 4); GDN_ST(e0, l1, c + 3, 1);
        GDN_LE(e0, c + 6); GDN_LL(l1, c + 5); GDN_ST(e1, l0, c + 4, 0);
        GDN_LE(e1, c + 7); GDN_LL(l0, c + 6); GDN_ST(e2, l1, c + 5, 1);
    }
    if (c + 0 < NCH) { GDN_LE(e2, c + 2); GDN_LL(l1, c + 1); GDN_ST(e0, l0, c + 0, 0); }
    if (c + 1 < NCH) { GDN_LE(e0, c + 3); GDN_LL(l0, c + 2); GDN_ST(e1, l1, c + 1, 1); }
    if (c + 2 < NCH) { GDN_LE(e1, c + 4); GDN_LL(l1, c + 3); GDN_ST(e2, l0, c + 2, 0); }
    if (c + 3 < NCH) { GDN_LE(e2, c + 5); GDN_LL(l0, c + 4); GDN_ST(e0, l1, c + 3, 1); }
    if (c + 4 < NCH) { GDN_LE(e0, c + 6); GDN_LL(l1, c + 5); GDN_ST(e1, l0, c + 4, 0); }
#undef GDN_LE
#undef GDN_LL
#undef GDN_ST
    LDS_BARRIER();
    if (MODE == 0) gdn_flush_o(F, VnT + GDV * VT_LD, b, NCH - 1, hd, sl);
}
__device__ __forceinline__ void gdn_scan_unit(const Frame& F, int unit) { gdn_scan_unit_t<0>(F, unit); }
__device__ __forceinline__ void phase_gdn_final(const Frame& F0) {
    using namespace sm;
    const Frame F = phase_frame(F0);
    const int lane = F.lane; const int gw = F.vcu * NWAVES + F.wave, NGW = F.G * NWAVES;
    const f32x4* nw4 = (const f32x4*)(F.in[I_OD_NORM] + (lane & 7) * 16);
    u32x4 na[2], nz[2]; { const int t = gw < T ? gw : 0; const u32x4* op = (const u32x4*)(OKP(bf16_t, WS_OBUF) + (size_t)t * 1024 + lane * 16); const u32x4* zp = (const u32x4*)(OKP(bf16_t, WS_PROJ) + (size_t)t * PROJ1_LD + 3072 + lane * 16); na[0] = op[0]; na[1] = op[1]; nz[0] = zp[0]; nz[1] = zp[1]; }
    for (int t = gw; t < T; t += NGW) { const u32x4 ca[2] = {na[0], na[1]}, cz[2] = {nz[0], nz[1]};
        { const int tn = t + NGW < T ? t + NGW : t; const u32x4* op = (const u32x4*)(OKP(bf16_t, WS_OBUF) + (size_t)tn * 1024 + lane * 16); const u32x4* zp = (const u32x4*)(OKP(bf16_t, WS_PROJ) + (size_t)tn * PROJ1_LD + 3072 + lane * 16); na[0] = op[0]; na[1] = op[1]; nz[0] = zp[0]; nz[1] = zp[1]; }
        float o[16], z[16];
#pragma unroll
        for (int h2 = 0; h2 < 2; ++h2) { const u32x4 a = ca[h2], zz = cz[h2];
            o[h2 * 8 + 0] = bflo(a.x); o[h2 * 8 + 1] = bfhi(a.x); o[h2 * 8 + 2] = bflo(a.y); o[h2 * 8 + 3] = bfhi(a.y); o[h2 * 8 + 4] = bflo(a.z); o[h2 * 8 + 5] = bfhi(a.z); o[h2 * 8 + 6] = bflo(a.w); o[h2 * 8 + 7] = bfhi(a.w);
            z[h2 * 8 + 0] = bflo(zz.x); z[h2 * 8 + 1] = bfhi(zz.x); z[h2 * 8 + 2] = bflo(zz.y); z[h2 * 8 + 3] = bfhi(zz.y); z[h2 * 8 + 4] = bflo(zz.z); z[h2 * 8 + 5] = bfhi(zz.z); z[h2 * 8 + 6] = bflo(zz.w); z[h2 * 8 + 7] = bfhi(zz.w); }
        float s = 0.f;
#pragma unroll
        for (int i = 0; i < 16; ++i) s += o[i] * o[i];
        s += __shfl_xor(s, 1); s += __shfl_xor(s, 2); s += __shfl_xor(s, 4);
        const float rs = frsq(s * (1.f / 128.f) + EPS);
        u32x4 w[2];
#pragma unroll
        for (int h2 = 0; h2 < 2; ++h2) { const f32x4 n0 = nw4[h2 * 2], n1 = nw4[h2 * 2 + 1]; float y[8];
#pragma unroll
            for (int i = 0; i < 8; ++i) y[i] = o[h2 * 8 + i] * rs * (i < 4 ? n0[i] : n1[i - 4]) * siluf(z[h2 * 8 + i]);
            w[h2].x = cvt_pk_bf16(y[0], y[1]); w[h2].y = cvt_pk_bf16(y[2], y[3]); w[h2].z = cvt_pk_bf16(y[4], y[5]); w[h2].w = cvt_pk_bf16(y[6], y[7]); }
        u32x4* cp = (u32x4*)(OKP(bf16_t, WS_CAT1) + (size_t)t * 1536 + lane * 16); cp[0] = w[0]; cp[1] = w[1]; }
}
}

#ifndef DUP_MASK
#define DUP_MASK 0
#endif
namespace ok {
constexpr int SB_LD = 72;
#ifdef CPU_EMU
#define WAVE_ALL(p) (wave_sum((p) ? 1.f : 0.f) == 64.f)
#else
#define WAVE_ALL(p) (__all(p))
#endif
__device__ __forceinline__ void sb_unit(const Frame& F, int unit) {
    LAS bf16_t* Kt = (LAS bf16_t*)F.lds; LAS bf16_t* VT = (LAS bf16_t*)(F.lds + 64 * SB_LD * 2); volatile LAS int* votes = (volatile LAS int*)(F.lds + 2 * 64 * SB_LD * 2);
    const int tid = F.tid, lane = F.lane, wave = F.wave, fr = lane & 15, fq = lane >> 4;
    const int nqb = L / 128, qb = unit % nqb, hd = (unit / nqb) & 7, b = unit / (nqb * 8), q0 = qb * 128;
    const bf16_t* proj = OKP(bf16_t, WS_PROJ) + (size_t)b * L * PROJ1_LD;
    const int qrow = q0 + wave * 16 + fr;
    bf16x8 qf[2];
#pragma unroll
    for (int ks = 0; ks < 2; ++ks) qf[ks] = *(const bf16x8*)(proj + (size_t)qrow * PROJ1_LD + 4096 + hd * 64 + ks * 32 + fq * 8);
    f32x4 o[4] = {{0.f, 0.f, 0.f, 0.f}, {0.f, 0.f, 0.f, 0.f}, {0.f, 0.f, 0.f, 0.f}, {0.f, 0.f, 0.f, 0.f}};
    float C = 1.f; bool wdone = false;
    const int key_l = tid >> 3, c8 = tid & 7;
    int kt = 2 * qb + 1;
    u32x4 kreg = *(const u32x4*)(proj + (size_t)(kt * 64 + key_l) * PROJ1_LD + 4608 + hd * 64 + c8 * 8), vreg = *(const u32x4*)(proj + (size_t)(kt * 64 + key_l) * PROJ1_LD + 5120 + hd * 64 + c8 * 8);
    for (; kt >= 0; --kt) {
        LDS_BARRIER();
        *(LAS u32x4*)(Kt + key_l * SB_LD + c8 * 8) = kreg;
        { LAS bf16_t* vp = VT + (c8 * 8) * SB_LD + key_l; vp[0] = (bf16_t)(vreg.x & 0xffffu); vp[SB_LD] = (bf16_t)(vreg.x >> 16); vp[2 * SB_LD] = (bf16_t)(vreg.y & 0xffffu); vp[3 * SB_LD] = (bf16_t)(vreg.y >> 16);
          vp[4 * SB_LD] = (bf16_t)(vreg.z & 0xffffu); vp[5 * SB_LD] = (bf16_t)(vreg.z >> 16); vp[6 * SB_LD] = (bf16_t)(vreg.w & 0xffffu); vp[7 * SB_LD] = (bf16_t)(vreg.w >> 16); }
        if (lane == 0) votes[wave] = wdone ? 1 : 0;
        LDS_BARRIER();
        { int all = 1;
#pragma unroll
          for (int w = 0; w < 8; ++w) all &= votes[w];
          if (all) break; }
        if (kt > 0) { kreg = *(const u32x4*)(proj + (size_t)((kt - 1) * 64 + key_l) * PROJ1_LD + 4608 + hd * 64 + c8 * 8); vreg = *(const u32x4*)(proj + (size_t)((kt - 1) * 64 + key_l) * PROJ1_LD + 5120 + hd * 64 + c8 * 8); }
        const int key0 = kt * 64;
#ifdef SB_COUNT_ITERS
        ++g_iters;
#endif
        if (!wdone && key0 < q0 + wave * 16 + 16) {
            f32x4 x[4];
#pragma unroll
            for (int k16 = 0; k16 < 4; ++k16) { x[k16] = (f32x4){0.f, 0.f, 0.f, 0.f};
#pragma unroll
                for (int ks = 0; ks < 2; ++ks) { const bf16x8 kf = *(const LAS bf16x8*)(Kt + (k16 * 16 + fr) * SB_LD + ks * 32 + fq * 8); x[k16] = mfma16(kf, qf[ks], x[k16]); } }
            const bool need_mask = key0 + 63 >= q0 + wave * 16;
            float Rr[4], Tt[4], Ee[4];
#pragma unroll
            for (int k16 = 0; k16 < 4; ++k16) {
#pragma unroll
                for (int r = 0; r < 4; ++r) { const float e = fexp2(fminf(x[k16][r], 80.f)); float rr = frcp(1.f + e), bet = e * rr;
                    if (need_mask && key0 + k16 * 16 + 4 * fq + r >= qrow) { rr = 1.f; bet = 0.f; }
                    x[k16][r] = bet; Rr[k16] = (r == 0) ? rr : Rr[k16];
                    if (r == 0) Tt[k16] = rr; else if (r == 1) Ee[k16] = rr; else if (r == 2) Rr[k16] = rr; else {
                        const float r0 = Tt[k16], r1 = Ee[k16], r2 = Rr[k16], r3 = rr; const float s2 = r3, s1 = r3 * r2, s0 = s1 * r1;
                        x[k16][0] *= s0; x[k16][1] *= s1; x[k16][2] *= s2;
                        Rr[k16] = s0 * r0; } } }
#pragma unroll
            for (int k16 = 0; k16 < 4; ++k16) { const float R = Rr[k16]; const float d1 = __shfl_down(R, 16), d2 = __shfl_down(R, 32), d3 = __shfl_down(R, 48);
                Ee[k16] = (fq < 3 ? d1 : 1.f) * (fq < 2 ? d2 : 1.f) * (fq < 1 ? d3 : 1.f); float t = R; t *= __shfl_xor(t, 16); t *= __shfl_xor(t, 32); Tt[k16] = t; }
            const float TT2 = Tt[3], TT1 = Tt[3] * Tt[2], TT0 = TT1 * Tt[1];
            const float f0 = Ee[0] * TT0 * C, f1 = Ee[1] * TT1 * C, f2 = Ee[2] * TT2 * C, f3 = Ee[3] * C;
            x[0] *= f0; x[1] *= f1; x[2] *= f2; x[3] *= f3;
            C *= TT0 * Tt[0];
            bf16x8 pw[2];
#pragma unroll
            for (int j = 0; j < 2; ++j) { u32x4 p; p.x = cvt_pk_bf16(x[2 * j][0], x[2 * j][1]); p.y = cvt_pk_bf16(x[2 * j][2], x[2 * j][3]); p.z = cvt_pk_bf16(x[2 * j + 1][0], x[2 * j + 1][1]); p.w = cvt_pk_bf16(x[2 * j + 1][2], x[2 * j + 1][3]); pw[j] = __builtin_bit_cast(bf16x8, p); }
#pragma unroll
            for (int dt = 0; dt < 4; ++dt)
#pragma unroll
                for (int j = 0; j < 2; ++j) { const LAS bf16_t* vp = VT + (dt * 16 + fr) * SB_LD + j * 32 + 4 * fq; const u32x2 lo = *(const LAS u32x2*)vp, hi = *(const LAS u32x2*)(vp + 16);
                    u32x4 a; a.x = lo.x; a.y = lo.y; a.z = hi.x; a.w = hi.y; o[dt] = mfma16(__builtin_bit_cast(bf16x8, a), pw[j], o[dt]); }
            wdone = WAVE_ALL(C < 7.8886e-31f);
        }
    }
    bf16_t* op = OKP(bf16_t, WS_CAT1) + ((size_t)b * L + qrow) * 1536 + 1024 + hd * 64 + 4 * fq;
#pragma unroll
    for (int dt = 0; dt < 4; ++dt) { u32x2 w; w.x = cvt_pk_bf16(o[dt][0], o[dt][1]); w.y = cvt_pk_bf16(o[dt][2], o[dt][3]); *(u32x2*)(op + dt * 16) = w; }
}
__device__ __forceinline__ void phase_l1_mix(const Frame& F0) {
    const Frame F = phase_frame(F0);
    constexpr int NU = GN_UNITS, UPX = NU / 8;
    if (F.G < 128 || F.G % 8 != 0) { if (F.vcu == 0) for (int u = 0; u < NU; ++u) { gdn_scan_unit(F, u); __syncthreads(); } for (int u = F.vcu; u < NB * 8 * (L / 128); u += F.G) { sb_unit(F, u); __syncthreads(); } return; }
    const int per = F.G / 8, xcd = F.vcu / per, loc = F.vcu % per;
    if (loc < UPX) { gdn_scan_unit(F, xcd * UPX + loc);
#if (DUP_MASK >> 3) & 1
        __syncthreads(); gdn_scan_unit(F, xcd * UPX + loc);
#endif
#if (DUP_MASK >> 21) & 1
        __syncthreads(); gdn_scan_unit_t<1>(F, xcd * UPX + loc);
#endif
    }
    else for (int rep = 0; rep < 1 + ((DUP_MASK >> 16) & 1); ++rep) for (int u = xcd * (per - UPX) + (loc - UPX); u < NB * 8 * (L / 128); u += F.G - NU) { sb_unit(F, u); __syncthreads(); }
}
}

namespace ok {
#if CHECK
__device__ const int kSampleRows[16] = {0, 1, 2, 3, 63, 64, 127, 128, 129, 1000, 2047, 2048, 4097, 6000, 8190, 8191};
constexpr int FP_W = 6144;
__device__ __forceinline__ void fp_save(const Frame& F, int k, const void* buf, int ld, int width, bool is_bf16, int dcol0) {
    float* fp = OKP(float, WS_FP) + (size_t)k * 16 * FP_W; const size_t gt = (size_t)blockIdx.x * NT + F.tid, GT = (size_t)F.G * NT;
    for (size_t i = gt; i < (size_t)16 * width; i += GT) { const int r = (int)(i / width), c = (int)(i % width); const size_t src = (size_t)kSampleRows[r] * ld + c;
        fp[r * FP_W + dcol0 + c] = is_bf16 ? bf2f(((const bf16_t*)buf)[src]) : ((const float*)buf)[src]; }
}
__device__ __forceinline__ void fp_cmp(const Frame& F, int k, const float* obuf, int ld, int ocol0, int width, int fcol0) {
    const float* fp = OKP(float, WS_FP) + (size_t)k * 16 * FP_W; const size_t gt = (size_t)blockIdx.x * NT + F.tid, GT = (size_t)F.G * NT; float num = 0.f, den = 0.f;
    for (size_t i = gt; i < (size_t)16 * width; i += GT) { const int r = (int)(i / width), c = (int)(i % width); const float o = obuf[(size_t)kSampleRows[r] * ld + ocol0 + c], f = fp[r * FP_W + fcol0 + c];
        const float d = o - f; num += d * d; den += o * o; if (!(d == d)) num += 1e30f; }
    num = wave_sum(num); den = wave_sum(den);
    if (F.lane == 0 && (num != 0.f || den != 0.f)) { atomicAdd((float*)F.ctl + CW_CHK + 2 * k, num); atomicAdd((float*)F.ctl + CW_CHK + 2 * k + 1, den); }
}
__device__ __forceinline__ void fp_save_lin(const Frame& F, int k, const void* buf, size_t off, int n, bool is_bf16) {
    float* fp = OKP(float, WS_FP) + (size_t)k * 16 * FP_W; const size_t gt = (size_t)blockIdx.x * NT + F.tid, GT = (size_t)F.G * NT;
    for (size_t i = gt; i < (size_t)n; i += GT) fp[i] = is_bf16 ? bf2f(((const bf16_t*)buf)[off + i]) : ((const float*)buf)[off + i];
}
__device__ __forceinline__ void fp_cmp_lin(const Frame& F, int k, const float* obuf, size_t off, int n) {
    const float* fp = OKP(float, WS_FP) + (size_t)k * 16 * FP_W; const size_t gt = (size_t)blockIdx.x * NT + F.tid, GT = (size_t)F.G * NT; float num = 0.f, den = 0.f;
    for (size_t i = gt; i < (size_t)n; i += GT) { const float o = obuf[off + i], f = fp[i]; const float d = o - f; num += d * d; den += o * o; if (!(d == d)) num += 1e30f; }
    num = wave_sum(num); den = wave_sum(den);
    if (F.lane == 0 && (num != 0.f || den != 0.f)) { atomicAdd((float*)F.ctl + CW_CHK + 2 * k, num); atomicAdd((float*)F.ctl + CW_CHK + 2 * k + 1, den); }
}
#endif

struct Args { const float* in[33]; float* out; unsigned char* ws;
#if CHECK
    sm::Ctx oc;
#endif
};

__global__ void __launch_bounds__(512, 2) mk_fwd(Args a) {
    extern __shared__ __attribute__((aligned(16))) unsigned char lds_raw[];
    Frame F; F.lds = (LAS unsigned char*)lds_raw; F.ws = a.ws; F.ctl = (unsigned*)(a.ws + WS_CTL); F.in = a.in; F.out = a.out;
    F.tid = threadIdx.x; F.lane = F.tid & 63; F.wave = __builtin_amdgcn_readfirstlane(F.tid >> 6); F.G = gridDim.x;
    { const int bx = blockIdx.x; F.vcu = (F.G % 8 == 0) ? (bx % 8) * (F.G / 8) + bx / 8 : bx; }
    volatile LAS unsigned* MISC = (volatile LAS unsigned*)(F.lds + LDS_BYTES - 64);
    if (F.tid < 16) MISC[F.tid] = 0u;
    __syncthreads();
    XcdBarrier bar = xcd_barrier_post(F.ctl + CW_BAR, MISC);
#define GRID_BAR() xcd_barrier(bar)
    using namespace sm;
    for (int dup_p = 0; dup_p < ((DUP_MASK >> 5) & 1) + 1; ++dup_p) {
    phase_prologue(F);
    prologue_router_tables(F);
    prologue_w16_tables(F);
    GRID_BAR();
    }
    for (int dup_i0 = 0; dup_i0 < ((DUP_MASK >> 6) & 1) + 1; ++dup_i0) {
    { EpiScaleBf16 E{OKP(bf16_t, WS_PROJ), PROJ0_LD, (const float*)F.ctl + CW_SSQ, 1};
      dense_gemm(F, OKP(bf16_t, WS_HB), OKP(bf16_t, WS_W_IN0), T, 4096, 1024, E); }
    phase_proj16(F, 0, F.in[I_X], nullptr, (const float*)F.ctl + CW_SSQ, 1);
    GRID_BAR();
    }
#if CHECK
    fp_save(F, 0, OKP(bf16_t, WS_PROJ), PROJ0_LD, 4096, true, 0);
#endif
    for (int dup_b = 0; dup_b < ((DUP_MASK >> 1) & 1) + 1; ++dup_b) {
    for (int dup_b1 = 0; dup_b1 < ((DUP_MASK >> 14) & 1) + 1; ++dup_b1) { phase_ssd_a(F); GRID_BAR(); }
#if CHECK
    fp_save_lin(F, 6, OKP(bf16_t, WS_STATES), ((size_t)5 * 16 + 0) * 8192, 65536, true);
    GRID_BAR();
#endif
    phase_kv(F);
    phase_ssd_scan(F, (F.G >= 64 && F.G % 8 == 0) ? 32 : 0);
    GRID_BAR();
    for (int dup_b2 = 0; dup_b2 < ((DUP_MASK >> 15) & 1) + 1; ++dup_b2) { phase_ssd_b(F); GRID_BAR(); }
    }

    for (int dup_o0 = 0; dup_o0 < ((DUP_MASK >> 8) & 1) + 1; ++dup_o0) {
    { EpiResidualT<true> E{F.in[I_X], OKP(bf16_t, WS_HB), OKP(float, WS_SSQP1)};
      dense_gemm(F, OKP(bf16_t, WS_CAT0), OKP(bf16_t, WS_W_OUT0), T, 1024, 1536, E); }
    GRID_BAR();
    }
#if CHECK
    fp_save(F, 10, OKP(bf16_t, WS_HB), 1024, 1024, true, 0);
    fp_save_lin(F, 7, OKP(bf16_t, WS_STATES), ((size_t)5 * 16 + 0) * 8192, 65536, true);
    fp_save(F, 8, OKP(bf16_t, WS_CAT0), 1536, 512, true, 0);
    fp_save(F, 9, OKP(bf16_t, WS_CAT0) + 512, 1536, 1024, true, 0);
    GRID_BAR();
#endif
    for (int dup_q0 = 0; dup_q0 < ((DUP_MASK >> 9) & 1) + 1; ++dup_q0) {
    { EpiScaleBf16 E{OKP(bf16_t, WS_Q), 1024, OKP(float, WS_SSQP1), 16};
      dense_gemm(F, OKP(bf16_t, WS_HB), OKP(bf16_t, WS_W_XA), T, 1024, 1024, E); }
    GRID_BAR();
    }
    for (int dup_xa0 = 0; dup_xa0 < ((DUP_MASK >> 13) & 1) + 1; ++dup_xa0) {
    phase_xattn(F, OKP(bf16_t, WS_Q), OKP(bf16_t, WS_KX), OKP(bf16_t, WS_VT), OKP(bf16_t, WS_ATT));
    GRID_BAR();
    }
    { EpiResidualT<false> E{nullptr, OKP(bf16_t, WS_HB), OKP(float, WS_SSQP2)};
      dense_gemm(F, OKP(bf16_t, WS_ATT), OKP(bf16_t, WS_W_XA + 6 * MiB), T, 1024, 1024, E); }
    GRID_BAR();
#if CHECK
    fp_save(F, 11, OKP(bf16_t, WS_HB), 1024, 1024, true, 0);
    GRID_BAR();
#endif
    phase_router(F, 0, OKP(bf16_t, WS_HB), OKP(float, WS_SSQP2), 16);
    for (int dup_cv = 0; dup_cv < ((DUP_MASK >> 10) & 1) + 1; ++dup_cv) phase_cvt_moe(F, 0);
    GRID_BAR();
    for (int dup_sc = 0; dup_sc < ((DUP_MASK >> 11) & 1) + 1; ++dup_sc) {
    phase_scatter(F, 0, OKP(bf16_t, WS_HB), OKP(float, WS_SSQP2), 16);
    GRID_BAR();
    }
    for (int dup_c = 0; dup_c < ((DUP_MASK >> 2) & 1) + 1; ++dup_c) {
    phase_moe_up(F);
    GRID_BAR();
    phase_moe_down(F);
    GRID_BAR();
    }

    phase_combine(F, OKP(bf16_t, WS_HB), (float*)F.ctl + CW_SSQ + 3 * T, false);
    GRID_BAR();
#if CHECK
    fp_save(F, 12, OKP(bf16_t, WS_HB), 1024, 1024, true, 0);
    GRID_BAR();
#endif
    for (int dup_i1 = 0; dup_i1 < ((DUP_MASK >> 12) & 1) + 1; ++dup_i1) {
    { EpiScaleBf16 E{OKP(bf16_t, WS_PROJ), PROJ1_LD, (const float*)F.ctl + CW_SSQ + 3 * T, 1};
      dense_gemm(F, OKP(bf16_t, WS_HB), OKP(bf16_t, WS_W_IN1), T, 5632, 1024, E); }
    phase_proj16(F, 1, nullptr, OKP(bf16_t, WS_HB), (const float*)F.ctl + CW_SSQ + 3 * T, 1);
    GRID_BAR();
    }
#if CHECK
    fp_save(F, 13, OKP(bf16_t, WS_PROJ), PROJ1_LD, 4096, true, 0);
    fp_save(F, 13, OKP(bf16_t, WS_PROJ) + 4608, PROJ1_LD, 1024, true, 4096);
#endif
#if (DUP_MASK >> 22) & 255
    phase_gdn_prep_t<(DUP_MASK >> 22) & 255>(F); GRID_BAR();
#endif
    for (int dup_a = 0; dup_a < ((DUP_MASK >> 0) & 1) + 1; ++dup_a) { phase_gdn_prep(F); GRID_BAR(); }
    phase_l1_mix(F); GRID_BAR();
    for (int dup_e = 0; dup_e < ((DUP_MASK >> 4) & 1) + 1; ++dup_e) { phase_gdn_final(F); GRID_BAR(); }

    { EpiResidualT<false> E{nullptr, OKP(bf16_t, WS_HB), OKP(float, WS_SSQP4)};
      dense_gemm(F, OKP(bf16_t, WS_CAT1), OKP(bf16_t, WS_W_OUT1), T, 1024, 1536, E); }
    GRID_BAR();
#if CHECK
    fp_save(F, 14, OKP(bf16_t, WS_CAT1), 1536, 1024, true, 0);
    fp_save(F, 15, OKP(bf16_t, WS_CAT1) + 1024, 1536, 512, true, 0);
    fp_save(F, 16, OKP(bf16_t, WS_HB), 1024, 1024, true, 0);
    GRID_BAR();
#endif
    { EpiScaleBf16 E{OKP(bf16_t, WS_Q), 1024, OKP(float, WS_SSQP4), 16};
      dense_gemm(F, OKP(bf16_t, WS_HB), OKP(bf16_t, WS_W_XA + 8 * MiB), T, 1024, 1024, E); }
    GRID_BAR();
    phase_xattn(F, OKP(bf16_t, WS_Q), OKP(bf16_t, WS_KX) + (size_t)NB * 256 * 1024, OKP(bf16_t, WS_VT) + (size_t)1024 * NB * 256, OKP(bf16_t, WS_ATT));
    GRID_BAR();
    { EpiResidualT<false> E{nullptr, OKP(bf16_t, WS_HB), OKP(float, WS_SSQP5)};
      dense_gemm(F, OKP(bf16_t, WS_ATT), OKP(bf16_t, WS_W_XA + 8 * MiB + 6 * MiB), T, 1024, 1024, E); }
    GRID_BAR();
#if CHECK
    fp_save(F, 17, OKP(bf16_t, WS_HB), 1024, 1024, true, 0);
    GRID_BAR();
#endif
    phase_router(F, 1, OKP(bf16_t, WS_HB), OKP(float, WS_SSQP5), 16);
    phase_cvt_moe(F, 1);
    GRID_BAR();
    phase_scatter(F, 1, OKP(bf16_t, WS_HB), OKP(float, WS_SSQP5), 16);
    GRID_BAR();
    phase_moe_up(F);
    GRID_BAR();
    phase_moe_down(F);
    GRID_BAR();
    phase_combine(F, OKP(bf16_t, WS_HB), nullptr, true);
#if CHECK
    GRID_BAR();
    fp_save(F, 18, F.out, 1024, 1024, false, 0);
    fp_save(F, 1, OKP(float, WS_DTV), 16, 16, false, 0);
    fp_save(F, 2, OKP(float, WS_ACS), 16, 16, false, 0);
    GRID_BAR();
    {
        const size_t gid = (size_t)blockIdx.x * NT + F.tid, gs = (size_t)F.G * NT;
        for (int st = 0;; ++st) {
            const int s = st % sm::NSTAGE_L;
            if (st < 2 * sm::NSTAGE_L && s >= sm::N_STAGES_USED) continue;
            if (!sm::run_stage(a.oc, st, gid, gs)) break;
            GRID_BAR();
            if (st == 3) fp_cmp(F, 0, a.oc.proj, sm::PROJ_LD, 0, 4096, 0);
            if (st == 4) { fp_cmp(F, 1, a.oc.dtv, 16, 0, 16, 0); fp_cmp(F, 2, a.oc.acs, 16, 0, 16, 0); }
            if (st == 4 && gid == 0) { float* c = (float*)F.ctl + CW_CHK; c[6] = 0.f; c[7] = 1.f; c[8] = 0.f; c[9] = 1.f; c[10] = 0.f; c[11] = 1.f; }
            if (st == 5) fp_cmp_lin(F, 6, a.oc.states, ((size_t)5 * 16 + 0) * 8192, 65536);
            if (st == 6) fp_cmp_lin(F, 7, a.oc.states, ((size_t)5 * 16 + 0) * 8192, 65536);
            if (st == 10) { fp_cmp(F, 8, a.oc.cat, 1536, 0, 512, 0); fp_cmp(F, 9, a.oc.cat, 1536, 512, 1024, 0); }
            if (st == 11) fp_cmp(F, 10, a.oc.h, 1024, 0, 1024, 0);
            if (st == 18) fp_cmp(F, 11, a.oc.h, 1024, 0, 1024, 0);
            if (st == 23) fp_cmp(F, 12, a.oc.h, 1024, 0, 1024, 0);
            if (st == 63) { fp_cmp(F, 13, a.oc.proj, sm::PROJ_LD, 0, 4096, 0); fp_cmp(F, 13, a.oc.proj, sm::PROJ_LD, 4624, 1024, 4096); }
            if (st == 70) { fp_cmp(F, 14, a.oc.cat, 1536, 0, 1024, 0); fp_cmp(F, 15, a.oc.cat, 1536, 1024, 512, 0); }
            if (st == 71) fp_cmp(F, 16, a.oc.h, 1024, 0, 1024, 0);
            if (st == 78) fp_cmp(F, 17, a.oc.h, 1024, 0, 1024, 0);
            if (st == 121) fp_cmp(F, 18, a.oc.out, 1024, 0, 1024, 0);
            GRID_BAR();
        }
        GRID_BAR();
        int code = 0;
        for (int k = CHECK - 1; k >= 0; --k) { const float num = __hip_atomic_load((float*)F.ctl + CW_CHK + 2 * k, __ATOMIC_RELAXED, __HIP_MEMORY_SCOPE_AGENT), den = __hip_atomic_load((float*)F.ctl + CW_CHK + 2 * k + 1, __ATOMIC_RELAXED, __HIP_MEMORY_SCOPE_AGENT);
            if (!(num <= 1e-3f * den) || den == 0.f) code = k + 1; }
        const float sc = 1.f + 0.2f * (float)code;
        for (size_t i = gid; i < (size_t)L * DM; i += gs) { F.out[i] *= sc; F.out[(size_t)L * DM + i] = 0.f; }
    }
#endif
}
}

extern "C" void kernel_launch(void* const* d_in, const int* in_sizes, int n_in, void* d_out, int out_size, void* d_ws, size_t ws_size, hipStream_t stream) {
    static int grid = 0;
    if (grid == 0) {
        int dev = 0, cus = 0, per_cu = 0;
        hipGetDevice(&dev); hipDeviceGetAttribute(&cus, hipDeviceAttributeMultiprocessorCount, dev);
        if (hipFuncSetAttribute((const void*)ok::mk_fwd, hipFuncAttributeMaxDynamicSharedMemorySize, LDS_BYTES) != hipSuccess) { fprintf(stderr, "kernel_launch: hipFuncSetAttribute failed\n"); grid = -1; return; }
        hipOccupancyMaxActiveBlocksPerMultiprocessor(&per_cu, (const void*)ok::mk_fwd, ok::NT, LDS_BYTES);
        (void)hipGetLastError();
        grid = cus;
        if (n_in != 33 || ws_size < ok::WS_END || per_cu < 1) { fprintf(stderr, "kernel_launch: n_in %d ws %zu need %zu per_cu %d\n", n_in, ws_size, (size_t)ok::WS_END, per_cu); grid = -1; }
    }
    if (grid < 0) return;
    hipMemsetAsync((char*)d_ws + ok::WS_CTL, 0, ok::CTL_BYTES, stream);
    ok::Args a{};
    for (int i = 0; i < 33; ++i) a.in[i] = (const float*)d_in[i];
    a.out = (float*)d_out; a.ws = (unsigned char*)d_ws;
#if CHECK
    sm::carve(a.oc, (float*)((char*)d_ws + 16 * ok::MiB));
    for (int i = 0; i < 33; ++i) a.oc.in[i] = (const float*)d_in[i];
    a.oc.out = (float*)d_out;
#endif
    hipLaunchKernelGGL(ok::mk_fwd, dim3(grid), dim3(ok::NT), LDS_BYTES, stream, a);
}
```

```cpp
#include <hip/hip_runtime.h>
#include <cstdio>
#include <cstdint>
#ifndef CHECK
#define CHECK 0
#endif
#define DUP_MASK 0
constexpr int LDS_BYTES = 147456;

#define XB_TMO      128
#define XB_XCNT(j)  (256  + 64 * (j))
#define XB_XSUB(j)  (1280 + 64 * (j))
#define XB_XGEN(j)  (2304 + 64 * (j))
#define XB_TOP      3328
#define XB_TOPGEN   3392
#define XCD_BAR_WORDS 3456
#define XB_SPIN_CAP (1u << 18)
#define LAS __attribute__((address_space(3)))

__device__ __forceinline__ unsigned xb_ld(unsigned* p)              { return __hip_atomic_load(p, __ATOMIC_RELAXED, __HIP_MEMORY_SCOPE_AGENT); }
__device__ __forceinline__ unsigned xb_add(unsigned* p, unsigned v) { return __hip_atomic_fetch_add(p, v, __ATOMIC_RELAXED, __HIP_MEMORY_SCOPE_AGENT); }
__device__ __forceinline__ unsigned xb_xcc_id() { return (unsigned)__builtin_amdgcn_s_getreg((3 << 11) | 20) & 0xFu; }
#define XB_SPIN(cond, bar) do { unsigned _sp = 0; while (cond) { __builtin_amdgcn_s_sleep(1); \
    if ((++_sp & 255u) == 0u) { if (xb_ld(&(bar)[XB_TMO])) break; if (_sp > XB_SPIN_CAP) { atomicAdd(&(bar)[XB_TMO], 1u); break; } } } } while (0)

struct XcdBarrier {
    unsigned* bar; unsigned x;
    volatile LAS unsigned* st;
};

__device__ __forceinline__ XcdBarrier xcd_barrier_post(unsigned* bar, volatile LAS unsigned* st) {
    XcdBarrier b; b.bar = bar; b.x = xb_xcc_id(); b.st = st;
    if (threadIdx.x == 0) (void)xb_add(&bar[XB_XCNT(b.x)], 1u);
    return b;
}
__device__ __forceinline__ void xcd_barrier_complete(unsigned* bar, unsigned x, unsigned& nloc, unsigned& nx) {
    const unsigned G = gridDim.x * gridDim.y * gridDim.z;
    unsigned sum, cnt, mine, sp = 0u;
    for (;;) {
        sum = 0u; cnt = 0u; mine = 0u;
#pragma unroll
        for (unsigned j = 0; j < 16; ++j) { const unsigned c = xb_ld(&bar[XB_XCNT(j)]); sum += c; cnt += (c > 0u) ? 1u : 0u; mine = (j == x) ? c : mine; }
        if (sum == G) break;
        __builtin_amdgcn_s_sleep(1);
        if ((++sp & 255u) == 0u) { if (xb_ld(&bar[XB_TMO])) break; if (sp > XB_SPIN_CAP) { atomicAdd(&bar[XB_TMO], 1u); break; } }
    }
    nloc = mine > 0u ? mine : 1u; nx = cnt > 0u ? cnt : 1u;
}

__device__ __forceinline__ void xcd_barrier(const XcdBarrier& b) {
    asm volatile("s_waitcnt vmcnt(0)" ::: "memory");
    __syncthreads();
    if (threadIdx.x == 0) {
        unsigned* bar = b.bar;
        __builtin_amdgcn_s_waitcnt(0);
        unsigned nloc = b.st[0], nx = b.st[1];
        if (nloc == 0u) { xcd_barrier_complete(bar, b.x, nloc, nx); b.st[0] = nloc; b.st[1] = nx; }
        const unsigned old = xb_add(&bar[XB_XSUB(b.x)], 1u);
        const unsigned gen = old / nloc;
        if (old + 1u == (gen + 1u) * nloc) {
            __builtin_amdgcn_fence(__ATOMIC_RELEASE, "agent");
            asm volatile("s_waitcnt vmcnt(0)" ::: "memory");
            const unsigned og = xb_add(&bar[XB_TOP], 1u);
            const unsigned tg = og / nx;
            if (og + 1u == (tg + 1u) * nx) xb_add(&bar[XB_TOPGEN], 1u);
            else XB_SPIN(xb_ld(&bar[XB_TOPGEN]) == tg, bar);
            __builtin_amdgcn_fence(__ATOMIC_ACQUIRE, "agent");
            xb_add(&bar[XB_XGEN(b.x)], 1u);
            asm volatile("s_waitcnt vmcnt(0)" ::: "memory");
        } else {
            XB_SPIN(xb_ld(&bar[XB_XGEN(b.x)]) == gen, bar);
            __builtin_amdgcn_fence(__ATOMIC_ACQUIRE, "agent");
            asm volatile("s_waitcnt vmcnt(0)" ::: "memory");
        }
    }
    __syncthreads();
}


#undef LAS

#ifndef SEQ
#define SEQ 8192
#endif
namespace sm {
constexpr int DM = 1024, NB = 1  , L = SEQ, T = NB * L, NCH = L / 64, MEM = 256;
constexpr int EV_IN = 4112, OD_IN = 5648, PROJ_LD = 5648;
constexpr int E_SCB = 0, E_SCC = 512, E_SCX = 1024, E_Z = 1536, E_XBC = 2560, E_DT = 4096;
constexpr int O_QKV = 0, O_Z = 3072, O_A = 4096, O_B = 4104, O_SQ = 4112, O_SK = 4624, O_SV = 5136;

struct Ctx {
    const float* in[33];
    float* out;
    float *memn, *kx, *vx, *h, *un, *rstd, *proj, *cat, *xbcc, *dtv, *acs, *states, *cb, *ybuf, *rstd2;
    float *q, *att, *sc;
    float *gatew, *act; int* eid;
    float *qkvc, *beta, *gcs, *Lm, *aqk, *uw, *S, *vn, *obuf;
};
enum In { I_X = 0, I_MEM, I_MEM_NORM, I_FINAL_NORM, I_NORM_MIX, I_NORM_XA, I_NORM_FFN, I_XA_WQ, I_XA_WK, I_XA_WV, I_XA_WO,
          I_MOE_WG, I_MOE_BG, I_MOE_WE, I_MOE_BE, I_MOE_WGATE, I_MOE_WUP, I_MOE_WDOWN,
          I_EV_WIN, I_EV_SCCONV, I_EV_CONVW, I_EV_CONVB, I_EV_DTB, I_EV_ALOG, I_EV_D, I_EV_NORM, I_EV_WOUT,
          I_OD_WIN, I_OD_CONV, I_OD_DTB, I_OD_ALOG, I_OD_NORM, I_OD_WOUT };

__device__ __forceinline__ float siluf(float x) { return x / (1.f + expf(-x)); }
__device__ __forceinline__ float softplusf(float x) { return x > 20.f ? x : log1pf(expf(x)); }
__device__ __forceinline__ float sigmoidf(float x) { return 1.f / (1.f + expf(-x)); }

__device__ __forceinline__ void s_copy(const float* src, float* dst, size_t n, size_t gid, size_t gs) { for (size_t i = gid; i < n; i += gs) dst[i] = src[i]; }
__device__ __forceinline__ void s_rstd(const float* x, int R, int W, int ld, float* rstd, size_t gid, size_t gs) {
    for (size_t r = gid; r < (size_t)R; r += gs) { const float* p = x + r * ld; float s = 0.f; for (int i = 0; i < W; ++i) s += p[i] * p[i]; rstd[r] = 1.f / sqrtf(s / W + 1e-6f); }
}
__device__ __forceinline__ void s_norm(const float* x, const float* rstd, const float* g, float* y, int R, size_t gid, size_t gs) {
    for (size_t i = gid; i < (size_t)R * DM; i += gs) { const size_t r = i / DM; const int c = (int)(i % DM); y[i] = x[i] * rstd[r] * g[c]; }
}
__device__ __forceinline__ void s_gemm(const float* A, int lda, const float* W, int ldw, float* C, int ldc, int M, int N, int K, int accum, size_t gid, size_t gs) {
    const int N4 = N / 4;
    for (size_t i = gid; i < (size_t)M * N4; i += gs) { const size_t m = i / N4; const int n = (int)(i % N4) * 4; const float* a = A + m * lda; const float* w = W + n; float s0 = 0.f, s1 = 0.f, s2 = 0.f, s3 = 0.f;
        for (int k = 0; k < K; ++k) { const float av = a[k]; const float4 wv = *(const float4*)(w + (size_t)k * ldw); s0 += av * wv.x; s1 += av * wv.y; s2 += av * wv.z; s3 += av * wv.w; }
        float4* c = (float4*)(C + m * ldc + n); float4 o = accum ? *c : float4{0.f, 0.f, 0.f, 0.f}; o.x += s0; o.y += s1; o.z += s2; o.w += s3; *c = o; }
}
__device__ __forceinline__ void s_scmix(const Ctx& c, size_t gid, size_t gs) {
    const float* w = c.in[I_EV_SCCONV];
    for (size_t i = gid; i < (size_t)T * 512; i += gs) { const size_t t = i / 512; const int ch = (int)(i % 512); const int tl = (int)(t % L); float s = 0.f;
        for (int j = 0; j < 3; ++j) { const int tt = tl - 2 + j; if (tt >= 0) { const float* p = c.proj + (t - 2 + j) * PROJ_LD; s += w[j * 512 + ch] * p[E_SCC + ch] * p[E_SCX + ch]; } }
        c.cat[t * 1536 + ch] = c.proj[t * PROJ_LD + E_SCB + ch] * s; }
}
__device__ __forceinline__ void s_ssd_conv(const Ctx& c, size_t gid, size_t gs) {
    const float* w = c.in[I_EV_CONVW]; const float* b = c.in[I_EV_CONVB];
    for (size_t i = gid; i < (size_t)T * 1536; i += gs) { const size_t t = i / 1536; const int ch = (int)(i % 1536); const int tl = (int)(t % L); float s = b[ch];
        for (int j = 0; j < 4; ++j) { const int tt = tl - 3 + j; if (tt >= 0) s += w[j * 1536 + ch] * c.proj[(t - 3 + j) * PROJ_LD + E_XBC + ch]; }
        c.xbcc[i] = siluf(s); }
}
__device__ __forceinline__ void s_ssd_dt(const Ctx& c, size_t gid, size_t gs) {
    for (size_t i = gid; i < (size_t)NB * NCH * 16; i += gs) { const int hd = (int)(i % 16); const size_t bc = i / 16; const float a = -expf(c.in[I_EV_ALOG][hd]); float cs = 0.f;
        for (int s = 0; s < 64; ++s) { const size_t t = bc * 64 + s; const float dt = softplusf(c.proj[t * PROJ_LD + E_DT + hd] + c.in[I_EV_DTB][hd]); cs += dt * a; c.dtv[t * 16 + hd] = dt; c.acs[t * 16 + hd] = cs; } }
}
__device__ __forceinline__ void s_ssd_states(const Ctx& c, size_t gid, size_t gs) {
    for (size_t i = gid; i < (size_t)NB * NCH * 16 * 64 * 128; i += gs) { const int n = (int)(i % 128); const int p = (int)((i / 128) % 64); const int hd = (int)((i / 8192) % 16); const size_t bc = i / (8192 * 16);
        const int g = hd / 8; const float last = c.acs[(bc * 64 + 63) * 16 + hd]; float s = 0.f;
        for (int k = 0; k < 64; ++k) { const size_t t = bc * 64 + k; s += c.xbcc[t * 1536 + 1024 + g * 128 + n] * c.xbcc[t * 1536 + hd * 64 + p] * c.dtv[t * 16 + hd] * expf(last - c.acs[t * 16 + hd]); }
        c.states[i] = s; }
}
__device__ __forceinline__ void s_ssd_scan(const Ctx& c, size_t gid, size_t gs) {
    for (size_t i = gid; i < (size_t)NB * 16 * 8192; i += gs) { const size_t b = i / (16 * 8192); const size_t r = i % (16 * 8192); const int hd = (int)(r / 8192); float s = 0.f;
        for (int ch = 0; ch < NCH; ++ch) { const size_t bc = b * NCH + ch; const size_t idx = bc * (16 * 8192) + r; const float st = c.states[idx]; c.states[idx] = s; s = s * expf(c.acs[(bc * 64 + 63) * 16 + hd]) + st; } }
}
__device__ __forceinline__ void s_ssd_cb(const Ctx& c, size_t gid, size_t gs) {
    for (size_t i = gid; i < (size_t)NB * NCH * 2 * 4096; i += gs) { const int s = (int)(i % 64); const int t = (int)((i / 64) % 64); const int g = (int)((i / 4096) % 2); const size_t bc = i / 8192;
        const float* cm = c.xbcc + (bc * 64 + t) * 1536 + 1280 + g * 128; const float* bm = c.xbcc + (bc * 64 + s) * 1536 + 1024 + g * 128; float a = 0.f;
        for (int n = 0; n < 128; ++n) a += cm[n] * bm[n];
        c.cb[i] = a; }
}
__device__ __forceinline__ void s_ssd_y(const Ctx& c, size_t gid, size_t gs) {
    for (size_t i = gid; i < (size_t)T * 1024; i += gs) { const size_t t = i / 1024; const int hp = (int)(i % 1024); const int hd = hp / 64, p = hp % 64, g = hd / 8; const size_t bc = t / 64; const int tl = (int)(t % 64);
        const float at = c.acs[t * 16 + hd]; float y = 0.f;
        for (int s = 0; s <= tl; ++s) { const size_t ts = bc * 64 + s; y += c.cb[(bc * 2 + g) * 4096 + tl * 64 + s] * expf(at - c.acs[ts * 16 + hd]) * c.xbcc[ts * 1536 + hp] * c.dtv[ts * 16 + hd]; }
        const float* cm = c.xbcc + t * 1536 + 1280 + g * 128; const float* pv = c.states + (bc * 16 + hd) * 8192 + p * 128; float yo = 0.f;
        for (int n = 0; n < 128; ++n) yo += cm[n] * pv[n];
        y += yo * expf(at) + c.xbcc[t * 1536 + hp] * c.in[I_EV_D][hd];
        c.ybuf[i] = y * siluf(c.proj[t * PROJ_LD + E_Z + hp]); }
}
__device__ __forceinline__ void s_ssd_out(const Ctx& c, size_t gid, size_t gs) {
    for (size_t i = gid; i < (size_t)T * 1024; i += gs) { const size_t t = i / 1024; const int ch = (int)(i % 1024); c.cat[t * 1536 + 512 + ch] = c.ybuf[i] * c.rstd2[t * 2 + ch / 512] * c.in[I_EV_NORM][ch]; }
}
__device__ __forceinline__ void s_xa_scores(const Ctx& c, size_t gid, size_t gs) {
    for (size_t i = gid; i < (size_t)T * 4 * 256; i += gs) { const int m = (int)(i % 256); const int hd = (int)((i / 256) % 4); const size_t t = i / 1024; const size_t b = t / L;
        const float* q = c.q + t * 1024 + hd * 256; const float* k = c.kx + (b * 256 + m) * 1024 + hd * 256; float s = 0.f;
        for (int d = 0; d < 256; ++d) s += q[d] * k[d];
        c.sc[i] = s * 0.0625f; }
}
__device__ __forceinline__ void s_xa_softmax(const Ctx& c, size_t gid, size_t gs) {
    for (size_t i = gid; i < (size_t)T * 4; i += gs) { float* p = c.sc + i * 256; float mx = p[0]; for (int m = 1; m < 256; ++m) mx = fmaxf(mx, p[m]); float s = 0.f; for (int m = 0; m < 256; ++m) { const float e = expf(p[m] - mx); p[m] = e; s += e; } const float r = 1.f / s; for (int m = 0; m < 256; ++m) p[m] *= r; }
}
__device__ __forceinline__ void s_xa_pv(const Ctx& c, size_t gid, size_t gs) {
    for (size_t i = gid; i < (size_t)T * 1024; i += gs) { const size_t t = i / 1024; const int col = (int)(i % 1024); const int hd = col / 256; const size_t b = t / L; const float* p = c.sc + (t * 4 + hd) * 256; const float* v = c.vx + b * 256 * 1024 + col; float s = 0.f;
        for (int m = 0; m < 256; ++m) s += p[m] * v[(size_t)m * 1024];
        c.att[i] = s; }
}
__device__ __forceinline__ void s_router(const Ctx& c, int l, size_t gid, size_t gs) {
    const float* wg = c.in[I_MOE_WG] + (size_t)l * 1024 * 4; const float* bg = c.in[I_MOE_BG] + l * 4; const float* we = c.in[I_MOE_WE] + (size_t)l * 1024 * 32; const float* be = c.in[I_MOE_BE] + l * 32;
    for (size_t t = gid; t < (size_t)T; t += gs) { const float* x = c.un + t * 1024; float g0 = 0.f, g1 = 0.f, g2 = 0.f, g3 = 0.f;
        for (int k = 0; k < 1024; ++k) { const float xv = x[k]; g0 += xv * wg[k * 4 + 0]; g1 += xv * wg[k * 4 + 1]; g2 += xv * wg[k * 4 + 2]; g3 += xv * wg[k * 4 + 3]; }
        g0 += bg[0]; g1 += bg[1]; g2 += bg[2]; g3 += bg[3];
        int gsel = 0; float gm = g0; if (g1 > gm) { gm = g1; gsel = 1; } if (g2 > gm) { gm = g2; gsel = 2; } if (g3 > gm) { gm = g3; gsel = 3; }
        const float gw = 1.f / (expf(g0 - gm) + expf(g1 - gm) + expf(g2 - gm) + expf(g3 - gm));
        float e0 = 0, e1 = 0, e2 = 0, e3 = 0, e4 = 0, e5 = 0, e6 = 0, e7 = 0; const float* w = we + gsel * 8;
        for (int k = 0; k < 1024; ++k) { const float xv = x[k]; const float* wk = w + k * 32; e0 += xv * wk[0]; e1 += xv * wk[1]; e2 += xv * wk[2]; e3 += xv * wk[3]; e4 += xv * wk[4]; e5 += xv * wk[5]; e6 += xv * wk[6]; e7 += xv * wk[7]; }
        const float* bb = be + gsel * 8; e0 += bb[0]; e1 += bb[1]; e2 += bb[2]; e3 += bb[3]; e4 += bb[4]; e5 += bb[5]; e6 += bb[6]; e7 += bb[7];
        int i1 = 0; float m1 = e0;
#define SM_T1(j, v) if (v > m1) { m1 = v; i1 = j; }
        SM_T1(1, e1) SM_T1(2, e2) SM_T1(3, e3) SM_T1(4, e4) SM_T1(5, e5) SM_T1(6, e6) SM_T1(7, e7)
        int i2 = -1; float m2 = -3.0e38f;
#define SM_T2(j, v) if (j != i1 && v > m2) { m2 = v; i2 = j; }
        SM_T2(0, e0) SM_T2(1, e1) SM_T2(2, e2) SM_T2(3, e3) SM_T2(4, e4) SM_T2(5, e5) SM_T2(6, e6) SM_T2(7, e7)
        const float r = expf(m2 - m1); const float w1 = gw / (1.f + r), w2 = gw * r / (1.f + r);
        c.eid[t * 2 + 0] = gsel * 8 + i1; c.eid[t * 2 + 1] = gsel * 8 + i2; c.gatew[t * 2 + 0] = w1; c.gatew[t * 2 + 1] = w2; }
}
__device__ __forceinline__ void s_moe_up(const Ctx& c, int l, size_t gid, size_t gs) {
    for (size_t i = gid; i < (size_t)T * 2 * 512; i += gs) { const int f = (int)(i % 512); const size_t tk = i / 512; const size_t t = tk / 2; const int e = c.eid[tk] & 31;
        const float* wg = c.in[I_MOE_WGATE] + ((size_t)l * 32 + e) * 1024 * 512 + f; const float* wu = c.in[I_MOE_WUP] + ((size_t)l * 32 + e) * 1024 * 512 + f; const float* x = c.un + t * 1024; float a = 0.f, b = 0.f;
        for (int k = 0; k < 1024; ++k) { a += x[k] * wg[(size_t)k * 512]; b += x[k] * wu[(size_t)k * 512]; }
        c.act[i] = siluf(a) * b; }
}
__device__ __forceinline__ void s_moe_down(const Ctx& c, int l, size_t gid, size_t gs) {
    for (size_t i = gid; i < (size_t)T * 1024; i += gs) { const size_t t = i / 1024; const int n = (int)(i % 1024); float y = 0.f;
        for (int k = 0; k < 2; ++k) { const int e = c.eid[t * 2 + k] & 31; const float* wd = c.in[I_MOE_WDOWN] + ((size_t)l * 32 + e) * 512 * 1024 + n; const float* a = c.act + (t * 2 + k) * 512; float s = 0.f;
            for (int f = 0; f < 512; ++f) s += a[f] * wd[(size_t)f * 1024];
            y += s * c.gatew[t * 2 + k]; }
        c.h[i] += y; }
}
__device__ __forceinline__ void s_gdn_conv(const Ctx& c, size_t gid, size_t gs) {
    const float* w = c.in[I_OD_CONV];
    for (size_t i = gid; i < (size_t)T * 3072; i += gs) { const size_t t = i / 3072; const int ch = (int)(i % 3072); const int tl = (int)(t % L); float s = 0.f;
        for (int j = 0; j < 4; ++j) { const int tt = tl - 3 + j; if (tt >= 0) s += w[j * 3072 + ch] * c.proj[(t - 3 + j) * PROJ_LD + O_QKV + ch]; }
        c.qkvc[i] = siluf(s); }
}
__device__ __forceinline__ void s_gdn_qkscale(const Ctx& c, size_t gid, size_t gs) {
    for (size_t i = gid; i < (size_t)T * 16; i += gs) { const size_t t = i / 16; const int wh = (int)(i % 16); float* p = c.qkvc + t * 3072 + wh * 128; float s = 0.f; for (int d = 0; d < 128; ++d) s += p[d] * p[d];
        float r = 1.f / sqrtf(s + 1e-6f); if (wh < 8) r *= 0.08838834764831845f; for (int d = 0; d < 128; ++d) p[d] *= r; }
}
__device__ __forceinline__ void s_gdn_gates(const Ctx& c, size_t gid, size_t gs) {
    for (size_t i = gid; i < (size_t)NB * NCH * 8; i += gs) { const int hd = (int)(i % 8); const size_t bc = i / 8; const float na = -expf(c.in[I_OD_ALOG][hd]); const float db = c.in[I_OD_DTB][hd]; float cs = 0.f;
        for (int s = 0; s < 64; ++s) { const size_t t = bc * 64 + s; cs += na * softplusf(c.proj[t * PROJ_LD + O_A + hd] + db); c.gcs[t * 8 + hd] = cs; c.beta[t * 8 + hd] = sigmoidf(c.proj[t * PROJ_LD + O_B + hd]); } }
}
__device__ __forceinline__ void s_gdn_kk(const Ctx& c, size_t gid, size_t gs) {
    for (size_t i = gid; i < (size_t)NB * NCH * 8 * 4096; i += gs) { const int s = (int)(i % 64); const int t = (int)((i / 64) % 64); const int hd = (int)((i / 4096) % 8); const size_t bc = i / (4096 * 8);
        float lv = 0.f, av = 0.f;
        if (s <= t) { const size_t tt = bc * 64 + t, ts = bc * 64 + s; const float* kt = c.qkvc + tt * 3072 + 1024 + hd * 128; const float* ks = c.qkvc + ts * 3072 + 1024 + hd * 128; const float* qt = c.qkvc + tt * 3072 + hd * 128; float kk = 0.f, qk = 0.f;
            for (int d = 0; d < 128; ++d) { kk += kt[d] * ks[d]; qk += qt[d] * ks[d]; }
            const float dec = expf(c.gcs[tt * 8 + hd] - c.gcs[ts * 8 + hd]); av = qk * dec; if (s < t) lv = kk * c.beta[tt * 8 + hd] * dec; }
        c.Lm[i] = lv; c.aqk[i] = av; }
}
__device__ __forceinline__ void s_gdn_solve(const Ctx& c, size_t gid, size_t gs) {
    for (size_t i = gid; i < (size_t)NB * NCH * 8 * 256; i += gs) { const int j = (int)(i % 256); const int hd = (int)((i / 256) % 8); const size_t bc = i / 2048; float* sol = c.uw + (bc * 8 + hd) * (64 * 256) + j; const float* Lp = c.Lm + (bc * 8 + hd) * 4096;
        for (int t = 0; t < 64; ++t) { const size_t tt = bc * 64 + t; const float bt = c.beta[tt * 8 + hd];
            float r = (j < 128) ? c.qkvc[tt * 3072 + 2048 + hd * 128 + j] * bt : c.qkvc[tt * 3072 + 1024 + hd * 128 + (j - 128)] * bt * expf(c.gcs[tt * 8 + hd]);
            for (int s = 0; s < t; ++s) r -= Lp[t * 64 + s] * sol[(size_t)s * 256];
            sol[(size_t)t * 256] = r; } }
}
__device__ __forceinline__ void s_gdn_scan(const Ctx& c, size_t gid, size_t gs) {
    for (size_t i = gid; i < (size_t)NB * 8 * 128; i += gs) { const int j = (int)(i % 128); const size_t bh = i / 128; const int hd = (int)(bh % 8); const size_t b = bh / 8; float* S = c.S + bh * 16384 + j; float* vn = c.vn + bh * 8192 + j;
        for (int d = 0; d < 128; ++d) S[(size_t)d * 128] = 0.f;
        for (int ch = 0; ch < NCH; ++ch) { const size_t bc = b * NCH + ch; const float* uw = c.uw + (bc * 8 + hd) * (64 * 256); const float* aq = c.aqk + (bc * 8 + hd) * 4096; const float glast = c.gcs[(bc * 64 + 63) * 8 + hd];
            for (int t = 0; t < 64; ++t) { float v = uw[t * 256 + j]; const float* w = uw + t * 256 + 128; for (int d = 0; d < 128; ++d) v -= w[d] * S[(size_t)d * 128]; vn[(size_t)t * 128] = v; }
            for (int t = 0; t < 64; ++t) { const size_t tt = bc * 64 + t; const float* q = c.qkvc + tt * 3072 + hd * 128; float o = 0.f; for (int d = 0; d < 128; ++d) o += q[d] * S[(size_t)d * 128];
                o *= expf(c.gcs[tt * 8 + hd]); for (int s = 0; s <= t; ++s) o += aq[t * 64 + s] * vn[(size_t)s * 128];
                c.obuf[tt * 1024 + hd * 128 + j] = o; }
            const float dl = expf(glast);
            for (int d = 0; d < 128; ++d) { float a = S[(size_t)d * 128] * dl; for (int t = 0; t < 64; ++t) { const size_t tt = bc * 64 + t; a += c.qkvc[tt * 3072 + 1024 + hd * 128 + d] * expf(glast - c.gcs[tt * 8 + hd]) * vn[(size_t)t * 128]; } S[(size_t)d * 128] = a; } } }
}
__device__ __forceinline__ void s_gdn_out(const Ctx& c, size_t gid, size_t gs) {
    for (size_t i = gid; i < (size_t)T * 1024; i += gs) { const size_t t = i / 1024; const int col = (int)(i % 1024); c.cat[t * 1536 + col] = c.obuf[i] * c.rstd2[t * 8 + col / 128] * c.in[I_OD_NORM][col % 128] * siluf(c.proj[t * PROJ_LD + O_Z + col]); }
}
__device__ __forceinline__ void s_sb(const Ctx& c, size_t gid, size_t gs) {
    for (size_t i = gid; i < (size_t)T * 32; i += gs) { const int qd = (int)(i % 4); const int hd = (int)((i / 4) % 8); const size_t t = i / 32; const int tl = (int)(t % L); const float* q = c.proj + t * PROJ_LD + O_SQ + hd * 64;
        float o[16];
#pragma unroll
        for (int d = 0; d < 16; ++d) o[d] = 0.f;
        float carry = 0.f;
        for (int s = tl - 1; s >= 0 && carry > -150.f; --s) { const size_t ts = t - (size_t)(tl - s); const float* k = c.proj + ts * PROJ_LD + O_SK + hd * 64; const float* v = c.proj + ts * PROJ_LD + O_SV + hd * 64 + qd * 16; float lg = 0.f;
            for (int d = 0; d < 64; ++d) lg += q[d] * k[d];
            lg *= 0.125f; const float wgt = expf(-softplusf(-lg) + carry); carry -= softplusf(lg);
#pragma unroll
            for (int d = 0; d < 16; ++d) o[d] += wgt * v[d]; }
#pragma unroll
        for (int d = 0; d < 16; ++d) c.cat[t * 1536 + 1024 + hd * 64 + qd * 16 + d] = o[d]; }
}
__device__ __forceinline__ void s_final(const Ctx& c, size_t gid, size_t gs) { s_norm(c.h, c.rstd, c.in[I_FINAL_NORM], c.out, T, gid, gs); }

constexpr int XA_BASE = 20, MOE_BASE = 30, L1_BASE = 40, NSTAGE_L = 60;
__device__ __forceinline__ bool run_stage(const Ctx& c, int st, size_t gid, size_t gs) {
    const int layer = st / NSTAGE_L, s = st % NSTAGE_L;
    if (st >= 2 * NSTAGE_L + 2) return false;
    if (st == 2 * NSTAGE_L) { s_rstd(c.h, T, DM, DM, c.rstd, gid, gs); return true; }
    if (st == 2 * NSTAGE_L + 1) { s_final(c, gid, gs); return true; }
    const int l = layer;
    switch (s) {
    case 0: if (l == 0) { s_copy(c.in[I_X], c.h, (size_t)T * DM, gid, gs); s_rstd(c.in[I_MEM], NB * MEM, DM, DM, c.rstd2, gid, gs); } break;
    case 1: if (l == 0) s_norm(c.in[I_MEM], c.rstd2, c.in[I_MEM_NORM], c.memn, NB * MEM, gid, gs); s_rstd(c.h, T, DM, DM, c.rstd, gid, gs); break;
    case 2: s_norm(c.h, c.rstd, c.in[I_NORM_MIX] + l * DM, c.un, T, gid, gs); break;
    case 3: if (l == 0) s_gemm(c.un, DM, c.in[I_EV_WIN], EV_IN, c.proj, PROJ_LD, T, EV_IN, DM, 0, gid, gs); else s_gemm(c.un, DM, c.in[I_OD_WIN], OD_IN, c.proj, PROJ_LD, T, OD_IN, DM, 0, gid, gs); break;
    case 4: if (l == 0) { s_scmix(c, gid, gs); s_ssd_conv(c, gid, gs); s_ssd_dt(c, gid, gs); } else { s_gdn_conv(c, gid, gs); s_gdn_gates(c, gid, gs); s_sb(c, gid, gs); } break;
    case 5: if (l == 0) { s_ssd_states(c, gid, gs); s_ssd_cb(c, gid, gs); } else s_gdn_qkscale(c, gid, gs); break;
    case 6: if (l == 0) s_ssd_scan(c, gid, gs); else s_gdn_kk(c, gid, gs); break;
    case 7: if (l == 0) s_ssd_y(c, gid, gs); else s_gdn_solve(c, gid, gs); break;
    case 8: if (l == 0) s_rstd(c.ybuf, T * 2, 512, 512, c.rstd2, gid, gs); else s_gdn_scan(c, gid, gs); break;
    case 9: if (l == 0) s_ssd_out(c, gid, gs); else s_rstd(c.obuf, T * 8, 128, 128, c.rstd2, gid, gs); break;
    case 10: if (l == 1) s_gdn_out(c, gid, gs); break;
    case 11: s_gemm(c.cat, 1536, l == 0 ? c.in[I_EV_WOUT] : c.in[I_OD_WOUT], DM, c.h, DM, T, DM, 1536, 1, gid, gs); break;
    case 12: s_rstd(c.h, T, DM, DM, c.rstd, gid, gs); break;
    case 13: s_norm(c.h, c.rstd, c.in[I_NORM_XA] + l * DM, c.un, T, gid, gs); break;
    case 14: s_gemm(c.un, DM, c.in[I_XA_WQ] + (size_t)l * DM * DM, DM, c.q, DM, T, DM, DM, 0, gid, gs);
             s_gemm(c.memn, DM, c.in[I_XA_WK] + (size_t)l * DM * DM, DM, c.kx, DM, NB * MEM, DM, DM, 0, gid, gs);
             s_gemm(c.memn, DM, c.in[I_XA_WV] + (size_t)l * DM * DM, DM, c.vx, DM, NB * MEM, DM, DM, 0, gid, gs); break;
    case 15: s_xa_scores(c, gid, gs); break;
    case 16: s_xa_softmax(c, gid, gs); break;
    case 17: s_xa_pv(c, gid, gs); break;
    case 18: s_gemm(c.att, DM, c.in[I_XA_WO] + (size_t)l * DM * DM, DM, c.h, DM, T, DM, DM, 1, gid, gs); break;
    case 19: s_rstd(c.h, T, DM, DM, c.rstd, gid, gs); break;
    case 20: s_norm(c.h, c.rstd, c.in[I_NORM_FFN] + l * DM, c.un, T, gid, gs); break;
    case 21: s_router(c, l, gid, gs); break;
    case 22: s_moe_up(c, l, gid, gs); break;
    case 23: s_moe_down(c, l, gid, gs); break;
    default: break;
    }
    return true;
}
constexpr int N_STAGES_USED = 24;

__host__ __device__ __forceinline__ size_t carve(Ctx& c, float* w) {
    size_t o = 0;
    auto take = [&](size_t n) { float* p = w + o; o += (n + 63) & ~(size_t)63; return p; };
    c.h = take((size_t)T * DM); c.rstd = take(T); c.rstd2 = take((size_t)T * 8); c.memn = take((size_t)MEM * DM); c.kx = take((size_t)MEM * DM); c.vx = take((size_t)MEM * DM);
    c.eid = (int*)take((size_t)T * 2); c.gatew = take((size_t)T * 2); c.dtv = take((size_t)T * 16); c.acs = take((size_t)T * 16); c.beta = take((size_t)T * 8); c.gcs = take((size_t)T * 8);
    c.S = take(8 * 16384); c.vn = take(8 * 8192);
    c.un = take((size_t)T * DM); c.ybuf = c.un; c.obuf = c.un;
    c.proj = take((size_t)T * PROJ_LD);
    c.cat = take((size_t)T * 1536);
    const size_t d0 = o;
    c.xbcc = take((size_t)T * 1536); c.states = take((size_t)NCH * 16 * 8192); c.cb = take((size_t)NCH * 2 * 4096); size_t dmax = o;
    o = d0; c.qkvc = take((size_t)T * 3072); c.Lm = take((size_t)NCH * 8 * 4096); c.aqk = take((size_t)NCH * 8 * 4096); c.uw = take((size_t)NCH * 8 * 64 * 256); if (o > dmax) dmax = o;
    o = d0; c.q = take((size_t)T * DM); c.sc = take((size_t)T * DM); c.att = take((size_t)T * DM); if (o > dmax) dmax = o;
    o = d0; c.act = take((size_t)T * 2 * 512); if (o > dmax) dmax = o;
    return dmax;
}
}

namespace pg8 {
#define PG8_LAS __attribute__((address_space(3)))
typedef unsigned short bf16_t;
typedef short bf16x8 __attribute__((ext_vector_type(8)));
typedef float f32x4 __attribute__((ext_vector_type(4)));
typedef unsigned u32x4 __attribute__((ext_vector_type(4)));
constexpr int BM = 256, BK = 64, HALF = 128, HTB = HALF * BK * 2  , STAGE_BYTES = 8 * HTB, NXCD = 8, WGM = 8;

__host__ __device__ __forceinline__ int lds_byte(int r, int c) { const int st = (r >> 4) * 2 + (c >> 5), rr = r & 15, cc = c & 31, ob = rr * 64 + cc * 2; return st * 1024 + (ob ^ (((ob >> 9) & 1) << 5)); }
__host__ __device__ __forceinline__ void stage_rc(int b, int& R, int& C) { const int st = b / 1024, sb = b % 1024, swz = sb ^ (((sb >> 9) & 1) << 5); R = (st >> 1) * 16 + swz / 64; C = (st & 1) * 32 + (swz % 64) / 2; }
__host__ __device__ __forceinline__ int perm32(int rho) { const int n = rho >> 4, i = rho & 15; return 8 * (i >> 2) + 4 * n + (i & 3); }

struct Unit { int pm, pn, tag; const char* a; const char* b; };
struct Gemm { const bf16_t* A; const bf16_t* Bt; int M, N, K; };

struct StaticOrder {
    static constexpr bool LIGHT = false;
    int nM, nN, nwg, G, c; const char* A; const char* B; size_t tstep;
    __host__ __device__ void init(const Gemm& g, int G_, int c_) { nM = g.M / BM; nN = g.N / BM; nwg = nM * nN; G = G_; c = c_; A = (const char*)g.A; B = (const char*)g.Bt; tstep = (size_t)BM * g.K * 2; }
    __host__ __device__ bool next(int i, Unit& u) const {
        const long L = (long)i * G + c; if (L >= nwg) return false;
        int wgid = (int)L; { const int q = nwg / NXCD, r = nwg % NXCD, xcd = wgid % NXCD, off = wgid / NXCD; wgid = (xcd < r ? xcd * (q + 1) : r * (q + 1) + (xcd - r) * q) + off; }
        const int nig = WGM * nN, gid = wgid / nig, fm = gid * WGM, gsz = (nM - fm) < WGM ? (nM - fm) : WGM;
        u.pm = fm + ((wgid % nig) % gsz); u.pn = (wgid % nig) / gsz; u.a = A + (size_t)u.pm * tstep; u.b = B + (size_t)u.pn * tstep; return true;
    }
    __device__ __forceinline__ void a_ready(const Unit&) const {}
    __device__ __forceinline__ void done(const Unit&) const {}
};

template <class Epi, class Sched, bool ALIGN_EPI = false, bool SP2 = false>
__device__ __forceinline__ void gemm_phase(PG8_LAS unsigned char* lds, const Gemm g, const Sched& S, const Epi& E, int wave_in) {
    int tid_ = threadIdx.x; asm volatile("" : "+v"(tid_));
    const int tid = tid_, wid = __builtin_amdgcn_readfirstlane(tid >> 6), lane = tid & 63, wr = wid >> 2, wc = wid & 3, fr = lane & 15, fq = lane >> 4;
    const int K = g.K, nt = K / BK;
    unsigned voffA[2], voffB[2];
#pragma unroll
    for (int i = 0; i < 2; ++i) { int R, C; stage_rc(tid * 16 + i * 8192, R, C); const int Rb = Epi::PERM ? ((R & ~31) + perm32(R & 31)) : R;
        voffA[i] = (unsigned)(R * K + C) * 2u; voffB[i] = (unsigned)(Rb * K + C) * 2u; }
    const size_t kstep = (size_t)(BK * 2);
    const size_t hstep = (size_t)HALF * K * 2;
    const unsigned ldsw = (unsigned)wid * 1024u;
    const int aoff = lds_byte(wr * 64 + fr, fq * 8), boff = lds_byte(wc * 32 + fr, fq * 8);
#define PG8_SA(b, h) (((b) * 2 + (h)) * HTB)
#define PG8_SB(b, h) ((4 + (b) * 2 + (h)) * HTB)
#define PG8_STAGE(bufoff, gbase, voff) do { _Pragma("unroll") for (int _i = 0; _i < 2; ++_i) \
        __builtin_amdgcn_global_load_lds((const unsigned*)((const char*)(gbase) + (voff)[_i]), (PG8_LAS unsigned*)(lds + (bufoff) + ldsw + _i * 8192), 16, 0, 0); } while (0)
#define PG8_LDA(dst, b, h) do { _Pragma("unroll") for (int m = 0; m < 4; ++m) _Pragma("unroll") for (int k = 0; k < 2; ++k) dst[m][k] = *(const PG8_LAS bf16x8*)(lds + PG8_SA(b, h) + aoff + m * 2048 + k * 1024); } while (0)
#define PG8_LDB(dst, b, h) do { _Pragma("unroll") for (int n = 0; n < 2; ++n) _Pragma("unroll") for (int k = 0; k < 2; ++k) dst[n][k] = *(const PG8_LAS bf16x8*)(lds + PG8_SB(b, h) + boff + n * 2048 + k * 1024); } while (0)
#define PG8_MMA(ai, bj, At, Bt) do { __builtin_amdgcn_s_setprio(1); _Pragma("unroll") for (int m = 0; m < 4; ++m) _Pragma("unroll") for (int n = 0; n < 2; ++n) _Pragma("unroll") for (int k = 0; k < 2; ++k) \
        acc[ai][bj][m][n] = __builtin_amdgcn_mfma_f32_16x16x32_bf16(Bt[n][k], At[m][k], acc[ai][bj][m][n], 0, 0, 0); __builtin_amdgcn_s_setprio(0); } while (0)
#define PG8_WAIT_V(n) asm volatile("s_waitcnt vmcnt(" #n ")" ::: "memory")
#define PG8_WAIT_L(n) asm volatile("s_waitcnt lgkmcnt(" #n ")" ::: "memory")
#define PG8_BAR __builtin_amdgcn_s_barrier()
#define PG8_SCHED __builtin_amdgcn_sched_barrier(0)
    Unit cur, nxt; int ui = 0;
    if (!S.next(0, cur)) return;
    f32x4 acc[2][2][4][2];
#pragma unroll
    for (int a = 0; a < 2; ++a)
#pragma unroll
        for (int b = 0; b < 2; ++b)
#pragma unroll
            for (int m = 0; m < 4; ++m)
#pragma unroll
                for (int n = 0; n < 2; ++n) acc[a][b][m][n] = (f32x4){0.f, 0.f, 0.f, 0.f};
    bf16x8 At[4][2], B0[2][2], B1[2][2];
    const char* cA = cur.a; const char* cB = cur.b;
    S.a_ready(cur);
    if constexpr (SP2) {
        PG8_STAGE(PG8_SB(0, 0), cB, voffB); PG8_STAGE(PG8_SB(0, 1), cB + hstep, voffB); PG8_STAGE(PG8_SA(0, 0), cA, voffA); PG8_STAGE(PG8_SA(0, 1), cA + hstep, voffA);
        if (wr == 1) PG8_BAR;
        PG8_WAIT_V(2); PG8_BAR;
        PG8_STAGE(PG8_SB(1, 0), cB + kstep, voffB); PG8_STAGE(PG8_SA(1, 0), cA + kstep, voffA); PG8_STAGE(PG8_SB(1, 1), cB + hstep + kstep, voffB);
        PG8_WAIT_V(6); PG8_BAR;
    } else {
        PG8_STAGE(PG8_SB(0, 0), cB, voffB); PG8_STAGE(PG8_SA(0, 0), cA, voffA); PG8_STAGE(PG8_SB(0, 1), cB + hstep, voffB); PG8_STAGE(PG8_SA(0, 1), cA + hstep, voffA);
        if (wr == 1) PG8_BAR;
        PG8_WAIT_V(4); PG8_BAR;
        PG8_STAGE(PG8_SB(1, 0), cB + kstep, voffB); PG8_STAGE(PG8_SA(1, 0), cA + kstep, voffA); PG8_STAGE(PG8_SB(1, 1), cB + hstep + kstep, voffB);
        PG8_WAIT_V(6); PG8_BAR;
    }
    for (;;) {
        const bool has_next = S.next(ui + 1, nxt);
        const char* nA = has_next ? nxt.a : cA; const char* nB = has_next ? nxt.b : cB;
        for (int t = 0; t < nt; t += 2) {
            const bool last = (t == nt - 2);
            const char* a1 = cA + (size_t)(t + 1) * kstep;
            const char* a2 = last ? nA : cA + (size_t)(t + 2) * kstep; const char* b2 = last ? nB : cB + (size_t)(t + 2) * kstep;
            const char* a3 = a2 + kstep; const char* b3 = b2 + kstep;
            if (last && has_next) S.a_ready(nxt);
            if constexpr (SP2) {
            PG8_LDB(B0, 0, 0); PG8_LDB(B1, 0, 1); PG8_SCHED; PG8_LDA(At, 0, 0); PG8_STAGE(PG8_SA(1, 1), a1 + hstep, voffA);
            PG8_WAIT_V(8); PG8_WAIT_L(0); PG8_BAR; PG8_MMA(0, 0, At, B0); PG8_MMA(0, 1, At, B1); PG8_BAR; PG8_SCHED;
            PG8_LDA(At, 0, 1); PG8_STAGE(PG8_SB(0, 0), b2, voffB); PG8_STAGE(PG8_SB(0, 1), b2 + hstep, voffB); PG8_STAGE(PG8_SA(0, 0), a2, voffA);
            PG8_WAIT_V(8); PG8_WAIT_L(0); PG8_BAR; if (!(Sched::LIGHT && (cur.tag & 1))) { PG8_MMA(1, 0, At, B0); PG8_MMA(1, 1, At, B1); } PG8_BAR; PG8_SCHED;
            PG8_LDB(B0, 1, 0); PG8_LDB(B1, 1, 1); PG8_SCHED; PG8_LDA(At, 1, 0); PG8_STAGE(PG8_SA(0, 1), a2 + hstep, voffA);
            PG8_WAIT_V(8); PG8_WAIT_L(0); PG8_BAR; PG8_MMA(0, 0, At, B0); PG8_MMA(0, 1, At, B1); PG8_BAR; PG8_SCHED;
            PG8_LDA(At, 1, 1); PG8_STAGE(PG8_SB(1, 0), b3, voffB); PG8_STAGE(PG8_SB(1, 1), b3 + hstep, voffB); PG8_STAGE(PG8_SA(1, 0), a3, voffA);
            PG8_WAIT_V(8); PG8_WAIT_L(0); PG8_BAR; if (!(Sched::LIGHT && (cur.tag & 1))) { PG8_MMA(1, 0, At, B0); PG8_MMA(1, 1, At, B1); } PG8_BAR; PG8_SCHED;
            } else {
            PG8_LDB(B0, 0, 0); PG8_SCHED; PG8_LDA(At, 0, 0); PG8_STAGE(PG8_SA(1, 1), a1 + hstep, voffA);
            PG8_WAIT_L(8); PG8_BAR; PG8_WAIT_L(0); PG8_MMA(0, 0, At, B0); PG8_BAR; PG8_SCHED;
            PG8_LDB(B1, 0, 1); PG8_STAGE(PG8_SB(0, 0), b2, voffB);
            PG8_BAR; PG8_WAIT_L(0); PG8_MMA(0, 1, At, B1); PG8_BAR;
            PG8_LDA(At, 0, 1); PG8_STAGE(PG8_SA(0, 0), a2, voffA);
            PG8_BAR; PG8_WAIT_L(0); PG8_MMA(1, 0, At, B0); PG8_BAR; PG8_SCHED;
            PG8_STAGE(PG8_SB(0, 1), b2 + hstep, voffB);
            PG8_WAIT_V(6); PG8_BAR; PG8_MMA(1, 1, At, B1); PG8_BAR;
            PG8_LDB(B0, 1, 0); PG8_SCHED; PG8_LDA(At, 1, 0); PG8_STAGE(PG8_SA(0, 1), a2 + hstep, voffA);
            PG8_WAIT_L(8); PG8_BAR; PG8_WAIT_L(0); PG8_MMA(0, 0, At, B0); PG8_BAR; PG8_SCHED;
            PG8_LDB(B1, 1, 1); PG8_STAGE(PG8_SB(1, 0), b3, voffB);
            PG8_BAR; PG8_WAIT_L(0); PG8_MMA(0, 1, At, B1); PG8_BAR;
            PG8_LDA(At, 1, 1); PG8_STAGE(PG8_SA(1, 0), a3, voffA);
            PG8_BAR; PG8_WAIT_L(0); PG8_MMA(1, 0, At, B0); PG8_BAR; PG8_SCHED;
            PG8_STAGE(PG8_SB(1, 1), b3 + hstep, voffB);
            PG8_WAIT_V(6); PG8_BAR; PG8_MMA(1, 1, At, B1); PG8_BAR;
            }
        }
        if constexpr (ALIGN_EPI) { if (wr == 0) PG8_BAR; }
        if constexpr (!Epi::AFTER_DRAIN) { E(acc, cur, wr, wc, fr, fq); S.done(cur); }
        if (!has_next) break;
#pragma unroll
        for (int a = 0; a < 2; ++a)
#pragma unroll
            for (int b = 0; b < 2; ++b)
#pragma unroll
                for (int m = 0; m < 4; ++m)
#pragma unroll
                    for (int n = 0; n < 2; ++n) acc[a][b][m][n] = (f32x4){0.f, 0.f, 0.f, 0.f};
        cur = nxt; cA = nA; cB = nB; ++ui;
        if constexpr (ALIGN_EPI) { if (wr == 1) PG8_BAR; }
    }
    PG8_WAIT_V(0);
    if constexpr (!ALIGN_EPI) { if (wr == 0) PG8_BAR; }
    PG8_BAR;
    if constexpr (Epi::AFTER_DRAIN) { E.fused(acc, cur, wr, wc, fr, fq, lds, wid, lane); S.done(cur); }
#undef PG8_SA
#undef PG8_SB
#undef PG8_STAGE
#undef PG8_LDA
#undef PG8_LDB
#undef PG8_MMA
#undef PG8_WAIT_V
#undef PG8_WAIT_L
#undef PG8_BAR
#undef PG8_SCHED
}
}

namespace ok {
using pg8::bf16_t; using pg8::bf16x8; using pg8::f32x4; using pg8::u32x4;
typedef unsigned u32x2 __attribute__((ext_vector_type(2)));
typedef float f32x2 __attribute__((ext_vector_type(2)));
#ifndef SEQ
#define SEQ 8192
#endif
constexpr int NB = 2, L = SEQ, NCH = L / 64, T = NB * L, DM = 1024, NWAVES = 8, NT = 512;
constexpr float EPS = 1e-6f, LOG2E = 1.4426950408889634f;
constexpr size_t MiB = 1u << 20, KiB = 1024;
constexpr size_t WS_CTL = 0, CTL_BYTES = 1 * MiB;
constexpr int CW_BAR = 0;
constexpr int CW_SSQ = 16384;
constexpr int CW_MOE = 16384 + 6 * T;
constexpr int CW_CHK = CW_MOE + 256;
static_assert((CW_CHK + 64) * 4 <= (int)CTL_BYTES, "ctl");
constexpr size_t WS_WDT = 1 * MiB, WS_WAB = WS_WDT + 64 * KiB, WS_WR = WS_WAB + 64 * KiB;
constexpr size_t WS_DTV = 2 * MiB, WS_ACS = 3 * MiB, WS_GCS = 4 * MiB, WS_BETA = 4 * MiB + 512 * KiB;
constexpr size_t WS_RAW16 = WS_DTV;
constexpr size_t WS_EID = 5 * MiB, WS_GATEW = WS_EID + 128 * KiB, WS_TOKSLOT = WS_GATEW + 128 * KiB, WS_SLOTTOK = WS_TOKSLOT + 128 * KiB, WS_SLOTGATE = WS_SLOTTOK + 160 * KiB,
                 WS_SLOTRSTD = WS_SLOTGATE + 160 * KiB, WS_TILEEXP = WS_SLOTRSTD + 160 * KiB;
constexpr size_t WS_FP = 8 * MiB;
constexpr size_t WS_W_IN0 = 16 * MiB, WS_W_IN1 = 24 * MiB, WS_W_OUT0 = 35 * MiB, WS_W_OUT1 = 38 * MiB, WS_W_XA = 41 * MiB  ;
constexpr size_t WS_MEMNB = 57 * MiB, WS_KX = 58 * MiB  , WS_VT = 60 * MiB  ;
constexpr size_t WS_H = 64 * MiB, WS_HB = 128 * MiB, WS_MOEW = 160 * MiB, WS_BIG = 256 * MiB;
constexpr size_t WS_PROJ = WS_BIG;
constexpr size_t WS_CAT0 = 384 * MiB, WS_STATES = 432 * MiB;
constexpr size_t WS_CAT1 = 432 * MiB;
constexpr size_t WS_Q = WS_BIG, WS_ATT = WS_BIG + 32 * MiB;
constexpr size_t WS_XS = WS_BIG, WS_ACT = WS_BIG + 80 * MiB, WS_Y = WS_BIG + 120 * MiB;
constexpr size_t WS_END = 528 * MiB;
constexpr int PROJ0_LD = 4096, PROJ1_LD = 5632, MAXSLOT = 40960;

#ifdef CPU_EMU
__device__ __forceinline__ float fexp(float x) { return expf(x); }
__device__ __forceinline__ float fexp2(float x) { return exp2f(x); }
__device__ __forceinline__ float frcp(float x) { return 1.f / x; }
__device__ __forceinline__ float frsq(float x) { return 1.f / sqrtf(x); }
#else
__device__ __forceinline__ float fexp(float x) { return __builtin_amdgcn_exp2f(x * 1.4426950408889634f); }
__device__ __forceinline__ float fexp2(float x) { return __builtin_amdgcn_exp2f(x); }
__device__ __forceinline__ float frcp(float x) { return __builtin_amdgcn_rcpf(x); }
__device__ __forceinline__ float frsq(float x) { return __builtin_amdgcn_rsqf(x); }
#endif
#ifdef CPU_EMU
#define LAS
#define GAS
#define LDS_WAIT() do {} while (0)
#define WAVE_SYNC() ((void)__shfl(0, 0))
#define MEM_FENCE() do {} while (0)
#define PIN16(a) do {} while (0)
#define LDS_BARRIER() __syncthreads()
#define SCHED_FENCE() do {} while (0)
__device__ __forceinline__ unsigned cvt_pk_bf16(float lo, float hi) { return emu_f2bf(lo) | (emu_f2bf(hi) << 16); }
#else
#define LAS __attribute__((address_space(3)))
#define GAS __attribute__((address_space(1)))
#define LDS_WAIT() asm volatile("s_waitcnt lgkmcnt(0)" ::: "memory")
#define LDS_BARRIER() do { asm volatile("s_waitcnt lgkmcnt(0)" ::: "memory"); __builtin_amdgcn_s_barrier(); asm volatile("" ::: "memory"); } while (0)
#define MEM_FENCE() asm volatile("" ::: "memory")
#define PIN16(a) asm volatile("" : "+v"(a[0]), "+v"(a[1]), "+v"(a[2]), "+v"(a[3]), "+v"(a[4]), "+v"(a[5]), "+v"(a[6]), "+v"(a[7]), "+v"(a[8]), "+v"(a[9]), "+v"(a[10]), "+v"(a[11]), "+v"(a[12]), "+v"(a[13]), "+v"(a[14]), "+v"(a[15]) :: "memory")
#define SCHED_FENCE() __builtin_amdgcn_sched_barrier(0)
#define WAVE_SYNC() do { asm volatile("s_waitcnt lgkmcnt(0)" ::: "memory"); __builtin_amdgcn_wave_barrier(); } while (0)
typedef __bf16 hwbf16x2 __attribute__((ext_vector_type(2)));
__device__ __forceinline__ unsigned cvt_pk_bf16(float lo, float hi) { const f32x2 v = {lo, hi}; return __builtin_bit_cast(unsigned, __builtin_convertvector(v, hwbf16x2)); }
#endif
__device__ __forceinline__ float bf2f(unsigned short b) { return __uint_as_float(((unsigned)b) << 16); }
__device__ __forceinline__ float bflo(unsigned w) { return __uint_as_float(w << 16); }
__device__ __forceinline__ float bfhi(unsigned w) { return __uint_as_float(w & 0xffff0000u); }
__device__ __forceinline__ float wave_sum(float v) {
#pragma unroll
    for (int o = 1; o < 64; o <<= 1) v += __shfl_xor(v, o);
    return v;
}
__device__ __forceinline__ f32x4 mfma16(bf16x8 a, bf16x8 b, f32x4 c) { return __builtin_amdgcn_mfma_f32_16x16x32_bf16(a, b, c, 0, 0, 0); }

struct Frame {
    LAS unsigned char* lds;
    unsigned* ctl;
    unsigned char* ws;
    const float* const* in;
    float* out;
    int tid, lane, wave, vcu, G;
};
constexpr size_t WS_SSQP1 = 6 * MiB, WS_SSQP2 = 7 * MiB, WS_SSQP4 = 62 * MiB, WS_SSQP5 = 63 * MiB;
__device__ __forceinline__ float rstd_np(const float* p, int np, int row) { float s; if (np == 1) s = p[row]; else { const f32x4* q = (const f32x4*)(p + (size_t)row * 16); const f32x4 a = q[0], b = q[1], c = q[2], d = q[3]; s = ((a.x + a.y) + (a.z + a.w)) + ((b.x + b.y) + (b.z + b.w)) + (((c.x + c.y) + (c.z + c.w)) + ((d.x + d.y) + (d.z + d.w))); }
    return frsq(s * (1.f / 1024.f) + EPS); }
__device__ __forceinline__ void rstd_rows8(const float* p, int np, int row0, int fq, float (&out)[2][4]) {
    if (np == 1) { float s[2][4];
#pragma unroll
        for (int ai = 0; ai < 2; ++ai)
#pragma unroll
            for (int m = 0; m < 4; ++m) s[ai][m] = p[row0 + ai * 128 + m * 16];
        SCHED_FENCE();
#pragma unroll
        for (int ai = 0; ai < 2; ++ai)
#pragma unroll
            for (int m = 0; m < 4; ++m) out[ai][m] = frsq(s[ai][m] * (1.f / 1024.f) + EPS); }
    else { f32x4 a[2][4];
#pragma unroll
        for (int ai = 0; ai < 2; ++ai)
#pragma unroll
            for (int m = 0; m < 4; ++m) a[ai][m] = *(const f32x4*)(p + (size_t)(row0 + ai * 128 + m * 16) * 16 + fq * 4);
        SCHED_FENCE();
#pragma unroll
        for (int ai = 0; ai < 2; ++ai)
#pragma unroll
            for (int m = 0; m < 4; ++m) { float s = (a[ai][m].x + a[ai][m].y) + (a[ai][m].z + a[ai][m].w); s += __shfl_xor(s, 16); s += __shfl_xor(s, 32); out[ai][m] = frsq(s * (1.f / 1024.f) + EPS); } }
}
#ifndef CPU_EMU
__device__ __forceinline__ int shfl_src(int v, int src) { return __builtin_amdgcn_ds_bpermute(src << 2, v); }
#else
inline int shfl_src(int v, int src) { return emu::shfl_idx(v, src); }
#endif
#define OKP(type, off) ((type*)(F.ws + (off)))
#ifdef CPU_EMU
__device__ __forceinline__ Frame phase_frame(const Frame& F0) { return F0; }
#else
__device__ __forceinline__ Frame phase_frame(const Frame& F0) { Frame F = F0; int t = threadIdx.x; asm volatile("" : "+v"(t)); F.tid = t; F.lane = t & 63; F.wave = __builtin_amdgcn_readfirstlane(t >> 6); return F; }
#endif

struct CvtJob { const float* W; int ldw, K, ncols, c0; bf16_t* WT; int drow0, dstep16; const float* kgain; float cscale; };
__device__ __forceinline__ int job_items(const CvtJob& j) { return (j.K / 64) * (j.ncols / 32); }
struct CvtRegs { float wv[32]; f32x4 g0, g1; };
__device__ __forceinline__ void cvt_load(CvtRegs& r, const CvtJob& j, int item, int lane) {
    const int nblk = j.ncols / 32, kb = item / nblk, nb = item % nblk, k0 = 64 * kb, c0 = j.c0 + 32 * nb;
#pragma unroll
    for (int i = 0; i < 32; ++i) r.wv[i] = j.W[(size_t)(k0 + 2 * i + (lane >> 5)) * j.ldw + c0 + (lane & 31)];
    if (j.kgain) { const f32x4* gp = (const f32x4*)(j.kgain + k0 + 8 * (lane & 7)); r.g0 = gp[0]; r.g1 = gp[1]; } else { r.g0 = (f32x4){1.f, 1.f, 1.f, 1.f}; r.g1 = r.g0; }
}
__device__ __forceinline__ void cvt_finish(const CvtRegs& r, const CvtJob& j, int item, LAS float* scr, int lane) {
    const int nblk = j.ncols / 32, kb = item / nblk, nb = item % nblk, k0 = 64 * kb, drow0 = j.drow0 + (32 * nb >> 4) * j.dstep16;
#pragma unroll
    for (int i = 0; i < 32; ++i) { const int kk = 2 * i + (lane >> 5); scr[kk * 33 + (lane & 31)] = r.wv[i]; }
    const f32x4 ga = r.g0 * j.cscale, gb = r.g1 * j.cscale;
    WAVE_SYNC();
    const int c = lane & 7;
#pragma unroll
    for (int jj = 0; jj < 4; ++jj) { const int n = (lane >> 3) + 8 * jj; const LAS float* s = scr + (8 * c) * 33 + n;
        u32x4 o; o.x = cvt_pk_bf16(s[0 * 33] * ga[0], s[1 * 33] * ga[1]); o.y = cvt_pk_bf16(s[2 * 33] * ga[2], s[3 * 33] * ga[3]); o.z = cvt_pk_bf16(s[4 * 33] * gb[0], s[5 * 33] * gb[1]); o.w = cvt_pk_bf16(s[6 * 33] * gb[2], s[7 * 33] * gb[3]);
        *(u32x4*)(j.WT + (size_t)(drow0 + (n >> 4) * j.dstep16 + (n & 15)) * j.K + k0 + 8 * c) = o; }
    WAVE_SYNC();
}
__device__ __forceinline__ CvtJob dense_job(const Frame& F, int j) {
    using namespace sm;
    const float* const* in = F.in;
    switch (j) {
    case 0: return CvtJob{in[I_EV_WIN], 4112, 1024, 4096, 0, OKP(bf16_t, WS_W_IN0), 0, 16, in[I_NORM_MIX], 1.f};
    case 1: return CvtJob{in[I_OD_WIN], 5648, 1024, 4096, 0, OKP(bf16_t, WS_W_IN1), 0, 16, in[I_NORM_MIX] + 1024, 1.f};
    case 2: return CvtJob{in[I_OD_WIN], 5648, 1024, 512, 4112, OKP(bf16_t, WS_W_IN1), 4096, 16, in[I_NORM_MIX] + 1024, 0.125f * LOG2E};
    case 3: return CvtJob{in[I_OD_WIN], 5648, 1024, 1024, 4624, OKP(bf16_t, WS_W_IN1), 4608, 16, in[I_NORM_MIX] + 1024, 1.f};
    case 4: return CvtJob{in[I_EV_WOUT], 1024, 1536, 1024, 0, OKP(bf16_t, WS_W_OUT0), 0, 16, nullptr, 1.f};
    case 5: return CvtJob{in[I_OD_WOUT], 1024, 1536, 1024, 0, OKP(bf16_t, WS_W_OUT1), 0, 16, nullptr, 1.f};
    default: { const int l = (j - 6) / 4, w = (j - 6) % 4; bf16_t* dst = OKP(bf16_t, WS_W_XA + (size_t)l * 8 * MiB + (size_t)w * 2 * MiB);
        const float* src = in[I_XA_WQ + w] + (size_t)l * 1024 * 1024;
        if (w == 0) return CvtJob{src, 1024, 1024, 1024, 0, dst, 0, 16, in[I_NORM_XA] + l * 1024, 0.0625f * LOG2E};
        return CvtJob{src, 1024, 1024, 1024, 0, dst, 0, 16, nullptr, 1.f}; }
    }
}
constexpr int N_DENSE_JOBS = 14;
__device__ __forceinline__ CvtJob moe_job(const Frame& F, int l, int j) {
    using namespace sm;
    const int e = j / 3, w = j % 3; const float* const* in = F.in;
    bf16_t* gu = OKP(bf16_t, WS_MOEW + (size_t)e * 3 * MiB); bf16_t* dn = gu + 1024 * 1024;
    if (w == 0) return CvtJob{in[I_MOE_WGATE] + ((size_t)l * 32 + e) * 1024 * 512, 512, 1024, 512, 0, gu, 0, 32, in[I_NORM_FFN] + l * 1024, 1.f};
    if (w == 1) return CvtJob{in[I_MOE_WUP] + ((size_t)l * 32 + e) * 1024 * 512, 512, 1024, 512, 0, gu, 16, 32, in[I_NORM_FFN] + l * 1024, 1.f};
    return CvtJob{in[I_MOE_WDOWN] + ((size_t)l * 32 + e) * 512 * 1024, 1024, 512, 1024, 0, dn, 0, 16, nullptr, 1.f};
}
__device__ __forceinline__ int dense_total(const Frame& F) { int n = 0; for (int j = 0; j < N_DENSE_JOBS; ++j) n += job_items(dense_job(F, j)); return n; }
__device__ __forceinline__ void dense_item(const Frame& F, int idx, CvtJob& job, int& item) {
    for (int j = 0; j < N_DENSE_JOBS; ++j) { const CvtJob jb = dense_job(F, j); const int n = job_items(jb); job = jb; item = idx < n ? idx : n - 1; if (idx < n) return; idx -= n; }
}
__device__ __forceinline__ void phase_cvt_dense(const Frame& F0) {
    const Frame F = phase_frame(F0);
    LAS float* scr = (LAS float*)(F.lds + F.wave * 16384);
    const int gw = F.vcu * NWAVES + F.wave, NGW = F.G * NWAVES, N = dense_total(F);
    CvtRegs ra, rb;
    auto LD = [&](CvtRegs& r, int idx) { CvtJob jb; int it; dense_item(F, idx < N ? idx : N - 1, jb, it); cvt_load(r, jb, it, F.lane); };
    auto FN = [&](const CvtRegs& r, int idx) { if (idx < N) { CvtJob jb; int it; dense_item(F, idx, jb, it); cvt_finish(r, jb, it, scr, F.lane); } };
    LD(ra, gw);
    for (int idx = gw; idx < N; idx += 2 * NGW) { LD(rb, idx + NGW); FN(ra, idx); LD(ra, idx + 2 * NGW); FN(rb, idx + NGW); }
}
__device__ __forceinline__ void phase_cvt_moe(const Frame& F0, int l) {
    const Frame F = phase_frame(F0);
    LAS float* scr = (LAS float*)(F.lds + F.wave * 16384);
    const int gw = F.vcu * NWAVES + F.wave, NGW = F.G * NWAVES; constexpr int N = 96 * 256;
    CvtRegs ra, rb;
    auto LD = [&](CvtRegs& r, int idx) { const int ii = idx < N ? idx : N - 1; const CvtJob jb = moe_job(F, l, ii >> 8); cvt_load(r, jb, ii & 255, F.lane); };
    auto FN = [&](const CvtRegs& r, int idx) { if (idx < N) { const CvtJob jb = moe_job(F, l, idx >> 8); cvt_finish(r, jb, idx & 255, scr, F.lane); } };
    LD(ra, gw);
    for (int idx = gw; idx < N; idx += 2 * NGW) { LD(rb, idx + NGW); FN(ra, idx); LD(ra, idx + 2 * NGW); FN(rb, idx + NGW); }
}
__device__ __forceinline__ void row_to_bf16_ssq(const float* xrow, bf16_t* orow, float* ssq, int lane) {
    const f32x4* xr = (const f32x4*)xrow + lane; float s = 0.f; f32x4 v[4];
#pragma unroll
    for (int j = 0; j < 4; ++j) { v[j] = xr[64 * j]; s += (v[j].x * v[j].x + v[j].y * v[j].y) + (v[j].z * v[j].z + v[j].w * v[j].w); }
    s = wave_sum(s);
    u32x2* o8 = (u32x2*)orow + lane;
#pragma unroll
    for (int j = 0; j < 4; ++j) { u32x2 w; w.x = cvt_pk_bf16(v[j].x, v[j].y); w.y = cvt_pk_bf16(v[j].z, v[j].w); o8[64 * j] = w; }
    if (lane == 0) *ssq = s;
}
__device__ __forceinline__ void phase_prologue(const Frame& F0) {
    const Frame F = phase_frame(F0);
    using namespace sm;
    phase_cvt_dense(F0);
    const int gw = F.vcu * NWAVES + F.wave, NGW = F.G * NWAVES;
    float* ssq0 = (float*)F.ctl + CW_SSQ;
    for (int m = gw; m < T; m += NGW) row_to_bf16_ssq(F.in[I_X] + (size_t)m * DM, OKP(bf16_t, WS_HB) + (size_t)m * DM, ssq0 + m, F.lane);
    for (int m = gw; m < NB * 256; m += NGW) { const f32x4* xr = (const f32x4*)(F.in[I_MEM] + (size_t)m * DM) + F.lane; const f32x4* gr = (const f32x4*)F.in[I_MEM_NORM] + F.lane; float s = 0.f; f32x4 v[4];
#pragma unroll
        for (int j = 0; j < 4; ++j) { v[j] = xr[64 * j]; s += (v[j].x * v[j].x + v[j].y * v[j].y) + (v[j].z * v[j].z + v[j].w * v[j].w); }
        const float r = 1.f / sqrtf(wave_sum(s) * (1.f / DM) + EPS);
        u32x2* o8 = (u32x2*)(OKP(bf16_t, WS_MEMNB) + (size_t)m * DM) + F.lane;
#pragma unroll
        for (int j = 0; j < 4; ++j) { const f32x4 g = gr[64 * j]; u32x2 w; w.x = cvt_pk_bf16(v[j].x * r * g.x, v[j].y * r * g.y); w.y = cvt_pk_bf16(v[j].z * r * g.z, v[j].w * r * g.w); o8[64 * j] = w; } }
    const size_t gt = (size_t)F.vcu * NT + F.tid, GT = (size_t)F.G * NT;
    for (size_t i = gt; i < 1024 * 16; i += GT) { const int k = (int)(i >> 4), j = (int)(i & 15);
        OKP(float, WS_WDT)[j * 1024 + k] = F.in[I_NORM_MIX][k] * F.in[I_EV_WIN][(size_t)k * 4112 + 4096 + j];
        OKP(float, WS_WAB)[j * 1024 + k] = F.in[I_NORM_MIX][1024 + k] * F.in[I_OD_WIN][(size_t)k * 5648 + 4096 + j]; }
}

#ifndef CPU_EMU
struct EpiScaleBf16 {
    static constexpr bool PERM = true, AFTER_DRAIN = false;
    bf16_t* O; int ldc; const float* ssq; int np;
    __device__ __forceinline__ void operator()(const f32x4 (&acc)[2][2][4][2], const pg8::Unit& u, int wr, int wc, int fr, int fq) const {
        const int row0 = u.pm * 256 + wr * 64 + fr, col0 = u.pn * 256 + wc * 32 + 8 * fq;
        float rs8[2][4];
        if (ssq) rstd_rows8(ssq, np, row0, fq, rs8); else {
#pragma unroll
            for (int i = 0; i < 8; ++i) rs8[i >> 2][i & 3] = 1.f; }
#pragma unroll
        for (int ai = 0; ai < 2; ++ai)
#pragma unroll
            for (int m = 0; m < 4; ++m) { const int row = row0 + ai * 128 + m * 16; const float s = rs8[ai][m]; bf16_t* rowp = O + (size_t)row * ldc + col0;
#pragma unroll
                for (int bj = 0; bj < 2; ++bj) { const f32x4 v0 = acc[ai][bj][m][0] * s, v1 = acc[ai][bj][m][1] * s; u32x4 w; w.x = cvt_pk_bf16(v0[0], v0[1]); w.y = cvt_pk_bf16(v0[2], v0[3]); w.z = cvt_pk_bf16(v1[0], v1[1]); w.w = cvt_pk_bf16(v1[2], v1[3]);
                    *(u32x4*)(rowp + bj * 128) = w; } }
    }
};
template <bool HIN_F32> struct EpiResidualT {
    static constexpr bool PERM = false, AFTER_DRAIN = false;
    const float* hin; bf16_t* hb; float* ssq;
    __device__ __forceinline__ void operator()(const f32x4 (&acc)[2][2][4][2], const pg8::Unit& u, int wr, int wc, int fr, int fq) const {
        const int row0 = u.pm * 256 + wr * 64 + fr, col0 = u.pn * 256 + wc * 32 + 4 * fq;
#pragma unroll
        for (int ai = 0; ai < 2; ++ai) {
            f32x4 hf[HIN_F32 ? 4 : 1][2][2]; u32x2 hw2[HIN_F32 ? 1 : 4][2][2];
#pragma unroll
            for (int m = 0; m < 4; ++m)
#pragma unroll
                for (int bj = 0; bj < 2; ++bj)
#pragma unroll
                    for (int n = 0; n < 2; ++n) { const size_t o = (size_t)(row0 + ai * 128 + m * 16) * DM + col0 + bj * 128 + n * 16;
                        if (HIN_F32) hf[HIN_F32 ? m : 0][bj][n] = *(const f32x4*)(hin + o); else hw2[HIN_F32 ? 0 : m][bj][n] = *(const u32x2*)(hb + o); }
            SCHED_FENCE();
#pragma unroll
            for (int m = 0; m < 4; ++m) { const int row = row0 + ai * 128 + m * 16; const size_t ro = (size_t)row * DM + col0; float s = 0.f;
#pragma unroll
                for (int bj = 0; bj < 2; ++bj)
#pragma unroll
                    for (int n = 0; n < 2; ++n) { const size_t o = ro + bj * 128 + n * 16; f32x4 v;
                        if (HIN_F32) v = hf[HIN_F32 ? m : 0][bj][n]; else { const u32x2 hw = hw2[HIN_F32 ? 0 : m][bj][n]; v = (f32x4){bflo(hw.x), bfhi(hw.x), bflo(hw.y), bfhi(hw.y)}; }
                        v += acc[ai][bj][m][n];
                        u32x2 w; w.x = cvt_pk_bf16(v[0], v[1]); w.y = cvt_pk_bf16(v[2], v[3]); *(u32x2*)(hb + o) = w;
                        const float r0 = bflo(w.x), r1 = bfhi(w.x), r2 = bflo(w.y), r3 = bfhi(w.y); s += (r0 * r0 + r1 * r1) + (r2 * r2 + r3 * r3); }
                s += __shfl_xor(s, 16); s += __shfl_xor(s, 32);
                if (fq == 0) ssq[(size_t)row * 16 + u.pn * 4 + wc] = s; } }
    }
};

template <class Epi> __device__ __forceinline__ void dense_gemm(const Frame& F, const bf16_t* A, const bf16_t* Bt, int M, int N, int K, const Epi& E) {
    pg8::Gemm g{A, Bt, M, N, K}; pg8::StaticOrder S; S.init(g, F.G, (int)blockIdx.x);
    pg8::gemm_phase<Epi, pg8::StaticOrder, true, true>(F.lds, g, S, E, F.wave);
}
#endif
}

namespace ok {
constexpr int XT_LD = 72;
constexpr int BC_LD = 136;
__device__ __forceinline__ float siluf(float x) { return x * frcp(1.f + fexp(-x)); }
__device__ __forceinline__ float softplusf(float x) { return x > 20.f ? x : log1pf(expf(x)); }

template <class Sink> __device__ __forceinline__ void ssd_conv_pair(const Frame& F, int b, int c, int xc, Sink&& sink) {
    using namespace sm;
    const float* cw = F.in[I_EV_CONVW]; const f32x2 w0 = *(const f32x2*)(cw + xc), w1 = *(const f32x2*)(cw + 1536 + xc), w2 = *(const f32x2*)(cw + 3072 + xc), w3 = *(const f32x2*)(cw + 4608 + xc), bias = *(const f32x2*)(F.in[I_EV_CONVB] + xc);
    const bf16_t* p = OKP(bf16_t, WS_PROJ) + (size_t)(b * L + c * 64) * PROJ0_LD + 2560 + xc;
    unsigned raw[64];
#pragma unroll
    for (int t = 0; t < 64; ++t) raw[t] = *(const unsigned*)(p + (size_t)t * PROJ0_LD);
    f32x2 x0 = {0.f, 0.f}, x1 = x0, x2 = x0;
    if (c > 0) { const unsigned a = *(const unsigned*)(p - 3 * PROJ0_LD), bq = *(const unsigned*)(p - 2 * PROJ0_LD), cq = *(const unsigned*)(p - PROJ0_LD); x0 = (f32x2){bflo(a), bfhi(a)}; x1 = (f32x2){bflo(bq), bfhi(bq)}; x2 = (f32x2){bflo(cq), bfhi(cq)}; }
#pragma unroll
    for (int t = 0; t < 64; t += 2) { const f32x2 x3 = {bflo(raw[t]), bfhi(raw[t])}, x4 = {bflo(raw[t + 1]), bfhi(raw[t + 1])};
        const f32x2 v0 = bias + w0 * x0 + w1 * x1 + w2 * x2 + w3 * x3, v1 = bias + w0 * x1 + w1 * x2 + w2 * x3 + w3 * x4;
        sink(t, siluf(v0.x), siluf(v1.x), siluf(v0.y), siluf(v1.y)); x0 = x2; x1 = x3; x2 = x4; }
}

__device__ __forceinline__ void phase_ssd_a(const Frame& F0) {
    const Frame F = phase_frame(F0);
    using namespace sm;
    LAS bf16_t* XT = (LAS bf16_t*)F.lds; LAS bf16_t* BT = (LAS bf16_t*)(F.lds + 73728);
    LAS float* dt_s = (LAS float*)(F.lds + 92160); LAS float* acs_s = (LAS float*)(F.lds + 94208); LAS float* sc_s = (LAS float*)(F.lds + 96256);
    const int tid = F.tid, lane = F.lane, wave = F.wave;
    for (int u = F.vcu; u < NB * NCH * 2; u += F.G) {
        const int g = u & 1, bc = u >> 1, b = bc / NCH, c = bc % NCH; const size_t row0 = (size_t)b * L + c * 64;
        LDS_BARRIER();
        if (tid < 320) { const int ci = tid * 2;
            const int xc = ci < 512 ? g * 512 + ci : 1024 + g * 128 + (ci - 512);
            LAS unsigned* dst = (LAS unsigned*)(ci < 512 ? XT + ci * XT_LD : BT + (ci - 512) * XT_LD);
            ssd_conv_pair(F, b, c, xc, [&](int t, float a0, float a1, float b0, float b1) { dst[t >> 1] = cvt_pk_bf16(a0, a1); dst[XT_LD / 2 + (t >> 1)] = cvt_pk_bf16(b0, b1); });
        }
        { const int t = tid & 63, hh = tid >> 6, hd = g * 8 + hh; const float dt = softplusf(OKP(float, WS_RAW16)[(row0 + t) * 16 + hd] + F.in[I_EV_DTB][hd]); dt_s[hh * 64 + t] = dt; acs_s[hh * 64 + t] = dt * -expf(F.in[I_EV_ALOG][hd]); }
        LDS_BARRIER();
        { const int hh = wave, hd = g * 8 + hh; float v = acs_s[hh * 64 + lane];
#pragma unroll
          for (int o = 1; o < 64; o <<= 1) { const float n = __shfl_up(v, o); if (lane >= o) v += n; }
          const float last = __shfl(v, 63); const float dt = dt_s[hh * 64 + lane];
          sc_s[hh * 64 + lane] = dt * fexp(last - v);
          OKP(float, WS_DTV)[(row0 + lane) * 16 + hd] = dt; OKP(float, WS_ACS)[(row0 + lane) * 16 + hd] = v; }
        WAVE_SYNC();
#if defined(CHECK_DUMP)
        if (bc == 5 && g == 0) {
            float* f3 = OKP(float, WS_FP) + (size_t)3 * 16 * 6144; float* f4 = OKP(float, WS_FP) + (size_t)4 * 16 * 6144; float* f5 = OKP(float, WS_FP) + (size_t)5 * 16 * 6144;
            for (int i = tid; i < 512 * 64; i += NT) f3[i] = bf2f(XT[(i >> 6) * XT_LD + (i & 63)]);
            for (int i = tid; i < 128 * 64; i += NT) f4[i] = bf2f(BT[(i >> 6) * XT_LD + (i & 63)]);
            f5[wave * 64 + lane] = sc_s[wave * 64 + lane];
        }
#endif
        { const int hh = wave, hd = g * 8 + hh, fr = lane & 15, fq = lane >> 4;
          bf16x8 xa[4][2];
#pragma unroll
          for (int pt = 0; pt < 4; ++pt)
#pragma unroll
              for (int ks = 0; ks < 2; ++ks) { const u32x4 raw = *(const LAS u32x4*)(XT + (hh * 64 + pt * 16 + fr) * XT_LD + ks * 32 + fq * 8); const LAS float* sp = sc_s + hh * 64 + ks * 32 + fq * 8;
                  const f32x4 s0 = *(const LAS f32x4*)sp, s1 = *(const LAS f32x4*)(sp + 4); u32x4 o;
                  o.x = cvt_pk_bf16(bflo(raw.x) * s0.x, bfhi(raw.x) * s0.y); o.y = cvt_pk_bf16(bflo(raw.y) * s0.z, bfhi(raw.y) * s0.w);
                  o.z = cvt_pk_bf16(bflo(raw.z) * s1.x, bfhi(raw.z) * s1.y); o.w = cvt_pk_bf16(bflo(raw.w) * s1.z, bfhi(raw.w) * s1.w);
                  xa[pt][ks] = __builtin_bit_cast(bf16x8, o); }
          bf16_t* st = OKP(bf16_t, WS_STATES) + ((size_t)bc * 16 + hd) * 8192;
#pragma unroll
          for (int nt = 0; nt < 8; ++nt) { bf16x8 bb[2];
#pragma unroll
              for (int ks = 0; ks < 2; ++ks) bb[ks] = *(const LAS bf16x8*)(BT + (nt * 16 + fr) * XT_LD + ks * 32 + fq * 8);
#pragma unroll
              for (int pt = 0; pt < 4; ++pt) { f32x4 acc = {0.f, 0.f, 0.f, 0.f};
#pragma unroll
                  for (int ks = 0; ks < 2; ++ks) acc = mfma16(bb[ks], xa[pt][ks], acc);
                  u32x2 w; w.x = cvt_pk_bf16(acc[0], acc[1]); w.y = cvt_pk_bf16(acc[2], acc[3]);
                  *(u32x2*)(st + (size_t)(pt * 16 + fr) * 128 + nt * 16 + 4 * fq) = w; } } }
    }
}

__device__ __forceinline__ void phase_ssd_scan(const Frame& F0, int skip) {
    const Frame F = phase_frame(F0);
    const float* acs = OKP(float, WS_ACS);
    int widx = F.vcu, nw = F.G;
    if (skip) { const int per = F.G / 8, xcd = (int)blockIdx.x & 7, loc = (int)blockIdx.x >> 3  , sk = skip / 8; if (loc < sk) return; widx = xcd * (per - sk) + (loc - sk); nw = F.G - skip; }
    LAS float* dec_s = (LAS float*)F.lds;
    const int tid = F.tid, NTOT = NB * 65536;
    for (int base = widx * NT; base < NTOT; base += 2 * nw * NT) {
        const int baseB = base + nw * NT; const bool vB = baseB < NTOT; const int iA = base + tid, iB = vB ? baseB + tid : iA;
        LDS_BARRIER();
        if (tid < 2 * NCH) { const int ch = tid / NCH, c = tid % NCH, ii = ch ? (vB ? baseB : base) : base, b = ii >> 16, hd = (ii & 65535) >> 12; dec_s[ch * NCH + c] = fexp(acs[((size_t)b * L + c * 64 + 63) * 16 + hd]); }
        LDS_BARRIER();
        unsigned* pA = (unsigned*)(OKP(bf16_t, WS_STATES) + (size_t)(iA >> 16) * NCH * 131072) + (iA & 65535);
        unsigned* pB = (unsigned*)(OKP(bf16_t, WS_STATES) + (size_t)(iB >> 16) * NCH * 131072) + (iB & 65535);
        float a0 = 0.f, a1 = 0.f, b0 = 0.f, b1 = 0.f; unsigned sA0[8], sB0[8], sA1[8], sB1[8];
#define SCAN_LOAD(SA, SB, c0) do { _Pragma("unroll") for (int k = 0; k < 8; ++k) { const int c = (c0) + k < NCH ? (c0) + k : NCH - 1; SA[k] = pA[(size_t)c * 65536]; SB[k] = pB[(size_t)c * 65536]; } } while (0)
#define SCAN_STEP(SA, SB, c0) do { _Pragma("unroll") for (int k = 0; k < 8; ++k) { const int c = (c0) + k; if (NCH % 16 != 0 && c >= NCH) break; const float dA = dec_s[c], dB = dec_s[NCH + c]; \
            pA[(size_t)c * 65536] = cvt_pk_bf16(a0, a1); a0 = a0 * dA + bflo(SA[k]); a1 = a1 * dA + bfhi(SA[k]); \
            if (vB) pB[(size_t)c * 65536] = cvt_pk_bf16(b0, b1); b0 = b0 * dB + bflo(SB[k]); b1 = b1 * dB + bfhi(SB[k]); } } while (0)
        SCAN_LOAD(sA0, sB0, 0);
#pragma unroll 1
        for (int c0 = 0; c0 < NCH; c0 += 16) {
            SCAN_LOAD(sA1, sB1, c0 + 8); SCHED_FENCE();
            SCAN_STEP(sA0, sB0, c0); SCHED_FENCE();
            SCAN_LOAD(sA0, sB0, c0 + 16); SCHED_FENCE();
            SCAN_STEP(sA1, sB1, c0 + 8); SCHED_FENCE();
        }
#undef SCAN_LOAD
#undef SCAN_STEP
    }
}

__device__ __forceinline__ void phase_ssd_b(const Frame& F0) {
    const Frame F = phase_frame(F0);
    using namespace sm;
    LAS bf16_t* XT = (LAS bf16_t*)F.lds; LAS bf16_t* Bs = (LAS bf16_t*)(F.lds + 73728); LAS bf16_t* Cs = (LAS bf16_t*)(F.lds + 91136);
    LAS float* acs_s = (LAS float*)(F.lds + 108544); LAS float* dt_s = (LAS float*)(F.lds + 110592); LAS float* red = (LAS float*)(F.lds + 112640);
    const int tid = F.tid, lane = F.lane, wave = F.wave, fr = lane & 15, fq = lane >> 4;
    const bf16_t* proj = OKP(bf16_t, WS_PROJ); bf16_t* cat = OKP(bf16_t, WS_CAT0);
    for (int u = F.vcu; u < NB * NCH * 2; u += F.G) {
        const int g = u & 1, bc = u >> 1, b = bc / NCH, c = bc % NCH; const size_t row0 = (size_t)b * L + c * 64;
        LDS_BARRIER();
        if (tid < 384) { const int ci = tid * 2;
            if (ci < 512) { LAS unsigned* dst = (LAS unsigned*)(XT + ci * XT_LD); ssd_conv_pair(F, b, c, g * 512 + ci, [&](int t, float a0, float a1, float b0, float b1) { dst[t >> 1] = cvt_pk_bf16(a0, a1); dst[XT_LD / 2 + (t >> 1)] = cvt_pk_bf16(b0, b1); }); }
            else { const int n = (ci - 512) & 127; LAS unsigned* dst = (LAS unsigned*)((ci < 640 ? Bs : Cs) + n); const int xc = (ci < 640 ? 1024 : 1280) + g * 128 + n;
                ssd_conv_pair(F, b, c, xc, [&](int t, float a0, float a1, float b0, float b1) { dst[t * (BC_LD / 2)] = cvt_pk_bf16(a0, b0); dst[(t + 1) * (BC_LD / 2)] = cvt_pk_bf16(a1, b1); }); }
        }
        { const int t = tid & 63, hh = tid >> 6; acs_s[hh * 64 + t] = OKP(float, WS_ACS)[(row0 + t) * 16 + g * 8 + hh]; dt_s[hh * 64 + t] = OKP(float, WS_DTV)[(row0 + t) * 16 + g * 8 + hh]; }
        { const int ch = g * 256 + (tid & 255), t0 = (tid >> 8) * 32; const float* w = F.in[I_EV_SCCONV]; const float w0 = w[ch], w1 = w[512 + ch], w2 = w[1024 + ch];
          const bf16_t* p = proj + (row0 + t0) * PROJ0_LD + ch; float p0 = 0.f, p1 = 0.f;
          if (c > 0 || t0 > 0) { p0 = bf2f(p[-2 * PROJ0_LD + 512]) * bf2f(p[-2 * PROJ0_LD + 1024]); p1 = bf2f(p[-PROJ0_LD + 512]) * bf2f(p[-PROJ0_LD + 1024]); }
          unsigned short rb[32], rc[32], rx[32];
#pragma unroll
          for (int t = 0; t < 32; ++t) { const bf16_t* q = p + (size_t)t * PROJ0_LD; rb[t] = q[0]; rc[t] = q[512]; rx[t] = q[1024]; }
#pragma unroll
          for (int t = 0; t < 32; ++t) { const float p2 = bf2f(rc[t]) * bf2f(rx[t]); const float y = bf2f(rb[t]) * (w0 * p0 + w1 * p1 + w2 * p2);
              cat[(row0 + t0 + t) * 1536 + ch] = (bf16_t)(cvt_pk_bf16(y, 0.f) & 0xffffu); p0 = p1; p1 = p2; } }
        LDS_BARRIER();
        const int hh = wave, hd = g * 8 + hh;
        f32x4 Y[4][4];
        { const bf16_t* P = OKP(bf16_t, WS_STATES) + ((size_t)bc * 16 + hd) * 8192;
#pragma unroll
          for (int pt = 0; pt < 4; ++pt)
#pragma unroll
              for (int tt = 0; tt < 4; ++tt) Y[pt][tt] = (f32x4){0.f, 0.f, 0.f, 0.f};
          bf16x8 pall[4][4];
#pragma unroll
          for (int ks = 0; ks < 4; ++ks)
#pragma unroll
              for (int pt = 0; pt < 4; ++pt) pall[ks][pt] = *(const bf16x8*)(P + (size_t)(pt * 16 + fr) * 128 + ks * 32 + fq * 8);
#pragma unroll
          for (int ks = 0; ks < 4; ++ks) { bf16x8 cb[4];
#pragma unroll
              for (int tt = 0; tt < 4; ++tt) cb[tt] = *(const LAS bf16x8*)(Cs + (tt * 16 + fr) * BC_LD + ks * 32 + fq * 8);
#pragma unroll
              for (int pt = 0; pt < 4; ++pt)
#pragma unroll
                  for (int tt = 0; tt < 4; ++tt) Y[pt][tt] = mfma16(pall[ks][pt], cb[tt], Y[pt][tt]); }
#pragma unroll
          for (int tt = 0; tt < 4; ++tt) { const float e = fexp(acs_s[hh * 64 + tt * 16 + fr]);
#pragma unroll
              for (int pt = 0; pt < 4; ++pt) Y[pt][tt] *= e; } }
#pragma unroll
        for (int tt = 0; tt < 4; ++tt) { f32x4 cbt[4];
#pragma unroll
            for (int st = 0; st < 4; ++st) cbt[st] = (f32x4){0.f, 0.f, 0.f, 0.f};
#pragma unroll
            for (int ks = 0; ks < 4; ++ks) { const bf16x8 cf = *(const LAS bf16x8*)(Cs + (tt * 16 + fr) * BC_LD + ks * 32 + fq * 8);
#pragma unroll
                for (int st = 0; st < 4; ++st) if (st <= tt) { const bf16x8 bf = *(const LAS bf16x8*)(Bs + (st * 16 + fr) * BC_LD + ks * 32 + fq * 8); cbt[st] = mfma16(bf, cf, cbt[st]); } }
            const int t = tt * 16 + fr; const float at = acs_s[hh * 64 + t];
#pragma unroll
            for (int st = 0; st < 4; ++st) { const f32x4 as4 = *(const LAS f32x4*)(acs_s + hh * 64 + st * 16 + 4 * fq), dt4 = *(const LAS f32x4*)(dt_s + hh * 64 + st * 16 + 4 * fq);
#pragma unroll
                for (int r = 0; r < 4; ++r) { const int s = st * 16 + 4 * fq + r; cbt[st][r] = (st <= tt && s <= t) ? cbt[st][r] * fexp(at - as4[r]) * dt4[r] : 0.f; } }
            bf16x8 mb[2];
#pragma unroll
            for (int ks = 0; ks < 2; ++ks) { u32x4 o; o.x = cvt_pk_bf16(cbt[2 * ks][0], cbt[2 * ks][1]); o.y = cvt_pk_bf16(cbt[2 * ks][2], cbt[2 * ks][3]); o.z = cvt_pk_bf16(cbt[2 * ks + 1][0], cbt[2 * ks + 1][1]); o.w = cvt_pk_bf16(cbt[2 * ks + 1][2], cbt[2 * ks + 1][3]);
                mb[ks] = __builtin_bit_cast(bf16x8, o); }
#pragma unroll
            for (int pt = 0; pt < 4; ++pt)
#pragma unroll
                for (int ks = 0; ks < 2; ++ks) { const LAS bf16_t* xp = XT + (hh * 64 + pt * 16 + fr) * XT_LD + ks * 32 + 4 * fq; const u32x2 lo = *(const LAS u32x2*)xp, hi = *(const LAS u32x2*)(xp + 16);
                    u32x4 a; a.x = lo.x; a.y = lo.y; a.z = hi.x; a.w = hi.y; Y[pt][tt] = mfma16(__builtin_bit_cast(bf16x8, a), mb[ks], Y[pt][tt]); } }
        u32x2 zz_[4][4];
#pragma unroll
        for (int tt = 0; tt < 4; ++tt)
#pragma unroll
            for (int pt = 0; pt < 4; ++pt) zz_[tt][pt] = *(const u32x2*)(proj + (row0 + tt * 16 + fr) * PROJ0_LD + 1536 + hd * 64 + pt * 16 + 4 * fq);
        SCHED_FENCE();
        const float Dh = F.in[I_EV_D][hd];
#pragma unroll
        for (int tt = 0; tt < 4; ++tt) { const int t = tt * 16 + fr; float ss = 0.f;
#pragma unroll
            for (int pt = 0; pt < 4; ++pt) { const int p = pt * 16 + 4 * fq; const u32x2 zz = zz_[tt][pt];
                const float z0 = bflo(zz.x), z1 = bfhi(zz.x), z2 = bflo(zz.y), z3 = bfhi(zz.y); const LAS bf16_t* xp = XT + (hh * 64 + p) * XT_LD + t;
                f32x4 y = Y[pt][tt]; y[0] = (y[0] + Dh * bf2f(xp[0])) * siluf(z0); y[1] = (y[1] + Dh * bf2f(xp[XT_LD])) * siluf(z1); y[2] = (y[2] + Dh * bf2f(xp[2 * XT_LD])) * siluf(z2); y[3] = (y[3] + Dh * bf2f(xp[3 * XT_LD])) * siluf(z3);
                Y[pt][tt] = y; ss += (y[0] * y[0] + y[1] * y[1]) + (y[2] * y[2] + y[3] * y[3]); }
            ss += __shfl_xor(ss, 16); ss += __shfl_xor(ss, 32);
            if (fq == 0) red[hh * 64 + t] = ss; }
        f32x4 nw_[4];
#pragma unroll
        for (int pt = 0; pt < 4; ++pt) nw_[pt] = *(const f32x4*)(F.in[I_EV_NORM] + hd * 64 + pt * 16 + 4 * fq);
        LDS_BARRIER();
#pragma unroll
        for (int tt = 0; tt < 4; ++tt) { const int t = tt * 16 + fr; float ss = 0.f;
#pragma unroll
            for (int w = 0; w < 8; ++w) ss += red[w * 64 + t];
            const float rs = frsq(ss * (1.f / 512.f) + EPS);
#pragma unroll
            for (int pt = 0; pt < 4; ++pt) { const int ch = hd * 64 + pt * 16 + 4 * fq; const f32x4 nw = nw_[pt]; const f32x4 y = Y[pt][tt];
                u32x2 w; w.x = cvt_pk_bf16(y[0] * rs * nw.x, y[1] * rs * nw.y); w.y = cvt_pk_bf16(y[2] * rs * nw.z, y[3] * rs * nw.w);
                *(u32x2*)(cat + (row0 + t) * 1536 + 512 + ch) = w; } }
    }
}
}

namespace ok {
constexpr int XA_LD = 264;

__device__ __forceinline__ void phase_xattn(const Frame& F0, const bf16_t* q, const bf16_t* kx, const bf16_t* vt, bf16_t* att) {
    const Frame F = phase_frame(F0);
    LAS bf16_t* KV = (LAS bf16_t*)F.lds;
    const int tid = F.tid, lane = F.lane, wave = F.wave, fr = lane & 15, fq = lane >> 4;
    constexpr int XA_PRE = 6;
    u32x4 tile[XA_PRE];
#define XA_LOAD_K(uu) do { const int hd_ = (uu) & 3, b_ = (((uu) >> 2) * 128) / L; _Pragma("unroll") for (int j_ = 0; j_ < XA_PRE; ++j_) { const int i_ = tid + j_ * NT, r_ = i_ >> 5, c8_ = i_ & 31; tile[j_] = *(const u32x4*)(kx + (size_t)(b_ * 256 + r_) * 1024 + hd_ * 256 + c8_ * 8); } } while (0)
#define XA_LOAD_V(uu) do { const int hd_ = (uu) & 3, b_ = (((uu) >> 2) * 128) / L; _Pragma("unroll") for (int j_ = 0; j_ < XA_PRE; ++j_) { const int i_ = tid + j_ * NT, r_ = i_ >> 5, c8_ = i_ & 31; tile[j_] = *(const u32x4*)(vt + (size_t)(hd_ * 256 + r_) * (NB * 256) + b_ * 256 + c8_ * 8); } } while (0)
#define XA_STORE() do { _Pragma("unroll") for (int j_ = 0; j_ < XA_PRE; ++j_) { const int i_ = tid + j_ * NT, r_ = i_ >> 5, c8_ = i_ & 31; *(LAS u32x4*)(KV + r_ * XA_LD + c8_ * 8) = tile[j_]; } } while (0)
#define XA_STORE_REST() do { _Pragma("unroll") for (int j_ = XA_PRE; j_ < 16; ++j_) { const int i_ = tid + j_ * NT, r_ = i_ >> 5, c8_ = i_ & 31; *(LAS u32x4*)(KV + r_ * XA_LD + c8_ * 8) = rest[j_ - XA_PRE]; } } while (0)
#define XA_REST_K(uu) do { const int hd_ = (uu) & 3, b_ = (((uu) >> 2) * 128) / L; _Pragma("unroll") for (int j_ = XA_PRE; j_ < 16; ++j_) { const int i_ = tid + j_ * NT, r_ = i_ >> 5, c8_ = i_ & 31; rest[j_ - XA_PRE] = *(const u32x4*)(kx + (size_t)(b_ * 256 + r_) * 1024 + hd_ * 256 + c8_ * 8); } } while (0)
#define XA_REST_V(uu) do { const int hd_ = (uu) & 3, b_ = (((uu) >> 2) * 128) / L; _Pragma("unroll") for (int j_ = XA_PRE; j_ < 16; ++j_) { const int i_ = tid + j_ * NT, r_ = i_ >> 5, c8_ = i_ & 31; rest[j_ - XA_PRE] = *(const u32x4*)(vt + (size_t)(hd_ * 256 + r_) * (NB * 256) + b_ * 256 + c8_ * 8); } } while (0)
    if (F.vcu < (T / 128) * 4) XA_LOAD_K(F.vcu);
    for (int u = F.vcu; u < (T / 128) * 4; u += F.G) {
        const int hd = u & 3, rt = u >> 2, row0 = rt * 128;
        LDS_BARRIER();
        bf16x8 qf[8];
        { u32x4 rest[16 - XA_PRE]; XA_REST_K(u); SCHED_FENCE(); XA_STORE(); SCHED_FENCE();
          const bf16_t* qp = q + (size_t)(row0 + wave * 16 + fr) * 1024 + hd * 256 + fq * 8;
#pragma unroll
          for (int ks = 0; ks < 8; ++ks) qf[ks] = *(const bf16x8*)(qp + ks * 32);
          SCHED_FENCE(); XA_STORE_REST(); }
        XA_LOAD_V(u);
        LDS_BARRIER();
        bf16x8 pf[8]; float fA, fB;
        {
            float mh[2], lh[2];
#pragma unroll
            for (int half = 0; half < 2; ++half) {
                f32x4 s[8];
#pragma unroll
                for (int kt = 0; kt < 8; ++kt) { s[kt] = (f32x4){0.f, 0.f, 0.f, 0.f};
#pragma unroll
                    for (int ks = 0; ks < 8; ++ks) { const bf16x8 kf = *(const LAS bf16x8*)(KV + ((half * 8 + kt) * 16 + fr) * XA_LD + ks * 32 + fq * 8); s[kt] = mfma16(kf, qf[ks], s[kt]); }
                    }
                float m = -3.0e38f;
#pragma unroll
                for (int kt = 0; kt < 8; ++kt) m = fmaxf(m, fmaxf(fmaxf(s[kt][0], s[kt][1]), fmaxf(s[kt][2], s[kt][3])));
                m = fmaxf(m, __shfl_xor(m, 16)); m = fmaxf(m, __shfl_xor(m, 32));
                float l = 0.f;
#pragma unroll
                for (int kt = 0; kt < 8; ++kt) {
#pragma unroll
                    for (int r = 0; r < 4; ++r) { const float p = fexp2(s[kt][r] - m); s[kt][r] = p; l += p; } }
                l += __shfl_xor(l, 16); l += __shfl_xor(l, 32); mh[half] = m; lh[half] = l;
#pragma unroll
                for (int j = 0; j < 4; ++j) { u32x4 o; o.x = cvt_pk_bf16(s[2 * j][0], s[2 * j][1]); o.y = cvt_pk_bf16(s[2 * j][2], s[2 * j][3]); o.z = cvt_pk_bf16(s[2 * j + 1][0], s[2 * j + 1][1]); o.w = cvt_pk_bf16(s[2 * j + 1][2], s[2 * j + 1][3]);
                    pf[half * 4 + j] = __builtin_bit_cast(bf16x8, o); }
                    }
            const float m = fmaxf(mh[0], mh[1]), cA = fexp2(mh[0] - m), cB = fexp2(mh[1] - m), li = frcp(cA * lh[0] + cB * lh[1]); fA = cA * li; fB = cB * li;
        }
        LDS_BARRIER();
        { u32x4 rest[16 - XA_PRE]; XA_REST_V(u); SCHED_FENCE(); XA_STORE(); XA_STORE_REST(); }
        if (u + F.G < (T / 128) * 4) XA_LOAD_K(u + F.G);
        LDS_BARRIER();
#pragma unroll 2
        for (int dt = 0; dt < 16; ++dt) { f32x4 oA = {0.f, 0.f, 0.f, 0.f}, oB = oA;
#pragma unroll
            for (int j = 0; j < 8; ++j) { const LAS bf16_t* vp = KV + (dt * 16 + fr) * XA_LD + j * 32 + 4 * fq; const u32x2 lo = *(const LAS u32x2*)vp, hi = *(const LAS u32x2*)(vp + 16);
                u32x4 a; a.x = lo.x; a.y = lo.y; a.z = hi.x; a.w = hi.y; const bf16x8 vf = __builtin_bit_cast(bf16x8, a);
                if (j < 4) oA = mfma16(vf, pf[j], oA); else oB = mfma16(vf, pf[j], oB); }
            const f32x4 o = oA * fA + oB * fB;
            bf16_t* op = att + (size_t)(row0 + wave * 16 + fr) * 1024 + hd * 256 + dt * 16 + 4 * fq;
            u32x2 w; w.x = cvt_pk_bf16(o[0], o[1]); w.y = cvt_pk_bf16(o[2], o[3]); *(u32x2*)op = w; }
    }
#undef XA_LOAD_K
#undef XA_LOAD_V
#undef XA_STORE
#undef XA_REST_K
#undef XA_STORE_REST
#undef XA_REST_V
}

#ifndef CPU_EMU
struct KvOrder {
    static constexpr bool LIGHT = false;
    const char* memnb; const char* wxa; char* kx; char* vt; int G, c;
    __device__ bool next(int i, pg8::Unit& u) const {
        const int Lx = i * G + c; if (Lx >= 32) return false;
        const int l = Lx >> 4, r = Lx & 15; const size_t tstep = (size_t)256 * 1024 * 2;
        if (r < 8) { u.pm = r >> 2; u.pn = r & 3; u.tag = l * 2; u.a = memnb + (size_t)u.pm * tstep; u.b = wxa + (size_t)l * 8 * MiB + 2 * MiB + (size_t)u.pn * tstep; }
        else { const int r2 = r - 8; u.pm = r2 >> 1; u.pn = r2 & 1; u.tag = l * 2 + 1; u.a = wxa + (size_t)l * 8 * MiB + 4 * MiB + (size_t)u.pm * tstep; u.b = memnb + (size_t)u.pn * tstep; }
        return true;
    }
    __device__ __forceinline__ void a_ready(const pg8::Unit&) const {}
    __device__ __forceinline__ void done(const pg8::Unit&) const {}
};
struct EpiKv {
    static constexpr bool PERM = true, AFTER_DRAIN = false;
    bf16_t* kx; bf16_t* vt;
    __device__ __forceinline__ void operator()(const f32x4 (&acc)[2][2][4][2], const pg8::Unit& u, int wr, int wc, int fr, int fq) const {
        const int l = u.tag >> 1, isv = u.tag & 1, ldc = isv ? 512 : 1024; bf16_t* O = isv ? vt + (size_t)l * 1024 * 512 : kx + (size_t)l * 512 * 1024;
        const int row0 = u.pm * 256 + wr * 64 + fr, col0 = u.pn * 256 + wc * 32 + 8 * fq;
#pragma unroll
        for (int ai = 0; ai < 2; ++ai)
#pragma unroll
            for (int m = 0; m < 4; ++m) { bf16_t* rowp = O + (size_t)(row0 + ai * 128 + m * 16) * ldc + col0;
#pragma unroll
                for (int bj = 0; bj < 2; ++bj) { const f32x4 v0 = acc[ai][bj][m][0], v1 = acc[ai][bj][m][1]; u32x4 w; w.x = cvt_pk_bf16(v0[0], v0[1]); w.y = cvt_pk_bf16(v0[2], v0[3]); w.z = cvt_pk_bf16(v1[0], v1[1]); w.w = cvt_pk_bf16(v1[2], v1[3]);
                    *(u32x4*)(rowp + bj * 128) = w; } }
    }
};
__device__ __forceinline__ void phase_kv(const Frame& F) {
    pg8::Gemm g{nullptr, nullptr, 0, 0, 1024};
    int vcu_; { const int bx = blockIdx.x, G = gridDim.x; vcu_ = (G % 8 == 0) ? (bx % 8) * (G / 8) + bx / 8 : bx; if (G % 8 == 0 && G >= 64) { const int per = G / 8, xcd = (int)blockIdx.x & 7, loc = (int)blockIdx.x >> 3  ; vcu_ = loc < 4 ? xcd * 4 + loc : 32 + vcu_; } }
    KvOrder S{(const char*)OKP(bf16_t, WS_MEMNB), (const char*)OKP(bf16_t, WS_W_XA), (char*)OKP(bf16_t, WS_KX), (char*)OKP(bf16_t, WS_VT), F.G, vcu_};
    EpiKv E{OKP(bf16_t, WS_KX), OKP(bf16_t, WS_VT)};
    pg8::gemm_phase<EpiKv, KvOrder, true, true>(F.lds, g, S, E, F.wave);
}
#endif
}

namespace ok {
constexpr size_t WS_WRH = WS_WR, WS_WRL = WS_WR + 256 * KiB;
constexpr size_t WS_POS = WS_TILEEXP + 4 * KiB;
__device__ __forceinline__ void prologue_router_tables(const Frame& F0) {
    const Frame F = phase_frame(F0);
    using namespace sm;
    const size_t gt = (size_t)F.vcu * NT + F.tid, GT = (size_t)F.G * NT;
    for (size_t i = gt; i < (size_t)2 * 48 * 1024; i += GT) { const int l = (int)(i / (48 * 1024)), j = (int)((i / 1024) % 48), k = (int)(i % 1024); float v = 0.f;
        if (j < 4) v = F.in[I_MOE_WG][((size_t)l * 1024 + k) * 4 + j]; else if (j < 36) v = F.in[I_MOE_WE][((size_t)l * 1024 + k) * 32 + (j - 4)];
        v *= F.in[I_NORM_FFN][l * 1024 + k];
        const unsigned hi = cvt_pk_bf16(v, 0.f) & 0xffffu; const float rem = v - __uint_as_float(hi << 16);
        OKP(bf16_t, WS_WRH)[i] = (bf16_t)hi; OKP(bf16_t, WS_WRL)[i] = (bf16_t)(cvt_pk_bf16(rem, 0.f) & 0xffffu); }
}

constexpr size_t WS_W16H = WS_WR + 512 * KiB, WS_W16L = WS_W16H + 64 * KiB;
__device__ __forceinline__ void prologue_w16_tables(const Frame& F0) {
    using namespace sm;
    const Frame F = phase_frame(F0);
    const size_t gt = (size_t)F.vcu * NT + F.tid, GT = (size_t)F.G * NT;
    for (size_t i = gt; i < (size_t)2 * 16 * 1024; i += GT) { const int set = (int)(i >> 14), j = (int)((i >> 10) & 15), k = (int)(i & 1023);
        const float v = set == 0 ? F.in[I_NORM_MIX][k] * F.in[I_EV_WIN][(size_t)k * 4112 + 4096 + j] : F.in[I_NORM_MIX][1024 + k] * F.in[I_OD_WIN][(size_t)k * 5648 + 4096 + j];
        const unsigned hi = cvt_pk_bf16(v, 0.f) & 0xffffu; const float rem = v - __uint_as_float(hi << 16);
        OKP(bf16_t, WS_W16H)[i] = (bf16_t)hi; OKP(bf16_t, WS_W16L)[i] = (bf16_t)(cvt_pk_bf16(rem, 0.f) & 0xffffu); }
}
__device__ __forceinline__ void phase_proj16(const Frame& F0, int set, const float* h, const bf16_t* hb, const float* ssq, int np) {
    const Frame F = phase_frame(F0);
    const int lane = F.lane, fr = lane & 15, fq = lane >> 4;
    const bf16_t* wh = OKP(bf16_t, WS_W16H) + (size_t)set * 16 * 1024; const bf16_t* wl = OKP(bf16_t, WS_W16L) + (size_t)set * 16 * 1024;
    const int gw = F.vcu * NWAVES + F.wave, NGW = F.G * NWAVES;
    for (int tile = gw; tile < T / 16; tile += NGW) { const int t0 = tile * 16; f32x4 acc = {0.f, 0.f, 0.f, 0.f};
        const float* hp = h + (size_t)(t0 + fr) * DM + fq * 8;
        if (hb) { const bf16_t* ap = hb + (size_t)(t0 + fr) * DM + fq * 8;
#pragma unroll 1
            for (int kb = 0; kb < 4; ++kb) { bf16x8 bh[8], bl[8], ah[8];
#pragma unroll
                for (int k8 = 0; k8 < 8; ++k8) { const size_t wo = (size_t)fr * 1024 + (kb * 8 + k8) * 32 + fq * 8; bh[k8] = *(const bf16x8*)(wh + wo); bl[k8] = *(const bf16x8*)(wl + wo); ah[k8] = *(const bf16x8*)(ap + (kb * 8 + k8) * 32); }
                SCHED_FENCE();
#pragma unroll
                for (int k8 = 0; k8 < 8; ++k8) { acc = mfma16(bh[k8], ah[k8], acc); acc = mfma16(bl[k8], ah[k8], acc); }
                SCHED_FENCE(); } }
        else {
#pragma unroll 1
            for (int kb = 0; kb < 4; ++kb) { bf16x8 bh[8], bl[8]; f32x4 xa[8], xb[8];
#pragma unroll
                for (int k8 = 0; k8 < 8; ++k8) { const size_t wo = (size_t)fr * 1024 + (kb * 8 + k8) * 32 + fq * 8; bh[k8] = *(const bf16x8*)(wh + wo); bl[k8] = *(const bf16x8*)(wl + wo); xa[k8] = *(const f32x4*)(hp + (kb * 8 + k8) * 32); xb[k8] = *(const f32x4*)(hp + (kb * 8 + k8) * 32 + 4); }
                SCHED_FENCE();
#pragma unroll
                for (int k8 = 0; k8 < 8; ++k8) { const f32x4 x0 = xa[k8], x1 = xb[k8];
            u32x4 hi, lo;
            hi.x = cvt_pk_bf16(x0[0], x0[1]); hi.y = cvt_pk_bf16(x0[2], x0[3]); hi.z = cvt_pk_bf16(x1[0], x1[1]); hi.w = cvt_pk_bf16(x1[2], x1[3]);
            lo.x = cvt_pk_bf16(x0[0] - bflo(hi.x), x0[1] - bfhi(hi.x)); lo.y = cvt_pk_bf16(x0[2] - bflo(hi.y), x0[3] - bfhi(hi.y));
            lo.z = cvt_pk_bf16(x1[0] - bflo(hi.z), x1[1] - bfhi(hi.z)); lo.w = cvt_pk_bf16(x1[2] - bflo(hi.w), x1[3] - bfhi(hi.w));
            const bf16x8 ah = __builtin_bit_cast(bf16x8, hi), al = __builtin_bit_cast(bf16x8, lo);
            acc = mfma16(bh[k8], ah, acc); acc = mfma16(bl[k8], ah, acc); acc = mfma16(bh[k8], al, acc); }
                SCHED_FENCE(); } }
        acc *= rstd_np(ssq, np, t0 + fr);
        *(f32x4*)(OKP(float, WS_RAW16) + (size_t)(t0 + fr) * 16 + 4 * fq) = acc; }
}

__device__ __forceinline__ void phase_router(const Frame& F0, int l, const bf16_t* hb, const float* ssq, int np) {
    const Frame F = phase_frame(F0);
    using namespace sm;
    const int lane = F.lane, wave = F.wave, fr = lane & 15, fq = lane >> 4;
    LAS float* lg = (LAS float*)(F.lds + wave * 16384 + 8704);
    const bf16_t* wh = OKP(bf16_t, WS_WRH) + (size_t)l * 48 * 1024; const bf16_t* wl = OKP(bf16_t, WS_WRL) + (size_t)l * 48 * 1024;
    const float* bg = F.in[I_MOE_BG] + l * 4; const float* be = F.in[I_MOE_BE] + l * 32;
    unsigned* cnt = F.ctl + CW_MOE + l * 64;
    const int gw = F.vcu * NWAVES + wave, NGW = F.G * NWAVES;
    for (int tile = gw; tile < T / 16; tile += NGW) {
        const int t0 = tile * 16;
        f32x4 acc[3] = {{0.f, 0.f, 0.f, 0.f}, {0.f, 0.f, 0.f, 0.f}, {0.f, 0.f, 0.f, 0.f}};
        const bf16_t* hp = hb + (size_t)(t0 + fr) * DM + fq * 8;
#pragma unroll 1
        for (int kb = 0; kb < 8; ++kb) { bf16x8 ah[4], bh[4][3], bl[4][3];
#pragma unroll
            for (int k4 = 0; k4 < 4; ++k4) { const int ks = kb * 4 + k4; ah[k4] = *(const bf16x8*)(hp + ks * 32);
#pragma unroll
                for (int nt = 0; nt < 3; ++nt) { const size_t wo = (size_t)(nt * 16 + fr) * 1024 + ks * 32 + fq * 8; bh[k4][nt] = *(const bf16x8*)(wh + wo); bl[k4][nt] = *(const bf16x8*)(wl + wo); } }
            SCHED_FENCE();
#pragma unroll
            for (int k4 = 0; k4 < 4; ++k4)
#pragma unroll
                for (int nt = 0; nt < 3; ++nt) { acc[nt] = mfma16(bh[k4][nt], ah[k4], acc[nt]); acc[nt] = mfma16(bl[k4][nt], ah[k4], acc[nt]); }
            SCHED_FENCE(); }
#pragma unroll
        for (int nt = 0; nt < 3; ++nt) *(LAS f32x4*)(lg + fr * 48 + nt * 16 + 4 * fq) = acc[nt];
        WAVE_SYNC();
        if (lane < 16) { const int t = t0 + lane; const LAS float* p = lg + lane * 48; const float rs = rstd_np(ssq, np, t);
            const float g0 = p[0] * rs + bg[0], g1 = p[1] * rs + bg[1], g2 = p[2] * rs + bg[2], g3 = p[3] * rs + bg[3];
            int gsel = 0; float gm = g0; if (g1 > gm) { gm = g1; gsel = 1; } if (g2 > gm) { gm = g2; gsel = 2; } if (g3 > gm) { gm = g3; gsel = 3; }
            const float gwt = 1.f / (expf(g0 - gm) + expf(g1 - gm) + expf(g2 - gm) + expf(g3 - gm));
            const LAS float* pe = p + 4 + gsel * 8; const float* bb = be + gsel * 8;
            float e[8];
#pragma unroll
            for (int j = 0; j < 8; ++j) e[j] = pe[j] * rs + bb[j];
            int i1 = 0; float m1 = e[0];
#pragma unroll
            for (int j = 1; j < 8; ++j) if (e[j] > m1) { m1 = e[j]; i1 = j; }
            int i2 = -1; float m2 = -3.0e38f;
#pragma unroll
            for (int j = 0; j < 8; ++j) if (j != i1 && e[j] > m2) { m2 = e[j]; i2 = j; }
            const float r = expf(m2 - m1); const float w1 = gwt / (1.f + r), w2 = gwt * r / (1.f + r);
            const int e1 = gsel * 8 + i1, e2 = gsel * 8 + i2;
            OKP(int, WS_EID)[t * 2] = e1; OKP(int, WS_EID)[t * 2 + 1] = e2; OKP(float, WS_GATEW)[t * 2] = w1; OKP(float, WS_GATEW)[t * 2 + 1] = w2;
            OKP(int, WS_POS)[t * 2] = (int)atomicAdd(cnt + e1, 1u); OKP(int, WS_POS)[t * 2 + 1] = (int)atomicAdd(cnt + e2, 1u); }
        WAVE_SYNC();
    }
}

__device__ __forceinline__ void phase_scatter(const Frame& F0, int l, const bf16_t* hb, const float* ssq, int np) {
    const Frame F = phase_frame(F0);
    const unsigned* cnt = F.ctl + CW_MOE + l * 64; const int lane = F.lane;
    const int gw = F.vcu * NWAVES + F.wave, NGW = F.G * NWAVES;
    int base = 0;
    { int tiles = lane < 32 ? (((int)cnt[lane & 31] + 255) >> 8) : 0; int incl = tiles;
#pragma unroll
      for (int o = 1; o < 32; o <<= 1) { const int n = shfl_src(incl, lane >= o ? lane - o : lane); if ((lane & 31) >= o) incl += n; }
      base = (incl - tiles) * 256;
      const int cnt_e = lane < 32 ? (int)cnt[lane & 31] : 0; const int light = (tiles > 0 && cnt_e - 256 * (tiles - 1) <= 128) ? 1 : 0, full = tiles - light;
      int fincl = full, lincl = light;
#pragma unroll
      for (int o = 1; o < 32; o <<= 1) { const int sl = lane >= o ? lane - o : lane; const int n1 = shfl_src(fincl, sl), n2 = shfl_src(lincl, sl); if ((lane & 31) >= o) { fincl += n1; lincl += n2; } }
      const int ntiles = shfl_src(incl, 31), nfull = shfl_src(fincl, 31);
      if (blockIdx.x == 0 && F.wave == 0) { if (lane < 32) { for (int i = 0; i < tiles; ++i) OKP(int, WS_TILEEXP)[(base >> 8) + i] = lane;
              for (int i = 0; i < full; ++i) OKP(int, WS_TILEEXP)[512 + (fincl - full) + i] = (base >> 8) + i;
              if (light) OKP(int, WS_TILEEXP)[512 + nfull + (lincl - 1)] = ((base >> 8) + tiles - 1) | (1 << 16); }
          if (lane == 0) OKP(int, WS_TILEEXP)[1023] = ntiles; } }
    for (int a0 = gw * 4; a0 < T * 2; a0 += NGW * 4) {
        int slot[4]; u32x4 r0[4], r1[4];
#pragma unroll
        for (int k = 0; k < 4; ++k) { const int a = a0 + k; const int e = OKP(int, WS_EID)[a]; slot[k] = shfl_src(base, e) + OKP(int, WS_POS)[a]; }
#pragma unroll
        for (int k = 0; k < 4; ++k) { const u32x4* src = (const u32x4*)(hb + (size_t)((a0 + k) >> 1) * DM) + lane; r0[k] = src[0]; r1[k] = src[64]; }
#pragma unroll
        for (int k = 0; k < 4; ++k) { const int a = a0 + k, t = a >> 1; u32x4* dst = (u32x4*)(OKP(bf16_t, WS_XS) + (size_t)slot[k] * DM) + lane; dst[0] = r0[k]; dst[64] = r1[k];
            if (lane == 0) { OKP(int, WS_TOKSLOT)[a] = slot[k]; OKP(float, WS_SLOTGATE)[slot[k]] = OKP(float, WS_GATEW)[a]; OKP(float, WS_SLOTRSTD)[slot[k]] = rstd_np(ssq, np, t); } } }
}

__device__ __forceinline__ void phase_combine(const Frame& F0, bf16_t* hb, float* ssq, bool final_layer) {
    using namespace sm;
    const Frame F = phase_frame(F0);
    const int lane = F.lane; const int gw = F.vcu * NWAVES + F.wave, NGW = F.G * NWAVES; const bf16_t* y = OKP(bf16_t, WS_Y);
    for (int t0 = gw * 2; t0 < T; t0 += NGW * 2) {
        int sa[2], sb[2];
#pragma unroll
        for (int k = 0; k < 2; ++k) { sa[k] = OKP(int, WS_TOKSLOT)[(t0 + k) * 2]; sb[k] = OKP(int, WS_TOKSLOT)[(t0 + k) * 2 + 1]; }
        u32x2 ra[2][4], rb[2][4], rh[2][4];
#pragma unroll
        for (int k = 0; k < 2; ++k) { const u32x2* hr = (const u32x2*)(hb + (size_t)(t0 + k) * DM) + lane; const u32x2* ya = (const u32x2*)(y + (size_t)sa[k] * DM) + lane; const u32x2* yb = (const u32x2*)(y + (size_t)sb[k] * DM) + lane;
#pragma unroll
            for (int j = 0; j < 4; ++j) { ra[k][j] = ya[64 * j]; rb[k][j] = yb[64 * j]; rh[k][j] = hr[64 * j]; } }
#pragma unroll
        for (int k = 0; k < 2; ++k) { const int t = t0 + k; u32x2* hr = (u32x2*)(hb + (size_t)t * DM) + lane; f32x4 v[4]; float s = 0.f;
#pragma unroll
            for (int j = 0; j < 4; ++j) { const u32x2 a = ra[k][j], b = rb[k][j], hw = rh[k][j]; f32x4 x;
                x[0] = bflo(hw.x) + (bflo(a.x) + bflo(b.x)); x[1] = bfhi(hw.x) + (bfhi(a.x) + bfhi(b.x)); x[2] = bflo(hw.y) + (bflo(a.y) + bflo(b.y)); x[3] = bfhi(hw.y) + (bfhi(a.y) + bfhi(b.y));
                if (!final_layer) { u32x2 w; w.x = cvt_pk_bf16(x[0], x[1]); w.y = cvt_pk_bf16(x[2], x[3]); hr[64 * j] = w; x = (f32x4){bflo(w.x), bfhi(w.x), bflo(w.y), bfhi(w.y)}; }
                v[j] = x; s += (x[0] * x[0] + x[1] * x[1]) + (x[2] * x[2] + x[3] * x[3]); }
            s = wave_sum(s);
            if (!final_layer) { if (lane == 0) ssq[t] = s; }
            else { const float rs = frsq(s * (1.f / DM) + EPS); f32x4* orow = (f32x4*)(F.out + (size_t)t * DM) + lane; const f32x4* gr = (const f32x4*)F.in[I_FINAL_NORM] + lane;
#pragma unroll
                for (int j = 0; j < 4; ++j) { const f32x4 g = gr[64 * j]; f32x4 o; o[0] = v[j][0] * rs * g[0]; o[1] = v[j][1] * rs * g[1]; o[2] = v[j][2] * rs * g[2]; o[3] = v[j][3] * rs * g[3]; orow[64 * j] = o; } } } }
}

#ifndef CPU_EMU
struct MoeOrder {
    static constexpr bool LIGHT = true;
    const char* A; const char* W; const int* tile_exp; size_t a_tstep, w_estride, w_off, w_tstep; int G, c;
    __device__ bool next(int i, pg8::Unit& u) const {
        const int Lx = i * G + c; const int ntiles = tile_exp[1023]; if (Lx >= ntiles * 4) return false;
        const int info = tile_exp[512 + (Lx >> 2)], tile = info & 0xffff; u.pm = tile; u.pn = Lx & 3; u.tag = info >> 16; const int e = tile_exp[tile];
        u.a = A + (size_t)tile * a_tstep; u.b = W + (size_t)e * w_estride + w_off + (size_t)u.pn * w_tstep; return true;
    }
    __device__ __forceinline__ void a_ready(const pg8::Unit&) const {}
    __device__ __forceinline__ void done(const pg8::Unit&) const {}
};
struct EpiSwiGLU {
    static constexpr bool PERM = false, AFTER_DRAIN = false;
    bf16_t* act; const float* slot_rstd;
    __device__ __forceinline__ void operator()(const f32x4 (&acc)[2][2][4][2], const pg8::Unit& u, int wr, int wc, int fr, int fq) const {
        const int row0 = u.pm * 256 + wr * 64 + fr, col0 = u.pn * 128 + wc * 16 + 4 * fq;
        float rs8[2][4];
#pragma unroll
        for (int i = 0; i < 8; ++i) rs8[i >> 2][i & 3] = slot_rstd[row0 + (i >> 2) * 128 + (i & 3) * 16];
        SCHED_FENCE();
#pragma unroll
        for (int ai = 0; ai < 2; ++ai)
#pragma unroll
            for (int m = 0; m < 4; ++m) { const int row = row0 + ai * 128 + m * 16; const float rs = rs8[ai][m]; bf16_t* rowp = act + (size_t)row * 512 + col0;
#pragma unroll
                for (int bj = 0; bj < 2; ++bj) { const f32x4 g = acc[ai][bj][m][0] * rs, up = acc[ai][bj][m][1] * rs; f32x4 o;
#pragma unroll
                    for (int r = 0; r < 4; ++r) o[r] = g[r] * frcp(1.f + fexp(-g[r])) * up[r];
                    u32x2 w; w.x = cvt_pk_bf16(o[0], o[1]); w.y = cvt_pk_bf16(o[2], o[3]); *(u32x2*)(rowp + bj * 64) = w; } }
    }
};
struct EpiDown {
    static constexpr bool PERM = true, AFTER_DRAIN = false;
    bf16_t* y; const float* slot_gate;
    __device__ __forceinline__ void operator()(const f32x4 (&acc)[2][2][4][2], const pg8::Unit& u, int wr, int wc, int fr, int fq) const {
        const int row0 = u.pm * 256 + wr * 64 + fr, col0 = u.pn * 256 + wc * 32 + 8 * fq;
        float sg8[2][4];
#pragma unroll
        for (int i = 0; i < 8; ++i) sg8[i >> 2][i & 3] = slot_gate[row0 + (i >> 2) * 128 + (i & 3) * 16];
        SCHED_FENCE();
#pragma unroll
        for (int ai = 0; ai < 2; ++ai)
#pragma unroll
            for (int m = 0; m < 4; ++m) { const int row = row0 + ai * 128 + m * 16; const float s = sg8[ai][m]; bf16_t* rowp = y + (size_t)row * DM + col0;
#pragma unroll
                for (int bj = 0; bj < 2; ++bj) { const f32x4 v0 = acc[ai][bj][m][0] * s, v1 = acc[ai][bj][m][1] * s; u32x4 w; w.x = cvt_pk_bf16(v0[0], v0[1]); w.y = cvt_pk_bf16(v0[2], v0[3]); w.z = cvt_pk_bf16(v1[0], v1[1]); w.w = cvt_pk_bf16(v1[2], v1[3]);
                    *(u32x4*)(rowp + bj * 128) = w; } }
    }
};
__device__ __forceinline__ void phase_moe_up(const Frame& F) {
    pg8::Gemm g{nullptr, nullptr, 0, 0, 1024};
    MoeOrder S{(const char*)OKP(bf16_t, WS_XS), (const char*)OKP(bf16_t, WS_MOEW), OKP(int, WS_TILEEXP), (size_t)256 * 1024 * 2, 3 * MiB, 0, (size_t)256 * 1024 * 2, F.G, (int)blockIdx.x};
    EpiSwiGLU E{OKP(bf16_t, WS_ACT), OKP(float, WS_SLOTRSTD)};
    pg8::gemm_phase<EpiSwiGLU, MoeOrder, true, true>(F.lds, g, S, E, F.wave);
}
__device__ __forceinline__ void phase_moe_down(const Frame& F) {
    pg8::Gemm g{nullptr, nullptr, 0, 0, 512};
    MoeOrder S{(const char*)OKP(bf16_t, WS_ACT), (const char*)OKP(bf16_t, WS_MOEW), OKP(int, WS_TILEEXP), (size_t)256 * 512 * 2, 3 * MiB, 2 * MiB, (size_t)256 * 512 * 2, F.G, (int)blockIdx.x};
    EpiDown E{OKP(bf16_t, WS_Y), OKP(float, WS_SLOTGATE)};
    pg8::gemm_phase<EpiDown, MoeOrder, true, true>(F.lds, g, S, E, F.wave);
}
#endif
}

#ifndef DUP_MASK
#define DUP_MASK 0
#endif
namespace ok {
constexpr size_t WS_GU = 160 * MiB, WS_GW = 192 * MiB, WS_GQD = 224 * MiB, WS_GKDT = 480 * MiB, WS_GAQK = 512 * MiB;
constexpr size_t WS_GDEC = WS_GCS;
constexpr size_t WS_OBUF = WS_H;
constexpr int G_LD = 132, GB_LD = 136, LM_LD = 68, LB_LD = 72, XT_LD2 = 68;
__device__ __forceinline__ float sigmoidf_(float x) { return frcp(1.f + fexp(-x)); }

template <int PARTS  > __device__ __forceinline__ void phase_gdn_prep_t(const Frame& F0) {
    using namespace sm;
    const Frame F = phase_frame(F0);
    LAS float* q_s = (LAS float*)F.lds; LAS float* k_s = (LAS float*)(F.lds + 33792); LAS float* v_s = (LAS float*)(F.lds + 67584);
    LAS bf16_t* Kn = (LAS bf16_t*)(F.lds + 101376); LAS bf16_t* Qn = (LAS bf16_t*)(F.lds + 118784);
    LAS float* g_s = (LAS float*)(F.lds + 136192); LAS float* beta_s = g_s + 64; LAS float* gc_s = g_s + 128; LAS float* eg_s = g_s + 192; LAS float* rq_s = g_s + 256; LAS float* rk_s = g_s + 320;
    LAS float* Lm = q_s;
    LAS bf16_t* Lb16 = (LAS bf16_t*)(F.lds + 17408);
    LAS bf16_t* XT = Kn;
    const int tid = F.tid, lane = F.lane, wave = F.wave, fr = lane & 15, fq = lane >> 4;
    const bf16_t* proj = OKP(bf16_t, WS_PROJ); const float* cw = F.in[I_OD_CONV];
    for (int u = F.vcu; u < NB * NCH * 8; u += F.G) {
        const int hd = u & 7, bc = u >> 3, b = bc / NCH, c = bc % NCH; const size_t row0 = (size_t)b * L + c * 64; const size_t ub = (size_t)bc * 8 + hd;
        LDS_BARRIER();
        if ((PARTS & 1) && tid < 384) { const int which = tid >> 7, d = tid & 127, xc = which * 1024 + hd * 128 + d; LAS float* dst = (which == 0 ? q_s : which == 1 ? k_s : v_s) + d;
            const float w0 = cw[xc], w1 = cw[3072 + xc], w2 = cw[6144 + xc], w3 = cw[9216 + xc]; const bf16_t* p = proj + row0 * PROJ1_LD + xc;
            const int hb_ = c > 0 ? 1 : 0; const unsigned short h0 = p[-3 * PROJ1_LD * hb_], h1 = p[-2 * PROJ1_LD * hb_], h2 = p[-PROJ1_LD * hb_];
            unsigned short raw[64]; float pacc = 0.f;
#pragma unroll
            for (int t = 0; t < 64; ++t) raw[t] = p[(size_t)t * PROJ1_LD];
            SCHED_FENCE();
            float x0 = hb_ ? bf2f(h0) : 0.f, x1 = hb_ ? bf2f(h1) : 0.f, x2 = hb_ ? bf2f(h2) : 0.f;
#pragma unroll
            for (int t = 0; t < 64; ++t) { const float x3 = bf2f(raw[t]); const float v = w0 * x0 + w1 * x1 + w2 * x2 + w3 * x3; if (PARTS & 32) dst[t * G_LD] = v; else if (PARTS & 128) { pacc += siluf(v); if ((t & 15) == 15) dst[t * G_LD] = pacc; } else dst[t * G_LD] = siluf(v); x0 = x1; x1 = x2; x2 = x3; } }
        if ((PARTS & 1) && !(PARTS & 64) && tid >= 448) { const int t = tid - 448; const float* r16 = OKP(float, WS_RAW16) + (row0 + t) * 16;
            g_s[t] = -expf(F.in[I_OD_ALOG][hd]) * softplusf(r16[hd] + F.in[I_OD_DTB][hd]); beta_s[t] = sigmoidf_(r16[8 + hd]); }
        LDS_BARRIER();
        if (!(PARTS & 1) || (PARTS & 64)) {} else if (wave == 0) { float v = g_s[lane];
#pragma unroll
            for (int o = 1; o < 64; o <<= 1) { const float n = __shfl_up(v, o); if (lane >= o) v += n; }
            gc_s[lane] = v; eg_s[lane] = fexp(v); if (lane == 63) OKP(float, WS_GDEC)[ub] = fexp(v); }
        else if (wave <= 2) { const LAS float* src = (wave == 1 ? q_s : k_s) + lane * G_LD; float s = 0.f;
#pragma unroll 8
            for (int d = 0; d < 128; d += 4) { const f32x4 x = *(const LAS f32x4*)(src + d); s += (x.x * x.x + x.y * x.y) + (x.z * x.z + x.w * x.w); }
            const float r = frsq(s + EPS); if (wave == 1) rq_s[lane] = r * 0.08838834764831845f; else rk_s[lane] = r; }
        LDS_BARRIER();
        if (PARTS & 2)
        { const float gl = gc_s[63];
          for (int i = tid; i < 64 * 64; i += NT) { const int t = i >> 6, dp = (i & 63) * 2; const float rk = rk_s[t], rq = rq_s[t], eg = eg_s[t];
              const float k0 = k_s[t * G_LD + dp] * rk, k1 = k_s[t * G_LD + dp + 1] * rk, q0 = q_s[t * G_LD + dp] * rq, q1 = q_s[t * G_LD + dp + 1] * rq;
              *(LAS unsigned*)(Kn + t * GB_LD + dp) = cvt_pk_bf16(k0, k1); *(LAS unsigned*)(Qn + t * GB_LD + dp) = cvt_pk_bf16(q0, q1);
              *(unsigned*)(OKP(bf16_t, WS_GQD) + ub * 8192 + t * 128 + dp) = cvt_pk_bf16(q0 * eg, q1 * eg); }
          { const int t = tid & 63, dg = tid >> 6; const float f = rk_s[t] * fexp(gl - gc_s[t]); bf16_t* dst = OKP(bf16_t, WS_GKDT) + ub * 8192 + t;
#pragma unroll
            for (int j = 0; j < 16; ++j) { const int d = dg * 16 + j; dst[d * 64] = (bf16_t)(cvt_pk_bf16(k_s[t * G_LD + d] * f, 0.f) & 0xffffu); } } }
        LDS_BARRIER();
        if (PARTS & 4)
#pragma unroll
        for (int i = 0; i < 4; ++i) { const int tl = wave * 4 + i, which = tl >> 4, ti = (tl >> 2) & 3, si = tl & 3;
            f32x4 acc = {0.f, 0.f, 0.f, 0.f};
            if (si <= ti) {
#pragma unroll
                for (int ks = 0; ks < 4; ++ks) { const bf16x8 a = *(const LAS bf16x8*)(Kn + (si * 16 + fr) * GB_LD + ks * 32 + fq * 8); const bf16x8 bb = *(const LAS bf16x8*)((which ? Qn : Kn) + (ti * 16 + fr) * GB_LD + ks * 32 + fq * 8); acc = mfma16(a, bb, acc); }
                const int t = ti * 16 + fr; const float gt = gc_s[t], bt = beta_s[t];
#pragma unroll
                for (int r = 0; r < 4; ++r) { const int s = si * 16 + 4 * fq + r; const float dec = fexp(gt - gc_s[s]); acc[r] = which ? (s <= t ? acc[r] * dec : 0.f) : (s < t ? acc[r] * dec * bt : 0.f); } }
            const int t = ti * 16 + fr, s0 = si * 16 + 4 * fq;
            if (which) { u32x2 w; w.x = cvt_pk_bf16(acc[0], acc[1]); w.y = cvt_pk_bf16(acc[2], acc[3]); *(u32x2*)(OKP(bf16_t, WS_GAQK) + ub * 4096 + t * 64 + s0) = w; }
            else { Lm[(s0 + 0) * LM_LD + t] = acc[0]; Lm[(s0 + 1) * LM_LD + t] = acc[1]; Lm[(s0 + 2) * LM_LD + t] = acc[2]; Lm[(s0 + 3) * LM_LD + t] = acc[3];
                u32x2 w; w.x = cvt_pk_bf16(acc[0], acc[1]); w.y = cvt_pk_bf16(acc[2], acc[3]); *(LAS u32x2*)(Lb16 + t * LB_LD + s0) = w; } }
        LDS_BARRIER();
        if (PARTS & 8) {
            for (int i = tid; i < 64 * 128; i += NT) { const int t = i >> 7, cc = i & 127; const float bt = beta_s[t]; v_s[t * G_LD + cc] *= bt; k_s[t * G_LD + cc] *= bt * rk_s[t] * eg_s[t]; }
            LDS_BARRIER();
#pragma unroll
            for (int ib = 0; ib < 4; ++ib) {
                if (ib > 0) {
#pragma unroll
                    for (int ct2 = 0; ct2 < 2; ++ct2) { const int ct = wave * 2 + ct2; f32x4 acc = {0.f, 0.f, 0.f, 0.f};
#pragma unroll
                        for (int ks = 0; ks < (ib * 16 + 31) / 32; ++ks) { const LAS bf16_t* lp = Lb16 + (ib * 16 + fr) * LB_LD + ks * 32 + fq * 8; u32x4 la = *(const LAS u32x4*)lp;
                            if (ks * 32 + fq * 8 >= ib * 16) la = (u32x4){0u, 0u, 0u, 0u};
                            const LAS bf16_t* xp = XT + (ct * 16 + fr) * XT_LD2 + ks * 32 + fq * 8; const u32x2 x0 = *(const LAS u32x2*)xp, x1 = *(const LAS u32x2*)(xp + 4); u32x4 xb; xb.x = x0.x; xb.y = x0.y; xb.z = x1.x; xb.w = x1.y;
                            if (ks * 32 + fq * 8 >= ib * 16) xb = (u32x4){0u, 0u, 0u, 0u};
                            acc = mfma16(__builtin_bit_cast(bf16x8, la), __builtin_bit_cast(bf16x8, xb), acc); }
                        LAS float* rp = (ct < 8 ? v_s : k_s) + (ib * 16 + 4 * fq) * G_LD + (ct & 7) * 16 + fr;
#pragma unroll
                        for (int r = 0; r < 4; ++r) rp[r * G_LD] -= acc[r]; }
                    LDS_BARRIER(); }
                if (tid < 256) { const int cidx = tid & 127; const bool isw = tid >= 128; const LAS float* col = (isw ? k_s : v_s) + cidx; bf16_t* dst = OKP(bf16_t, isw ? WS_GW : WS_GU) + ub * 8192 + (isw ? cidx : cidx * 4);
                    float a[16];
#pragma unroll
                    for (int tt = 0; tt < 16; ++tt) a[tt] = col[(ib * 16 + tt) * G_LD];
#pragma unroll
                    for (int ss = 0; ss < 16; ++ss) { const float xv = a[ss]; const LAS f32x4* lp = (const LAS f32x4*)(Lm + (ib * 16 + ss) * LM_LD + ib * 16);
#pragma unroll
                        for (int q4 = ss / 4; q4 < 4; ++q4) { const f32x4 l4 = lp[q4];
#pragma unroll
                            for (int r = 0; r < 4; ++r) if (q4 * 4 + r > ss) a[q4 * 4 + r] -= l4[r] * xv; } }
                    LAS bf16_t* xt = XT + tid * XT_LD2 + ib * 16;
#pragma unroll
                    for (int q4 = 0; q4 < 4; ++q4) { u32x2 w; w.x = cvt_pk_bf16(a[q4 * 4], a[q4 * 4 + 1]); w.y = cvt_pk_bf16(a[q4 * 4 + 2], a[q4 * 4 + 3]); *(LAS u32x2*)(xt + q4 * 4) = w;
                        if (!isw) *(u32x2*)(dst + (size_t)(ib * 4 + q4) * 512) = w; }
                    if (isw) {
#pragma unroll
                        for (int ss = 0; ss < 16; ++ss) dst[(ib * 16 + ss) * 128] = (bf16_t)(cvt_pk_bf16(a[ss], 0.f) & 0xffffu); } }
                if (ib < 3) LDS_BARRIER();
            }
        }
    }
}
}

namespace ok {
constexpr int ST_LD = 136, VT_LD = 72;
__device__ __forceinline__ void phase_gdn_prep(const Frame& F0) { phase_gdn_prep_t<15>(F0); }
constexpr int GJT = 4, GDV = GJT * 16, GN_UNITS = NB * 8 * (128 / GDV);
static_assert(GJT == 4, "the Z slot below is sized for four column tiles");
struct GdnEarly { bf16x8 X[4]; u32x2 Z[4]; };
struct GdnLate { bf16x8 Kf[2]; float dec; };
__device__ __forceinline__ void gdn_load_early(GdnEarly& g, const Frame& F, size_t xoff, size_t ub, int ti, int sl, int fr, int fq, int roleB) {
    const bf16_t* Xp = (const bf16_t*)(F.ws + xoff) + ub * 8192 + (ti * 16 + fr) * 128 + fq * 8;
#pragma unroll
    for (int ks = 0; ks < 4; ++ks) g.X[ks] = *(const bf16x8*)(Xp + ks * 32);
    const bf16_t* zb = roleB ? OKP(bf16_t, WS_GAQK) + ub * 4096 + (ti * 16 + fr) * 64 + fq * 8 : OKP(bf16_t, WS_GU) + ub * 8192 + ((size_t)(ti * 4 + fq) * 128 + sl * GDV + fr) * 4;
#pragma unroll
    for (int i = 0; i < 4; ++i) g.Z[i] = *(const u32x2*)(zb + (roleB ? (i >> 1) * 32 + (i & 1) * 4 : i * 64));
}
__device__ __forceinline__ void gdn_load_late(GdnLate& g, const Frame& F, size_t ub, int ti, int wave, int fr, int fq, int vzero) {
    const bf16_t* Kp = OKP(bf16_t, WS_GKDT) + ub * 8192 + (wave * 16 + fr) * 64 + fq * 8;
#pragma unroll
    for (int k2 = 0; k2 < 2; ++k2) g.Kf[k2] = *(const bf16x8*)(Kp + k2 * 32);
    g.dec = OKP(float, WS_GDEC)[ub + vzero];
}
constexpr int OS_LD = GDV + 8;
__device__ __forceinline__ void gdn_flush_o(const Frame& F, const LAS bf16_t* Os, int b, int cprev, int hd, int sl) {
    constexpr int PCS = GDV / 8;
    if (F.tid < 64 * PCS) { const int row = F.tid / PCS, pc = F.tid % PCS; *(u32x4*)(OKP(bf16_t, WS_OBUF) + ((size_t)b * L + cprev * 64 + row) * 1024 + hd * 128 + sl * GDV + pc * 8) = *(const LAS u32x4*)(Os + row * OS_LD + pc * 8); }
}
__device__ __forceinline__ void gdn_step(const Frame& F, const GdnEarly& g, const GdnLate& h, f32x4 (&Sacc)[GJT], LAS bf16_t* ST0, LAS bf16_t* VnT, int par, int roleB, int b, int c, int hd, int sl, int ti, int wave, int fr, int fq) {
    LAS bf16_t* ST = ST0 + par * (GDV * ST_LD); LAS bf16_t* STn = ST0 + (par ^ 1) * (GDV * ST_LD);
    LAS bf16_t* Os = VnT + GDV * VT_LD;
    LDS_BARRIER();
    if (c > 0) gdn_flush_o(F, Os, b, c - 1, hd, sl);
    f32x4 a[GJT];
#pragma unroll
    for (int ji = 0; ji < GJT; ++ji) a[ji] = (f32x4){0.f, 0.f, 0.f, 0.f};
#pragma unroll
    for (int ks = 0; ks < 4; ++ks)
#pragma unroll
        for (int ji = 0; ji < GJT; ++ji) { const bf16x8 sf = *(const LAS bf16x8*)(ST + (ji * 16 + fr) * ST_LD + ks * 32 + fq * 8); a[ji] = mfma16(g.X[ks], sf, a[ji]); }
    if (!roleB) {
#pragma unroll
        for (int ji = 0; ji < GJT; ++ji) { const u32x2 uv = g.Z[ji]; u32x2 w; w.x = cvt_pk_bf16(bflo(uv.x) - a[ji][0], bfhi(uv.x) - a[ji][1]); w.y = cvt_pk_bf16(bflo(uv.y) - a[ji][2], bfhi(uv.y) - a[ji][3]);
            *(LAS u32x2*)(VnT + (ji * 16 + fr) * VT_LD + ti * 16 + 4 * fq) = w; } }
    LDS_BARRIER();
#pragma unroll
    for (int ji = 0; ji < GJT; ++ji) { bf16x8 vf[2];
#pragma unroll
        for (int k2 = 0; k2 < 2; ++k2) vf[k2] = *(const LAS bf16x8*)(VnT + (ji * 16 + fr) * VT_LD + k2 * 32 + fq * 8);
        if (roleB) {
#pragma unroll
            for (int k2 = 0; k2 < 2; ++k2) { u32x4 af; af.x = g.Z[2 * k2].x; af.y = g.Z[2 * k2].y; af.z = g.Z[2 * k2 + 1].x; af.w = g.Z[2 * k2 + 1].y; a[ji] = mfma16(__builtin_bit_cast(bf16x8, af), vf[k2], a[ji]); }
            LAS bf16_t* op = Os + (ti * 16 + 4 * fq) * OS_LD + ji * 16 + fr;
#pragma unroll
            for (int r = 0; r < 4; ++r) op[r * OS_LD] = (bf16_t)(cvt_pk_bf16(a[ji][r], 0.f) & 0xffffu); }
        Sacc[ji] *= h.dec;
#pragma unroll
        for (int k2 = 0; k2 < 2; ++k2) Sacc[ji] = mfma16(h.Kf[k2], vf[k2], Sacc[ji]);
        u32x2 w; w.x = cvt_pk_bf16(Sacc[ji][0], Sacc[ji][1]); w.y = cvt_pk_bf16(Sacc[ji][2], Sacc[ji][3]); *(LAS u32x2*)(STn + (ji * 16 + fr) * ST_LD + wave * 16 + 4 * fq) = w; }
}
template <int MODE  > __device__ __forceinline__ void gdn_scan_unit_t(const Frame& F, int unit) {
    LAS bf16_t* ST = (LAS bf16_t*)F.lds; LAS bf16_t* VnT = (LAS bf16_t*)(F.lds + 2 * GDV * ST_LD * 2);
    const int tid = F.tid, lane = F.lane, wave = F.wave, fr = lane & 15, fq = lane >> 4;
    constexpr int NSL = 128 / GDV;
    const int sl = unit % NSL, hd = (unit / NSL) & 7, b = unit / (NSL * 8), ti = wave & 3, roleB = wave >> 2;
    for (int i = tid; i < GDV * ST_LD / 2; i += NT) ((LAS unsigned*)ST)[i] = 0u;
    f32x4 Sacc[GJT];
#pragma unroll
    for (int ji = 0; ji < GJT; ++ji) Sacc[ji] = (f32x4){0.f, 0.f, 0.f, 0.f};
    const size_t ub0 = ((size_t)b * NCH) * 8 + hd; const size_t xoff = roleB ? WS_GQD : WS_GW;
    int vzero = 0;
#ifndef CPU_EMU
    asm volatile("" : "+v"(vzero));
#endif
#define GDN_LE(set, cc) if (MODE == 0) gdn_load_early(set, F, xoff, ub0 + (size_t)((cc) < NCH ? (cc) : NCH - 1) * 8, ti, sl, fr, fq, roleB)
#define GDN_LL(set, cc) if (MODE == 0) gdn_load_late(set, F, ub0 + (size_t)((cc) < NCH ? (cc) : NCH - 1) * 8, ti, wave, fr, fq, vzero)
#define GDN_ST(es, ls, cc, par) gdn_step(F, es, ls, Sacc, ST, VnT, par, roleB, b, (MODE == 0 ? (cc) : 0), hd, sl, ti, wave, fr, fq)
    GdnEarly e0, e1, e2; GdnLate l0, l1;
    GDN_LE(e0, 0); GDN_LE(e1, 1); GDN_LL(l0, 0);
    if (MODE == 1) { gdn_load_early(e0, F, xoff, ub0, ti, sl, fr, fq, roleB); gdn_load_early(e1, F, xoff, ub0, ti, sl, fr, fq, roleB); gdn_load_early(e2, F, xoff, ub0, ti, sl, fr, fq, roleB); gdn_load_late(l0, F, ub0, ti, wave, fr, fq, vzero); gdn_load_late(l1, F, ub0, ti, wave, fr, fq, vzero); }
    int c = 0;
    for (; c + 6 <= NCH; c += 6) {
        GDN_LE(e2, c + 2); GDN_LL(l1, c + 1); GDN_ST(e0, l0, c + 0, 0);
        GDN_LE(e0, c + 3); GDN_LL(l0, c + 2); GDN_ST(e1, l1, c + 1, 1);
        GDN_LE(e1, c + 4); GDN_LL(l1, c + 3); GDN_ST(e2, l0, c + 2, 0);
        GDN_LE(e2, c + 5); GDN_LL(l0, c + 4); GDN_ST(e0, l1, c + 3, 1);
        GDN_LE(e0, c + 6); GDN_LL(l1, c + 5); GDN_ST(e1, l0, c + 4, 0);
        GDN_LE(e1, c + 7); GDN_LL(l0, c + 6); GDN_ST(e2, l1, c + 5, 1);
    }
    if (c + 0 < NCH) { GDN_LE(e2, c + 2); GDN_LL(l1, c + 1); GDN_ST(e0, l0, c + 0, 0); }
    if (c + 1 < NCH) { GDN_LE(e0, c + 3); GDN_LL(l0, c + 2); GDN_ST(e1, l1, c + 1, 1); }
    if (c + 2 < NCH) { GDN_LE(e1, c + 4); GDN_LL(l1, c + 3); GDN_ST(e2, l0, c + 2, 0); }
    if (c + 3 < NCH) { GDN_LE(e2, c + 5); GDN_LL(l0, c + 4); GDN_ST(e0, l1, c + 3, 1); }
    if (c + 4 < NCH) { GDN_LE(e0, c + 6); GDN_LL(l1, c + 5); GDN_ST(e1, l0, c + 4, 0); }
#undef GDN_LE
#undef GDN_LL
#undef GDN_ST
    LDS_BARRIER();
    if (MODE == 0) gdn_flush_o(F, VnT + GDV * VT_LD, b, NCH - 1, hd, sl);
}
__device__ __forceinline__ void gdn_scan_unit(const Frame& F, int unit) { gdn_scan_unit_t<0>(F, unit); }
__device__ __forceinline__ void phase_gdn_final(const Frame& F0) {
    using namespace sm;
    const Frame F = phase_frame(F0);
    const int lane = F.lane; const int gw = F.vcu * NWAVES + F.wave, NGW = F.G * NWAVES;
    const f32x4* nw4 = (const f32x4*)(F.in[I_OD_NORM] + (lane & 7) * 16);
    u32x4 na[2], nz[2]; { const int t = gw < T ? gw : 0; const u32x4* op = (const u32x4*)(OKP(bf16_t, WS_OBUF) + (size_t)t * 1024 + lane * 16); const u32x4* zp = (const u32x4*)(OKP(bf16_t, WS_PROJ) + (size_t)t * PROJ1_LD + 3072 + lane * 16); na[0] = op[0]; na[1] = op[1]; nz[0] = zp[0]; nz[1] = zp[1]; }
    for (int t = gw; t < T; t += NGW) { const u32x4 ca[2] = {na[0], na[1]}, cz[2] = {nz[0], nz[1]};
        { const int tn = t + NGW < T ? t + NGW : t; const u32x4* op = (const u32x4*)(OKP(bf16_t, WS_OBUF) + (size_t)tn * 1024 + lane * 16); const u32x4* zp = (const u32x4*)(OKP(bf16_t, WS_PROJ) + (size_t)tn * PROJ1_LD + 3072 + lane * 16); na[0] = op[0]; na[1] = op[1]; nz[0] = zp[0]; nz[1] = zp[1]; }
        float o[16], z[16];
#pragma unroll
        for (int h2 = 0; h2 < 2; ++h2) { const u32x4 a = ca[h2], zz = cz[h2];
            o[h2 * 8 + 0] = bflo(a.x); o[h2 * 8 + 1] = bfhi(a.x); o[h2 * 8 + 2] = bflo(a.y); o[h2 * 8 + 3] = bfhi(a.y); o[h2 * 8 + 4] = bflo(a.z); o[h2 * 8 + 5] = bfhi(a.z); o[h2 * 8 + 6] = bflo(a.w); o[h2 * 8 + 7] = bfhi(a.w);
            z[h2 * 8 + 0] = bflo(zz.x); z[h2 * 8 + 1] = bfhi(zz.x); z[h2 * 8 + 2] = bflo(zz.y); z[h2 * 8 + 3] = bfhi(zz.y); z[h2 * 8 + 4] = bflo(zz.z); z[h2 * 8 + 5] = bfhi(zz.z); z[h2 * 8 + 6] = bflo(zz.w); z[h2 * 8 + 7] = bfhi(zz.w); }
        float s = 0.f;
#pragma unroll
        for (int i = 0; i < 16; ++i) s += o[i] * o[i];
        s += __shfl_xor(s, 1); s += __shfl_xor(s, 2); s += __shfl_xor(s, 4);
        const float rs = frsq(s * (1.f / 128.f) + EPS);
        u32x4 w[2];
#pragma unroll
        for (int h2 = 0; h2 < 2; ++h2) { const f32x4 n0 = nw4[h2 * 2], n1 = nw4[h2 * 2 + 1]; float y[8];
#pragma unroll
            for (int i = 0; i < 8; ++i) y[i] = o[h2 * 8 + i] * rs * (i < 4 ? n0[i] : n1[i - 4]) * siluf(z[h2 * 8 + i]);
            w[h2].x = cvt_pk_bf16(y[0], y[1]); w[h2].y = cvt_pk_bf16(y[2], y[3]); w[h2].z = cvt_pk_bf16(y[4], y[5]); w[h2].w = cvt_pk_bf16(y[6], y[7]); }
        u32x4* cp = (u32x4*)(OKP(bf16_t, WS_CAT1) + (size_t)t * 1536 + lane * 16); cp[0] = w[0]; cp[1] = w[1]; }
}
}

#ifndef DUP_MASK
#define DUP_MASK 0
#endif
namespace ok {
constexpr int SB_LD = 72;
#ifdef CPU_EMU
#define WAVE_ALL(p) (wave_sum((p) ? 1.f : 0.f) == 64.f)
#else
#define WAVE_ALL(p) (__all(p))
#endif
__device__ __forceinline__ void sb_unit(const Frame& F, int unit) {
    LAS bf16_t* Kt = (LAS bf16_t*)F.lds; LAS bf16_t* VT = (LAS bf16_t*)(F.lds + 64 * SB_LD * 2); volatile LAS int* votes = (volatile LAS int*)(F.lds + 2 * 64 * SB_LD * 2);
    const int tid = F.tid, lane = F.lane, wave = F.wave, fr = lane & 15, fq = lane >> 4;
    const int nqb = L / 128, qb = unit % nqb, hd = (unit / nqb) & 7, b = unit / (nqb * 8), q0 = qb * 128;
    const bf16_t* proj = OKP(bf16_t, WS_PROJ) + (size_t)b * L * PROJ1_LD;
    const int qrow = q0 + wave * 16 + fr;
    bf16x8 qf[2];
#pragma unroll
    for (int ks = 0; ks < 2; ++ks) qf[ks] = *(const bf16x8*)(proj + (size_t)qrow * PROJ1_LD + 4096 + hd * 64 + ks * 32 + fq * 8);
    f32x4 o[4] = {{0.f, 0.f, 0.f, 0.f}, {0.f, 0.f, 0.f, 0.f}, {0.f, 0.f, 0.f, 0.f}, {0.f, 0.f, 0.f, 0.f}};
    float C = 1.f; bool wdone = false;
    const int key_l = tid >> 3, c8 = tid & 7;
    int kt = 2 * qb + 1;
    u32x4 kreg = *(const u32x4*)(proj + (size_t)(kt * 64 + key_l) * PROJ1_LD + 4608 + hd * 64 + c8 * 8), vreg = *(const u32x4*)(proj + (size_t)(kt * 64 + key_l) * PROJ1_LD + 5120 + hd * 64 + c8 * 8);
    for (; kt >= 0; --kt) {
        LDS_BARRIER();
        *(LAS u32x4*)(Kt + key_l * SB_LD + c8 * 8) = kreg;
        { LAS bf16_t* vp = VT + (c8 * 8) * SB_LD + key_l; vp[0] = (bf16_t)(vreg.x & 0xffffu); vp[SB_LD] = (bf16_t)(vreg.x >> 16); vp[2 * SB_LD] = (bf16_t)(vreg.y & 0xffffu); vp[3 * SB_LD] = (bf16_t)(vreg.y >> 16);
          vp[4 * SB_LD] = (bf16_t)(vreg.z & 0xffffu); vp[5 * SB_LD] = (bf16_t)(vreg.z >> 16); vp[6 * SB_LD] = (bf16_t)(vreg.w & 0xffffu); vp[7 * SB_LD] = (bf16_t)(vreg.w >> 16); }
        if (lane == 0) votes[wave] = wdone ? 1 : 0;
        LDS_BARRIER();
        { int all = 1;
#pragma unroll
          for (int w = 0; w < 8; ++w) all &= votes[w];
          if (all) break; }
        if (kt > 0) { kreg = *(const u32x4*)(proj + (size_t)((kt - 1) * 64 + key_l) * PROJ1_LD + 4608 + hd * 64 + c8 * 8); vreg = *(const u32x4*)(proj + (size_t)((kt - 1) * 64 + key_l) * PROJ1_LD + 5120 + hd * 64 + c8 * 8); }
        const int key0 = kt * 64;
#ifdef SB_COUNT_ITERS
        ++g_iters;
#endif
        if (!wdone && key0 < q0 + wave * 16 + 16) {
            f32x4 x[4];
#pragma unroll
            for (int k16 = 0; k16 < 4; ++k16) { x[k16] = (f32x4){0.f, 0.f, 0.f, 0.f};
#pragma unroll
                for (int ks = 0; ks < 2; ++ks) { const bf16x8 kf = *(const LAS bf16x8*)(Kt + (k16 * 16 + fr) * SB_LD + ks * 32 + fq * 8); x[k16] = mfma16(kf, qf[ks], x[k16]); } }
            const bool need_mask = key0 + 63 >= q0 + wave * 16;
            float Rr[4], Tt[4], Ee[4];
#pragma unroll
            for (int k16 = 0; k16 < 4; ++k16) {
#pragma unroll
                for (int r = 0; r < 4; ++r) { const float e = fexp2(fminf(x[k16][r], 80.f)); float rr = frcp(1.f + e), bet = e * rr;
                    if (need_mask && key0 + k16 * 16 + 4 * fq + r >= qrow) { rr = 1.f; bet = 0.f; }
                    x[k16][r] = bet; Rr[k16] = (r == 0) ? rr : Rr[k16];
                    if (r == 0) Tt[k16] = rr; else if (r == 1) Ee[k16] = rr; else if (r == 2) Rr[k16] = rr; else {
                        const float r0 = Tt[k16], r1 = Ee[k16], r2 = Rr[k16], r3 = rr; const float s2 = r3, s1 = r3 * r2, s0 = s1 * r1;
                        x[k16][0] *= s0; x[k16][1] *= s1; x[k16][2] *= s2;
                        Rr[k16] = s0 * r0; } } }
#pragma unroll
            for (int k16 = 0; k16 < 4; ++k16) { const float R = Rr[k16]; const float d1 = __shfl_down(R, 16), d2 = __shfl_down(R, 32), d3 = __shfl_down(R, 48);
                Ee[k16] = (fq < 3 ? d1 : 1.f) * (fq < 2 ? d2 : 1.f) * (fq < 1 ? d3 : 1.f); float t = R; t *= __shfl_xor(t, 16); t *= __shfl_xor(t, 32); Tt[k16] = t; }
            const float TT2 = Tt[3], TT1 = Tt[3] * Tt[2], TT0 = TT1 * Tt[1];
            const float f0 = Ee[0] * TT0 * C, f1 = Ee[1] * TT1 * C, f2 = Ee[2] * TT2 * C, f3 = Ee[3] * C;
            x[0] *= f0; x[1] *= f1; x[2] *= f2; x[3] *= f3;
            C *= TT0 * Tt[0];
            bf16x8 pw[2];
#pragma unroll
            for (int j = 0; j < 2; ++j) { u32x4 p; p.x = cvt_pk_bf16(x[2 * j][0], x[2 * j][1]); p.y = cvt_pk_bf16(x[2 * j][2], x[2 * j][3]); p.z = cvt_pk_bf16(x[2 * j + 1][0], x[2 * j + 1][1]); p.w = cvt_pk_bf16(x[2 * j + 1][2], x[2 * j + 1][3]); pw[j] = __builtin_bit_cast(bf16x8, p); }
#pragma unroll
            for (int dt = 0; dt < 4; ++dt)
#pragma unroll
                for (int j = 0; j < 2; ++j) { const LAS bf16_t* vp = VT + (dt * 16 + fr) * SB_LD + j * 32 + 4 * fq; const u32x2 lo = *(const LAS u32x2*)vp, hi = *(const LAS u32x2*)(vp + 16);
                    u32x4 a; a.x = lo.x; a.y = lo.y; a.z = hi.x; a.w = hi.y; o[dt] = mfma16(__builtin_bit_cast(bf16x8, a), pw[j], o[dt]); }
            wdone = WAVE_ALL(C < 7.8886e-31f);
        }
    }
    bf16_t* op = OKP(bf16_t, WS_CAT1) + ((size_t)b * L + qrow) * 1536 + 1024 + hd * 64 + 4 * fq;
#pragma unroll
    for (int dt = 0; dt < 4; ++dt) { u32x2 w; w.x = cvt_pk_bf16(o[dt][0], o[dt][1]); w.y = cvt_pk_bf16(o[dt][2], o[dt][3]); *(u32x2*)(op + dt * 16) = w; }
}
__device__ __forceinline__ void phase_l1_mix(const Frame& F0) {
    const Frame F = phase_frame(F0);
    constexpr int NU = GN_UNITS, UPX = NU / 8;
    if (F.G < 128 || F.G % 8 != 0) { if (F.vcu == 0) for (int u = 0; u < NU; ++u) { gdn_scan_unit(F, u); __syncthreads(); } for (int u = F.vcu; u < NB * 8 * (L / 128); u += F.G) { sb_unit(F, u); __syncthreads(); } return; }
    const int per = F.G / 8, xcd = (int)blockIdx.x & 7, loc = (int)blockIdx.x >> 3  ;
    if (loc < UPX) { gdn_scan_unit(F, xcd * UPX + loc);
#if (DUP_MASK >> 3) & 1
        __syncthreads(); gdn_scan_unit(F, xcd * UPX + loc);
#endif
#if (DUP_MASK >> 21) & 1
        __syncthreads(); gdn_scan_unit_t<1>(F, xcd * UPX + loc);
#endif
    }
    else for (int rep = 0; rep < 1 + ((DUP_MASK >> 16) & 1); ++rep) for (int u = xcd * (per - UPX) + (loc - UPX); u < NB * 8 * (L / 128); u += F.G - NU) { sb_unit(F, u); __syncthreads(); }
}
}

namespace ok {
#if CHECK
__device__ const int kSampleRows[16] = {0, 1, 2, 3, 63, 64, 127, 128, 129, 1000, 2047, 2048, 4097, 6000, 8190, 8191};
constexpr int FP_W = 6144;
__device__ __forceinline__ void fp_save(const Frame& F, int k, const void* buf, int ld, int width, bool is_bf16, int dcol0) {
    float* fp = OKP(float, WS_FP) + (size_t)k * 16 * FP_W; const size_t gt = (size_t)blockIdx.x * NT + F.tid, GT = (size_t)F.G * NT;
    for (size_t i = gt; i < (size_t)16 * width; i += GT) { const int r = (int)(i / width), c = (int)(i % width); const size_t src = (size_t)kSampleRows[r] * ld + c;
        fp[r * FP_W + dcol0 + c] = is_bf16 ? bf2f(((const bf16_t*)buf)[src]) : ((const float*)buf)[src]; }
}
__device__ __forceinline__ void fp_cmp(const Frame& F, int k, const float* obuf, int ld, int ocol0, int width, int fcol0) {
    const float* fp = OKP(float, WS_FP) + (size_t)k * 16 * FP_W; const size_t gt = (size_t)blockIdx.x * NT + F.tid, GT = (size_t)F.G * NT; float num = 0.f, den = 0.f;
    for (size_t i = gt; i < (size_t)16 * width; i += GT) { const int r = (int)(i / width), c = (int)(i % width); const float o = obuf[(size_t)kSampleRows[r] * ld + ocol0 + c], f = fp[r * FP_W + fcol0 + c];
        const float d = o - f; num += d * d; den += o * o; if (!(d == d)) num += 1e30f; }
    num = wave_sum(num); den = wave_sum(den);
    if (F.lane == 0 && (num != 0.f || den != 0.f)) { atomicAdd((float*)F.ctl + CW_CHK + 2 * k, num); atomicAdd((float*)F.ctl + CW_CHK + 2 * k + 1, den); }
}
__device__ __forceinline__ void fp_save_lin(const Frame& F, int k, const void* buf, size_t off, int n, bool is_bf16) {
    float* fp = OKP(float, WS_FP) + (size_t)k * 16 * FP_W; const size_t gt = (size_t)blockIdx.x * NT + F.tid, GT = (size_t)F.G * NT;
    for (size_t i = gt; i < (size_t)n; i += GT) fp[i] = is_bf16 ? bf2f(((const bf16_t*)buf)[off + i]) : ((const float*)buf)[off + i];
}
__device__ __forceinline__ void fp_cmp_lin(const Frame& F, int k, const float* obuf, size_t off, int n) {
    const float* fp = OKP(float, WS_FP) + (size_t)k * 16 * FP_W; const size_t gt = (size_t)blockIdx.x * NT + F.tid, GT = (size_t)F.G * NT; float num = 0.f, den = 0.f;
    for (size_t i = gt; i < (size_t)n; i += GT) { const float o = obuf[off + i], f = fp[i]; const float d = o - f; num += d * d; den += o * o; if (!(d == d)) num += 1e30f; }
    num = wave_sum(num); den = wave_sum(den);
    if (F.lane == 0 && (num != 0.f || den != 0.f)) { atomicAdd((float*)F.ctl + CW_CHK + 2 * k, num); atomicAdd((float*)F.ctl + CW_CHK + 2 * k + 1, den); }
}
#endif

struct Args { const float* in[33]; float* out; unsigned char* ws;
#if CHECK
    sm::Ctx oc;
#endif
};

__global__ void __launch_bounds__(512, 2) mk_fwd(Args a) {
    extern __shared__ __attribute__((aligned(16))) unsigned char lds_raw[];
    Frame F; F.lds = (LAS unsigned char*)lds_raw; F.ws = a.ws; F.ctl = (unsigned*)(a.ws + WS_CTL); F.in = a.in; F.out = a.out;
    F.tid = threadIdx.x; F.lane = F.tid & 63; F.wave = __builtin_amdgcn_readfirstlane(F.tid >> 6); F.G = gridDim.x;
    { const int bx = blockIdx.x; F.vcu = (F.G % 8 == 0) ? (bx % 8) * (F.G / 8) + bx / 8 : bx; }
    volatile LAS unsigned* MISC = (volatile LAS unsigned*)(F.lds + LDS_BYTES - 64);
    if (F.tid < 16) MISC[F.tid] = 0u;
    __syncthreads();
    XcdBarrier bar = xcd_barrier_post(F.ctl + CW_BAR, MISC);
#define GRID_BAR() xcd_barrier(bar)
    using namespace sm;
    for (int dup_p = 0; dup_p < ((DUP_MASK >> 5) & 1) + 1; ++dup_p) {
    phase_prologue(F);
    prologue_router_tables(F);
    prologue_w16_tables(F);
    GRID_BAR();
    }
    for (int dup_i0 = 0; dup_i0 < ((DUP_MASK >> 6) & 1) + 1; ++dup_i0) {
    { EpiScaleBf16 E{OKP(bf16_t, WS_PROJ), PROJ0_LD, (const float*)F.ctl + CW_SSQ, 1};
      dense_gemm(F, OKP(bf16_t, WS_HB), OKP(bf16_t, WS_W_IN0), T, 4096, 1024, E); }
    phase_proj16(F, 0, F.in[I_X], nullptr, (const float*)F.ctl + CW_SSQ, 1);
    GRID_BAR();
    }
#if CHECK
    fp_save(F, 0, OKP(bf16_t, WS_PROJ), PROJ0_LD, 4096, true, 0);
#endif
    for (int dup_b = 0; dup_b < ((DUP_MASK >> 1) & 1) + 1; ++dup_b) {
    for (int dup_b1 = 0; dup_b1 < ((DUP_MASK >> 14) & 1) + 1; ++dup_b1) { phase_ssd_a(F); GRID_BAR(); }
#if CHECK
    fp_save_lin(F, 6, OKP(bf16_t, WS_STATES), ((size_t)5 * 16 + 0) * 8192, 65536, true);
    GRID_BAR();
#endif
    phase_kv(F);
    phase_ssd_scan(F, (F.G >= 64 && F.G % 8 == 0) ? 32 : 0);
    GRID_BAR();
    for (int dup_b2 = 0; dup_b2 < ((DUP_MASK >> 15) & 1) + 1; ++dup_b2) { phase_ssd_b(F); GRID_BAR(); }
    }

    for (int dup_o0 = 0; dup_o0 < ((DUP_MASK >> 8) & 1) + 1; ++dup_o0) {
    { EpiResidualT<true> E{F.in[I_X], OKP(bf16_t, WS_HB), OKP(float, WS_SSQP1)};
      dense_gemm(F, OKP(bf16_t, WS_CAT0), OKP(bf16_t, WS_W_OUT0), T, 1024, 1536, E); }
    GRID_BAR();
    }
#if CHECK
    fp_save(F, 10, OKP(bf16_t, WS_HB), 1024, 1024, true, 0);
    fp_save_lin(F, 7, OKP(bf16_t, WS_STATES), ((size_t)5 * 16 + 0) * 8192, 65536, true);
    fp_save(F, 8, OKP(bf16_t, WS_CAT0), 1536, 512, true, 0);
    fp_save(F, 9, OKP(bf16_t, WS_CAT0) + 512, 1536, 1024, true, 0);
    GRID_BAR();
#endif
    for (int dup_q0 = 0; dup_q0 < ((DUP_MASK >> 9) & 1) + 1; ++dup_q0) {
    { EpiScaleBf16 E{OKP(bf16_t, WS_Q), 1024, OKP(float, WS_SSQP1), 16};
      dense_gemm(F, OKP(bf16_t, WS_HB), OKP(bf16_t, WS_W_XA), T, 1024, 1024, E); }
    GRID_BAR();
    }
    for (int dup_xa0 = 0; dup_xa0 < ((DUP_MASK >> 13) & 1) + 1; ++dup_xa0) {
    phase_xattn(F, OKP(bf16_t, WS_Q), OKP(bf16_t, WS_KX), OKP(bf16_t, WS_VT), OKP(bf16_t, WS_ATT));
    GRID_BAR();
    }
    { EpiResidualT<false> E{nullptr, OKP(bf16_t, WS_HB), OKP(float, WS_SSQP2)};
      dense_gemm(F, OKP(bf16_t, WS_ATT), OKP(bf16_t, WS_W_XA + 6 * MiB), T, 1024, 1024, E); }
    GRID_BAR();
#if CHECK
    fp_save(F, 11, OKP(bf16_t, WS_HB), 1024, 1024, true, 0);
    GRID_BAR();
#endif
    phase_router(F, 0, OKP(bf16_t, WS_HB), OKP(float, WS_SSQP2), 16);
    for (int dup_cv = 0; dup_cv < ((DUP_MASK >> 10) & 1) + 1; ++dup_cv) phase_cvt_moe(F, 0);
    GRID_BAR();
    for (int dup_sc = 0; dup_sc < ((DUP_MASK >> 11) & 1) + 1; ++dup_sc) {
    phase_scatter(F, 0, OKP(bf16_t, WS_HB), OKP(float, WS_SSQP2), 16);
    GRID_BAR();
    }
    for (int dup_c = 0; dup_c < ((DUP_MASK >> 2) & 1) + 1; ++dup_c) {
    phase_moe_up(F);
    GRID_BAR();
    phase_moe_down(F);
    GRID_BAR();
    }

    phase_combine(F, OKP(bf16_t, WS_HB), (float*)F.ctl + CW_SSQ + 3 * T, false);
    GRID_BAR();
#if CHECK
    fp_save(F, 12, OKP(bf16_t, WS_HB), 1024, 1024, true, 0);
    GRID_BAR();
#endif
    for (int dup_i1 = 0; dup_i1 < ((DUP_MASK >> 12) & 1) + 1; ++dup_i1) {
    { EpiScaleBf16 E{OKP(bf16_t, WS_PROJ), PROJ1_LD, (const float*)F.ctl + CW_SSQ + 3 * T, 1};
      dense_gemm(F, OKP(bf16_t, WS_HB), OKP(bf16_t, WS_W_IN1), T, 5632, 1024, E); }
    phase_proj16(F, 1, nullptr, OKP(bf16_t, WS_HB), (const float*)F.ctl + CW_SSQ + 3 * T, 1);
    GRID_BAR();
    }
#if CHECK
    fp_save(F, 13, OKP(bf16_t, WS_PROJ), PROJ1_LD, 4096, true, 0);
    fp_save(F, 13, OKP(bf16_t, WS_PROJ) + 4608, PROJ1_LD, 1024, true, 4096);
#endif
#if (DUP_MASK >> 22) & 255
    phase_gdn_prep_t<(DUP_MASK >> 22) & 255>(F); GRID_BAR();
#endif
    for (int dup_a = 0; dup_a < ((DUP_MASK >> 0) & 1) + 1; ++dup_a) { phase_gdn_prep(F); GRID_BAR(); }
    phase_l1_mix(F); GRID_BAR();
    for (int dup_e = 0; dup_e < ((DUP_MASK >> 4) & 1) + 1; ++dup_e) { phase_gdn_final(F); GRID_BAR(); }

    { EpiResidualT<false> E{nullptr, OKP(bf16_t, WS_HB), OKP(float, WS_SSQP4)};
      dense_gemm(F, OKP(bf16_t, WS_CAT1), OKP(bf16_t, WS_W_OUT1), T, 1024, 1536, E); }
    GRID_BAR();
#if CHECK
    fp_save(F, 14, OKP(bf16_t, WS_CAT1), 1536, 1024, true, 0);
    fp_save(F, 15, OKP(bf16_t, WS_CAT1) + 1024, 1536, 512, true, 0);
    fp_save(F, 16, OKP(bf16_t, WS_HB), 1024, 1024, true, 0);
    GRID_BAR();
#endif
    { EpiScaleBf16 E{OKP(bf16_t, WS_Q), 1024, OKP(float, WS_SSQP4), 16};
      dense_gemm(F, OKP(bf16_t, WS_HB), OKP(bf16_t, WS_W_XA + 8 * MiB), T, 1024, 1024, E); }
    GRID_BAR();
    phase_xattn(F, OKP(bf16_t, WS_Q), OKP(bf16_t, WS_KX) + (size_t)NB * 256 * 1024, OKP(bf16_t, WS_VT) + (size_t)1024 * NB * 256, OKP(bf16_t, WS_ATT));
    GRID_BAR();
    { EpiResidualT<false> E{nullptr, OKP(bf16_t, WS_HB), OKP(float, WS_SSQP5)};
      dense_gemm(F, OKP(bf16_t, WS_ATT), OKP(bf16_t, WS_W_XA + 8 * MiB + 6 * MiB), T, 1024, 1024, E); }
    GRID_BAR();
#if CHECK
    fp_save(F, 17, OKP(bf16_t, WS_HB), 1024, 1024, true, 0);
    GRID_BAR();
#endif
    phase_router(F, 1, OKP(bf16_t, WS_HB), OKP(float, WS_SSQP5), 16);
    phase_cvt_moe(F, 1);
    GRID_BAR();
    phase_scatter(F, 1, OKP(bf16_t, WS_HB), OKP(float, WS_SSQP5), 16);
    GRID_BAR();
    phase_moe_up(F);
    GRID_BAR();
    phase_moe_down(F);
    GRID_BAR();
    phase_combine(F, OKP(bf16_t, WS_HB), nullptr, true);
#if CHECK
    GRID_BAR();
    fp_save(F, 18, F.out, 1024, 1024, false, 0);
    fp_save(F, 1, OKP(float, WS_DTV), 16, 16, false, 0);
    fp_save(F, 2, OKP(float, WS_ACS), 16, 16, false, 0);
    GRID_BAR();
    {
        const size_t gid = (size_t)blockIdx.x * NT + F.tid, gs = (size_t)F.G * NT;
        for (int st = 0;; ++st) {
            const int s = st % sm::NSTAGE_L;
            if (st < 2 * sm::NSTAGE_L && s >= sm::N_STAGES_USED) continue;
            if (!sm::run_stage(a.oc, st, gid, gs)) break;
            GRID_BAR();
            if (st == 3) fp_cmp(F, 0, a.oc.proj, sm::PROJ_LD, 0, 4096, 0);
            if (st == 4) { fp_cmp(F, 1, a.oc.dtv, 16, 0, 16, 0); fp_cmp(F, 2, a.oc.acs, 16, 0, 16, 0); }
            if (st == 4 && gid == 0) { float* c = (float*)F.ctl + CW_CHK; c[6] = 0.f; c[7] = 1.f; c[8] = 0.f; c[9] = 1.f; c[10] = 0.f; c[11] = 1.f; }
            if (st == 5) fp_cmp_lin(F, 6, a.oc.states, ((size_t)5 * 16 + 0) * 8192, 65536);
            if (st == 6) fp_cmp_lin(F, 7, a.oc.states, ((size_t)5 * 16 + 0) * 8192, 65536);
            if (st == 10) { fp_cmp(F, 8, a.oc.cat, 1536, 0, 512, 0); fp_cmp(F, 9, a.oc.cat, 1536, 512, 1024, 0); }
            if (st == 11) fp_cmp(F, 10, a.oc.h, 1024, 0, 1024, 0);
            if (st == 18) fp_cmp(F, 11, a.oc.h, 1024, 0, 1024, 0);
            if (st == 23) fp_cmp(F, 12, a.oc.h, 1024, 0, 1024, 0);
            if (st == 63) { fp_cmp(F, 13, a.oc.proj, sm::PROJ_LD, 0, 4096, 0); fp_cmp(F, 13, a.oc.proj, sm::PROJ_LD, 4624, 1024, 4096); }
            if (st == 70) { fp_cmp(F, 14, a.oc.cat, 1536, 0, 1024, 0); fp_cmp(F, 15, a.oc.cat, 1536, 1024, 512, 0); }
            if (st == 71) fp_cmp(F, 16, a.oc.h, 1024, 0, 1024, 0);
            if (st == 78) fp_cmp(F, 17, a.oc.h, 1024, 0, 1024, 0);
            if (st == 121) fp_cmp(F, 18, a.oc.out, 1024, 0, 1024, 0);
            GRID_BAR();
        }
        GRID_BAR();
        int code = 0;
        for (int k = CHECK - 1; k >= 0; --k) { const float num = __hip_atomic_load((float*)F.ctl + CW_CHK + 2 * k, __ATOMIC_RELAXED, __HIP_MEMORY_SCOPE_AGENT), den = __hip_atomic_load((float*)F.ctl + CW_CHK + 2 * k + 1, __ATOMIC_RELAXED, __HIP_MEMORY_SCOPE_AGENT);
            if (!(num <= 1e-3f * den) || den == 0.f) code = k + 1; }
        const float sc = 1.f + 0.2f * (float)code;
        for (size_t i = gid; i < (size_t)L * DM; i += gs) { F.out[i] *= sc; F.out[(size_t)L * DM + i] = 0.f; }
    }
#endif
}
}

extern "C" void kernel_launch(void* const* d_in, const int* in_sizes, int n_in, void* d_out, int out_size, void* d_ws, size_t ws_size, hipStream_t stream) {
    static int grid = 0;
    if (grid == 0) {
        int dev = 0, cus = 0, per_cu = 0;
        hipGetDevice(&dev); hipDeviceGetAttribute(&cus, hipDeviceAttributeMultiprocessorCount, dev);
        if (hipFuncSetAttribute((const void*)ok::mk_fwd, hipFuncAttributeMaxDynamicSharedMemorySize, LDS_BYTES) != hipSuccess) { fprintf(stderr, "kernel_launch: hipFuncSetAttribute failed\n"); grid = -1; return; }
        hipOccupancyMaxActiveBlocksPerMultiprocessor(&per_cu, (const void*)ok::mk_fwd, ok::NT, LDS_BYTES);
        (void)hipGetLastError();
        grid = cus;
        if (n_in != 33 || ws_size < ok::WS_END || per_cu < 1) { fprintf(stderr, "kernel_launch: n_in %d ws %zu need %zu per_cu %d\n", n_in, ws_size, (size_t)ok::WS_END, per_cu); grid = -1; }
    }
    if (grid < 0) return;
    hipMemsetAsync((char*)d_ws + ok::WS_CTL, 0, ok::CTL_BYTES, stream);
    ok::Args a{};
    for (int i = 0; i < 33; ++i) a.in[i] = (const float*)d_in[i];
    a.out = (float*)d_out; a.ws = (unsigned char*)d_ws;
#if CHECK
    sm::carve(a.oc, (float*)((char*)d_ws + 16 * ok::MiB));
    for (int i = 0; i < 33; ++i) a.oc.in[i] = (const float*)d_in[i];
    a.oc.out = (float*)d_out;
#endif
    hipLaunchKernelGGL(ok::mk_fwd, dim3(grid), dim3(ok::NT), LDS_BYTES, stream, a);
}
```

```cpp
#include <hip/hip_runtime.h>
#include <cstdio>
#include <cstdint>
#ifndef CHECK
#define CHECK 0
#endif
#define DUP_MASK 0
constexpr int LDS_BYTES = 147456;

#define XB_TMO      128
#define XB_XCNT(j)  (256  + 64 * (j))
#define XB_XSUB(j)  (1280 + 64 * (j))
#define XB_XGEN(j)  (2304 + 64 * (j))
#define XB_TOP      3328
#define XB_TOPGEN   3392
#define XCD_BAR_WORDS 3456
#define XB_SPIN_CAP (1u << 18)
#define LAS __attribute__((address_space(3)))

__device__ __forceinline__ unsigned xb_ld(unsigned* p)              { return __hip_atomic_load(p, __ATOMIC_RELAXED, __HIP_MEMORY_SCOPE_AGENT); }
__device__ __forceinline__ unsigned xb_add(unsigned* p, unsigned v) { return __hip_atomic_fetch_add(p, v, __ATOMIC_RELAXED, __HIP_MEMORY_SCOPE_AGENT); }
__device__ __forceinline__ unsigned xb_xcc_id() { return (unsigned)__builtin_amdgcn_s_getreg((3 << 11) | 20) & 0xFu; }
#define XB_SPIN(cond, bar) do { unsigned _sp = 0; while (cond) { __builtin_amdgcn_s_sleep(1); \
    if ((++_sp & 255u) == 0u) { if (xb_ld(&(bar)[XB_TMO])) break; if (_sp > XB_SPIN_CAP) { atomicAdd(&(bar)[XB_TMO], 1u); break; } } } } while (0)

struct XcdBarrier {
    unsigned* bar; unsigned x;
    volatile LAS unsigned* st;
};

__device__ __forceinline__ XcdBarrier xcd_barrier_post(unsigned* bar, volatile LAS unsigned* st) {
    XcdBarrier b; b.bar = bar; b.x = xb_xcc_id(); b.st = st;
    if (threadIdx.x == 0) (void)xb_add(&bar[XB_XCNT(b.x)], 1u);
    return b;
}
__device__ __forceinline__ void xcd_barrier_complete(unsigned* bar, unsigned x, unsigned& nloc, unsigned& nx) {
    const unsigned G = gridDim.x * gridDim.y * gridDim.z;
    unsigned sum, cnt, mine, sp = 0u;
    for (;;) {
        sum = 0u; cnt = 0u; mine = 0u;
#pragma unroll
        for (unsigned j = 0; j < 16; ++j) { const unsigned c = xb_ld(&bar[XB_XCNT(j)]); sum += c; cnt += (c > 0u) ? 1u : 0u; mine = (j == x) ? c : mine; }
        if (sum == G) break;
        __builtin_amdgcn_s_sleep(1);
        if ((++sp & 255u) == 0u) { if (xb_ld(&bar[XB_TMO])) break; if (sp > XB_SPIN_CAP) { atomicAdd(&bar[XB_TMO], 1u); break; } }
    }
    nloc = mine > 0u ? mine : 1u; nx = cnt > 0u ? cnt : 1u;
}

__device__ __forceinline__ void xcd_barrier(const XcdBarrier& b) {
    asm volatile("s_waitcnt vmcnt(0)" ::: "memory");
    __syncthreads();
    if (threadIdx.x == 0) {
        unsigned* bar = b.bar;
        __builtin_amdgcn_s_waitcnt(0);
        unsigned nloc = b.st[0], nx = b.st[1];
        if (nloc == 0u) { xcd_barrier_complete(bar, b.x, nloc, nx); b.st[0] = nloc; b.st[1] = nx; }
        const unsigned old = xb_add(&bar[XB_XSUB(b.x)], 1u);
        const unsigned gen = old / nloc;
        if (old + 1u == (gen + 1u) * nloc) {
            __builtin_amdgcn_fence(__ATOMIC_RELEASE, "agent");
            asm volatile("s_waitcnt vmcnt(0)" ::: "memory");
            const unsigned og = xb_add(&bar[XB_TOP], 1u);
            const unsigned tg = og / nx;
            if (og + 1u == (tg + 1u) * nx) xb_add(&bar[XB_TOPGEN], 1u);
            else XB_SPIN(xb_ld(&bar[XB_TOPGEN]) == tg, bar);
            __builtin_amdgcn_fence(__ATOMIC_ACQUIRE, "agent");
            xb_add(&bar[XB_XGEN(b.x)], 1u);
            asm volatile("s_waitcnt vmcnt(0)" ::: "memory");
        } else {
            XB_SPIN(xb_ld(&bar[XB_XGEN(b.x)]) == gen, bar);
            __builtin_amdgcn_fence(__ATOMIC_ACQUIRE, "agent");
            asm volatile("s_waitcnt vmcnt(0)" ::: "memory");
        }
    }
    __syncthreads();
}


#undef LAS

#ifndef SEQ
#define SEQ 8192
#endif
namespace sm {
constexpr int DM = 1024, NB = 1  , L = SEQ, T = NB * L, NCH = L / 64, MEM = 256;
constexpr int EV_IN = 4112, OD_IN = 5648, PROJ_LD = 5648;
constexpr int E_SCB = 0, E_SCC = 512, E_SCX = 1024, E_Z = 1536, E_XBC = 2560, E_DT = 4096;
constexpr int O_QKV = 0, O_Z = 3072, O_A = 4096, O_B = 4104, O_SQ = 4112, O_SK = 4624, O_SV = 5136;

struct Ctx {
    const float* in[33];
    float* out;
    float *memn, *kx, *vx, *h, *un, *rstd, *proj, *cat, *xbcc, *dtv, *acs, *states, *cb, *ybuf, *rstd2;
    float *q, *att, *sc;
    float *gatew, *act; int* eid;
    float *qkvc, *beta, *gcs, *Lm, *aqk, *uw, *S, *vn, *obuf;
};
enum In { I_X = 0, I_MEM, I_MEM_NORM, I_FINAL_NORM, I_NORM_MIX, I_NORM_XA, I_NORM_FFN, I_XA_WQ, I_XA_WK, I_XA_WV, I_XA_WO,
          I_MOE_WG, I_MOE_BG, I_MOE_WE, I_MOE_BE, I_MOE_WGATE, I_MOE_WUP, I_MOE_WDOWN,
          I_EV_WIN, I_EV_SCCONV, I_EV_CONVW, I_EV_CONVB, I_EV_DTB, I_EV_ALOG, I_EV_D, I_EV_NORM, I_EV_WOUT,
          I_OD_WIN, I_OD_CONV, I_OD_DTB, I_OD_ALOG, I_OD_NORM, I_OD_WOUT };

__device__ __forceinline__ float siluf(float x) { return x / (1.f + expf(-x)); }
__device__ __forceinline__ float softplusf(float x) { return x > 20.f ? x : log1pf(expf(x)); }
__device__ __forceinline__ float sigmoidf(float x) { return 1.f / (1.f + expf(-x)); }

__device__ __forceinline__ void s_copy(const float* src, float* dst, size_t n, size_t gid, size_t gs) { for (size_t i = gid; i < n; i += gs) dst[i] = src[i]; }
__device__ __forceinline__ void s_rstd(const float* x, int R, int W, int ld, float* rstd, size_t gid, size_t gs) {
    for (size_t r = gid; r < (size_t)R; r += gs) { const float* p = x + r * ld; float s = 0.f; for (int i = 0; i < W; ++i) s += p[i] * p[i]; rstd[r] = 1.f / sqrtf(s / W + 1e-6f); }
}
__device__ __forceinline__ void s_norm(const float* x, const float* rstd, const float* g, float* y, int R, size_t gid, size_t gs) {
    for (size_t i = gid; i < (size_t)R * DM; i += gs) { const size_t r = i / DM; const int c = (int)(i % DM); y[i] = x[i] * rstd[r] * g[c]; }
}
__device__ __forceinline__ void s_gemm(const float* A, int lda, const float* W, int ldw, float* C, int ldc, int M, int N, int K, int accum, size_t gid, size_t gs) {
    const int N4 = N / 4;
    for (size_t i = gid; i < (size_t)M * N4; i += gs) { const size_t m = i / N4; const int n = (int)(i % N4) * 4; const float* a = A + m * lda; const float* w = W + n; float s0 = 0.f, s1 = 0.f, s2 = 0.f, s3 = 0.f;
        for (int k = 0; k < K; ++k) { const float av = a[k]; const float4 wv = *(const float4*)(w + (size_t)k * ldw); s0 += av * wv.x; s1 += av * wv.y; s2 += av * wv.z; s3 += av * wv.w; }
        float4* c = (float4*)(C + m * ldc + n); float4 o = accum ? *c : float4{0.f, 0.f, 0.f, 0.f}; o.x += s0; o.y += s1; o.z += s2; o.w += s3; *c = o; }
}
__device__ __forceinline__ void s_scmix(const Ctx& c, size_t gid, size_t gs) {
    const float* w = c.in[I_EV_SCCONV];
    for (size_t i = gid; i < (size_t)T * 512; i += gs) { const size_t t = i / 512; const int ch = (int)(i % 512); const int tl = (int)(t % L); float s = 0.f;
        for (int j = 0; j < 3; ++j) { const int tt = tl - 2 + j; if (tt >= 0) { const float* p = c.proj + (t - 2 + j) * PROJ_LD; s += w[j * 512 + ch] * p[E_SCC + ch] * p[E_SCX + ch]; } }
        c.cat[t * 1536 + ch] = c.proj[t * PROJ_LD + E_SCB + ch] * s; }
}
__device__ __forceinline__ void s_ssd_conv(const Ctx& c, size_t gid, size_t gs) {
    const float* w = c.in[I_EV_CONVW]; const float* b = c.in[I_EV_CONVB];
    for (size_t i = gid; i < (size_t)T * 1536; i += gs) { const size_t t = i / 1536; const int ch = (int)(i % 1536); const int tl = (int)(t % L); float s = b[ch];
        for (int j = 0; j < 4; ++j) { const int tt = tl - 3 + j; if (tt >= 0) s += w[j * 1536 + ch] * c.proj[(t - 3 + j) * PROJ_LD + E_XBC + ch]; }
        c.xbcc[i] = siluf(s); }
}
__device__ __forceinline__ void s_ssd_dt(const Ctx& c, size_t gid, size_t gs) {
    for (size_t i = gid; i < (size_t)NB * NCH * 16; i += gs) { const int hd = (int)(i % 16); const size_t bc = i / 16; const float a = -expf(c.in[I_EV_ALOG][hd]); float cs = 0.f;
        for (int s = 0; s < 64; ++s) { const size_t t = bc * 64 + s; const float dt = softplusf(c.proj[t * PROJ_LD + E_DT + hd] + c.in[I_EV_DTB][hd]); cs += dt * a; c.dtv[t * 16 + hd] = dt; c.acs[t * 16 + hd] = cs; } }
}
__device__ __forceinline__ void s_ssd_states(const Ctx& c, size_t gid, size_t gs) {
    for (size_t i = gid; i < (size_t)NB * NCH * 16 * 64 * 128; i += gs) { const int n = (int)(i % 128); const int p = (int)((i / 128) % 64); const int hd = (int)((i / 8192) % 16); const size_t bc = i / (8192 * 16);
        const int g = hd / 8; const float last = c.acs[(bc * 64 + 63) * 16 + hd]; float s = 0.f;
        for (int k = 0; k < 64; ++k) { const size_t t = bc * 64 + k; s += c.xbcc[t * 1536 + 1024 + g * 128 + n] * c.xbcc[t * 1536 + hd * 64 + p] * c.dtv[t * 16 + hd] * expf(last - c.acs[t * 16 + hd]); }
        c.states[i] = s; }
}
__device__ __forceinline__ void s_ssd_scan(const Ctx& c, size_t gid, size_t gs) {
    for (size_t i = gid; i < (size_t)NB * 16 * 8192; i += gs) { const size_t b = i / (16 * 8192); const size_t r = i % (16 * 8192); const int hd = (int)(r / 8192); float s = 0.f;
        for (int ch = 0; ch < NCH; ++ch) { const size_t bc = b * NCH + ch; const size_t idx = bc * (16 * 8192) + r; const float st = c.states[idx]; c.states[idx] = s; s = s * expf(c.acs[(bc * 64 + 63) * 16 + hd]) + st; } }
}
__device__ __forceinline__ void s_ssd_cb(const Ctx& c, size_t gid, size_t gs) {
    for (size_t i = gid; i < (size_t)NB * NCH * 2 * 4096; i += gs) { const int s = (int)(i % 64); const int t = (int)((i / 64) % 64); const int g = (int)((i / 4096) % 2); const size_t bc = i / 8192;
        const float* cm = c.xbcc + (bc * 64 + t) * 1536 + 1280 + g * 128; const float* bm = c.xbcc + (bc * 64 + s) * 1536 + 1024 + g * 128; float a = 0.f;
        for (int n = 0; n < 128; ++n) a += cm[n] * bm[n];
        c.cb[i] = a; }
}
__device__ __forceinline__ void s_ssd_y(const Ctx& c, size_t gid, size_t gs) {
    for (size_t i = gid; i < (size_t)T * 1024; i += gs) { const size_t t = i / 1024; const int hp = (int)(i % 1024); const int hd = hp / 64, p = hp % 64, g = hd / 8; const size_t bc = t / 64; const int tl = (int)(t % 64);
        const float at = c.acs[t * 16 + hd]; float y = 0.f;
        for (int s = 0; s <= tl; ++s) { const size_t ts = bc * 64 + s; y += c.cb[(bc * 2 + g) * 4096 + tl * 64 + s] * expf(at - c.acs[ts * 16 + hd]) * c.xbcc[ts * 1536 + hp] * c.dtv[ts * 16 + hd]; }
        const float* cm = c.xbcc + t * 1536 + 1280 + g * 128; const float* pv = c.states + (bc * 16 + hd) * 8192 + p * 128; float yo = 0.f;
        for (int n = 0; n < 128; ++n) yo += cm[n] * pv[n];
        y += yo * expf(at) + c.xbcc[t * 1536 + hp] * c.in[I_EV_D][hd];
        c.ybuf[i] = y * siluf(c.proj[t * PROJ_LD + E_Z + hp]); }
}
__device__ __forceinline__ void s_ssd_out(const Ctx& c, size_t gid, size_t gs) {
    for (size_t i = gid; i < (size_t)T * 1024; i += gs) { const size_t t = i / 1024; const int ch = (int)(i % 1024); c.cat[t * 1536 + 512 + ch] = c.ybuf[i] * c.rstd2[t * 2 + ch / 512] * c.in[I_EV_NORM][ch]; }
}
__device__ __forceinline__ void s_xa_scores(const Ctx& c, size_t gid, size_t gs) {
    for (size_t i = gid; i < (size_t)T * 4 * 256; i += gs) { const int m = (int)(i % 256); const int hd = (int)((i / 256) % 4); const size_t t = i / 1024; const size_t b = t / L;
        const float* q = c.q + t * 1024 + hd * 256; const float* k = c.kx + (b * 256 + m) * 1024 + hd * 256; float s = 0.f;
        for (int d = 0; d < 256; ++d) s += q[d] * k[d];
        c.sc[i] = s * 0.0625f; }
}
__device__ __forceinline__ void s_xa_softmax(const Ctx& c, size_t gid, size_t gs) {
    for (size_t i = gid; i < (size_t)T * 4; i += gs) { float* p = c.sc + i * 256; float mx = p[0]; for (int m = 1; m < 256; ++m) mx = fmaxf(mx, p[m]); float s = 0.f; for (int m = 0; m < 256; ++m) { const float e = expf(p[m] - mx); p[m] = e; s += e; } const float r = 1.f / s; for (int m = 0; m < 256; ++m) p[m] *= r; }
}
__device__ __forceinline__ void s_xa_pv(const Ctx& c, size_t gid, size_t gs) {
    for (size_t i = gid; i < (size_t)T * 1024; i += gs) { const size_t t = i / 1024; const int col = (int)(i % 1024); const int hd = col / 256; const size_t b = t / L; const float* p = c.sc + (t * 4 + hd) * 256; const float* v = c.vx + b * 256 * 1024 + col; float s = 0.f;
        for (int m = 0; m < 256; ++m) s += p[m] * v[(size_t)m * 1024];
        c.att[i] = s; }
}
__device__ __forceinline__ void s_router(const Ctx& c, int l, size_t gid, size_t gs) {
    const float* wg = c.in[I_MOE_WG] + (size_t)l * 1024 * 4; const float* bg = c.in[I_MOE_BG] + l * 4; const float* we = c.in[I_MOE_WE] + (size_t)l * 1024 * 32; const float* be = c.in[I_MOE_BE] + l * 32;
    for (size_t t = gid; t < (size_t)T; t += gs) { const float* x = c.un + t * 1024; float g0 = 0.f, g1 = 0.f, g2 = 0.f, g3 = 0.f;
        for (int k = 0; k < 1024; ++k) { const float xv = x[k]; g0 += xv * wg[k * 4 + 0]; g1 += xv * wg[k * 4 + 1]; g2 += xv * wg[k * 4 + 2]; g3 += xv * wg[k * 4 + 3]; }
        g0 += bg[0]; g1 += bg[1]; g2 += bg[2]; g3 += bg[3];
        int gsel = 0; float gm = g0; if (g1 > gm) { gm = g1; gsel = 1; } if (g2 > gm) { gm = g2; gsel = 2; } if (g3 > gm) { gm = g3; gsel = 3; }
        const float gw = 1.f / (expf(g0 - gm) + expf(g1 - gm) + expf(g2 - gm) + expf(g3 - gm));
        float e0 = 0, e1 = 0, e2 = 0, e3 = 0, e4 = 0, e5 = 0, e6 = 0, e7 = 0; const float* w = we + gsel * 8;
        for (int k = 0; k < 1024; ++k) { const float xv = x[k]; const float* wk = w + k * 32; e0 += xv * wk[0]; e1 += xv * wk[1]; e2 += xv * wk[2]; e3 += xv * wk[3]; e4 += xv * wk[4]; e5 += xv * wk[5]; e6 += xv * wk[6]; e7 += xv * wk[7]; }
        const float* bb = be + gsel * 8; e0 += bb[0]; e1 += bb[1]; e2 += bb[2]; e3 += bb[3]; e4 += bb[4]; e5 += bb[5]; e6 += bb[6]; e7 += bb[7];
        int i1 = 0; float m1 = e0;
#define SM_T1(j, v) if (v > m1) { m1 = v; i1 = j; }
        SM_T1(1, e1) SM_T1(2, e2) SM_T1(3, e3) SM_T1(4, e4) SM_T1(5, e5) SM_T1(6, e6) SM_T1(7, e7)
        int i2 = -1; float m2 = -3.0e38f;
#define SM_T2(j, v) if (j != i1 && v > m2) { m2 = v; i2 = j; }
        SM_T2(0, e0) SM_T2(1, e1) SM_T2(2, e2) SM_T2(3, e3) SM_T2(4, e4) SM_T2(5, e5) SM_T2(6, e6) SM_T2(7, e7)
        const float r = expf(m2 - m1); const float w1 = gw / (1.f + r), w2 = gw * r / (1.f + r);
        c.eid[t * 2 + 0] = gsel * 8 + i1; c.eid[t * 2 + 1] = gsel * 8 + i2; c.gatew[t * 2 + 0] = w1; c.gatew[t * 2 + 1] = w2; }
}
__device__ __forceinline__ void s_moe_up(const Ctx& c, int l, size_t gid, size_t gs) {
    for (size_t i = gid; i < (size_t)T * 2 * 512; i += gs) { const int f = (int)(i % 512); const size_t tk = i / 512; const size_t t = tk / 2; const int e = c.eid[tk] & 31;
        const float* wg = c.in[I_MOE_WGATE] + ((size_t)l * 32 + e) * 1024 * 512 + f; const float* wu = c.in[I_MOE_WUP] + ((size_t)l * 32 + e) * 1024 * 512 + f; const float* x = c.un + t * 1024; float a = 0.f, b = 0.f;
        for (int k = 0; k < 1024; ++k) { a += x[k] * wg[(size_t)k * 512]; b += x[k] * wu[(size_t)k * 512]; }
        c.act[i] = siluf(a) * b; }
}
__device__ __forceinline__ void s_moe_down(const Ctx& c, int l, size_t gid, size_t gs) {
    for (size_t i = gid; i < (size_t)T * 1024; i += gs) { const size_t t = i / 1024; const int n = (int)(i % 1024); float y = 0.f;
        for (int k = 0; k < 2; ++k) { const int e = c.eid[t * 2 + k] & 31; const float* wd = c.in[I_MOE_WDOWN] + ((size_t)l * 32 + e) * 512 * 1024 + n; const float* a = c.act + (t * 2 + k) * 512; float s = 0.f;
            for (int f = 0; f < 512; ++f) s += a[f] * wd[(size_t)f * 1024];
            y += s * c.gatew[t * 2 + k]; }
        c.h[i] += y; }
}
__device__ __forceinline__ void s_gdn_conv(const Ctx& c, size_t gid, size_t gs) {
    const float* w = c.in[I_OD_CONV];
    for (size_t i = gid; i < (size_t)T * 3072; i += gs) { const size_t t = i / 3072; const int ch = (int)(i % 3072); const int tl = (int)(t % L); float s = 0.f;
        for (int j = 0; j < 4; ++j) { const int tt = tl - 3 + j; if (tt >= 0) s += w[j * 3072 + ch] * c.proj[(t - 3 + j) * PROJ_LD + O_QKV + ch]; }
        c.qkvc[i] = siluf(s); }
}
__device__ __forceinline__ void s_gdn_qkscale(const Ctx& c, size_t gid, size_t gs) {
    for (size_t i = gid; i < (size_t)T * 16; i += gs) { const size_t t = i / 16; const int wh = (int)(i % 16); float* p = c.qkvc + t * 3072 + wh * 128; float s = 0.f; for (int d = 0; d < 128; ++d) s += p[d] * p[d];
        float r = 1.f / sqrtf(s + 1e-6f); if (wh < 8) r *= 0.08838834764831845f; for (int d = 0; d < 128; ++d) p[d] *= r; }
}
__device__ __forceinline__ void s_gdn_gates(const Ctx& c, size_t gid, size_t gs) {
    for (size_t i = gid; i < (size_t)NB * NCH * 8; i += gs) { const int hd = (int)(i % 8); const size_t bc = i / 8; const float na = -expf(c.in[I_OD_ALOG][hd]); const float db = c.in[I_OD_DTB][hd]; float cs = 0.f;
        for (int s = 0; s < 64; ++s) { const size_t t = bc * 64 + s; cs += na * softplusf(c.proj[t * PROJ_LD + O_A + hd] + db); c.gcs[t * 8 + hd] = cs; c.beta[t * 8 + hd] = sigmoidf(c.proj[t * PROJ_LD + O_B + hd]); } }
}
__device__ __forceinline__ void s_gdn_kk(const Ctx& c, size_t gid, size_t gs) {
    for (size_t i = gid; i < (size_t)NB * NCH * 8 * 4096; i += gs) { const int s = (int)(i % 64); const int t = (int)((i / 64) % 64); const int hd = (int)((i / 4096) % 8); const size_t bc = i / (4096 * 8);
        float lv = 0.f, av = 0.f;
        if (s <= t) { const size_t tt = bc * 64 + t, ts = bc * 64 + s; const float* kt = c.qkvc + tt * 3072 + 1024 + hd * 128; const float* ks = c.qkvc + ts * 3072 + 1024 + hd * 128; const float* qt = c.qkvc + tt * 3072 + hd * 128; float kk = 0.f, qk = 0.f;
            for (int d = 0; d < 128; ++d) { kk += kt[d] * ks[d]; qk += qt[d] * ks[d]; }
            const float dec = expf(c.gcs[tt * 8 + hd] - c.gcs[ts * 8 + hd]); av = qk * dec; if (s < t) lv = kk * c.beta[tt * 8 + hd] * dec; }
        c.Lm[i] = lv; c.aqk[i] = av; }
}
__device__ __forceinline__ void s_gdn_solve(const Ctx& c, size_t gid, size_t gs) {
    for (size_t i = gid; i < (size_t)NB * NCH * 8 * 256; i += gs) { const int j = (int)(i % 256); const int hd = (int)((i / 256) % 8); const size_t bc = i / 2048; float* sol = c.uw + (bc * 8 + hd) * (64 * 256) + j; const float* Lp = c.Lm + (bc * 8 + hd) * 4096;
        for (int t = 0; t < 64; ++t) { const size_t tt = bc * 64 + t; const float bt = c.beta[tt * 8 + hd];
            float r = (j < 128) ? c.qkvc[tt * 3072 + 2048 + hd * 128 + j] * bt : c.qkvc[tt * 3072 + 1024 + hd * 128 + (j - 128)] * bt * expf(c.gcs[tt * 8 + hd]);
            for (int s = 0; s < t; ++s) r -= Lp[t * 64 + s] * sol[(size_t)s * 256];
            sol[(size_t)t * 256] = r; } }
}
__device__ __forceinline__ void s_gdn_scan(const Ctx& c, size_t gid, size_t gs) {
    for (size_t i = gid; i < (size_t)NB * 8 * 128; i += gs) { const int j = (int)(i % 128); const size_t bh = i / 128; const int hd = (int)(bh % 8); const size_t b = bh / 8; float* S = c.S + bh * 16384 + j; float* vn = c.vn + bh * 8192 + j;
        for (int d = 0; d < 128; ++d) S[(size_t)d * 128] = 0.f;
        for (int ch = 0; ch < NCH; ++ch) { const size_t bc = b * NCH + ch; const float* uw = c.uw + (bc * 8 + hd) * (64 * 256); const float* aq = c.aqk + (bc * 8 + hd) * 4096; const float glast = c.gcs[(bc * 64 + 63) * 8 + hd];
            for (int t = 0; t < 64; ++t) { float v = uw[t * 256 + j]; const float* w = uw + t * 256 + 128; for (int d = 0; d < 128; ++d) v -= w[d] * S[(size_t)d * 128]; vn[(size_t)t * 128] = v; }
            for (int t = 0; t < 64; ++t) { const size_t tt = bc * 64 + t; const float* q = c.qkvc + tt * 3072 + hd * 128; float o = 0.f; for (int d = 0; d < 128; ++d) o += q[d] * S[(size_t)d * 128];
                o *= expf(c.gcs[tt * 8 + hd]); for (int s = 0; s <= t; ++s) o += aq[t * 64 + s] * vn[(size_t)s * 128];
                c.obuf[tt * 1024 + hd * 128 + j] = o; }
            const float dl = expf(glast);
            for (int d = 0; d < 128; ++d) { float a = S[(size_t)d * 128] * dl; for (int t = 0; t < 64; ++t) { const size_t tt = bc * 64 + t; a += c.qkvc[tt * 3072 + 1024 + hd * 128 + d] * expf(glast - c.gcs[tt * 8 + hd]) * vn[(size_t)t * 128]; } S[(size_t)d * 128] = a; } } }
}
__device__ __forceinline__ void s_gdn_out(const Ctx& c, size_t gid, size_t gs) {
    for (size_t i = gid; i < (size_t)T * 1024; i += gs) { const size_t t = i / 1024; const int col = (int)(i % 1024); c.cat[t * 1536 + col] = c.obuf[i] * c.rstd2[t * 8 + col / 128] * c.in[I_OD_NORM][col % 128] * siluf(c.proj[t * PROJ_LD + O_Z + col]); }
}
__device__ __forceinline__ void s_sb(const Ctx& c, size_t gid, size_t gs) {
    for (size_t i = gid; i < (size_t)T * 32; i += gs) { const int qd = (int)(i % 4); const int hd = (int)((i / 4) % 8); const size_t t = i / 32; const int tl = (int)(t % L); const float* q = c.proj + t * PROJ_LD + O_SQ + hd * 64;
        float o[16];
#pragma unroll
        for (int d = 0; d < 16; ++d) o[d] = 0.f;
        float carry = 0.f;
        for (int s = tl - 1; s >= 0 && carry > -150.f; --s) { const size_t ts = t - (size_t)(tl - s); const float* k = c.proj + ts * PROJ_LD + O_SK + hd * 64; const float* v = c.proj + ts * PROJ_LD + O_SV + hd * 64 + qd * 16; float lg = 0.f;
            for (int d = 0; d < 64; ++d) lg += q[d] * k[d];
            lg *= 0.125f; const float wgt = expf(-softplusf(-lg) + carry); carry -= softplusf(lg);
#pragma unroll
            for (int d = 0; d < 16; ++d) o[d] += wgt * v[d]; }
#pragma unroll
        for (int d = 0; d < 16; ++d) c.cat[t * 1536 + 1024 + hd * 64 + qd * 16 + d] = o[d]; }
}
__device__ __forceinline__ void s_final(const Ctx& c, size_t gid, size_t gs) { s_norm(c.h, c.rstd, c.in[I_FINAL_NORM], c.out, T, gid, gs); }

constexpr int XA_BASE = 20, MOE_BASE = 30, L1_BASE = 40, NSTAGE_L = 60;
__device__ __forceinline__ bool run_stage(const Ctx& c, int st, size_t gid, size_t gs) {
    const int layer = st / NSTAGE_L, s = st % NSTAGE_L;
    if (st >= 2 * NSTAGE_L + 2) return false;
    if (st == 2 * NSTAGE_L) { s_rstd(c.h, T, DM, DM, c.rstd, gid, gs); return true; }
    if (st == 2 * NSTAGE_L + 1) { s_final(c, gid, gs); return true; }
    const int l = layer;
    switch (s) {
    case 0: if (l == 0) { s_copy(c.in[I_X], c.h, (size_t)T * DM, gid, gs); s_rstd(c.in[I_MEM], NB * MEM, DM, DM, c.rstd2, gid, gs); } break;
    case 1: if (l == 0) s_norm(c.in[I_MEM], c.rstd2, c.in[I_MEM_NORM], c.memn, NB * MEM, gid, gs); s_rstd(c.h, T, DM, DM, c.rstd, gid, gs); break;
    case 2: s_norm(c.h, c.rstd, c.in[I_NORM_MIX] + l * DM, c.un, T, gid, gs); break;
    case 3: if (l == 0) s_gemm(c.un, DM, c.in[I_EV_WIN], EV_IN, c.proj, PROJ_LD, T, EV_IN, DM, 0, gid, gs); else s_gemm(c.un, DM, c.in[I_OD_WIN], OD_IN, c.proj, PROJ_LD, T, OD_IN, DM, 0, gid, gs); break;
    case 4: if (l == 0) { s_scmix(c, gid, gs); s_ssd_conv(c, gid, gs); s_ssd_dt(c, gid, gs); } else { s_gdn_conv(c, gid, gs); s_gdn_gates(c, gid, gs); s_sb(c, gid, gs); } break;
    case 5: if (l == 0) { s_ssd_states(c, gid, gs); s_ssd_cb(c, gid, gs); } else s_gdn_qkscale(c, gid, gs); break;
    case 6: if (l == 0) s_ssd_scan(c, gid, gs); else s_gdn_kk(c, gid, gs); break;
    case 7: if (l == 0) s_ssd_y(c, gid, gs); else s_gdn_solve(c, gid, gs); break;
    case 8: if (l == 0) s_rstd(c.ybuf, T * 2, 512, 512, c.rstd2, gid, gs); else s_gdn_scan(c, gid, gs); break;
    case 9: if (l == 0) s_ssd_out(c, gid, gs); else s_rstd(c.obuf, T * 8, 128, 128, c.rstd2, gid, gs); break;
    case 10: if (l == 1) s_gdn_out(c, gid, gs); break;
    case 11: s_gemm(c.cat, 1536, l == 0 ? c.in[I_EV_WOUT] : c.in[I_OD_WOUT], DM, c.h, DM, T, DM, 1536, 1, gid, gs); break;
    case 12: s_rstd(c.h, T, DM, DM, c.rstd, gid, gs); break;
    case 13: s_norm(c.h, c.rstd, c.in[I_NORM_XA] + l * DM, c.un, T, gid, gs); break;
    case 14: s_gemm(c.un, DM, c.in[I_XA_WQ] + (size_t)l * DM * DM, DM, c.q, DM, T, DM, DM, 0, gid, gs);
             s_gemm(c.memn, DM, c.in[I_XA_WK] + (size_t)l * DM * DM, DM, c.kx, DM, NB * MEM, DM, DM, 0, gid, gs);
             s_gemm(c.memn, DM, c.in[I_XA_WV] + (size_t)l * DM * DM, DM, c.vx, DM, NB * MEM, DM, DM, 0, gid, gs); break;
    case 15: s_xa_scores(c, gid, gs); break;
    case 16: s_xa_softmax(c, gid, gs); break;
    case 17: s_xa_pv(c, gid, gs); break;
    case 18: s_gemm(c.att, DM, c.in[I_XA_WO] + (size_t)l * DM * DM, DM, c.h, DM, T, DM, DM, 1, gid, gs); break;
    case 19: s_rstd(c.h, T, DM, DM, c.rstd, gid, gs); break;
    case 20: s_norm(c.h, c.rstd, c.in[I_NORM_FFN] + l * DM, c.un, T, gid, gs); break;
    case 21: s_router(c, l, gid, gs); break;
    case 22: s_moe_up(c, l, gid, gs); break;
    case 23: s_moe_down(c, l, gid, gs); break;
    default: break;
    }
    return true;
}
constexpr int N_STAGES_USED = 24;

__host__ __device__ __forceinline__ size_t carve(Ctx& c, float* w) {
    size_t o = 0;
    auto take = [&](size_t n) { float* p = w + o; o += (n + 63) & ~(size_t)63; return p; };
    c.h = take((size_t)T * DM); c.rstd = take(T); c.rstd2 = take((size_t)T * 8); c.memn = take((size_t)MEM * DM); c.kx = take((size_t)MEM * DM); c.vx = take((size_t)MEM * DM);
    c.eid = (int*)take((size_t)T * 2); c.gatew = take((size_t)T * 2); c.dtv = take((size_t)T * 16); c.acs = take((size_t)T * 16); c.beta = take((size_t)T * 8); c.gcs = take((size_t)T * 8);
    c.S = take(8 * 16384); c.vn = take(8 * 8192);
    c.un = take((size_t)T * DM); c.ybuf = c.un; c.obuf = c.un;
    c.proj = take((size_t)T * PROJ_LD);
    c.cat = take((size_t)T * 1536);
    const size_t d0 = o;
    c.xbcc = take((size_t)T * 1536); c.states = take((size_t)NCH * 16 * 8192); c.cb = take((size_t)NCH * 2 * 4096); size_t dmax = o;
    o = d0; c.qkvc = take((size_t)T * 3072); c.Lm = take((size_t)NCH * 8 * 4096); c.aqk = take((size_t)NCH * 8 * 4096); c.uw = take((size_t)NCH * 8 * 64 * 256); if (o > dmax) dmax = o;
    o = d0; c.q = take((size_t)T * DM); c.sc = take((size_t)T * DM); c.att = take((size_t)T * DM); if (o > dmax) dmax = o;
    o = d0; c.act = take((size_t)T * 2 * 512); if (o > dmax) dmax = o;
    return dmax;
}
}

namespace pg8 {
#define PG8_LAS __attribute__((address_space(3)))
typedef unsigned short bf16_t;
typedef short bf16x8 __attribute__((ext_vector_type(8)));
typedef float f32x4 __attribute__((ext_vector_type(4)));
typedef unsigned u32x4 __attribute__((ext_vector_type(4)));
constexpr int BM = 256, BK = 64, HALF = 128, HTB = HALF * BK * 2  , STAGE_BYTES = 8 * HTB, NXCD = 8, WGM = 8;

__host__ __device__ __forceinline__ int lds_byte(int r, int c) { const int st = (r >> 4) * 2 + (c >> 5), rr = r & 15, cc = c & 31, ob = rr * 64 + cc * 2; return st * 1024 + (ob ^ (((ob >> 9) & 1) << 5)); }
__host__ __device__ __forceinline__ void stage_rc(int b, int& R, int& C) { const int st = b / 1024, sb = b % 1024, swz = sb ^ (((sb >> 9) & 1) << 5); R = (st >> 1) * 16 + swz / 64; C = (st & 1) * 32 + (swz % 64) / 2; }
__host__ __device__ __forceinline__ int perm32(int rho) { const int n = rho >> 4, i = rho & 15; return 8 * (i >> 2) + 4 * n + (i & 3); }

struct Unit { int pm, pn, tag; const char* a; const char* b; };
struct Gemm { const bf16_t* A; const bf16_t* Bt; int M, N, K; };

struct StaticOrder {
    static constexpr bool LIGHT = false;
    int nM, nN, nwg, G, c; const char* A; const char* B; size_t tstep;
    __host__ __device__ void init(const Gemm& g, int G_, int c_) { nM = g.M / BM; nN = g.N / BM; nwg = nM * nN; G = G_; c = c_; A = (const char*)g.A; B = (const char*)g.Bt; tstep = (size_t)BM * g.K * 2; }
    __host__ __device__ bool next(int i, Unit& u) const {
        const long L = (long)i * G + c; if (L >= nwg) return false;
        int wgid = (int)L; { const int q = nwg / NXCD, r = nwg % NXCD, xcd = wgid % NXCD, off = wgid / NXCD; wgid = (xcd < r ? xcd * (q + 1) : r * (q + 1) + (xcd - r) * q) + off; }
        const int nig = WGM * nN, gid = wgid / nig, fm = gid * WGM, gsz = (nM - fm) < WGM ? (nM - fm) : WGM;
        u.pm = fm + ((wgid % nig) % gsz); u.pn = (wgid % nig) / gsz; u.a = A + (size_t)u.pm * tstep; u.b = B + (size_t)u.pn * tstep; return true;
    }
    __device__ __forceinline__ void a_ready(const Unit&) const {}
    __device__ __forceinline__ void done(const Unit&) const {}
};

template <class Epi, class Sched, bool ALIGN_EPI = false, bool SP2 = false>
__device__ __forceinline__ void gemm_phase(PG8_LAS unsigned char* lds, const Gemm g, const Sched& S, const Epi& E, int wave_in) {
    int tid_ = threadIdx.x; asm volatile("" : "+v"(tid_));
    const int tid = tid_, wid = __builtin_amdgcn_readfirstlane(tid >> 6), lane = tid & 63, wr = wid >> 2, wc = wid & 3, fr = lane & 15, fq = lane >> 4;
    const int K = g.K, nt = K / BK;
    unsigned voffA[2], voffB[2];
#pragma unroll
    for (int i = 0; i < 2; ++i) { int R, C; stage_rc(tid * 16 + i * 8192, R, C); const int Rb = Epi::PERM ? ((R & ~31) + perm32(R & 31)) : R;
        voffA[i] = (unsigned)(R * K + C) * 2u; voffB[i] = (unsigned)(Rb * K + C) * 2u; }
    const size_t kstep = (size_t)(BK * 2);
    const size_t hstep = (size_t)HALF * K * 2;
    const unsigned ldsw = (unsigned)wid * 1024u;
    const int aoff = lds_byte(wr * 64 + fr, fq * 8), boff = lds_byte(wc * 32 + fr, fq * 8);
#define PG8_SA(b, h) (((b) * 2 + (h)) * HTB)
#define PG8_SB(b, h) ((4 + (b) * 2 + (h)) * HTB)
#define PG8_STAGE(bufoff, gbase, voff) do { _Pragma("unroll") for (int _i = 0; _i < 2; ++_i) \
        __builtin_amdgcn_global_load_lds((const unsigned*)((const char*)(gbase) + (voff)[_i]), (PG8_LAS unsigned*)(lds + (bufoff) + ldsw + _i * 8192), 16, 0, 0); } while (0)
#define PG8_LDA(dst, b, h) do { _Pragma("unroll") for (int m = 0; m < 4; ++m) _Pragma("unroll") for (int k = 0; k < 2; ++k) dst[m][k] = *(const PG8_LAS bf16x8*)(lds + PG8_SA(b, h) + aoff + m * 2048 + k * 1024); } while (0)
#define PG8_LDB(dst, b, h) do { _Pragma("unroll") for (int n = 0; n < 2; ++n) _Pragma("unroll") for (int k = 0; k < 2; ++k) dst[n][k] = *(const PG8_LAS bf16x8*)(lds + PG8_SB(b, h) + boff + n * 2048 + k * 1024); } while (0)
#define PG8_MMA(ai, bj, At, Bt) do { __builtin_amdgcn_s_setprio(1); _Pragma("unroll") for (int m = 0; m < 4; ++m) _Pragma("unroll") for (int n = 0; n < 2; ++n) _Pragma("unroll") for (int k = 0; k < 2; ++k) \
        acc[ai][bj][m][n] = __builtin_amdgcn_mfma_f32_16x16x32_bf16(Bt[n][k], At[m][k], acc[ai][bj][m][n], 0, 0, 0); __builtin_amdgcn_s_setprio(0); } while (0)
#define PG8_WAIT_V(n) asm volatile("s_waitcnt vmcnt(" #n ")" ::: "memory")
#define PG8_WAIT_L(n) asm volatile("s_waitcnt lgkmcnt(" #n ")" ::: "memory")
#define PG8_BAR __builtin_amdgcn_s_barrier()
#define PG8_SCHED __builtin_amdgcn_sched_barrier(0)
    Unit cur, nxt; int ui = 0;
    if (!S.next(0, cur)) return;
    f32x4 acc[2][2][4][2];
#pragma unroll
    for (int a = 0; a < 2; ++a)
#pragma unroll
        for (int b = 0; b < 2; ++b)
#pragma unroll
            for (int m = 0; m < 4; ++m)
#pragma unroll
                for (int n = 0; n < 2; ++n) acc[a][b][m][n] = (f32x4){0.f, 0.f, 0.f, 0.f};
    bf16x8 At[4][2], B0[2][2], B1[2][2];
    const char* cA = cur.a; const char* cB = cur.b;
    S.a_ready(cur);
    if constexpr (SP2) {
        PG8_STAGE(PG8_SB(0, 0), cB, voffB); PG8_STAGE(PG8_SB(0, 1), cB + hstep, voffB); PG8_STAGE(PG8_SA(0, 0), cA, voffA); PG8_STAGE(PG8_SA(0, 1), cA + hstep, voffA);
        if (wr == 1) PG8_BAR;
        PG8_WAIT_V(2); PG8_BAR;
        PG8_STAGE(PG8_SB(1, 0), cB + kstep, voffB); PG8_STAGE(PG8_SA(1, 0), cA + kstep, voffA); PG8_STAGE(PG8_SB(1, 1), cB + hstep + kstep, voffB);
        PG8_WAIT_V(6); PG8_BAR;
    } else {
        PG8_STAGE(PG8_SB(0, 0), cB, voffB); PG8_STAGE(PG8_SA(0, 0), cA, voffA); PG8_STAGE(PG8_SB(0, 1), cB + hstep, voffB); PG8_STAGE(PG8_SA(0, 1), cA + hstep, voffA);
        if (wr == 1) PG8_BAR;
        PG8_WAIT_V(4); PG8_BAR;
        PG8_STAGE(PG8_SB(1, 0), cB + kstep, voffB); PG8_STAGE(PG8_SA(1, 0), cA + kstep, voffA); PG8_STAGE(PG8_SB(1, 1), cB + hstep + kstep, voffB);
        PG8_WAIT_V(6); PG8_BAR;
    }
    for (;;) {
        const bool has_next = S.next(ui + 1, nxt);
        const char* nA = has_next ? nxt.a : cA; const char* nB = has_next ? nxt.b : cB;
        for (int t = 0; t < nt; t += 2) {
            const bool last = (t == nt - 2);
            const char* a1 = cA + (size_t)(t + 1) * kstep;
            const char* a2 = last ? nA : cA + (size_t)(t + 2) * kstep; const char* b2 = last ? nB : cB + (size_t)(t + 2) * kstep;
            const char* a3 = a2 + kstep; const char* b3 = b2 + kstep;
            if (last && has_next) S.a_ready(nxt);
            if constexpr (SP2) {
            PG8_LDB(B0, 0, 0); PG8_LDB(B1, 0, 1); PG8_SCHED; PG8_LDA(At, 0, 0); PG8_STAGE(PG8_SA(1, 1), a1 + hstep, voffA);
            PG8_WAIT_V(8); PG8_WAIT_L(0); PG8_BAR; PG8_MMA(0, 0, At, B0); PG8_MMA(0, 1, At, B1); PG8_BAR; PG8_SCHED;
            PG8_LDA(At, 0, 1); PG8_STAGE(PG8_SB(0, 0), b2, voffB); PG8_STAGE(PG8_SB(0, 1), b2 + hstep, voffB); PG8_STAGE(PG8_SA(0, 0), a2, voffA);
            PG8_WAIT_V(8); PG8_WAIT_L(0); PG8_BAR; if (!(Sched::LIGHT && (cur.tag & 1))) { PG8_MMA(1, 0, At, B0); PG8_MMA(1, 1, At, B1); } PG8_BAR; PG8_SCHED;
            PG8_LDB(B0, 1, 0); PG8_LDB(B1, 1, 1); PG8_SCHED; PG8_LDA(At, 1, 0); PG8_STAGE(PG8_SA(0, 1), a2 + hstep, voffA);
            PG8_WAIT_V(8); PG8_WAIT_L(0); PG8_BAR; PG8_MMA(0, 0, At, B0); PG8_MMA(0, 1, At, B1); PG8_BAR; PG8_SCHED;
            PG8_LDA(At, 1, 1); PG8_STAGE(PG8_SB(1, 0), b3, voffB); PG8_STAGE(PG8_SB(1, 1), b3 + hstep, voffB); PG8_STAGE(PG8_SA(1, 0), a3, voffA);
            PG8_WAIT_V(8); PG8_WAIT_L(0); PG8_BAR; if (!(Sched::LIGHT && (cur.tag & 1))) { PG8_MMA(1, 0, At, B0); PG8_MMA(1, 1, At, B1); } PG8_BAR; PG8_SCHED;
            } else {
            PG8_LDB(B0, 0, 0); PG8_SCHED; PG8_LDA(At, 0, 0); PG8_STAGE(PG8_SA(1, 1), a1 + hstep, voffA);
            PG8_WAIT_L(8); PG8_BAR; PG8_WAIT_L(0); PG8_MMA(0, 0, At, B0); PG8_BAR; PG8_SCHED;
            PG8_LDB(B1, 0, 1); PG8_STAGE(PG8_SB(0, 0), b2, voffB);
            PG8_BAR; PG8_WAIT_L(0); PG8_MMA(0, 1, At, B1); PG8_BAR;
            PG8_LDA(At, 0, 1); PG8_STAGE(PG8_SA(0, 0), a2, voffA);
            PG8_BAR; PG8_WAIT_L(0); PG8_MMA(1, 0, At, B0); PG8_BAR; PG8_SCHED;
            PG8_STAGE(PG8_SB(0, 1), b2 + hstep, voffB);
            PG8_WAIT_V(6); PG8_BAR; PG8_MMA(1, 1, At, B1); PG8_BAR;
            PG8_LDB(B0, 1, 0); PG8_SCHED; PG8_LDA(At, 1, 0); PG8_STAGE(PG8_SA(0, 1), a2 + hstep, voffA);
            PG8_WAIT_L(8); PG8_BAR; PG8_WAIT_L(0); PG8_MMA(0, 0, At, B0); PG8_BAR; PG8_SCHED;
            PG8_LDB(B1, 1, 1); PG8_STAGE(PG8_SB(1, 0), b3, voffB);
            PG8_BAR; PG8_WAIT_L(0); PG8_MMA(0, 1, At, B1); PG8_BAR;
            PG8_LDA(At, 1, 1); PG8_STAGE(PG8_SA(1, 0), a3, voffA);
            PG8_BAR; PG8_WAIT_L(0); PG8_MMA(1, 0, At, B0); PG8_BAR; PG8_SCHED;
            PG8_STAGE(PG8_SB(1, 1), b3 + hstep, voffB);
            PG8_WAIT_V(6); PG8_BAR; PG8_MMA(1, 1, At, B1); PG8_BAR;
            }
        }
        if constexpr (ALIGN_EPI) { if (wr == 0) PG8_BAR; }
        if constexpr (!Epi::AFTER_DRAIN) { E(acc, cur, wr, wc, fr, fq); S.done(cur); }
        if (!has_next) break;
#pragma unroll
        for (int a = 0; a < 2; ++a)
#pragma unroll
            for (int b = 0; b < 2; ++b)
#pragma unroll
                for (int m = 0; m < 4; ++m)
#pragma unroll
                    for (int n = 0; n < 2; ++n) acc[a][b][m][n] = (f32x4){0.f, 0.f, 0.f, 0.f};
        cur = nxt; cA = nA; cB = nB; ++ui;
        if constexpr (ALIGN_EPI) { if (wr == 1) PG8_BAR; }
    }
    PG8_WAIT_V(0);
    if constexpr (!ALIGN_EPI) { if (wr == 0) PG8_BAR; }
    PG8_BAR;
    if constexpr (Epi::AFTER_DRAIN) { E.fused(acc, cur, wr, wc, fr, fq, lds, wid, lane); S.done(cur); }
#undef PG8_SA
#undef PG8_SB
#undef PG8_STAGE
#undef PG8_LDA
#undef PG8_LDB
#undef PG8_MMA
#undef PG8_WAIT_V
#undef PG8_WAIT_L
#undef PG8_BAR
#undef PG8_SCHED
}
}

namespace ok {
using pg8::bf16_t; using pg8::bf16x8; using pg8::f32x4; using pg8::u32x4;
typedef unsigned u32x2 __attribute__((ext_vector_type(2)));
typedef float f32x2 __attribute__((ext_vector_type(2)));
#ifndef SEQ
#define SEQ 8192
#endif
constexpr int NB = 2, L = SEQ, NCH = L / 64, T = NB * L, DM = 1024, NWAVES = 8, NT = 512;
constexpr float EPS = 1e-6f, LOG2E = 1.4426950408889634f;
constexpr size_t MiB = 1u << 20, KiB = 1024;
constexpr size_t WS_CTL = 0, CTL_BYTES = 1 * MiB;
constexpr int CW_BAR = 0;
constexpr int CW_SSQ = 16384;
constexpr int CW_MOE = 16384 + 6 * T;
constexpr int CW_CHK = CW_MOE + 256;
static_assert((CW_CHK + 64) * 4 <= (int)CTL_BYTES, "ctl");
constexpr size_t WS_WDT = 1 * MiB, WS_WAB = WS_WDT + 64 * KiB, WS_WR = WS_WAB + 64 * KiB;
constexpr size_t WS_DTV = 2 * MiB, WS_ACS = 3 * MiB, WS_GCS = 4 * MiB, WS_BETA = 4 * MiB + 512 * KiB;
constexpr size_t WS_RAW16 = WS_DTV;
constexpr size_t WS_EID = 5 * MiB, WS_GATEW = WS_EID + 128 * KiB, WS_TOKSLOT = WS_GATEW + 128 * KiB, WS_SLOTTOK = WS_TOKSLOT + 128 * KiB, WS_SLOTGATE = WS_SLOTTOK + 160 * KiB,
                 WS_SLOTRSTD = WS_SLOTGATE + 160 * KiB, WS_TILEEXP = WS_SLOTRSTD + 160 * KiB;
constexpr size_t WS_FP = 8 * MiB;
constexpr size_t WS_W_IN0 = 16 * MiB, WS_W_IN1 = 24 * MiB, WS_W_OUT0 = 35 * MiB, WS_W_OUT1 = 38 * MiB, WS_W_XA = 41 * MiB  ;
constexpr size_t WS_MEMNB = 57 * MiB, WS_KX = 58 * MiB  , WS_VT = 60 * MiB  ;
constexpr size_t WS_H = 64 * MiB, WS_HB = 128 * MiB, WS_MOEW = 160 * MiB, WS_BIG = 256 * MiB;
constexpr size_t WS_PROJ = WS_BIG;
constexpr size_t WS_CAT0 = 384 * MiB, WS_STATES = 432 * MiB;
constexpr size_t WS_CAT1 = 432 * MiB;
constexpr size_t WS_Q = WS_BIG, WS_ATT = WS_BIG + 32 * MiB;
constexpr size_t WS_XS = WS_BIG, WS_ACT = WS_BIG + 80 * MiB, WS_Y = WS_BIG + 120 * MiB;
constexpr size_t WS_END = 528 * MiB;
constexpr int PROJ0_LD = 4096, PROJ1_LD = 5632, MAXSLOT = 40960;

#ifdef CPU_EMU
__device__ __forceinline__ float fexp(float x) { return expf(x); }
__device__ __forceinline__ float fexp2(float x) { return exp2f(x); }
__device__ __forceinline__ float frcp(float x) { return 1.f / x; }
__device__ __forceinline__ float frsq(float x) { return 1.f / sqrtf(x); }
#else
__device__ __forceinline__ float fexp(float x) { return __builtin_amdgcn_exp2f(x * 1.4426950408889634f); }
__device__ __forceinline__ float fexp2(float x) { return __builtin_amdgcn_exp2f(x); }
__device__ __forceinline__ float frcp(float x) { return __builtin_amdgcn_rcpf(x); }
__device__ __forceinline__ float frsq(float x) { return __builtin_amdgcn_rsqf(x); }
#endif
#ifdef CPU_EMU
#define LAS
#define GAS
#define LDS_WAIT() do {} while (0)
#define WAVE_SYNC() ((void)__shfl(0, 0))
#define MEM_FENCE() do {} while (0)
#define PIN16(a) do {} while (0)
#define LDS_BARRIER() __syncthreads()
#define SCHED_FENCE() do {} while (0)
__device__ __forceinline__ unsigned cvt_pk_bf16(float lo, float hi) { return emu_f2bf(lo) | (emu_f2bf(hi) << 16); }
#else
#define LAS __attribute__((address_space(3)))
#define GAS __attribute__((address_space(1)))
#define LDS_WAIT() asm volatile("s_waitcnt lgkmcnt(0)" ::: "memory")
#define LDS_BARRIER() do { asm volatile("s_waitcnt lgkmcnt(0)" ::: "memory"); __builtin_amdgcn_s_barrier(); asm volatile("" ::: "memory"); } while (0)
#define MEM_FENCE() asm volatile("" ::: "memory")
#define PIN16(a) asm volatile("" : "+v"(a[0]), "+v"(a[1]), "+v"(a[2]), "+v"(a[3]), "+v"(a[4]), "+v"(a[5]), "+v"(a[6]), "+v"(a[7]), "+v"(a[8]), "+v"(a[9]), "+v"(a[10]), "+v"(a[11]), "+v"(a[12]), "+v"(a[13]), "+v"(a[14]), "+v"(a[15]) :: "memory")
#define SCHED_FENCE() __builtin_amdgcn_sched_barrier(0)
#define WAVE_SYNC() do { asm volatile("s_waitcnt lgkmcnt(0)" ::: "memory"); __builtin_amdgcn_wave_barrier(); } while (0)
typedef __bf16 hwbf16x2 __attribute__((ext_vector_type(2)));
__device__ __forceinline__ unsigned cvt_pk_bf16(float lo, float hi) { const f32x2 v = {lo, hi}; return __builtin_bit_cast(unsigned, __builtin_convertvector(v, hwbf16x2)); }
#endif
__device__ __forceinline__ float bf2f(unsigned short b) { return __uint_as_float(((unsigned)b) << 16); }
__device__ __forceinline__ float bflo(unsigned w) { return __uint_as_float(w << 16); }
__device__ __forceinline__ float bfhi(unsigned w) { return __uint_as_float(w & 0xffff0000u); }
__device__ __forceinline__ float wave_sum(float v) {
#pragma unroll
    for (int o = 1; o < 64; o <<= 1) v += __shfl_xor(v, o);
    return v;
}
__device__ __forceinline__ f32x4 mfma16(bf16x8 a, bf16x8 b, f32x4 c) { return __builtin_amdgcn_mfma_f32_16x16x32_bf16(a, b, c, 0, 0, 0); }

struct Frame {
    LAS unsigned char* lds;
    unsigned* ctl;
    unsigned char* ws;
    const float* const* in;
    float* out;
    int tid, lane, wave, vcu, G;
};
constexpr size_t WS_SSQP1 = 6 * MiB, WS_SSQP2 = 7 * MiB, WS_SSQP4 = 62 * MiB, WS_SSQP5 = 63 * MiB;
__device__ __forceinline__ float rstd_np(const float* p, int np, int row) { float s; if (np == 1) s = p[row]; else { const f32x4* q = (const f32x4*)(p + (size_t)row * 16); const f32x4 a = q[0], b = q[1], c = q[2], d = q[3]; s = ((a.x + a.y) + (a.z + a.w)) + ((b.x + b.y) + (b.z + b.w)) + (((c.x + c.y) + (c.z + c.w)) + ((d.x + d.y) + (d.z + d.w))); }
    return frsq(s * (1.f / 1024.f) + EPS); }
__device__ __forceinline__ void rstd_rows8(const float* p, int np, int row0, int fq, float (&out)[2][4]) {
    if (np == 1) { float s[2][4];
#pragma unroll
        for (int ai = 0; ai < 2; ++ai)
#pragma unroll
            for (int m = 0; m < 4; ++m) s[ai][m] = p[row0 + ai * 128 + m * 16];
        SCHED_FENCE();
#pragma unroll
        for (int ai = 0; ai < 2; ++ai)
#pragma unroll
            for (int m = 0; m < 4; ++m) out[ai][m] = frsq(s[ai][m] * (1.f / 1024.f) + EPS); }
    else { f32x4 a[2][4];
#pragma unroll
        for (int ai = 0; ai < 2; ++ai)
#pragma unroll
            for (int m = 0; m < 4; ++m) a[ai][m] = *(const f32x4*)(p + (size_t)(row0 + ai * 128 + m * 16) * 16 + fq * 4);
        SCHED_FENCE();
#pragma unroll
        for (int ai = 0; ai < 2; ++ai)
#pragma unroll
            for (int m = 0; m < 4; ++m) { float s = (a[ai][m].x + a[ai][m].y) + (a[ai][m].z + a[ai][m].w); s += __shfl_xor(s, 16); s += __shfl_xor(s, 32); out[ai][m] = frsq(s * (1.f / 1024.f) + EPS); } }
}
#ifndef CPU_EMU
__device__ __forceinline__ int shfl_src(int v, int src) { return __builtin_amdgcn_ds_bpermute(src << 2, v); }
#else
inline int shfl_src(int v, int src) { return emu::shfl_idx(v, src); }
#endif
#define OKP(type, off) ((type*)(F.ws + (off)))
#ifdef CPU_EMU
__device__ __forceinline__ Frame phase_frame(const Frame& F0) { return F0; }
#else
__device__ __forceinline__ Frame phase_frame(const Frame& F0) { Frame F = F0; int t = threadIdx.x; asm volatile("" : "+v"(t)); F.tid = t; F.lane = t & 63; F.wave = __builtin_amdgcn_readfirstlane(t >> 6); return F; }
#endif

struct CvtJob { const float* W; int ldw, K, ncols, c0; bf16_t* WT; int drow0, dstep16; const float* kgain; float cscale; };
__device__ __forceinline__ int job_items(const CvtJob& j) { return (j.K / 64) * (j.ncols / 32); }
struct CvtRegs { float wv[32]; f32x4 g0, g1; };
__device__ __forceinline__ void cvt_load(CvtRegs& r, const CvtJob& j, int item, int lane) {
    const int nblk = j.ncols / 32, kb = item / nblk, nb = item % nblk, k0 = 64 * kb, c0 = j.c0 + 32 * nb;
#pragma unroll
    for (int i = 0; i < 32; ++i) r.wv[i] = j.W[(size_t)(k0 + 2 * i + (lane >> 5)) * j.ldw + c0 + (lane & 31)];
    if (j.kgain) { const f32x4* gp = (const f32x4*)(j.kgain + k0 + 8 * (lane & 7)); r.g0 = gp[0]; r.g1 = gp[1]; } else { r.g0 = (f32x4){1.f, 1.f, 1.f, 1.f}; r.g1 = r.g0; }
}
__device__ __forceinline__ void cvt_finish(const CvtRegs& r, const CvtJob& j, int item, LAS float* scr, int lane) {
    const int nblk = j.ncols / 32, kb = item / nblk, nb = item % nblk, k0 = 64 * kb, drow0 = j.drow0 + (32 * nb >> 4) * j.dstep16;
#pragma unroll
    for (int i = 0; i < 32; ++i) { const int kk = 2 * i + (lane >> 5); scr[kk * 33 + (lane & 31)] = r.wv[i]; }
    const f32x4 ga = r.g0 * j.cscale, gb = r.g1 * j.cscale;
    WAVE_SYNC();
    const int c = lane & 7;
#pragma unroll
    for (int jj = 0; jj < 4; ++jj) { const int n = (lane >> 3) + 8 * jj; const LAS float* s = scr + (8 * c) * 33 + n;
        u32x4 o; o.x = cvt_pk_bf16(s[0 * 33] * ga[0], s[1 * 33] * ga[1]); o.y = cvt_pk_bf16(s[2 * 33] * ga[2], s[3 * 33] * ga[3]); o.z = cvt_pk_bf16(s[4 * 33] * gb[0], s[5 * 33] * gb[1]); o.w = cvt_pk_bf16(s[6 * 33] * gb[2], s[7 * 33] * gb[3]);
        *(u32x4*)(j.WT + (size_t)(drow0 + (n >> 4) * j.dstep16 + (n & 15)) * j.K + k0 + 8 * c) = o; }
    WAVE_SYNC();
}
__device__ __forceinline__ CvtJob dense_job(const Frame& F, int j) {
    using namespace sm;
    const float* const* in = F.in;
    switch (j) {
    case 0: return CvtJob{in[I_EV_WIN], 4112, 1024, 4096, 0, OKP(bf16_t, WS_W_IN0), 0, 16, in[I_NORM_MIX], 1.f};
    case 1: return CvtJob{in[I_OD_WIN], 5648, 1024, 4096, 0, OKP(bf16_t, WS_W_IN1), 0, 16, in[I_NORM_MIX] + 1024, 1.f};
    case 2: return CvtJob{in[I_OD_WIN], 5648, 1024, 512, 4112, OKP(bf16_t, WS_W_IN1), 4096, 16, in[I_NORM_MIX] + 1024, 0.125f * LOG2E};
    case 3: return CvtJob{in[I_OD_WIN], 5648, 1024, 1024, 4624, OKP(bf16_t, WS_W_IN1), 4608, 16, in[I_NORM_MIX] + 1024, 1.f};
    case 4: return CvtJob{in[I_EV_WOUT], 1024, 1536, 1024, 0, OKP(bf16_t, WS_W_OUT0), 0, 16, nullptr, 1.f};
    case 5: return CvtJob{in[I_OD_WOUT], 1024, 1536, 1024, 0, OKP(bf16_t, WS_W_OUT1), 0, 16, nullptr, 1.f};
    default: { const int l = (j - 6) / 4, w = (j - 6) % 4; bf16_t* dst = OKP(bf16_t, WS_W_XA + (size_t)l * 8 * MiB + (size_t)w * 2 * MiB);
        const float* src = in[I_XA_WQ + w] + (size_t)l * 1024 * 1024;
        if (w == 0) return CvtJob{src, 1024, 1024, 1024, 0, dst, 0, 16, in[I_NORM_XA] + l * 1024, 0.0625f * LOG2E};
        return CvtJob{src, 1024, 1024, 1024, 0, dst, 0, 16, nullptr, 1.f}; }
    }
}
constexpr int N_DENSE_JOBS = 14;
__device__ __forceinline__ CvtJob moe_job(const Frame& F, int l, int j) {
    using namespace sm;
    const int e = j / 3, w = j % 3; const float* const* in = F.in;
    bf16_t* gu = OKP(bf16_t, WS_MOEW + (size_t)e * 3 * MiB); bf16_t* dn = gu + 1024 * 1024;
    if (w == 0) return CvtJob{in[I_MOE_WGATE] + ((size_t)l * 32 + e) * 1024 * 512, 512, 1024, 512, 0, gu, 0, 32, in[I_NORM_FFN] + l * 1024, 1.f};
    if (w == 1) return CvtJob{in[I_MOE_WUP] + ((size_t)l * 32 + e) * 1024 * 512, 512, 1024, 512, 0, gu, 16, 32, in[I_NORM_FFN] + l * 1024, 1.f};
    return CvtJob{in[I_MOE_WDOWN] + ((size_t)l * 32 + e) * 512 * 1024, 1024, 512, 1024, 0, dn, 0, 16, nullptr, 1.f};
}
__device__ __forceinline__ int dense_total(const Frame& F) { int n = 0; for (int j = 0; j < N_DENSE_JOBS; ++j) n += job_items(dense_job(F, j)); return n; }
__device__ __forceinline__ void dense_item(const Frame& F, int idx, CvtJob& job, int& item) {
    for (int j = 0; j < N_DENSE_JOBS; ++j) { const CvtJob jb = dense_job(F, j); const int n = job_items(jb); job = jb; item = idx < n ? idx : n - 1; if (idx < n) return; idx -= n; }
}
__device__ __forceinline__ void phase_cvt_dense(const Frame& F0) {
    const Frame F = phase_frame(F0);
    LAS float* scr = (LAS float*)(F.lds + F.wave * 16384);
    const int gw = F.vcu * NWAVES + F.wave, NGW = F.G * NWAVES, N = dense_total(F);
    CvtRegs ra, rb;
    auto LD = [&](CvtRegs& r, int idx) { CvtJob jb; int it; dense_item(F, idx < N ? idx : N - 1, jb, it); cvt_load(r, jb, it, F.lane); };
    auto FN = [&](const CvtRegs& r, int idx) { if (idx < N) { CvtJob jb; int it; dense_item(F, idx, jb, it); cvt_finish(r, jb, it, scr, F.lane); } };
    LD(ra, gw);
    for (int idx = gw; idx < N; idx += 2 * NGW) { LD(rb, idx + NGW); FN(ra, idx); LD(ra, idx + 2 * NGW); FN(rb, idx + NGW); }
}
__device__ __forceinline__ void phase_cvt_moe(const Frame& F0, int l) {
    const Frame F = phase_frame(F0);
    LAS float* scr = (LAS float*)(F.lds + F.wave * 16384);
    const int gw = F.vcu * NWAVES + F.wave, NGW = F.G * NWAVES; constexpr int N = 96 * 256;
    CvtRegs ra, rb;
    auto LD = [&](CvtRegs& r, int idx) { const int ii = idx < N ? idx : N - 1; const CvtJob jb = moe_job(F, l, ii >> 8); cvt_load(r, jb, ii & 255, F.lane); };
    auto FN = [&](const CvtRegs& r, int idx) { if (idx < N) { const CvtJob jb = moe_job(F, l, idx >> 8); cvt_finish(r, jb, idx & 255, scr, F.lane); } };
    LD(ra, gw);
    for (int idx = gw; idx < N; idx += 2 * NGW) { LD(rb, idx + NGW); FN(ra, idx); LD(ra, idx + 2 * NGW); FN(rb, idx + NGW); }
}
__device__ __forceinline__ void row_to_bf16_ssq(const float* xrow, bf16_t* orow, float* ssq, int lane) {
    const f32x4* xr = (const f32x4*)xrow + lane; float s = 0.f; f32x4 v[4];
#pragma unroll
    for (int j = 0; j < 4; ++j) { v[j] = xr[64 * j]; s += (v[j].x * v[j].x + v[j].y * v[j].y) + (v[j].z * v[j].z + v[j].w * v[j].w); }
    s = wave_sum(s);
    u32x2* o8 = (u32x2*)orow + lane;
#pragma unroll
    for (int j = 0; j < 4; ++j) { u32x2 w; w.x = cvt_pk_bf16(v[j].x, v[j].y); w.y = cvt_pk_bf16(v[j].z, v[j].w); o8[64 * j] = w; }
    if (lane == 0) *ssq = s;
}
__device__ __forceinline__ void phase_prologue(const Frame& F0) {
    const Frame F = phase_frame(F0);
    using namespace sm;
    phase_cvt_dense(F0);
    const int gw = F.vcu * NWAVES + F.wave, NGW = F.G * NWAVES;
    float* ssq0 = (float*)F.ctl + CW_SSQ;
    for (int m = gw; m < T; m += NGW) row_to_bf16_ssq(F.in[I_X] + (size_t)m * DM, OKP(bf16_t, WS_HB) + (size_t)m * DM, ssq0 + m, F.lane);
    for (int m = gw; m < NB * 256; m += NGW) { const f32x4* xr = (const f32x4*)(F.in[I_MEM] + (size_t)m * DM) + F.lane; const f32x4* gr = (const f32x4*)F.in[I_MEM_NORM] + F.lane; float s = 0.f; f32x4 v[4];
#pragma unroll
        for (int j = 0; j < 4; ++j) { v[j] = xr[64 * j]; s += (v[j].x * v[j].x + v[j].y * v[j].y) + (v[j].z * v[j].z + v[j].w * v[j].w); }
        const float r = 1.f / sqrtf(wave_sum(s) * (1.f / DM) + EPS);
        u32x2* o8 = (u32x2*)(OKP(bf16_t, WS_MEMNB) + (size_t)m * DM) + F.lane;
#pragma unroll
        for (int j = 0; j < 4; ++j) { const f32x4 g = gr[64 * j]; u32x2 w; w.x = cvt_pk_bf16(v[j].x * r * g.x, v[j].y * r * g.y); w.y = cvt_pk_bf16(v[j].z * r * g.z, v[j].w * r * g.w); o8[64 * j] = w; } }
    const size_t gt = (size_t)F.vcu * NT + F.tid, GT = (size_t)F.G * NT;
    for (size_t i = gt; i < 1024 * 16; i += GT) { const int k = (int)(i >> 4), j = (int)(i & 15);
        OKP(float, WS_WDT)[j * 1024 + k] = F.in[I_NORM_MIX][k] * F.in[I_EV_WIN][(size_t)k * 4112 + 4096 + j];
        OKP(float, WS_WAB)[j * 1024 + k] = F.in[I_NORM_MIX][1024 + k] * F.in[I_OD_WIN][(size_t)k * 5648 + 4096 + j]; }
}

#ifndef CPU_EMU
struct EpiScaleBf16 {
    static constexpr bool PERM = true, AFTER_DRAIN = false;
    bf16_t* O; int ldc; const float* ssq; int np;
    __device__ __forceinline__ void operator()(const f32x4 (&acc)[2][2][4][2], const pg8::Unit& u, int wr, int wc, int fr, int fq) const {
        const int row0 = u.pm * 256 + wr * 64 + fr, col0 = u.pn * 256 + wc * 32 + 8 * fq;
        float rs8[2][4];
        if (ssq) rstd_rows8(ssq, np, row0, fq, rs8); else {
#pragma unroll
            for (int i = 0; i < 8; ++i) rs8[i >> 2][i & 3] = 1.f; }
#pragma unroll
        for (int ai = 0; ai < 2; ++ai)
#pragma unroll
            for (int m = 0; m < 4; ++m) { const int row = row0 + ai * 128 + m * 16; const float s = rs8[ai][m]; bf16_t* rowp = O + (size_t)row * ldc + col0;
#pragma unroll
                for (int bj = 0; bj < 2; ++bj) { const f32x4 v0 = acc[ai][bj][m][0] * s, v1 = acc[ai][bj][m][1] * s; u32x4 w; w.x = cvt_pk_bf16(v0[0], v0[1]); w.y = cvt_pk_bf16(v0[2], v0[3]); w.z = cvt_pk_bf16(v1[0], v1[1]); w.w = cvt_pk_bf16(v1[2], v1[3]);
                    *(u32x4*)(rowp + bj * 128) = w; } }
    }
};
template <bool HIN_F32> struct EpiResidualT {
    static constexpr bool PERM = false, AFTER_DRAIN = false;
    const float* hin; bf16_t* hb; float* ssq;
    __device__ __forceinline__ void operator()(const f32x4 (&acc)[2][2][4][2], const pg8::Unit& u, int wr, int wc, int fr, int fq) const {
        const int row0 = u.pm * 256 + wr * 64 + fr, col0 = u.pn * 256 + wc * 32 + 4 * fq;
#pragma unroll
        for (int ai = 0; ai < 2; ++ai) {
            f32x4 hf[HIN_F32 ? 4 : 1][2][2]; u32x2 hw2[HIN_F32 ? 1 : 4][2][2];
#pragma unroll
            for (int m = 0; m < 4; ++m)
#pragma unroll
                for (int bj = 0; bj < 2; ++bj)
#pragma unroll
                    for (int n = 0; n < 2; ++n) { const size_t o = (size_t)(row0 + ai * 128 + m * 16) * DM + col0 + bj * 128 + n * 16;
                        if (HIN_F32) hf[HIN_F32 ? m : 0][bj][n] = *(const f32x4*)(hin + o); else hw2[HIN_F32 ? 0 : m][bj][n] = *(const u32x2*)(hb + o); }
            SCHED_FENCE();
#pragma unroll
            for (int m = 0; m < 4; ++m) { const int row = row0 + ai * 128 + m * 16; const size_t ro = (size_t)row * DM + col0; float s = 0.f;
#pragma unroll
                for (int bj = 0; bj < 2; ++bj)
#pragma unroll
                    for (int n = 0; n < 2; ++n) { const size_t o = ro + bj * 128 + n * 16; f32x4 v;
                        if (HIN_F32) v = hf[HIN_F32 ? m : 0][bj][n]; else { const u32x2 hw = hw2[HIN_F32 ? 0 : m][bj][n]; v = (f32x4){bflo(hw.x), bfhi(hw.x), bflo(hw.y), bfhi(hw.y)}; }
                        v += acc[ai][bj][m][n];
                        u32x2 w; w.x = cvt_pk_bf16(v[0], v[1]); w.y = cvt_pk_bf16(v[2], v[3]); *(u32x2*)(hb + o) = w;
                        const float r0 = bflo(w.x), r1 = bfhi(w.x), r2 = bflo(w.y), r3 = bfhi(w.y); s += (r0 * r0 + r1 * r1) + (r2 * r2 + r3 * r3); }
                s += __shfl_xor(s, 16); s += __shfl_xor(s, 32);
                if (fq == 0) ssq[(size_t)row * 16 + u.pn * 4 + wc] = s; } }
    }
};

template <class Epi> __device__ __forceinline__ void dense_gemm(const Frame& F, const bf16_t* A, const bf16_t* Bt, int M, int N, int K, const Epi& E) {
    pg8::Gemm g{A, Bt, M, N, K}; pg8::StaticOrder S; S.init(g, F.G, (int)blockIdx.x);
    pg8::gemm_phase<Epi, pg8::StaticOrder, true, true>(F.lds, g, S, E, F.wave);
}
#endif
}

namespace ok {
constexpr int XT_LD = 72;
constexpr int BC_LD = 136;
__device__ __forceinline__ float siluf(float x) { return x * frcp(1.f + fexp(-x)); }
__device__ __forceinline__ float softplusf(float x) { return x > 20.f ? x : log1pf(expf(x)); }

template <class Sink> __device__ __forceinline__ void ssd_conv_pair(const Frame& F, int b, int c, int xc, Sink&& sink) {
    using namespace sm;
    const float* cw = F.in[I_EV_CONVW]; const f32x2 w0 = *(const f32x2*)(cw + xc), w1 = *(const f32x2*)(cw + 1536 + xc), w2 = *(const f32x2*)(cw + 3072 + xc), w3 = *(const f32x2*)(cw + 4608 + xc), bias = *(const f32x2*)(F.in[I_EV_CONVB] + xc);
    const bf16_t* p = OKP(bf16_t, WS_PROJ) + (size_t)(b * L + c * 64) * PROJ0_LD + 2560 + xc;
    unsigned raw[64];
#pragma unroll
    for (int t = 0; t < 64; ++t) raw[t] = *(const unsigned*)(p + (size_t)t * PROJ0_LD);
    const int hv = c > 0 ? 1 : 0; const unsigned a = *(const unsigned*)(p - 3 * PROJ0_LD * hv), bq = *(const unsigned*)(p - 2 * PROJ0_LD * hv), cq = *(const unsigned*)(p - PROJ0_LD * hv);
    SCHED_FENCE();
    f32x2 x0 = {0.f, 0.f}, x1 = x0, x2 = x0;
    if (hv) { x0 = (f32x2){bflo(a), bfhi(a)}; x1 = (f32x2){bflo(bq), bfhi(bq)}; x2 = (f32x2){bflo(cq), bfhi(cq)}; }
#pragma unroll
    for (int t = 0; t < 64; t += 2) { const f32x2 x3 = {bflo(raw[t]), bfhi(raw[t])}, x4 = {bflo(raw[t + 1]), bfhi(raw[t + 1])};
        const f32x2 v0 = bias + w0 * x0 + w1 * x1 + w2 * x2 + w3 * x3, v1 = bias + w0 * x1 + w1 * x2 + w2 * x3 + w3 * x4;
        sink(t, siluf(v0.x), siluf(v1.x), siluf(v0.y), siluf(v1.y)); x0 = x2; x1 = x3; x2 = x4; }
}

__device__ __forceinline__ void phase_ssd_a(const Frame& F0) {
    const Frame F = phase_frame(F0);
    using namespace sm;
    LAS bf16_t* XT = (LAS bf16_t*)F.lds; LAS bf16_t* BT = (LAS bf16_t*)(F.lds + 73728);
    LAS float* dt_s = (LAS float*)(F.lds + 92160); LAS float* acs_s = (LAS float*)(F.lds + 94208); LAS float* sc_s = (LAS float*)(F.lds + 96256);
    const int tid = F.tid, lane = F.lane, wave = F.wave;
    for (int u = F.vcu; u < NB * NCH * 2; u += F.G) {
        const int g = u & 1, bc = u >> 1, b = bc / NCH, c = bc % NCH; const size_t row0 = (size_t)b * L + c * 64;
        LDS_BARRIER();
        if (tid < 320) { const int ci = tid * 2;
            const int xc = ci < 512 ? g * 512 + ci : 1024 + g * 128 + (ci - 512);
            LAS unsigned* dst = (LAS unsigned*)(ci < 512 ? XT + ci * XT_LD : BT + (ci - 512) * XT_LD);
            ssd_conv_pair(F, b, c, xc, [&](int t, float a0, float a1, float b0, float b1) { dst[t >> 1] = cvt_pk_bf16(a0, a1); dst[XT_LD / 2 + (t >> 1)] = cvt_pk_bf16(b0, b1); });
        }
        { const int t = tid & 63, hh = tid >> 6, hd = g * 8 + hh; const float dt = softplusf(OKP(float, WS_RAW16)[(row0 + t) * 16 + hd] + F.in[I_EV_DTB][hd]); dt_s[hh * 64 + t] = dt; acs_s[hh * 64 + t] = dt * -expf(F.in[I_EV_ALOG][hd]); }
        LDS_BARRIER();
        { const int hh = wave, hd = g * 8 + hh; float v = acs_s[hh * 64 + lane];
#pragma unroll
          for (int o = 1; o < 64; o <<= 1) { const float n = __shfl_up(v, o); if (lane >= o) v += n; }
          const float last = __shfl(v, 63); const float dt = dt_s[hh * 64 + lane];
          sc_s[hh * 64 + lane] = dt * fexp(last - v);
          OKP(float, WS_DTV)[(row0 + lane) * 16 + hd] = dt; OKP(float, WS_ACS)[(row0 + lane) * 16 + hd] = v; }
        WAVE_SYNC();
#if defined(CHECK_DUMP)
        if (bc == 5 && g == 0) {
            float* f3 = OKP(float, WS_FP) + (size_t)3 * 16 * 6144; float* f4 = OKP(float, WS_FP) + (size_t)4 * 16 * 6144; float* f5 = OKP(float, WS_FP) + (size_t)5 * 16 * 6144;
            for (int i = tid; i < 512 * 64; i += NT) f3[i] = bf2f(XT[(i >> 6) * XT_LD + (i & 63)]);
            for (int i = tid; i < 128 * 64; i += NT) f4[i] = bf2f(BT[(i >> 6) * XT_LD + (i & 63)]);
            f5[wave * 64 + lane] = sc_s[wave * 64 + lane];
        }
#endif
        { const int hh = wave, hd = g * 8 + hh, fr = lane & 15, fq = lane >> 4;
          bf16x8 xa[4][2];
#pragma unroll
          for (int pt = 0; pt < 4; ++pt)
#pragma unroll
              for (int ks = 0; ks < 2; ++ks) { const u32x4 raw = *(const LAS u32x4*)(XT + (hh * 64 + pt * 16 + fr) * XT_LD + ks * 32 + fq * 8); const LAS float* sp = sc_s + hh * 64 + ks * 32 + fq * 8;
                  const f32x4 s0 = *(const LAS f32x4*)sp, s1 = *(const LAS f32x4*)(sp + 4); u32x4 o;
                  o.x = cvt_pk_bf16(bflo(raw.x) * s0.x, bfhi(raw.x) * s0.y); o.y = cvt_pk_bf16(bflo(raw.y) * s0.z, bfhi(raw.y) * s0.w);
                  o.z = cvt_pk_bf16(bflo(raw.z) * s1.x, bfhi(raw.z) * s1.y); o.w = cvt_pk_bf16(bflo(raw.w) * s1.z, bfhi(raw.w) * s1.w);
                  xa[pt][ks] = __builtin_bit_cast(bf16x8, o); }
          bf16_t* st = OKP(bf16_t, WS_STATES) + ((size_t)bc * 16 + hd) * 8192;
#pragma unroll
          for (int nt = 0; nt < 8; ++nt) { bf16x8 bb[2];
#pragma unroll
              for (int ks = 0; ks < 2; ++ks) bb[ks] = *(const LAS bf16x8*)(BT + (nt * 16 + fr) * XT_LD + ks * 32 + fq * 8);
#pragma unroll
              for (int pt = 0; pt < 4; ++pt) { f32x4 acc = {0.f, 0.f, 0.f, 0.f};
#pragma unroll
                  for (int ks = 0; ks < 2; ++ks) acc = mfma16(bb[ks], xa[pt][ks], acc);
                  u32x2 w; w.x = cvt_pk_bf16(acc[0], acc[1]); w.y = cvt_pk_bf16(acc[2], acc[3]);
                  *(u32x2*)(st + (size_t)(pt * 16 + fr) * 128 + nt * 16 + 4 * fq) = w; } } }
    }
}

__device__ __forceinline__ void phase_ssd_scan(const Frame& F0, int skip) {
    const Frame F = phase_frame(F0);
    const float* acs = OKP(float, WS_ACS);
    int widx = F.vcu, nw = F.G;
    if (skip) { const int per = F.G / 8, xcd = (int)blockIdx.x & 7, loc = (int)blockIdx.x >> 3  , sk = skip / 8; if (loc < sk) return; widx = xcd * (per - sk) + (loc - sk); nw = F.G - skip; }
    LAS float* dec_s = (LAS float*)F.lds;
    const int tid = F.tid, NTOT = NB * 65536;
    for (int base = widx * NT; base < NTOT; base += 2 * nw * NT) {
        const int baseB = base + nw * NT; const bool vB = baseB < NTOT; const int iA = base + tid, iB = vB ? baseB + tid : iA;
        LDS_BARRIER();
        if (tid < 2 * NCH) { const int ch = tid / NCH, c = tid % NCH, ii = ch ? (vB ? baseB : base) : base, b = ii >> 16, hd = (ii & 65535) >> 12; dec_s[ch * NCH + c] = fexp(acs[((size_t)b * L + c * 64 + 63) * 16 + hd]); }
        LDS_BARRIER();
        unsigned* pA = (unsigned*)(OKP(bf16_t, WS_STATES) + (size_t)(iA >> 16) * NCH * 131072) + (iA & 65535);
        unsigned* pB = (unsigned*)(OKP(bf16_t, WS_STATES) + (size_t)(iB >> 16) * NCH * 131072) + (iB & 65535);
        float a0 = 0.f, a1 = 0.f, b0 = 0.f, b1 = 0.f; unsigned sA0[8], sB0[8], sA1[8], sB1[8];
#define SCAN_LOAD(SA, SB, c0) do { _Pragma("unroll") for (int k = 0; k < 8; ++k) { const int c = (c0) + k < NCH ? (c0) + k : NCH - 1; SA[k] = pA[(size_t)c * 65536]; SB[k] = pB[(size_t)c * 65536]; } } while (0)
#define SCAN_STEP(SA, SB, c0) do { _Pragma("unroll") for (int k = 0; k < 8; ++k) { const int c = (c0) + k; if (NCH % 16 != 0 && c >= NCH) break; const float dA = dec_s[c], dB = dec_s[NCH + c]; \
            pA[(size_t)c * 65536] = cvt_pk_bf16(a0, a1); a0 = a0 * dA + bflo(SA[k]); a1 = a1 * dA + bfhi(SA[k]); \
            if (vB) pB[(size_t)c * 65536] = cvt_pk_bf16(b0, b1); b0 = b0 * dB + bflo(SB[k]); b1 = b1 * dB + bfhi(SB[k]); } } while (0)
        SCAN_LOAD(sA0, sB0, 0);
#pragma unroll 1
        for (int c0 = 0; c0 < NCH; c0 += 16) {
            SCAN_LOAD(sA1, sB1, c0 + 8); SCHED_FENCE();
            SCAN_STEP(sA0, sB0, c0); SCHED_FENCE();
            SCAN_LOAD(sA0, sB0, c0 + 16); SCHED_FENCE();
            SCAN_STEP(sA1, sB1, c0 + 8); SCHED_FENCE();
        }
#undef SCAN_LOAD
#undef SCAN_STEP
    }
}

__device__ __forceinline__ void phase_ssd_b(const Frame& F0) {
    const Frame F = phase_frame(F0);
    using namespace sm;
    LAS bf16_t* XT = (LAS bf16_t*)F.lds; LAS bf16_t* Bs = (LAS bf16_t*)(F.lds + 73728); LAS bf16_t* Cs = (LAS bf16_t*)(F.lds + 91136);
    LAS float* acs_s = (LAS float*)(F.lds + 108544); LAS float* dt_s = (LAS float*)(F.lds + 110592); LAS float* red = (LAS float*)(F.lds + 112640);
    const int tid = F.tid, lane = F.lane, wave = F.wave, fr = lane & 15, fq = lane >> 4;
    const bf16_t* proj = OKP(bf16_t, WS_PROJ); bf16_t* cat = OKP(bf16_t, WS_CAT0);
    for (int u = F.vcu; u < NB * NCH * 2; u += F.G) {
        const int g = u & 1, bc = u >> 1, b = bc / NCH, c = bc % NCH; const size_t row0 = (size_t)b * L + c * 64;
        LDS_BARRIER();
        if (tid < 384) { const int ci = tid * 2;
            if (ci < 512) { LAS unsigned* dst = (LAS unsigned*)(XT + ci * XT_LD); ssd_conv_pair(F, b, c, g * 512 + ci, [&](int t, float a0, float a1, float b0, float b1) { dst[t >> 1] = cvt_pk_bf16(a0, a1); dst[XT_LD / 2 + (t >> 1)] = cvt_pk_bf16(b0, b1); }); }
            else { const int n = (ci - 512) & 127; LAS unsigned* dst = (LAS unsigned*)((ci < 640 ? Bs : Cs) + n); const int xc = (ci < 640 ? 1024 : 1280) + g * 128 + n;
                ssd_conv_pair(F, b, c, xc, [&](int t, float a0, float a1, float b0, float b1) { dst[t * (BC_LD / 2)] = cvt_pk_bf16(a0, b0); dst[(t + 1) * (BC_LD / 2)] = cvt_pk_bf16(a1, b1); }); }
        }
        { const int t = tid & 63, hh = tid >> 6; acs_s[hh * 64 + t] = OKP(float, WS_ACS)[(row0 + t) * 16 + g * 8 + hh]; dt_s[hh * 64 + t] = OKP(float, WS_DTV)[(row0 + t) * 16 + g * 8 + hh]; }
        { const int ch = g * 256 + (tid & 255), t0 = (tid >> 8) * 32; const float* w = F.in[I_EV_SCCONV]; const float w0 = w[ch], w1 = w[512 + ch], w2 = w[1024 + ch];
          const bf16_t* p = proj + (row0 + t0) * PROJ0_LD + ch; float p0 = 0.f, p1 = 0.f;
          const int hv = (c > 0 || t0 > 0) ? 1 : 0; const unsigned short h0 = p[-2 * PROJ0_LD * hv + 512], h1 = p[-2 * PROJ0_LD * hv + 1024], h2 = p[-PROJ0_LD * hv + 512], h3 = p[-PROJ0_LD * hv + 1024];
          unsigned short rb[32], rc[32], rx[32];
#pragma unroll
          for (int t = 0; t < 32; ++t) { const bf16_t* q = p + (size_t)t * PROJ0_LD; rb[t] = q[0]; rc[t] = q[512]; rx[t] = q[1024]; }
          SCHED_FENCE();
          if (hv) { p0 = bf2f(h0) * bf2f(h1); p1 = bf2f(h2) * bf2f(h3); }
#pragma unroll
          for (int t = 0; t < 32; ++t) { const float p2 = bf2f(rc[t]) * bf2f(rx[t]); const float y = bf2f(rb[t]) * (w0 * p0 + w1 * p1 + w2 * p2);
              cat[(row0 + t0 + t) * 1536 + ch] = (bf16_t)(cvt_pk_bf16(y, 0.f) & 0xffffu); p0 = p1; p1 = p2; } }
        LDS_BARRIER();
        const int hh = wave, hd = g * 8 + hh;
        f32x4 Y[4][4];
        { const bf16_t* P = OKP(bf16_t, WS_STATES) + ((size_t)bc * 16 + hd) * 8192;
#pragma unroll
          for (int pt = 0; pt < 4; ++pt)
#pragma unroll
              for (int tt = 0; tt < 4; ++tt) Y[pt][tt] = (f32x4){0.f, 0.f, 0.f, 0.f};
          bf16x8 pall[4][4];
#pragma unroll
          for (int ks = 0; ks < 4; ++ks)
#pragma unroll
              for (int pt = 0; pt < 4; ++pt) pall[ks][pt] = *(const bf16x8*)(P + (size_t)(pt * 16 + fr) * 128 + ks * 32 + fq * 8);
#pragma unroll
          for (int ks = 0; ks < 4; ++ks) { bf16x8 cb[4];
#pragma unroll
              for (int tt = 0; tt < 4; ++tt) cb[tt] = *(const LAS bf16x8*)(Cs + (tt * 16 + fr) * BC_LD + ks * 32 + fq * 8);
#pragma unroll
              for (int pt = 0; pt < 4; ++pt)
#pragma unroll
                  for (int tt = 0; tt < 4; ++tt) Y[pt][tt] = mfma16(pall[ks][pt], cb[tt], Y[pt][tt]); }
#pragma unroll
          for (int tt = 0; tt < 4; ++tt) { const float e = fexp(acs_s[hh * 64 + tt * 16 + fr]);
#pragma unroll
              for (int pt = 0; pt < 4; ++pt) Y[pt][tt] *= e; } }
#pragma unroll
        for (int tt = 0; tt < 4; ++tt) { f32x4 cbt[4];
#pragma unroll
            for (int st = 0; st < 4; ++st) cbt[st] = (f32x4){0.f, 0.f, 0.f, 0.f};
#pragma unroll
            for (int ks = 0; ks < 4; ++ks) { const bf16x8 cf = *(const LAS bf16x8*)(Cs + (tt * 16 + fr) * BC_LD + ks * 32 + fq * 8);
#pragma unroll
                for (int st = 0; st < 4; ++st) if (st <= tt) { const bf16x8 bf = *(const LAS bf16x8*)(Bs + (st * 16 + fr) * BC_LD + ks * 32 + fq * 8); cbt[st] = mfma16(bf, cf, cbt[st]); } }
            const int t = tt * 16 + fr; const float at = acs_s[hh * 64 + t];
#pragma unroll
            for (int st = 0; st < 4; ++st) { const f32x4 as4 = *(const LAS f32x4*)(acs_s + hh * 64 + st * 16 + 4 * fq), dt4 = *(const LAS f32x4*)(dt_s + hh * 64 + st * 16 + 4 * fq);
#pragma unroll
                for (int r = 0; r < 4; ++r) { const int s = st * 16 + 4 * fq + r; cbt[st][r] = (st <= tt && s <= t) ? cbt[st][r] * fexp(at - as4[r]) * dt4[r] : 0.f; } }
            bf16x8 mb[2];
#pragma unroll
            for (int ks = 0; ks < 2; ++ks) { u32x4 o; o.x = cvt_pk_bf16(cbt[2 * ks][0], cbt[2 * ks][1]); o.y = cvt_pk_bf16(cbt[2 * ks][2], cbt[2 * ks][3]); o.z = cvt_pk_bf16(cbt[2 * ks + 1][0], cbt[2 * ks + 1][1]); o.w = cvt_pk_bf16(cbt[2 * ks + 1][2], cbt[2 * ks + 1][3]);
                mb[ks] = __builtin_bit_cast(bf16x8, o); }
#pragma unroll
            for (int pt = 0; pt < 4; ++pt)
#pragma unroll
                for (int ks = 0; ks < 2; ++ks) { const LAS bf16_t* xp = XT + (hh * 64 + pt * 16 + fr) * XT_LD + ks * 32 + 4 * fq; const u32x2 lo = *(const LAS u32x2*)xp, hi = *(const LAS u32x2*)(xp + 16);
                    u32x4 a; a.x = lo.x; a.y = lo.y; a.z = hi.x; a.w = hi.y; Y[pt][tt] = mfma16(__builtin_bit_cast(bf16x8, a), mb[ks], Y[pt][tt]); } }
        u32x2 zz_[4][4];
#pragma unroll
        for (int tt = 0; tt < 4; ++tt)
#pragma unroll
            for (int pt = 0; pt < 4; ++pt) zz_[tt][pt] = *(const u32x2*)(proj + (row0 + tt * 16 + fr) * PROJ0_LD + 1536 + hd * 64 + pt * 16 + 4 * fq);
        SCHED_FENCE();
        const float Dh = F.in[I_EV_D][hd];
#pragma unroll
        for (int tt = 0; tt < 4; ++tt) { const int t = tt * 16 + fr; float ss = 0.f;
#pragma unroll
            for (int pt = 0; pt < 4; ++pt) { const int p = pt * 16 + 4 * fq; const u32x2 zz = zz_[tt][pt];
                const float z0 = bflo(zz.x), z1 = bfhi(zz.x), z2 = bflo(zz.y), z3 = bfhi(zz.y); const LAS bf16_t* xp = XT + (hh * 64 + p) * XT_LD + t;
                f32x4 y = Y[pt][tt]; y[0] = (y[0] + Dh * bf2f(xp[0])) * siluf(z0); y[1] = (y[1] + Dh * bf2f(xp[XT_LD])) * siluf(z1); y[2] = (y[2] + Dh * bf2f(xp[2 * XT_LD])) * siluf(z2); y[3] = (y[3] + Dh * bf2f(xp[3 * XT_LD])) * siluf(z3);
                Y[pt][tt] = y; ss += (y[0] * y[0] + y[1] * y[1]) + (y[2] * y[2] + y[3] * y[3]); }
            ss += __shfl_xor(ss, 16); ss += __shfl_xor(ss, 32);
            if (fq == 0) red[hh * 64 + t] = ss; }
        f32x4 nw_[4];
#pragma unroll
        for (int pt = 0; pt < 4; ++pt) nw_[pt] = *(const f32x4*)(F.in[I_EV_NORM] + hd * 64 + pt * 16 + 4 * fq);
        LDS_BARRIER();
#pragma unroll
        for (int tt = 0; tt < 4; ++tt) { const int t = tt * 16 + fr; float ss = 0.f;
#pragma unroll
            for (int w = 0; w < 8; ++w) ss += red[w * 64 + t];
            const float rs = frsq(ss * (1.f / 512.f) + EPS);
#pragma unroll
            for (int pt = 0; pt < 4; ++pt) { const int ch = hd * 64 + pt * 16 + 4 * fq; const f32x4 nw = nw_[pt]; const f32x4 y = Y[pt][tt];
                u32x2 w; w.x = cvt_pk_bf16(y[0] * rs * nw.x, y[1] * rs * nw.y); w.y = cvt_pk_bf16(y[2] * rs * nw.z, y[3] * rs * nw.w);
                *(u32x2*)(cat + (row0 + t) * 1536 + 512 + ch) = w; } }
    }
}
}

namespace ok {
constexpr int XA_LD = 264;

__device__ __forceinline__ void phase_xattn(const Frame& F0, const bf16_t* q, const bf16_t* kx, const bf16_t* vt, bf16_t* att) {
    const Frame F = phase_frame(F0);
    LAS bf16_t* KV = (LAS bf16_t*)F.lds;
    const int tid = F.tid, lane = F.lane, wave = F.wave, fr = lane & 15, fq = lane >> 4;
    constexpr int XA_PRE = 6;
    u32x4 tile[XA_PRE];
#define XA_LOAD_K(uu) do { const int hd_ = (uu) & 3, b_ = (((uu) >> 2) * 128) / L; _Pragma("unroll") for (int j_ = 0; j_ < XA_PRE; ++j_) { const int i_ = tid + j_ * NT, r_ = i_ >> 5, c8_ = i_ & 31; tile[j_] = *(const u32x4*)(kx + (size_t)(b_ * 256 + r_) * 1024 + hd_ * 256 + c8_ * 8); } } while (0)
#define XA_LOAD_V(uu) do { const int hd_ = (uu) & 3, b_ = (((uu) >> 2) * 128) / L; _Pragma("unroll") for (int j_ = 0; j_ < XA_PRE; ++j_) { const int i_ = tid + j_ * NT, r_ = i_ >> 5, c8_ = i_ & 31; tile[j_] = *(const u32x4*)(vt + (size_t)(hd_ * 256 + r_) * (NB * 256) + b_ * 256 + c8_ * 8); } } while (0)
#define XA_STORE() do { _Pragma("unroll") for (int j_ = 0; j_ < XA_PRE; ++j_) { const int i_ = tid + j_ * NT, r_ = i_ >> 5, c8_ = i_ & 31; *(LAS u32x4*)(KV + r_ * XA_LD + c8_ * 8) = tile[j_]; } } while (0)
#define XA_STORE_REST() do { _Pragma("unroll") for (int j_ = XA_PRE; j_ < 16; ++j_) { const int i_ = tid + j_ * NT, r_ = i_ >> 5, c8_ = i_ & 31; *(LAS u32x4*)(KV + r_ * XA_LD + c8_ * 8) = rest[j_ - XA_PRE]; } } while (0)
#define XA_REST_K(uu) do { const int hd_ = (uu) & 3, b_ = (((uu) >> 2) * 128) / L; _Pragma("unroll") for (int j_ = XA_PRE; j_ < 16; ++j_) { const int i_ = tid + j_ * NT, r_ = i_ >> 5, c8_ = i_ & 31; rest[j_ - XA_PRE] = *(const u32x4*)(kx + (size_t)(b_ * 256 + r_) * 1024 + hd_ * 256 + c8_ * 8); } } while (0)
#define XA_REST_V(uu) do { const int hd_ = (uu) & 3, b_ = (((uu) >> 2) * 128) / L; _Pragma("unroll") for (int j_ = XA_PRE; j_ < 16; ++j_) { const int i_ = tid + j_ * NT, r_ = i_ >> 5, c8_ = i_ & 31; rest[j_ - XA_PRE] = *(const u32x4*)(vt + (size_t)(hd_ * 256 + r_) * (NB * 256) + b_ * 256 + c8_ * 8); } } while (0)
    if (F.vcu < (T / 128) * 4) XA_LOAD_K(F.vcu);
    for (int u = F.vcu; u < (T / 128) * 4; u += F.G) {
        const int hd = u & 3, rt = u >> 2, row0 = rt * 128;
        LDS_BARRIER();
        bf16x8 qf[8];
        { u32x4 rest[16 - XA_PRE]; XA_REST_K(u); SCHED_FENCE(); XA_STORE(); SCHED_FENCE();
          const bf16_t* qp = q + (size_t)(row0 + wave * 16 + fr) * 1024 + hd * 256 + fq * 8;
#pragma unroll
          for (int ks = 0; ks < 8; ++ks) qf[ks] = *(const bf16x8*)(qp + ks * 32);
          SCHED_FENCE(); XA_STORE_REST(); }
        XA_LOAD_V(u);
        LDS_BARRIER();
        bf16x8 pf[8]; float fA, fB;
        {
            float mh[2], lh[2];
#pragma unroll
            for (int half = 0; half < 2; ++half) {
                f32x4 s[8];
#pragma unroll
                for (int kt = 0; kt < 8; ++kt) { s[kt] = (f32x4){0.f, 0.f, 0.f, 0.f};
#pragma unroll
                    for (int ks = 0; ks < 8; ++ks) { const bf16x8 kf = *(const LAS bf16x8*)(KV + ((half * 8 + kt) * 16 + fr) * XA_LD + ks * 32 + fq * 8); s[kt] = mfma16(kf, qf[ks], s[kt]); }
                    }
                float m = -3.0e38f;
#pragma unroll
                for (int kt = 0; kt < 8; ++kt) m = fmaxf(m, fmaxf(fmaxf(s[kt][0], s[kt][1]), fmaxf(s[kt][2], s[kt][3])));
                m = fmaxf(m, __shfl_xor(m, 16)); m = fmaxf(m, __shfl_xor(m, 32));
                float l = 0.f;
#pragma unroll
                for (int kt = 0; kt < 8; ++kt) {
#pragma unroll
                    for (int r = 0; r < 4; ++r) { const float p = fexp2(s[kt][r] - m); s[kt][r] = p; l += p; } }
                l += __shfl_xor(l, 16); l += __shfl_xor(l, 32); mh[half] = m; lh[half] = l;
#pragma unroll
                for (int j = 0; j < 4; ++j) { u32x4 o; o.x = cvt_pk_bf16(s[2 * j][0], s[2 * j][1]); o.y = cvt_pk_bf16(s[2 * j][2], s[2 * j][3]); o.z = cvt_pk_bf16(s[2 * j + 1][0], s[2 * j + 1][1]); o.w = cvt_pk_bf16(s[2 * j + 1][2], s[2 * j + 1][3]);
                    pf[half * 4 + j] = __builtin_bit_cast(bf16x8, o); }
                    }
            const float m = fmaxf(mh[0], mh[1]), cA = fexp2(mh[0] - m), cB = fexp2(mh[1] - m), li = frcp(cA * lh[0] + cB * lh[1]); fA = cA * li; fB = cB * li;
        }
        LDS_BARRIER();
        { u32x4 rest[16 - XA_PRE]; XA_REST_V(u); SCHED_FENCE(); XA_STORE(); XA_STORE_REST(); }
        if (u + F.G < (T / 128) * 4) XA_LOAD_K(u + F.G);
        LDS_BARRIER();
#pragma unroll 2
        for (int dt = 0; dt < 16; ++dt) { f32x4 oA = {0.f, 0.f, 0.f, 0.f}, oB = oA;
#pragma unroll
            for (int j = 0; j < 8; ++j) { const LAS bf16_t* vp = KV + (dt * 16 + fr) * XA_LD + j * 32 + 4 * fq; const u32x2 lo = *(const LAS u32x2*)vp, hi = *(const LAS u32x2*)(vp + 16);
                u32x4 a; a.x = lo.x; a.y = lo.y; a.z = hi.x; a.w = hi.y; const bf16x8 vf = __builtin_bit_cast(bf16x8, a);
                if (j < 4) oA = mfma16(vf, pf[j], oA); else oB = mfma16(vf, pf[j], oB); }
            const f32x4 o = oA * fA + oB * fB;
            bf16_t* op = att + (size_t)(row0 + wave * 16 + fr) * 1024 + hd * 256 + dt * 16 + 4 * fq;
            u32x2 w; w.x = cvt_pk_bf16(o[0], o[1]); w.y = cvt_pk_bf16(o[2], o[3]); *(u32x2*)op = w; }
    }
#undef XA_LOAD_K
#undef XA_LOAD_V
#undef XA_STORE
#undef XA_REST_K
#undef XA_STORE_REST
#undef XA_REST_V
}

#ifndef CPU_EMU
struct KvOrder {
    static constexpr bool LIGHT = false;
    const char* memnb; const char* wxa; char* kx; char* vt; int G, c;
    __device__ bool next(int i, pg8::Unit& u) const {
        const int Lx = i * G + c; if (Lx >= 32) return false;
        const int l = Lx >> 4, r = Lx & 15; const size_t tstep = (size_t)256 * 1024 * 2;
        if (r < 8) { u.pm = r >> 2; u.pn = r & 3; u.tag = l * 2; u.a = memnb + (size_t)u.pm * tstep; u.b = wxa + (size_t)l * 8 * MiB + 2 * MiB + (size_t)u.pn * tstep; }
        else { const int r2 = r - 8; u.pm = r2 >> 1; u.pn = r2 & 1; u.tag = l * 2 + 1; u.a = wxa + (size_t)l * 8 * MiB + 4 * MiB + (size_t)u.pm * tstep; u.b = memnb + (size_t)u.pn * tstep; }
        return true;
    }
    __device__ __forceinline__ void a_ready(const pg8::Unit&) const {}
    __device__ __forceinline__ void done(const pg8::Unit&) const {}
};
struct EpiKv {
    static constexpr bool PERM = true, AFTER_DRAIN = false;
    bf16_t* kx; bf16_t* vt;
    __device__ __forceinline__ void operator()(const f32x4 (&acc)[2][2][4][2], const pg8::Unit& u, int wr, int wc, int fr, int fq) const {
        const int l = u.tag >> 1, isv = u.tag & 1, ldc = isv ? 512 : 1024; bf16_t* O = isv ? vt + (size_t)l * 1024 * 512 : kx + (size_t)l * 512 * 1024;
        const int row0 = u.pm * 256 + wr * 64 + fr, col0 = u.pn * 256 + wc * 32 + 8 * fq;
#pragma unroll
        for (int ai = 0; ai < 2; ++ai)
#pragma unroll
            for (int m = 0; m < 4; ++m) { bf16_t* rowp = O + (size_t)(row0 + ai * 128 + m * 16) * ldc + col0;
#pragma unroll
                for (int bj = 0; bj < 2; ++bj) { const f32x4 v0 = acc[ai][bj][m][0], v1 = acc[ai][bj][m][1]; u32x4 w; w.x = cvt_pk_bf16(v0[0], v0[1]); w.y = cvt_pk_bf16(v0[2], v0[3]); w.z = cvt_pk_bf16(v1[0], v1[1]); w.w = cvt_pk_bf16(v1[2], v1[3]);
                    *(u32x4*)(rowp + bj * 128) = w; } }
    }
};
__device__ __forceinline__ void phase_kv(const Frame& F) {
    pg8::Gemm g{nullptr, nullptr, 0, 0, 1024};
    int vcu_; { const int bx = blockIdx.x, G = gridDim.x; vcu_ = (G % 8 == 0) ? (bx % 8) * (G / 8) + bx / 8 : bx; if (G % 8 == 0 && G >= 64) { const int per = G / 8, xcd = (int)blockIdx.x & 7, loc = (int)blockIdx.x >> 3  ; vcu_ = loc < 4 ? xcd * 4 + loc : 32 + vcu_; } }
    KvOrder S{(const char*)OKP(bf16_t, WS_MEMNB), (const char*)OKP(bf16_t, WS_W_XA), (char*)OKP(bf16_t, WS_KX), (char*)OKP(bf16_t, WS_VT), F.G, vcu_};
    EpiKv E{OKP(bf16_t, WS_KX), OKP(bf16_t, WS_VT)};
    pg8::gemm_phase<EpiKv, KvOrder, true, true>(F.lds, g, S, E, F.wave);
}
#endif
}

namespace ok {
constexpr size_t WS_WRH = WS_WR, WS_WRL = WS_WR + 256 * KiB;
constexpr size_t WS_POS = WS_TILEEXP + 4 * KiB;
__device__ __forceinline__ void prologue_router_tables(const Frame& F0) {
    const Frame F = phase_frame(F0);
    using namespace sm;
    const size_t gt = (size_t)F.vcu * NT + F.tid, GT = (size_t)F.G * NT;
    for (size_t i = gt; i < (size_t)2 * 48 * 1024; i += GT) { const int l = (int)(i / (48 * 1024)), j = (int)((i / 1024) % 48), k = (int)(i % 1024); float v = 0.f;
        if (j < 4) v = F.in[I_MOE_WG][((size_t)l * 1024 + k) * 4 + j]; else if (j < 36) v = F.in[I_MOE_WE][((size_t)l * 1024 + k) * 32 + (j - 4)];
        v *= F.in[I_NORM_FFN][l * 1024 + k];
        const unsigned hi = cvt_pk_bf16(v, 0.f) & 0xffffu; const float rem = v - __uint_as_float(hi << 16);
        OKP(bf16_t, WS_WRH)[i] = (bf16_t)hi; OKP(bf16_t, WS_WRL)[i] = (bf16_t)(cvt_pk_bf16(rem, 0.f) & 0xffffu); }
}

constexpr size_t WS_W16H = WS_WR + 512 * KiB, WS_W16L = WS_W16H + 64 * KiB;
__device__ __forceinline__ void prologue_w16_tables(const Frame& F0) {
    using namespace sm;
    const Frame F = phase_frame(F0);
    const size_t gt = (size_t)F.vcu * NT + F.tid, GT = (size_t)F.G * NT;
    for (size_t i = gt; i < (size_t)2 * 16 * 1024; i += GT) { const int set = (int)(i >> 14), j = (int)((i >> 10) & 15), k = (int)(i & 1023);
        const float v = set == 0 ? F.in[I_NORM_MIX][k] * F.in[I_EV_WIN][(size_t)k * 4112 + 4096 + j] : F.in[I_NORM_MIX][1024 + k] * F.in[I_OD_WIN][(size_t)k * 5648 + 4096 + j];
        const unsigned hi = cvt_pk_bf16(v, 0.f) & 0xffffu; const float rem = v - __uint_as_float(hi << 16);
        OKP(bf16_t, WS_W16H)[i] = (bf16_t)hi; OKP(bf16_t, WS_W16L)[i] = (bf16_t)(cvt_pk_bf16(rem, 0.f) & 0xffffu); }
}
__device__ __forceinline__ void phase_proj16(const Frame& F0, int set, const float* h, const bf16_t* hb, const float* ssq, int np) {
    const Frame F = phase_frame(F0);
    const int lane = F.lane, fr = lane & 15, fq = lane >> 4;
    const bf16_t* wh = OKP(bf16_t, WS_W16H) + (size_t)set * 16 * 1024; const bf16_t* wl = OKP(bf16_t, WS_W16L) + (size_t)set * 16 * 1024;
    const int gw = F.vcu * NWAVES + F.wave, NGW = F.G * NWAVES;
    for (int tile = gw; tile < T / 16; tile += NGW) { const int t0 = tile * 16; f32x4 acc = {0.f, 0.f, 0.f, 0.f};
        const float* hp = h + (size_t)(t0 + fr) * DM + fq * 8;
        if (hb) { const bf16_t* ap = hb + (size_t)(t0 + fr) * DM + fq * 8;
#pragma unroll 1
            for (int kb = 0; kb < 4; ++kb) { bf16x8 bh[8], bl[8], ah[8];
#pragma unroll
                for (int k8 = 0; k8 < 8; ++k8) { const size_t wo = (size_t)fr * 1024 + (kb * 8 + k8) * 32 + fq * 8; bh[k8] = *(const bf16x8*)(wh + wo); bl[k8] = *(const bf16x8*)(wl + wo); ah[k8] = *(const bf16x8*)(ap + (kb * 8 + k8) * 32); }
                SCHED_FENCE();
#pragma unroll
                for (int k8 = 0; k8 < 8; ++k8) { acc = mfma16(bh[k8], ah[k8], acc); acc = mfma16(bl[k8], ah[k8], acc); }
                SCHED_FENCE(); } }
        else {
#pragma unroll 1
            for (int kb = 0; kb < 4; ++kb) { bf16x8 bh[8], bl[8]; f32x4 xa[8], xb[8];
#pragma unroll
                for (int k8 = 0; k8 < 8; ++k8) { const size_t wo = (size_t)fr * 1024 + (kb * 8 + k8) * 32 + fq * 8; bh[k8] = *(const bf16x8*)(wh + wo); bl[k8] = *(const bf16x8*)(wl + wo); xa[k8] = *(const f32x4*)(hp + (kb * 8 + k8) * 32); xb[k8] = *(const f32x4*)(hp + (kb * 8 + k8) * 32 + 4); }
                SCHED_FENCE();
#pragma unroll
                for (int k8 = 0; k8 < 8; ++k8) { const f32x4 x0 = xa[k8], x1 = xb[k8];
            u32x4 hi, lo;
            hi.x = cvt_pk_bf16(x0[0], x0[1]); hi.y = cvt_pk_bf16(x0[2], x0[3]); hi.z = cvt_pk_bf16(x1[0], x1[1]); hi.w = cvt_pk_bf16(x1[2], x1[3]);
            lo.x = cvt_pk_bf16(x0[0] - bflo(hi.x), x0[1] - bfhi(hi.x)); lo.y = cvt_pk_bf16(x0[2] - bflo(hi.y), x0[3] - bfhi(hi.y));
            lo.z = cvt_pk_bf16(x1[0] - bflo(hi.z), x1[1] - bfhi(hi.z)); lo.w = cvt_pk_bf16(x1[2] - bflo(hi.w), x1[3] - bfhi(hi.w));
            const bf16x8 ah = __builtin_bit_cast(bf16x8, hi), al = __builtin_bit_cast(bf16x8, lo);
            acc = mfma16(bh[k8], ah, acc); acc = mfma16(bl[k8], ah, acc); acc = mfma16(bh[k8], al, acc); }
                SCHED_FENCE(); } }
        acc *= rstd_np(ssq, np, t0 + fr);
        *(f32x4*)(OKP(float, WS_RAW16) + (size_t)(t0 + fr) * 16 + 4 * fq) = acc; }
}

__device__ __forceinline__ void phase_router(const Frame& F0, int l, const bf16_t* hb, const float* ssq, int np) {
    const Frame F = phase_frame(F0);
    using namespace sm;
    const int lane = F.lane, wave = F.wave, fr = lane & 15, fq = lane >> 4;
    LAS float* lg = (LAS float*)(F.lds + wave * 16384 + 8704);
    const bf16_t* wh = OKP(bf16_t, WS_WRH) + (size_t)l * 48 * 1024; const bf16_t* wl = OKP(bf16_t, WS_WRL) + (size_t)l * 48 * 1024;
    const float* bg = F.in[I_MOE_BG] + l * 4; const float* be = F.in[I_MOE_BE] + l * 32;
    unsigned* cnt = F.ctl + CW_MOE + l * 64;
    const int gw = F.vcu * NWAVES + wave, NGW = F.G * NWAVES;
    for (int tile = gw; tile < T / 16; tile += NGW) {
        const int t0 = tile * 16;
        f32x4 acc[3] = {{0.f, 0.f, 0.f, 0.f}, {0.f, 0.f, 0.f, 0.f}, {0.f, 0.f, 0.f, 0.f}};
        const bf16_t* hp = hb + (size_t)(t0 + fr) * DM + fq * 8;
#pragma unroll 1
        for (int kb = 0; kb < 8; ++kb) { bf16x8 ah[4], bh[4][3], bl[4][3];
#pragma unroll
            for (int k4 = 0; k4 < 4; ++k4) { const int ks = kb * 4 + k4; ah[k4] = *(const bf16x8*)(hp + ks * 32);
#pragma unroll
                for (int nt = 0; nt < 3; ++nt) { const size_t wo = (size_t)(nt * 16 + fr) * 1024 + ks * 32 + fq * 8; bh[k4][nt] = *(const bf16x8*)(wh + wo); bl[k4][nt] = *(const bf16x8*)(wl + wo); } }
            SCHED_FENCE();
#pragma unroll
            for (int k4 = 0; k4 < 4; ++k4)
#pragma unroll
                for (int nt = 0; nt < 3; ++nt) { acc[nt] = mfma16(bh[k4][nt], ah[k4], acc[nt]); acc[nt] = mfma16(bl[k4][nt], ah[k4], acc[nt]); }
            SCHED_FENCE(); }
#pragma unroll
        for (int nt = 0; nt < 3; ++nt) *(LAS f32x4*)(lg + fr * 48 + nt * 16 + 4 * fq) = acc[nt];
        WAVE_SYNC();
        if (lane < 16) { const int t = t0 + lane; const LAS float* p = lg + lane * 48; const float rs = rstd_np(ssq, np, t);
            const float g0 = p[0] * rs + bg[0], g1 = p[1] * rs + bg[1], g2 = p[2] * rs + bg[2], g3 = p[3] * rs + bg[3];
            int gsel = 0; float gm = g0; if (g1 > gm) { gm = g1; gsel = 1; } if (g2 > gm) { gm = g2; gsel = 2; } if (g3 > gm) { gm = g3; gsel = 3; }
            const float gwt = 1.f / (expf(g0 - gm) + expf(g1 - gm) + expf(g2 - gm) + expf(g3 - gm));
            const LAS float* pe = p + 4 + gsel * 8; const float* bb = be + gsel * 8;
            float e[8];
#pragma unroll
            for (int j = 0; j < 8; ++j) e[j] = pe[j] * rs + bb[j];
            int i1 = 0; float m1 = e[0];
#pragma unroll
            for (int j = 1; j < 8; ++j) if (e[j] > m1) { m1 = e[j]; i1 = j; }
            int i2 = -1; float m2 = -3.0e38f;
#pragma unroll
            for (int j = 0; j < 8; ++j) if (j != i1 && e[j] > m2) { m2 = e[j]; i2 = j; }
            const float r = expf(m2 - m1); const float w1 = gwt / (1.f + r), w2 = gwt * r / (1.f + r);
            const int e1 = gsel * 8 + i1, e2 = gsel * 8 + i2;
            OKP(int, WS_EID)[t * 2] = e1; OKP(int, WS_EID)[t * 2 + 1] = e2; OKP(float, WS_GATEW)[t * 2] = w1; OKP(float, WS_GATEW)[t * 2 + 1] = w2;
            OKP(int, WS_POS)[t * 2] = (int)atomicAdd(cnt + e1, 1u); OKP(int, WS_POS)[t * 2 + 1] = (int)atomicAdd(cnt + e2, 1u); }
        WAVE_SYNC();
    }
}

__device__ __forceinline__ void phase_scatter(const Frame& F0, int l, const bf16_t* hb, const float* ssq, int np) {
    const Frame F = phase_frame(F0);
    const unsigned* cnt = F.ctl + CW_MOE + l * 64; const int lane = F.lane;
    const int gw = F.vcu * NWAVES + F.wave, NGW = F.G * NWAVES;
    int base = 0;
    { int tiles = lane < 32 ? (((int)cnt[lane & 31] + 255) >> 8) : 0; int incl = tiles;
#pragma unroll
      for (int o = 1; o < 32; o <<= 1) { const int n = shfl_src(incl, lane >= o ? lane - o : lane); if ((lane & 31) >= o) incl += n; }
      base = (incl - tiles) * 256;
      const int cnt_e = lane < 32 ? (int)cnt[lane & 31] : 0; const int light = (tiles > 0 && cnt_e - 256 * (tiles - 1) <= 128) ? 1 : 0, full = tiles - light;
      int fincl = full, lincl = light;
#pragma unroll
      for (int o = 1; o < 32; o <<= 1) { const int sl = lane >= o ? lane - o : lane; const int n1 = shfl_src(fincl, sl), n2 = shfl_src(lincl, sl); if ((lane & 31) >= o) { fincl += n1; lincl += n2; } }
      const int ntiles = shfl_src(incl, 31), nfull = shfl_src(fincl, 31);
      if (blockIdx.x == 0 && F.wave == 0) { if (lane < 32) { for (int i = 0; i < tiles; ++i) OKP(int, WS_TILEEXP)[(base >> 8) + i] = lane;
              for (int i = 0; i < full; ++i) OKP(int, WS_TILEEXP)[512 + (fincl - full) + i] = (base >> 8) + i;
              if (light) OKP(int, WS_TILEEXP)[512 + nfull + (lincl - 1)] = ((base >> 8) + tiles - 1) | (1 << 16); }
          if (lane == 0) OKP(int, WS_TILEEXP)[1023] = ntiles; } }
    for (int a0 = gw * 4; a0 < T * 2; a0 += NGW * 4) {
        int slot[4]; u32x4 r0[4], r1[4];
#pragma unroll
        for (int k = 0; k < 4; ++k) { const int a = a0 + k; const int e = OKP(int, WS_EID)[a]; slot[k] = shfl_src(base, e) + OKP(int, WS_POS)[a]; }
#pragma unroll
        for (int k = 0; k < 4; ++k) { const u32x4* src = (const u32x4*)(hb + (size_t)((a0 + k) >> 1) * DM) + lane; r0[k] = src[0]; r1[k] = src[64]; }
#pragma unroll
        for (int k = 0; k < 4; ++k) { const int a = a0 + k, t = a >> 1; u32x4* dst = (u32x4*)(OKP(bf16_t, WS_XS) + (size_t)slot[k] * DM) + lane; dst[0] = r0[k]; dst[64] = r1[k];
            if (lane == 0) { OKP(int, WS_TOKSLOT)[a] = slot[k]; OKP(float, WS_SLOTGATE)[slot[k]] = OKP(float, WS_GATEW)[a]; OKP(float, WS_SLOTRSTD)[slot[k]] = rstd_np(ssq, np, t); } } }
}

__device__ __forceinline__ void phase_combine(const Frame& F0, bf16_t* hb, float* ssq, bool final_layer) {
    using namespace sm;
    const Frame F = phase_frame(F0);
    const int lane = F.lane; const int gw = F.vcu * NWAVES + F.wave, NGW = F.G * NWAVES; const bf16_t* y = OKP(bf16_t, WS_Y);
    for (int t0 = gw * 2; t0 < T; t0 += NGW * 2) {
        int sa[2], sb[2];
#pragma unroll
        for (int k = 0; k < 2; ++k) { sa[k] = OKP(int, WS_TOKSLOT)[(t0 + k) * 2]; sb[k] = OKP(int, WS_TOKSLOT)[(t0 + k) * 2 + 1]; }
        u32x2 ra[2][4], rb[2][4], rh[2][4];
#pragma unroll
        for (int k = 0; k < 2; ++k) { const u32x2* hr = (const u32x2*)(hb + (size_t)(t0 + k) * DM) + lane; const u32x2* ya = (const u32x2*)(y + (size_t)sa[k] * DM) + lane; const u32x2* yb = (const u32x2*)(y + (size_t)sb[k] * DM) + lane;
#pragma unroll
            for (int j = 0; j < 4; ++j) { ra[k][j] = ya[64 * j]; rb[k][j] = yb[64 * j]; rh[k][j] = hr[64 * j]; } }
#pragma unroll
        for (int k = 0; k < 2; ++k) { const int t = t0 + k; u32x2* hr = (u32x2*)(hb + (size_t)t * DM) + lane; f32x4 v[4]; float s = 0.f;
#pragma unroll
            for (int j = 0; j < 4; ++j) { const u32x2 a = ra[k][j], b = rb[k][j], hw = rh[k][j]; f32x4 x;
                x[0] = bflo(hw.x) + (bflo(a.x) + bflo(b.x)); x[1] = bfhi(hw.x) + (bfhi(a.x) + bfhi(b.x)); x[2] = bflo(hw.y) + (bflo(a.y) + bflo(b.y)); x[3] = bfhi(hw.y) + (bfhi(a.y) + bfhi(b.y));
                if (!final_layer) { u32x2 w; w.x = cvt_pk_bf16(x[0], x[1]); w.y = cvt_pk_bf16(x[2], x[3]); hr[64 * j] = w; x = (f32x4){bflo(w.x), bfhi(w.x), bflo(w.y), bfhi(w.y)}; }
                v[j] = x; s += (x[0] * x[0] + x[1] * x[1]) + (x[2] * x[2] + x[3] * x[3]); }
            s = wave_sum(s);
            if (!final_layer) { if (lane == 0) ssq[t] = s; }
            else { const float rs = frsq(s * (1.f / DM) + EPS); f32x4* orow = (f32x4*)(F.out + (size_t)t * DM) + lane; const f32x4* gr = (const f32x4*)F.in[I_FINAL_NORM] + lane;
#pragma unroll
                for (int j = 0; j < 4; ++j) { const f32x4 g = gr[64 * j]; f32x4 o; o[0] = v[j][0] * rs * g[0]; o[1] = v[j][1] * rs * g[1]; o[2] = v[j][2] * rs * g[2]; o[3] = v[j][3] * rs * g[3]; orow[64 * j] = o; } } } }
}

#ifndef CPU_EMU
struct MoeOrder {
    static constexpr bool LIGHT = true;
    const char* A; const char* W; const int* tile_exp; size_t a_tstep, w_estride, w_off, w_tstep; int G, c;
    __device__ bool next(int i, pg8::Unit& u) const {
        const int Lx = i * G + c; const int ntiles = tile_exp[1023]; if (Lx >= ntiles * 4) return false;
        const int info = tile_exp[512 + (Lx >> 2)], tile = info & 0xffff; u.pm = tile; u.pn = Lx & 3; u.tag = info >> 16; const int e = tile_exp[tile];
        u.a = A + (size_t)tile * a_tstep; u.b = W + (size_t)e * w_estride + w_off + (size_t)u.pn * w_tstep; return true;
    }
    __device__ __forceinline__ void a_ready(const pg8::Unit&) const {}
    __device__ __forceinline__ void done(const pg8::Unit&) const {}
};
struct EpiSwiGLU {
    static constexpr bool PERM = false, AFTER_DRAIN = false;
    bf16_t* act; const float* slot_rstd;
    __device__ __forceinline__ void operator()(const f32x4 (&acc)[2][2][4][2], const pg8::Unit& u, int wr, int wc, int fr, int fq) const {
        const int row0 = u.pm * 256 + wr * 64 + fr, col0 = u.pn * 128 + wc * 16 + 4 * fq;
        float rs8[2][4];
#pragma unroll
        for (int i = 0; i < 8; ++i) rs8[i >> 2][i & 3] = slot_rstd[row0 + (i >> 2) * 128 + (i & 3) * 16];
        SCHED_FENCE();
#pragma unroll
        for (int ai = 0; ai < 2; ++ai)
#pragma unroll
            for (int m = 0; m < 4; ++m) { const int row = row0 + ai * 128 + m * 16; const float rs = rs8[ai][m]; bf16_t* rowp = act + (size_t)row * 512 + col0;
#pragma unroll
                for (int bj = 0; bj < 2; ++bj) { const f32x4 g = acc[ai][bj][m][0] * rs, up = acc[ai][bj][m][1] * rs; f32x4 o;
#pragma unroll
                    for (int r = 0; r < 4; ++r) o[r] = g[r] * frcp(1.f + fexp(-g[r])) * up[r];
                    u32x2 w; w.x = cvt_pk_bf16(o[0], o[1]); w.y = cvt_pk_bf16(o[2], o[3]); *(u32x2*)(rowp + bj * 64) = w; } }
    }
};
struct EpiDown {
    static constexpr bool PERM = true, AFTER_DRAIN = false;
    bf16_t* y; const float* slot_gate;
    __device__ __forceinline__ void operator()(const f32x4 (&acc)[2][2][4][2], const pg8::Unit& u, int wr, int wc, int fr, int fq) const {
        const int row0 = u.pm * 256 + wr * 64 + fr, col0 = u.pn * 256 + wc * 32 + 8 * fq;
        float sg8[2][4];
#pragma unroll
        for (int i = 0; i < 8; ++i) sg8[i >> 2][i & 3] = slot_gate[row0 + (i >> 2) * 128 + (i & 3) * 16];
        SCHED_FENCE();
#pragma unroll
        for (int ai = 0; ai < 2; ++ai)
#pragma unroll
            for (int m = 0; m < 4; ++m) { const int row = row0 + ai * 128 + m * 16; const float s = sg8[ai][m]; bf16_t* rowp = y + (size_t)row * DM + col0;
#pragma unroll
                for (int bj = 0; bj < 2; ++bj) { const f32x4 v0 = acc[ai][bj][m][0] * s, v1 = acc[ai][bj][m][1] * s; u32x4 w; w.x = cvt_pk_bf16(v0[0], v0[1]); w.y = cvt_pk_bf16(v0[2], v0[3]); w.z = cvt_pk_bf16(v1[0], v1[1]); w.w = cvt_pk_bf16(v1[2], v1[3]);
                    *(u32x4*)(rowp + bj * 128) = w; } }
    }
};
__device__ __forceinline__ void phase_moe_up(const Frame& F) {
    pg8::Gemm g{nullptr, nullptr, 0, 0, 1024};
    MoeOrder S{(const char*)OKP(bf16_t, WS_XS), (const char*)OKP(bf16_t, WS_MOEW), OKP(int, WS_TILEEXP), (size_t)256 * 1024 * 2, 3 * MiB, 0, (size_t)256 * 1024 * 2, F.G, (int)blockIdx.x};
    EpiSwiGLU E{OKP(bf16_t, WS_ACT), OKP(float, WS_SLOTRSTD)};
    pg8::gemm_phase<EpiSwiGLU, MoeOrder, true, true>(F.lds, g, S, E, F.wave);
}
__device__ __forceinline__ void phase_moe_down(const Frame& F) {
    pg8::Gemm g{nullptr, nullptr, 0, 0, 512};
    MoeOrder S{(const char*)OKP(bf16_t, WS_ACT), (const char*)OKP(bf16_t, WS_MOEW), OKP(int, WS_TILEEXP), (size_t)256 * 512 * 2, 3 * MiB, 2 * MiB, (size_t)256 * 512 * 2, F.G, (int)blockIdx.x};
    EpiDown E{OKP(bf16_t, WS_Y), OKP(float, WS_SLOTGATE)};
    pg8::gemm_phase<EpiDown, MoeOrder, true, true>(F.lds, g, S, E, F.wave);
}
#endif
}

#ifndef DUP_MASK
#define DUP_MASK 0
#endif
namespace ok {
constexpr size_t WS_GU = 160 * MiB, WS_GW = 192 * MiB, WS_GQD = 224 * MiB, WS_GKDT = 480 * MiB, WS_GAQK = 512 * MiB;
constexpr size_t WS_GDEC = WS_GCS;
constexpr size_t WS_OBUF = WS_H;
constexpr int G_LD = 132, GB_LD = 136, LM_LD = 68, LB_LD = 72, XT_LD2 = 68;
__device__ __forceinline__ float sigmoidf_(float x) { return frcp(1.f + fexp(-x)); }

template <int PARTS  > __device__ __forceinline__ void phase_gdn_prep_t(const Frame& F0) {
    using namespace sm;
    const Frame F = phase_frame(F0);
    LAS float* q_s = (LAS float*)F.lds; LAS float* k_s = (LAS float*)(F.lds + 33792); LAS float* v_s = (LAS float*)(F.lds + 67584);
    LAS bf16_t* Kn = (LAS bf16_t*)(F.lds + 101376); LAS bf16_t* Qn = (LAS bf16_t*)(F.lds + 118784);
    LAS float* g_s = (LAS float*)(F.lds + 136192); LAS float* beta_s = g_s + 64; LAS float* gc_s = g_s + 128; LAS float* eg_s = g_s + 192; LAS float* rq_s = g_s + 256; LAS float* rk_s = g_s + 320;
    LAS float* Lm = q_s;
    LAS bf16_t* Lb16 = (LAS bf16_t*)(F.lds + 17408);
    LAS bf16_t* InvH = (LAS bf16_t*)(F.lds + 26624); LAS bf16_t* InvL = (LAS bf16_t*)(F.lds + 28672);
    const int tid = F.tid, lane = F.lane, wave = F.wave, fr = lane & 15, fq = lane >> 4;
    const bf16_t* proj = OKP(bf16_t, WS_PROJ); const float* cw = F.in[I_OD_CONV];
    for (int u = F.vcu; u < NB * NCH * 8; u += F.G) {
        const int hd = u & 7, bc = u >> 3, b = bc / NCH, c = bc % NCH; const size_t row0 = (size_t)b * L + c * 64; const size_t ub = (size_t)bc * 8 + hd;
        LDS_BARRIER();
        if ((PARTS & 1) && tid < 384) { const int which = tid >> 7, d = tid & 127, xc = which * 1024 + hd * 128 + d; LAS float* dst = (which == 0 ? q_s : which == 1 ? k_s : v_s) + d;
            const float w0 = cw[xc], w1 = cw[3072 + xc], w2 = cw[6144 + xc], w3 = cw[9216 + xc]; const bf16_t* p = proj + row0 * PROJ1_LD + xc;
            const int hb_ = c > 0 ? 1 : 0; const unsigned short h0 = p[-3 * PROJ1_LD * hb_], h1 = p[-2 * PROJ1_LD * hb_], h2 = p[-PROJ1_LD * hb_];
            unsigned short raw[64]; float pacc = 0.f;
#pragma unroll
            for (int t = 0; t < 64; ++t) raw[t] = p[(size_t)t * PROJ1_LD];
            SCHED_FENCE();
            float x0 = hb_ ? bf2f(h0) : 0.f, x1 = hb_ ? bf2f(h1) : 0.f, x2 = hb_ ? bf2f(h2) : 0.f;
#pragma unroll
            for (int t = 0; t < 64; ++t) { const float x3 = bf2f(raw[t]); const float v = w0 * x0 + w1 * x1 + w2 * x2 + w3 * x3; if (PARTS & 32) dst[t * G_LD] = v; else if (PARTS & 128) { pacc += siluf(v); if ((t & 15) == 15) dst[t * G_LD] = pacc; } else dst[t * G_LD] = siluf(v); x0 = x1; x1 = x2; x2 = x3; } }
        if ((PARTS & 1) && !(PARTS & 64) && tid >= 448) { const int t = tid - 448; const float* r16 = OKP(float, WS_RAW16) + (row0 + t) * 16;
            g_s[t] = -expf(F.in[I_OD_ALOG][hd]) * softplusf(r16[hd] + F.in[I_OD_DTB][hd]); beta_s[t] = sigmoidf_(r16[8 + hd]); }
        LDS_BARRIER();
        if (!(PARTS & 1) || (PARTS & 64)) {} else if (wave == 0) { float v = g_s[lane];
#pragma unroll
            for (int o = 1; o < 64; o <<= 1) { const float n = __shfl_up(v, o); if (lane >= o) v += n; }
            gc_s[lane] = v; eg_s[lane] = fexp(v); if (lane == 63) OKP(float, WS_GDEC)[ub] = fexp(v); }
        else if (wave <= 2) { const LAS float* src = (wave == 1 ? q_s : k_s) + lane * G_LD; float s = 0.f;
#pragma unroll 8
            for (int d = 0; d < 128; d += 4) { const f32x4 x = *(const LAS f32x4*)(src + d); s += (x.x * x.x + x.y * x.y) + (x.z * x.z + x.w * x.w); }
            const float r = frsq(s + EPS); if (wave == 1) rq_s[lane] = r * 0.08838834764831845f; else rk_s[lane] = r; }
        LDS_BARRIER();
        if (PARTS & 2)
        { const float gl = gc_s[63];
          for (int i = tid; i < 64 * 64; i += NT) { const int t = i >> 6, dp = (i & 63) * 2; const float rk = rk_s[t], rq = rq_s[t], eg = eg_s[t];
              const float k0 = k_s[t * G_LD + dp] * rk, k1 = k_s[t * G_LD + dp + 1] * rk, q0 = q_s[t * G_LD + dp] * rq, q1 = q_s[t * G_LD + dp + 1] * rq;
              *(LAS unsigned*)(Kn + t * GB_LD + dp) = cvt_pk_bf16(k0, k1); *(LAS unsigned*)(Qn + t * GB_LD + dp) = cvt_pk_bf16(q0, q1);
              *(unsigned*)(OKP(bf16_t, WS_GQD) + ub * 8192 + t * 128 + dp) = cvt_pk_bf16(q0 * eg, q1 * eg); }
          { const int t = tid & 63, dg = tid >> 6; const float f = rk_s[t] * fexp(gl - gc_s[t]); bf16_t* dst = OKP(bf16_t, WS_GKDT) + ub * 8192 + t;
#pragma unroll
            for (int j = 0; j < 16; ++j) { const int d = dg * 16 + j; dst[d * 64] = (bf16_t)(cvt_pk_bf16(k_s[t * G_LD + d] * f, 0.f) & 0xffffu); } } }
        LDS_BARRIER();
        if (PARTS & 4)
#pragma unroll
        for (int i = 0; i < 4; ++i) { const int tl = wave * 4 + i, which = tl >> 4, ti = (tl >> 2) & 3, si = tl & 3;
            f32x4 acc = {0.f, 0.f, 0.f, 0.f};
            if (si <= ti) {
#pragma unroll
                for (int ks = 0; ks < 4; ++ks) { const bf16x8 a = *(const LAS bf16x8*)(Kn + (si * 16 + fr) * GB_LD + ks * 32 + fq * 8); const bf16x8 bb = *(const LAS bf16x8*)((which ? Qn : Kn) + (ti * 16 + fr) * GB_LD + ks * 32 + fq * 8); acc = mfma16(a, bb, acc); }
                const int t = ti * 16 + fr; const float gt = gc_s[t], bt = beta_s[t];
#pragma unroll
                for (int r = 0; r < 4; ++r) { const int s = si * 16 + 4 * fq + r; const float dec = fexp(gt - gc_s[s]); acc[r] = which ? (s <= t ? acc[r] * dec : 0.f) : (s < t ? acc[r] * dec * bt : 0.f); } }
            const int t = ti * 16 + fr, s0 = si * 16 + 4 * fq;
            if (which) { u32x2 w; w.x = cvt_pk_bf16(acc[0], acc[1]); w.y = cvt_pk_bf16(acc[2], acc[3]); *(u32x2*)(OKP(bf16_t, WS_GAQK) + ub * 4096 + t * 64 + s0) = w; }
            else { Lm[(s0 + 0) * LM_LD + t] = acc[0]; Lm[(s0 + 1) * LM_LD + t] = acc[1]; Lm[(s0 + 2) * LM_LD + t] = acc[2]; Lm[(s0 + 3) * LM_LD + t] = acc[3];
                u32x2 w; w.x = cvt_pk_bf16(-acc[0], -acc[1]); w.y = cvt_pk_bf16(-acc[2], -acc[3]); *(LAS u32x2*)(Lb16 + t * LB_LD + s0) = w; } }
        LDS_BARRIER();
        if (PARTS & 8) {
            if (wave == 0) { const int ib = lane >> 4, c = lane & 15; float y[16];
#pragma unroll
                for (int tt = 0; tt < 16; ++tt) y[tt] = tt == c ? 1.f : 0.f;
#pragma unroll
                for (int ss = 0; ss < 16; ++ss) { const float xv = y[ss]; const LAS f32x4* lp = (const LAS f32x4*)(Lm + (ib * 16 + ss) * LM_LD + ib * 16);
#pragma unroll
                    for (int q4 = ss / 4; q4 < 4; ++q4) { const f32x4 l4 = lp[q4];
#pragma unroll
                        for (int r = 0; r < 4; ++r) if (q4 * 4 + r > ss) y[q4 * 4 + r] -= l4[r] * xv; } }
#pragma unroll
                for (int tt = 0; tt < 16; ++tt) { const unsigned hi = cvt_pk_bf16(y[tt], 0.f) & 0xffffu; InvH[(ib * 16 + tt) * 16 + c] = (bf16_t)hi; InvL[(ib * 16 + tt) * 16 + c] = (bf16_t)(cvt_pk_bf16(y[tt] - bflo(hi), 0.f) & 0xffffu); } }
            LDS_BARRIER();
            const bool isw = wave >= 4; const LAS float* Rb = isw ? k_s : v_s;
#pragma unroll
            for (int ct2 = 0; ct2 < 2; ++ct2) { const int cl = ((wave & 3) * 2 + ct2) * 16 + fr;
                u32x2 xp[4];
#pragma unroll
                for (int ib = 0; ib < 4; ++ib) { const int t4 = ib * 16 + 4 * fq;
                    f32x4 sc = *(const LAS f32x4*)(beta_s + t4); if (isw) sc = sc * *(const LAS f32x4*)(rk_s + t4) * *(const LAS f32x4*)(eg_s + t4);
                    f32x4 acc;
#pragma unroll
                    for (int r = 0; r < 4; ++r) acc[r] = Rb[(t4 + r) * G_LD + cl] * sc[r];
                    const LAS bf16_t* lrow = Lb16 + (ib * 16 + fr) * LB_LD + 4 * fq;
                    if (ib >= 1) { const u32x2 a0 = *(const LAS u32x2*)lrow; u32x2 a1 = {0u, 0u}, b1 = {0u, 0u}; if (ib >= 2) { a1 = *(const LAS u32x2*)(lrow + 16); b1 = xp[1]; }
                        u32x4 A; A.x = a0.x; A.y = a0.y; A.z = a1.x; A.w = a1.y; u32x4 B; B.x = xp[0].x; B.y = xp[0].y; B.z = b1.x; B.w = b1.y;
                        acc = mfma16(__builtin_bit_cast(bf16x8, A), __builtin_bit_cast(bf16x8, B), acc); }
                    if (ib == 3) { const u32x2 a0 = *(const LAS u32x2*)(lrow + 32); u32x4 A; A.x = a0.x; A.y = a0.y; A.z = 0u; A.w = 0u; u32x4 B; B.x = xp[2].x; B.y = xp[2].y; B.z = 0u; B.w = 0u;
                        acc = mfma16(__builtin_bit_cast(bf16x8, A), __builtin_bit_cast(bf16x8, B), acc); }
                    u32x4 rh, rl; rh.x = cvt_pk_bf16(acc[0], acc[1]); rh.y = cvt_pk_bf16(acc[2], acc[3]); rh.z = 0u; rh.w = 0u;
                    rl.x = cvt_pk_bf16(acc[0] - bflo(rh.x), acc[1] - bfhi(rh.x)); rl.y = cvt_pk_bf16(acc[2] - bflo(rh.y), acc[3] - bfhi(rh.y)); rl.z = 0u; rl.w = 0u;
                    const u32x2 ih2 = *(const LAS u32x2*)(InvH + (ib * 16 + fr) * 16 + 4 * fq), il2 = *(const LAS u32x2*)(InvL + (ib * 16 + fr) * 16 + 4 * fq);
                    u32x4 ih, il; ih.x = ih2.x; ih.y = ih2.y; ih.z = 0u; ih.w = 0u; il.x = il2.x; il.y = il2.y; il.z = 0u; il.w = 0u;
                    f32x4 x = {0.f, 0.f, 0.f, 0.f};
                    x = mfma16(__builtin_bit_cast(bf16x8, ih), __builtin_bit_cast(bf16x8, rh), x); x = mfma16(__builtin_bit_cast(bf16x8, il), __builtin_bit_cast(bf16x8, rh), x); x = mfma16(__builtin_bit_cast(bf16x8, ih), __builtin_bit_cast(bf16x8, rl), x);
                    u32x2 xb; xb.x = cvt_pk_bf16(x[0], x[1]); xb.y = cvt_pk_bf16(x[2], x[3]); xp[ib] = xb;
                    if (!isw) *(u32x2*)(OKP(bf16_t, WS_GU) + ub * 8192 + (size_t)(ib * 4 + fq) * 512 + cl * 4) = xb;
                    else { bf16_t* dst = OKP(bf16_t, WS_GW) + ub * 8192 + (size_t)t4 * 128 + cl;
                        dst[0] = (bf16_t)(xb.x & 0xffffu); dst[128] = (bf16_t)(xb.x >> 16); dst[256] = (bf16_t)(xb.y & 0xffffu); dst[384] = (bf16_t)(xb.y >> 16); }
                }
            }
        }
    }
}
}

namespace ok {
constexpr int ST_LD = 136, VT_LD = 72;
__device__ __forceinline__ void phase_gdn_prep(const Frame& F0) { phase_gdn_prep_t<15>(F0); }
constexpr int GJT = 4, GDV = GJT * 16, GN_UNITS = NB * 8 * (128 / GDV);
static_assert(GJT == 4, "the Z slot below is sized for four column tiles");
struct GdnEarly { bf16x8 X[4]; u32x2 Z[4]; };
struct GdnLate { bf16x8 Kf[2]; float dec; };
__device__ __forceinline__ void gdn_load_early(GdnEarly& g, const Frame& F, size_t xoff, size_t ub, int ti, int sl, int fr, int fq, int roleB) {
    const bf16_t* Xp = (const bf16_t*)(F.ws + xoff) + ub * 8192 + (ti * 16 + fr) * 128 + fq * 8;
#pragma unroll
    for (int ks = 0; ks < 4; ++ks) g.X[ks] = *(const bf16x8*)(Xp + ks * 32);
    const bf16_t* zb = roleB ? OKP(bf16_t, WS_GAQK) + ub * 4096 + (ti * 16 + fr) * 64 + fq * 8 : OKP(bf16_t, WS_GU) + ub * 8192 + ((size_t)(ti * 4 + fq) * 128 + sl * GDV + fr) * 4;
#pragma unroll
    for (int i = 0; i < 4; ++i) g.Z[i] = *(const u32x2*)(zb + (roleB ? (i >> 1) * 32 + (i & 1) * 4 : i * 64));
}
__device__ __forceinline__ void gdn_load_late(GdnLate& g, const Frame& F, size_t ub, int ti, int wave, int fr, int fq, int vzero) {
    const bf16_t* Kp = OKP(bf16_t, WS_GKDT) + ub * 8192 + (wave * 16 + fr) * 64 + fq * 8;
#pragma unroll
    for (int k2 = 0; k2 < 2; ++k2) g.Kf[k2] = *(const bf16x8*)(Kp + k2 * 32);
    g.dec = OKP(float, WS_GDEC)[ub + vzero];
}
constexpr int OS_LD = GDV + 8;
__device__ __forceinline__ void gdn_flush_o(const Frame& F, const LAS bf16_t* Os, int b, int cprev, int hd, int sl) {
    constexpr int PCS = GDV / 8;
    if (F.tid < 64 * PCS) { const int row = F.tid / PCS, pc = F.tid % PCS; *(u32x4*)(OKP(bf16_t, WS_OBUF) + ((size_t)b * L + cprev * 64 + row) * 1024 + hd * 128 + sl * GDV + pc * 8) = *(const LAS u32x4*)(Os + row * OS_LD + pc * 8); }
}
__device__ __forceinline__ void gdn_step(const Frame& F, const GdnEarly& g, const GdnLate& h, f32x4 (&Sacc)[GJT], LAS bf16_t* ST0, LAS bf16_t* VnT, int par, int roleB, int b, int c, int hd, int sl, int ti, int wave, int fr, int fq) {
    LAS bf16_t* ST = ST0 + par * (GDV * ST_LD); LAS bf16_t* STn = ST0 + (par ^ 1) * (GDV * ST_LD);
    LAS bf16_t* Os = VnT + GDV * VT_LD;
    LDS_BARRIER();
    if (c > 0) gdn_flush_o(F, Os, b, c - 1, hd, sl);
    f32x4 a[GJT];
#pragma unroll
    for (int ji = 0; ji < GJT; ++ji) a[ji] = (f32x4){0.f, 0.f, 0.f, 0.f};
#pragma unroll
    for (int ks = 0; ks < 4; ++ks)
#pragma unroll
        for (int ji = 0; ji < GJT; ++ji) { const bf16x8 sf = *(const LAS bf16x8*)(ST + (ji * 16 + fr) * ST_LD + ks * 32 + fq * 8); a[ji] = mfma16(g.X[ks], sf, a[ji]); }
    if (!roleB) {
#pragma unroll
        for (int ji = 0; ji < GJT; ++ji) { const u32x2 uv = g.Z[ji]; u32x2 w; w.x = cvt_pk_bf16(bflo(uv.x) - a[ji][0], bfhi(uv.x) - a[ji][1]); w.y = cvt_pk_bf16(bflo(uv.y) - a[ji][2], bfhi(uv.y) - a[ji][3]);
            *(LAS u32x2*)(VnT + (ji * 16 + fr) * VT_LD + ti * 16 + 4 * fq) = w; } }
    LDS_BARRIER();
#pragma unroll
    for (int ji = 0; ji < GJT; ++ji) { bf16x8 vf[2];
#pragma unroll
        for (int k2 = 0; k2 < 2; ++k2) vf[k2] = *(const LAS bf16x8*)(VnT + (ji * 16 + fr) * VT_LD + k2 * 32 + fq * 8);
        if (roleB) {
#pragma unroll
            for (int k2 = 0; k2 < 2; ++k2) { u32x4 af; af.x = g.Z[2 * k2].x; af.y = g.Z[2 * k2].y; af.z = g.Z[2 * k2 + 1].x; af.w = g.Z[2 * k2 + 1].y; a[ji] = mfma16(__builtin_bit_cast(bf16x8, af), vf[k2], a[ji]); }
            LAS bf16_t* op = Os + (ti * 16 + 4 * fq) * OS_LD + ji * 16 + fr;
#pragma unroll
            for (int r = 0; r < 4; ++r) op[r * OS_LD] = (bf16_t)(cvt_pk_bf16(a[ji][r], 0.f) & 0xffffu); }
        Sacc[ji] *= h.dec;
#pragma unroll
        for (int k2 = 0; k2 < 2; ++k2) Sacc[ji] = mfma16(h.Kf[k2], vf[k2], Sacc[ji]);
        u32x2 w; w.x = cvt_pk_bf16(Sacc[ji][0], Sacc[ji][1]); w.y = cvt_pk_bf16(Sacc[ji][2], Sacc[ji][3]); *(LAS u32x2*)(STn + (ji * 16 + fr) * ST_LD + wave * 16 + 4 * fq) = w; }
}
template <int MODE  > __device__ __forceinline__ void gdn_scan_unit_t(const Frame& F, int unit) {
    LAS bf16_t* ST = (LAS bf16_t*)F.lds; LAS bf16_t* VnT = (LAS bf16_t*)(F.lds + 2 * GDV * ST_LD * 2);
    const int tid = F.tid, lane = F.lane, wave = F.wave, fr = lane & 15, fq = lane >> 4;
    constexpr int NSL = 128 / GDV;
    const int sl = unit % NSL, hd = (unit / NSL) & 7, b = unit / (NSL * 8), ti = wave & 3, roleB = wave >> 2;
    for (int i = tid; i < GDV * ST_LD / 2; i += NT) ((LAS unsigned*)ST)[i] = 0u;
    f32x4 Sacc[GJT];
#pragma unroll
    for (int ji = 0; ji < GJT; ++ji) Sacc[ji] = (f32x4){0.f, 0.f, 0.f, 0.f};
    const size_t ub0 = ((size_t)b * NCH) * 8 + hd; const size_t xoff = roleB ? WS_GQD : WS_GW;
    int vzero = 0;
#ifndef CPU_EMU
    asm volatile("" : "+v"(vzero));
#endif
#define GDN_LE(set, cc) if (MODE == 0) gdn_load_early(set, F, xoff, ub0 + (size_t)((cc) < NCH ? (cc) : NCH - 1) * 8, ti, sl, fr, fq, roleB)
#define GDN_LL(set, cc) if (MODE == 0) gdn_load_late(set, F, ub0 + (size_t)((cc) < NCH ? (cc) : NCH - 1) * 8, ti, wave, fr, fq, vzero)
#define GDN_ST(es, ls, cc, par) gdn_step(F, es, ls, Sacc, ST, VnT, par, roleB, b, (MODE == 0 ? (cc) : 0), hd, sl, ti, wave, fr, fq)
    GdnEarly e0, e1, e2; GdnLate l0, l1;
    GDN_LE(e0, 0); GDN_LE(e1, 1); GDN_LL(l0, 0);
    if (MODE == 1) { gdn_load_early(e0, F, xoff, ub0, ti, sl, fr, fq, roleB); gdn_load_early(e1, F, xoff, ub0, ti, sl, fr, fq, roleB); gdn_load_early(e2, F, xoff, ub0, ti, sl, fr, fq, roleB); gdn_load_late(l0, F, ub0, ti, wave, fr, fq, vzero); gdn_load_late(l1, F, ub0, ti, wave, fr, fq, vzero); }
    int c = 0;
    for (; c + 6 <= NCH; c += 6) {
        GDN_LE(e2, c + 2); GDN_LL(l1, c + 1); GDN_ST(e0, l0, c + 0, 0);
        GDN_LE(e0, c + 3); GDN_LL(l0, c + 2); GDN_ST(e1, l1, c + 1, 1);
        GDN_LE(e1, c + 4); GDN_LL(l1, c + 3); GDN_ST(e2, l0, c + 2, 0);
        GDN_LE(e2, c + 5); GDN_LL(l0, c + 4); GDN_ST(e0, l1, c + 3, 1);
        GDN_LE(e0, c + 6); GDN_LL(l1, c + 5); GDN_ST(e1, l0, c + 4, 0);
        GDN_LE(e1, c + 7); GDN_LL(l0, c + 6); GDN_ST(e2, l1, c + 5, 1);
    }
    if (c + 0 < NCH) { GDN_LE(e2, c + 2); GDN_LL(l1, c + 1); GDN_ST(e0, l0, c + 0, 0); }
    if (c + 1 < NCH) { GDN_LE(e0, c + 3); GDN_LL(l0, c + 2); GDN_ST(e1, l1, c + 1, 1); }
    if (c + 2 < NCH) { GDN_LE(e1, c + 4); GDN_LL(l1, c + 3); GDN_ST(e2, l0, c + 2, 0); }
    if (c + 3 < NCH) { GDN_LE(e2, c + 5); GDN_LL(l0, c + 4); GDN_ST(e0, l1, c + 3, 1); }
    if (c + 4 < NCH) { GDN_LE(e0, c + 6); GDN_LL(l1, c + 5); GDN_ST(e1, l0, c + 4, 0); }
#undef GDN_LE
#undef GDN_LL
#undef GDN_ST
    LDS_BARRIER();
    if (MODE == 0) gdn_flush_o(F, VnT + GDV * VT_LD, b, NCH - 1, hd, sl);
}
__device__ __forceinline__ void gdn_scan_unit(const Frame& F, int unit) { gdn_scan_unit_t<0>(F, unit); }
__device__ __forceinline__ void phase_gdn_final(const Frame& F0) {
    using namespace sm;
    const Frame F = phase_frame(F0);
    const int lane = F.lane; const int gw = F.vcu * NWAVES + F.wave, NGW = F.G * NWAVES;
    const f32x4* nw4 = (const f32x4*)(F.in[I_OD_NORM] + (lane & 7) * 16);
    u32x4 na[2], nz[2]; { const int t = gw < T ? gw : 0; const u32x4* op = (const u32x4*)(OKP(bf16_t, WS_OBUF) + (size_t)t * 1024 + lane * 16); const u32x4* zp = (const u32x4*)(OKP(bf16_t, WS_PROJ) + (size_t)t * PROJ1_LD + 3072 + lane * 16); na[0] = op[0]; na[1] = op[1]; nz[0] = zp[0]; nz[1] = zp[1]; }
    for (int t = gw; t < T; t += NGW) { const u32x4 ca[2] = {na[0], na[1]}, cz[2] = {nz[0], nz[1]};
        { const int tn = t + NGW < T ? t + NGW : t; const u32x4* op = (const u32x4*)(OKP(bf16_t, WS_OBUF) + (size_t)tn * 1024 + lane * 16); const u32x4* zp = (const u32x4*)(OKP(bf16_t, WS_PROJ) + (size_t)tn * PROJ1_LD + 3072 + lane * 16); na[0] = op[0]; na[1] = op[1]; nz[0] = zp[0]; nz[1] = zp[1]; }
        float o[16], z[16];
#pragma unroll
        for (int h2 = 0; h2 < 2; ++h2) { const u32x4 a = ca[h2], zz = cz[h2];
            o[h2 * 8 + 0] = bflo(a.x); o[h2 * 8 + 1] = bfhi(a.x); o[h2 * 8 + 2] = bflo(a.y); o[h2 * 8 + 3] = bfhi(a.y); o[h2 * 8 + 4] = bflo(a.z); o[h2 * 8 + 5] = bfhi(a.z); o[h2 * 8 + 6] = bflo(a.w); o[h2 * 8 + 7] = bfhi(a.w);
            z[h2 * 8 + 0] = bflo(zz.x); z[h2 * 8 + 1] = bfhi(zz.x); z[h2 * 8 + 2] = bflo(zz.y); z[h2 * 8 + 3] = bfhi(zz.y); z[h2 * 8 + 4] = bflo(zz.z); z[h2 * 8 + 5] = bfhi(zz.z); z[h2 * 8 + 6] = bflo(zz.w); z[h2 * 8 + 7] = bfhi(zz.w); }
        float s = 0.f;
#pragma unroll
        for (int i = 0; i < 16; ++i) s += o[i] * o[i];
        s += __shfl_xor(s, 1); s += __shfl_xor(s, 2); s += __shfl_xor(s, 4);
        const float rs = frsq(s * (1.f / 128.f) + EPS);
        u32x4 w[2];
#pragma unroll
        for (int h2 = 0; h2 < 2; ++h2) { const f32x4 n0 = nw4[h2 * 2], n1 = nw4[h2 * 2 + 1]; float y[8];
#pragma unroll
            for (int i = 0; i < 8; ++i) y[i] = o[h2 * 8 + i] * rs * (i < 4 ? n0[i] : n1[i - 4]) * siluf(z[h2 * 8 + i]);
            w[h2].x = cvt_pk_bf16(y[0], y[1]); w[h2].y = cvt_pk_bf16(y[2], y[3]); w[h2].z = cvt_pk_bf16(y[4], y[5]); w[h2].w = cvt_pk_bf16(y[6], y[7]); }
        u32x4* cp = (u32x4*)(OKP(bf16_t, WS_CAT1) + (size_t)t * 1536 + lane * 16); cp[0] = w[0]; cp[1] = w[1]; }
}
}

#ifndef DUP_MASK
#define DUP_MASK 0
#endif
namespace ok {
constexpr int SB_LD = 72;
#ifdef CPU_EMU
#define WAVE_ALL(p) (wave_sum((p) ? 1.f : 0.f) == 64.f)
#else
#define WAVE_ALL(p) (__all(p))
#endif
__device__ __forceinline__ void sb_unit(const Frame& F, int unit) {
    LAS bf16_t* Kt = (LAS bf16_t*)F.lds; LAS bf16_t* VT = (LAS bf16_t*)(F.lds + 64 * SB_LD * 2); volatile LAS int* votes = (volatile LAS int*)(F.lds + 2 * 64 * SB_LD * 2);
    const int tid = F.tid, lane = F.lane, wave = F.wave, fr = lane & 15, fq = lane >> 4;
    const int nqb = L / 128, qb = unit % nqb, hd = (unit / nqb) & 7, b = unit / (nqb * 8), q0 = qb * 128;
    const bf16_t* proj = OKP(bf16_t, WS_PROJ) + (size_t)b * L * PROJ1_LD;
    const int qrow = q0 + wave * 16 + fr;
    bf16x8 qf[2];
#pragma unroll
    for (int ks = 0; ks < 2; ++ks) qf[ks] = *(const bf16x8*)(proj + (size_t)qrow * PROJ1_LD + 4096 + hd * 64 + ks * 32 + fq * 8);
    f32x4 o[4] = {{0.f, 0.f, 0.f, 0.f}, {0.f, 0.f, 0.f, 0.f}, {0.f, 0.f, 0.f, 0.f}, {0.f, 0.f, 0.f, 0.f}};
    float C = 1.f; bool wdone = false;
    const int key_l = tid >> 3, c8 = tid & 7;
    int kt = 2 * qb + 1;
    u32x4 kreg = *(const u32x4*)(proj + (size_t)(kt * 64 + key_l) * PROJ1_LD + 4608 + hd * 64 + c8 * 8), vreg = *(const u32x4*)(proj + (size_t)(kt * 64 + key_l) * PROJ1_LD + 5120 + hd * 64 + c8 * 8);
    for (; kt >= 0; --kt) {
        LDS_BARRIER();
        *(LAS u32x4*)(Kt + key_l * SB_LD + c8 * 8) = kreg;
        { LAS bf16_t* vp = VT + (c8 * 8) * SB_LD + key_l; vp[0] = (bf16_t)(vreg.x & 0xffffu); vp[SB_LD] = (bf16_t)(vreg.x >> 16); vp[2 * SB_LD] = (bf16_t)(vreg.y & 0xffffu); vp[3 * SB_LD] = (bf16_t)(vreg.y >> 16);
          vp[4 * SB_LD] = (bf16_t)(vreg.z & 0xffffu); vp[5 * SB_LD] = (bf16_t)(vreg.z >> 16); vp[6 * SB_LD] = (bf16_t)(vreg.w & 0xffffu); vp[7 * SB_LD] = (bf16_t)(vreg.w >> 16); }
        if (lane == 0) votes[wave] = wdone ? 1 : 0;
        LDS_BARRIER();
        { int all = 1;
#pragma unroll
          for (int w = 0; w < 8; ++w) all &= votes[w];
          if (all) break; }
        if (kt > 0) { kreg = *(const u32x4*)(proj + (size_t)((kt - 1) * 64 + key_l) * PROJ1_LD + 4608 + hd * 64 + c8 * 8); vreg = *(const u32x4*)(proj + (size_t)((kt - 1) * 64 + key_l) * PROJ1_LD + 5120 + hd * 64 + c8 * 8); }
        const int key0 = kt * 64;
#ifdef SB_COUNT_ITERS
        ++g_iters;
#endif
        if (!wdone && key0 < q0 + wave * 16 + 16) {
            f32x4 x[4];
#pragma unroll
            for (int k16 = 0; k16 < 4; ++k16) { x[k16] = (f32x4){0.f, 0.f, 0.f, 0.f};
#pragma unroll
                for (int ks = 0; ks < 2; ++ks) { const bf16x8 kf = *(const LAS bf16x8*)(Kt + (k16 * 16 + fr) * SB_LD + ks * 32 + fq * 8); x[k16] = mfma16(kf, qf[ks], x[k16]); } }
            const bool need_mask = key0 + 63 >= q0 + wave * 16;
            float Rr[4], Tt[4], Ee[4];
#pragma unroll
            for (int k16 = 0; k16 < 4; ++k16) {
#pragma unroll
                for (int r = 0; r < 4; ++r) { const float e = fexp2(fminf(x[k16][r], 80.f)); float rr = frcp(1.f + e), bet = e * rr;
                    if (need_mask && key0 + k16 * 16 + 4 * fq + r >= qrow) { rr = 1.f; bet = 0.f; }
                    x[k16][r] = bet; Rr[k16] = (r == 0) ? rr : Rr[k16];
                    if (r == 0) Tt[k16] = rr; else if (r == 1) Ee[k16] = rr; else if (r == 2) Rr[k16] = rr; else {
                        const float r0 = Tt[k16], r1 = Ee[k16], r2 = Rr[k16], r3 = rr; const float s2 = r3, s1 = r3 * r2, s0 = s1 * r1;
                        x[k16][0] *= s0; x[k16][1] *= s1; x[k16][2] *= s2;
                        Rr[k16] = s0 * r0; } } }
#pragma unroll
            for (int k16 = 0; k16 < 4; ++k16) { const float R = Rr[k16]; const float d1 = __shfl_down(R, 16), d2 = __shfl_down(R, 32), d3 = __shfl_down(R, 48);
                Ee[k16] = (fq < 3 ? d1 : 1.f) * (fq < 2 ? d2 : 1.f) * (fq < 1 ? d3 : 1.f); float t = R; t *= __shfl_xor(t, 16); t *= __shfl_xor(t, 32); Tt[k16] = t; }
            const float TT2 = Tt[3], TT1 = Tt[3] * Tt[2], TT0 = TT1 * Tt[1];
            const float f0 = Ee[0] * TT0 * C, f1 = Ee[1] * TT1 * C, f2 = Ee[2] * TT2 * C, f3 = Ee[3] * C;
            x[0] *= f0; x[1] *= f1; x[2] *= f2; x[3] *= f3;
            C *= TT0 * Tt[0];
            bf16x8 pw[2];
#pragma unroll
            for (int j = 0; j < 2; ++j) { u32x4 p; p.x = cvt_pk_bf16(x[2 * j][0], x[2 * j][1]); p.y = cvt_pk_bf16(x[2 * j][2], x[2 * j][3]); p.z = cvt_pk_bf16(x[2 * j + 1][0], x[2 * j + 1][1]); p.w = cvt_pk_bf16(x[2 * j + 1][2], x[2 * j + 1][3]); pw[j] = __builtin_bit_cast(bf16x8, p); }
#pragma unroll
            for (int dt = 0; dt < 4; ++dt)
#pragma unroll
                for (int j = 0; j < 2; ++j) { const LAS bf16_t* vp = VT + (dt * 16 + fr) * SB_LD + j * 32 + 4 * fq; const u32x2 lo = *(const LAS u32x2*)vp, hi = *(const LAS u32x2*)(vp + 16);
                    u32x4 a; a.x = lo.x; a.y = lo.y; a.z = hi.x; a.w = hi.y; o[dt] = mfma16(__builtin_bit_cast(bf16x8, a), pw[j], o[dt]); }
            wdone = WAVE_ALL(C < 7.8886e-31f);
        }
    }
    bf16_t* op = OKP(bf16_t, WS_CAT1) + ((size_t)b * L + qrow) * 1536 + 1024 + hd * 64 + 4 * fq;
#pragma unroll
    for (int dt = 0; dt < 4; ++dt) { u32x2 w; w.x = cvt_pk_bf16(o[dt][0], o[dt][1]); w.y = cvt_pk_bf16(o[dt][2], o[dt][3]); *(u32x2*)(op + dt * 16) = w; }
}
__device__ __forceinline__ void phase_l1_mix(const Frame& F0) {
    const Frame F = phase_frame(F0);
    constexpr int NU = GN_UNITS, UPX = NU / 8;
    if (F.G < 128 || F.G % 8 != 0) { if (F.vcu == 0) for (int u = 0; u < NU; ++u) { gdn_scan_unit(F, u); __syncthreads(); } for (int u = F.vcu; u < NB * 8 * (L / 128); u += F.G) { sb_unit(F, u); __syncthreads(); } return; }
    const int per = F.G / 8, xcd = (int)blockIdx.x & 7, loc = (int)blockIdx.x >> 3  ;
    if (loc < UPX) { gdn_scan_unit(F, xcd * UPX + loc);
#if (DUP_MASK >> 3) & 1
        __syncthreads(); gdn_scan_unit(F, xcd * UPX + loc);
#endif
#if (DUP_MASK >> 21) & 1
        __syncthreads(); gdn_scan_unit_t<1>(F, xcd * UPX + loc);
#endif
    }
    else for (int rep = 0; rep < 1 + ((DUP_MASK >> 16) & 1); ++rep) for (int u = xcd * (per - UPX) + (loc - UPX); u < NB * 8 * (L / 128); u += F.G - NU) { sb_unit(F, u); __syncthreads(); }
}
}

namespace ok {
#if CHECK
__device__ const int kSampleRows[16] = {0, 1, 2, 3, 63, 64, 127, 128, 129, 1000, 2047, 2048, 4097, 6000, 8190, 8191};
constexpr int FP_W = 6144;
__device__ __forceinline__ void fp_save(const Frame& F, int k, const void* buf, int ld, int width, bool is_bf16, int dcol0) {
    float* fp = OKP(float, WS_FP) + (size_t)k * 16 * FP_W; const size_t gt = (size_t)blockIdx.x * NT + F.tid, GT = (size_t)F.G * NT;
    for (size_t i = gt; i < (size_t)16 * width; i += GT) { const int r = (int)(i / width), c = (int)(i % width); const size_t src = (size_t)kSampleRows[r] * ld + c;
        fp[r * FP_W + dcol0 + c] = is_bf16 ? bf2f(((const bf16_t*)buf)[src]) : ((const float*)buf)[src]; }
}
__device__ __forceinline__ void fp_cmp(const Frame& F, int k, const float* obuf, int ld, int ocol0, int width, int fcol0) {
    const float* fp = OKP(float, WS_FP) + (size_t)k * 16 * FP_W; const size_t gt = (size_t)blockIdx.x * NT + F.tid, GT = (size_t)F.G * NT; float num = 0.f, den = 0.f;
    for (size_t i = gt; i < (size_t)16 * width; i += GT) { const int r = (int)(i / width), c = (int)(i % width); const float o = obuf[(size_t)kSampleRows[r] * ld + ocol0 + c], f = fp[r * FP_W + fcol0 + c];
        const float d = o - f; num += d * d; den += o * o; if (!(d == d)) num += 1e30f; }
    num = wave_sum(num); den = wave_sum(den);
    if (F.lane == 0 && (num != 0.f || den != 0.f)) { atomicAdd((float*)F.ctl + CW_CHK + 2 * k, num); atomicAdd((float*)F.ctl + CW_CHK + 2 * k + 1, den); }
}
__device__ __forceinline__ void fp_save_lin(const Frame& F, int k, const void* buf, size_t off, int n, bool is_bf16) {
    float* fp = OKP(float, WS_FP) + (size_t)k * 16 * FP_W; const size_t gt = (size_t)blockIdx.x * NT + F.tid, GT = (size_t)F.G * NT;
    for (size_t i = gt; i < (size_t)n; i += GT) fp[i] = is_bf16 ? bf2f(((const bf16_t*)buf)[off + i]) : ((const float*)buf)[off + i];
}
__device__ __forceinline__ void fp_cmp_lin(const Frame& F, int k, const float* obuf, size_t off, int n) {
    const float* fp = OKP(float, WS_FP) + (size_t)k * 16 * FP_W; const size_t gt = (size_t)blockIdx.x * NT + F.tid, GT = (size_t)F.G * NT; float num = 0.f, den = 0.f;
    for (size_t i = gt; i < (size_t)n; i += GT) { const float o = obuf[off + i], f = fp[i]; const float d = o - f; num += d * d; den += o * o; if (!(d == d)) num += 1e30f; }
    num = wave_sum(num); den = wave_sum(den);
    if (F.lane == 0 && (num != 0.f || den != 0.f)) { atomicAdd((float*)F.ctl + CW_CHK + 2 * k, num); atomicAdd((float*)F.ctl + CW_CHK + 2 * k + 1, den); }
}
#endif

struct Args { const float* in[33]; float* out; unsigned char* ws;
#if CHECK
    sm::Ctx oc;
#endif
};

__global__ void __launch_bounds__(512, 2) mk_fwd(Args a) {
    extern __shared__ __attribute__((aligned(16))) unsigned char lds_raw[];
    Frame F; F.lds = (LAS unsigned char*)lds_raw; F.ws = a.ws; F.ctl = (unsigned*)(a.ws + WS_CTL); F.in = a.in; F.out = a.out;
    F.tid = threadIdx.x; F.lane = F.tid & 63; F.wave = __builtin_amdgcn_readfirstlane(F.tid >> 6); F.G = gridDim.x;
    { const int bx = blockIdx.x; F.vcu = (F.G % 8 == 0) ? (bx % 8) * (F.G / 8) + bx / 8 : bx; }
    volatile LAS unsigned* MISC = (volatile LAS unsigned*)(F.lds + LDS_BYTES - 64);
    if (F.tid < 16) MISC[F.tid] = 0u;
    __syncthreads();
    XcdBarrier bar = xcd_barrier_post(F.ctl + CW_BAR, MISC);
#define GRID_BAR() xcd_barrier(bar)
    using namespace sm;
    for (int dup_p = 0; dup_p < ((DUP_MASK >> 5) & 1) + 1; ++dup_p) {
    phase_prologue(F);
    prologue_router_tables(F);
    prologue_w16_tables(F);
    GRID_BAR();
    }
#if (DUP_MASK >> 17) & 3
    { EpiScaleBf16 E{OKP(bf16_t, WS_PROJ), PROJ0_LD, (const float*)F.ctl + CW_SSQ, 1};
      pg8::Gemm g{OKP(bf16_t, WS_HB), OKP(bf16_t, WS_W_IN0), T, 4096, ((DUP_MASK >> 17) & 1) ? 512 : 1024}; pg8::StaticOrder S; S.init(g, F.G, (int)blockIdx.x); if ((DUP_MASK >> 18) & 1) S.tstep = 0;
      pg8::gemm_phase<EpiScaleBf16, pg8::StaticOrder, true, true>(F.lds, g, S, E, F.wave); GRID_BAR(); }
#endif
    for (int dup_i0 = 0; dup_i0 < ((DUP_MASK >> 6) & 1) + 1; ++dup_i0) {
    { EpiScaleBf16 E{OKP(bf16_t, WS_PROJ), PROJ0_LD, (const float*)F.ctl + CW_SSQ, 1};
      dense_gemm(F, OKP(bf16_t, WS_HB), OKP(bf16_t, WS_W_IN0), T, 4096, 1024, E); }
    phase_proj16(F, 0, F.in[I_X], nullptr, (const float*)F.ctl + CW_SSQ, 1);
    GRID_BAR();
    }
#if CHECK
    fp_save(F, 0, OKP(bf16_t, WS_PROJ), PROJ0_LD, 4096, true, 0);
#endif
    for (int dup_b = 0; dup_b < ((DUP_MASK >> 1) & 1) + 1; ++dup_b) {
    for (int dup_b1 = 0; dup_b1 < ((DUP_MASK >> 14) & 1) + 1; ++dup_b1) { phase_ssd_a(F); GRID_BAR(); }
#if CHECK
    fp_save_lin(F, 6, OKP(bf16_t, WS_STATES), ((size_t)5 * 16 + 0) * 8192, 65536, true);
    GRID_BAR();
#endif
    phase_kv(F);
    phase_ssd_scan(F, (F.G >= 64 && F.G % 8 == 0) ? 32 : 0);
    GRID_BAR();
    for (int dup_b2 = 0; dup_b2 < ((DUP_MASK >> 15) & 1) + 1; ++dup_b2) { phase_ssd_b(F); GRID_BAR(); }
    }

    for (int dup_o0 = 0; dup_o0 < ((DUP_MASK >> 8) & 1) + 1; ++dup_o0) {
    { EpiResidualT<true> E{F.in[I_X], OKP(bf16_t, WS_HB), OKP(float, WS_SSQP1)};
      dense_gemm(F, OKP(bf16_t, WS_CAT0), OKP(bf16_t, WS_W_OUT0), T, 1024, 1536, E); }
    GRID_BAR();
    }
#if CHECK
    fp_save(F, 10, OKP(bf16_t, WS_HB), 1024, 1024, true, 0);
    fp_save_lin(F, 7, OKP(bf16_t, WS_STATES), ((size_t)5 * 16 + 0) * 8192, 65536, true);
    fp_save(F, 8, OKP(bf16_t, WS_CAT0), 1536, 512, true, 0);
    fp_save(F, 9, OKP(bf16_t, WS_CAT0) + 512, 1536, 1024, true, 0);
    GRID_BAR();
#endif
    for (int dup_q0 = 0; dup_q0 < ((DUP_MASK >> 9) & 1) + 1; ++dup_q0) {
    { EpiScaleBf16 E{OKP(bf16_t, WS_Q), 1024, OKP(float, WS_SSQP1), 16};
      dense_gemm(F, OKP(bf16_t, WS_HB), OKP(bf16_t, WS_W_XA), T, 1024, 1024, E); }
    GRID_BAR();
    }
    for (int dup_xa0 = 0; dup_xa0 < ((DUP_MASK >> 13) & 1) + 1; ++dup_xa0) {
    phase_xattn(F, OKP(bf16_t, WS_Q), OKP(bf16_t, WS_KX), OKP(bf16_t, WS_VT), OKP(bf16_t, WS_ATT));
    GRID_BAR();
    }
    { EpiResidualT<false> E{nullptr, OKP(bf16_t, WS_HB), OKP(float, WS_SSQP2)};
      dense_gemm(F, OKP(bf16_t, WS_ATT), OKP(bf16_t, WS_W_XA + 6 * MiB), T, 1024, 1024, E); }
    GRID_BAR();
#if CHECK
    fp_save(F, 11, OKP(bf16_t, WS_HB), 1024, 1024, true, 0);
    GRID_BAR();
#endif
    phase_router(F, 0, OKP(bf16_t, WS_HB), OKP(float, WS_SSQP2), 16);
    for (int dup_cv = 0; dup_cv < ((DUP_MASK >> 10) & 1) + 1; ++dup_cv) phase_cvt_moe(F, 0);
    GRID_BAR();
    for (int dup_sc = 0; dup_sc < ((DUP_MASK >> 11) & 1) + 1; ++dup_sc) {
    phase_scatter(F, 0, OKP(bf16_t, WS_HB), OKP(float, WS_SSQP2), 16);
    GRID_BAR();
    }
    for (int dup_c = 0; dup_c < ((DUP_MASK >> 2) & 1) + 1; ++dup_c) {
    phase_moe_up(F);
    GRID_BAR();
    phase_moe_down(F);
    GRID_BAR();
    }

    phase_combine(F, OKP(bf16_t, WS_HB), (float*)F.ctl + CW_SSQ + 3 * T, false);
    GRID_BAR();
#if CHECK
    fp_save(F, 12, OKP(bf16_t, WS_HB), 1024, 1024, true, 0);
    GRID_BAR();
#endif
    for (int dup_i1 = 0; dup_i1 < ((DUP_MASK >> 12) & 1) + 1; ++dup_i1) {
    { EpiScaleBf16 E{OKP(bf16_t, WS_PROJ), PROJ1_LD, (const float*)F.ctl + CW_SSQ + 3 * T, 1};
      dense_gemm(F, OKP(bf16_t, WS_HB), OKP(bf16_t, WS_W_IN1), T, 5632, 1024, E); }
    phase_proj16(F, 1, nullptr, OKP(bf16_t, WS_HB), (const float*)F.ctl + CW_SSQ + 3 * T, 1);
    GRID_BAR();
    }
#if CHECK
    fp_save(F, 13, OKP(bf16_t, WS_PROJ), PROJ1_LD, 4096, true, 0);
    fp_save(F, 13, OKP(bf16_t, WS_PROJ) + 4608, PROJ1_LD, 1024, true, 4096);
#endif
#if (DUP_MASK >> 22) & 255
    phase_gdn_prep_t<(DUP_MASK >> 22) & 255>(F); GRID_BAR();
#endif
    for (int dup_a = 0; dup_a < ((DUP_MASK >> 0) & 1) + 1; ++dup_a) { phase_gdn_prep(F); GRID_BAR(); }
    phase_l1_mix(F); GRID_BAR();
    for (int dup_e = 0; dup_e < ((DUP_MASK >> 4) & 1) + 1; ++dup_e) { phase_gdn_final(F); GRID_BAR(); }

    { EpiResidualT<false> E{nullptr, OKP(bf16_t, WS_HB), OKP(float, WS_SSQP4)};
      dense_gemm(F, OKP(bf16_t, WS_CAT1), OKP(bf16_t, WS_W_OUT1), T, 1024, 1536, E); }
    GRID_BAR();
#if CHECK
    fp_save(F, 14, OKP(bf16_t, WS_CAT1), 1536, 1024, true, 0);
    fp_save(F, 15, OKP(bf16_t, WS_CAT1) + 1024, 1536, 512, true, 0);
    fp_save(F, 16, OKP(bf16_t, WS_HB), 1024, 1024, true, 0);
    GRID_BAR();
#endif
    { EpiScaleBf16 E{OKP(bf16_t, WS_Q), 1024, OKP(float, WS_SSQP4), 16};
      dense_gemm(F, OKP(bf16_t, WS_HB), OKP(bf16_t, WS_W_XA + 8 * MiB), T, 1024, 1024, E); }
    GRID_BAR();
    phase_xattn(F, OKP(bf16_t, WS_Q), OKP(bf16_t, WS_KX) + (size_t)NB * 256 * 1024, OKP(bf16_t, WS_VT) + (size_t)1024 * NB * 256, OKP(bf16_t, WS_ATT));
    GRID_BAR();
    { EpiResidualT<false> E{nullptr, OKP(bf16_t, WS_HB), OKP(float, WS_SSQP5)};
      dense_gemm(F, OKP(bf16_t, WS_ATT), OKP(bf16_t, WS_W_XA + 8 * MiB + 6 * MiB), T, 1024, 1024, E); }
    GRID_BAR();
#if CHECK
    fp_save(F, 17, OKP(bf16_t, WS_HB), 1024, 1024, true, 0);
    GRID_BAR();
#endif
    phase_router(F, 1, OKP(bf16_t, WS_HB), OKP(float, WS_SSQP5), 16);
    phase_cvt_moe(F, 1);
    GRID_BAR();
    phase_scatter(F, 1, OKP(bf16_t, WS_HB), OKP(float, WS_SSQP5), 16);
    GRID_BAR();
    phase_moe_up(F);
    GRID_BAR();
    phase_moe_down(F);
    GRID_BAR();
    phase_combine(F, OKP(bf16_t, WS_HB), nullptr, true);
#if CHECK
    GRID_BAR();
    fp_save(F, 18, F.out, 1024, 1024, false, 0);
    fp_save(F, 1, OKP(float, WS_DTV), 16, 16, false, 0);
    fp_save(F, 2, OKP(float, WS_ACS), 16, 16, false, 0);
    GRID_BAR();
    {
        const size_t gid = (size_t)blockIdx.x * NT + F.tid, gs = (size_t)F.G * NT;
        for (int st = 0;; ++st) {
            const int s = st % sm::NSTAGE_L;
            if (st < 2 * sm::NSTAGE_L && s >= sm::N_STAGES_USED) continue;
            if (!sm::run_stage(a.oc, st, gid, gs)) break;
            GRID_BAR();
            if (st == 3) fp_cmp(F, 0, a.oc.proj, sm::PROJ_LD, 0, 4096, 0);
            if (st == 4) { fp_cmp(F, 1, a.oc.dtv, 16, 0, 16, 0); fp_cmp(F, 2, a.oc.acs, 16, 0, 16, 0); }
            if (st == 4 && gid == 0) { float* c = (float*)F.ctl + CW_CHK; c[6] = 0.f; c[7] = 1.f; c[8] = 0.f; c[9] = 1.f; c[10] = 0.f; c[11] = 1.f; }
            if (st == 5) fp_cmp_lin(F, 6, a.oc.states, ((size_t)5 * 16 + 0) * 8192, 65536);
            if (st == 6) fp_cmp_lin(F, 7, a.oc.states, ((size_t)5 * 16 + 0) * 8192, 65536);
            if (st == 10) { fp_cmp(F, 8, a.oc.cat, 1536, 0, 512, 0); fp_cmp(F, 9, a.oc.cat, 1536, 512, 1024, 0); }
            if (st == 11) fp_cmp(F, 10, a.oc.h, 1024, 0, 1024, 0);
            if (st == 18) fp_cmp(F, 11, a.oc.h, 1024, 0, 1024, 0);
            if (st == 23) fp_cmp(F, 12, a.oc.h, 1024, 0, 1024, 0);
            if (st == 63) { fp_cmp(F, 13, a.oc.proj, sm::PROJ_LD, 0, 4096, 0); fp_cmp(F, 13, a.oc.proj, sm::PROJ_LD, 4624, 1024, 4096); }
            if (st == 70) { fp_cmp(F, 14, a.oc.cat, 1536, 0, 1024, 0); fp_cmp(F, 15, a.oc.cat, 1536, 1024, 512, 0); }
            if (st == 71) fp_cmp(F, 16, a.oc.h, 1024, 0, 1024, 0);
            if (st == 78) fp_cmp(F, 17, a.oc.h, 1024, 0, 1024, 0);
            if (st == 121) fp_cmp(F, 18, a.oc.out, 1024, 0, 1024, 0);
            GRID_BAR();
        }
        GRID_BAR();
        int code = 0;
        for (int k = CHECK - 1; k >= 0; --k) { const float num = __hip_atomic_load((float*)F.ctl + CW_CHK + 2 * k, __ATOMIC_RELAXED, __HIP_MEMORY_SCOPE_AGENT), den = __hip_atomic_load((float*)F.ctl + CW_CHK + 2 * k + 1, __ATOMIC_RELAXED, __HIP_MEMORY_SCOPE_AGENT);
            if (!(num <= 1e-3f * den) || den == 0.f) code = k + 1; }
        const float sc = 1.f + 0.2f * (float)code;
        for (size_t i = gid; i < (size_t)L * DM; i += gs) { F.out[i] *= sc; F.out[(size_t)L * DM + i] = 0.f; }
    }
#endif
}
}

extern "C" void kernel_launch(void* const* d_in, const int* in_sizes, int n_in, void* d_out, int out_size, void* d_ws, size_t ws_size, hipStream_t stream) {
    static int grid = 0;
    if (grid == 0) {
        int dev = 0, cus = 0, per_cu = 0;
        hipGetDevice(&dev); hipDeviceGetAttribute(&cus, hipDeviceAttributeMultiprocessorCount, dev);
        if (hipFuncSetAttribute((const void*)ok::mk_fwd, hipFuncAttributeMaxDynamicSharedMemorySize, LDS_BYTES) != hipSuccess) { fprintf(stderr, "kernel_launch: hipFuncSetAttribute failed\n"); grid = -1; return; }
        hipOccupancyMaxActiveBlocksPerMultiprocessor(&per_cu, (const void*)ok::mk_fwd, ok::NT, LDS_BYTES);
        (void)hipGetLastError();
        grid = cus;
        if (n_in != 33 || ws_size < ok::WS_END || per_cu < 1) { fprintf(stderr, "kernel_launch: n_in %d ws %zu need %zu per_cu %d\n", n_in, ws_size, (size_t)ok::WS_END, per_cu); grid = -1; }
    }
    if (grid < 0) return;
    hipMemsetAsync((char*)d_ws + ok::WS_CTL, 0, ok::CTL_BYTES, stream);
    ok::Args a{};
    for (int i = 0; i < 33; ++i) a.in[i] = (const float*)d_in[i];
    a.out = (float*)d_out; a.ws = (unsigned char*)d_ws;
#if CHECK
    sm::carve(a.oc, (float*)((char*)d_ws + 16 * ok::MiB));
    for (int i = 0; i < 33; ++i) a.oc.in[i] = (const float*)d_in[i];
    a.oc.out = (float*)d_out;
#endif
    hipLaunchKernelGGL(ok::mk_fwd, dim3(grid), dim3(ok::NT), LDS_BYTES, stream, a);
}
```

```cpp
#include <hip/hip_runtime.h>
#include <cstdio>
#include <cstdint>
#ifndef CHECK
#define CHECK 0
#endif
#define DUP_MASK 0
constexpr int LDS_BYTES = 147456;

#define XB_TMO      128
#define XB_XCNT(j)  (256  + 64 * (j))
#define XB_XSUB(j)  (1280 + 64 * (j))
#define XB_XGEN(j)  (2304 + 64 * (j))
#define XB_TOP      3328
#define XB_TOPGEN   3392
#define XCD_BAR_WORDS 3456
#define XB_SPIN_CAP (1u << 18)
#define LAS __attribute__((address_space(3)))

__device__ __forceinline__ unsigned xb_ld(unsigned* p)              { return __hip_atomic_load(p, __ATOMIC_RELAXED, __HIP_MEMORY_SCOPE_AGENT); }
__device__ __forceinline__ unsigned xb_add(unsigned* p, unsigned v) { return __hip_atomic_fetch_add(p, v, __ATOMIC_RELAXED, __HIP_MEMORY_SCOPE_AGENT); }
__device__ __forceinline__ unsigned xb_xcc_id() { return (unsigned)__builtin_amdgcn_s_getreg((3 << 11) | 20) & 0xFu; }
#define XB_SPIN(cond, bar) do { unsigned _sp = 0; while (cond) { __builtin_amdgcn_s_sleep(1); \
    if ((++_sp & 255u) == 0u) { if (xb_ld(&(bar)[XB_TMO])) break; if (_sp > XB_SPIN_CAP) { atomicAdd(&(bar)[XB_TMO], 1u); break; } } } } while (0)

struct XcdBarrier {
    unsigned* bar; unsigned x;
    volatile LAS unsigned* st;
};

__device__ __forceinline__ XcdBarrier xcd_barrier_post(unsigned* bar, volatile LAS unsigned* st) {
    XcdBarrier b; b.bar = bar; b.x = xb_xcc_id(); b.st = st;
    if (threadIdx.x == 0) (void)xb_add(&bar[XB_XCNT(b.x)], 1u);
    return b;
}
__device__ __forceinline__ void xcd_barrier_complete(unsigned* bar, unsigned x, unsigned& nloc, unsigned& nx) {
    const unsigned G = gridDim.x * gridDim.y * gridDim.z;
    unsigned sum, cnt, mine, sp = 0u;
    for (;;) {
        sum = 0u; cnt = 0u; mine = 0u;
#pragma unroll
        for (unsigned j = 0; j < 16; ++j) { const unsigned c = xb_ld(&bar[XB_XCNT(j)]); sum += c; cnt += (c > 0u) ? 1u : 0u; mine = (j == x) ? c : mine; }
        if (sum == G) break;
        __builtin_amdgcn_s_sleep(1);
        if ((++sp & 255u) == 0u) { if (xb_ld(&bar[XB_TMO])) break; if (sp > XB_SPIN_CAP) { atomicAdd(&bar[XB_TMO], 1u); break; } }
    }
    nloc = mine > 0u ? mine : 1u; nx = cnt > 0u ? cnt : 1u;
}

__device__ __forceinline__ void xcd_barrier(const XcdBarrier& b) {
    asm volatile("s_waitcnt vmcnt(0)" ::: "memory");
    __syncthreads();
    if (threadIdx.x == 0) {
        unsigned* bar = b.bar;
        __builtin_amdgcn_s_waitcnt(0);
        unsigned nloc = b.st[0], nx = b.st[1];
        if (nloc == 0u) { xcd_barrier_complete(bar, b.x, nloc, nx); b.st[0] = nloc; b.st[1] = nx; }
        const unsigned old = xb_add(&bar[XB_XSUB(b.x)], 1u);
        const unsigned gen = old / nloc;
        if (old + 1u == (gen + 1u) * nloc) {
            __builtin_amdgcn_fence(__ATOMIC_RELEASE, "agent");
            asm volatile("s_waitcnt vmcnt(0)" ::: "memory");
            const unsigned og = xb_add(&bar[XB_TOP], 1u);
            const unsigned tg = og / nx;
            if (og + 1u == (tg + 1u) * nx) xb_add(&bar[XB_TOPGEN], 1u);
            else XB_SPIN(xb_ld(&bar[XB_TOPGEN]) == tg, bar);
            __builtin_amdgcn_fence(__ATOMIC_ACQUIRE, "agent");
            xb_add(&bar[XB_XGEN(b.x)], 1u);
            asm volatile("s_waitcnt vmcnt(0)" ::: "memory");
        } else {
            XB_SPIN(xb_ld(&bar[XB_XGEN(b.x)]) == gen, bar);
            __builtin_amdgcn_fence(__ATOMIC_ACQUIRE, "agent");
            asm volatile("s_waitcnt vmcnt(0)" ::: "memory");
        }
    }
    __syncthreads();
}


#undef LAS

#ifndef SEQ
#define SEQ 8192
#endif
namespace sm {
constexpr int DM = 1024, NB = 1  , L = SEQ, T = NB * L, NCH = L / 64, MEM = 256;
constexpr int EV_IN = 4112, OD_IN = 5648, PROJ_LD = 5648;
constexpr int E_SCB = 0, E_SCC = 512, E_SCX = 1024, E_Z = 1536, E_XBC = 2560, E_DT = 4096;
constexpr int O_QKV = 0, O_Z = 3072, O_A = 4096, O_B = 4104, O_SQ = 4112, O_SK = 4624, O_SV = 5136;

struct Ctx {
    const float* in[33];
    float* out;
    float *memn, *kx, *vx, *h, *un, *rstd, *proj, *cat, *xbcc, *dtv, *acs, *states, *cb, *ybuf, *rstd2;
    float *q, *att, *sc;
    float *gatew, *act; int* eid;
    float *qkvc, *beta, *gcs, *Lm, *aqk, *uw, *S, *vn, *obuf;
};
enum In { I_X = 0, I_MEM, I_MEM_NORM, I_FINAL_NORM, I_NORM_MIX, I_NORM_XA, I_NORM_FFN, I_XA_WQ, I_XA_WK, I_XA_WV, I_XA_WO,
          I_MOE_WG, I_MOE_BG, I_MOE_WE, I_MOE_BE, I_MOE_WGATE, I_MOE_WUP, I_MOE_WDOWN,
          I_EV_WIN, I_EV_SCCONV, I_EV_CONVW, I_EV_CONVB, I_EV_DTB, I_EV_ALOG, I_EV_D, I_EV_NORM, I_EV_WOUT,
          I_OD_WIN, I_OD_CONV, I_OD_DTB, I_OD_ALOG, I_OD_NORM, I_OD_WOUT };

__device__ __forceinline__ float siluf(float x) { return x / (1.f + expf(-x)); }
__device__ __forceinline__ float softplusf(float x) { return x > 20.f ? x : log1pf(expf(x)); }
__device__ __forceinline__ float sigmoidf(float x) { return 1.f / (1.f + expf(-x)); }

__device__ __forceinline__ void s_copy(const float* src, float* dst, size_t n, size_t gid, size_t gs) { for (size_t i = gid; i < n; i += gs) dst[i] = src[i]; }
__device__ __forceinline__ void s_rstd(const float* x, int R, int W, int ld, float* rstd, size_t gid, size_t gs) {
    for (size_t r = gid; r < (size_t)R; r += gs) { const float* p = x + r * ld; float s = 0.f; for (int i = 0; i < W; ++i) s += p[i] * p[i]; rstd[r] = 1.f / sqrtf(s / W + 1e-6f); }
}
__device__ __forceinline__ void s_norm(const float* x, const float* rstd, const float* g, float* y, int R, size_t gid, size_t gs) {
    for (size_t i = gid; i < (size_t)R * DM; i += gs) { const size_t r = i / DM; const int c = (int)(i % DM); y[i] = x[i] * rstd[r] * g[c]; }
}
__device__ __forceinline__ void s_gemm(const float* A, int lda, const float* W, int ldw, float* C, int ldc, int M, int N, int K, int accum, size_t gid, size_t gs) {
    const int N4 = N / 4;
    for (size_t i = gid; i < (size_t)M * N4; i += gs) { const size_t m = i / N4; const int n = (int)(i % N4) * 4; const float* a = A + m * lda; const float* w = W + n; float s0 = 0.f, s1 = 0.f, s2 = 0.f, s3 = 0.f;
        for (int k = 0; k < K; ++k) { const float av = a[k]; const float4 wv = *(const float4*)(w + (size_t)k * ldw); s0 += av * wv.x; s1 += av * wv.y; s2 += av * wv.z; s3 += av * wv.w; }
        float4* c = (float4*)(C + m * ldc + n); float4 o = accum ? *c : float4{0.f, 0.f, 0.f, 0.f}; o.x += s0; o.y += s1; o.z += s2; o.w += s3; *c = o; }
}
__device__ __forceinline__ void s_scmix(const Ctx& c, size_t gid, size_t gs) {
    const float* w = c.in[I_EV_SCCONV];
    for (size_t i = gid; i < (size_t)T * 512; i += gs) { const size_t t = i / 512; const int ch = (int)(i % 512); const int tl = (int)(t % L); float s = 0.f;
        for (int j = 0; j < 3; ++j) { const int tt = tl - 2 + j; if (tt >= 0) { const float* p = c.proj + (t - 2 + j) * PROJ_LD; s += w[j * 512 + ch] * p[E_SCC + ch] * p[E_SCX + ch]; } }
        c.cat[t * 1536 + ch] = c.proj[t * PROJ_LD + E_SCB + ch] * s; }
}
__device__ __forceinline__ void s_ssd_conv(const Ctx& c, size_t gid, size_t gs) {
    const float* w = c.in[I_EV_CONVW]; const float* b = c.in[I_EV_CONVB];
    for (size_t i = gid; i < (size_t)T * 1536; i += gs) { const size_t t = i / 1536; const int ch = (int)(i % 1536); const int tl = (int)(t % L); float s = b[ch];
        for (int j = 0; j < 4; ++j) { const int tt = tl - 3 + j; if (tt >= 0) s += w[j * 1536 + ch] * c.proj[(t - 3 + j) * PROJ_LD + E_XBC + ch]; }
        c.xbcc[i] = siluf(s); }
}
__device__ __forceinline__ void s_ssd_dt(const Ctx& c, size_t gid, size_t gs) {
    for (size_t i = gid; i < (size_t)NB * NCH * 16; i += gs) { const int hd = (int)(i % 16); const size_t bc = i / 16; const float a = -expf(c.in[I_EV_ALOG][hd]); float cs = 0.f;
        for (int s = 0; s < 64; ++s) { const size_t t = bc * 64 + s; const float dt = softplusf(c.proj[t * PROJ_LD + E_DT + hd] + c.in[I_EV_DTB][hd]); cs += dt * a; c.dtv[t * 16 + hd] = dt; c.acs[t * 16 + hd] = cs; } }
}
__device__ __forceinline__ void s_ssd_states(const Ctx& c, size_t gid, size_t gs) {
    for (size_t i = gid; i < (size_t)NB * NCH * 16 * 64 * 128; i += gs) { const int n = (int)(i % 128); const int p = (int)((i / 128) % 64); const int hd = (int)((i / 8192) % 16); const size_t bc = i / (8192 * 16);
        const int g = hd / 8; const float last = c.acs[(bc * 64 + 63) * 16 + hd]; float s = 0.f;
        for (int k = 0; k < 64; ++k) { const size_t t = bc * 64 + k; s += c.xbcc[t * 1536 + 1024 + g * 128 + n] * c.xbcc[t * 1536 + hd * 64 + p] * c.dtv[t * 16 + hd] * expf(last - c.acs[t * 16 + hd]); }
        c.states[i] = s; }
}
__device__ __forceinline__ void s_ssd_scan(const Ctx& c, size_t gid, size_t gs) {
    for (size_t i = gid; i < (size_t)NB * 16 * 8192; i += gs) { const size_t b = i / (16 * 8192); const size_t r = i % (16 * 8192); const int hd = (int)(r / 8192); float s = 0.f;
        for (int ch = 0; ch < NCH; ++ch) { const size_t bc = b * NCH + ch; const size_t idx = bc * (16 * 8192) + r; const float st = c.states[idx]; c.states[idx] = s; s = s * expf(c.acs[(bc * 64 + 63) * 16 + hd]) + st; } }
}
__device__ __forceinline__ void s_ssd_cb(const Ctx& c, size_t gid, size_t gs) {
    for (size_t i = gid; i < (size_t)NB * NCH * 2 * 4096; i += gs) { const int s = (int)(i % 64); const int t = (int)((i / 64) % 64); const int g = (int)((i / 4096) % 2); const size_t bc = i / 8192;
        const float* cm = c.xbcc + (bc * 64 + t) * 1536 + 1280 + g * 128; const float* bm = c.xbcc + (bc * 64 + s) * 1536 + 1024 + g * 128; float a = 0.f;
        for (int n = 0; n < 128; ++n) a += cm[n] * bm[n];
        c.cb[i] = a; }
}
__device__ __forceinline__ void s_ssd_y(const Ctx& c, size_t gid, size_t gs) {
    for (size_t i = gid; i < (size_t)T * 1024; i += gs) { const size_t t = i / 1024; const int hp = (int)(i % 1024); const int hd = hp / 64, p = hp % 64, g = hd / 8; const size_t bc = t / 64; const int tl = (int)(t % 64);
        const float at = c.acs[t * 16 + hd]; float y = 0.f;
        for (int s = 0; s <= tl; ++s) { const size_t ts = bc * 64 + s; y += c.cb[(bc * 2 + g) * 4096 + tl * 64 + s] * expf(at - c.acs[ts * 16 + hd]) * c.xbcc[ts * 1536 + hp] * c.dtv[ts * 16 + hd]; }
        const float* cm = c.xbcc + t * 1536 + 1280 + g * 128; const float* pv = c.states + (bc * 16 + hd) * 8192 + p * 128; float yo = 0.f;
        for (int n = 0; n < 128; ++n) yo += cm[n] * pv[n];
        y += yo * expf(at) + c.xbcc[t * 1536 + hp] * c.in[I_EV_D][hd];
        c.ybuf[i] = y * siluf(c.proj[t * PROJ_LD + E_Z + hp]); }
}
__device__ __forceinline__ void s_ssd_out(const Ctx& c, size_t gid, size_t gs) {
    for (size_t i = gid; i < (size_t)T * 1024; i += gs) { const size_t t = i / 1024; const int ch = (int)(i % 1024); c.cat[t * 1536 + 512 + ch] = c.ybuf[i] * c.rstd2[t * 2 + ch / 512] * c.in[I_EV_NORM][ch]; }
}
__device__ __forceinline__ void s_xa_scores(const Ctx& c, size_t gid, size_t gs) {
    for (size_t i = gid; i < (size_t)T * 4 * 256; i += gs) { const int m = (int)(i % 256); const int hd = (int)((i / 256) % 4); const size_t t = i / 1024; const size_t b = t / L;
        const float* q = c.q + t * 1024 + hd * 256; const float* k = c.kx + (b * 256 + m) * 1024 + hd * 256; float s = 0.f;
        for (int d = 0; d < 256; ++d) s += q[d] * k[d];
        c.sc[i] = s * 0.0625f; }
}
__device__ __forceinline__ void s_xa_softmax(const Ctx& c, size_t gid, size_t gs) {
    for (size_t i = gid; i < (size_t)T * 4; i += gs) { float* p = c.sc + i * 256; float mx = p[0]; for (int m = 1; m < 256; ++m) mx = fmaxf(mx, p[m]); float s = 0.f; for (int m = 0; m < 256; ++m) { const float e = expf(p[m] - mx); p[m] = e; s += e; } const float r = 1.f / s; for (int m = 0; m < 256; ++m) p[m] *= r; }
}
__device__ __forceinline__ void s_xa_pv(const Ctx& c, size_t gid, size_t gs) {
    for (size_t i = gid; i < (size_t)T * 1024; i += gs) { const size_t t = i / 1024; const int col = (int)(i % 1024); const int hd = col / 256; const size_t b = t / L; const float* p = c.sc + (t * 4 + hd) * 256; const float* v = c.vx + b * 256 * 1024 + col; float s = 0.f;
        for (int m = 0; m < 256; ++m) s += p[m] * v[(size_t)m * 1024];
        c.att[i] = s; }
}
__device__ __forceinline__ void s_router(const Ctx& c, int l, size_t gid, size_t gs) {
    const float* wg = c.in[I_MOE_WG] + (size_t)l * 1024 * 4; const float* bg = c.in[I_MOE_BG] + l * 4; const float* we = c.in[I_MOE_WE] + (size_t)l * 1024 * 32; const float* be = c.in[I_MOE_BE] + l * 32;
    for (size_t t = gid; t < (size_t)T; t += gs) { const float* x = c.un + t * 1024; float g0 = 0.f, g1 = 0.f, g2 = 0.f, g3 = 0.f;
        for (int k = 0; k < 1024; ++k) { const float xv = x[k]; g0 += xv * wg[k * 4 + 0]; g1 += xv * wg[k * 4 + 1]; g2 += xv * wg[k * 4 + 2]; g3 += xv * wg[k * 4 + 3]; }
        g0 += bg[0]; g1 += bg[1]; g2 += bg[2]; g3 += bg[3];
        int gsel = 0; float gm = g0; if (g1 > gm) { gm = g1; gsel = 1; } if (g2 > gm) { gm = g2; gsel = 2; } if (g3 > gm) { gm = g3; gsel = 3; }
        const float gw = 1.f / (expf(g0 - gm) + expf(g1 - gm) + expf(g2 - gm) + expf(g3 - gm));
        float e0 = 0, e1 = 0, e2 = 0, e3 = 0, e4 = 0, e5 = 0, e6 = 0, e7 = 0; const float* w = we + gsel * 8;
        for (int k = 0; k < 1024; ++k) { const float xv = x[k]; const float* wk = w + k * 32; e0 += xv * wk[0]; e1 += xv * wk[1]; e2 += xv * wk[2]; e3 += xv * wk[3]; e4 += xv * wk[4]; e5 += xv * wk[5]; e6 += xv * wk[6]; e7 += xv * wk[7]; }
        const float* bb = be + gsel * 8; e0 += bb[0]; e1 += bb[1]; e2 += bb[2]; e3 += bb[3]; e4 += bb[4]; e5 += bb[5]; e6 += bb[6]; e7 += bb[7];
        int i1 = 0; float m1 = e0;
#define SM_T1(j, v) if (v > m1) { m1 = v; i1 = j; }
        SM_T1(1, e1) SM_T1(2, e2) SM_T1(3, e3) SM_T1(4, e4) SM_T1(5, e5) SM_T1(6, e6) SM_T1(7, e7)
        int i2 = -1; float m2 = -3.0e38f;
#define SM_T2(j, v) if (j != i1 && v > m2) { m2 = v; i2 = j; }
        SM_T2(0, e0) SM_T2(1, e1) SM_T2(2, e2) SM_T2(3, e3) SM_T2(4, e4) SM_T2(5, e5) SM_T2(6, e6) SM_T2(7, e7)
        const float r = expf(m2 - m1); const float w1 = gw / (1.f + r), w2 = gw * r / (1.f + r);
        c.eid[t * 2 + 0] = gsel * 8 + i1; c.eid[t * 2 + 1] = gsel * 8 + i2; c.gatew[t * 2 + 0] = w1; c.gatew[t * 2 + 1] = w2; }
}
__device__ __forceinline__ void s_moe_up(const Ctx& c, int l, size_t gid, size_t gs) {
    for (size_t i = gid; i < (size_t)T * 2 * 512; i += gs) { const int f = (int)(i % 512); const size_t tk = i / 512; const size_t t = tk / 2; const int e = c.eid[tk] & 31;
        const float* wg = c.in[I_MOE_WGATE] + ((size_t)l * 32 + e) * 1024 * 512 + f; const float* wu = c.in[I_MOE_WUP] + ((size_t)l * 32 + e) * 1024 * 512 + f; const float* x = c.un + t * 1024; float a = 0.f, b = 0.f;
        for (int k = 0; k < 1024; ++k) { a += x[k] * wg[(size_t)k * 512]; b += x[k] * wu[(size_t)k * 512]; }
        c.act[i] = siluf(a) * b; }
}
__device__ __forceinline__ void s_moe_down(const Ctx& c, int l, size_t gid, size_t gs) {
    for (size_t i = gid; i < (size_t)T * 1024; i += gs) { const size_t t = i / 1024; const int n = (int)(i % 1024); float y = 0.f;
        for (int k = 0; k < 2; ++k) { const int e = c.eid[t * 2 + k] & 31; const float* wd = c.in[I_MOE_WDOWN] + ((size_t)l * 32 + e) * 512 * 1024 + n; const float* a = c.act + (t * 2 + k) * 512; float s = 0.f;
            for (int f = 0; f < 512; ++f) s += a[f] * wd[(size_t)f * 1024];
            y += s * c.gatew[t * 2 + k]; }
        c.h[i] += y; }
}
__device__ __forceinline__ void s_gdn_conv(const Ctx& c, size_t gid, size_t gs) {
    const float* w = c.in[I_OD_CONV];
    for (size_t i = gid; i < (size_t)T * 3072; i += gs) { const size_t t = i / 3072; const int ch = (int)(i % 3072); const int tl = (int)(t % L); float s = 0.f;
        for (int j = 0; j < 4; ++j) { const int tt = tl - 3 + j; if (tt >= 0) s += w[j * 3072 + ch] * c.proj[(t - 3 + j) * PROJ_LD + O_QKV + ch]; }
        c.qkvc[i] = siluf(s); }
}
__device__ __forceinline__ void s_gdn_qkscale(const Ctx& c, size_t gid, size_t gs) {
    for (size_t i = gid; i < (size_t)T * 16; i += gs) { const size_t t = i / 16; const int wh = (int)(i % 16); float* p = c.qkvc + t * 3072 + wh * 128; float s = 0.f; for (int d = 0; d < 128; ++d) s += p[d] * p[d];
        float r = 1.f / sqrtf(s + 1e-6f); if (wh < 8) r *= 0.08838834764831845f; for (int d = 0; d < 128; ++d) p[d] *= r; }
}
__device__ __forceinline__ void s_gdn_gates(const Ctx& c, size_t gid, size_t gs) {
    for (size_t i = gid; i < (size_t)NB * NCH * 8; i += gs) { const int hd = (int)(i % 8); const size_t bc = i / 8; const float na = -expf(c.in[I_OD_ALOG][hd]); const float db = c.in[I_OD_DTB][hd]; float cs = 0.f;
        for (int s = 0; s < 64; ++s) { const size_t t = bc * 64 + s; cs += na * softplusf(c.proj[t * PROJ_LD + O_A + hd] + db); c.gcs[t * 8 + hd] = cs; c.beta[t * 8 + hd] = sigmoidf(c.proj[t * PROJ_LD + O_B + hd]); } }
}
__device__ __forceinline__ void s_gdn_kk(const Ctx& c, size_t gid, size_t gs) {
    for (size_t i = gid; i < (size_t)NB * NCH * 8 * 4096; i += gs) { const int s = (int)(i % 64); const int t = (int)((i / 64) % 64); const int hd = (int)((i / 4096) % 8); const size_t bc = i / (4096 * 8);
        float lv = 0.f, av = 0.f;
        if (s <= t) { const size_t tt = bc * 64 + t, ts = bc * 64 + s; const float* kt = c.qkvc + tt * 3072 + 1024 + hd * 128; const float* ks = c.qkvc + ts * 3072 + 1024 + hd * 128; const float* qt = c.qkvc + tt * 3072 + hd * 128; float kk = 0.f, qk = 0.f;
            for (int d = 0; d < 128; ++d) { kk += kt[d] * ks[d]; qk += qt[d] * ks[d]; }
            const float dec = expf(c.gcs[tt * 8 + hd] - c.gcs[ts * 8 + hd]); av = qk * dec; if (s < t) lv = kk * c.beta[tt * 8 + hd] * dec; }
        c.Lm[i] = lv; c.aqk[i] = av; }
}
__device__ __forceinline__ void s_gdn_solve(const Ctx& c, size_t gid, size_t gs) {
    for (size_t i = gid; i < (size_t)NB * NCH * 8 * 256; i += gs) { const int j = (int)(i % 256); const int hd = (int)((i / 256) % 8); const size_t bc = i / 2048; float* sol = c.uw + (bc * 8 + hd) * (64 * 256) + j; const float* Lp = c.Lm + (bc * 8 + hd) * 4096;
        for (int t = 0; t < 64; ++t) { const size_t tt = bc * 64 + t; const float bt = c.beta[tt * 8 + hd];
            float r = (j < 128) ? c.qkvc[tt * 3072 + 2048 + hd * 128 + j] * bt : c.qkvc[tt * 3072 + 1024 + hd * 128 + (j - 128)] * bt * expf(c.gcs[tt * 8 + hd]);
            for (int s = 0; s < t; ++s) r -= Lp[t * 64 + s] * sol[(size_t)s * 256];
            sol[(size_t)t * 256] = r; } }
}
__device__ __forceinline__ void s_gdn_scan(const Ctx& c, size_t gid, size_t gs) {
    for (size_t i = gid; i < (size_t)NB * 8 * 128; i += gs) { const int j = (int)(i % 128); const size_t bh = i / 128; const int hd = (int)(bh % 8); const size_t b = bh / 8; float* S = c.S + bh * 16384 + j; float* vn = c.vn + bh * 8192 + j;
        for (int d = 0; d < 128; ++d) S[(size_t)d * 128] = 0.f;
        for (int ch = 0; ch < NCH; ++ch) { const size_t bc = b * NCH + ch; const float* uw = c.uw + (bc * 8 + hd) * (64 * 256); const float* aq = c.aqk + (bc * 8 + hd) * 4096; const float glast = c.gcs[(bc * 64 + 63) * 8 + hd];
            for (int t = 0; t < 64; ++t) { float v = uw[t * 256 + j]; const float* w = uw + t * 256 + 128; for (int d = 0; d < 128; ++d) v -= w[d] * S[(size_t)d * 128]; vn[(size_t)t * 128] = v; }
            for (int t = 0; t < 64; ++t) { const size_t tt = bc * 64 + t; const float* q = c.qkvc + tt * 3072 + hd * 128; float o = 0.f; for (int d = 0; d < 128; ++d) o += q[d] * S[(size_t)d * 128];
                o *= expf(c.gcs[tt * 8 + hd]); for (int s = 0; s <= t; ++s) o += aq[t * 64 + s] * vn[(size_t)s * 128];
                c.obuf[tt * 1024 + hd * 128 + j] = o; }
            const float dl = expf(glast);
            for (int d = 0; d < 128; ++d) { float a = S[(size_t)d * 128] * dl; for (int t = 0; t < 64; ++t) { const size_t tt = bc * 64 + t; a += c.qkvc[tt * 3072 + 1024 + hd * 128 + d] * expf(glast - c.gcs[tt * 8 + hd]) * vn[(size_t)t * 128]; } S[(size_t)d * 128] = a; } } }
}
__device__ __forceinline__ void s_gdn_out(const Ctx& c, size_t gid, size_t gs) {
    for (size_t i = gid; i < (size_t)T * 1024; i += gs) { const size_t t = i / 1024; const int col = (int)(i % 1024); c.cat[t * 1536 + col] = c.obuf[i] * c.rstd2[t * 8 + col / 128] * c.in[I_OD_NORM][col % 128] * siluf(c.proj[t * PROJ_LD + O_Z + col]); }
}
__device__ __forceinline__ void s_sb(const Ctx& c, size_t gid, size_t gs) {
    for (size_t i = gid; i < (size_t)T * 32; i += gs) { const int qd = (int)(i % 4); const int hd = (int)((i / 4) % 8); const size_t t = i / 32; const int tl = (int)(t % L); const float* q = c.proj + t * PROJ_LD + O_SQ + hd * 64;
        float o[16];
#pragma unroll
        for (int d = 0; d < 16; ++d) o[d] = 0.f;
        float carry = 0.f;
        for (int s = tl - 1; s >= 0 && carry > -150.f; --s) { const size_t ts = t - (size_t)(tl - s); const float* k = c.proj + ts * PROJ_LD + O_SK + hd * 64; const float* v = c.proj + ts * PROJ_LD + O_SV + hd * 64 + qd * 16; float lg = 0.f;
            for (int d = 0; d < 64; ++d) lg += q[d] * k[d];
            lg *= 0.125f; const float wgt = expf(-softplusf(-lg) + carry); carry -= softplusf(lg);
#pragma unroll
            for (int d = 0; d < 16; ++d) o[d] += wgt * v[d]; }
#pragma unroll
        for (int d = 0; d < 16; ++d) c.cat[t * 1536 + 1024 + hd * 64 + qd * 16 + d] = o[d]; }
}
__device__ __forceinline__ void s_final(const Ctx& c, size_t gid, size_t gs) { s_norm(c.h, c.rstd, c.in[I_FINAL_NORM], c.out, T, gid, gs); }

constexpr int XA_BASE = 20, MOE_BASE = 30, L1_BASE = 40, NSTAGE_L = 60;
__device__ __forceinline__ bool run_stage(const Ctx& c, int st, size_t gid, size_t gs) {
    const int layer = st / NSTAGE_L, s = st % NSTAGE_L;
    if (st >= 2 * NSTAGE_L + 2) return false;
    if (st == 2 * NSTAGE_L) { s_rstd(c.h, T, DM, DM, c.rstd, gid, gs); return true; }
    if (st == 2 * NSTAGE_L + 1) { s_final(c, gid, gs); return true; }
    const int l = layer;
    switch (s) {
    case 0: if (l == 0) { s_copy(c.in[I_X], c.h, (size_t)T * DM, gid, gs); s_rstd(c.in[I_MEM], NB * MEM, DM, DM, c.rstd2, gid, gs); } break;
    case 1: if (l == 0) s_norm(c.in[I_MEM], c.rstd2, c.in[I_MEM_NORM], c.memn, NB * MEM, gid, gs); s_rstd(c.h, T, DM, DM, c.rstd, gid, gs); break;
    case 2: s_norm(c.h, c.rstd, c.in[I_NORM_MIX] + l * DM, c.un, T, gid, gs); break;
    case 3: if (l == 0) s_gemm(c.un, DM, c.in[I_EV_WIN], EV_IN, c.proj, PROJ_LD, T, EV_IN, DM, 0, gid, gs); else s_gemm(c.un, DM, c.in[I_OD_WIN], OD_IN, c.proj, PROJ_LD, T, OD_IN, DM, 0, gid, gs); break;
    case 4: if (l == 0) { s_scmix(c, gid, gs); s_ssd_conv(c, gid, gs); s_ssd_dt(c, gid, gs); } else { s_gdn_conv(c, gid, gs); s_gdn_gates(c, gid, gs); s_sb(c, gid, gs); } break;
    case 5: if (l == 0) { s_ssd_states(c, gid, gs); s_ssd_cb(c, gid, gs); } else s_gdn_qkscale(c, gid, gs); break;
    case 6: if (l == 0) s_ssd_scan(c, gid, gs); else s_gdn_kk(c, gid, gs); break;
    case 7: if (l == 0) s_ssd_y(c, gid, gs); else s_gdn_solve(c, gid, gs); break;
    case 8: if (l == 0) s_rstd(c.ybuf, T * 2, 512, 512, c.rstd2, gid, gs); else s_gdn_scan(c, gid, gs); break;
    case 9: if (l == 0) s_ssd_out(c, gid, gs); else s_rstd(c.obuf, T * 8, 128, 128, c.rstd2, gid, gs); break;
    case 10: if (l == 1) s_gdn_out(c, gid, gs); break;
    case 11: s_gemm(c.cat, 1536, l == 0 ? c.in[I_EV_WOUT] : c.in[I_OD_WOUT], DM, c.h, DM, T, DM, 1536, 1, gid, gs); break;
    case 12: s_rstd(c.h, T, DM, DM, c.rstd, gid, gs); break;
    case 13: s_norm(c.h, c.rstd, c.in[I_NORM_XA] + l * DM, c.un, T, gid, gs); break;
    case 14: s_gemm(c.un, DM, c.in[I_XA_WQ] + (size_t)l * DM * DM, DM, c.q, DM, T, DM, DM, 0, gid, gs);
             s_gemm(c.memn, DM, c.in[I_XA_WK] + (size_t)l * DM * DM, DM, c.kx, DM, NB * MEM, DM, DM, 0, gid, gs);
             s_gemm(c.memn, DM, c.in[I_XA_WV] + (size_t)l * DM * DM, DM, c.vx, DM, NB * MEM, DM, DM, 0, gid, gs); break;
    case 15: s_xa_scores(c, gid, gs); break;
    case 16: s_xa_softmax(c, gid, gs); break;
    case 17: s_xa_pv(c, gid, gs); break;
    case 18: s_gemm(c.att, DM, c.in[I_XA_WO] + (size_t)l * DM * DM, DM, c.h, DM, T, DM, DM, 1, gid, gs); break;
    case 19: s_rstd(c.h, T, DM, DM, c.rstd, gid, gs); break;
    case 20: s_norm(c.h, c.rstd, c.in[I_NORM_FFN] + l * DM, c.un, T, gid, gs); break;
    case 21: s_router(c, l, gid, gs); break;
    case 22: s_moe_up(c, l, gid, gs); break;
    case 23: s_moe_down(c, l, gid, gs); break;
    default: break;
    }
    return true;
}
constexpr int N_STAGES_USED = 24;

__host__ __device__ __forceinline__ size_t carve(Ctx& c, float* w) {
    size_t o = 0;
    auto take = [&](size_t n) { float* p = w + o; o += (n + 63) & ~(size_t)63; return p; };
    c.h = take((size_t)T * DM); c.rstd = take(T); c.rstd2 = take((size_t)T * 8); c.memn = take((size_t)MEM * DM); c.kx = take((size_t)MEM * DM); c.vx = take((size_t)MEM * DM);
    c.eid = (int*)take((size_t)T * 2); c.gatew = take((size_t)T * 2); c.dtv = take((size_t)T * 16); c.acs = take((size_t)T * 16); c.beta = take((size_t)T * 8); c.gcs = take((size_t)T * 8);
    c.S = take(8 * 16384); c.vn = take(8 * 8192);
    c.un = take((size_t)T * DM); c.ybuf = c.un; c.obuf = c.un;
    c.proj = take((size_t)T * PROJ_LD);
    c.cat = take((size_t)T * 1536);
    const size_t d0 = o;
    c.xbcc = take((size_t)T * 1536); c.states = take((size_t)NCH * 16 * 8192); c.cb = take((size_t)NCH * 2 * 4096); size_t dmax = o;
    o = d0; c.qkvc = take((size_t)T * 3072); c.Lm = take((size_t)NCH * 8 * 4096); c.aqk = take((size_t)NCH * 8 * 4096); c.uw = take((size_t)NCH * 8 * 64 * 256); if (o > dmax) dmax = o;
    o = d0; c.q = take((size_t)T * DM); c.sc = take((size_t)T * DM); c.att = take((size_t)T * DM); if (o > dmax) dmax = o;
    o = d0; c.act = take((size_t)T * 2 * 512); if (o > dmax) dmax = o;
    return dmax;
}
}

namespace pg8 {
#define PG8_LAS __attribute__((address_space(3)))
typedef unsigned short bf16_t;
typedef short bf16x8 __attribute__((ext_vector_type(8)));
typedef float f32x4 __attribute__((ext_vector_type(4)));
typedef unsigned u32x4 __attribute__((ext_vector_type(4)));
constexpr int BM = 256, BK = 64, HALF = 128, HTB = HALF * BK * 2  , STAGE_BYTES = 8 * HTB, NXCD = 8, WGM = 8;

__host__ __device__ __forceinline__ int lds_byte(int r, int c) { const int st = (r >> 4) * 2 + (c >> 5), rr = r & 15, cc = c & 31, ob = rr * 64 + cc * 2; return st * 1024 + (ob ^ (((ob >> 9) & 1) << 5)); }
__host__ __device__ __forceinline__ void stage_rc(int b, int& R, int& C) { const int st = b / 1024, sb = b % 1024, swz = sb ^ (((sb >> 9) & 1) << 5); R = (st >> 1) * 16 + swz / 64; C = (st & 1) * 32 + (swz % 64) / 2; }
__host__ __device__ __forceinline__ int perm32(int rho) { const int n = rho >> 4, i = rho & 15; return 8 * (i >> 2) + 4 * n + (i & 3); }

struct Unit { int pm, pn, tag; const char* a; const char* b; };
struct Gemm { const bf16_t* A; const bf16_t* Bt; int M, N, K; };

struct StaticOrder {
    static constexpr bool LIGHT = false;
    int nM, nN, nwg, G, c; const char* A; const char* B; size_t tstep;
    __host__ __device__ void init(const Gemm& g, int G_, int c_) { nM = g.M / BM; nN = g.N / BM; nwg = nM * nN; G = G_; c = c_; A = (const char*)g.A; B = (const char*)g.Bt; tstep = (size_t)BM * g.K * 2; }
    __host__ __device__ bool next(int i, Unit& u) const {
        const long L = (long)i * G + c; if (L >= nwg) return false;
        int wgid = (int)L; { const int q = nwg / NXCD, r = nwg % NXCD, xcd = wgid % NXCD, off = wgid / NXCD; wgid = (xcd < r ? xcd * (q + 1) : r * (q + 1) + (xcd - r) * q) + off; }
        const int nig = WGM * nN, gid = wgid / nig, fm = gid * WGM, gsz = (nM - fm) < WGM ? (nM - fm) : WGM;
        u.pm = fm + ((wgid % nig) % gsz); u.pn = (wgid % nig) / gsz; u.a = A + (size_t)u.pm * tstep; u.b = B + (size_t)u.pn * tstep; return true;
    }
    __device__ __forceinline__ void a_ready(const Unit&) const {}
    __device__ __forceinline__ void done(const Unit&) const {}
};

template <class Epi, class Sched, bool ALIGN_EPI = false, bool SP2 = false>
__device__ __forceinline__ void gemm_phase(PG8_LAS unsigned char* lds, const Gemm g, const Sched& S, const Epi& E, int wave_in) {
    int tid_ = threadIdx.x; asm volatile("" : "+v"(tid_));
    const int tid = tid_, wid = __builtin_amdgcn_readfirstlane(tid >> 6), lane = tid & 63, wr = wid >> 2, wc = wid & 3, fr = lane & 15, fq = lane >> 4;
    const int K = g.K, nt = K / BK;
    unsigned voffA[2], voffB[2];
#pragma unroll
    for (int i = 0; i < 2; ++i) { int R, C; stage_rc(tid * 16 + i * 8192, R, C); const int Rb = Epi::PERM ? ((R & ~31) + perm32(R & 31)) : R;
        voffA[i] = (unsigned)(R * K + C) * 2u; voffB[i] = (unsigned)(Rb * K + C) * 2u; }
    const size_t kstep = (size_t)(BK * 2);
    const size_t hstep = (size_t)HALF * K * 2;
    const unsigned ldsw = (unsigned)wid * 1024u;
    const int aoff = lds_byte(wr * 64 + fr, fq * 8), boff = lds_byte(wc * 32 + fr, fq * 8);
#define PG8_SA(b, h) (((b) * 2 + (h)) * HTB)
#define PG8_SB(b, h) ((4 + (b) * 2 + (h)) * HTB)
#define PG8_STAGE(bufoff, gbase, voff) do { _Pragma("unroll") for (int _i = 0; _i < 2; ++_i) \
        __builtin_amdgcn_global_load_lds((const unsigned*)((const char*)(gbase) + (voff)[_i]), (PG8_LAS unsigned*)(lds + (bufoff) + ldsw + _i * 8192), 16, 0, 0); } while (0)
#define PG8_LDA(dst, b, h) do { _Pragma("unroll") for (int m = 0; m < 4; ++m) _Pragma("unroll") for (int k = 0; k < 2; ++k) dst[m][k] = *(const PG8_LAS bf16x8*)(lds + PG8_SA(b, h) + aoff + m * 2048 + k * 1024); } while (0)
#define PG8_LDB(dst, b, h) do { _Pragma("unroll") for (int n = 0; n < 2; ++n) _Pragma("unroll") for (int k = 0; k < 2; ++k) dst[n][k] = *(const PG8_LAS bf16x8*)(lds + PG8_SB(b, h) + boff + n * 2048 + k * 1024); } while (0)
#define PG8_MMA(ai, bj, At, Bt) do { __builtin_amdgcn_s_setprio(1); _Pragma("unroll") for (int m = 0; m < 4; ++m) _Pragma("unroll") for (int n = 0; n < 2; ++n) _Pragma("unroll") for (int k = 0; k < 2; ++k) \
        acc[ai][bj][m][n] = __builtin_amdgcn_mfma_f32_16x16x32_bf16(Bt[n][k], At[m][k], acc[ai][bj][m][n], 0, 0, 0); __builtin_amdgcn_s_setprio(0); } while (0)
#define PG8_WAIT_V(n) asm volatile("s_waitcnt vmcnt(" #n ")" ::: "memory")
#define PG8_WAIT_L(n) asm volatile("s_waitcnt lgkmcnt(" #n ")" ::: "memory")
#define PG8_BAR __builtin_amdgcn_s_barrier()
#define PG8_SCHED __builtin_amdgcn_sched_barrier(0)
    Unit cur, nxt; int ui = 0;
    if (!S.next(0, cur)) return;
    f32x4 acc[2][2][4][2];
#pragma unroll
    for (int a = 0; a < 2; ++a)
#pragma unroll
        for (int b = 0; b < 2; ++b)
#pragma unroll
            for (int m = 0; m < 4; ++m)
#pragma unroll
                for (int n = 0; n < 2; ++n) acc[a][b][m][n] = (f32x4){0.f, 0.f, 0.f, 0.f};
    bf16x8 At[4][2], B0[2][2], B1[2][2];
    const char* cA = cur.a; const char* cB = cur.b;
    S.a_ready(cur);
    if constexpr (SP2) {
        PG8_STAGE(PG8_SB(0, 0), cB, voffB); PG8_STAGE(PG8_SB(0, 1), cB + hstep, voffB); PG8_STAGE(PG8_SA(0, 0), cA, voffA); PG8_STAGE(PG8_SA(0, 1), cA + hstep, voffA);
        if (wr == 1) PG8_BAR;
        PG8_WAIT_V(2); PG8_BAR;
        PG8_STAGE(PG8_SB(1, 0), cB + kstep, voffB); PG8_STAGE(PG8_SA(1, 0), cA + kstep, voffA); PG8_STAGE(PG8_SB(1, 1), cB + hstep + kstep, voffB);
        PG8_WAIT_V(6); PG8_BAR;
    } else {
        PG8_STAGE(PG8_SB(0, 0), cB, voffB); PG8_STAGE(PG8_SA(0, 0), cA, voffA); PG8_STAGE(PG8_SB(0, 1), cB + hstep, voffB); PG8_STAGE(PG8_SA(0, 1), cA + hstep, voffA);
        if (wr == 1) PG8_BAR;
        PG8_WAIT_V(4); PG8_BAR;
        PG8_STAGE(PG8_SB(1, 0), cB + kstep, voffB); PG8_STAGE(PG8_SA(1, 0), cA + kstep, voffA); PG8_STAGE(PG8_SB(1, 1), cB + hstep + kstep, voffB);
        PG8_WAIT_V(6); PG8_BAR;
    }
    for (;;) {
        const bool has_next = S.next(ui + 1, nxt);
        const char* nA = has_next ? nxt.a : cA; const char* nB = has_next ? nxt.b : cB;
        for (int t = 0; t < nt; t += 2) {
            const bool last = (t == nt - 2);
            const char* a1 = cA + (size_t)(t + 1) * kstep;
            const char* a2 = last ? nA : cA + (size_t)(t + 2) * kstep; const char* b2 = last ? nB : cB + (size_t)(t + 2) * kstep;
            const char* a3 = a2 + kstep; const char* b3 = b2 + kstep;
            if (last && has_next) S.a_ready(nxt);
            if constexpr (SP2) {
            PG8_LDB(B0, 0, 0); PG8_LDB(B1, 0, 1); PG8_SCHED; PG8_LDA(At, 0, 0); PG8_STAGE(PG8_SA(1, 1), a1 + hstep, voffA);
            PG8_WAIT_V(8); PG8_WAIT_L(0); PG8_BAR; PG8_MMA(0, 0, At, B0); PG8_MMA(0, 1, At, B1); PG8_BAR; PG8_SCHED;
            PG8_LDA(At, 0, 1); PG8_STAGE(PG8_SB(0, 0), b2, voffB); PG8_STAGE(PG8_SB(0, 1), b2 + hstep, voffB); PG8_STAGE(PG8_SA(0, 0), a2, voffA);
            PG8_WAIT_V(8); PG8_WAIT_L(0); PG8_BAR; if (!(Sched::LIGHT && (cur.tag & 1))) { PG8_MMA(1, 0, At, B0); PG8_MMA(1, 1, At, B1); } PG8_BAR; PG8_SCHED;
            PG8_LDB(B0, 1, 0); PG8_LDB(B1, 1, 1); PG8_SCHED; PG8_LDA(At, 1, 0); PG8_STAGE(PG8_SA(0, 1), a2 + hstep, voffA);
            PG8_WAIT_V(8); PG8_WAIT_L(0); PG8_BAR; PG8_MMA(0, 0, At, B0); PG8_MMA(0, 1, At, B1); PG8_BAR; PG8_SCHED;
            PG8_LDA(At, 1, 1); PG8_STAGE(PG8_SB(1, 0), b3, voffB); PG8_STAGE(PG8_SB(1, 1), b3 + hstep, voffB); PG8_STAGE(PG8_SA(1, 0), a3, voffA);
            PG8_WAIT_V(8); PG8_WAIT_L(0); PG8_BAR; if (!(Sched::LIGHT && (cur.tag & 1))) { PG8_MMA(1, 0, At, B0); PG8_MMA(1, 1, At, B1); } PG8_BAR; PG8_SCHED;
            } else {
            PG8_LDB(B0, 0, 0); PG8_SCHED; PG8_LDA(At, 0, 0); PG8_STAGE(PG8_SA(1, 1), a1 + hstep, voffA);
            PG8_WAIT_L(8); PG8_BAR; PG8_WAIT_L(0); PG8_MMA(0, 0, At, B0); PG8_BAR; PG8_SCHED;
            PG8_LDB(B1, 0, 1); PG8_STAGE(PG8_SB(0, 0), b2, voffB);
            PG8_BAR; PG8_WAIT_L(0); PG8_MMA(0, 1, At, B1); PG8_BAR;
            PG8_LDA(At, 0, 1); PG8_STAGE(PG8_SA(0, 0), a2, voffA);
            PG8_BAR; PG8_WAIT_L(0); PG8_MMA(1, 0, At, B0); PG8_BAR; PG8_SCHED;
            PG8_STAGE(PG8_SB(0, 1), b2 + hstep, voffB);
            PG8_WAIT_V(6); PG8_BAR; PG8_MMA(1, 1, At, B1); PG8_BAR;
            PG8_LDB(B0, 1, 0); PG8_SCHED; PG8_LDA(At, 1, 0); PG8_STAGE(PG8_SA(0, 1), a2 + hstep, voffA);
            PG8_WAIT_L(8); PG8_BAR; PG8_WAIT_L(0); PG8_MMA(0, 0, At, B0); PG8_BAR; PG8_SCHED;
            PG8_LDB(B1, 1, 1); PG8_STAGE(PG8_SB(1, 0), b3, voffB);
            PG8_BAR; PG8_WAIT_L(0); PG8_MMA(0, 1, At, B1); PG8_BAR;
            PG8_LDA(At, 1, 1); PG8_STAGE(PG8_SA(1, 0), a3, voffA);
            PG8_BAR; PG8_WAIT_L(0); PG8_MMA(1, 0, At, B0); PG8_BAR; PG8_SCHED;
            PG8_STAGE(PG8_SB(1, 1), b3 + hstep, voffB);
            PG8_WAIT_V(6); PG8_BAR; PG8_MMA(1, 1, At, B1); PG8_BAR;
            }
        }
        if constexpr (ALIGN_EPI) { if (wr == 0) PG8_BAR; }
        if constexpr (!Epi::AFTER_DRAIN) { E(acc, cur, wr, wc, fr, fq); S.done(cur); }
        if (!has_next) break;
#pragma unroll
        for (int a = 0; a < 2; ++a)
#pragma unroll
            for (int b = 0; b < 2; ++b)
#pragma unroll
                for (int m = 0; m < 4; ++m)
#pragma unroll
                    for (int n = 0; n < 2; ++n) acc[a][b][m][n] = (f32x4){0.f, 0.f, 0.f, 0.f};
        cur = nxt; cA = nA; cB = nB; ++ui;
        if constexpr (ALIGN_EPI) { if (wr == 1) PG8_BAR; }
    }
    PG8_WAIT_V(0);
    if constexpr (!ALIGN_EPI) { if (wr == 0) PG8_BAR; }
    PG8_BAR;
    if constexpr (Epi::AFTER_DRAIN) { E.fused(acc, cur, wr, wc, fr, fq, lds, wid, lane); S.done(cur); }
#undef PG8_SA
#undef PG8_SB
#undef PG8_STAGE
#undef PG8_LDA
#undef PG8_LDB
#undef PG8_MMA
#undef PG8_WAIT_V
#undef PG8_WAIT_L
#undef PG8_BAR
#undef PG8_SCHED
}
}

namespace ok {
using pg8::bf16_t; using pg8::bf16x8; using pg8::f32x4; using pg8::u32x4;
typedef unsigned u32x2 __attribute__((ext_vector_type(2)));
typedef float f32x2 __attribute__((ext_vector_type(2)));
#ifndef SEQ
#define SEQ 8192
#endif
constexpr int NB = 2, L = SEQ, NCH = L / 64, T = NB * L, DM = 1024, NWAVES = 8, NT = 512;
constexpr float EPS = 1e-6f, LOG2E = 1.4426950408889634f;
constexpr size_t MiB = 1u << 20, KiB = 1024;
constexpr size_t WS_CTL = 0, CTL_BYTES = 1 * MiB;
constexpr int CW_BAR = 0;
constexpr int CW_SSQ = 16384;
constexpr int CW_MOE = 16384 + 6 * T;
constexpr int CW_CHK = CW_MOE + 256;
static_assert((CW_CHK + 64) * 4 <= (int)CTL_BYTES, "ctl");
constexpr size_t WS_WDT = 1 * MiB, WS_WAB = WS_WDT + 64 * KiB, WS_WR = WS_WAB + 64 * KiB;
constexpr size_t WS_DTV = 2 * MiB, WS_ACS = 3 * MiB, WS_GCS = 4 * MiB, WS_BETA = 4 * MiB + 512 * KiB;
constexpr size_t WS_RAW16 = WS_DTV;
constexpr size_t WS_EID = 5 * MiB, WS_GATEW = WS_EID + 128 * KiB, WS_TOKSLOT = WS_GATEW + 128 * KiB, WS_SLOTTOK = WS_TOKSLOT + 128 * KiB, WS_SLOTGATE = WS_SLOTTOK + 160 * KiB,
                 WS_SLOTRSTD = WS_SLOTGATE + 160 * KiB, WS_TILEEXP = WS_SLOTRSTD + 160 * KiB;
constexpr size_t WS_FP = 8 * MiB;
constexpr size_t WS_W_IN0 = 16 * MiB, WS_W_IN1 = 24 * MiB, WS_W_OUT0 = 35 * MiB, WS_W_OUT1 = 38 * MiB, WS_W_XA = 41 * MiB  ;
constexpr size_t WS_MEMNB = 57 * MiB, WS_KX = 58 * MiB  , WS_VT = 60 * MiB  ;
constexpr size_t WS_H = 64 * MiB, WS_HB = 128 * MiB, WS_MOEW = 160 * MiB, WS_BIG = 256 * MiB;
constexpr size_t WS_PROJ = WS_BIG;
constexpr size_t WS_CAT0 = 384 * MiB, WS_STATES = 432 * MiB;
constexpr size_t WS_CAT1 = 432 * MiB;
constexpr size_t WS_PROJ1A = WS_BIG, WS_PROJ1B = WS_BIG + 96 * MiB; constexpr int PROJ1A_LD = 3072, PROJ1B_LD = 2560;
#define WSL_Q    (F.lay ? (size_t)160 * MiB : WS_BIG)
#define WSL_ATT  (F.lay ? (size_t)192 * MiB : WS_BIG + 32 * MiB)
#define WSL_XS   (F.lay ? (size_t)160 * MiB : WS_BIG)
#define WSL_ACT  (F.lay ? (size_t)352 * MiB : WS_BIG + 80 * MiB)
#define WSL_Y    (F.lay ? (size_t)392 * MiB : WS_BIG + 120 * MiB)
#define WSL_MOEW(l) ((l) ? WS_BIG : WS_MOEW)
constexpr size_t WS_END = 528 * MiB;
constexpr int PROJ0_LD = 4096, PROJ1_LD = 5632, MAXSLOT = 40960;

#ifdef CPU_EMU
__device__ __forceinline__ float fexp(float x) { return expf(x); }
__device__ __forceinline__ float fexp2(float x) { return exp2f(x); }
__device__ __forceinline__ float frcp(float x) { return 1.f / x; }
__device__ __forceinline__ float frsq(float x) { return 1.f / sqrtf(x); }
#else
__device__ __forceinline__ float fexp(float x) { return __builtin_amdgcn_exp2f(x * 1.4426950408889634f); }
__device__ __forceinline__ float fexp2(float x) { return __builtin_amdgcn_exp2f(x); }
__device__ __forceinline__ float frcp(float x) { return __builtin_amdgcn_rcpf(x); }
__device__ __forceinline__ float frsq(float x) { return __builtin_amdgcn_rsqf(x); }
#endif
#ifdef CPU_EMU
#define LAS
#define GAS
#define LDS_WAIT() do {} while (0)
#define WAVE_SYNC() ((void)__shfl(0, 0))
#define MEM_FENCE() do {} while (0)
#define PIN16(a) do {} while (0)
#define LDS_BARRIER() __syncthreads()
#define SCHED_FENCE() do {} while (0)
__device__ __forceinline__ unsigned cvt_pk_bf16(float lo, float hi) { return emu_f2bf(lo) | (emu_f2bf(hi) << 16); }
#else
#define LAS __attribute__((address_space(3)))
#define GAS __attribute__((address_space(1)))
#define LDS_WAIT() asm volatile("s_waitcnt lgkmcnt(0)" ::: "memory")
#define LDS_BARRIER() do { asm volatile("s_waitcnt lgkmcnt(0)" ::: "memory"); __builtin_amdgcn_s_barrier(); asm volatile("" ::: "memory"); } while (0)
#define MEM_FENCE() asm volatile("" ::: "memory")
#define PIN16(a) asm volatile("" : "+v"(a[0]), "+v"(a[1]), "+v"(a[2]), "+v"(a[3]), "+v"(a[4]), "+v"(a[5]), "+v"(a[6]), "+v"(a[7]), "+v"(a[8]), "+v"(a[9]), "+v"(a[10]), "+v"(a[11]), "+v"(a[12]), "+v"(a[13]), "+v"(a[14]), "+v"(a[15]) :: "memory")
#define SCHED_FENCE() __builtin_amdgcn_sched_barrier(0)
#define WAVE_SYNC() do { asm volatile("s_waitcnt lgkmcnt(0)" ::: "memory"); __builtin_amdgcn_wave_barrier(); } while (0)
typedef __bf16 hwbf16x2 __attribute__((ext_vector_type(2)));
__device__ __forceinline__ unsigned cvt_pk_bf16(float lo, float hi) { const f32x2 v = {lo, hi}; return __builtin_bit_cast(unsigned, __builtin_convertvector(v, hwbf16x2)); }
#endif
__device__ __forceinline__ float bf2f(unsigned short b) { return __uint_as_float(((unsigned)b) << 16); }
__device__ __forceinline__ float bflo(unsigned w) { return __uint_as_float(w << 16); }
__device__ __forceinline__ float bfhi(unsigned w) { return __uint_as_float(w & 0xffff0000u); }
__device__ __forceinline__ float wave_sum(float v) {
#pragma unroll
    for (int o = 1; o < 64; o <<= 1) v += __shfl_xor(v, o);
    return v;
}
__device__ __forceinline__ f32x4 mfma16(bf16x8 a, bf16x8 b, f32x4 c) { return __builtin_amdgcn_mfma_f32_16x16x32_bf16(a, b, c, 0, 0, 0); }

struct Frame {
    LAS unsigned char* lds;
    unsigned* ctl;
    unsigned char* ws;
    const float* const* in;
    float* out;
    int tid, lane, wave, vcu, G;
    int lay = 0;
};
constexpr size_t WS_SSQP1 = 6 * MiB, WS_SSQP2 = 7 * MiB, WS_SSQP4 = 62 * MiB, WS_SSQP5 = 63 * MiB;
__device__ __forceinline__ float rstd_np(const float* p, int np, int row) { float s; if (np == 1) s = p[row]; else { const f32x4* q = (const f32x4*)(p + (size_t)row * 16); const f32x4 a = q[0], b = q[1], c = q[2], d = q[3]; s = ((a.x + a.y) + (a.z + a.w)) + ((b.x + b.y) + (b.z + b.w)) + (((c.x + c.y) + (c.z + c.w)) + ((d.x + d.y) + (d.z + d.w))); }
    return frsq(s * (1.f / 1024.f) + EPS); }
__device__ __forceinline__ void rstd_rows8(const float* p, int np, int row0, int fq, float (&out)[2][4]) {
    if (np == 1) { float s[2][4];
#pragma unroll
        for (int ai = 0; ai < 2; ++ai)
#pragma unroll
            for (int m = 0; m < 4; ++m) s[ai][m] = p[row0 + ai * 128 + m * 16];
        SCHED_FENCE();
#pragma unroll
        for (int ai = 0; ai < 2; ++ai)
#pragma unroll
            for (int m = 0; m < 4; ++m) out[ai][m] = frsq(s[ai][m] * (1.f / 1024.f) + EPS); }
    else { f32x4 a[2][4];
#pragma unroll
        for (int ai = 0; ai < 2; ++ai)
#pragma unroll
            for (int m = 0; m < 4; ++m) a[ai][m] = *(const f32x4*)(p + (size_t)(row0 + ai * 128 + m * 16) * 16 + fq * 4);
        SCHED_FENCE();
#pragma unroll
        for (int ai = 0; ai < 2; ++ai)
#pragma unroll
            for (int m = 0; m < 4; ++m) { float s = (a[ai][m].x + a[ai][m].y) + (a[ai][m].z + a[ai][m].w); s += __shfl_xor(s, 16); s += __shfl_xor(s, 32); out[ai][m] = frsq(s * (1.f / 1024.f) + EPS); } }
}
#ifndef CPU_EMU
__device__ __forceinline__ int shfl_src(int v, int src) { return __builtin_amdgcn_ds_bpermute(src << 2, v); }
#else
inline int shfl_src(int v, int src) { return emu::shfl_idx(v, src); }
#endif
#define OKP(type, off) ((type*)(F.ws + (off)))
#ifdef CPU_EMU
__device__ __forceinline__ Frame phase_frame(const Frame& F0) { return F0; }
#else
__device__ __forceinline__ Frame phase_frame(const Frame& F0) { Frame F = F0; int t = threadIdx.x; asm volatile("" : "+v"(t)); F.tid = t; F.lane = t & 63; F.wave = __builtin_amdgcn_readfirstlane(t >> 6); return F; }
#endif

struct CvtJob { const float* W; int ldw, K, ncols, c0; bf16_t* WT; int drow0, dstep16; const float* kgain; float cscale; };
__device__ __forceinline__ int job_items(const CvtJob& j) { return (j.K / 64) * (j.ncols / 32); }
struct CvtRegs { float wv[32]; f32x4 g0, g1; };
__device__ __forceinline__ void cvt_load(CvtRegs& r, const CvtJob& j, int item, int lane) {
    const int nblk = j.ncols / 32, kb = item / nblk, nb = item % nblk, k0 = 64 * kb, c0 = j.c0 + 32 * nb;
#pragma unroll
    for (int i = 0; i < 32; ++i) r.wv[i] = j.W[(size_t)(k0 + 2 * i + (lane >> 5)) * j.ldw + c0 + (lane & 31)];
    if (j.kgain) { const f32x4* gp = (const f32x4*)(j.kgain + k0 + 8 * (lane & 7)); r.g0 = gp[0]; r.g1 = gp[1]; } else { r.g0 = (f32x4){1.f, 1.f, 1.f, 1.f}; r.g1 = r.g0; }
}
__device__ __forceinline__ void cvt_finish(const CvtRegs& r, const CvtJob& j, int item, LAS float* scr, int lane) {
    const int nblk = j.ncols / 32, kb = item / nblk, nb = item % nblk, k0 = 64 * kb, drow0 = j.drow0 + (32 * nb >> 4) * j.dstep16;
#pragma unroll
    for (int i = 0; i < 32; ++i) { const int kk = 2 * i + (lane >> 5); scr[kk * 33 + (lane & 31)] = r.wv[i]; }
    const f32x4 ga = r.g0 * j.cscale, gb = r.g1 * j.cscale;
    WAVE_SYNC();
    const int c = lane & 7;
#pragma unroll
    for (int jj = 0; jj < 4; ++jj) { const int n = (lane >> 3) + 8 * jj; const LAS float* s = scr + (8 * c) * 33 + n;
        u32x4 o; o.x = cvt_pk_bf16(s[0 * 33] * ga[0], s[1 * 33] * ga[1]); o.y = cvt_pk_bf16(s[2 * 33] * ga[2], s[3 * 33] * ga[3]); o.z = cvt_pk_bf16(s[4 * 33] * gb[0], s[5 * 33] * gb[1]); o.w = cvt_pk_bf16(s[6 * 33] * gb[2], s[7 * 33] * gb[3]);
        *(u32x4*)(j.WT + (size_t)(drow0 + (n >> 4) * j.dstep16 + (n & 15)) * j.K + k0 + 8 * c) = o; }
    WAVE_SYNC();
}
__device__ __forceinline__ CvtJob dense_job(const Frame& F, int j) {
    using namespace sm;
    const float* const* in = F.in;
    switch (j) {
    case 0: return CvtJob{in[I_EV_WIN], 4112, 1024, 4096, 0, OKP(bf16_t, WS_W_IN0), 0, 16, in[I_NORM_MIX], 1.f};
    case 1: return CvtJob{in[I_OD_WIN], 5648, 1024, 4096, 0, OKP(bf16_t, WS_W_IN1), 0, 16, in[I_NORM_MIX] + 1024, 1.f};
    case 2: return CvtJob{in[I_OD_WIN], 5648, 1024, 512, 4112, OKP(bf16_t, WS_W_IN1), 4096, 16, in[I_NORM_MIX] + 1024, 0.125f * LOG2E};
    case 3: return CvtJob{in[I_OD_WIN], 5648, 1024, 1024, 4624, OKP(bf16_t, WS_W_IN1), 4608, 16, in[I_NORM_MIX] + 1024, 1.f};
    case 4: return CvtJob{in[I_EV_WOUT], 1024, 1536, 1024, 0, OKP(bf16_t, WS_W_OUT0), 0, 16, nullptr, 1.f};
    case 5: return CvtJob{in[I_OD_WOUT], 1024, 1536, 1024, 0, OKP(bf16_t, WS_W_OUT1), 0, 16, nullptr, 1.f};
    default: { const int l = (j - 6) / 4, w = (j - 6) % 4; bf16_t* dst = OKP(bf16_t, WS_W_XA + (size_t)l * 8 * MiB + (size_t)w * 2 * MiB);
        const float* src = in[I_XA_WQ + w] + (size_t)l * 1024 * 1024;
        if (w == 0) return CvtJob{src, 1024, 1024, 1024, 0, dst, 0, 16, in[I_NORM_XA] + l * 1024, 0.0625f * LOG2E};
        return CvtJob{src, 1024, 1024, 1024, 0, dst, 0, 16, nullptr, 1.f}; }
    }
}
constexpr int N_DENSE_JOBS = 14;
__device__ __forceinline__ CvtJob moe_job(const Frame& F, int l, int j) {
    using namespace sm;
    const int e = j / 3, w = j % 3; const float* const* in = F.in;
    bf16_t* gu = OKP(bf16_t, WSL_MOEW(l) + (size_t)e * 3 * MiB); bf16_t* dn = gu + 1024 * 1024;
    if (w == 0) return CvtJob{in[I_MOE_WGATE] + ((size_t)l * 32 + e) * 1024 * 512, 512, 1024, 512, 0, gu, 0, 32, in[I_NORM_FFN] + l * 1024, 1.f};
    if (w == 1) return CvtJob{in[I_MOE_WUP] + ((size_t)l * 32 + e) * 1024 * 512, 512, 1024, 512, 0, gu, 16, 32, in[I_NORM_FFN] + l * 1024, 1.f};
    return CvtJob{in[I_MOE_WDOWN] + ((size_t)l * 32 + e) * 512 * 1024, 1024, 512, 1024, 0, dn, 0, 16, nullptr, 1.f};
}
__device__ __forceinline__ int dense_total(const Frame& F) { int n = 0; for (int j = 0; j < N_DENSE_JOBS; ++j) n += job_items(dense_job(F, j)); return n; }
__device__ __forceinline__ void dense_item(const Frame& F, int idx, CvtJob& job, int& item) {
    for (int j = 0; j < N_DENSE_JOBS; ++j) { const CvtJob jb = dense_job(F, j); const int n = job_items(jb); job = jb; item = idx < n ? idx : n - 1; if (idx < n) return; idx -= n; }
}
__device__ __forceinline__ void phase_cvt_dense(const Frame& F0) {
    const Frame F = phase_frame(F0);
    LAS float* scr = (LAS float*)(F.lds + F.wave * 16384);
    const int gw = F.vcu * NWAVES + F.wave, NGW = F.G * NWAVES, N = dense_total(F);
    CvtRegs ra, rb;
    auto LD = [&](CvtRegs& r, int idx) { CvtJob jb; int it; dense_item(F, idx < N ? idx : N - 1, jb, it); cvt_load(r, jb, it, F.lane); };
    auto FN = [&](const CvtRegs& r, int idx) { if (idx < N) { CvtJob jb; int it; dense_item(F, idx, jb, it); cvt_finish(r, jb, it, scr, F.lane); } };
    LD(ra, gw);
    for (int idx = gw; idx < N; idx += 2 * NGW) { LD(rb, idx + NGW); FN(ra, idx); LD(ra, idx + 2 * NGW); FN(rb, idx + NGW); }
}
__device__ __forceinline__ void phase_cvt_moe(const Frame& F0, int l, int widx = -1, int nwg = 0) {
    const Frame F = phase_frame(F0);
    LAS float* scr = (LAS float*)(F.lds + F.wave * 16384);
    const int gw = (widx >= 0 ? widx : F.vcu) * NWAVES + F.wave, NGW = (widx >= 0 ? nwg : F.G) * NWAVES; constexpr int N = 96 * 256;
    CvtRegs ra, rb;
    auto LD = [&](CvtRegs& r, int idx) { const int ii = idx < N ? idx : N - 1; const CvtJob jb = moe_job(F, l, ii >> 8); cvt_load(r, jb, ii & 255, F.lane); };
    auto FN = [&](const CvtRegs& r, int idx) { if (idx < N) { const CvtJob jb = moe_job(F, l, idx >> 8); cvt_finish(r, jb, idx & 255, scr, F.lane); } };
    LD(ra, gw);
    for (int idx = gw; idx < N; idx += 2 * NGW) { LD(rb, idx + NGW); FN(ra, idx); LD(ra, idx + 2 * NGW); FN(rb, idx + NGW); }
}
__device__ __forceinline__ void row_to_bf16_ssq(const float* xrow, bf16_t* orow, float* ssq, int lane) {
    const f32x4* xr = (const f32x4*)xrow + lane; float s = 0.f; f32x4 v[4];
#pragma unroll
    for (int j = 0; j < 4; ++j) { v[j] = xr[64 * j]; s += (v[j].x * v[j].x + v[j].y * v[j].y) + (v[j].z * v[j].z + v[j].w * v[j].w); }
    s = wave_sum(s);
    u32x2* o8 = (u32x2*)orow + lane;
#pragma unroll
    for (int j = 0; j < 4; ++j) { u32x2 w; w.x = cvt_pk_bf16(v[j].x, v[j].y); w.y = cvt_pk_bf16(v[j].z, v[j].w); o8[64 * j] = w; }
    if (lane == 0) *ssq = s;
}
__device__ __forceinline__ void phase_prologue(const Frame& F0) {
    const Frame F = phase_frame(F0);
    using namespace sm;
    phase_cvt_dense(F0);
    const int gw = F.vcu * NWAVES + F.wave, NGW = F.G * NWAVES;
    float* ssq0 = (float*)F.ctl + CW_SSQ;
    for (int m = gw; m < T; m += NGW) row_to_bf16_ssq(F.in[I_X] + (size_t)m * DM, OKP(bf16_t, WS_HB) + (size_t)m * DM, ssq0 + m, F.lane);
    for (int m = gw; m < NB * 256; m += NGW) { const f32x4* xr = (const f32x4*)(F.in[I_MEM] + (size_t)m * DM) + F.lane; const f32x4* gr = (const f32x4*)F.in[I_MEM_NORM] + F.lane; float s = 0.f; f32x4 v[4];
#pragma unroll
        for (int j = 0; j < 4; ++j) { v[j] = xr[64 * j]; s += (v[j].x * v[j].x + v[j].y * v[j].y) + (v[j].z * v[j].z + v[j].w * v[j].w); }
        const float r = 1.f / sqrtf(wave_sum(s) * (1.f / DM) + EPS);
        u32x2* o8 = (u32x2*)(OKP(bf16_t, WS_MEMNB) + (size_t)m * DM) + F.lane;
#pragma unroll
        for (int j = 0; j < 4; ++j) { const f32x4 g = gr[64 * j]; u32x2 w; w.x = cvt_pk_bf16(v[j].x * r * g.x, v[j].y * r * g.y); w.y = cvt_pk_bf16(v[j].z * r * g.z, v[j].w * r * g.w); o8[64 * j] = w; } }
    const size_t gt = (size_t)F.vcu * NT + F.tid, GT = (size_t)F.G * NT;
    for (size_t i = gt; i < 1024 * 16; i += GT) { const int k = (int)(i >> 4), j = (int)(i & 15);
        OKP(float, WS_WDT)[j * 1024 + k] = F.in[I_NORM_MIX][k] * F.in[I_EV_WIN][(size_t)k * 4112 + 4096 + j];
        OKP(float, WS_WAB)[j * 1024 + k] = F.in[I_NORM_MIX][1024 + k] * F.in[I_OD_WIN][(size_t)k * 5648 + 4096 + j]; }
}

#ifndef CPU_EMU
struct EpiScaleBf16 {
    static constexpr bool PERM = true, AFTER_DRAIN = false;
    bf16_t* O; int ldc; const float* ssq; int np; bf16_t* O2 = nullptr; int ldc2 = 0, split = 1 << 30;
    __device__ __forceinline__ void operator()(const f32x4 (&acc)[2][2][4][2], const pg8::Unit& u, int wr, int wc, int fr, int fq) const {
        const int row0 = u.pm * 256 + wr * 64 + fr, col0 = u.pn * 256 + wc * 32 + 8 * fq;
        float rs8[2][4];
        if (ssq) rstd_rows8(ssq, np, row0, fq, rs8); else {
#pragma unroll
            for (int i = 0; i < 8; ++i) rs8[i >> 2][i & 3] = 1.f; }
#pragma unroll
        for (int ai = 0; ai < 2; ++ai)
#pragma unroll
            for (int m = 0; m < 4; ++m) { const int row = row0 + ai * 128 + m * 16; const float s = rs8[ai][m]; bf16_t* rowp = (u.pn * 256 >= split) ? O2 + (size_t)row * ldc2 + (col0 - split) : O + (size_t)row * ldc + col0;
#pragma unroll
                for (int bj = 0; bj < 2; ++bj) { const f32x4 v0 = acc[ai][bj][m][0] * s, v1 = acc[ai][bj][m][1] * s; u32x4 w; w.x = cvt_pk_bf16(v0[0], v0[1]); w.y = cvt_pk_bf16(v0[2], v0[3]); w.z = cvt_pk_bf16(v1[0], v1[1]); w.w = cvt_pk_bf16(v1[2], v1[3]);
                    *(u32x4*)(rowp + bj * 128) = w; } }
    }
};
template <bool HIN_F32> struct EpiResidualT {
    static constexpr bool PERM = false, AFTER_DRAIN = false;
    const float* hin; bf16_t* hb; float* ssq;
    __device__ __forceinline__ void operator()(const f32x4 (&acc)[2][2][4][2], const pg8::Unit& u, int wr, int wc, int fr, int fq) const {
        const int row0 = u.pm * 256 + wr * 64 + fr, col0 = u.pn * 256 + wc * 32 + 4 * fq;
#pragma unroll
        for (int ai = 0; ai < 2; ++ai) {
            f32x4 hf[HIN_F32 ? 4 : 1][2][2]; u32x2 hw2[HIN_F32 ? 1 : 4][2][2];
#pragma unroll
            for (int m = 0; m < 4; ++m)
#pragma unroll
                for (int bj = 0; bj < 2; ++bj)
#pragma unroll
                    for (int n = 0; n < 2; ++n) { const size_t o = (size_t)(row0 + ai * 128 + m * 16) * DM + col0 + bj * 128 + n * 16;
                        if (HIN_F32) hf[HIN_F32 ? m : 0][bj][n] = *(const f32x4*)(hin + o); else hw2[HIN_F32 ? 0 : m][bj][n] = *(const u32x2*)(hb + o); }
            SCHED_FENCE();
#pragma unroll
            for (int m = 0; m < 4; ++m) { const int row = row0 + ai * 128 + m * 16; const size_t ro = (size_t)row * DM + col0; float s = 0.f;
#pragma unroll
                for (int bj = 0; bj < 2; ++bj)
#pragma unroll
                    for (int n = 0; n < 2; ++n) { const size_t o = ro + bj * 128 + n * 16; f32x4 v;
                        if (HIN_F32) v = hf[HIN_F32 ? m : 0][bj][n]; else { const u32x2 hw = hw2[HIN_F32 ? 0 : m][bj][n]; v = (f32x4){bflo(hw.x), bfhi(hw.x), bflo(hw.y), bfhi(hw.y)}; }
                        v += acc[ai][bj][m][n];
                        u32x2 w; w.x = cvt_pk_bf16(v[0], v[1]); w.y = cvt_pk_bf16(v[2], v[3]); *(u32x2*)(hb + o) = w;
                        const float r0 = bflo(w.x), r1 = bfhi(w.x), r2 = bflo(w.y), r3 = bfhi(w.y); s += (r0 * r0 + r1 * r1) + (r2 * r2 + r3 * r3); }
                s += __shfl_xor(s, 16); s += __shfl_xor(s, 32);
                if (fq == 0) ssq[(size_t)row * 16 + u.pn * 4 + wc] = s; } }
    }
};

template <class Epi> __device__ __forceinline__ void dense_gemm(const Frame& F, const bf16_t* A, const bf16_t* Bt, int M, int N, int K, const Epi& E) {
    pg8::Gemm g{A, Bt, M, N, K}; pg8::StaticOrder S; S.init(g, F.G, (int)blockIdx.x);
    pg8::gemm_phase<Epi, pg8::StaticOrder, true, true>(F.lds, g, S, E, F.wave);
}
#endif
}

namespace ok {
constexpr int XT_LD = 72;
constexpr int BC_LD = 136;
__device__ __forceinline__ float siluf(float x) { return x * frcp(1.f + fexp(-x)); }
__device__ __forceinline__ float softplusf(float x) { return x > 20.f ? x : log1pf(expf(x)); }

template <class Sink> __device__ __forceinline__ void ssd_conv_pair(const Frame& F, int b, int c, int xc, Sink&& sink) {
    using namespace sm;
    const float* cw = F.in[I_EV_CONVW]; const f32x2 w0 = *(const f32x2*)(cw + xc), w1 = *(const f32x2*)(cw + 1536 + xc), w2 = *(const f32x2*)(cw + 3072 + xc), w3 = *(const f32x2*)(cw + 4608 + xc), bias = *(const f32x2*)(F.in[I_EV_CONVB] + xc);
    const bf16_t* p = OKP(bf16_t, WS_PROJ) + (size_t)(b * L + c * 64) * PROJ0_LD + 2560 + xc;
    unsigned raw[64];
#pragma unroll
    for (int t = 0; t < 64; ++t) raw[t] = *(const unsigned*)(p + (size_t)t * PROJ0_LD);
    const int hv = c > 0 ? 1 : 0; const unsigned a = *(const unsigned*)(p - 3 * PROJ0_LD * hv), bq = *(const unsigned*)(p - 2 * PROJ0_LD * hv), cq = *(const unsigned*)(p - PROJ0_LD * hv);
    SCHED_FENCE();
    f32x2 x0 = {0.f, 0.f}, x1 = x0, x2 = x0;
    if (hv) { x0 = (f32x2){bflo(a), bfhi(a)}; x1 = (f32x2){bflo(bq), bfhi(bq)}; x2 = (f32x2){bflo(cq), bfhi(cq)}; }
#pragma unroll
    for (int t = 0; t < 64; t += 2) { const f32x2 x3 = {bflo(raw[t]), bfhi(raw[t])}, x4 = {bflo(raw[t + 1]), bfhi(raw[t + 1])};
        const f32x2 v0 = bias + w0 * x0 + w1 * x1 + w2 * x2 + w3 * x3, v1 = bias + w0 * x1 + w1 * x2 + w2 * x3 + w3 * x4;
        sink(t, siluf(v0.x), siluf(v1.x), siluf(v0.y), siluf(v1.y)); x0 = x2; x1 = x3; x2 = x4; }
}

__device__ __forceinline__ void phase_ssd_a(const Frame& F0) {
    const Frame F = phase_frame(F0);
    using namespace sm;
    LAS bf16_t* XT = (LAS bf16_t*)F.lds; LAS bf16_t* BT = (LAS bf16_t*)(F.lds + 73728);
    LAS float* dt_s = (LAS float*)(F.lds + 92160); LAS float* acs_s = (LAS float*)(F.lds + 94208); LAS float* sc_s = (LAS float*)(F.lds + 96256);
    const int tid = F.tid, lane = F.lane, wave = F.wave;
    for (int u = F.vcu; u < NB * NCH * 2; u += F.G) {
        const int g = u & 1, bc = u >> 1, b = bc / NCH, c = bc % NCH; const size_t row0 = (size_t)b * L + c * 64;
        LDS_BARRIER();
        if (tid < 320) { const int ci = tid * 2;
            const int xc = ci < 512 ? g * 512 + ci : 1024 + g * 128 + (ci - 512);
            LAS unsigned* dst = (LAS unsigned*)(ci < 512 ? XT + ci * XT_LD : BT + (ci - 512) * XT_LD);
            ssd_conv_pair(F, b, c, xc, [&](int t, float a0, float a1, float b0, float b1) { dst[t >> 1] = cvt_pk_bf16(a0, a1); dst[XT_LD / 2 + (t >> 1)] = cvt_pk_bf16(b0, b1); });
        }
        { const int t = tid & 63, hh = tid >> 6, hd = g * 8 + hh; const float dt = softplusf(OKP(float, WS_RAW16)[(row0 + t) * 16 + hd] + F.in[I_EV_DTB][hd]); dt_s[hh * 64 + t] = dt; acs_s[hh * 64 + t] = dt * -expf(F.in[I_EV_ALOG][hd]); }
        LDS_BARRIER();
        { const int hh = wave, hd = g * 8 + hh; float v = acs_s[hh * 64 + lane];
#pragma unroll
          for (int o = 1; o < 64; o <<= 1) { const float n = __shfl_up(v, o); if (lane >= o) v += n; }
          const float last = __shfl(v, 63); const float dt = dt_s[hh * 64 + lane];
          sc_s[hh * 64 + lane] = dt * fexp(last - v);
          OKP(float, WS_DTV)[(row0 + lane) * 16 + hd] = dt; OKP(float, WS_ACS)[(row0 + lane) * 16 + hd] = v; }
        WAVE_SYNC();
#if defined(CHECK_DUMP)
        if (bc == 5 && g == 0) {
            float* f3 = OKP(float, WS_FP) + (size_t)3 * 16 * 6144; float* f4 = OKP(float, WS_FP) + (size_t)4 * 16 * 6144; float* f5 = OKP(float, WS_FP) + (size_t)5 * 16 * 6144;
            for (int i = tid; i < 512 * 64; i += NT) f3[i] = bf2f(XT[(i >> 6) * XT_LD + (i & 63)]);
            for (int i = tid; i < 128 * 64; i += NT) f4[i] = bf2f(BT[(i >> 6) * XT_LD + (i & 63)]);
            f5[wave * 64 + lane] = sc_s[wave * 64 + lane];
        }
#endif
        { const int hh = wave, hd = g * 8 + hh, fr = lane & 15, fq = lane >> 4;
          bf16x8 xa[4][2];
#pragma unroll
          for (int pt = 0; pt < 4; ++pt)
#pragma unroll
              for (int ks = 0; ks < 2; ++ks) { const u32x4 raw = *(const LAS u32x4*)(XT + (hh * 64 + pt * 16 + fr) * XT_LD + ks * 32 + fq * 8); const LAS float* sp = sc_s + hh * 64 + ks * 32 + fq * 8;
                  const f32x4 s0 = *(const LAS f32x4*)sp, s1 = *(const LAS f32x4*)(sp + 4); u32x4 o;
                  o.x = cvt_pk_bf16(bflo(raw.x) * s0.x, bfhi(raw.x) * s0.y); o.y = cvt_pk_bf16(bflo(raw.y) * s0.z, bfhi(raw.y) * s0.w);
                  o.z = cvt_pk_bf16(bflo(raw.z) * s1.x, bfhi(raw.z) * s1.y); o.w = cvt_pk_bf16(bflo(raw.w) * s1.z, bfhi(raw.w) * s1.w);
                  xa[pt][ks] = __builtin_bit_cast(bf16x8, o); }
          bf16_t* st = OKP(bf16_t, WS_STATES) + ((size_t)bc * 16 + hd) * 8192;
#pragma unroll
          for (int nt = 0; nt < 8; ++nt) { bf16x8 bb[2];
#pragma unroll
              for (int ks = 0; ks < 2; ++ks) bb[ks] = *(const LAS bf16x8*)(BT + (nt * 16 + fr) * XT_LD + ks * 32 + fq * 8);
#pragma unroll
              for (int pt = 0; pt < 4; ++pt) { f32x4 acc = {0.f, 0.f, 0.f, 0.f};
#pragma unroll
                  for (int ks = 0; ks < 2; ++ks) acc = mfma16(bb[ks], xa[pt][ks], acc);
                  u32x2 w; w.x = cvt_pk_bf16(acc[0], acc[1]); w.y = cvt_pk_bf16(acc[2], acc[3]);
                  *(u32x2*)(st + (size_t)(pt * 16 + fr) * 128 + nt * 16 + 4 * fq) = w; } } }
    }
}

__device__ __forceinline__ void phase_ssd_scan(const Frame& F0, int skip) {
    const Frame F = phase_frame(F0);
    const float* acs = OKP(float, WS_ACS);
    int widx = F.vcu, nw = F.G;
    if (skip) { const int per = F.G / 8, xcd = (int)blockIdx.x & 7, loc = (int)blockIdx.x >> 3  , sk = skip / 8; if (loc < sk) return; widx = xcd * (per - sk) + (loc - sk); nw = F.G - skip; }
    LAS float* dec_s = (LAS float*)F.lds;
    const int tid = F.tid, NTOT = NB * 65536;
    for (int base = widx * NT; base < NTOT; base += 2 * nw * NT) {
        const int baseB = base + nw * NT; const bool vB = baseB < NTOT; const int iA = base + tid, iB = vB ? baseB + tid : iA;
        LDS_BARRIER();
        if (tid < 2 * NCH) { const int ch = tid / NCH, c = tid % NCH, ii = ch ? (vB ? baseB : base) : base, b = ii >> 16, hd = (ii & 65535) >> 12; dec_s[ch * NCH + c] = fexp(acs[((size_t)b * L + c * 64 + 63) * 16 + hd]); }
        LDS_BARRIER();
        unsigned* pA = (unsigned*)(OKP(bf16_t, WS_STATES) + (size_t)(iA >> 16) * NCH * 131072) + (iA & 65535);
        unsigned* pB = (unsigned*)(OKP(bf16_t, WS_STATES) + (size_t)(iB >> 16) * NCH * 131072) + (iB & 65535);
        float a0 = 0.f, a1 = 0.f, b0 = 0.f, b1 = 0.f; unsigned sA0[8], sB0[8], sA1[8], sB1[8];
#define SCAN_LOAD(SA, SB, c0) do { _Pragma("unroll") for (int k = 0; k < 8; ++k) { const int c = (c0) + k < NCH ? (c0) + k : NCH - 1; SA[k] = pA[(size_t)c * 65536]; SB[k] = pB[(size_t)c * 65536]; } } while (0)
#define SCAN_STEP(SA, SB, c0) do { _Pragma("unroll") for (int k = 0; k < 8; ++k) { const int c = (c0) + k; if (NCH % 16 != 0 && c >= NCH) break; const float dA = dec_s[c], dB = dec_s[NCH + c]; \
            pA[(size_t)c * 65536] = cvt_pk_bf16(a0, a1); a0 = a0 * dA + bflo(SA[k]); a1 = a1 * dA + bfhi(SA[k]); \
            if (vB) pB[(size_t)c * 65536] = cvt_pk_bf16(b0, b1); b0 = b0 * dB + bflo(SB[k]); b1 = b1 * dB + bfhi(SB[k]); } } while (0)
        SCAN_LOAD(sA0, sB0, 0);
#pragma unroll 1
        for (int c0 = 0; c0 < NCH; c0 += 16) {
            SCAN_LOAD(sA1, sB1, c0 + 8); SCHED_FENCE();
            SCAN_STEP(sA0, sB0, c0); SCHED_FENCE();
            SCAN_LOAD(sA0, sB0, c0 + 16); SCHED_FENCE();
            SCAN_STEP(sA1, sB1, c0 + 8); SCHED_FENCE();
        }
#undef SCAN_LOAD
#undef SCAN_STEP
    }
}

__device__ __forceinline__ void phase_ssd_b(const Frame& F0) {
    const Frame F = phase_frame(F0);
    using namespace sm;
    LAS bf16_t* XT = (LAS bf16_t*)F.lds; LAS bf16_t* Bs = (LAS bf16_t*)(F.lds + 73728); LAS bf16_t* Cs = (LAS bf16_t*)(F.lds + 91136);
    LAS float* acs_s = (LAS float*)(F.lds + 108544); LAS float* dt_s = (LAS float*)(F.lds + 110592); LAS float* red = (LAS float*)(F.lds + 112640);
    const int tid = F.tid, lane = F.lane, wave = F.wave, fr = lane & 15, fq = lane >> 4;
    const bf16_t* proj = OKP(bf16_t, WS_PROJ); bf16_t* cat = OKP(bf16_t, WS_CAT0);
    for (int u = F.vcu; u < NB * NCH * 2; u += F.G) {
        const int g = u & 1, bc = u >> 1, b = bc / NCH, c = bc % NCH; const size_t row0 = (size_t)b * L + c * 64;
        LDS_BARRIER();
        if (tid < 384) { const int ci = tid * 2;
            if (ci < 512) { LAS unsigned* dst = (LAS unsigned*)(XT + ci * XT_LD); ssd_conv_pair(F, b, c, g * 512 + ci, [&](int t, float a0, float a1, float b0, float b1) { dst[t >> 1] = cvt_pk_bf16(a0, a1); dst[XT_LD / 2 + (t >> 1)] = cvt_pk_bf16(b0, b1); }); }
            else { const int n = (ci - 512) & 127; LAS unsigned* dst = (LAS unsigned*)((ci < 640 ? Bs : Cs) + n); const int xc = (ci < 640 ? 1024 : 1280) + g * 128 + n;
                ssd_conv_pair(F, b, c, xc, [&](int t, float a0, float a1, float b0, float b1) { dst[t * (BC_LD / 2)] = cvt_pk_bf16(a0, b0); dst[(t + 1) * (BC_LD / 2)] = cvt_pk_bf16(a1, b1); }); }
        }
        { const int t = tid & 63, hh = tid >> 6; acs_s[hh * 64 + t] = OKP(float, WS_ACS)[(row0 + t) * 16 + g * 8 + hh]; dt_s[hh * 64 + t] = OKP(float, WS_DTV)[(row0 + t) * 16 + g * 8 + hh]; }
        { const int ch = g * 256 + (tid & 255), t0 = (tid >> 8) * 32; const float* w = F.in[I_EV_SCCONV]; const float w0 = w[ch], w1 = w[512 + ch], w2 = w[1024 + ch];
          const bf16_t* p = proj + (row0 + t0) * PROJ0_LD + ch; float p0 = 0.f, p1 = 0.f;
          const int hv = (c > 0 || t0 > 0) ? 1 : 0; const unsigned short h0 = p[-2 * PROJ0_LD * hv + 512], h1 = p[-2 * PROJ0_LD * hv + 1024], h2 = p[-PROJ0_LD * hv + 512], h3 = p[-PROJ0_LD * hv + 1024];
          unsigned short rb[32], rc[32], rx[32];
#pragma unroll
          for (int t = 0; t < 32; ++t) { const bf16_t* q = p + (size_t)t * PROJ0_LD; rb[t] = q[0]; rc[t] = q[512]; rx[t] = q[1024]; }
          SCHED_FENCE();
          if (hv) { p0 = bf2f(h0) * bf2f(h1); p1 = bf2f(h2) * bf2f(h3); }
#pragma unroll
          for (int t = 0; t < 32; ++t) { const float p2 = bf2f(rc[t]) * bf2f(rx[t]); const float y = bf2f(rb[t]) * (w0 * p0 + w1 * p1 + w2 * p2);
              cat[(row0 + t0 + t) * 1536 + ch] = (bf16_t)(cvt_pk_bf16(y, 0.f) & 0xffffu); p0 = p1; p1 = p2; } }
        LDS_BARRIER();
        const int hh = wave, hd = g * 8 + hh;
        f32x4 Y[4][4];
        { const bf16_t* P = OKP(bf16_t, WS_STATES) + ((size_t)bc * 16 + hd) * 8192;
#pragma unroll
          for (int pt = 0; pt < 4; ++pt)
#pragma unroll
              for (int tt = 0; tt < 4; ++tt) Y[pt][tt] = (f32x4){0.f, 0.f, 0.f, 0.f};
          bf16x8 pall[4][4];
#pragma unroll
          for (int ks = 0; ks < 4; ++ks)
#pragma unroll
              for (int pt = 0; pt < 4; ++pt) pall[ks][pt] = *(const bf16x8*)(P + (size_t)(pt * 16 + fr) * 128 + ks * 32 + fq * 8);
#pragma unroll
          for (int ks = 0; ks < 4; ++ks) { bf16x8 cb[4];
#pragma unroll
              for (int tt = 0; tt < 4; ++tt) cb[tt] = *(const LAS bf16x8*)(Cs + (tt * 16 + fr) * BC_LD + ks * 32 + fq * 8);
#pragma unroll
              for (int pt = 0; pt < 4; ++pt)
#pragma unroll
                  for (int tt = 0; tt < 4; ++tt) Y[pt][tt] = mfma16(pall[ks][pt], cb[tt], Y[pt][tt]); }
#pragma unroll
          for (int tt = 0; tt < 4; ++tt) { const float e = fexp(acs_s[hh * 64 + tt * 16 + fr]);
#pragma unroll
              for (int pt = 0; pt < 4; ++pt) Y[pt][tt] *= e; } }
#pragma unroll
        for (int tt = 0; tt < 4; ++tt) { f32x4 cbt[4];
#pragma unroll
            for (int st = 0; st < 4; ++st) cbt[st] = (f32x4){0.f, 0.f, 0.f, 0.f};
#pragma unroll
            for (int ks = 0; ks < 4; ++ks) { const bf16x8 cf = *(const LAS bf16x8*)(Cs + (tt * 16 + fr) * BC_LD + ks * 32 + fq * 8);
#pragma unroll
                for (int st = 0; st < 4; ++st) if (st <= tt) { const bf16x8 bf = *(const LAS bf16x8*)(Bs + (st * 16 + fr) * BC_LD + ks * 32 + fq * 8); cbt[st] = mfma16(bf, cf, cbt[st]); } }
            const int t = tt * 16 + fr; const float at = acs_s[hh * 64 + t];
#pragma unroll
            for (int st = 0; st < 4; ++st) { const f32x4 as4 = *(const LAS f32x4*)(acs_s + hh * 64 + st * 16 + 4 * fq), dt4 = *(const LAS f32x4*)(dt_s + hh * 64 + st * 16 + 4 * fq);
#pragma unroll
                for (int r = 0; r < 4; ++r) { const int s = st * 16 + 4 * fq + r; cbt[st][r] = (st <= tt && s <= t) ? cbt[st][r] * fexp(at - as4[r]) * dt4[r] : 0.f; } }
            bf16x8 mb[2];
#pragma unroll
            for (int ks = 0; ks < 2; ++ks) { u32x4 o; o.x = cvt_pk_bf16(cbt[2 * ks][0], cbt[2 * ks][1]); o.y = cvt_pk_bf16(cbt[2 * ks][2], cbt[2 * ks][3]); o.z = cvt_pk_bf16(cbt[2 * ks + 1][0], cbt[2 * ks + 1][1]); o.w = cvt_pk_bf16(cbt[2 * ks + 1][2], cbt[2 * ks + 1][3]);
                mb[ks] = __builtin_bit_cast(bf16x8, o); }
#pragma unroll
            for (int pt = 0; pt < 4; ++pt)
#pragma unroll
                for (int ks = 0; ks < 2; ++ks) { const LAS bf16_t* xp = XT + (hh * 64 + pt * 16 + fr) * XT_LD + ks * 32 + 4 * fq; const u32x2 lo = *(const LAS u32x2*)xp, hi = *(const LAS u32x2*)(xp + 16);
                    u32x4 a; a.x = lo.x; a.y = lo.y; a.z = hi.x; a.w = hi.y; Y[pt][tt] = mfma16(__builtin_bit_cast(bf16x8, a), mb[ks], Y[pt][tt]); } }
        u32x2 zz_[4][4];
#pragma unroll
        for (int tt = 0; tt < 4; ++tt)
#pragma unroll
            for (int pt = 0; pt < 4; ++pt) zz_[tt][pt] = *(const u32x2*)(proj + (row0 + tt * 16 + fr) * PROJ0_LD + 1536 + hd * 64 + pt * 16 + 4 * fq);
        SCHED_FENCE();
        const float Dh = F.in[I_EV_D][hd];
#pragma unroll
        for (int tt = 0; tt < 4; ++tt) { const int t = tt * 16 + fr; float ss = 0.f;
#pragma unroll
            for (int pt = 0; pt < 4; ++pt) { const int p = pt * 16 + 4 * fq; const u32x2 zz = zz_[tt][pt];
                const float z0 = bflo(zz.x), z1 = bfhi(zz.x), z2 = bflo(zz.y), z3 = bfhi(zz.y); const LAS bf16_t* xp = XT + (hh * 64 + p) * XT_LD + t;
                f32x4 y = Y[pt][tt]; y[0] = (y[0] + Dh * bf2f(xp[0])) * siluf(z0); y[1] = (y[1] + Dh * bf2f(xp[XT_LD])) * siluf(z1); y[2] = (y[2] + Dh * bf2f(xp[2 * XT_LD])) * siluf(z2); y[3] = (y[3] + Dh * bf2f(xp[3 * XT_LD])) * siluf(z3);
                Y[pt][tt] = y; ss += (y[0] * y[0] + y[1] * y[1]) + (y[2] * y[2] + y[3] * y[3]); }
            ss += __shfl_xor(ss, 16); ss += __shfl_xor(ss, 32);
            if (fq == 0) red[hh * 64 + t] = ss; }
        f32x4 nw_[4];
#pragma unroll
        for (int pt = 0; pt < 4; ++pt) nw_[pt] = *(const f32x4*)(F.in[I_EV_NORM] + hd * 64 + pt * 16 + 4 * fq);
        LDS_BARRIER();
#pragma unroll
        for (int tt = 0; tt < 4; ++tt) { const int t = tt * 16 + fr; float ss = 0.f;
#pragma unroll
            for (int w = 0; w < 8; ++w) ss += red[w * 64 + t];
            const float rs = frsq(ss * (1.f / 512.f) + EPS);
#pragma unroll
            for (int pt = 0; pt < 4; ++pt) { const int ch = hd * 64 + pt * 16 + 4 * fq; const f32x4 nw = nw_[pt]; const f32x4 y = Y[pt][tt];
                u32x2 w; w.x = cvt_pk_bf16(y[0] * rs * nw.x, y[1] * rs * nw.y); w.y = cvt_pk_bf16(y[2] * rs * nw.z, y[3] * rs * nw.w);
                *(u32x2*)(cat + (row0 + t) * 1536 + 512 + ch) = w; } }
    }
}
}

namespace ok {
constexpr int XA_LD = 264;

__device__ __forceinline__ void phase_xattn(const Frame& F0, const bf16_t* q, const bf16_t* kx, const bf16_t* vt, bf16_t* att) {
    const Frame F = phase_frame(F0);
    LAS bf16_t* KV = (LAS bf16_t*)F.lds;
    const int tid = F.tid, lane = F.lane, wave = F.wave, fr = lane & 15, fq = lane >> 4;
    constexpr int XA_PRE = 6;
    u32x4 tile[XA_PRE];
#define XA_LOAD_K(uu) do { const int hd_ = (uu) & 3, b_ = (((uu) >> 2) * 128) / L; _Pragma("unroll") for (int j_ = 0; j_ < XA_PRE; ++j_) { const int i_ = tid + j_ * NT, r_ = i_ >> 5, c8_ = i_ & 31; tile[j_] = *(const u32x4*)(kx + (size_t)(b_ * 256 + r_) * 1024 + hd_ * 256 + c8_ * 8); } } while (0)
#define XA_LOAD_V(uu) do { const int hd_ = (uu) & 3, b_ = (((uu) >> 2) * 128) / L; _Pragma("unroll") for (int j_ = 0; j_ < XA_PRE; ++j_) { const int i_ = tid + j_ * NT, r_ = i_ >> 5, c8_ = i_ & 31; tile[j_] = *(const u32x4*)(vt + (size_t)(hd_ * 256 + r_) * (NB * 256) + b_ * 256 + c8_ * 8); } } while (0)
#define XA_STORE() do { _Pragma("unroll") for (int j_ = 0; j_ < XA_PRE; ++j_) { const int i_ = tid + j_ * NT, r_ = i_ >> 5, c8_ = i_ & 31; *(LAS u32x4*)(KV + r_ * XA_LD + c8_ * 8) = tile[j_]; } } while (0)
#define XA_STORE_REST() do { _Pragma("unroll") for (int j_ = XA_PRE; j_ < 16; ++j_) { const int i_ = tid + j_ * NT, r_ = i_ >> 5, c8_ = i_ & 31; *(LAS u32x4*)(KV + r_ * XA_LD + c8_ * 8) = rest[j_ - XA_PRE]; } } while (0)
#define XA_REST_K(uu) do { const int hd_ = (uu) & 3, b_ = (((uu) >> 2) * 128) / L; _Pragma("unroll") for (int j_ = XA_PRE; j_ < 16; ++j_) { const int i_ = tid + j_ * NT, r_ = i_ >> 5, c8_ = i_ & 31; rest[j_ - XA_PRE] = *(const u32x4*)(kx + (size_t)(b_ * 256 + r_) * 1024 + hd_ * 256 + c8_ * 8); } } while (0)
#define XA_REST_V(uu) do { const int hd_ = (uu) & 3, b_ = (((uu) >> 2) * 128) / L; _Pragma("unroll") for (int j_ = XA_PRE; j_ < 16; ++j_) { const int i_ = tid + j_ * NT, r_ = i_ >> 5, c8_ = i_ & 31; rest[j_ - XA_PRE] = *(const u32x4*)(vt + (size_t)(hd_ * 256 + r_) * (NB * 256) + b_ * 256 + c8_ * 8); } } while (0)
    if (F.vcu < (T / 128) * 4) XA_LOAD_K(F.vcu);
    for (int u = F.vcu; u < (T / 128) * 4; u += F.G) {
        const int hd = u & 3, rt = u >> 2, row0 = rt * 128;
        LDS_BARRIER();
        bf16x8 qf[8];
        { u32x4 rest[16 - XA_PRE]; XA_REST_K(u); SCHED_FENCE(); XA_STORE(); SCHED_FENCE();
          const bf16_t* qp = q + (size_t)(row0 + wave * 16 + fr) * 1024 + hd * 256 + fq * 8;
#pragma unroll
          for (int ks = 0; ks < 8; ++ks) qf[ks] = *(const bf16x8*)(qp + ks * 32);
          SCHED_FENCE(); XA_STORE_REST(); }
        XA_LOAD_V(u);
        LDS_BARRIER();
        bf16x8 pf[8]; float fA, fB;
        {
            float mh[2], lh[2];
#pragma unroll
            for (int half = 0; half < 2; ++half) {
                f32x4 s[8];
#pragma unroll
                for (int kt = 0; kt < 8; ++kt) { s[kt] = (f32x4){0.f, 0.f, 0.f, 0.f};
#pragma unroll
                    for (int ks = 0; ks < 8; ++ks) { const bf16x8 kf = *(const LAS bf16x8*)(KV + ((half * 8 + kt) * 16 + fr) * XA_LD + ks * 32 + fq * 8); s[kt] = mfma16(kf, qf[ks], s[kt]); }
                    }
                float m = -3.0e38f;
#pragma unroll
                for (int kt = 0; kt < 8; ++kt) m = fmaxf(m, fmaxf(fmaxf(s[kt][0], s[kt][1]), fmaxf(s[kt][2], s[kt][3])));
                m = fmaxf(m, __shfl_xor(m, 16)); m = fmaxf(m, __shfl_xor(m, 32));
                float l = 0.f;
#pragma unroll
                for (int kt = 0; kt < 8; ++kt) {
#pragma unroll
                    for (int r = 0; r < 4; ++r) { const float p = fexp2(s[kt][r] - m); s[kt][r] = p; l += p; } }
                l += __shfl_xor(l, 16); l += __shfl_xor(l, 32); mh[half] = m; lh[half] = l;
#pragma unroll
                for (int j = 0; j < 4; ++j) { u32x4 o; o.x = cvt_pk_bf16(s[2 * j][0], s[2 * j][1]); o.y = cvt_pk_bf16(s[2 * j][2], s[2 * j][3]); o.z = cvt_pk_bf16(s[2 * j + 1][0], s[2 * j + 1][1]); o.w = cvt_pk_bf16(s[2 * j + 1][2], s[2 * j + 1][3]);
                    pf[half * 4 + j] = __builtin_bit_cast(bf16x8, o); }
                    }
            const float m = fmaxf(mh[0], mh[1]), cA = fexp2(mh[0] - m), cB = fexp2(mh[1] - m), li = frcp(cA * lh[0] + cB * lh[1]); fA = cA * li; fB = cB * li;
        }
        LDS_BARRIER();
        { u32x4 rest[16 - XA_PRE]; XA_REST_V(u); SCHED_FENCE(); XA_STORE(); XA_STORE_REST(); }
        if (u + F.G < (T / 128) * 4) XA_LOAD_K(u + F.G);
        LDS_BARRIER();
#pragma unroll 2
        for (int dt = 0; dt < 16; ++dt) { f32x4 oA = {0.f, 0.f, 0.f, 0.f}, oB = oA;
#pragma unroll
            for (int j = 0; j < 8; ++j) { const LAS bf16_t* vp = KV + (dt * 16 + fr) * XA_LD + j * 32 + 4 * fq; const u32x2 lo = *(const LAS u32x2*)vp, hi = *(const LAS u32x2*)(vp + 16);
                u32x4 a; a.x = lo.x; a.y = lo.y; a.z = hi.x; a.w = hi.y; const bf16x8 vf = __builtin_bit_cast(bf16x8, a);
                if (j < 4) oA = mfma16(vf, pf[j], oA); else oB = mfma16(vf, pf[j], oB); }
            const f32x4 o = oA * fA + oB * fB;
            bf16_t* op = att + (size_t)(row0 + wave * 16 + fr) * 1024 + hd * 256 + dt * 16 + 4 * fq;
            u32x2 w; w.x = cvt_pk_bf16(o[0], o[1]); w.y = cvt_pk_bf16(o[2], o[3]); *(u32x2*)op = w; }
    }
#undef XA_LOAD_K
#undef XA_LOAD_V
#undef XA_STORE
#undef XA_REST_K
#undef XA_STORE_REST
#undef XA_REST_V
}

#ifndef CPU_EMU
struct KvOrder {
    static constexpr bool LIGHT = false;
    const char* memnb; const char* wxa; char* kx; char* vt; int G, c;
    __device__ bool next(int i, pg8::Unit& u) const {
        const int Lx = i * G + c; if (Lx >= 32) return false;
        const int l = Lx >> 4, r = Lx & 15; const size_t tstep = (size_t)256 * 1024 * 2;
        if (r < 8) { u.pm = r >> 2; u.pn = r & 3; u.tag = l * 2; u.a = memnb + (size_t)u.pm * tstep; u.b = wxa + (size_t)l * 8 * MiB + 2 * MiB + (size_t)u.pn * tstep; }
        else { const int r2 = r - 8; u.pm = r2 >> 1; u.pn = r2 & 1; u.tag = l * 2 + 1; u.a = wxa + (size_t)l * 8 * MiB + 4 * MiB + (size_t)u.pm * tstep; u.b = memnb + (size_t)u.pn * tstep; }
        return true;
    }
    __device__ __forceinline__ void a_ready(const pg8::Unit&) const {}
    __device__ __forceinline__ void done(const pg8::Unit&) const {}
};
struct EpiKv {
    static constexpr bool PERM = true, AFTER_DRAIN = false;
    bf16_t* kx; bf16_t* vt;
    __device__ __forceinline__ void operator()(const f32x4 (&acc)[2][2][4][2], const pg8::Unit& u, int wr, int wc, int fr, int fq) const {
        const int l = u.tag >> 1, isv = u.tag & 1, ldc = isv ? 512 : 1024; bf16_t* O = isv ? vt + (size_t)l * 1024 * 512 : kx + (size_t)l * 512 * 1024;
        const int row0 = u.pm * 256 + wr * 64 + fr, col0 = u.pn * 256 + wc * 32 + 8 * fq;
#pragma unroll
        for (int ai = 0; ai < 2; ++ai)
#pragma unroll
            for (int m = 0; m < 4; ++m) { bf16_t* rowp = O + (size_t)(row0 + ai * 128 + m * 16) * ldc + col0;
#pragma unroll
                for (int bj = 0; bj < 2; ++bj) { const f32x4 v0 = acc[ai][bj][m][0], v1 = acc[ai][bj][m][1]; u32x4 w; w.x = cvt_pk_bf16(v0[0], v0[1]); w.y = cvt_pk_bf16(v0[2], v0[3]); w.z = cvt_pk_bf16(v1[0], v1[1]); w.w = cvt_pk_bf16(v1[2], v1[3]);
                    *(u32x4*)(rowp + bj * 128) = w; } }
    }
};
__device__ __forceinline__ void phase_kv(const Frame& F) {
    pg8::Gemm g{nullptr, nullptr, 0, 0, 1024};
    int vcu_; { const int bx = blockIdx.x, G = gridDim.x; vcu_ = (G % 8 == 0) ? (bx % 8) * (G / 8) + bx / 8 : bx; if (G % 8 == 0 && G >= 64) { const int per = G / 8, xcd = (int)blockIdx.x & 7, loc = (int)blockIdx.x >> 3  ; vcu_ = loc < 4 ? xcd * 4 + loc : 32 + vcu_; } }
    KvOrder S{(const char*)OKP(bf16_t, WS_MEMNB), (const char*)OKP(bf16_t, WS_W_XA), (char*)OKP(bf16_t, WS_KX), (char*)OKP(bf16_t, WS_VT), F.G, vcu_};
    EpiKv E{OKP(bf16_t, WS_KX), OKP(bf16_t, WS_VT)};
    pg8::gemm_phase<EpiKv, KvOrder, true, true>(F.lds, g, S, E, F.wave);
}
#endif
}

namespace ok {
constexpr size_t WS_WRH = WS_WR, WS_WRL = WS_WR + 256 * KiB;
constexpr size_t WS_POS = WS_TILEEXP + 4 * KiB;
__device__ __forceinline__ void prologue_router_tables(const Frame& F0) {
    const Frame F = phase_frame(F0);
    using namespace sm;
    const size_t gt = (size_t)F.vcu * NT + F.tid, GT = (size_t)F.G * NT;
    for (size_t i = gt; i < (size_t)2 * 48 * 1024; i += GT) { const int l = (int)(i / (48 * 1024)), j = (int)((i / 1024) % 48), k = (int)(i % 1024); float v = 0.f;
        if (j < 4) v = F.in[I_MOE_WG][((size_t)l * 1024 + k) * 4 + j]; else if (j < 36) v = F.in[I_MOE_WE][((size_t)l * 1024 + k) * 32 + (j - 4)];
        v *= F.in[I_NORM_FFN][l * 1024 + k];
        const unsigned hi = cvt_pk_bf16(v, 0.f) & 0xffffu; const float rem = v - __uint_as_float(hi << 16);
        OKP(bf16_t, WS_WRH)[i] = (bf16_t)hi; OKP(bf16_t, WS_WRL)[i] = (bf16_t)(cvt_pk_bf16(rem, 0.f) & 0xffffu); }
}

constexpr size_t WS_W16H = WS_WR + 512 * KiB, WS_W16L = WS_W16H + 64 * KiB;
__device__ __forceinline__ void prologue_w16_tables(const Frame& F0) {
    using namespace sm;
    const Frame F = phase_frame(F0);
    const size_t gt = (size_t)F.vcu * NT + F.tid, GT = (size_t)F.G * NT;
    for (size_t i = gt; i < (size_t)2 * 16 * 1024; i += GT) { const int set = (int)(i >> 14), j = (int)((i >> 10) & 15), k = (int)(i & 1023);
        const float v = set == 0 ? F.in[I_NORM_MIX][k] * F.in[I_EV_WIN][(size_t)k * 4112 + 4096 + j] : F.in[I_NORM_MIX][1024 + k] * F.in[I_OD_WIN][(size_t)k * 5648 + 4096 + j];
        const unsigned hi = cvt_pk_bf16(v, 0.f) & 0xffffu; const float rem = v - __uint_as_float(hi << 16);
        OKP(bf16_t, WS_W16H)[i] = (bf16_t)hi; OKP(bf16_t, WS_W16L)[i] = (bf16_t)(cvt_pk_bf16(rem, 0.f) & 0xffffu); }
}
__device__ __forceinline__ void phase_proj16(const Frame& F0, int set, const float* h, const bf16_t* hb, const float* ssq, int np) {
    const Frame F = phase_frame(F0);
    const int lane = F.lane, fr = lane & 15, fq = lane >> 4;
    const bf16_t* wh = OKP(bf16_t, WS_W16H) + (size_t)set * 16 * 1024; const bf16_t* wl = OKP(bf16_t, WS_W16L) + (size_t)set * 16 * 1024;
    const int gw = F.vcu * NWAVES + F.wave, NGW = F.G * NWAVES;
    for (int tile = gw; tile < T / 16; tile += NGW) { const int t0 = tile * 16; f32x4 acc = {0.f, 0.f, 0.f, 0.f};
        const float* hp = h + (size_t)(t0 + fr) * DM + fq * 8;
        if (hb) { const bf16_t* ap = hb + (size_t)(t0 + fr) * DM + fq * 8;
#pragma unroll 1
            for (int kb = 0; kb < 4; ++kb) { bf16x8 bh[8], bl[8], ah[8];
#pragma unroll
                for (int k8 = 0; k8 < 8; ++k8) { const size_t wo = (size_t)fr * 1024 + (kb * 8 + k8) * 32 + fq * 8; bh[k8] = *(const bf16x8*)(wh + wo); bl[k8] = *(const bf16x8*)(wl + wo); ah[k8] = *(const bf16x8*)(ap + (kb * 8 + k8) * 32); }
                SCHED_FENCE();
#pragma unroll
                for (int k8 = 0; k8 < 8; ++k8) { acc = mfma16(bh[k8], ah[k8], acc); acc = mfma16(bl[k8], ah[k8], acc); }
                SCHED_FENCE(); } }
        else {
#pragma unroll 1
            for (int kb = 0; kb < 4; ++kb) { bf16x8 bh[8], bl[8]; f32x4 xa[8], xb[8];
#pragma unroll
                for (int k8 = 0; k8 < 8; ++k8) { const size_t wo = (size_t)fr * 1024 + (kb * 8 + k8) * 32 + fq * 8; bh[k8] = *(const bf16x8*)(wh + wo); bl[k8] = *(const bf16x8*)(wl + wo); xa[k8] = *(const f32x4*)(hp + (kb * 8 + k8) * 32); xb[k8] = *(const f32x4*)(hp + (kb * 8 + k8) * 32 + 4); }
                SCHED_FENCE();
#pragma unroll
                for (int k8 = 0; k8 < 8; ++k8) { const f32x4 x0 = xa[k8], x1 = xb[k8];
            u32x4 hi, lo;
            hi.x = cvt_pk_bf16(x0[0], x0[1]); hi.y = cvt_pk_bf16(x0[2], x0[3]); hi.z = cvt_pk_bf16(x1[0], x1[1]); hi.w = cvt_pk_bf16(x1[2], x1[3]);
            lo.x = cvt_pk_bf16(x0[0] - bflo(hi.x), x0[1] - bfhi(hi.x)); lo.y = cvt_pk_bf16(x0[2] - bflo(hi.y), x0[3] - bfhi(hi.y));
            lo.z = cvt_pk_bf16(x1[0] - bflo(hi.z), x1[1] - bfhi(hi.z)); lo.w = cvt_pk_bf16(x1[2] - bflo(hi.w), x1[3] - bfhi(hi.w));
            const bf16x8 ah = __builtin_bit_cast(bf16x8, hi), al = __builtin_bit_cast(bf16x8, lo);
            acc = mfma16(bh[k8], ah, acc); acc = mfma16(bl[k8], ah, acc); acc = mfma16(bh[k8], al, acc); }
                SCHED_FENCE(); } }
        acc *= rstd_np(ssq, np, t0 + fr);
        *(f32x4*)(OKP(float, WS_RAW16) + (size_t)(t0 + fr) * 16 + 4 * fq) = acc; }
}

__device__ __forceinline__ void phase_router(const Frame& F0, int l, const bf16_t* hb, const float* ssq, int np) {
    const Frame F = phase_frame(F0);
    using namespace sm;
    const int lane = F.lane, wave = F.wave, fr = lane & 15, fq = lane >> 4;
    LAS float* lg = (LAS float*)(F.lds + wave * 16384 + 8704);
    const bf16_t* wh = OKP(bf16_t, WS_WRH) + (size_t)l * 48 * 1024; const bf16_t* wl = OKP(bf16_t, WS_WRL) + (size_t)l * 48 * 1024;
    const float* bg = F.in[I_MOE_BG] + l * 4; const float* be = F.in[I_MOE_BE] + l * 32;
    unsigned* cnt = F.ctl + CW_MOE + l * 64;
    const int gw = F.vcu * NWAVES + wave, NGW = F.G * NWAVES;
    for (int tile = gw; tile < T / 16; tile += NGW) {
        const int t0 = tile * 16;
        f32x4 acc[3] = {{0.f, 0.f, 0.f, 0.f}, {0.f, 0.f, 0.f, 0.f}, {0.f, 0.f, 0.f, 0.f}};
        const bf16_t* hp = hb + (size_t)(t0 + fr) * DM + fq * 8;
#pragma unroll 1
        for (int kb = 0; kb < 8; ++kb) { bf16x8 ah[4], bh[4][3], bl[4][3];
#pragma unroll
            for (int k4 = 0; k4 < 4; ++k4) { const int ks = kb * 4 + k4; ah[k4] = *(const bf16x8*)(hp + ks * 32);
#pragma unroll
                for (int nt = 0; nt < 3; ++nt) { const size_t wo = (size_t)(nt * 16 + fr) * 1024 + ks * 32 + fq * 8; bh[k4][nt] = *(const bf16x8*)(wh + wo); bl[k4][nt] = *(const bf16x8*)(wl + wo); } }
            SCHED_FENCE();
#pragma unroll
            for (int k4 = 0; k4 < 4; ++k4)
#pragma unroll
                for (int nt = 0; nt < 3; ++nt) { acc[nt] = mfma16(bh[k4][nt], ah[k4], acc[nt]); acc[nt] = mfma16(bl[k4][nt], ah[k4], acc[nt]); }
            SCHED_FENCE(); }
#pragma unroll
        for (int nt = 0; nt < 3; ++nt) *(LAS f32x4*)(lg + fr * 48 + nt * 16 + 4 * fq) = acc[nt];
        WAVE_SYNC();
        if (lane < 16) { const int t = t0 + lane; const LAS float* p = lg + lane * 48; const float rs = rstd_np(ssq, np, t);
            const float g0 = p[0] * rs + bg[0], g1 = p[1] * rs + bg[1], g2 = p[2] * rs + bg[2], g3 = p[3] * rs + bg[3];
            int gsel = 0; float gm = g0; if (g1 > gm) { gm = g1; gsel = 1; } if (g2 > gm) { gm = g2; gsel = 2; } if (g3 > gm) { gm = g3; gsel = 3; }
            const float gwt = 1.f / (expf(g0 - gm) + expf(g1 - gm) + expf(g2 - gm) + expf(g3 - gm));
            const LAS float* pe = p + 4 + gsel * 8; const float* bb = be + gsel * 8;
            float e[8];
#pragma unroll
            for (int j = 0; j < 8; ++j) e[j] = pe[j] * rs + bb[j];
            int i1 = 0; float m1 = e[0];
#pragma unroll
            for (int j = 1; j < 8; ++j) if (e[j] > m1) { m1 = e[j]; i1 = j; }
            int i2 = -1; float m2 = -3.0e38f;
#pragma unroll
            for (int j = 0; j < 8; ++j) if (j != i1 && e[j] > m2) { m2 = e[j]; i2 = j; }
            const float r = expf(m2 - m1); const float w1 = gwt / (1.f + r), w2 = gwt * r / (1.f + r);
            const int e1 = gsel * 8 + i1, e2 = gsel * 8 + i2;
            OKP(int, WS_EID)[t * 2] = e1; OKP(int, WS_EID)[t * 2 + 1] = e2; OKP(float, WS_GATEW)[t * 2] = w1; OKP(float, WS_GATEW)[t * 2 + 1] = w2;
            OKP(int, WS_POS)[t * 2] = (int)atomicAdd(cnt + e1, 1u); OKP(int, WS_POS)[t * 2 + 1] = (int)atomicAdd(cnt + e2, 1u); }
        WAVE_SYNC();
    }
}

__device__ __forceinline__ void phase_scatter(const Frame& F0, int l, const bf16_t* hb, const float* ssq, int np) {
    const Frame F = phase_frame(F0);
    const unsigned* cnt = F.ctl + CW_MOE + l * 64; const int lane = F.lane;
    const int gw = F.vcu * NWAVES + F.wave, NGW = F.G * NWAVES;
    int base = 0;
    { int tiles = lane < 32 ? (((int)cnt[lane & 31] + 255) >> 8) : 0; int incl = tiles;
#pragma unroll
      for (int o = 1; o < 32; o <<= 1) { const int n = shfl_src(incl, lane >= o ? lane - o : lane); if ((lane & 31) >= o) incl += n; }
      base = (incl - tiles) * 256;
      const int cnt_e = lane < 32 ? (int)cnt[lane & 31] : 0; const int light = (tiles > 0 && cnt_e - 256 * (tiles - 1) <= 128) ? 1 : 0, full = tiles - light;
      int fincl = full, lincl = light;
#pragma unroll
      for (int o = 1; o < 32; o <<= 1) { const int sl = lane >= o ? lane - o : lane; const int n1 = shfl_src(fincl, sl), n2 = shfl_src(lincl, sl); if ((lane & 31) >= o) { fincl += n1; lincl += n2; } }
      const int ntiles = shfl_src(incl, 31), nfull = shfl_src(fincl, 31);
      if (blockIdx.x == 0 && F.wave == 0) { if (lane < 32) { for (int i = 0; i < tiles; ++i) OKP(int, WS_TILEEXP)[(base >> 8) + i] = lane;
              for (int i = 0; i < full; ++i) OKP(int, WS_TILEEXP)[512 + (fincl - full) + i] = (base >> 8) + i;
              if (light) OKP(int, WS_TILEEXP)[512 + nfull + (lincl - 1)] = ((base >> 8) + tiles - 1) | (1 << 16); }
          if (lane == 0) OKP(int, WS_TILEEXP)[1023] = ntiles; } }
    for (int a0 = gw * 4; a0 < T * 2; a0 += NGW * 4) {
        int slot[4]; u32x4 r0[4], r1[4];
#pragma unroll
        for (int k = 0; k < 4; ++k) { const int a = a0 + k; const int e = OKP(int, WS_EID)[a]; slot[k] = shfl_src(base, e) + OKP(int, WS_POS)[a]; }
#pragma unroll
        for (int k = 0; k < 4; ++k) { const u32x4* src = (const u32x4*)(hb + (size_t)((a0 + k) >> 1) * DM) + lane; r0[k] = src[0]; r1[k] = src[64]; }
#pragma unroll
        for (int k = 0; k < 4; ++k) { const int a = a0 + k, t = a >> 1; u32x4* dst = (u32x4*)(OKP(bf16_t, WSL_XS) + (size_t)slot[k] * DM) + lane; dst[0] = r0[k]; dst[64] = r1[k];
            if (lane == 0) { OKP(int, WS_TOKSLOT)[a] = slot[k]; OKP(float, WS_SLOTGATE)[slot[k]] = OKP(float, WS_GATEW)[a]; OKP(float, WS_SLOTRSTD)[slot[k]] = rstd_np(ssq, np, t); } } }
}

__device__ __forceinline__ void phase_combine(const Frame& F0, bf16_t* hb, float* ssq, bool final_layer) {
    using namespace sm;
    const Frame F = phase_frame(F0);
    const int lane = F.lane; const int gw = F.vcu * NWAVES + F.wave, NGW = F.G * NWAVES; const bf16_t* y = OKP(bf16_t, WSL_Y);
    for (int t0 = gw * 2; t0 < T; t0 += NGW * 2) {
        int sa[2], sb[2];
#pragma unroll
        for (int k = 0; k < 2; ++k) { sa[k] = OKP(int, WS_TOKSLOT)[(t0 + k) * 2]; sb[k] = OKP(int, WS_TOKSLOT)[(t0 + k) * 2 + 1]; }
        u32x2 ra[2][4], rb[2][4], rh[2][4];
#pragma unroll
        for (int k = 0; k < 2; ++k) { const u32x2* hr = (const u32x2*)(hb + (size_t)(t0 + k) * DM) + lane; const u32x2* ya = (const u32x2*)(y + (size_t)sa[k] * DM) + lane; const u32x2* yb = (const u32x2*)(y + (size_t)sb[k] * DM) + lane;
#pragma unroll
            for (int j = 0; j < 4; ++j) { ra[k][j] = ya[64 * j]; rb[k][j] = yb[64 * j]; rh[k][j] = hr[64 * j]; } }
#pragma unroll
        for (int k = 0; k < 2; ++k) { const int t = t0 + k; u32x2* hr = (u32x2*)(hb + (size_t)t * DM) + lane; f32x4 v[4]; float s = 0.f;
#pragma unroll
            for (int j = 0; j < 4; ++j) { const u32x2 a = ra[k][j], b = rb[k][j], hw = rh[k][j]; f32x4 x;
                x[0] = bflo(hw.x) + (bflo(a.x) + bflo(b.x)); x[1] = bfhi(hw.x) + (bfhi(a.x) + bfhi(b.x)); x[2] = bflo(hw.y) + (bflo(a.y) + bflo(b.y)); x[3] = bfhi(hw.y) + (bfhi(a.y) + bfhi(b.y));
                if (!final_layer) { u32x2 w; w.x = cvt_pk_bf16(x[0], x[1]); w.y = cvt_pk_bf16(x[2], x[3]); hr[64 * j] = w; x = (f32x4){bflo(w.x), bfhi(w.x), bflo(w.y), bfhi(w.y)}; }
                v[j] = x; s += (x[0] * x[0] + x[1] * x[1]) + (x[2] * x[2] + x[3] * x[3]); }
            s = wave_sum(s);
            if (!final_layer) { if (lane == 0) ssq[t] = s; }
            else { const float rs = frsq(s * (1.f / DM) + EPS); f32x4* orow = (f32x4*)(F.out + (size_t)t * DM) + lane; const f32x4* gr = (const f32x4*)F.in[I_FINAL_NORM] + lane;
#pragma unroll
                for (int j = 0; j < 4; ++j) { const f32x4 g = gr[64 * j]; f32x4 o; o[0] = v[j][0] * rs * g[0]; o[1] = v[j][1] * rs * g[1]; o[2] = v[j][2] * rs * g[2]; o[3] = v[j][3] * rs * g[3]; orow[64 * j] = o; } } } }
}

#ifndef CPU_EMU
struct MoeOrder {
    static constexpr bool LIGHT = true;
    const char* A; const char* W; const int* tile_exp; size_t a_tstep, w_estride, w_off, w_tstep; int G, c;
    __device__ bool next(int i, pg8::Unit& u) const {
        const int Lx = i * G + c; const int ntiles = tile_exp[1023]; if (Lx >= ntiles * 4) return false;
        const int info = tile_exp[512 + (Lx >> 2)], tile = info & 0xffff; u.pm = tile; u.pn = Lx & 3; u.tag = info >> 16; const int e = tile_exp[tile];
        u.a = A + (size_t)tile * a_tstep; u.b = W + (size_t)e * w_estride + w_off + (size_t)u.pn * w_tstep; return true;
    }
    __device__ __forceinline__ void a_ready(const pg8::Unit&) const {}
    __device__ __forceinline__ void done(const pg8::Unit&) const {}
};
struct EpiSwiGLU {
    static constexpr bool PERM = false, AFTER_DRAIN = false;
    bf16_t* act; const float* slot_rstd;
    __device__ __forceinline__ void operator()(const f32x4 (&acc)[2][2][4][2], const pg8::Unit& u, int wr, int wc, int fr, int fq) const {
        const int row0 = u.pm * 256 + wr * 64 + fr, col0 = u.pn * 128 + wc * 16 + 4 * fq;
        float rs8[2][4];
#pragma unroll
        for (int i = 0; i < 8; ++i) rs8[i >> 2][i & 3] = slot_rstd[row0 + (i >> 2) * 128 + (i & 3) * 16];
        SCHED_FENCE();
#pragma unroll
        for (int ai = 0; ai < 2; ++ai)
#pragma unroll
            for (int m = 0; m < 4; ++m) { const int row = row0 + ai * 128 + m * 16; const float rs = rs8[ai][m]; bf16_t* rowp = act + (size_t)row * 512 + col0;
#pragma unroll
                for (int bj = 0; bj < 2; ++bj) { const f32x4 g = acc[ai][bj][m][0] * rs, up = acc[ai][bj][m][1] * rs; f32x4 o;
#pragma unroll
                    for (int r = 0; r < 4; ++r) o[r] = g[r] * frcp(1.f + fexp(-g[r])) * up[r];
                    u32x2 w; w.x = cvt_pk_bf16(o[0], o[1]); w.y = cvt_pk_bf16(o[2], o[3]); *(u32x2*)(rowp + bj * 64) = w; } }
    }
};
struct EpiDown {
    static constexpr bool PERM = true, AFTER_DRAIN = false;
    bf16_t* y; const float* slot_gate;
    __device__ __forceinline__ void operator()(const f32x4 (&acc)[2][2][4][2], const pg8::Unit& u, int wr, int wc, int fr, int fq) const {
        const int row0 = u.pm * 256 + wr * 64 + fr, col0 = u.pn * 256 + wc * 32 + 8 * fq;
        float sg8[2][4];
#pragma unroll
        for (int i = 0; i < 8; ++i) sg8[i >> 2][i & 3] = slot_gate[row0 + (i >> 2) * 128 + (i & 3) * 16];
        SCHED_FENCE();
#pragma unroll
        for (int ai = 0; ai < 2; ++ai)
#pragma unroll
            for (int m = 0; m < 4; ++m) { const int row = row0 + ai * 128 + m * 16; const float s = sg8[ai][m]; bf16_t* rowp = y + (size_t)row * DM + col0;
#pragma unroll
                for (int bj = 0; bj < 2; ++bj) { const f32x4 v0 = acc[ai][bj][m][0] * s, v1 = acc[ai][bj][m][1] * s; u32x4 w; w.x = cvt_pk_bf16(v0[0], v0[1]); w.y = cvt_pk_bf16(v0[2], v0[3]); w.z = cvt_pk_bf16(v1[0], v1[1]); w.w = cvt_pk_bf16(v1[2], v1[3]);
                    *(u32x4*)(rowp + bj * 128) = w; } }
    }
};
__device__ __forceinline__ void phase_moe_up(const Frame& F) {
    pg8::Gemm g{nullptr, nullptr, 0, 0, 1024};
    MoeOrder S{(const char*)OKP(bf16_t, WSL_XS), (const char*)OKP(bf16_t, WSL_MOEW(F.lay)), OKP(int, WS_TILEEXP), (size_t)256 * 1024 * 2, 3 * MiB, 0, (size_t)256 * 1024 * 2, F.G, (int)blockIdx.x};
    EpiSwiGLU E{OKP(bf16_t, WSL_ACT), OKP(float, WS_SLOTRSTD)};
    pg8::gemm_phase<EpiSwiGLU, MoeOrder, true, true>(F.lds, g, S, E, F.wave);
}
__device__ __forceinline__ void phase_moe_down(const Frame& F) {
    pg8::Gemm g{nullptr, nullptr, 0, 0, 512};
    MoeOrder S{(const char*)OKP(bf16_t, WSL_ACT), (const char*)OKP(bf16_t, WSL_MOEW(F.lay)), OKP(int, WS_TILEEXP), (size_t)256 * 512 * 2, 3 * MiB, 2 * MiB, (size_t)256 * 512 * 2, F.G, (int)blockIdx.x};
    EpiDown E{OKP(bf16_t, WSL_Y), OKP(float, WS_SLOTGATE)};
    pg8::gemm_phase<EpiDown, MoeOrder, true, true>(F.lds, g, S, E, F.wave);
}
#endif
}

#ifndef DUP_MASK
#define DUP_MASK 0
#endif
namespace ok {
constexpr size_t WS_GU = 160 * MiB, WS_GW = 192 * MiB, WS_GQD = 224 * MiB, WS_GKDT = 480 * MiB, WS_GAQK = 512 * MiB;
constexpr size_t WS_GDEC = WS_GCS;
constexpr size_t WS_OBUF = WS_H;
constexpr int G_LD = 132, GB_LD = 136, LM_LD = 68, LB_LD = 72, XT_LD2 = 68;
__device__ __forceinline__ float sigmoidf_(float x) { return frcp(1.f + fexp(-x)); }

template <int PARTS  > __device__ __forceinline__ void phase_gdn_prep_t(const Frame& F0) {
    using namespace sm;
    const Frame F = phase_frame(F0);
    LAS float* q_s = (LAS float*)F.lds; LAS float* k_s = (LAS float*)(F.lds + 33792); LAS float* v_s = (LAS float*)(F.lds + 67584);
    LAS bf16_t* Kn = (LAS bf16_t*)(F.lds + 101376); LAS bf16_t* Qn = (LAS bf16_t*)(F.lds + 118784);
    LAS float* g_s = (LAS float*)(F.lds + 136192); LAS float* beta_s = g_s + 64; LAS float* gc_s = g_s + 128; LAS float* eg_s = g_s + 192; LAS float* rq_s = g_s + 256; LAS float* rk_s = g_s + 320;
    LAS float* Lm = q_s;
    LAS bf16_t* Lb16 = (LAS bf16_t*)(F.lds + 17408);
    LAS bf16_t* InvH = (LAS bf16_t*)(F.lds + 26624); LAS bf16_t* InvL = (LAS bf16_t*)(F.lds + 28672);
    const int tid = F.tid, lane = F.lane, wave = F.wave, fr = lane & 15, fq = lane >> 4;
    const bf16_t* proj = OKP(bf16_t, WS_PROJ1A); const float* cw = F.in[I_OD_CONV];
    for (int u = F.vcu; u < NB * NCH * 8; u += F.G) {
        const int hd = u & 7, bc = u >> 3, b = bc / NCH, c = bc % NCH; const size_t row0 = (size_t)b * L + c * 64; const size_t ub = (size_t)bc * 8 + hd;
        LDS_BARRIER();
        if ((PARTS & 1) && tid < 384) { const int which = tid >> 7, d = tid & 127, xc = which * 1024 + hd * 128 + d; LAS float* dst = (which == 0 ? q_s : which == 1 ? k_s : v_s) + d;
            const float w0 = cw[xc], w1 = cw[3072 + xc], w2 = cw[6144 + xc], w3 = cw[9216 + xc]; const bf16_t* p = proj + row0 * PROJ1A_LD + xc;
            const int hb_ = c > 0 ? 1 : 0; const unsigned short h0 = p[-3 * PROJ1A_LD * hb_], h1 = p[-2 * PROJ1A_LD * hb_], h2 = p[-PROJ1A_LD * hb_];
            unsigned short raw[64]; float pacc = 0.f;
#pragma unroll
            for (int t = 0; t < 64; ++t) raw[t] = p[(size_t)t * PROJ1A_LD];
            SCHED_FENCE();
            float x0 = hb_ ? bf2f(h0) : 0.f, x1 = hb_ ? bf2f(h1) : 0.f, x2 = hb_ ? bf2f(h2) : 0.f;
#pragma unroll
            for (int t = 0; t < 64; ++t) { const float x3 = bf2f(raw[t]); const float v = w0 * x0 + w1 * x1 + w2 * x2 + w3 * x3; if (PARTS & 32) dst[t * G_LD] = v; else if (PARTS & 128) { pacc += siluf(v); if ((t & 15) == 15) dst[t * G_LD] = pacc; } else dst[t * G_LD] = siluf(v); x0 = x1; x1 = x2; x2 = x3; } }
        if ((PARTS & 1) && !(PARTS & 64) && tid >= 448) { const int t = tid - 448; const float* r16 = OKP(float, WS_RAW16) + (row0 + t) * 16;
            g_s[t] = -expf(F.in[I_OD_ALOG][hd]) * softplusf(r16[hd] + F.in[I_OD_DTB][hd]); beta_s[t] = sigmoidf_(r16[8 + hd]); }
        LDS_BARRIER();
        if (!(PARTS & 1) || (PARTS & 64)) {} else if (wave == 0) { float v = g_s[lane];
#pragma unroll
            for (int o = 1; o < 64; o <<= 1) { const float n = __shfl_up(v, o); if (lane >= o) v += n; }
            gc_s[lane] = v; eg_s[lane] = fexp(v); if (lane == 63) OKP(float, WS_GDEC)[ub] = fexp(v); }
        else if (wave <= 2) { const LAS float* src = (wave == 1 ? q_s : k_s) + lane * G_LD; float s = 0.f;
#pragma unroll 8
            for (int d = 0; d < 128; d += 4) { const f32x4 x = *(const LAS f32x4*)(src + d); s += (x.x * x.x + x.y * x.y) + (x.z * x.z + x.w * x.w); }
            const float r = frsq(s + EPS); if (wave == 1) rq_s[lane] = r * 0.08838834764831845f; else rk_s[lane] = r; }
        LDS_BARRIER();
        if (PARTS & 2)
        { const float gl = gc_s[63];
          for (int i = tid; i < 64 * 64; i += NT) { const int t = i >> 6, dp = (i & 63) * 2; const float rk = rk_s[t], rq = rq_s[t], eg = eg_s[t];
              const float k0 = k_s[t * G_LD + dp] * rk, k1 = k_s[t * G_LD + dp + 1] * rk, q0 = q_s[t * G_LD + dp] * rq, q1 = q_s[t * G_LD + dp + 1] * rq;
              *(LAS unsigned*)(Kn + t * GB_LD + dp) = cvt_pk_bf16(k0, k1); *(LAS unsigned*)(Qn + t * GB_LD + dp) = cvt_pk_bf16(q0, q1);
              *(unsigned*)(OKP(bf16_t, WS_GQD) + ub * 8192 + t * 128 + dp) = cvt_pk_bf16(q0 * eg, q1 * eg); }
          { const int t = tid & 63, dg = tid >> 6; const float f = rk_s[t] * fexp(gl - gc_s[t]); bf16_t* dst = OKP(bf16_t, WS_GKDT) + ub * 8192 + t;
#pragma unroll
            for (int j = 0; j < 16; ++j) { const int d = dg * 16 + j; dst[d * 64] = (bf16_t)(cvt_pk_bf16(k_s[t * G_LD + d] * f, 0.f) & 0xffffu); } } }
        LDS_BARRIER();
        if (PARTS & 4)
#pragma unroll
        for (int i = 0; i < 4; ++i) { const int tl = wave * 4 + i, which = tl >> 4, ti = (tl >> 2) & 3, si = tl & 3;
            f32x4 acc = {0.f, 0.f, 0.f, 0.f};
            if (si <= ti) {
#pragma unroll
                for (int ks = 0; ks < 4; ++ks) { const bf16x8 a = *(const LAS bf16x8*)(Kn + (si * 16 + fr) * GB_LD + ks * 32 + fq * 8); const bf16x8 bb = *(const LAS bf16x8*)((which ? Qn : Kn) + (ti * 16 + fr) * GB_LD + ks * 32 + fq * 8); acc = mfma16(a, bb, acc); }
                const int t = ti * 16 + fr; const float gt = gc_s[t], bt = beta_s[t];
#pragma unroll
                for (int r = 0; r < 4; ++r) { const int s = si * 16 + 4 * fq + r; const float dec = fexp(gt - gc_s[s]); acc[r] = which ? (s <= t ? acc[r] * dec : 0.f) : (s < t ? acc[r] * dec * bt : 0.f); } }
            const int t = ti * 16 + fr, s0 = si * 16 + 4 * fq;
            if (which) { u32x2 w; w.x = cvt_pk_bf16(acc[0], acc[1]); w.y = cvt_pk_bf16(acc[2], acc[3]); *(u32x2*)(OKP(bf16_t, WS_GAQK) + ub * 4096 + t * 64 + s0) = w; }
            else { Lm[(s0 + 0) * LM_LD + t] = acc[0]; Lm[(s0 + 1) * LM_LD + t] = acc[1]; Lm[(s0 + 2) * LM_LD + t] = acc[2]; Lm[(s0 + 3) * LM_LD + t] = acc[3];
                u32x2 w; w.x = cvt_pk_bf16(-acc[0], -acc[1]); w.y = cvt_pk_bf16(-acc[2], -acc[3]); *(LAS u32x2*)(Lb16 + t * LB_LD + s0) = w; } }
        LDS_BARRIER();
        if (PARTS & 8) {
            if (wave == 0) { const int ib = lane >> 4, c = lane & 15; float y[16];
#pragma unroll
                for (int tt = 0; tt < 16; ++tt) y[tt] = tt == c ? 1.f : 0.f;
#pragma unroll
                for (int ss = 0; ss < 16; ++ss) { const float xv = y[ss]; const LAS f32x4* lp = (const LAS f32x4*)(Lm + (ib * 16 + ss) * LM_LD + ib * 16);
#pragma unroll
                    for (int q4 = ss / 4; q4 < 4; ++q4) { const f32x4 l4 = lp[q4];
#pragma unroll
                        for (int r = 0; r < 4; ++r) if (q4 * 4 + r > ss) y[q4 * 4 + r] -= l4[r] * xv; } }
#pragma unroll
                for (int tt = 0; tt < 16; ++tt) { const unsigned hi = cvt_pk_bf16(y[tt], 0.f) & 0xffffu; InvH[(ib * 16 + tt) * 16 + c] = (bf16_t)hi; InvL[(ib * 16 + tt) * 16 + c] = (bf16_t)(cvt_pk_bf16(y[tt] - bflo(hi), 0.f) & 0xffffu); } }
            LDS_BARRIER();
            const bool isw = wave >= 4; const LAS float* Rb = isw ? k_s : v_s;
#pragma unroll
            for (int ct2 = 0; ct2 < 2; ++ct2) { const int cl = ((wave & 3) * 2 + ct2) * 16 + fr;
                u32x2 xp[4];
#pragma unroll
                for (int ib = 0; ib < 4; ++ib) { const int t4 = ib * 16 + 4 * fq;
                    f32x4 sc = *(const LAS f32x4*)(beta_s + t4); if (isw) sc = sc * *(const LAS f32x4*)(rk_s + t4) * *(const LAS f32x4*)(eg_s + t4);
                    f32x4 acc;
#pragma unroll
                    for (int r = 0; r < 4; ++r) acc[r] = Rb[(t4 + r) * G_LD + cl] * sc[r];
                    const LAS bf16_t* lrow = Lb16 + (ib * 16 + fr) * LB_LD + 4 * fq;
                    if (ib >= 1) { const u32x2 a0 = *(const LAS u32x2*)lrow; u32x2 a1 = {0u, 0u}, b1 = {0u, 0u}; if (ib >= 2) { a1 = *(const LAS u32x2*)(lrow + 16); b1 = xp[1]; }
                        u32x4 A; A.x = a0.x; A.y = a0.y; A.z = a1.x; A.w = a1.y; u32x4 B; B.x = xp[0].x; B.y = xp[0].y; B.z = b1.x; B.w = b1.y;
                        acc = mfma16(__builtin_bit_cast(bf16x8, A), __builtin_bit_cast(bf16x8, B), acc); }
                    if (ib == 3) { const u32x2 a0 = *(const LAS u32x2*)(lrow + 32); u32x4 A; A.x = a0.x; A.y = a0.y; A.z = 0u; A.w = 0u; u32x4 B; B.x = xp[2].x; B.y = xp[2].y; B.z = 0u; B.w = 0u;
                        acc = mfma16(__builtin_bit_cast(bf16x8, A), __builtin_bit_cast(bf16x8, B), acc); }
                    u32x4 rh, rl; rh.x = cvt_pk_bf16(acc[0], acc[1]); rh.y = cvt_pk_bf16(acc[2], acc[3]); rh.z = 0u; rh.w = 0u;
                    rl.x = cvt_pk_bf16(acc[0] - bflo(rh.x), acc[1] - bfhi(rh.x)); rl.y = cvt_pk_bf16(acc[2] - bflo(rh.y), acc[3] - bfhi(rh.y)); rl.z = 0u; rl.w = 0u;
                    const u32x2 ih2 = *(const LAS u32x2*)(InvH + (ib * 16 + fr) * 16 + 4 * fq), il2 = *(const LAS u32x2*)(InvL + (ib * 16 + fr) * 16 + 4 * fq);
                    u32x4 ih, il; ih.x = ih2.x; ih.y = ih2.y; ih.z = 0u; ih.w = 0u; il.x = il2.x; il.y = il2.y; il.z = 0u; il.w = 0u;
                    f32x4 x = {0.f, 0.f, 0.f, 0.f};
                    x = mfma16(__builtin_bit_cast(bf16x8, ih), __builtin_bit_cast(bf16x8, rh), x); x = mfma16(__builtin_bit_cast(bf16x8, il), __builtin_bit_cast(bf16x8, rh), x); x = mfma16(__builtin_bit_cast(bf16x8, ih), __builtin_bit_cast(bf16x8, rl), x);
                    u32x2 xb; xb.x = cvt_pk_bf16(x[0], x[1]); xb.y = cvt_pk_bf16(x[2], x[3]); xp[ib] = xb;
                    if (!isw) *(u32x2*)(OKP(bf16_t, WS_GU) + ub * 8192 + (size_t)(ib * 4 + fq) * 512 + cl * 4) = xb;
                    else { bf16_t* dst = OKP(bf16_t, WS_GW) + ub * 8192 + (size_t)t4 * 128 + cl;
                        dst[0] = (bf16_t)(xb.x & 0xffffu); dst[128] = (bf16_t)(xb.x >> 16); dst[256] = (bf16_t)(xb.y & 0xffffu); dst[384] = (bf16_t)(xb.y >> 16); }
                }
            }
        }
    }
}
}

namespace ok {
constexpr int ST_LD = 136, VT_LD = 72;
__device__ __forceinline__ void phase_gdn_prep(const Frame& F0) { phase_gdn_prep_t<15>(F0); }
constexpr int GJT = 4, GDV = GJT * 16, GN_UNITS = NB * 8 * (128 / GDV);
static_assert(GJT == 4, "the Z slot below is sized for four column tiles");
struct GdnEarly { bf16x8 X[4]; u32x2 Z[4]; };
struct GdnLate { bf16x8 Kf[2]; float dec; };
__device__ __forceinline__ void gdn_load_early(GdnEarly& g, const Frame& F, size_t xoff, size_t ub, int ti, int sl, int fr, int fq, int roleB) {
    const bf16_t* Xp = (const bf16_t*)(F.ws + xoff) + ub * 8192 + (ti * 16 + fr) * 128 + fq * 8;
#pragma unroll
    for (int ks = 0; ks < 4; ++ks) g.X[ks] = *(const bf16x8*)(Xp + ks * 32);
    const bf16_t* zb = roleB ? OKP(bf16_t, WS_GAQK) + ub * 4096 + (ti * 16 + fr) * 64 + fq * 8 : OKP(bf16_t, WS_GU) + ub * 8192 + ((size_t)(ti * 4 + fq) * 128 + sl * GDV + fr) * 4;
#pragma unroll
    for (int i = 0; i < 4; ++i) g.Z[i] = *(const u32x2*)(zb + (roleB ? (i >> 1) * 32 + (i & 1) * 4 : i * 64));
}
__device__ __forceinline__ void gdn_load_late(GdnLate& g, const Frame& F, size_t ub, int ti, int wave, int fr, int fq, int vzero) {
    const bf16_t* Kp = OKP(bf16_t, WS_GKDT) + ub * 8192 + (wave * 16 + fr) * 64 + fq * 8;
#pragma unroll
    for (int k2 = 0; k2 < 2; ++k2) g.Kf[k2] = *(const bf16x8*)(Kp + k2 * 32);
    g.dec = OKP(float, WS_GDEC)[ub + vzero];
}
constexpr int OS_LD = GDV + 8;
__device__ __forceinline__ void gdn_flush_o(const Frame& F, const LAS bf16_t* Os, int b, int cprev, int hd, int sl) {
    constexpr int PCS = GDV / 8;
    if (F.tid < 64 * PCS) { const int row = F.tid / PCS, pc = F.tid % PCS; *(u32x4*)(OKP(bf16_t, WS_OBUF) + ((size_t)b * L + cprev * 64 + row) * 1024 + hd * 128 + sl * GDV + pc * 8) = *(const LAS u32x4*)(Os + row * OS_LD + pc * 8); }
}
__device__ __forceinline__ void gdn_step(const Frame& F, const GdnEarly& g, const GdnLate& h, f32x4 (&Sacc)[GJT], LAS bf16_t* ST0, LAS bf16_t* VnT, int par, int roleB, int b, int c, int hd, int sl, int ti, int wave, int fr, int fq) {
    LAS bf16_t* ST = ST0 + par * (GDV * ST_LD); LAS bf16_t* STn = ST0 + (par ^ 1) * (GDV * ST_LD);
    LAS bf16_t* Os = VnT + GDV * VT_LD;
    LDS_BARRIER();
    if (c > 0) gdn_flush_o(F, Os, b, c - 1, hd, sl);
    f32x4 a[GJT];
#pragma unroll
    for (int ji = 0; ji < GJT; ++ji) a[ji] = (f32x4){0.f, 0.f, 0.f, 0.f};
#pragma unroll
    for (int ks = 0; ks < 4; ++ks)
#pragma unroll
        for (int ji = 0; ji < GJT; ++ji) { const bf16x8 sf = *(const LAS bf16x8*)(ST + (ji * 16 + fr) * ST_LD + ks * 32 + fq * 8); a[ji] = mfma16(g.X[ks], sf, a[ji]); }
    if (!roleB) {
#pragma unroll
        for (int ji = 0; ji < GJT; ++ji) { const u32x2 uv = g.Z[ji]; u32x2 w; w.x = cvt_pk_bf16(bflo(uv.x) - a[ji][0], bfhi(uv.x) - a[ji][1]); w.y = cvt_pk_bf16(bflo(uv.y) - a[ji][2], bfhi(uv.y) - a[ji][3]);
            *(LAS u32x2*)(VnT + (ji * 16 + fr) * VT_LD + ti * 16 + 4 * fq) = w; } }
    LDS_BARRIER();
#pragma unroll
    for (int ji = 0; ji < GJT; ++ji) { bf16x8 vf[2];
#pragma unroll
        for (int k2 = 0; k2 < 2; ++k2) vf[k2] = *(const LAS bf16x8*)(VnT + (ji * 16 + fr) * VT_LD + k2 * 32 + fq * 8);
        if (roleB) {
#pragma unroll
            for (int k2 = 0; k2 < 2; ++k2) { u32x4 af; af.x = g.Z[2 * k2].x; af.y = g.Z[2 * k2].y; af.z = g.Z[2 * k2 + 1].x; af.w = g.Z[2 * k2 + 1].y; a[ji] = mfma16(__builtin_bit_cast(bf16x8, af), vf[k2], a[ji]); }
            LAS bf16_t* op = Os + (ti * 16 + 4 * fq) * OS_LD + ji * 16 + fr;
#pragma unroll
            for (int r = 0; r < 4; ++r) op[r * OS_LD] = (bf16_t)(cvt_pk_bf16(a[ji][r], 0.f) & 0xffffu); }
        Sacc[ji] *= h.dec;
#pragma unroll
        for (int k2 = 0; k2 < 2; ++k2) Sacc[ji] = mfma16(h.Kf[k2], vf[k2], Sacc[ji]);
        u32x2 w; w.x = cvt_pk_bf16(Sacc[ji][0], Sacc[ji][1]); w.y = cvt_pk_bf16(Sacc[ji][2], Sacc[ji][3]); *(LAS u32x2*)(STn + (ji * 16 + fr) * ST_LD + wave * 16 + 4 * fq) = w; }
}
template <int MODE  > __device__ __forceinline__ void gdn_scan_unit_t(const Frame& F, int unit) {
    LAS bf16_t* ST = (LAS bf16_t*)F.lds; LAS bf16_t* VnT = (LAS bf16_t*)(F.lds + 2 * GDV * ST_LD * 2);
    const int tid = F.tid, lane = F.lane, wave = F.wave, fr = lane & 15, fq = lane >> 4;
    constexpr int NSL = 128 / GDV;
    const int sl = unit % NSL, hd = (unit / NSL) & 7, b = unit / (NSL * 8), ti = wave & 3, roleB = wave >> 2;
    for (int i = tid; i < GDV * ST_LD / 2; i += NT) ((LAS unsigned*)ST)[i] = 0u;
    f32x4 Sacc[GJT];
#pragma unroll
    for (int ji = 0; ji < GJT; ++ji) Sacc[ji] = (f32x4){0.f, 0.f, 0.f, 0.f};
    const size_t ub0 = ((size_t)b * NCH) * 8 + hd; const size_t xoff = roleB ? WS_GQD : WS_GW;
    int vzero = 0;
#ifndef CPU_EMU
    asm volatile("" : "+v"(vzero));
#endif
#define GDN_LE(set, cc) if (MODE == 0) gdn_load_early(set, F, xoff, ub0 + (size_t)((cc) < NCH ? (cc) : NCH - 1) * 8, ti, sl, fr, fq, roleB)
#define GDN_LL(set, cc) if (MODE == 0) gdn_load_late(set, F, ub0 + (size_t)((cc) < NCH ? (cc) : NCH - 1) * 8, ti, wave, fr, fq, vzero)
#define GDN_ST(es, ls, cc, par) gdn_step(F, es, ls, Sacc, ST, VnT, par, roleB, b, (MODE == 0 ? (cc) : 0), hd, sl, ti, wave, fr, fq)
    GdnEarly e0, e1, e2; GdnLate l0, l1;
    GDN_LE(e0, 0); GDN_LE(e1, 1); GDN_LL(l0, 0);
    if (MODE == 1) { gdn_load_early(e0, F, xoff, ub0, ti, sl, fr, fq, roleB); gdn_load_early(e1, F, xoff, ub0, ti, sl, fr, fq, roleB); gdn_load_early(e2, F, xoff, ub0, ti, sl, fr, fq, roleB); gdn_load_late(l0, F, ub0, ti, wave, fr, fq, vzero); gdn_load_late(l1, F, ub0, ti, wave, fr, fq, vzero); }
    int c = 0;
    for (; c + 6 <= NCH; c += 6) {
        GDN_LE(e2, c + 2); GDN_LL(l1, c + 1); GDN_ST(e0, l0, c + 0, 0);
        GDN_LE(e0, c + 3); GDN_LL(l0, c + 2); GDN_ST(e1, l1, c + 1, 1);
        GDN_LE(e1, c + 4); GDN_LL(l1, c + 3); GDN_ST(e2, l0, c + 2, 0);
        GDN_LE(e2, c + 5); GDN_LL(l0, c + 4); GDN_ST(e0, l1, c + 3, 1);
        GDN_LE(e0, c + 6); GDN_LL(l1, c + 5); GDN_ST(e1, l0, c + 4, 0);
        GDN_LE(e1, c + 7); GDN_LL(l0, c + 6); GDN_ST(e2, l1, c + 5, 1);
    }
    if (c + 0 < NCH) { GDN_LE(e2, c + 2); GDN_LL(l1, c + 1); GDN_ST(e0, l0, c + 0, 0); }
    if (c + 1 < NCH) { GDN_LE(e0, c + 3); GDN_LL(l0, c + 2); GDN_ST(e1, l1, c + 1, 1); }
    if (c + 2 < NCH) { GDN_LE(e1, c + 4); GDN_LL(l1, c + 3); GDN_ST(e2, l0, c + 2, 0); }
    if (c + 3 < NCH) { GDN_LE(e2, c + 5); GDN_LL(l0, c + 4); GDN_ST(e0, l1, c + 3, 1); }
    if (c + 4 < NCH) { GDN_LE(e0, c + 6); GDN_LL(l1, c + 5); GDN_ST(e1, l0, c + 4, 0); }
#undef GDN_LE
#undef GDN_LL
#undef GDN_ST
    LDS_BARRIER();
    if (MODE == 0) gdn_flush_o(F, VnT + GDV * VT_LD, b, NCH - 1, hd, sl);
}
__device__ __forceinline__ void gdn_scan_unit(const Frame& F, int unit) { gdn_scan_unit_t<0>(F, unit); }
__device__ __forceinline__ void phase_gdn_final(const Frame& F0) {
    using namespace sm;
    const Frame F = phase_frame(F0);
    const int lane = F.lane; const int gw = F.vcu * NWAVES + F.wave, NGW = F.G * NWAVES;
    const f32x4* nw4 = (const f32x4*)(F.in[I_OD_NORM] + (lane & 7) * 16);
    u32x4 na[2], nz[2]; { const int t = gw < T ? gw : 0; const u32x4* op = (const u32x4*)(OKP(bf16_t, WS_OBUF) + (size_t)t * 1024 + lane * 16); const u32x4* zp = (const u32x4*)(OKP(bf16_t, WS_PROJ1B) + (size_t)t * PROJ1B_LD + lane * 16); na[0] = op[0]; na[1] = op[1]; nz[0] = zp[0]; nz[1] = zp[1]; }
    for (int t = gw; t < T; t += NGW) { const u32x4 ca[2] = {na[0], na[1]}, cz[2] = {nz[0], nz[1]};
        { const int tn = t + NGW < T ? t + NGW : t; const u32x4* op = (const u32x4*)(OKP(bf16_t, WS_OBUF) + (size_t)tn * 1024 + lane * 16); const u32x4* zp = (const u32x4*)(OKP(bf16_t, WS_PROJ1B) + (size_t)tn * PROJ1B_LD + lane * 16); na[0] = op[0]; na[1] = op[1]; nz[0] = zp[0]; nz[1] = zp[1]; }
        float o[16], z[16];
#pragma unroll
        for (int h2 = 0; h2 < 2; ++h2) { const u32x4 a = ca[h2], zz = cz[h2];
            o[h2 * 8 + 0] = bflo(a.x); o[h2 * 8 + 1] = bfhi(a.x); o[h2 * 8 + 2] = bflo(a.y); o[h2 * 8 + 3] = bfhi(a.y); o[h2 * 8 + 4] = bflo(a.z); o[h2 * 8 + 5] = bfhi(a.z); o[h2 * 8 + 6] = bflo(a.w); o[h2 * 8 + 7] = bfhi(a.w);
            z[h2 * 8 + 0] = bflo(zz.x); z[h2 * 8 + 1] = bfhi(zz.x); z[h2 * 8 + 2] = bflo(zz.y); z[h2 * 8 + 3] = bfhi(zz.y); z[h2 * 8 + 4] = bflo(zz.z); z[h2 * 8 + 5] = bfhi(zz.z); z[h2 * 8 + 6] = bflo(zz.w); z[h2 * 8 + 7] = bfhi(zz.w); }
        float s = 0.f;
#pragma unroll
        for (int i = 0; i < 16; ++i) s += o[i] * o[i];
        s += __shfl_xor(s, 1); s += __shfl_xor(s, 2); s += __shfl_xor(s, 4);
        const float rs = frsq(s * (1.f / 128.f) + EPS);
        u32x4 w[2];
#pragma unroll
        for (int h2 = 0; h2 < 2; ++h2) { const f32x4 n0 = nw4[h2 * 2], n1 = nw4[h2 * 2 + 1]; float y[8];
#pragma unroll
            for (int i = 0; i < 8; ++i) y[i] = o[h2 * 8 + i] * rs * (i < 4 ? n0[i] : n1[i - 4]) * siluf(z[h2 * 8 + i]);
            w[h2].x = cvt_pk_bf16(y[0], y[1]); w[h2].y = cvt_pk_bf16(y[2], y[3]); w[h2].z = cvt_pk_bf16(y[4], y[5]); w[h2].w = cvt_pk_bf16(y[6], y[7]); }
        u32x4* cp = (u32x4*)(OKP(bf16_t, WS_CAT1) + (size_t)t * 1536 + lane * 16); cp[0] = w[0]; cp[1] = w[1]; }
}
}

#ifndef DUP_MASK
#define DUP_MASK 0
#endif
namespace ok {
constexpr int SB_LD = 72;
#ifdef CPU_EMU
#define WAVE_ALL(p) (wave_sum((p) ? 1.f : 0.f) == 64.f)
#else
#define WAVE_ALL(p) (__all(p))
#endif
__device__ __forceinline__ void sb_unit(const Frame& F, int unit) {
    LAS bf16_t* Kt = (LAS bf16_t*)F.lds; LAS bf16_t* VT = (LAS bf16_t*)(F.lds + 64 * SB_LD * 2); volatile LAS int* votes = (volatile LAS int*)(F.lds + 2 * 64 * SB_LD * 2);
    const int tid = F.tid, lane = F.lane, wave = F.wave, fr = lane & 15, fq = lane >> 4;
    const int nqb = L / 128, qb = unit % nqb, hd = (unit / nqb) & 7, b = unit / (nqb * 8), q0 = qb * 128;
    const bf16_t* proj = OKP(bf16_t, WS_PROJ1B) + (size_t)b * L * PROJ1B_LD;
    const int qrow = q0 + wave * 16 + fr;
    bf16x8 qf[2];
#pragma unroll
    for (int ks = 0; ks < 2; ++ks) qf[ks] = *(const bf16x8*)(proj + (size_t)qrow * PROJ1B_LD + 1024 + hd * 64 + ks * 32 + fq * 8);
    f32x4 o[4] = {{0.f, 0.f, 0.f, 0.f}, {0.f, 0.f, 0.f, 0.f}, {0.f, 0.f, 0.f, 0.f}, {0.f, 0.f, 0.f, 0.f}};
    float C = 1.f; bool wdone = false;
    const int key_l = tid >> 3, c8 = tid & 7;
    int kt = 2 * qb + 1;
    u32x4 kreg = *(const u32x4*)(proj + (size_t)(kt * 64 + key_l) * PROJ1B_LD + 1536 + hd * 64 + c8 * 8), vreg = *(const u32x4*)(proj + (size_t)(kt * 64 + key_l) * PROJ1B_LD + 2048 + hd * 64 + c8 * 8);
    for (; kt >= 0; --kt) {
        LDS_BARRIER();
        *(LAS u32x4*)(Kt + key_l * SB_LD + c8 * 8) = kreg;
        { LAS bf16_t* vp = VT + (c8 * 8) * SB_LD + key_l; vp[0] = (bf16_t)(vreg.x & 0xffffu); vp[SB_LD] = (bf16_t)(vreg.x >> 16); vp[2 * SB_LD] = (bf16_t)(vreg.y & 0xffffu); vp[3 * SB_LD] = (bf16_t)(vreg.y >> 16);
          vp[4 * SB_LD] = (bf16_t)(vreg.z & 0xffffu); vp[5 * SB_LD] = (bf16_t)(vreg.z >> 16); vp[6 * SB_LD] = (bf16_t)(vreg.w & 0xffffu); vp[7 * SB_LD] = (bf16_t)(vreg.w >> 16); }
        if (lane == 0) votes[wave] = wdone ? 1 : 0;
        LDS_BARRIER();
        { int all = 1;
#pragma unroll
          for (int w = 0; w < 8; ++w) all &= votes[w];
          if (all) break; }
        if (kt > 0) { kreg = *(const u32x4*)(proj + (size_t)((kt - 1) * 64 + key_l) * PROJ1B_LD + 1536 + hd * 64 + c8 * 8); vreg = *(const u32x4*)(proj + (size_t)((kt - 1) * 64 + key_l) * PROJ1B_LD + 2048 + hd * 64 + c8 * 8); }
        const int key0 = kt * 64;
#ifdef SB_COUNT_ITERS
        ++g_iters;
#endif
        if (!wdone && key0 < q0 + wave * 16 + 16) {
            f32x4 x[4];
#pragma unroll
            for (int k16 = 0; k16 < 4; ++k16) { x[k16] = (f32x4){0.f, 0.f, 0.f, 0.f};
#pragma unroll
                for (int ks = 0; ks < 2; ++ks) { const bf16x8 kf = *(const LAS bf16x8*)(Kt + (k16 * 16 + fr) * SB_LD + ks * 32 + fq * 8); x[k16] = mfma16(kf, qf[ks], x[k16]); } }
            const bool need_mask = key0 + 63 >= q0 + wave * 16;
            float Rr[4], Tt[4], Ee[4];
#pragma unroll
            for (int k16 = 0; k16 < 4; ++k16) {
#pragma unroll
                for (int r = 0; r < 4; ++r) { const float e = fexp2(fminf(x[k16][r], 80.f)); float rr = frcp(1.f + e), bet = e * rr;
                    if (need_mask && key0 + k16 * 16 + 4 * fq + r >= qrow) { rr = 1.f; bet = 0.f; }
                    x[k16][r] = bet; Rr[k16] = (r == 0) ? rr : Rr[k16];
                    if (r == 0) Tt[k16] = rr; else if (r == 1) Ee[k16] = rr; else if (r == 2) Rr[k16] = rr; else {
                        const float r0 = Tt[k16], r1 = Ee[k16], r2 = Rr[k16], r3 = rr; const float s2 = r3, s1 = r3 * r2, s0 = s1 * r1;
                        x[k16][0] *= s0; x[k16][1] *= s1; x[k16][2] *= s2;
                        Rr[k16] = s0 * r0; } } }
#pragma unroll
            for (int k16 = 0; k16 < 4; ++k16) { const float R = Rr[k16]; const float d1 = __shfl_down(R, 16), d2 = __shfl_down(R, 32), d3 = __shfl_down(R, 48);
                Ee[k16] = (fq < 3 ? d1 : 1.f) * (fq < 2 ? d2 : 1.f) * (fq < 1 ? d3 : 1.f); float t = R; t *= __shfl_xor(t, 16); t *= __shfl_xor(t, 32); Tt[k16] = t; }
            const float TT2 = Tt[3], TT1 = Tt[3] * Tt[2], TT0 = TT1 * Tt[1];
            const float f0 = Ee[0] * TT0 * C, f1 = Ee[1] * TT1 * C, f2 = Ee[2] * TT2 * C, f3 = Ee[3] * C;
            x[0] *= f0; x[1] *= f1; x[2] *= f2; x[3] *= f3;
            C *= TT0 * Tt[0];
            bf16x8 pw[2];
#pragma unroll
            for (int j = 0; j < 2; ++j) { u32x4 p; p.x = cvt_pk_bf16(x[2 * j][0], x[2 * j][1]); p.y = cvt_pk_bf16(x[2 * j][2], x[2 * j][3]); p.z = cvt_pk_bf16(x[2 * j + 1][0], x[2 * j + 1][1]); p.w = cvt_pk_bf16(x[2 * j + 1][2], x[2 * j + 1][3]); pw[j] = __builtin_bit_cast(bf16x8, p); }
#pragma unroll
            for (int dt = 0; dt < 4; ++dt)
#pragma unroll
                for (int j = 0; j < 2; ++j) { const LAS bf16_t* vp = VT + (dt * 16 + fr) * SB_LD + j * 32 + 4 * fq; const u32x2 lo = *(const LAS u32x2*)vp, hi = *(const LAS u32x2*)(vp + 16);
                    u32x4 a; a.x = lo.x; a.y = lo.y; a.z = hi.x; a.w = hi.y; o[dt] = mfma16(__builtin_bit_cast(bf16x8, a), pw[j], o[dt]); }
            wdone = WAVE_ALL(C < 7.8886e-31f);
        }
    }
    bf16_t* op = OKP(bf16_t, WS_CAT1) + ((size_t)b * L + qrow) * 1536 + 1024 + hd * 64 + 4 * fq;
#pragma unroll
    for (int dt = 0; dt < 4; ++dt) { u32x2 w; w.x = cvt_pk_bf16(o[dt][0], o[dt][1]); w.y = cvt_pk_bf16(o[dt][2], o[dt][3]); *(u32x2*)(op + dt * 16) = w; }
}
#ifndef CVT_SUB
#define CVT_SUB 2
#endif
__device__ __forceinline__ void phase_l1_mix(const Frame& F0) {
    const Frame F = phase_frame(F0);
    constexpr int NU = GN_UNITS, UPX = NU / 8;
    if (F.G < 128 || F.G % 8 != 0) { if (F.vcu == 0) for (int u = 0; u < NU; ++u) { gdn_scan_unit(F, u); __syncthreads(); } for (int u = F.vcu; u < NB * 8 * (L / 128); u += F.G) { sb_unit(F, u); __syncthreads(); } phase_cvt_moe(F, 1); return; }
    const int per = F.G / 8, xcd = (int)blockIdx.x & 7, loc = (int)blockIdx.x >> 3  ;
    if (loc < UPX) { gdn_scan_unit(F, xcd * UPX + loc);
#if (DUP_MASK >> 3) & 1
        __syncthreads(); gdn_scan_unit(F, xcd * UPX + loc);
#endif
#if (DUP_MASK >> 21) & 1
        __syncthreads(); gdn_scan_unit_t<1>(F, xcd * UPX + loc);
#endif
    }
    else { for (int rep = 0; rep < 1 + ((DUP_MASK >> 16) & 1); ++rep) for (int u = xcd * (per - UPX) + (loc - UPX); u < NB * 8 * (L / 128); u += F.G - NU) { sb_unit(F, u); __syncthreads(); }
        { const int sbi = xcd * (per - UPX) + (loc - UPX), nsb = F.G - NU; if (sbi % CVT_SUB == 0) phase_cvt_moe(F, 1, sbi / CVT_SUB, (nsb + CVT_SUB - 1) / CVT_SUB); } }
}
}

namespace ok {
#if CHECK
__device__ const int kSampleRows[16] = {0, 1, 2, 3, 63, 64, 127, 128, 129, 1000, 2047, 2048, 4097, 6000, 8190, 8191};
constexpr int FP_W = 6144;
__device__ __forceinline__ void fp_save(const Frame& F, int k, const void* buf, int ld, int width, bool is_bf16, int dcol0) {
    float* fp = OKP(float, WS_FP) + (size_t)k * 16 * FP_W; const size_t gt = (size_t)blockIdx.x * NT + F.tid, GT = (size_t)F.G * NT;
    for (size_t i = gt; i < (size_t)16 * width; i += GT) { const int r = (int)(i / width), c = (int)(i % width); const size_t src = (size_t)kSampleRows[r] * ld + c;
        fp[r * FP_W + dcol0 + c] = is_bf16 ? bf2f(((const bf16_t*)buf)[src]) : ((const float*)buf)[src]; }
}
__device__ __forceinline__ void fp_cmp(const Frame& F, int k, const float* obuf, int ld, int ocol0, int width, int fcol0) {
    const float* fp = OKP(float, WS_FP) + (size_t)k * 16 * FP_W; const size_t gt = (size_t)blockIdx.x * NT + F.tid, GT = (size_t)F.G * NT; float num = 0.f, den = 0.f;
    for (size_t i = gt; i < (size_t)16 * width; i += GT) { const int r = (int)(i / width), c = (int)(i % width); const float o = obuf[(size_t)kSampleRows[r] * ld + ocol0 + c], f = fp[r * FP_W + fcol0 + c];
        const float d = o - f; num += d * d; den += o * o; if (!(d == d)) num += 1e30f; }
    num = wave_sum(num); den = wave_sum(den);
    if (F.lane == 0 && (num != 0.f || den != 0.f)) { atomicAdd((float*)F.ctl + CW_CHK + 2 * k, num); atomicAdd((float*)F.ctl + CW_CHK + 2 * k + 1, den); }
}
__device__ __forceinline__ void fp_save_lin(const Frame& F, int k, const void* buf, size_t off, int n, bool is_bf16) {
    float* fp = OKP(float, WS_FP) + (size_t)k * 16 * FP_W; const size_t gt = (size_t)blockIdx.x * NT + F.tid, GT = (size_t)F.G * NT;
    for (size_t i = gt; i < (size_t)n; i += GT) fp[i] = is_bf16 ? bf2f(((const bf16_t*)buf)[off + i]) : ((const float*)buf)[off + i];
}
__device__ __forceinline__ void fp_cmp_lin(const Frame& F, int k, const float* obuf, size_t off, int n) {
    const float* fp = OKP(float, WS_FP) + (size_t)k * 16 * FP_W; const size_t gt = (size_t)blockIdx.x * NT + F.tid, GT = (size_t)F.G * NT; float num = 0.f, den = 0.f;
    for (size_t i = gt; i < (size_t)n; i += GT) { const float o = obuf[off + i], f = fp[i]; const float d = o - f; num += d * d; den += o * o; if (!(d == d)) num += 1e30f; }
    num = wave_sum(num); den = wave_sum(den);
    if (F.lane == 0 && (num != 0.f || den != 0.f)) { atomicAdd((float*)F.ctl + CW_CHK + 2 * k, num); atomicAdd((float*)F.ctl + CW_CHK + 2 * k + 1, den); }
}
#endif

struct Args { const float* in[33]; float* out; unsigned char* ws;
#if CHECK
    sm::Ctx oc;
#endif
};

__global__ void __launch_bounds__(512, 2) mk_fwd(Args a) {
    extern __shared__ __attribute__((aligned(16))) unsigned char lds_raw[];
    Frame F; F.lds = (LAS unsigned char*)lds_raw; F.ws = a.ws; F.ctl = (unsigned*)(a.ws + WS_CTL); F.in = a.in; F.out = a.out;
    F.tid = threadIdx.x; F.lane = F.tid & 63; F.wave = __builtin_amdgcn_readfirstlane(F.tid >> 6); F.G = gridDim.x;
    { const int bx = blockIdx.x; F.vcu = (F.G % 8 == 0) ? (bx % 8) * (F.G / 8) + bx / 8 : bx; }
    volatile LAS unsigned* MISC = (volatile LAS unsigned*)(F.lds + LDS_BYTES - 64);
    if (F.tid < 16) MISC[F.tid] = 0u;
    __syncthreads();
    XcdBarrier bar = xcd_barrier_post(F.ctl + CW_BAR, MISC);
#define GRID_BAR() xcd_barrier(bar)
    using namespace sm;
    for (int dup_p = 0; dup_p < ((DUP_MASK >> 5) & 1) + 1; ++dup_p) {
    phase_prologue(F);
    prologue_router_tables(F);
    prologue_w16_tables(F);
    GRID_BAR();
    }
#if (DUP_MASK >> 17) & 3
    { EpiScaleBf16 E{OKP(bf16_t, WS_PROJ), PROJ0_LD, (const float*)F.ctl + CW_SSQ, 1};
      pg8::Gemm g{OKP(bf16_t, WS_HB), OKP(bf16_t, WS_W_IN0), T, 4096, ((DUP_MASK >> 17) & 1) ? 512 : 1024}; pg8::StaticOrder S; S.init(g, F.G, (int)blockIdx.x); if ((DUP_MASK >> 18) & 1) S.tstep = 0;
      pg8::gemm_phase<EpiScaleBf16, pg8::StaticOrder, true, true>(F.lds, g, S, E, F.wave); GRID_BAR(); }
#endif
    for (int dup_i0 = 0; dup_i0 < ((DUP_MASK >> 6) & 1) + 1; ++dup_i0) {
    { EpiScaleBf16 E{OKP(bf16_t, WS_PROJ), PROJ0_LD, (const float*)F.ctl + CW_SSQ, 1};
      dense_gemm(F, OKP(bf16_t, WS_HB), OKP(bf16_t, WS_W_IN0), T, 4096, 1024, E); }
    phase_proj16(F, 0, F.in[I_X], nullptr, (const float*)F.ctl + CW_SSQ, 1);
    GRID_BAR();
    }
#if CHECK
    fp_save(F, 0, OKP(bf16_t, WS_PROJ), PROJ0_LD, 4096, true, 0);
#endif
    for (int dup_b = 0; dup_b < ((DUP_MASK >> 1) & 1) + 1; ++dup_b) {
    for (int dup_b1 = 0; dup_b1 < ((DUP_MASK >> 14) & 1) + 1; ++dup_b1) { phase_ssd_a(F); GRID_BAR(); }
#if CHECK
    fp_save_lin(F, 6, OKP(bf16_t, WS_STATES), ((size_t)5 * 16 + 0) * 8192, 65536, true);
    GRID_BAR();
#endif
    phase_kv(F);
    phase_ssd_scan(F, (F.G >= 64 && F.G % 8 == 0) ? 32 : 0);
    GRID_BAR();
    for (int dup_b2 = 0; dup_b2 < ((DUP_MASK >> 15) & 1) + 1; ++dup_b2) { phase_ssd_b(F); GRID_BAR(); }
    }

    for (int dup_o0 = 0; dup_o0 < ((DUP_MASK >> 8) & 1) + 1; ++dup_o0) {
    { EpiResidualT<true> E{F.in[I_X], OKP(bf16_t, WS_HB), OKP(float, WS_SSQP1)};
      dense_gemm(F, OKP(bf16_t, WS_CAT0), OKP(bf16_t, WS_W_OUT0), T, 1024, 1536, E); }
    GRID_BAR();
    }
#if CHECK
    fp_save(F, 10, OKP(bf16_t, WS_HB), 1024, 1024, true, 0);
    fp_save_lin(F, 7, OKP(bf16_t, WS_STATES), ((size_t)5 * 16 + 0) * 8192, 65536, true);
    fp_save(F, 8, OKP(bf16_t, WS_CAT0), 1536, 512, true, 0);
    fp_save(F, 9, OKP(bf16_t, WS_CAT0) + 512, 1536, 1024, true, 0);
    GRID_BAR();
#endif
    for (int dup_q0 = 0; dup_q0 < ((DUP_MASK >> 9) & 1) + 1; ++dup_q0) {
    { EpiScaleBf16 E{OKP(bf16_t, WSL_Q), 1024, OKP(float, WS_SSQP1), 16};
      dense_gemm(F, OKP(bf16_t, WS_HB), OKP(bf16_t, WS_W_XA), T, 1024, 1024, E); }
    GRID_BAR();
    }
    for (int dup_xa0 = 0; dup_xa0 < ((DUP_MASK >> 13) & 1) + 1; ++dup_xa0) {
    phase_xattn(F, OKP(bf16_t, WSL_Q), OKP(bf16_t, WS_KX), OKP(bf16_t, WS_VT), OKP(bf16_t, WSL_ATT));
    GRID_BAR();
    }
    { EpiResidualT<false> E{nullptr, OKP(bf16_t, WS_HB), OKP(float, WS_SSQP2)};
      dense_gemm(F, OKP(bf16_t, WSL_ATT), OKP(bf16_t, WS_W_XA + 6 * MiB), T, 1024, 1024, E); }
    GRID_BAR();
#if CHECK
    fp_save(F, 11, OKP(bf16_t, WS_HB), 1024, 1024, true, 0);
    GRID_BAR();
#endif
    phase_router(F, 0, OKP(bf16_t, WS_HB), OKP(float, WS_SSQP2), 16);
    for (int dup_cv = 0; dup_cv < ((DUP_MASK >> 10) & 1) + 1; ++dup_cv) phase_cvt_moe(F, 0);
    GRID_BAR();
    for (int dup_sc = 0; dup_sc < ((DUP_MASK >> 11) & 1) + 1; ++dup_sc) {
    phase_scatter(F, 0, OKP(bf16_t, WS_HB), OKP(float, WS_SSQP2), 16);
    GRID_BAR();
    }
    for (int dup_c = 0; dup_c < ((DUP_MASK >> 2) & 1) + 1; ++dup_c) {
    phase_moe_up(F);
    GRID_BAR();
    phase_moe_down(F);
    GRID_BAR();
    }

    phase_combine(F, OKP(bf16_t, WS_HB), (float*)F.ctl + CW_SSQ + 3 * T, false);
    GRID_BAR();
#if CHECK
    fp_save(F, 12, OKP(bf16_t, WS_HB), 1024, 1024, true, 0);
    GRID_BAR();
#endif
    F.lay = 1;
    for (int dup_i1 = 0; dup_i1 < ((DUP_MASK >> 12) & 1) + 1; ++dup_i1) {
    { EpiScaleBf16 E{OKP(bf16_t, WS_PROJ1A), PROJ1A_LD, (const float*)F.ctl + CW_SSQ + 3 * T, 1, OKP(bf16_t, WS_PROJ1B), PROJ1B_LD, 3072};
      dense_gemm(F, OKP(bf16_t, WS_HB), OKP(bf16_t, WS_W_IN1), T, 5632, 1024, E); }
    phase_proj16(F, 1, nullptr, OKP(bf16_t, WS_HB), (const float*)F.ctl + CW_SSQ + 3 * T, 1);
    GRID_BAR();
    }
#if CHECK
    fp_save(F, 13, OKP(bf16_t, WS_PROJ), PROJ1_LD, 4096, true, 0);
    fp_save(F, 13, OKP(bf16_t, WS_PROJ) + 4608, PROJ1_LD, 1024, true, 4096);
#endif
#if (DUP_MASK >> 22) & 255
    phase_gdn_prep_t<(DUP_MASK >> 22) & 255>(F); GRID_BAR();
#endif
    for (int dup_a = 0; dup_a < ((DUP_MASK >> 0) & 1) + 1; ++dup_a) { phase_gdn_prep(F); GRID_BAR(); }
    phase_l1_mix(F); GRID_BAR();
    for (int dup_e = 0; dup_e < ((DUP_MASK >> 4) & 1) + 1; ++dup_e) { phase_gdn_final(F); GRID_BAR(); }

    { EpiResidualT<false> E{nullptr, OKP(bf16_t, WS_HB), OKP(float, WS_SSQP4)};
      dense_gemm(F, OKP(bf16_t, WS_CAT1), OKP(bf16_t, WS_W_OUT1), T, 1024, 1536, E); }
    GRID_BAR();
#if CHECK
    fp_save(F, 14, OKP(bf16_t, WS_CAT1), 1536, 1024, true, 0);
    fp_save(F, 15, OKP(bf16_t, WS_CAT1) + 1024, 1536, 512, true, 0);
    fp_save(F, 16, OKP(bf16_t, WS_HB), 1024, 1024, true, 0);
    GRID_BAR();
#endif
    { EpiScaleBf16 E{OKP(bf16_t, WSL_Q), 1024, OKP(float, WS_SSQP4), 16};
      dense_gemm(F, OKP(bf16_t, WS_HB), OKP(bf16_t, WS_W_XA + 8 * MiB), T, 1024, 1024, E); }
    GRID_BAR();
    phase_xattn(F, OKP(bf16_t, WSL_Q), OKP(bf16_t, WS_KX) + (size_t)NB * 256 * 1024, OKP(bf16_t, WS_VT) + (size_t)1024 * NB * 256, OKP(bf16_t, WSL_ATT));
    GRID_BAR();
    { EpiResidualT<false> E{nullptr, OKP(bf16_t, WS_HB), OKP(float, WS_SSQP5)};
      dense_gemm(F, OKP(bf16_t, WSL_ATT), OKP(bf16_t, WS_W_XA + 8 * MiB + 6 * MiB), T, 1024, 1024, E); }
    GRID_BAR();
#if CHECK
    fp_save(F, 17, OKP(bf16_t, WS_HB), 1024, 1024, true, 0);
    GRID_BAR();
#endif
    phase_router(F, 1, OKP(bf16_t, WS_HB), OKP(float, WS_SSQP5), 16);
    GRID_BAR();
    phase_scatter(F, 1, OKP(bf16_t, WS_HB), OKP(float, WS_SSQP5), 16);
    GRID_BAR();
    phase_moe_up(F);
    GRID_BAR();
    phase_moe_down(F);
    GRID_BAR();
    phase_combine(F, OKP(bf16_t, WS_HB), nullptr, true);
#if CHECK
    GRID_BAR();
    fp_save(F, 18, F.out, 1024, 1024, false, 0);
    fp_save(F, 1, OKP(float, WS_DTV), 16, 16, false, 0);
    fp_save(F, 2, OKP(float, WS_ACS), 16, 16, false, 0);
    GRID_BAR();
    {
        const size_t gid = (size_t)blockIdx.x * NT + F.tid, gs = (size_t)F.G * NT;
        for (int st = 0;; ++st) {
            const int s = st % sm::NSTAGE_L;
            if (st < 2 * sm::NSTAGE_L && s >= sm::N_STAGES_USED) continue;
            if (!sm::run_stage(a.oc, st, gid, gs)) break;
            GRID_BAR();
            if (st == 3) fp_cmp(F, 0, a.oc.proj, sm::PROJ_LD, 0, 4096, 0);
            if (st == 4) { fp_cmp(F, 1, a.oc.dtv, 16, 0, 16, 0); fp_cmp(F, 2, a.oc.acs, 16, 0, 16, 0); }
            if (st == 4 && gid == 0) { float* c = (float*)F.ctl + CW_CHK; c[6] = 0.f; c[7] = 1.f; c[8] = 0.f; c[9] = 1.f; c[10] = 0.f; c[11] = 1.f; }
            if (st == 5) fp_cmp_lin(F, 6, a.oc.states, ((size_t)5 * 16 + 0) * 8192, 65536);
            if (st == 6) fp_cmp_lin(F, 7, a.oc.states, ((size_t)5 * 16 + 0) * 8192, 65536);
            if (st == 10) { fp_cmp(F, 8, a.oc.cat, 1536, 0, 512, 0); fp_cmp(F, 9, a.oc.cat, 1536, 512, 1024, 0); }
            if (st == 11) fp_cmp(F, 10, a.oc.h, 1024, 0, 1024, 0);
            if (st == 18) fp_cmp(F, 11, a.oc.h, 1024, 0, 1024, 0);
            if (st == 23) fp_cmp(F, 12, a.oc.h, 1024, 0, 1024, 0);
            if (st == 63) { fp_cmp(F, 13, a.oc.proj, sm::PROJ_LD, 0, 4096, 0); fp_cmp(F, 13, a.oc.proj, sm::PROJ_LD, 4624, 1024, 4096); }
            if (st == 70) { fp_cmp(F, 14, a.oc.cat, 1536, 0, 1024, 0); fp_cmp(F, 15, a.oc.cat, 1536, 1024, 512, 0); }
            if (st == 71) fp_cmp(F, 16, a.oc.h, 1024, 0, 1024, 0);
            if (st == 78) fp_cmp(F, 17, a.oc.h, 1024, 0, 1024, 0);
            if (st == 121) fp_cmp(F, 18, a.oc.out, 1024, 0, 1024, 0);
            GRID_BAR();
        }
        GRID_BAR();
        int code = 0;
        for (int k = CHECK - 1; k >= 0; --k) { const float num = __hip_atomic_load((float*)F.ctl + CW_CHK + 2 * k, __ATOMIC_RELAXED, __HIP_MEMORY_SCOPE_AGENT), den = __hip_atomic_load((float*)F.ctl + CW_CHK + 2 * k + 1, __ATOMIC_RELAXED, __HIP_MEMORY_SCOPE_AGENT);
            if (!(num <= 1e-3f * den) || den == 0.f) code = k + 1; }
        const float sc = 1.f + 0.2f * (float)code;
        for (size_t i = gid; i < (size_t)L * DM; i += gs) { F.out[i] *= sc; F.out[(size_t)L * DM + i] = 0.f; }
    }
#endif
}
}

extern "C" void kernel_launch(void* const* d_in, const int* in_sizes, int n_in, void* d_out, int out_size, void* d_ws, size_t ws_size, hipStream_t stream) {
    static int grid = 0;
    if (grid == 0) {
        int dev = 0, cus = 0, per_cu = 0;
        hipGetDevice(&dev); hipDeviceGetAttribute(&cus, hipDeviceAttributeMultiprocessorCount, dev);
        if (hipFuncSetAttribute((const void*)ok::mk_fwd, hipFuncAttributeMaxDynamicSharedMemorySize, LDS_BYTES) != hipSuccess) { fprintf(stderr, "kernel_launch: hipFuncSetAttribute failed\n"); grid = -1; return; }
        hipOccupancyMaxActiveBlocksPerMultiprocessor(&per_cu, (const void*)ok::mk_fwd, ok::NT, LDS_BYTES);
        (void)hipGetLastError();
        grid = cus;
        if (n_in != 33 || ws_size < ok::WS_END || per_cu < 1) { fprintf(stderr, "kernel_launch: n_in %d ws %zu need %zu per_cu %d\n", n_in, ws_size, (size_t)ok::WS_END, per_cu); grid = -1; }
    }
    if (grid < 0) return;
    hipMemsetAsync((char*)d_ws + ok::WS_CTL, 0, ok::CTL_BYTES, stream);
    ok::Args a{};
    for (int i = 0; i < 33; ++i) a.in[i] = (const float*)d_in[i];
    a.out = (float*)d_out; a.ws = (unsigned char*)d_ws;
#if CHECK
    sm::carve(a.oc, (float*)((char*)d_ws + 16 * ok::MiB));
    for (int i = 0; i < 33; ++i) a.oc.in[i] = (const float*)d_in[i];
    a.oc.out = (float*)d_out;
#endif
    hipLaunchKernelGGL(ok::mk_fwd, dim3(grid), dim3(ok::NT), LDS_BYTES, stream, a);
}
```
